# Optimizing an MI355X kernel written in HIP

```python
import math
import jax, jax.numpy as jnp
from jax import lax
import numpy as np

D_MODEL = 1024
BATCH = 8
SEQ = 2048
DEPTH = 2

RET_HEADS = 4
RET_WIDTH = D_MODEL // 2
RET_HEAD_DIM = RET_WIDTH // RET_HEADS
RET_CHUNK = 128
S5_WIDTH = D_MODEL // 2
S5_GROUP_CH = 16
S5_GROUPS = S5_WIDTH // S5_GROUP_CH
S5_STATE = 64
IN_WIDTH = 4 * RET_WIDTH + S5_WIDTH
SWA_HEAD_DIM = 64
SWA_HEADS = D_MODEL // SWA_HEAD_DIM
SWA_KV_HEADS = SWA_HEADS // 4
SWA_Q_PER_KV = SWA_HEADS // SWA_KV_HEADS
SWA_WINDOW = 128
SWA_BLOCK = 128
REL_BUCKETS = 32
REL_MAX_DIST = 128
MOE_GROUPS = 4
MOE_EXPERTS_PER_GROUP = 8
MOE_EXPERTS = MOE_GROUPS * MOE_EXPERTS_PER_GROUP
MOE_TOP_K = 2
MOE_HIDDEN = D_MODEL // 2
MOE_BLOCK = 128
ROPE_BASE = 10000.0
RMS_EPS = 1e-6
GN_EPS = 1e-5
NEG_INF = -1e30

kernel_name = 'hybrid_retention_s5_swa_hmoe_encoder'


def rms_norm(x, g):
    xf = x.astype(jnp.float32)
    y = xf * lax.rsqrt(jnp.mean(xf * xf, axis=-1, keepdims=True) + RMS_EPS)
    return (y * g.astype(jnp.float32)).astype(x.dtype)


def rotary(t):
    seq, dim = t.shape[1], t.shape[-1]
    inv_freq = ROPE_BASE ** (-jnp.arange(0, dim, 2, dtype=jnp.float32) / dim)
    ang = jnp.arange(seq, dtype=jnp.float32)[:, None] * inv_freq[None, :]
    cos = jnp.cos(ang)[None, :, None, :]
    sin = jnp.sin(ang)[None, :, None, :]
    t1, t2 = t[..., : dim // 2], t[..., dim // 2:]
    return jnp.concatenate([t1 * cos - t2 * sin, t1 * sin + t2 * cos], axis=-1)


def chunk_state_scan(inc, chunk_decay, reverse):
    def step(state, inc_c):
        return state * chunk_decay + inc_c, state
    _, states = lax.scan(step, jnp.zeros_like(inc[0]), inc, reverse=reverse)
    return states


def bidirectional_retention(q, k, v, decay_logit):
    bsz, seq, nh, dk = q.shape
    dv = v.shape[-1]
    nc = seq // RET_CHUNK
    log_gamma = jax.nn.log_sigmoid(decay_logit.astype(jnp.float32))
    lg_f, lg_b = log_gamma[0], log_gamma[1]
    pos = jnp.arange(RET_CHUNK, dtype=jnp.float32)
    rel = pos[:, None] - pos[None, :]
    lg_sel = jnp.where(rel[None] >= 0, lg_f[:, None, None], lg_b[:, None, None])
    decay_mask = jnp.exp(jnp.abs(rel)[None] * lg_sel)
    qc = q.reshape(bsz, nc, RET_CHUNK, nh, dk)
    kc = k.reshape(bsz, nc, RET_CHUNK, nh, dk)
    vc = v.reshape(bsz, nc, RET_CHUNK, nh, dv)
    scores = jnp.einsum('bnihd,bnjhd->bnhij', qc, kc) * decay_mask
    out = jnp.einsum('bnhij,bnjhe->bnihe', scores, vc)
    k_f = kc * jnp.exp((RET_CHUNK - 1.0 - pos)[:, None] * lg_f[None, :])[:, :, None]
    inc_f = jnp.einsum('bnjhd,bnjhe->nbhde', k_f, vc)
    s_prev = chunk_state_scan(inc_f, jnp.exp(RET_CHUNK * lg_f)[:, None, None], reverse=False)
    q_f = qc * jnp.exp((pos + 1.0)[:, None] * lg_f[None, :])[:, :, None]
    out = out + jnp.einsum('bnihd,nbhde->bnihe', q_f, s_prev)
    k_b = kc * jnp.exp(pos[:, None] * lg_b[None, :])[:, :, None]
    inc_b = jnp.einsum('bnjhd,bnjhe->nbhde', k_b, vc)
    s_next = chunk_state_scan(inc_b, jnp.exp(RET_CHUNK * lg_b)[:, None, None], reverse=True)
    q_b = qc * jnp.exp((RET_CHUNK - pos)[:, None] * lg_b[None, :])[:, :, None]
    out = out + jnp.einsum('bnihd,nbhde->bnihe', q_b, s_next)
    return out.reshape(bsz, seq, nh, dv)


def complex_affine_combine(e1, e2):
    a1r, a1i, b1r, b1i = e1
    a2r, a2i, b2r, b2i = e2
    return (a1r * a2r - a1i * a2i,
            a1r * a2i + a1i * a2r,
            a2r * b1r - a2i * b1i + b2r,
            a2r * b1i + a2i * b1r + b2i)


def s5_glu(u, a_re, a_im, log_step, b_re, b_im, c_re, c_im, d_skip, w_glu, b_glu):
    bsz, seq, _ = u.shape
    ug = u.reshape(bsz, seq, S5_GROUPS, S5_GROUP_CH)
    bre, bim = b_re.astype(jnp.float32), b_im.astype(jnp.float32)
    y = ug * d_skip.astype(jnp.float32)
    for direction in range(2):
        ar = a_re[direction].astype(jnp.float32)
        ai = a_im[direction].astype(jnp.float32)
        dt = jnp.exp(log_step[direction].astype(jnp.float32))[:, None]
        mag = jnp.exp(ar * dt)
        lam_re, lam_im = mag * jnp.cos(ai * dt), mag * jnp.sin(ai * dt)
        nr, ni = lam_re - 1.0, lam_im
        den = ar * ar + ai * ai
        coef_re = (nr * ar + ni * ai) / den
        coef_im = (ni * ar - nr * ai) / den
        bbar_re = coef_re[..., None] * bre - coef_im[..., None] * bim
        bbar_im = coef_re[..., None] * bim + coef_im[..., None] * bre
        bu_re = jnp.einsum('blgc,gpc->blgp', ug, bbar_re)
        bu_im = jnp.einsum('blgc,gpc->blgp', ug, bbar_im)
        lam_re_b = jnp.broadcast_to(lam_re, bu_re.shape)
        lam_im_b = jnp.broadcast_to(lam_im, bu_re.shape)
        _, _, x_re, x_im = lax.associative_scan(
            complex_affine_combine, (lam_re_b, lam_im_b, bu_re, bu_im), axis=1, reverse=(direction == 1))
        y = (y + jnp.einsum('blgp,gcp->blgc', x_re, c_re[direction].astype(jnp.float32))
             - jnp.einsum('blgp,gcp->blgc', x_im, c_im[direction].astype(jnp.float32)))
    y = jax.nn.gelu(y.reshape(bsz, seq, S5_WIDTH))
    return y * jax.nn.sigmoid(y @ w_glu.astype(jnp.float32) + b_glu.astype(jnp.float32))


def hybrid_retention_s5(h, w_in, decay_logit, a_re, a_im, log_step, b_re, b_im, c_re, c_im,
                        d_skip, w_glu, b_glu, w_out):
    bsz, seq, _ = h.shape
    z = (h @ w_in).astype(jnp.float32)
    q, k, v, g, u = jnp.split(z, [RET_WIDTH, 2 * RET_WIDTH, 3 * RET_WIDTH, 4 * RET_WIDTH], axis=-1)
    q = rotary(q.reshape(bsz, seq, RET_HEADS, RET_HEAD_DIM))
    k = rotary(k.reshape(bsz, seq, RET_HEADS, RET_HEAD_DIM)) * (RET_HEAD_DIM ** -0.5)
    v = v.reshape(bsz, seq, RET_HEADS, RET_HEAD_DIM)
    r = bidirectional_retention(q, k, v, decay_logit)
    mu = jnp.mean(r, axis=-1, keepdims=True)
    var = jnp.mean(jnp.square(r - mu), axis=-1, keepdims=True)
    r = ((r - mu) * lax.rsqrt(var + GN_EPS)).reshape(bsz, seq, RET_WIDTH)
    y_ret = jax.nn.silu(g) * r
    y_s5 = s5_glu(u, a_re, a_im, log_step, b_re, b_im, c_re, c_im, d_skip, w_glu, b_glu)
    return jnp.concatenate([y_ret, y_s5], axis=-1).astype(h.dtype) @ w_out


def t5_bucket(rel):
    half = REL_BUCKETS // 2
    max_exact = half // 2
    n = jnp.abs(rel)
    large = max_exact + (jnp.log(jnp.maximum(n, 1).astype(jnp.float32) / max_exact)
                         / math.log(REL_MAX_DIST / max_exact) * (half - max_exact)).astype(jnp.int32)
    large = jnp.minimum(large, half - 1)
    return jnp.where(rel > 0, half, 0) + jnp.where(n < max_exact, n, large)


def windowed_gqa(h, w_qkv, sink, w_o, rel_bias):
    bsz, seq, _ = h.shape
    nb = seq // SWA_BLOCK
    qd = SWA_HEADS * SWA_HEAD_DIM
    kvd = SWA_KV_HEADS * SWA_HEAD_DIM
    qkv = h @ w_qkv
    q = qkv[..., :qd].reshape(bsz, nb, SWA_BLOCK, SWA_KV_HEADS, SWA_Q_PER_KV, SWA_HEAD_DIM)
    k = qkv[..., qd:qd + kvd].reshape(bsz, seq, SWA_KV_HEADS, SWA_HEAD_DIM)
    v = qkv[..., qd + kvd:].reshape(bsz, seq, SWA_KV_HEADS, SWA_HEAD_DIM)

    def band(t):
        tp = jnp.pad(t, ((0, 0), (SWA_BLOCK, SWA_BLOCK), (0, 0), (0, 0)))
        tp = tp.reshape(bsz, nb + 2, SWA_BLOCK, SWA_KV_HEADS, SWA_HEAD_DIM)
        return jnp.concatenate([tp[:, :-2], tp[:, 1:-1], tp[:, 2:]], axis=2)

    kb, vb = band(k), band(v)
    s = jnp.einsum('bnqkgd,bnskd->bnkgqs', q, kb).astype(jnp.float32) * (SWA_HEAD_DIM ** -0.5)
    rel = jnp.arange(3 * SWA_BLOCK)[None, :] - SWA_BLOCK - jnp.arange(SWA_BLOCK)[:, None]
    bias = rel_bias.astype(jnp.float32)[t5_bucket(rel)]
    bias = bias.transpose(2, 0, 1).reshape(SWA_KV_HEADS, SWA_Q_PER_KV, SWA_BLOCK, 3 * SWA_BLOCK)
    key_pos = (jnp.arange(nb)[:, None] - 1) * SWA_BLOCK + jnp.arange(3 * SWA_BLOCK)[None, :]
    mask = (jnp.abs(rel) <= SWA_WINDOW)[None] & ((key_pos >= 0) & (key_pos < seq))[:, None, :]
    s = jnp.where(mask[None, :, None, None], s + bias, NEG_INF)
    sink_col = jnp.broadcast_to(sink.astype(jnp.float32).reshape(SWA_KV_HEADS, SWA_Q_PER_KV, 1, 1),
                                s.shape[:-1] + (1,))
    p = jax.nn.softmax(jnp.concatenate([s, sink_col], axis=-1), axis=-1)[..., :-1]
    o = jnp.einsum('bnkgqs,bnskd->bnqkgd', p.astype(vb.dtype), vb).reshape(bsz, seq, qd)
    return o @ w_o


def hier_moe(h, w_group, b_group, w_er, b_er, w_gate, w_up, w_down):
    bsz, seq, d = h.shape
    t = h.reshape(-1, d)
    n_tok = t.shape[0]
    g_logit = (t @ w_group).astype(jnp.float32) + b_group.astype(jnp.float32)
    g_prob = jax.nn.softmax(g_logit, axis=-1)
    g_sel = jnp.argmax(g_logit, axis=-1)
    p_g = jnp.take_along_axis(g_prob, g_sel[:, None], axis=-1)[:, 0]
    e_logit = jnp.einsum('td,gde->tge', t, w_er).astype(jnp.float32) + b_er.astype(jnp.float32)
    e_logit = jnp.take_along_axis(e_logit, g_sel[:, None, None], axis=1)[:, 0]
    top_v, top_i = lax.top_k(e_logit, MOE_TOP_K)
    gate = jax.nn.softmax(top_v, axis=-1) * p_g[:, None]
    expert = g_sel[:, None] * MOE_EXPERTS_PER_GROUP + top_i
    n_asg = n_tok * MOE_TOP_K
    e_flat = expert.reshape(-1)
    tok_flat = jnp.arange(n_asg) // MOE_TOP_K
    order = jnp.argsort(e_flat)
    e_sorted = e_flat[order]
    tok_sorted = tok_flat[order]
    gate_sorted = gate.reshape(-1)[order].astype(t.dtype)
    counts = jnp.bincount(e_flat, length=MOE_EXPERTS)
    padded = ((counts + MOE_BLOCK - 1) // MOE_BLOCK) * MOE_BLOCK
    start = jnp.cumsum(counts) - counts
    pend = jnp.cumsum(padded)
    pstart = pend - padded
    dest = pstart[e_sorted] + jnp.arange(n_asg) - start[e_sorted]
    n_blocks = -(-n_asg // MOE_BLOCK) + MOE_EXPERTS
    xbuf = jnp.zeros((n_blocks * MOE_BLOCK, d), t.dtype).at[dest].set(t[tok_sorted])
    block_expert = jnp.minimum(
        jnp.searchsorted(pend, jnp.arange(n_blocks) * MOE_BLOCK, side='right'), MOE_EXPERTS - 1)

    def expert_block(args):
        xb, e = args
        return (jax.nn.silu(xb @ w_gate[e]) * (xb @ w_up[e])) @ w_down[e]

    ybuf = lax.map(expert_block, (xbuf.reshape(n_blocks, MOE_BLOCK, d), block_expert)).reshape(-1, d)
    y = jnp.zeros_like(t).at[tok_sorted].add(ybuf[dest] * gate_sorted[:, None])
    return y.reshape(bsz, seq, d)


def setup_inputs(seed: int = 0) -> dict:
    key = jax.random.key(seed)
    ks = iter(jax.random.split(key, 40))
    f32 = jnp.float32
    n_even = (DEPTH + 1) // 2
    n_odd = DEPTH // 2

    def nrm(shape, scale):
        return jax.random.normal(next(ks), shape, f32) * scale

    x = nrm((BATCH, SEQ, D_MODEL), 1.0)
    norm_mix_g = 1.0 + nrm((DEPTH, D_MODEL), 0.02)
    norm_ffn_g = 1.0 + nrm((DEPTH, D_MODEL), 0.02)
    norm_final_g = 1.0 + nrm((D_MODEL,), 0.02)
    hyb_w_in = nrm((n_even, D_MODEL, IN_WIDTH), D_MODEL ** -0.5)
    heads = jnp.arange(RET_HEADS, dtype=f32)
    ret_logit0 = jnp.log(2.0 ** (5.0 + heads) - 1.0)
    ret_decay_logit = ret_logit0[None, None, :] + nrm((n_even, 2, RET_HEADS), 0.01)
    s5_a_re = -0.5 + nrm((n_even, 2, S5_GROUPS, S5_STATE), 0.01)
    s5_a_im = jnp.pi * jnp.arange(S5_STATE, dtype=f32) + nrm((n_even, 2, S5_GROUPS, S5_STATE), 0.01)
    s5_log_step = jax.random.uniform(next(ks), (n_even, 2, S5_GROUPS), f32,
                                     minval=math.log(1e-3), maxval=math.log(1e-1))
    s5_b_re = nrm((n_even, S5_GROUPS, S5_STATE, S5_GROUP_CH), (2 * S5_GROUP_CH) ** -0.5)
    s5_b_im = nrm((n_even, S5_GROUPS, S5_STATE, S5_GROUP_CH), (2 * S5_GROUP_CH) ** -0.5)
    s5_c_re = nrm((n_even, 2, S5_GROUPS, S5_GROUP_CH, S5_STATE), S5_STATE ** -0.5)
    s5_c_im = nrm((n_even, 2, S5_GROUPS, S5_GROUP_CH, S5_STATE), S5_STATE ** -0.5)
    s5_d = nrm((n_even, S5_GROUPS, S5_GROUP_CH), 0.5)
    s5_w_glu = nrm((n_even, S5_WIDTH, S5_WIDTH), S5_WIDTH ** -0.5)
    s5_b_glu = nrm((n_even, S5_WIDTH), 0.02)
    hyb_w_out = nrm((n_even, RET_WIDTH + S5_WIDTH, D_MODEL), (RET_WIDTH + S5_WIDTH) ** -0.5)
    qkv_width = (SWA_HEADS + 2 * SWA_KV_HEADS) * SWA_HEAD_DIM
    swa_w_qkv = nrm((n_odd, D_MODEL, qkv_width), D_MODEL ** -0.5)
    swa_sink = nrm((n_odd, SWA_HEADS), 0.5)
    swa_w_o = nrm((n_odd, SWA_HEADS * SWA_HEAD_DIM, D_MODEL), (SWA_HEADS * SWA_HEAD_DIM) ** -0.5)
    rel_bias = nrm((REL_BUCKETS, SWA_HEADS), 0.5)
    moe_w_group = nrm((DEPTH, D_MODEL, MOE_GROUPS), D_MODEL ** -0.5)
    moe_b_group = nrm((DEPTH, MOE_GROUPS), 0.01)
    moe_w_expert_router = nrm((DEPTH, MOE_GROUPS, D_MODEL, MOE_EXPERTS_PER_GROUP), D_MODEL ** -0.5)
    moe_b_expert_router = nrm((DEPTH, MOE_GROUPS, MOE_EXPERTS_PER_GROUP), 0.01)
    moe_w_gate = nrm((DEPTH, MOE_EXPERTS, D_MODEL, MOE_HIDDEN), D_MODEL ** -0.5)
    moe_w_up = nrm((DEPTH, MOE_EXPERTS, D_MODEL, MOE_HIDDEN), D_MODEL ** -0.5)
    moe_w_down = nrm((DEPTH, MOE_EXPERTS, MOE_HIDDEN, D_MODEL), MOE_HIDDEN ** -0.5)
    return {'x': x, 'norm_mix_g': norm_mix_g, 'norm_ffn_g': norm_ffn_g, 'norm_final_g': norm_final_g,
            'hyb_w_in': hyb_w_in, 'ret_decay_logit': ret_decay_logit, 's5_a_re': s5_a_re,
            's5_a_im': s5_a_im, 's5_log_step': s5_log_step, 's5_b_re': s5_b_re, 's5_b_im': s5_b_im,
            's5_c_re': s5_c_re, 's5_c_im': s5_c_im, 's5_d': s5_d, 's5_w_glu': s5_w_glu,
            's5_b_glu': s5_b_glu, 'hyb_w_out': hyb_w_out, 'swa_w_qkv': swa_w_qkv, 'swa_sink': swa_sink,
            'swa_w_o': swa_w_o, 'rel_bias': rel_bias, 'moe_w_group': moe_w_group,
            'moe_b_group': moe_b_group, 'moe_w_expert_router': moe_w_expert_router,
            'moe_b_expert_router': moe_b_expert_router, 'moe_w_gate': moe_w_gate,
            'moe_w_up': moe_w_up, 'moe_w_down': moe_w_down}


def reference(x, norm_mix_g, norm_ffn_g, norm_final_g, hyb_w_in, ret_decay_logit, s5_a_re, s5_a_im,
              s5_log_step, s5_b_re, s5_b_im, s5_c_re, s5_c_im, s5_d, s5_w_glu, s5_b_glu, hyb_w_out,
              swa_w_qkv, swa_sink, swa_w_o, rel_bias, moe_w_group, moe_b_group, moe_w_expert_router,
              moe_b_expert_router, moe_w_gate, moe_w_up, moe_w_down):
    for layer in range(DEPTH):
        i = layer // 2
        h = rms_norm(x, norm_mix_g[layer])
        if layer % 2 == 0:
            mix = hybrid_retention_s5(h, hyb_w_in[i], ret_decay_logit[i], s5_a_re[i], s5_a_im[i],
                                      s5_log_step[i], s5_b_re[i], s5_b_im[i], s5_c_re[i], s5_c_im[i],
                                      s5_d[i], s5_w_glu[i], s5_b_glu[i], hyb_w_out[i])
        else:
            mix = windowed_gqa(h, swa_w_qkv[i], swa_sink[i], swa_w_o[i], rel_bias)
        x = x + mix.astype(x.dtype)
        h = rms_norm(x, norm_ffn_g[layer])
        x = x + hier_moe(h, moe_w_group[layer], moe_b_group[layer], moe_w_expert_router[layer],
                         moe_b_expert_router[layer], moe_w_gate[layer], moe_w_up[layer],
                         moe_w_down[layer]).astype(x.dtype)
    return rms_norm(x, norm_final_g)
```

```cpp
#include <hip/hip_runtime.h>
#include <hip/hip_cooperative_groups.h>
#include <cstdio>
#include <cstdint>
namespace cg = cooperative_groups;

#ifndef USE_FP16
#define USE_FP16 1
#endif
#ifndef MULTI_LAUNCH
#define MULTI_LAUNCH 1
#endif

typedef unsigned short u16;
typedef float f32x4 __attribute__((ext_vector_type(4)));
typedef float f32x2 __attribute__((ext_vector_type(2)));
typedef _Float16 f16x8 __attribute__((ext_vector_type(8)));
typedef __bf16 b16x8 __attribute__((ext_vector_type(8)));

constexpr int T_TOK = 16384, DM = 1024, SEQ = 2048, NBATCH = 8;
constexpr int CAP = 32768;
constexpr int NTHR = 256;

constexpr size_t MB = 1024ull * 1024ull;
constexpr size_t WS_XA    = 0;
constexpr size_t WS_XB    = WS_XA + 64 * MB;
constexpr size_t WS_Z     = WS_XB + 32 * MB;
constexpr size_t WS_A2    = WS_Z + 64 * MB;
constexpr size_t WS_INC   = WS_A2 + 24 * MB;
constexpr size_t WS_YCAT  = WS_INC + 64 * MB;
constexpr size_t WS_YGELU = WS_YCAT + 32 * MB;
constexpr size_t WS_H     = WS_YGELU + 16 * MB;
constexpr size_t WS_LIST  = WS_H + 36 * MB;
constexpr size_t WS_GATE  = WS_LIST + 4 * MB;
constexpr size_t WS_ROPE  = WS_GATE + 1 * MB;
constexpr size_t WS_CNT   = WS_ROPE + 1 * MB;
constexpr size_t WS_END   = WS_CNT + 1 * MB;

struct P {
  const float *x, *norm_mix_g, *norm_ffn_g, *norm_final_g, *w_in, *ret_decay, *a_re, *a_im, *log_step, *b_re, *b_im, *c_re, *c_im,
      *s5d, *w_glu, *b_glu, *w_out, *w_qkv, *sink, *w_o, *rel_bias, *w_group, *b_group, *w_er, *b_er, *w_gate, *w_up, *w_down;
  float* out;
  char* ws;
};

__device__ __forceinline__ u16 f2h(float f) {
#if USE_FP16
  _Float16 h = (_Float16)f; return __builtin_bit_cast(u16, h);
#else
  unsigned u = __builtin_bit_cast(unsigned, f); u += 0x7fffu + ((u >> 16) & 1u); return (u16)(u >> 16);
#endif
}
__device__ __forceinline__ float h2f(u16 h) {
#if USE_FP16
  return (float)__builtin_bit_cast(_Float16, h);
#else
  return __builtin_bit_cast(float, ((unsigned)h) << 16);
#endif
}
__device__ __forceinline__ unsigned pk2(float a, float b) { return (unsigned)f2h(a) | ((unsigned)f2h(b) << 16); }
__device__ __forceinline__ float lo16(unsigned w) { return h2f((u16)(w & 0xffffu)); }
__device__ __forceinline__ float hi16(unsigned w) { return h2f((u16)(w >> 16)); }
__device__ __forceinline__ f32x4 mfma16(uint4 a, uint4 b, f32x4 c) {
#if USE_FP16
  return __builtin_amdgcn_mfma_f32_16x16x32_f16(__builtin_bit_cast(f16x8, a), __builtin_bit_cast(f16x8, b), c, 0, 0, 0);
#else
  return __builtin_amdgcn_mfma_f32_16x16x32_bf16(__builtin_bit_cast(b16x8, a), __builtin_bit_cast(b16x8, b), c, 0, 0, 0);
#endif
}
__device__ __forceinline__ float wave_sum(float v) {
#pragma unroll
  for (int o = 1; o < 64; o <<= 1) v += __shfl_xor(v, o);
  return v;
}
__device__ __forceinline__ float sigmoidf_(float x) { return 1.0f / (1.0f + __expf(-x)); }
__device__ __forceinline__ float gelu_tanh(float x) {
  const float u = 0.7978845608028654f * (x + 0.044715f * x * x * x);
  return 0.5f * x * (1.0f + tanhf(u));
}

struct GemmDesc {
  const u16* A; long lda;
  const int* rowmap; int rowshift;
  int mvalid;
  const float* W; const float* W2; long ldw;
  const u16* Bt; long ldb;
  int K;
};
constexpr int LSTR = 40;
constexpr int GEMM_LDS = 2 * 128 * LSTR * 2;

template <class Epi>
__device__ __forceinline__ void gemm_tile(const GemmDesc& g, int m0, int n0, Epi&& epi, char* smem) {
  u16* sA = (u16*)smem;
  u16* sB = sA + 128 * LSTR;
  const int tid = threadIdx.x, lane = tid & 63, wid = tid >> 6, wr = wid >> 1, wc = wid & 1, fr = lane & 15, fq = lane >> 4;
  f32x4 acc[4][4];
#pragma unroll
  for (int m = 0; m < 4; ++m)
#pragma unroll
    for (int n = 0; n < 4; ++n) acc[m][n] = (f32x4){0.f, 0.f, 0.f, 0.f};
  const int ar = tid >> 2, akc = (tid & 3) * 8;
  const u16* ap[2];
#pragma unroll
  for (int i = 0; i < 2; ++i) {
    const int m = m0 + ar + i * 64; const u16* q = nullptr;
    if (m < g.mvalid) { const long row = g.rowmap ? (long)(g.rowmap[m] >> g.rowshift) : (long)m; q = g.A + row * g.lda + akc; }
    ap[i] = q;
  }
  const bool useBt = (g.Bt != nullptr);
  const float* wp = nullptr; const u16* bp[2] = {nullptr, nullptr};
  if (!useBt) {
    const int v = n0 + (tid & 31) * 4;
    if (g.W2) wp = ((((v >> 5) & 1) ? g.W2 : g.W) + ((v >> 6) * 32 + (v & 31)));
    else wp = g.W + v;
    wp += (long)((tid >> 5) * 4) * g.ldw;
  } else {
#pragma unroll
    for (int i = 0; i < 2; ++i) bp[i] = g.Bt + (long)(n0 + ar + i * 64) * g.ldb + akc;
  }
  uint4 ra[2], rb[2]; f32x4 rw[4];
  auto gload = [&](int k0) {
#pragma unroll
    for (int i = 0; i < 2; ++i) ra[i] = ap[i] ? *(const uint4*)(ap[i] + k0) : make_uint4(0u, 0u, 0u, 0u);
    if (useBt) {
#pragma unroll
      for (int i = 0; i < 2; ++i) rb[i] = *(const uint4*)(bp[i] + k0);
    } else {
#pragma unroll
      for (int j = 0; j < 4; ++j) rw[j] = *(const f32x4*)(wp + (long)(k0 + j) * g.ldw);
    }
  };
  gload(0);
  for (int k0 = 0; k0 < g.K; k0 += 32) {
    __syncthreads();
#pragma unroll
    for (int i = 0; i < 2; ++i) *(uint4*)(sA + (ar + i * 64) * LSTR + akc) = ra[i];
    if (useBt) {
#pragma unroll
      for (int i = 0; i < 2; ++i) *(uint4*)(sB + (ar + i * 64) * LSTR + akc) = rb[i];
    } else {
      const int nl = (tid & 31) * 4, kl = (tid >> 5) * 4;
#pragma unroll
      for (int c = 0; c < 4; ++c) {
        uint2 v; v.x = pk2(rw[0][c], rw[1][c]); v.y = pk2(rw[2][c], rw[3][c]);
        *(uint2*)(sB + (nl + c) * LSTR + kl) = v;
      }
    }
    __syncthreads();
    if (k0 + 32 < g.K) gload(k0 + 32);
    uint4 fa[4], fb[4];
#pragma unroll
    for (int m = 0; m < 4; ++m) fa[m] = *(const uint4*)(sA + (wr * 64 + m * 16 + fr) * LSTR + fq * 8);
#pragma unroll
    for (int n = 0; n < 4; ++n) fb[n] = *(const uint4*)(sB + (wc * 64 + n * 16 + fr) * LSTR + fq * 8);
#pragma unroll
    for (int m = 0; m < 4; ++m)
#pragma unroll
      for (int n = 0; n < 4; ++n) acc[m][n] = mfma16(fb[n], fa[m], acc[m][n]);
  }
  epi(acc, m0 + wr * 64 + fr, n0 + wc * 64 + fq * 4);
}

__device__ void phase_prep(const P& p) {
  const int gtid = blockIdx.x * NTHR + threadIdx.x, gsz = gridDim.x * NTHR;
  int* cnt = (int*)(p.ws + WS_CNT);
  if (gtid < 64) cnt[gtid] = 0;
  f32x2* rope = (f32x2*)(p.ws + WS_ROPE);
  for (int i = gtid; i < SEQ * 64; i += gsz) {
    const int pos = i >> 6, f = i & 63;
    const float inv = powf(10000.0f, -(float)(2 * f) / 128.0f);
    const float ang = (float)pos * inv;
    float s, c; sincosf(ang, &s, &c);
    rope[i] = (f32x2){c, s};
  }
}

__device__ void phase_rowpass(const P& p, const float* src, const u16* slots, float* dstx, const float* gain, int route_layer, float* fout) {
  const int lane = threadIdx.x & 63, gw = blockIdx.x * 4 + (threadIdx.x >> 6), nw = gridDim.x * 4;
  u16* xb = (u16*)(p.ws + WS_XB);
  int* cnt = (int*)(p.ws + WS_CNT);
  int* list = (int*)(p.ws + WS_LIST);
  float* gate = (float*)(p.ws + WS_GATE);
  for (int row = gw; row < T_TOK; row += nw) {
    f32x4 v[4];
    float ss = 0.f;
#pragma unroll
    for (int i = 0; i < 4; ++i) {
      const int k = (i * 64 + lane) * 4;
      v[i] = *(const f32x4*)(src + (size_t)row * DM + k);
      if (slots) {
#pragma unroll
        for (int s = 0; s < 2; ++s) {
          const uint2 w = *(const uint2*)(slots + ((size_t)row * 2 + s) * DM + k);
          v[i][0] += lo16(w.x); v[i][1] += hi16(w.x); v[i][2] += lo16(w.y); v[i][3] += hi16(w.y);
        }
      }
      if (dstx) *(f32x4*)(dstx + (size_t)row * DM + k) = v[i];
      ss += v[i][0] * v[i][0] + v[i][1] * v[i][1] + v[i][2] * v[i][2] + v[i][3] * v[i][3];
    }
    ss = wave_sum(ss);
    const float rstd = rsqrtf(ss * (1.0f / DM) + 1e-6f);
#pragma unroll
    for (int i = 0; i < 4; ++i) {
      const int k = (i * 64 + lane) * 4;
      const f32x4 gv = *(const f32x4*)(gain + k);
      v[i] = v[i] * rstd * gv;
      if (fout) *(f32x4*)(fout + (size_t)row * DM + k) = v[i];
      else { uint2 w; w.x = pk2(v[i][0], v[i][1]); w.y = pk2(v[i][2], v[i][3]); *(uint2*)(xb + (size_t)row * DM + k) = w; }
    }
    if (route_layer >= 0) {
      const float* wg = p.w_group + (size_t)route_layer * DM * 4;
      const float* we = p.w_er + (size_t)route_layer * 4 * DM * 8;
      float acc[36];
#pragma unroll
      for (int j = 0; j < 36; ++j) acc[j] = 0.f;
#pragma unroll
      for (int i = 0; i < 4; ++i) {
#pragma unroll
        for (int c = 0; c < 4; ++c) {
          const int k = (i * 64 + lane) * 4 + c;
          const float hv = v[i][c];
          const f32x4 g4 = *(const f32x4*)(wg + (size_t)k * 4);
#pragma unroll
          for (int j = 0; j < 4; ++j) acc[j] += hv * g4[j];
#pragma unroll
          for (int gg = 0; gg < 4; ++gg) {
            const f32x4 e0 = *(const f32x4*)(we + ((size_t)gg * DM + k) * 8);
            const f32x4 e1 = *(const f32x4*)(we + ((size_t)gg * DM + k) * 8 + 4);
#pragma unroll
            for (int j = 0; j < 4; ++j) { acc[4 + gg * 8 + j] += hv * e0[j]; acc[4 + gg * 8 + 4 + j] += hv * e1[j]; }
          }
        }
      }
#pragma unroll
      for (int j = 0; j < 36; ++j) acc[j] = wave_sum(acc[j]);
      if (lane == 0) {
        const float* bg = p.b_group + route_layer * 4;
        const float* be = p.b_er + route_layer * 32;
        float gl[4];
#pragma unroll
        for (int j = 0; j < 4; ++j) gl[j] = acc[j] + bg[j];
        int gs = 0; float gm = gl[0];
#pragma unroll
        for (int j = 1; j < 4; ++j) if (gl[j] > gm) { gm = gl[j]; gs = j; }
        float den = 0.f;
#pragma unroll
        for (int j = 0; j < 4; ++j) den += expf(gl[j] - gm);
        const float pg = 1.0f / den;
        float el[8];
#pragma unroll
        for (int j = 0; j < 8; ++j) {
          float a = acc[4 + j];
#pragma unroll
          for (int gg = 1; gg < 4; ++gg) a = (gs == gg) ? acc[4 + gg * 8 + j] : a;
          el[j] = a + be[gs * 8 + j];
        }
        int i1 = 0; float v1 = el[0];
#pragma unroll
        for (int j = 1; j < 8; ++j) if (el[j] > v1) { v1 = el[j]; i1 = j; }
        int i2 = -1; float v2 = -3.0e38f;
#pragma unroll
        for (int j = 0; j < 8; ++j) if (j != i1 && el[j] > v2) { v2 = el[j]; i2 = j; }
        const float e2 = expf(v2 - v1);
        const float g1 = pg / (1.0f + e2), g2 = pg * e2 / (1.0f + e2);
        const int ex1 = gs * 8 + i1, ex2 = gs * 8 + i2;
        const int r1 = atomicAdd(&cnt[route_layer * 32 + ex1], 1);
        list[(size_t)ex1 * CAP + r1] = row * 2;
        gate[row * 2] = g1;
        const int r2 = atomicAdd(&cnt[route_layer * 32 + ex2], 1);
        list[(size_t)ex2 * CAP + r2] = row * 2 + 1;
        gate[row * 2 + 1] = g2;
      }
    }
  }
}

__device__ void phase_inproj(const P& p, char* smem) {
  GemmDesc g{}; g.A = (const u16*)(p.ws + WS_XB); g.lda = DM; g.mvalid = T_TOK; g.W = p.w_in; g.ldw = 2560; g.K = DM;
  u16* zb = (u16*)(p.ws + WS_Z); u16* a2 = (u16*)(p.ws + WS_A2);
  const int ntiles = 128 * 20;
  for (int t = blockIdx.x; t < ntiles; t += gridDim.x) {
    const int mt = t / 20, nt = t % 20;
    gemm_tile(g, mt * 128, nt * 128, [&](f32x4 (&acc)[4][4], int row0, int col0) {
      const int seg = (nt * 128) / 512;
#pragma unroll
      for (int m = 0; m < 4; ++m)
#pragma unroll
        for (int n = 0; n < 4; ++n) {
          const int row = row0 + m * 16, col = col0 + n * 16;
          uint2 w; w.x = pk2(acc[m][n][0], acc[m][n][1]); w.y = pk2(acc[m][n][2], acc[m][n][3]);
          if (seg < 4) *(uint2*)(zb + (size_t)seg * T_TOK * 512 + (size_t)row * 512 + (col - seg * 512)) = w;
          else { const int ch = col - 2048, gi = ch >> 4, c = ch & 15; *(uint2*)(a2 + ((size_t)gi * 512 + (row >> 5)) * 768 + (row & 31) * 16 + c) = w; }
        }
    }, smem);
  }
}

constexpr int RSTR = 136;
__device__ __forceinline__ void ret_load_tile(u16* dst, const u16* src, int t0, int h, int mode  , const f32x2* rope) {
  const int pos0 = t0 & (SEQ - 1);
  for (int idx = threadIdx.x; idx < 128 * 64; idx += NTHR) {
    const int i = idx >> 6, d = idx & 63;
    float t1 = h2f(src[(size_t)(t0 + i) * 512 + h * 128 + d]), t2 = h2f(src[(size_t)(t0 + i) * 512 + h * 128 + d + 64]);
    if (mode) {
      const f32x2 cs = rope[(pos0 + i) * 64 + d];
      const float o1 = t1 * cs[0] - t2 * cs[1], o2 = t1 * cs[1] + t2 * cs[0];
      t1 = o1; t2 = o2;
      if (mode == 2) { t1 *= 0.08838834764831845f; t2 *= 0.08838834764831845f; }
    }
    dst[i * RSTR + d] = f2h(t1); dst[i * RSTR + d + 64] = f2h(t2);
  }
}
__device__ __forceinline__ float log_sigmoid(float x) { return -log1pf(expf(-x)); }

__device__ void phase_ret_inc(const P& p, char* smem) {
  u16* sK = (u16*)smem; u16* sV = sK + 128 * RSTR; float* sWf = (float*)(sV + 128 * RSTR); float* sWb = sWf + 128;
  const u16* kb = (const u16*)(p.ws + WS_Z) + (size_t)1 * T_TOK * 512; const u16* vb = (const u16*)(p.ws + WS_Z) + (size_t)2 * T_TOK * 512;
  const f32x2* rope = (const f32x2*)(p.ws + WS_ROPE);
  float* incf = (float*)(p.ws + WS_INC); float* incb = incf + (size_t)512 * 16384;
  const int tid = threadIdx.x;
  for (int item = blockIdx.x; item < 512; item += gridDim.x) {
    const int h = item & 3, bn = item >> 2, t0 = bn * 128;
    const float lgf = log_sigmoid(p.ret_decay[h]), lgb = log_sigmoid(p.ret_decay[4 + h]);
    __syncthreads();
    ret_load_tile(sK, kb, t0, h, 2, rope);
    ret_load_tile(sV, vb, t0, h, 0, rope);
    if (tid < 128) { sWf[tid] = expf(lgf * (float)(127 - tid)); sWb[tid] = expf(lgb * (float)tid); }
    __syncthreads();
    const int d0 = (tid >> 4) * 8, e0 = (tid & 15) * 8;
    float af[8][8], ab[8][8];
#pragma unroll
    for (int a = 0; a < 8; ++a)
#pragma unroll
      for (int b = 0; b < 8; ++b) { af[a][b] = 0.f; ab[a][b] = 0.f; }
    for (int j = 0; j < 128; ++j) {
      const uint4 kq = *(const uint4*)(sK + j * RSTR + d0), vq = *(const uint4*)(sV + j * RSTR + e0);
      const float kd[8] = {lo16(kq.x), hi16(kq.x), lo16(kq.y), hi16(kq.y), lo16(kq.z), hi16(kq.z), lo16(kq.w), hi16(kq.w)};
      const float ve[8] = {lo16(vq.x), hi16(vq.x), lo16(vq.y), hi16(vq.y), lo16(vq.z), hi16(vq.z), lo16(vq.w), hi16(vq.w)};
      const float wf = sWf[j], wb = sWb[j];
#pragma unroll
      for (int a = 0; a < 8; ++a) {
        const float kf = kd[a] * wf, kbw = kd[a] * wb;
#pragma unroll
        for (int b = 0; b < 8; ++b) { af[a][b] += kf * ve[b]; ab[a][b] += kbw * ve[b]; }
      }
    }
#pragma unroll
    for (int a = 0; a < 8; ++a) {
      float* of = incf + (size_t)item * 16384 + (d0 + a) * 128 + e0;
      float* ob = incb + (size_t)item * 16384 + (d0 + a) * 128 + e0;
      *(f32x4*)of = (f32x4){af[a][0], af[a][1], af[a][2], af[a][3]}; *(f32x4*)(of + 4) = (f32x4){af[a][4], af[a][5], af[a][6], af[a][7]};
      *(f32x4*)ob = (f32x4){ab[a][0], ab[a][1], ab[a][2], ab[a][3]}; *(f32x4*)(ob + 4) = (f32x4){ab[a][4], ab[a][5], ab[a][6], ab[a][7]};
    }
  }
}

__device__ void phase_ret_scan(const P& p) {
  float* incf = (float*)(p.ws + WS_INC); float* incb = incf + (size_t)512 * 16384;
  const int gtid = blockIdx.x * NTHR + threadIdx.x, gsz = gridDim.x * NTHR;
  for (int idx = gtid; idx < 32 * 16384; idx += gsz) {
    const int de = idx & 16383, bh = idx >> 14, b = bh >> 2, h = bh & 3;
    const float Gf = expf(128.0f * log_sigmoid(p.ret_decay[h])), Gb = expf(128.0f * log_sigmoid(p.ret_decay[4 + h]));
    float s = 0.f;
    for (int n = 0; n < 16; ++n) { float* q = incf + ((size_t)((b * 16 + n) * 4 + h)) * 16384 + de; const float t = *q; *q = s; s = s * Gf + t; }
    s = 0.f;
    for (int n = 15; n >= 0; --n) { float* q = incb + ((size_t)((b * 16 + n) * 4 + h)) * 16384 + de; const float t = *q; *q = s; s = s * Gb + t; }
  }
}

__device__ void phase_ret_out(const P& p, char* smem) {
  u16* sQ = (u16*)smem; u16* sK = sQ + 128 * RSTR; u16* sV = sK + 128 * RSTR; u16* sS = sV + 128 * RSTR;
  float* sPf = (float*)(sS + 128 * RSTR); float* sPb = sPf + 132;
  const u16* zb = (const u16*)(p.ws + WS_Z);
  const u16* qb = zb; const u16* kb = zb + (size_t)1 * T_TOK * 512; const u16* vb = zb + (size_t)2 * T_TOK * 512; const u16* gb = zb + (size_t)3 * T_TOK * 512;
  const f32x2* rope = (const f32x2*)(p.ws + WS_ROPE);
  const float* incf = (const float*)(p.ws + WS_INC); const float* incb = incf + (size_t)512 * 16384;
  u16* ycat = (u16*)(p.ws + WS_YCAT);
  const int tid = threadIdx.x;
  for (int item = blockIdx.x; item < 512; item += gridDim.x) {
    const int h = item & 3, bn = item >> 2, t0 = bn * 128;
    const float lgf = log_sigmoid(p.ret_decay[h]), lgb = log_sigmoid(p.ret_decay[4 + h]);
    __syncthreads();
    ret_load_tile(sQ, qb, t0, h, 1, rope);
    ret_load_tile(sK, kb, t0, h, 2, rope);
    ret_load_tile(sV, vb, t0, h, 0, rope);
    if (tid < 129) { sPf[tid] = expf(lgf * (float)tid); sPb[tid] = expf(lgb * (float)tid); }
    __syncthreads();
    const int i0 = (tid >> 4) * 8, j0 = (tid & 15) * 8;
    {
      float s[8][8];
#pragma unroll
      for (int a = 0; a < 8; ++a)
#pragma unroll
        for (int b = 0; b < 8; ++b) s[a][b] = 0.f;
      for (int d = 0; d < 128; d += 8) {
        float kk[8][8];
#pragma unroll
        for (int b = 0; b < 8; ++b) {
          const uint4 kq = *(const uint4*)(sK + (j0 + b) * RSTR + d);
          kk[b][0] = lo16(kq.x); kk[b][1] = hi16(kq.x); kk[b][2] = lo16(kq.y); kk[b][3] = hi16(kq.y); kk[b][4] = lo16(kq.z); kk[b][5] = hi16(kq.z); kk[b][6] = lo16(kq.w); kk[b][7] = hi16(kq.w);
        }
#pragma unroll
        for (int a = 0; a < 8; ++a) {
          const uint4 qq = *(const uint4*)(sQ + (i0 + a) * RSTR + d);
          const float qv[8] = {lo16(qq.x), hi16(qq.x), lo16(qq.y), hi16(qq.y), lo16(qq.z), hi16(qq.z), lo16(qq.w), hi16(qq.w)};
#pragma unroll
          for (int b = 0; b < 8; ++b)
#pragma unroll
            for (int c = 0; c < 8; ++c) s[a][b] += qv[c] * kk[b][c];
        }
      }
#pragma unroll
      for (int a = 0; a < 8; ++a) {
        unsigned w[4];
#pragma unroll
        for (int b = 0; b < 8; b += 2) {
          const int i = i0 + a, j = j0 + b;
          const float m0 = (i >= j) ? sPf[i - j] : sPb[j - i];
          const float m1 = (i >= j + 1) ? sPf[i - j - 1] : sPb[j + 1 - i];
          w[b >> 1] = pk2(s[a][b] * m0, s[a][b + 1] * m1);
        }
        *(uint4*)(sS + (i0 + a) * RSTR + j0) = make_uint4(w[0], w[1], w[2], w[3]);
      }
    }
    __syncthreads();
    {
      const int e0 = j0;
      float o[8][8];
#pragma unroll
      for (int a = 0; a < 8; ++a)
#pragma unroll
        for (int b = 0; b < 8; ++b) o[a][b] = 0.f;
      for (int j = 0; j < 128; j += 8) {
        float vv[8][8];
#pragma unroll
        for (int c = 0; c < 8; ++c) {
          const uint4 vq = *(const uint4*)(sV + (j + c) * RSTR + e0);
          vv[c][0] = lo16(vq.x); vv[c][1] = hi16(vq.x); vv[c][2] = lo16(vq.y); vv[c][3] = hi16(vq.y); vv[c][4] = lo16(vq.z); vv[c][5] = hi16(vq.z); vv[c][6] = lo16(vq.w); vv[c][7] = hi16(vq.w);
        }
#pragma unroll
        for (int a = 0; a < 8; ++a) {
          const uint4 sq = *(const uint4*)(sS + (i0 + a) * RSTR + j);
          const float sv[8] = {lo16(sq.x), hi16(sq.x), lo16(sq.y), hi16(sq.y), lo16(sq.z), hi16(sq.z), lo16(sq.w), hi16(sq.w)};
#pragma unroll
          for (int c = 0; c < 8; ++c)
#pragma unroll
            for (int b = 0; b < 8; ++b) o[a][b] += sv[c] * vv[c][b];
        }
      }
      const float* sp = incf + (size_t)item * 16384 + e0;
      const float* sn = incb + (size_t)item * 16384 + e0;
      float pf[8], pb[8];
#pragma unroll
      for (int a = 0; a < 8; ++a) { pf[a] = sPf[i0 + a + 1]; pb[a] = sPb[128 - (i0 + a)]; }
      for (int d = 0; d < 128; ++d) {
        const f32x4 p0 = *(const f32x4*)(sp + d * 128), p1 = *(const f32x4*)(sp + d * 128 + 4);
        const f32x4 n0 = *(const f32x4*)(sn + d * 128), n1 = *(const f32x4*)(sn + d * 128 + 4);
        const float spv[8] = {p0[0], p0[1], p0[2], p0[3], p1[0], p1[1], p1[2], p1[3]};
        const float snv[8] = {n0[0], n0[1], n0[2], n0[3], n1[0], n1[1], n1[2], n1[3]};
#pragma unroll
        for (int a = 0; a < 8; ++a) {
          const float qv = h2f(sQ[(i0 + a) * RSTR + d]);
          const float qf = qv * pf[a], qbk = qv * pb[a];
#pragma unroll
          for (int b = 0; b < 8; ++b) o[a][b] += qf * spv[b] + qbk * snv[b];
        }
      }
#pragma unroll
      for (int a = 0; a < 8; ++a) {
        float s1 = 0.f;
#pragma unroll
        for (int b = 0; b < 8; ++b) s1 += o[a][b];
        s1 += __shfl_xor(s1, 1); s1 += __shfl_xor(s1, 2); s1 += __shfl_xor(s1, 4); s1 += __shfl_xor(s1, 8);
        const float mu = s1 * (1.0f / 128.0f);
        float s2 = 0.f;
#pragma unroll
        for (int b = 0; b < 8; ++b) { const float dlt = o[a][b] - mu; s2 += dlt * dlt; }
        s2 += __shfl_xor(s2, 1); s2 += __shfl_xor(s2, 2); s2 += __shfl_xor(s2, 4); s2 += __shfl_xor(s2, 8);
        const float rs = rsqrtf(s2 * (1.0f / 128.0f) + 1e-5f);
        const size_t tok = (size_t)(t0 + i0 + a);
        const uint4 gq = *(const uint4*)(gb + tok * 512 + h * 128 + e0);
        const float gv[8] = {lo16(gq.x), hi16(gq.x), lo16(gq.y), hi16(gq.y), lo16(gq.z), hi16(gq.z), lo16(gq.w), hi16(gq.w)};
        unsigned w[4];
#pragma unroll
        for (int b = 0; b < 8; b += 2) {
          const float y0 = gv[b] * sigmoidf_(gv[b]) * (o[a][b] - mu) * rs;
          const float y1 = gv[b + 1] * sigmoidf_(gv[b + 1]) * (o[a][b + 1] - mu) * rs;
          w[b >> 1] = pk2(y0, y1);
        }
        *(uint4*)(ycat + tok * DM + h * 128 + e0) = make_uint4(w[0], w[1], w[2], w[3]);
      }
    }
  }
}

__device__ void phase_s5_naive(const P& p, char* smem) {
  float* ylds = (float*)smem;
  float* xs = ylds + 2048 * 16;
  const u16* a2 = (const u16*)(p.ws + WS_A2);
  u16* ygelu = (u16*)(p.ws + WS_YGELU);
  const int lane = threadIdx.x & 63;
  if (threadIdx.x < 64) {
    for (int item = blockIdx.x; item < 256; item += gridDim.x) {
      const int b = item >> 5, g = item & 31;
      const int pidx = lane;
      const int cidx = lane & 15, quart = lane >> 4;
      for (int dir = 0; dir < 2; ++dir) {
        const float dt = expf(p.log_step[dir * 32 + g]);
        const float ar = p.a_re[(dir * 32 + g) * 64 + pidx], ai = p.a_im[(dir * 32 + g) * 64 + pidx];
        const float mag = expf(ar * dt);
        float sn, cs; sincosf(ai * dt, &sn, &cs);
        const float lre = mag * cs, lim = mag * sn;
        const float nr = lre - 1.0f, ni = lim, den = ar * ar + ai * ai;
        const float cre = (nr * ar + ni * ai) / den, cim = (ni * ar - nr * ai) / den;
        float bbr[16], bbi[16];
#pragma unroll
        for (int c = 0; c < 16; ++c) {
          const float br = p.b_re[(g * 64 + pidx) * 16 + c], bi = p.b_im[(g * 64 + pidx) * 16 + c];
          bbr[c] = cre * br - cim * bi; bbi[c] = cre * bi + cim * br;
        }
        float ccr[16], cci[16];
#pragma unroll
        for (int q = 0; q < 16; ++q) {
          ccr[q] = p.c_re[((dir * 32 + g) * 16 + cidx) * 64 + quart * 16 + q];
          cci[q] = p.c_im[((dir * 32 + g) * 16 + cidx) * 64 + quart * 16 + q];
        }
        const float dsk = p.s5d[g * 16 + cidx];
        float xr = 0.f, xi = 0.f;
        for (int step = 0; step < SEQ; ++step) {
          const int n = dir ? (SEQ - 1 - step) : step;
          const int t = b * SEQ + n;
          const u16* up = a2 + ((size_t)g * 512 + (t >> 5)) * 768 + (t & 31) * 16;
          const uint4 u0 = *(const uint4*)up, u1 = *(const uint4*)(up + 8);
          const float uv[16] = {lo16(u0.x), hi16(u0.x), lo16(u0.y), hi16(u0.y), lo16(u0.z), hi16(u0.z), lo16(u0.w), hi16(u0.w),
                                lo16(u1.x), hi16(u1.x), lo16(u1.y), hi16(u1.y), lo16(u1.z), hi16(u1.z), lo16(u1.w), hi16(u1.w)};
          float bur = 0.f, bui = 0.f;
#pragma unroll
          for (int c = 0; c < 16; ++c) { bur += bbr[c] * uv[c]; bui += bbi[c] * uv[c]; }
          const float nxr = lre * xr - lim * xi + bur, nxi = lre * xi + lim * xr + bui;
          xr = nxr; xi = nxi;
          asm volatile("s_waitcnt lgkmcnt(0)" ::: "memory");
          xs[lane] = xr; xs[64 + lane] = xi;
          asm volatile("s_waitcnt lgkmcnt(0)" ::: "memory");
          float part = 0.f;
#pragma unroll
          for (int q = 0; q < 16; ++q) part += ccr[q] * xs[quart * 16 + q] - cci[q] * xs[64 + quart * 16 + q];
          asm volatile("s_waitcnt lgkmcnt(0)" ::: "memory");
          part += __shfl_xor(part, 16); part += __shfl_xor(part, 32);
          if (lane < 16) {
            if (dir == 0) ylds[n * 16 + cidx] = dsk * h2f(up[cidx]) + part;
            else ygelu[(size_t)t * 512 + g * 16 + cidx] = f2h(gelu_tanh(ylds[n * 16 + cidx] + part));
          }
        }
      }
    }
  }
}

__device__ void phase_glu(const P& p, char* smem) {
  const u16* yg = (const u16*)(p.ws + WS_YGELU); u16* ycat = (u16*)(p.ws + WS_YCAT);
  GemmDesc g{}; g.A = yg; g.lda = 512; g.mvalid = T_TOK; g.W = p.w_glu; g.ldw = 512; g.K = 512;
  for (int t = blockIdx.x; t < 128 * 4; t += gridDim.x) {
    const int mt = t >> 2, nt = t & 3;
    gemm_tile(g, mt * 128, nt * 128, [&](f32x4 (&acc)[4][4], int row0, int col0) {
#pragma unroll
      for (int m = 0; m < 4; ++m)
#pragma unroll
        for (int n = 0; n < 4; ++n) {
          const int row = row0 + m * 16, col = col0 + n * 16;
          const uint2 yv = *(const uint2*)(yg + (size_t)row * 512 + col);
          const f32x4 bb = *(const f32x4*)(p.b_glu + col);
          const float y0 = lo16(yv.x) * sigmoidf_(acc[m][n][0] + bb[0]), y1 = hi16(yv.x) * sigmoidf_(acc[m][n][1] + bb[1]);
          const float y2 = lo16(yv.y) * sigmoidf_(acc[m][n][2] + bb[2]), y3 = hi16(yv.y) * sigmoidf_(acc[m][n][3] + bb[3]);
          uint2 w; w.x = pk2(y0, y1); w.y = pk2(y2, y3);
          *(uint2*)(ycat + (size_t)row * DM + 512 + col) = w;
        }
    }, smem);
  }
}

__device__ void phase_outproj(const P& p, const u16* A, const float* W, const float* xin, float* xout, char* smem) {
  GemmDesc g{}; g.A = A; g.lda = DM; g.mvalid = T_TOK; g.W = W; g.ldw = DM; g.K = DM;
  for (int t = blockIdx.x; t < 128 * 8; t += gridDim.x) {
    const int mt = t >> 3, nt = t & 7;
    gemm_tile(g, mt * 128, nt * 128, [&](f32x4 (&acc)[4][4], int row0, int col0) {
#pragma unroll
      for (int m = 0; m < 4; ++m)
#pragma unroll
        for (int n = 0; n < 4; ++n) {
          const size_t o = (size_t)(row0 + m * 16) * DM + col0 + n * 16;
          const f32x4 xv = *(const f32x4*)(xin + o);
          *(f32x4*)(xout + o) = xv + acc[m][n];
        }
    }, smem);
  }
}

__device__ void phase_qkv(const P& p, char* smem) {
  GemmDesc g{}; g.A = (const u16*)(p.ws + WS_XB); g.lda = DM; g.mvalid = T_TOK; g.W = p.w_qkv; g.ldw = 1536; g.K = DM;
  u16* q1 = (u16*)(p.ws + WS_Z); u16* k1 = (u16*)(p.ws + WS_Z + 32 * MB); u16* v1 = (u16*)(p.ws + WS_Z + 40 * MB);
  for (int t = blockIdx.x; t < 128 * 12; t += gridDim.x) {
    const int mt = t / 12, nt = t % 12;
    gemm_tile(g, mt * 128, nt * 128, [&](f32x4 (&acc)[4][4], int row0, int col0) {
#pragma unroll
      for (int m = 0; m < 4; ++m)
#pragma unroll
        for (int n = 0; n < 4; ++n) {
          const int row = row0 + m * 16, col = col0 + n * 16;
          uint2 w;
          if (nt < 8) { w.x = pk2(acc[m][n][0] * 0.125f, acc[m][n][1] * 0.125f); w.y = pk2(acc[m][n][2] * 0.125f, acc[m][n][3] * 0.125f); *(uint2*)(q1 + (size_t)row * DM + col) = w; }
          else {
            w.x = pk2(acc[m][n][0], acc[m][n][1]); w.y = pk2(acc[m][n][2], acc[m][n][3]);
            if (nt < 10) *(uint2*)(k1 + (size_t)row * 256 + (col - 1024)) = w; else *(uint2*)(v1 + (size_t)row * 256 + (col - 1280)) = w;
          }
        }
    }, smem);
  }
}

struct MoeTile { int e, rt, ct, cnt, hbase; };
__device__ __forceinline__ bool moe_decode(const int* cnt, int t, MoeTile& mt) {
  int base = 0, hb = 0;
  for (int e = 0; e < 32; ++e) {
    const int c = cnt[e], nt = (c + 127) >> 7, span = nt * 8;
    if (t < base + span) { const int loc = t - base; mt.e = e; mt.rt = loc % nt; mt.ct = loc / nt; mt.cnt = c; mt.hbase = hb; return true; }
    base += span; hb += nt * 128;
  }
  return false;
}
__device__ void phase_moe1(const P& p, int layer, char* smem) {
  const int* cnt = (const int*)(p.ws + WS_CNT) + layer * 32;
  const int* list = (const int*)(p.ws + WS_LIST);
  u16* hbuf = (u16*)(p.ws + WS_H);
  for (int t = blockIdx.x;; t += gridDim.x) {
    MoeTile mt; if (!moe_decode(cnt, t, mt)) break;
    GemmDesc g{}; g.A = (const u16*)(p.ws + WS_XB); g.lda = DM; g.rowmap = list + (size_t)mt.e * CAP; g.rowshift = 1; g.mvalid = mt.cnt;
    g.W = p.w_gate + (size_t)(layer * 32 + mt.e) * DM * 512; g.W2 = p.w_up + (size_t)(layer * 32 + mt.e) * DM * 512; g.ldw = 512; g.K = DM;
    gemm_tile(g, mt.rt * 128, mt.ct * 128, [&](f32x4 (&acc)[4][4], int row0, int col0) {
      const int ocol0 = (col0 >> 6) * 32 + (col0 & 31);
#pragma unroll
      for (int m = 0; m < 4; ++m) {
        const int row = row0 + m * 16;
        if (row < mt.cnt) {
#pragma unroll
          for (int nn = 0; nn < 2; ++nn) {
            float hv[4];
#pragma unroll
            for (int r = 0; r < 4; ++r) { const float gt = acc[m][nn][r]; hv[r] = gt * sigmoidf_(gt) * acc[m][nn + 2][r]; }
            uint2 w; w.x = pk2(hv[0], hv[1]); w.y = pk2(hv[2], hv[3]);
            *(uint2*)(hbuf + (size_t)(mt.hbase + row) * 512 + ocol0 + nn * 16) = w;
          }
        }
      }
    }, smem);
  }
}
__device__ void phase_moe2(const P& p, int layer, char* smem) {
  const int* cnt = (const int*)(p.ws + WS_CNT) + layer * 32;
  const int* list = (const int*)(p.ws + WS_LIST);
  const float* gate = (const float*)(p.ws + WS_GATE);
  const u16* hbuf = (const u16*)(p.ws + WS_H);
  u16* slots = (u16*)(p.ws + WS_INC);
  for (int t = blockIdx.x;; t += gridDim.x) {
    MoeTile mt; if (!moe_decode(cnt, t, mt)) break;
    GemmDesc g{}; g.A = hbuf + (size_t)mt.hbase * 512; g.lda = 512; g.mvalid = mt.cnt;
    g.W = p.w_down + (size_t)(layer * 32 + mt.e) * 512 * DM; g.ldw = DM; g.K = 512;
    gemm_tile(g, mt.rt * 128, mt.ct * 128, [&](f32x4 (&acc)[4][4], int row0, int col0) {
#pragma unroll
      for (int m = 0; m < 4; ++m) {
        const int row = row0 + m * 16;
        if (row < mt.cnt) {
          const int asg = list[(size_t)mt.e * CAP + row];
          const float gt = gate[asg];
#pragma unroll
          for (int n = 0; n < 4; ++n) {
            uint2 w; w.x = pk2(gt * acc[m][n][0], gt * acc[m][n][1]); w.y = pk2(gt * acc[m][n][2], gt * acc[m][n][3]);
            *(uint2*)(slots + (size_t)asg * DM + col0 + n * 16) = w;
          }
        }
      }
    }, smem);
  }
}

constexpr int KSTR = 72;
__device__ __forceinline__ int t5_bucket_abs(int n) {
  return n < 8 ? n : 8 + (n >= 12) + (n >= 16) + (n >= 23) + (n >= 32) + (n >= 46) + (n >= 64) + (n >= 91);
}
__device__ void phase_attn_naive(const P& p, char* smem) {
  u16* sK = (u16*)smem; u16* sV = sK + 384 * KSTR; float* sBias = (float*)(sV + 384 * KSTR);
  const u16* q1 = (const u16*)(p.ws + WS_Z); const u16* k1 = (const u16*)(p.ws + WS_Z + 32 * MB); const u16* v1 = (const u16*)(p.ws + WS_Z + 40 * MB);
  u16* ao = (u16*)(p.ws + WS_YCAT);
  const int tid = threadIdx.x;
  for (int item = blockIdx.x; item < 512; item += gridDim.x) {
    const int b = item >> 6, nb = (item >> 2) & 15, kvh = item & 3;
    __syncthreads();
    for (int c = tid; c < 384 * 8; c += NTHR) {
      const int s = c >> 3, ch = (c & 7) * 8, pos = (nb - 1) * 128 + s;
      uint4 kq = make_uint4(0u, 0u, 0u, 0u), vq = kq;
      if (pos >= 0 && pos < SEQ) { kq = *(const uint4*)(k1 + (size_t)(b * SEQ + pos) * 256 + kvh * 64 + ch); vq = *(const uint4*)(v1 + (size_t)(b * SEQ + pos) * 256 + kvh * 64 + ch); }
      *(uint4*)(sK + s * KSTR + ch) = kq; *(uint4*)(sV + s * KSTR + ch) = vq;
    }
    for (int c = tid; c < 4 * 257; c += NTHR) {
      const int hq = c / 257, ri = c % 257, rel = ri - 128, n = rel < 0 ? -rel : rel;
      const int bucket = (rel > 0 ? 16 : 0) + t5_bucket_abs(n);
      sBias[hq * 260 + ri] = p.rel_bias[bucket * 16 + kvh * 4 + hq];
    }
    __syncthreads();
    for (int pass = 0; pass < 2; ++pass) {
      const int hq = pass * 2 + (tid >> 7), qi = tid & 127, head = kvh * 4 + hq;
      const size_t tok = (size_t)b * SEQ + nb * 128 + qi;
      float q[64];
#pragma unroll
      for (int d = 0; d < 64; d += 8) {
        const uint4 qq = *(const uint4*)(q1 + tok * DM + head * 64 + d);
        q[d] = lo16(qq.x); q[d + 1] = hi16(qq.x); q[d + 2] = lo16(qq.y); q[d + 3] = hi16(qq.y); q[d + 4] = lo16(qq.z); q[d + 5] = hi16(qq.z); q[d + 6] = lo16(qq.w); q[d + 7] = hi16(qq.w);
      }
      float mx = p.sink[head], l = 1.0f, o[64];
#pragma unroll
      for (int d = 0; d < 64; ++d) o[d] = 0.f;
      for (int r = 0; r <= 256; ++r) {
        const int s = qi + r, pos = (nb - 1) * 128 + s;
        if (pos < 0 || pos >= SEQ) continue;
        float sc = 0.f;
#pragma unroll
        for (int d = 0; d < 64; d += 8) {
          const uint4 kq = *(const uint4*)(sK + s * KSTR + d);
          sc += q[d] * lo16(kq.x) + q[d + 1] * hi16(kq.x) + q[d + 2] * lo16(kq.y) + q[d + 3] * hi16(kq.y) + q[d + 4] * lo16(kq.z) + q[d + 5] * hi16(kq.z) + q[d + 6] * lo16(kq.w) + q[d + 7] * hi16(kq.w);
        }
        sc += sBias[hq * 260 + r];
        const float mn = fmaxf(mx, sc), alpha = __expf(mx - mn), pe = __expf(sc - mn);
        l = l * alpha + pe; mx = mn;
#pragma unroll
        for (int d = 0; d < 64; d += 8) {
          const uint4 vq = *(const uint4*)(sV + s * KSTR + d);
          o[d] = o[d] * alpha + pe * lo16(vq.x); o[d + 1] = o[d + 1] * alpha + pe * hi16(vq.x); o[d + 2] = o[d + 2] * alpha + pe * lo16(vq.y); o[d + 3] = o[d + 3] * alpha + pe * hi16(vq.y);
          o[d + 4] = o[d + 4] * alpha + pe * lo16(vq.z); o[d + 5] = o[d + 5] * alpha + pe * hi16(vq.z); o[d + 6] = o[d + 6] * alpha + pe * lo16(vq.w); o[d + 7] = o[d + 7] * alpha + pe * hi16(vq.w);
        }
      }
      const float inv = 1.0f / l;
#pragma unroll
      for (int d = 0; d < 64; d += 8) {
        uint4 w; w.x = pk2(o[d] * inv, o[d + 1] * inv); w.y = pk2(o[d + 2] * inv, o[d + 3] * inv); w.z = pk2(o[d + 4] * inv, o[d + 5] * inv); w.w = pk2(o[d + 6] * inv, o[d + 7] * inv);
        *(uint4*)(ao + tok * DM + head * 64 + d) = w;
      }
    }
  }
}

constexpr int NPHASE = 20;
constexpr int LDS_BYTES = 141312;
__device__ __forceinline__ void run_phase(const P& p, int ph, char* smem) {
  float* xa = (float*)(p.ws + WS_XA);
  const u16* ycat = (const u16*)(p.ws + WS_YCAT);
  const u16* slots = (const u16*)(p.ws + WS_INC);
  switch (ph) {
    case 0: phase_prep(p); break;
    case 1: phase_rowpass(p, p.x, nullptr, nullptr, p.norm_mix_g, -1, nullptr); break;
    case 2: phase_inproj(p, smem); break;
    case 3: phase_ret_inc(p, smem); break;
    case 4: phase_ret_scan(p); break;
    case 5: phase_ret_out(p, smem); break;
    case 6: phase_s5_naive(p, smem); break;
    case 7: phase_glu(p, smem); break;
    case 8: phase_outproj(p, ycat, p.w_out, p.x, xa, smem); break;
    case 9: phase_rowpass(p, xa, nullptr, nullptr, p.norm_ffn_g, 0, nullptr); break;
    case 10: phase_moe1(p, 0, smem); break;
    case 11: phase_moe2(p, 0, smem); break;
    case 12: phase_rowpass(p, xa, slots, xa, p.norm_mix_g + DM, -1, nullptr); break;
    case 13: phase_qkv(p, smem); break;
    case 14: phase_attn_naive(p, smem); break;
    case 15: phase_outproj(p, ycat, p.w_o, xa, xa, smem); break;
    case 16: phase_rowpass(p, xa, nullptr, nullptr, p.norm_ffn_g + DM, 1, nullptr); break;
    case 17: phase_moe1(p, 1, smem); break;
    case 18: phase_moe2(p, 1, smem); break;
    case 19: phase_rowpass(p, xa, slots, nullptr, p.norm_final_g, -1, p.out); break;
    default: break;
  }
}

extern __shared__ __attribute__((aligned(16))) char dyn_smem[];

#if MULTI_LAUNCH
__global__ void __launch_bounds__(NTHR) k_phase(P p, int ph) { run_phase(p, ph, dyn_smem); }
#else

__global__ void __launch_bounds__(NTHR) k_mega(P p) {
  cg::grid_group grid = cg::this_grid();
  for (int ph = 0; ph < NPHASE; ++ph) {
    run_phase(p, ph, dyn_smem);
    if (ph + 1 < NPHASE) grid.sync();
  }
}
#endif

extern "C" void kernel_launch(void* const* d_in, const int* in_sizes, int n_in, void* d_out, int out_size, void* d_ws, size_t ws_size, hipStream_t stream) {
  static int grid_blocks = 0;
  if (grid_blocks == 0) {
    if (n_in != 28 || out_size != T_TOK * DM || ws_size < WS_END) { fprintf(stderr, "kernel_launch: unexpected problem (n_in %d out %d ws %zu need %zu)\n", n_in, out_size, ws_size, (size_t)WS_END); grid_blocks = -1; return; }
    int dev = 0, cus = 0, per_cu = 0;
    (void)hipGetDevice(&dev);
    (void)hipDeviceGetAttribute(&cus, hipDeviceAttributeMultiprocessorCount, dev);
#if MULTI_LAUNCH
    const void* fn = (const void*)k_phase;
#else
    const void* fn = (const void*)k_mega;
#endif
    if (hipFuncSetAttribute(fn, hipFuncAttributeMaxDynamicSharedMemorySize, LDS_BYTES) != hipSuccess) { fprintf(stderr, "kernel_launch: hipFuncSetAttribute failed\n"); }
    if (hipOccupancyMaxActiveBlocksPerMultiprocessor(&per_cu, fn, NTHR, LDS_BYTES) != hipSuccess || per_cu < 1) { fprintf(stderr, "kernel_launch: occupancy query failed (%d)\n", per_cu); per_cu = 1; }
    (void)hipGetLastError();
    grid_blocks = cus * per_cu;
    fprintf(stderr, "kernel_launch: cus %d per_cu %d grid %d\n", cus, per_cu, grid_blocks);
  }
  if (grid_blocks < 0) return;
  P p{};
  const float** pp = (const float**)&p;
  for (int i = 0; i < 28; ++i) pp[i] = (const float*)d_in[i];
  p.out = (float*)d_out; p.ws = (char*)d_ws;
#if MULTI_LAUNCH
  for (int ph = 0; ph < NPHASE; ++ph) hipLaunchKernelGGL(k_phase, dim3(grid_blocks), dim3(NTHR), LDS_BYTES, stream, p, ph);
#else
  void* args[] = {&p};
  hipError_t e = hipLaunchCooperativeKernel((const void*)k_mega, dim3(grid_blocks), dim3(NTHR), args, LDS_BYTES, stream);
  if (e != hipSuccess) fprintf(stderr, "cooperative launch failed: %s (grid %d)\n", hipGetErrorString(e), grid_blocks);
#endif
}
```

```cpp
#include <hip/hip_runtime.h>
#include <hip/hip_cooperative_groups.h>
#include <cstdio>
#include <cstdint>
namespace cg = cooperative_groups;

#ifndef USE_FP16
#define USE_FP16 1
#endif
#ifndef MULTI_LAUNCH
#define MULTI_LAUNCH 0
#endif

typedef unsigned short u16;
typedef float f32x4 __attribute__((ext_vector_type(4)));
typedef float f32x2 __attribute__((ext_vector_type(2)));
typedef _Float16 f16x8 __attribute__((ext_vector_type(8)));
typedef __bf16 b16x8 __attribute__((ext_vector_type(8)));

constexpr int T_TOK = 16384, DM = 1024, SEQ = 2048, NBATCH = 8;
constexpr int CAP = 32768;
constexpr int NTHR = 256;

constexpr size_t MB = 1024ull * 1024ull;
constexpr size_t WS_XA    = 0;
constexpr size_t WS_XB    = WS_XA + 64 * MB;
constexpr size_t WS_Z     = WS_XB + 32 * MB;
constexpr size_t WS_A2    = WS_Z + 64 * MB;
constexpr size_t WS_INC   = WS_A2 + 24 * MB;
constexpr size_t WS_YCAT  = WS_INC + 64 * MB;
constexpr size_t WS_YGELU = WS_YCAT + 32 * MB;
constexpr size_t WS_H     = WS_YGELU + 16 * MB;
constexpr size_t WS_LIST  = WS_H + 36 * MB;
constexpr size_t WS_GATE  = WS_LIST + 4 * MB;
constexpr size_t WS_ROPE  = WS_GATE + 1 * MB;
constexpr size_t WS_CNT   = WS_ROPE + 1 * MB;
constexpr size_t WS_END   = WS_CNT + 1 * MB;

struct P {
  const float *x, *norm_mix_g, *norm_ffn_g, *norm_final_g, *w_in, *ret_decay, *a_re, *a_im, *log_step, *b_re, *b_im, *c_re, *c_im,
      *s5d, *w_glu, *b_glu, *w_out, *w_qkv, *sink, *w_o, *rel_bias, *w_group, *b_group, *w_er, *b_er, *w_gate, *w_up, *w_down;
  float* out;
  char* ws;
};

__device__ __forceinline__ u16 f2h(float f) {
#if USE_FP16
  _Float16 h = (_Float16)f; return __builtin_bit_cast(u16, h);
#else
  unsigned u = __builtin_bit_cast(unsigned, f); u += 0x7fffu + ((u >> 16) & 1u); return (u16)(u >> 16);
#endif
}
__device__ __forceinline__ float h2f(u16 h) {
#if USE_FP16
  return (float)__builtin_bit_cast(_Float16, h);
#else
  return __builtin_bit_cast(float, ((unsigned)h) << 16);
#endif
}
__device__ __forceinline__ unsigned pk2(float a, float b) { return (unsigned)f2h(a) | ((unsigned)f2h(b) << 16); }
__device__ __forceinline__ float lo16(unsigned w) { return h2f((u16)(w & 0xffffu)); }
__device__ __forceinline__ float hi16(unsigned w) { return h2f((u16)(w >> 16)); }
__device__ __forceinline__ f32x4 mfma16(uint4 a, uint4 b, f32x4 c) {
#if USE_FP16
  return __builtin_amdgcn_mfma_f32_16x16x32_f16(__builtin_bit_cast(f16x8, a), __builtin_bit_cast(f16x8, b), c, 0, 0, 0);
#else
  return __builtin_amdgcn_mfma_f32_16x16x32_bf16(__builtin_bit_cast(b16x8, a), __builtin_bit_cast(b16x8, b), c, 0, 0, 0);
#endif
}
__device__ __forceinline__ float wave_sum(float v) {
#pragma unroll
  for (int o = 1; o < 64; o <<= 1) v += __shfl_xor(v, o);
  return v;
}
__device__ __forceinline__ float sigmoidf_(float x) { return 1.0f / (1.0f + __expf(-x)); }
__device__ __forceinline__ float gelu_tanh(float x) {
  const float u = 0.7978845608028654f * (x + 0.044715f * x * x * x);
  return 0.5f * x * (1.0f + tanhf(u));
}

struct GemmDesc {
  const u16* A; long lda;
  const int* rowmap; int rowshift;
  int mvalid;
  const float* W; const float* W2; long ldw;
  const u16* Bt; long ldb;
  int K;
};
constexpr int LSTR = 40;
constexpr int GEMM_LDS = 2 * 128 * LSTR * 2;

template <class Epi>
__device__ __forceinline__ void gemm_tile(const GemmDesc& g, int m0, int n0, Epi&& epi, char* smem) {
  u16* sA = (u16*)smem;
  u16* sB = sA + 128 * LSTR;
  const int tid = threadIdx.x, lane = tid & 63, wid = tid >> 6, wr = wid >> 1, wc = wid & 1, fr = lane & 15, fq = lane >> 4;
  f32x4 acc[4][4];
#pragma unroll
  for (int m = 0; m < 4; ++m)
#pragma unroll
    for (int n = 0; n < 4; ++n) acc[m][n] = (f32x4){0.f, 0.f, 0.f, 0.f};
  const int ar = tid >> 2, akc = (tid & 3) * 8;
  const u16* ap[2];
#pragma unroll
  for (int i = 0; i < 2; ++i) {
    const int m = m0 + ar + i * 64; const u16* q = nullptr;
    if (m < g.mvalid) { const long row = g.rowmap ? (long)(g.rowmap[m] >> g.rowshift) : (long)m; q = g.A + row * g.lda + akc; }
    ap[i] = q;
  }
  const bool useBt = (g.Bt != nullptr);
  const float* wp = nullptr; const u16* bp[2] = {nullptr, nullptr};
  if (!useBt) {
    const int v = n0 + (tid & 31) * 4;
    if (g.W2) wp = ((((v >> 5) & 1) ? g.W2 : g.W) + ((v >> 6) * 32 + (v & 31)));
    else wp = g.W + v;
    wp += (long)((tid >> 5) * 4) * g.ldw;
  } else {
#pragma unroll
    for (int i = 0; i < 2; ++i) bp[i] = g.Bt + (long)(n0 + ar + i * 64) * g.ldb + akc;
  }
  uint4 ra[2], rb[2]; f32x4 rw[4];
  auto gload = [&](int k0) {
#pragma unroll
    for (int i = 0; i < 2; ++i) ra[i] = ap[i] ? *(const uint4*)(ap[i] + k0) : make_uint4(0u, 0u, 0u, 0u);
    if (useBt) {
#pragma unroll
      for (int i = 0; i < 2; ++i) rb[i] = *(const uint4*)(bp[i] + k0);
    } else {
#pragma unroll
      for (int j = 0; j < 4; ++j) rw[j] = *(const f32x4*)(wp + (long)(k0 + j) * g.ldw);
    }
  };
  gload(0);
  for (int k0 = 0; k0 < g.K; k0 += 32) {
    __syncthreads();
#pragma unroll
    for (int i = 0; i < 2; ++i) *(uint4*)(sA + (ar + i * 64) * LSTR + akc) = ra[i];
    if (useBt) {
#pragma unroll
      for (int i = 0; i < 2; ++i) *(uint4*)(sB + (ar + i * 64) * LSTR + akc) = rb[i];
    } else {
      const int nl = (tid & 31) * 4, kl = (tid >> 5) * 4;
#pragma unroll
      for (int c = 0; c < 4; ++c) {
        uint2 v; v.x = pk2(rw[0][c], rw[1][c]); v.y = pk2(rw[2][c], rw[3][c]);
        *(uint2*)(sB + (nl + c) * LSTR + kl) = v;
      }
    }
    __syncthreads();
    if (k0 + 32 < g.K) gload(k0 + 32);
    uint4 fa[4], fb[4];
#pragma unroll
    for (int m = 0; m < 4; ++m) fa[m] = *(const uint4*)(sA + (wr * 64 + m * 16 + fr) * LSTR + fq * 8);
#pragma unroll
    for (int n = 0; n < 4; ++n) fb[n] = *(const uint4*)(sB + (wc * 64 + n * 16 + fr) * LSTR + fq * 8);
#pragma unroll
    for (int m = 0; m < 4; ++m)
#pragma unroll
      for (int n = 0; n < 4; ++n) acc[m][n] = mfma16(fb[n], fa[m], acc[m][n]);
  }
  epi(acc, m0 + wr * 64 + fr, n0 + wc * 64 + fq * 4);
}

__device__ void phase_prep(const P& p) {
  const int gtid = blockIdx.x * NTHR + threadIdx.x, gsz = gridDim.x * NTHR;
  int* cnt = (int*)(p.ws + WS_CNT);
  if (gtid < 64) cnt[gtid] = 0;
  f32x2* rope = (f32x2*)(p.ws + WS_ROPE);
  for (int i = gtid; i < SEQ * 64; i += gsz) {
    const int pos = i >> 6, f = i & 63;
    const float inv = powf(10000.0f, -(float)(2 * f) / 128.0f);
    const float ang = (float)pos * inv;
    float s, c; sincosf(ang, &s, &c);
    rope[i] = (f32x2){c, s};
  }
}

__device__ void phase_rowpass(const P& p, const float* src, const u16* slots, float* dstx, const float* gain, int route_layer, float* fout) {
  const int lane = threadIdx.x & 63, gw = blockIdx.x * 4 + (threadIdx.x >> 6), nw = gridDim.x * 4;
  u16* xb = (u16*)(p.ws + WS_XB);
  int* cnt = (int*)(p.ws + WS_CNT);
  int* list = (int*)(p.ws + WS_LIST);
  float* gate = (float*)(p.ws + WS_GATE);
  for (int row = gw; row < T_TOK; row += nw) {
    f32x4 v[4];
    float ss = 0.f;
#pragma unroll
    for (int i = 0; i < 4; ++i) {
      const int k = (i * 64 + lane) * 4;
      v[i] = *(const f32x4*)(src + (size_t)row * DM + k);
      if (slots) {
#pragma unroll
        for (int s = 0; s < 2; ++s) {
          const uint2 w = *(const uint2*)(slots + ((size_t)row * 2 + s) * DM + k);
          v[i][0] += lo16(w.x); v[i][1] += hi16(w.x); v[i][2] += lo16(w.y); v[i][3] += hi16(w.y);
        }
      }
      if (dstx) *(f32x4*)(dstx + (size_t)row * DM + k) = v[i];
      ss += v[i][0] * v[i][0] + v[i][1] * v[i][1] + v[i][2] * v[i][2] + v[i][3] * v[i][3];
    }
    ss = wave_sum(ss);
    const float rstd = rsqrtf(ss * (1.0f / DM) + 1e-6f);
#pragma unroll
    for (int i = 0; i < 4; ++i) {
      const int k = (i * 64 + lane) * 4;
      const f32x4 gv = *(const f32x4*)(gain + k);
      v[i] = v[i] * rstd * gv;
      if (fout) *(f32x4*)(fout + (size_t)row * DM + k) = v[i];
      else { uint2 w; w.x = pk2(v[i][0], v[i][1]); w.y = pk2(v[i][2], v[i][3]); *(uint2*)(xb + (size_t)row * DM + k) = w; }
    }
    if (route_layer >= 0) {
      const float* wg = p.w_group + (size_t)route_layer * DM * 4;
      const float* we = p.w_er + (size_t)route_layer * 4 * DM * 8;
      float acc[36];
#pragma unroll
      for (int j = 0; j < 36; ++j) acc[j] = 0.f;
#pragma unroll
      for (int i = 0; i < 4; ++i) {
#pragma unroll
        for (int c = 0; c < 4; ++c) {
          const int k = (i * 64 + lane) * 4 + c;
          const float hv = v[i][c];
          const f32x4 g4 = *(const f32x4*)(wg + (size_t)k * 4);
#pragma unroll
          for (int j = 0; j < 4; ++j) acc[j] += hv * g4[j];
#pragma unroll
          for (int gg = 0; gg < 4; ++gg) {
            const f32x4 e0 = *(const f32x4*)(we + ((size_t)gg * DM + k) * 8);
            const f32x4 e1 = *(const f32x4*)(we + ((size_t)gg * DM + k) * 8 + 4);
#pragma unroll
            for (int j = 0; j < 4; ++j) { acc[4 + gg * 8 + j] += hv * e0[j]; acc[4 + gg * 8 + 4 + j] += hv * e1[j]; }
          }
        }
      }
#pragma unroll
      for (int j = 0; j < 36; ++j) acc[j] = wave_sum(acc[j]);
      if (lane == 0) {
        const float* bg = p.b_group + route_layer * 4;
        const float* be = p.b_er + route_layer * 32;
        float gl[4];
#pragma unroll
        for (int j = 0; j < 4; ++j) gl[j] = acc[j] + bg[j];
        int gs = 0; float gm = gl[0];
#pragma unroll
        for (int j = 1; j < 4; ++j) if (gl[j] > gm) { gm = gl[j]; gs = j; }
        float den = 0.f;
#pragma unroll
        for (int j = 0; j < 4; ++j) den += expf(gl[j] - gm);
        const float pg = 1.0f / den;
        float el[8];
#pragma unroll
        for (int j = 0; j < 8; ++j) {
          float a = acc[4 + j];
#pragma unroll
          for (int gg = 1; gg < 4; ++gg) a = (gs == gg) ? acc[4 + gg * 8 + j] : a;
          el[j] = a + be[gs * 8 + j];
        }
        int i1 = 0; float v1 = el[0];
#pragma unroll
        for (int j = 1; j < 8; ++j) if (el[j] > v1) { v1 = el[j]; i1 = j; }
        int i2 = -1; float v2 = -3.0e38f;
#pragma unroll
        for (int j = 0; j < 8; ++j) if (j != i1 && el[j] > v2) { v2 = el[j]; i2 = j; }
        const float e2 = expf(v2 - v1);
        const float g1 = pg / (1.0f + e2), g2 = pg * e2 / (1.0f + e2);
        const int ex1 = gs * 8 + i1, ex2 = gs * 8 + i2;
        const int r1 = atomicAdd(&cnt[route_layer * 32 + ex1], 1);
        list[(size_t)ex1 * CAP + r1] = row * 2;
        gate[row * 2] = g1;
        const int r2 = atomicAdd(&cnt[route_layer * 32 + ex2], 1);
        list[(size_t)ex2 * CAP + r2] = row * 2 + 1;
        gate[row * 2 + 1] = g2;
      }
    }
  }
}

__device__ void phase_inproj(const P& p, char* smem) {
  GemmDesc g{}; g.A = (const u16*)(p.ws + WS_XB); g.lda = DM; g.mvalid = T_TOK; g.W = p.w_in; g.ldw = 2560; g.K = DM;
  u16* zb = (u16*)(p.ws + WS_Z); u16* a2 = (u16*)(p.ws + WS_A2);
  const int ntiles = 128 * 20;
  for (int t = blockIdx.x; t < ntiles; t += gridDim.x) {
    const int mt = t / 20, nt = t % 20;
    gemm_tile(g, mt * 128, nt * 128, [&](f32x4 (&acc)[4][4], int row0, int col0) {
      const int seg = (nt * 128) / 512;
#pragma unroll
      for (int m = 0; m < 4; ++m)
#pragma unroll
        for (int n = 0; n < 4; ++n) {
          const int row = row0 + m * 16, col = col0 + n * 16;
          uint2 w; w.x = pk2(acc[m][n][0], acc[m][n][1]); w.y = pk2(acc[m][n][2], acc[m][n][3]);
          if (seg < 4) *(uint2*)(zb + (size_t)seg * T_TOK * 512 + (size_t)row * 512 + (col - seg * 512)) = w;
          else { const int ch = col - 2048, gi = ch >> 4, c = ch & 15; *(uint2*)(a2 + ((size_t)gi * 512 + (row >> 5)) * 768 + (row & 31) * 16 + c) = w; }
        }
    }, smem);
  }
}

constexpr int RSTR = 136;
__device__ __forceinline__ void ret_load_tile(u16* dst, const u16* src, int t0, int h, int mode  , const f32x2* rope) {
  const int pos0 = t0 & (SEQ - 1);
  for (int idx = threadIdx.x; idx < 128 * 64; idx += NTHR) {
    const int i = idx >> 6, d = idx & 63;
    float t1 = h2f(src[(size_t)(t0 + i) * 512 + h * 128 + d]), t2 = h2f(src[(size_t)(t0 + i) * 512 + h * 128 + d + 64]);
    if (mode) {
      const f32x2 cs = rope[(pos0 + i) * 64 + d];
      const float o1 = t1 * cs[0] - t2 * cs[1], o2 = t1 * cs[1] + t2 * cs[0];
      t1 = o1; t2 = o2;
      if (mode == 2) { t1 *= 0.08838834764831845f; t2 *= 0.08838834764831845f; }
    }
    dst[i * RSTR + d] = f2h(t1); dst[i * RSTR + d + 64] = f2h(t2);
  }
}
__device__ __forceinline__ float log_sigmoid(float x) { return -log1pf(expf(-x)); }

__device__ void phase_ret_inc(const P& p, char* smem) {
  u16* sK = (u16*)smem; u16* sV = sK + 128 * RSTR; float* sWf = (float*)(sV + 128 * RSTR); float* sWb = sWf + 128;
  const u16* kb = (const u16*)(p.ws + WS_Z) + (size_t)1 * T_TOK * 512; const u16* vb = (const u16*)(p.ws + WS_Z) + (size_t)2 * T_TOK * 512;
  const f32x2* rope = (const f32x2*)(p.ws + WS_ROPE);
  float* incf = (float*)(p.ws + WS_INC); float* incb = incf + (size_t)512 * 16384;
  const int tid = threadIdx.x;
  for (int item = blockIdx.x; item < 512; item += gridDim.x) {
    const int h = item & 3, bn = item >> 2, t0 = bn * 128;
    const float lgf = log_sigmoid(p.ret_decay[h]), lgb = log_sigmoid(p.ret_decay[4 + h]);
    __syncthreads();
    ret_load_tile(sK, kb, t0, h, 2, rope);
    ret_load_tile(sV, vb, t0, h, 0, rope);
    if (tid < 128) { sWf[tid] = expf(lgf * (float)(127 - tid)); sWb[tid] = expf(lgb * (float)tid); }
    __syncthreads();
    const int d0 = (tid >> 4) * 8, e0 = (tid & 15) * 8;
    float af[8][8], ab[8][8];
#pragma unroll
    for (int a = 0; a < 8; ++a)
#pragma unroll
      for (int b = 0; b < 8; ++b) { af[a][b] = 0.f; ab[a][b] = 0.f; }
    for (int j = 0; j < 128; ++j) {
      const uint4 kq = *(const uint4*)(sK + j * RSTR + d0), vq = *(const uint4*)(sV + j * RSTR + e0);
      const float kd[8] = {lo16(kq.x), hi16(kq.x), lo16(kq.y), hi16(kq.y), lo16(kq.z), hi16(kq.z), lo16(kq.w), hi16(kq.w)};
      const float ve[8] = {lo16(vq.x), hi16(vq.x), lo16(vq.y), hi16(vq.y), lo16(vq.z), hi16(vq.z), lo16(vq.w), hi16(vq.w)};
      const float wf = sWf[j], wb = sWb[j];
#pragma unroll
      for (int a = 0; a < 8; ++a) {
        const float kf = kd[a] * wf, kbw = kd[a] * wb;
#pragma unroll
        for (int b = 0; b < 8; ++b) { af[a][b] += kf * ve[b]; ab[a][b] += kbw * ve[b]; }
      }
    }
#pragma unroll
    for (int a = 0; a < 8; ++a) {
      float* of = incf + (size_t)item * 16384 + (d0 + a) * 128 + e0;
      float* ob = incb + (size_t)item * 16384 + (d0 + a) * 128 + e0;
      *(f32x4*)of = (f32x4){af[a][0], af[a][1], af[a][2], af[a][3]}; *(f32x4*)(of + 4) = (f32x4){af[a][4], af[a][5], af[a][6], af[a][7]};
      *(f32x4*)ob = (f32x4){ab[a][0], ab[a][1], ab[a][2], ab[a][3]}; *(f32x4*)(ob + 4) = (f32x4){ab[a][4], ab[a][5], ab[a][6], ab[a][7]};
    }
  }
}

__device__ void phase_ret_scan(const P& p) {
  float* incf = (float*)(p.ws + WS_INC); float* incb = incf + (size_t)512 * 16384;
  const int gtid = blockIdx.x * NTHR + threadIdx.x, gsz = gridDim.x * NTHR;
  for (int idx = gtid; idx < 32 * 16384; idx += gsz) {
    const int de = idx & 16383, bh = idx >> 14, b = bh >> 2, h = bh & 3;
    const float Gf = expf(128.0f * log_sigmoid(p.ret_decay[h])), Gb = expf(128.0f * log_sigmoid(p.ret_decay[4 + h]));
    float s = 0.f;
    for (int n = 0; n < 16; ++n) { float* q = incf + ((size_t)((b * 16 + n) * 4 + h)) * 16384 + de; const float t = *q; *q = s; s = s * Gf + t; }
    s = 0.f;
    for (int n = 15; n >= 0; --n) { float* q = incb + ((size_t)((b * 16 + n) * 4 + h)) * 16384 + de; const float t = *q; *q = s; s = s * Gb + t; }
  }
}

__device__ void phase_ret_out(const P& p, char* smem) {
  u16* sQ = (u16*)smem; u16* sK = sQ + 128 * RSTR; u16* sV = sK + 128 * RSTR; u16* sS = sV + 128 * RSTR;
  float* sPf = (float*)(sS + 128 * RSTR); float* sPb = sPf + 132;
  const u16* zb = (const u16*)(p.ws + WS_Z);
  const u16* qb = zb; const u16* kb = zb + (size_t)1 * T_TOK * 512; const u16* vb = zb + (size_t)2 * T_TOK * 512; const u16* gb = zb + (size_t)3 * T_TOK * 512;
  const f32x2* rope = (const f32x2*)(p.ws + WS_ROPE);
  const float* incf = (const float*)(p.ws + WS_INC); const float* incb = incf + (size_t)512 * 16384;
  u16* ycat = (u16*)(p.ws + WS_YCAT);
  const int tid = threadIdx.x;
  for (int item = blockIdx.x; item < 512; item += gridDim.x) {
    const int h = item & 3, bn = item >> 2, t0 = bn * 128;
    const float lgf = log_sigmoid(p.ret_decay[h]), lgb = log_sigmoid(p.ret_decay[4 + h]);
    __syncthreads();
    ret_load_tile(sQ, qb, t0, h, 1, rope);
    ret_load_tile(sK, kb, t0, h, 2, rope);
    ret_load_tile(sV, vb, t0, h, 0, rope);
    if (tid < 129) { sPf[tid] = expf(lgf * (float)tid); sPb[tid] = expf(lgb * (float)tid); }
    __syncthreads();
    const int i0 = (tid >> 4) * 8, j0 = (tid & 15) * 8;
    {
      float s[8][8];
#pragma unroll
      for (int a = 0; a < 8; ++a)
#pragma unroll
        for (int b = 0; b < 8; ++b) s[a][b] = 0.f;
      for (int d = 0; d < 128; d += 8) {
        float kk[8][8];
#pragma unroll
        for (int b = 0; b < 8; ++b) {
          const uint4 kq = *(const uint4*)(sK + (j0 + b) * RSTR + d);
          kk[b][0] = lo16(kq.x); kk[b][1] = hi16(kq.x); kk[b][2] = lo16(kq.y); kk[b][3] = hi16(kq.y); kk[b][4] = lo16(kq.z); kk[b][5] = hi16(kq.z); kk[b][6] = lo16(kq.w); kk[b][7] = hi16(kq.w);
        }
#pragma unroll
        for (int a = 0; a < 8; ++a) {
          const uint4 qq = *(const uint4*)(sQ + (i0 + a) * RSTR + d);
          const float qv[8] = {lo16(qq.x), hi16(qq.x), lo16(qq.y), hi16(qq.y), lo16(qq.z), hi16(qq.z), lo16(qq.w), hi16(qq.w)};
#pragma unroll
          for (int b = 0; b < 8; ++b)
#pragma unroll
            for (int c = 0; c < 8; ++c) s[a][b] += qv[c] * kk[b][c];
        }
      }
#pragma unroll
      for (int a = 0; a < 8; ++a) {
        unsigned w[4];
#pragma unroll
        for (int b = 0; b < 8; b += 2) {
          const int i = i0 + a, j = j0 + b;
          const float m0 = (i >= j) ? sPf[i - j] : sPb[j - i];
          const float m1 = (i >= j + 1) ? sPf[i - j - 1] : sPb[j + 1 - i];
          w[b >> 1] = pk2(s[a][b] * m0, s[a][b + 1] * m1);
        }
        *(uint4*)(sS + (i0 + a) * RSTR + j0) = make_uint4(w[0], w[1], w[2], w[3]);
      }
    }
    __syncthreads();
    {
      const int e0 = j0;
      float o[8][8];
#pragma unroll
      for (int a = 0; a < 8; ++a)
#pragma unroll
        for (int b = 0; b < 8; ++b) o[a][b] = 0.f;
      for (int j = 0; j < 128; j += 8) {
        float vv[8][8];
#pragma unroll
        for (int c = 0; c < 8; ++c) {
          const uint4 vq = *(const uint4*)(sV + (j + c) * RSTR + e0);
          vv[c][0] = lo16(vq.x); vv[c][1] = hi16(vq.x); vv[c][2] = lo16(vq.y); vv[c][3] = hi16(vq.y); vv[c][4] = lo16(vq.z); vv[c][5] = hi16(vq.z); vv[c][6] = lo16(vq.w); vv[c][7] = hi16(vq.w);
        }
#pragma unroll
        for (int a = 0; a < 8; ++a) {
          const uint4 sq = *(const uint4*)(sS + (i0 + a) * RSTR + j);
          const float sv[8] = {lo16(sq.x), hi16(sq.x), lo16(sq.y), hi16(sq.y), lo16(sq.z), hi16(sq.z), lo16(sq.w), hi16(sq.w)};
#pragma unroll
          for (int c = 0; c < 8; ++c)
#pragma unroll
            for (int b = 0; b < 8; ++b) o[a][b] += sv[c] * vv[c][b];
        }
      }
      const float* sp = incf + (size_t)item * 16384 + e0;
      const float* sn = incb + (size_t)item * 16384 + e0;
      float pf[8], pb[8];
#pragma unroll
      for (int a = 0; a < 8; ++a) { pf[a] = sPf[i0 + a + 1]; pb[a] = sPb[128 - (i0 + a)]; }
      for (int d = 0; d < 128; ++d) {
        const f32x4 p0 = *(const f32x4*)(sp + d * 128), p1 = *(const f32x4*)(sp + d * 128 + 4);
        const f32x4 n0 = *(const f32x4*)(sn + d * 128), n1 = *(const f32x4*)(sn + d * 128 + 4);
        const float spv[8] = {p0[0], p0[1], p0[2], p0[3], p1[0], p1[1], p1[2], p1[3]};
        const float snv[8] = {n0[0], n0[1], n0[2], n0[3], n1[0], n1[1], n1[2], n1[3]};
#pragma unroll
        for (int a = 0; a < 8; ++a) {
          const float qv = h2f(sQ[(i0 + a) * RSTR + d]);
          const float qf = qv * pf[a], qbk = qv * pb[a];
#pragma unroll
          for (int b = 0; b < 8; ++b) o[a][b] += qf * spv[b] + qbk * snv[b];
        }
      }
#pragma unroll
      for (int a = 0; a < 8; ++a) {
        float s1 = 0.f;
#pragma unroll
        for (int b = 0; b < 8; ++b) s1 += o[a][b];
        s1 += __shfl_xor(s1, 1); s1 += __shfl_xor(s1, 2); s1 += __shfl_xor(s1, 4); s1 += __shfl_xor(s1, 8);
        const float mu = s1 * (1.0f / 128.0f);
        float s2 = 0.f;
#pragma unroll
        for (int b = 0; b < 8; ++b) { const float dlt = o[a][b] - mu; s2 += dlt * dlt; }
        s2 += __shfl_xor(s2, 1); s2 += __shfl_xor(s2, 2); s2 += __shfl_xor(s2, 4); s2 += __shfl_xor(s2, 8);
        const float rs = rsqrtf(s2 * (1.0f / 128.0f) + 1e-5f);
        const size_t tok = (size_t)(t0 + i0 + a);
        const uint4 gq = *(const uint4*)(gb + tok * 512 + h * 128 + e0);
        const float gv[8] = {lo16(gq.x), hi16(gq.x), lo16(gq.y), hi16(gq.y), lo16(gq.z), hi16(gq.z), lo16(gq.w), hi16(gq.w)};
        unsigned w[4];
#pragma unroll
        for (int b = 0; b < 8; b += 2) {
          const float y0 = gv[b] * sigmoidf_(gv[b]) * (o[a][b] - mu) * rs;
          const float y1 = gv[b + 1] * sigmoidf_(gv[b + 1]) * (o[a][b + 1] - mu) * rs;
          w[b >> 1] = pk2(y0, y1);
        }
        *(uint4*)(ycat + tok * DM + h * 128 + e0) = make_uint4(w[0], w[1], w[2], w[3]);
      }
    }
  }
}

__device__ void phase_s5_naive(const P& p, char* smem) {
  float* ylds = (float*)smem;
  float* xs = ylds + 2048 * 16;
  const u16* a2 = (const u16*)(p.ws + WS_A2);
  u16* ygelu = (u16*)(p.ws + WS_YGELU);
  const int lane = threadIdx.x & 63;
  if (threadIdx.x < 64) {
    for (int item = blockIdx.x; item < 256; item += gridDim.x) {
      const int b = item >> 5, g = item & 31;
      const int pidx = lane;
      const int cidx = lane & 15, quart = lane >> 4;
      for (int dir = 0; dir < 2; ++dir) {
        const float dt = expf(p.log_step[dir * 32 + g]);
        const float ar = p.a_re[(dir * 32 + g) * 64 + pidx], ai = p.a_im[(dir * 32 + g) * 64 + pidx];
        const float mag = expf(ar * dt);
        float sn, cs; sincosf(ai * dt, &sn, &cs);
        const float lre = mag * cs, lim = mag * sn;
        const float nr = lre - 1.0f, ni = lim, den = ar * ar + ai * ai;
        const float cre = (nr * ar + ni * ai) / den, cim = (ni * ar - nr * ai) / den;
        float bbr[16], bbi[16];
#pragma unroll
        for (int c = 0; c < 16; ++c) {
          const float br = p.b_re[(g * 64 + pidx) * 16 + c], bi = p.b_im[(g * 64 + pidx) * 16 + c];
          bbr[c] = cre * br - cim * bi; bbi[c] = cre * bi + cim * br;
        }
        float ccr[16], cci[16];
#pragma unroll
        for (int q = 0; q < 16; ++q) {
          ccr[q] = p.c_re[((dir * 32 + g) * 16 + cidx) * 64 + quart * 16 + q];
          cci[q] = p.c_im[((dir * 32 + g) * 16 + cidx) * 64 + quart * 16 + q];
        }
        const float dsk = p.s5d[g * 16 + cidx];
        float xr = 0.f, xi = 0.f;
        for (int step = 0; step < SEQ; ++step) {
          const int n = dir ? (SEQ - 1 - step) : step;
          const int t = b * SEQ + n;
          const u16* up = a2 + ((size_t)g * 512 + (t >> 5)) * 768 + (t & 31) * 16;
          const uint4 u0 = *(const uint4*)up, u1 = *(const uint4*)(up + 8);
          const float uv[16] = {lo16(u0.x), hi16(u0.x), lo16(u0.y), hi16(u0.y), lo16(u0.z), hi16(u0.z), lo16(u0.w), hi16(u0.w),
                                lo16(u1.x), hi16(u1.x), lo16(u1.y), hi16(u1.y), lo16(u1.z), hi16(u1.z), lo16(u1.w), hi16(u1.w)};
          float bur = 0.f, bui = 0.f;
#pragma unroll
          for (int c = 0; c < 16; ++c) { bur += bbr[c] * uv[c]; bui += bbi[c] * uv[c]; }
          const float nxr = lre * xr - lim * xi + bur, nxi = lre * xi + lim * xr + bui;
          xr = nxr; xi = nxi;
          asm volatile("s_waitcnt lgkmcnt(0)" ::: "memory");
          xs[lane] = xr; xs[64 + lane] = xi;
          asm volatile("s_waitcnt lgkmcnt(0)" ::: "memory");
          float part = 0.f;
#pragma unroll
          for (int q = 0; q < 16; ++q) part += ccr[q] * xs[quart * 16 + q] - cci[q] * xs[64 + quart * 16 + q];
          asm volatile("s_waitcnt lgkmcnt(0)" ::: "memory");
          part += __shfl_xor(part, 16); part += __shfl_xor(part, 32);
          if (lane < 16) {
            if (dir == 0) ylds[n * 16 + cidx] = dsk * h2f(up[cidx]) + part;
            else ygelu[(size_t)t * 512 + g * 16 + cidx] = f2h(gelu_tanh(ylds[n * 16 + cidx] + part));
          }
        }
      }
    }
  }
}

__device__ void phase_glu(const P& p, char* smem) {
  const u16* yg = (const u16*)(p.ws + WS_YGELU); u16* ycat = (u16*)(p.ws + WS_YCAT);
  GemmDesc g{}; g.A = yg; g.lda = 512; g.mvalid = T_TOK; g.W = p.w_glu; g.ldw = 512; g.K = 512;
  for (int t = blockIdx.x; t < 128 * 4; t += gridDim.x) {
    const int mt = t >> 2, nt = t & 3;
    gemm_tile(g, mt * 128, nt * 128, [&](f32x4 (&acc)[4][4], int row0, int col0) {
#pragma unroll
      for (int m = 0; m < 4; ++m)
#pragma unroll
        for (int n = 0; n < 4; ++n) {
          const int row = row0 + m * 16, col = col0 + n * 16;
          const uint2 yv = *(const uint2*)(yg + (size_t)row * 512 + col);
          const f32x4 bb = *(const f32x4*)(p.b_glu + col);
          const float y0 = lo16(yv.x) * sigmoidf_(acc[m][n][0] + bb[0]), y1 = hi16(yv.x) * sigmoidf_(acc[m][n][1] + bb[1]);
          const float y2 = lo16(yv.y) * sigmoidf_(acc[m][n][2] + bb[2]), y3 = hi16(yv.y) * sigmoidf_(acc[m][n][3] + bb[3]);
          uint2 w; w.x = pk2(y0, y1); w.y = pk2(y2, y3);
          *(uint2*)(ycat + (size_t)row * DM + 512 + col) = w;
        }
    }, smem);
  }
}

__device__ void phase_outproj(const P& p, const u16* A, const float* W, const float* xin, float* xout, char* smem) {
  GemmDesc g{}; g.A = A; g.lda = DM; g.mvalid = T_TOK; g.W = W; g.ldw = DM; g.K = DM;
  for (int t = blockIdx.x; t < 128 * 8; t += gridDim.x) {
    const int mt = t >> 3, nt = t & 7;
    gemm_tile(g, mt * 128, nt * 128, [&](f32x4 (&acc)[4][4], int row0, int col0) {
#pragma unroll
      for (int m = 0; m < 4; ++m)
#pragma unroll
        for (int n = 0; n < 4; ++n) {
          const size_t o = (size_t)(row0 + m * 16) * DM + col0 + n * 16;
          const f32x4 xv = *(const f32x4*)(xin + o);
          *(f32x4*)(xout + o) = xv + acc[m][n];
        }
    }, smem);
  }
}

__device__ void phase_qkv(const P& p, char* smem) {
  GemmDesc g{}; g.A = (const u16*)(p.ws + WS_XB); g.lda = DM; g.mvalid = T_TOK; g.W = p.w_qkv; g.ldw = 1536; g.K = DM;
  u16* q1 = (u16*)(p.ws + WS_Z); u16* k1 = (u16*)(p.ws + WS_Z + 32 * MB); u16* v1 = (u16*)(p.ws + WS_Z + 40 * MB);
  for (int t = blockIdx.x; t < 128 * 12; t += gridDim.x) {
    const int mt = t / 12, nt = t % 12;
    gemm_tile(g, mt * 128, nt * 128, [&](f32x4 (&acc)[4][4], int row0, int col0) {
#pragma unroll
      for (int m = 0; m < 4; ++m)
#pragma unroll
        for (int n = 0; n < 4; ++n) {
          const int row = row0 + m * 16, col = col0 + n * 16;
          uint2 w;
          if (nt < 8) { w.x = pk2(acc[m][n][0] * 0.125f, acc[m][n][1] * 0.125f); w.y = pk2(acc[m][n][2] * 0.125f, acc[m][n][3] * 0.125f); *(uint2*)(q1 + (size_t)row * DM + col) = w; }
          else {
            w.x = pk2(acc[m][n][0], acc[m][n][1]); w.y = pk2(acc[m][n][2], acc[m][n][3]);
            if (nt < 10) *(uint2*)(k1 + (size_t)row * 256 + (col - 1024)) = w; else *(uint2*)(v1 + (size_t)row * 256 + (col - 1280)) = w;
          }
        }
    }, smem);
  }
}

struct MoeTile { int e, rt, ct, cnt, hbase; };
__device__ __forceinline__ bool moe_decode(const int* cnt, int t, MoeTile& mt) {
  int base = 0, hb = 0;
  for (int e = 0; e < 32; ++e) {
    const int c = cnt[e], nt = (c + 127) >> 7, span = nt * 8;
    if (t < base + span) { const int loc = t - base; mt.e = e; mt.rt = loc % nt; mt.ct = loc / nt; mt.cnt = c; mt.hbase = hb; return true; }
    base += span; hb += nt * 128;
  }
  return false;
}
__device__ void phase_moe1(const P& p, int layer, char* smem) {
  const int* cnt = (const int*)(p.ws + WS_CNT) + layer * 32;
  const int* list = (const int*)(p.ws + WS_LIST);
  u16* hbuf = (u16*)(p.ws + WS_H);
  for (int t = blockIdx.x;; t += gridDim.x) {
    MoeTile mt; if (!moe_decode(cnt, t, mt)) break;
    GemmDesc g{}; g.A = (const u16*)(p.ws + WS_XB); g.lda = DM; g.rowmap = list + (size_t)mt.e * CAP; g.rowshift = 1; g.mvalid = mt.cnt;
    g.W = p.w_gate + (size_t)(layer * 32 + mt.e) * DM * 512; g.W2 = p.w_up + (size_t)(layer * 32 + mt.e) * DM * 512; g.ldw = 512; g.K = DM;
    gemm_tile(g, mt.rt * 128, mt.ct * 128, [&](f32x4 (&acc)[4][4], int row0, int col0) {
      const int ocol0 = (col0 >> 6) * 32 + (col0 & 31);
#pragma unroll
      for (int m = 0; m < 4; ++m) {
        const int row = row0 + m * 16;
        if (row < mt.cnt) {
#pragma unroll
          for (int nn = 0; nn < 2; ++nn) {
            float hv[4];
#pragma unroll
            for (int r = 0; r < 4; ++r) { const float gt = acc[m][nn][r]; hv[r] = gt * sigmoidf_(gt) * acc[m][nn + 2][r]; }
            uint2 w; w.x = pk2(hv[0], hv[1]); w.y = pk2(hv[2], hv[3]);
            *(uint2*)(hbuf + (size_t)(mt.hbase + row) * 512 + ocol0 + nn * 16) = w;
          }
        }
      }
    }, smem);
  }
}
__device__ void phase_moe2(const P& p, int layer, char* smem) {
  const int* cnt = (const int*)(p.ws + WS_CNT) + layer * 32;
  const int* list = (const int*)(p.ws + WS_LIST);
  const float* gate = (const float*)(p.ws + WS_GATE);
  const u16* hbuf = (const u16*)(p.ws + WS_H);
  u16* slots = (u16*)(p.ws + WS_INC);
  for (int t = blockIdx.x;; t += gridDim.x) {
    MoeTile mt; if (!moe_decode(cnt, t, mt)) break;
    GemmDesc g{}; g.A = hbuf + (size_t)mt.hbase * 512; g.lda = 512; g.mvalid = mt.cnt;
    g.W = p.w_down + (size_t)(layer * 32 + mt.e) * 512 * DM; g.ldw = DM; g.K = 512;
    gemm_tile(g, mt.rt * 128, mt.ct * 128, [&](f32x4 (&acc)[4][4], int row0, int col0) {
#pragma unroll
      for (int m = 0; m < 4; ++m) {
        const int row = row0 + m * 16;
        if (row < mt.cnt) {
          const int asg = list[(size_t)mt.e * CAP + row];
          const float gt = gate[asg];
#pragma unroll
          for (int n = 0; n < 4; ++n) {
            uint2 w; w.x = pk2(gt * acc[m][n][0], gt * acc[m][n][1]); w.y = pk2(gt * acc[m][n][2], gt * acc[m][n][3]);
            *(uint2*)(slots + (size_t)asg * DM + col0 + n * 16) = w;
          }
        }
      }
    }, smem);
  }
}

constexpr int KSTR = 72;
__device__ __forceinline__ int t5_bucket_abs(int n) {
  return n < 8 ? n : 8 + (n >= 12) + (n >= 16) + (n >= 23) + (n >= 32) + (n >= 46) + (n >= 64) + (n >= 91);
}
__device__ void phase_attn_naive(const P& p, char* smem) {
  u16* sK = (u16*)smem; u16* sV = sK + 384 * KSTR; float* sBias = (float*)(sV + 384 * KSTR);
  const u16* q1 = (const u16*)(p.ws + WS_Z); const u16* k1 = (const u16*)(p.ws + WS_Z + 32 * MB); const u16* v1 = (const u16*)(p.ws + WS_Z + 40 * MB);
  u16* ao = (u16*)(p.ws + WS_YCAT);
  const int tid = threadIdx.x;
  for (int item = blockIdx.x; item < 512; item += gridDim.x) {
    const int b = item >> 6, nb = (item >> 2) & 15, kvh = item & 3;
    __syncthreads();
    for (int c = tid; c < 384 * 8; c += NTHR) {
      const int s = c >> 3, ch = (c & 7) * 8, pos = (nb - 1) * 128 + s;
      uint4 kq = make_uint4(0u, 0u, 0u, 0u), vq = kq;
      if (pos >= 0 && pos < SEQ) { kq = *(const uint4*)(k1 + (size_t)(b * SEQ + pos) * 256 + kvh * 64 + ch); vq = *(const uint4*)(v1 + (size_t)(b * SEQ + pos) * 256 + kvh * 64 + ch); }
      *(uint4*)(sK + s * KSTR + ch) = kq; *(uint4*)(sV + s * KSTR + ch) = vq;
    }
    for (int c = tid; c < 4 * 257; c += NTHR) {
      const int hq = c / 257, ri = c % 257, rel = ri - 128, n = rel < 0 ? -rel : rel;
      const int bucket = (rel > 0 ? 16 : 0) + t5_bucket_abs(n);
      sBias[hq * 260 + ri] = p.rel_bias[bucket * 16 + kvh * 4 + hq];
    }
    __syncthreads();
    for (int pass = 0; pass < 2; ++pass) {
      const int hq = pass * 2 + (tid >> 7), qi = tid & 127, head = kvh * 4 + hq;
      const size_t tok = (size_t)b * SEQ + nb * 128 + qi;
      float q[64];
#pragma unroll
      for (int d = 0; d < 64; d += 8) {
        const uint4 qq = *(const uint4*)(q1 + tok * DM + head * 64 + d);
        q[d] = lo16(qq.x); q[d + 1] = hi16(qq.x); q[d + 2] = lo16(qq.y); q[d + 3] = hi16(qq.y); q[d + 4] = lo16(qq.z); q[d + 5] = hi16(qq.z); q[d + 6] = lo16(qq.w); q[d + 7] = hi16(qq.w);
      }
      float mx = p.sink[head], l = 1.0f, o[64];
#pragma unroll
      for (int d = 0; d < 64; ++d) o[d] = 0.f;
      for (int r = 0; r <= 256; ++r) {
        const int s = qi + r, pos = (nb - 1) * 128 + s;
        if (pos < 0 || pos >= SEQ) continue;
        float sc = 0.f;
#pragma unroll
        for (int d = 0; d < 64; d += 8) {
          const uint4 kq = *(const uint4*)(sK + s * KSTR + d);
          sc += q[d] * lo16(kq.x) + q[d + 1] * hi16(kq.x) + q[d + 2] * lo16(kq.y) + q[d + 3] * hi16(kq.y) + q[d + 4] * lo16(kq.z) + q[d + 5] * hi16(kq.z) + q[d + 6] * lo16(kq.w) + q[d + 7] * hi16(kq.w);
        }
        sc += sBias[hq * 260 + r];
        const float mn = fmaxf(mx, sc), alpha = __expf(mx - mn), pe = __expf(sc - mn);
        l = l * alpha + pe; mx = mn;
#pragma unroll
        for (int d = 0; d < 64; d += 8) {
          const uint4 vq = *(const uint4*)(sV + s * KSTR + d);
          o[d] = o[d] * alpha + pe * lo16(vq.x); o[d + 1] = o[d + 1] * alpha + pe * hi16(vq.x); o[d + 2] = o[d + 2] * alpha + pe * lo16(vq.y); o[d + 3] = o[d + 3] * alpha + pe * hi16(vq.y);
          o[d + 4] = o[d + 4] * alpha + pe * lo16(vq.z); o[d + 5] = o[d + 5] * alpha + pe * hi16(vq.z); o[d + 6] = o[d + 6] * alpha + pe * lo16(vq.w); o[d + 7] = o[d + 7] * alpha + pe * hi16(vq.w);
        }
      }
      const float inv = 1.0f / l;
#pragma unroll
      for (int d = 0; d < 64; d += 8) {
        uint4 w; w.x = pk2(o[d] * inv, o[d + 1] * inv); w.y = pk2(o[d + 2] * inv, o[d + 3] * inv); w.z = pk2(o[d + 4] * inv, o[d + 5] * inv); w.w = pk2(o[d + 6] * inv, o[d + 7] * inv);
        *(uint4*)(ao + tok * DM + head * 64 + d) = w;
      }
    }
  }
}

constexpr int NPHASE = 20;
constexpr int LDS_BYTES = 141312;
__device__ __forceinline__ void run_phase(const P& p, int ph, char* smem) {
  float* xa = (float*)(p.ws + WS_XA);
  const u16* ycat = (const u16*)(p.ws + WS_YCAT);
  const u16* slots = (const u16*)(p.ws + WS_INC);
  switch (ph) {
    case 0: phase_prep(p); break;
    case 1: phase_rowpass(p, p.x, nullptr, nullptr, p.norm_mix_g, -1, nullptr); break;
    case 2: phase_inproj(p, smem); break;
    case 3: phase_ret_inc(p, smem); break;
    case 4: phase_ret_scan(p); break;
    case 5: phase_ret_out(p, smem); break;
    case 6: phase_s5_naive(p, smem); break;
    case 7: phase_glu(p, smem); break;
    case 8: phase_outproj(p, ycat, p.w_out, p.x, xa, smem); break;
    case 9: phase_rowpass(p, xa, nullptr, nullptr, p.norm_ffn_g, 0, nullptr); break;
    case 10: phase_moe1(p, 0, smem); break;
    case 11: phase_moe2(p, 0, smem); break;
    case 12: phase_rowpass(p, xa, slots, xa, p.norm_mix_g + DM, -1, nullptr); break;
    case 13: phase_qkv(p, smem); break;
    case 14: phase_attn_naive(p, smem); break;
    case 15: phase_outproj(p, ycat, p.w_o, xa, xa, smem); break;
    case 16: phase_rowpass(p, xa, nullptr, nullptr, p.norm_ffn_g + DM, 1, nullptr); break;
    case 17: phase_moe1(p, 1, smem); break;
    case 18: phase_moe2(p, 1, smem); break;
    case 19: phase_rowpass(p, xa, slots, nullptr, p.norm_final_g, -1, p.out); break;
    default: break;
  }
}

extern __shared__ __attribute__((aligned(16))) char dyn_smem[];

#if MULTI_LAUNCH
__global__ void __launch_bounds__(NTHR) k_phase(P p, int ph) { run_phase(p, ph, dyn_smem); }
#else

template <int PH> __device__ __forceinline__ void mega_steps(const P& p, char* smem, cg::grid_group& grid) {
  run_phase(p, PH, smem);
  if constexpr (PH + 1 < NPHASE) { grid.sync(); mega_steps<PH + 1>(p, smem, grid); }
}
__global__ void __launch_bounds__(NTHR) k_mega(P p) {
  cg::grid_group grid = cg::this_grid();
  mega_steps<0>(p, dyn_smem, grid);
}
#endif

extern "C" void kernel_launch(void* const* d_in, const int* in_sizes, int n_in, void* d_out, int out_size, void* d_ws, size_t ws_size, hipStream_t stream) {
  static int grid_blocks = 0;
  if (grid_blocks == 0) {
    if (n_in != 28 || out_size != T_TOK * DM || ws_size < WS_END) { fprintf(stderr, "kernel_launch: unexpected problem (n_in %d out %d ws %zu need %zu)\n", n_in, out_size, ws_size, (size_t)WS_END); grid_blocks = -1; return; }
    int dev = 0, cus = 0, per_cu = 0;
    (void)hipGetDevice(&dev);
    (void)hipDeviceGetAttribute(&cus, hipDeviceAttributeMultiprocessorCount, dev);
#if MULTI_LAUNCH
    const void* fn = (const void*)k_phase;
#else
    const void* fn = (const void*)k_mega;
#endif
    if (hipFuncSetAttribute(fn, hipFuncAttributeMaxDynamicSharedMemorySize, LDS_BYTES) != hipSuccess) { fprintf(stderr, "kernel_launch: hipFuncSetAttribute failed\n"); }
    if (hipOccupancyMaxActiveBlocksPerMultiprocessor(&per_cu, fn, NTHR, LDS_BYTES) != hipSuccess || per_cu < 1) { fprintf(stderr, "kernel_launch: occupancy query failed (%d)\n", per_cu); per_cu = 1; }
    (void)hipGetLastError();
    grid_blocks = cus * per_cu;
    fprintf(stderr, "kernel_launch: cus %d per_cu %d grid %d\n", cus, per_cu, grid_blocks);
  }
  if (grid_blocks < 0) return;
  P p{};
  const float** pp = (const float**)&p;
  for (int i = 0; i < 28; ++i) pp[i] = (const float*)d_in[i];
  p.out = (float*)d_out; p.ws = (char*)d_ws;
#if MULTI_LAUNCH
  for (int ph = 0; ph < NPHASE; ++ph) hipLaunchKernelGGL(k_phase, dim3(grid_blocks), dim3(NTHR), LDS_BYTES, stream, p, ph);
#else
  void* args[] = {&p};
  hipError_t e = hipLaunchCooperativeKernel((const void*)k_mega, dim3(grid_blocks), dim3(NTHR), args, LDS_BYTES, stream);
  if (e != hipSuccess) fprintf(stderr, "cooperative launch failed: %s (grid %d)\n", hipGetErrorString(e), grid_blocks);
#endif
}
```

```cpp
#include <hip/hip_runtime.h>
#include <hip/hip_cooperative_groups.h>
#include <cstdio>
#include <cstdint>
namespace cg = cooperative_groups;

#ifndef USE_FP16
#define USE_FP16 1
#endif
#ifndef MULTI_LAUNCH
#define MULTI_LAUNCH 0
#endif

typedef unsigned short u16;
typedef float f32x4 __attribute__((ext_vector_type(4)));
typedef float f32x2 __attribute__((ext_vector_type(2)));
typedef _Float16 f16x8 __attribute__((ext_vector_type(8)));
typedef __bf16 b16x8 __attribute__((ext_vector_type(8)));

constexpr int T_TOK = 16384, DM = 1024, SEQ = 2048, NBATCH = 8;
constexpr int CAP = 32768;
constexpr int NTHR = 256;

constexpr size_t MB = 1024ull * 1024ull;
constexpr size_t WS_XA    = 0;
constexpr size_t WS_XB    = WS_XA + 64 * MB;
constexpr size_t WS_Z     = WS_XB + 32 * MB;
constexpr size_t WS_A2    = WS_Z + 64 * MB;
constexpr size_t WS_INC   = WS_A2 + 24 * MB;
constexpr size_t WS_YCAT  = WS_INC + 64 * MB;
constexpr size_t WS_YGELU = WS_YCAT + 32 * MB;
constexpr size_t WS_H     = WS_YGELU + 16 * MB;
constexpr size_t WS_LIST  = WS_H + 36 * MB;
constexpr size_t WS_GATE  = WS_LIST + 4 * MB;
constexpr size_t WS_ROPE  = WS_GATE + 1 * MB;
constexpr size_t WS_CNT   = WS_ROPE + 1 * MB;
constexpr size_t WS_KTAB  = WS_CNT + 1 * MB;
constexpr size_t WS_BTY   = WS_KTAB + 2 * MB;
constexpr size_t WS_WET   = WS_BTY + 24 * MB;
constexpr size_t WS_E     = WS_WET + 8 * MB;
constexpr size_t WS_END   = WS_E + 16 * MB;

struct P {
  const float *x, *norm_mix_g, *norm_ffn_g, *norm_final_g, *w_in, *ret_decay, *a_re, *a_im, *log_step, *b_re, *b_im, *c_re, *c_im,
      *s5d, *w_glu, *b_glu, *w_out, *w_qkv, *sink, *w_o, *rel_bias, *w_group, *b_group, *w_er, *b_er, *w_gate, *w_up, *w_down;
  float* out;
  char* ws;
};

__device__ __forceinline__ u16 f2h(float f) {
#if USE_FP16
  _Float16 h = (_Float16)f; return __builtin_bit_cast(u16, h);
#else
  unsigned u = __builtin_bit_cast(unsigned, f); u += 0x7fffu + ((u >> 16) & 1u); return (u16)(u >> 16);
#endif
}
__device__ __forceinline__ float h2f(u16 h) {
#if USE_FP16
  return (float)__builtin_bit_cast(_Float16, h);
#else
  return __builtin_bit_cast(float, ((unsigned)h) << 16);
#endif
}
__device__ __forceinline__ unsigned pk2(float a, float b) { return (unsigned)f2h(a) | ((unsigned)f2h(b) << 16); }
__device__ __forceinline__ float lo16(unsigned w) { return h2f((u16)(w & 0xffffu)); }
__device__ __forceinline__ float hi16(unsigned w) { return h2f((u16)(w >> 16)); }
__device__ __forceinline__ f32x4 mfma16(uint4 a, uint4 b, f32x4 c) {
#if USE_FP16
  return __builtin_amdgcn_mfma_f32_16x16x32_f16(__builtin_bit_cast(f16x8, a), __builtin_bit_cast(f16x8, b), c, 0, 0, 0);
#else
  return __builtin_amdgcn_mfma_f32_16x16x32_bf16(__builtin_bit_cast(b16x8, a), __builtin_bit_cast(b16x8, b), c, 0, 0, 0);
#endif
}
__device__ __forceinline__ float wave_sum(float v) {
#pragma unroll
  for (int o = 1; o < 64; o <<= 1) v += __shfl_xor(v, o);
  return v;
}
__device__ __forceinline__ float sigmoidf_(float x) { return 1.0f / (1.0f + __expf(-x)); }
__device__ __forceinline__ float gelu_tanh(float x) {
  const float u = 0.7978845608028654f * (x + 0.044715f * x * x * x);
  return 0.5f * x * (1.0f + tanhf(u));
}

struct GemmDesc {
  const u16* A; long lda;
  const int* rowmap; int rowshift;
  int mvalid;
  const float* W; const float* W2; long ldw;
  const u16* Bt; long ldb;
  int K;
};
constexpr int LSTR = 40;
constexpr int GEMM_LDS = 2 * 128 * LSTR * 2;

template <class Epi>
__device__ __forceinline__ void gemm_tile(const GemmDesc& g, int m0, int n0, Epi&& epi, char* smem) {
  u16* sA = (u16*)smem;
  u16* sB = sA + 128 * LSTR;
  const int tid = threadIdx.x, lane = tid & 63, wid = tid >> 6, wr = wid >> 1, wc = wid & 1, fr = lane & 15, fq = lane >> 4;
  f32x4 acc[4][4];
#pragma unroll
  for (int m = 0; m < 4; ++m)
#pragma unroll
    for (int n = 0; n < 4; ++n) acc[m][n] = (f32x4){0.f, 0.f, 0.f, 0.f};
  const int ar = tid >> 2, akc = (tid & 3) * 8;
  const u16* ap[2];
#pragma unroll
  for (int i = 0; i < 2; ++i) {
    const int m = m0 + ar + i * 64; const u16* q = nullptr;
    if (m < g.mvalid) { const long row = g.rowmap ? (long)(g.rowmap[m] >> g.rowshift) : (long)m; q = g.A + row * g.lda + akc; }
    ap[i] = q;
  }
  const bool useBt = (g.Bt != nullptr);
  const float* wp = nullptr; const u16* bp[2] = {nullptr, nullptr};
  if (!useBt) {
    const int v = n0 + (tid & 31) * 4;
    if (g.W2) wp = ((((v >> 5) & 1) ? g.W2 : g.W) + ((v >> 6) * 32 + (v & 31)));
    else wp = g.W + v;
    wp += (long)((tid >> 5) * 4) * g.ldw;
  } else {
#pragma unroll
    for (int i = 0; i < 2; ++i) bp[i] = g.Bt + (long)(n0 + ar + i * 64) * g.ldb + akc;
  }
  uint4 ra0, ra1, rb0 = make_uint4(0u, 0u, 0u, 0u), rb1 = rb0; f32x4 rw0 = {0.f, 0.f, 0.f, 0.f}, rw1 = rw0, rw2 = rw0, rw3 = rw0;
#define GEMM_GLOAD(k0_)                                                                                   \
  do {                                                                                                    \
    const int kq_ = (k0_);                                                                                \
    ra0 = ap[0] ? *(const uint4*)(ap[0] + kq_) : make_uint4(0u, 0u, 0u, 0u);                              \
    ra1 = ap[1] ? *(const uint4*)(ap[1] + kq_) : make_uint4(0u, 0u, 0u, 0u);                              \
    if (useBt) { rb0 = *(const uint4*)(bp[0] + kq_); rb1 = *(const uint4*)(bp[1] + kq_); }               \
    else {                                                                                                \
      rw0 = *(const f32x4*)(wp + (long)(kq_ + 0) * g.ldw); rw1 = *(const f32x4*)(wp + (long)(kq_ + 1) * g.ldw); \
      rw2 = *(const f32x4*)(wp + (long)(kq_ + 2) * g.ldw); rw3 = *(const f32x4*)(wp + (long)(kq_ + 3) * g.ldw); \
    }                                                                                                     \
  } while (0)
  GEMM_GLOAD(0);
  for (int k0 = 0; k0 < g.K; k0 += 32) {
    __syncthreads();
    *(uint4*)(sA + ar * LSTR + akc) = ra0; *(uint4*)(sA + (ar + 64) * LSTR + akc) = ra1;
    if (useBt) {
      *(uint4*)(sB + ar * LSTR + akc) = rb0; *(uint4*)(sB + (ar + 64) * LSTR + akc) = rb1;
    } else {
      const int nl = (tid & 31) * 4, kl = (tid >> 5) * 4;
#pragma unroll
      for (int c = 0; c < 4; ++c) {
        uint2 v; v.x = pk2(rw0[c], rw1[c]); v.y = pk2(rw2[c], rw3[c]);
        *(uint2*)(sB + (nl + c) * LSTR + kl) = v;
      }
    }
    __syncthreads();
    if (k0 + 32 < g.K) GEMM_GLOAD(k0 + 32);
    uint4 fa[4], fb[4];
#pragma unroll
    for (int m = 0; m < 4; ++m) fa[m] = *(const uint4*)(sA + (wr * 64 + m * 16 + fr) * LSTR + fq * 8);
#pragma unroll
    for (int n = 0; n < 4; ++n) fb[n] = *(const uint4*)(sB + (wc * 64 + n * 16 + fr) * LSTR + fq * 8);
#pragma unroll
    for (int m = 0; m < 4; ++m)
#pragma unroll
      for (int n = 0; n < 4; ++n) acc[m][n] = mfma16(fb[n], fa[m], acc[m][n]);
  }
  epi(acc, m0 + wr * 64 + fr, n0 + wc * 64 + fq * 4);
}

__device__ void phase_prep(const P& p) {
  const int gtid = blockIdx.x * NTHR + threadIdx.x, gsz = gridDim.x * NTHR;
  int* cnt = (int*)(p.ws + WS_CNT);
  if (gtid < 64) cnt[gtid] = 0;
  f32x2* rope = (f32x2*)(p.ws + WS_ROPE);
  for (int i = gtid; i < SEQ * 64; i += gsz) {
    const int pos = i >> 6, f = i & 63;
    const float inv = powf(10000.0f, -(float)(2 * f) / 128.0f);
    const float ang = (float)pos * inv;
    float s, c; sincosf(ang, &s, &c);
    rope[i] = (f32x2){c, s};
  }
}

__device__ void phase_rowpass(const P& p, const float* src, const u16* slots, float* dstx, const float* gain, int route_layer, float* fout) {
  const int lane = threadIdx.x & 63, gw = blockIdx.x * 4 + (threadIdx.x >> 6), nw = gridDim.x * 4;
  u16* xb = (u16*)(p.ws + WS_XB);
  int* cnt = (int*)(p.ws + WS_CNT);
  int* list = (int*)(p.ws + WS_LIST);
  float* gate = (float*)(p.ws + WS_GATE);
  for (int row = gw; row < T_TOK; row += nw) {
    f32x4 v[4];
    float ss = 0.f;
#pragma unroll
    for (int i = 0; i < 4; ++i) {
      const int k = (i * 64 + lane) * 4;
      v[i] = *(const f32x4*)(src + (size_t)row * DM + k);
      if (slots) {
#pragma unroll
        for (int s = 0; s < 2; ++s) {
          const uint2 w = *(const uint2*)(slots + ((size_t)row * 2 + s) * DM + k);
          v[i][0] += lo16(w.x); v[i][1] += hi16(w.x); v[i][2] += lo16(w.y); v[i][3] += hi16(w.y);
        }
      }
      if (dstx) *(f32x4*)(dstx + (size_t)row * DM + k) = v[i];
      ss += v[i][0] * v[i][0] + v[i][1] * v[i][1] + v[i][2] * v[i][2] + v[i][3] * v[i][3];
    }
    ss = wave_sum(ss);
    const float rstd = rsqrtf(ss * (1.0f / DM) + 1e-6f);
#pragma unroll
    for (int i = 0; i < 4; ++i) {
      const int k = (i * 64 + lane) * 4;
      const f32x4 gv = *(const f32x4*)(gain + k);
      v[i] = v[i] * rstd * gv;
      if (fout) *(f32x4*)(fout + (size_t)row * DM + k) = v[i];
      else { uint2 w; w.x = pk2(v[i][0], v[i][1]); w.y = pk2(v[i][2], v[i][3]); *(uint2*)(xb + (size_t)row * DM + k) = w; }
    }
    if (route_layer >= 0) {
      const float* wg = p.w_group + (size_t)route_layer * DM * 4;
      const float* we = p.w_er + (size_t)route_layer * 4 * DM * 8;
      float acc[36];
#pragma unroll
      for (int j = 0; j < 36; ++j) acc[j] = 0.f;
#pragma unroll
      for (int i = 0; i < 4; ++i) {
#pragma unroll
        for (int c = 0; c < 4; ++c) {
          const int k = (i * 64 + lane) * 4 + c;
          const float hv = v[i][c];
          const f32x4 g4 = *(const f32x4*)(wg + (size_t)k * 4);
#pragma unroll
          for (int j = 0; j < 4; ++j) acc[j] += hv * g4[j];
#pragma unroll
          for (int gg = 0; gg < 4; ++gg) {
            const f32x4 e0 = *(const f32x4*)(we + ((size_t)gg * DM + k) * 8);
            const f32x4 e1 = *(const f32x4*)(we + ((size_t)gg * DM + k) * 8 + 4);
#pragma unroll
            for (int j = 0; j < 4; ++j) { acc[4 + gg * 8 + j] += hv * e0[j]; acc[4 + gg * 8 + 4 + j] += hv * e1[j]; }
          }
        }
      }
#pragma unroll
      for (int j = 0; j < 36; ++j) acc[j] = wave_sum(acc[j]);
      if (lane == 0) {
        const float* bg = p.b_group + route_layer * 4;
        const float* be = p.b_er + route_layer * 32;
        float gl[4];
#pragma unroll
        for (int j = 0; j < 4; ++j) gl[j] = acc[j] + bg[j];
        int gs = 0; float gm = gl[0];
#pragma unroll
        for (int j = 1; j < 4; ++j) if (gl[j] > gm) { gm = gl[j]; gs = j; }
        float den = 0.f;
#pragma unroll
        for (int j = 0; j < 4; ++j) den += expf(gl[j] - gm);
        const float pg = 1.0f / den;
        float el[8];
#pragma unroll
        for (int j = 0; j < 8; ++j) {
          float a = acc[4 + j];
#pragma unroll
          for (int gg = 1; gg < 4; ++gg) a = (gs == gg) ? acc[4 + gg * 8 + j] : a;
          el[j] = a + be[gs * 8 + j];
        }
        int i1 = 0; float v1 = el[0];
#pragma unroll
        for (int j = 1; j < 8; ++j) if (el[j] > v1) { v1 = el[j]; i1 = j; }
        int i2 = -1; float v2 = -3.0e38f;
#pragma unroll
        for (int j = 0; j < 8; ++j) if (j != i1 && el[j] > v2) { v2 = el[j]; i2 = j; }
        const float e2 = expf(v2 - v1);
        const float g1 = pg / (1.0f + e2), g2 = pg * e2 / (1.0f + e2);
        const int ex1 = gs * 8 + i1, ex2 = gs * 8 + i2;
        const int r1 = atomicAdd(&cnt[route_layer * 32 + ex1], 1);
        list[(size_t)ex1 * CAP + r1] = row * 2;
        gate[row * 2] = g1;
        const int r2 = atomicAdd(&cnt[route_layer * 32 + ex2], 1);
        list[(size_t)ex2 * CAP + r2] = row * 2 + 1;
        gate[row * 2 + 1] = g2;
      }
    }
  }
}

__device__ void phase_inproj(const P& p, char* smem) {
  GemmDesc g{}; g.A = (const u16*)(p.ws + WS_XB); g.lda = DM; g.mvalid = T_TOK; g.W = p.w_in; g.ldw = 2560; g.K = DM;
  u16* zb = (u16*)(p.ws + WS_Z); u16* a2 = (u16*)(p.ws + WS_A2);
  const int ntiles = 128 * 20;
  for (int t = blockIdx.x; t < ntiles; t += gridDim.x) {
    const int mt = t / 20, nt = t % 20;
    gemm_tile(g, mt * 128, nt * 128, [&](f32x4 (&acc)[4][4], int row0, int col0) {
      const int seg = (nt * 128) / 512;
#pragma unroll
      for (int m = 0; m < 4; ++m)
#pragma unroll
        for (int n = 0; n < 4; ++n) {
          const int row = row0 + m * 16, col = col0 + n * 16;
          uint2 w; w.x = pk2(acc[m][n][0], acc[m][n][1]); w.y = pk2(acc[m][n][2], acc[m][n][3]);
          if (seg < 4) *(uint2*)(zb + (size_t)seg * T_TOK * 512 + (size_t)row * 512 + (col - seg * 512)) = w;
          else { const int ch = col - 2048, gi = ch >> 4, c = ch & 15; *(uint2*)(a2 + ((size_t)gi * 512 + (row >> 5)) * 768 + (row & 31) * 16 + c) = w; }
        }
    }, smem);
  }
}

constexpr int RSTR = 136;
__device__ __forceinline__ void ret_load_tile(u16* dst, const u16* src, int t0, int h, int mode  , const f32x2* rope) {
  const int pos0 = t0 & (SEQ - 1);
  for (int idx = threadIdx.x; idx < 128 * 64; idx += NTHR) {
    const int i = idx >> 6, d = idx & 63;
    float t1 = h2f(src[(size_t)(t0 + i) * 512 + h * 128 + d]), t2 = h2f(src[(size_t)(t0 + i) * 512 + h * 128 + d + 64]);
    if (mode) {
      const f32x2 cs = rope[(pos0 + i) * 64 + d];
      const float o1 = t1 * cs[0] - t2 * cs[1], o2 = t1 * cs[1] + t2 * cs[0];
      t1 = o1; t2 = o2;
      if (mode == 2) { t1 *= 0.08838834764831845f; t2 *= 0.08838834764831845f; }
    }
    dst[i * RSTR + d] = f2h(t1); dst[i * RSTR + d + 64] = f2h(t2);
  }
}
__device__ __forceinline__ float log_sigmoid(float x) { return -log1pf(expf(-x)); }

__device__ void phase_ret_inc(const P& p, char* smem) {
  u16* sK = (u16*)smem; u16* sV = sK + 128 * RSTR; float* sWf = (float*)(sV + 128 * RSTR); float* sWb = sWf + 128;
  const u16* kb = (const u16*)(p.ws + WS_Z) + (size_t)1 * T_TOK * 512; const u16* vb = (const u16*)(p.ws + WS_Z) + (size_t)2 * T_TOK * 512;
  const f32x2* rope = (const f32x2*)(p.ws + WS_ROPE);
  float* incf = (float*)(p.ws + WS_INC); float* incb = incf + (size_t)512 * 16384;
  const int tid = threadIdx.x;
  for (int item = blockIdx.x; item < 512; item += gridDim.x) {
    const int h = item & 3, bn = item >> 2, t0 = bn * 128;
    const float lgf = log_sigmoid(p.ret_decay[h]), lgb = log_sigmoid(p.ret_decay[4 + h]);
    __syncthreads();
    ret_load_tile(sK, kb, t0, h, 2, rope);
    ret_load_tile(sV, vb, t0, h, 0, rope);
    if (tid < 128) { sWf[tid] = expf(lgf * (float)(127 - tid)); sWb[tid] = expf(lgb * (float)tid); }
    __syncthreads();
    const int d0 = (tid >> 4) * 8, e0 = (tid & 15) * 8;
    float af[8][8], ab[8][8];
#pragma unroll
    for (int a = 0; a < 8; ++a)
#pragma unroll
      for (int b = 0; b < 8; ++b) { af[a][b] = 0.f; ab[a][b] = 0.f; }
    for (int j = 0; j < 128; ++j) {
      const uint4 kq = *(const uint4*)(sK + j * RSTR + d0), vq = *(const uint4*)(sV + j * RSTR + e0);
      const float kd[8] = {lo16(kq.x), hi16(kq.x), lo16(kq.y), hi16(kq.y), lo16(kq.z), hi16(kq.z), lo16(kq.w), hi16(kq.w)};
      const float ve[8] = {lo16(vq.x), hi16(vq.x), lo16(vq.y), hi16(vq.y), lo16(vq.z), hi16(vq.z), lo16(vq.w), hi16(vq.w)};
      const float wf = sWf[j], wb = sWb[j];
#pragma unroll
      for (int a = 0; a < 8; ++a) {
        const float kf = kd[a] * wf, kbw = kd[a] * wb;
#pragma unroll
        for (int b = 0; b < 8; ++b) { af[a][b] += kf * ve[b]; ab[a][b] += kbw * ve[b]; }
      }
    }
#pragma unroll
    for (int a = 0; a < 8; ++a) {
      float* of = incf + (size_t)item * 16384 + (d0 + a) * 128 + e0;
      float* ob = incb + (size_t)item * 16384 + (d0 + a) * 128 + e0;
      *(f32x4*)of = (f32x4){af[a][0], af[a][1], af[a][2], af[a][3]}; *(f32x4*)(of + 4) = (f32x4){af[a][4], af[a][5], af[a][6], af[a][7]};
      *(f32x4*)ob = (f32x4){ab[a][0], ab[a][1], ab[a][2], ab[a][3]}; *(f32x4*)(ob + 4) = (f32x4){ab[a][4], ab[a][5], ab[a][6], ab[a][7]};
    }
  }
}

__device__ void phase_ret_scan(const P& p) {
  float* incf = (float*)(p.ws + WS_INC); float* incb = incf + (size_t)512 * 16384;
  const int gtid = blockIdx.x * NTHR + threadIdx.x, gsz = gridDim.x * NTHR;
  for (int idx = gtid; idx < 32 * 16384; idx += gsz) {
    const int de = idx & 16383, bh = idx >> 14, b = bh >> 2, h = bh & 3;
    const float Gf = expf(128.0f * log_sigmoid(p.ret_decay[h])), Gb = expf(128.0f * log_sigmoid(p.ret_decay[4 + h]));
    float s = 0.f;
    for (int n = 0; n < 16; ++n) { float* q = incf + ((size_t)((b * 16 + n) * 4 + h)) * 16384 + de; const float t = *q; *q = s; s = s * Gf + t; }
    s = 0.f;
    for (int n = 15; n >= 0; --n) { float* q = incb + ((size_t)((b * 16 + n) * 4 + h)) * 16384 + de; const float t = *q; *q = s; s = s * Gb + t; }
  }
}

__device__ void phase_ret_out(const P& p, char* smem) {
  u16* sQ = (u16*)smem; u16* sK = sQ + 128 * RSTR; u16* sV = sK + 128 * RSTR; u16* sS = sV + 128 * RSTR;
  float* sPf = (float*)(sS + 128 * RSTR); float* sPb = sPf + 132;
  const u16* zb = (const u16*)(p.ws + WS_Z);
  const u16* qb = zb; const u16* kb = zb + (size_t)1 * T_TOK * 512; const u16* vb = zb + (size_t)2 * T_TOK * 512; const u16* gb = zb + (size_t)3 * T_TOK * 512;
  const f32x2* rope = (const f32x2*)(p.ws + WS_ROPE);
  const float* incf = (const float*)(p.ws + WS_INC); const float* incb = incf + (size_t)512 * 16384;
  u16* ycat = (u16*)(p.ws + WS_YCAT);
  const int tid = threadIdx.x;
  for (int item = blockIdx.x; item < 512; item += gridDim.x) {
    const int h = item & 3, bn = item >> 2, t0 = bn * 128;
    const float lgf = log_sigmoid(p.ret_decay[h]), lgb = log_sigmoid(p.ret_decay[4 + h]);
    __syncthreads();
    ret_load_tile(sQ, qb, t0, h, 1, rope);
    ret_load_tile(sK, kb, t0, h, 2, rope);
    ret_load_tile(sV, vb, t0, h, 0, rope);
    if (tid < 129) { sPf[tid] = expf(lgf * (float)tid); sPb[tid] = expf(lgb * (float)tid); }
    __syncthreads();
    const int i0 = (tid >> 4) * 8, j0 = (tid & 15) * 8;
    {
      float s[8][8];
#pragma unroll
      for (int a = 0; a < 8; ++a)
#pragma unroll
        for (int b = 0; b < 8; ++b) s[a][b] = 0.f;
      for (int d = 0; d < 128; d += 8) {
        float kk[8][8];
#pragma unroll
        for (int b = 0; b < 8; ++b) {
          const uint4 kq = *(const uint4*)(sK + (j0 + b) * RSTR + d);
          kk[b][0] = lo16(kq.x); kk[b][1] = hi16(kq.x); kk[b][2] = lo16(kq.y); kk[b][3] = hi16(kq.y); kk[b][4] = lo16(kq.z); kk[b][5] = hi16(kq.z); kk[b][6] = lo16(kq.w); kk[b][7] = hi16(kq.w);
        }
#pragma unroll
        for (int a = 0; a < 8; ++a) {
          const uint4 qq = *(const uint4*)(sQ + (i0 + a) * RSTR + d);
          const float qv[8] = {lo16(qq.x), hi16(qq.x), lo16(qq.y), hi16(qq.y), lo16(qq.z), hi16(qq.z), lo16(qq.w), hi16(qq.w)};
#pragma unroll
          for (int b = 0; b < 8; ++b)
#pragma unroll
            for (int c = 0; c < 8; ++c) s[a][b] += qv[c] * kk[b][c];
        }
      }
#pragma unroll
      for (int a = 0; a < 8; ++a) {
        unsigned w[4];
#pragma unroll
        for (int b = 0; b < 8; b += 2) {
          const int i = i0 + a, j = j0 + b;
          const float m0 = (i >= j) ? sPf[i - j] : sPb[j - i];
          const float m1 = (i >= j + 1) ? sPf[i - j - 1] : sPb[j + 1 - i];
          w[b >> 1] = pk2(s[a][b] * m0, s[a][b + 1] * m1);
        }
        *(uint4*)(sS + (i0 + a) * RSTR + j0) = make_uint4(w[0], w[1], w[2], w[3]);
      }
    }
    __syncthreads();
    {
      const int e0 = j0;
      float o[8][8];
#pragma unroll
      for (int a = 0; a < 8; ++a)
#pragma unroll
        for (int b = 0; b < 8; ++b) o[a][b] = 0.f;
      for (int j = 0; j < 128; j += 8) {
        float vv[8][8];
#pragma unroll
        for (int c = 0; c < 8; ++c) {
          const uint4 vq = *(const uint4*)(sV + (j + c) * RSTR + e0);
          vv[c][0] = lo16(vq.x); vv[c][1] = hi16(vq.x); vv[c][2] = lo16(vq.y); vv[c][3] = hi16(vq.y); vv[c][4] = lo16(vq.z); vv[c][5] = hi16(vq.z); vv[c][6] = lo16(vq.w); vv[c][7] = hi16(vq.w);
        }
#pragma unroll
        for (int a = 0; a < 8; ++a) {
          const uint4 sq = *(const uint4*)(sS + (i0 + a) * RSTR + j);
          const float sv[8] = {lo16(sq.x), hi16(sq.x), lo16(sq.y), hi16(sq.y), lo16(sq.z), hi16(sq.z), lo16(sq.w), hi16(sq.w)};
#pragma unroll
          for (int c = 0; c < 8; ++c)
#pragma unroll
            for (int b = 0; b < 8; ++b) o[a][b] += sv[c] * vv[c][b];
        }
      }
      const float* sp = incf + (size_t)item * 16384 + e0;
      const float* sn = incb + (size_t)item * 16384 + e0;
      float pf[8], pb[8];
#pragma unroll
      for (int a = 0; a < 8; ++a) { pf[a] = sPf[i0 + a + 1]; pb[a] = sPb[128 - (i0 + a)]; }
      for (int d = 0; d < 128; ++d) {
        const f32x4 p0 = *(const f32x4*)(sp + d * 128), p1 = *(const f32x4*)(sp + d * 128 + 4);
        const f32x4 n0 = *(const f32x4*)(sn + d * 128), n1 = *(const f32x4*)(sn + d * 128 + 4);
        const float spv[8] = {p0[0], p0[1], p0[2], p0[3], p1[0], p1[1], p1[2], p1[3]};
        const float snv[8] = {n0[0], n0[1], n0[2], n0[3], n1[0], n1[1], n1[2], n1[3]};
#pragma unroll
        for (int a = 0; a < 8; ++a) {
          const float qv = h2f(sQ[(i0 + a) * RSTR + d]);
          const float qf = qv * pf[a], qbk = qv * pb[a];
#pragma unroll
          for (int b = 0; b < 8; ++b) o[a][b] += qf * spv[b] + qbk * snv[b];
        }
      }
#pragma unroll
      for (int a = 0; a < 8; ++a) {
        float s1 = 0.f;
#pragma unroll
        for (int b = 0; b < 8; ++b) s1 += o[a][b];
        s1 += __shfl_xor(s1, 1); s1 += __shfl_xor(s1, 2); s1 += __shfl_xor(s1, 4); s1 += __shfl_xor(s1, 8);
        const float mu = s1 * (1.0f / 128.0f);
        float s2 = 0.f;
#pragma unroll
        for (int b = 0; b < 8; ++b) { const float dlt = o[a][b] - mu; s2 += dlt * dlt; }
        s2 += __shfl_xor(s2, 1); s2 += __shfl_xor(s2, 2); s2 += __shfl_xor(s2, 4); s2 += __shfl_xor(s2, 8);
        const float rs = rsqrtf(s2 * (1.0f / 128.0f) + 1e-5f);
        const size_t tok = (size_t)(t0 + i0 + a);
        const uint4 gq = *(const uint4*)(gb + tok * 512 + h * 128 + e0);
        const float gv[8] = {lo16(gq.x), hi16(gq.x), lo16(gq.y), hi16(gq.y), lo16(gq.z), hi16(gq.z), lo16(gq.w), hi16(gq.w)};
        unsigned w[4];
#pragma unroll
        for (int b = 0; b < 8; b += 2) {
          const float y0 = gv[b] * sigmoidf_(gv[b]) * (o[a][b] - mu) * rs;
          const float y1 = gv[b + 1] * sigmoidf_(gv[b + 1]) * (o[a][b + 1] - mu) * rs;
          w[b >> 1] = pk2(y0, y1);
        }
        *(uint4*)(ycat + tok * DM + h * 128 + e0) = make_uint4(w[0], w[1], w[2], w[3]);
      }
    }
  }
}

__device__ void phase_s5_naive(const P& p, char* smem) {
  float* ylds = (float*)smem;
  float* xs = ylds + 2048 * 16;
  const u16* a2 = (const u16*)(p.ws + WS_A2);
  u16* ygelu = (u16*)(p.ws + WS_YGELU);
  const int lane = threadIdx.x & 63;
  if (threadIdx.x < 64) {
    for (int item = blockIdx.x; item < 256; item += gridDim.x) {
      const int b = item >> 5, g = item & 31;
      const int pidx = lane;
      const int cidx = lane & 15, quart = lane >> 4;
      for (int dir = 0; dir < 2; ++dir) {
        const float dt = expf(p.log_step[dir * 32 + g]);
        const float ar = p.a_re[(dir * 32 + g) * 64 + pidx], ai = p.a_im[(dir * 32 + g) * 64 + pidx];
        const float mag = expf(ar * dt);
        float sn, cs; sincosf(ai * dt, &sn, &cs);
        const float lre = mag * cs, lim = mag * sn;
        const float nr = lre - 1.0f, ni = lim, den = ar * ar + ai * ai;
        const float cre = (nr * ar + ni * ai) / den, cim = (ni * ar - nr * ai) / den;
        float bbr[16], bbi[16];
#pragma unroll
        for (int c = 0; c < 16; ++c) {
          const float br = p.b_re[(g * 64 + pidx) * 16 + c], bi = p.b_im[(g * 64 + pidx) * 16 + c];
          bbr[c] = cre * br - cim * bi; bbi[c] = cre * bi + cim * br;
        }
        float ccr[16], cci[16];
#pragma unroll
        for (int q = 0; q < 16; ++q) {
          ccr[q] = p.c_re[((dir * 32 + g) * 16 + cidx) * 64 + quart * 16 + q];
          cci[q] = p.c_im[((dir * 32 + g) * 16 + cidx) * 64 + quart * 16 + q];
        }
        const float dsk = p.s5d[g * 16 + cidx];
        float xr = 0.f, xi = 0.f;
        for (int step = 0; step < SEQ; ++step) {
          const int n = dir ? (SEQ - 1 - step) : step;
          const int t = b * SEQ + n;
          const u16* up = a2 + ((size_t)g * 512 + (t >> 5)) * 768 + (t & 31) * 16;
          const uint4 u0 = *(const uint4*)up, u1 = *(const uint4*)(up + 8);
          const float uv[16] = {lo16(u0.x), hi16(u0.x), lo16(u0.y), hi16(u0.y), lo16(u0.z), hi16(u0.z), lo16(u0.w), hi16(u0.w),
                                lo16(u1.x), hi16(u1.x), lo16(u1.y), hi16(u1.y), lo16(u1.z), hi16(u1.z), lo16(u1.w), hi16(u1.w)};
          float bur = 0.f, bui = 0.f;
#pragma unroll
          for (int c = 0; c < 16; ++c) { bur += bbr[c] * uv[c]; bui += bbi[c] * uv[c]; }
          const float nxr = lre * xr - lim * xi + bur, nxi = lre * xi + lim * xr + bui;
          xr = nxr; xi = nxi;
          asm volatile("s_waitcnt lgkmcnt(0)" ::: "memory");
          xs[lane] = xr; xs[64 + lane] = xi;
          asm volatile("s_waitcnt lgkmcnt(0)" ::: "memory");
          float part = 0.f;
#pragma unroll
          for (int q = 0; q < 16; ++q) part += ccr[q] * xs[quart * 16 + q] - cci[q] * xs[64 + quart * 16 + q];
          asm volatile("s_waitcnt lgkmcnt(0)" ::: "memory");
          part += __shfl_xor(part, 16); part += __shfl_xor(part, 32);
          if (lane < 16) {
            if (dir == 0) ylds[n * 16 + cidx] = dsk * h2f(up[cidx]) + part;
            else ygelu[(size_t)t * 512 + g * 16 + cidx] = f2h(gelu_tanh(ylds[n * 16 + cidx] + part));
          }
        }
      }
    }
  }
}

struct Cpx { float re, im; };
__device__ __forceinline__ Cpx cmul(Cpx a, Cpx b) { return {a.re * b.re - a.im * b.im, a.re * b.im + a.im * b.re}; }
__device__ __forceinline__ Cpx s5_lam_pow(float ar, float ai, float dt, float e) {
  const float mag = expf(ar * dt * e); float sn, cs; sincosf(ai * dt * e, &sn, &cs); return {mag * cs, mag * sn};
}
__device__ __forceinline__ Cpx s5_coef(float ar, float ai, float dt) {
  float sn, cs; sincosf(ai * dt, &sn, &cs);
  const float em1 = expm1f(ar * dt), sh = sinf(0.5f * ai * dt);
  const float nr = em1 * cs - 2.0f * sh * sh, ni = (em1 + 1.0f) * sn, den = ar * ar + ai * ai;
  return {(nr * ar + ni * ai) / den, (ni * ar - nr * ai) / den};
}
__device__ void phase_s5_ktab(const P& p) {
  float* ktab = (float*)(p.ws + WS_KTAB);
  const int gtid = blockIdx.x * NTHR + threadIdx.x, gsz = gridDim.x * NTHR;
  for (int item = gtid; item < 32 * 2 * 32 * 16; item += gsz) {
    const int c = item & 15, l = (item >> 4) & 31, dir = (item >> 9) & 1, g = item >> 10;
    const float dt = expf(p.log_step[dir * 32 + g]);
    float acc[16];
#pragma unroll
    for (int j = 0; j < 16; ++j) acc[j] = 0.f;
    for (int q = 0; q < 64; ++q) {
      const float ar = p.a_re[(dir * 32 + g) * 64 + q], ai = p.a_im[(dir * 32 + g) * 64 + q];
      const Cpx L = s5_lam_pow(ar, ai, dt, (float)l), cf = s5_coef(ar, ai, dt);
      const Cpx C = {p.c_re[((dir * 32 + g) * 16 + c) * 64 + q], p.c_im[((dir * 32 + g) * 16 + c) * 64 + q]};
      const Cpx w = cmul(cmul(C, L), cf);
#pragma unroll
      for (int j = 0; j < 16; ++j) acc[j] += w.re * p.b_re[(g * 64 + q) * 16 + j] - w.im * p.b_im[(g * 64 + q) * 16 + j];
    }
#pragma unroll
    for (int j = 0; j < 16; j += 4) *(f32x4*)(ktab + (size_t)item * 16 + j) = (f32x4){acc[j], acc[j + 1], acc[j + 2], acc[j + 3]};
  }
}
__device__ void phase_s5_fill(const P& p) {
  const float* ktab = (const float*)(p.ws + WS_KTAB);
  u16* bty = (u16*)(p.ws + WS_BTY); u16* wet = (u16*)(p.ws + WS_WET);
  const int gtid = blockIdx.x * NTHR + threadIdx.x, gsz = gridDim.x * NTHR;
  for (int item = gtid; item < 32 * 512 * 64; item += gsz) {
    const int ch = item & 63, n = (item >> 6) & 511, g = item >> 15;
    const int ip = ch >> 1, c0 = (ch & 1) * 8, i = n >> 4, c = n & 15;
    float v[8];
    if (ip != i) {
      const int dir = ip < i ? 0 : 1, l = ip < i ? i - ip : ip - i;
      const float* src = ktab + ((size_t)((g * 2 + dir) * 32 + l) * 16 + c) * 16 + c0;
      const f32x4 a = *(const f32x4*)src, b = *(const f32x4*)(src + 4);
      v[0] = a[0]; v[1] = a[1]; v[2] = a[2]; v[3] = a[3]; v[4] = b[0]; v[5] = b[1]; v[6] = b[2]; v[7] = b[3];
    } else {
      const float* s0 = ktab + ((size_t)((g * 2 + 0) * 32) * 16 + c) * 16 + c0;
      const float* s1 = ktab + ((size_t)((g * 2 + 1) * 32) * 16 + c) * 16 + c0;
      const float dd = p.s5d[g * 16 + c];
#pragma unroll
      for (int j = 0; j < 8; ++j) v[j] = s0[j] + s1[j] + ((c0 + j) == c ? dd : 0.f);
    }
    *(uint4*)(bty + ((size_t)g * 512 + n) * 768 + ch * 8) = make_uint4(pk2(v[0], v[1]), pk2(v[2], v[3]), pk2(v[4], v[5]), pk2(v[6], v[7]));
  }
  for (int item = gtid; item < 32 * 512 * 32; item += gsz) {
    const int ch = item & 31, n = (item >> 5) & 511, g = item >> 14;
    const int kk = ch * 8, dir = kk >> 7, p0 = (kk & 127) >> 1, i = n >> 4, c = n & 15;
    const float dt = expf(p.log_step[dir * 32 + g]), e = dir ? (float)(32 - i) : (float)(i + 1);
    float v[8];
#pragma unroll
    for (int q = 0; q < 4; ++q) {
      const int pq = p0 + q;
      const float ar = p.a_re[(dir * 32 + g) * 64 + pq], ai = p.a_im[(dir * 32 + g) * 64 + pq];
      const Cpx L = s5_lam_pow(ar, ai, dt, e);
      const Cpx C = {p.c_re[((dir * 32 + g) * 16 + c) * 64 + pq], p.c_im[((dir * 32 + g) * 16 + c) * 64 + pq]};
      const Cpx w = cmul(C, L);
      v[2 * q] = w.re; v[2 * q + 1] = -w.im;
    }
    *(uint4*)(bty + ((size_t)g * 512 + n) * 768 + 512 + kk) = make_uint4(pk2(v[0], v[1]), pk2(v[2], v[3]), pk2(v[4], v[5]), pk2(v[6], v[7]));
  }
  for (int item = gtid; item < 32 * 256 * 64; item += gsz) {
    const int ch = item & 63, n = (item >> 6) & 255, g = item >> 14;
    const int ip = ch >> 1, c0 = (ch & 1) * 8, ri = n & 1, pq = (n >> 1) & 63, dir = n >> 7;
    const float dt = expf(p.log_step[dir * 32 + g]), e = dir ? (float)ip : (float)(31 - ip);
    const float ar = p.a_re[(dir * 32 + g) * 64 + pq], ai = p.a_im[(dir * 32 + g) * 64 + pq];
    const Cpx w = cmul(s5_lam_pow(ar, ai, dt, e), s5_coef(ar, ai, dt));
    float v[8];
#pragma unroll
    for (int j = 0; j < 8; ++j) {
      const float br = p.b_re[(g * 64 + pq) * 16 + c0 + j], bi = p.b_im[(g * 64 + pq) * 16 + c0 + j];
      v[j] = ri ? (w.re * bi + w.im * br) : (w.re * br - w.im * bi);
    }
    *(uint4*)(wet + ((size_t)g * 256 + n) * 512 + ch * 8) = make_uint4(pk2(v[0], v[1]), pk2(v[2], v[3]), pk2(v[4], v[5]), pk2(v[6], v[7]));
  }
}
__device__ void phase_s5_egemm(const P& p, char* smem) {
  float* E = (float*)(p.ws + WS_E);
  for (int t = blockIdx.x; t < 32 * 8; t += gridDim.x) {
    const int g = t >> 3, mt = (t >> 1) & 3, nt = t & 1;
    GemmDesc d{}; d.A = (const u16*)(p.ws + WS_A2) + (size_t)g * 512 * 768; d.lda = 768; d.mvalid = 512;
    d.Bt = (const u16*)(p.ws + WS_WET) + (size_t)g * 256 * 512; d.ldb = 512; d.K = 512;
    gemm_tile(d, mt * 128, nt * 128, [&](f32x4 (&acc)[4][4], int row0, int col0) {
#pragma unroll
      for (int m = 0; m < 4; ++m)
#pragma unroll
        for (int n = 0; n < 4; ++n) *(f32x4*)(E + ((size_t)g * 512 + row0 + m * 16) * 256 + col0 + n * 16) = acc[m][n];
    }, smem);
  }
}
__device__ void phase_s5_carry(const P& p) {
  const float* E = (const float*)(p.ws + WS_E);
  u16* a2 = (u16*)(p.ws + WS_A2);
  const int gtid = blockIdx.x * NTHR + threadIdx.x, gsz = gridDim.x * NTHR;
  for (int idx = gtid; idx < 32 * 8 * 128; idx += gsz) {
    const int pq = idx & 63, dir = (idx >> 6) & 1, b = (idx >> 7) & 7, g = idx >> 10;
    const float dt = expf(p.log_step[dir * 32 + g]);
    const Cpx L = s5_lam_pow(p.a_re[(dir * 32 + g) * 64 + pq], p.a_im[(dir * 32 + g) * 64 + pq], dt, 32.0f);
    Cpx s = {0.f, 0.f};
    for (int jj = 0; jj < 64; ++jj) {
      const int j = dir ? 63 - jj : jj, r = b * 64 + j;
      const f32x2 e = *(const f32x2*)(E + ((size_t)g * 512 + r) * 256 + (dir * 64 + pq) * 2);
      *(unsigned*)(a2 + ((size_t)g * 512 + r) * 768 + 512 + (dir * 64 + pq) * 2) = pk2(s.re, s.im);
      const Cpx ns = cmul(L, s);
      s.re = ns.re + e[0]; s.im = ns.im + e[1];
    }
  }
}
__device__ void phase_s5_ygemm(const P& p, char* smem) {
  u16* ygelu = (u16*)(p.ws + WS_YGELU);
  for (int t = blockIdx.x; t < 32 * 16; t += gridDim.x) {
    const int g = t >> 4, mt = (t >> 2) & 3, nt = t & 3;
    GemmDesc d{}; d.A = (const u16*)(p.ws + WS_A2) + (size_t)g * 512 * 768; d.lda = 768; d.mvalid = 512;
    d.Bt = (const u16*)(p.ws + WS_BTY) + (size_t)g * 512 * 768; d.ldb = 768; d.K = 768;
    gemm_tile(d, mt * 128, nt * 128, [&](f32x4 (&acc)[4][4], int row0, int col0) {
#pragma unroll
      for (int m = 0; m < 4; ++m)
#pragma unroll
        for (int n = 0; n < 4; ++n) {
          const int row = row0 + m * 16, col = col0 + n * 16;
          uint2 w; w.x = pk2(gelu_tanh(acc[m][n][0]), gelu_tanh(acc[m][n][1])); w.y = pk2(gelu_tanh(acc[m][n][2]), gelu_tanh(acc[m][n][3]));
          *(uint2*)(ygelu + ((size_t)row * 32 + (col >> 4)) * 512 + g * 16 + (col & 15)) = w;
        }
    }, smem);
  }
}

__device__ void phase_glu(const P& p, char* smem) {
  const u16* yg = (const u16*)(p.ws + WS_YGELU); u16* ycat = (u16*)(p.ws + WS_YCAT);
  GemmDesc g{}; g.A = yg; g.lda = 512; g.mvalid = T_TOK; g.W = p.w_glu; g.ldw = 512; g.K = 512;
  for (int t = blockIdx.x; t < 128 * 4; t += gridDim.x) {
    const int mt = t >> 2, nt = t & 3;
    gemm_tile(g, mt * 128, nt * 128, [&](f32x4 (&acc)[4][4], int row0, int col0) {
#pragma unroll
      for (int m = 0; m < 4; ++m)
#pragma unroll
        for (int n = 0; n < 4; ++n) {
          const int row = row0 + m * 16, col = col0 + n * 16;
          const uint2 yv = *(const uint2*)(yg + (size_t)row * 512 + col);
          const f32x4 bb = *(const f32x4*)(p.b_glu + col);
          const float y0 = lo16(yv.x) * sigmoidf_(acc[m][n][0] + bb[0]), y1 = hi16(yv.x) * sigmoidf_(acc[m][n][1] + bb[1]);
          const float y2 = lo16(yv.y) * sigmoidf_(acc[m][n][2] + bb[2]), y3 = hi16(yv.y) * sigmoidf_(acc[m][n][3] + bb[3]);
          uint2 w; w.x = pk2(y0, y1); w.y = pk2(y2, y3);
          *(uint2*)(ycat + (size_t)row * DM + 512 + col) = w;
        }
    }, smem);
  }
}

__device__ void phase_outproj(const P& p, const u16* A, const float* W, const float* xin, float* xout, char* smem) {
  GemmDesc g{}; g.A = A; g.lda = DM; g.mvalid = T_TOK; g.W = W; g.ldw = DM; g.K = DM;
  for (int t = blockIdx.x; t < 128 * 8; t += gridDim.x) {
    const int mt = t >> 3, nt = t & 7;
    gemm_tile(g, mt * 128, nt * 128, [&](f32x4 (&acc)[4][4], int row0, int col0) {
#pragma unroll
      for (int m = 0; m < 4; ++m)
#pragma unroll
        for (int n = 0; n < 4; ++n) {
          const size_t o = (size_t)(row0 + m * 16) * DM + col0 + n * 16;
          const f32x4 xv = *(const f32x4*)(xin + o);
          *(f32x4*)(xout + o) = xv + acc[m][n];
        }
    }, smem);
  }
}

__device__ void phase_qkv(const P& p, char* smem) {
  GemmDesc g{}; g.A = (const u16*)(p.ws + WS_XB); g.lda = DM; g.mvalid = T_TOK; g.W = p.w_qkv; g.ldw = 1536; g.K = DM;
  u16* q1 = (u16*)(p.ws + WS_Z); u16* k1 = (u16*)(p.ws + WS_Z + 32 * MB); u16* v1 = (u16*)(p.ws + WS_Z + 40 * MB);
  for (int t = blockIdx.x; t < 128 * 12; t += gridDim.x) {
    const int mt = t / 12, nt = t % 12;
    gemm_tile(g, mt * 128, nt * 128, [&](f32x4 (&acc)[4][4], int row0, int col0) {
#pragma unroll
      for (int m = 0; m < 4; ++m)
#pragma unroll
        for (int n = 0; n < 4; ++n) {
          const int row = row0 + m * 16, col = col0 + n * 16;
          uint2 w;
          if (nt < 8) { w.x = pk2(acc[m][n][0] * 0.125f, acc[m][n][1] * 0.125f); w.y = pk2(acc[m][n][2] * 0.125f, acc[m][n][3] * 0.125f); *(uint2*)(q1 + (size_t)row * DM + col) = w; }
          else {
            w.x = pk2(acc[m][n][0], acc[m][n][1]); w.y = pk2(acc[m][n][2], acc[m][n][3]);
            if (nt < 10) *(uint2*)(k1 + (size_t)row * 256 + (col - 1024)) = w; else *(uint2*)(v1 + (size_t)row * 256 + (col - 1280)) = w;
          }
        }
    }, smem);
  }
}

struct MoeTile { int e, rt, ct, cnt, hbase; };
__device__ __forceinline__ bool moe_decode(const int* cnt, int t, MoeTile& mt) {
  int base = 0, hb = 0;
  for (int e = 0; e < 32; ++e) {
    const int c = cnt[e], nt = (c + 127) >> 7, span = nt * 8;
    if (t < base + span) { const int loc = t - base; mt.e = e; mt.rt = loc % nt; mt.ct = loc / nt; mt.cnt = c; mt.hbase = hb; return true; }
    base += span; hb += nt * 128;
  }
  return false;
}
__device__ void phase_moe1(const P& p, int layer, char* smem) {
  const int* cnt = (const int*)(p.ws + WS_CNT) + layer * 32;
  const int* list = (const int*)(p.ws + WS_LIST);
  u16* hbuf = (u16*)(p.ws + WS_H);
  for (int t = blockIdx.x;; t += gridDim.x) {
    MoeTile mt; if (!moe_decode(cnt, t, mt)) break;
    GemmDesc g{}; g.A = (const u16*)(p.ws + WS_XB); g.lda = DM; g.rowmap = list + (size_t)mt.e * CAP; g.rowshift = 1; g.mvalid = mt.cnt;
    g.W = p.w_gate + (size_t)(layer * 32 + mt.e) * DM * 512; g.W2 = p.w_up + (size_t)(layer * 32 + mt.e) * DM * 512; g.ldw = 512; g.K = DM;
    gemm_tile(g, mt.rt * 128, mt.ct * 128, [&](f32x4 (&acc)[4][4], int row0, int col0) {
      const int ocol0 = (col0 >> 6) * 32 + (col0 & 31);
#pragma unroll
      for (int m = 0; m < 4; ++m) {
        const int row = row0 + m * 16;
        if (row < mt.cnt) {
#pragma unroll
          for (int nn = 0; nn < 2; ++nn) {
            float hv[4];
#pragma unroll
            for (int r = 0; r < 4; ++r) { const float gt = acc[m][nn][r]; hv[r] = gt * sigmoidf_(gt) * acc[m][nn + 2][r]; }
            uint2 w; w.x = pk2(hv[0], hv[1]); w.y = pk2(hv[2], hv[3]);
            *(uint2*)(hbuf + (size_t)(mt.hbase + row) * 512 + ocol0 + nn * 16) = w;
          }
        }
      }
    }, smem);
  }
}
__device__ void phase_moe2(const P& p, int layer, char* smem) {
  const int* cnt = (const int*)(p.ws + WS_CNT) + layer * 32;
  const int* list = (const int*)(p.ws + WS_LIST);
  const float* gate = (const float*)(p.ws + WS_GATE);
  const u16* hbuf = (const u16*)(p.ws + WS_H);
  u16* slots = (u16*)(p.ws + WS_INC);
  for (int t = blockIdx.x;; t += gridDim.x) {
    MoeTile mt; if (!moe_decode(cnt, t, mt)) break;
    GemmDesc g{}; g.A = hbuf + (size_t)mt.hbase * 512; g.lda = 512; g.mvalid = mt.cnt;
    g.W = p.w_down + (size_t)(layer * 32 + mt.e) * 512 * DM; g.ldw = DM; g.K = 512;
    gemm_tile(g, mt.rt * 128, mt.ct * 128, [&](f32x4 (&acc)[4][4], int row0, int col0) {
#pragma unroll
      for (int m = 0; m < 4; ++m) {
        const int row = row0 + m * 16;
        if (row < mt.cnt) {
          const int asg = list[(size_t)mt.e * CAP + row];
          const float gt = gate[asg];
#pragma unroll
          for (int n = 0; n < 4; ++n) {
            uint2 w; w.x = pk2(gt * acc[m][n][0], gt * acc[m][n][1]); w.y = pk2(gt * acc[m][n][2], gt * acc[m][n][3]);
            *(uint2*)(slots + (size_t)asg * DM + col0 + n * 16) = w;
          }
        }
      }
    }, smem);
  }
}

constexpr int KSTR = 72;
__device__ __forceinline__ int t5_bucket_abs(int n) {
  return n < 8 ? n : 8 + (n >= 12) + (n >= 16) + (n >= 23) + (n >= 32) + (n >= 46) + (n >= 64) + (n >= 91);
}
__device__ void phase_attn_naive(const P& p, char* smem) {
  u16* sK = (u16*)smem; u16* sV = sK + 384 * KSTR; float* sBias = (float*)(sV + 384 * KSTR);
  const u16* q1 = (const u16*)(p.ws + WS_Z); const u16* k1 = (const u16*)(p.ws + WS_Z + 32 * MB); const u16* v1 = (const u16*)(p.ws + WS_Z + 40 * MB);
  u16* ao = (u16*)(p.ws + WS_YCAT);
  const int tid = threadIdx.x;
  for (int item = blockIdx.x; item < 512; item += gridDim.x) {
    const int b = item >> 6, nb = (item >> 2) & 15, kvh = item & 3;
    __syncthreads();
    for (int c = tid; c < 384 * 8; c += NTHR) {
      const int s = c >> 3, ch = (c & 7) * 8, pos = (nb - 1) * 128 + s;
      uint4 kq = make_uint4(0u, 0u, 0u, 0u), vq = kq;
      if (pos >= 0 && pos < SEQ) { kq = *(const uint4*)(k1 + (size_t)(b * SEQ + pos) * 256 + kvh * 64 + ch); vq = *(const uint4*)(v1 + (size_t)(b * SEQ + pos) * 256 + kvh * 64 + ch); }
      *(uint4*)(sK + s * KSTR + ch) = kq; *(uint4*)(sV + s * KSTR + ch) = vq;
    }
    for (int c = tid; c < 4 * 257; c += NTHR) {
      const int hq = c / 257, ri = c % 257, rel = ri - 128, n = rel < 0 ? -rel : rel;
      const int bucket = (rel > 0 ? 16 : 0) + t5_bucket_abs(n);
      sBias[hq * 260 + ri] = p.rel_bias[bucket * 16 + kvh * 4 + hq];
    }
    __syncthreads();
    for (int pass = 0; pass < 2; ++pass) {
      const int hq = pass * 2 + (tid >> 7), qi = tid & 127, head = kvh * 4 + hq;
      const size_t tok = (size_t)b * SEQ + nb * 128 + qi;
      float q[64];
#pragma unroll
      for (int d = 0; d < 64; d += 8) {
        const uint4 qq = *(const uint4*)(q1 + tok * DM + head * 64 + d);
        q[d] = lo16(qq.x); q[d + 1] = hi16(qq.x); q[d + 2] = lo16(qq.y); q[d + 3] = hi16(qq.y); q[d + 4] = lo16(qq.z); q[d + 5] = hi16(qq.z); q[d + 6] = lo16(qq.w); q[d + 7] = hi16(qq.w);
      }
      float mx = p.sink[head], l = 1.0f, o[64];
#pragma unroll
      for (int d = 0; d < 64; ++d) o[d] = 0.f;
      for (int r = 0; r <= 256; ++r) {
        const int s = qi + r, pos = (nb - 1) * 128 + s;
        if (pos < 0 || pos >= SEQ) continue;
        float sc = 0.f;
#pragma unroll
        for (int d = 0; d < 64; d += 8) {
          const uint4 kq = *(const uint4*)(sK + s * KSTR + d);
          sc += q[d] * lo16(kq.x) + q[d + 1] * hi16(kq.x) + q[d + 2] * lo16(kq.y) + q[d + 3] * hi16(kq.y) + q[d + 4] * lo16(kq.z) + q[d + 5] * hi16(kq.z) + q[d + 6] * lo16(kq.w) + q[d + 7] * hi16(kq.w);
        }
        sc += sBias[hq * 260 + r];
        const float mn = fmaxf(mx, sc), alpha = __expf(mx - mn), pe = __expf(sc - mn);
        l = l * alpha + pe; mx = mn;
#pragma unroll
        for (int d = 0; d < 64; d += 8) {
          const uint4 vq = *(const uint4*)(sV + s * KSTR + d);
          o[d] = o[d] * alpha + pe * lo16(vq.x); o[d + 1] = o[d + 1] * alpha + pe * hi16(vq.x); o[d + 2] = o[d + 2] * alpha + pe * lo16(vq.y); o[d + 3] = o[d + 3] * alpha + pe * hi16(vq.y);
          o[d + 4] = o[d + 4] * alpha + pe * lo16(vq.z); o[d + 5] = o[d + 5] * alpha + pe * hi16(vq.z); o[d + 6] = o[d + 6] * alpha + pe * lo16(vq.w); o[d + 7] = o[d + 7] * alpha + pe * hi16(vq.w);
        }
      }
      const float inv = 1.0f / l;
#pragma unroll
      for (int d = 0; d < 64; d += 8) {
        uint4 w; w.x = pk2(o[d] * inv, o[d + 1] * inv); w.y = pk2(o[d + 2] * inv, o[d + 3] * inv); w.z = pk2(o[d + 4] * inv, o[d + 5] * inv); w.w = pk2(o[d + 6] * inv, o[d + 7] * inv);
        *(uint4*)(ao + tok * DM + head * 64 + d) = w;
      }
    }
  }
}

constexpr int NPHASE = 20;
constexpr int LDS_BYTES = 141312;
__device__ __forceinline__ void run_phase(const P& p, int ph, char* smem) {
  float* xa = (float*)(p.ws + WS_XA);
  const u16* ycat = (const u16*)(p.ws + WS_YCAT);
  const u16* slots = (const u16*)(p.ws + WS_INC);
  switch (ph) {
    case 0: phase_prep(p); phase_s5_ktab(p); break;
    case 1: phase_rowpass(p, p.x, nullptr, nullptr, p.norm_mix_g, -1, nullptr); phase_s5_fill(p); break;
    case 2: phase_inproj(p, smem); break;
    case 3: phase_ret_inc(p, smem); phase_s5_egemm(p, smem); break;
    case 4: phase_ret_scan(p); phase_s5_carry(p); break;
    case 5: phase_ret_out(p, smem); phase_s5_ygemm(p, smem); break;
    case 6: break;
    case 7: phase_glu(p, smem); break;
    case 8: phase_outproj(p, ycat, p.w_out, p.x, xa, smem); break;
    case 9: phase_rowpass(p, xa, nullptr, nullptr, p.norm_ffn_g, 0, nullptr); break;
    case 10: phase_moe1(p, 0, smem); break;
    case 11: phase_moe2(p, 0, smem); break;
    case 12: phase_rowpass(p, xa, slots, xa, p.norm_mix_g + DM, -1, nullptr); break;
    case 13: phase_qkv(p, smem); break;
    case 14: phase_attn_naive(p, smem); break;
    case 15: phase_outproj(p, ycat, p.w_o, xa, xa, smem); break;
    case 16: phase_rowpass(p, xa, nullptr, nullptr, p.norm_ffn_g + DM, 1, nullptr); break;
    case 17: phase_moe1(p, 1, smem); break;
    case 18: phase_moe2(p, 1, smem); break;
    case 19: phase_rowpass(p, xa, slots, nullptr, p.norm_final_g, -1, p.out); break;
    default: break;
  }
}

extern __shared__ __attribute__((aligned(16))) char dyn_smem[];

#if MULTI_LAUNCH
__global__ void __launch_bounds__(NTHR) k_phase(P p, int ph) { run_phase(p, ph, dyn_smem); }
#else

template <int PH> __device__ __forceinline__ void mega_steps(const P& p, char* smem, cg::grid_group& grid) {
  run_phase(p, PH, smem);
  if constexpr (PH + 1 < NPHASE) { grid.sync(); mega_steps<PH + 1>(p, smem, grid); }
}
__global__ void __launch_bounds__(NTHR) k_mega(P p) {
  cg::grid_group grid = cg::this_grid();
  mega_steps<0>(p, dyn_smem, grid);
}
#endif

extern "C" void kernel_launch(void* const* d_in, const int* in_sizes, int n_in, void* d_out, int out_size, void* d_ws, size_t ws_size, hipStream_t stream) {
  static int grid_blocks = 0;
  if (grid_blocks == 0) {
    if (n_in != 28 || out_size != T_TOK * DM || ws_size < WS_END) { fprintf(stderr, "kernel_launch: unexpected problem (n_in %d out %d ws %zu need %zu)\n", n_in, out_size, ws_size, (size_t)WS_END); grid_blocks = -1; return; }
    int dev = 0, cus = 0, per_cu = 0;
    (void)hipGetDevice(&dev);
    (void)hipDeviceGetAttribute(&cus, hipDeviceAttributeMultiprocessorCount, dev);
#if MULTI_LAUNCH
    const void* fn = (const void*)k_phase;
#else
    const void* fn = (const void*)k_mega;
#endif
    if (hipFuncSetAttribute(fn, hipFuncAttributeMaxDynamicSharedMemorySize, LDS_BYTES) != hipSuccess) { fprintf(stderr, "kernel_launch: hipFuncSetAttribute failed\n"); }
    if (hipOccupancyMaxActiveBlocksPerMultiprocessor(&per_cu, fn, NTHR, LDS_BYTES) != hipSuccess || per_cu < 1) { fprintf(stderr, "kernel_launch: occupancy query failed (%d)\n", per_cu); per_cu = 1; }
    (void)hipGetLastError();
    grid_blocks = cus * per_cu;
    fprintf(stderr, "kernel_launch: cus %d per_cu %d grid %d\n", cus, per_cu, grid_blocks);
  }
  if (grid_blocks < 0) return;
  P p{};
  const float** pp = (const float**)&p;
  for (int i = 0; i < 28; ++i) pp[i] = (const float*)d_in[i];
  p.out = (float*)d_out; p.ws = (char*)d_ws;
#if MULTI_LAUNCH
  for (int ph = 0; ph < NPHASE; ++ph) hipLaunchKernelGGL(k_phase, dim3(grid_blocks), dim3(NTHR), LDS_BYTES, stream, p, ph);
#else
  void* args[] = {&p};
  hipError_t e = hipLaunchCooperativeKernel((const void*)k_mega, dim3(grid_blocks), dim3(NTHR), args, LDS_BYTES, stream);
  if (e != hipSuccess) fprintf(stderr, "cooperative launch failed: %s (grid %d)\n", hipGetErrorString(e), grid_blocks);
#endif
}
```

```cpp
#include <hip/hip_runtime.h>
#include <hip/hip_cooperative_groups.h>
#include <cstdio>
#include <cstdint>
namespace cg = cooperative_groups;

#ifndef USE_FP16
#define USE_FP16 1
#endif
#ifndef MULTI_LAUNCH
#define MULTI_LAUNCH 0
#endif

typedef unsigned short u16;
typedef float f32x4 __attribute__((ext_vector_type(4)));
typedef float f32x2 __attribute__((ext_vector_type(2)));
typedef _Float16 f16x8 __attribute__((ext_vector_type(8)));
typedef __bf16 b16x8 __attribute__((ext_vector_type(8)));

constexpr int T_TOK = 16384, DM = 1024, SEQ = 2048, NBATCH = 8;
constexpr int CAP = 32768;
constexpr int NTHR = 256;

constexpr size_t MB = 1024ull * 1024ull;
constexpr size_t WS_XA    = 0;
constexpr size_t WS_XB    = WS_XA + 64 * MB;
constexpr size_t WS_Z     = WS_XB + 32 * MB;
constexpr size_t WS_A2    = WS_Z + 64 * MB;
constexpr size_t WS_INC   = WS_A2 + 24 * MB;
constexpr size_t WS_YCAT  = WS_INC + 64 * MB;
constexpr size_t WS_YGELU = WS_YCAT + 32 * MB;
constexpr size_t WS_H     = WS_YGELU + 16 * MB;
constexpr size_t WS_LIST  = WS_H + 36 * MB;
constexpr size_t WS_GATE  = WS_LIST + 4 * MB;
constexpr size_t WS_ROPE  = WS_GATE + 1 * MB;
constexpr size_t WS_CNT   = WS_ROPE + 1 * MB;
constexpr size_t WS_KTAB  = WS_CNT + 1 * MB;
constexpr size_t WS_BTY   = WS_KTAB + 2 * MB;
constexpr size_t WS_WET   = WS_BTY + 24 * MB;
constexpr size_t WS_E     = WS_WET + 8 * MB;
constexpr size_t WS_END   = WS_E + 16 * MB;

struct P {
  const float *x, *norm_mix_g, *norm_ffn_g, *norm_final_g, *w_in, *ret_decay, *a_re, *a_im, *log_step, *b_re, *b_im, *c_re, *c_im,
      *s5d, *w_glu, *b_glu, *w_out, *w_qkv, *sink, *w_o, *rel_bias, *w_group, *b_group, *w_er, *b_er, *w_gate, *w_up, *w_down;
  float* out;
  char* ws;
};

__device__ __forceinline__ u16 f2h(float f) {
#if USE_FP16
  _Float16 h = (_Float16)f; return __builtin_bit_cast(u16, h);
#else
  unsigned u = __builtin_bit_cast(unsigned, f); u += 0x7fffu + ((u >> 16) & 1u); return (u16)(u >> 16);
#endif
}
__device__ __forceinline__ float h2f(u16 h) {
#if USE_FP16
  return (float)__builtin_bit_cast(_Float16, h);
#else
  return __builtin_bit_cast(float, ((unsigned)h) << 16);
#endif
}
__device__ __forceinline__ unsigned pk2(float a, float b) { return (unsigned)f2h(a) | ((unsigned)f2h(b) << 16); }
__device__ __forceinline__ float lo16(unsigned w) { return h2f((u16)(w & 0xffffu)); }
__device__ __forceinline__ float hi16(unsigned w) { return h2f((u16)(w >> 16)); }
__device__ __forceinline__ f32x4 mfma16(uint4 a, uint4 b, f32x4 c) {
#if USE_FP16
  return __builtin_amdgcn_mfma_f32_16x16x32_f16(__builtin_bit_cast(f16x8, a), __builtin_bit_cast(f16x8, b), c, 0, 0, 0);
#else
  return __builtin_amdgcn_mfma_f32_16x16x32_bf16(__builtin_bit_cast(b16x8, a), __builtin_bit_cast(b16x8, b), c, 0, 0, 0);
#endif
}
__device__ __forceinline__ float wave_sum(float v) {
#pragma unroll
  for (int o = 1; o < 64; o <<= 1) v += __shfl_xor(v, o);
  return v;
}
__device__ __forceinline__ float sigmoidf_(float x) { return 1.0f / (1.0f + __expf(-x)); }
__device__ __forceinline__ float gelu_tanh(float x) {
  const float u = 0.7978845608028654f * (x + 0.044715f * x * x * x);
  return 0.5f * x * (1.0f + tanhf(u));
}

struct GemmDesc {
  const u16* A; long lda;
  const int* rowmap; int rowshift;
  int mvalid;
  const float* W; const float* W2; long ldw;
  const u16* Bt; long ldb;
  int K;
};
constexpr int LSTR = 40;
constexpr int GEMM_LDS = 2 * 128 * LSTR * 2;

template <class Epi>
__device__ __forceinline__ void gemm_tile(const GemmDesc& g, int m0, int n0, Epi&& epi, char* smem) {
  u16* sA = (u16*)smem;
  u16* sB = sA + 128 * LSTR;
  const int tid = threadIdx.x, lane = tid & 63, wid = tid >> 6, wr = wid >> 1, wc = wid & 1, fr = lane & 15, fq = lane >> 4;
  f32x4 acc[4][4];
#pragma unroll
  for (int m = 0; m < 4; ++m)
#pragma unroll
    for (int n = 0; n < 4; ++n) acc[m][n] = (f32x4){0.f, 0.f, 0.f, 0.f};
  const int ar = tid >> 2, akc = (tid & 3) * 8;
  const u16* ap[2];
#pragma unroll
  for (int i = 0; i < 2; ++i) {
    const int m = m0 + ar + i * 64; const u16* q = nullptr;
    if (m < g.mvalid) { const long row = g.rowmap ? (long)(g.rowmap[m] >> g.rowshift) : (long)m; q = g.A + row * g.lda + akc; }
    ap[i] = q;
  }
  const bool useBt = (g.Bt != nullptr);
  const float* wp = nullptr; const u16* bp[2] = {nullptr, nullptr};
  if (!useBt) {
    const int v = n0 + (tid & 31) * 4;
    if (g.W2) wp = ((((v >> 5) & 1) ? g.W2 : g.W) + ((v >> 6) * 32 + (v & 31)));
    else wp = g.W + v;
    wp += (long)((tid >> 5) * 4) * g.ldw;
  } else {
#pragma unroll
    for (int i = 0; i < 2; ++i) bp[i] = g.Bt + (long)(n0 + ar + i * 64) * g.ldb + akc;
  }
  uint4 ra0, ra1, rb0 = make_uint4(0u, 0u, 0u, 0u), rb1 = rb0; f32x4 rw0 = {0.f, 0.f, 0.f, 0.f}, rw1 = rw0, rw2 = rw0, rw3 = rw0;
#define GEMM_GLOAD(k0_)                                                                                   \
  do {                                                                                                    \
    const int kq_ = (k0_);                                                                                \
    ra0 = ap[0] ? *(const uint4*)(ap[0] + kq_) : make_uint4(0u, 0u, 0u, 0u);                              \
    ra1 = ap[1] ? *(const uint4*)(ap[1] + kq_) : make_uint4(0u, 0u, 0u, 0u);                              \
    if (useBt) { rb0 = *(const uint4*)(bp[0] + kq_); rb1 = *(const uint4*)(bp[1] + kq_); }               \
    else {                                                                                                \
      rw0 = *(const f32x4*)(wp + (long)(kq_ + 0) * g.ldw); rw1 = *(const f32x4*)(wp + (long)(kq_ + 1) * g.ldw); \
      rw2 = *(const f32x4*)(wp + (long)(kq_ + 2) * g.ldw); rw3 = *(const f32x4*)(wp + (long)(kq_ + 3) * g.ldw); \
    }                                                                                                     \
  } while (0)
  GEMM_GLOAD(0);
  for (int k0 = 0; k0 < g.K; k0 += 32) {
    __syncthreads();
    *(uint4*)(sA + ar * LSTR + akc) = ra0; *(uint4*)(sA + (ar + 64) * LSTR + akc) = ra1;
    if (useBt) {
      *(uint4*)(sB + ar * LSTR + akc) = rb0; *(uint4*)(sB + (ar + 64) * LSTR + akc) = rb1;
    } else {
      const int nl = (tid & 31) * 4, kl = (tid >> 5) * 4;
#pragma unroll
      for (int c = 0; c < 4; ++c) {
        uint2 v; v.x = pk2(rw0[c], rw1[c]); v.y = pk2(rw2[c], rw3[c]);
        *(uint2*)(sB + (nl + c) * LSTR + kl) = v;
      }
    }
    __syncthreads();
    if (k0 + 32 < g.K) GEMM_GLOAD(k0 + 32);
    uint4 fa[4], fb[4];
#pragma unroll
    for (int m = 0; m < 4; ++m) fa[m] = *(const uint4*)(sA + (wr * 64 + m * 16 + fr) * LSTR + fq * 8);
#pragma unroll
    for (int n = 0; n < 4; ++n) fb[n] = *(const uint4*)(sB + (wc * 64 + n * 16 + fr) * LSTR + fq * 8);
#pragma unroll
    for (int m = 0; m < 4; ++m)
#pragma unroll
      for (int n = 0; n < 4; ++n) acc[m][n] = mfma16(fb[n], fa[m], acc[m][n]);
  }
  epi(acc, m0 + wr * 64 + fr, n0 + wc * 64 + fq * 4);
}

__device__ __forceinline__ void phase_prep(const P& p) {
  const int gtid = blockIdx.x * NTHR + threadIdx.x, gsz = gridDim.x * NTHR;
  int* cnt = (int*)(p.ws + WS_CNT);
  if (gtid < 64) cnt[gtid] = 0;
  f32x2* rope = (f32x2*)(p.ws + WS_ROPE);
  for (int i = gtid; i < SEQ * 64; i += gsz) {
    const int pos = i >> 6, f = i & 63;
    const float inv = powf(10000.0f, -(float)(2 * f) / 128.0f);
    const float ang = (float)pos * inv;
    float s, c; sincosf(ang, &s, &c);
    rope[i] = (f32x2){c, s};
  }
}

__device__ __forceinline__ void phase_rowpass(const P& p, const float* src, const u16* slots, float* dstx, const float* gain, int route_layer, float* fout) {
  const int lane = threadIdx.x & 63, gw = blockIdx.x * 4 + (threadIdx.x >> 6), nw = gridDim.x * 4;
  u16* xb = (u16*)(p.ws + WS_XB);
  int* cnt = (int*)(p.ws + WS_CNT);
  int* list = (int*)(p.ws + WS_LIST);
  float* gate = (float*)(p.ws + WS_GATE);
  for (int row = gw; row < T_TOK; row += nw) {
    f32x4 v[4];
    float ss = 0.f;
#pragma unroll
    for (int i = 0; i < 4; ++i) {
      const int k = (i * 64 + lane) * 4;
      v[i] = *(const f32x4*)(src + (size_t)row * DM + k);
      if (slots) {
#pragma unroll
        for (int s = 0; s < 2; ++s) {
          const uint2 w = *(const uint2*)(slots + ((size_t)row * 2 + s) * DM + k);
          v[i][0] += lo16(w.x); v[i][1] += hi16(w.x); v[i][2] += lo16(w.y); v[i][3] += hi16(w.y);
        }
      }
      if (dstx) *(f32x4*)(dstx + (size_t)row * DM + k) = v[i];
      ss += v[i][0] * v[i][0] + v[i][1] * v[i][1] + v[i][2] * v[i][2] + v[i][3] * v[i][3];
    }
    ss = wave_sum(ss);
    const float rstd = rsqrtf(ss * (1.0f / DM) + 1e-6f);
#pragma unroll
    for (int i = 0; i < 4; ++i) {
      const int k = (i * 64 + lane) * 4;
      const f32x4 gv = *(const f32x4*)(gain + k);
      v[i] = v[i] * rstd * gv;
      if (fout) *(f32x4*)(fout + (size_t)row * DM + k) = v[i];
      else { uint2 w; w.x = pk2(v[i][0], v[i][1]); w.y = pk2(v[i][2], v[i][3]); *(uint2*)(xb + (size_t)row * DM + k) = w; }
    }
    if (route_layer >= 0) {
      const float* wg = p.w_group + (size_t)route_layer * DM * 4;
      const float* we = p.w_er + (size_t)route_layer * 4 * DM * 8;
      float acc[36];
#pragma unroll
      for (int j = 0; j < 36; ++j) acc[j] = 0.f;
#pragma unroll
      for (int i = 0; i < 4; ++i) {
#pragma unroll
        for (int c = 0; c < 4; ++c) {
          const int k = (i * 64 + lane) * 4 + c;
          const float hv = v[i][c];
          const f32x4 g4 = *(const f32x4*)(wg + (size_t)k * 4);
#pragma unroll
          for (int j = 0; j < 4; ++j) acc[j] += hv * g4[j];
#pragma unroll
          for (int gg = 0; gg < 4; ++gg) {
            const f32x4 e0 = *(const f32x4*)(we + ((size_t)gg * DM + k) * 8);
            const f32x4 e1 = *(const f32x4*)(we + ((size_t)gg * DM + k) * 8 + 4);
#pragma unroll
            for (int j = 0; j < 4; ++j) { acc[4 + gg * 8 + j] += hv * e0[j]; acc[4 + gg * 8 + 4 + j] += hv * e1[j]; }
          }
        }
      }
#pragma unroll
      for (int j = 0; j < 36; ++j) acc[j] = wave_sum(acc[j]);
      if (lane == 0) {
        const float* bg = p.b_group + route_layer * 4;
        const float* be = p.b_er + route_layer * 32;
        float gl[4];
#pragma unroll
        for (int j = 0; j < 4; ++j) gl[j] = acc[j] + bg[j];
        int gs = 0; float gm = gl[0];
#pragma unroll
        for (int j = 1; j < 4; ++j) if (gl[j] > gm) { gm = gl[j]; gs = j; }
        float den = 0.f;
#pragma unroll
        for (int j = 0; j < 4; ++j) den += expf(gl[j] - gm);
        const float pg = 1.0f / den;
        float el[8];
#pragma unroll
        for (int j = 0; j < 8; ++j) {
          float a = acc[4 + j];
#pragma unroll
          for (int gg = 1; gg < 4; ++gg) a = (gs == gg) ? acc[4 + gg * 8 + j] : a;
          el[j] = a + be[gs * 8 + j];
        }
        int i1 = 0; float v1 = el[0];
#pragma unroll
        for (int j = 1; j < 8; ++j) if (el[j] > v1) { v1 = el[j]; i1 = j; }
        int i2 = -1; float v2 = -3.0e38f;
#pragma unroll
        for (int j = 0; j < 8; ++j) if (j != i1 && el[j] > v2) { v2 = el[j]; i2 = j; }
        const float e2 = expf(v2 - v1);
        const float g1 = pg / (1.0f + e2), g2 = pg * e2 / (1.0f + e2);
        const int ex1 = gs * 8 + i1, ex2 = gs * 8 + i2;
        const int r1 = atomicAdd(&cnt[route_layer * 32 + ex1], 1);
        list[(size_t)ex1 * CAP + r1] = row * 2;
        gate[row * 2] = g1;
        const int r2 = atomicAdd(&cnt[route_layer * 32 + ex2], 1);
        list[(size_t)ex2 * CAP + r2] = row * 2 + 1;
        gate[row * 2 + 1] = g2;
      }
    }
  }
}

__device__ __forceinline__ void phase_inproj(const P& p, char* smem) {
  GemmDesc g{}; g.A = (const u16*)(p.ws + WS_XB); g.lda = DM; g.mvalid = T_TOK; g.W = p.w_in; g.ldw = 2560; g.K = DM;
  u16* zb = (u16*)(p.ws + WS_Z); u16* a2 = (u16*)(p.ws + WS_A2);
  const int ntiles = 128 * 20;
  for (int t = blockIdx.x; t < ntiles; t += gridDim.x) {
    const int mt = t / 20, nt = t % 20;
    gemm_tile(g, mt * 128, nt * 128, [&](f32x4 (&acc)[4][4], int row0, int col0) {
      const int seg = (nt * 128) / 512;
#pragma unroll
      for (int m = 0; m < 4; ++m)
#pragma unroll
        for (int n = 0; n < 4; ++n) {
          const int row = row0 + m * 16, col = col0 + n * 16;
          uint2 w; w.x = pk2(acc[m][n][0], acc[m][n][1]); w.y = pk2(acc[m][n][2], acc[m][n][3]);
          if (seg < 4) *(uint2*)(zb + (size_t)seg * T_TOK * 512 + (size_t)row * 512 + (col - seg * 512)) = w;
          else { const int ch = col - 2048, gi = ch >> 4, c = ch & 15; *(uint2*)(a2 + ((size_t)gi * 512 + (row >> 5)) * 768 + (row & 31) * 16 + c) = w; }
        }
    }, smem);
  }
}

constexpr int RSTR = 136;
__device__ __forceinline__ void ret_load_tile(u16* dst, const u16* src, int t0, int h, int mode  , const f32x2* rope) {
  const int pos0 = t0 & (SEQ - 1);
  for (int idx = threadIdx.x; idx < 128 * 64; idx += NTHR) {
    const int i = idx >> 6, d = idx & 63;
    float t1 = h2f(src[(size_t)(t0 + i) * 512 + h * 128 + d]), t2 = h2f(src[(size_t)(t0 + i) * 512 + h * 128 + d + 64]);
    if (mode) {
      const f32x2 cs = rope[(pos0 + i) * 64 + d];
      const float o1 = t1 * cs[0] - t2 * cs[1], o2 = t1 * cs[1] + t2 * cs[0];
      t1 = o1; t2 = o2;
      if (mode == 2) { t1 *= 0.08838834764831845f; t2 *= 0.08838834764831845f; }
    }
    dst[i * RSTR + d] = f2h(t1); dst[i * RSTR + d + 64] = f2h(t2);
  }
}
__device__ __forceinline__ float log_sigmoid(float x) { return -log1pf(expf(-x)); }

__device__ __forceinline__ void phase_ret_inc(const P& p, char* smem) {
  u16* sK = (u16*)smem; u16* sV = sK + 128 * RSTR; float* sWf = (float*)(sV + 128 * RSTR); float* sWb = sWf + 128;
  const u16* kb = (const u16*)(p.ws + WS_Z) + (size_t)1 * T_TOK * 512; const u16* vb = (const u16*)(p.ws + WS_Z) + (size_t)2 * T_TOK * 512;
  const f32x2* rope = (const f32x2*)(p.ws + WS_ROPE);
  float* incf = (float*)(p.ws + WS_INC); float* incb = incf + (size_t)512 * 16384;
  const int tid = threadIdx.x;
  for (int item = blockIdx.x; item < 512; item += gridDim.x) {
    const int h = item & 3, bn = item >> 2, t0 = bn * 128;
    const float lgf = log_sigmoid(p.ret_decay[h]), lgb = log_sigmoid(p.ret_decay[4 + h]);
    __syncthreads();
    ret_load_tile(sK, kb, t0, h, 2, rope);
    ret_load_tile(sV, vb, t0, h, 0, rope);
    if (tid < 128) { sWf[tid] = expf(lgf * (float)(127 - tid)); sWb[tid] = expf(lgb * (float)tid); }
    __syncthreads();
    const int d0 = (tid >> 4) * 8, e0 = (tid & 15) * 8;
    float af[8][8], ab[8][8];
#pragma unroll
    for (int a = 0; a < 8; ++a)
#pragma unroll
      for (int b = 0; b < 8; ++b) { af[a][b] = 0.f; ab[a][b] = 0.f; }
    for (int j = 0; j < 128; ++j) {
      const uint4 kq = *(const uint4*)(sK + j * RSTR + d0), vq = *(const uint4*)(sV + j * RSTR + e0);
      const float kd[8] = {lo16(kq.x), hi16(kq.x), lo16(kq.y), hi16(kq.y), lo16(kq.z), hi16(kq.z), lo16(kq.w), hi16(kq.w)};
      const float ve[8] = {lo16(vq.x), hi16(vq.x), lo16(vq.y), hi16(vq.y), lo16(vq.z), hi16(vq.z), lo16(vq.w), hi16(vq.w)};
      const float wf = sWf[j], wb = sWb[j];
#pragma unroll
      for (int a = 0; a < 8; ++a) {
        const float kf = kd[a] * wf, kbw = kd[a] * wb;
#pragma unroll
        for (int b = 0; b < 8; ++b) { af[a][b] += kf * ve[b]; ab[a][b] += kbw * ve[b]; }
      }
    }
#pragma unroll
    for (int a = 0; a < 8; ++a) {
      float* of = incf + (size_t)item * 16384 + (d0 + a) * 128 + e0;
      float* ob = incb + (size_t)item * 16384 + (d0 + a) * 128 + e0;
      *(f32x4*)of = (f32x4){af[a][0], af[a][1], af[a][2], af[a][3]}; *(f32x4*)(of + 4) = (f32x4){af[a][4], af[a][5], af[a][6], af[a][7]};
      *(f32x4*)ob = (f32x4){ab[a][0], ab[a][1], ab[a][2], ab[a][3]}; *(f32x4*)(ob + 4) = (f32x4){ab[a][4], ab[a][5], ab[a][6], ab[a][7]};
    }
  }
}

__device__ __forceinline__ void phase_ret_scan(const P& p) {
  float* incf = (float*)(p.ws + WS_INC); float* incb = incf + (size_t)512 * 16384;
  const int gtid = blockIdx.x * NTHR + threadIdx.x, gsz = gridDim.x * NTHR;
  for (int idx = gtid; idx < 32 * 16384; idx += gsz) {
    const int de = idx & 16383, bh = idx >> 14, b = bh >> 2, h = bh & 3;
    const float Gf = expf(128.0f * log_sigmoid(p.ret_decay[h])), Gb = expf(128.0f * log_sigmoid(p.ret_decay[4 + h]));
    float s = 0.f;
    for (int n = 0; n < 16; ++n) { float* q = incf + ((size_t)((b * 16 + n) * 4 + h)) * 16384 + de; const float t = *q; *q = s; s = s * Gf + t; }
    s = 0.f;
    for (int n = 15; n >= 0; --n) { float* q = incb + ((size_t)((b * 16 + n) * 4 + h)) * 16384 + de; const float t = *q; *q = s; s = s * Gb + t; }
  }
}

__device__ __forceinline__ void phase_ret_out(const P& p, char* smem) {
  u16* sQ = (u16*)smem; u16* sK = sQ + 128 * RSTR; u16* sV = sK + 128 * RSTR; u16* sS = sV + 128 * RSTR;
  float* sPf = (float*)(sS + 128 * RSTR); float* sPb = sPf + 132;
  const u16* zb = (const u16*)(p.ws + WS_Z);
  const u16* qb = zb; const u16* kb = zb + (size_t)1 * T_TOK * 512; const u16* vb = zb + (size_t)2 * T_TOK * 512; const u16* gb = zb + (size_t)3 * T_TOK * 512;
  const f32x2* rope = (const f32x2*)(p.ws + WS_ROPE);
  const float* incf = (const float*)(p.ws + WS_INC); const float* incb = incf + (size_t)512 * 16384;
  u16* ycat = (u16*)(p.ws + WS_YCAT);
  const int tid = threadIdx.x;
  for (int item = blockIdx.x; item < 512; item += gridDim.x) {
    const int h = item & 3, bn = item >> 2, t0 = bn * 128;
    const float lgf = log_sigmoid(p.ret_decay[h]), lgb = log_sigmoid(p.ret_decay[4 + h]);
    __syncthreads();
    ret_load_tile(sQ, qb, t0, h, 1, rope);
    ret_load_tile(sK, kb, t0, h, 2, rope);
    ret_load_tile(sV, vb, t0, h, 0, rope);
    if (tid < 129) { sPf[tid] = expf(lgf * (float)tid); sPb[tid] = expf(lgb * (float)tid); }
    __syncthreads();
    const int i0 = (tid >> 4) * 8, j0 = (tid & 15) * 8;
    {
      float s[8][8];
#pragma unroll
      for (int a = 0; a < 8; ++a)
#pragma unroll
        for (int b = 0; b < 8; ++b) s[a][b] = 0.f;
      for (int d = 0; d < 128; d += 8) {
        float kk[8][8];
#pragma unroll
        for (int b = 0; b < 8; ++b) {
          const uint4 kq = *(const uint4*)(sK + (j0 + b) * RSTR + d);
          kk[b][0] = lo16(kq.x); kk[b][1] = hi16(kq.x); kk[b][2] = lo16(kq.y); kk[b][3] = hi16(kq.y); kk[b][4] = lo16(kq.z); kk[b][5] = hi16(kq.z); kk[b][6] = lo16(kq.w); kk[b][7] = hi16(kq.w);
        }
#pragma unroll
        for (int a = 0; a < 8; ++a) {
          const uint4 qq = *(const uint4*)(sQ + (i0 + a) * RSTR + d);
          const float qv[8] = {lo16(qq.x), hi16(qq.x), lo16(qq.y), hi16(qq.y), lo16(qq.z), hi16(qq.z), lo16(qq.w), hi16(qq.w)};
#pragma unroll
          for (int b = 0; b < 8; ++b)
#pragma unroll
            for (int c = 0; c < 8; ++c) s[a][b] += qv[c] * kk[b][c];
        }
      }
#pragma unroll
      for (int a = 0; a < 8; ++a) {
        unsigned w[4];
#pragma unroll
        for (int b = 0; b < 8; b += 2) {
          const int i = i0 + a, j = j0 + b;
          const float m0 = (i >= j) ? sPf[i - j] : sPb[j - i];
          const float m1 = (i >= j + 1) ? sPf[i - j - 1] : sPb[j + 1 - i];
          w[b >> 1] = pk2(s[a][b] * m0, s[a][b + 1] * m1);
        }
        *(uint4*)(sS + (i0 + a) * RSTR + j0) = make_uint4(w[0], w[1], w[2], w[3]);
      }
    }
    __syncthreads();
    {
      const int e0 = j0;
      float o[8][8];
#pragma unroll
      for (int a = 0; a < 8; ++a)
#pragma unroll
        for (int b = 0; b < 8; ++b) o[a][b] = 0.f;
      for (int j = 0; j < 128; j += 8) {
        float vv[8][8];
#pragma unroll
        for (int c = 0; c < 8; ++c) {
          const uint4 vq = *(const uint4*)(sV + (j + c) * RSTR + e0);
          vv[c][0] = lo16(vq.x); vv[c][1] = hi16(vq.x); vv[c][2] = lo16(vq.y); vv[c][3] = hi16(vq.y); vv[c][4] = lo16(vq.z); vv[c][5] = hi16(vq.z); vv[c][6] = lo16(vq.w); vv[c][7] = hi16(vq.w);
        }
#pragma unroll
        for (int a = 0; a < 8; ++a) {
          const uint4 sq = *(const uint4*)(sS + (i0 + a) * RSTR + j);
          const float sv[8] = {lo16(sq.x), hi16(sq.x), lo16(sq.y), hi16(sq.y), lo16(sq.z), hi16(sq.z), lo16(sq.w), hi16(sq.w)};
#pragma unroll
          for (int c = 0; c < 8; ++c)
#pragma unroll
            for (int b = 0; b < 8; ++b) o[a][b] += sv[c] * vv[c][b];
        }
      }
      const float* sp = incf + (size_t)item * 16384 + e0;
      const float* sn = incb + (size_t)item * 16384 + e0;
      float pf[8], pb[8];
#pragma unroll
      for (int a = 0; a < 8; ++a) { pf[a] = sPf[i0 + a + 1]; pb[a] = sPb[128 - (i0 + a)]; }
      for (int d = 0; d < 128; ++d) {
        const f32x4 p0 = *(const f32x4*)(sp + d * 128), p1 = *(const f32x4*)(sp + d * 128 + 4);
        const f32x4 n0 = *(const f32x4*)(sn + d * 128), n1 = *(const f32x4*)(sn + d * 128 + 4);
        const float spv[8] = {p0[0], p0[1], p0[2], p0[3], p1[0], p1[1], p1[2], p1[3]};
        const float snv[8] = {n0[0], n0[1], n0[2], n0[3], n1[0], n1[1], n1[2], n1[3]};
#pragma unroll
        for (int a = 0; a < 8; ++a) {
          const float qv = h2f(sQ[(i0 + a) * RSTR + d]);
          const float qf = qv * pf[a], qbk = qv * pb[a];
#pragma unroll
          for (int b = 0; b < 8; ++b) o[a][b] += qf * spv[b] + qbk * snv[b];
        }
      }
#pragma unroll
      for (int a = 0; a < 8; ++a) {
        float s1 = 0.f;
#pragma unroll
        for (int b = 0; b < 8; ++b) s1 += o[a][b];
        s1 += __shfl_xor(s1, 1); s1 += __shfl_xor(s1, 2); s1 += __shfl_xor(s1, 4); s1 += __shfl_xor(s1, 8);
        const float mu = s1 * (1.0f / 128.0f);
        float s2 = 0.f;
#pragma unroll
        for (int b = 0; b < 8; ++b) { const float dlt = o[a][b] - mu; s2 += dlt * dlt; }
        s2 += __shfl_xor(s2, 1); s2 += __shfl_xor(s2, 2); s2 += __shfl_xor(s2, 4); s2 += __shfl_xor(s2, 8);
        const float rs = rsqrtf(s2 * (1.0f / 128.0f) + 1e-5f);
        const size_t tok = (size_t)(t0 + i0 + a);
        const uint4 gq = *(const uint4*)(gb + tok * 512 + h * 128 + e0);
        const float gv[8] = {lo16(gq.x), hi16(gq.x), lo16(gq.y), hi16(gq.y), lo16(gq.z), hi16(gq.z), lo16(gq.w), hi16(gq.w)};
        unsigned w[4];
#pragma unroll
        for (int b = 0; b < 8; b += 2) {
          const float y0 = gv[b] * sigmoidf_(gv[b]) * (o[a][b] - mu) * rs;
          const float y1 = gv[b + 1] * sigmoidf_(gv[b + 1]) * (o[a][b + 1] - mu) * rs;
          w[b >> 1] = pk2(y0, y1);
        }
        *(uint4*)(ycat + tok * DM + h * 128 + e0) = make_uint4(w[0], w[1], w[2], w[3]);
      }
    }
  }
}

__device__ __forceinline__ void phase_s5_naive(const P& p, char* smem) {
  float* ylds = (float*)smem;
  float* xs = ylds + 2048 * 16;
  const u16* a2 = (const u16*)(p.ws + WS_A2);
  u16* ygelu = (u16*)(p.ws + WS_YGELU);
  const int lane = threadIdx.x & 63;
  if (threadIdx.x < 64) {
    for (int item = blockIdx.x; item < 256; item += gridDim.x) {
      const int b = item >> 5, g = item & 31;
      const int pidx = lane;
      const int cidx = lane & 15, quart = lane >> 4;
      for (int dir = 0; dir < 2; ++dir) {
        const float dt = expf(p.log_step[dir * 32 + g]);
        const float ar = p.a_re[(dir * 32 + g) * 64 + pidx], ai = p.a_im[(dir * 32 + g) * 64 + pidx];
        const float mag = expf(ar * dt);
        float sn, cs; sincosf(ai * dt, &sn, &cs);
        const float lre = mag * cs, lim = mag * sn;
        const float nr = lre - 1.0f, ni = lim, den = ar * ar + ai * ai;
        const float cre = (nr * ar + ni * ai) / den, cim = (ni * ar - nr * ai) / den;
        float bbr[16], bbi[16];
#pragma unroll
        for (int c = 0; c < 16; ++c) {
          const float br = p.b_re[(g * 64 + pidx) * 16 + c], bi = p.b_im[(g * 64 + pidx) * 16 + c];
          bbr[c] = cre * br - cim * bi; bbi[c] = cre * bi + cim * br;
        }
        float ccr[16], cci[16];
#pragma unroll
        for (int q = 0; q < 16; ++q) {
          ccr[q] = p.c_re[((dir * 32 + g) * 16 + cidx) * 64 + quart * 16 + q];
          cci[q] = p.c_im[((dir * 32 + g) * 16 + cidx) * 64 + quart * 16 + q];
        }
        const float dsk = p.s5d[g * 16 + cidx];
        float xr = 0.f, xi = 0.f;
        for (int step = 0; step < SEQ; ++step) {
          const int n = dir ? (SEQ - 1 - step) : step;
          const int t = b * SEQ + n;
          const u16* up = a2 + ((size_t)g * 512 + (t >> 5)) * 768 + (t & 31) * 16;
          const uint4 u0 = *(const uint4*)up, u1 = *(const uint4*)(up + 8);
          const float uv[16] = {lo16(u0.x), hi16(u0.x), lo16(u0.y), hi16(u0.y), lo16(u0.z), hi16(u0.z), lo16(u0.w), hi16(u0.w),
                                lo16(u1.x), hi16(u1.x), lo16(u1.y), hi16(u1.y), lo16(u1.z), hi16(u1.z), lo16(u1.w), hi16(u1.w)};
          float bur = 0.f, bui = 0.f;
#pragma unroll
          for (int c = 0; c < 16; ++c) { bur += bbr[c] * uv[c]; bui += bbi[c] * uv[c]; }
          const float nxr = lre * xr - lim * xi + bur, nxi = lre * xi + lim * xr + bui;
          xr = nxr; xi = nxi;
          asm volatile("s_waitcnt lgkmcnt(0)" ::: "memory");
          xs[lane] = xr; xs[64 + lane] = xi;
          asm volatile("s_waitcnt lgkmcnt(0)" ::: "memory");
          float part = 0.f;
#pragma unroll
          for (int q = 0; q < 16; ++q) part += ccr[q] * xs[quart * 16 + q] - cci[q] * xs[64 + quart * 16 + q];
          asm volatile("s_waitcnt lgkmcnt(0)" ::: "memory");
          part += __shfl_xor(part, 16); part += __shfl_xor(part, 32);
          if (lane < 16) {
            if (dir == 0) ylds[n * 16 + cidx] = dsk * h2f(up[cidx]) + part;
            else ygelu[(size_t)t * 512 + g * 16 + cidx] = f2h(gelu_tanh(ylds[n * 16 + cidx] + part));
          }
        }
      }
    }
  }
}

struct Cpx { float re, im; };
__device__ __forceinline__ Cpx cmul(Cpx a, Cpx b) { return {a.re * b.re - a.im * b.im, a.re * b.im + a.im * b.re}; }
__device__ __forceinline__ Cpx s5_lam_pow(float ar, float ai, float dt, float e) {
  const float mag = expf(ar * dt * e); float sn, cs; sincosf(ai * dt * e, &sn, &cs); return {mag * cs, mag * sn};
}
__device__ __forceinline__ Cpx s5_coef(float ar, float ai, float dt) {
  float sn, cs; sincosf(ai * dt, &sn, &cs);
  const float em1 = expm1f(ar * dt), sh = sinf(0.5f * ai * dt);
  const float nr = em1 * cs - 2.0f * sh * sh, ni = (em1 + 1.0f) * sn, den = ar * ar + ai * ai;
  return {(nr * ar + ni * ai) / den, (ni * ar - nr * ai) / den};
}
__device__ __forceinline__ void phase_s5_ktab(const P& p) {
  float* ktab = (float*)(p.ws + WS_KTAB);
  const int gtid = blockIdx.x * NTHR + threadIdx.x, gsz = gridDim.x * NTHR;
  for (int item = gtid; item < 32 * 2 * 32 * 16; item += gsz) {
    const int c = item & 15, l = (item >> 4) & 31, dir = (item >> 9) & 1, g = item >> 10;
    const float dt = expf(p.log_step[dir * 32 + g]);
    float acc[16];
#pragma unroll
    for (int j = 0; j < 16; ++j) acc[j] = 0.f;
    for (int q = 0; q < 64; ++q) {
      const float ar = p.a_re[(dir * 32 + g) * 64 + q], ai = p.a_im[(dir * 32 + g) * 64 + q];
      const Cpx L = s5_lam_pow(ar, ai, dt, (float)l), cf = s5_coef(ar, ai, dt);
      const Cpx C = {p.c_re[((dir * 32 + g) * 16 + c) * 64 + q], p.c_im[((dir * 32 + g) * 16 + c) * 64 + q]};
      const Cpx w = cmul(cmul(C, L), cf);
#pragma unroll
      for (int j = 0; j < 16; ++j) acc[j] += w.re * p.b_re[(g * 64 + q) * 16 + j] - w.im * p.b_im[(g * 64 + q) * 16 + j];
    }
#pragma unroll
    for (int j = 0; j < 16; j += 4) *(f32x4*)(ktab + (size_t)item * 16 + j) = (f32x4){acc[j], acc[j + 1], acc[j + 2], acc[j + 3]};
  }
}
__device__ __forceinline__ void phase_s5_fill(const P& p) {
  const float* ktab = (const float*)(p.ws + WS_KTAB);
  u16* bty = (u16*)(p.ws + WS_BTY); u16* wet = (u16*)(p.ws + WS_WET);
  const int gtid = blockIdx.x * NTHR + threadIdx.x, gsz = gridDim.x * NTHR;
  for (int item = gtid; item < 32 * 512 * 64; item += gsz) {
    const int ch = item & 63, n = (item >> 6) & 511, g = item >> 15;
    const int ip = ch >> 1, c0 = (ch & 1) * 8, i = n >> 4, c = n & 15;
    float v[8];
    if (ip != i) {
      const int dir = ip < i ? 0 : 1, l = ip < i ? i - ip : ip - i;
      const float* src = ktab + ((size_t)((g * 2 + dir) * 32 + l) * 16 + c) * 16 + c0;
      const f32x4 a = *(const f32x4*)src, b = *(const f32x4*)(src + 4);
      v[0] = a[0]; v[1] = a[1]; v[2] = a[2]; v[3] = a[3]; v[4] = b[0]; v[5] = b[1]; v[6] = b[2]; v[7] = b[3];
    } else {
      const float* s0 = ktab + ((size_t)((g * 2 + 0) * 32) * 16 + c) * 16 + c0;
      const float* s1 = ktab + ((size_t)((g * 2 + 1) * 32) * 16 + c) * 16 + c0;
      const float dd = p.s5d[g * 16 + c];
#pragma unroll
      for (int j = 0; j < 8; ++j) v[j] = s0[j] + s1[j] + ((c0 + j) == c ? dd : 0.f);
    }
    *(uint4*)(bty + ((size_t)g * 512 + n) * 768 + ch * 8) = make_uint4(pk2(v[0], v[1]), pk2(v[2], v[3]), pk2(v[4], v[5]), pk2(v[6], v[7]));
  }
  for (int item = gtid; item < 32 * 512 * 32; item += gsz) {
    const int ch = item & 31, n = (item >> 5) & 511, g = item >> 14;
    const int kk = ch * 8, dir = kk >> 7, p0 = (kk & 127) >> 1, i = n >> 4, c = n & 15;
    const float dt = expf(p.log_step[dir * 32 + g]), e = dir ? (float)(32 - i) : (float)(i + 1);
    float v[8];
#pragma unroll
    for (int q = 0; q < 4; ++q) {
      const int pq = p0 + q;
      const float ar = p.a_re[(dir * 32 + g) * 64 + pq], ai = p.a_im[(dir * 32 + g) * 64 + pq];
      const Cpx L = s5_lam_pow(ar, ai, dt, e);
      const Cpx C = {p.c_re[((dir * 32 + g) * 16 + c) * 64 + pq], p.c_im[((dir * 32 + g) * 16 + c) * 64 + pq]};
      const Cpx w = cmul(C, L);
      v[2 * q] = w.re; v[2 * q + 1] = -w.im;
    }
    *(uint4*)(bty + ((size_t)g * 512 + n) * 768 + 512 + kk) = make_uint4(pk2(v[0], v[1]), pk2(v[2], v[3]), pk2(v[4], v[5]), pk2(v[6], v[7]));
  }
  for (int item = gtid; item < 32 * 256 * 64; item += gsz) {
    const int ch = item & 63, n = (item >> 6) & 255, g = item >> 14;
    const int ip = ch >> 1, c0 = (ch & 1) * 8, ri = n & 1, pq = (n >> 1) & 63, dir = n >> 7;
    const float dt = expf(p.log_step[dir * 32 + g]), e = dir ? (float)ip : (float)(31 - ip);
    const float ar = p.a_re[(dir * 32 + g) * 64 + pq], ai = p.a_im[(dir * 32 + g) * 64 + pq];
    const Cpx w = cmul(s5_lam_pow(ar, ai, dt, e), s5_coef(ar, ai, dt));
    float v[8];
#pragma unroll
    for (int j = 0; j < 8; ++j) {
      const float br = p.b_re[(g * 64 + pq) * 16 + c0 + j], bi = p.b_im[(g * 64 + pq) * 16 + c0 + j];
      v[j] = ri ? (w.re * bi + w.im * br) : (w.re * br - w.im * bi);
    }
    *(uint4*)(wet + ((size_t)g * 256 + n) * 512 + ch * 8) = make_uint4(pk2(v[0], v[1]), pk2(v[2], v[3]), pk2(v[4], v[5]), pk2(v[6], v[7]));
  }
}
__device__ __forceinline__ void phase_s5_egemm(const P& p, char* smem) {
  float* E = (float*)(p.ws + WS_E);
  for (int t = blockIdx.x; t < 32 * 8; t += gridDim.x) {
    const int g = t >> 3, mt = (t >> 1) & 3, nt = t & 1;
    GemmDesc d{}; d.A = (const u16*)(p.ws + WS_A2) + (size_t)g * 512 * 768; d.lda = 768; d.mvalid = 512;
    d.Bt = (const u16*)(p.ws + WS_WET) + (size_t)g * 256 * 512; d.ldb = 512; d.K = 512;
    gemm_tile(d, mt * 128, nt * 128, [&](f32x4 (&acc)[4][4], int row0, int col0) {
#pragma unroll
      for (int m = 0; m < 4; ++m)
#pragma unroll
        for (int n = 0; n < 4; ++n) *(f32x4*)(E + ((size_t)g * 512 + row0 + m * 16) * 256 + col0 + n * 16) = acc[m][n];
    }, smem);
  }
}
__device__ __forceinline__ void phase_s5_carry(const P& p) {
  const float* E = (const float*)(p.ws + WS_E);
  u16* a2 = (u16*)(p.ws + WS_A2);
  const int gtid = blockIdx.x * NTHR + threadIdx.x, gsz = gridDim.x * NTHR;
  for (int idx = gtid; idx < 32 * 8 * 128; idx += gsz) {
    const int pq = idx & 63, dir = (idx >> 6) & 1, b = (idx >> 7) & 7, g = idx >> 10;
    const float dt = expf(p.log_step[dir * 32 + g]);
    const Cpx L = s5_lam_pow(p.a_re[(dir * 32 + g) * 64 + pq], p.a_im[(dir * 32 + g) * 64 + pq], dt, 32.0f);
    Cpx s = {0.f, 0.f};
    for (int jj = 0; jj < 64; ++jj) {
      const int j = dir ? 63 - jj : jj, r = b * 64 + j;
      const f32x2 e = *(const f32x2*)(E + ((size_t)g * 512 + r) * 256 + (dir * 64 + pq) * 2);
      *(unsigned*)(a2 + ((size_t)g * 512 + r) * 768 + 512 + (dir * 64 + pq) * 2) = pk2(s.re, s.im);
      const Cpx ns = cmul(L, s);
      s.re = ns.re + e[0]; s.im = ns.im + e[1];
    }
  }
}
__device__ __forceinline__ void phase_s5_ygemm(const P& p, char* smem) {
  u16* ygelu = (u16*)(p.ws + WS_YGELU);
  for (int t = blockIdx.x; t < 32 * 16; t += gridDim.x) {
    const int g = t >> 4, mt = (t >> 2) & 3, nt = t & 3;
    GemmDesc d{}; d.A = (const u16*)(p.ws + WS_A2) + (size_t)g * 512 * 768; d.lda = 768; d.mvalid = 512;
    d.Bt = (const u16*)(p.ws + WS_BTY) + (size_t)g * 512 * 768; d.ldb = 768; d.K = 768;
    gemm_tile(d, mt * 128, nt * 128, [&](f32x4 (&acc)[4][4], int row0, int col0) {
#pragma unroll
      for (int m = 0; m < 4; ++m)
#pragma unroll
        for (int n = 0; n < 4; ++n) {
          const int row = row0 + m * 16, col = col0 + n * 16;
          uint2 w; w.x = pk2(gelu_tanh(acc[m][n][0]), gelu_tanh(acc[m][n][1])); w.y = pk2(gelu_tanh(acc[m][n][2]), gelu_tanh(acc[m][n][3]));
          *(uint2*)(ygelu + ((size_t)row * 32 + (col >> 4)) * 512 + g * 16 + (col & 15)) = w;
        }
    }, smem);
  }
}

__device__ __forceinline__ void phase_glu(const P& p, char* smem) {
  const u16* yg = (const u16*)(p.ws + WS_YGELU); u16* ycat = (u16*)(p.ws + WS_YCAT);
  GemmDesc g{}; g.A = yg; g.lda = 512; g.mvalid = T_TOK; g.W = p.w_glu; g.ldw = 512; g.K = 512;
  for (int t = blockIdx.x; t < 128 * 4; t += gridDim.x) {
    const int mt = t >> 2, nt = t & 3;
    gemm_tile(g, mt * 128, nt * 128, [&](f32x4 (&acc)[4][4], int row0, int col0) {
#pragma unroll
      for (int m = 0; m < 4; ++m)
#pragma unroll
        for (int n = 0; n < 4; ++n) {
          const int row = row0 + m * 16, col = col0 + n * 16;
          const uint2 yv = *(const uint2*)(yg + (size_t)row * 512 + col);
          const f32x4 bb = *(const f32x4*)(p.b_glu + col);
          const float y0 = lo16(yv.x) * sigmoidf_(acc[m][n][0] + bb[0]), y1 = hi16(yv.x) * sigmoidf_(acc[m][n][1] + bb[1]);
          const float y2 = lo16(yv.y) * sigmoidf_(acc[m][n][2] + bb[2]), y3 = hi16(yv.y) * sigmoidf_(acc[m][n][3] + bb[3]);
          uint2 w; w.x = pk2(y0, y1); w.y = pk2(y2, y3);
          *(uint2*)(ycat + (size_t)row * DM + 512 + col) = w;
        }
    }, smem);
  }
}

__device__ __forceinline__ void phase_outproj(const P& p, const u16* A, const float* W, const float* xin, float* xout, char* smem) {
  GemmDesc g{}; g.A = A; g.lda = DM; g.mvalid = T_TOK; g.W = W; g.ldw = DM; g.K = DM;
  for (int t = blockIdx.x; t < 128 * 8; t += gridDim.x) {
    const int mt = t >> 3, nt = t & 7;
    gemm_tile(g, mt * 128, nt * 128, [&](f32x4 (&acc)[4][4], int row0, int col0) {
#pragma unroll
      for (int m = 0; m < 4; ++m)
#pragma unroll
        for (int n = 0; n < 4; ++n) {
          const size_t o = (size_t)(row0 + m * 16) * DM + col0 + n * 16;
          const f32x4 xv = *(const f32x4*)(xin + o);
          *(f32x4*)(xout + o) = xv + acc[m][n];
        }
    }, smem);
  }
}

__device__ __forceinline__ void phase_qkv(const P& p, char* smem) {
  GemmDesc g{}; g.A = (const u16*)(p.ws + WS_XB); g.lda = DM; g.mvalid = T_TOK; g.W = p.w_qkv; g.ldw = 1536; g.K = DM;
  u16* q1 = (u16*)(p.ws + WS_Z); u16* k1 = (u16*)(p.ws + WS_Z + 32 * MB); u16* v1 = (u16*)(p.ws + WS_Z + 40 * MB);
  for (int t = blockIdx.x; t < 128 * 12; t += gridDim.x) {
    const int mt = t / 12, nt = t % 12;
    gemm_tile(g, mt * 128, nt * 128, [&](f32x4 (&acc)[4][4], int row0, int col0) {
#pragma unroll
      for (int m = 0; m < 4; ++m)
#pragma unroll
        for (int n = 0; n < 4; ++n) {
          const int row = row0 + m * 16, col = col0 + n * 16;
          uint2 w;
          if (nt < 8) { w.x = pk2(acc[m][n][0] * 0.125f, acc[m][n][1] * 0.125f); w.y = pk2(acc[m][n][2] * 0.125f, acc[m][n][3] * 0.125f); *(uint2*)(q1 + (size_t)row * DM + col) = w; }
          else {
            w.x = pk2(acc[m][n][0], acc[m][n][1]); w.y = pk2(acc[m][n][2], acc[m][n][3]);
            if (nt < 10) *(uint2*)(k1 + (size_t)row * 256 + (col - 1024)) = w; else *(uint2*)(v1 + (size_t)row * 256 + (col - 1280)) = w;
          }
        }
    }, smem);
  }
}

struct MoeTile { int e, rt, ct, cnt, hbase; };
__device__ __forceinline__ bool moe_decode(const int* cnt, int t, MoeTile& mt) {
  int base = 0, hb = 0;
  for (int e = 0; e < 32; ++e) {
    const int c = cnt[e], nt = (c + 127) >> 7, span = nt * 8;
    if (t < base + span) { const int loc = t - base; mt.e = e; mt.rt = loc % nt; mt.ct = loc / nt; mt.cnt = c; mt.hbase = hb; return true; }
    base += span; hb += nt * 128;
  }
  return false;
}
__device__ __forceinline__ void phase_moe1(const P& p, int layer, char* smem) {
  const int* cnt = (const int*)(p.ws + WS_CNT) + layer * 32;
  const int* list = (const int*)(p.ws + WS_LIST);
  u16* hbuf = (u16*)(p.ws + WS_H);
  for (int t = blockIdx.x;; t += gridDim.x) {
    MoeTile mt; if (!moe_decode(cnt, t, mt)) break;
    GemmDesc g{}; g.A = (const u16*)(p.ws + WS_XB); g.lda = DM; g.rowmap = list + (size_t)mt.e * CAP; g.rowshift = 1; g.mvalid = mt.cnt;
    g.W = p.w_gate + (size_t)(layer * 32 + mt.e) * DM * 512; g.W2 = p.w_up + (size_t)(layer * 32 + mt.e) * DM * 512; g.ldw = 512; g.K = DM;
    gemm_tile(g, mt.rt * 128, mt.ct * 128, [&](f32x4 (&acc)[4][4], int row0, int col0) {
      const int ocol0 = (col0 >> 6) * 32 + (col0 & 31);
#pragma unroll
      for (int m = 0; m < 4; ++m) {
        const int row = row0 + m * 16;
        if (row < mt.cnt) {
#pragma unroll
          for (int nn = 0; nn < 2; ++nn) {
            float hv[4];
#pragma unroll
            for (int r = 0; r < 4; ++r) { const float gt = acc[m][nn][r]; hv[r] = gt * sigmoidf_(gt) * acc[m][nn + 2][r]; }
            uint2 w; w.x = pk2(hv[0], hv[1]); w.y = pk2(hv[2], hv[3]);
            *(uint2*)(hbuf + (size_t)(mt.hbase + row) * 512 + ocol0 + nn * 16) = w;
          }
        }
      }
    }, smem);
  }
}
__device__ __forceinline__ void phase_moe2(const P& p, int layer, char* smem) {
  const int* cnt = (const int*)(p.ws + WS_CNT) + layer * 32;
  const int* list = (const int*)(p.ws + WS_LIST);
  const float* gate = (const float*)(p.ws + WS_GATE);
  const u16* hbuf = (const u16*)(p.ws + WS_H);
  u16* slots = (u16*)(p.ws + WS_INC);
  for (int t = blockIdx.x;; t += gridDim.x) {
    MoeTile mt; if (!moe_decode(cnt, t, mt)) break;
    GemmDesc g{}; g.A = hbuf + (size_t)mt.hbase * 512; g.lda = 512; g.mvalid = mt.cnt;
    g.W = p.w_down + (size_t)(layer * 32 + mt.e) * 512 * DM; g.ldw = DM; g.K = 512;
    gemm_tile(g, mt.rt * 128, mt.ct * 128, [&](f32x4 (&acc)[4][4], int row0, int col0) {
#pragma unroll
      for (int m = 0; m < 4; ++m) {
        const int row = row0 + m * 16;
        if (row < mt.cnt) {
          const int asg = list[(size_t)mt.e * CAP + row];
          const float gt = gate[asg];
#pragma unroll
          for (int n = 0; n < 4; ++n) {
            uint2 w; w.x = pk2(gt * acc[m][n][0], gt * acc[m][n][1]); w.y = pk2(gt * acc[m][n][2], gt * acc[m][n][3]);
            *(uint2*)(slots + (size_t)asg * DM + col0 + n * 16) = w;
          }
        }
      }
    }, smem);
  }
}

constexpr int KSTR = 72;
__device__ __forceinline__ int t5_bucket_abs(int n) {
  return n < 8 ? n : 8 + (n >= 12) + (n >= 16) + (n >= 23) + (n >= 32) + (n >= 46) + (n >= 64) + (n >= 91);
}
__device__ __forceinline__ void phase_attn_naive(const P& p, char* smem) {
  u16* sK = (u16*)smem; u16* sV = sK + 384 * KSTR; float* sBias = (float*)(sV + 384 * KSTR);
  const u16* q1 = (const u16*)(p.ws + WS_Z); const u16* k1 = (const u16*)(p.ws + WS_Z + 32 * MB); const u16* v1 = (const u16*)(p.ws + WS_Z + 40 * MB);
  u16* ao = (u16*)(p.ws + WS_YCAT);
  const int tid = threadIdx.x;
  for (int item = blockIdx.x; item < 512; item += gridDim.x) {
    const int b = item >> 6, nb = (item >> 2) & 15, kvh = item & 3;
    __syncthreads();
    for (int c = tid; c < 384 * 8; c += NTHR) {
      const int s = c >> 3, ch = (c & 7) * 8, pos = (nb - 1) * 128 + s;
      uint4 kq = make_uint4(0u, 0u, 0u, 0u), vq = kq;
      if (pos >= 0 && pos < SEQ) { kq = *(const uint4*)(k1 + (size_t)(b * SEQ + pos) * 256 + kvh * 64 + ch); vq = *(const uint4*)(v1 + (size_t)(b * SEQ + pos) * 256 + kvh * 64 + ch); }
      *(uint4*)(sK + s * KSTR + ch) = kq; *(uint4*)(sV + s * KSTR + ch) = vq;
    }
    for (int c = tid; c < 4 * 257; c += NTHR) {
      const int hq = c / 257, ri = c % 257, rel = ri - 128, n = rel < 0 ? -rel : rel;
      const int bucket = (rel > 0 ? 16 : 0) + t5_bucket_abs(n);
      sBias[hq * 260 + ri] = p.rel_bias[bucket * 16 + kvh * 4 + hq];
    }
    __syncthreads();
    for (int pass = 0; pass < 2; ++pass) {
      const int hq = pass * 2 + (tid >> 7), qi = tid & 127, head = kvh * 4 + hq;
      const size_t tok = (size_t)b * SEQ + nb * 128 + qi;
      float q[64];
#pragma unroll
      for (int d = 0; d < 64; d += 8) {
        const uint4 qq = *(const uint4*)(q1 + tok * DM + head * 64 + d);
        q[d] = lo16(qq.x); q[d + 1] = hi16(qq.x); q[d + 2] = lo16(qq.y); q[d + 3] = hi16(qq.y); q[d + 4] = lo16(qq.z); q[d + 5] = hi16(qq.z); q[d + 6] = lo16(qq.w); q[d + 7] = hi16(qq.w);
      }
      float mx = p.sink[head], l = 1.0f, o[64];
#pragma unroll
      for (int d = 0; d < 64; ++d) o[d] = 0.f;
      for (int r = 0; r <= 256; ++r) {
        const int s = qi + r, pos = (nb - 1) * 128 + s;
        if (pos < 0 || pos >= SEQ) continue;
        float sc = 0.f;
#pragma unroll
        for (int d = 0; d < 64; d += 8) {
          const uint4 kq = *(const uint4*)(sK + s * KSTR + d);
          sc += q[d] * lo16(kq.x) + q[d + 1] * hi16(kq.x) + q[d + 2] * lo16(kq.y) + q[d + 3] * hi16(kq.y) + q[d + 4] * lo16(kq.z) + q[d + 5] * hi16(kq.z) + q[d + 6] * lo16(kq.w) + q[d + 7] * hi16(kq.w);
        }
        sc += sBias[hq * 260 + r];
        const float mn = fmaxf(mx, sc), alpha = __expf(mx - mn), pe = __expf(sc - mn);
        l = l * alpha + pe; mx = mn;
#pragma unroll
        for (int d = 0; d < 64; d += 8) {
          const uint4 vq = *(const uint4*)(sV + s * KSTR + d);
          o[d] = o[d] * alpha + pe * lo16(vq.x); o[d + 1] = o[d + 1] * alpha + pe * hi16(vq.x); o[d + 2] = o[d + 2] * alpha + pe * lo16(vq.y); o[d + 3] = o[d + 3] * alpha + pe * hi16(vq.y);
          o[d + 4] = o[d + 4] * alpha + pe * lo16(vq.z); o[d + 5] = o[d + 5] * alpha + pe * hi16(vq.z); o[d + 6] = o[d + 6] * alpha + pe * lo16(vq.w); o[d + 7] = o[d + 7] * alpha + pe * hi16(vq.w);
        }
      }
      const float inv = 1.0f / l;
#pragma unroll
      for (int d = 0; d < 64; d += 8) {
        uint4 w; w.x = pk2(o[d] * inv, o[d + 1] * inv); w.y = pk2(o[d + 2] * inv, o[d + 3] * inv); w.z = pk2(o[d + 4] * inv, o[d + 5] * inv); w.w = pk2(o[d + 6] * inv, o[d + 7] * inv);
        *(uint4*)(ao + tok * DM + head * 64 + d) = w;
      }
    }
  }
}

constexpr int VSTR = 392;
__device__ __forceinline__ void phase_attn(const P& p, char* smem) {
  u16* sK = (u16*)smem; u16* sVt = sK + 384 * KSTR; float* sBias = (float*)(sVt + 64 * VSTR);
  const u16* q1 = (const u16*)(p.ws + WS_Z); const u16* k1 = (const u16*)(p.ws + WS_Z + 32 * MB); const u16* v1 = (const u16*)(p.ws + WS_Z + 40 * MB);
  u16* ao = (u16*)(p.ws + WS_YCAT);
  const int tid = threadIdx.x, lane = tid & 63, wv = tid >> 6, fr = lane & 15, lg = lane >> 4, q0 = wv * 32;
  for (int item = blockIdx.x; item < 512; item += gridDim.x) {
    const int b = item >> 6, nb = (item >> 2) & 15, kvh = item & 3;
    __syncthreads();
    for (int c = tid; c < 384 * 8; c += NTHR) {
      const int s = c >> 3, ch = (c & 7) * 8, pos = (nb - 1) * 128 + s;
      uint4 kq = make_uint4(0u, 0u, 0u, 0u), vq = kq;
      if (pos >= 0 && pos < SEQ) { kq = *(const uint4*)(k1 + (size_t)(b * SEQ + pos) * 256 + kvh * 64 + ch); vq = *(const uint4*)(v1 + (size_t)(b * SEQ + pos) * 256 + kvh * 64 + ch); }
      *(uint4*)(sK + s * KSTR + ch) = kq;
      const unsigned vw[4] = {vq.x, vq.y, vq.z, vq.w};
#pragma unroll
      for (int j = 0; j < 4; ++j) { sVt[(ch + 2 * j) * VSTR + s] = (u16)(vw[j] & 0xffffu); sVt[(ch + 2 * j + 1) * VSTR + s] = (u16)(vw[j] >> 16); }
    }
    for (int c = tid; c < 4 * 257; c += NTHR) {
      const int hq = c / 257, ri = c % 257, rel = ri - 128, n = rel < 0 ? -rel : rel;
      const int bucket = (rel > 0 ? 16 : 0) + t5_bucket_abs(n);
      sBias[hq * 260 + ri] = p.rel_bias[bucket * 16 + kvh * 4 + hq];
    }
    __syncthreads();
    for (int hq = 0; hq < 4; ++hq) {
      const int head = kvh * 4 + hq;
      const size_t tok0 = (size_t)b * SEQ + nb * 128 + q0;
      uint4 qf[2][2];
#pragma unroll
      for (int qb = 0; qb < 2; ++qb)
#pragma unroll
        for (int ks = 0; ks < 2; ++ks) qf[qb][ks] = *(const uint4*)(q1 + (tok0 + qb * 16 + fr) * DM + head * 64 + ks * 32 + lg * 8);
      f32x4 O[4][2];
#pragma unroll
      for (int mb = 0; mb < 4; ++mb)
#pragma unroll
        for (int qb = 0; qb < 2; ++qb) O[mb][qb] = (f32x4){0.f, 0.f, 0.f, 0.f};
      const float sinkv = p.sink[head];
      float mrun[2] = {sinkv, sinkv}, lpart[2] = {lg == 0 ? 1.0f : 0.0f, lg == 0 ? 1.0f : 0.0f};
#pragma unroll
      for (int c = 0; c < 3; ++c) {
        if ((c == 0 && nb == 0) || (c == 2 && nb == 15)) continue;
        f32x4 S[8][2];
#pragma unroll
        for (int kb = 0; kb < 8; ++kb) {
          S[kb][0] = (f32x4){0.f, 0.f, 0.f, 0.f}; S[kb][1] = S[kb][0];
          const bool act = (c == 0) ? (16 * kb + 15 >= q0) : ((c == 2) ? (16 * kb <= q0 + 31) : true);
          if (act) {
#pragma unroll
            for (int ks = 0; ks < 2; ++ks) {
              const uint4 kf = *(const uint4*)(sK + (c * 128 + kb * 16 + fr) * KSTR + ks * 32 + lg * 8);
              S[kb][0] = mfma16(kf, qf[0][ks], S[kb][0]);
              S[kb][1] = mfma16(kf, qf[1][ks], S[kb][1]);
            }
          }
        }
        float cmax[2] = {-1e30f, -1e30f};
#pragma unroll
        for (int kb = 0; kb < 8; ++kb)
#pragma unroll
          for (int qb = 0; qb < 2; ++qb)
#pragma unroll
            for (int r = 0; r < 4; ++r) {
              const int sidx = c * 128 + kb * 16 + 4 * lg + r, qi = q0 + qb * 16 + fr, rel = sidx - 128 - qi;
              const bool valid = (rel >= -128) && (rel <= 128);
              const float v = valid ? S[kb][qb][r] + sBias[hq * 260 + (valid ? rel + 128 : 0)] : -1e30f;
              S[kb][qb][r] = v; cmax[qb] = fmaxf(cmax[qb], v);
            }
#pragma unroll
        for (int qb = 0; qb < 2; ++qb) {
          cmax[qb] = fmaxf(cmax[qb], __shfl_xor(cmax[qb], 16)); cmax[qb] = fmaxf(cmax[qb], __shfl_xor(cmax[qb], 32));
          const float mn = fmaxf(mrun[qb], cmax[qb]), alpha = __expf(mrun[qb] - mn);
          mrun[qb] = mn; lpart[qb] *= alpha;
#pragma unroll
          for (int mb = 0; mb < 4; ++mb) O[mb][qb] = O[mb][qb] * alpha;
          float ps = 0.f;
#pragma unroll
          for (int kb = 0; kb < 8; ++kb)
#pragma unroll
            for (int r = 0; r < 4; ++r) { const float e = __expf(S[kb][qb][r] - mn); S[kb][qb][r] = e; ps += e; }
          lpart[qb] += ps;
        }
#pragma unroll
        for (int kk = 0; kk < 4; ++kk) {
          const int kb0 = 2 * kk, kb1 = 2 * kk + 1;
          const bool act = (c == 0) ? (16 * kb1 + 15 >= q0) : ((c == 2) ? (16 * kb0 <= q0 + 31) : true);
          if (act) {
            uint4 pf[2];
#pragma unroll
            for (int qb = 0; qb < 2; ++qb) pf[qb] = make_uint4(pk2(S[kb0][qb][0], S[kb0][qb][1]), pk2(S[kb0][qb][2], S[kb0][qb][3]), pk2(S[kb1][qb][0], S[kb1][qb][1]), pk2(S[kb1][qb][2], S[kb1][qb][3]));
#pragma unroll
            for (int mb = 0; mb < 4; ++mb) {
              const uint2 v0 = *(const uint2*)(sVt + (mb * 16 + fr) * VSTR + c * 128 + kb0 * 16 + 4 * lg);
              const uint2 v1r = *(const uint2*)(sVt + (mb * 16 + fr) * VSTR + c * 128 + kb1 * 16 + 4 * lg);
              const uint4 vf = make_uint4(v0.x, v0.y, v1r.x, v1r.y);
              O[mb][0] = mfma16(vf, pf[0], O[mb][0]);
              O[mb][1] = mfma16(vf, pf[1], O[mb][1]);
            }
          }
        }
      }
#pragma unroll
      for (int qb = 0; qb < 2; ++qb) {
        float lt = lpart[qb]; lt += __shfl_xor(lt, 16); lt += __shfl_xor(lt, 32);
        const float inv = 1.0f / lt;
#pragma unroll
        for (int mb = 0; mb < 4; ++mb) {
          uint2 w; w.x = pk2(O[mb][qb][0] * inv, O[mb][qb][1] * inv); w.y = pk2(O[mb][qb][2] * inv, O[mb][qb][3] * inv);
          *(uint2*)(ao + (tok0 + qb * 16 + fr) * DM + head * 64 + mb * 16 + 4 * lg) = w;
        }
      }
    }
  }
}

constexpr int NPHASE = 20;
constexpr int LDS_BYTES = 141312;
__device__ __forceinline__ void run_phase(const P& p, int ph, char* smem) {
  float* xa = (float*)(p.ws + WS_XA);
  const u16* ycat = (const u16*)(p.ws + WS_YCAT);
  const u16* slots = (const u16*)(p.ws + WS_INC);
  switch (ph) {
    case 0: phase_prep(p); phase_s5_ktab(p); break;
    case 1: phase_rowpass(p, p.x, nullptr, nullptr, p.norm_mix_g, -1, nullptr); phase_s5_fill(p); break;
    case 2: phase_inproj(p, smem); break;
    case 3: phase_ret_inc(p, smem); phase_s5_egemm(p, smem); break;
    case 4: phase_ret_scan(p); phase_s5_carry(p); break;
    case 5: phase_ret_out(p, smem); phase_s5_ygemm(p, smem); break;
    case 6: break;
    case 7: phase_glu(p, smem); break;
    case 8: phase_outproj(p, ycat, p.w_out, p.x, xa, smem); break;
    case 9: phase_rowpass(p, xa, nullptr, nullptr, p.norm_ffn_g, 0, nullptr); break;
    case 10: phase_moe1(p, 0, smem); break;
    case 11: phase_moe2(p, 0, smem); break;
    case 12: phase_rowpass(p, xa, slots, xa, p.norm_mix_g + DM, -1, nullptr); break;
    case 13: phase_qkv(p, smem); break;
    case 14: phase_attn(p, smem); break;
    case 15: phase_outproj(p, ycat, p.w_o, xa, xa, smem); break;
    case 16: phase_rowpass(p, xa, nullptr, nullptr, p.norm_ffn_g + DM, 1, nullptr); break;
    case 17: phase_moe1(p, 1, smem); break;
    case 18: phase_moe2(p, 1, smem); break;
    case 19: phase_rowpass(p, xa, slots, nullptr, p.norm_final_g, -1, p.out); break;
    default: break;
  }
}

extern __shared__ __attribute__((aligned(16))) char dyn_smem[];

#if MULTI_LAUNCH
__global__ void __launch_bounds__(NTHR) k_phase(P p, int ph) { run_phase(p, ph, dyn_smem); }
#else

template <int PH> __device__ __forceinline__ void mega_steps(const P& p, char* smem, cg::grid_group& grid) {
  run_phase(p, PH, smem);
  if constexpr (PH + 1 < NPHASE) { grid.sync(); mega_steps<PH + 1>(p, smem, grid); }
}
__global__ void __launch_bounds__(NTHR) k_mega(P p) {
  cg::grid_group grid = cg::this_grid();
  mega_steps<0>(p, dyn_smem, grid);
}
#endif

extern "C" void kernel_launch(void* const* d_in, const int* in_sizes, int n_in, void* d_out, int out_size, void* d_ws, size_t ws_size, hipStream_t stream) {
  static int grid_blocks = 0;
  if (grid_blocks == 0) {
    if (n_in != 28 || out_size != T_TOK * DM || ws_size < WS_END) { fprintf(stderr, "kernel_launch: unexpected problem (n_in %d out %d ws %zu need %zu)\n", n_in, out_size, ws_size, (size_t)WS_END); grid_blocks = -1; return; }
    int dev = 0, cus = 0, per_cu = 0;
    (void)hipGetDevice(&dev);
    (void)hipDeviceGetAttribute(&cus, hipDeviceAttributeMultiprocessorCount, dev);
#if MULTI_LAUNCH
    const void* fn = (const void*)k_phase;
#else
    const void* fn = (const void*)k_mega;
#endif
    if (hipFuncSetAttribute(fn, hipFuncAttributeMaxDynamicSharedMemorySize, LDS_BYTES) != hipSuccess) { fprintf(stderr, "kernel_launch: hipFuncSetAttribute failed\n"); }
    if (hipOccupancyMaxActiveBlocksPerMultiprocessor(&per_cu, fn, NTHR, LDS_BYTES) != hipSuccess || per_cu < 1) { fprintf(stderr, "kernel_launch: occupancy query failed (%d)\n", per_cu); per_cu = 1; }
    (void)hipGetLastError();
    grid_blocks = cus * per_cu;
    fprintf(stderr, "kernel_launch: cus %d per_cu %d grid %d\n", cus, per_cu, grid_blocks);
  }
  if (grid_blocks < 0) return;
  P p{};
  const float** pp = (const float**)&p;
  for (int i = 0; i < 28; ++i) pp[i] = (const float*)d_in[i];
  p.out = (float*)d_out; p.ws = (char*)d_ws;
#if MULTI_LAUNCH
  for (int ph = 0; ph < NPHASE; ++ph) hipLaunchKernelGGL(k_phase, dim3(grid_blocks), dim3(NTHR), LDS_BYTES, stream, p, ph);
#else
  void* args[] = {&p};
  hipError_t e = hipLaunchCooperativeKernel((const void*)k_mega, dim3(grid_blocks), dim3(NTHR), args, LDS_BYTES, stream);
  if (e != hipSuccess) fprintf(stderr, "cooperative launch failed: %s (grid %d)\n", hipGetErrorString(e), grid_blocks);
#endif
}
```

```cpp
#include <hip/hip_runtime.h>
#include <hip/hip_cooperative_groups.h>
#include <cstdio>
#include <cstdint>
namespace cg = cooperative_groups;

#ifndef USE_FP16
#define USE_FP16 1
#endif
#ifndef MULTI_LAUNCH
#define MULTI_LAUNCH 0
#endif

typedef unsigned short u16;
typedef float f32x4 __attribute__((ext_vector_type(4)));
typedef float f32x2 __attribute__((ext_vector_type(2)));
typedef _Float16 f16x8 __attribute__((ext_vector_type(8)));
typedef __bf16 b16x8 __attribute__((ext_vector_type(8)));

constexpr int T_TOK = 16384, DM = 1024, SEQ = 2048, NBATCH = 8;
constexpr int CAP = 32768;
constexpr int NTHR = 256;

constexpr size_t MB = 1024ull * 1024ull;
constexpr size_t WS_XA    = 0;
constexpr size_t WS_XB    = WS_XA + 64 * MB;
constexpr size_t WS_Z     = WS_XB + 32 * MB;
constexpr size_t WS_A2    = WS_Z + 64 * MB;
constexpr size_t WS_INC   = WS_A2 + 24 * MB;
constexpr size_t WS_YCAT  = WS_INC + 64 * MB;
constexpr size_t WS_YGELU = WS_YCAT + 32 * MB;
constexpr size_t WS_H     = WS_YGELU + 16 * MB;
constexpr size_t WS_LIST  = WS_H + 36 * MB;
constexpr size_t WS_GATE  = WS_LIST + 4 * MB;
constexpr size_t WS_ROPE  = WS_GATE + 1 * MB;
constexpr size_t WS_CNT   = WS_ROPE + 1 * MB;
constexpr size_t WS_KTAB  = WS_CNT + 1 * MB;
constexpr size_t WS_BTY   = WS_KTAB + 2 * MB;
constexpr size_t WS_WET   = WS_BTY + 24 * MB;
constexpr size_t WS_E     = WS_WET + 8 * MB;
constexpr size_t WS_SP16  = WS_E + 16 * MB;
constexpr size_t WS_END   = WS_SP16 + 32 * MB;

struct P {
  const float *x, *norm_mix_g, *norm_ffn_g, *norm_final_g, *w_in, *ret_decay, *a_re, *a_im, *log_step, *b_re, *b_im, *c_re, *c_im,
      *s5d, *w_glu, *b_glu, *w_out, *w_qkv, *sink, *w_o, *rel_bias, *w_group, *b_group, *w_er, *b_er, *w_gate, *w_up, *w_down;
  float* out;
  char* ws;
};

__device__ __forceinline__ u16 f2h(float f) {
#if USE_FP16
  _Float16 h = (_Float16)f; return __builtin_bit_cast(u16, h);
#else
  unsigned u = __builtin_bit_cast(unsigned, f); u += 0x7fffu + ((u >> 16) & 1u); return (u16)(u >> 16);
#endif
}
__device__ __forceinline__ float h2f(u16 h) {
#if USE_FP16
  return (float)__builtin_bit_cast(_Float16, h);
#else
  return __builtin_bit_cast(float, ((unsigned)h) << 16);
#endif
}
__device__ __forceinline__ unsigned pk2(float a, float b) { return (unsigned)f2h(a) | ((unsigned)f2h(b) << 16); }
__device__ __forceinline__ float lo16(unsigned w) { return h2f((u16)(w & 0xffffu)); }
__device__ __forceinline__ float hi16(unsigned w) { return h2f((u16)(w >> 16)); }
__device__ __forceinline__ f32x4 mfma16(uint4 a, uint4 b, f32x4 c) {
#if USE_FP16
  return __builtin_amdgcn_mfma_f32_16x16x32_f16(__builtin_bit_cast(f16x8, a), __builtin_bit_cast(f16x8, b), c, 0, 0, 0);
#else
  return __builtin_amdgcn_mfma_f32_16x16x32_bf16(__builtin_bit_cast(b16x8, a), __builtin_bit_cast(b16x8, b), c, 0, 0, 0);
#endif
}
__device__ __forceinline__ float wave_sum(float v) {
#pragma unroll
  for (int o = 1; o < 64; o <<= 1) v += __shfl_xor(v, o);
  return v;
}
__device__ __forceinline__ float sigmoidf_(float x) { return 1.0f / (1.0f + __expf(-x)); }
__device__ __forceinline__ float gelu_tanh(float x) {
  const float u = 0.7978845608028654f * (x + 0.044715f * x * x * x);
  return 0.5f * x * (1.0f + tanhf(u));
}

struct GemmDesc {
  const u16* A; long lda;
  const int* rowmap; int rowshift;
  int mvalid;
  const float* W; const float* W2; long ldw;
  const u16* Bt; long ldb;
  int K;
};
constexpr int LSTR = 40;
constexpr int GEMM_LDS = 2 * 128 * LSTR * 2;

template <class Epi>
__device__ __forceinline__ void gemm_tile(const GemmDesc& g, int m0, int n0, Epi&& epi, char* smem) {
  u16* sA = (u16*)smem;
  u16* sB = sA + 128 * LSTR;
  const int tid = threadIdx.x, lane = tid & 63, wid = tid >> 6, wr = wid >> 1, wc = wid & 1, fr = lane & 15, fq = lane >> 4;
  f32x4 acc[4][4];
#pragma unroll
  for (int m = 0; m < 4; ++m)
#pragma unroll
    for (int n = 0; n < 4; ++n) acc[m][n] = (f32x4){0.f, 0.f, 0.f, 0.f};
  const int ar = tid >> 2, akc = (tid & 3) * 8;
  const u16* ap[2];
#pragma unroll
  for (int i = 0; i < 2; ++i) {
    const int m = m0 + ar + i * 64; const u16* q = nullptr;
    if (m < g.mvalid) { const long row = g.rowmap ? (long)(g.rowmap[m] >> g.rowshift) : (long)m; q = g.A + row * g.lda + akc; }
    ap[i] = q;
  }
  const bool useBt = (g.Bt != nullptr);
  const float* wp = nullptr; const u16* bp[2] = {nullptr, nullptr};
  if (!useBt) {
    const int v = n0 + (tid & 31) * 4;
    if (g.W2) wp = ((((v >> 5) & 1) ? g.W2 : g.W) + ((v >> 6) * 32 + (v & 31)));
    else wp = g.W + v;
    wp += (long)((tid >> 5) * 4) * g.ldw;
  } else {
#pragma unroll
    for (int i = 0; i < 2; ++i) bp[i] = g.Bt + (long)(n0 + ar + i * 64) * g.ldb + akc;
  }
  uint4 ra0, ra1, rb0 = make_uint4(0u, 0u, 0u, 0u), rb1 = rb0; f32x4 rw0 = {0.f, 0.f, 0.f, 0.f}, rw1 = rw0, rw2 = rw0, rw3 = rw0;
#define GEMM_GLOAD(k0_)                                                                                   \
  do {                                                                                                    \
    const int kq_ = (k0_);                                                                                \
    ra0 = ap[0] ? *(const uint4*)(ap[0] + kq_) : make_uint4(0u, 0u, 0u, 0u);                              \
    ra1 = ap[1] ? *(const uint4*)(ap[1] + kq_) : make_uint4(0u, 0u, 0u, 0u);                              \
    if (useBt) { rb0 = *(const uint4*)(bp[0] + kq_); rb1 = *(const uint4*)(bp[1] + kq_); }               \
    else {                                                                                                \
      rw0 = *(const f32x4*)(wp + (long)(kq_ + 0) * g.ldw); rw1 = *(const f32x4*)(wp + (long)(kq_ + 1) * g.ldw); \
      rw2 = *(const f32x4*)(wp + (long)(kq_ + 2) * g.ldw); rw3 = *(const f32x4*)(wp + (long)(kq_ + 3) * g.ldw); \
    }                                                                                                     \
  } while (0)
  GEMM_GLOAD(0);
  for (int k0 = 0; k0 < g.K; k0 += 32) {
    __syncthreads();
    *(uint4*)(sA + ar * LSTR + akc) = ra0; *(uint4*)(sA + (ar + 64) * LSTR + akc) = ra1;
    if (useBt) {
      *(uint4*)(sB + ar * LSTR + akc) = rb0; *(uint4*)(sB + (ar + 64) * LSTR + akc) = rb1;
    } else {
      const int nl = (tid & 31) * 4, kl = (tid >> 5) * 4;
#pragma unroll
      for (int c = 0; c < 4; ++c) {
        uint2 v; v.x = pk2(rw0[c], rw1[c]); v.y = pk2(rw2[c], rw3[c]);
        *(uint2*)(sB + (nl + c) * LSTR + kl) = v;
      }
    }
    __syncthreads();
    if (k0 + 32 < g.K) GEMM_GLOAD(k0 + 32);
    uint4 fa[4], fb[4];
#pragma unroll
    for (int m = 0; m < 4; ++m) fa[m] = *(const uint4*)(sA + (wr * 64 + m * 16 + fr) * LSTR + fq * 8);
#pragma unroll
    for (int n = 0; n < 4; ++n) fb[n] = *(const uint4*)(sB + (wc * 64 + n * 16 + fr) * LSTR + fq * 8);
#pragma unroll
    for (int m = 0; m < 4; ++m)
#pragma unroll
      for (int n = 0; n < 4; ++n) acc[m][n] = mfma16(fb[n], fa[m], acc[m][n]);
  }
  epi(acc, m0 + wr * 64 + fr, n0 + wc * 64 + fq * 4);
}

__device__ __forceinline__ void phase_prep(const P& p) {
  const int gtid = blockIdx.x * NTHR + threadIdx.x, gsz = gridDim.x * NTHR;
  int* cnt = (int*)(p.ws + WS_CNT);
  if (gtid < 64) cnt[gtid] = 0;
  f32x2* rope = (f32x2*)(p.ws + WS_ROPE);
  for (int i = gtid; i < SEQ * 64; i += gsz) {
    const int pos = i >> 6, f = i & 63;
    const float inv = powf(10000.0f, -(float)(2 * f) / 128.0f);
    const float ang = (float)pos * inv;
    float s, c; sincosf(ang, &s, &c);
    rope[i] = (f32x2){c, s};
  }
}

__device__ __forceinline__ void phase_rowpass(const P& p, const float* src, const u16* slots, float* dstx, const float* gain, int route_layer, float* fout) {
  const int lane = threadIdx.x & 63, gw = blockIdx.x * 4 + (threadIdx.x >> 6), nw = gridDim.x * 4;
  u16* xb = (u16*)(p.ws + WS_XB);
  int* cnt = (int*)(p.ws + WS_CNT);
  int* list = (int*)(p.ws + WS_LIST);
  float* gate = (float*)(p.ws + WS_GATE);
  for (int row = gw; row < T_TOK; row += nw) {
    f32x4 v[4];
    float ss = 0.f;
#pragma unroll
    for (int i = 0; i < 4; ++i) {
      const int k = (i * 64 + lane) * 4;
      v[i] = *(const f32x4*)(src + (size_t)row * DM + k);
      if (slots) {
#pragma unroll
        for (int s = 0; s < 2; ++s) {
          const uint2 w = *(const uint2*)(slots + ((size_t)row * 2 + s) * DM + k);
          v[i][0] += lo16(w.x); v[i][1] += hi16(w.x); v[i][2] += lo16(w.y); v[i][3] += hi16(w.y);
        }
      }
      if (dstx) *(f32x4*)(dstx + (size_t)row * DM + k) = v[i];
      ss += v[i][0] * v[i][0] + v[i][1] * v[i][1] + v[i][2] * v[i][2] + v[i][3] * v[i][3];
    }
    ss = wave_sum(ss);
    const float rstd = rsqrtf(ss * (1.0f / DM) + 1e-6f);
#pragma unroll
    for (int i = 0; i < 4; ++i) {
      const int k = (i * 64 + lane) * 4;
      const f32x4 gv = *(const f32x4*)(gain + k);
      v[i] = v[i] * rstd * gv;
      if (fout) *(f32x4*)(fout + (size_t)row * DM + k) = v[i];
      else { uint2 w; w.x = pk2(v[i][0], v[i][1]); w.y = pk2(v[i][2], v[i][3]); *(uint2*)(xb + (size_t)row * DM + k) = w; }
    }
    if (route_layer >= 0) {
      const float* wg = p.w_group + (size_t)route_layer * DM * 4;
      const float* we = p.w_er + (size_t)route_layer * 4 * DM * 8;
      float acc[36];
#pragma unroll
      for (int j = 0; j < 36; ++j) acc[j] = 0.f;
#pragma unroll
      for (int i = 0; i < 4; ++i) {
#pragma unroll
        for (int c = 0; c < 4; ++c) {
          const int k = (i * 64 + lane) * 4 + c;
          const float hv = v[i][c];
          const f32x4 g4 = *(const f32x4*)(wg + (size_t)k * 4);
#pragma unroll
          for (int j = 0; j < 4; ++j) acc[j] += hv * g4[j];
#pragma unroll
          for (int gg = 0; gg < 4; ++gg) {
            const f32x4 e0 = *(const f32x4*)(we + ((size_t)gg * DM + k) * 8);
            const f32x4 e1 = *(const f32x4*)(we + ((size_t)gg * DM + k) * 8 + 4);
#pragma unroll
            for (int j = 0; j < 4; ++j) { acc[4 + gg * 8 + j] += hv * e0[j]; acc[4 + gg * 8 + 4 + j] += hv * e1[j]; }
          }
        }
      }
#pragma unroll
      for (int j = 0; j < 36; ++j) acc[j] = wave_sum(acc[j]);
      if (lane == 0) {
        const float* bg = p.b_group + route_layer * 4;
        const float* be = p.b_er + route_layer * 32;
        float gl[4];
#pragma unroll
        for (int j = 0; j < 4; ++j) gl[j] = acc[j] + bg[j];
        int gs = 0; float gm = gl[0];
#pragma unroll
        for (int j = 1; j < 4; ++j) if (gl[j] > gm) { gm = gl[j]; gs = j; }
        float den = 0.f;
#pragma unroll
        for (int j = 0; j < 4; ++j) den += expf(gl[j] - gm);
        const float pg = 1.0f / den;
        float el[8];
#pragma unroll
        for (int j = 0; j < 8; ++j) {
          float a = acc[4 + j];
#pragma unroll
          for (int gg = 1; gg < 4; ++gg) a = (gs == gg) ? acc[4 + gg * 8 + j] : a;
          el[j] = a + be[gs * 8 + j];
        }
        int i1 = 0; float v1 = el[0];
#pragma unroll
        for (int j = 1; j < 8; ++j) if (el[j] > v1) { v1 = el[j]; i1 = j; }
        int i2 = -1; float v2 = -3.0e38f;
#pragma unroll
        for (int j = 0; j < 8; ++j) if (j != i1 && el[j] > v2) { v2 = el[j]; i2 = j; }
        const float e2 = expf(v2 - v1);
        const float g1 = pg / (1.0f + e2), g2 = pg * e2 / (1.0f + e2);
        const int ex1 = gs * 8 + i1, ex2 = gs * 8 + i2;
        const int r1 = atomicAdd(&cnt[route_layer * 32 + ex1], 1);
        list[(size_t)ex1 * CAP + r1] = row * 2;
        gate[row * 2] = g1;
        const int r2 = atomicAdd(&cnt[route_layer * 32 + ex2], 1);
        list[(size_t)ex2 * CAP + r2] = row * 2 + 1;
        gate[row * 2 + 1] = g2;
      }
    }
  }
}

__device__ __forceinline__ void phase_inproj(const P& p, char* smem) {
  GemmDesc g{}; g.A = (const u16*)(p.ws + WS_XB); g.lda = DM; g.mvalid = T_TOK; g.W = p.w_in; g.ldw = 2560; g.K = DM;
  u16* zb = (u16*)(p.ws + WS_Z); u16* a2 = (u16*)(p.ws + WS_A2);
  const int ntiles = 128 * 20;
  for (int t = blockIdx.x; t < ntiles; t += gridDim.x) {
    const int mt = t / 20, nt = t % 20;
    gemm_tile(g, mt * 128, nt * 128, [&](f32x4 (&acc)[4][4], int row0, int col0) {
      const int seg = (nt * 128) / 512;
#pragma unroll
      for (int m = 0; m < 4; ++m)
#pragma unroll
        for (int n = 0; n < 4; ++n) {
          const int row = row0 + m * 16, col = col0 + n * 16;
          uint2 w; w.x = pk2(acc[m][n][0], acc[m][n][1]); w.y = pk2(acc[m][n][2], acc[m][n][3]);
          if (seg < 4) *(uint2*)(zb + (size_t)seg * T_TOK * 512 + (size_t)row * 512 + (col - seg * 512)) = w;
          else { const int ch = col - 2048, gi = ch >> 4, c = ch & 15; *(uint2*)(a2 + ((size_t)gi * 512 + (row >> 5)) * 768 + (row & 31) * 16 + c) = w; }
        }
    }, smem);
  }
}

constexpr int RSTR = 136;
__device__ __forceinline__ void ret_load_tile(u16* dst, const u16* src, int t0, int h, int mode  , const f32x2* rope) {
  const int pos0 = t0 & (SEQ - 1);
  for (int idx = threadIdx.x; idx < 128 * 64; idx += NTHR) {
    const int i = idx >> 6, d = idx & 63;
    float t1 = h2f(src[(size_t)(t0 + i) * 512 + h * 128 + d]), t2 = h2f(src[(size_t)(t0 + i) * 512 + h * 128 + d + 64]);
    if (mode) {
      const f32x2 cs = rope[(pos0 + i) * 64 + d];
      const float o1 = t1 * cs[0] - t2 * cs[1], o2 = t1 * cs[1] + t2 * cs[0];
      t1 = o1; t2 = o2;
      if (mode == 2) { t1 *= 0.08838834764831845f; t2 *= 0.08838834764831845f; }
    }
    dst[i * RSTR + d] = f2h(t1); dst[i * RSTR + d + 64] = f2h(t2);
  }
}
__device__ __forceinline__ float log_sigmoid(float x) { return -log1pf(expf(-x)); }

__device__ __forceinline__ void phase_ret_inc(const P& p, char* smem) {
  u16* sK = (u16*)smem; u16* sV = sK + 128 * RSTR; float* sWf = (float*)(sV + 128 * RSTR); float* sWb = sWf + 128;
  const u16* kb = (const u16*)(p.ws + WS_Z) + (size_t)1 * T_TOK * 512; const u16* vb = (const u16*)(p.ws + WS_Z) + (size_t)2 * T_TOK * 512;
  const f32x2* rope = (const f32x2*)(p.ws + WS_ROPE);
  float* incf = (float*)(p.ws + WS_INC); float* incb = incf + (size_t)512 * 16384;
  const int tid = threadIdx.x;
  for (int item = blockIdx.x; item < 512; item += gridDim.x) {
    const int h = item & 3, bn = item >> 2, t0 = bn * 128;
    const float lgf = log_sigmoid(p.ret_decay[h]), lgb = log_sigmoid(p.ret_decay[4 + h]);
    __syncthreads();
    ret_load_tile(sK, kb, t0, h, 2, rope);
    ret_load_tile(sV, vb, t0, h, 0, rope);
    if (tid < 128) { sWf[tid] = expf(lgf * (float)(127 - tid)); sWb[tid] = expf(lgb * (float)tid); }
    __syncthreads();
    const int d0 = (tid >> 4) * 8, e0 = (tid & 15) * 8;
    float af[8][8], ab[8][8];
#pragma unroll
    for (int a = 0; a < 8; ++a)
#pragma unroll
      for (int b = 0; b < 8; ++b) { af[a][b] = 0.f; ab[a][b] = 0.f; }
    for (int j = 0; j < 128; ++j) {
      const uint4 kq = *(const uint4*)(sK + j * RSTR + d0), vq = *(const uint4*)(sV + j * RSTR + e0);
      const float kd[8] = {lo16(kq.x), hi16(kq.x), lo16(kq.y), hi16(kq.y), lo16(kq.z), hi16(kq.z), lo16(kq.w), hi16(kq.w)};
      const float ve[8] = {lo16(vq.x), hi16(vq.x), lo16(vq.y), hi16(vq.y), lo16(vq.z), hi16(vq.z), lo16(vq.w), hi16(vq.w)};
      const float wf = sWf[j], wb = sWb[j];
#pragma unroll
      for (int a = 0; a < 8; ++a) {
        const float kf = kd[a] * wf, kbw = kd[a] * wb;
#pragma unroll
        for (int b = 0; b < 8; ++b) { af[a][b] += kf * ve[b]; ab[a][b] += kbw * ve[b]; }
      }
    }
#pragma unroll
    for (int a = 0; a < 8; ++a) {
      float* of = incf + (size_t)item * 16384 + (d0 + a) * 128 + e0;
      float* ob = incb + (size_t)item * 16384 + (d0 + a) * 128 + e0;
      *(f32x4*)of = (f32x4){af[a][0], af[a][1], af[a][2], af[a][3]}; *(f32x4*)(of + 4) = (f32x4){af[a][4], af[a][5], af[a][6], af[a][7]};
      *(f32x4*)ob = (f32x4){ab[a][0], ab[a][1], ab[a][2], ab[a][3]}; *(f32x4*)(ob + 4) = (f32x4){ab[a][4], ab[a][5], ab[a][6], ab[a][7]};
    }
  }
}

__device__ __forceinline__ void phase_ret_scan(const P& p) {
  float* incf = (float*)(p.ws + WS_INC); float* incb = incf + (size_t)512 * 16384;
  const int gtid = blockIdx.x * NTHR + threadIdx.x, gsz = gridDim.x * NTHR;
  for (int idx = gtid; idx < 32 * 16384; idx += gsz) {
    const int de = idx & 16383, bh = idx >> 14, b = bh >> 2, h = bh & 3;
    const float Gf = expf(128.0f * log_sigmoid(p.ret_decay[h])), Gb = expf(128.0f * log_sigmoid(p.ret_decay[4 + h]));
    float s = 0.f;
    for (int n = 0; n < 16; ++n) { float* q = incf + ((size_t)((b * 16 + n) * 4 + h)) * 16384 + de; const float t = *q; *q = s; s = s * Gf + t; }
    s = 0.f;
    for (int n = 15; n >= 0; --n) { float* q = incb + ((size_t)((b * 16 + n) * 4 + h)) * 16384 + de; const float t = *q; *q = s; s = s * Gb + t; }
  }
}

__device__ __forceinline__ void phase_ret_out(const P& p, char* smem) {
  u16* sQ = (u16*)smem; u16* sK = sQ + 128 * RSTR; u16* sV = sK + 128 * RSTR; u16* sS = sV + 128 * RSTR;
  float* sPf = (float*)(sS + 128 * RSTR); float* sPb = sPf + 132;
  const u16* zb = (const u16*)(p.ws + WS_Z);
  const u16* qb = zb; const u16* kb = zb + (size_t)1 * T_TOK * 512; const u16* vb = zb + (size_t)2 * T_TOK * 512; const u16* gb = zb + (size_t)3 * T_TOK * 512;
  const f32x2* rope = (const f32x2*)(p.ws + WS_ROPE);
  const float* incf = (const float*)(p.ws + WS_INC); const float* incb = incf + (size_t)512 * 16384;
  u16* ycat = (u16*)(p.ws + WS_YCAT);
  const int tid = threadIdx.x;
  for (int item = blockIdx.x; item < 512; item += gridDim.x) {
    const int h = item & 3, bn = item >> 2, t0 = bn * 128;
    const float lgf = log_sigmoid(p.ret_decay[h]), lgb = log_sigmoid(p.ret_decay[4 + h]);
    __syncthreads();
    ret_load_tile(sQ, qb, t0, h, 1, rope);
    ret_load_tile(sK, kb, t0, h, 2, rope);
    ret_load_tile(sV, vb, t0, h, 0, rope);
    if (tid < 129) { sPf[tid] = expf(lgf * (float)tid); sPb[tid] = expf(lgb * (float)tid); }
    __syncthreads();
    const int i0 = (tid >> 4) * 8, j0 = (tid & 15) * 8;
    {
      float s[8][8];
#pragma unroll
      for (int a = 0; a < 8; ++a)
#pragma unroll
        for (int b = 0; b < 8; ++b) s[a][b] = 0.f;
      for (int d = 0; d < 128; d += 8) {
        float kk[8][8];
#pragma unroll
        for (int b = 0; b < 8; ++b) {
          const uint4 kq = *(const uint4*)(sK + (j0 + b) * RSTR + d);
          kk[b][0] = lo16(kq.x); kk[b][1] = hi16(kq.x); kk[b][2] = lo16(kq.y); kk[b][3] = hi16(kq.y); kk[b][4] = lo16(kq.z); kk[b][5] = hi16(kq.z); kk[b][6] = lo16(kq.w); kk[b][7] = hi16(kq.w);
        }
#pragma unroll
        for (int a = 0; a < 8; ++a) {
          const uint4 qq = *(const uint4*)(sQ + (i0 + a) * RSTR + d);
          const float qv[8] = {lo16(qq.x), hi16(qq.x), lo16(qq.y), hi16(qq.y), lo16(qq.z), hi16(qq.z), lo16(qq.w), hi16(qq.w)};
#pragma unroll
          for (int b = 0; b < 8; ++b)
#pragma unroll
            for (int c = 0; c < 8; ++c) s[a][b] += qv[c] * kk[b][c];
        }
      }
#pragma unroll
      for (int a = 0; a < 8; ++a) {
        unsigned w[4];
#pragma unroll
        for (int b = 0; b < 8; b += 2) {
          const int i = i0 + a, j = j0 + b;
          const float m0 = (i >= j) ? sPf[i - j] : sPb[j - i];
          const float m1 = (i >= j + 1) ? sPf[i - j - 1] : sPb[j + 1 - i];
          w[b >> 1] = pk2(s[a][b] * m0, s[a][b + 1] * m1);
        }
        *(uint4*)(sS + (i0 + a) * RSTR + j0) = make_uint4(w[0], w[1], w[2], w[3]);
      }
    }
    __syncthreads();
    {
      const int e0 = j0;
      float o[8][8];
#pragma unroll
      for (int a = 0; a < 8; ++a)
#pragma unroll
        for (int b = 0; b < 8; ++b) o[a][b] = 0.f;
      for (int j = 0; j < 128; j += 8) {
        float vv[8][8];
#pragma unroll
        for (int c = 0; c < 8; ++c) {
          const uint4 vq = *(const uint4*)(sV + (j + c) * RSTR + e0);
          vv[c][0] = lo16(vq.x); vv[c][1] = hi16(vq.x); vv[c][2] = lo16(vq.y); vv[c][3] = hi16(vq.y); vv[c][4] = lo16(vq.z); vv[c][5] = hi16(vq.z); vv[c][6] = lo16(vq.w); vv[c][7] = hi16(vq.w);
        }
#pragma unroll
        for (int a = 0; a < 8; ++a) {
          const uint4 sq = *(const uint4*)(sS + (i0 + a) * RSTR + j);
          const float sv[8] = {lo16(sq.x), hi16(sq.x), lo16(sq.y), hi16(sq.y), lo16(sq.z), hi16(sq.z), lo16(sq.w), hi16(sq.w)};
#pragma unroll
          for (int c = 0; c < 8; ++c)
#pragma unroll
            for (int b = 0; b < 8; ++b) o[a][b] += sv[c] * vv[c][b];
        }
      }
      const float* sp = incf + (size_t)item * 16384 + e0;
      const float* sn = incb + (size_t)item * 16384 + e0;
      float pf[8], pb[8];
#pragma unroll
      for (int a = 0; a < 8; ++a) { pf[a] = sPf[i0 + a + 1]; pb[a] = sPb[128 - (i0 + a)]; }
      for (int d = 0; d < 128; ++d) {
        const f32x4 p0 = *(const f32x4*)(sp + d * 128), p1 = *(const f32x4*)(sp + d * 128 + 4);
        const f32x4 n0 = *(const f32x4*)(sn + d * 128), n1 = *(const f32x4*)(sn + d * 128 + 4);
        const float spv[8] = {p0[0], p0[1], p0[2], p0[3], p1[0], p1[1], p1[2], p1[3]};
        const float snv[8] = {n0[0], n0[1], n0[2], n0[3], n1[0], n1[1], n1[2], n1[3]};
#pragma unroll
        for (int a = 0; a < 8; ++a) {
          const float qv = h2f(sQ[(i0 + a) * RSTR + d]);
          const float qf = qv * pf[a], qbk = qv * pb[a];
#pragma unroll
          for (int b = 0; b < 8; ++b) o[a][b] += qf * spv[b] + qbk * snv[b];
        }
      }
#pragma unroll
      for (int a = 0; a < 8; ++a) {
        float s1 = 0.f;
#pragma unroll
        for (int b = 0; b < 8; ++b) s1 += o[a][b];
        s1 += __shfl_xor(s1, 1); s1 += __shfl_xor(s1, 2); s1 += __shfl_xor(s1, 4); s1 += __shfl_xor(s1, 8);
        const float mu = s1 * (1.0f / 128.0f);
        float s2 = 0.f;
#pragma unroll
        for (int b = 0; b < 8; ++b) { const float dlt = o[a][b] - mu; s2 += dlt * dlt; }
        s2 += __shfl_xor(s2, 1); s2 += __shfl_xor(s2, 2); s2 += __shfl_xor(s2, 4); s2 += __shfl_xor(s2, 8);
        const float rs = rsqrtf(s2 * (1.0f / 128.0f) + 1e-5f);
        const size_t tok = (size_t)(t0 + i0 + a);
        const uint4 gq = *(const uint4*)(gb + tok * 512 + h * 128 + e0);
        const float gv[8] = {lo16(gq.x), hi16(gq.x), lo16(gq.y), hi16(gq.y), lo16(gq.z), hi16(gq.z), lo16(gq.w), hi16(gq.w)};
        unsigned w[4];
#pragma unroll
        for (int b = 0; b < 8; b += 2) {
          const float y0 = gv[b] * sigmoidf_(gv[b]) * (o[a][b] - mu) * rs;
          const float y1 = gv[b + 1] * sigmoidf_(gv[b + 1]) * (o[a][b + 1] - mu) * rs;
          w[b >> 1] = pk2(y0, y1);
        }
        *(uint4*)(ycat + tok * DM + h * 128 + e0) = make_uint4(w[0], w[1], w[2], w[3]);
      }
    }
  }
}

template <int MB_, int NB_>
__device__ __forceinline__ void lds_mma(f32x4 (&acc)[MB_][NB_], const u16* sA, int sa, int a0, const u16* sB, int sb, int b0, int K, int lane, const float* sc) {
  const int fr = lane & 15, fq = lane >> 4;
  for (int k0 = 0; k0 < K; k0 += 32) {
    uint4 fa[MB_], fb[NB_];
#pragma unroll
    for (int m = 0; m < MB_; ++m) {
      fa[m] = *(const uint4*)(sA + (a0 + m * 16 + fr) * sa + k0 + fq * 8);
      if (sc) {
        const float f = sc[m];
        fa[m].x = pk2(lo16(fa[m].x) * f, hi16(fa[m].x) * f); fa[m].y = pk2(lo16(fa[m].y) * f, hi16(fa[m].y) * f);
        fa[m].z = pk2(lo16(fa[m].z) * f, hi16(fa[m].z) * f); fa[m].w = pk2(lo16(fa[m].w) * f, hi16(fa[m].w) * f);
      }
    }
#pragma unroll
    for (int n = 0; n < NB_; ++n) fb[n] = *(const uint4*)(sB + (b0 + n * 16 + fr) * sb + k0 + fq * 8);
#pragma unroll
    for (int m = 0; m < MB_; ++m)
#pragma unroll
      for (int n = 0; n < NB_; ++n) acc[m][n] = mfma16(fb[n], fa[m], acc[m][n]);
  }
}
__device__ __forceinline__ void ret_stage_T(u16* dst0, u16* dst1, const u16* src, int t0, int h, int mode, const f32x2* rope, const float* w0, const float* w1) {
  const int pos0 = t0 & (SEQ - 1);
  for (int idx = threadIdx.x; idx < 32 * 64; idx += NTHR) {
    const int ii = idx >> 6, d = idx & 63;
    float a1[4], a2[4];
#pragma unroll
    for (int r = 0; r < 4; ++r) {
      const int i = 4 * ii + r;
      float t1 = h2f(src[(size_t)(t0 + i) * 512 + h * 128 + d]), t2 = h2f(src[(size_t)(t0 + i) * 512 + h * 128 + d + 64]);
      if (mode) {
        const f32x2 cs = rope[(pos0 + i) * 64 + d];
        const float o1 = t1 * cs[0] - t2 * cs[1], o2 = t1 * cs[1] + t2 * cs[0];
        t1 = o1; t2 = o2;
        if (mode == 2) { t1 *= 0.08838834764831845f; t2 *= 0.08838834764831845f; }
      }
      a1[r] = t1; a2[r] = t2;
    }
    if (w0) {
      const f32x4 wa = *(const f32x4*)(w0 + 4 * ii), wb = *(const f32x4*)(w1 + 4 * ii);
      uint2 o;
      o.x = pk2(a1[0] * wa[0], a1[1] * wa[1]); o.y = pk2(a1[2] * wa[2], a1[3] * wa[3]); *(uint2*)(dst0 + d * RSTR + 4 * ii) = o;
      o.x = pk2(a2[0] * wa[0], a2[1] * wa[1]); o.y = pk2(a2[2] * wa[2], a2[3] * wa[3]); *(uint2*)(dst0 + (d + 64) * RSTR + 4 * ii) = o;
      o.x = pk2(a1[0] * wb[0], a1[1] * wb[1]); o.y = pk2(a1[2] * wb[2], a1[3] * wb[3]); *(uint2*)(dst1 + d * RSTR + 4 * ii) = o;
      o.x = pk2(a2[0] * wb[0], a2[1] * wb[1]); o.y = pk2(a2[2] * wb[2], a2[3] * wb[3]); *(uint2*)(dst1 + (d + 64) * RSTR + 4 * ii) = o;
    } else {
      uint2 o;
      o.x = pk2(a1[0], a1[1]); o.y = pk2(a1[2], a1[3]); *(uint2*)(dst0 + d * RSTR + 4 * ii) = o;
      o.x = pk2(a2[0], a2[1]); o.y = pk2(a2[2], a2[3]); *(uint2*)(dst0 + (d + 64) * RSTR + 4 * ii) = o;
    }
  }
}
__device__ __forceinline__ void phase_ret_inc_mfma(const P& p, char* smem) {
  u16* sKf = (u16*)smem; u16* sKb = sKf + 128 * RSTR; u16* sVT = sKb + 128 * RSTR; float* sWf = (float*)(sVT + 128 * RSTR); float* sWb = sWf + 128;
  const u16* kb = (const u16*)(p.ws + WS_Z) + (size_t)1 * T_TOK * 512; const u16* vb = (const u16*)(p.ws + WS_Z) + (size_t)2 * T_TOK * 512;
  const f32x2* rope = (const f32x2*)(p.ws + WS_ROPE);
  float* incf = (float*)(p.ws + WS_INC); float* incb = incf + (size_t)512 * 16384;
  const int tid = threadIdx.x, lane = tid & 63, wv = tid >> 6, wr = wv >> 1, wc = wv & 1, fr = lane & 15, fq = lane >> 4;
  for (int item = blockIdx.x; item < 512; item += gridDim.x) {
    const int h = item & 3, bn = item >> 2, t0 = bn * 128;
    const float lgf = log_sigmoid(p.ret_decay[h]), lgb = log_sigmoid(p.ret_decay[4 + h]);
    __syncthreads();
    if (tid < 128) { sWf[tid] = expf(lgf * (float)(127 - tid)); sWb[tid] = expf(lgb * (float)tid); }
    __syncthreads();
    ret_stage_T(sKf, sKb, kb, t0, h, 2, rope, sWf, sWb);
    ret_stage_T(sVT, nullptr, vb, t0, h, 0, rope, nullptr, nullptr);
    __syncthreads();
#pragma unroll
    for (int dirn = 0; dirn < 2; ++dirn) {
      f32x4 acc[4][4];
#pragma unroll
      for (int m = 0; m < 4; ++m)
#pragma unroll
        for (int n = 0; n < 4; ++n) acc[m][n] = (f32x4){0.f, 0.f, 0.f, 0.f};
      lds_mma<4, 4>(acc, sVT, RSTR, wr * 64, dirn ? sKb : sKf, RSTR, wc * 64, 128, lane, nullptr);
      float* o = (dirn ? incb : incf) + (size_t)item * 16384;
#pragma unroll
      for (int m = 0; m < 4; ++m)
#pragma unroll
        for (int n = 0; n < 4; ++n) *(f32x4*)(o + (wr * 64 + m * 16 + fr) * 128 + wc * 64 + n * 16 + 4 * fq) = acc[m][n];
    }
  }
}
__device__ __forceinline__ void phase_ret_scan16(const P& p) {
  const float* incf = (const float*)(p.ws + WS_INC); const float* incb = incf + (size_t)512 * 16384;
  u16* spf = (u16*)(p.ws + WS_SP16); u16* spb = spf + (size_t)512 * 16384;
  const int gtid = blockIdx.x * NTHR + threadIdx.x, gsz = gridDim.x * NTHR;
  for (int idx = gtid; idx < 32 * 4096; idx += gsz) {
    const int de = (idx & 4095) * 4, bh = idx >> 12, b = bh >> 2, h = bh & 3;
    const float Gf = expf(128.0f * log_sigmoid(p.ret_decay[h])), Gb = expf(128.0f * log_sigmoid(p.ret_decay[4 + h]));
    f32x4 s = {0.f, 0.f, 0.f, 0.f};
    for (int n = 0; n < 16; ++n) {
      const size_t o = ((size_t)((b * 16 + n) * 4 + h)) * 16384 + de;
      const f32x4 t = *(const f32x4*)(incf + o);
      uint2 w; w.x = pk2(s[0], s[1]); w.y = pk2(s[2], s[3]); *(uint2*)(spf + o) = w;
      s = s * Gf + t;
    }
    s = (f32x4){0.f, 0.f, 0.f, 0.f};
    for (int n = 15; n >= 0; --n) {
      const size_t o = ((size_t)((b * 16 + n) * 4 + h)) * 16384 + de;
      const f32x4 t = *(const f32x4*)(incb + o);
      uint2 w; w.x = pk2(s[0], s[1]); w.y = pk2(s[2], s[3]); *(uint2*)(spb + o) = w;
      s = s * Gb + t;
    }
  }
}
__device__ __forceinline__ void phase_ret_out_mfma(const P& p, char* smem) {
  u16* R0 = (u16*)smem; u16* R1 = R0 + 128 * RSTR; u16* R2 = R1 + 128 * RSTR; u16* R3 = R2 + 128 * RSTR;
  float* sPf = (float*)(R3 + 128 * RSTR); float* sPb = sPf + 132;
  const u16* zb = (const u16*)(p.ws + WS_Z);
  const u16* qb = zb; const u16* kb = zb + (size_t)1 * T_TOK * 512; const u16* vb = zb + (size_t)2 * T_TOK * 512; const u16* gb = zb + (size_t)3 * T_TOK * 512;
  const f32x2* rope = (const f32x2*)(p.ws + WS_ROPE);
  const u16* spf = (const u16*)(p.ws + WS_SP16); const u16* spb = spf + (size_t)512 * 16384;
  u16* ycat = (u16*)(p.ws + WS_YCAT);
  const int tid = threadIdx.x, lane = tid & 63, wv = tid >> 6, wr = wv >> 1, wc = wv & 1, fr = lane & 15, fq = lane >> 4;
  for (int item = blockIdx.x; item < 512; item += gridDim.x) {
    const int h = item & 3, bn = item >> 2, t0 = bn * 128;
    const float lgf = log_sigmoid(p.ret_decay[h]), lgb = log_sigmoid(p.ret_decay[4 + h]);
    __syncthreads();
    ret_load_tile(R0, qb, t0, h, 1, rope);
    ret_load_tile(R1, kb, t0, h, 2, rope);
    ret_stage_T(R2, nullptr, vb, t0, h, 0, rope, nullptr, nullptr);
    if (tid < 129) { sPf[tid] = expf(lgf * (float)tid); sPb[tid] = expf(lgb * (float)tid); }
    __syncthreads();
    {
      f32x4 acc[4][4];
#pragma unroll
      for (int m = 0; m < 4; ++m)
#pragma unroll
        for (int n = 0; n < 4; ++n) acc[m][n] = (f32x4){0.f, 0.f, 0.f, 0.f};
      lds_mma<4, 4>(acc, R0, RSTR, wr * 64, R1, RSTR, wc * 64, 128, lane, nullptr);
#pragma unroll
      for (int m = 0; m < 4; ++m)
#pragma unroll
        for (int n = 0; n < 4; ++n) {
          const int i = wr * 64 + m * 16 + fr, j = wc * 64 + n * 16 + 4 * fq;
          float v[4];
#pragma unroll
          for (int r = 0; r < 4; ++r) { const int jj = j + r; v[r] = acc[m][n][r] * ((i >= jj) ? sPf[i - jj] : sPb[jj - i]); }
          uint2 w; w.x = pk2(v[0], v[1]); w.y = pk2(v[2], v[3]);
          *(uint2*)(R3 + i * RSTR + j) = w;
        }
    }
    __syncthreads();
    const u16* spT = spf + (size_t)item * 16384; const u16* snT = spb + (size_t)item * 16384;
    for (int c = tid; c < 128 * 16; c += NTHR) { const int e = c >> 4, ch = (c & 15) * 8; *(uint4*)(R1 + e * RSTR + ch) = *(const uint4*)(spT + e * 128 + ch); }
    f32x4 o[2][8];
#pragma unroll
    for (int m = 0; m < 2; ++m)
#pragma unroll
      for (int n = 0; n < 8; ++n) o[m][n] = (f32x4){0.f, 0.f, 0.f, 0.f};
    lds_mma<2, 8>(o, R3, RSTR, wv * 32, R2, RSTR, 0, 128, lane, nullptr);
    __syncthreads();
    for (int c = tid; c < 128 * 16; c += NTHR) { const int e = c >> 4, ch = (c & 15) * 8; *(uint4*)(R2 + e * RSTR + ch) = *(const uint4*)(snT + e * 128 + ch); }
    float scf[2], scb[2];
#pragma unroll
    for (int m = 0; m < 2; ++m) { const int i = wv * 32 + m * 16 + fr; scf[m] = sPf[i + 1]; scb[m] = sPb[128 - i]; }
    lds_mma<2, 8>(o, R0, RSTR, wv * 32, R1, RSTR, 0, 128, lane, scf);
    __syncthreads();
    lds_mma<2, 8>(o, R0, RSTR, wv * 32, R2, RSTR, 0, 128, lane, scb);
#pragma unroll
    for (int m = 0; m < 2; ++m) {
      float s1 = 0.f;
#pragma unroll
      for (int n = 0; n < 8; ++n) s1 += (o[m][n][0] + o[m][n][1]) + (o[m][n][2] + o[m][n][3]);
      s1 += __shfl_xor(s1, 16); s1 += __shfl_xor(s1, 32);
      const float mu = s1 * (1.0f / 128.0f);
      float s2 = 0.f;
#pragma unroll
      for (int n = 0; n < 8; ++n)
#pragma unroll
        for (int r = 0; r < 4; ++r) { const float dl = o[m][n][r] - mu; s2 += dl * dl; }
      s2 += __shfl_xor(s2, 16); s2 += __shfl_xor(s2, 32);
      const float rs = rsqrtf(s2 * (1.0f / 128.0f) + 1e-5f);
      const size_t tok = (size_t)(t0 + wv * 32 + m * 16 + fr);
#pragma unroll
      for (int n = 0; n < 8; ++n) {
        const int e = n * 16 + 4 * fq;
        const uint2 gq = *(const uint2*)(gb + tok * 512 + h * 128 + e);
        const float g0 = lo16(gq.x), g1 = hi16(gq.x), g2 = lo16(gq.y), g3 = hi16(gq.y);
        uint2 w;
        w.x = pk2(g0 * sigmoidf_(g0) * (o[m][n][0] - mu) * rs, g1 * sigmoidf_(g1) * (o[m][n][1] - mu) * rs);
        w.y = pk2(g2 * sigmoidf_(g2) * (o[m][n][2] - mu) * rs, g3 * sigmoidf_(g3) * (o[m][n][3] - mu) * rs);
        *(uint2*)(ycat + tok * DM + h * 128 + e) = w;
      }
    }
  }
}

__device__ __forceinline__ void phase_s5_naive(const P& p, char* smem) {
  float* ylds = (float*)smem;
  float* xs = ylds + 2048 * 16;
  const u16* a2 = (const u16*)(p.ws + WS_A2);
  u16* ygelu = (u16*)(p.ws + WS_YGELU);
  const int lane = threadIdx.x & 63;
  if (threadIdx.x < 64) {
    for (int item = blockIdx.x; item < 256; item += gridDim.x) {
      const int b = item >> 5, g = item & 31;
      const int pidx = lane;
      const int cidx = lane & 15, quart = lane >> 4;
      for (int dir = 0; dir < 2; ++dir) {
        const float dt = expf(p.log_step[dir * 32 + g]);
        const float ar = p.a_re[(dir * 32 + g) * 64 + pidx], ai = p.a_im[(dir * 32 + g) * 64 + pidx];
        const float mag = expf(ar * dt);
        float sn, cs; sincosf(ai * dt, &sn, &cs);
        const float lre = mag * cs, lim = mag * sn;
        const float nr = lre - 1.0f, ni = lim, den = ar * ar + ai * ai;
        const float cre = (nr * ar + ni * ai) / den, cim = (ni * ar - nr * ai) / den;
        float bbr[16], bbi[16];
#pragma unroll
        for (int c = 0; c < 16; ++c) {
          const float br = p.b_re[(g * 64 + pidx) * 16 + c], bi = p.b_im[(g * 64 + pidx) * 16 + c];
          bbr[c] = cre * br - cim * bi; bbi[c] = cre * bi + cim * br;
        }
        float ccr[16], cci[16];
#pragma unroll
        for (int q = 0; q < 16; ++q) {
          ccr[q] = p.c_re[((dir * 32 + g) * 16 + cidx) * 64 + quart * 16 + q];
          cci[q] = p.c_im[((dir * 32 + g) * 16 + cidx) * 64 + quart * 16 + q];
        }
        const float dsk = p.s5d[g * 16 + cidx];
        float xr = 0.f, xi = 0.f;
        for (int step = 0; step < SEQ; ++step) {
          const int n = dir ? (SEQ - 1 - step) : step;
          const int t = b * SEQ + n;
          const u16* up = a2 + ((size_t)g * 512 + (t >> 5)) * 768 + (t & 31) * 16;
          const uint4 u0 = *(const uint4*)up, u1 = *(const uint4*)(up + 8);
          const float uv[16] = {lo16(u0.x), hi16(u0.x), lo16(u0.y), hi16(u0.y), lo16(u0.z), hi16(u0.z), lo16(u0.w), hi16(u0.w),
                                lo16(u1.x), hi16(u1.x), lo16(u1.y), hi16(u1.y), lo16(u1.z), hi16(u1.z), lo16(u1.w), hi16(u1.w)};
          float bur = 0.f, bui = 0.f;
#pragma unroll
          for (int c = 0; c < 16; ++c) { bur += bbr[c] * uv[c]; bui += bbi[c] * uv[c]; }
          const float nxr = lre * xr - lim * xi + bur, nxi = lre * xi + lim * xr + bui;
          xr = nxr; xi = nxi;
          asm volatile("s_waitcnt lgkmcnt(0)" ::: "memory");
          xs[lane] = xr; xs[64 + lane] = xi;
          asm volatile("s_waitcnt lgkmcnt(0)" ::: "memory");
          float part = 0.f;
#pragma unroll
          for (int q = 0; q < 16; ++q) part += ccr[q] * xs[quart * 16 + q] - cci[q] * xs[64 + quart * 16 + q];
          asm volatile("s_waitcnt lgkmcnt(0)" ::: "memory");
          part += __shfl_xor(part, 16); part += __shfl_xor(part, 32);
          if (lane < 16) {
            if (dir == 0) ylds[n * 16 + cidx] = dsk * h2f(up[cidx]) + part;
            else ygelu[(size_t)t * 512 + g * 16 + cidx] = f2h(gelu_tanh(ylds[n * 16 + cidx] + part));
          }
        }
      }
    }
  }
}

struct Cpx { float re, im; };
__device__ __forceinline__ Cpx cmul(Cpx a, Cpx b) { return {a.re * b.re - a.im * b.im, a.re * b.im + a.im * b.re}; }
__device__ __forceinline__ Cpx s5_lam_pow(float ar, float ai, float dt, float e) {
  const float mag = expf(ar * dt * e); float sn, cs; sincosf(ai * dt * e, &sn, &cs); return {mag * cs, mag * sn};
}
__device__ __forceinline__ Cpx s5_coef(float ar, float ai, float dt) {
  float sn, cs; sincosf(ai * dt, &sn, &cs);
  const float em1 = expm1f(ar * dt), sh = sinf(0.5f * ai * dt);
  const float nr = em1 * cs - 2.0f * sh * sh, ni = (em1 + 1.0f) * sn, den = ar * ar + ai * ai;
  return {(nr * ar + ni * ai) / den, (ni * ar - nr * ai) / den};
}
__device__ __forceinline__ void phase_s5_ktab(const P& p) {
  float* ktab = (float*)(p.ws + WS_KTAB);
  const int gtid = blockIdx.x * NTHR + threadIdx.x, gsz = gridDim.x * NTHR;
  for (int item = gtid; item < 32 * 2 * 32 * 16; item += gsz) {
    const int c = item & 15, l = (item >> 4) & 31, dir = (item >> 9) & 1, g = item >> 10;
    const float dt = expf(p.log_step[dir * 32 + g]);
    float acc[16];
#pragma unroll
    for (int j = 0; j < 16; ++j) acc[j] = 0.f;
    for (int q = 0; q < 64; ++q) {
      const float ar = p.a_re[(dir * 32 + g) * 64 + q], ai = p.a_im[(dir * 32 + g) * 64 + q];
      const Cpx L = s5_lam_pow(ar, ai, dt, (float)l), cf = s5_coef(ar, ai, dt);
      const Cpx C = {p.c_re[((dir * 32 + g) * 16 + c) * 64 + q], p.c_im[((dir * 32 + g) * 16 + c) * 64 + q]};
      const Cpx w = cmul(cmul(C, L), cf);
#pragma unroll
      for (int j = 0; j < 16; ++j) acc[j] += w.re * p.b_re[(g * 64 + q) * 16 + j] - w.im * p.b_im[(g * 64 + q) * 16 + j];
    }
#pragma unroll
    for (int j = 0; j < 16; j += 4) *(f32x4*)(ktab + (size_t)item * 16 + j) = (f32x4){acc[j], acc[j + 1], acc[j + 2], acc[j + 3]};
  }
}
__device__ __forceinline__ void phase_s5_fill(const P& p) {
  const float* ktab = (const float*)(p.ws + WS_KTAB);
  u16* bty = (u16*)(p.ws + WS_BTY); u16* wet = (u16*)(p.ws + WS_WET);
  const int gtid = blockIdx.x * NTHR + threadIdx.x, gsz = gridDim.x * NTHR;
  for (int item = gtid; item < 32 * 512 * 64; item += gsz) {
    const int ch = item & 63, n = (item >> 6) & 511, g = item >> 15;
    const int ip = ch >> 1, c0 = (ch & 1) * 8, i = n >> 4, c = n & 15;
    float v[8];
    if (ip != i) {
      const int dir = ip < i ? 0 : 1, l = ip < i ? i - ip : ip - i;
      const float* src = ktab + ((size_t)((g * 2 + dir) * 32 + l) * 16 + c) * 16 + c0;
      const f32x4 a = *(const f32x4*)src, b = *(const f32x4*)(src + 4);
      v[0] = a[0]; v[1] = a[1]; v[2] = a[2]; v[3] = a[3]; v[4] = b[0]; v[5] = b[1]; v[6] = b[2]; v[7] = b[3];
    } else {
      const float* s0 = ktab + ((size_t)((g * 2 + 0) * 32) * 16 + c) * 16 + c0;
      const float* s1 = ktab + ((size_t)((g * 2 + 1) * 32) * 16 + c) * 16 + c0;
      const float dd = p.s5d[g * 16 + c];
#pragma unroll
      for (int j = 0; j < 8; ++j) v[j] = s0[j] + s1[j] + ((c0 + j) == c ? dd : 0.f);
    }
    *(uint4*)(bty + ((size_t)g * 512 + n) * 768 + ch * 8) = make_uint4(pk2(v[0], v[1]), pk2(v[2], v[3]), pk2(v[4], v[5]), pk2(v[6], v[7]));
  }
  for (int item = gtid; item < 32 * 512 * 32; item += gsz) {
    const int ch = item & 31, n = (item >> 5) & 511, g = item >> 14;
    const int kk = ch * 8, dir = kk >> 7, p0 = (kk & 127) >> 1, i = n >> 4, c = n & 15;
    const float dt = expf(p.log_step[dir * 32 + g]), e = dir ? (float)(32 - i) : (float)(i + 1);
    float v[8];
#pragma unroll
    for (int q = 0; q < 4; ++q) {
      const int pq = p0 + q;
      const float ar = p.a_re[(dir * 32 + g) * 64 + pq], ai = p.a_im[(dir * 32 + g) * 64 + pq];
      const Cpx L = s5_lam_pow(ar, ai, dt, e);
      const Cpx C = {p.c_re[((dir * 32 + g) * 16 + c) * 64 + pq], p.c_im[((dir * 32 + g) * 16 + c) * 64 + pq]};
      const Cpx w = cmul(C, L);
      v[2 * q] = w.re; v[2 * q + 1] = -w.im;
    }
    *(uint4*)(bty + ((size_t)g * 512 + n) * 768 + 512 + kk) = make_uint4(pk2(v[0], v[1]), pk2(v[2], v[3]), pk2(v[4], v[5]), pk2(v[6], v[7]));
  }
  for (int item = gtid; item < 32 * 256 * 64; item += gsz) {
    const int ch = item & 63, n = (item >> 6) & 255, g = item >> 14;
    const int ip = ch >> 1, c0 = (ch & 1) * 8, ri = n & 1, pq = (n >> 1) & 63, dir = n >> 7;
    const float dt = expf(p.log_step[dir * 32 + g]), e = dir ? (float)ip : (float)(31 - ip);
    const float ar = p.a_re[(dir * 32 + g) * 64 + pq], ai = p.a_im[(dir * 32 + g) * 64 + pq];
    const Cpx w = cmul(s5_lam_pow(ar, ai, dt, e), s5_coef(ar, ai, dt));
    float v[8];
#pragma unroll
    for (int j = 0; j < 8; ++j) {
      const float br = p.b_re[(g * 64 + pq) * 16 + c0 + j], bi = p.b_im[(g * 64 + pq) * 16 + c0 + j];
      v[j] = ri ? (w.re * bi + w.im * br) : (w.re * br - w.im * bi);
    }
    *(uint4*)(wet + ((size_t)g * 256 + n) * 512 + ch * 8) = make_uint4(pk2(v[0], v[1]), pk2(v[2], v[3]), pk2(v[4], v[5]), pk2(v[6], v[7]));
  }
}
__device__ __forceinline__ void phase_s5_egemm(const P& p, char* smem) {
  float* E = (float*)(p.ws + WS_E);
  for (int t = blockIdx.x; t < 32 * 8; t += gridDim.x) {
    const int g = t >> 3, mt = (t >> 1) & 3, nt = t & 1;
    GemmDesc d{}; d.A = (const u16*)(p.ws + WS_A2) + (size_t)g * 512 * 768; d.lda = 768; d.mvalid = 512;
    d.Bt = (const u16*)(p.ws + WS_WET) + (size_t)g * 256 * 512; d.ldb = 512; d.K = 512;
    gemm_tile(d, mt * 128, nt * 128, [&](f32x4 (&acc)[4][4], int row0, int col0) {
#pragma unroll
      for (int m = 0; m < 4; ++m)
#pragma unroll
        for (int n = 0; n < 4; ++n) *(f32x4*)(E + ((size_t)g * 512 + row0 + m * 16) * 256 + col0 + n * 16) = acc[m][n];
    }, smem);
  }
}
__device__ __forceinline__ void phase_s5_carry(const P& p) {
  const float* E = (const float*)(p.ws + WS_E);
  u16* a2 = (u16*)(p.ws + WS_A2);
  const int gtid = blockIdx.x * NTHR + threadIdx.x, gsz = gridDim.x * NTHR;
  for (int idx = gtid; idx < 32 * 8 * 128; idx += gsz) {
    const int pq = idx & 63, dir = (idx >> 6) & 1, b = (idx >> 7) & 7, g = idx >> 10;
    const float dt = expf(p.log_step[dir * 32 + g]);
    const Cpx L = s5_lam_pow(p.a_re[(dir * 32 + g) * 64 + pq], p.a_im[(dir * 32 + g) * 64 + pq], dt, 32.0f);
    Cpx s = {0.f, 0.f};
    for (int jj = 0; jj < 64; ++jj) {
      const int j = dir ? 63 - jj : jj, r = b * 64 + j;
      const f32x2 e = *(const f32x2*)(E + ((size_t)g * 512 + r) * 256 + (dir * 64 + pq) * 2);
      *(unsigned*)(a2 + ((size_t)g * 512 + r) * 768 + 512 + (dir * 64 + pq) * 2) = pk2(s.re, s.im);
      const Cpx ns = cmul(L, s);
      s.re = ns.re + e[0]; s.im = ns.im + e[1];
    }
  }
}
__device__ __forceinline__ void phase_s5_ygemm(const P& p, char* smem) {
  u16* ygelu = (u16*)(p.ws + WS_YGELU);
  for (int t = blockIdx.x; t < 32 * 16; t += gridDim.x) {
    const int g = t >> 4, mt = (t >> 2) & 3, nt = t & 3;
    GemmDesc d{}; d.A = (const u16*)(p.ws + WS_A2) + (size_t)g * 512 * 768; d.lda = 768; d.mvalid = 512;
    d.Bt = (const u16*)(p.ws + WS_BTY) + (size_t)g * 512 * 768; d.ldb = 768; d.K = 768;
    gemm_tile(d, mt * 128, nt * 128, [&](f32x4 (&acc)[4][4], int row0, int col0) {
#pragma unroll
      for (int m = 0; m < 4; ++m)
#pragma unroll
        for (int n = 0; n < 4; ++n) {
          const int row = row0 + m * 16, col = col0 + n * 16;
          uint2 w; w.x = pk2(gelu_tanh(acc[m][n][0]), gelu_tanh(acc[m][n][1])); w.y = pk2(gelu_tanh(acc[m][n][2]), gelu_tanh(acc[m][n][3]));
          *(uint2*)(ygelu + ((size_t)row * 32 + (col >> 4)) * 512 + g * 16 + (col & 15)) = w;
        }
    }, smem);
  }
}

__device__ __forceinline__ void phase_glu(const P& p, char* smem) {
  const u16* yg = (const u16*)(p.ws + WS_YGELU); u16* ycat = (u16*)(p.ws + WS_YCAT);
  GemmDesc g{}; g.A = yg; g.lda = 512; g.mvalid = T_TOK; g.W = p.w_glu; g.ldw = 512; g.K = 512;
  for (int t = blockIdx.x; t < 128 * 4; t += gridDim.x) {
    const int mt = t >> 2, nt = t & 3;
    gemm_tile(g, mt * 128, nt * 128, [&](f32x4 (&acc)[4][4], int row0, int col0) {
#pragma unroll
      for (int m = 0; m < 4; ++m)
#pragma unroll
        for (int n = 0; n < 4; ++n) {
          const int row = row0 + m * 16, col = col0 + n * 16;
          const uint2 yv = *(const uint2*)(yg + (size_t)row * 512 + col);
          const f32x4 bb = *(const f32x4*)(p.b_glu + col);
          const float y0 = lo16(yv.x) * sigmoidf_(acc[m][n][0] + bb[0]), y1 = hi16(yv.x) * sigmoidf_(acc[m][n][1] + bb[1]);
          const float y2 = lo16(yv.y) * sigmoidf_(acc[m][n][2] + bb[2]), y3 = hi16(yv.y) * sigmoidf_(acc[m][n][3] + bb[3]);
          uint2 w; w.x = pk2(y0, y1); w.y = pk2(y2, y3);
          *(uint2*)(ycat + (size_t)row * DM + 512 + col) = w;
        }
    }, smem);
  }
}

__device__ __forceinline__ void phase_outproj(const P& p, const u16* A, const float* W, const float* xin, float* xout, char* smem) {
  GemmDesc g{}; g.A = A; g.lda = DM; g.mvalid = T_TOK; g.W = W; g.ldw = DM; g.K = DM;
  for (int t = blockIdx.x; t < 128 * 8; t += gridDim.x) {
    const int mt = t >> 3, nt = t & 7;
    gemm_tile(g, mt * 128, nt * 128, [&](f32x4 (&acc)[4][4], int row0, int col0) {
#pragma unroll
      for (int m = 0; m < 4; ++m)
#pragma unroll
        for (int n = 0; n < 4; ++n) {
          const size_t o = (size_t)(row0 + m * 16) * DM + col0 + n * 16;
          const f32x4 xv = *(const f32x4*)(xin + o);
          *(f32x4*)(xout + o) = xv + acc[m][n];
        }
    }, smem);
  }
}

__device__ __forceinline__ void phase_qkv(const P& p, char* smem) {
  GemmDesc g{}; g.A = (const u16*)(p.ws + WS_XB); g.lda = DM; g.mvalid = T_TOK; g.W = p.w_qkv; g.ldw = 1536; g.K = DM;
  u16* q1 = (u16*)(p.ws + WS_Z); u16* k1 = (u16*)(p.ws + WS_Z + 32 * MB); u16* v1 = (u16*)(p.ws + WS_Z + 40 * MB);
  for (int t = blockIdx.x; t < 128 * 12; t += gridDim.x) {
    const int mt = t / 12, nt = t % 12;
    gemm_tile(g, mt * 128, nt * 128, [&](f32x4 (&acc)[4][4], int row0, int col0) {
#pragma unroll
      for (int m = 0; m < 4; ++m)
#pragma unroll
        for (int n = 0; n < 4; ++n) {
          const int row = row0 + m * 16, col = col0 + n * 16;
          uint2 w;
          if (nt < 8) { w.x = pk2(acc[m][n][0] * 0.125f, acc[m][n][1] * 0.125f); w.y = pk2(acc[m][n][2] * 0.125f, acc[m][n][3] * 0.125f); *(uint2*)(q1 + (size_t)row * DM + col) = w; }
          else {
            w.x = pk2(acc[m][n][0], acc[m][n][1]); w.y = pk2(acc[m][n][2], acc[m][n][3]);
            if (nt < 10) *(uint2*)(k1 + (size_t)row * 256 + (col - 1024)) = w; else *(uint2*)(v1 + (size_t)row * 256 + (col - 1280)) = w;
          }
        }
    }, smem);
  }
}

struct MoeTile { int e, rt, ct, cnt, hbase; };
__device__ __forceinline__ bool moe_decode(const int* cnt, int t, MoeTile& mt) {
  int base = 0, hb = 0;
  for (int e = 0; e < 32; ++e) {
    const int c = cnt[e], nt = (c + 127) >> 7, span = nt * 8;
    if (t < base + span) { const int loc = t - base; mt.e = e; mt.rt = loc % nt; mt.ct = loc / nt; mt.cnt = c; mt.hbase = hb; return true; }
    base += span; hb += nt * 128;
  }
  return false;
}
__device__ __forceinline__ void phase_moe1(const P& p, int layer, char* smem) {
  const int* cnt = (const int*)(p.ws + WS_CNT) + layer * 32;
  const int* list = (const int*)(p.ws + WS_LIST);
  u16* hbuf = (u16*)(p.ws + WS_H);
  for (int t = blockIdx.x;; t += gridDim.x) {
    MoeTile mt; if (!moe_decode(cnt, t, mt)) break;
    GemmDesc g{}; g.A = (const u16*)(p.ws + WS_XB); g.lda = DM; g.rowmap = list + (size_t)mt.e * CAP; g.rowshift = 1; g.mvalid = mt.cnt;
    g.W = p.w_gate + (size_t)(layer * 32 + mt.e) * DM * 512; g.W2 = p.w_up + (size_t)(layer * 32 + mt.e) * DM * 512; g.ldw = 512; g.K = DM;
    gemm_tile(g, mt.rt * 128, mt.ct * 128, [&](f32x4 (&acc)[4][4], int row0, int col0) {
      const int ocol0 = (col0 >> 6) * 32 + (col0 & 31);
#pragma unroll
      for (int m = 0; m < 4; ++m) {
        const int row = row0 + m * 16;
        if (row < mt.cnt) {
#pragma unroll
          for (int nn = 0; nn < 2; ++nn) {
            float hv[4];
#pragma unroll
            for (int r = 0; r < 4; ++r) { const float gt = acc[m][nn][r]; hv[r] = gt * sigmoidf_(gt) * acc[m][nn + 2][r]; }
            uint2 w; w.x = pk2(hv[0], hv[1]); w.y = pk2(hv[2], hv[3]);
            *(uint2*)(hbuf + (size_t)(mt.hbase + row) * 512 + ocol0 + nn * 16) = w;
          }
        }
      }
    }, smem);
  }
}
__device__ __forceinline__ void phase_moe2(const P& p, int layer, char* smem) {
  const int* cnt = (const int*)(p.ws + WS_CNT) + layer * 32;
  const int* list = (const int*)(p.ws + WS_LIST);
  const float* gate = (const float*)(p.ws + WS_GATE);
  const u16* hbuf = (const u16*)(p.ws + WS_H);
  u16* slots = (u16*)(p.ws + WS_INC);
  for (int t = blockIdx.x;; t += gridDim.x) {
    MoeTile mt; if (!moe_decode(cnt, t, mt)) break;
    GemmDesc g{}; g.A = hbuf + (size_t)mt.hbase * 512; g.lda = 512; g.mvalid = mt.cnt;
    g.W = p.w_down + (size_t)(layer * 32 + mt.e) * 512 * DM; g.ldw = DM; g.K = 512;
    gemm_tile(g, mt.rt * 128, mt.ct * 128, [&](f32x4 (&acc)[4][4], int row0, int col0) {
#pragma unroll
      for (int m = 0; m < 4; ++m) {
        const int row = row0 + m * 16;
        if (row < mt.cnt) {
          const int asg = list[(size_t)mt.e * CAP + row];
          const float gt = gate[asg];
#pragma unroll
          for (int n = 0; n < 4; ++n) {
            uint2 w; w.x = pk2(gt * acc[m][n][0], gt * acc[m][n][1]); w.y = pk2(gt * acc[m][n][2], gt * acc[m][n][3]);
            *(uint2*)(slots + (size_t)asg * DM + col0 + n * 16) = w;
          }
        }
      }
    }, smem);
  }
}

constexpr int KSTR = 72;
__device__ __forceinline__ int t5_bucket_abs(int n) {
  return n < 8 ? n : 8 + (n >= 12) + (n >= 16) + (n >= 23) + (n >= 32) + (n >= 46) + (n >= 64) + (n >= 91);
}
__device__ __forceinline__ void phase_attn_naive(const P& p, char* smem) {
  u16* sK = (u16*)smem; u16* sV = sK + 384 * KSTR; float* sBias = (float*)(sV + 384 * KSTR);
  const u16* q1 = (const u16*)(p.ws + WS_Z); const u16* k1 = (const u16*)(p.ws + WS_Z + 32 * MB); const u16* v1 = (const u16*)(p.ws + WS_Z + 40 * MB);
  u16* ao = (u16*)(p.ws + WS_YCAT);
  const int tid = threadIdx.x;
  for (int item = blockIdx.x; item < 512; item += gridDim.x) {
    const int b = item >> 6, nb = (item >> 2) & 15, kvh = item & 3;
    __syncthreads();
    for (int c = tid; c < 384 * 8; c += NTHR) {
      const int s = c >> 3, ch = (c & 7) * 8, pos = (nb - 1) * 128 + s;
      uint4 kq = make_uint4(0u, 0u, 0u, 0u), vq = kq;
      if (pos >= 0 && pos < SEQ) { kq = *(const uint4*)(k1 + (size_t)(b * SEQ + pos) * 256 + kvh * 64 + ch); vq = *(const uint4*)(v1 + (size_t)(b * SEQ + pos) * 256 + kvh * 64 + ch); }
      *(uint4*)(sK + s * KSTR + ch) = kq; *(uint4*)(sV + s * KSTR + ch) = vq;
    }
    for (int c = tid; c < 4 * 257; c += NTHR) {
      const int hq = c / 257, ri = c % 257, rel = ri - 128, n = rel < 0 ? -rel : rel;
      const int bucket = (rel > 0 ? 16 : 0) + t5_bucket_abs(n);
      sBias[hq * 260 + ri] = p.rel_bias[bucket * 16 + kvh * 4 + hq];
    }
    __syncthreads();
    for (int pass = 0; pass < 2; ++pass) {
      const int hq = pass * 2 + (tid >> 7), qi = tid & 127, head = kvh * 4 + hq;
      const size_t tok = (size_t)b * SEQ + nb * 128 + qi;
      float q[64];
#pragma unroll
      for (int d = 0; d < 64; d += 8) {
        const uint4 qq = *(const uint4*)(q1 + tok * DM + head * 64 + d);
        q[d] = lo16(qq.x); q[d + 1] = hi16(qq.x); q[d + 2] = lo16(qq.y); q[d + 3] = hi16(qq.y); q[d + 4] = lo16(qq.z); q[d + 5] = hi16(qq.z); q[d + 6] = lo16(qq.w); q[d + 7] = hi16(qq.w);
      }
      float mx = p.sink[head], l = 1.0f, o[64];
#pragma unroll
      for (int d = 0; d < 64; ++d) o[d] = 0.f;
      for (int r = 0; r <= 256; ++r) {
        const int s = qi + r, pos = (nb - 1) * 128 + s;
        if (pos < 0 || pos >= SEQ) continue;
        float sc = 0.f;
#pragma unroll
        for (int d = 0; d < 64; d += 8) {
          const uint4 kq = *(const uint4*)(sK + s * KSTR + d);
          sc += q[d] * lo16(kq.x) + q[d + 1] * hi16(kq.x) + q[d + 2] * lo16(kq.y) + q[d + 3] * hi16(kq.y) + q[d + 4] * lo16(kq.z) + q[d + 5] * hi16(kq.z) + q[d + 6] * lo16(kq.w) + q[d + 7] * hi16(kq.w);
        }
        sc += sBias[hq * 260 + r];
        const float mn = fmaxf(mx, sc), alpha = __expf(mx - mn), pe = __expf(sc - mn);
        l = l * alpha + pe; mx = mn;
#pragma unroll
        for (int d = 0; d < 64; d += 8) {
          const uint4 vq = *(const uint4*)(sV + s * KSTR + d);
          o[d] = o[d] * alpha + pe * lo16(vq.x); o[d + 1] = o[d + 1] * alpha + pe * hi16(vq.x); o[d + 2] = o[d + 2] * alpha + pe * lo16(vq.y); o[d + 3] = o[d + 3] * alpha + pe * hi16(vq.y);
          o[d + 4] = o[d + 4] * alpha + pe * lo16(vq.z); o[d + 5] = o[d + 5] * alpha + pe * hi16(vq.z); o[d + 6] = o[d + 6] * alpha + pe * lo16(vq.w); o[d + 7] = o[d + 7] * alpha + pe * hi16(vq.w);
        }
      }
      const float inv = 1.0f / l;
#pragma unroll
      for (int d = 0; d < 64; d += 8) {
        uint4 w; w.x = pk2(o[d] * inv, o[d + 1] * inv); w.y = pk2(o[d + 2] * inv, o[d + 3] * inv); w.z = pk2(o[d + 4] * inv, o[d + 5] * inv); w.w = pk2(o[d + 6] * inv, o[d + 7] * inv);
        *(uint4*)(ao + tok * DM + head * 64 + d) = w;
      }
    }
  }
}

constexpr int VSTR = 392;
__device__ __forceinline__ void phase_attn(const P& p, char* smem) {
  u16* sK = (u16*)smem; u16* sVt = sK + 384 * KSTR; float* sBias = (float*)(sVt + 64 * VSTR);
  const u16* q1 = (const u16*)(p.ws + WS_Z); const u16* k1 = (const u16*)(p.ws + WS_Z + 32 * MB); const u16* v1 = (const u16*)(p.ws + WS_Z + 40 * MB);
  u16* ao = (u16*)(p.ws + WS_YCAT);
  const int tid = threadIdx.x, lane = tid & 63, wv = tid >> 6, fr = lane & 15, lg = lane >> 4, q0 = wv * 32;
  for (int item = blockIdx.x; item < 512; item += gridDim.x) {
    const int b = item >> 6, nb = (item >> 2) & 15, kvh = item & 3;
    __syncthreads();
    for (int c = tid; c < 384 * 8; c += NTHR) {
      const int s = c >> 3, ch = (c & 7) * 8, pos = (nb - 1) * 128 + s;
      uint4 kq = make_uint4(0u, 0u, 0u, 0u), vq = kq;
      if (pos >= 0 && pos < SEQ) { kq = *(const uint4*)(k1 + (size_t)(b * SEQ + pos) * 256 + kvh * 64 + ch); vq = *(const uint4*)(v1 + (size_t)(b * SEQ + pos) * 256 + kvh * 64 + ch); }
      *(uint4*)(sK + s * KSTR + ch) = kq;
      const unsigned vw[4] = {vq.x, vq.y, vq.z, vq.w};
#pragma unroll
      for (int j = 0; j < 4; ++j) { sVt[(ch + 2 * j) * VSTR + s] = (u16)(vw[j] & 0xffffu); sVt[(ch + 2 * j + 1) * VSTR + s] = (u16)(vw[j] >> 16); }
    }
    for (int c = tid; c < 4 * 257; c += NTHR) {
      const int hq = c / 257, ri = c % 257, rel = ri - 128, n = rel < 0 ? -rel : rel;
      const int bucket = (rel > 0 ? 16 : 0) + t5_bucket_abs(n);
      sBias[hq * 260 + ri] = p.rel_bias[bucket * 16 + kvh * 4 + hq];
    }
    __syncthreads();
    for (int hq = 0; hq < 4; ++hq) {
      const int head = kvh * 4 + hq;
      const size_t tok0 = (size_t)b * SEQ + nb * 128 + q0;
      uint4 qf[2][2];
#pragma unroll
      for (int qb = 0; qb < 2; ++qb)
#pragma unroll
        for (int ks = 0; ks < 2; ++ks) qf[qb][ks] = *(const uint4*)(q1 + (tok0 + qb * 16 + fr) * DM + head * 64 + ks * 32 + lg * 8);
      f32x4 O[4][2];
#pragma unroll
      for (int mb = 0; mb < 4; ++mb)
#pragma unroll
        for (int qb = 0; qb < 2; ++qb) O[mb][qb] = (f32x4){0.f, 0.f, 0.f, 0.f};
      const float sinkv = p.sink[head];
      float mrun[2] = {sinkv, sinkv}, lpart[2] = {lg == 0 ? 1.0f : 0.0f, lg == 0 ? 1.0f : 0.0f};
#pragma unroll
      for (int c = 0; c < 3; ++c) {
        if ((c == 0 && nb == 0) || (c == 2 && nb == 15)) continue;
        f32x4 S[8][2];
#pragma unroll
        for (int kb = 0; kb < 8; ++kb) {
          S[kb][0] = (f32x4){0.f, 0.f, 0.f, 0.f}; S[kb][1] = S[kb][0];
          const bool act = (c == 0) ? (16 * kb + 15 >= q0) : ((c == 2) ? (16 * kb <= q0 + 31) : true);
          if (act) {
#pragma unroll
            for (int ks = 0; ks < 2; ++ks) {
              const uint4 kf = *(const uint4*)(sK + (c * 128 + kb * 16 + fr) * KSTR + ks * 32 + lg * 8);
              S[kb][0] = mfma16(kf, qf[0][ks], S[kb][0]);
              S[kb][1] = mfma16(kf, qf[1][ks], S[kb][1]);
            }
          }
        }
        float cmax[2] = {-1e30f, -1e30f};
#pragma unroll
        for (int kb = 0; kb < 8; ++kb)
#pragma unroll
          for (int qb = 0; qb < 2; ++qb)
#pragma unroll
            for (int r = 0; r < 4; ++r) {
              const int sidx = c * 128 + kb * 16 + 4 * lg + r, qi = q0 + qb * 16 + fr, rel = sidx - 128 - qi;
              const bool valid = (rel >= -128) && (rel <= 128);
              const float v = valid ? S[kb][qb][r] + sBias[hq * 260 + (valid ? rel + 128 : 0)] : -1e30f;
              S[kb][qb][r] = v; cmax[qb] = fmaxf(cmax[qb], v);
            }
#pragma unroll
        for (int qb = 0; qb < 2; ++qb) {
          cmax[qb] = fmaxf(cmax[qb], __shfl_xor(cmax[qb], 16)); cmax[qb] = fmaxf(cmax[qb], __shfl_xor(cmax[qb], 32));
          const float mn = fmaxf(mrun[qb], cmax[qb]), alpha = __expf(mrun[qb] - mn);
          mrun[qb] = mn; lpart[qb] *= alpha;
#pragma unroll
          for (int mb = 0; mb < 4; ++mb) O[mb][qb] = O[mb][qb] * alpha;
          float ps = 0.f;
#pragma unroll
          for (int kb = 0; kb < 8; ++kb)
#pragma unroll
            for (int r = 0; r < 4; ++r) { const float e = __expf(S[kb][qb][r] - mn); S[kb][qb][r] = e; ps += e; }
          lpart[qb] += ps;
        }
#pragma unroll
        for (int kk = 0; kk < 4; ++kk) {
          const int kb0 = 2 * kk, kb1 = 2 * kk + 1;
          const bool act = (c == 0) ? (16 * kb1 + 15 >= q0) : ((c == 2) ? (16 * kb0 <= q0 + 31) : true);
          if (act) {
            uint4 pf[2];
#pragma unroll
            for (int qb = 0; qb < 2; ++qb) pf[qb] = make_uint4(pk2(S[kb0][qb][0], S[kb0][qb][1]), pk2(S[kb0][qb][2], S[kb0][qb][3]), pk2(S[kb1][qb][0], S[kb1][qb][1]), pk2(S[kb1][qb][2], S[kb1][qb][3]));
#pragma unroll
            for (int mb = 0; mb < 4; ++mb) {
              const uint2 v0 = *(const uint2*)(sVt + (mb * 16 + fr) * VSTR + c * 128 + kb0 * 16 + 4 * lg);
              const uint2 v1r = *(const uint2*)(sVt + (mb * 16 + fr) * VSTR + c * 128 + kb1 * 16 + 4 * lg);
              const uint4 vf = make_uint4(v0.x, v0.y, v1r.x, v1r.y);
              O[mb][0] = mfma16(vf, pf[0], O[mb][0]);
              O[mb][1] = mfma16(vf, pf[1], O[mb][1]);
            }
          }
        }
      }
#pragma unroll
      for (int qb = 0; qb < 2; ++qb) {
        float lt = lpart[qb]; lt += __shfl_xor(lt, 16); lt += __shfl_xor(lt, 32);
        const float inv = 1.0f / lt;
#pragma unroll
        for (int mb = 0; mb < 4; ++mb) {
          uint2 w; w.x = pk2(O[mb][qb][0] * inv, O[mb][qb][1] * inv); w.y = pk2(O[mb][qb][2] * inv, O[mb][qb][3] * inv);
          *(uint2*)(ao + (tok0 + qb * 16 + fr) * DM + head * 64 + mb * 16 + 4 * lg) = w;
        }
      }
    }
  }
}

constexpr int NPHASE = 20;
constexpr int LDS_BYTES = 141312;
__device__ __forceinline__ void run_phase(const P& p, int ph, char* smem) {
  float* xa = (float*)(p.ws + WS_XA);
  const u16* ycat = (const u16*)(p.ws + WS_YCAT);
  const u16* slots = (const u16*)(p.ws + WS_INC);
  switch (ph) {
    case 0: phase_prep(p); phase_s5_ktab(p); break;
    case 1: phase_rowpass(p, p.x, nullptr, nullptr, p.norm_mix_g, -1, nullptr); phase_s5_fill(p); break;
    case 2: phase_inproj(p, smem); break;
    case 3: phase_ret_inc_mfma(p, smem); phase_s5_egemm(p, smem); break;
    case 4: phase_ret_scan16(p); phase_s5_carry(p); break;
    case 5: phase_ret_out_mfma(p, smem); phase_s5_ygemm(p, smem); break;
    case 6: break;
    case 7: phase_glu(p, smem); break;
    case 8: phase_outproj(p, ycat, p.w_out, p.x, xa, smem); break;
    case 9: phase_rowpass(p, xa, nullptr, nullptr, p.norm_ffn_g, 0, nullptr); break;
    case 10: phase_moe1(p, 0, smem); break;
    case 11: phase_moe2(p, 0, smem); break;
    case 12: phase_rowpass(p, xa, slots, xa, p.norm_mix_g + DM, -1, nullptr); break;
    case 13: phase_qkv(p, smem); break;
    case 14: phase_attn(p, smem); break;
    case 15: phase_outproj(p, ycat, p.w_o, xa, xa, smem); break;
    case 16: phase_rowpass(p, xa, nullptr, nullptr, p.norm_ffn_g + DM, 1, nullptr); break;
    case 17: phase_moe1(p, 1, smem); break;
    case 18: phase_moe2(p, 1, smem); break;
    case 19: phase_rowpass(p, xa, slots, nullptr, p.norm_final_g, -1, p.out); break;
    default: break;
  }
}

extern __shared__ __attribute__((aligned(16))) char dyn_smem[];

#if MULTI_LAUNCH
__global__ void __launch_bounds__(NTHR) k_phase(P p, int ph) { run_phase(p, ph, dyn_smem); }
#else

template <int PH> __device__ __forceinline__ void mega_steps(const P& p, char* smem, cg::grid_group& grid) {
  run_phase(p, PH, smem);
  if constexpr (PH + 1 < NPHASE) { grid.sync(); mega_steps<PH + 1>(p, smem, grid); }
}
__global__ void __launch_bounds__(NTHR) k_mega(P p) {
  cg::grid_group grid = cg::this_grid();
  mega_steps<0>(p, dyn_smem, grid);
}
#endif

extern "C" void kernel_launch(void* const* d_in, const int* in_sizes, int n_in, void* d_out, int out_size, void* d_ws, size_t ws_size, hipStream_t stream) {
  static int grid_blocks = 0;
  if (grid_blocks == 0) {
    if (n_in != 28 || out_size != T_TOK * DM || ws_size < WS_END) { fprintf(stderr, "kernel_launch: unexpected problem (n_in %d out %d ws %zu need %zu)\n", n_in, out_size, ws_size, (size_t)WS_END); grid_blocks = -1; return; }
    int dev = 0, cus = 0, per_cu = 0;
    (void)hipGetDevice(&dev);
    (void)hipDeviceGetAttribute(&cus, hipDeviceAttributeMultiprocessorCount, dev);
#if MULTI_LAUNCH
    const void* fn = (const void*)k_phase;
#else
    const void* fn = (const void*)k_mega;
#endif
    if (hipFuncSetAttribute(fn, hipFuncAttributeMaxDynamicSharedMemorySize, LDS_BYTES) != hipSuccess) { fprintf(stderr, "kernel_launch: hipFuncSetAttribute failed\n"); }
    if (hipOccupancyMaxActiveBlocksPerMultiprocessor(&per_cu, fn, NTHR, LDS_BYTES) != hipSuccess || per_cu < 1) { fprintf(stderr, "kernel_launch: occupancy query failed (%d)\n", per_cu); per_cu = 1; }
    (void)hipGetLastError();
    grid_blocks = cus * per_cu;
    fprintf(stderr, "kernel_launch: cus %d per_cu %d grid %d\n", cus, per_cu, grid_blocks);
  }
  if (grid_blocks < 0) return;
  P p{};
  const float** pp = (const float**)&p;
  for (int i = 0; i < 28; ++i) pp[i] = (const float*)d_in[i];
  p.out = (float*)d_out; p.ws = (char*)d_ws;
#if MULTI_LAUNCH
  for (int ph = 0; ph < NPHASE; ++ph) hipLaunchKernelGGL(k_phase, dim3(grid_blocks), dim3(NTHR), LDS_BYTES, stream, p, ph);
#else
  void* args[] = {&p};
  hipError_t e = hipLaunchCooperativeKernel((const void*)k_mega, dim3(grid_blocks), dim3(NTHR), args, LDS_BYTES, stream);
  if (e != hipSuccess) fprintf(stderr, "cooperative launch failed: %s (grid %d)\n", hipGetErrorString(e), grid_blocks);
#endif
}
```

```cpp
#include <hip/hip_runtime.h>
#include <hip/hip_cooperative_groups.h>
#include <cstdio>
#include <cstdint>
namespace cg = cooperative_groups;

#ifndef USE_FP16
#define USE_FP16 1
#endif
#ifndef MULTI_LAUNCH
#define MULTI_LAUNCH 0
#endif

typedef unsigned short u16;
typedef float f32x4 __attribute__((ext_vector_type(4)));
typedef float f32x2 __attribute__((ext_vector_type(2)));
typedef _Float16 f16x8 __attribute__((ext_vector_type(8)));
typedef __bf16 b16x8 __attribute__((ext_vector_type(8)));

constexpr int T_TOK = 16384, DM = 1024, SEQ = 2048, NBATCH = 8;
constexpr int CAP = 32768;
constexpr int NTHR = 256;

constexpr size_t MB = 1024ull * 1024ull;
constexpr size_t WS_XA    = 0;
constexpr size_t WS_XB    = WS_XA + 64 * MB;
constexpr size_t WS_Z     = WS_XB + 32 * MB;
constexpr size_t WS_A2    = WS_Z + 64 * MB;
constexpr size_t WS_INC   = WS_A2 + 24 * MB;
constexpr size_t WS_YCAT  = WS_INC + 64 * MB;
constexpr size_t WS_YGELU = WS_YCAT + 32 * MB;
constexpr size_t WS_H     = WS_YGELU + 16 * MB;
constexpr size_t WS_LIST  = WS_H + 36 * MB;
constexpr size_t WS_GATE  = WS_LIST + 4 * MB;
constexpr size_t WS_ROPE  = WS_GATE + 1 * MB;
constexpr size_t WS_CNT   = WS_ROPE + 1 * MB;
constexpr size_t WS_KTAB  = WS_CNT + 1 * MB;
constexpr size_t WS_BTY   = WS_KTAB + 2 * MB;
constexpr size_t WS_WET   = WS_BTY + 24 * MB;
constexpr size_t WS_E     = WS_WET + 8 * MB;
constexpr size_t WS_SP16  = WS_E + 16 * MB;
constexpr size_t WS_BAR   = WS_SP16 + 32 * MB;
constexpr size_t WS_END   = WS_BAR + 1 * MB;

struct P {
  const float *x, *norm_mix_g, *norm_ffn_g, *norm_final_g, *w_in, *ret_decay, *a_re, *a_im, *log_step, *b_re, *b_im, *c_re, *c_im,
      *s5d, *w_glu, *b_glu, *w_out, *w_qkv, *sink, *w_o, *rel_bias, *w_group, *b_group, *w_er, *b_er, *w_gate, *w_up, *w_down;
  float* out;
  char* ws;
};

__device__ __forceinline__ u16 f2h(float f) {
#if USE_FP16
  _Float16 h = (_Float16)f; return __builtin_bit_cast(u16, h);
#else
  unsigned u = __builtin_bit_cast(unsigned, f); u += 0x7fffu + ((u >> 16) & 1u); return (u16)(u >> 16);
#endif
}
__device__ __forceinline__ float h2f(u16 h) {
#if USE_FP16
  return (float)__builtin_bit_cast(_Float16, h);
#else
  return __builtin_bit_cast(float, ((unsigned)h) << 16);
#endif
}
__device__ __forceinline__ unsigned pk2(float a, float b) { return (unsigned)f2h(a) | ((unsigned)f2h(b) << 16); }
__device__ __forceinline__ float lo16(unsigned w) { return h2f((u16)(w & 0xffffu)); }
__device__ __forceinline__ float hi16(unsigned w) { return h2f((u16)(w >> 16)); }
__device__ __forceinline__ f32x4 mfma16(uint4 a, uint4 b, f32x4 c) {
#if USE_FP16
  return __builtin_amdgcn_mfma_f32_16x16x32_f16(__builtin_bit_cast(f16x8, a), __builtin_bit_cast(f16x8, b), c, 0, 0, 0);
#else
  return __builtin_amdgcn_mfma_f32_16x16x32_bf16(__builtin_bit_cast(b16x8, a), __builtin_bit_cast(b16x8, b), c, 0, 0, 0);
#endif
}
__device__ __forceinline__ float wave_sum(float v) {
#pragma unroll
  for (int o = 1; o < 64; o <<= 1) v += __shfl_xor(v, o);
  return v;
}
__device__ __forceinline__ float sigmoidf_(float x) { return 1.0f / (1.0f + __expf(-x)); }
__device__ __forceinline__ float gelu_tanh(float x) {
  const float u = 0.7978845608028654f * (x + 0.044715f * x * x * x);
  return 0.5f * x * (1.0f + tanhf(u));
}

struct GemmDesc {
  const u16* A; long lda;
  const int* rowmap; int rowshift;
  int mvalid;
  const float* W; const float* W2; long ldw;
  const u16* Bt; long ldb;
  int K;
};
constexpr int LSTR = 40;
constexpr int GEMM_LDS = 2 * 128 * LSTR * 2;

template <class Epi>
__device__ __forceinline__ void gemm_tile(const GemmDesc& g, int m0, int n0, Epi&& epi, char* smem) {
  u16* sA = (u16*)smem;
  u16* sB = sA + 128 * LSTR;
  const int tid = threadIdx.x, lane = tid & 63, wid = tid >> 6, wr = wid >> 1, wc = wid & 1, fr = lane & 15, fq = lane >> 4;
  f32x4 acc[4][4];
#pragma unroll
  for (int m = 0; m < 4; ++m)
#pragma unroll
    for (int n = 0; n < 4; ++n) acc[m][n] = (f32x4){0.f, 0.f, 0.f, 0.f};
  const int ar = tid >> 2, akc = (tid & 3) * 8;
  const u16* ap[2];
#pragma unroll
  for (int i = 0; i < 2; ++i) {
    const int m = m0 + ar + i * 64; const u16* q = nullptr;
    if (m < g.mvalid) { const long row = g.rowmap ? (long)(g.rowmap[m] >> g.rowshift) : (long)m; q = g.A + row * g.lda + akc; }
    ap[i] = q;
  }
  const bool useBt = (g.Bt != nullptr);
  const float* wp = nullptr; const u16* bp[2] = {nullptr, nullptr};
  if (!useBt) {
    const int v = n0 + (tid & 31) * 4;
    if (g.W2) wp = ((((v >> 5) & 1) ? g.W2 : g.W) + ((v >> 6) * 32 + (v & 31)));
    else wp = g.W + v;
    wp += (long)((tid >> 5) * 4) * g.ldw;
  } else {
#pragma unroll
    for (int i = 0; i < 2; ++i) bp[i] = g.Bt + (long)(n0 + ar + i * 64) * g.ldb + akc;
  }
  uint4 ra0, ra1, rb0 = make_uint4(0u, 0u, 0u, 0u), rb1 = rb0; f32x4 rw0 = {0.f, 0.f, 0.f, 0.f}, rw1 = rw0, rw2 = rw0, rw3 = rw0;
#define GEMM_GLOAD(k0_)                                                                                   \
  do {                                                                                                    \
    const int kq_ = (k0_);                                                                                \
    ra0 = ap[0] ? *(const uint4*)(ap[0] + kq_) : make_uint4(0u, 0u, 0u, 0u);                              \
    ra1 = ap[1] ? *(const uint4*)(ap[1] + kq_) : make_uint4(0u, 0u, 0u, 0u);                              \
    if (useBt) { rb0 = *(const uint4*)(bp[0] + kq_); rb1 = *(const uint4*)(bp[1] + kq_); }               \
    else {                                                                                                \
      rw0 = *(const f32x4*)(wp + (long)(kq_ + 0) * g.ldw); rw1 = *(const f32x4*)(wp + (long)(kq_ + 1) * g.ldw); \
      rw2 = *(const f32x4*)(wp + (long)(kq_ + 2) * g.ldw); rw3 = *(const f32x4*)(wp + (long)(kq_ + 3) * g.ldw); \
    }                                                                                                     \
  } while (0)
  GEMM_GLOAD(0);
  for (int k0 = 0; k0 < g.K; k0 += 32) {
    __syncthreads();
    *(uint4*)(sA + ar * LSTR + akc) = ra0; *(uint4*)(sA + (ar + 64) * LSTR + akc) = ra1;
    if (useBt) {
      *(uint4*)(sB + ar * LSTR + akc) = rb0; *(uint4*)(sB + (ar + 64) * LSTR + akc) = rb1;
    } else {
      const int nl = (tid & 31) * 4, kl = (tid >> 5) * 4;
#pragma unroll
      for (int c = 0; c < 4; ++c) {
        uint2 v; v.x = pk2(rw0[c], rw1[c]); v.y = pk2(rw2[c], rw3[c]);
        *(uint2*)(sB + (nl + c) * LSTR + kl) = v;
      }
    }
    __syncthreads();
    if (k0 + 32 < g.K) GEMM_GLOAD(k0 + 32);
    uint4 fa[4], fb[4];
#pragma unroll
    for (int m = 0; m < 4; ++m) fa[m] = *(const uint4*)(sA + (wr * 64 + m * 16 + fr) * LSTR + fq * 8);
#pragma unroll
    for (int n = 0; n < 4; ++n) fb[n] = *(const uint4*)(sB + (wc * 64 + n * 16 + fr) * LSTR + fq * 8);
#pragma unroll
    for (int m = 0; m < 4; ++m)
#pragma unroll
      for (int n = 0; n < 4; ++n) acc[m][n] = mfma16(fb[n], fa[m], acc[m][n]);
  }
  epi(acc, m0 + wr * 64 + fr, n0 + wc * 64 + fq * 4);
}

__device__ __forceinline__ void phase_prep(const P& p) {
  const int gtid = blockIdx.x * NTHR + threadIdx.x, gsz = gridDim.x * NTHR;
  int* cnt = (int*)(p.ws + WS_CNT);
  if (gtid < 64) cnt[gtid] = 0;
  f32x2* rope = (f32x2*)(p.ws + WS_ROPE);
  for (int i = gtid; i < SEQ * 64; i += gsz) {
    const int pos = i >> 6, f = i & 63;
    const float inv = powf(10000.0f, -(float)(2 * f) / 128.0f);
    const float ang = (float)pos * inv;
    float s, c; sincosf(ang, &s, &c);
    rope[i] = (f32x2){c, s};
  }
}

__device__ __forceinline__ void phase_rowpass(const P& p, const float* src, const u16* slots, float* dstx, const float* gain, int route_layer, float* fout) {
  const int lane = threadIdx.x & 63, gw = blockIdx.x * 4 + (threadIdx.x >> 6), nw = gridDim.x * 4;
  u16* xb = (u16*)(p.ws + WS_XB);
  int* cnt = (int*)(p.ws + WS_CNT);
  int* list = (int*)(p.ws + WS_LIST);
  float* gate = (float*)(p.ws + WS_GATE);
  for (int row = gw; row < T_TOK; row += nw) {
    f32x4 v[4];
    float ss = 0.f;
#pragma unroll
    for (int i = 0; i < 4; ++i) {
      const int k = (i * 64 + lane) * 4;
      v[i] = *(const f32x4*)(src + (size_t)row * DM + k);
      if (slots) {
#pragma unroll
        for (int s = 0; s < 2; ++s) {
          const uint2 w = *(const uint2*)(slots + ((size_t)row * 2 + s) * DM + k);
          v[i][0] += lo16(w.x); v[i][1] += hi16(w.x); v[i][2] += lo16(w.y); v[i][3] += hi16(w.y);
        }
      }
      if (dstx) *(f32x4*)(dstx + (size_t)row * DM + k) = v[i];
      ss += v[i][0] * v[i][0] + v[i][1] * v[i][1] + v[i][2] * v[i][2] + v[i][3] * v[i][3];
    }
    ss = wave_sum(ss);
    const float rstd = rsqrtf(ss * (1.0f / DM) + 1e-6f);
#pragma unroll
    for (int i = 0; i < 4; ++i) {
      const int k = (i * 64 + lane) * 4;
      const f32x4 gv = *(const f32x4*)(gain + k);
      v[i] = v[i] * rstd * gv;
      if (fout) *(f32x4*)(fout + (size_t)row * DM + k) = v[i];
      else { uint2 w; w.x = pk2(v[i][0], v[i][1]); w.y = pk2(v[i][2], v[i][3]); *(uint2*)(xb + (size_t)row * DM + k) = w; }
    }
    if (route_layer >= 0) {
      const float* wg = p.w_group + (size_t)route_layer * DM * 4;
      const float* we = p.w_er + (size_t)route_layer * 4 * DM * 8;
      float acc[36];
#pragma unroll
      for (int j = 0; j < 36; ++j) acc[j] = 0.f;
#pragma unroll
      for (int i = 0; i < 4; ++i) {
#pragma unroll
        for (int c = 0; c < 4; ++c) {
          const int k = (i * 64 + lane) * 4 + c;
          const float hv = v[i][c];
          const f32x4 g4 = *(const f32x4*)(wg + (size_t)k * 4);
#pragma unroll
          for (int j = 0; j < 4; ++j) acc[j] += hv * g4[j];
#pragma unroll
          for (int gg = 0; gg < 4; ++gg) {
            const f32x4 e0 = *(const f32x4*)(we + ((size_t)gg * DM + k) * 8);
            const f32x4 e1 = *(const f32x4*)(we + ((size_t)gg * DM + k) * 8 + 4);
#pragma unroll
            for (int j = 0; j < 4; ++j) { acc[4 + gg * 8 + j] += hv * e0[j]; acc[4 + gg * 8 + 4 + j] += hv * e1[j]; }
          }
        }
      }
#pragma unroll
      for (int j = 0; j < 36; ++j) acc[j] = wave_sum(acc[j]);
      if (lane == 0) {
        const float* bg = p.b_group + route_layer * 4;
        const float* be = p.b_er + route_layer * 32;
        float gl[4];
#pragma unroll
        for (int j = 0; j < 4; ++j) gl[j] = acc[j] + bg[j];
        int gs = 0; float gm = gl[0];
#pragma unroll
        for (int j = 1; j < 4; ++j) if (gl[j] > gm) { gm = gl[j]; gs = j; }
        float den = 0.f;
#pragma unroll
        for (int j = 0; j < 4; ++j) den += expf(gl[j] - gm);
        const float pg = 1.0f / den;
        float el[8];
#pragma unroll
        for (int j = 0; j < 8; ++j) {
          float a = acc[4 + j];
#pragma unroll
          for (int gg = 1; gg < 4; ++gg) a = (gs == gg) ? acc[4 + gg * 8 + j] : a;
          el[j] = a + be[gs * 8 + j];
        }
        int i1 = 0; float v1 = el[0];
#pragma unroll
        for (int j = 1; j < 8; ++j) if (el[j] > v1) { v1 = el[j]; i1 = j; }
        int i2 = -1; float v2 = -3.0e38f;
#pragma unroll
        for (int j = 0; j < 8; ++j) if (j != i1 && el[j] > v2) { v2 = el[j]; i2 = j; }
        const float e2 = expf(v2 - v1);
        const float g1 = pg / (1.0f + e2), g2 = pg * e2 / (1.0f + e2);
        const int ex1 = gs * 8 + i1, ex2 = gs * 8 + i2;
        const int r1 = atomicAdd(&cnt[route_layer * 32 + ex1], 1);
        list[(size_t)ex1 * CAP + r1] = row * 2;
        gate[row * 2] = g1;
        const int r2 = atomicAdd(&cnt[route_layer * 32 + ex2], 1);
        list[(size_t)ex2 * CAP + r2] = row * 2 + 1;
        gate[row * 2 + 1] = g2;
      }
    }
  }
}

__device__ __forceinline__ void phase_inproj(const P& p, char* smem) {
  GemmDesc g{}; g.A = (const u16*)(p.ws + WS_XB); g.lda = DM; g.mvalid = T_TOK; g.W = p.w_in; g.ldw = 2560; g.K = DM;
  u16* zb = (u16*)(p.ws + WS_Z); u16* a2 = (u16*)(p.ws + WS_A2);
  const int ntiles = 128 * 20;
  for (int t = blockIdx.x; t < ntiles; t += gridDim.x) {
    const int mt = t / 20, nt = t % 20;
    gemm_tile(g, mt * 128, nt * 128, [&](f32x4 (&acc)[4][4], int row0, int col0) {
      const int seg = (nt * 128) / 512;
#pragma unroll
      for (int m = 0; m < 4; ++m)
#pragma unroll
        for (int n = 0; n < 4; ++n) {
          const int row = row0 + m * 16, col = col0 + n * 16;
          uint2 w; w.x = pk2(acc[m][n][0], acc[m][n][1]); w.y = pk2(acc[m][n][2], acc[m][n][3]);
          if (seg < 4) *(uint2*)(zb + (size_t)seg * T_TOK * 512 + (size_t)row * 512 + (col - seg * 512)) = w;
          else { const int ch = col - 2048, gi = ch >> 4, c = ch & 15; *(uint2*)(a2 + ((size_t)gi * 512 + (row >> 5)) * 768 + (row & 31) * 16 + c) = w; }
        }
    }, smem);
  }
}

constexpr int RSTR = 136;
__device__ __forceinline__ void ret_load_tile(u16* dst, const u16* src, int t0, int h, int mode  , const f32x2* rope) {
  const int pos0 = t0 & (SEQ - 1);
  for (int idx = threadIdx.x; idx < 128 * 64; idx += NTHR) {
    const int i = idx >> 6, d = idx & 63;
    float t1 = h2f(src[(size_t)(t0 + i) * 512 + h * 128 + d]), t2 = h2f(src[(size_t)(t0 + i) * 512 + h * 128 + d + 64]);
    if (mode) {
      const f32x2 cs = rope[(pos0 + i) * 64 + d];
      const float o1 = t1 * cs[0] - t2 * cs[1], o2 = t1 * cs[1] + t2 * cs[0];
      t1 = o1; t2 = o2;
      if (mode == 2) { t1 *= 0.08838834764831845f; t2 *= 0.08838834764831845f; }
    }
    dst[i * RSTR + d] = f2h(t1); dst[i * RSTR + d + 64] = f2h(t2);
  }
}
__device__ __forceinline__ float log_sigmoid(float x) { return -log1pf(expf(-x)); }

__device__ __forceinline__ void phase_ret_inc(const P& p, char* smem) {
  u16* sK = (u16*)smem; u16* sV = sK + 128 * RSTR; float* sWf = (float*)(sV + 128 * RSTR); float* sWb = sWf + 128;
  const u16* kb = (const u16*)(p.ws + WS_Z) + (size_t)1 * T_TOK * 512; const u16* vb = (const u16*)(p.ws + WS_Z) + (size_t)2 * T_TOK * 512;
  const f32x2* rope = (const f32x2*)(p.ws + WS_ROPE);
  float* incf = (float*)(p.ws + WS_INC); float* incb = incf + (size_t)512 * 16384;
  const int tid = threadIdx.x;
  for (int item = blockIdx.x; item < 512; item += gridDim.x) {
    const int h = item & 3, bn = item >> 2, t0 = bn * 128;
    const float lgf = log_sigmoid(p.ret_decay[h]), lgb = log_sigmoid(p.ret_decay[4 + h]);
    __syncthreads();
    ret_load_tile(sK, kb, t0, h, 2, rope);
    ret_load_tile(sV, vb, t0, h, 0, rope);
    if (tid < 128) { sWf[tid] = expf(lgf * (float)(127 - tid)); sWb[tid] = expf(lgb * (float)tid); }
    __syncthreads();
    const int d0 = (tid >> 4) * 8, e0 = (tid & 15) * 8;
    float af[8][8], ab[8][8];
#pragma unroll
    for (int a = 0; a < 8; ++a)
#pragma unroll
      for (int b = 0; b < 8; ++b) { af[a][b] = 0.f; ab[a][b] = 0.f; }
    for (int j = 0; j < 128; ++j) {
      const uint4 kq = *(const uint4*)(sK + j * RSTR + d0), vq = *(const uint4*)(sV + j * RSTR + e0);
      const float kd[8] = {lo16(kq.x), hi16(kq.x), lo16(kq.y), hi16(kq.y), lo16(kq.z), hi16(kq.z), lo16(kq.w), hi16(kq.w)};
      const float ve[8] = {lo16(vq.x), hi16(vq.x), lo16(vq.y), hi16(vq.y), lo16(vq.z), hi16(vq.z), lo16(vq.w), hi16(vq.w)};
      const float wf = sWf[j], wb = sWb[j];
#pragma unroll
      for (int a = 0; a < 8; ++a) {
        const float kf = kd[a] * wf, kbw = kd[a] * wb;
#pragma unroll
        for (int b = 0; b < 8; ++b) { af[a][b] += kf * ve[b]; ab[a][b] += kbw * ve[b]; }
      }
    }
#pragma unroll
    for (int a = 0; a < 8; ++a) {
      float* of = incf + (size_t)item * 16384 + (d0 + a) * 128 + e0;
      float* ob = incb + (size_t)item * 16384 + (d0 + a) * 128 + e0;
      *(f32x4*)of = (f32x4){af[a][0], af[a][1], af[a][2], af[a][3]}; *(f32x4*)(of + 4) = (f32x4){af[a][4], af[a][5], af[a][6], af[a][7]};
      *(f32x4*)ob = (f32x4){ab[a][0], ab[a][1], ab[a][2], ab[a][3]}; *(f32x4*)(ob + 4) = (f32x4){ab[a][4], ab[a][5], ab[a][6], ab[a][7]};
    }
  }
}

__device__ __forceinline__ void phase_ret_scan(const P& p) {
  float* incf = (float*)(p.ws + WS_INC); float* incb = incf + (size_t)512 * 16384;
  const int gtid = blockIdx.x * NTHR + threadIdx.x, gsz = gridDim.x * NTHR;
  for (int idx = gtid; idx < 32 * 16384; idx += gsz) {
    const int de = idx & 16383, bh = idx >> 14, b = bh >> 2, h = bh & 3;
    const float Gf = expf(128.0f * log_sigmoid(p.ret_decay[h])), Gb = expf(128.0f * log_sigmoid(p.ret_decay[4 + h]));
    float s = 0.f;
    for (int n = 0; n < 16; ++n) { float* q = incf + ((size_t)((b * 16 + n) * 4 + h)) * 16384 + de; const float t = *q; *q = s; s = s * Gf + t; }
    s = 0.f;
    for (int n = 15; n >= 0; --n) { float* q = incb + ((size_t)((b * 16 + n) * 4 + h)) * 16384 + de; const float t = *q; *q = s; s = s * Gb + t; }
  }
}

__device__ __forceinline__ void phase_ret_out(const P& p, char* smem) {
  u16* sQ = (u16*)smem; u16* sK = sQ + 128 * RSTR; u16* sV = sK + 128 * RSTR; u16* sS = sV + 128 * RSTR;
  float* sPf = (float*)(sS + 128 * RSTR); float* sPb = sPf + 132;
  const u16* zb = (const u16*)(p.ws + WS_Z);
  const u16* qb = zb; const u16* kb = zb + (size_t)1 * T_TOK * 512; const u16* vb = zb + (size_t)2 * T_TOK * 512; const u16* gb = zb + (size_t)3 * T_TOK * 512;
  const f32x2* rope = (const f32x2*)(p.ws + WS_ROPE);
  const float* incf = (const float*)(p.ws + WS_INC); const float* incb = incf + (size_t)512 * 16384;
  u16* ycat = (u16*)(p.ws + WS_YCAT);
  const int tid = threadIdx.x;
  for (int item = blockIdx.x; item < 512; item += gridDim.x) {
    const int h = item & 3, bn = item >> 2, t0 = bn * 128;
    const float lgf = log_sigmoid(p.ret_decay[h]), lgb = log_sigmoid(p.ret_decay[4 + h]);
    __syncthreads();
    ret_load_tile(sQ, qb, t0, h, 1, rope);
    ret_load_tile(sK, kb, t0, h, 2, rope);
    ret_load_tile(sV, vb, t0, h, 0, rope);
    if (tid < 129) { sPf[tid] = expf(lgf * (float)tid); sPb[tid] = expf(lgb * (float)tid); }
    __syncthreads();
    const int i0 = (tid >> 4) * 8, j0 = (tid & 15) * 8;
    {
      float s[8][8];
#pragma unroll
      for (int a = 0; a < 8; ++a)
#pragma unroll
        for (int b = 0; b < 8; ++b) s[a][b] = 0.f;
      for (int d = 0; d < 128; d += 8) {
        float kk[8][8];
#pragma unroll
        for (int b = 0; b < 8; ++b) {
          const uint4 kq = *(const uint4*)(sK + (j0 + b) * RSTR + d);
          kk[b][0] = lo16(kq.x); kk[b][1] = hi16(kq.x); kk[b][2] = lo16(kq.y); kk[b][3] = hi16(kq.y); kk[b][4] = lo16(kq.z); kk[b][5] = hi16(kq.z); kk[b][6] = lo16(kq.w); kk[b][7] = hi16(kq.w);
        }
#pragma unroll
        for (int a = 0; a < 8; ++a) {
          const uint4 qq = *(const uint4*)(sQ + (i0 + a) * RSTR + d);
          const float qv[8] = {lo16(qq.x), hi16(qq.x), lo16(qq.y), hi16(qq.y), lo16(qq.z), hi16(qq.z), lo16(qq.w), hi16(qq.w)};
#pragma unroll
          for (int b = 0; b < 8; ++b)
#pragma unroll
            for (int c = 0; c < 8; ++c) s[a][b] += qv[c] * kk[b][c];
        }
      }
#pragma unroll
      for (int a = 0; a < 8; ++a) {
        unsigned w[4];
#pragma unroll
        for (int b = 0; b < 8; b += 2) {
          const int i = i0 + a, j = j0 + b;
          const float m0 = (i >= j) ? sPf[i - j] : sPb[j - i];
          const float m1 = (i >= j + 1) ? sPf[i - j - 1] : sPb[j + 1 - i];
          w[b >> 1] = pk2(s[a][b] * m0, s[a][b + 1] * m1);
        }
        *(uint4*)(sS + (i0 + a) * RSTR + j0) = make_uint4(w[0], w[1], w[2], w[3]);
      }
    }
    __syncthreads();
    {
      const int e0 = j0;
      float o[8][8];
#pragma unroll
      for (int a = 0; a < 8; ++a)
#pragma unroll
        for (int b = 0; b < 8; ++b) o[a][b] = 0.f;
      for (int j = 0; j < 128; j += 8) {
        float vv[8][8];
#pragma unroll
        for (int c = 0; c < 8; ++c) {
          const uint4 vq = *(const uint4*)(sV + (j + c) * RSTR + e0);
          vv[c][0] = lo16(vq.x); vv[c][1] = hi16(vq.x); vv[c][2] = lo16(vq.y); vv[c][3] = hi16(vq.y); vv[c][4] = lo16(vq.z); vv[c][5] = hi16(vq.z); vv[c][6] = lo16(vq.w); vv[c][7] = hi16(vq.w);
        }
#pragma unroll
        for (int a = 0; a < 8; ++a) {
          const uint4 sq = *(const uint4*)(sS + (i0 + a) * RSTR + j);
          const float sv[8] = {lo16(sq.x), hi16(sq.x), lo16(sq.y), hi16(sq.y), lo16(sq.z), hi16(sq.z), lo16(sq.w), hi16(sq.w)};
#pragma unroll
          for (int c = 0; c < 8; ++c)
#pragma unroll
            for (int b = 0; b < 8; ++b) o[a][b] += sv[c] * vv[c][b];
        }
      }
      const float* sp = incf + (size_t)item * 16384 + e0;
      const float* sn = incb + (size_t)item * 16384 + e0;
      float pf[8], pb[8];
#pragma unroll
      for (int a = 0; a < 8; ++a) { pf[a] = sPf[i0 + a + 1]; pb[a] = sPb[128 - (i0 + a)]; }
      for (int d = 0; d < 128; ++d) {
        const f32x4 p0 = *(const f32x4*)(sp + d * 128), p1 = *(const f32x4*)(sp + d * 128 + 4);
        const f32x4 n0 = *(const f32x4*)(sn + d * 128), n1 = *(const f32x4*)(sn + d * 128 + 4);
        const float spv[8] = {p0[0], p0[1], p0[2], p0[3], p1[0], p1[1], p1[2], p1[3]};
        const float snv[8] = {n0[0], n0[1], n0[2], n0[3], n1[0], n1[1], n1[2], n1[3]};
#pragma unroll
        for (int a = 0; a < 8; ++a) {
          const float qv = h2f(sQ[(i0 + a) * RSTR + d]);
          const float qf = qv * pf[a], qbk = qv * pb[a];
#pragma unroll
          for (int b = 0; b < 8; ++b) o[a][b] += qf * spv[b] + qbk * snv[b];
        }
      }
#pragma unroll
      for (int a = 0; a < 8; ++a) {
        float s1 = 0.f;
#pragma unroll
        for (int b = 0; b < 8; ++b) s1 += o[a][b];
        s1 += __shfl_xor(s1, 1); s1 += __shfl_xor(s1, 2); s1 += __shfl_xor(s1, 4); s1 += __shfl_xor(s1, 8);
        const float mu = s1 * (1.0f / 128.0f);
        float s2 = 0.f;
#pragma unroll
        for (int b = 0; b < 8; ++b) { const float dlt = o[a][b] - mu; s2 += dlt * dlt; }
        s2 += __shfl_xor(s2, 1); s2 += __shfl_xor(s2, 2); s2 += __shfl_xor(s2, 4); s2 += __shfl_xor(s2, 8);
        const float rs = rsqrtf(s2 * (1.0f / 128.0f) + 1e-5f);
        const size_t tok = (size_t)(t0 + i0 + a);
        const uint4 gq = *(const uint4*)(gb + tok * 512 + h * 128 + e0);
        const float gv[8] = {lo16(gq.x), hi16(gq.x), lo16(gq.y), hi16(gq.y), lo16(gq.z), hi16(gq.z), lo16(gq.w), hi16(gq.w)};
        unsigned w[4];
#pragma unroll
        for (int b = 0; b < 8; b += 2) {
          const float y0 = gv[b] * sigmoidf_(gv[b]) * (o[a][b] - mu) * rs;
          const float y1 = gv[b + 1] * sigmoidf_(gv[b + 1]) * (o[a][b + 1] - mu) * rs;
          w[b >> 1] = pk2(y0, y1);
        }
        *(uint4*)(ycat + tok * DM + h * 128 + e0) = make_uint4(w[0], w[1], w[2], w[3]);
      }
    }
  }
}

template <int MB_, int NB_>
__device__ __forceinline__ void lds_mma(f32x4 (&acc)[MB_][NB_], const u16* sA, int sa, int a0, const u16* sB, int sb, int b0, int K, int lane, const float* sc) {
  const int fr = lane & 15, fq = lane >> 4;
  for (int k0 = 0; k0 < K; k0 += 32) {
    uint4 fa[MB_], fb[NB_];
#pragma unroll
    for (int m = 0; m < MB_; ++m) {
      fa[m] = *(const uint4*)(sA + (a0 + m * 16 + fr) * sa + k0 + fq * 8);
      if (sc) {
        const float f = sc[m];
        fa[m].x = pk2(lo16(fa[m].x) * f, hi16(fa[m].x) * f); fa[m].y = pk2(lo16(fa[m].y) * f, hi16(fa[m].y) * f);
        fa[m].z = pk2(lo16(fa[m].z) * f, hi16(fa[m].z) * f); fa[m].w = pk2(lo16(fa[m].w) * f, hi16(fa[m].w) * f);
      }
    }
#pragma unroll
    for (int n = 0; n < NB_; ++n) fb[n] = *(const uint4*)(sB + (b0 + n * 16 + fr) * sb + k0 + fq * 8);
#pragma unroll
    for (int m = 0; m < MB_; ++m)
#pragma unroll
      for (int n = 0; n < NB_; ++n) acc[m][n] = mfma16(fb[n], fa[m], acc[m][n]);
  }
}
__device__ __forceinline__ void ret_stage_T(u16* dst0, u16* dst1, const u16* src, int t0, int h, int mode, const f32x2* rope, const float* w0, const float* w1) {
  const int pos0 = t0 & (SEQ - 1);
  for (int idx = threadIdx.x; idx < 32 * 64; idx += NTHR) {
    const int ii = idx >> 6, d = idx & 63;
    float a1[4], a2[4];
#pragma unroll
    for (int r = 0; r < 4; ++r) {
      const int i = 4 * ii + r;
      float t1 = h2f(src[(size_t)(t0 + i) * 512 + h * 128 + d]), t2 = h2f(src[(size_t)(t0 + i) * 512 + h * 128 + d + 64]);
      if (mode) {
        const f32x2 cs = rope[(pos0 + i) * 64 + d];
        const float o1 = t1 * cs[0] - t2 * cs[1], o2 = t1 * cs[1] + t2 * cs[0];
        t1 = o1; t2 = o2;
        if (mode == 2) { t1 *= 0.08838834764831845f; t2 *= 0.08838834764831845f; }
      }
      a1[r] = t1; a2[r] = t2;
    }
    if (w0) {
      const f32x4 wa = *(const f32x4*)(w0 + 4 * ii), wb = *(const f32x4*)(w1 + 4 * ii);
      uint2 o;
      o.x = pk2(a1[0] * wa[0], a1[1] * wa[1]); o.y = pk2(a1[2] * wa[2], a1[3] * wa[3]); *(uint2*)(dst0 + d * RSTR + 4 * ii) = o;
      o.x = pk2(a2[0] * wa[0], a2[1] * wa[1]); o.y = pk2(a2[2] * wa[2], a2[3] * wa[3]); *(uint2*)(dst0 + (d + 64) * RSTR + 4 * ii) = o;
      o.x = pk2(a1[0] * wb[0], a1[1] * wb[1]); o.y = pk2(a1[2] * wb[2], a1[3] * wb[3]); *(uint2*)(dst1 + d * RSTR + 4 * ii) = o;
      o.x = pk2(a2[0] * wb[0], a2[1] * wb[1]); o.y = pk2(a2[2] * wb[2], a2[3] * wb[3]); *(uint2*)(dst1 + (d + 64) * RSTR + 4 * ii) = o;
    } else {
      uint2 o;
      o.x = pk2(a1[0], a1[1]); o.y = pk2(a1[2], a1[3]); *(uint2*)(dst0 + d * RSTR + 4 * ii) = o;
      o.x = pk2(a2[0], a2[1]); o.y = pk2(a2[2], a2[3]); *(uint2*)(dst0 + (d + 64) * RSTR + 4 * ii) = o;
    }
  }
}
__device__ __forceinline__ void phase_ret_inc_mfma(const P& p, char* smem) {
  u16* sKf = (u16*)smem; u16* sKb = sKf + 128 * RSTR; u16* sVT = sKb + 128 * RSTR; float* sWf = (float*)(sVT + 128 * RSTR); float* sWb = sWf + 128;
  const u16* kb = (const u16*)(p.ws + WS_Z) + (size_t)1 * T_TOK * 512; const u16* vb = (const u16*)(p.ws + WS_Z) + (size_t)2 * T_TOK * 512;
  const f32x2* rope = (const f32x2*)(p.ws + WS_ROPE);
  float* incf = (float*)(p.ws + WS_INC); float* incb = incf + (size_t)512 * 16384;
  const int tid = threadIdx.x, lane = tid & 63, wv = tid >> 6, wr = wv >> 1, wc = wv & 1, fr = lane & 15, fq = lane >> 4;
  for (int item = blockIdx.x; item < 512; item += gridDim.x) {
    const int h = item & 3, bn = item >> 2, t0 = bn * 128;
    const float lgf = log_sigmoid(p.ret_decay[h]), lgb = log_sigmoid(p.ret_decay[4 + h]);
    __syncthreads();
    if (tid < 128) { sWf[tid] = expf(lgf * (float)(127 - tid)); sWb[tid] = expf(lgb * (float)tid); }
    __syncthreads();
    ret_stage_T(sKf, sKb, kb, t0, h, 2, rope, sWf, sWb);
    ret_stage_T(sVT, nullptr, vb, t0, h, 0, rope, nullptr, nullptr);
    __syncthreads();
#pragma unroll
    for (int dirn = 0; dirn < 2; ++dirn) {
      f32x4 acc[4][4];
#pragma unroll
      for (int m = 0; m < 4; ++m)
#pragma unroll
        for (int n = 0; n < 4; ++n) acc[m][n] = (f32x4){0.f, 0.f, 0.f, 0.f};
      lds_mma<4, 4>(acc, sVT, RSTR, wr * 64, dirn ? sKb : sKf, RSTR, wc * 64, 128, lane, nullptr);
      float* o = (dirn ? incb : incf) + (size_t)item * 16384;
#pragma unroll
      for (int m = 0; m < 4; ++m)
#pragma unroll
        for (int n = 0; n < 4; ++n) *(f32x4*)(o + (wr * 64 + m * 16 + fr) * 128 + wc * 64 + n * 16 + 4 * fq) = acc[m][n];
    }
  }
}
__device__ __forceinline__ void phase_ret_scan16(const P& p) {
  const float* incf = (const float*)(p.ws + WS_INC); const float* incb = incf + (size_t)512 * 16384;
  u16* spf = (u16*)(p.ws + WS_SP16); u16* spb = spf + (size_t)512 * 16384;
  const int gtid = blockIdx.x * NTHR + threadIdx.x, gsz = gridDim.x * NTHR;
  for (int idx = gtid; idx < 32 * 4096; idx += gsz) {
    const int de = (idx & 4095) * 4, bh = idx >> 12, b = bh >> 2, h = bh & 3;
    const float Gf = expf(128.0f * log_sigmoid(p.ret_decay[h])), Gb = expf(128.0f * log_sigmoid(p.ret_decay[4 + h]));
    f32x4 s = {0.f, 0.f, 0.f, 0.f};
    for (int n = 0; n < 16; ++n) {
      const size_t o = ((size_t)((b * 16 + n) * 4 + h)) * 16384 + de;
      const f32x4 t = *(const f32x4*)(incf + o);
      uint2 w; w.x = pk2(s[0], s[1]); w.y = pk2(s[2], s[3]); *(uint2*)(spf + o) = w;
      s = s * Gf + t;
    }
    s = (f32x4){0.f, 0.f, 0.f, 0.f};
    for (int n = 15; n >= 0; --n) {
      const size_t o = ((size_t)((b * 16 + n) * 4 + h)) * 16384 + de;
      const f32x4 t = *(const f32x4*)(incb + o);
      uint2 w; w.x = pk2(s[0], s[1]); w.y = pk2(s[2], s[3]); *(uint2*)(spb + o) = w;
      s = s * Gb + t;
    }
  }
}
__device__ __forceinline__ void phase_ret_out_mfma(const P& p, char* smem) {
  u16* R0 = (u16*)smem; u16* R1 = R0 + 128 * RSTR; u16* R2 = R1 + 128 * RSTR; u16* R3 = R2 + 128 * RSTR;
  float* sPf = (float*)(R3 + 128 * RSTR); float* sPb = sPf + 132;
  const u16* zb = (const u16*)(p.ws + WS_Z);
  const u16* qb = zb; const u16* kb = zb + (size_t)1 * T_TOK * 512; const u16* vb = zb + (size_t)2 * T_TOK * 512; const u16* gb = zb + (size_t)3 * T_TOK * 512;
  const f32x2* rope = (const f32x2*)(p.ws + WS_ROPE);
  const u16* spf = (const u16*)(p.ws + WS_SP16); const u16* spb = spf + (size_t)512 * 16384;
  u16* ycat = (u16*)(p.ws + WS_YCAT);
  const int tid = threadIdx.x, lane = tid & 63, wv = tid >> 6, wr = wv >> 1, wc = wv & 1, fr = lane & 15, fq = lane >> 4;
  for (int item = blockIdx.x; item < 512; item += gridDim.x) {
    const int h = item & 3, bn = item >> 2, t0 = bn * 128;
    const float lgf = log_sigmoid(p.ret_decay[h]), lgb = log_sigmoid(p.ret_decay[4 + h]);
    __syncthreads();
    ret_load_tile(R0, qb, t0, h, 1, rope);
    ret_load_tile(R1, kb, t0, h, 2, rope);
    ret_stage_T(R2, nullptr, vb, t0, h, 0, rope, nullptr, nullptr);
    if (tid < 129) { sPf[tid] = expf(lgf * (float)tid); sPb[tid] = expf(lgb * (float)tid); }
    __syncthreads();
    {
      f32x4 acc[4][4];
#pragma unroll
      for (int m = 0; m < 4; ++m)
#pragma unroll
        for (int n = 0; n < 4; ++n) acc[m][n] = (f32x4){0.f, 0.f, 0.f, 0.f};
      lds_mma<4, 4>(acc, R0, RSTR, wr * 64, R1, RSTR, wc * 64, 128, lane, nullptr);
#pragma unroll
      for (int m = 0; m < 4; ++m)
#pragma unroll
        for (int n = 0; n < 4; ++n) {
          const int i = wr * 64 + m * 16 + fr, j = wc * 64 + n * 16 + 4 * fq;
          float v[4];
#pragma unroll
          for (int r = 0; r < 4; ++r) { const int jj = j + r; v[r] = acc[m][n][r] * ((i >= jj) ? sPf[i - jj] : sPb[jj - i]); }
          uint2 w; w.x = pk2(v[0], v[1]); w.y = pk2(v[2], v[3]);
          *(uint2*)(R3 + i * RSTR + j) = w;
        }
    }
    __syncthreads();
    const u16* spT = spf + (size_t)item * 16384; const u16* snT = spb + (size_t)item * 16384;
    for (int c = tid; c < 128 * 16; c += NTHR) { const int e = c >> 4, ch = (c & 15) * 8; *(uint4*)(R1 + e * RSTR + ch) = *(const uint4*)(spT + e * 128 + ch); }
    f32x4 o[2][8];
#pragma unroll
    for (int m = 0; m < 2; ++m)
#pragma unroll
      for (int n = 0; n < 8; ++n) o[m][n] = (f32x4){0.f, 0.f, 0.f, 0.f};
    lds_mma<2, 8>(o, R3, RSTR, wv * 32, R2, RSTR, 0, 128, lane, nullptr);
    __syncthreads();
    for (int c = tid; c < 128 * 16; c += NTHR) { const int e = c >> 4, ch = (c & 15) * 8; *(uint4*)(R2 + e * RSTR + ch) = *(const uint4*)(snT + e * 128 + ch); }
    float scf[2], scb[2];
#pragma unroll
    for (int m = 0; m < 2; ++m) { const int i = wv * 32 + m * 16 + fr; scf[m] = sPf[i + 1]; scb[m] = sPb[128 - i]; }
    lds_mma<2, 8>(o, R0, RSTR, wv * 32, R1, RSTR, 0, 128, lane, scf);
    __syncthreads();
    lds_mma<2, 8>(o, R0, RSTR, wv * 32, R2, RSTR, 0, 128, lane, scb);
#pragma unroll
    for (int m = 0; m < 2; ++m) {
      float s1 = 0.f;
#pragma unroll
      for (int n = 0; n < 8; ++n) s1 += (o[m][n][0] + o[m][n][1]) + (o[m][n][2] + o[m][n][3]);
      s1 += __shfl_xor(s1, 16); s1 += __shfl_xor(s1, 32);
      const float mu = s1 * (1.0f / 128.0f);
      float s2 = 0.f;
#pragma unroll
      for (int n = 0; n < 8; ++n)
#pragma unroll
        for (int r = 0; r < 4; ++r) { const float dl = o[m][n][r] - mu; s2 += dl * dl; }
      s2 += __shfl_xor(s2, 16); s2 += __shfl_xor(s2, 32);
      const float rs = rsqrtf(s2 * (1.0f / 128.0f) + 1e-5f);
      const size_t tok = (size_t)(t0 + wv * 32 + m * 16 + fr);
#pragma unroll
      for (int n = 0; n < 8; ++n) {
        const int e = n * 16 + 4 * fq;
        const uint2 gq = *(const uint2*)(gb + tok * 512 + h * 128 + e);
        const float g0 = lo16(gq.x), g1 = hi16(gq.x), g2 = lo16(gq.y), g3 = hi16(gq.y);
        uint2 w;
        w.x = pk2(g0 * sigmoidf_(g0) * (o[m][n][0] - mu) * rs, g1 * sigmoidf_(g1) * (o[m][n][1] - mu) * rs);
        w.y = pk2(g2 * sigmoidf_(g2) * (o[m][n][2] - mu) * rs, g3 * sigmoidf_(g3) * (o[m][n][3] - mu) * rs);
        *(uint2*)(ycat + tok * DM + h * 128 + e) = w;
      }
    }
  }
}

__device__ __forceinline__ void phase_s5_naive(const P& p, char* smem) {
  float* ylds = (float*)smem;
  float* xs = ylds + 2048 * 16;
  const u16* a2 = (const u16*)(p.ws + WS_A2);
  u16* ygelu = (u16*)(p.ws + WS_YGELU);
  const int lane = threadIdx.x & 63;
  if (threadIdx.x < 64) {
    for (int item = blockIdx.x; item < 256; item += gridDim.x) {
      const int b = item >> 5, g = item & 31;
      const int pidx = lane;
      const int cidx = lane & 15, quart = lane >> 4;
      for (int dir = 0; dir < 2; ++dir) {
        const float dt = expf(p.log_step[dir * 32 + g]);
        const float ar = p.a_re[(dir * 32 + g) * 64 + pidx], ai = p.a_im[(dir * 32 + g) * 64 + pidx];
        const float mag = expf(ar * dt);
        float sn, cs; sincosf(ai * dt, &sn, &cs);
        const float lre = mag * cs, lim = mag * sn;
        const float nr = lre - 1.0f, ni = lim, den = ar * ar + ai * ai;
        const float cre = (nr * ar + ni * ai) / den, cim = (ni * ar - nr * ai) / den;
        float bbr[16], bbi[16];
#pragma unroll
        for (int c = 0; c < 16; ++c) {
          const float br = p.b_re[(g * 64 + pidx) * 16 + c], bi = p.b_im[(g * 64 + pidx) * 16 + c];
          bbr[c] = cre * br - cim * bi; bbi[c] = cre * bi + cim * br;
        }
        float ccr[16], cci[16];
#pragma unroll
        for (int q = 0; q < 16; ++q) {
          ccr[q] = p.c_re[((dir * 32 + g) * 16 + cidx) * 64 + quart * 16 + q];
          cci[q] = p.c_im[((dir * 32 + g) * 16 + cidx) * 64 + quart * 16 + q];
        }
        const float dsk = p.s5d[g * 16 + cidx];
        float xr = 0.f, xi = 0.f;
        for (int step = 0; step < SEQ; ++step) {
          const int n = dir ? (SEQ - 1 - step) : step;
          const int t = b * SEQ + n;
          const u16* up = a2 + ((size_t)g * 512 + (t >> 5)) * 768 + (t & 31) * 16;
          const uint4 u0 = *(const uint4*)up, u1 = *(const uint4*)(up + 8);
          const float uv[16] = {lo16(u0.x), hi16(u0.x), lo16(u0.y), hi16(u0.y), lo16(u0.z), hi16(u0.z), lo16(u0.w), hi16(u0.w),
                                lo16(u1.x), hi16(u1.x), lo16(u1.y), hi16(u1.y), lo16(u1.z), hi16(u1.z), lo16(u1.w), hi16(u1.w)};
          float bur = 0.f, bui = 0.f;
#pragma unroll
          for (int c = 0; c < 16; ++c) { bur += bbr[c] * uv[c]; bui += bbi[c] * uv[c]; }
          const float nxr = lre * xr - lim * xi + bur, nxi = lre * xi + lim * xr + bui;
          xr = nxr; xi = nxi;
          asm volatile("s_waitcnt lgkmcnt(0)" ::: "memory");
          xs[lane] = xr; xs[64 + lane] = xi;
          asm volatile("s_waitcnt lgkmcnt(0)" ::: "memory");
          float part = 0.f;
#pragma unroll
          for (int q = 0; q < 16; ++q) part += ccr[q] * xs[quart * 16 + q] - cci[q] * xs[64 + quart * 16 + q];
          asm volatile("s_waitcnt lgkmcnt(0)" ::: "memory");
          part += __shfl_xor(part, 16); part += __shfl_xor(part, 32);
          if (lane < 16) {
            if (dir == 0) ylds[n * 16 + cidx] = dsk * h2f(up[cidx]) + part;
            else ygelu[(size_t)t * 512 + g * 16 + cidx] = f2h(gelu_tanh(ylds[n * 16 + cidx] + part));
          }
        }
      }
    }
  }
}

struct Cpx { float re, im; };
__device__ __forceinline__ Cpx cmul(Cpx a, Cpx b) { return {a.re * b.re - a.im * b.im, a.re * b.im + a.im * b.re}; }
__device__ __forceinline__ Cpx s5_lam_pow(float ar, float ai, float dt, float e) {
  const float mag = expf(ar * dt * e); float sn, cs; sincosf(ai * dt * e, &sn, &cs); return {mag * cs, mag * sn};
}
__device__ __forceinline__ Cpx s5_coef(float ar, float ai, float dt) {
  float sn, cs; sincosf(ai * dt, &sn, &cs);
  const float em1 = expm1f(ar * dt), sh = sinf(0.5f * ai * dt);
  const float nr = em1 * cs - 2.0f * sh * sh, ni = (em1 + 1.0f) * sn, den = ar * ar + ai * ai;
  return {(nr * ar + ni * ai) / den, (ni * ar - nr * ai) / den};
}
__device__ __forceinline__ void phase_s5_ktab(const P& p) {
  float* ktab = (float*)(p.ws + WS_KTAB);
  const int gtid = blockIdx.x * NTHR + threadIdx.x, gsz = gridDim.x * NTHR;
  for (int item = gtid; item < 32 * 2 * 32 * 16; item += gsz) {
    const int c = item & 15, l = (item >> 4) & 31, dir = (item >> 9) & 1, g = item >> 10;
    const float dt = expf(p.log_step[dir * 32 + g]);
    float acc[16];
#pragma unroll
    for (int j = 0; j < 16; ++j) acc[j] = 0.f;
    for (int q = 0; q < 64; ++q) {
      const float ar = p.a_re[(dir * 32 + g) * 64 + q], ai = p.a_im[(dir * 32 + g) * 64 + q];
      const Cpx L = s5_lam_pow(ar, ai, dt, (float)l), cf = s5_coef(ar, ai, dt);
      const Cpx C = {p.c_re[((dir * 32 + g) * 16 + c) * 64 + q], p.c_im[((dir * 32 + g) * 16 + c) * 64 + q]};
      const Cpx w = cmul(cmul(C, L), cf);
#pragma unroll
      for (int j = 0; j < 16; ++j) acc[j] += w.re * p.b_re[(g * 64 + q) * 16 + j] - w.im * p.b_im[(g * 64 + q) * 16 + j];
    }
#pragma unroll
    for (int j = 0; j < 16; j += 4) *(f32x4*)(ktab + (size_t)item * 16 + j) = (f32x4){acc[j], acc[j + 1], acc[j + 2], acc[j + 3]};
  }
}
__device__ __forceinline__ void phase_s5_fill(const P& p) {
  const float* ktab = (const float*)(p.ws + WS_KTAB);
  u16* bty = (u16*)(p.ws + WS_BTY); u16* wet = (u16*)(p.ws + WS_WET);
  const int gtid = blockIdx.x * NTHR + threadIdx.x, gsz = gridDim.x * NTHR;
  for (int item = gtid; item < 32 * 512 * 64; item += gsz) {
    const int ch = item & 63, n = (item >> 6) & 511, g = item >> 15;
    const int ip = ch >> 1, c0 = (ch & 1) * 8, i = n >> 4, c = n & 15;
    float v[8];
    if (ip != i) {
      const int dir = ip < i ? 0 : 1, l = ip < i ? i - ip : ip - i;
      const float* src = ktab + ((size_t)((g * 2 + dir) * 32 + l) * 16 + c) * 16 + c0;
      const f32x4 a = *(const f32x4*)src, b = *(const f32x4*)(src + 4);
      v[0] = a[0]; v[1] = a[1]; v[2] = a[2]; v[3] = a[3]; v[4] = b[0]; v[5] = b[1]; v[6] = b[2]; v[7] = b[3];
    } else {
      const float* s0 = ktab + ((size_t)((g * 2 + 0) * 32) * 16 + c) * 16 + c0;
      const float* s1 = ktab + ((size_t)((g * 2 + 1) * 32) * 16 + c) * 16 + c0;
      const float dd = p.s5d[g * 16 + c];
#pragma unroll
      for (int j = 0; j < 8; ++j) v[j] = s0[j] + s1[j] + ((c0 + j) == c ? dd : 0.f);
    }
    *(uint4*)(bty + ((size_t)g * 512 + n) * 768 + ch * 8) = make_uint4(pk2(v[0], v[1]), pk2(v[2], v[3]), pk2(v[4], v[5]), pk2(v[6], v[7]));
  }
  for (int item = gtid; item < 32 * 512 * 32; item += gsz) {
    const int ch = item & 31, n = (item >> 5) & 511, g = item >> 14;
    const int kk = ch * 8, dir = kk >> 7, p0 = (kk & 127) >> 1, i = n >> 4, c = n & 15;
    const float dt = expf(p.log_step[dir * 32 + g]), e = dir ? (float)(32 - i) : (float)(i + 1);
    float v[8];
#pragma unroll
    for (int q = 0; q < 4; ++q) {
      const int pq = p0 + q;
      const float ar = p.a_re[(dir * 32 + g) * 64 + pq], ai = p.a_im[(dir * 32 + g) * 64 + pq];
      const Cpx L = s5_lam_pow(ar, ai, dt, e);
      const Cpx C = {p.c_re[((dir * 32 + g) * 16 + c) * 64 + pq], p.c_im[((dir * 32 + g) * 16 + c) * 64 + pq]};
      const Cpx w = cmul(C, L);
      v[2 * q] = w.re; v[2 * q + 1] = -w.im;
    }
    *(uint4*)(bty + ((size_t)g * 512 + n) * 768 + 512 + kk) = make_uint4(pk2(v[0], v[1]), pk2(v[2], v[3]), pk2(v[4], v[5]), pk2(v[6], v[7]));
  }
  for (int item = gtid; item < 32 * 256 * 64; item += gsz) {
    const int ch = item & 63, n = (item >> 6) & 255, g = item >> 14;
    const int ip = ch >> 1, c0 = (ch & 1) * 8, ri = n & 1, pq = (n >> 1) & 63, dir = n >> 7;
    const float dt = expf(p.log_step[dir * 32 + g]), e = dir ? (float)ip : (float)(31 - ip);
    const float ar = p.a_re[(dir * 32 + g) * 64 + pq], ai = p.a_im[(dir * 32 + g) * 64 + pq];
    const Cpx w = cmul(s5_lam_pow(ar, ai, dt, e), s5_coef(ar, ai, dt));
    float v[8];
#pragma unroll
    for (int j = 0; j < 8; ++j) {
      const float br = p.b_re[(g * 64 + pq) * 16 + c0 + j], bi = p.b_im[(g * 64 + pq) * 16 + c0 + j];
      v[j] = ri ? (w.re * bi + w.im * br) : (w.re * br - w.im * bi);
    }
    *(uint4*)(wet + ((size_t)g * 256 + n) * 512 + ch * 8) = make_uint4(pk2(v[0], v[1]), pk2(v[2], v[3]), pk2(v[4], v[5]), pk2(v[6], v[7]));
  }
}
__device__ __forceinline__ void phase_s5_egemm(const P& p, char* smem) {
  float* E = (float*)(p.ws + WS_E);
  for (int t = blockIdx.x; t < 32 * 8; t += gridDim.x) {
    const int g = t >> 3, mt = (t >> 1) & 3, nt = t & 1;
    GemmDesc d{}; d.A = (const u16*)(p.ws + WS_A2) + (size_t)g * 512 * 768; d.lda = 768; d.mvalid = 512;
    d.Bt = (const u16*)(p.ws + WS_WET) + (size_t)g * 256 * 512; d.ldb = 512; d.K = 512;
    gemm_tile(d, mt * 128, nt * 128, [&](f32x4 (&acc)[4][4], int row0, int col0) {
#pragma unroll
      for (int m = 0; m < 4; ++m)
#pragma unroll
        for (int n = 0; n < 4; ++n) *(f32x4*)(E + ((size_t)g * 512 + row0 + m * 16) * 256 + col0 + n * 16) = acc[m][n];
    }, smem);
  }
}
__device__ __forceinline__ void phase_s5_carry(const P& p) {
  const float* E = (const float*)(p.ws + WS_E);
  u16* a2 = (u16*)(p.ws + WS_A2);
  const int gtid = blockIdx.x * NTHR + threadIdx.x, gsz = gridDim.x * NTHR;
  for (int idx = gtid; idx < 32 * 8 * 128; idx += gsz) {
    const int pq = idx & 63, dir = (idx >> 6) & 1, b = (idx >> 7) & 7, g = idx >> 10;
    const float dt = expf(p.log_step[dir * 32 + g]);
    const Cpx L = s5_lam_pow(p.a_re[(dir * 32 + g) * 64 + pq], p.a_im[(dir * 32 + g) * 64 + pq], dt, 32.0f);
    Cpx s = {0.f, 0.f};
    for (int jj = 0; jj < 64; ++jj) {
      const int j = dir ? 63 - jj : jj, r = b * 64 + j;
      const f32x2 e = *(const f32x2*)(E + ((size_t)g * 512 + r) * 256 + (dir * 64 + pq) * 2);
      *(unsigned*)(a2 + ((size_t)g * 512 + r) * 768 + 512 + (dir * 64 + pq) * 2) = pk2(s.re, s.im);
      const Cpx ns = cmul(L, s);
      s.re = ns.re + e[0]; s.im = ns.im + e[1];
    }
  }
}
__device__ __forceinline__ void phase_s5_ygemm(const P& p, char* smem) {
  u16* ygelu = (u16*)(p.ws + WS_YGELU);
  for (int t = blockIdx.x; t < 32 * 16; t += gridDim.x) {
    const int g = t >> 4, mt = (t >> 2) & 3, nt = t & 3;
    GemmDesc d{}; d.A = (const u16*)(p.ws + WS_A2) + (size_t)g * 512 * 768; d.lda = 768; d.mvalid = 512;
    d.Bt = (const u16*)(p.ws + WS_BTY) + (size_t)g * 512 * 768; d.ldb = 768; d.K = 768;
    gemm_tile(d, mt * 128, nt * 128, [&](f32x4 (&acc)[4][4], int row0, int col0) {
#pragma unroll
      for (int m = 0; m < 4; ++m)
#pragma unroll
        for (int n = 0; n < 4; ++n) {
          const int row = row0 + m * 16, col = col0 + n * 16;
          uint2 w; w.x = pk2(gelu_tanh(acc[m][n][0]), gelu_tanh(acc[m][n][1])); w.y = pk2(gelu_tanh(acc[m][n][2]), gelu_tanh(acc[m][n][3]));
          *(uint2*)(ygelu + ((size_t)row * 32 + (col >> 4)) * 512 + g * 16 + (col & 15)) = w;
        }
    }, smem);
  }
}

__device__ __forceinline__ void phase_glu(const P& p, char* smem) {
  const u16* yg = (const u16*)(p.ws + WS_YGELU); u16* ycat = (u16*)(p.ws + WS_YCAT);
  GemmDesc g{}; g.A = yg; g.lda = 512; g.mvalid = T_TOK; g.W = p.w_glu; g.ldw = 512; g.K = 512;
  for (int t = blockIdx.x; t < 128 * 4; t += gridDim.x) {
    const int mt = t >> 2, nt = t & 3;
    gemm_tile(g, mt * 128, nt * 128, [&](f32x4 (&acc)[4][4], int row0, int col0) {
#pragma unroll
      for (int m = 0; m < 4; ++m)
#pragma unroll
        for (int n = 0; n < 4; ++n) {
          const int row = row0 + m * 16, col = col0 + n * 16;
          const uint2 yv = *(const uint2*)(yg + (size_t)row * 512 + col);
          const f32x4 bb = *(const f32x4*)(p.b_glu + col);
          const float y0 = lo16(yv.x) * sigmoidf_(acc[m][n][0] + bb[0]), y1 = hi16(yv.x) * sigmoidf_(acc[m][n][1] + bb[1]);
          const float y2 = lo16(yv.y) * sigmoidf_(acc[m][n][2] + bb[2]), y3 = hi16(yv.y) * sigmoidf_(acc[m][n][3] + bb[3]);
          uint2 w; w.x = pk2(y0, y1); w.y = pk2(y2, y3);
          *(uint2*)(ycat + (size_t)row * DM + 512 + col) = w;
        }
    }, smem);
  }
}

__device__ __forceinline__ void phase_outproj(const P& p, const u16* A, const float* W, const float* xin, float* xout, char* smem) {
  GemmDesc g{}; g.A = A; g.lda = DM; g.mvalid = T_TOK; g.W = W; g.ldw = DM; g.K = DM;
  for (int t = blockIdx.x; t < 128 * 8; t += gridDim.x) {
    const int mt = t >> 3, nt = t & 7;
    gemm_tile(g, mt * 128, nt * 128, [&](f32x4 (&acc)[4][4], int row0, int col0) {
#pragma unroll
      for (int m = 0; m < 4; ++m)
#pragma unroll
        for (int n = 0; n < 4; ++n) {
          const size_t o = (size_t)(row0 + m * 16) * DM + col0 + n * 16;
          const f32x4 xv = *(const f32x4*)(xin + o);
          *(f32x4*)(xout + o) = xv + acc[m][n];
        }
    }, smem);
  }
}

__device__ __forceinline__ void phase_qkv(const P& p, char* smem) {
  GemmDesc g{}; g.A = (const u16*)(p.ws + WS_XB); g.lda = DM; g.mvalid = T_TOK; g.W = p.w_qkv; g.ldw = 1536; g.K = DM;
  u16* q1 = (u16*)(p.ws + WS_Z); u16* k1 = (u16*)(p.ws + WS_Z + 32 * MB); u16* v1 = (u16*)(p.ws + WS_Z + 40 * MB);
  for (int t = blockIdx.x; t < 128 * 12; t += gridDim.x) {
    const int mt = t / 12, nt = t % 12;
    gemm_tile(g, mt * 128, nt * 128, [&](f32x4 (&acc)[4][4], int row0, int col0) {
#pragma unroll
      for (int m = 0; m < 4; ++m)
#pragma unroll
        for (int n = 0; n < 4; ++n) {
          const int row = row0 + m * 16, col = col0 + n * 16;
          uint2 w;
          if (nt < 8) { w.x = pk2(acc[m][n][0] * 0.125f, acc[m][n][1] * 0.125f); w.y = pk2(acc[m][n][2] * 0.125f, acc[m][n][3] * 0.125f); *(uint2*)(q1 + (size_t)row * DM + col) = w; }
          else {
            w.x = pk2(acc[m][n][0], acc[m][n][1]); w.y = pk2(acc[m][n][2], acc[m][n][3]);
            if (nt < 10) *(uint2*)(k1 + (size_t)row * 256 + (col - 1024)) = w; else *(uint2*)(v1 + (size_t)row * 256 + (col - 1280)) = w;
          }
        }
    }, smem);
  }
}

struct MoeTile { int e, rt, ct, cnt, hbase; };
__device__ __forceinline__ bool moe_decode(const int* cnt, int t, MoeTile& mt) {
  int base = 0, hb = 0;
  for (int e = 0; e < 32; ++e) {
    const int c = cnt[e], nt = (c + 127) >> 7, span = nt * 8;
    if (t < base + span) { const int loc = t - base; mt.e = e; mt.rt = loc % nt; mt.ct = loc / nt; mt.cnt = c; mt.hbase = hb; return true; }
    base += span; hb += nt * 128;
  }
  return false;
}
__device__ __forceinline__ void phase_moe1(const P& p, int layer, char* smem) {
  const int* cnt = (const int*)(p.ws + WS_CNT) + layer * 32;
  const int* list = (const int*)(p.ws + WS_LIST);
  u16* hbuf = (u16*)(p.ws + WS_H);
  for (int t = blockIdx.x;; t += gridDim.x) {
    MoeTile mt; if (!moe_decode(cnt, t, mt)) break;
    GemmDesc g{}; g.A = (const u16*)(p.ws + WS_XB); g.lda = DM; g.rowmap = list + (size_t)mt.e * CAP; g.rowshift = 1; g.mvalid = mt.cnt;
    g.W = p.w_gate + (size_t)(layer * 32 + mt.e) * DM * 512; g.W2 = p.w_up + (size_t)(layer * 32 + mt.e) * DM * 512; g.ldw = 512; g.K = DM;
    gemm_tile(g, mt.rt * 128, mt.ct * 128, [&](f32x4 (&acc)[4][4], int row0, int col0) {
      const int ocol0 = (col0 >> 6) * 32 + (col0 & 31);
#pragma unroll
      for (int m = 0; m < 4; ++m) {
        const int row = row0 + m * 16;
        if (row < mt.cnt) {
#pragma unroll
          for (int nn = 0; nn < 2; ++nn) {
            float hv[4];
#pragma unroll
            for (int r = 0; r < 4; ++r) { const float gt = acc[m][nn][r]; hv[r] = gt * sigmoidf_(gt) * acc[m][nn + 2][r]; }
            uint2 w; w.x = pk2(hv[0], hv[1]); w.y = pk2(hv[2], hv[3]);
            *(uint2*)(hbuf + (size_t)(mt.hbase + row) * 512 + ocol0 + nn * 16) = w;
          }
        }
      }
    }, smem);
  }
}
__device__ __forceinline__ void phase_moe2(const P& p, int layer, char* smem) {
  const int* cnt = (const int*)(p.ws + WS_CNT) + layer * 32;
  const int* list = (const int*)(p.ws + WS_LIST);
  const float* gate = (const float*)(p.ws + WS_GATE);
  const u16* hbuf = (const u16*)(p.ws + WS_H);
  u16* slots = (u16*)(p.ws + WS_INC);
  for (int t = blockIdx.x;; t += gridDim.x) {
    MoeTile mt; if (!moe_decode(cnt, t, mt)) break;
    GemmDesc g{}; g.A = hbuf + (size_t)mt.hbase * 512; g.lda = 512; g.mvalid = mt.cnt;
    g.W = p.w_down + (size_t)(layer * 32 + mt.e) * 512 * DM; g.ldw = DM; g.K = 512;
    gemm_tile(g, mt.rt * 128, mt.ct * 128, [&](f32x4 (&acc)[4][4], int row0, int col0) {
#pragma unroll
      for (int m = 0; m < 4; ++m) {
        const int row = row0 + m * 16;
        if (row < mt.cnt) {
          const int asg = list[(size_t)mt.e * CAP + row];
          const float gt = gate[asg];
#pragma unroll
          for (int n = 0; n < 4; ++n) {
            uint2 w; w.x = pk2(gt * acc[m][n][0], gt * acc[m][n][1]); w.y = pk2(gt * acc[m][n][2], gt * acc[m][n][3]);
            *(uint2*)(slots + (size_t)asg * DM + col0 + n * 16) = w;
          }
        }
      }
    }, smem);
  }
}

constexpr int KSTR = 72;
__device__ __forceinline__ int t5_bucket_abs(int n) {
  return n < 8 ? n : 8 + (n >= 12) + (n >= 16) + (n >= 23) + (n >= 32) + (n >= 46) + (n >= 64) + (n >= 91);
}
__device__ __forceinline__ void phase_attn_naive(const P& p, char* smem) {
  u16* sK = (u16*)smem; u16* sV = sK + 384 * KSTR; float* sBias = (float*)(sV + 384 * KSTR);
  const u16* q1 = (const u16*)(p.ws + WS_Z); const u16* k1 = (const u16*)(p.ws + WS_Z + 32 * MB); const u16* v1 = (const u16*)(p.ws + WS_Z + 40 * MB);
  u16* ao = (u16*)(p.ws + WS_YCAT);
  const int tid = threadIdx.x;
  for (int item = blockIdx.x; item < 512; item += gridDim.x) {
    const int b = item >> 6, nb = (item >> 2) & 15, kvh = item & 3;
    __syncthreads();
    for (int c = tid; c < 384 * 8; c += NTHR) {
      const int s = c >> 3, ch = (c & 7) * 8, pos = (nb - 1) * 128 + s;
      uint4 kq = make_uint4(0u, 0u, 0u, 0u), vq = kq;
      if (pos >= 0 && pos < SEQ) { kq = *(const uint4*)(k1 + (size_t)(b * SEQ + pos) * 256 + kvh * 64 + ch); vq = *(const uint4*)(v1 + (size_t)(b * SEQ + pos) * 256 + kvh * 64 + ch); }
      *(uint4*)(sK + s * KSTR + ch) = kq; *(uint4*)(sV + s * KSTR + ch) = vq;
    }
    for (int c = tid; c < 4 * 257; c += NTHR) {
      const int hq = c / 257, ri = c % 257, rel = ri - 128, n = rel < 0 ? -rel : rel;
      const int bucket = (rel > 0 ? 16 : 0) + t5_bucket_abs(n);
      sBias[hq * 260 + ri] = p.rel_bias[bucket * 16 + kvh * 4 + hq];
    }
    __syncthreads();
    for (int pass = 0; pass < 2; ++pass) {
      const int hq = pass * 2 + (tid >> 7), qi = tid & 127, head = kvh * 4 + hq;
      const size_t tok = (size_t)b * SEQ + nb * 128 + qi;
      float q[64];
#pragma unroll
      for (int d = 0; d < 64; d += 8) {
        const uint4 qq = *(const uint4*)(q1 + tok * DM + head * 64 + d);
        q[d] = lo16(qq.x); q[d + 1] = hi16(qq.x); q[d + 2] = lo16(qq.y); q[d + 3] = hi16(qq.y); q[d + 4] = lo16(qq.z); q[d + 5] = hi16(qq.z); q[d + 6] = lo16(qq.w); q[d + 7] = hi16(qq.w);
      }
      float mx = p.sink[head], l = 1.0f, o[64];
#pragma unroll
      for (int d = 0; d < 64; ++d) o[d] = 0.f;
      for (int r = 0; r <= 256; ++r) {
        const int s = qi + r, pos = (nb - 1) * 128 + s;
        if (pos < 0 || pos >= SEQ) continue;
        float sc = 0.f;
#pragma unroll
        for (int d = 0; d < 64; d += 8) {
          const uint4 kq = *(const uint4*)(sK + s * KSTR + d);
          sc += q[d] * lo16(kq.x) + q[d + 1] * hi16(kq.x) + q[d + 2] * lo16(kq.y) + q[d + 3] * hi16(kq.y) + q[d + 4] * lo16(kq.z) + q[d + 5] * hi16(kq.z) + q[d + 6] * lo16(kq.w) + q[d + 7] * hi16(kq.w);
        }
        sc += sBias[hq * 260 + r];
        const float mn = fmaxf(mx, sc), alpha = __expf(mx - mn), pe = __expf(sc - mn);
        l = l * alpha + pe; mx = mn;
#pragma unroll
        for (int d = 0; d < 64; d += 8) {
          const uint4 vq = *(const uint4*)(sV + s * KSTR + d);
          o[d] = o[d] * alpha + pe * lo16(vq.x); o[d + 1] = o[d + 1] * alpha + pe * hi16(vq.x); o[d + 2] = o[d + 2] * alpha + pe * lo16(vq.y); o[d + 3] = o[d + 3] * alpha + pe * hi16(vq.y);
          o[d + 4] = o[d + 4] * alpha + pe * lo16(vq.z); o[d + 5] = o[d + 5] * alpha + pe * hi16(vq.z); o[d + 6] = o[d + 6] * alpha + pe * lo16(vq.w); o[d + 7] = o[d + 7] * alpha + pe * hi16(vq.w);
        }
      }
      const float inv = 1.0f / l;
#pragma unroll
      for (int d = 0; d < 64; d += 8) {
        uint4 w; w.x = pk2(o[d] * inv, o[d + 1] * inv); w.y = pk2(o[d + 2] * inv, o[d + 3] * inv); w.z = pk2(o[d + 4] * inv, o[d + 5] * inv); w.w = pk2(o[d + 6] * inv, o[d + 7] * inv);
        *(uint4*)(ao + tok * DM + head * 64 + d) = w;
      }
    }
  }
}

constexpr int VSTR = 392;
__device__ __forceinline__ void phase_attn(const P& p, char* smem) {
  u16* sK = (u16*)smem; u16* sVt = sK + 384 * KSTR; float* sBias = (float*)(sVt + 64 * VSTR);
  const u16* q1 = (const u16*)(p.ws + WS_Z); const u16* k1 = (const u16*)(p.ws + WS_Z + 32 * MB); const u16* v1 = (const u16*)(p.ws + WS_Z + 40 * MB);
  u16* ao = (u16*)(p.ws + WS_YCAT);
  const int tid = threadIdx.x, lane = tid & 63, wv = tid >> 6, fr = lane & 15, lg = lane >> 4, q0 = wv * 32;
  for (int item = blockIdx.x; item < 512; item += gridDim.x) {
    const int b = item >> 6, nb = (item >> 2) & 15, kvh = item & 3;
    __syncthreads();
    for (int c = tid; c < 384 * 8; c += NTHR) {
      const int s = c >> 3, ch = (c & 7) * 8, pos = (nb - 1) * 128 + s;
      uint4 kq = make_uint4(0u, 0u, 0u, 0u), vq = kq;
      if (pos >= 0 && pos < SEQ) { kq = *(const uint4*)(k1 + (size_t)(b * SEQ + pos) * 256 + kvh * 64 + ch); vq = *(const uint4*)(v1 + (size_t)(b * SEQ + pos) * 256 + kvh * 64 + ch); }
      *(uint4*)(sK + s * KSTR + ch) = kq;
      const unsigned vw[4] = {vq.x, vq.y, vq.z, vq.w};
#pragma unroll
      for (int j = 0; j < 4; ++j) { sVt[(ch + 2 * j) * VSTR + s] = (u16)(vw[j] & 0xffffu); sVt[(ch + 2 * j + 1) * VSTR + s] = (u16)(vw[j] >> 16); }
    }
    for (int c = tid; c < 4 * 257; c += NTHR) {
      const int hq = c / 257, ri = c % 257, rel = ri - 128, n = rel < 0 ? -rel : rel;
      const int bucket = (rel > 0 ? 16 : 0) + t5_bucket_abs(n);
      sBias[hq * 260 + ri] = p.rel_bias[bucket * 16 + kvh * 4 + hq];
    }
    __syncthreads();
    for (int hq = 0; hq < 4; ++hq) {
      const int head = kvh * 4 + hq;
      const size_t tok0 = (size_t)b * SEQ + nb * 128 + q0;
      uint4 qf[2][2];
#pragma unroll
      for (int qb = 0; qb < 2; ++qb)
#pragma unroll
        for (int ks = 0; ks < 2; ++ks) qf[qb][ks] = *(const uint4*)(q1 + (tok0 + qb * 16 + fr) * DM + head * 64 + ks * 32 + lg * 8);
      f32x4 O[4][2];
#pragma unroll
      for (int mb = 0; mb < 4; ++mb)
#pragma unroll
        for (int qb = 0; qb < 2; ++qb) O[mb][qb] = (f32x4){0.f, 0.f, 0.f, 0.f};
      const float sinkv = p.sink[head];
      float mrun[2] = {sinkv, sinkv}, lpart[2] = {lg == 0 ? 1.0f : 0.0f, lg == 0 ? 1.0f : 0.0f};
#pragma unroll
      for (int c = 0; c < 3; ++c) {
        if ((c == 0 && nb == 0) || (c == 2 && nb == 15)) continue;
        f32x4 S[8][2];
#pragma unroll
        for (int kb = 0; kb < 8; ++kb) {
          S[kb][0] = (f32x4){0.f, 0.f, 0.f, 0.f}; S[kb][1] = S[kb][0];
          const bool act = (c == 0) ? (16 * kb + 15 >= q0) : ((c == 2) ? (16 * kb <= q0 + 31) : true);
          if (act) {
#pragma unroll
            for (int ks = 0; ks < 2; ++ks) {
              const uint4 kf = *(const uint4*)(sK + (c * 128 + kb * 16 + fr) * KSTR + ks * 32 + lg * 8);
              S[kb][0] = mfma16(kf, qf[0][ks], S[kb][0]);
              S[kb][1] = mfma16(kf, qf[1][ks], S[kb][1]);
            }
          }
        }
        float cmax[2] = {-1e30f, -1e30f};
#pragma unroll
        for (int kb = 0; kb < 8; ++kb)
#pragma unroll
          for (int qb = 0; qb < 2; ++qb)
#pragma unroll
            for (int r = 0; r < 4; ++r) {
              const int sidx = c * 128 + kb * 16 + 4 * lg + r, qi = q0 + qb * 16 + fr, rel = sidx - 128 - qi;
              const bool valid = (rel >= -128) && (rel <= 128);
              const float v = valid ? S[kb][qb][r] + sBias[hq * 260 + (valid ? rel + 128 : 0)] : -1e30f;
              S[kb][qb][r] = v; cmax[qb] = fmaxf(cmax[qb], v);
            }
#pragma unroll
        for (int qb = 0; qb < 2; ++qb) {
          cmax[qb] = fmaxf(cmax[qb], __shfl_xor(cmax[qb], 16)); cmax[qb] = fmaxf(cmax[qb], __shfl_xor(cmax[qb], 32));
          const float mn = fmaxf(mrun[qb], cmax[qb]), alpha = __expf(mrun[qb] - mn);
          mrun[qb] = mn; lpart[qb] *= alpha;
#pragma unroll
          for (int mb = 0; mb < 4; ++mb) O[mb][qb] = O[mb][qb] * alpha;
          float ps = 0.f;
#pragma unroll
          for (int kb = 0; kb < 8; ++kb)
#pragma unroll
            for (int r = 0; r < 4; ++r) { const float e = __expf(S[kb][qb][r] - mn); S[kb][qb][r] = e; ps += e; }
          lpart[qb] += ps;
        }
#pragma unroll
        for (int kk = 0; kk < 4; ++kk) {
          const int kb0 = 2 * kk, kb1 = 2 * kk + 1;
          const bool act = (c == 0) ? (16 * kb1 + 15 >= q0) : ((c == 2) ? (16 * kb0 <= q0 + 31) : true);
          if (act) {
            uint4 pf[2];
#pragma unroll
            for (int qb = 0; qb < 2; ++qb) pf[qb] = make_uint4(pk2(S[kb0][qb][0], S[kb0][qb][1]), pk2(S[kb0][qb][2], S[kb0][qb][3]), pk2(S[kb1][qb][0], S[kb1][qb][1]), pk2(S[kb1][qb][2], S[kb1][qb][3]));
#pragma unroll
            for (int mb = 0; mb < 4; ++mb) {
              const uint2 v0 = *(const uint2*)(sVt + (mb * 16 + fr) * VSTR + c * 128 + kb0 * 16 + 4 * lg);
              const uint2 v1r = *(const uint2*)(sVt + (mb * 16 + fr) * VSTR + c * 128 + kb1 * 16 + 4 * lg);
              const uint4 vf = make_uint4(v0.x, v0.y, v1r.x, v1r.y);
              O[mb][0] = mfma16(vf, pf[0], O[mb][0]);
              O[mb][1] = mfma16(vf, pf[1], O[mb][1]);
            }
          }
        }
      }
#pragma unroll
      for (int qb = 0; qb < 2; ++qb) {
        float lt = lpart[qb]; lt += __shfl_xor(lt, 16); lt += __shfl_xor(lt, 32);
        const float inv = 1.0f / lt;
#pragma unroll
        for (int mb = 0; mb < 4; ++mb) {
          uint2 w; w.x = pk2(O[mb][qb][0] * inv, O[mb][qb][1] * inv); w.y = pk2(O[mb][qb][2] * inv, O[mb][qb][3] * inv);
          *(uint2*)(ao + (tok0 + qb * 16 + fr) * DM + head * 64 + mb * 16 + 4 * lg) = w;
        }
      }
    }
  }
}

#define XB_TMO      128
#define XB_XCNT(j)  (256  + 64 * (j))
#define XB_XSUB(j)  (1280 + 64 * (j))
#define XB_XGEN(j)  (2304 + 64 * (j))
#define XB_TOP      3328
#define XB_TOPGEN   3392
#define XCD_BAR_WORDS 3456
#define XB_SPIN_CAP (1u << 22)
#define LAS __attribute__((address_space(3)))
__device__ __forceinline__ unsigned xb_ld(unsigned* p)              { return __hip_atomic_load(p, __ATOMIC_RELAXED, __HIP_MEMORY_SCOPE_AGENT); }
__device__ __forceinline__ unsigned xb_add(unsigned* p, unsigned v) { return __hip_atomic_fetch_add(p, v, __ATOMIC_RELAXED, __HIP_MEMORY_SCOPE_AGENT); }
__device__ __forceinline__ unsigned xb_xcc_id() { return (unsigned)__builtin_amdgcn_s_getreg((3 << 11) | 20) & 0xFu; }
#define XB_SPIN(cond, bar) do { unsigned _sp = 0; while (cond) { __builtin_amdgcn_s_sleep(1); \
    if ((++_sp & 255u) == 0u) { if (xb_ld(&(bar)[XB_TMO])) break; if (_sp > XB_SPIN_CAP) { atomicAdd(&(bar)[XB_TMO], 1u); break; } } } } while (0)
struct XcdBarrier { unsigned* bar; unsigned x; volatile LAS unsigned* st; };
__device__ __forceinline__ XcdBarrier xcd_barrier_post(unsigned* bar, volatile LAS unsigned* st) {
  XcdBarrier b; b.bar = bar; b.x = xb_xcc_id(); b.st = st;
  if (threadIdx.x == 0) (void)xb_add(&bar[XB_XCNT(b.x)], 1u);
  return b;
}
__device__ __forceinline__ void xcd_barrier_complete(unsigned* bar, unsigned x, unsigned& nloc, unsigned& nx) {
  const unsigned G = gridDim.x * gridDim.y * gridDim.z;
  unsigned sum, cnt, mine, sp = 0u;
  for (;;) {
    sum = 0u; cnt = 0u; mine = 0u;
#pragma unroll
    for (unsigned j = 0; j < 16; ++j) { const unsigned c = xb_ld(&bar[XB_XCNT(j)]); sum += c; cnt += (c > 0u) ? 1u : 0u; mine = (j == x) ? c : mine; }
    if (sum == G) break;
    __builtin_amdgcn_s_sleep(1);
    if ((++sp & 255u) == 0u) { if (xb_ld(&bar[XB_TMO])) break; if (sp > XB_SPIN_CAP) { atomicAdd(&bar[XB_TMO], 1u); break; } }
  }
  nloc = mine > 0u ? mine : 1u; nx = cnt > 0u ? cnt : 1u;
}
__device__ __forceinline__ void xcd_barrier(const XcdBarrier& b) {
  asm volatile("s_waitcnt vmcnt(0)" ::: "memory");
  __syncthreads();
  if (threadIdx.x == 0) {
    unsigned* bar = b.bar;
    __builtin_amdgcn_s_waitcnt(0);
    unsigned nloc = b.st[0], nx = b.st[1];
    if (nloc == 0u) { xcd_barrier_complete(bar, b.x, nloc, nx); b.st[0] = nloc; b.st[1] = nx; }
    const unsigned old = xb_add(&bar[XB_XSUB(b.x)], 1u);
    const unsigned gen = old / nloc;
    if (old + 1u == (gen + 1u) * nloc) {
      __builtin_amdgcn_fence(__ATOMIC_RELEASE, "agent");
      asm volatile("s_waitcnt vmcnt(0)" ::: "memory");
      const unsigned og = xb_add(&bar[XB_TOP], 1u);
      const unsigned tg = og / nx;
      if (og + 1u == (tg + 1u) * nx) xb_add(&bar[XB_TOPGEN], 1u);
      else XB_SPIN(xb_ld(&bar[XB_TOPGEN]) == tg, bar);
      __builtin_amdgcn_fence(__ATOMIC_ACQUIRE, "agent");
      xb_add(&bar[XB_XGEN(b.x)], 1u);
      asm volatile("s_waitcnt vmcnt(0)" ::: "memory");
    } else {
      XB_SPIN(xb_ld(&bar[XB_XGEN(b.x)]) == gen, bar);
      __builtin_amdgcn_fence(__ATOMIC_ACQUIRE, "agent");
      asm volatile("s_waitcnt vmcnt(0)" ::: "memory");
    }
  }
  __syncthreads();
}

constexpr int NPHASE = 20;
constexpr int LDS_BYTES = 141312 + 16;
__device__ __forceinline__ void run_phase(const P& p, int ph, char* smem) {
  float* xa = (float*)(p.ws + WS_XA);
  const u16* ycat = (const u16*)(p.ws + WS_YCAT);
  const u16* slots = (const u16*)(p.ws + WS_INC);
  switch (ph) {
    case 0: phase_prep(p); phase_s5_ktab(p); break;
    case 1: phase_rowpass(p, p.x, nullptr, nullptr, p.norm_mix_g, -1, nullptr); phase_s5_fill(p); break;
    case 2: phase_inproj(p, smem); break;
    case 3: phase_ret_inc_mfma(p, smem); phase_s5_egemm(p, smem); break;
    case 4: phase_ret_scan16(p); phase_s5_carry(p); break;
    case 5: phase_ret_out_mfma(p, smem); phase_s5_ygemm(p, smem); break;
    case 6: break;
    case 7: phase_glu(p, smem); break;
    case 8: phase_outproj(p, ycat, p.w_out, p.x, xa, smem); break;
    case 9: phase_rowpass(p, xa, nullptr, nullptr, p.norm_ffn_g, 0, nullptr); break;
    case 10: phase_moe1(p, 0, smem); break;
    case 11: phase_moe2(p, 0, smem); break;
    case 12: phase_rowpass(p, xa, slots, xa, p.norm_mix_g + DM, -1, nullptr); break;
    case 13: phase_qkv(p, smem); break;
    case 14: phase_attn(p, smem); break;
    case 15: phase_outproj(p, ycat, p.w_o, xa, xa, smem); break;
    case 16: phase_rowpass(p, xa, nullptr, nullptr, p.norm_ffn_g + DM, 1, nullptr); break;
    case 17: phase_moe1(p, 1, smem); break;
    case 18: phase_moe2(p, 1, smem); break;
    case 19: phase_rowpass(p, xa, slots, nullptr, p.norm_final_g, -1, p.out); break;
    default: break;
  }
}

extern __shared__ __attribute__((aligned(16))) char dyn_smem[];

#if MULTI_LAUNCH
__global__ void __launch_bounds__(NTHR) k_phase(P p, int ph) { run_phase(p, ph, dyn_smem); }
#else

template <int PH> __device__ __forceinline__ void mega_steps(const P& p, char* smem, cg::grid_group& grid, const XcdBarrier& xb) {
  run_phase(p, PH, smem);
  if constexpr (PH + 1 < NPHASE) {
    if constexpr (PH == 0) grid.sync(); else xcd_barrier(xb);
    mega_steps<PH + 1>(p, smem, grid, xb);
  }
}
__global__ void __launch_bounds__(NTHR) k_mega(P p) {
  cg::grid_group grid = cg::this_grid();
  volatile LAS unsigned* st = (volatile LAS unsigned*)(dyn_smem + LDS_BYTES - 16);
  if (threadIdx.x == 0) { st[0] = 0u; st[1] = 0u; }
  __syncthreads();
  const XcdBarrier xb = xcd_barrier_post((unsigned*)(p.ws + WS_BAR), st);
  mega_steps<0>(p, dyn_smem, grid, xb);
}
#endif

extern "C" void kernel_launch(void* const* d_in, const int* in_sizes, int n_in, void* d_out, int out_size, void* d_ws, size_t ws_size, hipStream_t stream) {
  static int grid_blocks = 0;
  if (grid_blocks == 0) {
    if (n_in != 28 || out_size != T_TOK * DM || ws_size < WS_END) { fprintf(stderr, "kernel_launch: unexpected problem (n_in %d out %d ws %zu need %zu)\n", n_in, out_size, ws_size, (size_t)WS_END); grid_blocks = -1; return; }
    int dev = 0, cus = 0, per_cu = 0;
    (void)hipGetDevice(&dev);
    (void)hipDeviceGetAttribute(&cus, hipDeviceAttributeMultiprocessorCount, dev);
#if MULTI_LAUNCH
    const void* fn = (const void*)k_phase;
#else
    const void* fn = (const void*)k_mega;
#endif
    if (hipFuncSetAttribute(fn, hipFuncAttributeMaxDynamicSharedMemorySize, LDS_BYTES) != hipSuccess) { fprintf(stderr, "kernel_launch: hipFuncSetAttribute failed\n"); }
    if (hipOccupancyMaxActiveBlocksPerMultiprocessor(&per_cu, fn, NTHR, LDS_BYTES) != hipSuccess || per_cu < 1) { fprintf(stderr, "kernel_launch: occupancy query failed (%d)\n", per_cu); per_cu = 1; }
    (void)hipGetLastError();
    grid_blocks = cus * per_cu;
    fprintf(stderr, "kernel_launch: cus %d per_cu %d grid %d\n", cus, per_cu, grid_blocks);
  }
  if (grid_blocks < 0) return;
  P p{};
  const float** pp = (const float**)&p;
  for (int i = 0; i < 28; ++i) pp[i] = (const float*)d_in[i];
  p.out = (float*)d_out; p.ws = (char*)d_ws;
#if MULTI_LAUNCH
  for (int ph = 0; ph < NPHASE; ++ph) hipLaunchKernelGGL(k_phase, dim3(grid_blocks), dim3(NTHR), LDS_BYTES, stream, p, ph);
#else
  (void)hipMemsetAsync((char*)d_ws + WS_BAR, 0, XCD_BAR_WORDS * 4, stream);
  void* args[] = {&p};
  hipError_t e = hipLaunchCooperativeKernel((const void*)k_mega, dim3(grid_blocks), dim3(NTHR), args, LDS_BYTES, stream);
  if (e != hipSuccess) fprintf(stderr, "cooperative launch failed: %s (grid %d)\n", hipGetErrorString(e), grid_blocks);
#endif
}
```

```cpp
#include <hip/hip_runtime.h>
#include <hip/hip_cooperative_groups.h>
#include <cstdio>
#include <cstdint>
namespace cg = cooperative_groups;

#ifndef USE_FP16
#define USE_FP16 1
#endif
#ifndef MULTI_LAUNCH
#define MULTI_LAUNCH 0
#endif

typedef unsigned short u16;
typedef float f32x4 __attribute__((ext_vector_type(4)));
typedef float f32x2 __attribute__((ext_vector_type(2)));
typedef _Float16 f16x8 __attribute__((ext_vector_type(8)));
typedef __bf16 b16x8 __attribute__((ext_vector_type(8)));

constexpr int T_TOK = 16384, DM = 1024, SEQ = 2048, NBATCH = 8;
constexpr int CAP = 32768;
constexpr int NTHR = 256;

constexpr size_t MB = 1024ull * 1024ull;
constexpr size_t WS_XA    = 0;
constexpr size_t WS_XB    = WS_XA + 64 * MB;
constexpr size_t WS_Z     = WS_XB + 32 * MB;
constexpr size_t WS_A2    = WS_Z + 64 * MB;
constexpr size_t WS_INC   = WS_A2 + 24 * MB;
constexpr size_t WS_YCAT  = WS_INC + 64 * MB;
constexpr size_t WS_YGELU = WS_YCAT + 32 * MB;
constexpr size_t WS_H     = WS_YGELU + 16 * MB;
constexpr size_t WS_LIST  = WS_H + 36 * MB;
constexpr size_t WS_GATE  = WS_LIST + 4 * MB;
constexpr size_t WS_ROPE  = WS_GATE + 1 * MB;
constexpr size_t WS_CNT   = WS_ROPE + 1 * MB;
constexpr size_t WS_KTAB  = WS_CNT + 1 * MB;
constexpr size_t WS_BTY   = WS_KTAB + 2 * MB;
constexpr size_t WS_WET   = WS_BTY + 24 * MB;
constexpr size_t WS_E     = WS_WET + 8 * MB;
constexpr size_t WS_SP16  = WS_E + 16 * MB;
constexpr size_t WS_WR16  = WS_SP16 + 32 * MB;
constexpr size_t WS_BAR   = WS_WR16 + 1 * MB;
constexpr size_t WS_END   = WS_BAR + 1 * MB;

struct P {
  const float *x, *norm_mix_g, *norm_ffn_g, *norm_final_g, *w_in, *ret_decay, *a_re, *a_im, *log_step, *b_re, *b_im, *c_re, *c_im,
      *s5d, *w_glu, *b_glu, *w_out, *w_qkv, *sink, *w_o, *rel_bias, *w_group, *b_group, *w_er, *b_er, *w_gate, *w_up, *w_down;
  float* out;
  char* ws;
};

__device__ __forceinline__ u16 f2h(float f) {
#if USE_FP16
  _Float16 h = (_Float16)f; return __builtin_bit_cast(u16, h);
#else
  unsigned u = __builtin_bit_cast(unsigned, f); u += 0x7fffu + ((u >> 16) & 1u); return (u16)(u >> 16);
#endif
}
__device__ __forceinline__ float h2f(u16 h) {
#if USE_FP16
  return (float)__builtin_bit_cast(_Float16, h);
#else
  return __builtin_bit_cast(float, ((unsigned)h) << 16);
#endif
}
__device__ __forceinline__ unsigned pk2(float a, float b) { return (unsigned)f2h(a) | ((unsigned)f2h(b) << 16); }
__device__ __forceinline__ float lo16(unsigned w) { return h2f((u16)(w & 0xffffu)); }
__device__ __forceinline__ float hi16(unsigned w) { return h2f((u16)(w >> 16)); }
__device__ __forceinline__ f32x4 mfma16(uint4 a, uint4 b, f32x4 c) {
#if USE_FP16
  return __builtin_amdgcn_mfma_f32_16x16x32_f16(__builtin_bit_cast(f16x8, a), __builtin_bit_cast(f16x8, b), c, 0, 0, 0);
#else
  return __builtin_amdgcn_mfma_f32_16x16x32_bf16(__builtin_bit_cast(b16x8, a), __builtin_bit_cast(b16x8, b), c, 0, 0, 0);
#endif
}
__device__ __forceinline__ float wave_sum(float v) {
#pragma unroll
  for (int o = 1; o < 64; o <<= 1) v += __shfl_xor(v, o);
  return v;
}
__device__ __forceinline__ float sigmoidf_(float x) { return 1.0f / (1.0f + __expf(-x)); }
__device__ __forceinline__ float gelu_tanh(float x) {
  const float u = 0.7978845608028654f * (x + 0.044715f * x * x * x);
  return 0.5f * x * (1.0f + tanhf(u));
}

struct GemmDesc {
  const u16* A; long lda;
  const int* rowmap; int rowshift;
  int mvalid;
  const float* W; const float* W2; long ldw;
  const u16* Bt; long ldb;
  int K;
};
constexpr int LSTR = 40;
constexpr int GEMM_LDS = 2 * 128 * LSTR * 2;

template <class Epi>
__device__ __forceinline__ void gemm_tile(const GemmDesc& g, int m0, int n0, Epi&& epi, char* smem) {
  u16* sA = (u16*)smem;
  u16* sB = sA + 128 * LSTR;
  const int tid = threadIdx.x, lane = tid & 63, wid = tid >> 6, wr = wid >> 1, wc = wid & 1, fr = lane & 15, fq = lane >> 4;
  f32x4 acc[4][4];
#pragma unroll
  for (int m = 0; m < 4; ++m)
#pragma unroll
    for (int n = 0; n < 4; ++n) acc[m][n] = (f32x4){0.f, 0.f, 0.f, 0.f};
  const int ar = tid >> 2, akc = (tid & 3) * 8;
  const u16* ap[2];
#pragma unroll
  for (int i = 0; i < 2; ++i) {
    const int m = m0 + ar + i * 64; const u16* q = nullptr;
    if (m < g.mvalid) { const long row = g.rowmap ? (long)(g.rowmap[m] >> g.rowshift) : (long)m; q = g.A + row * g.lda + akc; }
    ap[i] = q;
  }
  const bool useBt = (g.Bt != nullptr);
  const float* wp = nullptr; const u16* bp[2] = {nullptr, nullptr};
  if (!useBt) {
    const int v = n0 + (tid & 31) * 4;
    if (g.W2) wp = ((((v >> 5) & 1) ? g.W2 : g.W) + ((v >> 6) * 32 + (v & 31)));
    else wp = g.W + v;
    wp += (long)((tid >> 5) * 4) * g.ldw;
  } else {
#pragma unroll
    for (int i = 0; i < 2; ++i) bp[i] = g.Bt + (long)(n0 + ar + i * 64) * g.ldb + akc;
  }
  uint4 ra0, ra1, rb0 = make_uint4(0u, 0u, 0u, 0u), rb1 = rb0; f32x4 rw0 = {0.f, 0.f, 0.f, 0.f}, rw1 = rw0, rw2 = rw0, rw3 = rw0;
#define GEMM_GLOAD(k0_)                                                                                   \
  do {                                                                                                    \
    const int kq_ = (k0_);                                                                                \
    ra0 = ap[0] ? *(const uint4*)(ap[0] + kq_) : make_uint4(0u, 0u, 0u, 0u);                              \
    ra1 = ap[1] ? *(const uint4*)(ap[1] + kq_) : make_uint4(0u, 0u, 0u, 0u);                              \
    if (useBt) { rb0 = *(const uint4*)(bp[0] + kq_); rb1 = *(const uint4*)(bp[1] + kq_); }               \
    else {                                                                                                \
      rw0 = *(const f32x4*)(wp + (long)(kq_ + 0) * g.ldw); rw1 = *(const f32x4*)(wp + (long)(kq_ + 1) * g.ldw); \
      rw2 = *(const f32x4*)(wp + (long)(kq_ + 2) * g.ldw); rw3 = *(const f32x4*)(wp + (long)(kq_ + 3) * g.ldw); \
    }                                                                                                     \
  } while (0)
  GEMM_GLOAD(0);
  for (int k0 = 0; k0 < g.K; k0 += 32) {
    __syncthreads();
    *(uint4*)(sA + ar * LSTR + akc) = ra0; *(uint4*)(sA + (ar + 64) * LSTR + akc) = ra1;
    if (useBt) {
      *(uint4*)(sB + ar * LSTR + akc) = rb0; *(uint4*)(sB + (ar + 64) * LSTR + akc) = rb1;
    } else {
      const int nl = (tid & 31) * 4, kl = (tid >> 5) * 4;
#pragma unroll
      for (int c = 0; c < 4; ++c) {
        uint2 v; v.x = pk2(rw0[c], rw1[c]); v.y = pk2(rw2[c], rw3[c]);
        *(uint2*)(sB + (nl + c) * LSTR + kl) = v;
      }
    }
    __syncthreads();
    if (k0 + 32 < g.K) GEMM_GLOAD(k0 + 32);
    uint4 fa[4], fb[4];
#pragma unroll
    for (int m = 0; m < 4; ++m) fa[m] = *(const uint4*)(sA + (wr * 64 + m * 16 + fr) * LSTR + fq * 8);
#pragma unroll
    for (int n = 0; n < 4; ++n) fb[n] = *(const uint4*)(sB + (wc * 64 + n * 16 + fr) * LSTR + fq * 8);
#pragma unroll
    for (int m = 0; m < 4; ++m)
#pragma unroll
      for (int n = 0; n < 4; ++n) acc[m][n] = mfma16(fb[n], fa[m], acc[m][n]);
  }
  epi(acc, m0 + wr * 64 + fr, n0 + wc * 64 + fq * 4);
}

__device__ __forceinline__ void phase_prep(const P& p) {
  const int gtid = blockIdx.x * NTHR + threadIdx.x, gsz = gridDim.x * NTHR;
  int* cnt = (int*)(p.ws + WS_CNT);
  if (gtid < 64) cnt[gtid] = 0;
  f32x2* rope = (f32x2*)(p.ws + WS_ROPE);
  for (int i = gtid; i < SEQ * 64; i += gsz) {
    const int pos = i >> 6, f = i & 63;
    const float inv = powf(10000.0f, -(float)(2 * f) / 128.0f);
    const float ang = (float)pos * inv;
    float s, c; sincosf(ang, &s, &c);
    rope[i] = (f32x2){c, s};
  }
  u16* wr16 = (u16*)(p.ws + WS_WR16);
  for (int i = gtid; i < 2 * 48 * DM; i += gsz) {
    const int k = i & (DM - 1), n = (i >> 10) % 48, layer = i / (48 * DM);
    float w = 0.f;
    if (n < 4) w = p.w_group[((size_t)layer * DM + k) * 4 + n];
    else if (n < 36) { const int gg = (n - 4) >> 3, j = (n - 4) & 7; w = p.w_er[(((size_t)layer * 4 + gg) * DM + k) * 8 + j]; }
    w *= p.norm_ffn_g[layer * DM + k];
    const u16 hi = f2h(w), lo = f2h(w - h2f(hi));
    wr16[((size_t)(layer * 2 + 0) * 48 + n) * DM + k] = hi;
    wr16[((size_t)(layer * 2 + 1) * 48 + n) * DM + k] = lo;
  }
}

constexpr int NWAVE = NTHR / 64;
__device__ __forceinline__ void phase_rowpass(const P& p, const float* src, const u16* slots, float* dstx, const float* gain, int route_layer, float* fout, char* smem) {
  const int lane = threadIdx.x & 63, wv = threadIdx.x >> 6, gw = blockIdx.x * NWAVE + wv, nw = gridDim.x * NWAVE, fr = lane & 15, lg = lane >> 4;
  u16* xb = (u16*)(p.ws + WS_XB);
  int* cnt = (int*)(p.ws + WS_CNT);
  int* list = (int*)(p.ws + WS_LIST);
  float* gate = (float*)(p.ws + WS_GATE);
  float* sRs = (float*)smem + wv * 16;
  float* sLg = (float*)smem + NWAVE * 16 + wv * 16 * 49;
  for (int tile = gw; tile < T_TOK / 16; tile += nw) {
    for (int rr = 0; rr < 16; ++rr) {
      const int row = tile * 16 + rr;
      f32x4 v[4];
      float ss = 0.f;
#pragma unroll
      for (int i = 0; i < 4; ++i) {
        const int k = (i * 64 + lane) * 4;
        v[i] = *(const f32x4*)(src + (size_t)row * DM + k);
        if (slots) {
#pragma unroll
          for (int sl = 0; sl < 2; ++sl) {
            const uint2 w = *(const uint2*)(slots + ((size_t)row * 2 + sl) * DM + k);
            v[i][0] += lo16(w.x); v[i][1] += hi16(w.x); v[i][2] += lo16(w.y); v[i][3] += hi16(w.y);
          }
        }
        if (dstx) *(f32x4*)(dstx + (size_t)row * DM + k) = v[i];
        ss += v[i][0] * v[i][0] + v[i][1] * v[i][1] + v[i][2] * v[i][2] + v[i][3] * v[i][3];
      }
      ss = wave_sum(ss);
      const float rstd = rsqrtf(ss * (1.0f / DM) + 1e-6f);
      if (route_layer >= 0 && lane == 0) sRs[rr] = rstd;
#pragma unroll
      for (int i = 0; i < 4; ++i) {
        const int k = (i * 64 + lane) * 4;
        const f32x4 gv = *(const f32x4*)(gain + k);
        v[i] = v[i] * rstd * gv;
        if (fout) *(f32x4*)(fout + (size_t)row * DM + k) = v[i];
        else { uint2 w; w.x = pk2(v[i][0], v[i][1]); w.y = pk2(v[i][2], v[i][3]); *(uint2*)(xb + (size_t)row * DM + k) = w; }
      }
    }
    if (route_layer >= 0) {
      asm volatile("s_waitcnt lgkmcnt(0)" ::: "memory");
      const float rsv = sRs[fr];
      const float* xrow = src + (size_t)(tile * 16 + fr) * DM + lg * 8;
      const u16* whi = (const u16*)(p.ws + WS_WR16) + ((size_t)(route_layer * 2 + 0) * 48 + fr) * DM + lg * 8;
      const u16* wlo = (const u16*)(p.ws + WS_WR16) + ((size_t)(route_layer * 2 + 1) * 48 + fr) * DM + lg * 8;
      f32x4 acc[3];
#pragma unroll
      for (int nb = 0; nb < 3; ++nb) acc[nb] = (f32x4){0.f, 0.f, 0.f, 0.f};
      for (int ks = 0; ks < 32; ++ks) {
        const f32x4 x0 = *(const f32x4*)(xrow + ks * 32), x1 = *(const f32x4*)(xrow + ks * 32 + 4);
        const float hv[8] = {x0[0] * rsv, x0[1] * rsv, x0[2] * rsv, x0[3] * rsv, x1[0] * rsv, x1[1] * rsv, x1[2] * rsv, x1[3] * rsv};
        unsigned ah[4], al[4];
#pragma unroll
        for (int j = 0; j < 4; ++j) {
          const u16 h0 = f2h(hv[2 * j]), h1 = f2h(hv[2 * j + 1]);
          ah[j] = (unsigned)h0 | ((unsigned)h1 << 16);
          al[j] = pk2(hv[2 * j] - h2f(h0), hv[2 * j + 1] - h2f(h1));
        }
        const uint4 ahi = make_uint4(ah[0], ah[1], ah[2], ah[3]), alo = make_uint4(al[0], al[1], al[2], al[3]);
#pragma unroll
        for (int nb = 0; nb < 3; ++nb) {
          const uint4 bh = *(const uint4*)(whi + (size_t)nb * 16 * DM + ks * 32), bl = *(const uint4*)(wlo + (size_t)nb * 16 * DM + ks * 32);
          acc[nb] = mfma16(bh, ahi, acc[nb]); acc[nb] = mfma16(bh, alo, acc[nb]); acc[nb] = mfma16(bl, ahi, acc[nb]);
        }
      }
#pragma unroll
      for (int nb = 0; nb < 3; ++nb)
#pragma unroll
        for (int r = 0; r < 4; ++r) sLg[fr * 49 + nb * 16 + 4 * lg + r] = acc[nb][r];
      asm volatile("s_waitcnt lgkmcnt(0)" ::: "memory");
      if (lane < 16) {
        const int row = tile * 16 + lane;
        const float* lgt = sLg + lane * 49;
        const float* bg = p.b_group + route_layer * 4;
        const float* be = p.b_er + route_layer * 32;
        float gl[4];
#pragma unroll
        for (int j = 0; j < 4; ++j) gl[j] = lgt[j] + bg[j];
        int gs = 0; float gm = gl[0];
#pragma unroll
        for (int j = 1; j < 4; ++j) if (gl[j] > gm) { gm = gl[j]; gs = j; }
        float den = 0.f;
#pragma unroll
        for (int j = 0; j < 4; ++j) den += expf(gl[j] - gm);
        const float pg = 1.0f / den;
        float el[8];
#pragma unroll
        for (int j = 0; j < 8; ++j) el[j] = lgt[4 + gs * 8 + j] + be[gs * 8 + j];
        int i1 = 0; float v1 = el[0];
#pragma unroll
        for (int j = 1; j < 8; ++j) if (el[j] > v1) { v1 = el[j]; i1 = j; }
        int i2 = -1; float v2 = -3.0e38f;
#pragma unroll
        for (int j = 0; j < 8; ++j) if (j != i1 && el[j] > v2) { v2 = el[j]; i2 = j; }
        const float e2 = expf(v2 - v1);
        const float g1 = pg / (1.0f + e2), g2 = pg * e2 / (1.0f + e2);
        const int ex1 = gs * 8 + i1, ex2 = gs * 8 + i2;
        const int r1 = atomicAdd(&cnt[route_layer * 32 + ex1], 1);
        list[(size_t)ex1 * CAP + r1] = row * 2;
        gate[row * 2] = g1;
        const int r2 = atomicAdd(&cnt[route_layer * 32 + ex2], 1);
        list[(size_t)ex2 * CAP + r2] = row * 2 + 1;
        gate[row * 2 + 1] = g2;
      }
    }
  }
}

__device__ __forceinline__ void phase_inproj(const P& p, char* smem) {
  GemmDesc g{}; g.A = (const u16*)(p.ws + WS_XB); g.lda = DM; g.mvalid = T_TOK; g.W = p.w_in; g.ldw = 2560; g.K = DM;
  u16* zb = (u16*)(p.ws + WS_Z); u16* a2 = (u16*)(p.ws + WS_A2);
  const int ntiles = 128 * 20;
  for (int t = blockIdx.x; t < ntiles; t += gridDim.x) {
    const int mt = t / 20, nt = t % 20;
    gemm_tile(g, mt * 128, nt * 128, [&](f32x4 (&acc)[4][4], int row0, int col0) {
      const int seg = (nt * 128) / 512;
#pragma unroll
      for (int m = 0; m < 4; ++m)
#pragma unroll
        for (int n = 0; n < 4; ++n) {
          const int row = row0 + m * 16, col = col0 + n * 16;
          uint2 w; w.x = pk2(acc[m][n][0], acc[m][n][1]); w.y = pk2(acc[m][n][2], acc[m][n][3]);
          if (seg < 4) *(uint2*)(zb + (size_t)seg * T_TOK * 512 + (size_t)row * 512 + (col - seg * 512)) = w;
          else { const int ch = col - 2048, gi = ch >> 4, c = ch & 15; *(uint2*)(a2 + ((size_t)gi * 512 + (row >> 5)) * 768 + (row & 31) * 16 + c) = w; }
        }
    }, smem);
  }
}

constexpr int RSTR = 136;
__device__ __forceinline__ void ret_load_tile(u16* dst, const u16* src, int t0, int h, int mode  , const f32x2* rope) {
  const int pos0 = t0 & (SEQ - 1);
  for (int idx = threadIdx.x; idx < 128 * 64; idx += NTHR) {
    const int i = idx >> 6, d = idx & 63;
    float t1 = h2f(src[(size_t)(t0 + i) * 512 + h * 128 + d]), t2 = h2f(src[(size_t)(t0 + i) * 512 + h * 128 + d + 64]);
    if (mode) {
      const f32x2 cs = rope[(pos0 + i) * 64 + d];
      const float o1 = t1 * cs[0] - t2 * cs[1], o2 = t1 * cs[1] + t2 * cs[0];
      t1 = o1; t2 = o2;
      if (mode == 2) { t1 *= 0.08838834764831845f; t2 *= 0.08838834764831845f; }
    }
    dst[i * RSTR + d] = f2h(t1); dst[i * RSTR + d + 64] = f2h(t2);
  }
}
__device__ __forceinline__ float log_sigmoid(float x) { return -log1pf(expf(-x)); }

__device__ __forceinline__ void phase_ret_inc(const P& p, char* smem) {
  u16* sK = (u16*)smem; u16* sV = sK + 128 * RSTR; float* sWf = (float*)(sV + 128 * RSTR); float* sWb = sWf + 128;
  const u16* kb = (const u16*)(p.ws + WS_Z) + (size_t)1 * T_TOK * 512; const u16* vb = (const u16*)(p.ws + WS_Z) + (size_t)2 * T_TOK * 512;
  const f32x2* rope = (const f32x2*)(p.ws + WS_ROPE);
  float* incf = (float*)(p.ws + WS_INC); float* incb = incf + (size_t)512 * 16384;
  const int tid = threadIdx.x;
  for (int item = blockIdx.x; item < 512; item += gridDim.x) {
    const int h = item & 3, bn = item >> 2, t0 = bn * 128;
    const float lgf = log_sigmoid(p.ret_decay[h]), lgb = log_sigmoid(p.ret_decay[4 + h]);
    __syncthreads();
    ret_load_tile(sK, kb, t0, h, 2, rope);
    ret_load_tile(sV, vb, t0, h, 0, rope);
    if (tid < 128) { sWf[tid] = expf(lgf * (float)(127 - tid)); sWb[tid] = expf(lgb * (float)tid); }
    __syncthreads();
    const int d0 = (tid >> 4) * 8, e0 = (tid & 15) * 8;
    float af[8][8], ab[8][8];
#pragma unroll
    for (int a = 0; a < 8; ++a)
#pragma unroll
      for (int b = 0; b < 8; ++b) { af[a][b] = 0.f; ab[a][b] = 0.f; }
    for (int j = 0; j < 128; ++j) {
      const uint4 kq = *(const uint4*)(sK + j * RSTR + d0), vq = *(const uint4*)(sV + j * RSTR + e0);
      const float kd[8] = {lo16(kq.x), hi16(kq.x), lo16(kq.y), hi16(kq.y), lo16(kq.z), hi16(kq.z), lo16(kq.w), hi16(kq.w)};
      const float ve[8] = {lo16(vq.x), hi16(vq.x), lo16(vq.y), hi16(vq.y), lo16(vq.z), hi16(vq.z), lo16(vq.w), hi16(vq.w)};
      const float wf = sWf[j], wb = sWb[j];
#pragma unroll
      for (int a = 0; a < 8; ++a) {
        const float kf = kd[a] * wf, kbw = kd[a] * wb;
#pragma unroll
        for (int b = 0; b < 8; ++b) { af[a][b] += kf * ve[b]; ab[a][b] += kbw * ve[b]; }
      }
    }
#pragma unroll
    for (int a = 0; a < 8; ++a) {
      float* of = incf + (size_t)item * 16384 + (d0 + a) * 128 + e0;
      float* ob = incb + (size_t)item * 16384 + (d0 + a) * 128 + e0;
      *(f32x4*)of = (f32x4){af[a][0], af[a][1], af[a][2], af[a][3]}; *(f32x4*)(of + 4) = (f32x4){af[a][4], af[a][5], af[a][6], af[a][7]};
      *(f32x4*)ob = (f32x4){ab[a][0], ab[a][1], ab[a][2], ab[a][3]}; *(f32x4*)(ob + 4) = (f32x4){ab[a][4], ab[a][5], ab[a][6], ab[a][7]};
    }
  }
}

__device__ __forceinline__ void phase_ret_scan(const P& p) {
  float* incf = (float*)(p.ws + WS_INC); float* incb = incf + (size_t)512 * 16384;
  const int gtid = blockIdx.x * NTHR + threadIdx.x, gsz = gridDim.x * NTHR;
  for (int idx = gtid; idx < 32 * 16384; idx += gsz) {
    const int de = idx & 16383, bh = idx >> 14, b = bh >> 2, h = bh & 3;
    const float Gf = expf(128.0f * log_sigmoid(p.ret_decay[h])), Gb = expf(128.0f * log_sigmoid(p.ret_decay[4 + h]));
    float s = 0.f;
    for (int n = 0; n < 16; ++n) { float* q = incf + ((size_t)((b * 16 + n) * 4 + h)) * 16384 + de; const float t = *q; *q = s; s = s * Gf + t; }
    s = 0.f;
    for (int n = 15; n >= 0; --n) { float* q = incb + ((size_t)((b * 16 + n) * 4 + h)) * 16384 + de; const float t = *q; *q = s; s = s * Gb + t; }
  }
}

__device__ __forceinline__ void phase_ret_out(const P& p, char* smem) {
  u16* sQ = (u16*)smem; u16* sK = sQ + 128 * RSTR; u16* sV = sK + 128 * RSTR; u16* sS = sV + 128 * RSTR;
  float* sPf = (float*)(sS + 128 * RSTR); float* sPb = sPf + 132;
  const u16* zb = (const u16*)(p.ws + WS_Z);
  const u16* qb = zb; const u16* kb = zb + (size_t)1 * T_TOK * 512; const u16* vb = zb + (size_t)2 * T_TOK * 512; const u16* gb = zb + (size_t)3 * T_TOK * 512;
  const f32x2* rope = (const f32x2*)(p.ws + WS_ROPE);
  const float* incf = (const float*)(p.ws + WS_INC); const float* incb = incf + (size_t)512 * 16384;
  u16* ycat = (u16*)(p.ws + WS_YCAT);
  const int tid = threadIdx.x;
  for (int item = blockIdx.x; item < 512; item += gridDim.x) {
    const int h = item & 3, bn = item >> 2, t0 = bn * 128;
    const float lgf = log_sigmoid(p.ret_decay[h]), lgb = log_sigmoid(p.ret_decay[4 + h]);
    __syncthreads();
    ret_load_tile(sQ, qb, t0, h, 1, rope);
    ret_load_tile(sK, kb, t0, h, 2, rope);
    ret_load_tile(sV, vb, t0, h, 0, rope);
    if (tid < 129) { sPf[tid] = expf(lgf * (float)tid); sPb[tid] = expf(lgb * (float)tid); }
    __syncthreads();
    const int i0 = (tid >> 4) * 8, j0 = (tid & 15) * 8;
    {
      float s[8][8];
#pragma unroll
      for (int a = 0; a < 8; ++a)
#pragma unroll
        for (int b = 0; b < 8; ++b) s[a][b] = 0.f;
      for (int d = 0; d < 128; d += 8) {
        float kk[8][8];
#pragma unroll
        for (int b = 0; b < 8; ++b) {
          const uint4 kq = *(const uint4*)(sK + (j0 + b) * RSTR + d);
          kk[b][0] = lo16(kq.x); kk[b][1] = hi16(kq.x); kk[b][2] = lo16(kq.y); kk[b][3] = hi16(kq.y); kk[b][4] = lo16(kq.z); kk[b][5] = hi16(kq.z); kk[b][6] = lo16(kq.w); kk[b][7] = hi16(kq.w);
        }
#pragma unroll
        for (int a = 0; a < 8; ++a) {
          const uint4 qq = *(const uint4*)(sQ + (i0 + a) * RSTR + d);
          const float qv[8] = {lo16(qq.x), hi16(qq.x), lo16(qq.y), hi16(qq.y), lo16(qq.z), hi16(qq.z), lo16(qq.w), hi16(qq.w)};
#pragma unroll
          for (int b = 0; b < 8; ++b)
#pragma unroll
            for (int c = 0; c < 8; ++c) s[a][b] += qv[c] * kk[b][c];
        }
      }
#pragma unroll
      for (int a = 0; a < 8; ++a) {
        unsigned w[4];
#pragma unroll
        for (int b = 0; b < 8; b += 2) {
          const int i = i0 + a, j = j0 + b;
          const float m0 = (i >= j) ? sPf[i - j] : sPb[j - i];
          const float m1 = (i >= j + 1) ? sPf[i - j - 1] : sPb[j + 1 - i];
          w[b >> 1] = pk2(s[a][b] * m0, s[a][b + 1] * m1);
        }
        *(uint4*)(sS + (i0 + a) * RSTR + j0) = make_uint4(w[0], w[1], w[2], w[3]);
      }
    }
    __syncthreads();
    {
      const int e0 = j0;
      float o[8][8];
#pragma unroll
      for (int a = 0; a < 8; ++a)
#pragma unroll
        for (int b = 0; b < 8; ++b) o[a][b] = 0.f;
      for (int j = 0; j < 128; j += 8) {
        float vv[8][8];
#pragma unroll
        for (int c = 0; c < 8; ++c) {
          const uint4 vq = *(const uint4*)(sV + (j + c) * RSTR + e0);
          vv[c][0] = lo16(vq.x); vv[c][1] = hi16(vq.x); vv[c][2] = lo16(vq.y); vv[c][3] = hi16(vq.y); vv[c][4] = lo16(vq.z); vv[c][5] = hi16(vq.z); vv[c][6] = lo16(vq.w); vv[c][7] = hi16(vq.w);
        }
#pragma unroll
        for (int a = 0; a < 8; ++a) {
          const uint4 sq = *(const uint4*)(sS + (i0 + a) * RSTR + j);
          const float sv[8] = {lo16(sq.x), hi16(sq.x), lo16(sq.y), hi16(sq.y), lo16(sq.z), hi16(sq.z), lo16(sq.w), hi16(sq.w)};
#pragma unroll
          for (int c = 0; c < 8; ++c)
#pragma unroll
            for (int b = 0; b < 8; ++b) o[a][b] += sv[c] * vv[c][b];
        }
      }
      const float* sp = incf + (size_t)item * 16384 + e0;
      const float* sn = incb + (size_t)item * 16384 + e0;
      float pf[8], pb[8];
#pragma unroll
      for (int a = 0; a < 8; ++a) { pf[a] = sPf[i0 + a + 1]; pb[a] = sPb[128 - (i0 + a)]; }
      for (int d = 0; d < 128; ++d) {
        const f32x4 p0 = *(const f32x4*)(sp + d * 128), p1 = *(const f32x4*)(sp + d * 128 + 4);
        const f32x4 n0 = *(const f32x4*)(sn + d * 128), n1 = *(const f32x4*)(sn + d * 128 + 4);
        const float spv[8] = {p0[0], p0[1], p0[2], p0[3], p1[0], p1[1], p1[2], p1[3]};
        const float snv[8] = {n0[0], n0[1], n0[2], n0[3], n1[0], n1[1], n1[2], n1[3]};
#pragma unroll
        for (int a = 0; a < 8; ++a) {
          const float qv = h2f(sQ[(i0 + a) * RSTR + d]);
          const float qf = qv * pf[a], qbk = qv * pb[a];
#pragma unroll
          for (int b = 0; b < 8; ++b) o[a][b] += qf * spv[b] + qbk * snv[b];
        }
      }
#pragma unroll
      for (int a = 0; a < 8; ++a) {
        float s1 = 0.f;
#pragma unroll
        for (int b = 0; b < 8; ++b) s1 += o[a][b];
        s1 += __shfl_xor(s1, 1); s1 += __shfl_xor(s1, 2); s1 += __shfl_xor(s1, 4); s1 += __shfl_xor(s1, 8);
        const float mu = s1 * (1.0f / 128.0f);
        float s2 = 0.f;
#pragma unroll
        for (int b = 0; b < 8; ++b) { const float dlt = o[a][b] - mu; s2 += dlt * dlt; }
        s2 += __shfl_xor(s2, 1); s2 += __shfl_xor(s2, 2); s2 += __shfl_xor(s2, 4); s2 += __shfl_xor(s2, 8);
        const float rs = rsqrtf(s2 * (1.0f / 128.0f) + 1e-5f);
        const size_t tok = (size_t)(t0 + i0 + a);
        const uint4 gq = *(const uint4*)(gb + tok * 512 + h * 128 + e0);
        const float gv[8] = {lo16(gq.x), hi16(gq.x), lo16(gq.y), hi16(gq.y), lo16(gq.z), hi16(gq.z), lo16(gq.w), hi16(gq.w)};
        unsigned w[4];
#pragma unroll
        for (int b = 0; b < 8; b += 2) {
          const float y0 = gv[b] * sigmoidf_(gv[b]) * (o[a][b] - mu) * rs;
          const float y1 = gv[b + 1] * sigmoidf_(gv[b + 1]) * (o[a][b + 1] - mu) * rs;
          w[b >> 1] = pk2(y0, y1);
        }
        *(uint4*)(ycat + tok * DM + h * 128 + e0) = make_uint4(w[0], w[1], w[2], w[3]);
      }
    }
  }
}

template <int MB_, int NB_>
__device__ __forceinline__ void lds_mma(f32x4 (&acc)[MB_][NB_], const u16* sA, int sa, int a0, const u16* sB, int sb, int b0, int K, int lane, const float* sc) {
  const int fr = lane & 15, fq = lane >> 4;
  for (int k0 = 0; k0 < K; k0 += 32) {
    uint4 fa[MB_], fb[NB_];
#pragma unroll
    for (int m = 0; m < MB_; ++m) {
      fa[m] = *(const uint4*)(sA + (a0 + m * 16 + fr) * sa + k0 + fq * 8);
      if (sc) {
        const float f = sc[m];
        fa[m].x = pk2(lo16(fa[m].x) * f, hi16(fa[m].x) * f); fa[m].y = pk2(lo16(fa[m].y) * f, hi16(fa[m].y) * f);
        fa[m].z = pk2(lo16(fa[m].z) * f, hi16(fa[m].z) * f); fa[m].w = pk2(lo16(fa[m].w) * f, hi16(fa[m].w) * f);
      }
    }
#pragma unroll
    for (int n = 0; n < NB_; ++n) fb[n] = *(const uint4*)(sB + (b0 + n * 16 + fr) * sb + k0 + fq * 8);
#pragma unroll
    for (int m = 0; m < MB_; ++m)
#pragma unroll
      for (int n = 0; n < NB_; ++n) acc[m][n] = mfma16(fb[n], fa[m], acc[m][n]);
  }
}
__device__ __forceinline__ void ret_stage_T(u16* dst0, u16* dst1, const u16* src, int t0, int h, int mode, const f32x2* rope, const float* w0, const float* w1) {
  const int pos0 = t0 & (SEQ - 1);
  for (int idx = threadIdx.x; idx < 32 * 64; idx += NTHR) {
    const int ii = idx >> 6, d = idx & 63;
    float a1[4], a2[4];
#pragma unroll
    for (int r = 0; r < 4; ++r) {
      const int i = 4 * ii + r;
      float t1 = h2f(src[(size_t)(t0 + i) * 512 + h * 128 + d]), t2 = h2f(src[(size_t)(t0 + i) * 512 + h * 128 + d + 64]);
      if (mode) {
        const f32x2 cs = rope[(pos0 + i) * 64 + d];
        const float o1 = t1 * cs[0] - t2 * cs[1], o2 = t1 * cs[1] + t2 * cs[0];
        t1 = o1; t2 = o2;
        if (mode == 2) { t1 *= 0.08838834764831845f; t2 *= 0.08838834764831845f; }
      }
      a1[r] = t1; a2[r] = t2;
    }
    if (w0) {
      const f32x4 wa = *(const f32x4*)(w0 + 4 * ii), wb = *(const f32x4*)(w1 + 4 * ii);
      uint2 o;
      o.x = pk2(a1[0] * wa[0], a1[1] * wa[1]); o.y = pk2(a1[2] * wa[2], a1[3] * wa[3]); *(uint2*)(dst0 + d * RSTR + 4 * ii) = o;
      o.x = pk2(a2[0] * wa[0], a2[1] * wa[1]); o.y = pk2(a2[2] * wa[2], a2[3] * wa[3]); *(uint2*)(dst0 + (d + 64) * RSTR + 4 * ii) = o;
      o.x = pk2(a1[0] * wb[0], a1[1] * wb[1]); o.y = pk2(a1[2] * wb[2], a1[3] * wb[3]); *(uint2*)(dst1 + d * RSTR + 4 * ii) = o;
      o.x = pk2(a2[0] * wb[0], a2[1] * wb[1]); o.y = pk2(a2[2] * wb[2], a2[3] * wb[3]); *(uint2*)(dst1 + (d + 64) * RSTR + 4 * ii) = o;
    } else {
      uint2 o;
      o.x = pk2(a1[0], a1[1]); o.y = pk2(a1[2], a1[3]); *(uint2*)(dst0 + d * RSTR + 4 * ii) = o;
      o.x = pk2(a2[0], a2[1]); o.y = pk2(a2[2], a2[3]); *(uint2*)(dst0 + (d + 64) * RSTR + 4 * ii) = o;
    }
  }
}
__device__ __forceinline__ void phase_ret_inc_mfma(const P& p, char* smem) {
  u16* sKf = (u16*)smem; u16* sKb = sKf + 128 * RSTR; u16* sVT = sKb + 128 * RSTR; float* sWf = (float*)(sVT + 128 * RSTR); float* sWb = sWf + 128;
  const u16* kb = (const u16*)(p.ws + WS_Z) + (size_t)1 * T_TOK * 512; const u16* vb = (const u16*)(p.ws + WS_Z) + (size_t)2 * T_TOK * 512;
  const f32x2* rope = (const f32x2*)(p.ws + WS_ROPE);
  float* incf = (float*)(p.ws + WS_INC); float* incb = incf + (size_t)512 * 16384;
  const int tid = threadIdx.x, lane = tid & 63, wv = tid >> 6, wr = wv >> 1, wc = wv & 1, fr = lane & 15, fq = lane >> 4;
  for (int item = blockIdx.x; item < 512; item += gridDim.x) {
    const int h = item & 3, bn = item >> 2, t0 = bn * 128;
    const float lgf = log_sigmoid(p.ret_decay[h]), lgb = log_sigmoid(p.ret_decay[4 + h]);
    __syncthreads();
    if (tid < 128) { sWf[tid] = expf(lgf * (float)(127 - tid)); sWb[tid] = expf(lgb * (float)tid); }
    __syncthreads();
    ret_stage_T(sKf, sKb, kb, t0, h, 2, rope, sWf, sWb);
    ret_stage_T(sVT, nullptr, vb, t0, h, 0, rope, nullptr, nullptr);
    __syncthreads();
#pragma unroll
    for (int dirn = 0; dirn < 2; ++dirn) {
      f32x4 acc[4][4];
#pragma unroll
      for (int m = 0; m < 4; ++m)
#pragma unroll
        for (int n = 0; n < 4; ++n) acc[m][n] = (f32x4){0.f, 0.f, 0.f, 0.f};
      lds_mma<4, 4>(acc, sVT, RSTR, wr * 64, dirn ? sKb : sKf, RSTR, wc * 64, 128, lane, nullptr);
      float* o = (dirn ? incb : incf) + (size_t)item * 16384;
#pragma unroll
      for (int m = 0; m < 4; ++m)
#pragma unroll
        for (int n = 0; n < 4; ++n) *(f32x4*)(o + (wr * 64 + m * 16 + fr) * 128 + wc * 64 + n * 16 + 4 * fq) = acc[m][n];
    }
  }
}
__device__ __forceinline__ void phase_ret_scan16(const P& p) {
  const float* incf = (const float*)(p.ws + WS_INC); const float* incb = incf + (size_t)512 * 16384;
  u16* spf = (u16*)(p.ws + WS_SP16); u16* spb = spf + (size_t)512 * 16384;
  const int gtid = blockIdx.x * NTHR + threadIdx.x, gsz = gridDim.x * NTHR;
  for (int idx = gtid; idx < 32 * 4096; idx += gsz) {
    const int de = (idx & 4095) * 4, bh = idx >> 12, b = bh >> 2, h = bh & 3;
    const float Gf = expf(128.0f * log_sigmoid(p.ret_decay[h])), Gb = expf(128.0f * log_sigmoid(p.ret_decay[4 + h]));
    f32x4 s = {0.f, 0.f, 0.f, 0.f};
    for (int n = 0; n < 16; ++n) {
      const size_t o = ((size_t)((b * 16 + n) * 4 + h)) * 16384 + de;
      const f32x4 t = *(const f32x4*)(incf + o);
      uint2 w; w.x = pk2(s[0], s[1]); w.y = pk2(s[2], s[3]); *(uint2*)(spf + o) = w;
      s = s * Gf + t;
    }
    s = (f32x4){0.f, 0.f, 0.f, 0.f};
    for (int n = 15; n >= 0; --n) {
      const size_t o = ((size_t)((b * 16 + n) * 4 + h)) * 16384 + de;
      const f32x4 t = *(const f32x4*)(incb + o);
      uint2 w; w.x = pk2(s[0], s[1]); w.y = pk2(s[2], s[3]); *(uint2*)(spb + o) = w;
      s = s * Gb + t;
    }
  }
}
__device__ __forceinline__ void phase_ret_out_mfma(const P& p, char* smem) {
  u16* R0 = (u16*)smem; u16* R1 = R0 + 128 * RSTR; u16* R2 = R1 + 128 * RSTR; u16* R3 = R2 + 128 * RSTR;
  float* sPf = (float*)(R3 + 128 * RSTR); float* sPb = sPf + 132;
  const u16* zb = (const u16*)(p.ws + WS_Z);
  const u16* qb = zb; const u16* kb = zb + (size_t)1 * T_TOK * 512; const u16* vb = zb + (size_t)2 * T_TOK * 512; const u16* gb = zb + (size_t)3 * T_TOK * 512;
  const f32x2* rope = (const f32x2*)(p.ws + WS_ROPE);
  const u16* spf = (const u16*)(p.ws + WS_SP16); const u16* spb = spf + (size_t)512 * 16384;
  u16* ycat = (u16*)(p.ws + WS_YCAT);
  const int tid = threadIdx.x, lane = tid & 63, wv = tid >> 6, wr = wv >> 1, wc = wv & 1, fr = lane & 15, fq = lane >> 4;
  for (int item = blockIdx.x; item < 512; item += gridDim.x) {
    const int h = item & 3, bn = item >> 2, t0 = bn * 128;
    const float lgf = log_sigmoid(p.ret_decay[h]), lgb = log_sigmoid(p.ret_decay[4 + h]);
    __syncthreads();
    ret_load_tile(R0, qb, t0, h, 1, rope);
    ret_load_tile(R1, kb, t0, h, 2, rope);
    ret_stage_T(R2, nullptr, vb, t0, h, 0, rope, nullptr, nullptr);
    if (tid < 129) { sPf[tid] = expf(lgf * (float)tid); sPb[tid] = expf(lgb * (float)tid); }
    __syncthreads();
    {
      f32x4 acc[4][4];
#pragma unroll
      for (int m = 0; m < 4; ++m)
#pragma unroll
        for (int n = 0; n < 4; ++n) acc[m][n] = (f32x4){0.f, 0.f, 0.f, 0.f};
      lds_mma<4, 4>(acc, R0, RSTR, wr * 64, R1, RSTR, wc * 64, 128, lane, nullptr);
#pragma unroll
      for (int m = 0; m < 4; ++m)
#pragma unroll
        for (int n = 0; n < 4; ++n) {
          const int i = wr * 64 + m * 16 + fr, j = wc * 64 + n * 16 + 4 * fq;
          float v[4];
#pragma unroll
          for (int r = 0; r < 4; ++r) { const int jj = j + r; v[r] = acc[m][n][r] * ((i >= jj) ? sPf[i - jj] : sPb[jj - i]); }
          uint2 w; w.x = pk2(v[0], v[1]); w.y = pk2(v[2], v[3]);
          *(uint2*)(R3 + i * RSTR + j) = w;
        }
    }
    __syncthreads();
    const u16* spT = spf + (size_t)item * 16384; const u16* snT = spb + (size_t)item * 16384;
    for (int c = tid; c < 128 * 16; c += NTHR) { const int e = c >> 4, ch = (c & 15) * 8; *(uint4*)(R1 + e * RSTR + ch) = *(const uint4*)(spT + e * 128 + ch); }
    f32x4 o[2][8];
#pragma unroll
    for (int m = 0; m < 2; ++m)
#pragma unroll
      for (int n = 0; n < 8; ++n) o[m][n] = (f32x4){0.f, 0.f, 0.f, 0.f};
    lds_mma<2, 8>(o, R3, RSTR, wv * 32, R2, RSTR, 0, 128, lane, nullptr);
    __syncthreads();
    for (int c = tid; c < 128 * 16; c += NTHR) { const int e = c >> 4, ch = (c & 15) * 8; *(uint4*)(R2 + e * RSTR + ch) = *(const uint4*)(snT + e * 128 + ch); }
    float scf[2], scb[2];
#pragma unroll
    for (int m = 0; m < 2; ++m) { const int i = wv * 32 + m * 16 + fr; scf[m] = sPf[i + 1]; scb[m] = sPb[128 - i]; }
    lds_mma<2, 8>(o, R0, RSTR, wv * 32, R1, RSTR, 0, 128, lane, scf);
    __syncthreads();
    lds_mma<2, 8>(o, R0, RSTR, wv * 32, R2, RSTR, 0, 128, lane, scb);
#pragma unroll
    for (int m = 0; m < 2; ++m) {
      float s1 = 0.f;
#pragma unroll
      for (int n = 0; n < 8; ++n) s1 += (o[m][n][0] + o[m][n][1]) + (o[m][n][2] + o[m][n][3]);
      s1 += __shfl_xor(s1, 16); s1 += __shfl_xor(s1, 32);
      const float mu = s1 * (1.0f / 128.0f);
      float s2 = 0.f;
#pragma unroll
      for (int n = 0; n < 8; ++n)
#pragma unroll
        for (int r = 0; r < 4; ++r) { const float dl = o[m][n][r] - mu; s2 += dl * dl; }
      s2 += __shfl_xor(s2, 16); s2 += __shfl_xor(s2, 32);
      const float rs = rsqrtf(s2 * (1.0f / 128.0f) + 1e-5f);
      const size_t tok = (size_t)(t0 + wv * 32 + m * 16 + fr);
#pragma unroll
      for (int n = 0; n < 8; ++n) {
        const int e = n * 16 + 4 * fq;
        const uint2 gq = *(const uint2*)(gb + tok * 512 + h * 128 + e);
        const float g0 = lo16(gq.x), g1 = hi16(gq.x), g2 = lo16(gq.y), g3 = hi16(gq.y);
        uint2 w;
        w.x = pk2(g0 * sigmoidf_(g0) * (o[m][n][0] - mu) * rs, g1 * sigmoidf_(g1) * (o[m][n][1] - mu) * rs);
        w.y = pk2(g2 * sigmoidf_(g2) * (o[m][n][2] - mu) * rs, g3 * sigmoidf_(g3) * (o[m][n][3] - mu) * rs);
        *(uint2*)(ycat + tok * DM + h * 128 + e) = w;
      }
    }
  }
}

__device__ __forceinline__ void phase_s5_naive(const P& p, char* smem) {
  float* ylds = (float*)smem;
  float* xs = ylds + 2048 * 16;
  const u16* a2 = (const u16*)(p.ws + WS_A2);
  u16* ygelu = (u16*)(p.ws + WS_YGELU);
  const int lane = threadIdx.x & 63;
  if (threadIdx.x < 64) {
    for (int item = blockIdx.x; item < 256; item += gridDim.x) {
      const int b = item >> 5, g = item & 31;
      const int pidx = lane;
      const int cidx = lane & 15, quart = lane >> 4;
      for (int dir = 0; dir < 2; ++dir) {
        const float dt = expf(p.log_step[dir * 32 + g]);
        const float ar = p.a_re[(dir * 32 + g) * 64 + pidx], ai = p.a_im[(dir * 32 + g) * 64 + pidx];
        const float mag = expf(ar * dt);
        float sn, cs; sincosf(ai * dt, &sn, &cs);
        const float lre = mag * cs, lim = mag * sn;
        const float nr = lre - 1.0f, ni = lim, den = ar * ar + ai * ai;
        const float cre = (nr * ar + ni * ai) / den, cim = (ni * ar - nr * ai) / den;
        float bbr[16], bbi[16];
#pragma unroll
        for (int c = 0; c < 16; ++c) {
          const float br = p.b_re[(g * 64 + pidx) * 16 + c], bi = p.b_im[(g * 64 + pidx) * 16 + c];
          bbr[c] = cre * br - cim * bi; bbi[c] = cre * bi + cim * br;
        }
        float ccr[16], cci[16];
#pragma unroll
        for (int q = 0; q < 16; ++q) {
          ccr[q] = p.c_re[((dir * 32 + g) * 16 + cidx) * 64 + quart * 16 + q];
          cci[q] = p.c_im[((dir * 32 + g) * 16 + cidx) * 64 + quart * 16 + q];
        }
        const float dsk = p.s5d[g * 16 + cidx];
        float xr = 0.f, xi = 0.f;
        for (int step = 0; step < SEQ; ++step) {
          const int n = dir ? (SEQ - 1 - step) : step;
          const int t = b * SEQ + n;
          const u16* up = a2 + ((size_t)g * 512 + (t >> 5)) * 768 + (t & 31) * 16;
          const uint4 u0 = *(const uint4*)up, u1 = *(const uint4*)(up + 8);
          const float uv[16] = {lo16(u0.x), hi16(u0.x), lo16(u0.y), hi16(u0.y), lo16(u0.z), hi16(u0.z), lo16(u0.w), hi16(u0.w),
                                lo16(u1.x), hi16(u1.x), lo16(u1.y), hi16(u1.y), lo16(u1.z), hi16(u1.z), lo16(u1.w), hi16(u1.w)};
          float bur = 0.f, bui = 0.f;
#pragma unroll
          for (int c = 0; c < 16; ++c) { bur += bbr[c] * uv[c]; bui += bbi[c] * uv[c]; }
          const float nxr = lre * xr - lim * xi + bur, nxi = lre * xi + lim * xr + bui;
          xr = nxr; xi = nxi;
          asm volatile("s_waitcnt lgkmcnt(0)" ::: "memory");
          xs[lane] = xr; xs[64 + lane] = xi;
          asm volatile("s_waitcnt lgkmcnt(0)" ::: "memory");
          float part = 0.f;
#pragma unroll
          for (int q = 0; q < 16; ++q) part += ccr[q] * xs[quart * 16 + q] - cci[q] * xs[64 + quart * 16 + q];
          asm volatile("s_waitcnt lgkmcnt(0)" ::: "memory");
          part += __shfl_xor(part, 16); part += __shfl_xor(part, 32);
          if (lane < 16) {
            if (dir == 0) ylds[n * 16 + cidx] = dsk * h2f(up[cidx]) + part;
            else ygelu[(size_t)t * 512 + g * 16 + cidx] = f2h(gelu_tanh(ylds[n * 16 + cidx] + part));
          }
        }
      }
    }
  }
}

struct Cpx { float re, im; };
__device__ __forceinline__ Cpx cmul(Cpx a, Cpx b) { return {a.re * b.re - a.im * b.im, a.re * b.im + a.im * b.re}; }
__device__ __forceinline__ Cpx s5_lam_pow(float ar, float ai, float dt, float e) {
  const float mag = expf(ar * dt * e); float sn, cs; sincosf(ai * dt * e, &sn, &cs); return {mag * cs, mag * sn};
}
__device__ __forceinline__ Cpx s5_coef(float ar, float ai, float dt) {
  float sn, cs; sincosf(ai * dt, &sn, &cs);
  const float em1 = expm1f(ar * dt), sh = sinf(0.5f * ai * dt);
  const float nr = em1 * cs - 2.0f * sh * sh, ni = (em1 + 1.0f) * sn, den = ar * ar + ai * ai;
  return {(nr * ar + ni * ai) / den, (ni * ar - nr * ai) / den};
}
__device__ __forceinline__ void phase_s5_ktab(const P& p) {
  float* ktab = (float*)(p.ws + WS_KTAB);
  const int gtid = blockIdx.x * NTHR + threadIdx.x, gsz = gridDim.x * NTHR;
  for (int item = gtid; item < 32 * 2 * 32 * 16; item += gsz) {
    const int c = item & 15, l = (item >> 4) & 31, dir = (item >> 9) & 1, g = item >> 10;
    const float dt = expf(p.log_step[dir * 32 + g]);
    float acc[16];
#pragma unroll
    for (int j = 0; j < 16; ++j) acc[j] = 0.f;
    for (int q = 0; q < 64; ++q) {
      const float ar = p.a_re[(dir * 32 + g) * 64 + q], ai = p.a_im[(dir * 32 + g) * 64 + q];
      const Cpx L = s5_lam_pow(ar, ai, dt, (float)l), cf = s5_coef(ar, ai, dt);
      const Cpx C = {p.c_re[((dir * 32 + g) * 16 + c) * 64 + q], p.c_im[((dir * 32 + g) * 16 + c) * 64 + q]};
      const Cpx w = cmul(cmul(C, L), cf);
#pragma unroll
      for (int j = 0; j < 16; ++j) acc[j] += w.re * p.b_re[(g * 64 + q) * 16 + j] - w.im * p.b_im[(g * 64 + q) * 16 + j];
    }
#pragma unroll
    for (int j = 0; j < 16; j += 4) *(f32x4*)(ktab + (size_t)item * 16 + j) = (f32x4){acc[j], acc[j + 1], acc[j + 2], acc[j + 3]};
  }
}
__device__ __forceinline__ void phase_s5_fill(const P& p) {
  const float* ktab = (const float*)(p.ws + WS_KTAB);
  u16* bty = (u16*)(p.ws + WS_BTY); u16* wet = (u16*)(p.ws + WS_WET);
  const int gtid = blockIdx.x * NTHR + threadIdx.x, gsz = gridDim.x * NTHR;
  for (int item = gtid; item < 32 * 512 * 64; item += gsz) {
    const int ch = item & 63, n = (item >> 6) & 511, g = item >> 15;
    const int ip = ch >> 1, c0 = (ch & 1) * 8, i = n >> 4, c = n & 15;
    float v[8];
    if (ip != i) {
      const int dir = ip < i ? 0 : 1, l = ip < i ? i - ip : ip - i;
      const float* src = ktab + ((size_t)((g * 2 + dir) * 32 + l) * 16 + c) * 16 + c0;
      const f32x4 a = *(const f32x4*)src, b = *(const f32x4*)(src + 4);
      v[0] = a[0]; v[1] = a[1]; v[2] = a[2]; v[3] = a[3]; v[4] = b[0]; v[5] = b[1]; v[6] = b[2]; v[7] = b[3];
    } else {
      const float* s0 = ktab + ((size_t)((g * 2 + 0) * 32) * 16 + c) * 16 + c0;
      const float* s1 = ktab + ((size_t)((g * 2 + 1) * 32) * 16 + c) * 16 + c0;
      const float dd = p.s5d[g * 16 + c];
#pragma unroll
      for (int j = 0; j < 8; ++j) v[j] = s0[j] + s1[j] + ((c0 + j) == c ? dd : 0.f);
    }
    *(uint4*)(bty + ((size_t)g * 512 + n) * 768 + ch * 8) = make_uint4(pk2(v[0], v[1]), pk2(v[2], v[3]), pk2(v[4], v[5]), pk2(v[6], v[7]));
  }
  for (int item = gtid; item < 32 * 512 * 32; item += gsz) {
    const int ch = item & 31, n = (item >> 5) & 511, g = item >> 14;
    const int kk = ch * 8, dir = kk >> 7, p0 = (kk & 127) >> 1, i = n >> 4, c = n & 15;
    const float dt = expf(p.log_step[dir * 32 + g]), e = dir ? (float)(32 - i) : (float)(i + 1);
    float v[8];
#pragma unroll
    for (int q = 0; q < 4; ++q) {
      const int pq = p0 + q;
      const float ar = p.a_re[(dir * 32 + g) * 64 + pq], ai = p.a_im[(dir * 32 + g) * 64 + pq];
      const Cpx L = s5_lam_pow(ar, ai, dt, e);
      const Cpx C = {p.c_re[((dir * 32 + g) * 16 + c) * 64 + pq], p.c_im[((dir * 32 + g) * 16 + c) * 64 + pq]};
      const Cpx w = cmul(C, L);
      v[2 * q] = w.re; v[2 * q + 1] = -w.im;
    }
    *(uint4*)(bty + ((size_t)g * 512 + n) * 768 + 512 + kk) = make_uint4(pk2(v[0], v[1]), pk2(v[2], v[3]), pk2(v[4], v[5]), pk2(v[6], v[7]));
  }
  for (int item = gtid; item < 32 * 256 * 64; item += gsz) {
    const int ch = item & 63, n = (item >> 6) & 255, g = item >> 14;
    const int ip = ch >> 1, c0 = (ch & 1) * 8, ri = n & 1, pq = (n >> 1) & 63, dir = n >> 7;
    const float dt = expf(p.log_step[dir * 32 + g]), e = dir ? (float)ip : (float)(31 - ip);
    const float ar = p.a_re[(dir * 32 + g) * 64 + pq], ai = p.a_im[(dir * 32 + g) * 64 + pq];
    const Cpx w = cmul(s5_lam_pow(ar, ai, dt, e), s5_coef(ar, ai, dt));
    float v[8];
#pragma unroll
    for (int j = 0; j < 8; ++j) {
      const float br = p.b_re[(g * 64 + pq) * 16 + c0 + j], bi = p.b_im[(g * 64 + pq) * 16 + c0 + j];
      v[j] = ri ? (w.re * bi + w.im * br) : (w.re * br - w.im * bi);
    }
    *(uint4*)(wet + ((size_t)g * 256 + n) * 512 + ch * 8) = make_uint4(pk2(v[0], v[1]), pk2(v[2], v[3]), pk2(v[4], v[5]), pk2(v[6], v[7]));
  }
}
__device__ __forceinline__ void phase_s5_egemm(const P& p, char* smem) {
  float* E = (float*)(p.ws + WS_E);
  for (int t = blockIdx.x; t < 32 * 8; t += gridDim.x) {
    const int g = t >> 3, mt = (t >> 1) & 3, nt = t & 1;
    GemmDesc d{}; d.A = (const u16*)(p.ws + WS_A2) + (size_t)g * 512 * 768; d.lda = 768; d.mvalid = 512;
    d.Bt = (const u16*)(p.ws + WS_WET) + (size_t)g * 256 * 512; d.ldb = 512; d.K = 512;
    gemm_tile(d, mt * 128, nt * 128, [&](f32x4 (&acc)[4][4], int row0, int col0) {
#pragma unroll
      for (int m = 0; m < 4; ++m)
#pragma unroll
        for (int n = 0; n < 4; ++n) *(f32x4*)(E + ((size_t)g * 512 + row0 + m * 16) * 256 + col0 + n * 16) = acc[m][n];
    }, smem);
  }
}
__device__ __forceinline__ void phase_s5_carry(const P& p) {
  const float* E = (const float*)(p.ws + WS_E);
  u16* a2 = (u16*)(p.ws + WS_A2);
  const int gtid = blockIdx.x * NTHR + threadIdx.x, gsz = gridDim.x * NTHR;
  for (int idx = gtid; idx < 32 * 8 * 128; idx += gsz) {
    const int pq = idx & 63, dir = (idx >> 6) & 1, b = (idx >> 7) & 7, g = idx >> 10;
    const float dt = expf(p.log_step[dir * 32 + g]);
    const Cpx L = s5_lam_pow(p.a_re[(dir * 32 + g) * 64 + pq], p.a_im[(dir * 32 + g) * 64 + pq], dt, 32.0f);
    Cpx s = {0.f, 0.f};
    for (int jj = 0; jj < 64; ++jj) {
      const int j = dir ? 63 - jj : jj, r = b * 64 + j;
      const f32x2 e = *(const f32x2*)(E + ((size_t)g * 512 + r) * 256 + (dir * 64 + pq) * 2);
      *(unsigned*)(a2 + ((size_t)g * 512 + r) * 768 + 512 + (dir * 64 + pq) * 2) = pk2(s.re, s.im);
      const Cpx ns = cmul(L, s);
      s.re = ns.re + e[0]; s.im = ns.im + e[1];
    }
  }
}
__device__ __forceinline__ void phase_s5_ygemm(const P& p, char* smem) {
  u16* ygelu = (u16*)(p.ws + WS_YGELU);
  for (int t = blockIdx.x; t < 32 * 16; t += gridDim.x) {
    const int g = t >> 4, mt = (t >> 2) & 3, nt = t & 3;
    GemmDesc d{}; d.A = (const u16*)(p.ws + WS_A2) + (size_t)g * 512 * 768; d.lda = 768; d.mvalid = 512;
    d.Bt = (const u16*)(p.ws + WS_BTY) + (size_t)g * 512 * 768; d.ldb = 768; d.K = 768;
    gemm_tile(d, mt * 128, nt * 128, [&](f32x4 (&acc)[4][4], int row0, int col0) {
#pragma unroll
      for (int m = 0; m < 4; ++m)
#pragma unroll
        for (int n = 0; n < 4; ++n) {
          const int row = row0 + m * 16, col = col0 + n * 16;
          uint2 w; w.x = pk2(gelu_tanh(acc[m][n][0]), gelu_tanh(acc[m][n][1])); w.y = pk2(gelu_tanh(acc[m][n][2]), gelu_tanh(acc[m][n][3]));
          *(uint2*)(ygelu + ((size_t)row * 32 + (col >> 4)) * 512 + g * 16 + (col & 15)) = w;
        }
    }, smem);
  }
}

__device__ __forceinline__ void phase_glu(const P& p, char* smem) {
  const u16* yg = (const u16*)(p.ws + WS_YGELU); u16* ycat = (u16*)(p.ws + WS_YCAT);
  GemmDesc g{}; g.A = yg; g.lda = 512; g.mvalid = T_TOK; g.W = p.w_glu; g.ldw = 512; g.K = 512;
  for (int t = blockIdx.x; t < 128 * 4; t += gridDim.x) {
    const int mt = t >> 2, nt = t & 3;
    gemm_tile(g, mt * 128, nt * 128, [&](f32x4 (&acc)[4][4], int row0, int col0) {
#pragma unroll
      for (int m = 0; m < 4; ++m)
#pragma unroll
        for (int n = 0; n < 4; ++n) {
          const int row = row0 + m * 16, col = col0 + n * 16;
          const uint2 yv = *(const uint2*)(yg + (size_t)row * 512 + col);
          const f32x4 bb = *(const f32x4*)(p.b_glu + col);
          const float y0 = lo16(yv.x) * sigmoidf_(acc[m][n][0] + bb[0]), y1 = hi16(yv.x) * sigmoidf_(acc[m][n][1] + bb[1]);
          const float y2 = lo16(yv.y) * sigmoidf_(acc[m][n][2] + bb[2]), y3 = hi16(yv.y) * sigmoidf_(acc[m][n][3] + bb[3]);
          uint2 w; w.x = pk2(y0, y1); w.y = pk2(y2, y3);
          *(uint2*)(ycat + (size_t)row * DM + 512 + col) = w;
        }
    }, smem);
  }
}

__device__ __forceinline__ void phase_outproj(const P& p, const u16* A, const float* W, const float* xin, float* xout, char* smem) {
  GemmDesc g{}; g.A = A; g.lda = DM; g.mvalid = T_TOK; g.W = W; g.ldw = DM; g.K = DM;
  for (int t = blockIdx.x; t < 128 * 8; t += gridDim.x) {
    const int mt = t >> 3, nt = t & 7;
    gemm_tile(g, mt * 128, nt * 128, [&](f32x4 (&acc)[4][4], int row0, int col0) {
#pragma unroll
      for (int m = 0; m < 4; ++m)
#pragma unroll
        for (int n = 0; n < 4; ++n) {
          const size_t o = (size_t)(row0 + m * 16) * DM + col0 + n * 16;
          const f32x4 xv = *(const f32x4*)(xin + o);
          *(f32x4*)(xout + o) = xv + acc[m][n];
        }
    }, smem);
  }
}

__device__ __forceinline__ void phase_qkv(const P& p, char* smem) {
  GemmDesc g{}; g.A = (const u16*)(p.ws + WS_XB); g.lda = DM; g.mvalid = T_TOK; g.W = p.w_qkv; g.ldw = 1536; g.K = DM;
  u16* q1 = (u16*)(p.ws + WS_Z); u16* k1 = (u16*)(p.ws + WS_Z + 32 * MB); u16* v1 = (u16*)(p.ws + WS_Z + 40 * MB);
  for (int t = blockIdx.x; t < 128 * 12; t += gridDim.x) {
    const int mt = t / 12, nt = t % 12;
    gemm_tile(g, mt * 128, nt * 128, [&](f32x4 (&acc)[4][4], int row0, int col0) {
#pragma unroll
      for (int m = 0; m < 4; ++m)
#pragma unroll
        for (int n = 0; n < 4; ++n) {
          const int row = row0 + m * 16, col = col0 + n * 16;
          uint2 w;
          if (nt < 8) { w.x = pk2(acc[m][n][0] * 0.125f, acc[m][n][1] * 0.125f); w.y = pk2(acc[m][n][2] * 0.125f, acc[m][n][3] * 0.125f); *(uint2*)(q1 + (size_t)row * DM + col) = w; }
          else {
            w.x = pk2(acc[m][n][0], acc[m][n][1]); w.y = pk2(acc[m][n][2], acc[m][n][3]);
            if (nt < 10) *(uint2*)(k1 + (size_t)row * 256 + (col - 1024)) = w; else *(uint2*)(v1 + (size_t)row * 256 + (col - 1280)) = w;
          }
        }
    }, smem);
  }
}

struct MoeTile { int e, rt, ct, cnt, hbase; };
__device__ __forceinline__ bool moe_decode(const int* cnt, int t, MoeTile& mt) {
  int base = 0, hb = 0;
  for (int e = 0; e < 32; ++e) {
    const int c = cnt[e], nt = (c + 127) >> 7, span = nt * 8;
    if (t < base + span) { const int loc = t - base; mt.e = e; mt.rt = loc % nt; mt.ct = loc / nt; mt.cnt = c; mt.hbase = hb; return true; }
    base += span; hb += nt * 128;
  }
  return false;
}
__device__ __forceinline__ void phase_moe1(const P& p, int layer, char* smem) {
  const int* cnt = (const int*)(p.ws + WS_CNT) + layer * 32;
  const int* list = (const int*)(p.ws + WS_LIST);
  u16* hbuf = (u16*)(p.ws + WS_H);
  for (int t = blockIdx.x;; t += gridDim.x) {
    MoeTile mt; if (!moe_decode(cnt, t, mt)) break;
    GemmDesc g{}; g.A = (const u16*)(p.ws + WS_XB); g.lda = DM; g.rowmap = list + (size_t)mt.e * CAP; g.rowshift = 1; g.mvalid = mt.cnt;
    g.W = p.w_gate + (size_t)(layer * 32 + mt.e) * DM * 512; g.W2 = p.w_up + (size_t)(layer * 32 + mt.e) * DM * 512; g.ldw = 512; g.K = DM;
    gemm_tile(g, mt.rt * 128, mt.ct * 128, [&](f32x4 (&acc)[4][4], int row0, int col0) {
      const int ocol0 = (col0 >> 6) * 32 + (col0 & 31);
#pragma unroll
      for (int m = 0; m < 4; ++m) {
        const int row = row0 + m * 16;
        if (row < mt.cnt) {
#pragma unroll
          for (int nn = 0; nn < 2; ++nn) {
            float hv[4];
#pragma unroll
            for (int r = 0; r < 4; ++r) { const float gt = acc[m][nn][r]; hv[r] = gt * sigmoidf_(gt) * acc[m][nn + 2][r]; }
            uint2 w; w.x = pk2(hv[0], hv[1]); w.y = pk2(hv[2], hv[3]);
            *(uint2*)(hbuf + (size_t)(mt.hbase + row) * 512 + ocol0 + nn * 16) = w;
          }
        }
      }
    }, smem);
  }
}
__device__ __forceinline__ void phase_moe2(const P& p, int layer, char* smem) {
  const int* cnt = (const int*)(p.ws + WS_CNT) + layer * 32;
  const int* list = (const int*)(p.ws + WS_LIST);
  const float* gate = (const float*)(p.ws + WS_GATE);
  const u16* hbuf = (const u16*)(p.ws + WS_H);
  u16* slots = (u16*)(p.ws + WS_INC);
  for (int t = blockIdx.x;; t += gridDim.x) {
    MoeTile mt; if (!moe_decode(cnt, t, mt)) break;
    GemmDesc g{}; g.A = hbuf + (size_t)mt.hbase * 512; g.lda = 512; g.mvalid = mt.cnt;
    g.W = p.w_down + (size_t)(layer * 32 + mt.e) * 512 * DM; g.ldw = DM; g.K = 512;
    gemm_tile(g, mt.rt * 128, mt.ct * 128, [&](f32x4 (&acc)[4][4], int row0, int col0) {
#pragma unroll
      for (int m = 0; m < 4; ++m) {
        const int row = row0 + m * 16;
        if (row < mt.cnt) {
          const int asg = list[(size_t)mt.e * CAP + row];
          const float gt = gate[asg];
#pragma unroll
          for (int n = 0; n < 4; ++n) {
            uint2 w; w.x = pk2(gt * acc[m][n][0], gt * acc[m][n][1]); w.y = pk2(gt * acc[m][n][2], gt * acc[m][n][3]);
            *(uint2*)(slots + (size_t)asg * DM + col0 + n * 16) = w;
          }
        }
      }
    }, smem);
  }
}

constexpr int KSTR = 72;
__device__ __forceinline__ int t5_bucket_abs(int n) {
  return n < 8 ? n : 8 + (n >= 12) + (n >= 16) + (n >= 23) + (n >= 32) + (n >= 46) + (n >= 64) + (n >= 91);
}
__device__ __forceinline__ void phase_attn_naive(const P& p, char* smem) {
  u16* sK = (u16*)smem; u16* sV = sK + 384 * KSTR; float* sBias = (float*)(sV + 384 * KSTR);
  const u16* q1 = (const u16*)(p.ws + WS_Z); const u16* k1 = (const u16*)(p.ws + WS_Z + 32 * MB); const u16* v1 = (const u16*)(p.ws + WS_Z + 40 * MB);
  u16* ao = (u16*)(p.ws + WS_YCAT);
  const int tid = threadIdx.x;
  for (int item = blockIdx.x; item < 512; item += gridDim.x) {
    const int b = item >> 6, nb = (item >> 2) & 15, kvh = item & 3;
    __syncthreads();
    for (int c = tid; c < 384 * 8; c += NTHR) {
      const int s = c >> 3, ch = (c & 7) * 8, pos = (nb - 1) * 128 + s;
      uint4 kq = make_uint4(0u, 0u, 0u, 0u), vq = kq;
      if (pos >= 0 && pos < SEQ) { kq = *(const uint4*)(k1 + (size_t)(b * SEQ + pos) * 256 + kvh * 64 + ch); vq = *(const uint4*)(v1 + (size_t)(b * SEQ + pos) * 256 + kvh * 64 + ch); }
      *(uint4*)(sK + s * KSTR + ch) = kq; *(uint4*)(sV + s * KSTR + ch) = vq;
    }
    for (int c = tid; c < 4 * 257; c += NTHR) {
      const int hq = c / 257, ri = c % 257, rel = ri - 128, n = rel < 0 ? -rel : rel;
      const int bucket = (rel > 0 ? 16 : 0) + t5_bucket_abs(n);
      sBias[hq * 260 + ri] = p.rel_bias[bucket * 16 + kvh * 4 + hq];
    }
    __syncthreads();
    for (int pass = 0; pass < 2; ++pass) {
      const int hq = pass * 2 + (tid >> 7), qi = tid & 127, head = kvh * 4 + hq;
      const size_t tok = (size_t)b * SEQ + nb * 128 + qi;
      float q[64];
#pragma unroll
      for (int d = 0; d < 64; d += 8) {
        const uint4 qq = *(const uint4*)(q1 + tok * DM + head * 64 + d);
        q[d] = lo16(qq.x); q[d + 1] = hi16(qq.x); q[d + 2] = lo16(qq.y); q[d + 3] = hi16(qq.y); q[d + 4] = lo16(qq.z); q[d + 5] = hi16(qq.z); q[d + 6] = lo16(qq.w); q[d + 7] = hi16(qq.w);
      }
      float mx = p.sink[head], l = 1.0f, o[64];
#pragma unroll
      for (int d = 0; d < 64; ++d) o[d] = 0.f;
      for (int r = 0; r <= 256; ++r) {
        const int s = qi + r, pos = (nb - 1) * 128 + s;
        if (pos < 0 || pos >= SEQ) continue;
        float sc = 0.f;
#pragma unroll
        for (int d = 0; d < 64; d += 8) {
          const uint4 kq = *(const uint4*)(sK + s * KSTR + d);
          sc += q[d] * lo16(kq.x) + q[d + 1] * hi16(kq.x) + q[d + 2] * lo16(kq.y) + q[d + 3] * hi16(kq.y) + q[d + 4] * lo16(kq.z) + q[d + 5] * hi16(kq.z) + q[d + 6] * lo16(kq.w) + q[d + 7] * hi16(kq.w);
        }
        sc += sBias[hq * 260 + r];
        const float mn = fmaxf(mx, sc), alpha = __expf(mx - mn), pe = __expf(sc - mn);
        l = l * alpha + pe; mx = mn;
#pragma unroll
        for (int d = 0; d < 64; d += 8) {
          const uint4 vq = *(const uint4*)(sV + s * KSTR + d);
          o[d] = o[d] * alpha + pe * lo16(vq.x); o[d + 1] = o[d + 1] * alpha + pe * hi16(vq.x); o[d + 2] = o[d + 2] * alpha + pe * lo16(vq.y); o[d + 3] = o[d + 3] * alpha + pe * hi16(vq.y);
          o[d + 4] = o[d + 4] * alpha + pe * lo16(vq.z); o[d + 5] = o[d + 5] * alpha + pe * hi16(vq.z); o[d + 6] = o[d + 6] * alpha + pe * lo16(vq.w); o[d + 7] = o[d + 7] * alpha + pe * hi16(vq.w);
        }
      }
      const float inv = 1.0f / l;
#pragma unroll
      for (int d = 0; d < 64; d += 8) {
        uint4 w; w.x = pk2(o[d] * inv, o[d + 1] * inv); w.y = pk2(o[d + 2] * inv, o[d + 3] * inv); w.z = pk2(o[d + 4] * inv, o[d + 5] * inv); w.w = pk2(o[d + 6] * inv, o[d + 7] * inv);
        *(uint4*)(ao + tok * DM + head * 64 + d) = w;
      }
    }
  }
}

constexpr int VSTR = 392;
__device__ __forceinline__ void phase_attn(const P& p, char* smem) {
  u16* sK = (u16*)smem; u16* sVt = sK + 384 * KSTR; float* sBias = (float*)(sVt + 64 * VSTR);
  const u16* q1 = (const u16*)(p.ws + WS_Z); const u16* k1 = (const u16*)(p.ws + WS_Z + 32 * MB); const u16* v1 = (const u16*)(p.ws + WS_Z + 40 * MB);
  u16* ao = (u16*)(p.ws + WS_YCAT);
  const int tid = threadIdx.x, lane = tid & 63, wv = tid >> 6, fr = lane & 15, lg = lane >> 4, q0 = wv * 32;
  for (int item = blockIdx.x; item < 512; item += gridDim.x) {
    const int b = item >> 6, nb = (item >> 2) & 15, kvh = item & 3;
    __syncthreads();
    for (int c = tid; c < 384 * 8; c += NTHR) {
      const int s = c >> 3, ch = (c & 7) * 8, pos = (nb - 1) * 128 + s;
      uint4 kq = make_uint4(0u, 0u, 0u, 0u), vq = kq;
      if (pos >= 0 && pos < SEQ) { kq = *(const uint4*)(k1 + (size_t)(b * SEQ + pos) * 256 + kvh * 64 + ch); vq = *(const uint4*)(v1 + (size_t)(b * SEQ + pos) * 256 + kvh * 64 + ch); }
      *(uint4*)(sK + s * KSTR + ch) = kq;
      const unsigned vw[4] = {vq.x, vq.y, vq.z, vq.w};
#pragma unroll
      for (int j = 0; j < 4; ++j) { sVt[(ch + 2 * j) * VSTR + s] = (u16)(vw[j] & 0xffffu); sVt[(ch + 2 * j + 1) * VSTR + s] = (u16)(vw[j] >> 16); }
    }
    for (int c = tid; c < 4 * 257; c += NTHR) {
      const int hq = c / 257, ri = c % 257, rel = ri - 128, n = rel < 0 ? -rel : rel;
      const int bucket = (rel > 0 ? 16 : 0) + t5_bucket_abs(n);
      sBias[hq * 260 + ri] = p.rel_bias[bucket * 16 + kvh * 4 + hq];
    }
    __syncthreads();
    for (int hq = 0; hq < 4; ++hq) {
      const int head = kvh * 4 + hq;
      const size_t tok0 = (size_t)b * SEQ + nb * 128 + q0;
      uint4 qf[2][2];
#pragma unroll
      for (int qb = 0; qb < 2; ++qb)
#pragma unroll
        for (int ks = 0; ks < 2; ++ks) qf[qb][ks] = *(const uint4*)(q1 + (tok0 + qb * 16 + fr) * DM + head * 64 + ks * 32 + lg * 8);
      f32x4 O[4][2];
#pragma unroll
      for (int mb = 0; mb < 4; ++mb)
#pragma unroll
        for (int qb = 0; qb < 2; ++qb) O[mb][qb] = (f32x4){0.f, 0.f, 0.f, 0.f};
      const float sinkv = p.sink[head];
      float mrun[2] = {sinkv, sinkv}, lpart[2] = {lg == 0 ? 1.0f : 0.0f, lg == 0 ? 1.0f : 0.0f};
#pragma unroll
      for (int c = 0; c < 3; ++c) {
        if ((c == 0 && nb == 0) || (c == 2 && nb == 15)) continue;
        f32x4 S[8][2];
#pragma unroll
        for (int kb = 0; kb < 8; ++kb) {
          S[kb][0] = (f32x4){0.f, 0.f, 0.f, 0.f}; S[kb][1] = S[kb][0];
          const bool act = (c == 0) ? (16 * kb + 15 >= q0) : ((c == 2) ? (16 * kb <= q0 + 31) : true);
          if (act) {
#pragma unroll
            for (int ks = 0; ks < 2; ++ks) {
              const uint4 kf = *(const uint4*)(sK + (c * 128 + kb * 16 + fr) * KSTR + ks * 32 + lg * 8);
              S[kb][0] = mfma16(kf, qf[0][ks], S[kb][0]);
              S[kb][1] = mfma16(kf, qf[1][ks], S[kb][1]);
            }
          }
        }
        float cmax[2] = {-1e30f, -1e30f};
#pragma unroll
        for (int kb = 0; kb < 8; ++kb)
#pragma unroll
          for (int qb = 0; qb < 2; ++qb)
#pragma unroll
            for (int r = 0; r < 4; ++r) {
              const int sidx = c * 128 + kb * 16 + 4 * lg + r, qi = q0 + qb * 16 + fr, rel = sidx - 128 - qi;
              const bool valid = (rel >= -128) && (rel <= 128);
              const float v = valid ? S[kb][qb][r] + sBias[hq * 260 + (valid ? rel + 128 : 0)] : -1e30f;
              S[kb][qb][r] = v; cmax[qb] = fmaxf(cmax[qb], v);
            }
#pragma unroll
        for (int qb = 0; qb < 2; ++qb) {
          cmax[qb] = fmaxf(cmax[qb], __shfl_xor(cmax[qb], 16)); cmax[qb] = fmaxf(cmax[qb], __shfl_xor(cmax[qb], 32));
          const float mn = fmaxf(mrun[qb], cmax[qb]), alpha = __expf(mrun[qb] - mn);
          mrun[qb] = mn; lpart[qb] *= alpha;
#pragma unroll
          for (int mb = 0; mb < 4; ++mb) O[mb][qb] = O[mb][qb] * alpha;
          float ps = 0.f;
#pragma unroll
          for (int kb = 0; kb < 8; ++kb)
#pragma unroll
            for (int r = 0; r < 4; ++r) { const float e = __expf(S[kb][qb][r] - mn); S[kb][qb][r] = e; ps += e; }
          lpart[qb] += ps;
        }
#pragma unroll
        for (int kk = 0; kk < 4; ++kk) {
          const int kb0 = 2 * kk, kb1 = 2 * kk + 1;
          const bool act = (c == 0) ? (16 * kb1 + 15 >= q0) : ((c == 2) ? (16 * kb0 <= q0 + 31) : true);
          if (act) {
            uint4 pf[2];
#pragma unroll
            for (int qb = 0; qb < 2; ++qb) pf[qb] = make_uint4(pk2(S[kb0][qb][0], S[kb0][qb][1]), pk2(S[kb0][qb][2], S[kb0][qb][3]), pk2(S[kb1][qb][0], S[kb1][qb][1]), pk2(S[kb1][qb][2], S[kb1][qb][3]));
#pragma unroll
            for (int mb = 0; mb < 4; ++mb) {
              const uint2 v0 = *(const uint2*)(sVt + (mb * 16 + fr) * VSTR + c * 128 + kb0 * 16 + 4 * lg);
              const uint2 v1r = *(const uint2*)(sVt + (mb * 16 + fr) * VSTR + c * 128 + kb1 * 16 + 4 * lg);
              const uint4 vf = make_uint4(v0.x, v0.y, v1r.x, v1r.y);
              O[mb][0] = mfma16(vf, pf[0], O[mb][0]);
              O[mb][1] = mfma16(vf, pf[1], O[mb][1]);
            }
          }
        }
      }
#pragma unroll
      for (int qb = 0; qb < 2; ++qb) {
        float lt = lpart[qb]; lt += __shfl_xor(lt, 16); lt += __shfl_xor(lt, 32);
        const float inv = 1.0f / lt;
#pragma unroll
        for (int mb = 0; mb < 4; ++mb) {
          uint2 w; w.x = pk2(O[mb][qb][0] * inv, O[mb][qb][1] * inv); w.y = pk2(O[mb][qb][2] * inv, O[mb][qb][3] * inv);
          *(uint2*)(ao + (tok0 + qb * 16 + fr) * DM + head * 64 + mb * 16 + 4 * lg) = w;
        }
      }
    }
  }
}

#define XB_TMO      128
#define XB_XCNT(j)  (256  + 64 * (j))
#define XB_XSUB(j)  (1280 + 64 * (j))
#define XB_XGEN(j)  (2304 + 64 * (j))
#define XB_TOP      3328
#define XB_TOPGEN   3392
#define XCD_BAR_WORDS 3456
#define XB_SPIN_CAP (1u << 22)
#define LAS __attribute__((address_space(3)))
__device__ __forceinline__ unsigned xb_ld(unsigned* p)              { return __hip_atomic_load(p, __ATOMIC_RELAXED, __HIP_MEMORY_SCOPE_AGENT); }
__device__ __forceinline__ unsigned xb_add(unsigned* p, unsigned v) { return __hip_atomic_fetch_add(p, v, __ATOMIC_RELAXED, __HIP_MEMORY_SCOPE_AGENT); }
__device__ __forceinline__ unsigned xb_xcc_id() { return (unsigned)__builtin_amdgcn_s_getreg((3 << 11) | 20) & 0xFu; }
#define XB_SPIN(cond, bar) do { unsigned _sp = 0; while (cond) { __builtin_amdgcn_s_sleep(1); \
    if ((++_sp & 255u) == 0u) { if (xb_ld(&(bar)[XB_TMO])) break; if (_sp > XB_SPIN_CAP) { atomicAdd(&(bar)[XB_TMO], 1u); break; } } } } while (0)
struct XcdBarrier { unsigned* bar; unsigned x; volatile LAS unsigned* st; };
__device__ __forceinline__ XcdBarrier xcd_barrier_post(unsigned* bar, volatile LAS unsigned* st) {
  XcdBarrier b; b.bar = bar; b.x = xb_xcc_id(); b.st = st;
  if (threadIdx.x == 0) (void)xb_add(&bar[XB_XCNT(b.x)], 1u);
  return b;
}
__device__ __forceinline__ void xcd_barrier_complete(unsigned* bar, unsigned x, unsigned& nloc, unsigned& nx) {
  const unsigned G = gridDim.x * gridDim.y * gridDim.z;
  unsigned sum, cnt, mine, sp = 0u;
  for (;;) {
    sum = 0u; cnt = 0u; mine = 0u;
#pragma unroll
    for (unsigned j = 0; j < 16; ++j) { const unsigned c = xb_ld(&bar[XB_XCNT(j)]); sum += c; cnt += (c > 0u) ? 1u : 0u; mine = (j == x) ? c : mine; }
    if (sum == G) break;
    __builtin_amdgcn_s_sleep(1);
    if ((++sp & 255u) == 0u) { if (xb_ld(&bar[XB_TMO])) break; if (sp > XB_SPIN_CAP) { atomicAdd(&bar[XB_TMO], 1u); break; } }
  }
  nloc = mine > 0u ? mine : 1u; nx = cnt > 0u ? cnt : 1u;
}
__device__ __forceinline__ void xcd_barrier(const XcdBarrier& b) {
  asm volatile("s_waitcnt vmcnt(0)" ::: "memory");
  __syncthreads();
  if (threadIdx.x == 0) {
    unsigned* bar = b.bar;
    __builtin_amdgcn_s_waitcnt(0);
    unsigned nloc = b.st[0], nx = b.st[1];
    if (nloc == 0u) { xcd_barrier_complete(bar, b.x, nloc, nx); b.st[0] = nloc; b.st[1] = nx; }
    const unsigned old = xb_add(&bar[XB_XSUB(b.x)], 1u);
    const unsigned gen = old / nloc;
    if (old + 1u == (gen + 1u) * nloc) {
      __builtin_amdgcn_fence(__ATOMIC_RELEASE, "agent");
      asm volatile("s_waitcnt vmcnt(0)" ::: "memory");
      const unsigned og = xb_add(&bar[XB_TOP], 1u);
      const unsigned tg = og / nx;
      if (og + 1u == (tg + 1u) * nx) xb_add(&bar[XB_TOPGEN], 1u);
      else XB_SPIN(xb_ld(&bar[XB_TOPGEN]) == tg, bar);
      __builtin_amdgcn_fence(__ATOMIC_ACQUIRE, "agent");
      xb_add(&bar[XB_XGEN(b.x)], 1u);
      asm volatile("s_waitcnt vmcnt(0)" ::: "memory");
    } else {
      XB_SPIN(xb_ld(&bar[XB_XGEN(b.x)]) == gen, bar);
      __builtin_amdgcn_fence(__ATOMIC_ACQUIRE, "agent");
      asm volatile("s_waitcnt vmcnt(0)" ::: "memory");
    }
  }
  __syncthreads();
}

constexpr int NPHASE = 20;
constexpr int LDS_BYTES = 141312 + 16;
__device__ __forceinline__ void run_phase(const P& p, int ph, char* smem) {
  float* xa = (float*)(p.ws + WS_XA);
  const u16* ycat = (const u16*)(p.ws + WS_YCAT);
  const u16* slots = (const u16*)(p.ws + WS_INC);
  switch (ph) {
    case 0: phase_prep(p); phase_s5_ktab(p); break;
    case 1: phase_rowpass(p, p.x, nullptr, nullptr, p.norm_mix_g, -1, nullptr, smem); phase_s5_fill(p); break;
    case 2: phase_inproj(p, smem); break;
    case 3: phase_ret_inc_mfma(p, smem); phase_s5_egemm(p, smem); break;
    case 4: phase_ret_scan16(p); phase_s5_carry(p); break;
    case 5: phase_ret_out_mfma(p, smem); phase_s5_ygemm(p, smem); break;
    case 6: break;
    case 7: phase_glu(p, smem); break;
    case 8: phase_outproj(p, ycat, p.w_out, p.x, xa, smem); break;
    case 9: phase_rowpass(p, xa, nullptr, nullptr, p.norm_ffn_g, 0, nullptr, smem); break;
    case 10: phase_moe1(p, 0, smem); break;
    case 11: phase_moe2(p, 0, smem); break;
    case 12: phase_rowpass(p, xa, slots, xa, p.norm_mix_g + DM, -1, nullptr, smem); break;
    case 13: phase_qkv(p, smem); break;
    case 14: phase_attn(p, smem); break;
    case 15: phase_outproj(p, ycat, p.w_o, xa, xa, smem); break;
    case 16: phase_rowpass(p, xa, nullptr, nullptr, p.norm_ffn_g + DM, 1, nullptr, smem); break;
    case 17: phase_moe1(p, 1, smem); break;
    case 18: phase_moe2(p, 1, smem); break;
    case 19: phase_rowpass(p, xa, slots, nullptr, p.norm_final_g, -1, p.out, smem); break;
    default: break;
  }
}

extern __shared__ __attribute__((aligned(16))) char dyn_smem[];

#if MULTI_LAUNCH
__global__ void __launch_bounds__(NTHR) k_phase(P p, int ph) { run_phase(p, ph, dyn_smem); }
#else

template <int PH> __device__ __forceinline__ void mega_steps(const P& p, char* smem, cg::grid_group& grid, const XcdBarrier& xb) {
  run_phase(p, PH, smem);
  if constexpr (PH + 1 < NPHASE) {
    if constexpr (PH == 0) grid.sync(); else xcd_barrier(xb);
    mega_steps<PH + 1>(p, smem, grid, xb);
  }
}
__global__ void __launch_bounds__(NTHR) k_mega(P p) {
  cg::grid_group grid = cg::this_grid();
  volatile LAS unsigned* st = (volatile LAS unsigned*)(dyn_smem + LDS_BYTES - 16);
  if (threadIdx.x == 0) { st[0] = 0u; st[1] = 0u; }
  __syncthreads();
  const XcdBarrier xb = xcd_barrier_post((unsigned*)(p.ws + WS_BAR), st);
  mega_steps<0>(p, dyn_smem, grid, xb);
}
#endif

extern "C" void kernel_launch(void* const* d_in, const int* in_sizes, int n_in, void* d_out, int out_size, void* d_ws, size_t ws_size, hipStream_t stream) {
  static int grid_blocks = 0;
  if (grid_blocks == 0) {
    if (n_in != 28 || out_size != T_TOK * DM || ws_size < WS_END) { fprintf(stderr, "kernel_launch: unexpected problem (n_in %d out %d ws %zu need %zu)\n", n_in, out_size, ws_size, (size_t)WS_END); grid_blocks = -1; return; }
    int dev = 0, cus = 0, per_cu = 0;
    (void)hipGetDevice(&dev);
    (void)hipDeviceGetAttribute(&cus, hipDeviceAttributeMultiprocessorCount, dev);
#if MULTI_LAUNCH
    const void* fn = (const void*)k_phase;
#else
    const void* fn = (const void*)k_mega;
#endif
    if (hipFuncSetAttribute(fn, hipFuncAttributeMaxDynamicSharedMemorySize, LDS_BYTES) != hipSuccess) { fprintf(stderr, "kernel_launch: hipFuncSetAttribute failed\n"); }
    if (hipOccupancyMaxActiveBlocksPerMultiprocessor(&per_cu, fn, NTHR, LDS_BYTES) != hipSuccess || per_cu < 1) { fprintf(stderr, "kernel_launch: occupancy query failed (%d)\n", per_cu); per_cu = 1; }
    (void)hipGetLastError();
    grid_blocks = cus * per_cu;
    fprintf(stderr, "kernel_launch: cus %d per_cu %d grid %d\n", cus, per_cu, grid_blocks);
  }
  if (grid_blocks < 0) return;
  P p{};
  const float** pp = (const float**)&p;
  for (int i = 0; i < 28; ++i) pp[i] = (const float*)d_in[i];
  p.out = (float*)d_out; p.ws = (char*)d_ws;
#if MULTI_LAUNCH
  for (int ph = 0; ph < NPHASE; ++ph) hipLaunchKernelGGL(k_phase, dim3(grid_blocks), dim3(NTHR), LDS_BYTES, stream, p, ph);
#else
  (void)hipMemsetAsync((char*)d_ws + WS_BAR, 0, XCD_BAR_WORDS * 4, stream);
  void* args[] = {&p};
  hipError_t e = hipLaunchCooperativeKernel((const void*)k_mega, dim3(grid_blocks), dim3(NTHR), args, LDS_BYTES, stream);
  if (e != hipSuccess) fprintf(stderr, "cooperative launch failed: %s (grid %d)\n", hipGetErrorString(e), grid_blocks);
#endif
}
```

```cpp
#include <hip/hip_runtime.h>
#include <hip/hip_cooperative_groups.h>
#include <cstdio>
#include <cstdint>
namespace cg = cooperative_groups;

#define USE_FP16 1
#define LAS __attribute__((address_space(3)))

typedef unsigned short u16;
typedef float f32x4 __attribute__((ext_vector_type(4)));
typedef float f32x2 __attribute__((ext_vector_type(2)));
typedef _Float16 f16x8 __attribute__((ext_vector_type(8)));

constexpr int T_TOK = 16384, DM = 1024, SEQ = 2048, NBATCH = 8;
constexpr int CAP = 32768;
constexpr int NTHR = 512, NWAVE = NTHR / 64;

constexpr size_t MB = 1024ull * 1024ull;
constexpr size_t WS_XA    = 0;
constexpr size_t WS_XB    = 64 * MB;
constexpr size_t WS_Z     = 96 * MB;
constexpr size_t WS_A2    = 160 * MB;
constexpr size_t WS_BTY   = 184 * MB;
constexpr size_t WS_MW    = WS_Z;
constexpr size_t WS_WET   = 208 * MB;
constexpr size_t WS_E     = 216 * MB;
constexpr size_t WS_KTAB  = 232 * MB;
constexpr size_t WS_SP16  = 234 * MB;
constexpr size_t WS_INC   = 266 * MB;
constexpr size_t WS_YCAT  = 330 * MB;
constexpr size_t WS_YGELU = 362 * MB;
constexpr size_t WS_H     = 378 * MB;
constexpr size_t WS_LIST  = 418 * MB;
constexpr size_t WS_GATE  = 422 * MB;
constexpr size_t WS_ROPE  = 423 * MB;
constexpr size_t WS_CNT   = 424 * MB;
constexpr size_t WS_WR16  = 425 * MB;
constexpr size_t WS_BAR   = 426 * MB;
constexpr size_t WS_WIN   = 427 * MB;
constexpr size_t WS_WGLU  = 432 * MB;
constexpr size_t WS_WOUT  = 433 * MB;
constexpr size_t WS_WQKV  = 435 * MB;
constexpr size_t WS_WO    = 438 * MB;
constexpr size_t WS_END   = 440 * MB;

struct P {
  const float *x, *norm_mix_g, *norm_ffn_g, *norm_final_g, *w_in, *ret_decay, *a_re, *a_im, *log_step, *b_re, *b_im, *c_re, *c_im,
      *s5d, *w_glu, *b_glu, *w_out, *w_qkv, *sink, *w_o, *rel_bias, *w_group, *b_group, *w_er, *b_er, *w_gate, *w_up, *w_down;
  float* out;
  char* ws;
};

__device__ __forceinline__ u16 f2h(float f) { _Float16 h = (_Float16)f; return __builtin_bit_cast(u16, h); }
__device__ __forceinline__ float h2f(u16 h) { return (float)__builtin_bit_cast(_Float16, h); }
__device__ __forceinline__ unsigned pk2(float a, float b) { return (unsigned)f2h(a) | ((unsigned)f2h(b) << 16); }
__device__ __forceinline__ float lo16(unsigned w) { return h2f((u16)(w & 0xffffu)); }
__device__ __forceinline__ float hi16(unsigned w) { return h2f((u16)(w >> 16)); }
__device__ __forceinline__ f32x4 mfma16(uint4 a, uint4 b, f32x4 c) {
  return __builtin_amdgcn_mfma_f32_16x16x32_f16(__builtin_bit_cast(f16x8, a), __builtin_bit_cast(f16x8, b), c, 0, 0, 0);
}
__device__ __forceinline__ float wave_sum(float v) {
#pragma unroll
  for (int o = 1; o < 64; o <<= 1) v += __shfl_xor(v, o);
  return v;
}
__device__ __forceinline__ float sigmoidf_(float x) { return 1.0f / (1.0f + __expf(-x)); }
__device__ __forceinline__ float gelu_tanh(float x) {
  const float u = 0.7978845608028654f * (x + 0.044715f * x * x * x);
  return 0.5f * x * (1.0f + tanhf(u));
}
#define LDS_WAIT() asm volatile("s_waitcnt lgkmcnt(0)" ::: "memory")
__device__ __forceinline__ int tidx() { int t = threadIdx.x; asm volatile("" : "+v"(t)); return t; }

namespace pg8 {
constexpr int BM = 256, BK = 64, HALF = 128, HTB = HALF * BK * 2, STAGE_BYTES = 8 * HTB, NXCD = 8, WGM = 8;
__device__ __forceinline__ int lds_byte(int r, int c) { const int st = (r >> 4) * 2 + (c >> 5), rr = r & 15, cc = c & 31, ob = rr * 64 + cc * 2; return st * 1024 + (ob ^ (((ob >> 9) & 1) << 5)); }
__device__ __forceinline__ void stage_rc(int b, int& R, int& C) { const int st = b / 1024, sb = b % 1024, swz = sb ^ (((sb >> 9) & 1) << 5); R = (st >> 1) * 16 + swz / 64; C = (st & 1) * 32 + (swz % 64) / 2; }

struct Unit { const char* a; const char* b; int pm, pn, e, cnt, hbase; };

template <class Epi, class Sched, bool ALIGN_EPI, bool SP2>
__device__ __forceinline__ void gemm_phase(LAS unsigned char* lds, const int K, const Sched& S, const Epi& E) {
    const int tid = tidx(), wid = __builtin_amdgcn_readfirstlane(tid >> 6), lane = tid & 63, wr = wid >> 2, wc = wid & 3, fr = lane & 15, fq = lane >> 4;
    const int nt = K / BK;
    int Rr[2], Cc[2];
    unsigned voffB[2];
#pragma unroll
    for (int i = 0; i < 2; ++i) { stage_rc(tid * 16 + i * 8192, Rr[i], Cc[i]); voffB[i] = (unsigned)(Rr[i] * K + Cc[i]) * 2u; }
    const size_t kstep = (size_t)(BK * 2);
    const size_t hstepB = (size_t)HALF * K * 2;
    const unsigned ldsw = (unsigned)wid * 1024u;
    const int aoff = lds_byte(wr * 64 + fr, fq * 8), boff = lds_byte(wc * 32 + fr, fq * 8);
#define PG8_SA(b, h) (((b) * 2 + (h)) * HTB)
#define PG8_SB(b, h) ((4 + (b) * 2 + (h)) * HTB)
#define PG8_STAGE(bufoff, gbase, voff) do { _Pragma("unroll") for (int _i = 0; _i < 2; ++_i) \
        __builtin_amdgcn_global_load_lds((const unsigned*)((const char*)(gbase) + (voff)[_i]), (LAS unsigned*)(lds + (bufoff) + ldsw + _i * 8192), 16, 0, 0); } while (0)
#define PG8_LDA(dst, b, h) do { _Pragma("unroll") for (int m = 0; m < 4; ++m) _Pragma("unroll") for (int k = 0; k < 2; ++k) dst[m][k] = *(const LAS f16x8*)(lds + PG8_SA(b, h) + aoff + m * 2048 + k * 1024); } while (0)
#define PG8_LDB(dst, b, h) do { _Pragma("unroll") for (int n = 0; n < 2; ++n) _Pragma("unroll") for (int k = 0; k < 2; ++k) dst[n][k] = *(const LAS f16x8*)(lds + PG8_SB(b, h) + boff + n * 2048 + k * 1024); } while (0)
#define PG8_MMA(ai, bj, At, Bt) do { __builtin_amdgcn_s_setprio(1); _Pragma("unroll") for (int m = 0; m < 4; ++m) _Pragma("unroll") for (int n = 0; n < 2; ++n) _Pragma("unroll") for (int k = 0; k < 2; ++k) \
        acc[ai][bj][m][n] = __builtin_amdgcn_mfma_f32_16x16x32_f16(Bt[n][k], At[m][k], acc[ai][bj][m][n], 0, 0, 0); __builtin_amdgcn_s_setprio(0); } while (0)
#define PG8_WAIT_V(n) asm volatile("s_waitcnt vmcnt(" #n ")" ::: "memory")
#define PG8_WAIT_L(n) asm volatile("s_waitcnt lgkmcnt(" #n ")" ::: "memory")
#define PG8_BAR __builtin_amdgcn_s_barrier()
#define PG8_SCHED __builtin_amdgcn_sched_barrier(0)
    Unit cur, nxt; int ui = 0;
    if (!S.next(0, cur)) return;
    unsigned cv0[2], cv1[2], nv0[2], nv1[2];
#pragma unroll
    for (int i = 0; i < 2; ++i) { cv0[i] = S.a_voff(cur, 0, Rr[i], Cc[i]); cv1[i] = S.a_voff(cur, 1, Rr[i], Cc[i]); }
    f32x4 acc[2][2][4][2];
#pragma unroll
    for (int a = 0; a < 2; ++a)
#pragma unroll
        for (int b = 0; b < 2; ++b)
#pragma unroll
            for (int m = 0; m < 4; ++m)
#pragma unroll
                for (int n = 0; n < 2; ++n) acc[a][b][m][n] = (f32x4){0.f, 0.f, 0.f, 0.f};
    f16x8 At[4][2], B0[2][2], B1[2][2];
    const char* cA = cur.a; const char* cB = cur.b;
    if constexpr (SP2) {
        PG8_STAGE(PG8_SB(0, 0), cB, voffB); PG8_STAGE(PG8_SB(0, 1), cB + hstepB, voffB); PG8_STAGE(PG8_SA(0, 0), cA, cv0); PG8_STAGE(PG8_SA(0, 1), cA, cv1);
        if (wr == 1) PG8_BAR;
        PG8_WAIT_V(2); PG8_BAR;
        PG8_STAGE(PG8_SB(1, 0), cB + kstep, voffB); PG8_STAGE(PG8_SA(1, 0), cA + kstep, cv0); PG8_STAGE(PG8_SB(1, 1), cB + hstepB + kstep, voffB);
        PG8_WAIT_V(6); PG8_BAR;
    } else {
        PG8_STAGE(PG8_SB(0, 0), cB, voffB); PG8_STAGE(PG8_SA(0, 0), cA, cv0); PG8_STAGE(PG8_SB(0, 1), cB + hstepB, voffB); PG8_STAGE(PG8_SA(0, 1), cA, cv1);
        if (wr == 1) PG8_BAR;
        PG8_WAIT_V(4); PG8_BAR;
        PG8_STAGE(PG8_SB(1, 0), cB + kstep, voffB); PG8_STAGE(PG8_SA(1, 0), cA + kstep, cv0); PG8_STAGE(PG8_SB(1, 1), cB + hstepB + kstep, voffB);
        PG8_WAIT_V(6); PG8_BAR;
    }
    for (;;) {
        const bool has_next = S.next(ui + 1, nxt);
        if (has_next) {
#pragma unroll
            for (int i = 0; i < 2; ++i) { nv0[i] = S.a_voff(nxt, 0, Rr[i], Cc[i]); nv1[i] = S.a_voff(nxt, 1, Rr[i], Cc[i]); }
        } else {
            nxt = cur;
#pragma unroll
            for (int i = 0; i < 2; ++i) { nv0[i] = cv0[i]; nv1[i] = cv1[i]; }
        }
        const char* nA = nxt.a; const char* nB = nxt.b;
        for (int t = 0; t < nt; t += 2) {
            const bool last = (t == nt - 2);
            const char* a1 = cA + (size_t)(t + 1) * kstep;
            const char* a2 = last ? nA : cA + (size_t)(t + 2) * kstep; const char* b2 = last ? nB : cB + (size_t)(t + 2) * kstep;
            const char* a3 = a2 + kstep; const char* b3 = b2 + kstep;
            unsigned v0[2], v1[2];
#pragma unroll
            for (int i = 0; i < 2; ++i) { v0[i] = last ? nv0[i] : cv0[i]; v1[i] = last ? nv1[i] : cv1[i]; }
            if constexpr (SP2) {
            PG8_LDB(B0, 0, 0); PG8_LDB(B1, 0, 1); PG8_SCHED; PG8_LDA(At, 0, 0); PG8_STAGE(PG8_SA(1, 1), a1, cv1);
            PG8_WAIT_V(8); PG8_WAIT_L(0); PG8_BAR; PG8_MMA(0, 0, At, B0); PG8_MMA(0, 1, At, B1); PG8_BAR; PG8_SCHED;
            PG8_LDA(At, 0, 1); PG8_STAGE(PG8_SB(0, 0), b2, voffB); PG8_STAGE(PG8_SB(0, 1), b2 + hstepB, voffB); PG8_STAGE(PG8_SA(0, 0), a2, v0);
            PG8_WAIT_V(8); PG8_WAIT_L(0); PG8_BAR; PG8_MMA(1, 0, At, B0); PG8_MMA(1, 1, At, B1); PG8_BAR; PG8_SCHED;
            PG8_LDB(B0, 1, 0); PG8_LDB(B1, 1, 1); PG8_SCHED; PG8_LDA(At, 1, 0); PG8_STAGE(PG8_SA(0, 1), a2, v1);
            PG8_WAIT_V(8); PG8_WAIT_L(0); PG8_BAR; PG8_MMA(0, 0, At, B0); PG8_MMA(0, 1, At, B1); PG8_BAR; PG8_SCHED;
            PG8_LDA(At, 1, 1); PG8_STAGE(PG8_SB(1, 0), b3, voffB); PG8_STAGE(PG8_SB(1, 1), b3 + hstepB, voffB); PG8_STAGE(PG8_SA(1, 0), a3, v0);
            PG8_WAIT_V(8); PG8_WAIT_L(0); PG8_BAR; PG8_MMA(1, 0, At, B0); PG8_MMA(1, 1, At, B1); PG8_BAR; PG8_SCHED;
            } else {
            PG8_LDB(B0, 0, 0); PG8_SCHED; PG8_LDA(At, 0, 0); PG8_STAGE(PG8_SA(1, 1), a1, cv1);
            PG8_WAIT_L(8); PG8_BAR; PG8_WAIT_L(0); PG8_MMA(0, 0, At, B0); PG8_BAR; PG8_SCHED;
            PG8_LDB(B1, 0, 1); PG8_STAGE(PG8_SB(0, 0), b2, voffB);
            PG8_BAR; PG8_WAIT_L(0); PG8_MMA(0, 1, At, B1); PG8_BAR;
            PG8_LDA(At, 0, 1); PG8_STAGE(PG8_SA(0, 0), a2, v0);
            PG8_BAR; PG8_WAIT_L(0); PG8_MMA(1, 0, At, B0); PG8_BAR; PG8_SCHED;
            PG8_STAGE(PG8_SB(0, 1), b2 + hstepB, voffB);
            PG8_WAIT_V(6); PG8_BAR; PG8_MMA(1, 1, At, B1); PG8_BAR;
            PG8_LDB(B0, 1, 0); PG8_SCHED; PG8_LDA(At, 1, 0); PG8_STAGE(PG8_SA(0, 1), a2, v1);
            PG8_WAIT_L(8); PG8_BAR; PG8_WAIT_L(0); PG8_MMA(0, 0, At, B0); PG8_BAR; PG8_SCHED;
            PG8_LDB(B1, 1, 1); PG8_STAGE(PG8_SB(1, 0), b3, voffB);
            PG8_BAR; PG8_WAIT_L(0); PG8_MMA(0, 1, At, B1); PG8_BAR;
            PG8_LDA(At, 1, 1); PG8_STAGE(PG8_SA(1, 0), a3, v0);
            PG8_BAR; PG8_WAIT_L(0); PG8_MMA(1, 0, At, B0); PG8_BAR; PG8_SCHED;
            PG8_STAGE(PG8_SB(1, 1), b3 + hstepB, voffB);
            PG8_WAIT_V(6); PG8_BAR; PG8_MMA(1, 1, At, B1); PG8_BAR;
            }
        }
        if constexpr (ALIGN_EPI) { if (wr == 0) PG8_BAR; }
        E(acc, cur, wr, wc, fr, fq);
        if (!has_next) break;
#pragma unroll
        for (int a = 0; a < 2; ++a)
#pragma unroll
            for (int b = 0; b < 2; ++b)
#pragma unroll
                for (int m = 0; m < 4; ++m)
#pragma unroll
                    for (int n = 0; n < 2; ++n) acc[a][b][m][n] = (f32x4){0.f, 0.f, 0.f, 0.f};
        cur = nxt; cA = nA; cB = nB; ++ui;
#pragma unroll
        for (int i = 0; i < 2; ++i) { cv0[i] = nv0[i]; cv1[i] = nv1[i]; }
        if constexpr (ALIGN_EPI) { if (wr == 1) PG8_BAR; }
    }
    PG8_WAIT_V(0);
    if constexpr (!ALIGN_EPI) { if (wr == 0) PG8_BAR; }
    PG8_BAR;
#undef PG8_SA
#undef PG8_SB
#undef PG8_STAGE
#undef PG8_LDA
#undef PG8_LDB
#undef PG8_MMA
#undef PG8_WAIT_V
#undef PG8_WAIT_L
#undef PG8_BAR
#undef PG8_SCHED
}

struct DenseOrder {
    const char* A; const char* Bt; int lda_b, K, nM, nN, nwg, G, c;
    __device__ __forceinline__ void init(const void* A_, int lda_elems, const void* Bt_, int M, int N, int K_) { A = (const char*)A_; Bt = (const char*)Bt_; lda_b = lda_elems * 2; K = K_; nM = M / BM; nN = N / BM; nwg = nM * nN; G = gridDim.x; c = blockIdx.x; }
    __device__ __forceinline__ bool next(int i, Unit& u) const {
        const long L = (long)i * G + c; if (L >= nwg) return false;
        int wgid = (int)L; { const int q = nwg / NXCD, r = nwg % NXCD, xcd = wgid % NXCD, off = wgid / NXCD; wgid = (xcd < r ? xcd * (q + 1) : r * (q + 1) + (xcd - r) * q) + off; }
        const int nig = WGM * nN, gid = wgid / nig, fm = gid * WGM, gsz = (nM - fm) < WGM ? (nM - fm) : WGM;
        u.pm = fm + ((wgid % nig) % gsz); u.pn = (wgid % nig) / gsz; u.e = 0; u.cnt = 0; u.hbase = 0;
        u.a = A + (size_t)u.pm * BM * lda_b; u.b = Bt + (size_t)u.pn * BM * K * 2;
        return true;
    }
    __device__ __forceinline__ unsigned a_voff(const Unit&, int h, int R, int C) const { return (unsigned)((h * HALF + R) * lda_b + C * 2); }
};
struct GroupOrder {
    const char* A; const char* Bt; int lda_b, K, nM, nN, ng, G, c; size_t gsA, gsB;
    __device__ __forceinline__ void init(const void* A_, int lda_elems, size_t gsA_elems, const void* Bt_, size_t gsB_elems, int ng_, int M, int N, int K_) {
        A = (const char*)A_; Bt = (const char*)Bt_; lda_b = lda_elems * 2; K = K_; nM = M / BM; nN = N / BM; ng = ng_; gsA = gsA_elems * 2; gsB = gsB_elems * 2; G = gridDim.x; c = blockIdx.x; }
    __device__ __forceinline__ bool next(int i, Unit& u) const {
        const long L = (long)i * G + c; if (L >= (long)ng * nM * nN) return false;
        const int per = nM * nN, g = (int)L / per, r = (int)L % per;
        u.e = g; u.pm = r / nN; u.pn = r % nN; u.cnt = 0; u.hbase = 0;
        u.a = A + (size_t)g * gsA + (size_t)u.pm * BM * lda_b; u.b = Bt + (size_t)g * gsB + (size_t)u.pn * BM * K * 2;
        return true;
    }
    __device__ __forceinline__ unsigned a_voff(const Unit&, int h, int R, int C) const { return (unsigned)((h * HALF + R) * lda_b + C * 2); }
};
struct MoeOrder {
    const int* cnt; const int* list; const char* A; const char* Bt; int lda_b, K, nN, G, c; size_t esB; bool gather;
    __device__ __forceinline__ void init(const int* cnt_, const int* list_, const void* A_, int lda_elems, const void* Bt_, size_t esB_elems, int N, int K_, bool gather_) {
        cnt = cnt_; list = list_; A = (const char*)A_; Bt = (const char*)Bt_; lda_b = lda_elems * 2; K = K_; nN = N / BM; esB = esB_elems * 2; gather = gather_; G = gridDim.x; c = blockIdx.x; }
    __device__ __forceinline__ bool next(int i, Unit& u) const {
        int nwg = 0;
        for (int e = 0; e < 32; ++e) nwg += ((cnt[e] + BM - 1) / BM) * nN;
        const long L = (long)i * G + c; if (L >= nwg) return false;
        int wgid = (int)L; { const int q = nwg / NXCD, r = nwg % NXCD, xcd = wgid % NXCD, off = wgid / NXCD; wgid = (xcd < r ? xcd * (q + 1) : r * (q + 1) + (xcd - r) * q) + off; }
        int base = 0, hb = 0;
        for (int e = 0; e < 32; ++e) {
            const int ce = cnt[e], ntl = (ce + BM - 1) / BM, span = ntl * nN;
            if (wgid < base + span) {
                const int loc = wgid - base;
                u.e = e; u.pm = loc % ntl; u.pn = loc / ntl; u.cnt = ce; u.hbase = hb;
                u.a = gather ? A : A + (size_t)(hb + u.pm * BM) * lda_b;
                u.b = Bt + (size_t)e * esB + (size_t)u.pn * BM * K * 2;
                return true;
            }
            base += span; hb += ntl * BM;
        }
        return false;
    }
    __device__ __forceinline__ unsigned a_voff(const Unit& u, int h, int R, int C) const {
        if (!gather) return (unsigned)((h * HALF + R) * lda_b + C * 2);
        const int li = u.pm * BM + h * HALF + R;
        const int tok = (li < u.cnt) ? (list[(size_t)u.e * CAP + li] >> 1) : 0;
        return (unsigned)(tok * lda_b + C * 2);
    }
};
}
constexpr bool G_ALIGN = true, G_SP2 = true;

__device__ __forceinline__ void phase_prep(const P& p) {
  const int gtid = blockIdx.x * NTHR + tidx(), gsz = gridDim.x * NTHR;
  int* cnt = (int*)(p.ws + WS_CNT);
  if (gtid < 64) cnt[gtid] = 0;
  f32x2* rope = (f32x2*)(p.ws + WS_ROPE);
  for (int i = gtid; i < SEQ * 64; i += gsz) {
    const int pos = i >> 6, f = i & 63;
    const float inv = powf(10000.0f, -(float)(2 * f) / 128.0f);
    const float ang = (float)pos * inv;
    float s, c; sincosf(ang, &s, &c);
    rope[i] = (f32x2){c, s};
  }
  u16* wr16 = (u16*)(p.ws + WS_WR16);
  for (int i = gtid; i < 2 * 48 * DM; i += gsz) {
    const int k = i & (DM - 1), n = (i >> 10) % 48, layer = i / (48 * DM);
    float w = 0.f;
    if (n < 4) w = p.w_group[((size_t)layer * DM + k) * 4 + n];
    else if (n < 36) { const int gg = (n - 4) >> 3, j = (n - 4) & 7; w = p.w_er[(((size_t)layer * 4 + gg) * DM + k) * 8 + j]; }
    w *= p.norm_ffn_g[layer * DM + k];
    const u16 hi = f2h(w), lo = f2h(w - h2f(hi));
    wr16[((size_t)(layer * 2 + 0) * 48 + n) * DM + k] = hi;
    wr16[((size_t)(layer * 2 + 1) * 48 + n) * DM + k] = lo;
  }
}

template <class RowFn>
__device__ __forceinline__ void conv_item(const float* W, int ldw, int K, u16* WT, float* scr, int k0, int n0, int lane, RowFn rowfn) {
#pragma unroll 8
  for (int i = 0; i < 32; ++i) { const int kk = 2 * i + (lane >> 5); scr[kk * 33 + (lane & 31)] = W[(size_t)(k0 + kk) * ldw + n0 + (lane & 31)]; }
  LDS_WAIT();
  const int c = lane & 7;
#pragma unroll
  for (int j = 0; j < 4; ++j) {
    const int n = (lane >> 3) + 8 * j; const float* sp = scr + (8 * c) * 33 + n;
    uint4 o; o.x = pk2(sp[0 * 33], sp[1 * 33]); o.y = pk2(sp[2 * 33], sp[3 * 33]); o.z = pk2(sp[4 * 33], sp[5 * 33]); o.w = pk2(sp[6 * 33], sp[7 * 33]);
    *(uint4*)(WT + (size_t)rowfn(n0 + n) * K + k0 + 8 * c) = o;
  }
  LDS_WAIT();
}
template <class RowFn>
__device__ __forceinline__ int conv_matrix(const float* W, int ldw, int K, int N, u16* WT, char* smem, int item_base, RowFn rowfn) {
  const int lane = tidx() & 63, wv = tidx() >> 6, gw = blockIdx.x * NWAVE + wv, nw = gridDim.x * NWAVE;
  float* scr = (float*)smem + wv * (64 * 33);
  const int nkb = K / 64, nnb = N / 32, nitems = nkb * nnb;
  int it = gw - (item_base % nw); if (it < 0) it += nw;
  for (; it < nitems; it += nw) conv_item(W, ldw, K, WT, scr, (it / nnb) * 64, (it % nnb) * 32, lane, rowfn);
  return nitems;
}
__device__ __forceinline__ void phase_conv_dense(const P& p, char* smem) {
  auto id = [](int n) { return n; };
  int base = 0;
  base += conv_matrix(p.w_in, 2560, DM, 2560, (u16*)(p.ws + WS_WIN), smem, base, id);
  base += conv_matrix(p.w_glu, 512, 512, 512, (u16*)(p.ws + WS_WGLU), smem, base, id);
  base += conv_matrix(p.w_out, DM, DM, DM, (u16*)(p.ws + WS_WOUT), smem, base, id);
  base += conv_matrix(p.w_qkv, 1536, DM, 1536, (u16*)(p.ws + WS_WQKV), smem, base, id);
  base += conv_matrix(p.w_o, DM, DM, DM, (u16*)(p.ws + WS_WO), smem, base, id);
}
__device__ __forceinline__ void phase_conv_moe(const P& p, int layer, char* smem) {
  const int lane = tidx() & 63, wv = tidx() >> 6, gw = blockIdx.x * NWAVE + wv, nw = gridDim.x * NWAVE;
  float* scr = (float*)smem + wv * (64 * 33);
  u16* w1t = (u16*)(p.ws + WS_MW); u16* w2t = (u16*)(p.ws + WS_MW + 64 * MB);
  for (int it = gw; it < 32 * 768; it += nw) {
    const int e = it / 768, r = it % 768;
    if (r < 512) {
      const int which = r >> 8, q = r & 255, k0 = (q >> 4) * 64, n0 = (q & 15) * 32;
      const float* W = (which ? p.w_up : p.w_gate) + (size_t)(layer * 32 + e) * DM * 512;
      conv_item(W, 512, DM, w1t + (size_t)e * DM * DM, scr, k0, n0, lane, [which](int n) { return (n >> 4) * 32 + which * 16 + (n & 15); });
    } else {
      const int q = r - 512, k0 = (q >> 5) * 64, n0 = (q & 31) * 32;
      const float* W = p.w_down + (size_t)(layer * 32 + e) * 512 * DM;
      conv_item(W, DM, 512, w2t + (size_t)e * DM * 512, scr, k0, n0, lane, [](int n) { return n; });
    }
  }
}

__device__ __forceinline__ void phase_rowpass(const P& p, const float* src, const u16* slots, float* dstx, const float* gain, int route_layer, float* fout, char* smem) {
  const int lane = tidx() & 63, wv = tidx() >> 6, gw = blockIdx.x * NWAVE + wv, nw = gridDim.x * NWAVE, fr = lane & 15, lg = lane >> 4;
  u16* xb = (u16*)(p.ws + WS_XB);
  int* cnt = (int*)(p.ws + WS_CNT);
  int* list = (int*)(p.ws + WS_LIST);
  float* gate = (float*)(p.ws + WS_GATE);
  float* sRs = (float*)smem + wv * 16;
  float* sLg = (float*)smem + NWAVE * 16 + wv * 16 * 49;
  for (int tile = gw; tile < T_TOK / 16; tile += nw) {
    for (int rr = 0; rr < 16; ++rr) {
      const int row = tile * 16 + rr;
      f32x4 v[4];
      float ss = 0.f;
#pragma unroll
      for (int i = 0; i < 4; ++i) {
        const int k = (i * 64 + lane) * 4;
        v[i] = *(const f32x4*)(src + (size_t)row * DM + k);
        if (slots) {
#pragma unroll
          for (int sl = 0; sl < 2; ++sl) {
            const uint2 w = *(const uint2*)(slots + ((size_t)row * 2 + sl) * DM + k);
            v[i][0] += lo16(w.x); v[i][1] += hi16(w.x); v[i][2] += lo16(w.y); v[i][3] += hi16(w.y);
          }
        }
        if (dstx) *(f32x4*)(dstx + (size_t)row * DM + k) = v[i];
        ss += v[i][0] * v[i][0] + v[i][1] * v[i][1] + v[i][2] * v[i][2] + v[i][3] * v[i][3];
      }
      ss = wave_sum(ss);
      const float rstd = rsqrtf(ss * (1.0f / DM) + 1e-6f);
      if (route_layer >= 0 && lane == 0) sRs[rr] = rstd;
#pragma unroll
      for (int i = 0; i < 4; ++i) {
        const int k = (i * 64 + lane) * 4;
        const f32x4 gv = *(const f32x4*)(gain + k);
        v[i] = v[i] * rstd * gv;
        if (fout) *(f32x4*)(fout + (size_t)row * DM + k) = v[i];
        else { uint2 w; w.x = pk2(v[i][0], v[i][1]); w.y = pk2(v[i][2], v[i][3]); *(uint2*)(xb + (size_t)row * DM + k) = w; }
      }
    }
    if (route_layer >= 0) {
      asm volatile("s_waitcnt lgkmcnt(0)" ::: "memory");
      const float rsv = sRs[fr];
      const float* xrow = src + (size_t)(tile * 16 + fr) * DM + lg * 8;
      const u16* whi = (const u16*)(p.ws + WS_WR16) + ((size_t)(route_layer * 2 + 0) * 48 + fr) * DM + lg * 8;
      const u16* wlo = (const u16*)(p.ws + WS_WR16) + ((size_t)(route_layer * 2 + 1) * 48 + fr) * DM + lg * 8;
      f32x4 acc[3];
#pragma unroll
      for (int nb = 0; nb < 3; ++nb) acc[nb] = (f32x4){0.f, 0.f, 0.f, 0.f};
      for (int ks = 0; ks < 32; ++ks) {
        const f32x4 x0 = *(const f32x4*)(xrow + ks * 32), x1 = *(const f32x4*)(xrow + ks * 32 + 4);
        const float hv[8] = {x0[0] * rsv, x0[1] * rsv, x0[2] * rsv, x0[3] * rsv, x1[0] * rsv, x1[1] * rsv, x1[2] * rsv, x1[3] * rsv};
        unsigned ah[4], al[4];
#pragma unroll
        for (int j = 0; j < 4; ++j) {
          const u16 h0 = f2h(hv[2 * j]), h1 = f2h(hv[2 * j + 1]);
          ah[j] = (unsigned)h0 | ((unsigned)h1 << 16);
          al[j] = pk2(hv[2 * j] - h2f(h0), hv[2 * j + 1] - h2f(h1));
        }
        const uint4 ahi = make_uint4(ah[0], ah[1], ah[2], ah[3]), alo = make_uint4(al[0], al[1], al[2], al[3]);
#pragma unroll
        for (int nb = 0; nb < 3; ++nb) {
          const uint4 bh = *(const uint4*)(whi + (size_t)nb * 16 * DM + ks * 32), bl = *(const uint4*)(wlo + (size_t)nb * 16 * DM + ks * 32);
          acc[nb] = mfma16(bh, ahi, acc[nb]); acc[nb] = mfma16(bh, alo, acc[nb]); acc[nb] = mfma16(bl, ahi, acc[nb]);
        }
      }
#pragma unroll
      for (int nb = 0; nb < 3; ++nb)
#pragma unroll
        for (int r = 0; r < 4; ++r) sLg[fr * 49 + nb * 16 + 4 * lg + r] = acc[nb][r];
      asm volatile("s_waitcnt lgkmcnt(0)" ::: "memory");
      if (lane < 16) {
        const int row = tile * 16 + lane;
        const float* lgt = sLg + lane * 49;
        const float* bg = p.b_group + route_layer * 4;
        const float* be = p.b_er + route_layer * 32;
        float gl[4];
#pragma unroll
        for (int j = 0; j < 4; ++j) gl[j] = lgt[j] + bg[j];
        int gs = 0; float gm = gl[0];
#pragma unroll
        for (int j = 1; j < 4; ++j) if (gl[j] > gm) { gm = gl[j]; gs = j; }
        float den = 0.f;
#pragma unroll
        for (int j = 0; j < 4; ++j) den += expf(gl[j] - gm);
        const float pg = 1.0f / den;
        float el[8];
#pragma unroll
        for (int j = 0; j < 8; ++j) el[j] = lgt[4 + gs * 8 + j] + be[gs * 8 + j];
        int i1 = 0; float v1 = el[0];
#pragma unroll
        for (int j = 1; j < 8; ++j) if (el[j] > v1) { v1 = el[j]; i1 = j; }
        int i2 = -1; float v2 = -3.0e38f;
#pragma unroll
        for (int j = 0; j < 8; ++j) if (j != i1 && el[j] > v2) { v2 = el[j]; i2 = j; }
        const float e2 = expf(v2 - v1);
        const float g1 = pg / (1.0f + e2), g2 = pg * e2 / (1.0f + e2);
        const int ex1 = gs * 8 + i1, ex2 = gs * 8 + i2;
        const int r1 = atomicAdd(&cnt[route_layer * 32 + ex1], 1);
        list[(size_t)ex1 * CAP + r1] = row * 2;
        gate[row * 2] = g1;
        const int r2 = atomicAdd(&cnt[route_layer * 32 + ex2], 1);
        list[(size_t)ex2 * CAP + r2] = row * 2 + 1;
        gate[row * 2 + 1] = g2;
      }
    }
  }
}

constexpr int RSTR = 136;
__device__ __forceinline__ void ret_load_tile(u16* dst, const u16* src, int t0, int h, int mode  , const f32x2* rope) {
  const int pos0 = t0 & (SEQ - 1);
  for (int idx = tidx(); idx < 128 * 64; idx += NTHR) {
    const int i = idx >> 6, d = idx & 63;
    float t1 = h2f(src[(size_t)(t0 + i) * 512 + h * 128 + d]), t2 = h2f(src[(size_t)(t0 + i) * 512 + h * 128 + d + 64]);
    if (mode) {
      const f32x2 cs = rope[(pos0 + i) * 64 + d];
      const float o1 = t1 * cs[0] - t2 * cs[1], o2 = t1 * cs[1] + t2 * cs[0];
      t1 = o1; t2 = o2;
      if (mode == 2) { t1 *= 0.08838834764831845f; t2 *= 0.08838834764831845f; }
    }
    dst[i * RSTR + d] = f2h(t1); dst[i * RSTR + d + 64] = f2h(t2);
  }
}
__device__ __forceinline__ float log_sigmoid(float x) { return -log1pf(expf(-x)); }

template <int MB_, int NB_>
__device__ __forceinline__ void lds_mma(f32x4 (&acc)[MB_][NB_], const u16* sA, int sa, int a0, const u16* sB, int sb, int b0, int K, int lane, const float* sc) {
  const int fr = lane & 15, fq = lane >> 4;
  for (int k0 = 0; k0 < K; k0 += 32) {
    uint4 fa[MB_], fb[NB_];
#pragma unroll
    for (int m = 0; m < MB_; ++m) {
      fa[m] = *(const uint4*)(sA + (a0 + m * 16 + fr) * sa + k0 + fq * 8);
      if (sc) {
        const float f = sc[m];
        fa[m].x = pk2(lo16(fa[m].x) * f, hi16(fa[m].x) * f); fa[m].y = pk2(lo16(fa[m].y) * f, hi16(fa[m].y) * f);
        fa[m].z = pk2(lo16(fa[m].z) * f, hi16(fa[m].z) * f); fa[m].w = pk2(lo16(fa[m].w) * f, hi16(fa[m].w) * f);
      }
    }
#pragma unroll
    for (int n = 0; n < NB_; ++n) fb[n] = *(const uint4*)(sB + (b0 + n * 16 + fr) * sb + k0 + fq * 8);
#pragma unroll
    for (int m = 0; m < MB_; ++m)
#pragma unroll
      for (int n = 0; n < NB_; ++n) acc[m][n] = mfma16(fb[n], fa[m], acc[m][n]);
  }
}
__device__ __forceinline__ void ret_stage_T(u16* dst0, u16* dst1, const u16* src, int t0, int h, int mode, const f32x2* rope, const float* w0, const float* w1) {
  const int pos0 = t0 & (SEQ - 1);
  for (int idx = tidx(); idx < 32 * 64; idx += NTHR) {
    const int ii = idx >> 6, d = idx & 63;
    float a1[4], a2[4];
#pragma unroll
    for (int r = 0; r < 4; ++r) {
      const int i = 4 * ii + r;
      float t1 = h2f(src[(size_t)(t0 + i) * 512 + h * 128 + d]), t2 = h2f(src[(size_t)(t0 + i) * 512 + h * 128 + d + 64]);
      if (mode) {
        const f32x2 cs = rope[(pos0 + i) * 64 + d];
        const float o1 = t1 * cs[0] - t2 * cs[1], o2 = t1 * cs[1] + t2 * cs[0];
        t1 = o1; t2 = o2;
        if (mode == 2) { t1 *= 0.08838834764831845f; t2 *= 0.08838834764831845f; }
      }
      a1[r] = t1; a2[r] = t2;
    }
    if (w0) {
      const f32x4 wa = *(const f32x4*)(w0 + 4 * ii), wb = *(const f32x4*)(w1 + 4 * ii);
      uint2 o;
      o.x = pk2(a1[0] * wa[0], a1[1] * wa[1]); o.y = pk2(a1[2] * wa[2], a1[3] * wa[3]); *(uint2*)(dst0 + d * RSTR + 4 * ii) = o;
      o.x = pk2(a2[0] * wa[0], a2[1] * wa[1]); o.y = pk2(a2[2] * wa[2], a2[3] * wa[3]); *(uint2*)(dst0 + (d + 64) * RSTR + 4 * ii) = o;
      o.x = pk2(a1[0] * wb[0], a1[1] * wb[1]); o.y = pk2(a1[2] * wb[2], a1[3] * wb[3]); *(uint2*)(dst1 + d * RSTR + 4 * ii) = o;
      o.x = pk2(a2[0] * wb[0], a2[1] * wb[1]); o.y = pk2(a2[2] * wb[2], a2[3] * wb[3]); *(uint2*)(dst1 + (d + 64) * RSTR + 4 * ii) = o;
    } else {
      uint2 o;
      o.x = pk2(a1[0], a1[1]); o.y = pk2(a1[2], a1[3]); *(uint2*)(dst0 + d * RSTR + 4 * ii) = o;
      o.x = pk2(a2[0], a2[1]); o.y = pk2(a2[2], a2[3]); *(uint2*)(dst0 + (d + 64) * RSTR + 4 * ii) = o;
    }
  }
}
__device__ __forceinline__ void phase_ret_inc_mfma(const P& p, char* smem) {
  u16* sKf = (u16*)smem; u16* sKb = sKf + 128 * RSTR; u16* sVT = sKb + 128 * RSTR; float* sWf = (float*)(sVT + 128 * RSTR); float* sWb = sWf + 128;
  const u16* kb = (const u16*)(p.ws + WS_Z) + (size_t)1 * T_TOK * 512; const u16* vb = (const u16*)(p.ws + WS_Z) + (size_t)2 * T_TOK * 512;
  const f32x2* rope = (const f32x2*)(p.ws + WS_ROPE);
  float* incf = (float*)(p.ws + WS_INC); float* incb = incf + (size_t)512 * 16384;
  const int tid = tidx(), lane = tid & 63, wv = tid >> 6, wr = wv >> 1, wc = wv & 1, fr = lane & 15, fq = lane >> 4;
  for (int item = blockIdx.x; item < 512; item += gridDim.x) {
    const int h = item & 3, bn = item >> 2, t0 = bn * 128;
    const float lgf = log_sigmoid(p.ret_decay[h]), lgb = log_sigmoid(p.ret_decay[4 + h]);
    __syncthreads();
    if (tid < 128) { sWf[tid] = expf(lgf * (float)(127 - tid)); sWb[tid] = expf(lgb * (float)tid); }
    __syncthreads();
    ret_stage_T(sKf, sKb, kb, t0, h, 2, rope, sWf, sWb);
    ret_stage_T(sVT, nullptr, vb, t0, h, 0, rope, nullptr, nullptr);
    __syncthreads();
#pragma unroll
    for (int dirn = 0; dirn < 2; ++dirn) {
      f32x4 acc[2][4];
#pragma unroll
      for (int m = 0; m < 2; ++m)
#pragma unroll
        for (int n = 0; n < 4; ++n) acc[m][n] = (f32x4){0.f, 0.f, 0.f, 0.f};
      lds_mma<2, 4>(acc, sVT, RSTR, wr * 32, dirn ? sKb : sKf, RSTR, wc * 64, 128, lane, nullptr);
      float* o = (dirn ? incb : incf) + (size_t)item * 16384;
#pragma unroll
      for (int m = 0; m < 2; ++m)
#pragma unroll
        for (int n = 0; n < 4; ++n) *(f32x4*)(o + (wr * 32 + m * 16 + fr) * 128 + wc * 64 + n * 16 + 4 * fq) = acc[m][n];
    }
  }
}
__device__ __forceinline__ void phase_ret_scan16(const P& p) {
  const float* incf = (const float*)(p.ws + WS_INC); const float* incb = incf + (size_t)512 * 16384;
  u16* spf = (u16*)(p.ws + WS_SP16); u16* spb = spf + (size_t)512 * 16384;
  const int gtid = blockIdx.x * NTHR + tidx(), gsz = gridDim.x * NTHR;
  for (int idx = gtid; idx < 32 * 4096; idx += gsz) {
    const int de = (idx & 4095) * 4, bh = idx >> 12, b = bh >> 2, h = bh & 3;
    const float Gf = expf(128.0f * log_sigmoid(p.ret_decay[h])), Gb = expf(128.0f * log_sigmoid(p.ret_decay[4 + h]));
    f32x4 s = {0.f, 0.f, 0.f, 0.f};
    for (int n = 0; n < 16; ++n) {
      const size_t o = ((size_t)((b * 16 + n) * 4 + h)) * 16384 + de;
      const f32x4 t = *(const f32x4*)(incf + o);
      uint2 w; w.x = pk2(s[0], s[1]); w.y = pk2(s[2], s[3]); *(uint2*)(spf + o) = w;
      s = s * Gf + t;
    }
    s = (f32x4){0.f, 0.f, 0.f, 0.f};
    for (int n = 15; n >= 0; --n) {
      const size_t o = ((size_t)((b * 16 + n) * 4 + h)) * 16384 + de;
      const f32x4 t = *(const f32x4*)(incb + o);
      uint2 w; w.x = pk2(s[0], s[1]); w.y = pk2(s[2], s[3]); *(uint2*)(spb + o) = w;
      s = s * Gb + t;
    }
  }
}
__device__ __forceinline__ void phase_ret_out_mfma(const P& p, char* smem) {
  u16* R0 = (u16*)smem; u16* R1 = R0 + 128 * RSTR; u16* R2 = R1 + 128 * RSTR; u16* R3 = R2 + 128 * RSTR;
  float* sPf = (float*)(R3 + 128 * RSTR); float* sPb = sPf + 132;
  const u16* zb = (const u16*)(p.ws + WS_Z);
  const u16* qb = zb; const u16* kb = zb + (size_t)1 * T_TOK * 512; const u16* vb = zb + (size_t)2 * T_TOK * 512; const u16* gb = zb + (size_t)3 * T_TOK * 512;
  const f32x2* rope = (const f32x2*)(p.ws + WS_ROPE);
  const u16* spf = (const u16*)(p.ws + WS_SP16); const u16* spb = spf + (size_t)512 * 16384;
  u16* ycat = (u16*)(p.ws + WS_YCAT);
  const int tid = tidx(), lane = tid & 63, wv = tid >> 6, wr = wv >> 1, wc = wv & 1, fr = lane & 15, fq = lane >> 4;
  for (int item = blockIdx.x; item < 512; item += gridDim.x) {
    const int h = item & 3, bn = item >> 2, t0 = bn * 128;
    const float lgf = log_sigmoid(p.ret_decay[h]), lgb = log_sigmoid(p.ret_decay[4 + h]);
    __syncthreads();
    ret_load_tile(R0, qb, t0, h, 1, rope);
    ret_load_tile(R1, kb, t0, h, 2, rope);
    ret_stage_T(R2, nullptr, vb, t0, h, 0, rope, nullptr, nullptr);
    if (tid < 129) { sPf[tid] = expf(lgf * (float)tid); sPb[tid] = expf(lgb * (float)tid); }
    __syncthreads();
    {
      f32x4 acc[2][4];
#pragma unroll
      for (int m = 0; m < 2; ++m)
#pragma unroll
        for (int n = 0; n < 4; ++n) acc[m][n] = (f32x4){0.f, 0.f, 0.f, 0.f};
      lds_mma<2, 4>(acc, R0, RSTR, wr * 32, R1, RSTR, wc * 64, 128, lane, nullptr);
#pragma unroll
      for (int m = 0; m < 2; ++m)
#pragma unroll
        for (int n = 0; n < 4; ++n) {
          const int i = wr * 32 + m * 16 + fr, j = wc * 64 + n * 16 + 4 * fq;
          float v[4];
#pragma unroll
          for (int r = 0; r < 4; ++r) { const int jj = j + r; v[r] = acc[m][n][r] * ((i >= jj) ? sPf[i - jj] : sPb[jj - i]); }
          uint2 w; w.x = pk2(v[0], v[1]); w.y = pk2(v[2], v[3]);
          *(uint2*)(R3 + i * RSTR + j) = w;
        }
    }
    __syncthreads();
    const u16* spT = spf + (size_t)item * 16384; const u16* snT = spb + (size_t)item * 16384;
    for (int c = tid; c < 128 * 16; c += NTHR) { const int e = c >> 4, ch = (c & 15) * 8; *(uint4*)(R1 + e * RSTR + ch) = *(const uint4*)(spT + e * 128 + ch); }
    f32x4 o[1][8];
#pragma unroll
    for (int m = 0; m < 1; ++m)
#pragma unroll
      for (int n = 0; n < 8; ++n) o[m][n] = (f32x4){0.f, 0.f, 0.f, 0.f};
    lds_mma<1, 8>(o, R3, RSTR, wv * 16, R2, RSTR, 0, 128, lane, nullptr);
    __syncthreads();
    for (int c = tid; c < 128 * 16; c += NTHR) { const int e = c >> 4, ch = (c & 15) * 8; *(uint4*)(R2 + e * RSTR + ch) = *(const uint4*)(snT + e * 128 + ch); }
    float scf[1], scb[1];
    { const int i = wv * 16 + fr; scf[0] = sPf[i + 1]; scb[0] = sPb[128 - i]; }
    lds_mma<1, 8>(o, R0, RSTR, wv * 16, R1, RSTR, 0, 128, lane, scf);
    __syncthreads();
    lds_mma<1, 8>(o, R0, RSTR, wv * 16, R2, RSTR, 0, 128, lane, scb);
#pragma unroll
    for (int m = 0; m < 1; ++m) {
      float s1 = 0.f;
#pragma unroll
      for (int n = 0; n < 8; ++n) s1 += (o[m][n][0] + o[m][n][1]) + (o[m][n][2] + o[m][n][3]);
      s1 += __shfl_xor(s1, 16); s1 += __shfl_xor(s1, 32);
      const float mu = s1 * (1.0f / 128.0f);
      float s2 = 0.f;
#pragma unroll
      for (int n = 0; n < 8; ++n)
#pragma unroll
        for (int r = 0; r < 4; ++r) { const float dl = o[m][n][r] - mu; s2 += dl * dl; }
      s2 += __shfl_xor(s2, 16); s2 += __shfl_xor(s2, 32);
      const float rs = rsqrtf(s2 * (1.0f / 128.0f) + 1e-5f);
      const size_t tok = (size_t)(t0 + wv * 16 + m * 16 + fr);
#pragma unroll
      for (int n = 0; n < 8; ++n) {
        const int e = n * 16 + 4 * fq;
        const uint2 gq = *(const uint2*)(gb + tok * 512 + h * 128 + e);
        const float g0 = lo16(gq.x), g1 = hi16(gq.x), g2 = lo16(gq.y), g3 = hi16(gq.y);
        uint2 w;
        w.x = pk2(g0 * sigmoidf_(g0) * (o[m][n][0] - mu) * rs, g1 * sigmoidf_(g1) * (o[m][n][1] - mu) * rs);
        w.y = pk2(g2 * sigmoidf_(g2) * (o[m][n][2] - mu) * rs, g3 * sigmoidf_(g3) * (o[m][n][3] - mu) * rs);
        *(uint2*)(ycat + tok * DM + h * 128 + e) = w;
      }
    }
  }
}

struct Cpx { float re, im; };
__device__ __forceinline__ Cpx cmul(Cpx a, Cpx b) { return {a.re * b.re - a.im * b.im, a.re * b.im + a.im * b.re}; }
__device__ __forceinline__ Cpx s5_lam_pow(float ar, float ai, float dt, float e) {
  const float mag = expf(ar * dt * e); float sn, cs; sincosf(ai * dt * e, &sn, &cs); return {mag * cs, mag * sn};
}
__device__ __forceinline__ Cpx s5_coef(float ar, float ai, float dt) {
  float sn, cs; sincosf(ai * dt, &sn, &cs);
  const float em1 = expm1f(ar * dt), sh = sinf(0.5f * ai * dt);
  const float nr = em1 * cs - 2.0f * sh * sh, ni = (em1 + 1.0f) * sn, den = ar * ar + ai * ai;
  return {(nr * ar + ni * ai) / den, (ni * ar - nr * ai) / den};
}
__device__ __forceinline__ void phase_s5_ktab(const P& p) {
  float* ktab = (float*)(p.ws + WS_KTAB);
  const int gtid = blockIdx.x * NTHR + tidx(), gsz = gridDim.x * NTHR;
  for (int item = gtid; item < 32 * 2 * 32 * 16; item += gsz) {
    const int c = item & 15, l = (item >> 4) & 31, dir = (item >> 9) & 1, g = item >> 10;
    const float dt = expf(p.log_step[dir * 32 + g]);
    float acc[16];
#pragma unroll
    for (int j = 0; j < 16; ++j) acc[j] = 0.f;
    for (int q = 0; q < 64; ++q) {
      const float ar = p.a_re[(dir * 32 + g) * 64 + q], ai = p.a_im[(dir * 32 + g) * 64 + q];
      const Cpx L = s5_lam_pow(ar, ai, dt, (float)l), cf = s5_coef(ar, ai, dt);
      const Cpx C = {p.c_re[((dir * 32 + g) * 16 + c) * 64 + q], p.c_im[((dir * 32 + g) * 16 + c) * 64 + q]};
      const Cpx w = cmul(cmul(C, L), cf);
#pragma unroll
      for (int j = 0; j < 16; ++j) acc[j] += w.re * p.b_re[(g * 64 + q) * 16 + j] - w.im * p.b_im[(g * 64 + q) * 16 + j];
    }
#pragma unroll
    for (int j = 0; j < 16; j += 4) *(f32x4*)(ktab + (size_t)item * 16 + j) = (f32x4){acc[j], acc[j + 1], acc[j + 2], acc[j + 3]};
  }
}
__device__ __forceinline__ void phase_s5_fill(const P& p) {
  const float* ktab = (const float*)(p.ws + WS_KTAB);
  u16* bty = (u16*)(p.ws + WS_BTY); u16* wet = (u16*)(p.ws + WS_WET);
  const int gtid = blockIdx.x * NTHR + tidx(), gsz = gridDim.x * NTHR;
  for (int item = gtid; item < 32 * 512 * 64; item += gsz) {
    const int ch = item & 63, n = (item >> 6) & 511, g = item >> 15;
    const int ip = ch >> 1, c0 = (ch & 1) * 8, i = n >> 4, c = n & 15;
    float v[8];
    if (ip != i) {
      const int dir = ip < i ? 0 : 1, l = ip < i ? i - ip : ip - i;
      const float* src = ktab + ((size_t)((g * 2 + dir) * 32 + l) * 16 + c) * 16 + c0;
      const f32x4 a = *(const f32x4*)src, b = *(const f32x4*)(src + 4);
      v[0] = a[0]; v[1] = a[1]; v[2] = a[2]; v[3] = a[3]; v[4] = b[0]; v[5] = b[1]; v[6] = b[2]; v[7] = b[3];
    } else {
      const float* s0 = ktab + ((size_t)((g * 2 + 0) * 32) * 16 + c) * 16 + c0;
      const float* s1 = ktab + ((size_t)((g * 2 + 1) * 32) * 16 + c) * 16 + c0;
      const float dd = p.s5d[g * 16 + c];
#pragma unroll
      for (int j = 0; j < 8; ++j) v[j] = s0[j] + s1[j] + ((c0 + j) == c ? dd : 0.f);
    }
    *(uint4*)(bty + ((size_t)g * 512 + n) * 768 + ch * 8) = make_uint4(pk2(v[0], v[1]), pk2(v[2], v[3]), pk2(v[4], v[5]), pk2(v[6], v[7]));
  }
  for (int item = gtid; item < 32 * 512 * 32; item += gsz) {
    const int ch = item & 31, n = (item >> 5) & 511, g = item >> 14;
    const int kk = ch * 8, dir = kk >> 7, p0 = (kk & 127) >> 1, i = n >> 4, c = n & 15;
    const float dt = expf(p.log_step[dir * 32 + g]), e = dir ? (float)(32 - i) : (float)(i + 1);
    float v[8];
#pragma unroll
    for (int q = 0; q < 4; ++q) {
      const int pq = p0 + q;
      const float ar = p.a_re[(dir * 32 + g) * 64 + pq], ai = p.a_im[(dir * 32 + g) * 64 + pq];
      const Cpx L = s5_lam_pow(ar, ai, dt, e);
      const Cpx C = {p.c_re[((dir * 32 + g) * 16 + c) * 64 + pq], p.c_im[((dir * 32 + g) * 16 + c) * 64 + pq]};
      const Cpx w = cmul(C, L);
      v[2 * q] = w.re; v[2 * q + 1] = -w.im;
    }
    *(uint4*)(bty + ((size_t)g * 512 + n) * 768 + 512 + kk) = make_uint4(pk2(v[0], v[1]), pk2(v[2], v[3]), pk2(v[4], v[5]), pk2(v[6], v[7]));
  }
  for (int item = gtid; item < 32 * 256 * 64; item += gsz) {
    const int ch = item & 63, n = (item >> 6) & 255, g = item >> 14;
    const int ip = ch >> 1, c0 = (ch & 1) * 8, ri = n & 1, pq = (n >> 1) & 63, dir = n >> 7;
    const float dt = expf(p.log_step[dir * 32 + g]), e = dir ? (float)ip : (float)(31 - ip);
    const float ar = p.a_re[(dir * 32 + g) * 64 + pq], ai = p.a_im[(dir * 32 + g) * 64 + pq];
    const Cpx w = cmul(s5_lam_pow(ar, ai, dt, e), s5_coef(ar, ai, dt));
    float v[8];
#pragma unroll
    for (int j = 0; j < 8; ++j) {
      const float br = p.b_re[(g * 64 + pq) * 16 + c0 + j], bi = p.b_im[(g * 64 + pq) * 16 + c0 + j];
      v[j] = ri ? (w.re * bi + w.im * br) : (w.re * br - w.im * bi);
    }
    *(uint4*)(wet + ((size_t)g * 256 + n) * 512 + ch * 8) = make_uint4(pk2(v[0], v[1]), pk2(v[2], v[3]), pk2(v[4], v[5]), pk2(v[6], v[7]));
  }
}
__device__ __forceinline__ void phase_s5_carry(const P& p) {
  const float* E = (const float*)(p.ws + WS_E);
  u16* a2 = (u16*)(p.ws + WS_A2);
  const int gtid = blockIdx.x * NTHR + tidx(), gsz = gridDim.x * NTHR;
  for (int idx = gtid; idx < 32 * 8 * 128; idx += gsz) {
    const int pq = idx & 63, dir = (idx >> 6) & 1, b = (idx >> 7) & 7, g = idx >> 10;
    const float dt = expf(p.log_step[dir * 32 + g]);
    const Cpx L = s5_lam_pow(p.a_re[(dir * 32 + g) * 64 + pq], p.a_im[(dir * 32 + g) * 64 + pq], dt, 32.0f);
    Cpx s = {0.f, 0.f};
    for (int jj = 0; jj < 64; ++jj) {
      const int j = dir ? 63 - jj : jj, r = b * 64 + j;
      const f32x2 e = *(const f32x2*)(E + ((size_t)g * 512 + r) * 256 + (dir * 64 + pq) * 2);
      *(unsigned*)(a2 + ((size_t)g * 512 + r) * 768 + 512 + (dir * 64 + pq) * 2) = pk2(s.re, s.im);
      const Cpx ns = cmul(L, s);
      s.re = ns.re + e[0]; s.im = ns.im + e[1];
    }
  }
}
constexpr int KSTR = 72;
__device__ __forceinline__ int t5_bucket_abs(int n) {
  return n < 8 ? n : 8 + (n >= 12) + (n >= 16) + (n >= 23) + (n >= 32) + (n >= 46) + (n >= 64) + (n >= 91);
}
constexpr int VSTR = 392;
__device__ __forceinline__ void phase_attn(const P& p, char* smem) {
  u16* sK = (u16*)smem; u16* sVt = sK + 384 * KSTR; float* sBias = (float*)(sVt + 64 * VSTR);
  const u16* q1 = (const u16*)(p.ws + WS_Z); const u16* k1 = (const u16*)(p.ws + WS_Z + 32 * MB); const u16* v1 = (const u16*)(p.ws + WS_Z + 40 * MB);
  u16* ao = (u16*)(p.ws + WS_YCAT);
  const int tid = tidx(), lane = tid & 63, wv = tid >> 6, fr = lane & 15, lg = lane >> 4, q0 = wv * 16;
  for (int item = blockIdx.x; item < 512; item += gridDim.x) {
    const int b = item >> 6, nb = (item >> 2) & 15, kvh = item & 3;
    __syncthreads();
    for (int c = tid; c < 384 * 8; c += NTHR) {
      const int s = c >> 3, ch = (c & 7) * 8, pos = (nb - 1) * 128 + s;
      uint4 kq = make_uint4(0u, 0u, 0u, 0u), vq = kq;
      if (pos >= 0 && pos < SEQ) { kq = *(const uint4*)(k1 + (size_t)(b * SEQ + pos) * 256 + kvh * 64 + ch); vq = *(const uint4*)(v1 + (size_t)(b * SEQ + pos) * 256 + kvh * 64 + ch); }
      *(uint4*)(sK + s * KSTR + ch) = kq;
      const unsigned vw[4] = {vq.x, vq.y, vq.z, vq.w};
#pragma unroll
      for (int j = 0; j < 4; ++j) { sVt[(ch + 2 * j) * VSTR + s] = (u16)(vw[j] & 0xffffu); sVt[(ch + 2 * j + 1) * VSTR + s] = (u16)(vw[j] >> 16); }
    }
    for (int c = tid; c < 4 * 257; c += NTHR) {
      const int hq = c / 257, ri = c % 257, rel = ri - 128, n = rel < 0 ? -rel : rel;
      const int bucket = (rel > 0 ? 16 : 0) + t5_bucket_abs(n);
      sBias[hq * 260 + ri] = p.rel_bias[bucket * 16 + kvh * 4 + hq];
    }
    __syncthreads();
    for (int hq = 0; hq < 4; ++hq) {
      const int head = kvh * 4 + hq;
      const size_t tok0 = (size_t)b * SEQ + nb * 128 + q0;
      uint4 qf[1][2];
#pragma unroll
      for (int qb = 0; qb < 1; ++qb)
#pragma unroll
        for (int ks = 0; ks < 2; ++ks) qf[qb][ks] = *(const uint4*)(q1 + (tok0 + qb * 16 + fr) * DM + head * 64 + ks * 32 + lg * 8);
      f32x4 O[4][1];
#pragma unroll
      for (int mb = 0; mb < 4; ++mb)
#pragma unroll
        for (int qb = 0; qb < 1; ++qb) O[mb][qb] = (f32x4){0.f, 0.f, 0.f, 0.f};
      const float sinkv = p.sink[head];
      float mrun[1] = {sinkv}, lpart[1] = {lg == 0 ? 1.0f : 0.0f};
#pragma unroll
      for (int c = 0; c < 3; ++c) {
        if ((c == 0 && nb == 0) || (c == 2 && nb == 15)) continue;
        f32x4 S[8][1];
#pragma unroll
        for (int kb = 0; kb < 8; ++kb) {
          S[kb][0] = (f32x4){0.f, 0.f, 0.f, 0.f};
          const bool act = (c == 0) ? (16 * kb + 15 >= q0) : ((c == 2) ? (16 * kb <= q0 + 15) : true);
          if (act) {
#pragma unroll
            for (int ks = 0; ks < 2; ++ks) {
              const uint4 kf = *(const uint4*)(sK + (c * 128 + kb * 16 + fr) * KSTR + ks * 32 + lg * 8);
              S[kb][0] = mfma16(kf, qf[0][ks], S[kb][0]);
            }
          }
        }
        float cmax[1] = {-1e30f};
#pragma unroll
        for (int kb = 0; kb < 8; ++kb)
#pragma unroll
          for (int qb = 0; qb < 1; ++qb)
#pragma unroll
            for (int r = 0; r < 4; ++r) {
              const int sidx = c * 128 + kb * 16 + 4 * lg + r, qi = q0 + qb * 16 + fr, rel = sidx - 128 - qi;
              const bool valid = (rel >= -128) && (rel <= 128);
              const float v = valid ? S[kb][qb][r] + sBias[hq * 260 + (valid ? rel + 128 : 0)] : -1e30f;
              S[kb][qb][r] = v; cmax[qb] = fmaxf(cmax[qb], v);
            }
#pragma unroll
        for (int qb = 0; qb < 1; ++qb) {
          cmax[qb] = fmaxf(cmax[qb], __shfl_xor(cmax[qb], 16)); cmax[qb] = fmaxf(cmax[qb], __shfl_xor(cmax[qb], 32));
          const float mn = fmaxf(mrun[qb], cmax[qb]), alpha = __expf(mrun[qb] - mn);
          mrun[qb] = mn; lpart[qb] *= alpha;
#pragma unroll
          for (int mb = 0; mb < 4; ++mb) O[mb][qb] = O[mb][qb] * alpha;
          float ps = 0.f;
#pragma unroll
          for (int kb = 0; kb < 8; ++kb)
#pragma unroll
            for (int r = 0; r < 4; ++r) { const float e = __expf(S[kb][qb][r] - mn); S[kb][qb][r] = e; ps += e; }
          lpart[qb] += ps;
        }
#pragma unroll
        for (int kk = 0; kk < 4; ++kk) {
          const int kb0 = 2 * kk, kb1 = 2 * kk + 1;
          const bool act = (c == 0) ? (16 * kb1 + 15 >= q0) : ((c == 2) ? (16 * kb0 <= q0 + 15) : true);
          if (act) {
            uint4 pf[1];
#pragma unroll
            for (int qb = 0; qb < 1; ++qb) pf[qb] = make_uint4(pk2(S[kb0][qb][0], S[kb0][qb][1]), pk2(S[kb0][qb][2], S[kb0][qb][3]), pk2(S[kb1][qb][0], S[kb1][qb][1]), pk2(S[kb1][qb][2], S[kb1][qb][3]));
#pragma unroll
            for (int mb = 0; mb < 4; ++mb) {
              const uint2 v0 = *(const uint2*)(sVt + (mb * 16 + fr) * VSTR + c * 128 + kb0 * 16 + 4 * lg);
              const uint2 v1r = *(const uint2*)(sVt + (mb * 16 + fr) * VSTR + c * 128 + kb1 * 16 + 4 * lg);
              const uint4 vf = make_uint4(v0.x, v0.y, v1r.x, v1r.y);
              O[mb][0] = mfma16(vf, pf[0], O[mb][0]);
            }
          }
        }
      }
#pragma unroll
      for (int qb = 0; qb < 1; ++qb) {
        float lt = lpart[qb]; lt += __shfl_xor(lt, 16); lt += __shfl_xor(lt, 32);
        const float inv = 1.0f / lt;
#pragma unroll
        for (int mb = 0; mb < 4; ++mb) {
          uint2 w; w.x = pk2(O[mb][qb][0] * inv, O[mb][qb][1] * inv); w.y = pk2(O[mb][qb][2] * inv, O[mb][qb][3] * inv);
          *(uint2*)(ao + (tok0 + qb * 16 + fr) * DM + head * 64 + mb * 16 + 4 * lg) = w;
        }
      }
    }
  }
}

struct EpiInproj {
  u16* zb; u16* a2;
  __device__ __forceinline__ void operator()(const f32x4 (&acc)[2][2][4][2], const pg8::Unit& u, int wr, int wc, int fr, int fq) const {
    const int seg = u.pn >> 1;
#pragma unroll
    for (int ai = 0; ai < 2; ++ai)
#pragma unroll
      for (int m = 0; m < 4; ++m) {
        const int row = u.pm * 256 + ai * 128 + wr * 64 + m * 16 + fr;
#pragma unroll
        for (int bj = 0; bj < 2; ++bj)
#pragma unroll
          for (int n = 0; n < 2; ++n) {
            const int col = u.pn * 256 + bj * 128 + wc * 32 + n * 16 + 4 * fq;
            const f32x4 v = acc[ai][bj][m][n];
            uint2 w; w.x = pk2(v[0], v[1]); w.y = pk2(v[2], v[3]);
            if (seg < 4) *(uint2*)(zb + (size_t)seg * T_TOK * 512 + (size_t)row * 512 + (col - seg * 512)) = w;
            else { const int ch = col - 2048, gi = ch >> 4, c = ch & 15; *(uint2*)(a2 + ((size_t)gi * 512 + (row >> 5)) * 768 + (row & 31) * 16 + c) = w; }
          }
      }
  }
};
__device__ __forceinline__ void phase_inproj(const P& p, LAS unsigned char* lds) {
  pg8::DenseOrder S; S.init(p.ws + WS_XB, DM, p.ws + WS_WIN, T_TOK, 2560, DM);
  EpiInproj E{(u16*)(p.ws + WS_Z), (u16*)(p.ws + WS_A2)};
  pg8::gemm_phase<EpiInproj, pg8::DenseOrder, G_ALIGN, G_SP2>(lds, DM, S, E);
}
struct EpiS5E {
  float* E_;
  __device__ __forceinline__ void operator()(const f32x4 (&acc)[2][2][4][2], const pg8::Unit& u, int wr, int wc, int fr, int fq) const {
#pragma unroll
    for (int ai = 0; ai < 2; ++ai)
#pragma unroll
      for (int m = 0; m < 4; ++m) {
        const int row = u.pm * 256 + ai * 128 + wr * 64 + m * 16 + fr;
#pragma unroll
        for (int bj = 0; bj < 2; ++bj)
#pragma unroll
          for (int n = 0; n < 2; ++n) *(f32x4*)(E_ + ((size_t)u.e * 512 + row) * 256 + bj * 128 + wc * 32 + n * 16 + 4 * fq) = acc[ai][bj][m][n];
      }
  }
};
__device__ __forceinline__ void phase_s5_egemm(const P& p, LAS unsigned char* lds) {
  pg8::GroupOrder S; S.init(p.ws + WS_A2, 768, (size_t)512 * 768, p.ws + WS_WET, (size_t)256 * 512, 32, 512, 256, 512);
  EpiS5E E{(float*)(p.ws + WS_E)};
  pg8::gemm_phase<EpiS5E, pg8::GroupOrder, G_ALIGN, G_SP2>(lds, 512, S, E);
}
struct EpiS5Y {
  u16* yg;
  __device__ __forceinline__ void operator()(const f32x4 (&acc)[2][2][4][2], const pg8::Unit& u, int wr, int wc, int fr, int fq) const {
#pragma unroll
    for (int ai = 0; ai < 2; ++ai)
#pragma unroll
      for (int m = 0; m < 4; ++m) {
        const int row = u.pm * 256 + ai * 128 + wr * 64 + m * 16 + fr;
#pragma unroll
        for (int bj = 0; bj < 2; ++bj)
#pragma unroll
          for (int n = 0; n < 2; ++n) {
            const int col = u.pn * 256 + bj * 128 + wc * 32 + n * 16 + 4 * fq;
            const f32x4 v = acc[ai][bj][m][n];
            uint2 w; w.x = pk2(gelu_tanh(v[0]), gelu_tanh(v[1])); w.y = pk2(gelu_tanh(v[2]), gelu_tanh(v[3]));
            *(uint2*)(yg + ((size_t)row * 32 + (col >> 4)) * 512 + u.e * 16 + (col & 15)) = w;
          }
      }
  }
};
__device__ __forceinline__ void phase_s5_ygemm(const P& p, LAS unsigned char* lds) {
  pg8::GroupOrder S; S.init(p.ws + WS_A2, 768, (size_t)512 * 768, p.ws + WS_BTY, (size_t)512 * 768, 32, 512, 512, 768);
  EpiS5Y E{(u16*)(p.ws + WS_YGELU)};
  pg8::gemm_phase<EpiS5Y, pg8::GroupOrder, G_ALIGN, G_SP2>(lds, 768, S, E);
}
struct EpiGlu {
  const u16* yg; const float* bglu; u16* ycat;
  __device__ __forceinline__ void operator()(const f32x4 (&acc)[2][2][4][2], const pg8::Unit& u, int wr, int wc, int fr, int fq) const {
#pragma unroll
    for (int ai = 0; ai < 2; ++ai)
#pragma unroll
      for (int m = 0; m < 4; ++m) {
        const int row = u.pm * 256 + ai * 128 + wr * 64 + m * 16 + fr;
#pragma unroll
        for (int bj = 0; bj < 2; ++bj)
#pragma unroll
          for (int n = 0; n < 2; ++n) {
            const int col = u.pn * 256 + bj * 128 + wc * 32 + n * 16 + 4 * fq;
            const f32x4 v = acc[ai][bj][m][n];
            const uint2 yv = *(const uint2*)(yg + (size_t)row * 512 + col);
            const f32x4 bb = *(const f32x4*)(bglu + col);
            uint2 w;
            w.x = pk2(lo16(yv.x) * sigmoidf_(v[0] + bb[0]), hi16(yv.x) * sigmoidf_(v[1] + bb[1]));
            w.y = pk2(lo16(yv.y) * sigmoidf_(v[2] + bb[2]), hi16(yv.y) * sigmoidf_(v[3] + bb[3]));
            *(uint2*)(ycat + (size_t)row * DM + 512 + col) = w;
          }
      }
  }
};
__device__ __forceinline__ void phase_glu(const P& p, LAS unsigned char* lds) {
  pg8::DenseOrder S; S.init(p.ws + WS_YGELU, 512, p.ws + WS_WGLU, T_TOK, 512, 512);
  EpiGlu E{(const u16*)(p.ws + WS_YGELU), p.b_glu, (u16*)(p.ws + WS_YCAT)};
  pg8::gemm_phase<EpiGlu, pg8::DenseOrder, G_ALIGN, G_SP2>(lds, 512, S, E);
}
struct EpiResid {
  const float* xin; float* xout;
  __device__ __forceinline__ void operator()(const f32x4 (&acc)[2][2][4][2], const pg8::Unit& u, int wr, int wc, int fr, int fq) const {
#pragma unroll
    for (int ai = 0; ai < 2; ++ai)
#pragma unroll
      for (int m = 0; m < 4; ++m) {
        const int row = u.pm * 256 + ai * 128 + wr * 64 + m * 16 + fr;
#pragma unroll
        for (int bj = 0; bj < 2; ++bj)
#pragma unroll
          for (int n = 0; n < 2; ++n) {
            const size_t o = (size_t)row * DM + u.pn * 256 + bj * 128 + wc * 32 + n * 16 + 4 * fq;
            const f32x4 xv = *(const f32x4*)(xin + o);
            *(f32x4*)(xout + o) = xv + acc[ai][bj][m][n];
          }
      }
  }
};
__device__ __forceinline__ void phase_outproj(const P& p, const void* Wt, const float* xin, float* xout, LAS unsigned char* lds) {
  pg8::DenseOrder S; S.init(p.ws + WS_YCAT, DM, Wt, T_TOK, DM, DM);
  EpiResid E{xin, xout};
  pg8::gemm_phase<EpiResid, pg8::DenseOrder, G_ALIGN, G_SP2>(lds, DM, S, E);
}
struct EpiQkv {
  u16 *q1, *k1, *v1;
  __device__ __forceinline__ void operator()(const f32x4 (&acc)[2][2][4][2], const pg8::Unit& u, int wr, int wc, int fr, int fq) const {
#pragma unroll
    for (int ai = 0; ai < 2; ++ai)
#pragma unroll
      for (int m = 0; m < 4; ++m) {
        const int row = u.pm * 256 + ai * 128 + wr * 64 + m * 16 + fr;
#pragma unroll
        for (int bj = 0; bj < 2; ++bj)
#pragma unroll
          for (int n = 0; n < 2; ++n) {
            const int col = u.pn * 256 + bj * 128 + wc * 32 + n * 16 + 4 * fq;
            const f32x4 v = acc[ai][bj][m][n];
            uint2 w;
            if (u.pn < 4) { w.x = pk2(v[0] * 0.125f, v[1] * 0.125f); w.y = pk2(v[2] * 0.125f, v[3] * 0.125f); *(uint2*)(q1 + (size_t)row * DM + col) = w; }
            else {
              w.x = pk2(v[0], v[1]); w.y = pk2(v[2], v[3]);
              if (u.pn == 4) *(uint2*)(k1 + (size_t)row * 256 + (col - 1024)) = w; else *(uint2*)(v1 + (size_t)row * 256 + (col - 1280)) = w;
            }
          }
      }
  }
};
__device__ __forceinline__ void phase_qkv(const P& p, LAS unsigned char* lds) {
  pg8::DenseOrder S; S.init(p.ws + WS_XB, DM, p.ws + WS_WQKV, T_TOK, 1536, DM);
  EpiQkv E{(u16*)(p.ws + WS_Z), (u16*)(p.ws + WS_Z + 32 * MB), (u16*)(p.ws + WS_Z + 40 * MB)};
  pg8::gemm_phase<EpiQkv, pg8::DenseOrder, G_ALIGN, G_SP2>(lds, DM, S, E);
}
struct EpiMoe1 {
  u16* hbuf;
  __device__ __forceinline__ void operator()(const f32x4 (&acc)[2][2][4][2], const pg8::Unit& u, int wr, int wc, int fr, int fq) const {
#pragma unroll
    for (int ai = 0; ai < 2; ++ai)
#pragma unroll
      for (int m = 0; m < 4; ++m) {
        const int row = u.pm * 256 + ai * 128 + wr * 64 + m * 16 + fr;
        if (row < u.cnt) {
#pragma unroll
          for (int bj = 0; bj < 2; ++bj) {
            const f32x4 g = acc[ai][bj][m][0], up = acc[ai][bj][m][1];
            uint2 w; w.x = pk2(g[0] * sigmoidf_(g[0]) * up[0], g[1] * sigmoidf_(g[1]) * up[1]); w.y = pk2(g[2] * sigmoidf_(g[2]) * up[2], g[3] * sigmoidf_(g[3]) * up[3]);
            *(uint2*)(hbuf + (size_t)(u.hbase + row) * 512 + 16 * (8 * u.pn + 4 * bj + wc) + 4 * fq) = w;
          }
        }
      }
  }
};
__device__ __forceinline__ void phase_moe1(const P& p, int layer, LAS unsigned char* lds) {
  pg8::MoeOrder S; S.init((const int*)(p.ws + WS_CNT) + layer * 32, (const int*)(p.ws + WS_LIST), p.ws + WS_XB, DM, p.ws + WS_MW, (size_t)DM * DM, DM, DM, true);
  EpiMoe1 E{(u16*)(p.ws + WS_H)};
  pg8::gemm_phase<EpiMoe1, pg8::MoeOrder, G_ALIGN, G_SP2>(lds, DM, S, E);
}
struct EpiMoe2 {
  const int* list; const float* gate; u16* slots;
  __device__ __forceinline__ void operator()(const f32x4 (&acc)[2][2][4][2], const pg8::Unit& u, int wr, int wc, int fr, int fq) const {
#pragma unroll
    for (int ai = 0; ai < 2; ++ai)
#pragma unroll
      for (int m = 0; m < 4; ++m) {
        const int row = u.pm * 256 + ai * 128 + wr * 64 + m * 16 + fr;
        if (row < u.cnt) {
          const int asg = list[(size_t)u.e * CAP + row];
          const float gt = gate[asg];
#pragma unroll
          for (int bj = 0; bj < 2; ++bj)
#pragma unroll
            for (int n = 0; n < 2; ++n) {
              const f32x4 v = acc[ai][bj][m][n];
              uint2 w; w.x = pk2(gt * v[0], gt * v[1]); w.y = pk2(gt * v[2], gt * v[3]);
              *(uint2*)(slots + (size_t)asg * DM + u.pn * 256 + bj * 128 + wc * 32 + n * 16 + 4 * fq) = w;
            }
        }
      }
  }
};
__device__ __forceinline__ void phase_moe2(const P& p, int layer, LAS unsigned char* lds) {
  pg8::MoeOrder S; S.init((const int*)(p.ws + WS_CNT) + layer * 32, (const int*)(p.ws + WS_LIST), p.ws + WS_H, 512, p.ws + WS_MW + 64 * MB, (size_t)DM * 512, DM, 512, false);
  EpiMoe2 E{(const int*)(p.ws + WS_LIST), (const float*)(p.ws + WS_GATE), (u16*)(p.ws + WS_INC)};
  pg8::gemm_phase<EpiMoe2, pg8::MoeOrder, G_ALIGN, G_SP2>(lds, 512, S, E);
}

#define XB_TMO      128
#define XB_XCNT(j)  (256  + 64 * (j))
#define XB_XSUB(j)  (1280 + 64 * (j))
#define XB_XGEN(j)  (2304 + 64 * (j))
#define XB_TOP      3328
#define XB_TOPGEN   3392
#define XCD_BAR_WORDS 3456
#define XB_SPIN_CAP (1u << 22)
__device__ __forceinline__ unsigned xb_ld(unsigned* p)              { return __hip_atomic_load(p, __ATOMIC_RELAXED, __HIP_MEMORY_SCOPE_AGENT); }
__device__ __forceinline__ unsigned xb_add(unsigned* p, unsigned v) { return __hip_atomic_fetch_add(p, v, __ATOMIC_RELAXED, __HIP_MEMORY_SCOPE_AGENT); }
__device__ __forceinline__ unsigned xb_xcc_id() { return (unsigned)__builtin_amdgcn_s_getreg((3 << 11) | 20) & 0xFu; }
#define XB_SPIN(cond, bar) do { unsigned _sp = 0; while (cond) { __builtin_amdgcn_s_sleep(1); \
    if ((++_sp & 255u) == 0u) { if (xb_ld(&(bar)[XB_TMO])) break; if (_sp > XB_SPIN_CAP) { atomicAdd(&(bar)[XB_TMO], 1u); break; } } } } while (0)
struct XcdBarrier { unsigned* bar; unsigned x; volatile LAS unsigned* st; };
__device__ __forceinline__ XcdBarrier xcd_barrier_post(unsigned* bar, volatile LAS unsigned* st) {
  XcdBarrier b; b.bar = bar; b.x = xb_xcc_id(); b.st = st;
  if (tidx() == 0) (void)xb_add(&bar[XB_XCNT(b.x)], 1u);
  return b;
}
__device__ __forceinline__ void xcd_barrier_complete(unsigned* bar, unsigned x, unsigned& nloc, unsigned& nx) {
  const unsigned G = gridDim.x * gridDim.y * gridDim.z;
  unsigned sum, cnt, mine, sp = 0u;
  for (;;) {
    sum = 0u; cnt = 0u; mine = 0u;
#pragma unroll
    for (unsigned j = 0; j < 16; ++j) { const unsigned c = xb_ld(&bar[XB_XCNT(j)]); sum += c; cnt += (c > 0u) ? 1u : 0u; mine = (j == x) ? c : mine; }
    if (sum == G) break;
    __builtin_amdgcn_s_sleep(1);
    if ((++sp & 255u) == 0u) { if (xb_ld(&bar[XB_TMO])) break; if (sp > XB_SPIN_CAP) { atomicAdd(&bar[XB_TMO], 1u); break; } }
  }
  nloc = mine > 0u ? mine : 1u; nx = cnt > 0u ? cnt : 1u;
}
__device__ __forceinline__ void xcd_barrier(const XcdBarrier& b) {
  asm volatile("s_waitcnt vmcnt(0)" ::: "memory");
  __syncthreads();
  if (tidx() == 0) {
    unsigned* bar = b.bar;
    __builtin_amdgcn_s_waitcnt(0);
    unsigned nloc = b.st[0], nx = b.st[1];
    if (nloc == 0u) { xcd_barrier_complete(bar, b.x, nloc, nx); b.st[0] = nloc; b.st[1] = nx; }
    const unsigned old = xb_add(&bar[XB_XSUB(b.x)], 1u);
    const unsigned gen = old / nloc;
    if (old + 1u == (gen + 1u) * nloc) {
      __builtin_amdgcn_fence(__ATOMIC_RELEASE, "agent");
      asm volatile("s_waitcnt vmcnt(0)" ::: "memory");
      const unsigned og = xb_add(&bar[XB_TOP], 1u);
      const unsigned tg = og / nx;
      if (og + 1u == (tg + 1u) * nx) xb_add(&bar[XB_TOPGEN], 1u);
      else XB_SPIN(xb_ld(&bar[XB_TOPGEN]) == tg, bar);
      __builtin_amdgcn_fence(__ATOMIC_ACQUIRE, "agent");
      xb_add(&bar[XB_XGEN(b.x)], 1u);
      asm volatile("s_waitcnt vmcnt(0)" ::: "memory");
    } else {
      XB_SPIN(xb_ld(&bar[XB_XGEN(b.x)]) == gen, bar);
      __builtin_amdgcn_fence(__ATOMIC_ACQUIRE, "agent");
      asm volatile("s_waitcnt vmcnt(0)" ::: "memory");
    }
  }
  __syncthreads();
}

constexpr int NPHASE = 19;
constexpr int LDS_BYTES = 147456;
__device__ __forceinline__ void run_phase(const P& p, int ph, char* smem, LAS unsigned char* lds) {
  float* xa = (float*)(p.ws + WS_XA);
  const u16* slots = (const u16*)(p.ws + WS_INC);
  switch (ph) {
    case 0: phase_prep(p); phase_s5_ktab(p); phase_conv_dense(p, smem); break;
    case 1: phase_rowpass(p, p.x, nullptr, nullptr, p.norm_mix_g, -1, nullptr, smem); phase_s5_fill(p); break;
    case 2: phase_inproj(p, lds); break;
    case 3: phase_ret_inc_mfma(p, smem); __syncthreads(); phase_s5_egemm(p, lds); break;
    case 4: phase_ret_scan16(p); phase_s5_carry(p); break;
    case 5: phase_ret_out_mfma(p, smem); __syncthreads(); phase_s5_ygemm(p, lds); break;
    case 6: phase_glu(p, lds); break;
    case 7: phase_outproj(p, p.ws + WS_WOUT, p.x, xa, lds); break;
    case 8: phase_rowpass(p, xa, nullptr, nullptr, p.norm_ffn_g, 0, nullptr, smem); __syncthreads(); phase_conv_moe(p, 0, smem); break;
    case 9: phase_moe1(p, 0, lds); break;
    case 10: phase_moe2(p, 0, lds); break;
    case 11: phase_rowpass(p, xa, slots, xa, p.norm_mix_g + DM, -1, nullptr, smem); break;
    case 12: phase_qkv(p, lds); break;
    case 13: phase_attn(p, smem); break;
    case 14: phase_outproj(p, p.ws + WS_WO, xa, xa, lds); break;
    case 15: phase_rowpass(p, xa, nullptr, nullptr, p.norm_ffn_g + DM, 1, nullptr, smem); __syncthreads(); phase_conv_moe(p, 1, smem); break;
    case 16: phase_moe1(p, 1, lds); break;
    case 17: phase_moe2(p, 1, lds); break;
    case 18: phase_rowpass(p, xa, slots, nullptr, p.norm_final_g, -1, p.out, smem); break;
    default: break;
  }
}

extern __shared__ __attribute__((aligned(16))) char dyn_smem[];

template <int PH> __device__ __forceinline__ void mega_steps(const P& p, char* smem, LAS unsigned char* lds, cg::grid_group& grid, const XcdBarrier& xb) {
  run_phase(p, PH, smem, lds);
  if constexpr (PH + 1 < NPHASE) {
    if constexpr (PH == 0) grid.sync(); else xcd_barrier(xb);
    mega_steps<PH + 1>(p, smem, lds, grid, xb);
  }
}
__global__ void __launch_bounds__(NTHR, 2) k_mega(P p) {
  cg::grid_group grid = cg::this_grid();
  LAS unsigned char* lds = (LAS unsigned char*)dyn_smem;
  volatile LAS unsigned* st = (volatile LAS unsigned*)(lds + LDS_BYTES - 16);
  if (tidx() == 0) { st[0] = 0u; st[1] = 0u; }
  __syncthreads();
  const XcdBarrier xb = xcd_barrier_post((unsigned*)(p.ws + WS_BAR), st);
  mega_steps<0>(p, dyn_smem, lds, grid, xb);
}

extern "C" void kernel_launch(void* const* d_in, const int* in_sizes, int n_in, void* d_out, int out_size, void* d_ws, size_t ws_size, hipStream_t stream) {
  static int grid_blocks = 0;
  if (grid_blocks == 0) {
    if (n_in != 28 || out_size != T_TOK * DM || ws_size < WS_END) { fprintf(stderr, "kernel_launch: unexpected problem (n_in %d out %d ws %zu need %zu)\n", n_in, out_size, ws_size, (size_t)WS_END); grid_blocks = -1; return; }
    int dev = 0, cus = 0, per_cu = 0;
    (void)hipGetDevice(&dev);
    (void)hipDeviceGetAttribute(&cus, hipDeviceAttributeMultiprocessorCount, dev);
    const void* fn = (const void*)k_mega;
    if (hipFuncSetAttribute(fn, hipFuncAttributeMaxDynamicSharedMemorySize, LDS_BYTES) != hipSuccess) { fprintf(stderr, "kernel_launch: hipFuncSetAttribute failed\n"); }
    if (hipOccupancyMaxActiveBlocksPerMultiprocessor(&per_cu, fn, NTHR, LDS_BYTES) != hipSuccess || per_cu < 1) { fprintf(stderr, "kernel_launch: occupancy query failed (%d)\n", per_cu); per_cu = 1; }
    (void)hipGetLastError();
    if (per_cu > 1) per_cu = 1;
    grid_blocks = cus * per_cu;
    fprintf(stderr, "kernel_launch: cus %d per_cu %d grid %d\n", cus, per_cu, grid_blocks);
  }
  if (grid_blocks < 0) return;
  P p{};
  const float** pp = (const float**)&p;
  for (int i = 0; i < 28; ++i) pp[i] = (const float*)d_in[i];
  p.out = (float*)d_out; p.ws = (char*)d_ws;
  (void)hipMemsetAsync((char*)d_ws + WS_BAR, 0, XCD_BAR_WORDS * 4, stream);
  void* args[] = {&p};
  hipError_t e = hipLaunchCooperativeKernel((const void*)k_mega, dim3(grid_blocks), dim3(NTHR), args, LDS_BYTES, stream);
  if (e != hipSuccess) fprintf(stderr, "cooperative launch failed: %s (grid %d)\n", hipGetErrorString(e), grid_blocks);
}
```

```cpp
#include <hip/hip_runtime.h>
#include <hip/hip_cooperative_groups.h>
#include <cstdio>
#include <cstdint>
namespace cg = cooperative_groups;

#define USE_FP16 1
#define LAS __attribute__((address_space(3)))

typedef unsigned short u16;
typedef float f32x4 __attribute__((ext_vector_type(4)));
typedef float f32x2 __attribute__((ext_vector_type(2)));
typedef _Float16 f16x8 __attribute__((ext_vector_type(8)));

constexpr int T_TOK = 16384, DM = 1024, SEQ = 2048, NBATCH = 8;
constexpr int CAP = 32768;
constexpr int NTHR = 512, NWAVE = NTHR / 64;

constexpr size_t MB = 1024ull * 1024ull;
constexpr size_t WS_XA    = 0;
constexpr size_t WS_XB    = 64 * MB;
constexpr size_t WS_Z     = 96 * MB;
constexpr size_t WS_A2    = 160 * MB;
constexpr size_t WS_BTY   = 184 * MB;
constexpr size_t WS_MW    = WS_Z;
constexpr size_t WS_WET   = 208 * MB;
constexpr size_t WS_E     = 216 * MB;
constexpr size_t WS_KTAB  = 232 * MB;
constexpr size_t WS_SP16  = 234 * MB;
constexpr size_t WS_INC   = 266 * MB;
constexpr size_t WS_YCAT  = 330 * MB;
constexpr size_t WS_YGELU = 362 * MB;
constexpr size_t WS_H     = 378 * MB;
constexpr size_t WS_LIST  = 418 * MB;
constexpr size_t WS_GATE  = 422 * MB;
constexpr size_t WS_ROPE  = 423 * MB;
constexpr size_t WS_CNT   = 424 * MB;
constexpr size_t WS_WR16  = 425 * MB;
constexpr size_t WS_BAR   = 426 * MB;
constexpr size_t WS_WIN   = 427 * MB;
constexpr size_t WS_WGLU  = 432 * MB;
constexpr size_t WS_WOUT  = 433 * MB;
constexpr size_t WS_WQKV  = 435 * MB;
constexpr size_t WS_WO    = 438 * MB;
constexpr size_t WS_END   = 440 * MB;

struct P {
  const float *x, *norm_mix_g, *norm_ffn_g, *norm_final_g, *w_in, *ret_decay, *a_re, *a_im, *log_step, *b_re, *b_im, *c_re, *c_im,
      *s5d, *w_glu, *b_glu, *w_out, *w_qkv, *sink, *w_o, *rel_bias, *w_group, *b_group, *w_er, *b_er, *w_gate, *w_up, *w_down;
  float* out;
  char* ws;
};

__device__ __forceinline__ u16 f2h(float f) { _Float16 h = (_Float16)f; return __builtin_bit_cast(u16, h); }
__device__ __forceinline__ float h2f(u16 h) { return (float)__builtin_bit_cast(_Float16, h); }
__device__ __forceinline__ unsigned pk2(float a, float b) { return (unsigned)f2h(a) | ((unsigned)f2h(b) << 16); }
__device__ __forceinline__ float lo16(unsigned w) { return h2f((u16)(w & 0xffffu)); }
__device__ __forceinline__ float hi16(unsigned w) { return h2f((u16)(w >> 16)); }
__device__ __forceinline__ f32x4 mfma16(uint4 a, uint4 b, f32x4 c) {
  return __builtin_amdgcn_mfma_f32_16x16x32_f16(__builtin_bit_cast(f16x8, a), __builtin_bit_cast(f16x8, b), c, 0, 0, 0);
}
__device__ __forceinline__ float wave_sum(float v) {
#pragma unroll
  for (int o = 1; o < 64; o <<= 1) v += __shfl_xor(v, o);
  return v;
}
__device__ __forceinline__ float sigmoidf_(float x) { return 1.0f / (1.0f + __expf(-x)); }
__device__ __forceinline__ float gelu_tanh(float x) {
  const float u = 0.7978845608028654f * (x + 0.044715f * x * x * x);
  return 0.5f * x * (1.0f + tanhf(u));
}
#define LDS_WAIT() asm volatile("s_waitcnt lgkmcnt(0)" ::: "memory")
__device__ __forceinline__ int tidx() { int t = threadIdx.x; asm volatile("" : "+v"(t)); return t; }

namespace pg8 {
constexpr int BM = 256, BK = 64, HALF = 128, HTB = HALF * BK * 2, STAGE_BYTES = 8 * HTB, NXCD = 8, WGM = 8;
__device__ __forceinline__ int lds_byte(int r, int c) { const int st = (r >> 4) * 2 + (c >> 5), rr = r & 15, cc = c & 31, ob = rr * 64 + cc * 2; return st * 1024 + (ob ^ (((ob >> 9) & 1) << 5)); }
__device__ __forceinline__ void stage_rc(int b, int& R, int& C) { const int st = b / 1024, sb = b % 1024, swz = sb ^ (((sb >> 9) & 1) << 5); R = (st >> 1) * 16 + swz / 64; C = (st & 1) * 32 + (swz % 64) / 2; }

struct Unit { const char* a; const char* b; int pm, pn, e, cnt, hbase; };

template <class Epi, class Sched, bool ALIGN_EPI, bool SP2>
__device__ __forceinline__ void gemm_phase(LAS unsigned char* lds, const int K, const Sched& S, const Epi& E) {
    const int tid = tidx(), wid = __builtin_amdgcn_readfirstlane(tid >> 6), lane = tid & 63, wr = wid >> 2, wc = wid & 3, fr = lane & 15, fq = lane >> 4;
    const int nt = K / BK;
    int Rr[2], Cc[2];
    unsigned voffB[2];
#pragma unroll
    for (int i = 0; i < 2; ++i) { stage_rc(tid * 16 + i * 8192, Rr[i], Cc[i]); voffB[i] = (unsigned)(Rr[i] * K + Cc[i]) * 2u; }
    const size_t kstep = (size_t)(BK * 2);
    const size_t hstepB = (size_t)HALF * K * 2;
    const unsigned ldsw = (unsigned)wid * 1024u;
    const int aoff = lds_byte(wr * 64 + fr, fq * 8), boff = lds_byte(wc * 32 + fr, fq * 8);
#define PG8_SA(b, h) (((b) * 2 + (h)) * HTB)
#define PG8_SB(b, h) ((4 + (b) * 2 + (h)) * HTB)
#define PG8_STAGE(bufoff, gbase, voff) do { _Pragma("unroll") for (int _i = 0; _i < 2; ++_i) \
        __builtin_amdgcn_global_load_lds((const unsigned*)((const char*)(gbase) + (voff)[_i]), (LAS unsigned*)(lds + (bufoff) + ldsw + _i * 8192), 16, 0, 0); } while (0)
#define PG8_LDA(dst, b, h) do { _Pragma("unroll") for (int m = 0; m < 4; ++m) _Pragma("unroll") for (int k = 0; k < 2; ++k) dst[m][k] = *(const LAS f16x8*)(lds + PG8_SA(b, h) + aoff + m * 2048 + k * 1024); } while (0)
#define PG8_LDB(dst, b, h) do { _Pragma("unroll") for (int n = 0; n < 2; ++n) _Pragma("unroll") for (int k = 0; k < 2; ++k) dst[n][k] = *(const LAS f16x8*)(lds + PG8_SB(b, h) + boff + n * 2048 + k * 1024); } while (0)
#define PG8_MMA(ai, bj, At, Bt) do { __builtin_amdgcn_s_setprio(1); _Pragma("unroll") for (int m = 0; m < 4; ++m) _Pragma("unroll") for (int n = 0; n < 2; ++n) _Pragma("unroll") for (int k = 0; k < 2; ++k) \
        acc[ai][bj][m][n] = __builtin_amdgcn_mfma_f32_16x16x32_f16(Bt[n][k], At[m][k], acc[ai][bj][m][n], 0, 0, 0); __builtin_amdgcn_s_setprio(0); } while (0)
#define PG8_WAIT_V(n) asm volatile("s_waitcnt vmcnt(" #n ")" ::: "memory")
#define PG8_WAIT_L(n) asm volatile("s_waitcnt lgkmcnt(" #n ")" ::: "memory")
#define PG8_BAR __builtin_amdgcn_s_barrier()
#define PG8_SCHED __builtin_amdgcn_sched_barrier(0)
    Unit cur, nxt; int ui = 0;
    if (!S.next(0, cur)) return;
    unsigned cv0[2], cv1[2], nv0[2], nv1[2];
#pragma unroll
    for (int i = 0; i < 2; ++i) { cv0[i] = S.a_voff(cur, 0, Rr[i], Cc[i]); cv1[i] = S.a_voff(cur, 1, Rr[i], Cc[i]); }
    f32x4 acc[2][2][4][2];
#pragma unroll
    for (int a = 0; a < 2; ++a)
#pragma unroll
        for (int b = 0; b < 2; ++b)
#pragma unroll
            for (int m = 0; m < 4; ++m)
#pragma unroll
                for (int n = 0; n < 2; ++n) acc[a][b][m][n] = (f32x4){0.f, 0.f, 0.f, 0.f};
    f16x8 At[4][2], B0[2][2], B1[2][2];
    const char* cA = cur.a; const char* cB = cur.b;
    if constexpr (SP2) {
        PG8_STAGE(PG8_SB(0, 0), cB, voffB); PG8_STAGE(PG8_SB(0, 1), cB + hstepB, voffB); PG8_STAGE(PG8_SA(0, 0), cA, cv0); PG8_STAGE(PG8_SA(0, 1), cA, cv1);
        if (wr == 1) PG8_BAR;
        PG8_WAIT_V(2); PG8_BAR;
        PG8_STAGE(PG8_SB(1, 0), cB + kstep, voffB); PG8_STAGE(PG8_SA(1, 0), cA + kstep, cv0); PG8_STAGE(PG8_SB(1, 1), cB + hstepB + kstep, voffB);
        PG8_WAIT_V(6); PG8_BAR;
    } else {
        PG8_STAGE(PG8_SB(0, 0), cB, voffB); PG8_STAGE(PG8_SA(0, 0), cA, cv0); PG8_STAGE(PG8_SB(0, 1), cB + hstepB, voffB); PG8_STAGE(PG8_SA(0, 1), cA, cv1);
        if (wr == 1) PG8_BAR;
        PG8_WAIT_V(4); PG8_BAR;
        PG8_STAGE(PG8_SB(1, 0), cB + kstep, voffB); PG8_STAGE(PG8_SA(1, 0), cA + kstep, cv0); PG8_STAGE(PG8_SB(1, 1), cB + hstepB + kstep, voffB);
        PG8_WAIT_V(6); PG8_BAR;
    }
    for (;;) {
        const bool has_next = S.next(ui + 1, nxt);
        if (has_next) {
#pragma unroll
            for (int i = 0; i < 2; ++i) { nv0[i] = S.a_voff(nxt, 0, Rr[i], Cc[i]); nv1[i] = S.a_voff(nxt, 1, Rr[i], Cc[i]); }
        } else {
            nxt = cur;
#pragma unroll
            for (int i = 0; i < 2; ++i) { nv0[i] = cv0[i]; nv1[i] = cv1[i]; }
        }
        const char* nA = nxt.a; const char* nB = nxt.b;
        for (int t = 0; t < nt; t += 2) {
            const bool last = (t == nt - 2);
            const char* a1 = cA + (size_t)(t + 1) * kstep;
            const char* a2 = last ? nA : cA + (size_t)(t + 2) * kstep; const char* b2 = last ? nB : cB + (size_t)(t + 2) * kstep;
            const char* a3 = a2 + kstep; const char* b3 = b2 + kstep;
            unsigned v0[2], v1[2];
#pragma unroll
            for (int i = 0; i < 2; ++i) { v0[i] = last ? nv0[i] : cv0[i]; v1[i] = last ? nv1[i] : cv1[i]; }
            if constexpr (SP2) {
            PG8_LDB(B0, 0, 0); PG8_LDB(B1, 0, 1); PG8_SCHED; PG8_LDA(At, 0, 0); PG8_STAGE(PG8_SA(1, 1), a1, cv1);
            PG8_WAIT_V(8); PG8_WAIT_L(0); PG8_BAR; PG8_MMA(0, 0, At, B0); PG8_MMA(0, 1, At, B1); PG8_BAR; PG8_SCHED;
            PG8_LDA(At, 0, 1); PG8_STAGE(PG8_SB(0, 0), b2, voffB); PG8_STAGE(PG8_SB(0, 1), b2 + hstepB, voffB); PG8_STAGE(PG8_SA(0, 0), a2, v0);
            PG8_WAIT_V(8); PG8_WAIT_L(0); PG8_BAR; PG8_MMA(1, 0, At, B0); PG8_MMA(1, 1, At, B1); PG8_BAR; PG8_SCHED;
            PG8_LDB(B0, 1, 0); PG8_LDB(B1, 1, 1); PG8_SCHED; PG8_LDA(At, 1, 0); PG8_STAGE(PG8_SA(0, 1), a2, v1);
            PG8_WAIT_V(8); PG8_WAIT_L(0); PG8_BAR; PG8_MMA(0, 0, At, B0); PG8_MMA(0, 1, At, B1); PG8_BAR; PG8_SCHED;
            PG8_LDA(At, 1, 1); PG8_STAGE(PG8_SB(1, 0), b3, voffB); PG8_STAGE(PG8_SB(1, 1), b3 + hstepB, voffB); PG8_STAGE(PG8_SA(1, 0), a3, v0);
            PG8_WAIT_V(8); PG8_WAIT_L(0); PG8_BAR; PG8_MMA(1, 0, At, B0); PG8_MMA(1, 1, At, B1); PG8_BAR; PG8_SCHED;
            } else {
            PG8_LDB(B0, 0, 0); PG8_SCHED; PG8_LDA(At, 0, 0); PG8_STAGE(PG8_SA(1, 1), a1, cv1);
            PG8_WAIT_L(8); PG8_BAR; PG8_WAIT_L(0); PG8_MMA(0, 0, At, B0); PG8_BAR; PG8_SCHED;
            PG8_LDB(B1, 0, 1); PG8_STAGE(PG8_SB(0, 0), b2, voffB);
            PG8_BAR; PG8_WAIT_L(0); PG8_MMA(0, 1, At, B1); PG8_BAR;
            PG8_LDA(At, 0, 1); PG8_STAGE(PG8_SA(0, 0), a2, v0);
            PG8_BAR; PG8_WAIT_L(0); PG8_MMA(1, 0, At, B0); PG8_BAR; PG8_SCHED;
            PG8_STAGE(PG8_SB(0, 1), b2 + hstepB, voffB);
            PG8_WAIT_V(6); PG8_BAR; PG8_MMA(1, 1, At, B1); PG8_BAR;
            PG8_LDB(B0, 1, 0); PG8_SCHED; PG8_LDA(At, 1, 0); PG8_STAGE(PG8_SA(0, 1), a2, v1);
            PG8_WAIT_L(8); PG8_BAR; PG8_WAIT_L(0); PG8_MMA(0, 0, At, B0); PG8_BAR; PG8_SCHED;
            PG8_LDB(B1, 1, 1); PG8_STAGE(PG8_SB(1, 0), b3, voffB);
            PG8_BAR; PG8_WAIT_L(0); PG8_MMA(0, 1, At, B1); PG8_BAR;
            PG8_LDA(At, 1, 1); PG8_STAGE(PG8_SA(1, 0), a3, v0);
            PG8_BAR; PG8_WAIT_L(0); PG8_MMA(1, 0, At, B0); PG8_BAR; PG8_SCHED;
            PG8_STAGE(PG8_SB(1, 1), b3 + hstepB, voffB);
            PG8_WAIT_V(6); PG8_BAR; PG8_MMA(1, 1, At, B1); PG8_BAR;
            }
        }
        if constexpr (ALIGN_EPI) { if (wr == 0) PG8_BAR; }
        E(acc, cur, wr, wc, fr, fq);
        if (!has_next) break;
#pragma unroll
        for (int a = 0; a < 2; ++a)
#pragma unroll
            for (int b = 0; b < 2; ++b)
#pragma unroll
                for (int m = 0; m < 4; ++m)
#pragma unroll
                    for (int n = 0; n < 2; ++n) acc[a][b][m][n] = (f32x4){0.f, 0.f, 0.f, 0.f};
        cur = nxt; cA = nA; cB = nB; ++ui;
#pragma unroll
        for (int i = 0; i < 2; ++i) { cv0[i] = nv0[i]; cv1[i] = nv1[i]; }
        if constexpr (ALIGN_EPI) { if (wr == 1) PG8_BAR; }
    }
    PG8_WAIT_V(0);
    if constexpr (!ALIGN_EPI) { if (wr == 0) PG8_BAR; }
    PG8_BAR;
#undef PG8_SA
#undef PG8_SB
#undef PG8_STAGE
#undef PG8_LDA
#undef PG8_LDB
#undef PG8_MMA
#undef PG8_WAIT_V
#undef PG8_WAIT_L
#undef PG8_BAR
#undef PG8_SCHED
}

struct DenseOrder {
    const char* A; const char* Bt; int lda_b, K, nM, nN, nwg, G, c;
    __device__ __forceinline__ void init(const void* A_, int lda_elems, const void* Bt_, int M, int N, int K_) { A = (const char*)A_; Bt = (const char*)Bt_; lda_b = lda_elems * 2; K = K_; nM = M / BM; nN = N / BM; nwg = nM * nN; G = gridDim.x; c = blockIdx.x; }
    __device__ __forceinline__ bool next(int i, Unit& u) const {
        const long L = (long)i * G + c; if (L >= nwg) return false;
        int wgid = (int)L; { const int q = nwg / NXCD, r = nwg % NXCD, xcd = wgid % NXCD, off = wgid / NXCD; wgid = (xcd < r ? xcd * (q + 1) : r * (q + 1) + (xcd - r) * q) + off; }
        const int nig = WGM * nN, gid = wgid / nig, fm = gid * WGM, gsz = (nM - fm) < WGM ? (nM - fm) : WGM;
        u.pm = fm + ((wgid % nig) % gsz); u.pn = (wgid % nig) / gsz; u.e = 0; u.cnt = 0; u.hbase = 0;
        u.a = A + (size_t)u.pm * BM * lda_b; u.b = Bt + (size_t)u.pn * BM * K * 2;
        return true;
    }
    __device__ __forceinline__ unsigned a_voff(const Unit&, int h, int R, int C) const { return (unsigned)((h * HALF + R) * lda_b + C * 2); }
};
struct GroupOrder {
    const char* A; const char* Bt; int lda_b, K, nM, nN, ng, G, c; size_t gsA, gsB;
    __device__ __forceinline__ void init(const void* A_, int lda_elems, size_t gsA_elems, const void* Bt_, size_t gsB_elems, int ng_, int M, int N, int K_) {
        A = (const char*)A_; Bt = (const char*)Bt_; lda_b = lda_elems * 2; K = K_; nM = M / BM; nN = N / BM; ng = ng_; gsA = gsA_elems * 2; gsB = gsB_elems * 2; G = gridDim.x; c = blockIdx.x; }
    __device__ __forceinline__ bool next(int i, Unit& u) const {
        const long L = (long)i * G + c; if (L >= (long)ng * nM * nN) return false;
        const int per = nM * nN, g = (int)L / per, r = (int)L % per;
        u.e = g; u.pm = r / nN; u.pn = r % nN; u.cnt = 0; u.hbase = 0;
        u.a = A + (size_t)g * gsA + (size_t)u.pm * BM * lda_b; u.b = Bt + (size_t)g * gsB + (size_t)u.pn * BM * K * 2;
        return true;
    }
    __device__ __forceinline__ unsigned a_voff(const Unit&, int h, int R, int C) const { return (unsigned)((h * HALF + R) * lda_b + C * 2); }
};
struct MoeOrder {
    const int* cnt; const int* list; const char* A; const char* Bt; int lda_b, K, nN, G, c; size_t esB; bool gather;
    __device__ __forceinline__ void init(const int* cnt_, const int* list_, const void* A_, int lda_elems, const void* Bt_, size_t esB_elems, int N, int K_, bool gather_) {
        cnt = cnt_; list = list_; A = (const char*)A_; Bt = (const char*)Bt_; lda_b = lda_elems * 2; K = K_; nN = N / BM; esB = esB_elems * 2; gather = gather_; G = gridDim.x; c = blockIdx.x; }
    __device__ __forceinline__ bool next(int i, Unit& u) const {
        int nwg = 0;
        for (int e = 0; e < 32; ++e) nwg += ((cnt[e] + BM - 1) / BM) * nN;
        const long L = (long)i * G + c; if (L >= nwg) return false;
        int wgid = (int)L; { const int q = nwg / NXCD, r = nwg % NXCD, xcd = wgid % NXCD, off = wgid / NXCD; wgid = (xcd < r ? xcd * (q + 1) : r * (q + 1) + (xcd - r) * q) + off; }
        int base = 0, hb = 0;
        for (int e = 0; e < 32; ++e) {
            const int ce = cnt[e], ntl = (ce + BM - 1) / BM, span = ntl * nN;
            if (wgid < base + span) {
                const int loc = wgid - base;
                u.e = e; u.pm = loc % ntl; u.pn = loc / ntl; u.cnt = ce; u.hbase = hb;
                u.a = gather ? A : A + (size_t)(hb + u.pm * BM) * lda_b;
                u.b = Bt + (size_t)e * esB + (size_t)u.pn * BM * K * 2;
                return true;
            }
            base += span; hb += ntl * BM;
        }
        return false;
    }
    __device__ __forceinline__ unsigned a_voff(const Unit& u, int h, int R, int C) const {
        if (!gather) return (unsigned)((h * HALF + R) * lda_b + C * 2);
        const int li = u.pm * BM + h * HALF + R;
        const int tok = (li < u.cnt) ? (list[(size_t)u.e * CAP + li] >> 1) : 0;
        return (unsigned)(tok * lda_b + C * 2);
    }
};
}
constexpr bool G_ALIGN = true, G_SP2 = true;

__device__ __forceinline__ void phase_prep(const P& p) {
  const int gtid = blockIdx.x * NTHR + tidx(), gsz = gridDim.x * NTHR;
  int* cnt = (int*)(p.ws + WS_CNT);
  if (gtid < 64) cnt[gtid] = 0;
  f32x2* rope = (f32x2*)(p.ws + WS_ROPE);
  for (int i = gtid; i < SEQ * 64; i += gsz) {
    const int pos = i >> 6, f = i & 63;
    const float inv = powf(10000.0f, -(float)(2 * f) / 128.0f);
    const float ang = (float)pos * inv;
    float s, c; sincosf(ang, &s, &c);
    rope[i] = (f32x2){c, s};
  }
  u16* wr16 = (u16*)(p.ws + WS_WR16);
  for (int i = gtid; i < 2 * 48 * DM; i += gsz) {
    const int k = i & (DM - 1), n = (i >> 10) % 48, layer = i / (48 * DM);
    float w = 0.f;
    if (n < 4) w = p.w_group[((size_t)layer * DM + k) * 4 + n];
    else if (n < 36) { const int gg = (n - 4) >> 3, j = (n - 4) & 7; w = p.w_er[(((size_t)layer * 4 + gg) * DM + k) * 8 + j]; }
    w *= p.norm_ffn_g[layer * DM + k];
    const u16 hi = f2h(w), lo = f2h(w - h2f(hi));
    wr16[((size_t)(layer * 2 + 0) * 48 + n) * DM + k] = hi;
    wr16[((size_t)(layer * 2 + 1) * 48 + n) * DM + k] = lo;
  }
}

template <class RowFn>
__device__ __forceinline__ void conv_item(const float* W, int ldw, int K, u16* WT, float* scr, int k0, int n0, int lane, RowFn rowfn) {
#pragma unroll 8
  for (int i = 0; i < 32; ++i) { const int kk = 2 * i + (lane >> 5); scr[kk * 33 + (lane & 31)] = W[(size_t)(k0 + kk) * ldw + n0 + (lane & 31)]; }
  LDS_WAIT();
  const int c = lane & 7;
#pragma unroll
  for (int j = 0; j < 4; ++j) {
    const int n = (lane >> 3) + 8 * j; const float* sp = scr + (8 * c) * 33 + n;
    uint4 o; o.x = pk2(sp[0 * 33], sp[1 * 33]); o.y = pk2(sp[2 * 33], sp[3 * 33]); o.z = pk2(sp[4 * 33], sp[5 * 33]); o.w = pk2(sp[6 * 33], sp[7 * 33]);
    *(uint4*)(WT + (size_t)rowfn(n0 + n) * K + k0 + 8 * c) = o;
  }
  LDS_WAIT();
}
template <class RowFn>
__device__ __forceinline__ int conv_matrix(const float* W, int ldw, int K, int N, u16* WT, char* smem, int item_base, RowFn rowfn) {
  const int lane = tidx() & 63, wv = tidx() >> 6, gw = blockIdx.x * NWAVE + wv, nw = gridDim.x * NWAVE;
  float* scr = (float*)smem + wv * (64 * 33);
  const int nkb = K / 64, nnb = N / 32, nitems = nkb * nnb;
  int it = gw - (item_base % nw); if (it < 0) it += nw;
  for (; it < nitems; it += nw) conv_item(W, ldw, K, WT, scr, (it / nnb) * 64, (it % nnb) * 32, lane, rowfn);
  return nitems;
}
__device__ __forceinline__ void phase_conv_dense(const P& p, char* smem) {
  auto id = [](int n) { return n; };
  int base = 0;
  base += conv_matrix(p.w_in, 2560, DM, 2560, (u16*)(p.ws + WS_WIN), smem, base, id);
  base += conv_matrix(p.w_glu, 512, 512, 512, (u16*)(p.ws + WS_WGLU), smem, base, id);
  base += conv_matrix(p.w_out, DM, DM, DM, (u16*)(p.ws + WS_WOUT), smem, base, id);
  base += conv_matrix(p.w_qkv, 1536, DM, 1536, (u16*)(p.ws + WS_WQKV), smem, base, id);
  base += conv_matrix(p.w_o, DM, DM, DM, (u16*)(p.ws + WS_WO), smem, base, id);
}
__device__ __forceinline__ void phase_conv_moe(const P& p, int layer, char* smem) {
  const int lane = tidx() & 63, wv = tidx() >> 6, gw = blockIdx.x * NWAVE + wv, nw = gridDim.x * NWAVE;
  float* scr = (float*)smem + wv * (64 * 33);
  u16* w1t = (u16*)(p.ws + WS_MW); u16* w2t = (u16*)(p.ws + WS_MW + 64 * MB);
  for (int it = gw; it < 32 * 768; it += nw) {
    const int e = it / 768, r = it % 768;
    if (r < 512) {
      const int which = r >> 8, q = r & 255, k0 = (q >> 4) * 64, n0 = (q & 15) * 32;
      const float* W = (which ? p.w_up : p.w_gate) + (size_t)(layer * 32 + e) * DM * 512;
      conv_item(W, 512, DM, w1t + (size_t)e * DM * DM, scr, k0, n0, lane, [which](int n) { return (n >> 4) * 32 + which * 16 + (n & 15); });
    } else {
      const int q = r - 512, k0 = (q >> 5) * 64, n0 = (q & 31) * 32;
      const float* W = p.w_down + (size_t)(layer * 32 + e) * 512 * DM;
      conv_item(W, DM, 512, w2t + (size_t)e * DM * 512, scr, k0, n0, lane, [](int n) { return n; });
    }
  }
}

__device__ __forceinline__ void phase_rowpass(const P& p, const float* src, const u16* slots, float* dstx, const float* gain, int route_layer, float* fout, char* smem) {
  const int lane = tidx() & 63, wv = tidx() >> 6, fr = lane & 15, lg = lane >> 4;
  u16* xb = (u16*)(p.ws + WS_XB);
  int* cnt = (int*)(p.ws + WS_CNT);
  int* list = (int*)(p.ws + WS_LIST);
  float* gate = (float*)(p.ws + WS_GATE);
  float* sRs = (float*)smem;
  float* sLg = (float*)smem + 64;
  for (int st = blockIdx.x; st < T_TOK / 64; st += gridDim.x) {
    const int row0 = st * 64 + wv * 8;
#pragma unroll 1
    for (int rp = 0; rp < 4; ++rp) {
      f32x4 v[2][4];
#pragma unroll
      for (int q = 0; q < 2; ++q) {
        const int row = row0 + rp * 2 + q;
#pragma unroll
        for (int i = 0; i < 4; ++i) v[q][i] = *(const f32x4*)(src + (size_t)row * DM + (i * 64 + lane) * 4);
      }
      if (slots) {
#pragma unroll
        for (int q = 0; q < 2; ++q) {
          const int row = row0 + rp * 2 + q;
          uint2 w[2][4];
#pragma unroll
          for (int sl = 0; sl < 2; ++sl)
#pragma unroll
            for (int i = 0; i < 4; ++i) w[sl][i] = *(const uint2*)(slots + ((size_t)row * 2 + sl) * DM + (i * 64 + lane) * 4);
#pragma unroll
          for (int sl = 0; sl < 2; ++sl)
#pragma unroll
            for (int i = 0; i < 4; ++i) { v[q][i][0] += lo16(w[sl][i].x); v[q][i][1] += hi16(w[sl][i].x); v[q][i][2] += lo16(w[sl][i].y); v[q][i][3] += hi16(w[sl][i].y); }
        }
      }
#pragma unroll
      for (int q = 0; q < 2; ++q) {
        const int row = row0 + rp * 2 + q;
        float ss = 0.f;
#pragma unroll
        for (int i = 0; i < 4; ++i) {
          if (dstx) *(f32x4*)(dstx + (size_t)row * DM + (i * 64 + lane) * 4) = v[q][i];
          ss += v[q][i][0] * v[q][i][0] + v[q][i][1] * v[q][i][1] + v[q][i][2] * v[q][i][2] + v[q][i][3] * v[q][i][3];
        }
        ss = wave_sum(ss);
        const float rstd = rsqrtf(ss * (1.0f / DM) + 1e-6f);
        if (route_layer >= 0 && lane == 0) sRs[wv * 8 + rp * 2 + q] = rstd;
#pragma unroll
        for (int i = 0; i < 4; ++i) {
          const int k = (i * 64 + lane) * 4;
          const f32x4 gv = *(const f32x4*)(gain + k);
          const f32x4 hv = v[q][i] * rstd * gv;
          if (fout) *(f32x4*)(fout + (size_t)row * DM + k) = hv;
          else { uint2 w; w.x = pk2(hv[0], hv[1]); w.y = pk2(hv[2], hv[3]); *(uint2*)(xb + (size_t)row * DM + k) = w; }
        }
      }
    }
    if (route_layer >= 0) {
      __syncthreads();
      const int tl = wv & 3, kh = wv >> 2;
      const float rsv = sRs[tl * 16 + fr];
      const float* xrow = src + (size_t)(st * 64 + tl * 16 + fr) * DM + kh * 512 + lg * 8;
      const u16* whi = (const u16*)(p.ws + WS_WR16) + ((size_t)(route_layer * 2 + 0) * 48 + fr) * DM + kh * 512 + lg * 8;
      const u16* wlo = (const u16*)(p.ws + WS_WR16) + ((size_t)(route_layer * 2 + 1) * 48 + fr) * DM + kh * 512 + lg * 8;
      f32x4 acc[3];
#pragma unroll
      for (int nb = 0; nb < 3; ++nb) acc[nb] = (f32x4){0.f, 0.f, 0.f, 0.f};
#pragma unroll 4
      for (int ks = 0; ks < 16; ++ks) {
        const f32x4 x0 = *(const f32x4*)(xrow + ks * 32), x1 = *(const f32x4*)(xrow + ks * 32 + 4);
        const float hv[8] = {x0[0] * rsv, x0[1] * rsv, x0[2] * rsv, x0[3] * rsv, x1[0] * rsv, x1[1] * rsv, x1[2] * rsv, x1[3] * rsv};
        unsigned ah[4], al[4];
#pragma unroll
        for (int j = 0; j < 4; ++j) {
          const u16 h0 = f2h(hv[2 * j]), h1 = f2h(hv[2 * j + 1]);
          ah[j] = (unsigned)h0 | ((unsigned)h1 << 16);
          al[j] = pk2(hv[2 * j] - h2f(h0), hv[2 * j + 1] - h2f(h1));
        }
        const uint4 ahi = make_uint4(ah[0], ah[1], ah[2], ah[3]), alo = make_uint4(al[0], al[1], al[2], al[3]);
#pragma unroll
        for (int nb = 0; nb < 3; ++nb) {
          const uint4 bh = *(const uint4*)(whi + (size_t)nb * 16 * DM + ks * 32), bl = *(const uint4*)(wlo + (size_t)nb * 16 * DM + ks * 32);
          acc[nb] = mfma16(bh, ahi, acc[nb]); acc[nb] = mfma16(bh, alo, acc[nb]); acc[nb] = mfma16(bl, ahi, acc[nb]);
        }
      }
      float* lgw = sLg + ((kh * 4 + tl) * 16 + fr) * 49;
#pragma unroll
      for (int nb = 0; nb < 3; ++nb)
#pragma unroll
        for (int r = 0; r < 4; ++r) lgw[nb * 16 + 4 * lg + r] = acc[nb][r];
      __syncthreads();
      if (wv < 4 && lane < 16) {
        const int row = st * 64 + wv * 16 + lane;
        const float* l0 = sLg + ((0 * 4 + wv) * 16 + lane) * 49;
        const float* l1 = sLg + ((1 * 4 + wv) * 16 + lane) * 49;
        const float* bg = p.b_group + route_layer * 4;
        const float* be = p.b_er + route_layer * 32;
        float gl[4];
#pragma unroll
        for (int j = 0; j < 4; ++j) gl[j] = l0[j] + l1[j] + bg[j];
        int gs = 0; float gm = gl[0];
#pragma unroll
        for (int j = 1; j < 4; ++j) if (gl[j] > gm) { gm = gl[j]; gs = j; }
        float den = 0.f;
#pragma unroll
        for (int j = 0; j < 4; ++j) den += expf(gl[j] - gm);
        const float pg = 1.0f / den;
        float el[8];
#pragma unroll
        for (int j = 0; j < 8; ++j) el[j] = l0[4 + gs * 8 + j] + l1[4 + gs * 8 + j] + be[gs * 8 + j];
        int i1 = 0; float v1 = el[0];
#pragma unroll
        for (int j = 1; j < 8; ++j) if (el[j] > v1) { v1 = el[j]; i1 = j; }
        int i2 = -1; float v2 = -3.0e38f;
#pragma unroll
        for (int j = 0; j < 8; ++j) if (j != i1 && el[j] > v2) { v2 = el[j]; i2 = j; }
        const float e2 = expf(v2 - v1);
        const float g1 = pg / (1.0f + e2), g2 = pg * e2 / (1.0f + e2);
        const int ex1 = gs * 8 + i1, ex2 = gs * 8 + i2;
        const int r1 = atomicAdd(&cnt[route_layer * 32 + ex1], 1);
        list[(size_t)ex1 * CAP + r1] = row * 2;
        gate[row * 2] = g1;
        const int r2 = atomicAdd(&cnt[route_layer * 32 + ex2], 1);
        list[(size_t)ex2 * CAP + r2] = row * 2 + 1;
        gate[row * 2 + 1] = g2;
      }
      __syncthreads();
    }
  }
}

constexpr int RSTR = 136;
__device__ __forceinline__ void ret_load_tile(u16* dst, const u16* src, int t0, int h, int mode  , const f32x2* rope) {
  const int pos0 = t0 & (SEQ - 1);
  for (int idx = tidx(); idx < 128 * 64; idx += NTHR) {
    const int i = idx >> 6, d = idx & 63;
    float t1 = h2f(src[(size_t)(t0 + i) * 512 + h * 128 + d]), t2 = h2f(src[(size_t)(t0 + i) * 512 + h * 128 + d + 64]);
    if (mode) {
      const f32x2 cs = rope[(pos0 + i) * 64 + d];
      const float o1 = t1 * cs[0] - t2 * cs[1], o2 = t1 * cs[1] + t2 * cs[0];
      t1 = o1; t2 = o2;
      if (mode == 2) { t1 *= 0.08838834764831845f; t2 *= 0.08838834764831845f; }
    }
    dst[i * RSTR + d] = f2h(t1); dst[i * RSTR + d + 64] = f2h(t2);
  }
}
__device__ __forceinline__ float log_sigmoid(float x) { return -log1pf(expf(-x)); }

template <int MB_, int NB_>
__device__ __forceinline__ void lds_mma(f32x4 (&acc)[MB_][NB_], const u16* sA, int sa, int a0, const u16* sB, int sb, int b0, int K, int lane, const float* sc) {
  const int fr = lane & 15, fq = lane >> 4;
  for (int k0 = 0; k0 < K; k0 += 32) {
    uint4 fa[MB_], fb[NB_];
#pragma unroll
    for (int m = 0; m < MB_; ++m) {
      fa[m] = *(const uint4*)(sA + (a0 + m * 16 + fr) * sa + k0 + fq * 8);
      if (sc) {
        const float f = sc[m];
        fa[m].x = pk2(lo16(fa[m].x) * f, hi16(fa[m].x) * f); fa[m].y = pk2(lo16(fa[m].y) * f, hi16(fa[m].y) * f);
        fa[m].z = pk2(lo16(fa[m].z) * f, hi16(fa[m].z) * f); fa[m].w = pk2(lo16(fa[m].w) * f, hi16(fa[m].w) * f);
      }
    }
#pragma unroll
    for (int n = 0; n < NB_; ++n) fb[n] = *(const uint4*)(sB + (b0 + n * 16 + fr) * sb + k0 + fq * 8);
#pragma unroll
    for (int m = 0; m < MB_; ++m)
#pragma unroll
      for (int n = 0; n < NB_; ++n) acc[m][n] = mfma16(fb[n], fa[m], acc[m][n]);
  }
}
__device__ __forceinline__ void ret_stage_T(u16* dst0, u16* dst1, const u16* src, int t0, int h, int mode, const f32x2* rope, const float* w0, const float* w1) {
  const int pos0 = t0 & (SEQ - 1);
  for (int idx = tidx(); idx < 32 * 64; idx += NTHR) {
    const int ii = idx >> 6, d = idx & 63;
    float a1[4], a2[4];
#pragma unroll
    for (int r = 0; r < 4; ++r) {
      const int i = 4 * ii + r;
      float t1 = h2f(src[(size_t)(t0 + i) * 512 + h * 128 + d]), t2 = h2f(src[(size_t)(t0 + i) * 512 + h * 128 + d + 64]);
      if (mode) {
        const f32x2 cs = rope[(pos0 + i) * 64 + d];
        const float o1 = t1 * cs[0] - t2 * cs[1], o2 = t1 * cs[1] + t2 * cs[0];
        t1 = o1; t2 = o2;
        if (mode == 2) { t1 *= 0.08838834764831845f; t2 *= 0.08838834764831845f; }
      }
      a1[r] = t1; a2[r] = t2;
    }
    if (w0) {
      const f32x4 wa = *(const f32x4*)(w0 + 4 * ii), wb = *(const f32x4*)(w1 + 4 * ii);
      uint2 o;
      o.x = pk2(a1[0] * wa[0], a1[1] * wa[1]); o.y = pk2(a1[2] * wa[2], a1[3] * wa[3]); *(uint2*)(dst0 + d * RSTR + 4 * ii) = o;
      o.x = pk2(a2[0] * wa[0], a2[1] * wa[1]); o.y = pk2(a2[2] * wa[2], a2[3] * wa[3]); *(uint2*)(dst0 + (d + 64) * RSTR + 4 * ii) = o;
      o.x = pk2(a1[0] * wb[0], a1[1] * wb[1]); o.y = pk2(a1[2] * wb[2], a1[3] * wb[3]); *(uint2*)(dst1 + d * RSTR + 4 * ii) = o;
      o.x = pk2(a2[0] * wb[0], a2[1] * wb[1]); o.y = pk2(a2[2] * wb[2], a2[3] * wb[3]); *(uint2*)(dst1 + (d + 64) * RSTR + 4 * ii) = o;
    } else {
      uint2 o;
      o.x = pk2(a1[0], a1[1]); o.y = pk2(a1[2], a1[3]); *(uint2*)(dst0 + d * RSTR + 4 * ii) = o;
      o.x = pk2(a2[0], a2[1]); o.y = pk2(a2[2], a2[3]); *(uint2*)(dst0 + (d + 64) * RSTR + 4 * ii) = o;
    }
  }
}
__device__ __forceinline__ void phase_ret_inc_mfma(const P& p, char* smem) {
  u16* sKf = (u16*)smem; u16* sKb = sKf + 128 * RSTR; u16* sVT = sKb + 128 * RSTR; float* sWf = (float*)(sVT + 128 * RSTR); float* sWb = sWf + 128;
  const u16* kb = (const u16*)(p.ws + WS_Z) + (size_t)1 * T_TOK * 512; const u16* vb = (const u16*)(p.ws + WS_Z) + (size_t)2 * T_TOK * 512;
  const f32x2* rope = (const f32x2*)(p.ws + WS_ROPE);
  float* incf = (float*)(p.ws + WS_INC); float* incb = incf + (size_t)512 * 16384;
  const int tid = tidx(), lane = tid & 63, wv = tid >> 6, wr = wv >> 1, wc = wv & 1, fr = lane & 15, fq = lane >> 4;
  for (int item = blockIdx.x; item < 512; item += gridDim.x) {
    const int h = item & 3, bn = item >> 2, t0 = bn * 128;
    const float lgf = log_sigmoid(p.ret_decay[h]), lgb = log_sigmoid(p.ret_decay[4 + h]);
    __syncthreads();
    if (tid < 128) { sWf[tid] = expf(lgf * (float)(127 - tid)); sWb[tid] = expf(lgb * (float)tid); }
    __syncthreads();
    ret_stage_T(sKf, sKb, kb, t0, h, 2, rope, sWf, sWb);
    ret_stage_T(sVT, nullptr, vb, t0, h, 0, rope, nullptr, nullptr);
    __syncthreads();
#pragma unroll
    for (int dirn = 0; dirn < 2; ++dirn) {
      f32x4 acc[2][4];
#pragma unroll
      for (int m = 0; m < 2; ++m)
#pragma unroll
        for (int n = 0; n < 4; ++n) acc[m][n] = (f32x4){0.f, 0.f, 0.f, 0.f};
      lds_mma<2, 4>(acc, sVT, RSTR, wr * 32, dirn ? sKb : sKf, RSTR, wc * 64, 128, lane, nullptr);
      float* o = (dirn ? incb : incf) + (size_t)item * 16384;
#pragma unroll
      for (int m = 0; m < 2; ++m)
#pragma unroll
        for (int n = 0; n < 4; ++n) *(f32x4*)(o + (wr * 32 + m * 16 + fr) * 128 + wc * 64 + n * 16 + 4 * fq) = acc[m][n];
    }
  }
}
__device__ __forceinline__ void phase_ret_scan16(const P& p) {
  const float* incf = (const float*)(p.ws + WS_INC); const float* incb = incf + (size_t)512 * 16384;
  u16* spf = (u16*)(p.ws + WS_SP16); u16* spb = spf + (size_t)512 * 16384;
  const int gtid = blockIdx.x * NTHR + tidx(), gsz = gridDim.x * NTHR;
  for (int idx = gtid; idx < 32 * 4096; idx += gsz) {
    const int de = (idx & 4095) * 4, bh = idx >> 12, b = bh >> 2, h = bh & 3;
    const float Gf = expf(128.0f * log_sigmoid(p.ret_decay[h])), Gb = expf(128.0f * log_sigmoid(p.ret_decay[4 + h]));
    f32x4 s = {0.f, 0.f, 0.f, 0.f};
    for (int n = 0; n < 16; ++n) {
      const size_t o = ((size_t)((b * 16 + n) * 4 + h)) * 16384 + de;
      const f32x4 t = *(const f32x4*)(incf + o);
      uint2 w; w.x = pk2(s[0], s[1]); w.y = pk2(s[2], s[3]); *(uint2*)(spf + o) = w;
      s = s * Gf + t;
    }
    s = (f32x4){0.f, 0.f, 0.f, 0.f};
    for (int n = 15; n >= 0; --n) {
      const size_t o = ((size_t)((b * 16 + n) * 4 + h)) * 16384 + de;
      const f32x4 t = *(const f32x4*)(incb + o);
      uint2 w; w.x = pk2(s[0], s[1]); w.y = pk2(s[2], s[3]); *(uint2*)(spb + o) = w;
      s = s * Gb + t;
    }
  }
}
__device__ __forceinline__ void phase_ret_out_mfma(const P& p, char* smem) {
  u16* R0 = (u16*)smem; u16* R1 = R0 + 128 * RSTR; u16* R2 = R1 + 128 * RSTR; u16* R3 = R2 + 128 * RSTR;
  float* sPf = (float*)(R3 + 128 * RSTR); float* sPb = sPf + 132;
  const u16* zb = (const u16*)(p.ws + WS_Z);
  const u16* qb = zb; const u16* kb = zb + (size_t)1 * T_TOK * 512; const u16* vb = zb + (size_t)2 * T_TOK * 512; const u16* gb = zb + (size_t)3 * T_TOK * 512;
  const f32x2* rope = (const f32x2*)(p.ws + WS_ROPE);
  const u16* spf = (const u16*)(p.ws + WS_SP16); const u16* spb = spf + (size_t)512 * 16384;
  u16* ycat = (u16*)(p.ws + WS_YCAT);
  const int tid = tidx(), lane = tid & 63, wv = tid >> 6, wr = wv >> 1, wc = wv & 1, fr = lane & 15, fq = lane >> 4;
  for (int item = blockIdx.x; item < 512; item += gridDim.x) {
    const int h = item & 3, bn = item >> 2, t0 = bn * 128;
    const float lgf = log_sigmoid(p.ret_decay[h]), lgb = log_sigmoid(p.ret_decay[4 + h]);
    __syncthreads();
    ret_load_tile(R0, qb, t0, h, 1, rope);
    ret_load_tile(R1, kb, t0, h, 2, rope);
    ret_stage_T(R2, nullptr, vb, t0, h, 0, rope, nullptr, nullptr);
    if (tid < 129) { sPf[tid] = expf(lgf * (float)tid); sPb[tid] = expf(lgb * (float)tid); }
    __syncthreads();
    {
      f32x4 acc[2][4];
#pragma unroll
      for (int m = 0; m < 2; ++m)
#pragma unroll
        for (int n = 0; n < 4; ++n) acc[m][n] = (f32x4){0.f, 0.f, 0.f, 0.f};
      lds_mma<2, 4>(acc, R0, RSTR, wr * 32, R1, RSTR, wc * 64, 128, lane, nullptr);
#pragma unroll
      for (int m = 0; m < 2; ++m)
#pragma unroll
        for (int n = 0; n < 4; ++n) {
          const int i = wr * 32 + m * 16 + fr, j = wc * 64 + n * 16 + 4 * fq;
          float v[4];
#pragma unroll
          for (int r = 0; r < 4; ++r) { const int jj = j + r; v[r] = acc[m][n][r] * ((i >= jj) ? sPf[i - jj] : sPb[jj - i]); }
          uint2 w; w.x = pk2(v[0], v[1]); w.y = pk2(v[2], v[3]);
          *(uint2*)(R3 + i * RSTR + j) = w;
        }
    }
    __syncthreads();
    const u16* spT = spf + (size_t)item * 16384; const u16* snT = spb + (size_t)item * 16384;
    for (int c = tid; c < 128 * 16; c += NTHR) { const int e = c >> 4, ch = (c & 15) * 8; *(uint4*)(R1 + e * RSTR + ch) = *(const uint4*)(spT + e * 128 + ch); }
    f32x4 o[1][8];
#pragma unroll
    for (int m = 0; m < 1; ++m)
#pragma unroll
      for (int n = 0; n < 8; ++n) o[m][n] = (f32x4){0.f, 0.f, 0.f, 0.f};
    lds_mma<1, 8>(o, R3, RSTR, wv * 16, R2, RSTR, 0, 128, lane, nullptr);
    __syncthreads();
    for (int c = tid; c < 128 * 16; c += NTHR) { const int e = c >> 4, ch = (c & 15) * 8; *(uint4*)(R2 + e * RSTR + ch) = *(const uint4*)(snT + e * 128 + ch); }
    float scf[1], scb[1];
    { const int i = wv * 16 + fr; scf[0] = sPf[i + 1]; scb[0] = sPb[128 - i]; }
    lds_mma<1, 8>(o, R0, RSTR, wv * 16, R1, RSTR, 0, 128, lane, scf);
    __syncthreads();
    lds_mma<1, 8>(o, R0, RSTR, wv * 16, R2, RSTR, 0, 128, lane, scb);
#pragma unroll
    for (int m = 0; m < 1; ++m) {
      float s1 = 0.f;
#pragma unroll
      for (int n = 0; n < 8; ++n) s1 += (o[m][n][0] + o[m][n][1]) + (o[m][n][2] + o[m][n][3]);
      s1 += __shfl_xor(s1, 16); s1 += __shfl_xor(s1, 32);
      const float mu = s1 * (1.0f / 128.0f);
      float s2 = 0.f;
#pragma unroll
      for (int n = 0; n < 8; ++n)
#pragma unroll
        for (int r = 0; r < 4; ++r) { const float dl = o[m][n][r] - mu; s2 += dl * dl; }
      s2 += __shfl_xor(s2, 16); s2 += __shfl_xor(s2, 32);
      const float rs = rsqrtf(s2 * (1.0f / 128.0f) + 1e-5f);
      const size_t tok = (size_t)(t0 + wv * 16 + m * 16 + fr);
#pragma unroll
      for (int n = 0; n < 8; ++n) {
        const int e = n * 16 + 4 * fq;
        const uint2 gq = *(const uint2*)(gb + tok * 512 + h * 128 + e);
        const float g0 = lo16(gq.x), g1 = hi16(gq.x), g2 = lo16(gq.y), g3 = hi16(gq.y);
        uint2 w;
        w.x = pk2(g0 * sigmoidf_(g0) * (o[m][n][0] - mu) * rs, g1 * sigmoidf_(g1) * (o[m][n][1] - mu) * rs);
        w.y = pk2(g2 * sigmoidf_(g2) * (o[m][n][2] - mu) * rs, g3 * sigmoidf_(g3) * (o[m][n][3] - mu) * rs);
        *(uint2*)(ycat + tok * DM + h * 128 + e) = w;
      }
    }
  }
}

struct Cpx { float re, im; };
__device__ __forceinline__ Cpx cmul(Cpx a, Cpx b) { return {a.re * b.re - a.im * b.im, a.re * b.im + a.im * b.re}; }
__device__ __forceinline__ Cpx s5_lam_pow(float ar, float ai, float dt, float e) {
  const float mag = expf(ar * dt * e); float sn, cs; sincosf(ai * dt * e, &sn, &cs); return {mag * cs, mag * sn};
}
__device__ __forceinline__ Cpx s5_coef(float ar, float ai, float dt) {
  float sn, cs; sincosf(ai * dt, &sn, &cs);
  const float em1 = expm1f(ar * dt), sh = sinf(0.5f * ai * dt);
  const float nr = em1 * cs - 2.0f * sh * sh, ni = (em1 + 1.0f) * sn, den = ar * ar + ai * ai;
  return {(nr * ar + ni * ai) / den, (ni * ar - nr * ai) / den};
}
__device__ __forceinline__ void phase_s5_ktab(const P& p) {
  float* ktab = (float*)(p.ws + WS_KTAB);
  const int gtid = blockIdx.x * NTHR + tidx(), gsz = gridDim.x * NTHR;
  for (int item = gtid; item < 32 * 2 * 32 * 16; item += gsz) {
    const int c = item & 15, l = (item >> 4) & 31, dir = (item >> 9) & 1, g = item >> 10;
    const float dt = expf(p.log_step[dir * 32 + g]);
    float acc[16];
#pragma unroll
    for (int j = 0; j < 16; ++j) acc[j] = 0.f;
    for (int q = 0; q < 64; ++q) {
      const float ar = p.a_re[(dir * 32 + g) * 64 + q], ai = p.a_im[(dir * 32 + g) * 64 + q];
      const Cpx L = s5_lam_pow(ar, ai, dt, (float)l), cf = s5_coef(ar, ai, dt);
      const Cpx C = {p.c_re[((dir * 32 + g) * 16 + c) * 64 + q], p.c_im[((dir * 32 + g) * 16 + c) * 64 + q]};
      const Cpx w = cmul(cmul(C, L), cf);
#pragma unroll
      for (int j = 0; j < 16; ++j) acc[j] += w.re * p.b_re[(g * 64 + q) * 16 + j] - w.im * p.b_im[(g * 64 + q) * 16 + j];
    }
#pragma unroll
    for (int j = 0; j < 16; j += 4) *(f32x4*)(ktab + (size_t)item * 16 + j) = (f32x4){acc[j], acc[j + 1], acc[j + 2], acc[j + 3]};
  }
}
__device__ __forceinline__ void phase_s5_fill(const P& p) {
  const float* ktab = (const float*)(p.ws + WS_KTAB);
  u16* bty = (u16*)(p.ws + WS_BTY); u16* wet = (u16*)(p.ws + WS_WET);
  const int gtid = blockIdx.x * NTHR + tidx(), gsz = gridDim.x * NTHR;
  for (int item = gtid; item < 32 * 512 * 64; item += gsz) {
    const int ch = item & 63, n = (item >> 6) & 511, g = item >> 15;
    const int ip = ch >> 1, c0 = (ch & 1) * 8, i = n >> 4, c = n & 15;
    float v[8];
    if (ip != i) {
      const int dir = ip < i ? 0 : 1, l = ip < i ? i - ip : ip - i;
      const float* src = ktab + ((size_t)((g * 2 + dir) * 32 + l) * 16 + c) * 16 + c0;
      const f32x4 a = *(const f32x4*)src, b = *(const f32x4*)(src + 4);
      v[0] = a[0]; v[1] = a[1]; v[2] = a[2]; v[3] = a[3]; v[4] = b[0]; v[5] = b[1]; v[6] = b[2]; v[7] = b[3];
    } else {
      const float* s0 = ktab + ((size_t)((g * 2 + 0) * 32) * 16 + c) * 16 + c0;
      const float* s1 = ktab + ((size_t)((g * 2 + 1) * 32) * 16 + c) * 16 + c0;
      const float dd = p.s5d[g * 16 + c];
#pragma unroll
      for (int j = 0; j < 8; ++j) v[j] = s0[j] + s1[j] + ((c0 + j) == c ? dd : 0.f);
    }
    *(uint4*)(bty + ((size_t)g * 512 + n) * 768 + ch * 8) = make_uint4(pk2(v[0], v[1]), pk2(v[2], v[3]), pk2(v[4], v[5]), pk2(v[6], v[7]));
  }
  for (int item = gtid; item < 32 * 512 * 32; item += gsz) {
    const int ch = item & 31, n = (item >> 5) & 511, g = item >> 14;
    const int kk = ch * 8, dir = kk >> 7, p0 = (kk & 127) >> 1, i = n >> 4, c = n & 15;
    const float dt = expf(p.log_step[dir * 32 + g]), e = dir ? (float)(32 - i) : (float)(i + 1);
    float v[8];
#pragma unroll
    for (int q = 0; q < 4; ++q) {
      const int pq = p0 + q;
      const float ar = p.a_re[(dir * 32 + g) * 64 + pq], ai = p.a_im[(dir * 32 + g) * 64 + pq];
      const Cpx L = s5_lam_pow(ar, ai, dt, e);
      const Cpx C = {p.c_re[((dir * 32 + g) * 16 + c) * 64 + pq], p.c_im[((dir * 32 + g) * 16 + c) * 64 + pq]};
      const Cpx w = cmul(C, L);
      v[2 * q] = w.re; v[2 * q + 1] = -w.im;
    }
    *(uint4*)(bty + ((size_t)g * 512 + n) * 768 + 512 + kk) = make_uint4(pk2(v[0], v[1]), pk2(v[2], v[3]), pk2(v[4], v[5]), pk2(v[6], v[7]));
  }
  for (int item = gtid; item < 32 * 256 * 64; item += gsz) {
    const int ch = item & 63, n = (item >> 6) & 255, g = item >> 14;
    const int ip = ch >> 1, c0 = (ch & 1) * 8, ri = n & 1, pq = (n >> 1) & 63, dir = n >> 7;
    const float dt = expf(p.log_step[dir * 32 + g]), e = dir ? (float)ip : (float)(31 - ip);
    const float ar = p.a_re[(dir * 32 + g) * 64 + pq], ai = p.a_im[(dir * 32 + g) * 64 + pq];
    const Cpx w = cmul(s5_lam_pow(ar, ai, dt, e), s5_coef(ar, ai, dt));
    float v[8];
#pragma unroll
    for (int j = 0; j < 8; ++j) {
      const float br = p.b_re[(g * 64 + pq) * 16 + c0 + j], bi = p.b_im[(g * 64 + pq) * 16 + c0 + j];
      v[j] = ri ? (w.re * bi + w.im * br) : (w.re * br - w.im * bi);
    }
    *(uint4*)(wet + ((size_t)g * 256 + n) * 512 + ch * 8) = make_uint4(pk2(v[0], v[1]), pk2(v[2], v[3]), pk2(v[4], v[5]), pk2(v[6], v[7]));
  }
}
__device__ __forceinline__ void phase_s5_carry(const P& p) {
  const float* E = (const float*)(p.ws + WS_E);
  u16* a2 = (u16*)(p.ws + WS_A2);
  const int gtid = blockIdx.x * NTHR + tidx(), gsz = gridDim.x * NTHR;
  for (int idx = gtid; idx < 32 * 8 * 128; idx += gsz) {
    const int pq = idx & 63, dir = (idx >> 6) & 1, b = (idx >> 7) & 7, g = idx >> 10;
    const float dt = expf(p.log_step[dir * 32 + g]);
    const Cpx L = s5_lam_pow(p.a_re[(dir * 32 + g) * 64 + pq], p.a_im[(dir * 32 + g) * 64 + pq], dt, 32.0f);
    Cpx s = {0.f, 0.f};
    for (int jj = 0; jj < 64; ++jj) {
      const int j = dir ? 63 - jj : jj, r = b * 64 + j;
      const f32x2 e = *(const f32x2*)(E + ((size_t)g * 512 + r) * 256 + (dir * 64 + pq) * 2);
      *(unsigned*)(a2 + ((size_t)g * 512 + r) * 768 + 512 + (dir * 64 + pq) * 2) = pk2(s.re, s.im);
      const Cpx ns = cmul(L, s);
      s.re = ns.re + e[0]; s.im = ns.im + e[1];
    }
  }
}
constexpr int KSTR = 72;
__device__ __forceinline__ int t5_bucket_abs(int n) {
  return n < 8 ? n : 8 + (n >= 12) + (n >= 16) + (n >= 23) + (n >= 32) + (n >= 46) + (n >= 64) + (n >= 91);
}
constexpr int VSTR = 392;
__device__ __forceinline__ void phase_attn(const P& p, char* smem) {
  u16* sK = (u16*)smem; u16* sVt = sK + 384 * KSTR; float* sBias = (float*)(sVt + 64 * VSTR);
  const u16* q1 = (const u16*)(p.ws + WS_Z); const u16* k1 = (const u16*)(p.ws + WS_Z + 32 * MB); const u16* v1 = (const u16*)(p.ws + WS_Z + 40 * MB);
  u16* ao = (u16*)(p.ws + WS_YCAT);
  const int tid = tidx(), lane = tid & 63, wv = tid >> 6, fr = lane & 15, lg = lane >> 4, q0 = wv * 16;
  for (int item = blockIdx.x; item < 512; item += gridDim.x) {
    const int b = item >> 6, nb = (item >> 2) & 15, kvh = item & 3;
    __syncthreads();
    for (int c = tid; c < 384 * 8; c += NTHR) {
      const int s = c >> 3, ch = (c & 7) * 8, pos = (nb - 1) * 128 + s;
      uint4 kq = make_uint4(0u, 0u, 0u, 0u), vq = kq;
      if (pos >= 0 && pos < SEQ) { kq = *(const uint4*)(k1 + (size_t)(b * SEQ + pos) * 256 + kvh * 64 + ch); vq = *(const uint4*)(v1 + (size_t)(b * SEQ + pos) * 256 + kvh * 64 + ch); }
      *(uint4*)(sK + s * KSTR + ch) = kq;
      const unsigned vw[4] = {vq.x, vq.y, vq.z, vq.w};
#pragma unroll
      for (int j = 0; j < 4; ++j) { sVt[(ch + 2 * j) * VSTR + s] = (u16)(vw[j] & 0xffffu); sVt[(ch + 2 * j + 1) * VSTR + s] = (u16)(vw[j] >> 16); }
    }
    for (int c = tid; c < 4 * 257; c += NTHR) {
      const int hq = c / 257, ri = c % 257, rel = ri - 128, n = rel < 0 ? -rel : rel;
      const int bucket = (rel > 0 ? 16 : 0) + t5_bucket_abs(n);
      sBias[hq * 260 + ri] = p.rel_bias[bucket * 16 + kvh * 4 + hq];
    }
    __syncthreads();
    for (int hq = 0; hq < 4; ++hq) {
      const int head = kvh * 4 + hq;
      const size_t tok0 = (size_t)b * SEQ + nb * 128 + q0;
      uint4 qf[1][2];
#pragma unroll
      for (int qb = 0; qb < 1; ++qb)
#pragma unroll
        for (int ks = 0; ks < 2; ++ks) qf[qb][ks] = *(const uint4*)(q1 + (tok0 + qb * 16 + fr) * DM + head * 64 + ks * 32 + lg * 8);
      f32x4 O[4][1];
#pragma unroll
      for (int mb = 0; mb < 4; ++mb)
#pragma unroll
        for (int qb = 0; qb < 1; ++qb) O[mb][qb] = (f32x4){0.f, 0.f, 0.f, 0.f};
      const float sinkv = p.sink[head];
      float mrun[1] = {sinkv}, lpart[1] = {lg == 0 ? 1.0f : 0.0f};
#pragma unroll
      for (int c = 0; c < 3; ++c) {
        if ((c == 0 && nb == 0) || (c == 2 && nb == 15)) continue;
        f32x4 S[8][1];
#pragma unroll
        for (int kb = 0; kb < 8; ++kb) {
          S[kb][0] = (f32x4){0.f, 0.f, 0.f, 0.f};
          const bool act = (c == 0) ? (16 * kb + 15 >= q0) : ((c == 2) ? (16 * kb <= q0 + 15) : true);
          if (act) {
#pragma unroll
            for (int ks = 0; ks < 2; ++ks) {
              const uint4 kf = *(const uint4*)(sK + (c * 128 + kb * 16 + fr) * KSTR + ks * 32 + lg * 8);
              S[kb][0] = mfma16(kf, qf[0][ks], S[kb][0]);
            }
          }
        }
        float cmax[1] = {-1e30f};
#pragma unroll
        for (int kb = 0; kb < 8; ++kb)
#pragma unroll
          for (int qb = 0; qb < 1; ++qb)
#pragma unroll
            for (int r = 0; r < 4; ++r) {
              const int sidx = c * 128 + kb * 16 + 4 * lg + r, qi = q0 + qb * 16 + fr, rel = sidx - 128 - qi;
              const bool valid = (rel >= -128) && (rel <= 128);
              const float v = valid ? S[kb][qb][r] + sBias[hq * 260 + (valid ? rel + 128 : 0)] : -1e30f;
              S[kb][qb][r] = v; cmax[qb] = fmaxf(cmax[qb], v);
            }
#pragma unroll
        for (int qb = 0; qb < 1; ++qb) {
          cmax[qb] = fmaxf(cmax[qb], __shfl_xor(cmax[qb], 16)); cmax[qb] = fmaxf(cmax[qb], __shfl_xor(cmax[qb], 32));
          const float mn = fmaxf(mrun[qb], cmax[qb]), alpha = __expf(mrun[qb] - mn);
          mrun[qb] = mn; lpart[qb] *= alpha;
#pragma unroll
          for (int mb = 0; mb < 4; ++mb) O[mb][qb] = O[mb][qb] * alpha;
          float ps = 0.f;
#pragma unroll
          for (int kb = 0; kb < 8; ++kb)
#pragma unroll
            for (int r = 0; r < 4; ++r) { const float e = __expf(S[kb][qb][r] - mn); S[kb][qb][r] = e; ps += e; }
          lpart[qb] += ps;
        }
#pragma unroll
        for (int kk = 0; kk < 4; ++kk) {
          const int kb0 = 2 * kk, kb1 = 2 * kk + 1;
          const bool act = (c == 0) ? (16 * kb1 + 15 >= q0) : ((c == 2) ? (16 * kb0 <= q0 + 15) : true);
          if (act) {
            uint4 pf[1];
#pragma unroll
            for (int qb = 0; qb < 1; ++qb) pf[qb] = make_uint4(pk2(S[kb0][qb][0], S[kb0][qb][1]), pk2(S[kb0][qb][2], S[kb0][qb][3]), pk2(S[kb1][qb][0], S[kb1][qb][1]), pk2(S[kb1][qb][2], S[kb1][qb][3]));
#pragma unroll
            for (int mb = 0; mb < 4; ++mb) {
              const uint2 v0 = *(const uint2*)(sVt + (mb * 16 + fr) * VSTR + c * 128 + kb0 * 16 + 4 * lg);
              const uint2 v1r = *(const uint2*)(sVt + (mb * 16 + fr) * VSTR + c * 128 + kb1 * 16 + 4 * lg);
              const uint4 vf = make_uint4(v0.x, v0.y, v1r.x, v1r.y);
              O[mb][0] = mfma16(vf, pf[0], O[mb][0]);
            }
          }
        }
      }
#pragma unroll
      for (int qb = 0; qb < 1; ++qb) {
        float lt = lpart[qb]; lt += __shfl_xor(lt, 16); lt += __shfl_xor(lt, 32);
        const float inv = 1.0f / lt;
#pragma unroll
        for (int mb = 0; mb < 4; ++mb) {
          uint2 w; w.x = pk2(O[mb][qb][0] * inv, O[mb][qb][1] * inv); w.y = pk2(O[mb][qb][2] * inv, O[mb][qb][3] * inv);
          *(uint2*)(ao + (tok0 + qb * 16 + fr) * DM + head * 64 + mb * 16 + 4 * lg) = w;
        }
      }
    }
  }
}

struct EpiInproj {
  u16* zb; u16* a2;
  __device__ __forceinline__ void operator()(const f32x4 (&acc)[2][2][4][2], const pg8::Unit& u, int wr, int wc, int fr, int fq) const {
    const int seg = u.pn >> 1;
#pragma unroll
    for (int ai = 0; ai < 2; ++ai)
#pragma unroll
      for (int m = 0; m < 4; ++m) {
        const int row = u.pm * 256 + ai * 128 + wr * 64 + m * 16 + fr;
#pragma unroll
        for (int bj = 0; bj < 2; ++bj)
#pragma unroll
          for (int n = 0; n < 2; ++n) {
            const int col = u.pn * 256 + bj * 128 + wc * 32 + n * 16 + 4 * fq;
            const f32x4 v = acc[ai][bj][m][n];
            uint2 w; w.x = pk2(v[0], v[1]); w.y = pk2(v[2], v[3]);
            if (seg < 4) *(uint2*)(zb + (size_t)seg * T_TOK * 512 + (size_t)row * 512 + (col - seg * 512)) = w;
            else { const int ch = col - 2048, gi = ch >> 4, c = ch & 15; *(uint2*)(a2 + ((size_t)gi * 512 + (row >> 5)) * 768 + (row & 31) * 16 + c) = w; }
          }
      }
  }
};
__device__ __forceinline__ void phase_inproj(const P& p, LAS unsigned char* lds) {
  pg8::DenseOrder S; S.init(p.ws + WS_XB, DM, p.ws + WS_WIN, T_TOK, 2560, DM);
  EpiInproj E{(u16*)(p.ws + WS_Z), (u16*)(p.ws + WS_A2)};
  pg8::gemm_phase<EpiInproj, pg8::DenseOrder, G_ALIGN, G_SP2>(lds, DM, S, E);
}
struct EpiS5E {
  float* E_;
  __device__ __forceinline__ void operator()(const f32x4 (&acc)[2][2][4][2], const pg8::Unit& u, int wr, int wc, int fr, int fq) const {
#pragma unroll
    for (int ai = 0; ai < 2; ++ai)
#pragma unroll
      for (int m = 0; m < 4; ++m) {
        const int row = u.pm * 256 + ai * 128 + wr * 64 + m * 16 + fr;
#pragma unroll
        for (int bj = 0; bj < 2; ++bj)
#pragma unroll
          for (int n = 0; n < 2; ++n) *(f32x4*)(E_ + ((size_t)u.e * 512 + row) * 256 + bj * 128 + wc * 32 + n * 16 + 4 * fq) = acc[ai][bj][m][n];
      }
  }
};
__device__ __forceinline__ void phase_s5_egemm(const P& p, LAS unsigned char* lds) {
  pg8::GroupOrder S; S.init(p.ws + WS_A2, 768, (size_t)512 * 768, p.ws + WS_WET, (size_t)256 * 512, 32, 512, 256, 512);
  EpiS5E E{(float*)(p.ws + WS_E)};
  pg8::gemm_phase<EpiS5E, pg8::GroupOrder, G_ALIGN, G_SP2>(lds, 512, S, E);
}
struct EpiS5Y {
  u16* yg;
  __device__ __forceinline__ void operator()(const f32x4 (&acc)[2][2][4][2], const pg8::Unit& u, int wr, int wc, int fr, int fq) const {
#pragma unroll
    for (int ai = 0; ai < 2; ++ai)
#pragma unroll
      for (int m = 0; m < 4; ++m) {
        const int row = u.pm * 256 + ai * 128 + wr * 64 + m * 16 + fr;
#pragma unroll
        for (int bj = 0; bj < 2; ++bj)
#pragma unroll
          for (int n = 0; n < 2; ++n) {
            const int col = u.pn * 256 + bj * 128 + wc * 32 + n * 16 + 4 * fq;
            const f32x4 v = acc[ai][bj][m][n];
            uint2 w; w.x = pk2(gelu_tanh(v[0]), gelu_tanh(v[1])); w.y = pk2(gelu_tanh(v[2]), gelu_tanh(v[3]));
            *(uint2*)(yg + ((size_t)row * 32 + (col >> 4)) * 512 + u.e * 16 + (col & 15)) = w;
          }
      }
  }
};
__device__ __forceinline__ void phase_s5_ygemm(const P& p, LAS unsigned char* lds) {
  pg8::GroupOrder S; S.init(p.ws + WS_A2, 768, (size_t)512 * 768, p.ws + WS_BTY, (size_t)512 * 768, 32, 512, 512, 768);
  EpiS5Y E{(u16*)(p.ws + WS_YGELU)};
  pg8::gemm_phase<EpiS5Y, pg8::GroupOrder, G_ALIGN, G_SP2>(lds, 768, S, E);
}
struct EpiGlu {
  const u16* yg; const float* bglu; u16* ycat;
  __device__ __forceinline__ void operator()(const f32x4 (&acc)[2][2][4][2], const pg8::Unit& u, int wr, int wc, int fr, int fq) const {
#pragma unroll
    for (int ai = 0; ai < 2; ++ai)
#pragma unroll
      for (int m = 0; m < 4; ++m) {
        const int row = u.pm * 256 + ai * 128 + wr * 64 + m * 16 + fr;
#pragma unroll
        for (int bj = 0; bj < 2; ++bj)
#pragma unroll
          for (int n = 0; n < 2; ++n) {
            const int col = u.pn * 256 + bj * 128 + wc * 32 + n * 16 + 4 * fq;
            const f32x4 v = acc[ai][bj][m][n];
            const uint2 yv = *(const uint2*)(yg + (size_t)row * 512 + col);
            const f32x4 bb = *(const f32x4*)(bglu + col);
            uint2 w;
            w.x = pk2(lo16(yv.x) * sigmoidf_(v[0] + bb[0]), hi16(yv.x) * sigmoidf_(v[1] + bb[1]));
            w.y = pk2(lo16(yv.y) * sigmoidf_(v[2] + bb[2]), hi16(yv.y) * sigmoidf_(v[3] + bb[3]));
            *(uint2*)(ycat + (size_t)row * DM + 512 + col) = w;
          }
      }
  }
};
__device__ __forceinline__ void phase_glu(const P& p, LAS unsigned char* lds) {
  pg8::DenseOrder S; S.init(p.ws + WS_YGELU, 512, p.ws + WS_WGLU, T_TOK, 512, 512);
  EpiGlu E{(const u16*)(p.ws + WS_YGELU), p.b_glu, (u16*)(p.ws + WS_YCAT)};
  pg8::gemm_phase<EpiGlu, pg8::DenseOrder, G_ALIGN, G_SP2>(lds, 512, S, E);
}
struct EpiResid {
  const float* xin; float* xout;
  __device__ __forceinline__ void operator()(const f32x4 (&acc)[2][2][4][2], const pg8::Unit& u, int wr, int wc, int fr, int fq) const {
#pragma unroll
    for (int ai = 0; ai < 2; ++ai)
#pragma unroll
      for (int m = 0; m < 4; ++m) {
        const int row = u.pm * 256 + ai * 128 + wr * 64 + m * 16 + fr;
#pragma unroll
        for (int bj = 0; bj < 2; ++bj)
#pragma unroll
          for (int n = 0; n < 2; ++n) {
            const size_t o = (size_t)row * DM + u.pn * 256 + bj * 128 + wc * 32 + n * 16 + 4 * fq;
            const f32x4 xv = *(const f32x4*)(xin + o);
            *(f32x4*)(xout + o) = xv + acc[ai][bj][m][n];
          }
      }
  }
};
__device__ __forceinline__ void phase_outproj(const P& p, const void* Wt, const float* xin, float* xout, LAS unsigned char* lds) {
  pg8::DenseOrder S; S.init(p.ws + WS_YCAT, DM, Wt, T_TOK, DM, DM);
  EpiResid E{xin, xout};
  pg8::gemm_phase<EpiResid, pg8::DenseOrder, G_ALIGN, G_SP2>(lds, DM, S, E);
}
struct EpiQkv {
  u16 *q1, *k1, *v1;
  __device__ __forceinline__ void operator()(const f32x4 (&acc)[2][2][4][2], const pg8::Unit& u, int wr, int wc, int fr, int fq) const {
#pragma unroll
    for (int ai = 0; ai < 2; ++ai)
#pragma unroll
      for (int m = 0; m < 4; ++m) {
        const int row = u.pm * 256 + ai * 128 + wr * 64 + m * 16 + fr;
#pragma unroll
        for (int bj = 0; bj < 2; ++bj)
#pragma unroll
          for (int n = 0; n < 2; ++n) {
            const int col = u.pn * 256 + bj * 128 + wc * 32 + n * 16 + 4 * fq;
            const f32x4 v = acc[ai][bj][m][n];
            uint2 w;
            if (u.pn < 4) { w.x = pk2(v[0] * 0.125f, v[1] * 0.125f); w.y = pk2(v[2] * 0.125f, v[3] * 0.125f); *(uint2*)(q1 + (size_t)row * DM + col) = w; }
            else {
              w.x = pk2(v[0], v[1]); w.y = pk2(v[2], v[3]);
              if (u.pn == 4) *(uint2*)(k1 + (size_t)row * 256 + (col - 1024)) = w; else *(uint2*)(v1 + (size_t)row * 256 + (col - 1280)) = w;
            }
          }
      }
  }
};
__device__ __forceinline__ void phase_qkv(const P& p, LAS unsigned char* lds) {
  pg8::DenseOrder S; S.init(p.ws + WS_XB, DM, p.ws + WS_WQKV, T_TOK, 1536, DM);
  EpiQkv E{(u16*)(p.ws + WS_Z), (u16*)(p.ws + WS_Z + 32 * MB), (u16*)(p.ws + WS_Z + 40 * MB)};
  pg8::gemm_phase<EpiQkv, pg8::DenseOrder, G_ALIGN, G_SP2>(lds, DM, S, E);
}
struct EpiMoe1 {
  u16* hbuf;
  __device__ __forceinline__ void operator()(const f32x4 (&acc)[2][2][4][2], const pg8::Unit& u, int wr, int wc, int fr, int fq) const {
#pragma unroll
    for (int ai = 0; ai < 2; ++ai)
#pragma unroll
      for (int m = 0; m < 4; ++m) {
        const int row = u.pm * 256 + ai * 128 + wr * 64 + m * 16 + fr;
        if (row < u.cnt) {
#pragma unroll
          for (int bj = 0; bj < 2; ++bj) {
            const f32x4 g = acc[ai][bj][m][0], up = acc[ai][bj][m][1];
            uint2 w; w.x = pk2(g[0] * sigmoidf_(g[0]) * up[0], g[1] * sigmoidf_(g[1]) * up[1]); w.y = pk2(g[2] * sigmoidf_(g[2]) * up[2], g[3] * sigmoidf_(g[3]) * up[3]);
            *(uint2*)(hbuf + (size_t)(u.hbase + row) * 512 + 16 * (8 * u.pn + 4 * bj + wc) + 4 * fq) = w;
          }
        }
      }
  }
};
__device__ __forceinline__ void phase_moe1(const P& p, int layer, LAS unsigned char* lds) {
  pg8::MoeOrder S; S.init((const int*)(p.ws + WS_CNT) + layer * 32, (const int*)(p.ws + WS_LIST), p.ws + WS_XB, DM, p.ws + WS_MW, (size_t)DM * DM, DM, DM, true);
  EpiMoe1 E{(u16*)(p.ws + WS_H)};
  pg8::gemm_phase<EpiMoe1, pg8::MoeOrder, G_ALIGN, G_SP2>(lds, DM, S, E);
}
struct EpiMoe2 {
  const int* list; const float* gate; u16* slots;
  __device__ __forceinline__ void operator()(const f32x4 (&acc)[2][2][4][2], const pg8::Unit& u, int wr, int wc, int fr, int fq) const {
#pragma unroll
    for (int ai = 0; ai < 2; ++ai)
#pragma unroll
      for (int m = 0; m < 4; ++m) {
        const int row = u.pm * 256 + ai * 128 + wr * 64 + m * 16 + fr;
        if (row < u.cnt) {
          const int asg = list[(size_t)u.e * CAP + row];
          const float gt = gate[asg];
#pragma unroll
          for (int bj = 0; bj < 2; ++bj)
#pragma unroll
            for (int n = 0; n < 2; ++n) {
              const f32x4 v = acc[ai][bj][m][n];
              uint2 w; w.x = pk2(gt * v[0], gt * v[1]); w.y = pk2(gt * v[2], gt * v[3]);
              *(uint2*)(slots + (size_t)asg * DM + u.pn * 256 + bj * 128 + wc * 32 + n * 16 + 4 * fq) = w;
            }
        }
      }
  }
};
__device__ __forceinline__ void phase_moe2(const P& p, int layer, LAS unsigned char* lds) {
  pg8::MoeOrder S; S.init((const int*)(p.ws + WS_CNT) + layer * 32, (const int*)(p.ws + WS_LIST), p.ws + WS_H, 512, p.ws + WS_MW + 64 * MB, (size_t)DM * 512, DM, 512, false);
  EpiMoe2 E{(const int*)(p.ws + WS_LIST), (const float*)(p.ws + WS_GATE), (u16*)(p.ws + WS_INC)};
  pg8::gemm_phase<EpiMoe2, pg8::MoeOrder, G_ALIGN, G_SP2>(lds, 512, S, E);
}

#define XB_TMO      128
#define XB_XCNT(j)  (256  + 64 * (j))
#define XB_XSUB(j)  (1280 + 64 * (j))
#define XB_XGEN(j)  (2304 + 64 * (j))
#define XB_TOP      3328
#define XB_TOPGEN   3392
#define XCD_BAR_WORDS 3456
#define XB_SPIN_CAP (1u << 22)
__device__ __forceinline__ unsigned xb_ld(unsigned* p)              { return __hip_atomic_load(p, __ATOMIC_RELAXED, __HIP_MEMORY_SCOPE_AGENT); }
__device__ __forceinline__ unsigned xb_add(unsigned* p, unsigned v) { return __hip_atomic_fetch_add(p, v, __ATOMIC_RELAXED, __HIP_MEMORY_SCOPE_AGENT); }
__device__ __forceinline__ unsigned xb_xcc_id() { return (unsigned)__builtin_amdgcn_s_getreg((3 << 11) | 20) & 0xFu; }
#define XB_SPIN(cond, bar) do { unsigned _sp = 0; while (cond) { __builtin_amdgcn_s_sleep(1); \
    if ((++_sp & 255u) == 0u) { if (xb_ld(&(bar)[XB_TMO])) break; if (_sp > XB_SPIN_CAP) { atomicAdd(&(bar)[XB_TMO], 1u); break; } } } } while (0)
struct XcdBarrier { unsigned* bar; unsigned x; volatile LAS unsigned* st; };
__device__ __forceinline__ XcdBarrier xcd_barrier_post(unsigned* bar, volatile LAS unsigned* st) {
  XcdBarrier b; b.bar = bar; b.x = xb_xcc_id(); b.st = st;
  if (tidx() == 0) (void)xb_add(&bar[XB_XCNT(b.x)], 1u);
  return b;
}
__device__ __forceinline__ void xcd_barrier_complete(unsigned* bar, unsigned x, unsigned& nloc, unsigned& nx) {
  const unsigned G = gridDim.x * gridDim.y * gridDim.z;
  unsigned sum, cnt, mine, sp = 0u;
  for (;;) {
    sum = 0u; cnt = 0u; mine = 0u;
#pragma unroll
    for (unsigned j = 0; j < 16; ++j) { const unsigned c = xb_ld(&bar[XB_XCNT(j)]); sum += c; cnt += (c > 0u) ? 1u : 0u; mine = (j == x) ? c : mine; }
    if (sum == G) break;
    __builtin_amdgcn_s_sleep(1);
    if ((++sp & 255u) == 0u) { if (xb_ld(&bar[XB_TMO])) break; if (sp > XB_SPIN_CAP) { atomicAdd(&bar[XB_TMO], 1u); break; } }
  }
  nloc = mine > 0u ? mine : 1u; nx = cnt > 0u ? cnt : 1u;
}
__device__ __forceinline__ void xcd_barrier(const XcdBarrier& b) {
  asm volatile("s_waitcnt vmcnt(0)" ::: "memory");
  __syncthreads();
  if (tidx() == 0) {
    unsigned* bar = b.bar;
    __builtin_amdgcn_s_waitcnt(0);
    unsigned nloc = b.st[0], nx = b.st[1];
    if (nloc == 0u) { xcd_barrier_complete(bar, b.x, nloc, nx); b.st[0] = nloc; b.st[1] = nx; }
    const unsigned old = xb_add(&bar[XB_XSUB(b.x)], 1u);
    const unsigned gen = old / nloc;
    if (old + 1u == (gen + 1u) * nloc) {
      __builtin_amdgcn_fence(__ATOMIC_RELEASE, "agent");
      asm volatile("s_waitcnt vmcnt(0)" ::: "memory");
      const unsigned og = xb_add(&bar[XB_TOP], 1u);
      const unsigned tg = og / nx;
      if (og + 1u == (tg + 1u) * nx) xb_add(&bar[XB_TOPGEN], 1u);
      else XB_SPIN(xb_ld(&bar[XB_TOPGEN]) == tg, bar);
      __builtin_amdgcn_fence(__ATOMIC_ACQUIRE, "agent");
      xb_add(&bar[XB_XGEN(b.x)], 1u);
      asm volatile("s_waitcnt vmcnt(0)" ::: "memory");
    } else {
      XB_SPIN(xb_ld(&bar[XB_XGEN(b.x)]) == gen, bar);
      __builtin_amdgcn_fence(__ATOMIC_ACQUIRE, "agent");
      asm volatile("s_waitcnt vmcnt(0)" ::: "memory");
    }
  }
  __syncthreads();
}

constexpr int NPHASE = 18;
constexpr int LDS_BYTES = 147456;
__device__ __forceinline__ void run_phase(const P& p, int ph, char* smem, LAS unsigned char* lds) {
  float* xa = (float*)(p.ws + WS_XA);
  const u16* slots = (const u16*)(p.ws + WS_INC);
  switch (ph) {
    case 0: phase_rowpass(p, p.x, nullptr, nullptr, p.norm_mix_g, -1, nullptr, smem); phase_prep(p); phase_s5_ktab(p); __syncthreads(); phase_conv_dense(p, smem); break;
    case 1: phase_inproj(p, lds); phase_s5_fill(p); break;
    case 2: phase_ret_inc_mfma(p, smem); __syncthreads(); phase_s5_egemm(p, lds); break;
    case 3: phase_ret_scan16(p); phase_s5_carry(p); break;
    case 4: phase_ret_out_mfma(p, smem); __syncthreads(); phase_s5_ygemm(p, lds); break;
    case 5: phase_glu(p, lds); break;
    case 6: phase_outproj(p, p.ws + WS_WOUT, p.x, xa, lds); break;
    case 7: phase_rowpass(p, xa, nullptr, nullptr, p.norm_ffn_g, 0, nullptr, smem); __syncthreads(); phase_conv_moe(p, 0, smem); break;
    case 8: phase_moe1(p, 0, lds); break;
    case 9: phase_moe2(p, 0, lds); break;
    case 10: phase_rowpass(p, xa, slots, xa, p.norm_mix_g + DM, -1, nullptr, smem); break;
    case 11: phase_qkv(p, lds); break;
    case 12: phase_attn(p, smem); break;
    case 13: phase_outproj(p, p.ws + WS_WO, xa, xa, lds); break;
    case 14: phase_rowpass(p, xa, nullptr, nullptr, p.norm_ffn_g + DM, 1, nullptr, smem); __syncthreads(); phase_conv_moe(p, 1, smem); break;
    case 15: phase_moe1(p, 1, lds); break;
    case 16: phase_moe2(p, 1, lds); break;
    case 17: phase_rowpass(p, xa, slots, nullptr, p.norm_final_g, -1, p.out, smem); break;
    default: break;
  }
}

extern __shared__ __attribute__((aligned(16))) char dyn_smem[];

template <int PH> __device__ __forceinline__ void mega_steps(const P& p, char* smem, LAS unsigned char* lds, cg::grid_group& grid, const XcdBarrier& xb) {
  run_phase(p, PH, smem, lds);
  if constexpr (PH + 1 < NPHASE) {
    if constexpr (PH == 0) grid.sync(); else xcd_barrier(xb);
    mega_steps<PH + 1>(p, smem, lds, grid, xb);
  }
}
__global__ void __launch_bounds__(NTHR, 2) k_mega(P p) {
  cg::grid_group grid = cg::this_grid();
  LAS unsigned char* lds = (LAS unsigned char*)dyn_smem;
  volatile LAS unsigned* st = (volatile LAS unsigned*)(lds + LDS_BYTES - 16);
  if (tidx() == 0) { st[0] = 0u; st[1] = 0u; }
  __syncthreads();
  const XcdBarrier xb = xcd_barrier_post((unsigned*)(p.ws + WS_BAR), st);
  mega_steps<0>(p, dyn_smem, lds, grid, xb);
}

extern "C" void kernel_launch(void* const* d_in, const int* in_sizes, int n_in, void* d_out, int out_size, void* d_ws, size_t ws_size, hipStream_t stream) {
  static int grid_blocks = 0;
  if (grid_blocks == 0) {
    if (n_in != 28 || out_size != T_TOK * DM || ws_size < WS_END) { fprintf(stderr, "kernel_launch: unexpected problem (n_in %d out %d ws %zu need %zu)\n", n_in, out_size, ws_size, (size_t)WS_END); grid_blocks = -1; return; }
    int dev = 0, cus = 0, per_cu = 0;
    (void)hipGetDevice(&dev);
    (void)hipDeviceGetAttribute(&cus, hipDeviceAttributeMultiprocessorCount, dev);
    const void* fn = (const void*)k_mega;
    if (hipFuncSetAttribute(fn, hipFuncAttributeMaxDynamicSharedMemorySize, LDS_BYTES) != hipSuccess) { fprintf(stderr, "kernel_launch: hipFuncSetAttribute failed\n"); }
    if (hipOccupancyMaxActiveBlocksPerMultiprocessor(&per_cu, fn, NTHR, LDS_BYTES) != hipSuccess || per_cu < 1) { fprintf(stderr, "kernel_launch: occupancy query failed (%d)\n", per_cu); per_cu = 1; }
    (void)hipGetLastError();
    if (per_cu > 1) per_cu = 1;
    grid_blocks = cus * per_cu;
    fprintf(stderr, "kernel_launch: cus %d per_cu %d grid %d\n", cus, per_cu, grid_blocks);
  }
  if (grid_blocks < 0) return;
  P p{};
  const float** pp = (const float**)&p;
  for (int i = 0; i < 28; ++i) pp[i] = (const float*)d_in[i];
  p.out = (float*)d_out; p.ws = (char*)d_ws;
  (void)hipMemsetAsync((char*)d_ws + WS_BAR, 0, XCD_BAR_WORDS * 4, stream);
  void* args[] = {&p};
  hipError_t e = hipLaunchCooperativeKernel((const void*)k_mega, dim3(grid_blocks), dim3(NTHR), args, LDS_BYTES, stream);
  if (e != hipSuccess) fprintf(stderr, "cooperative launch failed: %s (grid %d)\n", hipGetErrorString(e), grid_blocks);
}
```

```cpp
#include <hip/hip_runtime.h>
#include <hip/hip_cooperative_groups.h>
#include <cstdio>
#include <cstdint>
namespace cg = cooperative_groups;

#define USE_FP16 1
#define LAS __attribute__((address_space(3)))

typedef unsigned short u16;
typedef float f32x4 __attribute__((ext_vector_type(4)));
typedef float f32x2 __attribute__((ext_vector_type(2)));
typedef _Float16 f16x8 __attribute__((ext_vector_type(8)));

constexpr int T_TOK = 16384, DM = 1024, SEQ = 2048, NBATCH = 8;
constexpr int CAP = 32768;
constexpr int NTHR = 512, NWAVE = NTHR / 64;

constexpr size_t MB = 1024ull * 1024ull;
constexpr size_t WS_XA    = 0;
constexpr size_t WS_XB    = 64 * MB;
constexpr size_t WS_Z     = 96 * MB;
constexpr size_t WS_A2    = 160 * MB;
constexpr size_t WS_BTY   = 184 * MB;
constexpr size_t WS_MW    = WS_Z;
constexpr size_t WS_WET   = 208 * MB;
constexpr size_t WS_E     = 216 * MB;
constexpr size_t WS_KTAB  = 232 * MB;
constexpr size_t WS_SP16  = 234 * MB;
constexpr size_t WS_INC   = 266 * MB;
constexpr size_t WS_YCAT  = 330 * MB;
constexpr size_t WS_YGELU = 362 * MB;
constexpr size_t WS_H     = 378 * MB;
constexpr size_t WS_LIST  = 418 * MB;
constexpr size_t WS_GATE  = 422 * MB;
constexpr size_t WS_ROPE  = 423 * MB;
constexpr size_t WS_CNT   = 424 * MB;
constexpr size_t WS_WR16  = 425 * MB;
constexpr size_t WS_BAR   = 426 * MB;
constexpr size_t WS_WIN   = 427 * MB;
constexpr size_t WS_WGLU  = 432 * MB;
constexpr size_t WS_WOUT  = 433 * MB;
constexpr size_t WS_WQKV  = 435 * MB;
constexpr size_t WS_WO    = 438 * MB;
constexpr size_t WS_END   = 440 * MB;

struct P {
  const float *x, *norm_mix_g, *norm_ffn_g, *norm_final_g, *w_in, *ret_decay, *a_re, *a_im, *log_step, *b_re, *b_im, *c_re, *c_im,
      *s5d, *w_glu, *b_glu, *w_out, *w_qkv, *sink, *w_o, *rel_bias, *w_group, *b_group, *w_er, *b_er, *w_gate, *w_up, *w_down;
  float* out;
  char* ws;
};

__device__ __forceinline__ u16 f2h(float f) { _Float16 h = (_Float16)f; return __builtin_bit_cast(u16, h); }
__device__ __forceinline__ float h2f(u16 h) { return (float)__builtin_bit_cast(_Float16, h); }
__device__ __forceinline__ unsigned pk2(float a, float b) { return (unsigned)f2h(a) | ((unsigned)f2h(b) << 16); }
__device__ __forceinline__ float lo16(unsigned w) { return h2f((u16)(w & 0xffffu)); }
__device__ __forceinline__ float hi16(unsigned w) { return h2f((u16)(w >> 16)); }
__device__ __forceinline__ f32x4 mfma16(uint4 a, uint4 b, f32x4 c) {
  return __builtin_amdgcn_mfma_f32_16x16x32_f16(__builtin_bit_cast(f16x8, a), __builtin_bit_cast(f16x8, b), c, 0, 0, 0);
}
__device__ __forceinline__ float wave_sum(float v) {
#pragma unroll
  for (int o = 1; o < 64; o <<= 1) v += __shfl_xor(v, o);
  return v;
}
__device__ __forceinline__ float sigmoidf_(float x) { return 1.0f / (1.0f + __expf(-x)); }
__device__ __forceinline__ float gelu_tanh(float x) {
  const float u = 0.7978845608028654f * (x + 0.044715f * x * x * x);
  return 0.5f * x * (1.0f + tanhf(u));
}
#define LDS_WAIT() asm volatile("s_waitcnt lgkmcnt(0)" ::: "memory")
__device__ __forceinline__ int tidx() { int t = threadIdx.x; asm volatile("" : "+v"(t)); return t; }

namespace pg8 {
constexpr int BM = 256, BK = 64, HALF = 128, HTB = HALF * BK * 2, STAGE_BYTES = 8 * HTB, NXCD = 8, WGM = 8;
__device__ __forceinline__ int lds_byte(int r, int c) { const int st = (r >> 4) * 2 + (c >> 5), rr = r & 15, cc = c & 31, ob = rr * 64 + cc * 2; return st * 1024 + (ob ^ (((ob >> 9) & 1) << 5)); }
__device__ __forceinline__ void stage_rc(int b, int& R, int& C) { const int st = b / 1024, sb = b % 1024, swz = sb ^ (((sb >> 9) & 1) << 5); R = (st >> 1) * 16 + swz / 64; C = (st & 1) * 32 + (swz % 64) / 2; }

struct Unit { const char* a; const char* b; int pm, pn, e, cnt, hbase; };

template <class Epi, class Sched, bool ALIGN_EPI, bool SP2>
__device__ __forceinline__ void gemm_phase(LAS unsigned char* lds, const int K, const Sched& S, const Epi& E) {
    const int tid = tidx(), wid = __builtin_amdgcn_readfirstlane(tid >> 6), lane = tid & 63, wr = wid >> 2, wc = wid & 3, fr = lane & 15, fq = lane >> 4;
    const int nt = K / BK;
    int Rr[2], Cc[2];
    unsigned voffB[2];
#pragma unroll
    for (int i = 0; i < 2; ++i) { stage_rc(tid * 16 + i * 8192, Rr[i], Cc[i]); voffB[i] = (unsigned)(Rr[i] * K + Cc[i]) * 2u; }
    const size_t kstep = (size_t)(BK * 2);
    const size_t hstepB = (size_t)HALF * K * 2;
    const unsigned ldsw = (unsigned)wid * 1024u;
    const int aoff = lds_byte(wr * 64 + fr, fq * 8), boff = lds_byte(wc * 32 + fr, fq * 8);
#define PG8_SA(b, h) (((b) * 2 + (h)) * HTB)
#define PG8_SB(b, h) ((4 + (b) * 2 + (h)) * HTB)
#define PG8_STAGE(bufoff, gbase, voff) do { _Pragma("unroll") for (int _i = 0; _i < 2; ++_i) \
        __builtin_amdgcn_global_load_lds((const unsigned*)((const char*)(gbase) + (voff)[_i]), (LAS unsigned*)(lds + (bufoff) + ldsw + _i * 8192), 16, 0, 0); } while (0)
#define PG8_LDA(dst, b, h) do { _Pragma("unroll") for (int m = 0; m < 4; ++m) _Pragma("unroll") for (int k = 0; k < 2; ++k) dst[m][k] = *(const LAS f16x8*)(lds + PG8_SA(b, h) + aoff + m * 2048 + k * 1024); } while (0)
#define PG8_LDB(dst, b, h) do { _Pragma("unroll") for (int n = 0; n < 2; ++n) _Pragma("unroll") for (int k = 0; k < 2; ++k) dst[n][k] = *(const LAS f16x8*)(lds + PG8_SB(b, h) + boff + n * 2048 + k * 1024); } while (0)
#define PG8_MMA(ai, bj, At, Bt) do { __builtin_amdgcn_s_setprio(1); _Pragma("unroll") for (int m = 0; m < 4; ++m) _Pragma("unroll") for (int n = 0; n < 2; ++n) _Pragma("unroll") for (int k = 0; k < 2; ++k) \
        acc[ai][bj][m][n] = __builtin_amdgcn_mfma_f32_16x16x32_f16(Bt[n][k], At[m][k], acc[ai][bj][m][n], 0, 0, 0); __builtin_amdgcn_s_setprio(0); } while (0)
#define PG8_WAIT_V(n) asm volatile("s_waitcnt vmcnt(" #n ")" ::: "memory")
#define PG8_WAIT_L(n) asm volatile("s_waitcnt lgkmcnt(" #n ")" ::: "memory")
#define PG8_BAR __builtin_amdgcn_s_barrier()
#define PG8_SCHED __builtin_amdgcn_sched_barrier(0)
    Unit cur, nxt; int ui = 0;
    if (!S.next(0, cur)) return;
    unsigned cv0[2], cv1[2], nv0[2], nv1[2];
#pragma unroll
    for (int i = 0; i < 2; ++i) { cv0[i] = S.a_voff(cur, 0, Rr[i], Cc[i]); cv1[i] = S.a_voff(cur, 1, Rr[i], Cc[i]); }
    f32x4 acc[2][2][4][2];
#pragma unroll
    for (int a = 0; a < 2; ++a)
#pragma unroll
        for (int b = 0; b < 2; ++b)
#pragma unroll
            for (int m = 0; m < 4; ++m)
#pragma unroll
                for (int n = 0; n < 2; ++n) acc[a][b][m][n] = (f32x4){0.f, 0.f, 0.f, 0.f};
    f16x8 At[4][2], B0[2][2], B1[2][2];
    const char* cA = cur.a; const char* cB = cur.b;
    if constexpr (SP2) {
        PG8_STAGE(PG8_SB(0, 0), cB, voffB); PG8_STAGE(PG8_SB(0, 1), cB + hstepB, voffB); PG8_STAGE(PG8_SA(0, 0), cA, cv0); PG8_STAGE(PG8_SA(0, 1), cA, cv1);
        if (wr == 1) PG8_BAR;
        PG8_WAIT_V(2); PG8_BAR;
        PG8_STAGE(PG8_SB(1, 0), cB + kstep, voffB); PG8_STAGE(PG8_SA(1, 0), cA + kstep, cv0); PG8_STAGE(PG8_SB(1, 1), cB + hstepB + kstep, voffB);
        PG8_WAIT_V(6); PG8_BAR;
    } else {
        PG8_STAGE(PG8_SB(0, 0), cB, voffB); PG8_STAGE(PG8_SA(0, 0), cA, cv0); PG8_STAGE(PG8_SB(0, 1), cB + hstepB, voffB); PG8_STAGE(PG8_SA(0, 1), cA, cv1);
        if (wr == 1) PG8_BAR;
        PG8_WAIT_V(4); PG8_BAR;
        PG8_STAGE(PG8_SB(1, 0), cB + kstep, voffB); PG8_STAGE(PG8_SA(1, 0), cA + kstep, cv0); PG8_STAGE(PG8_SB(1, 1), cB + hstepB + kstep, voffB);
        PG8_WAIT_V(6); PG8_BAR;
    }
    for (;;) {
        const bool has_next = S.next(ui + 1, nxt);
        if (has_next) {
#pragma unroll
            for (int i = 0; i < 2; ++i) { nv0[i] = S.a_voff(nxt, 0, Rr[i], Cc[i]); nv1[i] = S.a_voff(nxt, 1, Rr[i], Cc[i]); }
        } else {
            nxt = cur;
#pragma unroll
            for (int i = 0; i < 2; ++i) { nv0[i] = cv0[i]; nv1[i] = cv1[i]; }
        }
        const char* nA = nxt.a; const char* nB = nxt.b;
        for (int t = 0; t < nt; t += 2) {
            const bool last = (t == nt - 2);
            const char* a1 = cA + (size_t)(t + 1) * kstep;
            const char* a2 = last ? nA : cA + (size_t)(t + 2) * kstep; const char* b2 = last ? nB : cB + (size_t)(t + 2) * kstep;
            const char* a3 = a2 + kstep; const char* b3 = b2 + kstep;
            unsigned v0[2], v1[2];
#pragma unroll
            for (int i = 0; i < 2; ++i) { v0[i] = last ? nv0[i] : cv0[i]; v1[i] = last ? nv1[i] : cv1[i]; }
            if constexpr (SP2) {
            PG8_LDB(B0, 0, 0); PG8_LDB(B1, 0, 1); PG8_SCHED; PG8_LDA(At, 0, 0); PG8_STAGE(PG8_SA(1, 1), a1, cv1);
            PG8_WAIT_V(8); PG8_WAIT_L(0); PG8_BAR; PG8_MMA(0, 0, At, B0); PG8_MMA(0, 1, At, B1); PG8_BAR; PG8_SCHED;
            PG8_LDA(At, 0, 1); PG8_STAGE(PG8_SB(0, 0), b2, voffB); PG8_STAGE(PG8_SB(0, 1), b2 + hstepB, voffB); PG8_STAGE(PG8_SA(0, 0), a2, v0);
            PG8_WAIT_V(8); PG8_WAIT_L(0); PG8_BAR; PG8_MMA(1, 0, At, B0); PG8_MMA(1, 1, At, B1); PG8_BAR; PG8_SCHED;
            PG8_LDB(B0, 1, 0); PG8_LDB(B1, 1, 1); PG8_SCHED; PG8_LDA(At, 1, 0); PG8_STAGE(PG8_SA(0, 1), a2, v1);
            PG8_WAIT_V(8); PG8_WAIT_L(0); PG8_BAR; PG8_MMA(0, 0, At, B0); PG8_MMA(0, 1, At, B1); PG8_BAR; PG8_SCHED;
            PG8_LDA(At, 1, 1); PG8_STAGE(PG8_SB(1, 0), b3, voffB); PG8_STAGE(PG8_SB(1, 1), b3 + hstepB, voffB); PG8_STAGE(PG8_SA(1, 0), a3, v0);
            PG8_WAIT_V(8); PG8_WAIT_L(0); PG8_BAR; PG8_MMA(1, 0, At, B0); PG8_MMA(1, 1, At, B1); PG8_BAR; PG8_SCHED;
            } else {
            PG8_LDB(B0, 0, 0); PG8_SCHED; PG8_LDA(At, 0, 0); PG8_STAGE(PG8_SA(1, 1), a1, cv1);
            PG8_WAIT_L(8); PG8_BAR; PG8_WAIT_L(0); PG8_MMA(0, 0, At, B0); PG8_BAR; PG8_SCHED;
            PG8_LDB(B1, 0, 1); PG8_STAGE(PG8_SB(0, 0), b2, voffB);
            PG8_BAR; PG8_WAIT_L(0); PG8_MMA(0, 1, At, B1); PG8_BAR;
            PG8_LDA(At, 0, 1); PG8_STAGE(PG8_SA(0, 0), a2, v0);
            PG8_BAR; PG8_WAIT_L(0); PG8_MMA(1, 0, At, B0); PG8_BAR; PG8_SCHED;
            PG8_STAGE(PG8_SB(0, 1), b2 + hstepB, voffB);
            PG8_WAIT_V(6); PG8_BAR; PG8_MMA(1, 1, At, B1); PG8_BAR;
            PG8_LDB(B0, 1, 0); PG8_SCHED; PG8_LDA(At, 1, 0); PG8_STAGE(PG8_SA(0, 1), a2, v1);
            PG8_WAIT_L(8); PG8_BAR; PG8_WAIT_L(0); PG8_MMA(0, 0, At, B0); PG8_BAR; PG8_SCHED;
            PG8_LDB(B1, 1, 1); PG8_STAGE(PG8_SB(1, 0), b3, voffB);
            PG8_BAR; PG8_WAIT_L(0); PG8_MMA(0, 1, At, B1); PG8_BAR;
            PG8_LDA(At, 1, 1); PG8_STAGE(PG8_SA(1, 0), a3, v0);
            PG8_BAR; PG8_WAIT_L(0); PG8_MMA(1, 0, At, B0); PG8_BAR; PG8_SCHED;
            PG8_STAGE(PG8_SB(1, 1), b3 + hstepB, voffB);
            PG8_WAIT_V(6); PG8_BAR; PG8_MMA(1, 1, At, B1); PG8_BAR;
            }
        }
        if constexpr (ALIGN_EPI) { if (wr == 0) PG8_BAR; }
        E(acc, cur, wr, wc, fr, fq);
        if (!has_next) break;
#pragma unroll
        for (int a = 0; a < 2; ++a)
#pragma unroll
            for (int b = 0; b < 2; ++b)
#pragma unroll
                for (int m = 0; m < 4; ++m)
#pragma unroll
                    for (int n = 0; n < 2; ++n) acc[a][b][m][n] = (f32x4){0.f, 0.f, 0.f, 0.f};
        cur = nxt; cA = nA; cB = nB; ++ui;
#pragma unroll
        for (int i = 0; i < 2; ++i) { cv0[i] = nv0[i]; cv1[i] = nv1[i]; }
        if constexpr (ALIGN_EPI) { if (wr == 1) PG8_BAR; }
    }
    PG8_WAIT_V(0);
    if constexpr (!ALIGN_EPI) { if (wr == 0) PG8_BAR; }
    PG8_BAR;
#undef PG8_SA
#undef PG8_SB
#undef PG8_STAGE
#undef PG8_LDA
#undef PG8_LDB
#undef PG8_MMA
#undef PG8_WAIT_V
#undef PG8_WAIT_L
#undef PG8_BAR
#undef PG8_SCHED
}

struct DenseOrder {
    const char* A; const char* Bt; int lda_b, K, nM, nN, nwg, G, c;
    __device__ __forceinline__ void init(const void* A_, int lda_elems, const void* Bt_, int M, int N, int K_) { A = (const char*)A_; Bt = (const char*)Bt_; lda_b = lda_elems * 2; K = K_; nM = M / BM; nN = N / BM; nwg = nM * nN; G = gridDim.x; c = blockIdx.x; }
    __device__ __forceinline__ bool next(int i, Unit& u) const {
        const long L = (long)i * G + c; if (L >= nwg) return false;
        int wgid = (int)L; { const int q = nwg / NXCD, r = nwg % NXCD, xcd = wgid % NXCD, off = wgid / NXCD; wgid = (xcd < r ? xcd * (q + 1) : r * (q + 1) + (xcd - r) * q) + off; }
        const int nig = WGM * nN, gid = wgid / nig, fm = gid * WGM, gsz = (nM - fm) < WGM ? (nM - fm) : WGM;
        u.pm = fm + ((wgid % nig) % gsz); u.pn = (wgid % nig) / gsz; u.e = 0; u.cnt = 0; u.hbase = 0;
        u.a = A + (size_t)u.pm * BM * lda_b; u.b = Bt + (size_t)u.pn * BM * K * 2;
        return true;
    }
    __device__ __forceinline__ unsigned a_voff(const Unit&, int h, int R, int C) const { return (unsigned)((h * HALF + R) * lda_b + C * 2); }
};
struct GroupOrder {
    const char* A; const char* Bt; int lda_b, K, nM, nN, ng, G, c; size_t gsA, gsB;
    __device__ __forceinline__ void init(const void* A_, int lda_elems, size_t gsA_elems, const void* Bt_, size_t gsB_elems, int ng_, int M, int N, int K_) {
        A = (const char*)A_; Bt = (const char*)Bt_; lda_b = lda_elems * 2; K = K_; nM = M / BM; nN = N / BM; ng = ng_; gsA = gsA_elems * 2; gsB = gsB_elems * 2; G = gridDim.x; c = blockIdx.x; }
    __device__ __forceinline__ bool next(int i, Unit& u) const {
        const long L = (long)i * G + c; if (L >= (long)ng * nM * nN) return false;
        const int per = nM * nN, g = (int)L / per, r = (int)L % per;
        u.e = g; u.pm = r / nN; u.pn = r % nN; u.cnt = 0; u.hbase = 0;
        u.a = A + (size_t)g * gsA + (size_t)u.pm * BM * lda_b; u.b = Bt + (size_t)g * gsB + (size_t)u.pn * BM * K * 2;
        return true;
    }
    __device__ __forceinline__ unsigned a_voff(const Unit&, int h, int R, int C) const { return (unsigned)((h * HALF + R) * lda_b + C * 2); }
};
struct MoeOrder {
    const int* cnt; const int* list; const char* A; const char* Bt; int lda_b, K, nN, G, c; size_t esB; bool gather;
    __device__ __forceinline__ void init(const int* cnt_, const int* list_, const void* A_, int lda_elems, const void* Bt_, size_t esB_elems, int N, int K_, bool gather_) {
        cnt = cnt_; list = list_; A = (const char*)A_; Bt = (const char*)Bt_; lda_b = lda_elems * 2; K = K_; nN = N / BM; esB = esB_elems * 2; gather = gather_; G = gridDim.x; c = blockIdx.x; }
    __device__ __forceinline__ bool next(int i, Unit& u) const {
        int nwg = 0;
        for (int e = 0; e < 32; ++e) nwg += ((cnt[e] + BM - 1) / BM) * nN;
        const long L = (long)i * G + c; if (L >= nwg) return false;
        int wgid = (int)L; { const int q = nwg / NXCD, r = nwg % NXCD, xcd = wgid % NXCD, off = wgid / NXCD; wgid = (xcd < r ? xcd * (q + 1) : r * (q + 1) + (xcd - r) * q) + off; }
        int base = 0, hb = 0;
        for (int e = 0; e < 32; ++e) {
            const int ce = cnt[e], ntl = (ce + BM - 1) / BM, span = ntl * nN;
            if (wgid < base + span) {
                const int loc = wgid - base;
                u.e = e; u.pm = loc % ntl; u.pn = loc / ntl; u.cnt = ce; u.hbase = hb;
                u.a = gather ? A : A + (size_t)(hb + u.pm * BM) * lda_b;
                u.b = Bt + (size_t)e * esB + (size_t)u.pn * BM * K * 2;
                return true;
            }
            base += span; hb += ntl * BM;
        }
        return false;
    }
    __device__ __forceinline__ unsigned a_voff(const Unit& u, int h, int R, int C) const {
        if (!gather) return (unsigned)((h * HALF + R) * lda_b + C * 2);
        const int li = u.pm * BM + h * HALF + R;
        const int tok = (li < u.cnt) ? (list[(size_t)u.e * CAP + li] >> 1) : 0;
        return (unsigned)(tok * lda_b + C * 2);
    }
};
}
constexpr bool G_ALIGN = true, G_SP2 = true;

__device__ __forceinline__ void phase_prep(const P& p) {
  const int gtid = blockIdx.x * NTHR + tidx(), gsz = gridDim.x * NTHR;
  int* cnt = (int*)(p.ws + WS_CNT);
  if (gtid < 64) cnt[gtid] = 0;
  f32x2* rope = (f32x2*)(p.ws + WS_ROPE);
  for (int i = gtid; i < SEQ * 64; i += gsz) {
    const int pos = i >> 6, f = i & 63;
    const float inv = powf(10000.0f, -(float)(2 * f) / 128.0f);
    const float ang = (float)pos * inv;
    float s, c; sincosf(ang, &s, &c);
    rope[i] = (f32x2){c, s};
  }
  u16* wr16 = (u16*)(p.ws + WS_WR16);
  for (int i = gtid; i < 2 * 48 * DM; i += gsz) {
    const int k = i & (DM - 1), n = (i >> 10) % 48, layer = i / (48 * DM);
    float w = 0.f;
    if (n < 4) w = p.w_group[((size_t)layer * DM + k) * 4 + n];
    else if (n < 36) { const int gg = (n - 4) >> 3, j = (n - 4) & 7; w = p.w_er[(((size_t)layer * 4 + gg) * DM + k) * 8 + j]; }
    w *= p.norm_ffn_g[layer * DM + k];
    const u16 hi = f2h(w), lo = f2h(w - h2f(hi));
    wr16[((size_t)(layer * 2 + 0) * 48 + n) * DM + k] = hi;
    wr16[((size_t)(layer * 2 + 1) * 48 + n) * DM + k] = lo;
  }
}

template <class RowFn>
__device__ __forceinline__ void conv_item(const float* W, int ldw, int K, u16* WT, float* scr, int k0, int n0, int lane, RowFn rowfn) {
#pragma unroll 8
  for (int i = 0; i < 32; ++i) { const int kk = 2 * i + (lane >> 5); scr[kk * 33 + (lane & 31)] = W[(size_t)(k0 + kk) * ldw + n0 + (lane & 31)]; }
  LDS_WAIT();
  const int c = lane & 7;
#pragma unroll
  for (int j = 0; j < 4; ++j) {
    const int n = (lane >> 3) + 8 * j; const float* sp = scr + (8 * c) * 33 + n;
    uint4 o; o.x = pk2(sp[0 * 33], sp[1 * 33]); o.y = pk2(sp[2 * 33], sp[3 * 33]); o.z = pk2(sp[4 * 33], sp[5 * 33]); o.w = pk2(sp[6 * 33], sp[7 * 33]);
    *(uint4*)(WT + (size_t)rowfn(n0 + n) * K + k0 + 8 * c) = o;
  }
  LDS_WAIT();
}
template <class RowFn>
__device__ __forceinline__ int conv_matrix(const float* W, int ldw, int K, int N, u16* WT, char* smem, int item_base, RowFn rowfn) {
  const int lane = tidx() & 63, wv = tidx() >> 6, gw = blockIdx.x * NWAVE + wv, nw = gridDim.x * NWAVE;
  float* scr = (float*)smem + wv * (64 * 33);
  const int nkb = K / 64, nnb = N / 32, nitems = nkb * nnb;
  int it = gw - (item_base % nw); if (it < 0) it += nw;
  for (; it < nitems; it += nw) conv_item(W, ldw, K, WT, scr, (it / nnb) * 64, (it % nnb) * 32, lane, rowfn);
  return nitems;
}
__device__ __forceinline__ void phase_conv_dense(const P& p, char* smem) {
  auto id = [](int n) { return n; };
  int base = 0;
  base += conv_matrix(p.w_in, 2560, DM, 2560, (u16*)(p.ws + WS_WIN), smem, base, [](int n) { if (n >= 1024) return n; const int dd = n & 127, hf = dd >> 6, r = dd & 63; return (n & ~127) + 32 * (r >> 4) + 16 * hf + (r & 15); });
  base += conv_matrix(p.w_glu, 512, 512, 512, (u16*)(p.ws + WS_WGLU), smem, base, id);
  base += conv_matrix(p.w_out, DM, DM, DM, (u16*)(p.ws + WS_WOUT), smem, base, id);
  base += conv_matrix(p.w_qkv, 1536, DM, 1536, (u16*)(p.ws + WS_WQKV), smem, base, id);
  base += conv_matrix(p.w_o, DM, DM, DM, (u16*)(p.ws + WS_WO), smem, base, id);
}
__device__ __forceinline__ void phase_conv_moe(const P& p, int layer, char* smem) {
  const int lane = tidx() & 63, wv = tidx() >> 6, gw = blockIdx.x * NWAVE + wv, nw = gridDim.x * NWAVE;
  float* scr = (float*)smem + wv * (64 * 33);
  u16* w1t = (u16*)(p.ws + WS_MW); u16* w2t = (u16*)(p.ws + WS_MW + 64 * MB);
  for (int it = gw; it < 32 * 768; it += nw) {
    const int e = it / 768, r = it % 768;
    if (r < 512) {
      const int which = r >> 8, q = r & 255, k0 = (q >> 4) * 64, n0 = (q & 15) * 32;
      const float* W = (which ? p.w_up : p.w_gate) + (size_t)(layer * 32 + e) * DM * 512;
      conv_item(W, 512, DM, w1t + (size_t)e * DM * DM, scr, k0, n0, lane, [which](int n) { return (n >> 4) * 32 + which * 16 + (n & 15); });
    } else {
      const int q = r - 512, k0 = (q >> 5) * 64, n0 = (q & 31) * 32;
      const float* W = p.w_down + (size_t)(layer * 32 + e) * 512 * DM;
      conv_item(W, DM, 512, w2t + (size_t)e * DM * 512, scr, k0, n0, lane, [](int n) { return n; });
    }
  }
}

__device__ __forceinline__ void phase_rowpass(const P& p, const float* src, const u16* slots, float* dstx, const float* gain, int route_layer, float* fout, char* smem) {
  const int lane = tidx() & 63, wv = tidx() >> 6, fr = lane & 15, lg = lane >> 4;
  u16* xb = (u16*)(p.ws + WS_XB);
  int* cnt = (int*)(p.ws + WS_CNT);
  int* list = (int*)(p.ws + WS_LIST);
  float* gate = (float*)(p.ws + WS_GATE);
  float* sRs = (float*)smem;
  float* sLg = (float*)smem + 64;
  for (int st = blockIdx.x; st < T_TOK / 64; st += gridDim.x) {
    const int row0 = st * 64 + wv * 8;
#pragma unroll 1
    for (int rp = 0; rp < 4; ++rp) {
      f32x4 v[2][4];
#pragma unroll
      for (int q = 0; q < 2; ++q) {
        const int row = row0 + rp * 2 + q;
#pragma unroll
        for (int i = 0; i < 4; ++i) v[q][i] = *(const f32x4*)(src + (size_t)row * DM + (i * 64 + lane) * 4);
      }
      if (slots) {
#pragma unroll
        for (int q = 0; q < 2; ++q) {
          const int row = row0 + rp * 2 + q;
          uint2 w[2][4];
#pragma unroll
          for (int sl = 0; sl < 2; ++sl)
#pragma unroll
            for (int i = 0; i < 4; ++i) w[sl][i] = *(const uint2*)(slots + ((size_t)row * 2 + sl) * DM + (i * 64 + lane) * 4);
#pragma unroll
          for (int sl = 0; sl < 2; ++sl)
#pragma unroll
            for (int i = 0; i < 4; ++i) { v[q][i][0] += lo16(w[sl][i].x); v[q][i][1] += hi16(w[sl][i].x); v[q][i][2] += lo16(w[sl][i].y); v[q][i][3] += hi16(w[sl][i].y); }
        }
      }
#pragma unroll
      for (int q = 0; q < 2; ++q) {
        const int row = row0 + rp * 2 + q;
        float ss = 0.f;
#pragma unroll
        for (int i = 0; i < 4; ++i) {
          if (dstx) *(f32x4*)(dstx + (size_t)row * DM + (i * 64 + lane) * 4) = v[q][i];
          ss += v[q][i][0] * v[q][i][0] + v[q][i][1] * v[q][i][1] + v[q][i][2] * v[q][i][2] + v[q][i][3] * v[q][i][3];
        }
        ss = wave_sum(ss);
        const float rstd = rsqrtf(ss * (1.0f / DM) + 1e-6f);
        if (route_layer >= 0 && lane == 0) sRs[wv * 8 + rp * 2 + q] = rstd;
#pragma unroll
        for (int i = 0; i < 4; ++i) {
          const int k = (i * 64 + lane) * 4;
          const f32x4 gv = *(const f32x4*)(gain + k);
          const f32x4 hv = v[q][i] * rstd * gv;
          if (fout) *(f32x4*)(fout + (size_t)row * DM + k) = hv;
          else { uint2 w; w.x = pk2(hv[0], hv[1]); w.y = pk2(hv[2], hv[3]); *(uint2*)(xb + (size_t)row * DM + k) = w; }
        }
      }
    }
    if (route_layer >= 0) {
      __syncthreads();
      const int tl = wv & 3, kh = wv >> 2;
      const float rsv = sRs[tl * 16 + fr];
      const float* xrow = src + (size_t)(st * 64 + tl * 16 + fr) * DM + kh * 512 + lg * 8;
      const u16* whi = (const u16*)(p.ws + WS_WR16) + ((size_t)(route_layer * 2 + 0) * 48 + fr) * DM + kh * 512 + lg * 8;
      const u16* wlo = (const u16*)(p.ws + WS_WR16) + ((size_t)(route_layer * 2 + 1) * 48 + fr) * DM + kh * 512 + lg * 8;
      f32x4 acc[3];
#pragma unroll
      for (int nb = 0; nb < 3; ++nb) acc[nb] = (f32x4){0.f, 0.f, 0.f, 0.f};
#pragma unroll 4
      for (int ks = 0; ks < 16; ++ks) {
        const f32x4 x0 = *(const f32x4*)(xrow + ks * 32), x1 = *(const f32x4*)(xrow + ks * 32 + 4);
        const float hv[8] = {x0[0] * rsv, x0[1] * rsv, x0[2] * rsv, x0[3] * rsv, x1[0] * rsv, x1[1] * rsv, x1[2] * rsv, x1[3] * rsv};
        unsigned ah[4], al[4];
#pragma unroll
        for (int j = 0; j < 4; ++j) {
          const u16 h0 = f2h(hv[2 * j]), h1 = f2h(hv[2 * j + 1]);
          ah[j] = (unsigned)h0 | ((unsigned)h1 << 16);
          al[j] = pk2(hv[2 * j] - h2f(h0), hv[2 * j + 1] - h2f(h1));
        }
        const uint4 ahi = make_uint4(ah[0], ah[1], ah[2], ah[3]), alo = make_uint4(al[0], al[1], al[2], al[3]);
#pragma unroll
        for (int nb = 0; nb < 3; ++nb) {
          const uint4 bh = *(const uint4*)(whi + (size_t)nb * 16 * DM + ks * 32), bl = *(const uint4*)(wlo + (size_t)nb * 16 * DM + ks * 32);
          acc[nb] = mfma16(bh, ahi, acc[nb]); acc[nb] = mfma16(bh, alo, acc[nb]); acc[nb] = mfma16(bl, ahi, acc[nb]);
        }
      }
      float* lgw = sLg + ((kh * 4 + tl) * 16 + fr) * 49;
#pragma unroll
      for (int nb = 0; nb < 3; ++nb)
#pragma unroll
        for (int r = 0; r < 4; ++r) lgw[nb * 16 + 4 * lg + r] = acc[nb][r];
      __syncthreads();
      if (wv < 4 && lane < 16) {
        const int row = st * 64 + wv * 16 + lane;
        const float* l0 = sLg + ((0 * 4 + wv) * 16 + lane) * 49;
        const float* l1 = sLg + ((1 * 4 + wv) * 16 + lane) * 49;
        const float* bg = p.b_group + route_layer * 4;
        const float* be = p.b_er + route_layer * 32;
        float gl[4];
#pragma unroll
        for (int j = 0; j < 4; ++j) gl[j] = l0[j] + l1[j] + bg[j];
        int gs = 0; float gm = gl[0];
#pragma unroll
        for (int j = 1; j < 4; ++j) if (gl[j] > gm) { gm = gl[j]; gs = j; }
        float den = 0.f;
#pragma unroll
        for (int j = 0; j < 4; ++j) den += expf(gl[j] - gm);
        const float pg = 1.0f / den;
        float el[8];
#pragma unroll
        for (int j = 0; j < 8; ++j) el[j] = l0[4 + gs * 8 + j] + l1[4 + gs * 8 + j] + be[gs * 8 + j];
        int i1 = 0; float v1 = el[0];
#pragma unroll
        for (int j = 1; j < 8; ++j) if (el[j] > v1) { v1 = el[j]; i1 = j; }
        int i2 = -1; float v2 = -3.0e38f;
#pragma unroll
        for (int j = 0; j < 8; ++j) if (j != i1 && el[j] > v2) { v2 = el[j]; i2 = j; }
        const float e2 = expf(v2 - v1);
        const float g1 = pg / (1.0f + e2), g2 = pg * e2 / (1.0f + e2);
        const int ex1 = gs * 8 + i1, ex2 = gs * 8 + i2;
        const int r1 = atomicAdd(&cnt[route_layer * 32 + ex1], 1);
        list[(size_t)ex1 * CAP + r1] = row * 2;
        gate[row * 2] = g1;
        const int r2 = atomicAdd(&cnt[route_layer * 32 + ex2], 1);
        list[(size_t)ex2 * CAP + r2] = row * 2 + 1;
        gate[row * 2 + 1] = g2;
      }
      __syncthreads();
    }
  }
}

constexpr int RSTR = 136;
__device__ __forceinline__ float log_sigmoid(float x) { return -log1pf(expf(-x)); }
__device__ __forceinline__ uint2 lds_tr16(const u16* ptr) {
  typedef short s16x4 __attribute__((ext_vector_type(4)));
  const s16x4 v = __builtin_amdgcn_ds_read_tr16_b64_v4i16((LAS s16x4*)ptr);
  return __builtin_bit_cast(uint2, v);
}
__device__ __forceinline__ uint4 lds_frag_T(const u16* tile, int rs, int k0, int c0, int lane) {
  const int g = lane >> 4, q = (lane & 15) >> 2, pp = lane & 3;
  const u16* a = tile + (k0 + 8 * g + q) * rs + c0 + 4 * pp;
  const uint2 lo = lds_tr16(a), hi = lds_tr16(a + 4 * rs);
  return make_uint4(lo.x, lo.y, hi.x, hi.y);
}
__device__ __forceinline__ void ret_load_tile(u16* dst0, u16* dst1, const u16* src, int t0, int h, const float* w0, const float* w1) {
  for (int c = tidx(); c < 128 * 16; c += NTHR) {
    const int i = c >> 4, ch = (c & 15) * 8;
    const uint4 v = *(const uint4*)(src + (size_t)(t0 + i) * 512 + h * 128 + ch);
    if (w0) {
      const float a = w0[i], b = w1[i];
      const float f[8] = {lo16(v.x), hi16(v.x), lo16(v.y), hi16(v.y), lo16(v.z), hi16(v.z), lo16(v.w), hi16(v.w)};
      *(uint4*)(dst0 + i * RSTR + ch) = make_uint4(pk2(f[0] * a, f[1] * a), pk2(f[2] * a, f[3] * a), pk2(f[4] * a, f[5] * a), pk2(f[6] * a, f[7] * a));
      *(uint4*)(dst1 + i * RSTR + ch) = make_uint4(pk2(f[0] * b, f[1] * b), pk2(f[2] * b, f[3] * b), pk2(f[4] * b, f[5] * b), pk2(f[6] * b, f[7] * b));
    } else *(uint4*)(dst0 + i * RSTR + ch) = v;
  }
}
template <int MB_, int NB_, bool ATR, bool BTR>
__device__ __forceinline__ void lds_mma(f32x4 (&acc)[MB_][NB_], const u16* sA, int sa, int a0, const u16* sB, int sb, int b0, int K, int lane, const float* sc) {
  const int fr = lane & 15, fq = lane >> 4;
  for (int k0 = 0; k0 < K; k0 += 32) {
    uint4 fa[MB_], fb[NB_];
#pragma unroll
    for (int m = 0; m < MB_; ++m) {
      if constexpr (ATR) fa[m] = lds_frag_T(sA, sa, k0, a0 + m * 16, lane);
      else fa[m] = *(const uint4*)(sA + (a0 + m * 16 + fr) * sa + k0 + fq * 8);
      if (sc) {
        const float f = sc[m];
        fa[m].x = pk2(lo16(fa[m].x) * f, hi16(fa[m].x) * f); fa[m].y = pk2(lo16(fa[m].y) * f, hi16(fa[m].y) * f);
        fa[m].z = pk2(lo16(fa[m].z) * f, hi16(fa[m].z) * f); fa[m].w = pk2(lo16(fa[m].w) * f, hi16(fa[m].w) * f);
      }
    }
#pragma unroll
    for (int n = 0; n < NB_; ++n) {
      if constexpr (BTR) fb[n] = lds_frag_T(sB, sb, k0, b0 + n * 16, lane);
      else fb[n] = *(const uint4*)(sB + (b0 + n * 16 + fr) * sb + k0 + fq * 8);
    }
#pragma unroll
    for (int m = 0; m < MB_; ++m)
#pragma unroll
      for (int n = 0; n < NB_; ++n) acc[m][n] = mfma16(fb[n], fa[m], acc[m][n]);
  }
}
__device__ __forceinline__ void phase_ret_inc_mfma(const P& p, char* smem) {
  u16* sKf = (u16*)smem; u16* sKb = sKf + 128 * RSTR; u16* sV = sKb + 128 * RSTR; float* sWf = (float*)(sV + 128 * RSTR); float* sWb = sWf + 128;
  const u16* kb = (const u16*)(p.ws + WS_Z) + (size_t)1 * T_TOK * 512; const u16* vb = (const u16*)(p.ws + WS_Z) + (size_t)2 * T_TOK * 512;
  float* incf = (float*)(p.ws + WS_INC); float* incb = incf + (size_t)512 * 16384;
  const int tid = tidx(), lane = tid & 63, wv = tid >> 6, wr = wv >> 1, wc = wv & 1, fr = lane & 15, fq = lane >> 4;
  for (int item = blockIdx.x; item < 512; item += gridDim.x) {
    const int h = item & 3, bn = item >> 2, t0 = bn * 128;
    const float lgf = log_sigmoid(p.ret_decay[h]), lgb = log_sigmoid(p.ret_decay[4 + h]);
    __syncthreads();
    if (tid < 128) { sWf[tid] = expf(lgf * (float)(127 - tid)); sWb[tid] = expf(lgb * (float)tid); }
    __syncthreads();
    ret_load_tile(sKf, sKb, kb, t0, h, sWf, sWb);
    ret_load_tile(sV, nullptr, vb, t0, h, nullptr, nullptr);
    __syncthreads();
#pragma unroll
    for (int dirn = 0; dirn < 2; ++dirn) {
      f32x4 acc[2][4];
#pragma unroll
      for (int m = 0; m < 2; ++m)
#pragma unroll
        for (int n = 0; n < 4; ++n) acc[m][n] = (f32x4){0.f, 0.f, 0.f, 0.f};
      lds_mma<2, 4, true, true>(acc, sV, RSTR, wr * 32, dirn ? sKb : sKf, RSTR, wc * 64, 128, lane, nullptr);
      float* o = (dirn ? incb : incf) + (size_t)item * 16384;
#pragma unroll
      for (int m = 0; m < 2; ++m)
#pragma unroll
        for (int n = 0; n < 4; ++n) *(f32x4*)(o + (wr * 32 + m * 16 + fr) * 128 + wc * 64 + n * 16 + 4 * fq) = acc[m][n];
    }
  }
}
__device__ __forceinline__ void phase_ret_scan16(const P& p) {
  const float* incf = (const float*)(p.ws + WS_INC); const float* incb = incf + (size_t)512 * 16384;
  u16* spf = (u16*)(p.ws + WS_SP16); u16* spb = spf + (size_t)512 * 16384;
  const int gtid = blockIdx.x * NTHR + tidx(), gsz = gridDim.x * NTHR;
  for (int idx = gtid; idx < 32 * 4096; idx += gsz) {
    const int de = (idx & 4095) * 4, bh = idx >> 12, b = bh >> 2, h = bh & 3;
    const float Gf = expf(128.0f * log_sigmoid(p.ret_decay[h])), Gb = expf(128.0f * log_sigmoid(p.ret_decay[4 + h]));
    f32x4 s = {0.f, 0.f, 0.f, 0.f};
    for (int n = 0; n < 16; ++n) {
      const size_t o = ((size_t)((b * 16 + n) * 4 + h)) * 16384 + de;
      const f32x4 t = *(const f32x4*)(incf + o);
      uint2 w; w.x = pk2(s[0], s[1]); w.y = pk2(s[2], s[3]); *(uint2*)(spf + o) = w;
      s = s * Gf + t;
    }
    s = (f32x4){0.f, 0.f, 0.f, 0.f};
    for (int n = 15; n >= 0; --n) {
      const size_t o = ((size_t)((b * 16 + n) * 4 + h)) * 16384 + de;
      const f32x4 t = *(const f32x4*)(incb + o);
      uint2 w; w.x = pk2(s[0], s[1]); w.y = pk2(s[2], s[3]); *(uint2*)(spb + o) = w;
      s = s * Gb + t;
    }
  }
}
__device__ __forceinline__ void phase_ret_out_mfma(const P& p, char* smem) {
  u16* R0 = (u16*)smem; u16* R1 = R0 + 128 * RSTR; u16* R2 = R1 + 128 * RSTR; u16* R3 = R2 + 128 * RSTR;
  float* sPf = (float*)(R3 + 128 * RSTR); float* sPb = sPf + 132;
  const u16* zb = (const u16*)(p.ws + WS_Z);
  const u16* qb = zb; const u16* kb = zb + (size_t)1 * T_TOK * 512; const u16* vb = zb + (size_t)2 * T_TOK * 512; const u16* gb = zb + (size_t)3 * T_TOK * 512;
  const u16* spf = (const u16*)(p.ws + WS_SP16); const u16* spb = spf + (size_t)512 * 16384;
  u16* ycat = (u16*)(p.ws + WS_YCAT);
  const int tid = tidx(), lane = tid & 63, wv = tid >> 6, wr = wv >> 1, wc = wv & 1, fr = lane & 15, fq = lane >> 4;
  for (int item = blockIdx.x; item < 512; item += gridDim.x) {
    const int h = item & 3, bn = item >> 2, t0 = bn * 128;
    const float lgf = log_sigmoid(p.ret_decay[h]), lgb = log_sigmoid(p.ret_decay[4 + h]);
    __syncthreads();
    ret_load_tile(R0, nullptr, qb, t0, h, nullptr, nullptr);
    ret_load_tile(R1, nullptr, kb, t0, h, nullptr, nullptr);
    ret_load_tile(R2, nullptr, vb, t0, h, nullptr, nullptr);
    if (tid < 129) { sPf[tid] = expf(lgf * (float)tid); sPb[tid] = expf(lgb * (float)tid); }
    __syncthreads();
    {
      f32x4 acc[2][4];
#pragma unroll
      for (int m = 0; m < 2; ++m)
#pragma unroll
        for (int n = 0; n < 4; ++n) acc[m][n] = (f32x4){0.f, 0.f, 0.f, 0.f};
      lds_mma<2, 4, false, false>(acc, R0, RSTR, wr * 32, R1, RSTR, wc * 64, 128, lane, nullptr);
#pragma unroll
      for (int m = 0; m < 2; ++m)
#pragma unroll
        for (int n = 0; n < 4; ++n) {
          const int i = wr * 32 + m * 16 + fr, j = wc * 64 + n * 16 + 4 * fq;
          float v[4];
#pragma unroll
          for (int r = 0; r < 4; ++r) { const int jj = j + r; v[r] = acc[m][n][r] * ((i >= jj) ? sPf[i - jj] : sPb[jj - i]); }
          uint2 w; w.x = pk2(v[0], v[1]); w.y = pk2(v[2], v[3]);
          *(uint2*)(R3 + i * RSTR + j) = w;
        }
    }
    __syncthreads();
    const u16* spT = spf + (size_t)item * 16384; const u16* snT = spb + (size_t)item * 16384;
    for (int c = tid; c < 128 * 16; c += NTHR) { const int e = c >> 4, ch = (c & 15) * 8; *(uint4*)(R1 + e * RSTR + ch) = *(const uint4*)(spT + e * 128 + ch); }
    f32x4 o[1][8];
#pragma unroll
    for (int m = 0; m < 1; ++m)
#pragma unroll
      for (int n = 0; n < 8; ++n) o[m][n] = (f32x4){0.f, 0.f, 0.f, 0.f};
    lds_mma<1, 8, false, true>(o, R3, RSTR, wv * 16, R2, RSTR, 0, 128, lane, nullptr);
    __syncthreads();
    for (int c = tid; c < 128 * 16; c += NTHR) { const int e = c >> 4, ch = (c & 15) * 8; *(uint4*)(R2 + e * RSTR + ch) = *(const uint4*)(snT + e * 128 + ch); }
    float scf[1], scb[1];
    { const int i = wv * 16 + fr; scf[0] = sPf[i + 1]; scb[0] = sPb[128 - i]; }
    lds_mma<1, 8, false, false>(o, R0, RSTR, wv * 16, R1, RSTR, 0, 128, lane, scf);
    __syncthreads();
    lds_mma<1, 8, false, false>(o, R0, RSTR, wv * 16, R2, RSTR, 0, 128, lane, scb);
#pragma unroll
    for (int m = 0; m < 1; ++m) {
      float s1 = 0.f;
#pragma unroll
      for (int n = 0; n < 8; ++n) s1 += (o[m][n][0] + o[m][n][1]) + (o[m][n][2] + o[m][n][3]);
      s1 += __shfl_xor(s1, 16); s1 += __shfl_xor(s1, 32);
      const float mu = s1 * (1.0f / 128.0f);
      float s2 = 0.f;
#pragma unroll
      for (int n = 0; n < 8; ++n)
#pragma unroll
        for (int r = 0; r < 4; ++r) { const float dl = o[m][n][r] - mu; s2 += dl * dl; }
      s2 += __shfl_xor(s2, 16); s2 += __shfl_xor(s2, 32);
      const float rs = rsqrtf(s2 * (1.0f / 128.0f) + 1e-5f);
      const size_t tok = (size_t)(t0 + wv * 16 + m * 16 + fr);
#pragma unroll
      for (int n = 0; n < 8; ++n) {
        const int e = n * 16 + 4 * fq;
        const uint2 gq = *(const uint2*)(gb + tok * 512 + h * 128 + e);
        const float g0 = lo16(gq.x), g1 = hi16(gq.x), g2 = lo16(gq.y), g3 = hi16(gq.y);
        uint2 w;
        w.x = pk2(g0 * sigmoidf_(g0) * (o[m][n][0] - mu) * rs, g1 * sigmoidf_(g1) * (o[m][n][1] - mu) * rs);
        w.y = pk2(g2 * sigmoidf_(g2) * (o[m][n][2] - mu) * rs, g3 * sigmoidf_(g3) * (o[m][n][3] - mu) * rs);
        *(uint2*)(ycat + tok * DM + h * 128 + e) = w;
      }
    }
  }
}

struct Cpx { float re, im; };
__device__ __forceinline__ Cpx cmul(Cpx a, Cpx b) { return {a.re * b.re - a.im * b.im, a.re * b.im + a.im * b.re}; }
__device__ __forceinline__ Cpx s5_lam_pow(float ar, float ai, float dt, float e) {
  const float mag = expf(ar * dt * e); float sn, cs; sincosf(ai * dt * e, &sn, &cs); return {mag * cs, mag * sn};
}
__device__ __forceinline__ Cpx s5_coef(float ar, float ai, float dt) {
  float sn, cs; sincosf(ai * dt, &sn, &cs);
  const float em1 = expm1f(ar * dt), sh = sinf(0.5f * ai * dt);
  const float nr = em1 * cs - 2.0f * sh * sh, ni = (em1 + 1.0f) * sn, den = ar * ar + ai * ai;
  return {(nr * ar + ni * ai) / den, (ni * ar - nr * ai) / den};
}
__device__ __forceinline__ void phase_s5_ktab(const P& p) {
  float* ktab = (float*)(p.ws + WS_KTAB);
  const int gtid = blockIdx.x * NTHR + tidx(), gsz = gridDim.x * NTHR;
  for (int item = gtid; item < 32 * 2 * 32 * 16; item += gsz) {
    const int c = item & 15, l = (item >> 4) & 31, dir = (item >> 9) & 1, g = item >> 10;
    const float dt = expf(p.log_step[dir * 32 + g]);
    float acc[16];
#pragma unroll
    for (int j = 0; j < 16; ++j) acc[j] = 0.f;
    for (int q = 0; q < 64; ++q) {
      const float ar = p.a_re[(dir * 32 + g) * 64 + q], ai = p.a_im[(dir * 32 + g) * 64 + q];
      const Cpx L = s5_lam_pow(ar, ai, dt, (float)l), cf = s5_coef(ar, ai, dt);
      const Cpx C = {p.c_re[((dir * 32 + g) * 16 + c) * 64 + q], p.c_im[((dir * 32 + g) * 16 + c) * 64 + q]};
      const Cpx w = cmul(cmul(C, L), cf);
#pragma unroll
      for (int j = 0; j < 16; ++j) acc[j] += w.re * p.b_re[(g * 64 + q) * 16 + j] - w.im * p.b_im[(g * 64 + q) * 16 + j];
    }
#pragma unroll
    for (int j = 0; j < 16; j += 4) *(f32x4*)(ktab + (size_t)item * 16 + j) = (f32x4){acc[j], acc[j + 1], acc[j + 2], acc[j + 3]};
  }
}
__device__ __forceinline__ void phase_s5_fill(const P& p) {
  const float* ktab = (const float*)(p.ws + WS_KTAB);
  u16* bty = (u16*)(p.ws + WS_BTY); u16* wet = (u16*)(p.ws + WS_WET);
  const int gtid = blockIdx.x * NTHR + tidx(), gsz = gridDim.x * NTHR;
  for (int item = gtid; item < 32 * 512 * 64; item += gsz) {
    const int ch = item & 63, n = (item >> 6) & 511, g = item >> 15;
    const int ip = ch >> 1, c0 = (ch & 1) * 8, i = n >> 4, c = n & 15;
    float v[8];
    if (ip != i) {
      const int dir = ip < i ? 0 : 1, l = ip < i ? i - ip : ip - i;
      const float* src = ktab + ((size_t)((g * 2 + dir) * 32 + l) * 16 + c) * 16 + c0;
      const f32x4 a = *(const f32x4*)src, b = *(const f32x4*)(src + 4);
      v[0] = a[0]; v[1] = a[1]; v[2] = a[2]; v[3] = a[3]; v[4] = b[0]; v[5] = b[1]; v[6] = b[2]; v[7] = b[3];
    } else {
      const float* s0 = ktab + ((size_t)((g * 2 + 0) * 32) * 16 + c) * 16 + c0;
      const float* s1 = ktab + ((size_t)((g * 2 + 1) * 32) * 16 + c) * 16 + c0;
      const float dd = p.s5d[g * 16 + c];
#pragma unroll
      for (int j = 0; j < 8; ++j) v[j] = s0[j] + s1[j] + ((c0 + j) == c ? dd : 0.f);
    }
    *(uint4*)(bty + ((size_t)g * 512 + n) * 768 + ch * 8) = make_uint4(pk2(v[0], v[1]), pk2(v[2], v[3]), pk2(v[4], v[5]), pk2(v[6], v[7]));
  }
  for (int item = gtid; item < 32 * 512 * 32; item += gsz) {
    const int ch = item & 31, n = (item >> 5) & 511, g = item >> 14;
    const int kk = ch * 8, dir = kk >> 7, p0 = (kk & 127) >> 1, i = n >> 4, c = n & 15;
    const float dt = expf(p.log_step[dir * 32 + g]), e = dir ? (float)(32 - i) : (float)(i + 1);
    float v[8];
#pragma unroll
    for (int q = 0; q < 4; ++q) {
      const int pq = p0 + q;
      const float ar = p.a_re[(dir * 32 + g) * 64 + pq], ai = p.a_im[(dir * 32 + g) * 64 + pq];
      const Cpx L = s5_lam_pow(ar, ai, dt, e);
      const Cpx C = {p.c_re[((dir * 32 + g) * 16 + c) * 64 + pq], p.c_im[((dir * 32 + g) * 16 + c) * 64 + pq]};
      const Cpx w = cmul(C, L);
      v[2 * q] = w.re; v[2 * q + 1] = -w.im;
    }
    *(uint4*)(bty + ((size_t)g * 512 + n) * 768 + 512 + kk) = make_uint4(pk2(v[0], v[1]), pk2(v[2], v[3]), pk2(v[4], v[5]), pk2(v[6], v[7]));
  }
  for (int item = gtid; item < 32 * 256 * 64; item += gsz) {
    const int ch = item & 63, n = (item >> 6) & 255, g = item >> 14;
    const int ip = ch >> 1, c0 = (ch & 1) * 8, ri = n & 1, pq = (n >> 1) & 63, dir = n >> 7;
    const float dt = expf(p.log_step[dir * 32 + g]), e = dir ? (float)ip : (float)(31 - ip);
    const float ar = p.a_re[(dir * 32 + g) * 64 + pq], ai = p.a_im[(dir * 32 + g) * 64 + pq];
    const Cpx w = cmul(s5_lam_pow(ar, ai, dt, e), s5_coef(ar, ai, dt));
    float v[8];
#pragma unroll
    for (int j = 0; j < 8; ++j) {
      const float br = p.b_re[(g * 64 + pq) * 16 + c0 + j], bi = p.b_im[(g * 64 + pq) * 16 + c0 + j];
      v[j] = ri ? (w.re * bi + w.im * br) : (w.re * br - w.im * bi);
    }
    *(uint4*)(wet + ((size_t)g * 256 + n) * 512 + ch * 8) = make_uint4(pk2(v[0], v[1]), pk2(v[2], v[3]), pk2(v[4], v[5]), pk2(v[6], v[7]));
  }
}
__device__ __forceinline__ void phase_s5_carry(const P& p) {
  const float* E = (const float*)(p.ws + WS_E);
  u16* a2 = (u16*)(p.ws + WS_A2);
  const int gtid = blockIdx.x * NTHR + tidx(), gsz = gridDim.x * NTHR;
  for (int idx = gtid; idx < 32 * 8 * 128; idx += gsz) {
    const int pq = idx & 63, dir = (idx >> 6) & 1, b = (idx >> 7) & 7, g = idx >> 10;
    const float dt = expf(p.log_step[dir * 32 + g]);
    const Cpx L = s5_lam_pow(p.a_re[(dir * 32 + g) * 64 + pq], p.a_im[(dir * 32 + g) * 64 + pq], dt, 32.0f);
    Cpx s = {0.f, 0.f};
    for (int jj = 0; jj < 64; ++jj) {
      const int j = dir ? 63 - jj : jj, r = b * 64 + j;
      const f32x2 e = *(const f32x2*)(E + ((size_t)g * 512 + r) * 256 + (dir * 64 + pq) * 2);
      *(unsigned*)(a2 + ((size_t)g * 512 + r) * 768 + 512 + (dir * 64 + pq) * 2) = pk2(s.re, s.im);
      const Cpx ns = cmul(L, s);
      s.re = ns.re + e[0]; s.im = ns.im + e[1];
    }
  }
}
constexpr int KSTR = 72;
__device__ __forceinline__ int t5_bucket_abs(int n) {
  return n < 8 ? n : 8 + (n >= 12) + (n >= 16) + (n >= 23) + (n >= 32) + (n >= 46) + (n >= 64) + (n >= 91);
}
constexpr int VSTR = 392;
__device__ __forceinline__ void phase_attn(const P& p, char* smem) {
  u16* sK = (u16*)smem; u16* sV = sK + 384 * KSTR; float* sBias = (float*)(sV + 384 * KSTR);
  const u16* q1 = (const u16*)(p.ws + WS_Z); const u16* k1 = (const u16*)(p.ws + WS_Z + 32 * MB); const u16* v1 = (const u16*)(p.ws + WS_Z + 40 * MB);
  u16* ao = (u16*)(p.ws + WS_YCAT);
  const int tid = tidx(), lane = tid & 63, wv = tid >> 6, fr = lane & 15, lg = lane >> 4, q0 = wv * 16;
  for (int item = blockIdx.x; item < 512; item += gridDim.x) {
    const int b = item >> 6, nb = (item >> 2) & 15, kvh = item & 3;
    __syncthreads();
    for (int c = tid; c < 384 * 8; c += NTHR) {
      const int s = c >> 3, ch = (c & 7) * 8, pos = (nb - 1) * 128 + s;
      uint4 kq = make_uint4(0u, 0u, 0u, 0u), vq = kq;
      if (pos >= 0 && pos < SEQ) { kq = *(const uint4*)(k1 + (size_t)(b * SEQ + pos) * 256 + kvh * 64 + ch); vq = *(const uint4*)(v1 + (size_t)(b * SEQ + pos) * 256 + kvh * 64 + ch); }
      *(uint4*)(sK + s * KSTR + ch) = kq; *(uint4*)(sV + s * KSTR + ch) = vq;
    }
    for (int c = tid; c < 4 * 257; c += NTHR) {
      const int hq = c / 257, ri = c % 257, rel = ri - 128, n = rel < 0 ? -rel : rel;
      const int bucket = (rel > 0 ? 16 : 0) + t5_bucket_abs(n);
      sBias[hq * 260 + ri] = p.rel_bias[bucket * 16 + kvh * 4 + hq];
    }
    __syncthreads();
    for (int hq = 0; hq < 4; ++hq) {
      const int head = kvh * 4 + hq;
      const size_t tok0 = (size_t)b * SEQ + nb * 128 + q0;
      uint4 qf[1][2];
#pragma unroll
      for (int qb = 0; qb < 1; ++qb)
#pragma unroll
        for (int ks = 0; ks < 2; ++ks) qf[qb][ks] = *(const uint4*)(q1 + (tok0 + qb * 16 + fr) * DM + head * 64 + ks * 32 + lg * 8);
      f32x4 O[4][1];
#pragma unroll
      for (int mb = 0; mb < 4; ++mb)
#pragma unroll
        for (int qb = 0; qb < 1; ++qb) O[mb][qb] = (f32x4){0.f, 0.f, 0.f, 0.f};
      const float sinkv = p.sink[head];
      float mrun[1] = {sinkv}, lpart[1] = {lg == 0 ? 1.0f : 0.0f};
#pragma unroll
      for (int c = 0; c < 3; ++c) {
        if ((c == 0 && nb == 0) || (c == 2 && nb == 15)) continue;
        f32x4 S[8][1];
#pragma unroll
        for (int kb = 0; kb < 8; ++kb) {
          S[kb][0] = (f32x4){0.f, 0.f, 0.f, 0.f};
          const bool act = (c == 0) ? (16 * kb + 15 >= q0) : ((c == 2) ? (16 * kb <= q0 + 15) : true);
          if (act) {
#pragma unroll
            for (int ks = 0; ks < 2; ++ks) {
              const uint4 kf = *(const uint4*)(sK + (c * 128 + kb * 16 + fr) * KSTR + ks * 32 + lg * 8);
              S[kb][0] = mfma16(kf, qf[0][ks], S[kb][0]);
            }
          }
        }
        float cmax[1] = {-1e30f};
#pragma unroll
        for (int kb = 0; kb < 8; ++kb)
#pragma unroll
          for (int qb = 0; qb < 1; ++qb)
#pragma unroll
            for (int r = 0; r < 4; ++r) {
              const int sidx = c * 128 + kb * 16 + 4 * lg + r, qi = q0 + qb * 16 + fr, rel = sidx - 128 - qi;
              const bool valid = (rel >= -128) && (rel <= 128);
              const float v = valid ? S[kb][qb][r] + sBias[hq * 260 + (valid ? rel + 128 : 0)] : -1e30f;
              S[kb][qb][r] = v; cmax[qb] = fmaxf(cmax[qb], v);
            }
#pragma unroll
        for (int qb = 0; qb < 1; ++qb) {
          cmax[qb] = fmaxf(cmax[qb], __shfl_xor(cmax[qb], 16)); cmax[qb] = fmaxf(cmax[qb], __shfl_xor(cmax[qb], 32));
          const float mn = fmaxf(mrun[qb], cmax[qb]), alpha = __expf(mrun[qb] - mn);
          mrun[qb] = mn; lpart[qb] *= alpha;
#pragma unroll
          for (int mb = 0; mb < 4; ++mb) O[mb][qb] = O[mb][qb] * alpha;
          float ps = 0.f;
#pragma unroll
          for (int kb = 0; kb < 8; ++kb)
#pragma unroll
            for (int r = 0; r < 4; ++r) { const float e = __expf(S[kb][qb][r] - mn); S[kb][qb][r] = e; ps += e; }
          lpart[qb] += ps;
        }
#pragma unroll
        for (int kk = 0; kk < 4; ++kk) {
          const int kb0 = 2 * kk, kb1 = 2 * kk + 1;
          const bool act = (c == 0) ? (16 * kb1 + 15 >= q0) : ((c == 2) ? (16 * kb0 <= q0 + 15) : true);
          if (act) {
            uint4 pf[1];
#pragma unroll
            for (int qb = 0; qb < 1; ++qb) pf[qb] = make_uint4(pk2(S[kb0][qb][0], S[kb0][qb][1]), pk2(S[kb0][qb][2], S[kb0][qb][3]), pk2(S[kb1][qb][0], S[kb1][qb][1]), pk2(S[kb1][qb][2], S[kb1][qb][3]));
#pragma unroll
            for (int mb = 0; mb < 4; ++mb) {
              const int tq = (lane & 15) >> 2, tp = lane & 3;
              const uint2 v0 = lds_tr16(sV + (c * 128 + kb0 * 16 + 4 * lg + tq) * KSTR + mb * 16 + 4 * tp);
              const uint2 v1r = lds_tr16(sV + (c * 128 + kb1 * 16 + 4 * lg + tq) * KSTR + mb * 16 + 4 * tp);
              const uint4 vf = make_uint4(v0.x, v0.y, v1r.x, v1r.y);
              O[mb][0] = mfma16(vf, pf[0], O[mb][0]);
            }
          }
        }
      }
#pragma unroll
      for (int qb = 0; qb < 1; ++qb) {
        float lt = lpart[qb]; lt += __shfl_xor(lt, 16); lt += __shfl_xor(lt, 32);
        const float inv = 1.0f / lt;
#pragma unroll
        for (int mb = 0; mb < 4; ++mb) {
          uint2 w; w.x = pk2(O[mb][qb][0] * inv, O[mb][qb][1] * inv); w.y = pk2(O[mb][qb][2] * inv, O[mb][qb][3] * inv);
          *(uint2*)(ao + (tok0 + qb * 16 + fr) * DM + head * 64 + mb * 16 + 4 * lg) = w;
        }
      }
    }
  }
}

struct EpiInproj {
  u16* zb; u16* a2; const f32x2* rope;
  __device__ __forceinline__ void operator()(const f32x4 (&acc)[2][2][4][2], const pg8::Unit& u, int wr, int wc, int fr, int fq) const {
    const int seg = u.pn >> 1;
#pragma unroll
    for (int ai = 0; ai < 2; ++ai)
#pragma unroll
      for (int m = 0; m < 4; ++m) {
        const int row = u.pm * 256 + ai * 128 + wr * 64 + m * 16 + fr;
        if (seg < 2) {
          const int d = 16 * wc + 4 * fq;
          const f32x2* cs = rope + (size_t)(row & (SEQ - 1)) * 64 + d;
          const f32x4 c01 = *(const f32x4*)cs, c23 = *(const f32x4*)(cs + 2);
          const float cv[4] = {c01[0], c01[2], c23[0], c23[2]}, sv[4] = {c01[1], c01[3], c23[1], c23[3]};
          const float sc = seg == 1 ? 0.08838834764831845f : 1.0f;
#pragma unroll
          for (int bj = 0; bj < 2; ++bj) {
            const f32x4 x1 = acc[ai][bj][m][0], x2 = acc[ai][bj][m][1];
            float o1[4], o2[4];
#pragma unroll
            for (int r = 0; r < 4; ++r) { o1[r] = (x1[r] * cv[r] - x2[r] * sv[r]) * sc; o2[r] = (x1[r] * sv[r] + x2[r] * cv[r]) * sc; }
            u16* dst = zb + (size_t)seg * T_TOK * 512 + (size_t)row * 512 + ((u.pn & 1) * 2 + bj) * 128 + d;
            uint2 w; w.x = pk2(o1[0], o1[1]); w.y = pk2(o1[2], o1[3]); *(uint2*)dst = w;
            w.x = pk2(o2[0], o2[1]); w.y = pk2(o2[2], o2[3]); *(uint2*)(dst + 64) = w;
          }
        } else {
#pragma unroll
          for (int bj = 0; bj < 2; ++bj)
#pragma unroll
            for (int n = 0; n < 2; ++n) {
              const int col = u.pn * 256 + bj * 128 + wc * 32 + n * 16 + 4 * fq;
              const f32x4 v = acc[ai][bj][m][n];
              uint2 w; w.x = pk2(v[0], v[1]); w.y = pk2(v[2], v[3]);
              if (seg < 4) *(uint2*)(zb + (size_t)seg * T_TOK * 512 + (size_t)row * 512 + (col - seg * 512)) = w;
              else { const int ch = col - 2048, gi = ch >> 4, c = ch & 15; *(uint2*)(a2 + ((size_t)gi * 512 + (row >> 5)) * 768 + (row & 31) * 16 + c) = w; }
            }
        }
      }
  }
};
__device__ __forceinline__ void phase_inproj(const P& p, LAS unsigned char* lds) {
  pg8::DenseOrder S; S.init(p.ws + WS_XB, DM, p.ws + WS_WIN, T_TOK, 2560, DM);
  EpiInproj E{(u16*)(p.ws + WS_Z), (u16*)(p.ws + WS_A2), (const f32x2*)(p.ws + WS_ROPE)};
  pg8::gemm_phase<EpiInproj, pg8::DenseOrder, G_ALIGN, G_SP2>(lds, DM, S, E);
}
struct EpiS5E {
  float* E_;
  __device__ __forceinline__ void operator()(const f32x4 (&acc)[2][2][4][2], const pg8::Unit& u, int wr, int wc, int fr, int fq) const {
#pragma unroll
    for (int ai = 0; ai < 2; ++ai)
#pragma unroll
      for (int m = 0; m < 4; ++m) {
        const int row = u.pm * 256 + ai * 128 + wr * 64 + m * 16 + fr;
#pragma unroll
        for (int bj = 0; bj < 2; ++bj)
#pragma unroll
          for (int n = 0; n < 2; ++n) *(f32x4*)(E_ + ((size_t)u.e * 512 + row) * 256 + bj * 128 + wc * 32 + n * 16 + 4 * fq) = acc[ai][bj][m][n];
      }
  }
};
__device__ __forceinline__ void phase_s5_egemm(const P& p, LAS unsigned char* lds) {
  pg8::GroupOrder S; S.init(p.ws + WS_A2, 768, (size_t)512 * 768, p.ws + WS_WET, (size_t)256 * 512, 32, 512, 256, 512);
  EpiS5E E{(float*)(p.ws + WS_E)};
  pg8::gemm_phase<EpiS5E, pg8::GroupOrder, G_ALIGN, G_SP2>(lds, 512, S, E);
}
struct EpiS5Y {
  u16* yg;
  __device__ __forceinline__ void operator()(const f32x4 (&acc)[2][2][4][2], const pg8::Unit& u, int wr, int wc, int fr, int fq) const {
#pragma unroll
    for (int ai = 0; ai < 2; ++ai)
#pragma unroll
      for (int m = 0; m < 4; ++m) {
        const int row = u.pm * 256 + ai * 128 + wr * 64 + m * 16 + fr;
#pragma unroll
        for (int bj = 0; bj < 2; ++bj)
#pragma unroll
          for (int n = 0; n < 2; ++n) {
            const int col = u.pn * 256 + bj * 128 + wc * 32 + n * 16 + 4 * fq;
            const f32x4 v = acc[ai][bj][m][n];
            uint2 w; w.x = pk2(gelu_tanh(v[0]), gelu_tanh(v[1])); w.y = pk2(gelu_tanh(v[2]), gelu_tanh(v[3]));
            *(uint2*)(yg + ((size_t)row * 32 + (col >> 4)) * 512 + u.e * 16 + (col & 15)) = w;
          }
      }
  }
};
__device__ __forceinline__ void phase_s5_ygemm(const P& p, LAS unsigned char* lds) {
  pg8::GroupOrder S; S.init(p.ws + WS_A2, 768, (size_t)512 * 768, p.ws + WS_BTY, (size_t)512 * 768, 32, 512, 512, 768);
  EpiS5Y E{(u16*)(p.ws + WS_YGELU)};
  pg8::gemm_phase<EpiS5Y, pg8::GroupOrder, G_ALIGN, G_SP2>(lds, 768, S, E);
}
struct EpiGlu {
  const u16* yg; const float* bglu; u16* ycat;
  __device__ __forceinline__ void operator()(const f32x4 (&acc)[2][2][4][2], const pg8::Unit& u, int wr, int wc, int fr, int fq) const {
#pragma unroll
    for (int ai = 0; ai < 2; ++ai)
#pragma unroll
      for (int m = 0; m < 4; ++m) {
        const int row = u.pm * 256 + ai * 128 + wr * 64 + m * 16 + fr;
#pragma unroll
        for (int bj = 0; bj < 2; ++bj)
#pragma unroll
          for (int n = 0; n < 2; ++n) {
            const int col = u.pn * 256 + bj * 128 + wc * 32 + n * 16 + 4 * fq;
            const f32x4 v = acc[ai][bj][m][n];
            const uint2 yv = *(const uint2*)(yg + (size_t)row * 512 + col);
            const f32x4 bb = *(const f32x4*)(bglu + col);
            uint2 w;
            w.x = pk2(lo16(yv.x) * sigmoidf_(v[0] + bb[0]), hi16(yv.x) * sigmoidf_(v[1] + bb[1]));
            w.y = pk2(lo16(yv.y) * sigmoidf_(v[2] + bb[2]), hi16(yv.y) * sigmoidf_(v[3] + bb[3]));
            *(uint2*)(ycat + (size_t)row * DM + 512 + col) = w;
          }
      }
  }
};
__device__ __forceinline__ void phase_glu(const P& p, LAS unsigned char* lds) {
  pg8::DenseOrder S; S.init(p.ws + WS_YGELU, 512, p.ws + WS_WGLU, T_TOK, 512, 512);
  EpiGlu E{(const u16*)(p.ws + WS_YGELU), p.b_glu, (u16*)(p.ws + WS_YCAT)};
  pg8::gemm_phase<EpiGlu, pg8::DenseOrder, G_ALIGN, G_SP2>(lds, 512, S, E);
}
struct EpiResid {
  const float* xin; float* xout;
  __device__ __forceinline__ void operator()(const f32x4 (&acc)[2][2][4][2], const pg8::Unit& u, int wr, int wc, int fr, int fq) const {
#pragma unroll
    for (int ai = 0; ai < 2; ++ai)
#pragma unroll
      for (int m = 0; m < 4; ++m) {
        const int row = u.pm * 256 + ai * 128 + wr * 64 + m * 16 + fr;
#pragma unroll
        for (int bj = 0; bj < 2; ++bj)
#pragma unroll
          for (int n = 0; n < 2; ++n) {
            const size_t o = (size_t)row * DM + u.pn * 256 + bj * 128 + wc * 32 + n * 16 + 4 * fq;
            const f32x4 xv = *(const f32x4*)(xin + o);
            *(f32x4*)(xout + o) = xv + acc[ai][bj][m][n];
          }
      }
  }
};
__device__ __forceinline__ void phase_outproj(const P& p, const void* Wt, const float* xin, float* xout, LAS unsigned char* lds) {
  pg8::DenseOrder S; S.init(p.ws + WS_YCAT, DM, Wt, T_TOK, DM, DM);
  EpiResid E{xin, xout};
  pg8::gemm_phase<EpiResid, pg8::DenseOrder, G_ALIGN, G_SP2>(lds, DM, S, E);
}
struct EpiQkv {
  u16 *q1, *k1, *v1;
  __device__ __forceinline__ void operator()(const f32x4 (&acc)[2][2][4][2], const pg8::Unit& u, int wr, int wc, int fr, int fq) const {
#pragma unroll
    for (int ai = 0; ai < 2; ++ai)
#pragma unroll
      for (int m = 0; m < 4; ++m) {
        const int row = u.pm * 256 + ai * 128 + wr * 64 + m * 16 + fr;
#pragma unroll
        for (int bj = 0; bj < 2; ++bj)
#pragma unroll
          for (int n = 0; n < 2; ++n) {
            const int col = u.pn * 256 + bj * 128 + wc * 32 + n * 16 + 4 * fq;
            const f32x4 v = acc[ai][bj][m][n];
            uint2 w;
            if (u.pn < 4) { w.x = pk2(v[0] * 0.125f, v[1] * 0.125f); w.y = pk2(v[2] * 0.125f, v[3] * 0.125f); *(uint2*)(q1 + (size_t)row * DM + col) = w; }
            else {
              w.x = pk2(v[0], v[1]); w.y = pk2(v[2], v[3]);
              if (u.pn == 4) *(uint2*)(k1 + (size_t)row * 256 + (col - 1024)) = w; else *(uint2*)(v1 + (size_t)row * 256 + (col - 1280)) = w;
            }
          }
      }
  }
};
__device__ __forceinline__ void phase_qkv(const P& p, LAS unsigned char* lds) {
  pg8::DenseOrder S; S.init(p.ws + WS_XB, DM, p.ws + WS_WQKV, T_TOK, 1536, DM);
  EpiQkv E{(u16*)(p.ws + WS_Z), (u16*)(p.ws + WS_Z + 32 * MB), (u16*)(p.ws + WS_Z + 40 * MB)};
  pg8::gemm_phase<EpiQkv, pg8::DenseOrder, G_ALIGN, G_SP2>(lds, DM, S, E);
}
struct EpiMoe1 {
  u16* hbuf;
  __device__ __forceinline__ void operator()(const f32x4 (&acc)[2][2][4][2], const pg8::Unit& u, int wr, int wc, int fr, int fq) const {
#pragma unroll
    for (int ai = 0; ai < 2; ++ai)
#pragma unroll
      for (int m = 0; m < 4; ++m) {
        const int row = u.pm * 256 + ai * 128 + wr * 64 + m * 16 + fr;
        if (row < u.cnt) {
#pragma unroll
          for (int bj = 0; bj < 2; ++bj) {
            const f32x4 g = acc[ai][bj][m][0], up = acc[ai][bj][m][1];
            uint2 w; w.x = pk2(g[0] * sigmoidf_(g[0]) * up[0], g[1] * sigmoidf_(g[1]) * up[1]); w.y = pk2(g[2] * sigmoidf_(g[2]) * up[2], g[3] * sigmoidf_(g[3]) * up[3]);
            *(uint2*)(hbuf + (size_t)(u.hbase + row) * 512 + 16 * (8 * u.pn + 4 * bj + wc) + 4 * fq) = w;
          }
        }
      }
  }
};
__device__ __forceinline__ void phase_moe1(const P& p, int layer, LAS unsigned char* lds) {
  pg8::MoeOrder S; S.init((const int*)(p.ws + WS_CNT) + layer * 32, (const int*)(p.ws + WS_LIST), p.ws + WS_XB, DM, p.ws + WS_MW, (size_t)DM * DM, DM, DM, true);
  EpiMoe1 E{(u16*)(p.ws + WS_H)};
  pg8::gemm_phase<EpiMoe1, pg8::MoeOrder, G_ALIGN, G_SP2>(lds, DM, S, E);
}
struct EpiMoe2 {
  const int* list; const float* gate; u16* slots;
  __device__ __forceinline__ void operator()(const f32x4 (&acc)[2][2][4][2], const pg8::Unit& u, int wr, int wc, int fr, int fq) const {
#pragma unroll
    for (int ai = 0; ai < 2; ++ai)
#pragma unroll
      for (int m = 0; m < 4; ++m) {
        const int row = u.pm * 256 + ai * 128 + wr * 64 + m * 16 + fr;
        if (row < u.cnt) {
          const int asg = list[(size_t)u.e * CAP + row];
          const float gt = gate[asg];
#pragma unroll
          for (int bj = 0; bj < 2; ++bj)
#pragma unroll
            for (int n = 0; n < 2; ++n) {
              const f32x4 v = acc[ai][bj][m][n];
              uint2 w; w.x = pk2(gt * v[0], gt * v[1]); w.y = pk2(gt * v[2], gt * v[3]);
              *(uint2*)(slots + (size_t)asg * DM + u.pn * 256 + bj * 128 + wc * 32 + n * 16 + 4 * fq) = w;
            }
        }
      }
  }
};
__device__ __forceinline__ void phase_moe2(const P& p, int layer, LAS unsigned char* lds) {
  pg8::MoeOrder S; S.init((const int*)(p.ws + WS_CNT) + layer * 32, (const int*)(p.ws + WS_LIST), p.ws + WS_H, 512, p.ws + WS_MW + 64 * MB, (size_t)DM * 512, DM, 512, false);
  EpiMoe2 E{(const int*)(p.ws + WS_LIST), (const float*)(p.ws + WS_GATE), (u16*)(p.ws + WS_INC)};
  pg8::gemm_phase<EpiMoe2, pg8::MoeOrder, G_ALIGN, G_SP2>(lds, 512, S, E);
}

#define XB_TMO      128
#define XB_XCNT(j)  (256  + 64 * (j))
#define XB_XSUB(j)  (1280 + 64 * (j))
#define XB_XGEN(j)  (2304 + 64 * (j))
#define XB_TOP      3328
#define XB_TOPGEN   3392
#define XCD_BAR_WORDS 3456
#define XB_SPIN_CAP (1u << 22)
__device__ __forceinline__ unsigned xb_ld(unsigned* p)              { return __hip_atomic_load(p, __ATOMIC_RELAXED, __HIP_MEMORY_SCOPE_AGENT); }
__device__ __forceinline__ unsigned xb_add(unsigned* p, unsigned v) { return __hip_atomic_fetch_add(p, v, __ATOMIC_RELAXED, __HIP_MEMORY_SCOPE_AGENT); }
__device__ __forceinline__ unsigned xb_xcc_id() { return (unsigned)__builtin_amdgcn_s_getreg((3 << 11) | 20) & 0xFu; }
#define XB_SPIN(cond, bar) do { unsigned _sp = 0; while (cond) { __builtin_amdgcn_s_sleep(1); \
    if ((++_sp & 255u) == 0u) { if (xb_ld(&(bar)[XB_TMO])) break; if (_sp > XB_SPIN_CAP) { atomicAdd(&(bar)[XB_TMO], 1u); break; } } } } while (0)
struct XcdBarrier { unsigned* bar; unsigned x; volatile LAS unsigned* st; };
__device__ __forceinline__ XcdBarrier xcd_barrier_post(unsigned* bar, volatile LAS unsigned* st) {
  XcdBarrier b; b.bar = bar; b.x = xb_xcc_id(); b.st = st;
  if (tidx() == 0) (void)xb_add(&bar[XB_XCNT(b.x)], 1u);
  return b;
}
__device__ __forceinline__ void xcd_barrier_complete(unsigned* bar, unsigned x, unsigned& nloc, unsigned& nx) {
  const unsigned G = gridDim.x * gridDim.y * gridDim.z;
  unsigned sum, cnt, mine, sp = 0u;
  for (;;) {
    sum = 0u; cnt = 0u; mine = 0u;
#pragma unroll
    for (unsigned j = 0; j < 16; ++j) { const unsigned c = xb_ld(&bar[XB_XCNT(j)]); sum += c; cnt += (c > 0u) ? 1u : 0u; mine = (j == x) ? c : mine; }
    if (sum == G) break;
    __builtin_amdgcn_s_sleep(1);
    if ((++sp & 255u) == 0u) { if (xb_ld(&bar[XB_TMO])) break; if (sp > XB_SPIN_CAP) { atomicAdd(&bar[XB_TMO], 1u); break; } }
  }
  nloc = mine > 0u ? mine : 1u; nx = cnt > 0u ? cnt : 1u;
}
__device__ __forceinline__ void xcd_barrier(const XcdBarrier& b) {
  asm volatile("s_waitcnt vmcnt(0)" ::: "memory");
  __syncthreads();
  if (tidx() == 0) {
    unsigned* bar = b.bar;
    __builtin_amdgcn_s_waitcnt(0);
    unsigned nloc = b.st[0], nx = b.st[1];
    if (nloc == 0u) { xcd_barrier_complete(bar, b.x, nloc, nx); b.st[0] = nloc; b.st[1] = nx; }
    const unsigned old = xb_add(&bar[XB_XSUB(b.x)], 1u);
    const unsigned gen = old / nloc;
    if (old + 1u == (gen + 1u) * nloc) {
      __builtin_amdgcn_fence(__ATOMIC_RELEASE, "agent");
      asm volatile("s_waitcnt vmcnt(0)" ::: "memory");
      const unsigned og = xb_add(&bar[XB_TOP], 1u);
      const unsigned tg = og / nx;
      if (og + 1u == (tg + 1u) * nx) xb_add(&bar[XB_TOPGEN], 1u);
      else XB_SPIN(xb_ld(&bar[XB_TOPGEN]) == tg, bar);
      __builtin_amdgcn_fence(__ATOMIC_ACQUIRE, "agent");
      xb_add(&bar[XB_XGEN(b.x)], 1u);
      asm volatile("s_waitcnt vmcnt(0)" ::: "memory");
    } else {
      XB_SPIN(xb_ld(&bar[XB_XGEN(b.x)]) == gen, bar);
      __builtin_amdgcn_fence(__ATOMIC_ACQUIRE, "agent");
      asm volatile("s_waitcnt vmcnt(0)" ::: "memory");
    }
  }
  __syncthreads();
}

constexpr int NPHASE = 18;
constexpr int LDS_BYTES = 147456;
__device__ __forceinline__ void run_phase(const P& p, int ph, char* smem, LAS unsigned char* lds) {
  float* xa = (float*)(p.ws + WS_XA);
  const u16* slots = (const u16*)(p.ws + WS_INC);
  switch (ph) {
    case 0: phase_rowpass(p, p.x, nullptr, nullptr, p.norm_mix_g, -1, nullptr, smem); phase_prep(p); phase_s5_ktab(p); __syncthreads(); phase_conv_dense(p, smem); break;
    case 1: phase_inproj(p, lds); phase_s5_fill(p); break;
    case 2: phase_ret_inc_mfma(p, smem); __syncthreads(); phase_s5_egemm(p, lds); break;
    case 3: phase_ret_scan16(p); phase_s5_carry(p); break;
    case 4: phase_ret_out_mfma(p, smem); __syncthreads(); phase_s5_ygemm(p, lds); break;
    case 5: phase_glu(p, lds); break;
    case 6: phase_outproj(p, p.ws + WS_WOUT, p.x, xa, lds); break;
    case 7: phase_rowpass(p, xa, nullptr, nullptr, p.norm_ffn_g, 0, nullptr, smem); __syncthreads(); phase_conv_moe(p, 0, smem); break;
    case 8: phase_moe1(p, 0, lds); break;
    case 9: phase_moe2(p, 0, lds); break;
    case 10: phase_rowpass(p, xa, slots, xa, p.norm_mix_g + DM, -1, nullptr, smem); break;
    case 11: phase_qkv(p, lds); break;
    case 12: phase_attn(p, smem); break;
    case 13: phase_outproj(p, p.ws + WS_WO, xa, xa, lds); break;
    case 14: phase_rowpass(p, xa, nullptr, nullptr, p.norm_ffn_g + DM, 1, nullptr, smem); __syncthreads(); phase_conv_moe(p, 1, smem); break;
    case 15: phase_moe1(p, 1, lds); break;
    case 16: phase_moe2(p, 1, lds); break;
    case 17: phase_rowpass(p, xa, slots, nullptr, p.norm_final_g, -1, p.out, smem); break;
    default: break;
  }
}

extern __shared__ __attribute__((aligned(16))) char dyn_smem[];

template <int PH> __device__ __forceinline__ void mega_steps(const P& p, char* smem, LAS unsigned char* lds, cg::grid_group& grid, const XcdBarrier& xb) {
  run_phase(p, PH, smem, lds);
  if constexpr (PH + 1 < NPHASE) {
    if constexpr (PH == 0) grid.sync(); else xcd_barrier(xb);
    mega_steps<PH + 1>(p, smem, lds, grid, xb);
  }
}
__global__ void __launch_bounds__(NTHR, 2) k_mega(P p) {
  cg::grid_group grid = cg::this_grid();
  LAS unsigned char* lds = (LAS unsigned char*)dyn_smem;
  volatile LAS unsigned* st = (volatile LAS unsigned*)(lds + LDS_BYTES - 16);
  if (tidx() == 0) { st[0] = 0u; st[1] = 0u; }
  __syncthreads();
  const XcdBarrier xb = xcd_barrier_post((unsigned*)(p.ws + WS_BAR), st);
  mega_steps<0>(p, dyn_smem, lds, grid, xb);
}

extern "C" void kernel_launch(void* const* d_in, const int* in_sizes, int n_in, void* d_out, int out_size, void* d_ws, size_t ws_size, hipStream_t stream) {
  static int grid_blocks = 0;
  if (grid_blocks == 0) {
    if (n_in != 28 || out_size != T_TOK * DM || ws_size < WS_END) { fprintf(stderr, "kernel_launch: unexpected problem (n_in %d out %d ws %zu need %zu)\n", n_in, out_size, ws_size, (size_t)WS_END); grid_blocks = -1; return; }
    int dev = 0, cus = 0, per_cu = 0;
    (void)hipGetDevice(&dev);
    (void)hipDeviceGetAttribute(&cus, hipDeviceAttributeMultiprocessorCount, dev);
    const void* fn = (const void*)k_mega;
    if (hipFuncSetAttribute(fn, hipFuncAttributeMaxDynamicSharedMemorySize, LDS_BYTES) != hipSuccess) { fprintf(stderr, "kernel_launch: hipFuncSetAttribute failed\n"); }
    if (hipOccupancyMaxActiveBlocksPerMultiprocessor(&per_cu, fn, NTHR, LDS_BYTES) != hipSuccess || per_cu < 1) { fprintf(stderr, "kernel_launch: occupancy query failed (%d)\n", per_cu); per_cu = 1; }
    (void)hipGetLastError();
    if (per_cu > 1) per_cu = 1;
    grid_blocks = cus * per_cu;
    fprintf(stderr, "kernel_launch: cus %d per_cu %d grid %d\n", cus, per_cu, grid_blocks);
  }
  if (grid_blocks < 0) return;
  P p{};
  const float** pp = (const float**)&p;
  for (int i = 0; i < 28; ++i) pp[i] = (const float*)d_in[i];
  p.out = (float*)d_out; p.ws = (char*)d_ws;
  (void)hipMemsetAsync((char*)d_ws + WS_BAR, 0, XCD_BAR_WORDS * 4, stream);
  void* args[] = {&p};
  hipError_t e = hipLaunchCooperativeKernel((const void*)k_mega, dim3(grid_blocks), dim3(NTHR), args, LDS_BYTES, stream);
  if (e != hipSuccess) fprintf(stderr, "cooperative launch failed: %s (grid %d)\n", hipGetErrorString(e), grid_blocks);
}
```

```cpp
#include <hip/hip_runtime.h>
#include <hip/hip_cooperative_groups.h>
#include <cstdio>
#include <cstdint>
namespace cg = cooperative_groups;

#define USE_FP16 1
#define LAS __attribute__((address_space(3)))

typedef unsigned short u16;
typedef float f32x4 __attribute__((ext_vector_type(4)));
typedef float f32x2 __attribute__((ext_vector_type(2)));
typedef _Float16 f16x8 __attribute__((ext_vector_type(8)));

constexpr int T_TOK = 16384, DM = 1024, SEQ = 2048, NBATCH = 8;
constexpr int CAP = 32768;
constexpr int NTHR = 512, NWAVE = NTHR / 64;

constexpr size_t MB = 1024ull * 1024ull;
constexpr size_t WS_XA    = 0;
constexpr size_t WS_XB    = 64 * MB;
constexpr size_t WS_Z     = 96 * MB;
constexpr size_t WS_A2    = 160 * MB;
constexpr size_t WS_BTY   = 184 * MB;
constexpr size_t WS_MW    = WS_Z;
constexpr size_t WS_WET   = 208 * MB;
constexpr size_t WS_E     = 216 * MB;
constexpr size_t WS_KTAB  = 232 * MB;
constexpr size_t WS_SP16  = 234 * MB;
constexpr size_t WS_INC   = 266 * MB;
constexpr size_t WS_YCAT  = 330 * MB;
constexpr size_t WS_YGELU = 362 * MB;
constexpr size_t WS_H     = 378 * MB;
constexpr size_t WS_LIST  = 418 * MB;
constexpr size_t WS_GATE  = 422 * MB;
constexpr size_t WS_ROPE  = 423 * MB;
constexpr size_t WS_CNT   = 424 * MB;
constexpr size_t WS_WR16  = 425 * MB;
constexpr size_t WS_BAR   = 426 * MB;
constexpr size_t WS_PLAN  = 426 * MB + 512 * 1024;
constexpr size_t WS_WIN   = 427 * MB;
constexpr size_t WS_WGLU  = 432 * MB;
constexpr size_t WS_WOUT  = 433 * MB;
constexpr size_t WS_WQKV  = 435 * MB;
constexpr size_t WS_WO    = 438 * MB;
constexpr size_t WS_END   = 440 * MB;

struct P {
  const float *x, *norm_mix_g, *norm_ffn_g, *norm_final_g, *w_in, *ret_decay, *a_re, *a_im, *log_step, *b_re, *b_im, *c_re, *c_im,
      *s5d, *w_glu, *b_glu, *w_out, *w_qkv, *sink, *w_o, *rel_bias, *w_group, *b_group, *w_er, *b_er, *w_gate, *w_up, *w_down;
  float* out;
  char* ws;
};

__device__ __forceinline__ u16 f2h(float f) { _Float16 h = (_Float16)f; return __builtin_bit_cast(u16, h); }
__device__ __forceinline__ float h2f(u16 h) { return (float)__builtin_bit_cast(_Float16, h); }
__device__ __forceinline__ unsigned pk2(float a, float b) { return (unsigned)f2h(a) | ((unsigned)f2h(b) << 16); }
__device__ __forceinline__ float lo16(unsigned w) { return h2f((u16)(w & 0xffffu)); }
__device__ __forceinline__ float hi16(unsigned w) { return h2f((u16)(w >> 16)); }
__device__ __forceinline__ f32x4 mfma16(uint4 a, uint4 b, f32x4 c) {
  return __builtin_amdgcn_mfma_f32_16x16x32_f16(__builtin_bit_cast(f16x8, a), __builtin_bit_cast(f16x8, b), c, 0, 0, 0);
}
__device__ __forceinline__ float wave_sum(float v) {
#pragma unroll
  for (int o = 1; o < 64; o <<= 1) v += __shfl_xor(v, o);
  return v;
}
__device__ __forceinline__ float sigmoidf_(float x) { return 1.0f / (1.0f + __expf(-x)); }
__device__ __forceinline__ float gelu_tanh(float x) {
  const float u = 0.7978845608028654f * (x + 0.044715f * x * x * x);
  return 0.5f * x * (1.0f + tanhf(u));
}
#define LDS_WAIT() asm volatile("s_waitcnt lgkmcnt(0)" ::: "memory")
__device__ __forceinline__ int tidx() { int t = threadIdx.x; asm volatile("" : "+v"(t)); return t; }

namespace pg8 {
constexpr int BM = 256, BK = 64, HALF = 128, HTB = HALF * BK * 2, STAGE_BYTES = 8 * HTB, NXCD = 8, WGM = 8;
__device__ __forceinline__ int lds_byte(int r, int c) { const int st = (r >> 4) * 2 + (c >> 5), rr = r & 15, cc = c & 31, ob = rr * 64 + cc * 2; return st * 1024 + (ob ^ (((ob >> 9) & 1) << 5)); }
__device__ __forceinline__ void stage_rc(int b, int& R, int& C) { const int st = b / 1024, sb = b % 1024, swz = sb ^ (((sb >> 9) & 1) << 5); R = (st >> 1) * 16 + swz / 64; C = (st & 1) * 32 + (swz % 64) / 2; }

struct Unit { const char* a; const char* b; int pm, pn, e, cnt, hbase; };

template <class Epi, class Sched, bool ALIGN_EPI, bool SP2>
__device__ __forceinline__ void gemm_phase(LAS unsigned char* lds, const int K, const Sched& S, const Epi& E) {
    const int tid = tidx(), wid = __builtin_amdgcn_readfirstlane(tid >> 6), lane = tid & 63, wr = wid >> 2, wc = wid & 3, fr = lane & 15, fq = lane >> 4;
    const int nt = K / BK;
    int Rr[2], Cc[2];
    unsigned voffB[2];
#pragma unroll
    for (int i = 0; i < 2; ++i) { stage_rc(tid * 16 + i * 8192, Rr[i], Cc[i]); voffB[i] = (unsigned)(Rr[i] * K + Cc[i]) * 2u; }
    const size_t kstep = (size_t)(BK * 2);
    const size_t hstepB = (size_t)HALF * K * 2;
    const unsigned ldsw = (unsigned)wid * 1024u;
    const int aoff = lds_byte(wr * 64 + fr, fq * 8), boff = lds_byte(wc * 32 + fr, fq * 8);
#define PG8_SA(b, h) (((b) * 2 + (h)) * HTB)
#define PG8_SB(b, h) ((4 + (b) * 2 + (h)) * HTB)
#define PG8_STAGE(bufoff, gbase, voff) do { _Pragma("unroll") for (int _i = 0; _i < 2; ++_i) \
        __builtin_amdgcn_global_load_lds((const unsigned*)((const char*)(gbase) + (voff)[_i]), (LAS unsigned*)(lds + (bufoff) + ldsw + _i * 8192), 16, 0, 0); } while (0)
#define PG8_LDA(dst, b, h) do { _Pragma("unroll") for (int m = 0; m < 4; ++m) _Pragma("unroll") for (int k = 0; k < 2; ++k) dst[m][k] = *(const LAS f16x8*)(lds + PG8_SA(b, h) + aoff + m * 2048 + k * 1024); } while (0)
#define PG8_LDB(dst, b, h) do { _Pragma("unroll") for (int n = 0; n < 2; ++n) _Pragma("unroll") for (int k = 0; k < 2; ++k) dst[n][k] = *(const LAS f16x8*)(lds + PG8_SB(b, h) + boff + n * 2048 + k * 1024); } while (0)
#define PG8_MMA(ai, bj, At, Bt) do { if (128 * (ai) + 64 * wr >= urows) break; __builtin_amdgcn_s_setprio(1); _Pragma("unroll") for (int m = 0; m < 4; ++m) _Pragma("unroll") for (int n = 0; n < 2; ++n) _Pragma("unroll") for (int k = 0; k < 2; ++k) \
        acc[ai][bj][m][n] = __builtin_amdgcn_mfma_f32_16x16x32_f16(Bt[n][k], At[m][k], acc[ai][bj][m][n], 0, 0, 0); __builtin_amdgcn_s_setprio(0); } while (0)
#define PG8_WAIT_V(n) asm volatile("s_waitcnt vmcnt(" #n ")" ::: "memory")
#define PG8_WAIT_L(n) asm volatile("s_waitcnt lgkmcnt(" #n ")" ::: "memory")
#define PG8_BAR __builtin_amdgcn_s_barrier()
#define PG8_SCHED __builtin_amdgcn_sched_barrier(0)
    Unit cur, nxt; int ui = 0;
    if (!S.next(0, cur)) return;
    unsigned cv0[2], cv1[2], nv0[2], nv1[2];
#pragma unroll
    for (int i = 0; i < 2; ++i) { cv0[i] = S.a_voff(cur, 0, Rr[i], Cc[i]); cv1[i] = S.a_voff(cur, 1, Rr[i], Cc[i]); }
    f32x4 acc[2][2][4][2];
#pragma unroll
    for (int a = 0; a < 2; ++a)
#pragma unroll
        for (int b = 0; b < 2; ++b)
#pragma unroll
            for (int m = 0; m < 4; ++m)
#pragma unroll
                for (int n = 0; n < 2; ++n) acc[a][b][m][n] = (f32x4){0.f, 0.f, 0.f, 0.f};
    f16x8 At[4][2], B0[2][2], B1[2][2];
    const char* cA = cur.a; const char* cB = cur.b;
    int urows = S.rows(cur);
    if constexpr (SP2) {
        PG8_STAGE(PG8_SB(0, 0), cB, voffB); PG8_STAGE(PG8_SB(0, 1), cB + hstepB, voffB); PG8_STAGE(PG8_SA(0, 0), cA, cv0); PG8_STAGE(PG8_SA(0, 1), cA, cv1);
        if (wr == 1) PG8_BAR;
        PG8_WAIT_V(2); PG8_BAR;
        PG8_STAGE(PG8_SB(1, 0), cB + kstep, voffB); PG8_STAGE(PG8_SA(1, 0), cA + kstep, cv0); PG8_STAGE(PG8_SB(1, 1), cB + hstepB + kstep, voffB);
        PG8_WAIT_V(6); PG8_BAR;
    } else {
        PG8_STAGE(PG8_SB(0, 0), cB, voffB); PG8_STAGE(PG8_SA(0, 0), cA, cv0); PG8_STAGE(PG8_SB(0, 1), cB + hstepB, voffB); PG8_STAGE(PG8_SA(0, 1), cA, cv1);
        if (wr == 1) PG8_BAR;
        PG8_WAIT_V(4); PG8_BAR;
        PG8_STAGE(PG8_SB(1, 0), cB + kstep, voffB); PG8_STAGE(PG8_SA(1, 0), cA + kstep, cv0); PG8_STAGE(PG8_SB(1, 1), cB + hstepB + kstep, voffB);
        PG8_WAIT_V(6); PG8_BAR;
    }
    for (;;) {
        const bool has_next = S.next(ui + 1, nxt);
        if (has_next) {
#pragma unroll
            for (int i = 0; i < 2; ++i) { nv0[i] = S.a_voff(nxt, 0, Rr[i], Cc[i]); nv1[i] = S.a_voff(nxt, 1, Rr[i], Cc[i]); }
        } else {
            nxt = cur;
#pragma unroll
            for (int i = 0; i < 2; ++i) { nv0[i] = cv0[i]; nv1[i] = cv1[i]; }
        }
        const char* nA = nxt.a; const char* nB = nxt.b;
        for (int t = 0; t < nt; t += 2) {
            const bool last = (t == nt - 2);
            const char* a1 = cA + (size_t)(t + 1) * kstep;
            const char* a2 = last ? nA : cA + (size_t)(t + 2) * kstep; const char* b2 = last ? nB : cB + (size_t)(t + 2) * kstep;
            const char* a3 = a2 + kstep; const char* b3 = b2 + kstep;
            unsigned v0[2], v1[2];
#pragma unroll
            for (int i = 0; i < 2; ++i) { v0[i] = last ? nv0[i] : cv0[i]; v1[i] = last ? nv1[i] : cv1[i]; }
            if constexpr (SP2) {
            PG8_LDB(B0, 0, 0); PG8_LDB(B1, 0, 1); PG8_SCHED; PG8_LDA(At, 0, 0); PG8_STAGE(PG8_SA(1, 1), a1, cv1);
            PG8_WAIT_V(8); PG8_WAIT_L(0); PG8_BAR; PG8_MMA(0, 0, At, B0); PG8_MMA(0, 1, At, B1); PG8_BAR; PG8_SCHED;
            PG8_LDA(At, 0, 1); PG8_STAGE(PG8_SB(0, 0), b2, voffB); PG8_STAGE(PG8_SB(0, 1), b2 + hstepB, voffB); PG8_STAGE(PG8_SA(0, 0), a2, v0);
            PG8_WAIT_V(8); PG8_WAIT_L(0); PG8_BAR; PG8_MMA(1, 0, At, B0); PG8_MMA(1, 1, At, B1); PG8_BAR; PG8_SCHED;
            PG8_LDB(B0, 1, 0); PG8_LDB(B1, 1, 1); PG8_SCHED; PG8_LDA(At, 1, 0); PG8_STAGE(PG8_SA(0, 1), a2, v1);
            PG8_WAIT_V(8); PG8_WAIT_L(0); PG8_BAR; PG8_MMA(0, 0, At, B0); PG8_MMA(0, 1, At, B1); PG8_BAR; PG8_SCHED;
            PG8_LDA(At, 1, 1); PG8_STAGE(PG8_SB(1, 0), b3, voffB); PG8_STAGE(PG8_SB(1, 1), b3 + hstepB, voffB); PG8_STAGE(PG8_SA(1, 0), a3, v0);
            PG8_WAIT_V(8); PG8_WAIT_L(0); PG8_BAR; PG8_MMA(1, 0, At, B0); PG8_MMA(1, 1, At, B1); PG8_BAR; PG8_SCHED;
            } else {
            PG8_LDB(B0, 0, 0); PG8_SCHED; PG8_LDA(At, 0, 0); PG8_STAGE(PG8_SA(1, 1), a1, cv1);
            PG8_WAIT_L(8); PG8_BAR; PG8_WAIT_L(0); PG8_MMA(0, 0, At, B0); PG8_BAR; PG8_SCHED;
            PG8_LDB(B1, 0, 1); PG8_STAGE(PG8_SB(0, 0), b2, voffB);
            PG8_BAR; PG8_WAIT_L(0); PG8_MMA(0, 1, At, B1); PG8_BAR;
            PG8_LDA(At, 0, 1); PG8_STAGE(PG8_SA(0, 0), a2, v0);
            PG8_BAR; PG8_WAIT_L(0); PG8_MMA(1, 0, At, B0); PG8_BAR; PG8_SCHED;
            PG8_STAGE(PG8_SB(0, 1), b2 + hstepB, voffB);
            PG8_WAIT_V(6); PG8_BAR; PG8_MMA(1, 1, At, B1); PG8_BAR;
            PG8_LDB(B0, 1, 0); PG8_SCHED; PG8_LDA(At, 1, 0); PG8_STAGE(PG8_SA(0, 1), a2, v1);
            PG8_WAIT_L(8); PG8_BAR; PG8_WAIT_L(0); PG8_MMA(0, 0, At, B0); PG8_BAR; PG8_SCHED;
            PG8_LDB(B1, 1, 1); PG8_STAGE(PG8_SB(1, 0), b3, voffB);
            PG8_BAR; PG8_WAIT_L(0); PG8_MMA(0, 1, At, B1); PG8_BAR;
            PG8_LDA(At, 1, 1); PG8_STAGE(PG8_SA(1, 0), a3, v0);
            PG8_BAR; PG8_WAIT_L(0); PG8_MMA(1, 0, At, B0); PG8_BAR; PG8_SCHED;
            PG8_STAGE(PG8_SB(1, 1), b3 + hstepB, voffB);
            PG8_WAIT_V(6); PG8_BAR; PG8_MMA(1, 1, At, B1); PG8_BAR;
            }
        }
        if constexpr (ALIGN_EPI) { if (wr == 0) PG8_BAR; }
        E(acc, cur, wr, wc, fr, fq);
        if (!has_next) break;
#pragma unroll
        for (int a = 0; a < 2; ++a)
#pragma unroll
            for (int b = 0; b < 2; ++b)
#pragma unroll
                for (int m = 0; m < 4; ++m)
#pragma unroll
                    for (int n = 0; n < 2; ++n) acc[a][b][m][n] = (f32x4){0.f, 0.f, 0.f, 0.f};
        cur = nxt; cA = nA; cB = nB; ++ui; urows = S.rows(cur);
#pragma unroll
        for (int i = 0; i < 2; ++i) { cv0[i] = nv0[i]; cv1[i] = nv1[i]; }
        if constexpr (ALIGN_EPI) { if (wr == 1) PG8_BAR; }
    }
    PG8_WAIT_V(0);
    if constexpr (!ALIGN_EPI) { if (wr == 0) PG8_BAR; }
    PG8_BAR;
#undef PG8_SA
#undef PG8_SB
#undef PG8_STAGE
#undef PG8_LDA
#undef PG8_LDB
#undef PG8_MMA
#undef PG8_WAIT_V
#undef PG8_WAIT_L
#undef PG8_BAR
#undef PG8_SCHED
}

struct DenseOrder {
    const char* A; const char* Bt; int lda_b, K, nM, nN, nwg, G, c;
    __device__ __forceinline__ void init(const void* A_, int lda_elems, const void* Bt_, int M, int N, int K_) { A = (const char*)A_; Bt = (const char*)Bt_; lda_b = lda_elems * 2; K = K_; nM = M / BM; nN = N / BM; nwg = nM * nN; G = gridDim.x; c = blockIdx.x; }
    __device__ __forceinline__ bool next(int i, Unit& u) const {
        const long L = (long)i * G + c; if (L >= nwg) return false;
        int wgid = (int)L; { const int q = nwg / NXCD, r = nwg % NXCD, xcd = wgid % NXCD, off = wgid / NXCD; wgid = (xcd < r ? xcd * (q + 1) : r * (q + 1) + (xcd - r) * q) + off; }
        const int nig = WGM * nN, gid = wgid / nig, fm = gid * WGM, gsz = (nM - fm) < WGM ? (nM - fm) : WGM;
        u.pm = fm + ((wgid % nig) % gsz); u.pn = (wgid % nig) / gsz; u.e = 0; u.cnt = 0; u.hbase = 0;
        u.a = A + (size_t)u.pm * BM * lda_b; u.b = Bt + (size_t)u.pn * BM * K * 2;
        return true;
    }
    __device__ __forceinline__ unsigned a_voff(const Unit&, int h, int R, int C) const { return (unsigned)((h * HALF + R) * lda_b + C * 2); }
    __device__ __forceinline__ int rows(const Unit&) const { return BM; }
};
struct GroupOrder {
    const char* A; const char* Bt; int lda_b, K, nM, nN, ng, G, c; size_t gsA, gsB;
    __device__ __forceinline__ void init(const void* A_, int lda_elems, size_t gsA_elems, const void* Bt_, size_t gsB_elems, int ng_, int M, int N, int K_) {
        A = (const char*)A_; Bt = (const char*)Bt_; lda_b = lda_elems * 2; K = K_; nM = M / BM; nN = N / BM; ng = ng_; gsA = gsA_elems * 2; gsB = gsB_elems * 2; G = gridDim.x; c = blockIdx.x; }
    __device__ __forceinline__ bool next(int i, Unit& u) const {
        const long L = (long)i * G + c; if (L >= (long)ng * nM * nN) return false;
        const int per = nM * nN, g = (int)L / per, r = (int)L % per;
        u.e = g; u.pm = r / nN; u.pn = r % nN; u.cnt = 0; u.hbase = 0;
        u.a = A + (size_t)g * gsA + (size_t)u.pm * BM * lda_b; u.b = Bt + (size_t)g * gsB + (size_t)u.pn * BM * K * 2;
        return true;
    }
    __device__ __forceinline__ unsigned a_voff(const Unit&, int h, int R, int C) const { return (unsigned)((h * HALF + R) * lda_b + C * 2); }
    __device__ __forceinline__ int rows(const Unit&) const { return BM; }
};
constexpr int PLAN_STRIDE = 256;
struct PlanOrder {
    const int4* plan; const int* plan_n; const int* list; const char* A; const char* Bt; int lda_b, K, x, ib, nbx; size_t esB; bool gather;
    __device__ __forceinline__ void init(const void* planbase, const int* list_, const void* A_, int lda_elems, const void* Bt_, size_t esB_elems, int K_, bool gather_) {
        plan_n = (const int*)planbase; plan = (const int4*)((const char*)planbase + 256); list = list_; A = (const char*)A_; Bt = (const char*)Bt_; lda_b = lda_elems * 2; K = K_; esB = esB_elems * 2; gather = gather_;
        x = blockIdx.x & 7; ib = blockIdx.x >> 3; nbx = ((int)gridDim.x - x + 7) >> 3; }
    __device__ __forceinline__ bool next(int i, Unit& u) const {
        const int j = i * nbx + ib;
        if (j >= plan_n[x]) return false;
        const int4 en = plan[x * PLAN_STRIDE + j];
        u.e = en.x & 255; u.pm = (en.x >> 8) & 255; u.pn = (en.x >> 16) & 255; u.cnt = en.y; u.hbase = en.z;
        u.a = gather ? A : A + (size_t)(u.hbase + u.pm * BM) * lda_b;
        u.b = Bt + (size_t)u.e * esB + (size_t)u.pn * BM * K * 2;
        return true;
    }
    __device__ __forceinline__ unsigned a_voff(const Unit& u, int h, int R, int C) const {
        if (!gather) return (unsigned)((h * HALF + R) * lda_b + C * 2);
        const int li = u.pm * BM + h * HALF + R;
        const int tok = (li < u.cnt) ? (list[(size_t)u.e * CAP + li] >> 1) : 0;
        return (unsigned)(tok * lda_b + C * 2);
    }
    __device__ __forceinline__ int rows(const Unit& u) const { const int r = u.cnt - u.pm * BM; return r < BM ? r : BM; }
};
}
constexpr bool G_ALIGN = true, G_SP2 = true;

__device__ __forceinline__ void phase_prep(const P& p) {
  const int gtid = blockIdx.x * NTHR + tidx(), gsz = gridDim.x * NTHR;
  int* cnt = (int*)(p.ws + WS_CNT);
  if (gtid < 64) cnt[gtid] = 0;
  f32x2* rope = (f32x2*)(p.ws + WS_ROPE);
  for (int i = gtid; i < SEQ * 64; i += gsz) {
    const int pos = i >> 6, f = i & 63;
    const float inv = powf(10000.0f, -(float)(2 * f) / 128.0f);
    const float ang = (float)pos * inv;
    float s, c; sincosf(ang, &s, &c);
    rope[i] = (f32x2){c, s};
  }
  u16* wr16 = (u16*)(p.ws + WS_WR16);
  for (int i = gtid; i < 2 * 48 * DM; i += gsz) {
    const int k = i & (DM - 1), n = (i >> 10) % 48, layer = i / (48 * DM);
    float w = 0.f;
    if (n < 4) w = p.w_group[((size_t)layer * DM + k) * 4 + n];
    else if (n < 36) { const int gg = (n - 4) >> 3, j = (n - 4) & 7; w = p.w_er[(((size_t)layer * 4 + gg) * DM + k) * 8 + j]; }
    w *= p.norm_ffn_g[layer * DM + k];
    const u16 hi = f2h(w), lo = f2h(w - h2f(hi));
    wr16[((size_t)(layer * 2 + 0) * 48 + n) * DM + k] = hi;
    wr16[((size_t)(layer * 2 + 1) * 48 + n) * DM + k] = lo;
  }
}

template <class RowFn>
__device__ __forceinline__ void conv_item(const float* W, int ldw, int K, u16* WT, float* scr, int k0, int n0, int lane, RowFn rowfn) {
#pragma unroll 8
  for (int i = 0; i < 32; ++i) { const int kk = 2 * i + (lane >> 5); scr[kk * 33 + (lane & 31)] = W[(size_t)(k0 + kk) * ldw + n0 + (lane & 31)]; }
  LDS_WAIT();
  const int c = lane & 7;
#pragma unroll
  for (int j = 0; j < 4; ++j) {
    const int n = (lane >> 3) + 8 * j; const float* sp = scr + (8 * c) * 33 + n;
    uint4 o; o.x = pk2(sp[0 * 33], sp[1 * 33]); o.y = pk2(sp[2 * 33], sp[3 * 33]); o.z = pk2(sp[4 * 33], sp[5 * 33]); o.w = pk2(sp[6 * 33], sp[7 * 33]);
    *(uint4*)(WT + (size_t)rowfn(n0 + n) * K + k0 + 8 * c) = o;
  }
  LDS_WAIT();
}
template <class RowFn>
__device__ __forceinline__ int conv_matrix(const float* W, int ldw, int K, int N, u16* WT, char* smem, int item_base, RowFn rowfn) {
  const int lane = tidx() & 63, wv = tidx() >> 6, gw = blockIdx.x * NWAVE + wv, nw = gridDim.x * NWAVE;
  float* scr = (float*)smem + wv * (64 * 33);
  const int nkb = K / 64, nnb = N / 32, nitems = nkb * nnb;
  int it = gw - (item_base % nw); if (it < 0) it += nw;
  for (; it < nitems; it += nw) conv_item(W, ldw, K, WT, scr, (it / nnb) * 64, (it % nnb) * 32, lane, rowfn);
  return nitems;
}
__device__ __forceinline__ void phase_conv_dense(const P& p, char* smem) {
  auto id = [](int n) { return n; };
  int base = 0;
  base += conv_matrix(p.w_in, 2560, DM, 2560, (u16*)(p.ws + WS_WIN), smem, base, [](int n) { if (n >= 1024) return n; const int dd = n & 127, hf = dd >> 6, r = dd & 63; return (n & ~127) + 32 * (r >> 4) + 16 * hf + (r & 15); });
  base += conv_matrix(p.w_glu, 512, 512, 512, (u16*)(p.ws + WS_WGLU), smem, base, id);
  base += conv_matrix(p.w_out, DM, DM, DM, (u16*)(p.ws + WS_WOUT), smem, base, id);
  base += conv_matrix(p.w_qkv, 1536, DM, 1536, (u16*)(p.ws + WS_WQKV), smem, base, id);
  base += conv_matrix(p.w_o, DM, DM, DM, (u16*)(p.ws + WS_WO), smem, base, id);
}
__device__ __forceinline__ void phase_conv_moe(const P& p, int layer, char* smem) {
  const int lane = tidx() & 63, wv = tidx() >> 6, gw = blockIdx.x * NWAVE + wv, nw = gridDim.x * NWAVE;
  float* scr = (float*)smem + wv * (64 * 33);
  u16* w1t = (u16*)(p.ws + WS_MW); u16* w2t = (u16*)(p.ws + WS_MW + 64 * MB);
  for (int it = gw; it < 32 * 768; it += nw) {
    const int e = it / 768, r = it % 768;
    if (r < 512) {
      const int which = r >> 8, q = r & 255, k0 = (q >> 4) * 64, n0 = (q & 15) * 32;
      const float* W = (which ? p.w_up : p.w_gate) + (size_t)(layer * 32 + e) * DM * 512;
      conv_item(W, 512, DM, w1t + (size_t)e * DM * DM, scr, k0, n0, lane, [which](int n) { return (n >> 4) * 32 + which * 16 + (n & 15); });
    } else {
      const int q = r - 512, k0 = (q >> 5) * 64, n0 = (q & 31) * 32;
      const float* W = p.w_down + (size_t)(layer * 32 + e) * 512 * DM;
      conv_item(W, DM, 512, w2t + (size_t)e * DM * 512, scr, k0, n0, lane, [](int n) { return n; });
    }
  }
}

__device__ __forceinline__ void phase_rowpass(const P& p, const float* src, const u16* slots, float* dstx, const float* gain, int route_layer, float* fout, char* smem) {
  const int lane = tidx() & 63, wv = tidx() >> 6, fr = lane & 15, lg = lane >> 4;
  u16* xb = (u16*)(p.ws + WS_XB);
  int* cnt = (int*)(p.ws + WS_CNT);
  int* list = (int*)(p.ws + WS_LIST);
  float* gate = (float*)(p.ws + WS_GATE);
  float* sRs = (float*)smem;
  float* sLg = (float*)smem + 64;
  for (int st = blockIdx.x; st < T_TOK / 64; st += gridDim.x) {
    const int row0 = st * 64 + wv * 8;
#pragma unroll 1
    for (int rp = 0; rp < 4; ++rp) {
      f32x4 v[2][4];
#pragma unroll
      for (int q = 0; q < 2; ++q) {
        const int row = row0 + rp * 2 + q;
#pragma unroll
        for (int i = 0; i < 4; ++i) v[q][i] = *(const f32x4*)(src + (size_t)row * DM + (i * 64 + lane) * 4);
      }
      if (slots) {
#pragma unroll
        for (int q = 0; q < 2; ++q) {
          const int row = row0 + rp * 2 + q;
          uint2 w[2][4];
#pragma unroll
          for (int sl = 0; sl < 2; ++sl)
#pragma unroll
            for (int i = 0; i < 4; ++i) w[sl][i] = *(const uint2*)(slots + ((size_t)row * 2 + sl) * DM + (i * 64 + lane) * 4);
#pragma unroll
          for (int sl = 0; sl < 2; ++sl)
#pragma unroll
            for (int i = 0; i < 4; ++i) { v[q][i][0] += lo16(w[sl][i].x); v[q][i][1] += hi16(w[sl][i].x); v[q][i][2] += lo16(w[sl][i].y); v[q][i][3] += hi16(w[sl][i].y); }
        }
      }
#pragma unroll
      for (int q = 0; q < 2; ++q) {
        const int row = row0 + rp * 2 + q;
        float ss = 0.f;
#pragma unroll
        for (int i = 0; i < 4; ++i) {
          if (dstx) *(f32x4*)(dstx + (size_t)row * DM + (i * 64 + lane) * 4) = v[q][i];
          ss += v[q][i][0] * v[q][i][0] + v[q][i][1] * v[q][i][1] + v[q][i][2] * v[q][i][2] + v[q][i][3] * v[q][i][3];
        }
        ss = wave_sum(ss);
        const float rstd = rsqrtf(ss * (1.0f / DM) + 1e-6f);
        if (route_layer >= 0 && lane == 0) sRs[wv * 8 + rp * 2 + q] = rstd;
#pragma unroll
        for (int i = 0; i < 4; ++i) {
          const int k = (i * 64 + lane) * 4;
          const f32x4 gv = *(const f32x4*)(gain + k);
          const f32x4 hv = v[q][i] * rstd * gv;
          if (fout) *(f32x4*)(fout + (size_t)row * DM + k) = hv;
          else { uint2 w; w.x = pk2(hv[0], hv[1]); w.y = pk2(hv[2], hv[3]); *(uint2*)(xb + (size_t)row * DM + k) = w; }
        }
      }
    }
    if (route_layer >= 0) {
      __syncthreads();
      const int tl = wv & 3, kh = wv >> 2;
      const float rsv = sRs[tl * 16 + fr];
      const float* xrow = src + (size_t)(st * 64 + tl * 16 + fr) * DM + kh * 512 + lg * 8;
      const u16* whi = (const u16*)(p.ws + WS_WR16) + ((size_t)(route_layer * 2 + 0) * 48 + fr) * DM + kh * 512 + lg * 8;
      const u16* wlo = (const u16*)(p.ws + WS_WR16) + ((size_t)(route_layer * 2 + 1) * 48 + fr) * DM + kh * 512 + lg * 8;
      f32x4 acc[3];
#pragma unroll
      for (int nb = 0; nb < 3; ++nb) acc[nb] = (f32x4){0.f, 0.f, 0.f, 0.f};
#pragma unroll 4
      for (int ks = 0; ks < 16; ++ks) {
        const f32x4 x0 = *(const f32x4*)(xrow + ks * 32), x1 = *(const f32x4*)(xrow + ks * 32 + 4);
        const float hv[8] = {x0[0] * rsv, x0[1] * rsv, x0[2] * rsv, x0[3] * rsv, x1[0] * rsv, x1[1] * rsv, x1[2] * rsv, x1[3] * rsv};
        unsigned ah[4], al[4];
#pragma unroll
        for (int j = 0; j < 4; ++j) {
          const u16 h0 = f2h(hv[2 * j]), h1 = f2h(hv[2 * j + 1]);
          ah[j] = (unsigned)h0 | ((unsigned)h1 << 16);
          al[j] = pk2(hv[2 * j] - h2f(h0), hv[2 * j + 1] - h2f(h1));
        }
        const uint4 ahi = make_uint4(ah[0], ah[1], ah[2], ah[3]), alo = make_uint4(al[0], al[1], al[2], al[3]);
#pragma unroll
        for (int nb = 0; nb < 3; ++nb) {
          const uint4 bh = *(const uint4*)(whi + (size_t)nb * 16 * DM + ks * 32), bl = *(const uint4*)(wlo + (size_t)nb * 16 * DM + ks * 32);
          acc[nb] = mfma16(bh, ahi, acc[nb]); acc[nb] = mfma16(bh, alo, acc[nb]); acc[nb] = mfma16(bl, ahi, acc[nb]);
        }
      }
      float* lgw = sLg + ((kh * 4 + tl) * 16 + fr) * 49;
#pragma unroll
      for (int nb = 0; nb < 3; ++nb)
#pragma unroll
        for (int r = 0; r < 4; ++r) lgw[nb * 16 + 4 * lg + r] = acc[nb][r];
      __syncthreads();
      if (wv < 4 && lane < 16) {
        const int row = st * 64 + wv * 16 + lane;
        const float* l0 = sLg + ((0 * 4 + wv) * 16 + lane) * 49;
        const float* l1 = sLg + ((1 * 4 + wv) * 16 + lane) * 49;
        const float* bg = p.b_group + route_layer * 4;
        const float* be = p.b_er + route_layer * 32;
        float gl[4];
#pragma unroll
        for (int j = 0; j < 4; ++j) gl[j] = l0[j] + l1[j] + bg[j];
        int gs = 0; float gm = gl[0];
#pragma unroll
        for (int j = 1; j < 4; ++j) if (gl[j] > gm) { gm = gl[j]; gs = j; }
        float den = 0.f;
#pragma unroll
        for (int j = 0; j < 4; ++j) den += expf(gl[j] - gm);
        const float pg = 1.0f / den;
        float el[8];
#pragma unroll
        for (int j = 0; j < 8; ++j) el[j] = l0[4 + gs * 8 + j] + l1[4 + gs * 8 + j] + be[gs * 8 + j];
        int i1 = 0; float v1 = el[0];
#pragma unroll
        for (int j = 1; j < 8; ++j) if (el[j] > v1) { v1 = el[j]; i1 = j; }
        int i2 = -1; float v2 = -3.0e38f;
#pragma unroll
        for (int j = 0; j < 8; ++j) if (j != i1 && el[j] > v2) { v2 = el[j]; i2 = j; }
        const float e2 = expf(v2 - v1);
        const float g1 = pg / (1.0f + e2), g2 = pg * e2 / (1.0f + e2);
        const int ex1 = gs * 8 + i1, ex2 = gs * 8 + i2;
        const int r1 = atomicAdd(&cnt[route_layer * 32 + ex1], 1);
        list[(size_t)ex1 * CAP + r1] = row * 2;
        gate[row * 2] = g1;
        const int r2 = atomicAdd(&cnt[route_layer * 32 + ex2], 1);
        list[(size_t)ex2 * CAP + r2] = row * 2 + 1;
        gate[row * 2 + 1] = g2;
      }
      __syncthreads();
    }
  }
}

constexpr int RSTR = 136;
__device__ __forceinline__ float log_sigmoid(float x) { return -log1pf(expf(-x)); }
__device__ __forceinline__ uint2 lds_tr16(const u16* ptr) {
  typedef short s16x4 __attribute__((ext_vector_type(4)));
  const s16x4 v = __builtin_amdgcn_ds_read_tr16_b64_v4i16((LAS s16x4*)ptr);
  return __builtin_bit_cast(uint2, v);
}
__device__ __forceinline__ uint4 lds_frag_T(const u16* tile, int rs, int k0, int c0, int lane) {
  const int g = lane >> 4, q = (lane & 15) >> 2, pp = lane & 3;
  const u16* a = tile + (k0 + 8 * g + q) * rs + c0 + 4 * pp;
  const uint2 lo = lds_tr16(a), hi = lds_tr16(a + 4 * rs);
  return make_uint4(lo.x, lo.y, hi.x, hi.y);
}
__device__ __forceinline__ void ret_load_tile(u16* dst0, u16* dst1, const u16* src, int t0, int h, const float* w0, const float* w1) {
  for (int c = tidx(); c < 128 * 16; c += NTHR) {
    const int i = c >> 4, ch = (c & 15) * 8;
    const uint4 v = *(const uint4*)(src + (size_t)(t0 + i) * 512 + h * 128 + ch);
    if (w0) {
      const float a = w0[i], b = w1[i];
      const float f[8] = {lo16(v.x), hi16(v.x), lo16(v.y), hi16(v.y), lo16(v.z), hi16(v.z), lo16(v.w), hi16(v.w)};
      *(uint4*)(dst0 + i * RSTR + ch) = make_uint4(pk2(f[0] * a, f[1] * a), pk2(f[2] * a, f[3] * a), pk2(f[4] * a, f[5] * a), pk2(f[6] * a, f[7] * a));
      *(uint4*)(dst1 + i * RSTR + ch) = make_uint4(pk2(f[0] * b, f[1] * b), pk2(f[2] * b, f[3] * b), pk2(f[4] * b, f[5] * b), pk2(f[6] * b, f[7] * b));
    } else *(uint4*)(dst0 + i * RSTR + ch) = v;
  }
}
template <int MB_, int NB_, bool ATR, bool BTR>
__device__ __forceinline__ void lds_mma(f32x4 (&acc)[MB_][NB_], const u16* sA, int sa, int a0, const u16* sB, int sb, int b0, int K, int lane, const float* sc) {
  const int fr = lane & 15, fq = lane >> 4;
  for (int k0 = 0; k0 < K; k0 += 32) {
    uint4 fa[MB_], fb[NB_];
#pragma unroll
    for (int m = 0; m < MB_; ++m) {
      if constexpr (ATR) fa[m] = lds_frag_T(sA, sa, k0, a0 + m * 16, lane);
      else fa[m] = *(const uint4*)(sA + (a0 + m * 16 + fr) * sa + k0 + fq * 8);
      if (sc) {
        const float f = sc[m];
        fa[m].x = pk2(lo16(fa[m].x) * f, hi16(fa[m].x) * f); fa[m].y = pk2(lo16(fa[m].y) * f, hi16(fa[m].y) * f);
        fa[m].z = pk2(lo16(fa[m].z) * f, hi16(fa[m].z) * f); fa[m].w = pk2(lo16(fa[m].w) * f, hi16(fa[m].w) * f);
      }
    }
#pragma unroll
    for (int n = 0; n < NB_; ++n) {
      if constexpr (BTR) fb[n] = lds_frag_T(sB, sb, k0, b0 + n * 16, lane);
      else fb[n] = *(const uint4*)(sB + (b0 + n * 16 + fr) * sb + k0 + fq * 8);
    }
#pragma unroll
    for (int m = 0; m < MB_; ++m)
#pragma unroll
      for (int n = 0; n < NB_; ++n) acc[m][n] = mfma16(fb[n], fa[m], acc[m][n]);
  }
}
__device__ __forceinline__ void phase_ret_inc_mfma(const P& p, char* smem) {
  u16* sKf = (u16*)smem; u16* sKb = sKf + 128 * RSTR; u16* sV = sKb + 128 * RSTR; float* sWf = (float*)(sV + 128 * RSTR); float* sWb = sWf + 128;
  const u16* kb = (const u16*)(p.ws + WS_Z) + (size_t)1 * T_TOK * 512; const u16* vb = (const u16*)(p.ws + WS_Z) + (size_t)2 * T_TOK * 512;
  float* incf = (float*)(p.ws + WS_INC); float* incb = incf + (size_t)512 * 16384;
  const int tid = tidx(), lane = tid & 63, wv = tid >> 6, wr = wv >> 1, wc = wv & 1, fr = lane & 15, fq = lane >> 4;
  for (int item = blockIdx.x; item < 512; item += gridDim.x) {
    const int h = item & 3, bn = item >> 2, t0 = bn * 128;
    const float lgf = log_sigmoid(p.ret_decay[h]), lgb = log_sigmoid(p.ret_decay[4 + h]);
    __syncthreads();
    if (tid < 128) { sWf[tid] = expf(lgf * (float)(127 - tid)); sWb[tid] = expf(lgb * (float)tid); }
    __syncthreads();
    ret_load_tile(sKf, sKb, kb, t0, h, sWf, sWb);
    ret_load_tile(sV, nullptr, vb, t0, h, nullptr, nullptr);
    __syncthreads();
#pragma unroll
    for (int dirn = 0; dirn < 2; ++dirn) {
      f32x4 acc[2][4];
#pragma unroll
      for (int m = 0; m < 2; ++m)
#pragma unroll
        for (int n = 0; n < 4; ++n) acc[m][n] = (f32x4){0.f, 0.f, 0.f, 0.f};
      lds_mma<2, 4, true, true>(acc, sV, RSTR, wr * 32, dirn ? sKb : sKf, RSTR, wc * 64, 128, lane, nullptr);
      float* o = (dirn ? incb : incf) + (size_t)item * 16384;
#pragma unroll
      for (int m = 0; m < 2; ++m)
#pragma unroll
        for (int n = 0; n < 4; ++n) *(f32x4*)(o + (wr * 32 + m * 16 + fr) * 128 + wc * 64 + n * 16 + 4 * fq) = acc[m][n];
    }
  }
}
__device__ __forceinline__ void phase_ret_scan16(const P& p) {
  const float* incf = (const float*)(p.ws + WS_INC); const float* incb = incf + (size_t)512 * 16384;
  u16* spf = (u16*)(p.ws + WS_SP16); u16* spb = spf + (size_t)512 * 16384;
  const int gtid = blockIdx.x * NTHR + tidx(), gsz = gridDim.x * NTHR;
  for (int idx = gtid; idx < 32 * 4096; idx += gsz) {
    const int de = (idx & 4095) * 4, bh = idx >> 12, b = bh >> 2, h = bh & 3;
    const float Gf = expf(128.0f * log_sigmoid(p.ret_decay[h])), Gb = expf(128.0f * log_sigmoid(p.ret_decay[4 + h]));
    f32x4 s = {0.f, 0.f, 0.f, 0.f};
    for (int n = 0; n < 16; ++n) {
      const size_t o = ((size_t)((b * 16 + n) * 4 + h)) * 16384 + de;
      const f32x4 t = *(const f32x4*)(incf + o);
      uint2 w; w.x = pk2(s[0], s[1]); w.y = pk2(s[2], s[3]); *(uint2*)(spf + o) = w;
      s = s * Gf + t;
    }
    s = (f32x4){0.f, 0.f, 0.f, 0.f};
    for (int n = 15; n >= 0; --n) {
      const size_t o = ((size_t)((b * 16 + n) * 4 + h)) * 16384 + de;
      const f32x4 t = *(const f32x4*)(incb + o);
      uint2 w; w.x = pk2(s[0], s[1]); w.y = pk2(s[2], s[3]); *(uint2*)(spb + o) = w;
      s = s * Gb + t;
    }
  }
}
__device__ __forceinline__ void phase_ret_out_mfma(const P& p, char* smem) {
  u16* R0 = (u16*)smem; u16* R1 = R0 + 128 * RSTR; u16* R2 = R1 + 128 * RSTR; u16* R3 = R2 + 128 * RSTR;
  float* sPf = (float*)(R3 + 128 * RSTR); float* sPb = sPf + 132;
  const u16* zb = (const u16*)(p.ws + WS_Z);
  const u16* qb = zb; const u16* kb = zb + (size_t)1 * T_TOK * 512; const u16* vb = zb + (size_t)2 * T_TOK * 512; const u16* gb = zb + (size_t)3 * T_TOK * 512;
  const u16* spf = (const u16*)(p.ws + WS_SP16); const u16* spb = spf + (size_t)512 * 16384;
  u16* ycat = (u16*)(p.ws + WS_YCAT);
  const int tid = tidx(), lane = tid & 63, wv = tid >> 6, wr = wv >> 1, wc = wv & 1, fr = lane & 15, fq = lane >> 4;
  for (int item = blockIdx.x; item < 512; item += gridDim.x) {
    const int h = item & 3, bn = item >> 2, t0 = bn * 128;
    const float lgf = log_sigmoid(p.ret_decay[h]), lgb = log_sigmoid(p.ret_decay[4 + h]);
    __syncthreads();
    ret_load_tile(R0, nullptr, qb, t0, h, nullptr, nullptr);
    ret_load_tile(R1, nullptr, kb, t0, h, nullptr, nullptr);
    ret_load_tile(R2, nullptr, vb, t0, h, nullptr, nullptr);
    if (tid < 129) { sPf[tid] = expf(lgf * (float)tid); sPb[tid] = expf(lgb * (float)tid); }
    __syncthreads();
    {
      f32x4 acc[2][4];
#pragma unroll
      for (int m = 0; m < 2; ++m)
#pragma unroll
        for (int n = 0; n < 4; ++n) acc[m][n] = (f32x4){0.f, 0.f, 0.f, 0.f};
      lds_mma<2, 4, false, false>(acc, R0, RSTR, wr * 32, R1, RSTR, wc * 64, 128, lane, nullptr);
#pragma unroll
      for (int m = 0; m < 2; ++m)
#pragma unroll
        for (int n = 0; n < 4; ++n) {
          const int i = wr * 32 + m * 16 + fr, j = wc * 64 + n * 16 + 4 * fq;
          float v[4];
#pragma unroll
          for (int r = 0; r < 4; ++r) { const int jj = j + r; v[r] = acc[m][n][r] * ((i >= jj) ? sPf[i - jj] : sPb[jj - i]); }
          uint2 w; w.x = pk2(v[0], v[1]); w.y = pk2(v[2], v[3]);
          *(uint2*)(R3 + i * RSTR + j) = w;
        }
    }
    __syncthreads();
    const u16* spT = spf + (size_t)item * 16384; const u16* snT = spb + (size_t)item * 16384;
    for (int c = tid; c < 128 * 16; c += NTHR) { const int e = c >> 4, ch = (c & 15) * 8; *(uint4*)(R1 + e * RSTR + ch) = *(const uint4*)(spT + e * 128 + ch); }
    f32x4 o[1][8];
#pragma unroll
    for (int m = 0; m < 1; ++m)
#pragma unroll
      for (int n = 0; n < 8; ++n) o[m][n] = (f32x4){0.f, 0.f, 0.f, 0.f};
    lds_mma<1, 8, false, true>(o, R3, RSTR, wv * 16, R2, RSTR, 0, 128, lane, nullptr);
    __syncthreads();
    for (int c = tid; c < 128 * 16; c += NTHR) { const int e = c >> 4, ch = (c & 15) * 8; *(uint4*)(R2 + e * RSTR + ch) = *(const uint4*)(snT + e * 128 + ch); }
    float scf[1], scb[1];
    { const int i = wv * 16 + fr; scf[0] = sPf[i + 1]; scb[0] = sPb[128 - i]; }
    lds_mma<1, 8, false, false>(o, R0, RSTR, wv * 16, R1, RSTR, 0, 128, lane, scf);
    __syncthreads();
    lds_mma<1, 8, false, false>(o, R0, RSTR, wv * 16, R2, RSTR, 0, 128, lane, scb);
#pragma unroll
    for (int m = 0; m < 1; ++m) {
      float s1 = 0.f;
#pragma unroll
      for (int n = 0; n < 8; ++n) s1 += (o[m][n][0] + o[m][n][1]) + (o[m][n][2] + o[m][n][3]);
      s1 += __shfl_xor(s1, 16); s1 += __shfl_xor(s1, 32);
      const float mu = s1 * (1.0f / 128.0f);
      float s2 = 0.f;
#pragma unroll
      for (int n = 0; n < 8; ++n)
#pragma unroll
        for (int r = 0; r < 4; ++r) { const float dl = o[m][n][r] - mu; s2 += dl * dl; }
      s2 += __shfl_xor(s2, 16); s2 += __shfl_xor(s2, 32);
      const float rs = rsqrtf(s2 * (1.0f / 128.0f) + 1e-5f);
      const size_t tok = (size_t)(t0 + wv * 16 + m * 16 + fr);
#pragma unroll
      for (int n = 0; n < 8; ++n) {
        const int e = n * 16 + 4 * fq;
        const uint2 gq = *(const uint2*)(gb + tok * 512 + h * 128 + e);
        const float g0 = lo16(gq.x), g1 = hi16(gq.x), g2 = lo16(gq.y), g3 = hi16(gq.y);
        uint2 w;
        w.x = pk2(g0 * sigmoidf_(g0) * (o[m][n][0] - mu) * rs, g1 * sigmoidf_(g1) * (o[m][n][1] - mu) * rs);
        w.y = pk2(g2 * sigmoidf_(g2) * (o[m][n][2] - mu) * rs, g3 * sigmoidf_(g3) * (o[m][n][3] - mu) * rs);
        *(uint2*)(ycat + tok * DM + h * 128 + e) = w;
      }
    }
  }
}

struct Cpx { float re, im; };
__device__ __forceinline__ Cpx cmul(Cpx a, Cpx b) { return {a.re * b.re - a.im * b.im, a.re * b.im + a.im * b.re}; }
__device__ __forceinline__ Cpx s5_lam_pow(float ar, float ai, float dt, float e) {
  const float mag = expf(ar * dt * e); float sn, cs; sincosf(ai * dt * e, &sn, &cs); return {mag * cs, mag * sn};
}
__device__ __forceinline__ Cpx s5_coef(float ar, float ai, float dt) {
  float sn, cs; sincosf(ai * dt, &sn, &cs);
  const float em1 = expm1f(ar * dt), sh = sinf(0.5f * ai * dt);
  const float nr = em1 * cs - 2.0f * sh * sh, ni = (em1 + 1.0f) * sn, den = ar * ar + ai * ai;
  return {(nr * ar + ni * ai) / den, (ni * ar - nr * ai) / den};
}
__device__ __forceinline__ void phase_s5_ktab(const P& p) {
  float* ktab = (float*)(p.ws + WS_KTAB);
  const int gtid = blockIdx.x * NTHR + tidx(), gsz = gridDim.x * NTHR;
  for (int item = gtid; item < 32 * 2 * 32 * 16; item += gsz) {
    const int c = item & 15, l = (item >> 4) & 31, dir = (item >> 9) & 1, g = item >> 10;
    const float dt = expf(p.log_step[dir * 32 + g]);
    float acc[16];
#pragma unroll
    for (int j = 0; j < 16; ++j) acc[j] = 0.f;
    for (int q = 0; q < 64; ++q) {
      const float ar = p.a_re[(dir * 32 + g) * 64 + q], ai = p.a_im[(dir * 32 + g) * 64 + q];
      const Cpx L = s5_lam_pow(ar, ai, dt, (float)l), cf = s5_coef(ar, ai, dt);
      const Cpx C = {p.c_re[((dir * 32 + g) * 16 + c) * 64 + q], p.c_im[((dir * 32 + g) * 16 + c) * 64 + q]};
      const Cpx w = cmul(cmul(C, L), cf);
#pragma unroll
      for (int j = 0; j < 16; ++j) acc[j] += w.re * p.b_re[(g * 64 + q) * 16 + j] - w.im * p.b_im[(g * 64 + q) * 16 + j];
    }
#pragma unroll
    for (int j = 0; j < 16; j += 4) *(f32x4*)(ktab + (size_t)item * 16 + j) = (f32x4){acc[j], acc[j + 1], acc[j + 2], acc[j + 3]};
  }
}
__device__ __forceinline__ void phase_s5_fill(const P& p) {
  const float* ktab = (const float*)(p.ws + WS_KTAB);
  u16* bty = (u16*)(p.ws + WS_BTY); u16* wet = (u16*)(p.ws + WS_WET);
  const int gtid = blockIdx.x * NTHR + tidx(), gsz = gridDim.x * NTHR;
  for (int item = gtid; item < 32 * 512 * 64; item += gsz) {
    const int ch = item & 63, n = (item >> 6) & 511, g = item >> 15;
    const int ip = ch >> 1, c0 = (ch & 1) * 8, i = n >> 4, c = n & 15;
    float v[8];
    if (ip != i) {
      const int dir = ip < i ? 0 : 1, l = ip < i ? i - ip : ip - i;
      const float* src = ktab + ((size_t)((g * 2 + dir) * 32 + l) * 16 + c) * 16 + c0;
      const f32x4 a = *(const f32x4*)src, b = *(const f32x4*)(src + 4);
      v[0] = a[0]; v[1] = a[1]; v[2] = a[2]; v[3] = a[3]; v[4] = b[0]; v[5] = b[1]; v[6] = b[2]; v[7] = b[3];
    } else {
      const float* s0 = ktab + ((size_t)((g * 2 + 0) * 32) * 16 + c) * 16 + c0;
      const float* s1 = ktab + ((size_t)((g * 2 + 1) * 32) * 16 + c) * 16 + c0;
      const float dd = p.s5d[g * 16 + c];
#pragma unroll
      for (int j = 0; j < 8; ++j) v[j] = s0[j] + s1[j] + ((c0 + j) == c ? dd : 0.f);
    }
    *(uint4*)(bty + ((size_t)g * 512 + n) * 768 + ch * 8) = make_uint4(pk2(v[0], v[1]), pk2(v[2], v[3]), pk2(v[4], v[5]), pk2(v[6], v[7]));
  }
  for (int item = gtid; item < 32 * 512 * 32; item += gsz) {
    const int ch = item & 31, n = (item >> 5) & 511, g = item >> 14;
    const int kk = ch * 8, dir = kk >> 7, p0 = (kk & 127) >> 1, i = n >> 4, c = n & 15;
    const float dt = expf(p.log_step[dir * 32 + g]), e = dir ? (float)(32 - i) : (float)(i + 1);
    float v[8];
#pragma unroll
    for (int q = 0; q < 4; ++q) {
      const int pq = p0 + q;
      const float ar = p.a_re[(dir * 32 + g) * 64 + pq], ai = p.a_im[(dir * 32 + g) * 64 + pq];
      const Cpx L = s5_lam_pow(ar, ai, dt, e);
      const Cpx C = {p.c_re[((dir * 32 + g) * 16 + c) * 64 + pq], p.c_im[((dir * 32 + g) * 16 + c) * 64 + pq]};
      const Cpx w = cmul(C, L);
      v[2 * q] = w.re; v[2 * q + 1] = -w.im;
    }
    *(uint4*)(bty + ((size_t)g * 512 + n) * 768 + 512 + kk) = make_uint4(pk2(v[0], v[1]), pk2(v[2], v[3]), pk2(v[4], v[5]), pk2(v[6], v[7]));
  }
  for (int item = gtid; item < 32 * 256 * 64; item += gsz) {
    const int ch = item & 63, n = (item >> 6) & 255, g = item >> 14;
    const int ip = ch >> 1, c0 = (ch & 1) * 8, ri = n & 1, pq = (n >> 1) & 63, dir = n >> 7;
    const float dt = expf(p.log_step[dir * 32 + g]), e = dir ? (float)ip : (float)(31 - ip);
    const float ar = p.a_re[(dir * 32 + g) * 64 + pq], ai = p.a_im[(dir * 32 + g) * 64 + pq];
    const Cpx w = cmul(s5_lam_pow(ar, ai, dt, e), s5_coef(ar, ai, dt));
    float v[8];
#pragma unroll
    for (int j = 0; j < 8; ++j) {
      const float br = p.b_re[(g * 64 + pq) * 16 + c0 + j], bi = p.b_im[(g * 64 + pq) * 16 + c0 + j];
      v[j] = ri ? (w.re * bi + w.im * br) : (w.re * br - w.im * bi);
    }
    *(uint4*)(wet + ((size_t)g * 256 + n) * 512 + ch * 8) = make_uint4(pk2(v[0], v[1]), pk2(v[2], v[3]), pk2(v[4], v[5]), pk2(v[6], v[7]));
  }
}
__device__ __forceinline__ void phase_s5_carry(const P& p) {
  const float* E = (const float*)(p.ws + WS_E);
  u16* a2 = (u16*)(p.ws + WS_A2);
  const int gtid = blockIdx.x * NTHR + tidx(), gsz = gridDim.x * NTHR;
  for (int idx = gtid; idx < 32 * 8 * 128; idx += gsz) {
    const int pq = idx & 63, dir = (idx >> 6) & 1, b = (idx >> 7) & 7, g = idx >> 10;
    const float dt = expf(p.log_step[dir * 32 + g]);
    const Cpx L = s5_lam_pow(p.a_re[(dir * 32 + g) * 64 + pq], p.a_im[(dir * 32 + g) * 64 + pq], dt, 32.0f);
    Cpx s = {0.f, 0.f};
    for (int jj = 0; jj < 64; ++jj) {
      const int j = dir ? 63 - jj : jj, r = b * 64 + j;
      const f32x2 e = *(const f32x2*)(E + ((size_t)g * 512 + r) * 256 + (dir * 64 + pq) * 2);
      *(unsigned*)(a2 + ((size_t)g * 512 + r) * 768 + 512 + (dir * 64 + pq) * 2) = pk2(s.re, s.im);
      const Cpx ns = cmul(L, s);
      s.re = ns.re + e[0]; s.im = ns.im + e[1];
    }
  }
}
constexpr int KSTR = 72;
__device__ __forceinline__ int t5_bucket_abs(int n) {
  return n < 8 ? n : 8 + (n >= 12) + (n >= 16) + (n >= 23) + (n >= 32) + (n >= 46) + (n >= 64) + (n >= 91);
}
constexpr int VSTR = 392;
__device__ __forceinline__ void phase_attn(const P& p, char* smem) {
  u16* sK = (u16*)smem; u16* sV = sK + 384 * KSTR; float* sBias = (float*)(sV + 384 * KSTR);
  const u16* q1 = (const u16*)(p.ws + WS_Z); const u16* k1 = (const u16*)(p.ws + WS_Z + 32 * MB); const u16* v1 = (const u16*)(p.ws + WS_Z + 40 * MB);
  u16* ao = (u16*)(p.ws + WS_YCAT);
  const int tid = tidx(), lane = tid & 63, wv = tid >> 6, fr = lane & 15, lg = lane >> 4, q0 = wv * 16;
  for (int item = blockIdx.x; item < 512; item += gridDim.x) {
    const int b = item >> 6, nb = (item >> 2) & 15, kvh = item & 3;
    __syncthreads();
    for (int c = tid; c < 384 * 8; c += NTHR) {
      const int s = c >> 3, ch = (c & 7) * 8, pos = (nb - 1) * 128 + s;
      uint4 kq = make_uint4(0u, 0u, 0u, 0u), vq = kq;
      if (pos >= 0 && pos < SEQ) { kq = *(const uint4*)(k1 + (size_t)(b * SEQ + pos) * 256 + kvh * 64 + ch); vq = *(const uint4*)(v1 + (size_t)(b * SEQ + pos) * 256 + kvh * 64 + ch); }
      *(uint4*)(sK + s * KSTR + ch) = kq; *(uint4*)(sV + s * KSTR + ch) = vq;
    }
    for (int c = tid; c < 4 * 257; c += NTHR) {
      const int hq = c / 257, ri = c % 257, rel = ri - 128, n = rel < 0 ? -rel : rel;
      const int bucket = (rel > 0 ? 16 : 0) + t5_bucket_abs(n);
      sBias[hq * 260 + ri] = p.rel_bias[bucket * 16 + kvh * 4 + hq];
    }
    __syncthreads();
    for (int hq = 0; hq < 4; ++hq) {
      const int head = kvh * 4 + hq;
      const size_t tok0 = (size_t)b * SEQ + nb * 128 + q0;
      uint4 qf[1][2];
#pragma unroll
      for (int qb = 0; qb < 1; ++qb)
#pragma unroll
        for (int ks = 0; ks < 2; ++ks) qf[qb][ks] = *(const uint4*)(q1 + (tok0 + qb * 16 + fr) * DM + head * 64 + ks * 32 + lg * 8);
      f32x4 O[4][1];
#pragma unroll
      for (int mb = 0; mb < 4; ++mb)
#pragma unroll
        for (int qb = 0; qb < 1; ++qb) O[mb][qb] = (f32x4){0.f, 0.f, 0.f, 0.f};
      const float sinkv = p.sink[head];
      float mrun[1] = {sinkv}, lpart[1] = {lg == 0 ? 1.0f : 0.0f};
#pragma unroll
      for (int c = 0; c < 3; ++c) {
        if ((c == 0 && nb == 0) || (c == 2 && nb == 15)) continue;
        f32x4 S[8][1];
#pragma unroll
        for (int kb = 0; kb < 8; ++kb) {
          S[kb][0] = (f32x4){0.f, 0.f, 0.f, 0.f};
          const bool act = (c == 0) ? (16 * kb + 15 >= q0) : ((c == 2) ? (16 * kb <= q0 + 15) : true);
          if (act) {
#pragma unroll
            for (int ks = 0; ks < 2; ++ks) {
              const uint4 kf = *(const uint4*)(sK + (c * 128 + kb * 16 + fr) * KSTR + ks * 32 + lg * 8);
              S[kb][0] = mfma16(kf, qf[0][ks], S[kb][0]);
            }
          }
        }
        float cmax[1] = {-1e30f};
#pragma unroll
        for (int kb = 0; kb < 8; ++kb)
#pragma unroll
          for (int qb = 0; qb < 1; ++qb)
#pragma unroll
            for (int r = 0; r < 4; ++r) {
              const int sidx = c * 128 + kb * 16 + 4 * lg + r, qi = q0 + qb * 16 + fr, rel = sidx - 128 - qi;
              const bool valid = (rel >= -128) && (rel <= 128);
              const float v = valid ? S[kb][qb][r] + sBias[hq * 260 + (valid ? rel + 128 : 0)] : -1e30f;
              S[kb][qb][r] = v; cmax[qb] = fmaxf(cmax[qb], v);
            }
#pragma unroll
        for (int qb = 0; qb < 1; ++qb) {
          cmax[qb] = fmaxf(cmax[qb], __shfl_xor(cmax[qb], 16)); cmax[qb] = fmaxf(cmax[qb], __shfl_xor(cmax[qb], 32));
          const float mn = fmaxf(mrun[qb], cmax[qb]), alpha = __expf(mrun[qb] - mn);
          mrun[qb] = mn; lpart[qb] *= alpha;
#pragma unroll
          for (int mb = 0; mb < 4; ++mb) O[mb][qb] = O[mb][qb] * alpha;
          float ps = 0.f;
#pragma unroll
          for (int kb = 0; kb < 8; ++kb)
#pragma unroll
            for (int r = 0; r < 4; ++r) { const float e = __expf(S[kb][qb][r] - mn); S[kb][qb][r] = e; ps += e; }
          lpart[qb] += ps;
        }
#pragma unroll
        for (int kk = 0; kk < 4; ++kk) {
          const int kb0 = 2 * kk, kb1 = 2 * kk + 1;
          const bool act = (c == 0) ? (16 * kb1 + 15 >= q0) : ((c == 2) ? (16 * kb0 <= q0 + 15) : true);
          if (act) {
            uint4 pf[1];
#pragma unroll
            for (int qb = 0; qb < 1; ++qb) pf[qb] = make_uint4(pk2(S[kb0][qb][0], S[kb0][qb][1]), pk2(S[kb0][qb][2], S[kb0][qb][3]), pk2(S[kb1][qb][0], S[kb1][qb][1]), pk2(S[kb1][qb][2], S[kb1][qb][3]));
#pragma unroll
            for (int mb = 0; mb < 4; ++mb) {
              const int tq = (lane & 15) >> 2, tp = lane & 3;
              const uint2 v0 = lds_tr16(sV + (c * 128 + kb0 * 16 + 4 * lg + tq) * KSTR + mb * 16 + 4 * tp);
              const uint2 v1r = lds_tr16(sV + (c * 128 + kb1 * 16 + 4 * lg + tq) * KSTR + mb * 16 + 4 * tp);
              const uint4 vf = make_uint4(v0.x, v0.y, v1r.x, v1r.y);
              O[mb][0] = mfma16(vf, pf[0], O[mb][0]);
            }
          }
        }
      }
#pragma unroll
      for (int qb = 0; qb < 1; ++qb) {
        float lt = lpart[qb]; lt += __shfl_xor(lt, 16); lt += __shfl_xor(lt, 32);
        const float inv = 1.0f / lt;
#pragma unroll
        for (int mb = 0; mb < 4; ++mb) {
          uint2 w; w.x = pk2(O[mb][qb][0] * inv, O[mb][qb][1] * inv); w.y = pk2(O[mb][qb][2] * inv, O[mb][qb][3] * inv);
          *(uint2*)(ao + (tok0 + qb * 16 + fr) * DM + head * 64 + mb * 16 + 4 * lg) = w;
        }
      }
    }
  }
}

struct EpiInproj {
  u16* zb; u16* a2; const f32x2* rope;
  __device__ __forceinline__ void operator()(const f32x4 (&acc)[2][2][4][2], const pg8::Unit& u, int wr, int wc, int fr, int fq) const {
    const int seg = u.pn >> 1;
#pragma unroll
    for (int ai = 0; ai < 2; ++ai)
#pragma unroll
      for (int m = 0; m < 4; ++m) {
        const int row = u.pm * 256 + ai * 128 + wr * 64 + m * 16 + fr;
        if (seg < 2) {
          const int d = 16 * wc + 4 * fq;
          const f32x2* cs = rope + (size_t)(row & (SEQ - 1)) * 64 + d;
          const f32x4 c01 = *(const f32x4*)cs, c23 = *(const f32x4*)(cs + 2);
          const float cv[4] = {c01[0], c01[2], c23[0], c23[2]}, sv[4] = {c01[1], c01[3], c23[1], c23[3]};
          const float sc = seg == 1 ? 0.08838834764831845f : 1.0f;
#pragma unroll
          for (int bj = 0; bj < 2; ++bj) {
            const f32x4 x1 = acc[ai][bj][m][0], x2 = acc[ai][bj][m][1];
            float o1[4], o2[4];
#pragma unroll
            for (int r = 0; r < 4; ++r) { o1[r] = (x1[r] * cv[r] - x2[r] * sv[r]) * sc; o2[r] = (x1[r] * sv[r] + x2[r] * cv[r]) * sc; }
            u16* dst = zb + (size_t)seg * T_TOK * 512 + (size_t)row * 512 + ((u.pn & 1) * 2 + bj) * 128 + d;
            uint2 w; w.x = pk2(o1[0], o1[1]); w.y = pk2(o1[2], o1[3]); *(uint2*)dst = w;
            w.x = pk2(o2[0], o2[1]); w.y = pk2(o2[2], o2[3]); *(uint2*)(dst + 64) = w;
          }
        } else {
#pragma unroll
          for (int bj = 0; bj < 2; ++bj)
#pragma unroll
            for (int n = 0; n < 2; ++n) {
              const int col = u.pn * 256 + bj * 128 + wc * 32 + n * 16 + 4 * fq;
              const f32x4 v = acc[ai][bj][m][n];
              uint2 w; w.x = pk2(v[0], v[1]); w.y = pk2(v[2], v[3]);
              if (seg < 4) *(uint2*)(zb + (size_t)seg * T_TOK * 512 + (size_t)row * 512 + (col - seg * 512)) = w;
              else { const int ch = col - 2048, gi = ch >> 4, c = ch & 15; *(uint2*)(a2 + ((size_t)gi * 512 + (row >> 5)) * 768 + (row & 31) * 16 + c) = w; }
            }
        }
      }
  }
};
__device__ __forceinline__ void phase_inproj(const P& p, LAS unsigned char* lds) {
  pg8::DenseOrder S; S.init(p.ws + WS_XB, DM, p.ws + WS_WIN, T_TOK, 2560, DM);
  EpiInproj E{(u16*)(p.ws + WS_Z), (u16*)(p.ws + WS_A2), (const f32x2*)(p.ws + WS_ROPE)};
  pg8::gemm_phase<EpiInproj, pg8::DenseOrder, G_ALIGN, G_SP2>(lds, DM, S, E);
}
struct EpiS5E {
  float* E_;
  __device__ __forceinline__ void operator()(const f32x4 (&acc)[2][2][4][2], const pg8::Unit& u, int wr, int wc, int fr, int fq) const {
#pragma unroll
    for (int ai = 0; ai < 2; ++ai)
#pragma unroll
      for (int m = 0; m < 4; ++m) {
        const int row = u.pm * 256 + ai * 128 + wr * 64 + m * 16 + fr;
#pragma unroll
        for (int bj = 0; bj < 2; ++bj)
#pragma unroll
          for (int n = 0; n < 2; ++n) *(f32x4*)(E_ + ((size_t)u.e * 512 + row) * 256 + bj * 128 + wc * 32 + n * 16 + 4 * fq) = acc[ai][bj][m][n];
      }
  }
};
__device__ __forceinline__ void phase_s5_egemm(const P& p, LAS unsigned char* lds) {
  pg8::GroupOrder S; S.init(p.ws + WS_A2, 768, (size_t)512 * 768, p.ws + WS_WET, (size_t)256 * 512, 32, 512, 256, 512);
  EpiS5E E{(float*)(p.ws + WS_E)};
  pg8::gemm_phase<EpiS5E, pg8::GroupOrder, G_ALIGN, G_SP2>(lds, 512, S, E);
}
struct EpiS5Y {
  u16* yg;
  __device__ __forceinline__ void operator()(const f32x4 (&acc)[2][2][4][2], const pg8::Unit& u, int wr, int wc, int fr, int fq) const {
#pragma unroll
    for (int ai = 0; ai < 2; ++ai)
#pragma unroll
      for (int m = 0; m < 4; ++m) {
        const int row = u.pm * 256 + ai * 128 + wr * 64 + m * 16 + fr;
#pragma unroll
        for (int bj = 0; bj < 2; ++bj)
#pragma unroll
          for (int n = 0; n < 2; ++n) {
            const int col = u.pn * 256 + bj * 128 + wc * 32 + n * 16 + 4 * fq;
            const f32x4 v = acc[ai][bj][m][n];
            uint2 w; w.x = pk2(gelu_tanh(v[0]), gelu_tanh(v[1])); w.y = pk2(gelu_tanh(v[2]), gelu_tanh(v[3]));
            *(uint2*)(yg + ((size_t)row * 32 + (col >> 4)) * 512 + u.e * 16 + (col & 15)) = w;
          }
      }
  }
};
__device__ __forceinline__ void phase_s5_ygemm(const P& p, LAS unsigned char* lds) {
  pg8::GroupOrder S; S.init(p.ws + WS_A2, 768, (size_t)512 * 768, p.ws + WS_BTY, (size_t)512 * 768, 32, 512, 512, 768);
  EpiS5Y E{(u16*)(p.ws + WS_YGELU)};
  pg8::gemm_phase<EpiS5Y, pg8::GroupOrder, G_ALIGN, G_SP2>(lds, 768, S, E);
}
struct EpiGlu {
  const u16* yg; const float* bglu; u16* ycat;
  __device__ __forceinline__ void operator()(const f32x4 (&acc)[2][2][4][2], const pg8::Unit& u, int wr, int wc, int fr, int fq) const {
#pragma unroll
    for (int ai = 0; ai < 2; ++ai)
#pragma unroll
      for (int m = 0; m < 4; ++m) {
        const int row = u.pm * 256 + ai * 128 + wr * 64 + m * 16 + fr;
#pragma unroll
        for (int bj = 0; bj < 2; ++bj)
#pragma unroll
          for (int n = 0; n < 2; ++n) {
            const int col = u.pn * 256 + bj * 128 + wc * 32 + n * 16 + 4 * fq;
            const f32x4 v = acc[ai][bj][m][n];
            const uint2 yv = *(const uint2*)(yg + (size_t)row * 512 + col);
            const f32x4 bb = *(const f32x4*)(bglu + col);
            uint2 w;
            w.x = pk2(lo16(yv.x) * sigmoidf_(v[0] + bb[0]), hi16(yv.x) * sigmoidf_(v[1] + bb[1]));
            w.y = pk2(lo16(yv.y) * sigmoidf_(v[2] + bb[2]), hi16(yv.y) * sigmoidf_(v[3] + bb[3]));
            *(uint2*)(ycat + (size_t)row * DM + 512 + col) = w;
          }
      }
  }
};
__device__ __forceinline__ void phase_glu(const P& p, LAS unsigned char* lds) {
  pg8::DenseOrder S; S.init(p.ws + WS_YGELU, 512, p.ws + WS_WGLU, T_TOK, 512, 512);
  EpiGlu E{(const u16*)(p.ws + WS_YGELU), p.b_glu, (u16*)(p.ws + WS_YCAT)};
  pg8::gemm_phase<EpiGlu, pg8::DenseOrder, G_ALIGN, G_SP2>(lds, 512, S, E);
}
struct EpiResid {
  const float* xin; float* xout;
  __device__ __forceinline__ void operator()(const f32x4 (&acc)[2][2][4][2], const pg8::Unit& u, int wr, int wc, int fr, int fq) const {
#pragma unroll
    for (int ai = 0; ai < 2; ++ai)
#pragma unroll
      for (int m = 0; m < 4; ++m) {
        const int row = u.pm * 256 + ai * 128 + wr * 64 + m * 16 + fr;
#pragma unroll
        for (int bj = 0; bj < 2; ++bj)
#pragma unroll
          for (int n = 0; n < 2; ++n) {
            const size_t o = (size_t)row * DM + u.pn * 256 + bj * 128 + wc * 32 + n * 16 + 4 * fq;
            const f32x4 xv = *(const f32x4*)(xin + o);
            *(f32x4*)(xout + o) = xv + acc[ai][bj][m][n];
          }
      }
  }
};
__device__ __forceinline__ void phase_outproj(const P& p, const void* Wt, const float* xin, float* xout, LAS unsigned char* lds) {
  pg8::DenseOrder S; S.init(p.ws + WS_YCAT, DM, Wt, T_TOK, DM, DM);
  EpiResid E{xin, xout};
  pg8::gemm_phase<EpiResid, pg8::DenseOrder, G_ALIGN, G_SP2>(lds, DM, S, E);
}
struct EpiQkv {
  u16 *q1, *k1, *v1;
  __device__ __forceinline__ void operator()(const f32x4 (&acc)[2][2][4][2], const pg8::Unit& u, int wr, int wc, int fr, int fq) const {
#pragma unroll
    for (int ai = 0; ai < 2; ++ai)
#pragma unroll
      for (int m = 0; m < 4; ++m) {
        const int row = u.pm * 256 + ai * 128 + wr * 64 + m * 16 + fr;
#pragma unroll
        for (int bj = 0; bj < 2; ++bj)
#pragma unroll
          for (int n = 0; n < 2; ++n) {
            const int col = u.pn * 256 + bj * 128 + wc * 32 + n * 16 + 4 * fq;
            const f32x4 v = acc[ai][bj][m][n];
            uint2 w;
            if (u.pn < 4) { w.x = pk2(v[0] * 0.125f, v[1] * 0.125f); w.y = pk2(v[2] * 0.125f, v[3] * 0.125f); *(uint2*)(q1 + (size_t)row * DM + col) = w; }
            else {
              w.x = pk2(v[0], v[1]); w.y = pk2(v[2], v[3]);
              if (u.pn == 4) *(uint2*)(k1 + (size_t)row * 256 + (col - 1024)) = w; else *(uint2*)(v1 + (size_t)row * 256 + (col - 1280)) = w;
            }
          }
      }
  }
};
__device__ __forceinline__ void phase_qkv(const P& p, LAS unsigned char* lds) {
  pg8::DenseOrder S; S.init(p.ws + WS_XB, DM, p.ws + WS_WQKV, T_TOK, 1536, DM);
  EpiQkv E{(u16*)(p.ws + WS_Z), (u16*)(p.ws + WS_Z + 32 * MB), (u16*)(p.ws + WS_Z + 40 * MB)};
  pg8::gemm_phase<EpiQkv, pg8::DenseOrder, G_ALIGN, G_SP2>(lds, DM, S, E);
}
__device__ __forceinline__ void phase_moe_plan(const P& p, int layer, char* smem) {
  if (blockIdx.x != 0) return;
  using pg8::PLAN_STRIDE;
  const int tid = tidx();
  const int* cnt = (const int*)(p.ws + WS_CNT) + layer * 32;
  int* plan_n = (int*)(p.ws + WS_PLAN + layer * 65536); int4* plan = (int4*)(p.ws + WS_PLAN + layer * 65536 + 256);
  int* sc = (int*)smem;
  int* ecum = sc + 32; int* ebase = ecum + 32; int* ehb = ebase + 32; int* tot = ehb + 32;
  unsigned* keys = (unsigned*)(tot + 8);
  constexpr int NN = 4;
  __syncthreads();
  if (tid < 32) sc[tid] = cnt[tid];
  __syncthreads();
  if (tid == 0) {
    int cum = 0, ub = 0, hb = 0;
    for (int e = 0; e < 32; ++e) {
      const int c = sc[e], fl = c >> 8, rem = c & 255, rc = (rem + 63) >> 6, ntl = fl + (rem ? 1 : 0);
      ecum[e] = cum; ebase[e] = ub; ehb[e] = hb;
      cum += (fl * 4 + rc) * NN; ub += ntl * NN; hb += ntl * 256;
    }
    tot[0] = cum > 0 ? cum : 1; tot[1] = ub;
  }
  __syncthreads();
  const int total = tot[0], nunits = tot[1] < 1024 ? tot[1] : 1024;
  int4 en[2]; unsigned mykey[2];
#pragma unroll
  for (int q = 0; q < 2; ++q) {
    const int u = tid + q * NTHR;
    mykey[q] = 0xffffffffu; en[q] = make_int4(0, 0, 0, 0);
    if (u < nunits) {
      int e = 0;
      for (int j = 1; j < 32; ++j) if (ebase[j] <= u) e = j;
      const int c = sc[e], fl = c >> 8, rem = c & 255, rc = (rem + 63) >> 6, ntl = fl + (rem ? 1 : 0);
      const int local = u - ebase[e], ct = local / ntl, rt = local - ct * ntl;
      const int cum = ecum[e] + ct * (fl * 4 + rc) + rt * 4;
      const bool isfull = rt < fl;
      const int cost = isfull ? 4 : rc;
      int x = (cum * 8) / total; if (x > 7) x = 7;
      mykey[q] = ((unsigned)x << 28) | ((isfull ? 0u : 1u) << 27) | ((isfull ? 0u : (unsigned)(4 - cost)) << 24) | (unsigned)u;
      en[q] = make_int4(e | (rt << 8) | (ct << 16), c, ehb[e], 0);
      keys[u] = mykey[q];
    }
  }
  __syncthreads();
#pragma unroll
  for (int q = 0; q < 2; ++q) {
    const int u = tid + q * NTHR;
    if (u < nunits) {
      const unsigned k = mykey[q], x = k >> 28;
      int pos = 0;
      for (int v = 0; v < nunits; ++v) { const unsigned kv = keys[v]; pos += ((kv >> 28) == x && kv < k) ? 1 : 0; }
      if (pos < PLAN_STRIDE) plan[x * PLAN_STRIDE + pos] = en[q];
    }
  }
  if (tid < 8) {
    int n = 0;
    for (int v = 0; v < nunits; ++v) n += ((keys[v] >> 28) == (unsigned)tid) ? 1 : 0;
    plan_n[tid] = n < PLAN_STRIDE ? n : PLAN_STRIDE;
  }
  __syncthreads();
}
struct EpiMoe1 {
  u16* hbuf;
  __device__ __forceinline__ void operator()(const f32x4 (&acc)[2][2][4][2], const pg8::Unit& u, int wr, int wc, int fr, int fq) const {
#pragma unroll
    for (int ai = 0; ai < 2; ++ai)
#pragma unroll
      for (int m = 0; m < 4; ++m) {
        const int row = u.pm * 256 + ai * 128 + wr * 64 + m * 16 + fr;
        if (row < u.cnt) {
#pragma unroll
          for (int bj = 0; bj < 2; ++bj) {
            const f32x4 g = acc[ai][bj][m][0], up = acc[ai][bj][m][1];
            uint2 w; w.x = pk2(g[0] * sigmoidf_(g[0]) * up[0], g[1] * sigmoidf_(g[1]) * up[1]); w.y = pk2(g[2] * sigmoidf_(g[2]) * up[2], g[3] * sigmoidf_(g[3]) * up[3]);
            *(uint2*)(hbuf + (size_t)(u.hbase + row) * 512 + 16 * (8 * u.pn + 4 * bj + wc) + 4 * fq) = w;
          }
        }
      }
  }
};
__device__ __forceinline__ void phase_moe1(const P& p, int layer, LAS unsigned char* lds) {
  pg8::PlanOrder S; S.init(p.ws + WS_PLAN + layer * 65536, (const int*)(p.ws + WS_LIST), p.ws + WS_XB, DM, p.ws + WS_MW, (size_t)DM * DM, DM, true);
  EpiMoe1 E{(u16*)(p.ws + WS_H)};
  pg8::gemm_phase<EpiMoe1, pg8::PlanOrder, G_ALIGN, G_SP2>(lds, DM, S, E);
}
struct EpiMoe2 {
  const int* list; const float* gate; u16* slots;
  __device__ __forceinline__ void operator()(const f32x4 (&acc)[2][2][4][2], const pg8::Unit& u, int wr, int wc, int fr, int fq) const {
#pragma unroll
    for (int ai = 0; ai < 2; ++ai)
#pragma unroll
      for (int m = 0; m < 4; ++m) {
        const int row = u.pm * 256 + ai * 128 + wr * 64 + m * 16 + fr;
        if (row < u.cnt) {
          const int asg = list[(size_t)u.e * CAP + row];
          const float gt = gate[asg];
#pragma unroll
          for (int bj = 0; bj < 2; ++bj)
#pragma unroll
            for (int n = 0; n < 2; ++n) {
              const f32x4 v = acc[ai][bj][m][n];
              uint2 w; w.x = pk2(gt * v[0], gt * v[1]); w.y = pk2(gt * v[2], gt * v[3]);
              *(uint2*)(slots + (size_t)asg * DM + u.pn * 256 + bj * 128 + wc * 32 + n * 16 + 4 * fq) = w;
            }
        }
      }
  }
};
__device__ __forceinline__ void phase_moe2(const P& p, int layer, LAS unsigned char* lds) {
  pg8::PlanOrder S; S.init(p.ws + WS_PLAN + layer * 65536, (const int*)(p.ws + WS_LIST), p.ws + WS_H, 512, p.ws + WS_MW + 64 * MB, (size_t)DM * 512, 512, false);
  EpiMoe2 E{(const int*)(p.ws + WS_LIST), (const float*)(p.ws + WS_GATE), (u16*)(p.ws + WS_INC)};
  pg8::gemm_phase<EpiMoe2, pg8::PlanOrder, G_ALIGN, G_SP2>(lds, 512, S, E);
}

#define XB_TMO      128
#define XB_XCNT(j)  (256  + 64 * (j))
#define XB_XSUB(j)  (1280 + 64 * (j))
#define XB_XGEN(j)  (2304 + 64 * (j))
#define XB_TOP      3328
#define XB_TOPGEN   3392
#define XCD_BAR_WORDS 3456
#define XB_SPIN_CAP (1u << 22)
__device__ __forceinline__ unsigned xb_ld(unsigned* p)              { return __hip_atomic_load(p, __ATOMIC_RELAXED, __HIP_MEMORY_SCOPE_AGENT); }
__device__ __forceinline__ unsigned xb_add(unsigned* p, unsigned v) { return __hip_atomic_fetch_add(p, v, __ATOMIC_RELAXED, __HIP_MEMORY_SCOPE_AGENT); }
__device__ __forceinline__ unsigned xb_xcc_id() { return (unsigned)__builtin_amdgcn_s_getreg((3 << 11) | 20) & 0xFu; }
#define XB_SPIN(cond, bar) do { unsigned _sp = 0; while (cond) { __builtin_amdgcn_s_sleep(1); \
    if ((++_sp & 255u) == 0u) { if (xb_ld(&(bar)[XB_TMO])) break; if (_sp > XB_SPIN_CAP) { atomicAdd(&(bar)[XB_TMO], 1u); break; } } } } while (0)
struct XcdBarrier { unsigned* bar; unsigned x; volatile LAS unsigned* st; };
__device__ __forceinline__ XcdBarrier xcd_barrier_post(unsigned* bar, volatile LAS unsigned* st) {
  XcdBarrier b; b.bar = bar; b.x = xb_xcc_id(); b.st = st;
  if (tidx() == 0) (void)xb_add(&bar[XB_XCNT(b.x)], 1u);
  return b;
}
__device__ __forceinline__ void xcd_barrier_complete(unsigned* bar, unsigned x, unsigned& nloc, unsigned& nx) {
  const unsigned G = gridDim.x * gridDim.y * gridDim.z;
  unsigned sum, cnt, mine, sp = 0u;
  for (;;) {
    sum = 0u; cnt = 0u; mine = 0u;
#pragma unroll
    for (unsigned j = 0; j < 16; ++j) { const unsigned c = xb_ld(&bar[XB_XCNT(j)]); sum += c; cnt += (c > 0u) ? 1u : 0u; mine = (j == x) ? c : mine; }
    if (sum == G) break;
    __builtin_amdgcn_s_sleep(1);
    if ((++sp & 255u) == 0u) { if (xb_ld(&bar[XB_TMO])) break; if (sp > XB_SPIN_CAP) { atomicAdd(&bar[XB_TMO], 1u); break; } }
  }
  nloc = mine > 0u ? mine : 1u; nx = cnt > 0u ? cnt : 1u;
}
__device__ __forceinline__ void xcd_barrier(const XcdBarrier& b) {
  asm volatile("s_waitcnt vmcnt(0)" ::: "memory");
  __syncthreads();
  if (tidx() == 0) {
    unsigned* bar = b.bar;
    __builtin_amdgcn_s_waitcnt(0);
    unsigned nloc = b.st[0], nx = b.st[1];
    if (nloc == 0u) { xcd_barrier_complete(bar, b.x, nloc, nx); b.st[0] = nloc; b.st[1] = nx; }
    const unsigned old = xb_add(&bar[XB_XSUB(b.x)], 1u);
    const unsigned gen = old / nloc;
    if (old + 1u == (gen + 1u) * nloc) {
      __builtin_amdgcn_fence(__ATOMIC_RELEASE, "agent");
      asm volatile("s_waitcnt vmcnt(0)" ::: "memory");
      const unsigned og = xb_add(&bar[XB_TOP], 1u);
      const unsigned tg = og / nx;
      if (og + 1u == (tg + 1u) * nx) xb_add(&bar[XB_TOPGEN], 1u);
      else XB_SPIN(xb_ld(&bar[XB_TOPGEN]) == tg, bar);
      __builtin_amdgcn_fence(__ATOMIC_ACQUIRE, "agent");
      xb_add(&bar[XB_XGEN(b.x)], 1u);
      asm volatile("s_waitcnt vmcnt(0)" ::: "memory");
    } else {
      XB_SPIN(xb_ld(&bar[XB_XGEN(b.x)]) == gen, bar);
      __builtin_amdgcn_fence(__ATOMIC_ACQUIRE, "agent");
      asm volatile("s_waitcnt vmcnt(0)" ::: "memory");
    }
  }
  __syncthreads();
}

constexpr int NPHASE = 20;
constexpr int LDS_BYTES = 147456;
__device__ __forceinline__ void run_phase(const P& p, int ph, char* smem, LAS unsigned char* lds) {
  float* xa = (float*)(p.ws + WS_XA);
  const u16* slots = (const u16*)(p.ws + WS_INC);
  switch (ph) {
    case 0: phase_rowpass(p, p.x, nullptr, nullptr, p.norm_mix_g, -1, nullptr, smem); phase_prep(p); phase_s5_ktab(p); __syncthreads(); phase_conv_dense(p, smem); break;
    case 1: phase_inproj(p, lds); phase_s5_fill(p); break;
    case 2: phase_ret_inc_mfma(p, smem); __syncthreads(); phase_s5_egemm(p, lds); break;
    case 3: phase_ret_scan16(p); phase_s5_carry(p); break;
    case 4: phase_ret_out_mfma(p, smem); __syncthreads(); phase_s5_ygemm(p, lds); break;
    case 5: phase_glu(p, lds); break;
    case 6: phase_outproj(p, p.ws + WS_WOUT, p.x, xa, lds); break;
    case 7: phase_rowpass(p, xa, nullptr, nullptr, p.norm_ffn_g, 0, nullptr, smem); break;
    case 8: phase_moe_plan(p, 0, smem); phase_conv_moe(p, 0, smem); break;
    case 9: phase_moe1(p, 0, lds); break;
    case 10: phase_moe2(p, 0, lds); break;
    case 11: phase_rowpass(p, xa, slots, xa, p.norm_mix_g + DM, -1, nullptr, smem); break;
    case 12: phase_qkv(p, lds); break;
    case 13: phase_attn(p, smem); break;
    case 14: phase_outproj(p, p.ws + WS_WO, xa, xa, lds); break;
    case 15: phase_rowpass(p, xa, nullptr, nullptr, p.norm_ffn_g + DM, 1, nullptr, smem); break;
    case 16: phase_moe_plan(p, 1, smem); phase_conv_moe(p, 1, smem); break;
    case 17: phase_moe1(p, 1, lds); break;
    case 18: phase_moe2(p, 1, lds); break;
    case 19: phase_rowpass(p, xa, slots, nullptr, p.norm_final_g, -1, p.out, smem); break;
    default: break;
  }
}

extern __shared__ __attribute__((aligned(16))) char dyn_smem[];

template <int PH> __device__ __forceinline__ void mega_steps(const P& p, char* smem, LAS unsigned char* lds, cg::grid_group& grid, const XcdBarrier& xb) {
  run_phase(p, PH, smem, lds);
  if constexpr (PH + 1 < NPHASE) {
    if constexpr (PH == 0) grid.sync(); else xcd_barrier(xb);
    mega_steps<PH + 1>(p, smem, lds, grid, xb);
  }
}
__global__ void __launch_bounds__(NTHR, 2) k_mega(P p) {
  cg::grid_group grid = cg::this_grid();
  LAS unsigned char* lds = (LAS unsigned char*)dyn_smem;
  volatile LAS unsigned* st = (volatile LAS unsigned*)(lds + LDS_BYTES - 16);
  if (tidx() == 0) { st[0] = 0u; st[1] = 0u; }
  __syncthreads();
  const XcdBarrier xb = xcd_barrier_post((unsigned*)(p.ws + WS_BAR), st);
  mega_steps<0>(p, dyn_smem, lds, grid, xb);
}

extern "C" void kernel_launch(void* const* d_in, const int* in_sizes, int n_in, void* d_out, int out_size, void* d_ws, size_t ws_size, hipStream_t stream) {
  static int grid_blocks = 0;
  if (grid_blocks == 0) {
    if (n_in != 28 || out_size != T_TOK * DM || ws_size < WS_END) { fprintf(stderr, "kernel_launch: unexpected problem (n_in %d out %d ws %zu need %zu)\n", n_in, out_size, ws_size, (size_t)WS_END); grid_blocks = -1; return; }
    int dev = 0, cus = 0, per_cu = 0;
    (void)hipGetDevice(&dev);
    (void)hipDeviceGetAttribute(&cus, hipDeviceAttributeMultiprocessorCount, dev);
    const void* fn = (const void*)k_mega;
    if (hipFuncSetAttribute(fn, hipFuncAttributeMaxDynamicSharedMemorySize, LDS_BYTES) != hipSuccess) { fprintf(stderr, "kernel_launch: hipFuncSetAttribute failed\n"); }
    if (hipOccupancyMaxActiveBlocksPerMultiprocessor(&per_cu, fn, NTHR, LDS_BYTES) != hipSuccess || per_cu < 1) { fprintf(stderr, "kernel_launch: occupancy query failed (%d)\n", per_cu); per_cu = 1; }
    (void)hipGetLastError();
    if (per_cu > 1) per_cu = 1;
    grid_blocks = cus * per_cu;
    fprintf(stderr, "kernel_launch: cus %d per_cu %d grid %d\n", cus, per_cu, grid_blocks);
  }
  if (grid_blocks < 0) return;
  P p{};
  const float** pp = (const float**)&p;
  for (int i = 0; i < 28; ++i) pp[i] = (const float*)d_in[i];
  p.out = (float*)d_out; p.ws = (char*)d_ws;
  (void)hipMemsetAsync((char*)d_ws + WS_BAR, 0, XCD_BAR_WORDS * 4, stream);
  void* args[] = {&p};
  hipError_t e = hipLaunchCooperativeKernel((const void*)k_mega, dim3(grid_blocks), dim3(NTHR), args, LDS_BYTES, stream);
  if (e != hipSuccess) fprintf(stderr, "cooperative launch failed: %s (grid %d)\n", hipGetErrorString(e), grid_blocks);
}
```

```cpp
#include <hip/hip_runtime.h>
#include <hip/hip_cooperative_groups.h>
#include <cstdio>
#include <cstdint>
namespace cg = cooperative_groups;

#define USE_FP16 1
#define LAS __attribute__((address_space(3)))

typedef unsigned short u16;
typedef float f32x4 __attribute__((ext_vector_type(4)));
typedef float f32x2 __attribute__((ext_vector_type(2)));
typedef _Float16 f16x8 __attribute__((ext_vector_type(8)));

constexpr int T_TOK = 16384, DM = 1024, SEQ = 2048, NBATCH = 8;
constexpr int CAP = 32768;
constexpr int NTHR = 512, NWAVE = NTHR / 64;

constexpr size_t MB = 1024ull * 1024ull;
constexpr size_t WS_XA    = 0;
constexpr size_t WS_XB    = 64 * MB;
constexpr size_t WS_Z     = 96 * MB;
constexpr size_t WS_A2    = 160 * MB;
constexpr size_t WS_BTY   = 184 * MB;
constexpr size_t WS_MW    = WS_Z;
constexpr size_t WS_WET   = 208 * MB;
constexpr size_t WS_E     = 216 * MB;
constexpr size_t WS_KTAB  = 232 * MB;
constexpr size_t WS_SP16  = 234 * MB;
constexpr size_t WS_INC   = 266 * MB;
constexpr size_t WS_YCAT  = 330 * MB;
constexpr size_t WS_YGELU = 362 * MB;
constexpr size_t WS_H     = 378 * MB;
constexpr size_t WS_LIST  = 418 * MB;
constexpr size_t WS_GATE  = 422 * MB;
constexpr size_t WS_ROPE  = 423 * MB;
constexpr size_t WS_CNT   = 424 * MB;
constexpr size_t WS_WR16  = 425 * MB;
constexpr size_t WS_BAR   = 426 * MB;
constexpr size_t WS_PLAN  = 426 * MB + 512 * 1024;
constexpr size_t WS_WIN   = 427 * MB;
constexpr size_t WS_WGLU  = 432 * MB;
constexpr size_t WS_WOUT  = 433 * MB;
constexpr size_t WS_WQKV  = 435 * MB;
constexpr size_t WS_WO    = 438 * MB;
constexpr size_t WS_END   = 440 * MB;

struct P {
  const float *x, *norm_mix_g, *norm_ffn_g, *norm_final_g, *w_in, *ret_decay, *a_re, *a_im, *log_step, *b_re, *b_im, *c_re, *c_im,
      *s5d, *w_glu, *b_glu, *w_out, *w_qkv, *sink, *w_o, *rel_bias, *w_group, *b_group, *w_er, *b_er, *w_gate, *w_up, *w_down;
  float* out;
  char* ws;
};

__device__ __forceinline__ u16 f2h(float f) { _Float16 h = (_Float16)f; return __builtin_bit_cast(u16, h); }
__device__ __forceinline__ float h2f(u16 h) { return (float)__builtin_bit_cast(_Float16, h); }
__device__ __forceinline__ unsigned pk2(float a, float b) { return (unsigned)f2h(a) | ((unsigned)f2h(b) << 16); }
__device__ __forceinline__ float lo16(unsigned w) { return h2f((u16)(w & 0xffffu)); }
__device__ __forceinline__ float hi16(unsigned w) { return h2f((u16)(w >> 16)); }
__device__ __forceinline__ f32x4 mfma16(uint4 a, uint4 b, f32x4 c) {
  return __builtin_amdgcn_mfma_f32_16x16x32_f16(__builtin_bit_cast(f16x8, a), __builtin_bit_cast(f16x8, b), c, 0, 0, 0);
}
__device__ __forceinline__ float wave_sum(float v) {
#pragma unroll
  for (int o = 1; o < 64; o <<= 1) v += __shfl_xor(v, o);
  return v;
}
__device__ __forceinline__ float sigmoidf_(float x) { return 1.0f / (1.0f + __expf(-x)); }
__device__ __forceinline__ float gelu_tanh(float x) {
  const float u = 0.7978845608028654f * (x + 0.044715f * x * x * x);
  return 0.5f * x * (1.0f + tanhf(u));
}
#define LDS_WAIT() asm volatile("s_waitcnt lgkmcnt(0)" ::: "memory")
__device__ __forceinline__ int tidx() { int t = threadIdx.x; asm volatile("" : "+v"(t)); return t; }

namespace pg8 {
constexpr int BM = 256, BK = 64, HALF = 128, HTB = HALF * BK * 2, STAGE_BYTES = 8 * HTB, NXCD = 8, WGM = 8;
__device__ __forceinline__ int lds_byte(int r, int c) { const int st = (r >> 4) * 2 + (c >> 5), rr = r & 15, cc = c & 31, ob = rr * 64 + cc * 2; return st * 1024 + (ob ^ (((ob >> 9) & 1) << 5)); }
__device__ __forceinline__ void stage_rc(int b, int& R, int& C) { const int st = b / 1024, sb = b % 1024, swz = sb ^ (((sb >> 9) & 1) << 5); R = (st >> 1) * 16 + swz / 64; C = (st & 1) * 32 + (swz % 64) / 2; }

struct Unit { const char* a; const char* b; int pm, pn, e, cnt, hbase; };

template <class Epi, class Sched, bool ALIGN_EPI, bool SP2>
__device__ __forceinline__ void gemm_phase(LAS unsigned char* lds, const int K, const Sched& S, const Epi& E) {
    const int tid = tidx(), wid = __builtin_amdgcn_readfirstlane(tid >> 6), lane = tid & 63, wr = wid >> 2, wc = wid & 3, fr = lane & 15, fq = lane >> 4;
    const int nt = K / BK;
    int Rr[2], Cc[2];
    unsigned voffB[2];
#pragma unroll
    for (int i = 0; i < 2; ++i) { stage_rc(tid * 16 + i * 8192, Rr[i], Cc[i]); voffB[i] = (unsigned)(Rr[i] * K + Cc[i]) * 2u; }
    const size_t kstep = (size_t)(BK * 2);
    const size_t hstepB = (size_t)HALF * K * 2;
    const unsigned ldsw = (unsigned)wid * 1024u;
    const int aoff = lds_byte(wr * 64 + fr, fq * 8), boff = lds_byte(wc * 32 + fr, fq * 8);
#define PG8_SA(b, h) (((b) * 2 + (h)) * HTB)
#define PG8_SB(b, h) ((4 + (b) * 2 + (h)) * HTB)
#define PG8_STAGE(bufoff, gbase, voff) do { _Pragma("unroll") for (int _i = 0; _i < 2; ++_i) \
        __builtin_amdgcn_global_load_lds((const unsigned*)((const char*)(gbase) + (voff)[_i]), (LAS unsigned*)(lds + (bufoff) + ldsw + _i * 8192), 16, 0, 0); } while (0)
#define PG8_LDA(dst, b, h) do { _Pragma("unroll") for (int m = 0; m < 4; ++m) _Pragma("unroll") for (int k = 0; k < 2; ++k) dst[m][k] = *(const LAS f16x8*)(lds + PG8_SA(b, h) + aoff + m * 2048 + k * 1024); } while (0)
#define PG8_LDB(dst, b, h) do { _Pragma("unroll") for (int n = 0; n < 2; ++n) _Pragma("unroll") for (int k = 0; k < 2; ++k) dst[n][k] = *(const LAS f16x8*)(lds + PG8_SB(b, h) + boff + n * 2048 + k * 1024); } while (0)
#define PG8_MMA(ai, bj, At, Bt) do { if (128 * (ai) + 64 * wr >= urows) break; __builtin_amdgcn_s_setprio(1); _Pragma("unroll") for (int m = 0; m < 4; ++m) _Pragma("unroll") for (int n = 0; n < 2; ++n) _Pragma("unroll") for (int k = 0; k < 2; ++k) \
        acc[ai][bj][m][n] = __builtin_amdgcn_mfma_f32_16x16x32_f16(Bt[n][k], At[m][k], acc[ai][bj][m][n], 0, 0, 0); __builtin_amdgcn_s_setprio(0); } while (0)
#define PG8_WAIT_V(n) asm volatile("s_waitcnt vmcnt(" #n ")" ::: "memory")
#define PG8_WAIT_L(n) asm volatile("s_waitcnt lgkmcnt(" #n ")" ::: "memory")
#define PG8_BAR __builtin_amdgcn_s_barrier()
#define PG8_SCHED __builtin_amdgcn_sched_barrier(0)
    Unit cur, nxt; int ui = 0;
    if (!S.next(0, cur)) return;
    unsigned cv0[2], cv1[2], nv0[2], nv1[2];
#pragma unroll
    for (int i = 0; i < 2; ++i) { cv0[i] = S.a_voff(cur, 0, Rr[i], Cc[i]); cv1[i] = S.a_voff(cur, 1, Rr[i], Cc[i]); }
    f32x4 acc[2][2][4][2];
#pragma unroll
    for (int a = 0; a < 2; ++a)
#pragma unroll
        for (int b = 0; b < 2; ++b)
#pragma unroll
            for (int m = 0; m < 4; ++m)
#pragma unroll
                for (int n = 0; n < 2; ++n) acc[a][b][m][n] = (f32x4){0.f, 0.f, 0.f, 0.f};
    f16x8 At[4][2], B0[2][2], B1[2][2];
    const char* cA = cur.a; const char* cB = cur.b;
    int urows = S.rows(cur);
    if constexpr (SP2) {
        PG8_STAGE(PG8_SB(0, 0), cB, voffB); PG8_STAGE(PG8_SB(0, 1), cB + hstepB, voffB); PG8_STAGE(PG8_SA(0, 0), cA, cv0); PG8_STAGE(PG8_SA(0, 1), cA, cv1);
        if (wr == 1) PG8_BAR;
        PG8_WAIT_V(2); PG8_BAR;
        PG8_STAGE(PG8_SB(1, 0), cB + kstep, voffB); PG8_STAGE(PG8_SA(1, 0), cA + kstep, cv0); PG8_STAGE(PG8_SB(1, 1), cB + hstepB + kstep, voffB);
        PG8_WAIT_V(6); PG8_BAR;
    } else {
        PG8_STAGE(PG8_SB(0, 0), cB, voffB); PG8_STAGE(PG8_SA(0, 0), cA, cv0); PG8_STAGE(PG8_SB(0, 1), cB + hstepB, voffB); PG8_STAGE(PG8_SA(0, 1), cA, cv1);
        if (wr == 1) PG8_BAR;
        PG8_WAIT_V(4); PG8_BAR;
        PG8_STAGE(PG8_SB(1, 0), cB + kstep, voffB); PG8_STAGE(PG8_SA(1, 0), cA + kstep, cv0); PG8_STAGE(PG8_SB(1, 1), cB + hstepB + kstep, voffB);
        PG8_WAIT_V(6); PG8_BAR;
    }
    for (;;) {
        const bool has_next = S.next(ui + 1, nxt);
        if (has_next) {
#pragma unroll
            for (int i = 0; i < 2; ++i) { nv0[i] = S.a_voff(nxt, 0, Rr[i], Cc[i]); nv1[i] = S.a_voff(nxt, 1, Rr[i], Cc[i]); }
        } else {
            nxt = cur;
#pragma unroll
            for (int i = 0; i < 2; ++i) { nv0[i] = cv0[i]; nv1[i] = cv1[i]; }
        }
        const char* nA = nxt.a; const char* nB = nxt.b;
        for (int t = 0; t < nt; t += 2) {
            const bool last = (t == nt - 2);
            const char* a1 = cA + (size_t)(t + 1) * kstep;
            const char* a2 = last ? nA : cA + (size_t)(t + 2) * kstep; const char* b2 = last ? nB : cB + (size_t)(t + 2) * kstep;
            const char* a3 = a2 + kstep; const char* b3 = b2 + kstep;
            unsigned v0[2], v1[2];
#pragma unroll
            for (int i = 0; i < 2; ++i) { v0[i] = last ? nv0[i] : cv0[i]; v1[i] = last ? nv1[i] : cv1[i]; }
            if constexpr (SP2) {
            PG8_LDB(B0, 0, 0); PG8_LDB(B1, 0, 1); PG8_SCHED; PG8_LDA(At, 0, 0); PG8_STAGE(PG8_SA(1, 1), a1, cv1);
            PG8_WAIT_V(8); PG8_WAIT_L(0); PG8_BAR; PG8_MMA(0, 0, At, B0); PG8_MMA(0, 1, At, B1); PG8_BAR; PG8_SCHED;
            PG8_LDA(At, 0, 1); PG8_STAGE(PG8_SB(0, 0), b2, voffB); PG8_STAGE(PG8_SB(0, 1), b2 + hstepB, voffB); PG8_STAGE(PG8_SA(0, 0), a2, v0);
            PG8_WAIT_V(8); PG8_WAIT_L(0); PG8_BAR; PG8_MMA(1, 0, At, B0); PG8_MMA(1, 1, At, B1); PG8_BAR; PG8_SCHED;
            PG8_LDB(B0, 1, 0); PG8_LDB(B1, 1, 1); PG8_SCHED; PG8_LDA(At, 1, 0); PG8_STAGE(PG8_SA(0, 1), a2, v1);
            PG8_WAIT_V(8); PG8_WAIT_L(0); PG8_BAR; PG8_MMA(0, 0, At, B0); PG8_MMA(0, 1, At, B1); PG8_BAR; PG8_SCHED;
            PG8_LDA(At, 1, 1); PG8_STAGE(PG8_SB(1, 0), b3, voffB); PG8_STAGE(PG8_SB(1, 1), b3 + hstepB, voffB); PG8_STAGE(PG8_SA(1, 0), a3, v0);
            PG8_WAIT_V(8); PG8_WAIT_L(0); PG8_BAR; PG8_MMA(1, 0, At, B0); PG8_MMA(1, 1, At, B1); PG8_BAR; PG8_SCHED;
            } else {
            PG8_LDB(B0, 0, 0); PG8_SCHED; PG8_LDA(At, 0, 0); PG8_STAGE(PG8_SA(1, 1), a1, cv1);
            PG8_WAIT_L(8); PG8_BAR; PG8_WAIT_L(0); PG8_MMA(0, 0, At, B0); PG8_BAR; PG8_SCHED;
            PG8_LDB(B1, 0, 1); PG8_STAGE(PG8_SB(0, 0), b2, voffB);
            PG8_BAR; PG8_WAIT_L(0); PG8_MMA(0, 1, At, B1); PG8_BAR;
            PG8_LDA(At, 0, 1); PG8_STAGE(PG8_SA(0, 0), a2, v0);
            PG8_BAR; PG8_WAIT_L(0); PG8_MMA(1, 0, At, B0); PG8_BAR; PG8_SCHED;
            PG8_STAGE(PG8_SB(0, 1), b2 + hstepB, voffB);
            PG8_WAIT_V(6); PG8_BAR; PG8_MMA(1, 1, At, B1); PG8_BAR;
            PG8_LDB(B0, 1, 0); PG8_SCHED; PG8_LDA(At, 1, 0); PG8_STAGE(PG8_SA(0, 1), a2, v1);
            PG8_WAIT_L(8); PG8_BAR; PG8_WAIT_L(0); PG8_MMA(0, 0, At, B0); PG8_BAR; PG8_SCHED;
            PG8_LDB(B1, 1, 1); PG8_STAGE(PG8_SB(1, 0), b3, voffB);
            PG8_BAR; PG8_WAIT_L(0); PG8_MMA(0, 1, At, B1); PG8_BAR;
            PG8_LDA(At, 1, 1); PG8_STAGE(PG8_SA(1, 0), a3, v0);
            PG8_BAR; PG8_WAIT_L(0); PG8_MMA(1, 0, At, B0); PG8_BAR; PG8_SCHED;
            PG8_STAGE(PG8_SB(1, 1), b3 + hstepB, voffB);
            PG8_WAIT_V(6); PG8_BAR; PG8_MMA(1, 1, At, B1); PG8_BAR;
            }
        }
        if constexpr (ALIGN_EPI) { if (wr == 0) PG8_BAR; }
        E(acc, cur, wr, wc, fr, fq);
        if (!has_next) break;
#pragma unroll
        for (int a = 0; a < 2; ++a)
#pragma unroll
            for (int b = 0; b < 2; ++b)
#pragma unroll
                for (int m = 0; m < 4; ++m)
#pragma unroll
                    for (int n = 0; n < 2; ++n) acc[a][b][m][n] = (f32x4){0.f, 0.f, 0.f, 0.f};
        cur = nxt; cA = nA; cB = nB; ++ui; urows = S.rows(cur);
#pragma unroll
        for (int i = 0; i < 2; ++i) { cv0[i] = nv0[i]; cv1[i] = nv1[i]; }
        if constexpr (ALIGN_EPI) { if (wr == 1) PG8_BAR; }
    }
    PG8_WAIT_V(0);
    if constexpr (!ALIGN_EPI) { if (wr == 0) PG8_BAR; }
    PG8_BAR;
#undef PG8_SA
#undef PG8_SB
#undef PG8_STAGE
#undef PG8_LDA
#undef PG8_LDB
#undef PG8_MMA
#undef PG8_WAIT_V
#undef PG8_WAIT_L
#undef PG8_BAR
#undef PG8_SCHED
}

struct DenseOrder {
    const char* A; const char* Bt; int lda_b, K, nM, nN, nwg, G, c;
    __device__ __forceinline__ void init(const void* A_, int lda_elems, const void* Bt_, int M, int N, int K_) { A = (const char*)A_; Bt = (const char*)Bt_; lda_b = lda_elems * 2; K = K_; nM = M / BM; nN = N / BM; nwg = nM * nN; G = gridDim.x; c = blockIdx.x; }
    __device__ __forceinline__ bool next(int i, Unit& u) const {
        const long L = (long)i * G + c; if (L >= nwg) return false;
        int wgid = (int)L; { const int q = nwg / NXCD, r = nwg % NXCD, xcd = wgid % NXCD, off = wgid / NXCD; wgid = (xcd < r ? xcd * (q + 1) : r * (q + 1) + (xcd - r) * q) + off; }
        const int nig = WGM * nN, gid = wgid / nig, fm = gid * WGM, gsz = (nM - fm) < WGM ? (nM - fm) : WGM;
        u.pm = fm + ((wgid % nig) % gsz); u.pn = (wgid % nig) / gsz; u.e = 0; u.cnt = 0; u.hbase = 0;
        u.a = A + (size_t)u.pm * BM * lda_b; u.b = Bt + (size_t)u.pn * BM * K * 2;
        return true;
    }
    __device__ __forceinline__ unsigned a_voff(const Unit&, int h, int R, int C) const { return (unsigned)((h * HALF + R) * lda_b + C * 2); }
    __device__ __forceinline__ int rows(const Unit&) const { return BM; }
};
struct GroupOrder {
    const char* A; const char* Bt; int lda_b, K, nM, nN, ng, G, c; size_t gsA, gsB;
    __device__ __forceinline__ void init(const void* A_, int lda_elems, size_t gsA_elems, const void* Bt_, size_t gsB_elems, int ng_, int M, int N, int K_) {
        A = (const char*)A_; Bt = (const char*)Bt_; lda_b = lda_elems * 2; K = K_; nM = M / BM; nN = N / BM; ng = ng_; gsA = gsA_elems * 2; gsB = gsB_elems * 2; G = gridDim.x; c = blockIdx.x; }
    __device__ __forceinline__ bool next(int i, Unit& u) const {
        const long L = (long)i * G + c; if (L >= (long)ng * nM * nN) return false;
        const int per = nM * nN, g = (int)L / per, r = (int)L % per;
        u.e = g; u.pm = r / nN; u.pn = r % nN; u.cnt = 0; u.hbase = 0;
        u.a = A + (size_t)g * gsA + (size_t)u.pm * BM * lda_b; u.b = Bt + (size_t)g * gsB + (size_t)u.pn * BM * K * 2;
        return true;
    }
    __device__ __forceinline__ unsigned a_voff(const Unit&, int h, int R, int C) const { return (unsigned)((h * HALF + R) * lda_b + C * 2); }
    __device__ __forceinline__ int rows(const Unit&) const { return BM; }
};
constexpr int PLAN_STRIDE = 256;
struct PlanOrder {
    const int4* plan; const int* plan_n; const int* list; const char* A; const char* Bt; int lda_b, K, x, ib, nbx; size_t esB; bool gather;
    __device__ __forceinline__ void init(const void* planbase, const int* list_, const void* A_, int lda_elems, const void* Bt_, size_t esB_elems, int K_, bool gather_) {
        plan_n = (const int*)planbase; plan = (const int4*)((const char*)planbase + 256); list = list_; A = (const char*)A_; Bt = (const char*)Bt_; lda_b = lda_elems * 2; K = K_; esB = esB_elems * 2; gather = gather_;
        x = blockIdx.x & 7; ib = blockIdx.x >> 3; nbx = ((int)gridDim.x - x + 7) >> 3; }
    __device__ __forceinline__ bool next(int i, Unit& u) const {
        const int j = i * nbx + ib;
        if (j >= plan_n[x]) return false;
        const int4 en = plan[x * PLAN_STRIDE + j];
        u.e = en.x & 255; u.pm = (en.x >> 8) & 255; u.pn = (en.x >> 16) & 255; u.cnt = en.y; u.hbase = en.z;
        u.a = gather ? A : A + (size_t)(u.hbase + u.pm * BM) * lda_b;
        u.b = Bt + (size_t)u.e * esB + (size_t)u.pn * BM * K * 2;
        return true;
    }
    __device__ __forceinline__ unsigned a_voff(const Unit& u, int h, int R, int C) const {
        if (!gather) return (unsigned)((h * HALF + R) * lda_b + C * 2);
        const int li = u.pm * BM + h * HALF + R;
        const int tok = (li < u.cnt) ? (list[(size_t)u.e * CAP + li] >> 1) : 0;
        return (unsigned)(tok * lda_b + C * 2);
    }
    __device__ __forceinline__ int rows(const Unit& u) const { const int r = u.cnt - u.pm * BM; return r < BM ? r : BM; }
};
}
constexpr bool G_ALIGN = true, G_SP2 = true;

__device__ __forceinline__ void phase_prep(const P& p) {
  const int gtid = blockIdx.x * NTHR + tidx(), gsz = gridDim.x * NTHR;
  int* cnt = (int*)(p.ws + WS_CNT);
  if (gtid < 64) cnt[gtid] = 0;
  f32x2* rope = (f32x2*)(p.ws + WS_ROPE);
  for (int i = gtid; i < SEQ * 64; i += gsz) {
    const int pos = i >> 6, f = i & 63;
    const float inv = powf(10000.0f, -(float)(2 * f) / 128.0f);
    const float ang = (float)pos * inv;
    float s, c; sincosf(ang, &s, &c);
    rope[i] = (f32x2){c, s};
  }
  u16* wr16 = (u16*)(p.ws + WS_WR16);
  for (int i = gtid; i < 2 * 48 * DM; i += gsz) {
    const int k = i & (DM - 1), n = (i >> 10) % 48, layer = i / (48 * DM);
    float w = 0.f;
    if (n < 4) w = p.w_group[((size_t)layer * DM + k) * 4 + n];
    else if (n < 36) { const int gg = (n - 4) >> 3, j = (n - 4) & 7; w = p.w_er[(((size_t)layer * 4 + gg) * DM + k) * 8 + j]; }
    w *= p.norm_ffn_g[layer * DM + k];
    const u16 hi = f2h(w), lo = f2h(w - h2f(hi));
    wr16[((size_t)(layer * 2 + 0) * 48 + n) * DM + k] = hi;
    wr16[((size_t)(layer * 2 + 1) * 48 + n) * DM + k] = lo;
  }
}

template <class RowFn>
__device__ __forceinline__ void conv_item(const float* W, int ldw, int K, u16* WT, float* scr, int k0, int n0, int lane, RowFn rowfn) {
#pragma unroll 8
  for (int i = 0; i < 32; ++i) { const int kk = 2 * i + (lane >> 5); scr[kk * 33 + (lane & 31)] = W[(size_t)(k0 + kk) * ldw + n0 + (lane & 31)]; }
  LDS_WAIT();
  const int c = lane & 7;
#pragma unroll
  for (int j = 0; j < 4; ++j) {
    const int n = (lane >> 3) + 8 * j; const float* sp = scr + (8 * c) * 33 + n;
    uint4 o; o.x = pk2(sp[0 * 33], sp[1 * 33]); o.y = pk2(sp[2 * 33], sp[3 * 33]); o.z = pk2(sp[4 * 33], sp[5 * 33]); o.w = pk2(sp[6 * 33], sp[7 * 33]);
    *(uint4*)(WT + (size_t)rowfn(n0 + n) * K + k0 + 8 * c) = o;
  }
  LDS_WAIT();
}
template <class RowFn>
__device__ __forceinline__ int conv_matrix(const float* W, int ldw, int K, int N, u16* WT, char* smem, int item_base, RowFn rowfn) {
  const int lane = tidx() & 63, wv = tidx() >> 6, gw = blockIdx.x * NWAVE + wv, nw = gridDim.x * NWAVE;
  float* scr = (float*)smem + wv * (64 * 33);
  const int nkb = K / 64, nnb = N / 32, nitems = nkb * nnb;
  int it = gw - (item_base % nw); if (it < 0) it += nw;
  for (; it < nitems; it += nw) conv_item(W, ldw, K, WT, scr, (it / nnb) * 64, (it % nnb) * 32, lane, rowfn);
  return nitems;
}
__device__ __forceinline__ void phase_conv_dense(const P& p, char* smem) {
  auto id = [](int n) { return n; };
  int base = 0;
  base += conv_matrix(p.w_in, 2560, DM, 2560, (u16*)(p.ws + WS_WIN), smem, base, [](int n) { if (n >= 1024) return n; const int dd = n & 127, hf = dd >> 6, r = dd & 63; return (n & ~127) + 32 * (r >> 4) + 16 * hf + (r & 15); });
  base += conv_matrix(p.w_glu, 512, 512, 512, (u16*)(p.ws + WS_WGLU), smem, base, id);
  base += conv_matrix(p.w_out, DM, DM, DM, (u16*)(p.ws + WS_WOUT), smem, base, id);
  base += conv_matrix(p.w_qkv, 1536, DM, 1536, (u16*)(p.ws + WS_WQKV), smem, base, id);
  base += conv_matrix(p.w_o, DM, DM, DM, (u16*)(p.ws + WS_WO), smem, base, id);
}
__device__ __forceinline__ void phase_conv_moe(const P& p, int layer, char* smem) {
  const int lane = tidx() & 63, wv = tidx() >> 6, gw = blockIdx.x * NWAVE + wv, nw = gridDim.x * NWAVE;
  float* scr = (float*)smem + wv * (64 * 33);
  u16* w1t = (u16*)(p.ws + WS_MW); u16* w2t = (u16*)(p.ws + WS_MW + 64 * MB);
  for (int it = gw; it < 32 * 768; it += nw) {
    const int e = it / 768, r = it % 768;
    if (r < 512) {
      const int which = r >> 8, q = r & 255, k0 = (q >> 4) * 64, n0 = (q & 15) * 32;
      const float* W = (which ? p.w_up : p.w_gate) + (size_t)(layer * 32 + e) * DM * 512;
      conv_item(W, 512, DM, w1t + (size_t)e * DM * DM, scr, k0, n0, lane, [which](int n) { return (n >> 4) * 32 + which * 16 + (n & 15); });
    } else {
      const int q = r - 512, k0 = (q >> 5) * 64, n0 = (q & 31) * 32;
      const float* W = p.w_down + (size_t)(layer * 32 + e) * 512 * DM;
      conv_item(W, DM, 512, w2t + (size_t)e * DM * 512, scr, k0, n0, lane, [](int n) { return n; });
    }
  }
}

__device__ __forceinline__ void phase_rowpass(const P& p, const float* src, const u16* slots, float* dstx, const float* gain, int route_layer, float* fout, char* smem) {
  const int lane = tidx() & 63, wv = tidx() >> 6, fr = lane & 15, lg = lane >> 4;
  u16* xb = (u16*)(p.ws + WS_XB);
  int* cnt = (int*)(p.ws + WS_CNT);
  int* list = (int*)(p.ws + WS_LIST);
  float* gate = (float*)(p.ws + WS_GATE);
  float* sRs = (float*)smem;
  float* sLg = (float*)smem + 64;
  for (int st = blockIdx.x; st < T_TOK / 64; st += gridDim.x) {
    const int row0 = st * 64 + wv * 8;
#pragma unroll 1
    for (int rp = 0; rp < 4; ++rp) {
      f32x4 v[2][4];
#pragma unroll
      for (int q = 0; q < 2; ++q) {
        const int row = row0 + rp * 2 + q;
#pragma unroll
        for (int i = 0; i < 4; ++i) v[q][i] = *(const f32x4*)(src + (size_t)row * DM + (i * 64 + lane) * 4);
      }
      if (slots) {
#pragma unroll
        for (int q = 0; q < 2; ++q) {
          const int row = row0 + rp * 2 + q;
          uint2 w[2][4];
#pragma unroll
          for (int sl = 0; sl < 2; ++sl)
#pragma unroll
            for (int i = 0; i < 4; ++i) w[sl][i] = *(const uint2*)(slots + ((size_t)row * 2 + sl) * DM + (i * 64 + lane) * 4);
#pragma unroll
          for (int sl = 0; sl < 2; ++sl)
#pragma unroll
            for (int i = 0; i < 4; ++i) { v[q][i][0] += lo16(w[sl][i].x); v[q][i][1] += hi16(w[sl][i].x); v[q][i][2] += lo16(w[sl][i].y); v[q][i][3] += hi16(w[sl][i].y); }
        }
      }
#pragma unroll
      for (int q = 0; q < 2; ++q) {
        const int row = row0 + rp * 2 + q;
        float ss = 0.f;
#pragma unroll
        for (int i = 0; i < 4; ++i) {
          if (dstx) *(f32x4*)(dstx + (size_t)row * DM + (i * 64 + lane) * 4) = v[q][i];
          ss += v[q][i][0] * v[q][i][0] + v[q][i][1] * v[q][i][1] + v[q][i][2] * v[q][i][2] + v[q][i][3] * v[q][i][3];
        }
        ss = wave_sum(ss);
        const float rstd = rsqrtf(ss * (1.0f / DM) + 1e-6f);
        if (route_layer >= 0 && lane == 0) sRs[wv * 8 + rp * 2 + q] = rstd;
#pragma unroll
        for (int i = 0; i < 4; ++i) {
          const int k = (i * 64 + lane) * 4;
          const f32x4 gv = *(const f32x4*)(gain + k);
          const f32x4 hv = v[q][i] * rstd * gv;
          if (fout) *(f32x4*)(fout + (size_t)row * DM + k) = hv;
          else { uint2 w; w.x = pk2(hv[0], hv[1]); w.y = pk2(hv[2], hv[3]); *(uint2*)(xb + (size_t)row * DM + k) = w; }
        }
      }
    }
    if (route_layer >= 0) {
      __syncthreads();
      const int tl = wv & 3, kh = wv >> 2;
      const float rsv = sRs[tl * 16 + fr];
      const float* xrow = src + (size_t)(st * 64 + tl * 16 + fr) * DM + kh * 512 + lg * 8;
      const u16* whi = (const u16*)(p.ws + WS_WR16) + ((size_t)(route_layer * 2 + 0) * 48 + fr) * DM + kh * 512 + lg * 8;
      const u16* wlo = (const u16*)(p.ws + WS_WR16) + ((size_t)(route_layer * 2 + 1) * 48 + fr) * DM + kh * 512 + lg * 8;
      f32x4 acc[3];
#pragma unroll
      for (int nb = 0; nb < 3; ++nb) acc[nb] = (f32x4){0.f, 0.f, 0.f, 0.f};
#pragma unroll 4
      for (int ks = 0; ks < 16; ++ks) {
        const f32x4 x0 = *(const f32x4*)(xrow + ks * 32), x1 = *(const f32x4*)(xrow + ks * 32 + 4);
        const float hv[8] = {x0[0] * rsv, x0[1] * rsv, x0[2] * rsv, x0[3] * rsv, x1[0] * rsv, x1[1] * rsv, x1[2] * rsv, x1[3] * rsv};
        unsigned ah[4], al[4];
#pragma unroll
        for (int j = 0; j < 4; ++j) {
          const u16 h0 = f2h(hv[2 * j]), h1 = f2h(hv[2 * j + 1]);
          ah[j] = (unsigned)h0 | ((unsigned)h1 << 16);
          al[j] = pk2(hv[2 * j] - h2f(h0), hv[2 * j + 1] - h2f(h1));
        }
        const uint4 ahi = make_uint4(ah[0], ah[1], ah[2], ah[3]), alo = make_uint4(al[0], al[1], al[2], al[3]);
#pragma unroll
        for (int nb = 0; nb < 3; ++nb) {
          const uint4 bh = *(const uint4*)(whi + (size_t)nb * 16 * DM + ks * 32), bl = *(const uint4*)(wlo + (size_t)nb * 16 * DM + ks * 32);
          acc[nb] = mfma16(bh, ahi, acc[nb]); acc[nb] = mfma16(bh, alo, acc[nb]); acc[nb] = mfma16(bl, ahi, acc[nb]);
        }
      }
      float* lgw = sLg + ((kh * 4 + tl) * 16 + fr) * 49;
#pragma unroll
      for (int nb = 0; nb < 3; ++nb)
#pragma unroll
        for (int r = 0; r < 4; ++r) lgw[nb * 16 + 4 * lg + r] = acc[nb][r];
      __syncthreads();
      if (wv < 4 && lane < 16) {
        const int row = st * 64 + wv * 16 + lane;
        const float* l0 = sLg + ((0 * 4 + wv) * 16 + lane) * 49;
        const float* l1 = sLg + ((1 * 4 + wv) * 16 + lane) * 49;
        const float* bg = p.b_group + route_layer * 4;
        const float* be = p.b_er + route_layer * 32;
        float gl[4];
#pragma unroll
        for (int j = 0; j < 4; ++j) gl[j] = l0[j] + l1[j] + bg[j];
        int gs = 0; float gm = gl[0];
#pragma unroll
        for (int j = 1; j < 4; ++j) if (gl[j] > gm) { gm = gl[j]; gs = j; }
        float den = 0.f;
#pragma unroll
        for (int j = 0; j < 4; ++j) den += expf(gl[j] - gm);
        const float pg = 1.0f / den;
        float el[8];
#pragma unroll
        for (int j = 0; j < 8; ++j) el[j] = l0[4 + gs * 8 + j] + l1[4 + gs * 8 + j] + be[gs * 8 + j];
        int i1 = 0; float v1 = el[0];
#pragma unroll
        for (int j = 1; j < 8; ++j) if (el[j] > v1) { v1 = el[j]; i1 = j; }
        int i2 = -1; float v2 = -3.0e38f;
#pragma unroll
        for (int j = 0; j < 8; ++j) if (j != i1 && el[j] > v2) { v2 = el[j]; i2 = j; }
        const float e2 = expf(v2 - v1);
        const float g1 = pg / (1.0f + e2), g2 = pg * e2 / (1.0f + e2);
        const int ex1 = gs * 8 + i1, ex2 = gs * 8 + i2;
        const int r1 = atomicAdd(&cnt[route_layer * 32 + ex1], 1);
        list[(size_t)ex1 * CAP + r1] = row * 2;
        gate[row * 2] = g1;
        const int r2 = atomicAdd(&cnt[route_layer * 32 + ex2], 1);
        list[(size_t)ex2 * CAP + r2] = row * 2 + 1;
        gate[row * 2 + 1] = g2;
      }
      __syncthreads();
    }
  }
}

constexpr int RSTR = 136;
__device__ __forceinline__ float log_sigmoid(float x) { return -log1pf(expf(-x)); }
__device__ __forceinline__ uint2 lds_tr16(const u16* ptr) {
  typedef short s16x4 __attribute__((ext_vector_type(4)));
  const s16x4 v = __builtin_amdgcn_ds_read_tr16_b64_v4i16((LAS s16x4*)ptr);
  return __builtin_bit_cast(uint2, v);
}
__device__ __forceinline__ uint4 lds_frag_T(const u16* tile, int rs, int k0, int c0, int lane) {
  const int g = lane >> 4, q = (lane & 15) >> 2, pp = lane & 3;
  const u16* a = tile + (k0 + 8 * g + q) * rs + c0 + 4 * pp;
  const uint2 lo = lds_tr16(a), hi = lds_tr16(a + 4 * rs);
  return make_uint4(lo.x, lo.y, hi.x, hi.y);
}
__device__ __forceinline__ void ret_load_tile(u16* dst0, u16* dst1, const u16* src, int t0, int h, const float* w0, const float* w1) {
  for (int c = tidx(); c < 128 * 16; c += NTHR) {
    const int i = c >> 4, ch = (c & 15) * 8;
    const uint4 v = *(const uint4*)(src + (size_t)(t0 + i) * 512 + h * 128 + ch);
    if (w0) {
      const float a = w0[i], b = w1[i];
      const float f[8] = {lo16(v.x), hi16(v.x), lo16(v.y), hi16(v.y), lo16(v.z), hi16(v.z), lo16(v.w), hi16(v.w)};
      *(uint4*)(dst0 + i * RSTR + ch) = make_uint4(pk2(f[0] * a, f[1] * a), pk2(f[2] * a, f[3] * a), pk2(f[4] * a, f[5] * a), pk2(f[6] * a, f[7] * a));
      *(uint4*)(dst1 + i * RSTR + ch) = make_uint4(pk2(f[0] * b, f[1] * b), pk2(f[2] * b, f[3] * b), pk2(f[4] * b, f[5] * b), pk2(f[6] * b, f[7] * b));
    } else *(uint4*)(dst0 + i * RSTR + ch) = v;
  }
}
template <int MB_, int NB_, bool ATR, bool BTR>
__device__ __forceinline__ void lds_mma(f32x4 (&acc)[MB_][NB_], const u16* sA, int sa, int a0, const u16* sB, int sb, int b0, int K, int lane, const float* sc) {
  const int fr = lane & 15, fq = lane >> 4;
  for (int k0 = 0; k0 < K; k0 += 32) {
    uint4 fa[MB_], fb[NB_];
#pragma unroll
    for (int m = 0; m < MB_; ++m) {
      if constexpr (ATR) fa[m] = lds_frag_T(sA, sa, k0, a0 + m * 16, lane);
      else fa[m] = *(const uint4*)(sA + (a0 + m * 16 + fr) * sa + k0 + fq * 8);
      if (sc) {
        const float f = sc[m];
        fa[m].x = pk2(lo16(fa[m].x) * f, hi16(fa[m].x) * f); fa[m].y = pk2(lo16(fa[m].y) * f, hi16(fa[m].y) * f);
        fa[m].z = pk2(lo16(fa[m].z) * f, hi16(fa[m].z) * f); fa[m].w = pk2(lo16(fa[m].w) * f, hi16(fa[m].w) * f);
      }
    }
#pragma unroll
    for (int n = 0; n < NB_; ++n) {
      if constexpr (BTR) fb[n] = lds_frag_T(sB, sb, k0, b0 + n * 16, lane);
      else fb[n] = *(const uint4*)(sB + (b0 + n * 16 + fr) * sb + k0 + fq * 8);
    }
#pragma unroll
    for (int m = 0; m < MB_; ++m)
#pragma unroll
      for (int n = 0; n < NB_; ++n) acc[m][n] = mfma16(fb[n], fa[m], acc[m][n]);
  }
}
__device__ __forceinline__ void phase_ret_inc_mfma(const P& p, char* smem) {
  u16* sKf = (u16*)smem; u16* sKb = sKf + 128 * RSTR; u16* sV = sKb + 128 * RSTR; float* sWf = (float*)(sV + 128 * RSTR); float* sWb = sWf + 128;
  const u16* kb = (const u16*)(p.ws + WS_Z) + (size_t)1 * T_TOK * 512; const u16* vb = (const u16*)(p.ws + WS_Z) + (size_t)2 * T_TOK * 512;
  float* incf = (float*)(p.ws + WS_INC); float* incb = incf + (size_t)512 * 16384;
  const int tid = tidx(), lane = tid & 63, wv = tid >> 6, wr = wv >> 1, wc = wv & 1, fr = lane & 15, fq = lane >> 4;
  for (int item = blockIdx.x; item < 512; item += gridDim.x) {
    const int h = item & 3, bn = item >> 2, t0 = bn * 128;
    const float lgf = log_sigmoid(p.ret_decay[h]), lgb = log_sigmoid(p.ret_decay[4 + h]);
    __syncthreads();
    if (tid < 128) { sWf[tid] = expf(lgf * (float)(127 - tid)); sWb[tid] = expf(lgb * (float)tid); }
    __syncthreads();
    ret_load_tile(sKf, sKb, kb, t0, h, sWf, sWb);
    ret_load_tile(sV, nullptr, vb, t0, h, nullptr, nullptr);
    __syncthreads();
#pragma unroll
    for (int dirn = 0; dirn < 2; ++dirn) {
      f32x4 acc[2][4];
#pragma unroll
      for (int m = 0; m < 2; ++m)
#pragma unroll
        for (int n = 0; n < 4; ++n) acc[m][n] = (f32x4){0.f, 0.f, 0.f, 0.f};
      lds_mma<2, 4, true, true>(acc, sV, RSTR, wr * 32, dirn ? sKb : sKf, RSTR, wc * 64, 128, lane, nullptr);
      float* o = (dirn ? incb : incf) + (size_t)item * 16384;
#pragma unroll
      for (int m = 0; m < 2; ++m)
#pragma unroll
        for (int n = 0; n < 4; ++n) *(f32x4*)(o + (wr * 32 + m * 16 + fr) * 128 + wc * 64 + n * 16 + 4 * fq) = acc[m][n];
    }
  }
}
__device__ __forceinline__ void phase_ret_scan16(const P& p) {
  const float* incf = (const float*)(p.ws + WS_INC); const float* incb = incf + (size_t)512 * 16384;
  u16* spf = (u16*)(p.ws + WS_SP16); u16* spb = spf + (size_t)512 * 16384;
  const int gtid = blockIdx.x * NTHR + tidx(), gsz = gridDim.x * NTHR;
  for (int idx = gtid; idx < 32 * 4096; idx += gsz) {
    const int de = (idx & 4095) * 4, bh = idx >> 12, b = bh >> 2, h = bh & 3;
    const float Gf = expf(128.0f * log_sigmoid(p.ret_decay[h])), Gb = expf(128.0f * log_sigmoid(p.ret_decay[4 + h]));
    f32x4 s = {0.f, 0.f, 0.f, 0.f};
    for (int n = 0; n < 16; ++n) {
      const size_t o = ((size_t)((b * 16 + n) * 4 + h)) * 16384 + de;
      const f32x4 t = *(const f32x4*)(incf + o);
      uint2 w; w.x = pk2(s[0], s[1]); w.y = pk2(s[2], s[3]); *(uint2*)(spf + o) = w;
      s = s * Gf + t;
    }
    s = (f32x4){0.f, 0.f, 0.f, 0.f};
    for (int n = 15; n >= 0; --n) {
      const size_t o = ((size_t)((b * 16 + n) * 4 + h)) * 16384 + de;
      const f32x4 t = *(const f32x4*)(incb + o);
      uint2 w; w.x = pk2(s[0], s[1]); w.y = pk2(s[2], s[3]); *(uint2*)(spb + o) = w;
      s = s * Gb + t;
    }
  }
}
__device__ __forceinline__ void phase_ret_out_mfma(const P& p, char* smem) {
  u16* R0 = (u16*)smem; u16* R1 = R0 + 128 * RSTR; u16* R2 = R1 + 128 * RSTR; u16* R3 = R2 + 128 * RSTR;
  float* sPf = (float*)(R3 + 128 * RSTR); float* sPb = sPf + 132;
  const u16* zb = (const u16*)(p.ws + WS_Z);
  const u16* qb = zb; const u16* kb = zb + (size_t)1 * T_TOK * 512; const u16* vb = zb + (size_t)2 * T_TOK * 512; const u16* gb = zb + (size_t)3 * T_TOK * 512;
  const u16* spf = (const u16*)(p.ws + WS_SP16); const u16* spb = spf + (size_t)512 * 16384;
  u16* ycat = (u16*)(p.ws + WS_YCAT);
  const int tid = tidx(), lane = tid & 63, wv = tid >> 6, wr = wv >> 1, wc = wv & 1, fr = lane & 15, fq = lane >> 4;
  for (int item = blockIdx.x; item < 512; item += gridDim.x) {
    const int h = item & 3, bn = item >> 2, t0 = bn * 128;
    const float lgf = log_sigmoid(p.ret_decay[h]), lgb = log_sigmoid(p.ret_decay[4 + h]);
    __syncthreads();
    ret_load_tile(R0, nullptr, qb, t0, h, nullptr, nullptr);
    ret_load_tile(R1, nullptr, kb, t0, h, nullptr, nullptr);
    ret_load_tile(R2, nullptr, vb, t0, h, nullptr, nullptr);
    if (tid < 129) { sPf[tid] = expf(lgf * (float)tid); sPb[tid] = expf(lgb * (float)tid); }
    __syncthreads();
    {
      f32x4 acc[2][4];
#pragma unroll
      for (int m = 0; m < 2; ++m)
#pragma unroll
        for (int n = 0; n < 4; ++n) acc[m][n] = (f32x4){0.f, 0.f, 0.f, 0.f};
      lds_mma<2, 4, false, false>(acc, R0, RSTR, wr * 32, R1, RSTR, wc * 64, 128, lane, nullptr);
#pragma unroll
      for (int m = 0; m < 2; ++m)
#pragma unroll
        for (int n = 0; n < 4; ++n) {
          const int i = wr * 32 + m * 16 + fr, j = wc * 64 + n * 16 + 4 * fq;
          float v[4];
#pragma unroll
          for (int r = 0; r < 4; ++r) { const int jj = j + r; v[r] = acc[m][n][r] * ((i >= jj) ? sPf[i - jj] : sPb[jj - i]); }
          uint2 w; w.x = pk2(v[0], v[1]); w.y = pk2(v[2], v[3]);
          *(uint2*)(R3 + i * RSTR + j) = w;
        }
    }
    __syncthreads();
    const u16* spT = spf + (size_t)item * 16384; const u16* snT = spb + (size_t)item * 16384;
    for (int c = tid; c < 128 * 16; c += NTHR) { const int e = c >> 4, ch = (c & 15) * 8; *(uint4*)(R1 + e * RSTR + ch) = *(const uint4*)(spT + e * 128 + ch); }
    f32x4 o[1][8];
#pragma unroll
    for (int m = 0; m < 1; ++m)
#pragma unroll
      for (int n = 0; n < 8; ++n) o[m][n] = (f32x4){0.f, 0.f, 0.f, 0.f};
    lds_mma<1, 8, false, true>(o, R3, RSTR, wv * 16, R2, RSTR, 0, 128, lane, nullptr);
    __syncthreads();
    for (int c = tid; c < 128 * 16; c += NTHR) { const int e = c >> 4, ch = (c & 15) * 8; *(uint4*)(R2 + e * RSTR + ch) = *(const uint4*)(snT + e * 128 + ch); }
    float scf[1], scb[1];
    { const int i = wv * 16 + fr; scf[0] = sPf[i + 1]; scb[0] = sPb[128 - i]; }
    lds_mma<1, 8, false, false>(o, R0, RSTR, wv * 16, R1, RSTR, 0, 128, lane, scf);
    __syncthreads();
    lds_mma<1, 8, false, false>(o, R0, RSTR, wv * 16, R2, RSTR, 0, 128, lane, scb);
#pragma unroll
    for (int m = 0; m < 1; ++m) {
      float s1 = 0.f;
#pragma unroll
      for (int n = 0; n < 8; ++n) s1 += (o[m][n][0] + o[m][n][1]) + (o[m][n][2] + o[m][n][3]);
      s1 += __shfl_xor(s1, 16); s1 += __shfl_xor(s1, 32);
      const float mu = s1 * (1.0f / 128.0f);
      float s2 = 0.f;
#pragma unroll
      for (int n = 0; n < 8; ++n)
#pragma unroll
        for (int r = 0; r < 4; ++r) { const float dl = o[m][n][r] - mu; s2 += dl * dl; }
      s2 += __shfl_xor(s2, 16); s2 += __shfl_xor(s2, 32);
      const float rs = rsqrtf(s2 * (1.0f / 128.0f) + 1e-5f);
      const size_t tok = (size_t)(t0 + wv * 16 + m * 16 + fr);
#pragma unroll
      for (int n = 0; n < 8; ++n) {
        const int e = n * 16 + 4 * fq;
        const uint2 gq = *(const uint2*)(gb + tok * 512 + h * 128 + e);
        const float g0 = lo16(gq.x), g1 = hi16(gq.x), g2 = lo16(gq.y), g3 = hi16(gq.y);
        uint2 w;
        w.x = pk2(g0 * sigmoidf_(g0) * (o[m][n][0] - mu) * rs, g1 * sigmoidf_(g1) * (o[m][n][1] - mu) * rs);
        w.y = pk2(g2 * sigmoidf_(g2) * (o[m][n][2] - mu) * rs, g3 * sigmoidf_(g3) * (o[m][n][3] - mu) * rs);
        *(uint2*)(ycat + tok * DM + h * 128 + e) = w;
      }
    }
  }
}

struct Cpx { float re, im; };
__device__ __forceinline__ Cpx cmul(Cpx a, Cpx b) { return {a.re * b.re - a.im * b.im, a.re * b.im + a.im * b.re}; }
__device__ __forceinline__ Cpx s5_lam_pow(float ar, float ai, float dt, float e) {
  const float mag = expf(ar * dt * e); float sn, cs; sincosf(ai * dt * e, &sn, &cs); return {mag * cs, mag * sn};
}
__device__ __forceinline__ Cpx s5_coef(float ar, float ai, float dt) {
  float sn, cs; sincosf(ai * dt, &sn, &cs);
  const float em1 = expm1f(ar * dt), sh = sinf(0.5f * ai * dt);
  const float nr = em1 * cs - 2.0f * sh * sh, ni = (em1 + 1.0f) * sn, den = ar * ar + ai * ai;
  return {(nr * ar + ni * ai) / den, (ni * ar - nr * ai) / den};
}
__device__ __forceinline__ void phase_s5_ktab(const P& p) {
  float* ktab = (float*)(p.ws + WS_KTAB);
  const int gtid = blockIdx.x * NTHR + tidx(), gsz = gridDim.x * NTHR;
  for (int item = gtid; item < 32 * 2 * 32 * 16; item += gsz) {
    const int c = item & 15, l = (item >> 4) & 31, dir = (item >> 9) & 1, g = item >> 10;
    const float dt = expf(p.log_step[dir * 32 + g]);
    float acc[16];
#pragma unroll
    for (int j = 0; j < 16; ++j) acc[j] = 0.f;
    for (int q = 0; q < 64; ++q) {
      const float ar = p.a_re[(dir * 32 + g) * 64 + q], ai = p.a_im[(dir * 32 + g) * 64 + q];
      const Cpx L = s5_lam_pow(ar, ai, dt, (float)l), cf = s5_coef(ar, ai, dt);
      const Cpx C = {p.c_re[((dir * 32 + g) * 16 + c) * 64 + q], p.c_im[((dir * 32 + g) * 16 + c) * 64 + q]};
      const Cpx w = cmul(cmul(C, L), cf);
#pragma unroll
      for (int j = 0; j < 16; ++j) acc[j] += w.re * p.b_re[(g * 64 + q) * 16 + j] - w.im * p.b_im[(g * 64 + q) * 16 + j];
    }
#pragma unroll
    for (int j = 0; j < 16; j += 4) *(f32x4*)(ktab + (size_t)item * 16 + j) = (f32x4){acc[j], acc[j + 1], acc[j + 2], acc[j + 3]};
  }
}
__device__ __forceinline__ void phase_s5_fill(const P& p) {
  const float* ktab = (const float*)(p.ws + WS_KTAB);
  u16* bty = (u16*)(p.ws + WS_BTY); u16* wet = (u16*)(p.ws + WS_WET);
  const int gtid = blockIdx.x * NTHR + tidx(), gsz = gridDim.x * NTHR;
  for (int item = gtid; item < 32 * 512 * 64; item += gsz) {
    const int ch = item & 63, n = (item >> 6) & 511, g = item >> 15;
    const int ip = ch >> 1, c0 = (ch & 1) * 8, i = n >> 4, c = n & 15;
    float v[8];
    if (ip != i) {
      const int dir = ip < i ? 0 : 1, l = ip < i ? i - ip : ip - i;
      const float* src = ktab + ((size_t)((g * 2 + dir) * 32 + l) * 16 + c) * 16 + c0;
      const f32x4 a = *(const f32x4*)src, b = *(const f32x4*)(src + 4);
      v[0] = a[0]; v[1] = a[1]; v[2] = a[2]; v[3] = a[3]; v[4] = b[0]; v[5] = b[1]; v[6] = b[2]; v[7] = b[3];
    } else {
      const float* s0 = ktab + ((size_t)((g * 2 + 0) * 32) * 16 + c) * 16 + c0;
      const float* s1 = ktab + ((size_t)((g * 2 + 1) * 32) * 16 + c) * 16 + c0;
      const float dd = p.s5d[g * 16 + c];
#pragma unroll
      for (int j = 0; j < 8; ++j) v[j] = s0[j] + s1[j] + ((c0 + j) == c ? dd : 0.f);
    }
    *(uint4*)(bty + ((size_t)g * 512 + n) * 768 + ch * 8) = make_uint4(pk2(v[0], v[1]), pk2(v[2], v[3]), pk2(v[4], v[5]), pk2(v[6], v[7]));
  }
  for (int item = gtid; item < 32 * 512 * 32; item += gsz) {
    const int ch = item & 31, n = (item >> 5) & 511, g = item >> 14;
    const int kk = ch * 8, dir = kk >> 7, p0 = (kk & 127) >> 1, i = n >> 4, c = n & 15;
    const float dt = expf(p.log_step[dir * 32 + g]), e = dir ? (float)(32 - i) : (float)(i + 1);
    float v[8];
#pragma unroll
    for (int q = 0; q < 4; ++q) {
      const int pq = p0 + q;
      const float ar = p.a_re[(dir * 32 + g) * 64 + pq], ai = p.a_im[(dir * 32 + g) * 64 + pq];
      const Cpx L = s5_lam_pow(ar, ai, dt, e);
      const Cpx C = {p.c_re[((dir * 32 + g) * 16 + c) * 64 + pq], p.c_im[((dir * 32 + g) * 16 + c) * 64 + pq]};
      const Cpx w = cmul(C, L);
      v[2 * q] = w.re; v[2 * q + 1] = -w.im;
    }
    *(uint4*)(bty + ((size_t)g * 512 + n) * 768 + 512 + kk) = make_uint4(pk2(v[0], v[1]), pk2(v[2], v[3]), pk2(v[4], v[5]), pk2(v[6], v[7]));
  }
  for (int item = gtid; item < 32 * 256 * 64; item += gsz) {
    const int ch = item & 63, n = (item >> 6) & 255, g = item >> 14;
    const int ip = ch >> 1, c0 = (ch & 1) * 8, ri = n & 1, pq = (n >> 1) & 63, dir = n >> 7;
    const float dt = expf(p.log_step[dir * 32 + g]), e = dir ? (float)ip : (float)(31 - ip);
    const float ar = p.a_re[(dir * 32 + g) * 64 + pq], ai = p.a_im[(dir * 32 + g) * 64 + pq];
    const Cpx w = cmul(s5_lam_pow(ar, ai, dt, e), s5_coef(ar, ai, dt));
    float v[8];
#pragma unroll
    for (int j = 0; j < 8; ++j) {
      const float br = p.b_re[(g * 64 + pq) * 16 + c0 + j], bi = p.b_im[(g * 64 + pq) * 16 + c0 + j];
      v[j] = ri ? (w.re * bi + w.im * br) : (w.re * br - w.im * bi);
    }
    *(uint4*)(wet + ((size_t)g * 256 + n) * 512 + ch * 8) = make_uint4(pk2(v[0], v[1]), pk2(v[2], v[3]), pk2(v[4], v[5]), pk2(v[6], v[7]));
  }
}
__device__ __forceinline__ void phase_s5_carry(const P& p) {
  const float* E = (const float*)(p.ws + WS_E);
  u16* a2 = (u16*)(p.ws + WS_A2);
  const int gtid = blockIdx.x * NTHR + tidx(), gsz = gridDim.x * NTHR;
  for (int idx = gtid; idx < 32 * 8 * 128; idx += gsz) {
    const int pq = idx & 63, dir = (idx >> 6) & 1, b = (idx >> 7) & 7, g = idx >> 10;
    const float dt = expf(p.log_step[dir * 32 + g]);
    const Cpx L = s5_lam_pow(p.a_re[(dir * 32 + g) * 64 + pq], p.a_im[(dir * 32 + g) * 64 + pq], dt, 32.0f);
    Cpx s = {0.f, 0.f};
    for (int jj = 0; jj < 64; ++jj) {
      const int j = dir ? 63 - jj : jj, r = b * 64 + j;
      const f32x2 e = *(const f32x2*)(E + ((size_t)g * 512 + r) * 256 + (dir * 64 + pq) * 2);
      *(unsigned*)(a2 + ((size_t)g * 512 + r) * 768 + 512 + (dir * 64 + pq) * 2) = pk2(s.re, s.im);
      const Cpx ns = cmul(L, s);
      s.re = ns.re + e[0]; s.im = ns.im + e[1];
    }
  }
}
constexpr int KSTR = 72;
__device__ __forceinline__ int t5_bucket_abs(int n) {
  return n < 8 ? n : 8 + (n >= 12) + (n >= 16) + (n >= 23) + (n >= 32) + (n >= 46) + (n >= 64) + (n >= 91);
}
__device__ __forceinline__ void phase_attn(const P& p, char* smem) {
  u16* sK = (u16*)smem; u16* sV = sK + 384 * KSTR; float* sBias = (float*)(sV + 384 * KSTR);
  const u16* q1 = (const u16*)(p.ws + WS_Z); const u16* k1 = (const u16*)(p.ws + WS_Z + 32 * MB); const u16* v1 = (const u16*)(p.ws + WS_Z + 40 * MB);
  u16* ao = (u16*)(p.ws + WS_YCAT);
  const int tid = tidx(), lane = tid & 63, wv = tid >> 6, fr = lane & 15, lg = lane >> 4, q0 = (wv & 3) * 32, hp = wv >> 2;
  const int tq = (lane & 15) >> 2, tp = lane & 3;
  for (int item = blockIdx.x; item < 512; item += gridDim.x) {
    const int b = item >> 6, nb = (item >> 2) & 15, kvh = item & 3;
    __syncthreads();
    for (int c = tid; c < 384 * 8; c += NTHR) {
      const int s = c >> 3, ch = (c & 7) * 8, pos = (nb - 1) * 128 + s;
      uint4 kq = make_uint4(0u, 0u, 0u, 0u), vq = kq;
      if (pos >= 0 && pos < SEQ) { kq = *(const uint4*)(k1 + (size_t)(b * SEQ + pos) * 256 + kvh * 64 + ch); vq = *(const uint4*)(v1 + (size_t)(b * SEQ + pos) * 256 + kvh * 64 + ch); }
      *(uint4*)(sK + s * KSTR + ch) = kq; *(uint4*)(sV + s * KSTR + ch) = vq;
    }
    for (int c = tid; c < 4 * 257; c += NTHR) {
      const int hq = c / 257, ri = c % 257, rel = ri - 128, n = rel < 0 ? -rel : rel;
      const int bucket = (rel > 0 ? 16 : 0) + t5_bucket_abs(n);
      sBias[hq * 260 + ri] = p.rel_bias[bucket * 16 + kvh * 4 + hq];
    }
    __syncthreads();
#pragma unroll 1
    for (int hh = 0; hh < 2; ++hh) {
      const int hq = hp * 2 + hh, head = kvh * 4 + hq;
      const size_t tok0 = (size_t)b * SEQ + nb * 128 + q0;
      uint4 qf[2][2];
#pragma unroll
      for (int qb = 0; qb < 2; ++qb)
#pragma unroll
        for (int ks = 0; ks < 2; ++ks) qf[qb][ks] = *(const uint4*)(q1 + (tok0 + qb * 16 + fr) * DM + head * 64 + ks * 32 + lg * 8);
      f32x4 O[4][2];
#pragma unroll
      for (int mb = 0; mb < 4; ++mb)
#pragma unroll
        for (int qb = 0; qb < 2; ++qb) O[mb][qb] = (f32x4){0.f, 0.f, 0.f, 0.f};
      const float sinkv = p.sink[head];
      float mrun[2] = {sinkv, sinkv}, lpart[2] = {lg == 0 ? 1.0f : 0.0f, lg == 0 ? 1.0f : 0.0f};
      const float* bias = sBias + hq * 260;
#pragma unroll
      for (int c = 0; c < 3; ++c) {
        if ((c == 0 && nb == 0) || (c == 2 && nb == 15)) continue;
        f32x4 S[8][2];
#pragma unroll
        for (int kb = 0; kb < 8; ++kb) {
          S[kb][0] = (f32x4){0.f, 0.f, 0.f, 0.f}; S[kb][1] = S[kb][0];
          const bool act = (c == 0) ? (16 * kb + 15 >= q0) : ((c == 2) ? (16 * kb <= q0 + 31) : true);
          if (act) {
#pragma unroll
            for (int ks = 0; ks < 2; ++ks) {
              const uint4 kf = *(const uint4*)(sK + (c * 128 + kb * 16 + fr) * KSTR + ks * 32 + lg * 8);
              S[kb][0] = mfma16(kf, qf[0][ks], S[kb][0]);
              S[kb][1] = mfma16(kf, qf[1][ks], S[kb][1]);
            }
          }
        }
        float cmax[2] = {-1e30f, -1e30f};
#pragma unroll
        for (int kb = 0; kb < 8; ++kb)
#pragma unroll
          for (int qb = 0; qb < 2; ++qb)
#pragma unroll
            for (int r = 0; r < 4; ++r) {
              const int ri = c * 128 + kb * 16 + 4 * lg + r - (q0 + qb * 16 + fr);
              float v;
              if (c == 1) v = S[kb][qb][r] + bias[ri];
              else { const bool valid = (ri >= 0) && (ri <= 256); v = valid ? S[kb][qb][r] + bias[valid ? ri : 0] : -1e30f; }
              S[kb][qb][r] = v; cmax[qb] = fmaxf(cmax[qb], v);
            }
#pragma unroll
        for (int qb = 0; qb < 2; ++qb) {
          cmax[qb] = fmaxf(cmax[qb], __shfl_xor(cmax[qb], 16)); cmax[qb] = fmaxf(cmax[qb], __shfl_xor(cmax[qb], 32));
          const float mn = fmaxf(mrun[qb], cmax[qb]), alpha = __expf(mrun[qb] - mn);
          mrun[qb] = mn; lpart[qb] *= alpha;
#pragma unroll
          for (int mb = 0; mb < 4; ++mb) O[mb][qb] = O[mb][qb] * alpha;
          float ps = 0.f;
#pragma unroll
          for (int kb = 0; kb < 8; ++kb)
#pragma unroll
            for (int r = 0; r < 4; ++r) { const float e = __expf(S[kb][qb][r] - mn); S[kb][qb][r] = e; ps += e; }
          lpart[qb] += ps;
        }
#pragma unroll
        for (int kk = 0; kk < 4; ++kk) {
          const int kb0 = 2 * kk, kb1 = 2 * kk + 1;
          const bool act = (c == 0) ? (16 * kb1 + 15 >= q0) : ((c == 2) ? (16 * kb0 <= q0 + 31) : true);
          if (act) {
            uint4 pf[2];
#pragma unroll
            for (int qb = 0; qb < 2; ++qb) pf[qb] = make_uint4(pk2(S[kb0][qb][0], S[kb0][qb][1]), pk2(S[kb0][qb][2], S[kb0][qb][3]), pk2(S[kb1][qb][0], S[kb1][qb][1]), pk2(S[kb1][qb][2], S[kb1][qb][3]));
#pragma unroll
            for (int mb = 0; mb < 4; ++mb) {
              const uint2 v0 = lds_tr16(sV + (c * 128 + kb0 * 16 + 4 * lg + tq) * KSTR + mb * 16 + 4 * tp);
              const uint2 v1r = lds_tr16(sV + (c * 128 + kb1 * 16 + 4 * lg + tq) * KSTR + mb * 16 + 4 * tp);
              const uint4 vf = make_uint4(v0.x, v0.y, v1r.x, v1r.y);
              O[mb][0] = mfma16(vf, pf[0], O[mb][0]);
              O[mb][1] = mfma16(vf, pf[1], O[mb][1]);
            }
          }
        }
      }
#pragma unroll
      for (int qb = 0; qb < 2; ++qb) {
        float lt = lpart[qb]; lt += __shfl_xor(lt, 16); lt += __shfl_xor(lt, 32);
        const float inv = 1.0f / lt;
#pragma unroll
        for (int mb = 0; mb < 4; ++mb) {
          uint2 w; w.x = pk2(O[mb][qb][0] * inv, O[mb][qb][1] * inv); w.y = pk2(O[mb][qb][2] * inv, O[mb][qb][3] * inv);
          *(uint2*)(ao + (tok0 + qb * 16 + fr) * DM + head * 64 + mb * 16 + 4 * lg) = w;
        }
      }
    }
  }
}

struct EpiInproj {
  u16* zb; u16* a2; const f32x2* rope;
  __device__ __forceinline__ void operator()(const f32x4 (&acc)[2][2][4][2], const pg8::Unit& u, int wr, int wc, int fr, int fq) const {
    const int seg = u.pn >> 1;
#pragma unroll
    for (int ai = 0; ai < 2; ++ai)
#pragma unroll
      for (int m = 0; m < 4; ++m) {
        const int row = u.pm * 256 + ai * 128 + wr * 64 + m * 16 + fr;
        if (seg < 2) {
          const int d = 16 * wc + 4 * fq;
          const f32x2* cs = rope + (size_t)(row & (SEQ - 1)) * 64 + d;
          const f32x4 c01 = *(const f32x4*)cs, c23 = *(const f32x4*)(cs + 2);
          const float cv[4] = {c01[0], c01[2], c23[0], c23[2]}, sv[4] = {c01[1], c01[3], c23[1], c23[3]};
          const float sc = seg == 1 ? 0.08838834764831845f : 1.0f;
#pragma unroll
          for (int bj = 0; bj < 2; ++bj) {
            const f32x4 x1 = acc[ai][bj][m][0], x2 = acc[ai][bj][m][1];
            float o1[4], o2[4];
#pragma unroll
            for (int r = 0; r < 4; ++r) { o1[r] = (x1[r] * cv[r] - x2[r] * sv[r]) * sc; o2[r] = (x1[r] * sv[r] + x2[r] * cv[r]) * sc; }
            u16* dst = zb + (size_t)seg * T_TOK * 512 + (size_t)row * 512 + ((u.pn & 1) * 2 + bj) * 128 + d;
            uint2 w; w.x = pk2(o1[0], o1[1]); w.y = pk2(o1[2], o1[3]); *(uint2*)dst = w;
            w.x = pk2(o2[0], o2[1]); w.y = pk2(o2[2], o2[3]); *(uint2*)(dst + 64) = w;
          }
        } else {
#pragma unroll
          for (int bj = 0; bj < 2; ++bj)
#pragma unroll
            for (int n = 0; n < 2; ++n) {
              const int col = u.pn * 256 + bj * 128 + wc * 32 + n * 16 + 4 * fq;
              const f32x4 v = acc[ai][bj][m][n];
              uint2 w; w.x = pk2(v[0], v[1]); w.y = pk2(v[2], v[3]);
              if (seg < 4) *(uint2*)(zb + (size_t)seg * T_TOK * 512 + (size_t)row * 512 + (col - seg * 512)) = w;
              else { const int ch = col - 2048, gi = ch >> 4, c = ch & 15; *(uint2*)(a2 + ((size_t)gi * 512 + (row >> 5)) * 768 + (row & 31) * 16 + c) = w; }
            }
        }
      }
  }
};
__device__ __forceinline__ void phase_inproj(const P& p, LAS unsigned char* lds) {
  pg8::DenseOrder S; S.init(p.ws + WS_XB, DM, p.ws + WS_WIN, T_TOK, 2560, DM);
  EpiInproj E{(u16*)(p.ws + WS_Z), (u16*)(p.ws + WS_A2), (const f32x2*)(p.ws + WS_ROPE)};
  pg8::gemm_phase<EpiInproj, pg8::DenseOrder, G_ALIGN, G_SP2>(lds, DM, S, E);
}
struct EpiS5E {
  float* E_;
  __device__ __forceinline__ void operator()(const f32x4 (&acc)[2][2][4][2], const pg8::Unit& u, int wr, int wc, int fr, int fq) const {
#pragma unroll
    for (int ai = 0; ai < 2; ++ai)
#pragma unroll
      for (int m = 0; m < 4; ++m) {
        const int row = u.pm * 256 + ai * 128 + wr * 64 + m * 16 + fr;
#pragma unroll
        for (int bj = 0; bj < 2; ++bj)
#pragma unroll
          for (int n = 0; n < 2; ++n) *(f32x4*)(E_ + ((size_t)u.e * 512 + row) * 256 + bj * 128 + wc * 32 + n * 16 + 4 * fq) = acc[ai][bj][m][n];
      }
  }
};
__device__ __forceinline__ void phase_s5_egemm(const P& p, LAS unsigned char* lds) {
  pg8::GroupOrder S; S.init(p.ws + WS_A2, 768, (size_t)512 * 768, p.ws + WS_WET, (size_t)256 * 512, 32, 512, 256, 512);
  EpiS5E E{(float*)(p.ws + WS_E)};
  pg8::gemm_phase<EpiS5E, pg8::GroupOrder, G_ALIGN, G_SP2>(lds, 512, S, E);
}
struct EpiS5Y {
  u16* yg;
  __device__ __forceinline__ void operator()(const f32x4 (&acc)[2][2][4][2], const pg8::Unit& u, int wr, int wc, int fr, int fq) const {
#pragma unroll
    for (int ai = 0; ai < 2; ++ai)
#pragma unroll
      for (int m = 0; m < 4; ++m) {
        const int row = u.pm * 256 + ai * 128 + wr * 64 + m * 16 + fr;
#pragma unroll
        for (int bj = 0; bj < 2; ++bj)
#pragma unroll
          for (int n = 0; n < 2; ++n) {
            const int col = u.pn * 256 + bj * 128 + wc * 32 + n * 16 + 4 * fq;
            const f32x4 v = acc[ai][bj][m][n];
            uint2 w; w.x = pk2(gelu_tanh(v[0]), gelu_tanh(v[1])); w.y = pk2(gelu_tanh(v[2]), gelu_tanh(v[3]));
            *(uint2*)(yg + ((size_t)row * 32 + (col >> 4)) * 512 + u.e * 16 + (col & 15)) = w;
          }
      }
  }
};
__device__ __forceinline__ void phase_s5_ygemm(const P& p, LAS unsigned char* lds) {
  pg8::GroupOrder S; S.init(p.ws + WS_A2, 768, (size_t)512 * 768, p.ws + WS_BTY, (size_t)512 * 768, 32, 512, 512, 768);
  EpiS5Y E{(u16*)(p.ws + WS_YGELU)};
  pg8::gemm_phase<EpiS5Y, pg8::GroupOrder, G_ALIGN, G_SP2>(lds, 768, S, E);
}
struct EpiGlu {
  const u16* yg; const float* bglu; u16* ycat;
  __device__ __forceinline__ void operator()(const f32x4 (&acc)[2][2][4][2], const pg8::Unit& u, int wr, int wc, int fr, int fq) const {
#pragma unroll
    for (int ai = 0; ai < 2; ++ai)
#pragma unroll
      for (int m = 0; m < 4; ++m) {
        const int row = u.pm * 256 + ai * 128 + wr * 64 + m * 16 + fr;
#pragma unroll
        for (int bj = 0; bj < 2; ++bj)
#pragma unroll
          for (int n = 0; n < 2; ++n) {
            const int col = u.pn * 256 + bj * 128 + wc * 32 + n * 16 + 4 * fq;
            const f32x4 v = acc[ai][bj][m][n];
            const uint2 yv = *(const uint2*)(yg + (size_t)row * 512 + col);
            const f32x4 bb = *(const f32x4*)(bglu + col);
            uint2 w;
            w.x = pk2(lo16(yv.x) * sigmoidf_(v[0] + bb[0]), hi16(yv.x) * sigmoidf_(v[1] + bb[1]));
            w.y = pk2(lo16(yv.y) * sigmoidf_(v[2] + bb[2]), hi16(yv.y) * sigmoidf_(v[3] + bb[3]));
            *(uint2*)(ycat + (size_t)row * DM + 512 + col) = w;
          }
      }
  }
};
__device__ __forceinline__ void phase_glu(const P& p, LAS unsigned char* lds) {
  pg8::DenseOrder S; S.init(p.ws + WS_YGELU, 512, p.ws + WS_WGLU, T_TOK, 512, 512);
  EpiGlu E{(const u16*)(p.ws + WS_YGELU), p.b_glu, (u16*)(p.ws + WS_YCAT)};
  pg8::gemm_phase<EpiGlu, pg8::DenseOrder, G_ALIGN, G_SP2>(lds, 512, S, E);
}
struct EpiResid {
  const float* xin; float* xout;
  __device__ __forceinline__ void operator()(const f32x4 (&acc)[2][2][4][2], const pg8::Unit& u, int wr, int wc, int fr, int fq) const {
#pragma unroll
    for (int ai = 0; ai < 2; ++ai)
#pragma unroll
      for (int m = 0; m < 4; ++m) {
        const int row = u.pm * 256 + ai * 128 + wr * 64 + m * 16 + fr;
#pragma unroll
        for (int bj = 0; bj < 2; ++bj)
#pragma unroll
          for (int n = 0; n < 2; ++n) {
            const size_t o = (size_t)row * DM + u.pn * 256 + bj * 128 + wc * 32 + n * 16 + 4 * fq;
            const f32x4 xv = *(const f32x4*)(xin + o);
            *(f32x4*)(xout + o) = xv + acc[ai][bj][m][n];
          }
      }
  }
};
__device__ __forceinline__ void phase_outproj(const P& p, const void* Wt, const float* xin, float* xout, LAS unsigned char* lds) {
  pg8::DenseOrder S; S.init(p.ws + WS_YCAT, DM, Wt, T_TOK, DM, DM);
  EpiResid E{xin, xout};
  pg8::gemm_phase<EpiResid, pg8::DenseOrder, G_ALIGN, G_SP2>(lds, DM, S, E);
}
struct EpiQkv {
  u16 *q1, *k1, *v1;
  __device__ __forceinline__ void operator()(const f32x4 (&acc)[2][2][4][2], const pg8::Unit& u, int wr, int wc, int fr, int fq) const {
#pragma unroll
    for (int ai = 0; ai < 2; ++ai)
#pragma unroll
      for (int m = 0; m < 4; ++m) {
        const int row = u.pm * 256 + ai * 128 + wr * 64 + m * 16 + fr;
#pragma unroll
        for (int bj = 0; bj < 2; ++bj)
#pragma unroll
          for (int n = 0; n < 2; ++n) {
            const int col = u.pn * 256 + bj * 128 + wc * 32 + n * 16 + 4 * fq;
            const f32x4 v = acc[ai][bj][m][n];
            uint2 w;
            if (u.pn < 4) { w.x = pk2(v[0] * 0.125f, v[1] * 0.125f); w.y = pk2(v[2] * 0.125f, v[3] * 0.125f); *(uint2*)(q1 + (size_t)row * DM + col) = w; }
            else {
              w.x = pk2(v[0], v[1]); w.y = pk2(v[2], v[3]);
              if (u.pn == 4) *(uint2*)(k1 + (size_t)row * 256 + (col - 1024)) = w; else *(uint2*)(v1 + (size_t)row * 256 + (col - 1280)) = w;
            }
          }
      }
  }
};
__device__ __forceinline__ void phase_qkv(const P& p, LAS unsigned char* lds) {
  pg8::DenseOrder S; S.init(p.ws + WS_XB, DM, p.ws + WS_WQKV, T_TOK, 1536, DM);
  EpiQkv E{(u16*)(p.ws + WS_Z), (u16*)(p.ws + WS_Z + 32 * MB), (u16*)(p.ws + WS_Z + 40 * MB)};
  pg8::gemm_phase<EpiQkv, pg8::DenseOrder, G_ALIGN, G_SP2>(lds, DM, S, E);
}
__device__ __forceinline__ void phase_moe_plan(const P& p, int layer, char* smem) {
  if (blockIdx.x != 0) return;
  using pg8::PLAN_STRIDE;
  const int tid = tidx();
  const int* cnt = (const int*)(p.ws + WS_CNT) + layer * 32;
  int* plan_n = (int*)(p.ws + WS_PLAN + layer * 65536); int4* plan = (int4*)(p.ws + WS_PLAN + layer * 65536 + 256);
  int* sc = (int*)smem;
  int* ecum = sc + 32; int* ebase = ecum + 32; int* ehb = ebase + 32; int* tot = ehb + 32;
  unsigned* keys = (unsigned*)(tot + 8);
  constexpr int NN = 4;
  __syncthreads();
  if (tid < 32) sc[tid] = cnt[tid];
  __syncthreads();
  if (tid == 0) {
    int cum = 0, ub = 0, hb = 0;
    for (int e = 0; e < 32; ++e) {
      const int c = sc[e], fl = c >> 8, rem = c & 255, rc = (rem + 63) >> 6, ntl = fl + (rem ? 1 : 0);
      ecum[e] = cum; ebase[e] = ub; ehb[e] = hb;
      cum += (fl * 4 + rc) * NN; ub += ntl * NN; hb += ntl * 256;
    }
    tot[0] = cum > 0 ? cum : 1; tot[1] = ub;
  }
  __syncthreads();
  const int total = tot[0], nunits = tot[1] < 1024 ? tot[1] : 1024;
  int4 en[2]; unsigned mykey[2];
#pragma unroll
  for (int q = 0; q < 2; ++q) {
    const int u = tid + q * NTHR;
    mykey[q] = 0xffffffffu; en[q] = make_int4(0, 0, 0, 0);
    if (u < nunits) {
      int e = 0;
      for (int j = 1; j < 32; ++j) if (ebase[j] <= u) e = j;
      const int c = sc[e], fl = c >> 8, rem = c & 255, rc = (rem + 63) >> 6, ntl = fl + (rem ? 1 : 0);
      const int local = u - ebase[e], ct = local / ntl, rt = local - ct * ntl;
      const int cum = ecum[e] + ct * (fl * 4 + rc) + rt * 4;
      const bool isfull = rt < fl;
      const int cost = isfull ? 4 : rc;
      int x = (cum * 8) / total; if (x > 7) x = 7;
      mykey[q] = ((unsigned)x << 28) | ((isfull ? 0u : 1u) << 27) | ((isfull ? 0u : (unsigned)(4 - cost)) << 24) | (unsigned)u;
      en[q] = make_int4(e | (rt << 8) | (ct << 16), c, ehb[e], 0);
      keys[u] = mykey[q];
    }
  }
  __syncthreads();
#pragma unroll
  for (int q = 0; q < 2; ++q) {
    const int u = tid + q * NTHR;
    if (u < nunits) {
      const unsigned k = mykey[q], x = k >> 28;
      int pos = 0;
      for (int v = 0; v < nunits; ++v) { const unsigned kv = keys[v]; pos += ((kv >> 28) == x && kv < k) ? 1 : 0; }
      if (pos < PLAN_STRIDE) plan[x * PLAN_STRIDE + pos] = en[q];
    }
  }
  if (tid < 8) {
    int n = 0;
    for (int v = 0; v < nunits; ++v) n += ((keys[v] >> 28) == (unsigned)tid) ? 1 : 0;
    plan_n[tid] = n < PLAN_STRIDE ? n : PLAN_STRIDE;
  }
  __syncthreads();
}
struct EpiMoe1 {
  u16* hbuf;
  __device__ __forceinline__ void operator()(const f32x4 (&acc)[2][2][4][2], const pg8::Unit& u, int wr, int wc, int fr, int fq) const {
#pragma unroll
    for (int ai = 0; ai < 2; ++ai)
#pragma unroll
      for (int m = 0; m < 4; ++m) {
        const int row = u.pm * 256 + ai * 128 + wr * 64 + m * 16 + fr;
        if (row < u.cnt) {
#pragma unroll
          for (int bj = 0; bj < 2; ++bj) {
            const f32x4 g = acc[ai][bj][m][0], up = acc[ai][bj][m][1];
            uint2 w; w.x = pk2(g[0] * sigmoidf_(g[0]) * up[0], g[1] * sigmoidf_(g[1]) * up[1]); w.y = pk2(g[2] * sigmoidf_(g[2]) * up[2], g[3] * sigmoidf_(g[3]) * up[3]);
            *(uint2*)(hbuf + (size_t)(u.hbase + row) * 512 + 16 * (8 * u.pn + 4 * bj + wc) + 4 * fq) = w;
          }
        }
      }
  }
};
__device__ __forceinline__ void phase_moe1(const P& p, int layer, LAS unsigned char* lds) {
  pg8::PlanOrder S; S.init(p.ws + WS_PLAN + layer * 65536, (const int*)(p.ws + WS_LIST), p.ws + WS_XB, DM, p.ws + WS_MW, (size_t)DM * DM, DM, true);
  EpiMoe1 E{(u16*)(p.ws + WS_H)};
  pg8::gemm_phase<EpiMoe1, pg8::PlanOrder, G_ALIGN, G_SP2>(lds, DM, S, E);
}
struct EpiMoe2 {
  const int* list; const float* gate; u16* slots;
  __device__ __forceinline__ void operator()(const f32x4 (&acc)[2][2][4][2], const pg8::Unit& u, int wr, int wc, int fr, int fq) const {
#pragma unroll
    for (int ai = 0; ai < 2; ++ai)
#pragma unroll
      for (int m = 0; m < 4; ++m) {
        const int row = u.pm * 256 + ai * 128 + wr * 64 + m * 16 + fr;
        if (row < u.cnt) {
          const int asg = list[(size_t)u.e * CAP + row];
          const float gt = gate[asg];
#pragma unroll
          for (int bj = 0; bj < 2; ++bj)
#pragma unroll
            for (int n = 0; n < 2; ++n) {
              const f32x4 v = acc[ai][bj][m][n];
              uint2 w; w.x = pk2(gt * v[0], gt * v[1]); w.y = pk2(gt * v[2], gt * v[3]);
              *(uint2*)(slots + (size_t)asg * DM + u.pn * 256 + bj * 128 + wc * 32 + n * 16 + 4 * fq) = w;
            }
        }
      }
  }
};
__device__ __forceinline__ void phase_moe2(const P& p, int layer, LAS unsigned char* lds) {
  pg8::PlanOrder S; S.init(p.ws + WS_PLAN + layer * 65536, (const int*)(p.ws + WS_LIST), p.ws + WS_H, 512, p.ws + WS_MW + 64 * MB, (size_t)DM * 512, 512, false);
  EpiMoe2 E{(const int*)(p.ws + WS_LIST), (const float*)(p.ws + WS_GATE), (u16*)(p.ws + WS_INC)};
  pg8::gemm_phase<EpiMoe2, pg8::PlanOrder, G_ALIGN, G_SP2>(lds, 512, S, E);
}

#define XB_TMO      128
#define XB_XCNT(j)  (256  + 64 * (j))
#define XB_XSUB(j)  (1280 + 64 * (j))
#define XB_XGEN(j)  (2304 + 64 * (j))
#define XB_TOP      3328
#define XB_TOPGEN   3392
#define XCD_BAR_WORDS 3456
#define XB_SPIN_CAP (1u << 22)
__device__ __forceinline__ unsigned xb_ld(unsigned* p)              { return __hip_atomic_load(p, __ATOMIC_RELAXED, __HIP_MEMORY_SCOPE_AGENT); }
__device__ __forceinline__ unsigned xb_add(unsigned* p, unsigned v) { return __hip_atomic_fetch_add(p, v, __ATOMIC_RELAXED, __HIP_MEMORY_SCOPE_AGENT); }
__device__ __forceinline__ unsigned xb_xcc_id() { return (unsigned)__builtin_amdgcn_s_getreg((3 << 11) | 20) & 0xFu; }
#define XB_SPIN(cond, bar) do { unsigned _sp = 0; while (cond) { __builtin_amdgcn_s_sleep(1); \
    if ((++_sp & 255u) == 0u) { if (xb_ld(&(bar)[XB_TMO])) break; if (_sp > XB_SPIN_CAP) { atomicAdd(&(bar)[XB_TMO], 1u); break; } } } } while (0)
struct XcdBarrier { unsigned* bar; unsigned x; volatile LAS unsigned* st; };
__device__ __forceinline__ XcdBarrier xcd_barrier_post(unsigned* bar, volatile LAS unsigned* st) {
  XcdBarrier b; b.bar = bar; b.x = xb_xcc_id(); b.st = st;
  if (tidx() == 0) (void)xb_add(&bar[XB_XCNT(b.x)], 1u);
  return b;
}
__device__ __forceinline__ void xcd_barrier_complete(unsigned* bar, unsigned x, unsigned& nloc, unsigned& nx) {
  const unsigned G = gridDim.x * gridDim.y * gridDim.z;
  unsigned sum, cnt, mine, sp = 0u;
  for (;;) {
    sum = 0u; cnt = 0u; mine = 0u;
#pragma unroll
    for (unsigned j = 0; j < 16; ++j) { const unsigned c = xb_ld(&bar[XB_XCNT(j)]); sum += c; cnt += (c > 0u) ? 1u : 0u; mine = (j == x) ? c : mine; }
    if (sum == G) break;
    __builtin_amdgcn_s_sleep(1);
    if ((++sp & 255u) == 0u) { if (xb_ld(&bar[XB_TMO])) break; if (sp > XB_SPIN_CAP) { atomicAdd(&bar[XB_TMO], 1u); break; } }
  }
  nloc = mine > 0u ? mine : 1u; nx = cnt > 0u ? cnt : 1u;
}
__device__ __forceinline__ void xcd_barrier(const XcdBarrier& b) {
  asm volatile("s_waitcnt vmcnt(0)" ::: "memory");
  __syncthreads();
  if (tidx() == 0) {
    unsigned* bar = b.bar;
    __builtin_amdgcn_s_waitcnt(0);
    unsigned nloc = b.st[0], nx = b.st[1];
    if (nloc == 0u) { xcd_barrier_complete(bar, b.x, nloc, nx); b.st[0] = nloc; b.st[1] = nx; }
    const unsigned old = xb_add(&bar[XB_XSUB(b.x)], 1u);
    const unsigned gen = old / nloc;
    if (old + 1u == (gen + 1u) * nloc) {
      __builtin_amdgcn_fence(__ATOMIC_RELEASE, "agent");
      asm volatile("s_waitcnt vmcnt(0)" ::: "memory");
      const unsigned og = xb_add(&bar[XB_TOP], 1u);
      const unsigned tg = og / nx;
      if (og + 1u == (tg + 1u) * nx) xb_add(&bar[XB_TOPGEN], 1u);
      else XB_SPIN(xb_ld(&bar[XB_TOPGEN]) == tg, bar);
      __builtin_amdgcn_fence(__ATOMIC_ACQUIRE, "agent");
      xb_add(&bar[XB_XGEN(b.x)], 1u);
      asm volatile("s_waitcnt vmcnt(0)" ::: "memory");
    } else {
      XB_SPIN(xb_ld(&bar[XB_XGEN(b.x)]) == gen, bar);
      __builtin_amdgcn_fence(__ATOMIC_ACQUIRE, "agent");
      asm volatile("s_waitcnt vmcnt(0)" ::: "memory");
    }
  }
  __syncthreads();
}

constexpr int NPHASE = 20;
constexpr int LDS_BYTES = 147456;
__device__ __forceinline__ void run_phase(const P& p, int ph, char* smem, LAS unsigned char* lds) {
  float* xa = (float*)(p.ws + WS_XA);
  const u16* slots = (const u16*)(p.ws + WS_INC);
  switch (ph) {
    case 0: phase_rowpass(p, p.x, nullptr, nullptr, p.norm_mix_g, -1, nullptr, smem); phase_prep(p); phase_s5_ktab(p); __syncthreads(); phase_conv_dense(p, smem); break;
    case 1: phase_inproj(p, lds); phase_s5_fill(p); break;
    case 2: phase_ret_inc_mfma(p, smem); __syncthreads(); phase_s5_egemm(p, lds); break;
    case 3: phase_ret_scan16(p); phase_s5_carry(p); break;
    case 4: phase_ret_out_mfma(p, smem); __syncthreads(); phase_s5_ygemm(p, lds); break;
    case 5: phase_glu(p, lds); break;
    case 6: phase_outproj(p, p.ws + WS_WOUT, p.x, xa, lds); break;
    case 7: phase_rowpass(p, xa, nullptr, nullptr, p.norm_ffn_g, 0, nullptr, smem); break;
    case 8: phase_moe_plan(p, 0, smem); phase_conv_moe(p, 0, smem); break;
    case 9: phase_moe1(p, 0, lds); break;
    case 10: phase_moe2(p, 0, lds); break;
    case 11: phase_rowpass(p, xa, slots, xa, p.norm_mix_g + DM, -1, nullptr, smem); break;
    case 12: phase_qkv(p, lds); break;
    case 13: phase_attn(p, smem); break;
    case 14: phase_outproj(p, p.ws + WS_WO, xa, xa, lds); break;
    case 15: phase_rowpass(p, xa, nullptr, nullptr, p.norm_ffn_g + DM, 1, nullptr, smem); break;
    case 16: phase_moe_plan(p, 1, smem); phase_conv_moe(p, 1, smem); break;
    case 17: phase_moe1(p, 1, lds); break;
    case 18: phase_moe2(p, 1, lds); break;
    case 19: phase_rowpass(p, xa, slots, nullptr, p.norm_final_g, -1, p.out, smem); break;
    default: break;
  }
}

extern __shared__ __attribute__((aligned(16))) char dyn_smem[];

template <int PH> __device__ __forceinline__ void mega_steps(const P& p, char* smem, LAS unsigned char* lds, cg::grid_group& grid, const XcdBarrier& xb) {
  run_phase(p, PH, smem, lds);
  if constexpr (PH + 1 < NPHASE) {
    if constexpr (PH == 0) grid.sync(); else xcd_barrier(xb);
    mega_steps<PH + 1>(p, smem, lds, grid, xb);
  }
}
__global__ void __launch_bounds__(NTHR, 2) k_mega(P p) {
  cg::grid_group grid = cg::this_grid();
  LAS unsigned char* lds = (LAS unsigned char*)dyn_smem;
  volatile LAS unsigned* st = (volatile LAS unsigned*)(lds + LDS_BYTES - 16);
  if (tidx() == 0) { st[0] = 0u; st[1] = 0u; }
  __syncthreads();
  const XcdBarrier xb = xcd_barrier_post((unsigned*)(p.ws + WS_BAR), st);
  mega_steps<0>(p, dyn_smem, lds, grid, xb);
}

extern "C" void kernel_launch(void* const* d_in, const int* in_sizes, int n_in, void* d_out, int out_size, void* d_ws, size_t ws_size, hipStream_t stream) {
  static int grid_blocks = 0;
  if (grid_blocks == 0) {
    if (n_in != 28 || out_size != T_TOK * DM || ws_size < WS_END) { fprintf(stderr, "kernel_launch: unexpected problem (n_in %d out %d ws %zu need %zu)\n", n_in, out_size, ws_size, (size_t)WS_END); grid_blocks = -1; return; }
    int dev = 0, cus = 0, per_cu = 0;
    (void)hipGetDevice(&dev);
    (void)hipDeviceGetAttribute(&cus, hipDeviceAttributeMultiprocessorCount, dev);
    const void* fn = (const void*)k_mega;
    if (hipFuncSetAttribute(fn, hipFuncAttributeMaxDynamicSharedMemorySize, LDS_BYTES) != hipSuccess) { fprintf(stderr, "kernel_launch: hipFuncSetAttribute failed\n"); }
    if (hipOccupancyMaxActiveBlocksPerMultiprocessor(&per_cu, fn, NTHR, LDS_BYTES) != hipSuccess || per_cu < 1) { fprintf(stderr, "kernel_launch: occupancy query failed (%d)\n", per_cu); per_cu = 1; }
    (void)hipGetLastError();
    if (per_cu > 1) per_cu = 1;
    grid_blocks = cus * per_cu;
    fprintf(stderr, "kernel_launch: cus %d per_cu %d grid %d\n", cus, per_cu, grid_blocks);
  }
  if (grid_blocks < 0) return;
  P p{};
  const float** pp = (const float**)&p;
  for (int i = 0; i < 28; ++i) pp[i] = (const float*)d_in[i];
  p.out = (float*)d_out; p.ws = (char*)d_ws;
  (void)hipMemsetAsync((char*)d_ws + WS_BAR, 0, XCD_BAR_WORDS * 4, stream);
  void* args[] = {&p};
  hipError_t e = hipLaunchCooperativeKernel((const void*)k_mega, dim3(grid_blocks), dim3(NTHR), args, LDS_BYTES, stream);
  if (e != hipSuccess) fprintf(stderr, "cooperative launch failed: %s (grid %d)\n", hipGetErrorString(e), grid_blocks);
}
```

```cpp
#include <hip/hip_runtime.h>
#include <hip/hip_cooperative_groups.h>
#include <cstdio>
#include <cstdint>
namespace cg = cooperative_groups;

#define USE_FP16 1
#define LAS __attribute__((address_space(3)))

typedef unsigned short u16;
typedef float f32x4 __attribute__((ext_vector_type(4)));
typedef float f32x2 __attribute__((ext_vector_type(2)));
typedef _Float16 f16x8 __attribute__((ext_vector_type(8)));

constexpr int T_TOK = 16384, DM = 1024, SEQ = 2048, NBATCH = 8;
constexpr int CAP = 32768;
constexpr int NTHR = 512, NWAVE = NTHR / 64;

constexpr size_t MB = 1024ull * 1024ull;
constexpr size_t WS_XA    = 0;
constexpr size_t WS_XB    = 64 * MB;
constexpr size_t WS_Z     = 96 * MB;
constexpr size_t WS_A2    = 160 * MB;
constexpr size_t WS_BTY   = 184 * MB;
constexpr size_t WS_MW    = WS_Z;
constexpr size_t WS_WET   = 208 * MB;
constexpr size_t WS_E     = 216 * MB;
constexpr size_t WS_KTAB  = 232 * MB;
constexpr size_t WS_SP16  = 234 * MB;
constexpr size_t WS_INC   = 266 * MB;
constexpr size_t WS_YCAT  = 330 * MB;
constexpr size_t WS_YGELU = 362 * MB;
constexpr size_t WS_H     = 378 * MB;
constexpr size_t WS_LIST  = 418 * MB;
constexpr size_t WS_GATE  = 422 * MB;
constexpr size_t WS_ROPE  = 423 * MB;
constexpr size_t WS_CNT   = 424 * MB;
constexpr size_t WS_WR16  = 425 * MB;
constexpr size_t WS_BAR   = 426 * MB;
constexpr size_t WS_PLAN  = 426 * MB + 512 * 1024;
constexpr size_t WS_WIN   = 427 * MB;
constexpr size_t WS_WGLU  = 432 * MB;
constexpr size_t WS_WOUT  = 433 * MB;
constexpr size_t WS_WQKV  = 435 * MB;
constexpr size_t WS_WO    = 438 * MB;
constexpr size_t WS_LAMT  = 440 * MB;
constexpr size_t WS_END   = 442 * MB;

struct P {
  const float *x, *norm_mix_g, *norm_ffn_g, *norm_final_g, *w_in, *ret_decay, *a_re, *a_im, *log_step, *b_re, *b_im, *c_re, *c_im,
      *s5d, *w_glu, *b_glu, *w_out, *w_qkv, *sink, *w_o, *rel_bias, *w_group, *b_group, *w_er, *b_er, *w_gate, *w_up, *w_down;
  float* out;
  char* ws;
};

__device__ __forceinline__ u16 f2h(float f) { _Float16 h = (_Float16)f; return __builtin_bit_cast(u16, h); }
__device__ __forceinline__ float h2f(u16 h) { return (float)__builtin_bit_cast(_Float16, h); }
__device__ __forceinline__ unsigned pk2(float a, float b) { return (unsigned)f2h(a) | ((unsigned)f2h(b) << 16); }
__device__ __forceinline__ float lo16(unsigned w) { return h2f((u16)(w & 0xffffu)); }
__device__ __forceinline__ float hi16(unsigned w) { return h2f((u16)(w >> 16)); }
__device__ __forceinline__ f32x4 mfma16(uint4 a, uint4 b, f32x4 c) {
  return __builtin_amdgcn_mfma_f32_16x16x32_f16(__builtin_bit_cast(f16x8, a), __builtin_bit_cast(f16x8, b), c, 0, 0, 0);
}
__device__ __forceinline__ float wave_sum(float v) {
#pragma unroll
  for (int o = 1; o < 64; o <<= 1) v += __shfl_xor(v, o);
  return v;
}
__device__ __forceinline__ float sigmoidf_(float x) { return 1.0f / (1.0f + __expf(-x)); }
__device__ __forceinline__ float gelu_tanh(float x) {
  const float u = 0.7978845608028654f * (x + 0.044715f * x * x * x);
  return 0.5f * x * (1.0f + tanhf(u));
}
#define LDS_WAIT() asm volatile("s_waitcnt lgkmcnt(0)" ::: "memory")
__device__ __forceinline__ int tidx() { int t = threadIdx.x; asm volatile("" : "+v"(t)); return t; }

namespace pg8 {
constexpr int BM = 256, BK = 64, HALF = 128, HTB = HALF * BK * 2, STAGE_BYTES = 8 * HTB, NXCD = 8, WGM = 8;
__device__ __forceinline__ int lds_byte(int r, int c) { const int st = (r >> 4) * 2 + (c >> 5), rr = r & 15, cc = c & 31, ob = rr * 64 + cc * 2; return st * 1024 + (ob ^ (((ob >> 9) & 1) << 5)); }
__device__ __forceinline__ void stage_rc(int b, int& R, int& C) { const int st = b / 1024, sb = b % 1024, swz = sb ^ (((sb >> 9) & 1) << 5); R = (st >> 1) * 16 + swz / 64; C = (st & 1) * 32 + (swz % 64) / 2; }

struct Unit { const char* a; const char* b; int pm, pn, e, cnt, hbase; };

template <class Epi, class Sched, bool ALIGN_EPI, bool SP2>
__device__ __forceinline__ void gemm_phase(LAS unsigned char* lds, const int K, const Sched& S, const Epi& E) {
    const int tid = tidx(), wid = __builtin_amdgcn_readfirstlane(tid >> 6), lane = tid & 63, wr = wid >> 2, wc = wid & 3, fr = lane & 15, fq = lane >> 4;
    const int nt = K / BK;
    int Rr[2], Cc[2];
    unsigned voffB[2];
#pragma unroll
    for (int i = 0; i < 2; ++i) { stage_rc(tid * 16 + i * 8192, Rr[i], Cc[i]); voffB[i] = (unsigned)(Rr[i] * K + Cc[i]) * 2u; }
    const size_t kstep = (size_t)(BK * 2);
    const size_t hstepB = (size_t)HALF * K * 2;
    const unsigned ldsw = (unsigned)wid * 1024u;
    const int aoff = lds_byte(wr * 64 + fr, fq * 8), boff = lds_byte(wc * 32 + fr, fq * 8);
#define PG8_SA(b, h) (((b) * 2 + (h)) * HTB)
#define PG8_SB(b, h) ((4 + (b) * 2 + (h)) * HTB)
#define PG8_STAGE(bufoff, gbase, voff) do { _Pragma("unroll") for (int _i = 0; _i < 2; ++_i) \
        __builtin_amdgcn_global_load_lds((const unsigned*)((const char*)(gbase) + (voff)[_i]), (LAS unsigned*)(lds + (bufoff) + ldsw + _i * 8192), 16, 0, 0); } while (0)
#define PG8_LDA(dst, b, h) do { _Pragma("unroll") for (int m = 0; m < 4; ++m) _Pragma("unroll") for (int k = 0; k < 2; ++k) dst[m][k] = *(const LAS f16x8*)(lds + PG8_SA(b, h) + aoff + m * 2048 + k * 1024); } while (0)
#define PG8_LDB(dst, b, h) do { _Pragma("unroll") for (int n = 0; n < 2; ++n) _Pragma("unroll") for (int k = 0; k < 2; ++k) dst[n][k] = *(const LAS f16x8*)(lds + PG8_SB(b, h) + boff + n * 2048 + k * 1024); } while (0)
#define PG8_MMA(ai, bj, At, Bt) do { if (128 * (ai) + 64 * wr >= urows) break; __builtin_amdgcn_s_setprio(1); _Pragma("unroll") for (int m = 0; m < 4; ++m) _Pragma("unroll") for (int n = 0; n < 2; ++n) _Pragma("unroll") for (int k = 0; k < 2; ++k) \
        acc[ai][bj][m][n] = __builtin_amdgcn_mfma_f32_16x16x32_f16(Bt[n][k], At[m][k], acc[ai][bj][m][n], 0, 0, 0); __builtin_amdgcn_s_setprio(0); } while (0)
#define PG8_WAIT_V(n) asm volatile("s_waitcnt vmcnt(" #n ")" ::: "memory")
#define PG8_WAIT_L(n) asm volatile("s_waitcnt lgkmcnt(" #n ")" ::: "memory")
#define PG8_BAR __builtin_amdgcn_s_barrier()
#define PG8_SCHED __builtin_amdgcn_sched_barrier(0)
    Unit cur, nxt; int ui = 0;
    if (!S.next(0, cur)) return;
    unsigned cv0[2], cv1[2], nv0[2], nv1[2];
#pragma unroll
    for (int i = 0; i < 2; ++i) { cv0[i] = S.a_voff(cur, 0, Rr[i], Cc[i]); cv1[i] = S.a_voff(cur, 1, Rr[i], Cc[i]); }
    f32x4 acc[2][2][4][2];
#pragma unroll
    for (int a = 0; a < 2; ++a)
#pragma unroll
        for (int b = 0; b < 2; ++b)
#pragma unroll
            for (int m = 0; m < 4; ++m)
#pragma unroll
                for (int n = 0; n < 2; ++n) acc[a][b][m][n] = (f32x4){0.f, 0.f, 0.f, 0.f};
    f16x8 At[4][2], B0[2][2], B1[2][2];
    const char* cA = cur.a; const char* cB = cur.b;
    int urows = S.rows(cur);
    if constexpr (SP2) {
        PG8_STAGE(PG8_SB(0, 0), cB, voffB); PG8_STAGE(PG8_SB(0, 1), cB + hstepB, voffB); PG8_STAGE(PG8_SA(0, 0), cA, cv0); PG8_STAGE(PG8_SA(0, 1), cA, cv1);
        if (wr == 1) PG8_BAR;
        PG8_WAIT_V(2); PG8_BAR;
        PG8_STAGE(PG8_SB(1, 0), cB + kstep, voffB); PG8_STAGE(PG8_SA(1, 0), cA + kstep, cv0); PG8_STAGE(PG8_SB(1, 1), cB + hstepB + kstep, voffB);
        PG8_WAIT_V(6); PG8_BAR;
    } else {
        PG8_STAGE(PG8_SB(0, 0), cB, voffB); PG8_STAGE(PG8_SA(0, 0), cA, cv0); PG8_STAGE(PG8_SB(0, 1), cB + hstepB, voffB); PG8_STAGE(PG8_SA(0, 1), cA, cv1);
        if (wr == 1) PG8_BAR;
        PG8_WAIT_V(4); PG8_BAR;
        PG8_STAGE(PG8_SB(1, 0), cB + kstep, voffB); PG8_STAGE(PG8_SA(1, 0), cA + kstep, cv0); PG8_STAGE(PG8_SB(1, 1), cB + hstepB + kstep, voffB);
        PG8_WAIT_V(6); PG8_BAR;
    }
    for (;;) {
        const bool has_next = S.next(ui + 1, nxt);
        if (has_next) {
#pragma unroll
            for (int i = 0; i < 2; ++i) { nv0[i] = S.a_voff(nxt, 0, Rr[i], Cc[i]); nv1[i] = S.a_voff(nxt, 1, Rr[i], Cc[i]); }
        } else {
            nxt = cur;
#pragma unroll
            for (int i = 0; i < 2; ++i) { nv0[i] = cv0[i]; nv1[i] = cv1[i]; }
        }
        const char* nA = nxt.a; const char* nB = nxt.b;
        for (int t = 0; t < nt; t += 2) {
            const bool last = (t == nt - 2);
            const char* a1 = cA + (size_t)(t + 1) * kstep;
            const char* a2 = last ? nA : cA + (size_t)(t + 2) * kstep; const char* b2 = last ? nB : cB + (size_t)(t + 2) * kstep;
            const char* a3 = a2 + kstep; const char* b3 = b2 + kstep;
            unsigned v0[2], v1[2];
#pragma unroll
            for (int i = 0; i < 2; ++i) { v0[i] = last ? nv0[i] : cv0[i]; v1[i] = last ? nv1[i] : cv1[i]; }
            if constexpr (SP2) {
            PG8_LDB(B0, 0, 0); PG8_LDB(B1, 0, 1); PG8_SCHED; PG8_LDA(At, 0, 0); PG8_STAGE(PG8_SA(1, 1), a1, cv1);
            PG8_WAIT_V(8); PG8_WAIT_L(0); PG8_BAR; PG8_MMA(0, 0, At, B0); PG8_MMA(0, 1, At, B1); PG8_BAR; PG8_SCHED;
            PG8_LDA(At, 0, 1); PG8_STAGE(PG8_SB(0, 0), b2, voffB); PG8_STAGE(PG8_SB(0, 1), b2 + hstepB, voffB); PG8_STAGE(PG8_SA(0, 0), a2, v0);
            PG8_WAIT_V(8); PG8_WAIT_L(0); PG8_BAR; PG8_MMA(1, 0, At, B0); PG8_MMA(1, 1, At, B1); PG8_BAR; PG8_SCHED;
            PG8_LDB(B0, 1, 0); PG8_LDB(B1, 1, 1); PG8_SCHED; PG8_LDA(At, 1, 0); PG8_STAGE(PG8_SA(0, 1), a2, v1);
            PG8_WAIT_V(8); PG8_WAIT_L(0); PG8_BAR; PG8_MMA(0, 0, At, B0); PG8_MMA(0, 1, At, B1); PG8_BAR; PG8_SCHED;
            PG8_LDA(At, 1, 1); PG8_STAGE(PG8_SB(1, 0), b3, voffB); PG8_STAGE(PG8_SB(1, 1), b3 + hstepB, voffB); PG8_STAGE(PG8_SA(1, 0), a3, v0);
            PG8_WAIT_V(8); PG8_WAIT_L(0); PG8_BAR; PG8_MMA(1, 0, At, B0); PG8_MMA(1, 1, At, B1); PG8_BAR; PG8_SCHED;
            } else {
            PG8_LDB(B0, 0, 0); PG8_SCHED; PG8_LDA(At, 0, 0); PG8_STAGE(PG8_SA(1, 1), a1, cv1);
            PG8_WAIT_L(8); PG8_BAR; PG8_WAIT_L(0); PG8_MMA(0, 0, At, B0); PG8_BAR; PG8_SCHED;
            PG8_LDB(B1, 0, 1); PG8_STAGE(PG8_SB(0, 0), b2, voffB);
            PG8_BAR; PG8_WAIT_L(0); PG8_MMA(0, 1, At, B1); PG8_BAR;
            PG8_LDA(At, 0, 1); PG8_STAGE(PG8_SA(0, 0), a2, v0);
            PG8_BAR; PG8_WAIT_L(0); PG8_MMA(1, 0, At, B0); PG8_BAR; PG8_SCHED;
            PG8_STAGE(PG8_SB(0, 1), b2 + hstepB, voffB);
            PG8_WAIT_V(6); PG8_BAR; PG8_MMA(1, 1, At, B1); PG8_BAR;
            PG8_LDB(B0, 1, 0); PG8_SCHED; PG8_LDA(At, 1, 0); PG8_STAGE(PG8_SA(0, 1), a2, v1);
            PG8_WAIT_L(8); PG8_BAR; PG8_WAIT_L(0); PG8_MMA(0, 0, At, B0); PG8_BAR; PG8_SCHED;
            PG8_LDB(B1, 1, 1); PG8_STAGE(PG8_SB(1, 0), b3, voffB);
            PG8_BAR; PG8_WAIT_L(0); PG8_MMA(0, 1, At, B1); PG8_BAR;
            PG8_LDA(At, 1, 1); PG8_STAGE(PG8_SA(1, 0), a3, v0);
            PG8_BAR; PG8_WAIT_L(0); PG8_MMA(1, 0, At, B0); PG8_BAR; PG8_SCHED;
            PG8_STAGE(PG8_SB(1, 1), b3 + hstepB, voffB);
            PG8_WAIT_V(6); PG8_BAR; PG8_MMA(1, 1, At, B1); PG8_BAR;
            }
        }
        if constexpr (ALIGN_EPI) { if (wr == 0) PG8_BAR; }
        E(acc, cur, wr, wc, fr, fq);
        if (!has_next) break;
#pragma unroll
        for (int a = 0; a < 2; ++a)
#pragma unroll
            for (int b = 0; b < 2; ++b)
#pragma unroll
                for (int m = 0; m < 4; ++m)
#pragma unroll
                    for (int n = 0; n < 2; ++n) acc[a][b][m][n] = (f32x4){0.f, 0.f, 0.f, 0.f};
        cur = nxt; cA = nA; cB = nB; ++ui; urows = S.rows(cur);
#pragma unroll
        for (int i = 0; i < 2; ++i) { cv0[i] = nv0[i]; cv1[i] = nv1[i]; }
        if constexpr (ALIGN_EPI) { if (wr == 1) PG8_BAR; }
    }
    PG8_WAIT_V(0);
    if constexpr (!ALIGN_EPI) { if (wr == 0) PG8_BAR; }
    PG8_BAR;
#undef PG8_SA
#undef PG8_SB
#undef PG8_STAGE
#undef PG8_LDA
#undef PG8_LDB
#undef PG8_MMA
#undef PG8_WAIT_V
#undef PG8_WAIT_L
#undef PG8_BAR
#undef PG8_SCHED
}

struct DenseOrder {
    const char* A; const char* Bt; int lda_b, K, nM, nN, nwg, G, c;
    __device__ __forceinline__ void init(const void* A_, int lda_elems, const void* Bt_, int M, int N, int K_) { A = (const char*)A_; Bt = (const char*)Bt_; lda_b = lda_elems * 2; K = K_; nM = M / BM; nN = N / BM; nwg = nM * nN; G = gridDim.x; c = blockIdx.x; }
    __device__ __forceinline__ bool next(int i, Unit& u) const {
        const long L = (long)i * G + c; if (L >= nwg) return false;
        int wgid = (int)L; { const int q = nwg / NXCD, r = nwg % NXCD, xcd = wgid % NXCD, off = wgid / NXCD; wgid = (xcd < r ? xcd * (q + 1) : r * (q + 1) + (xcd - r) * q) + off; }
        const int nig = WGM * nN, gid = wgid / nig, fm = gid * WGM, gsz = (nM - fm) < WGM ? (nM - fm) : WGM;
        u.pm = fm + ((wgid % nig) % gsz); u.pn = (wgid % nig) / gsz; u.e = 0; u.cnt = 0; u.hbase = 0;
        u.a = A + (size_t)u.pm * BM * lda_b; u.b = Bt + (size_t)u.pn * BM * K * 2;
        return true;
    }
    __device__ __forceinline__ unsigned a_voff(const Unit&, int h, int R, int C) const { return (unsigned)((h * HALF + R) * lda_b + C * 2); }
    __device__ __forceinline__ int rows(const Unit&) const { return BM; }
};
struct GroupOrder {
    const char* A; const char* Bt; int lda_b, K, nM, nN, ng, G, c; size_t gsA, gsB;
    __device__ __forceinline__ void init(const void* A_, int lda_elems, size_t gsA_elems, const void* Bt_, size_t gsB_elems, int ng_, int M, int N, int K_) {
        A = (const char*)A_; Bt = (const char*)Bt_; lda_b = lda_elems * 2; K = K_; nM = M / BM; nN = N / BM; ng = ng_; gsA = gsA_elems * 2; gsB = gsB_elems * 2; G = gridDim.x; c = blockIdx.x; }
    __device__ __forceinline__ bool next(int i, Unit& u) const {
        const long L = (long)i * G + c; if (L >= (long)ng * nM * nN) return false;
        const int per = nM * nN, g = (int)L / per, r = (int)L % per;
        u.e = g; u.pm = r / nN; u.pn = r % nN; u.cnt = 0; u.hbase = 0;
        u.a = A + (size_t)g * gsA + (size_t)u.pm * BM * lda_b; u.b = Bt + (size_t)g * gsB + (size_t)u.pn * BM * K * 2;
        return true;
    }
    __device__ __forceinline__ unsigned a_voff(const Unit&, int h, int R, int C) const { return (unsigned)((h * HALF + R) * lda_b + C * 2); }
    __device__ __forceinline__ int rows(const Unit&) const { return BM; }
};
constexpr int PLAN_STRIDE = 256;
struct PlanOrder {
    const int4* plan; const int* plan_n; const int* list; const char* A; const char* Bt; int lda_b, K, x, ib, nbx; size_t esB; bool gather;
    __device__ __forceinline__ void init(const void* planbase, const int* list_, const void* A_, int lda_elems, const void* Bt_, size_t esB_elems, int K_, bool gather_) {
        plan_n = (const int*)planbase; plan = (const int4*)((const char*)planbase + 256); list = list_; A = (const char*)A_; Bt = (const char*)Bt_; lda_b = lda_elems * 2; K = K_; esB = esB_elems * 2; gather = gather_;
        x = blockIdx.x & 7; ib = blockIdx.x >> 3; nbx = ((int)gridDim.x - x + 7) >> 3; }
    __device__ __forceinline__ bool next(int i, Unit& u) const {
        const int j = i * nbx + ib;
        if (j >= plan_n[x]) return false;
        const int4 en = plan[x * PLAN_STRIDE + j];
        u.e = en.x & 255; u.pm = (en.x >> 8) & 255; u.pn = (en.x >> 16) & 255; u.cnt = en.y; u.hbase = en.z;
        u.a = gather ? A : A + (size_t)(u.hbase + u.pm * BM) * lda_b;
        u.b = Bt + (size_t)u.e * esB + (size_t)u.pn * BM * K * 2;
        return true;
    }
    __device__ __forceinline__ unsigned a_voff(const Unit& u, int h, int R, int C) const {
        if (!gather) return (unsigned)((h * HALF + R) * lda_b + C * 2);
        const int li = u.pm * BM + h * HALF + R;
        const int tok = (li < u.cnt) ? (list[(size_t)u.e * CAP + li] >> 1) : 0;
        return (unsigned)(tok * lda_b + C * 2);
    }
    __device__ __forceinline__ int rows(const Unit& u) const { const int r = u.cnt - u.pm * BM; return r < BM ? r : BM; }
};
}
constexpr bool G_ALIGN = true, G_SP2 = true;

__device__ __forceinline__ void phase_prep(const P& p) {
  const int gtid = blockIdx.x * NTHR + tidx(), gsz = gridDim.x * NTHR;
  int* cnt = (int*)(p.ws + WS_CNT);
  if (gtid < 64) cnt[gtid] = 0;
  f32x2* rope = (f32x2*)(p.ws + WS_ROPE);
  for (int i = gtid; i < SEQ * 64; i += gsz) {
    const int pos = i >> 6, f = i & 63;
    const float inv = powf(10000.0f, -(float)(2 * f) / 128.0f);
    const float ang = (float)pos * inv;
    float s, c; sincosf(ang, &s, &c);
    rope[i] = (f32x2){c, s};
  }
  f32x2* lamt = (f32x2*)(p.ws + WS_LAMT); f32x2* coeft = (f32x2*)(p.ws + WS_LAMT + 3 * MB / 2);
  for (int i = gtid; i < 32 * 2 * 33 * 64; i += gsz) {
    const int q = i & 63, l = (i >> 6) % 33, gd = i / (33 * 64);
    const int g = gd >> 1, dir = gd & 1;
    const float dt = expf(p.log_step[dir * 32 + g]), ar = p.a_re[(dir * 32 + g) * 64 + q], ai = p.a_im[(dir * 32 + g) * 64 + q];
    const float mag = expf(ar * dt * (float)l); float sn, cs; sincosf(ai * dt * (float)l, &sn, &cs);
    lamt[i] = (f32x2){mag * cs, mag * sn};
    if (l == 1) {
      const float em1 = expm1f(ar * dt), sh = sinf(0.5f * ai * dt);
      const float nr = em1 * cs - 2.0f * sh * sh, ni = (em1 + 1.0f) * sn, den = ar * ar + ai * ai;
      coeft[gd * 64 + q] = (f32x2){(nr * ar + ni * ai) / den, (ni * ar - nr * ai) / den};
    }
  }
  u16* wr16 = (u16*)(p.ws + WS_WR16);
  for (int i = gtid; i < 2 * 48 * DM; i += gsz) {
    const int k = i & (DM - 1), n = (i >> 10) % 48, layer = i / (48 * DM);
    float w = 0.f;
    if (n < 4) w = p.w_group[((size_t)layer * DM + k) * 4 + n];
    else if (n < 36) { const int gg = (n - 4) >> 3, j = (n - 4) & 7; w = p.w_er[(((size_t)layer * 4 + gg) * DM + k) * 8 + j]; }
    w *= p.norm_ffn_g[layer * DM + k];
    const u16 hi = f2h(w), lo = f2h(w - h2f(hi));
    wr16[((size_t)(layer * 2 + 0) * 48 + n) * DM + k] = hi;
    wr16[((size_t)(layer * 2 + 1) * 48 + n) * DM + k] = lo;
  }
}

template <class RowFn>
__device__ __forceinline__ void conv_item(const float* W, int ldw, int K, u16* WT, float* scr, int k0, int n0, int lane, RowFn rowfn) {
#pragma unroll 8
  for (int i = 0; i < 32; ++i) { const int kk = 2 * i + (lane >> 5); scr[kk * 33 + (lane & 31)] = W[(size_t)(k0 + kk) * ldw + n0 + (lane & 31)]; }
  LDS_WAIT();
  const int c = lane & 7;
#pragma unroll
  for (int j = 0; j < 4; ++j) {
    const int n = (lane >> 3) + 8 * j; const float* sp = scr + (8 * c) * 33 + n;
    uint4 o; o.x = pk2(sp[0 * 33], sp[1 * 33]); o.y = pk2(sp[2 * 33], sp[3 * 33]); o.z = pk2(sp[4 * 33], sp[5 * 33]); o.w = pk2(sp[6 * 33], sp[7 * 33]);
    *(uint4*)(WT + (size_t)rowfn(n0 + n) * K + k0 + 8 * c) = o;
  }
  LDS_WAIT();
}
template <class RowFn>
__device__ __forceinline__ int conv_matrix(const float* W, int ldw, int K, int N, u16* WT, char* smem, int item_base, RowFn rowfn) {
  const int lane = tidx() & 63, wv = tidx() >> 6, gw = blockIdx.x * NWAVE + wv, nw = gridDim.x * NWAVE;
  float* scr = (float*)smem + wv * (64 * 33);
  const int nkb = K / 64, nnb = N / 32, nitems = nkb * nnb;
  int it = gw - (item_base % nw); if (it < 0) it += nw;
  for (; it < nitems; it += nw) conv_item(W, ldw, K, WT, scr, (it / nnb) * 64, (it % nnb) * 32, lane, rowfn);
  return nitems;
}
__device__ __forceinline__ void phase_conv_dense(const P& p, char* smem) {
  auto id = [](int n) { return n; };
  int base = 0;
  base += conv_matrix(p.w_in, 2560, DM, 2560, (u16*)(p.ws + WS_WIN), smem, base, [](int n) { if (n >= 1024) return n; const int dd = n & 127, hf = dd >> 6, r = dd & 63; return (n & ~127) + 32 * (r >> 4) + 16 * hf + (r & 15); });
  base += conv_matrix(p.w_glu, 512, 512, 512, (u16*)(p.ws + WS_WGLU), smem, base, id);
  base += conv_matrix(p.w_out, DM, DM, DM, (u16*)(p.ws + WS_WOUT), smem, base, id);
  base += conv_matrix(p.w_qkv, 1536, DM, 1536, (u16*)(p.ws + WS_WQKV), smem, base, id);
  base += conv_matrix(p.w_o, DM, DM, DM, (u16*)(p.ws + WS_WO), smem, base, id);
}
__device__ __forceinline__ void phase_conv_moe(const P& p, int layer, char* smem) {
  if (blockIdx.x == 0) return;
  const int lane = tidx() & 63, wv = tidx() >> 6, gw = (blockIdx.x - 1) * NWAVE + wv, nw = (gridDim.x - 1) * NWAVE;
  float* scr = (float*)smem + wv * (64 * 33);
  u16* w1t = (u16*)(p.ws + WS_MW); u16* w2t = (u16*)(p.ws + WS_MW + 64 * MB);
  for (int it = gw; it < 32 * 768; it += nw) {
    const int e = it / 768, r = it % 768;
    if (r < 512) {
      const int which = r >> 8, q = r & 255, k0 = (q >> 4) * 64, n0 = (q & 15) * 32;
      const float* W = (which ? p.w_up : p.w_gate) + (size_t)(layer * 32 + e) * DM * 512;
      conv_item(W, 512, DM, w1t + (size_t)e * DM * DM, scr, k0, n0, lane, [which](int n) { return (n >> 4) * 32 + which * 16 + (n & 15); });
    } else {
      const int q = r - 512, k0 = (q >> 5) * 64, n0 = (q & 31) * 32;
      const float* W = p.w_down + (size_t)(layer * 32 + e) * 512 * DM;
      conv_item(W, DM, 512, w2t + (size_t)e * DM * 512, scr, k0, n0, lane, [](int n) { return n; });
    }
  }
}

__device__ __forceinline__ void phase_rowpass(const P& p, const float* src, const u16* slots, float* dstx, const float* gain, int route_layer, float* fout, char* smem) {
  const int lane = tidx() & 63, wv = tidx() >> 6, fr = lane & 15, lg = lane >> 4;
  u16* xb = (u16*)(p.ws + WS_XB);
  int* cnt = (int*)(p.ws + WS_CNT);
  int* list = (int*)(p.ws + WS_LIST);
  float* gate = (float*)(p.ws + WS_GATE);
  float* sRs = (float*)smem;
  float* sLg = (float*)smem + 64;
  for (int st = blockIdx.x; st < T_TOK / 64; st += gridDim.x) {
    const int row0 = st * 64 + wv * 8;
#pragma unroll 1
    for (int rp = 0; rp < 4; ++rp) {
      f32x4 v[2][4];
#pragma unroll
      for (int q = 0; q < 2; ++q) {
        const int row = row0 + rp * 2 + q;
#pragma unroll
        for (int i = 0; i < 4; ++i) v[q][i] = *(const f32x4*)(src + (size_t)row * DM + (i * 64 + lane) * 4);
      }
      if (slots) {
#pragma unroll
        for (int q = 0; q < 2; ++q) {
          const int row = row0 + rp * 2 + q;
          uint2 w[2][4];
#pragma unroll
          for (int sl = 0; sl < 2; ++sl)
#pragma unroll
            for (int i = 0; i < 4; ++i) w[sl][i] = *(const uint2*)(slots + ((size_t)row * 2 + sl) * DM + (i * 64 + lane) * 4);
#pragma unroll
          for (int sl = 0; sl < 2; ++sl)
#pragma unroll
            for (int i = 0; i < 4; ++i) { v[q][i][0] += lo16(w[sl][i].x); v[q][i][1] += hi16(w[sl][i].x); v[q][i][2] += lo16(w[sl][i].y); v[q][i][3] += hi16(w[sl][i].y); }
        }
      }
#pragma unroll
      for (int q = 0; q < 2; ++q) {
        const int row = row0 + rp * 2 + q;
        float ss = 0.f;
#pragma unroll
        for (int i = 0; i < 4; ++i) {
          if (dstx) *(f32x4*)(dstx + (size_t)row * DM + (i * 64 + lane) * 4) = v[q][i];
          ss += v[q][i][0] * v[q][i][0] + v[q][i][1] * v[q][i][1] + v[q][i][2] * v[q][i][2] + v[q][i][3] * v[q][i][3];
        }
        ss = wave_sum(ss);
        const float rstd = rsqrtf(ss * (1.0f / DM) + 1e-6f);
        if (route_layer >= 0 && lane == 0) sRs[wv * 8 + rp * 2 + q] = rstd;
#pragma unroll
        for (int i = 0; i < 4; ++i) {
          const int k = (i * 64 + lane) * 4;
          const f32x4 gv = *(const f32x4*)(gain + k);
          const f32x4 hv = v[q][i] * rstd * gv;
          if (fout) *(f32x4*)(fout + (size_t)row * DM + k) = hv;
          else { uint2 w; w.x = pk2(hv[0], hv[1]); w.y = pk2(hv[2], hv[3]); *(uint2*)(xb + (size_t)row * DM + k) = w; }
        }
      }
    }
    if (route_layer >= 0) {
      __syncthreads();
      const int tl = wv & 3, kh = wv >> 2;
      const float rsv = sRs[tl * 16 + fr];
      const float* xrow = src + (size_t)(st * 64 + tl * 16 + fr) * DM + kh * 512 + lg * 8;
      const u16* whi = (const u16*)(p.ws + WS_WR16) + ((size_t)(route_layer * 2 + 0) * 48 + fr) * DM + kh * 512 + lg * 8;
      const u16* wlo = (const u16*)(p.ws + WS_WR16) + ((size_t)(route_layer * 2 + 1) * 48 + fr) * DM + kh * 512 + lg * 8;
      f32x4 acc[3];
#pragma unroll
      for (int nb = 0; nb < 3; ++nb) acc[nb] = (f32x4){0.f, 0.f, 0.f, 0.f};
#pragma unroll 4
      for (int ks = 0; ks < 16; ++ks) {
        const f32x4 x0 = *(const f32x4*)(xrow + ks * 32), x1 = *(const f32x4*)(xrow + ks * 32 + 4);
        const float hv[8] = {x0[0] * rsv, x0[1] * rsv, x0[2] * rsv, x0[3] * rsv, x1[0] * rsv, x1[1] * rsv, x1[2] * rsv, x1[3] * rsv};
        unsigned ah[4], al[4];
#pragma unroll
        for (int j = 0; j < 4; ++j) {
          const u16 h0 = f2h(hv[2 * j]), h1 = f2h(hv[2 * j + 1]);
          ah[j] = (unsigned)h0 | ((unsigned)h1 << 16);
          al[j] = pk2(hv[2 * j] - h2f(h0), hv[2 * j + 1] - h2f(h1));
        }
        const uint4 ahi = make_uint4(ah[0], ah[1], ah[2], ah[3]), alo = make_uint4(al[0], al[1], al[2], al[3]);
#pragma unroll
        for (int nb = 0; nb < 3; ++nb) {
          const uint4 bh = *(const uint4*)(whi + (size_t)nb * 16 * DM + ks * 32), bl = *(const uint4*)(wlo + (size_t)nb * 16 * DM + ks * 32);
          acc[nb] = mfma16(bh, ahi, acc[nb]); acc[nb] = mfma16(bh, alo, acc[nb]); acc[nb] = mfma16(bl, ahi, acc[nb]);
        }
      }
      float* lgw = sLg + ((kh * 4 + tl) * 16 + fr) * 49;
#pragma unroll
      for (int nb = 0; nb < 3; ++nb)
#pragma unroll
        for (int r = 0; r < 4; ++r) lgw[nb * 16 + 4 * lg + r] = acc[nb][r];
      __syncthreads();
      if (wv < 4 && lane < 16) {
        const int row = st * 64 + wv * 16 + lane;
        const float* l0 = sLg + ((0 * 4 + wv) * 16 + lane) * 49;
        const float* l1 = sLg + ((1 * 4 + wv) * 16 + lane) * 49;
        const float* bg = p.b_group + route_layer * 4;
        const float* be = p.b_er + route_layer * 32;
        float gl[4];
#pragma unroll
        for (int j = 0; j < 4; ++j) gl[j] = l0[j] + l1[j] + bg[j];
        int gs = 0; float gm = gl[0];
#pragma unroll
        for (int j = 1; j < 4; ++j) if (gl[j] > gm) { gm = gl[j]; gs = j; }
        float den = 0.f;
#pragma unroll
        for (int j = 0; j < 4; ++j) den += expf(gl[j] - gm);
        const float pg = 1.0f / den;
        float el[8];
#pragma unroll
        for (int j = 0; j < 8; ++j) el[j] = l0[4 + gs * 8 + j] + l1[4 + gs * 8 + j] + be[gs * 8 + j];
        int i1 = 0; float v1 = el[0];
#pragma unroll
        for (int j = 1; j < 8; ++j) if (el[j] > v1) { v1 = el[j]; i1 = j; }
        int i2 = -1; float v2 = -3.0e38f;
#pragma unroll
        for (int j = 0; j < 8; ++j) if (j != i1 && el[j] > v2) { v2 = el[j]; i2 = j; }
        const float e2 = expf(v2 - v1);
        const float g1 = pg / (1.0f + e2), g2 = pg * e2 / (1.0f + e2);
        const int ex1 = gs * 8 + i1, ex2 = gs * 8 + i2;
        const int r1 = atomicAdd(&cnt[route_layer * 32 + ex1], 1);
        list[(size_t)ex1 * CAP + r1] = row * 2;
        gate[row * 2] = g1;
        const int r2 = atomicAdd(&cnt[route_layer * 32 + ex2], 1);
        list[(size_t)ex2 * CAP + r2] = row * 2 + 1;
        gate[row * 2 + 1] = g2;
      }
      __syncthreads();
    }
  }
}

constexpr int RSTR = 136;
__device__ __forceinline__ float log_sigmoid(float x) { return -log1pf(expf(-x)); }
__device__ __forceinline__ uint2 lds_tr16(const u16* ptr) {
  typedef short s16x4 __attribute__((ext_vector_type(4)));
  const s16x4 v = __builtin_amdgcn_ds_read_tr16_b64_v4i16((LAS s16x4*)ptr);
  return __builtin_bit_cast(uint2, v);
}
__device__ __forceinline__ uint4 lds_frag_T(const u16* tile, int rs, int k0, int c0, int lane) {
  const int g = lane >> 4, q = (lane & 15) >> 2, pp = lane & 3;
  const u16* a = tile + (k0 + 8 * g + q) * rs + c0 + 4 * pp;
  const uint2 lo = lds_tr16(a), hi = lds_tr16(a + 4 * rs);
  return make_uint4(lo.x, lo.y, hi.x, hi.y);
}
__device__ __forceinline__ void ret_load_tile(u16* dst0, u16* dst1, const u16* src, int t0, int h, const float* w0, const float* w1) {
  for (int c = tidx(); c < 128 * 16; c += NTHR) {
    const int i = c >> 4, ch = (c & 15) * 8;
    const uint4 v = *(const uint4*)(src + (size_t)(t0 + i) * 512 + h * 128 + ch);
    if (w0) {
      const float a = w0[i], b = w1[i];
      const float f[8] = {lo16(v.x), hi16(v.x), lo16(v.y), hi16(v.y), lo16(v.z), hi16(v.z), lo16(v.w), hi16(v.w)};
      *(uint4*)(dst0 + i * RSTR + ch) = make_uint4(pk2(f[0] * a, f[1] * a), pk2(f[2] * a, f[3] * a), pk2(f[4] * a, f[5] * a), pk2(f[6] * a, f[7] * a));
      *(uint4*)(dst1 + i * RSTR + ch) = make_uint4(pk2(f[0] * b, f[1] * b), pk2(f[2] * b, f[3] * b), pk2(f[4] * b, f[5] * b), pk2(f[6] * b, f[7] * b));
    } else *(uint4*)(dst0 + i * RSTR + ch) = v;
  }
}
template <int MB_, int NB_, bool ATR, bool BTR>
__device__ __forceinline__ void lds_mma(f32x4 (&acc)[MB_][NB_], const u16* sA, int sa, int a0, const u16* sB, int sb, int b0, int K, int lane, const float* sc) {
  const int fr = lane & 15, fq = lane >> 4;
  for (int k0 = 0; k0 < K; k0 += 32) {
    uint4 fa[MB_], fb[NB_];
#pragma unroll
    for (int m = 0; m < MB_; ++m) {
      if constexpr (ATR) fa[m] = lds_frag_T(sA, sa, k0, a0 + m * 16, lane);
      else fa[m] = *(const uint4*)(sA + (a0 + m * 16 + fr) * sa + k0 + fq * 8);
      if (sc) {
        const float f = sc[m];
        fa[m].x = pk2(lo16(fa[m].x) * f, hi16(fa[m].x) * f); fa[m].y = pk2(lo16(fa[m].y) * f, hi16(fa[m].y) * f);
        fa[m].z = pk2(lo16(fa[m].z) * f, hi16(fa[m].z) * f); fa[m].w = pk2(lo16(fa[m].w) * f, hi16(fa[m].w) * f);
      }
    }
#pragma unroll
    for (int n = 0; n < NB_; ++n) {
      if constexpr (BTR) fb[n] = lds_frag_T(sB, sb, k0, b0 + n * 16, lane);
      else fb[n] = *(const uint4*)(sB + (b0 + n * 16 + fr) * sb + k0 + fq * 8);
    }
#pragma unroll
    for (int m = 0; m < MB_; ++m)
#pragma unroll
      for (int n = 0; n < NB_; ++n) acc[m][n] = mfma16(fb[n], fa[m], acc[m][n]);
  }
}
__device__ __forceinline__ void phase_ret_inc_mfma(const P& p, char* smem) {
  u16* sKf = (u16*)smem; u16* sKb = sKf + 128 * RSTR; u16* sV = sKb + 128 * RSTR; float* sWf = (float*)(sV + 128 * RSTR); float* sWb = sWf + 128;
  const u16* kb = (const u16*)(p.ws + WS_Z) + (size_t)1 * T_TOK * 512; const u16* vb = (const u16*)(p.ws + WS_Z) + (size_t)2 * T_TOK * 512;
  float* incf = (float*)(p.ws + WS_INC); float* incb = incf + (size_t)512 * 16384;
  const int tid = tidx(), lane = tid & 63, wv = tid >> 6, wr = wv >> 1, wc = wv & 1, fr = lane & 15, fq = lane >> 4;
  for (int item = blockIdx.x; item < 512; item += gridDim.x) {
    const int h = item & 3, bn = item >> 2, t0 = bn * 128;
    const float lgf = log_sigmoid(p.ret_decay[h]), lgb = log_sigmoid(p.ret_decay[4 + h]);
    __syncthreads();
    if (tid < 128) { sWf[tid] = expf(lgf * (float)(127 - tid)); sWb[tid] = expf(lgb * (float)tid); }
    __syncthreads();
    ret_load_tile(sKf, sKb, kb, t0, h, sWf, sWb);
    ret_load_tile(sV, nullptr, vb, t0, h, nullptr, nullptr);
    __syncthreads();
#pragma unroll
    for (int dirn = 0; dirn < 2; ++dirn) {
      f32x4 acc[2][4];
#pragma unroll
      for (int m = 0; m < 2; ++m)
#pragma unroll
        for (int n = 0; n < 4; ++n) acc[m][n] = (f32x4){0.f, 0.f, 0.f, 0.f};
      lds_mma<2, 4, true, true>(acc, sV, RSTR, wr * 32, dirn ? sKb : sKf, RSTR, wc * 64, 128, lane, nullptr);
      float* o = (dirn ? incb : incf) + (size_t)item * 16384;
#pragma unroll
      for (int m = 0; m < 2; ++m)
#pragma unroll
        for (int n = 0; n < 4; ++n) *(f32x4*)(o + (wr * 32 + m * 16 + fr) * 128 + wc * 64 + n * 16 + 4 * fq) = acc[m][n];
    }
  }
}
__device__ __forceinline__ void phase_ret_scan16(const P& p) {
  const float* incf = (const float*)(p.ws + WS_INC); const float* incb = incf + (size_t)512 * 16384;
  u16* spf = (u16*)(p.ws + WS_SP16); u16* spb = spf + (size_t)512 * 16384;
  const int gtid = blockIdx.x * NTHR + tidx(), gsz = gridDim.x * NTHR;
  for (int idx = gtid; idx < 32 * 4096; idx += gsz) {
    const int de = (idx & 4095) * 4, bh = idx >> 12, b = bh >> 2, h = bh & 3;
    const float Gf = expf(128.0f * log_sigmoid(p.ret_decay[h])), Gb = expf(128.0f * log_sigmoid(p.ret_decay[4 + h]));
    f32x4 s = {0.f, 0.f, 0.f, 0.f};
    for (int n = 0; n < 16; ++n) {
      const size_t o = ((size_t)((b * 16 + n) * 4 + h)) * 16384 + de;
      const f32x4 t = *(const f32x4*)(incf + o);
      uint2 w; w.x = pk2(s[0], s[1]); w.y = pk2(s[2], s[3]); *(uint2*)(spf + o) = w;
      s = s * Gf + t;
    }
    s = (f32x4){0.f, 0.f, 0.f, 0.f};
    for (int n = 15; n >= 0; --n) {
      const size_t o = ((size_t)((b * 16 + n) * 4 + h)) * 16384 + de;
      const f32x4 t = *(const f32x4*)(incb + o);
      uint2 w; w.x = pk2(s[0], s[1]); w.y = pk2(s[2], s[3]); *(uint2*)(spb + o) = w;
      s = s * Gb + t;
    }
  }
}
__device__ __forceinline__ void phase_ret_out_mfma(const P& p, char* smem) {
  u16* R0 = (u16*)smem; u16* R1 = R0 + 128 * RSTR; u16* R2 = R1 + 128 * RSTR; u16* R3 = R2 + 128 * RSTR;
  float* sPf = (float*)(R3 + 128 * RSTR); float* sPb = sPf + 132;
  const u16* zb = (const u16*)(p.ws + WS_Z);
  const u16* qb = zb; const u16* kb = zb + (size_t)1 * T_TOK * 512; const u16* vb = zb + (size_t)2 * T_TOK * 512; const u16* gb = zb + (size_t)3 * T_TOK * 512;
  const u16* spf = (const u16*)(p.ws + WS_SP16); const u16* spb = spf + (size_t)512 * 16384;
  u16* ycat = (u16*)(p.ws + WS_YCAT);
  const int tid = tidx(), lane = tid & 63, wv = tid >> 6, wr = wv >> 1, wc = wv & 1, fr = lane & 15, fq = lane >> 4;
  for (int item = blockIdx.x; item < 512; item += gridDim.x) {
    const int h = item & 3, bn = item >> 2, t0 = bn * 128;
    const float lgf = log_sigmoid(p.ret_decay[h]), lgb = log_sigmoid(p.ret_decay[4 + h]);
    __syncthreads();
    ret_load_tile(R0, nullptr, qb, t0, h, nullptr, nullptr);
    ret_load_tile(R1, nullptr, kb, t0, h, nullptr, nullptr);
    ret_load_tile(R2, nullptr, vb, t0, h, nullptr, nullptr);
    if (tid < 129) { sPf[tid] = expf(lgf * (float)tid); sPb[tid] = expf(lgb * (float)tid); }
    __syncthreads();
    {
      f32x4 acc[2][4];
#pragma unroll
      for (int m = 0; m < 2; ++m)
#pragma unroll
        for (int n = 0; n < 4; ++n) acc[m][n] = (f32x4){0.f, 0.f, 0.f, 0.f};
      lds_mma<2, 4, false, false>(acc, R0, RSTR, wr * 32, R1, RSTR, wc * 64, 128, lane, nullptr);
#pragma unroll
      for (int m = 0; m < 2; ++m)
#pragma unroll
        for (int n = 0; n < 4; ++n) {
          const int i = wr * 32 + m * 16 + fr, j = wc * 64 + n * 16 + 4 * fq;
          float v[4];
#pragma unroll
          for (int r = 0; r < 4; ++r) { const int jj = j + r; v[r] = acc[m][n][r] * ((i >= jj) ? sPf[i - jj] : sPb[jj - i]); }
          uint2 w; w.x = pk2(v[0], v[1]); w.y = pk2(v[2], v[3]);
          *(uint2*)(R3 + i * RSTR + j) = w;
        }
    }
    __syncthreads();
    const u16* spT = spf + (size_t)item * 16384; const u16* snT = spb + (size_t)item * 16384;
    for (int c = tid; c < 128 * 16; c += NTHR) { const int e = c >> 4, ch = (c & 15) * 8; *(uint4*)(R1 + e * RSTR + ch) = *(const uint4*)(spT + e * 128 + ch); }
    f32x4 o[1][8];
#pragma unroll
    for (int m = 0; m < 1; ++m)
#pragma unroll
      for (int n = 0; n < 8; ++n) o[m][n] = (f32x4){0.f, 0.f, 0.f, 0.f};
    lds_mma<1, 8, false, true>(o, R3, RSTR, wv * 16, R2, RSTR, 0, 128, lane, nullptr);
    __syncthreads();
    for (int c = tid; c < 128 * 16; c += NTHR) { const int e = c >> 4, ch = (c & 15) * 8; *(uint4*)(R2 + e * RSTR + ch) = *(const uint4*)(snT + e * 128 + ch); }
    float scf[1], scb[1];
    { const int i = wv * 16 + fr; scf[0] = sPf[i + 1]; scb[0] = sPb[128 - i]; }
    lds_mma<1, 8, false, false>(o, R0, RSTR, wv * 16, R1, RSTR, 0, 128, lane, scf);
    __syncthreads();
    lds_mma<1, 8, false, false>(o, R0, RSTR, wv * 16, R2, RSTR, 0, 128, lane, scb);
#pragma unroll
    for (int m = 0; m < 1; ++m) {
      float s1 = 0.f;
#pragma unroll
      for (int n = 0; n < 8; ++n) s1 += (o[m][n][0] + o[m][n][1]) + (o[m][n][2] + o[m][n][3]);
      s1 += __shfl_xor(s1, 16); s1 += __shfl_xor(s1, 32);
      const float mu = s1 * (1.0f / 128.0f);
      float s2 = 0.f;
#pragma unroll
      for (int n = 0; n < 8; ++n)
#pragma unroll
        for (int r = 0; r < 4; ++r) { const float dl = o[m][n][r] - mu; s2 += dl * dl; }
      s2 += __shfl_xor(s2, 16); s2 += __shfl_xor(s2, 32);
      const float rs = rsqrtf(s2 * (1.0f / 128.0f) + 1e-5f);
      const size_t tok = (size_t)(t0 + wv * 16 + m * 16 + fr);
#pragma unroll
      for (int n = 0; n < 8; ++n) {
        const int e = n * 16 + 4 * fq;
        const uint2 gq = *(const uint2*)(gb + tok * 512 + h * 128 + e);
        const float g0 = lo16(gq.x), g1 = hi16(gq.x), g2 = lo16(gq.y), g3 = hi16(gq.y);
        uint2 w;
        w.x = pk2(g0 * sigmoidf_(g0) * (o[m][n][0] - mu) * rs, g1 * sigmoidf_(g1) * (o[m][n][1] - mu) * rs);
        w.y = pk2(g2 * sigmoidf_(g2) * (o[m][n][2] - mu) * rs, g3 * sigmoidf_(g3) * (o[m][n][3] - mu) * rs);
        *(uint2*)(ycat + tok * DM + h * 128 + e) = w;
      }
    }
  }
}

struct Cpx { float re, im; };
__device__ __forceinline__ Cpx cmul(Cpx a, Cpx b) { return {a.re * b.re - a.im * b.im, a.re * b.im + a.im * b.re}; }
__device__ __forceinline__ Cpx s5_lam(const P& p, int g, int dir, int l, int q) { const f32x2 v = ((const f32x2*)(p.ws + WS_LAMT))[((g * 2 + dir) * 33 + l) * 64 + q]; return {v[0], v[1]}; }
__device__ __forceinline__ Cpx s5_cf(const P& p, int g, int dir, int q) { const f32x2 v = ((const f32x2*)(p.ws + WS_LAMT + 3 * MB / 2))[(g * 2 + dir) * 64 + q]; return {v[0], v[1]}; }
__device__ __forceinline__ bool s5_setup_ids(int& gtid, int& gsz) {
  const bool half = (gridDim.x == 256);
  if (half && blockIdx.x < 128) return false;
  gtid = (half ? (int)blockIdx.x - 128 : (int)blockIdx.x) * NTHR + tidx(); gsz = (half ? 128 : (int)gridDim.x) * NTHR;
  return true;
}
__device__ __forceinline__ void phase_s5_ktab(const P& p) {
  float* ktab = (float*)(p.ws + WS_KTAB);
  int gtid, gsz; if (!s5_setup_ids(gtid, gsz)) return;
  for (int item = gtid; item < 32 * 2 * 32 * 16; item += gsz) {
    const int c = item & 15, l = (item >> 4) & 31, dir = (item >> 9) & 1, g = item >> 10;
    float acc[16];
#pragma unroll
    for (int j = 0; j < 16; ++j) acc[j] = 0.f;
    for (int q = 0; q < 64; ++q) {
      const Cpx L = s5_lam(p, g, dir, l, q), cf = s5_cf(p, g, dir, q);
      const Cpx C = {p.c_re[((dir * 32 + g) * 16 + c) * 64 + q], p.c_im[((dir * 32 + g) * 16 + c) * 64 + q]};
      const Cpx w = cmul(cmul(C, L), cf);
#pragma unroll
      for (int j = 0; j < 16; ++j) acc[j] += w.re * p.b_re[(g * 64 + q) * 16 + j] - w.im * p.b_im[(g * 64 + q) * 16 + j];
    }
#pragma unroll
    for (int j = 0; j < 16; j += 4) *(f32x4*)(ktab + (size_t)item * 16 + j) = (f32x4){acc[j], acc[j + 1], acc[j + 2], acc[j + 3]};
  }
}
__device__ __forceinline__ void phase_s5_fill_a(const P& p) {
  const float* ktab = (const float*)(p.ws + WS_KTAB);
  u16* bty = (u16*)(p.ws + WS_BTY);
  const int gtid = blockIdx.x * NTHR + tidx(), gsz = gridDim.x * NTHR;
  for (int item = gtid; item < 32 * 512 * 64; item += gsz) {
    const int ch = item & 63, n = (item >> 6) & 511, g = item >> 15;
    const int ip = ch >> 1, c0 = (ch & 1) * 8, i = n >> 4, c = n & 15;
    float v[8];
    if (ip != i) {
      const int dir = ip < i ? 0 : 1, l = ip < i ? i - ip : ip - i;
      const float* src = ktab + ((size_t)((g * 2 + dir) * 32 + l) * 16 + c) * 16 + c0;
      const f32x4 a = *(const f32x4*)src, b = *(const f32x4*)(src + 4);
      v[0] = a[0]; v[1] = a[1]; v[2] = a[2]; v[3] = a[3]; v[4] = b[0]; v[5] = b[1]; v[6] = b[2]; v[7] = b[3];
    } else {
      const float* s0 = ktab + ((size_t)((g * 2 + 0) * 32) * 16 + c) * 16 + c0;
      const float* s1 = ktab + ((size_t)((g * 2 + 1) * 32) * 16 + c) * 16 + c0;
      const float dd = p.s5d[g * 16 + c];
#pragma unroll
      for (int j = 0; j < 8; ++j) v[j] = s0[j] + s1[j] + ((c0 + j) == c ? dd : 0.f);
    }
    *(uint4*)(bty + ((size_t)g * 512 + n) * 768 + ch * 8) = make_uint4(pk2(v[0], v[1]), pk2(v[2], v[3]), pk2(v[4], v[5]), pk2(v[6], v[7]));
  }
}
__device__ __forceinline__ void phase_s5_fill_bc(const P& p) {
  u16* bty = (u16*)(p.ws + WS_BTY); u16* wet = (u16*)(p.ws + WS_WET);
  int gtid, gsz; if (!s5_setup_ids(gtid, gsz)) return;
  for (int item = gtid; item < 32 * 512 * 32; item += gsz) {
    const int ch = item & 31, n = (item >> 5) & 511, g = item >> 14;
    const int kk = ch * 8, dir = kk >> 7, p0 = (kk & 127) >> 1, i = n >> 4, c = n & 15;
    const int e = dir ? (32 - i) : (i + 1);
    float v[8];
#pragma unroll
    for (int q = 0; q < 4; ++q) {
      const int pq = p0 + q;
      const Cpx L = s5_lam(p, g, dir, e, pq);
      const Cpx C = {p.c_re[((dir * 32 + g) * 16 + c) * 64 + pq], p.c_im[((dir * 32 + g) * 16 + c) * 64 + pq]};
      const Cpx w = cmul(C, L);
      v[2 * q] = w.re; v[2 * q + 1] = -w.im;
    }
    *(uint4*)(bty + ((size_t)g * 512 + n) * 768 + 512 + kk) = make_uint4(pk2(v[0], v[1]), pk2(v[2], v[3]), pk2(v[4], v[5]), pk2(v[6], v[7]));
  }
  for (int item = gtid; item < 32 * 256 * 64; item += gsz) {
    const int ch = item & 63, n = (item >> 6) & 255, g = item >> 14;
    const int ip = ch >> 1, c0 = (ch & 1) * 8, ri = n & 1, pq = (n >> 1) & 63, dir = n >> 7;
    const int e = dir ? ip : (31 - ip);
    const Cpx w = cmul(s5_lam(p, g, dir, e, pq), s5_cf(p, g, dir, pq));
    float v[8];
#pragma unroll
    for (int j = 0; j < 8; ++j) {
      const float br = p.b_re[(g * 64 + pq) * 16 + c0 + j], bi = p.b_im[(g * 64 + pq) * 16 + c0 + j];
      v[j] = ri ? (w.re * bi + w.im * br) : (w.re * br - w.im * bi);
    }
    *(uint4*)(wet + ((size_t)g * 256 + n) * 512 + ch * 8) = make_uint4(pk2(v[0], v[1]), pk2(v[2], v[3]), pk2(v[4], v[5]), pk2(v[6], v[7]));
  }
}
__device__ __forceinline__ void phase_s5_carry(const P& p) {
  const float* E = (const float*)(p.ws + WS_E);
  u16* a2 = (u16*)(p.ws + WS_A2);
  const int gtid = blockIdx.x * NTHR + tidx(), gsz = gridDim.x * NTHR;
  for (int idx = gtid; idx < 32 * 8 * 128; idx += gsz) {
    const int pq = idx & 63, dir = (idx >> 6) & 1, b = (idx >> 7) & 7, g = idx >> 10;
    const Cpx L = s5_lam(p, g, dir, 32, pq);
    Cpx s = {0.f, 0.f};
    for (int jj = 0; jj < 64; ++jj) {
      const int j = dir ? 63 - jj : jj, r = b * 64 + j;
      const f32x2 e = *(const f32x2*)(E + ((size_t)g * 512 + r) * 256 + (dir * 64 + pq) * 2);
      *(unsigned*)(a2 + ((size_t)g * 512 + r) * 768 + 512 + (dir * 64 + pq) * 2) = pk2(s.re, s.im);
      const Cpx ns = cmul(L, s);
      s.re = ns.re + e[0]; s.im = ns.im + e[1];
    }
  }
}
constexpr int KSTR = 72;
__device__ __forceinline__ int t5_bucket_abs(int n) {
  return n < 8 ? n : 8 + (n >= 12) + (n >= 16) + (n >= 23) + (n >= 32) + (n >= 46) + (n >= 64) + (n >= 91);
}
__device__ __forceinline__ void phase_attn(const P& p, char* smem) {
  u16* sK = (u16*)smem; u16* sV = sK + 384 * KSTR; float* sBias = (float*)(sV + 384 * KSTR);
  const u16* q1 = (const u16*)(p.ws + WS_Z); const u16* k1 = (const u16*)(p.ws + WS_Z + 32 * MB); const u16* v1 = (const u16*)(p.ws + WS_Z + 40 * MB);
  u16* ao = (u16*)(p.ws + WS_YCAT);
  const int tid = tidx(), lane = tid & 63, wv = tid >> 6, fr = lane & 15, lg = lane >> 4, q0 = (wv & 3) * 32, hp = wv >> 2;
  const int tq = (lane & 15) >> 2, tp = lane & 3;
  for (int item = blockIdx.x; item < 512; item += gridDim.x) {
    const int b = item >> 6, nb = (item >> 2) & 15, kvh = item & 3;
    __syncthreads();
    for (int c = tid; c < 384 * 8; c += NTHR) {
      const int s = c >> 3, ch = (c & 7) * 8, pos = (nb - 1) * 128 + s;
      uint4 kq = make_uint4(0u, 0u, 0u, 0u), vq = kq;
      if (pos >= 0 && pos < SEQ) { kq = *(const uint4*)(k1 + (size_t)(b * SEQ + pos) * 256 + kvh * 64 + ch); vq = *(const uint4*)(v1 + (size_t)(b * SEQ + pos) * 256 + kvh * 64 + ch); }
      *(uint4*)(sK + s * KSTR + ch) = kq; *(uint4*)(sV + s * KSTR + ch) = vq;
    }
    for (int c = tid; c < 4 * 257; c += NTHR) {
      const int hq = c / 257, ri = c % 257, rel = ri - 128, n = rel < 0 ? -rel : rel;
      const int bucket = (rel > 0 ? 16 : 0) + t5_bucket_abs(n);
      sBias[hq * 260 + ri] = p.rel_bias[bucket * 16 + kvh * 4 + hq];
    }
    __syncthreads();
#pragma unroll 1
    for (int hh = 0; hh < 2; ++hh) {
      const int hq = hp * 2 + hh, head = kvh * 4 + hq;
      const size_t tok0 = (size_t)b * SEQ + nb * 128 + q0;
      uint4 qf[2][2];
#pragma unroll
      for (int qb = 0; qb < 2; ++qb)
#pragma unroll
        for (int ks = 0; ks < 2; ++ks) qf[qb][ks] = *(const uint4*)(q1 + (tok0 + qb * 16 + fr) * DM + head * 64 + ks * 32 + lg * 8);
      f32x4 O[4][2];
#pragma unroll
      for (int mb = 0; mb < 4; ++mb)
#pragma unroll
        for (int qb = 0; qb < 2; ++qb) O[mb][qb] = (f32x4){0.f, 0.f, 0.f, 0.f};
      const float sinkv = p.sink[head];
      float mrun[2] = {sinkv, sinkv}, lpart[2] = {lg == 0 ? 1.0f : 0.0f, lg == 0 ? 1.0f : 0.0f};
      const float* bias = sBias + hq * 260;
#pragma unroll
      for (int c = 0; c < 3; ++c) {
        if ((c == 0 && nb == 0) || (c == 2 && nb == 15)) continue;
        f32x4 S[8][2];
#pragma unroll
        for (int kb = 0; kb < 8; ++kb) {
          S[kb][0] = (f32x4){0.f, 0.f, 0.f, 0.f}; S[kb][1] = S[kb][0];
          const bool act = (c == 0) ? (16 * kb + 15 >= q0) : ((c == 2) ? (16 * kb <= q0 + 31) : true);
          if (act) {
#pragma unroll
            for (int ks = 0; ks < 2; ++ks) {
              const uint4 kf = *(const uint4*)(sK + (c * 128 + kb * 16 + fr) * KSTR + ks * 32 + lg * 8);
              S[kb][0] = mfma16(kf, qf[0][ks], S[kb][0]);
              S[kb][1] = mfma16(kf, qf[1][ks], S[kb][1]);
            }
          }
        }
        float cmax[2] = {-1e30f, -1e30f};
#pragma unroll
        for (int kb = 0; kb < 8; ++kb)
#pragma unroll
          for (int qb = 0; qb < 2; ++qb)
#pragma unroll
            for (int r = 0; r < 4; ++r) {
              const int ri = c * 128 + kb * 16 + 4 * lg + r - (q0 + qb * 16 + fr);
              float v;
              if (c == 1) v = S[kb][qb][r] + bias[ri];
              else { const bool valid = (ri >= 0) && (ri <= 256); v = valid ? S[kb][qb][r] + bias[valid ? ri : 0] : -1e30f; }
              S[kb][qb][r] = v; cmax[qb] = fmaxf(cmax[qb], v);
            }
#pragma unroll
        for (int qb = 0; qb < 2; ++qb) {
          cmax[qb] = fmaxf(cmax[qb], __shfl_xor(cmax[qb], 16)); cmax[qb] = fmaxf(cmax[qb], __shfl_xor(cmax[qb], 32));
          const float mn = fmaxf(mrun[qb], cmax[qb]), alpha = __expf(mrun[qb] - mn);
          mrun[qb] = mn; lpart[qb] *= alpha;
#pragma unroll
          for (int mb = 0; mb < 4; ++mb) O[mb][qb] = O[mb][qb] * alpha;
          float ps = 0.f;
#pragma unroll
          for (int kb = 0; kb < 8; ++kb)
#pragma unroll
            for (int r = 0; r < 4; ++r) { const float e = __expf(S[kb][qb][r] - mn); S[kb][qb][r] = e; ps += e; }
          lpart[qb] += ps;
        }
#pragma unroll
        for (int kk = 0; kk < 4; ++kk) {
          const int kb0 = 2 * kk, kb1 = 2 * kk + 1;
          const bool act = (c == 0) ? (16 * kb1 + 15 >= q0) : ((c == 2) ? (16 * kb0 <= q0 + 31) : true);
          if (act) {
            uint4 pf[2];
#pragma unroll
            for (int qb = 0; qb < 2; ++qb) pf[qb] = make_uint4(pk2(S[kb0][qb][0], S[kb0][qb][1]), pk2(S[kb0][qb][2], S[kb0][qb][3]), pk2(S[kb1][qb][0], S[kb1][qb][1]), pk2(S[kb1][qb][2], S[kb1][qb][3]));
#pragma unroll
            for (int mb = 0; mb < 4; ++mb) {
              const uint2 v0 = lds_tr16(sV + (c * 128 + kb0 * 16 + 4 * lg + tq) * KSTR + mb * 16 + 4 * tp);
              const uint2 v1r = lds_tr16(sV + (c * 128 + kb1 * 16 + 4 * lg + tq) * KSTR + mb * 16 + 4 * tp);
              const uint4 vf = make_uint4(v0.x, v0.y, v1r.x, v1r.y);
              O[mb][0] = mfma16(vf, pf[0], O[mb][0]);
              O[mb][1] = mfma16(vf, pf[1], O[mb][1]);
            }
          }
        }
      }
#pragma unroll
      for (int qb = 0; qb < 2; ++qb) {
        float lt = lpart[qb]; lt += __shfl_xor(lt, 16); lt += __shfl_xor(lt, 32);
        const float inv = 1.0f / lt;
#pragma unroll
        for (int mb = 0; mb < 4; ++mb) {
          uint2 w; w.x = pk2(O[mb][qb][0] * inv, O[mb][qb][1] * inv); w.y = pk2(O[mb][qb][2] * inv, O[mb][qb][3] * inv);
          *(uint2*)(ao + (tok0 + qb * 16 + fr) * DM + head * 64 + mb * 16 + 4 * lg) = w;
        }
      }
    }
  }
}

struct EpiInproj {
  u16* zb; u16* a2; const f32x2* rope;
  __device__ __forceinline__ void operator()(const f32x4 (&acc)[2][2][4][2], const pg8::Unit& u, int wr, int wc, int fr, int fq) const {
    const int seg = u.pn >> 1;
#pragma unroll
    for (int ai = 0; ai < 2; ++ai)
#pragma unroll
      for (int m = 0; m < 4; ++m) {
        const int row = u.pm * 256 + ai * 128 + wr * 64 + m * 16 + fr;
        if (seg < 2) {
          const int d = 16 * wc + 4 * fq;
          const f32x2* cs = rope + (size_t)(row & (SEQ - 1)) * 64 + d;
          const f32x4 c01 = *(const f32x4*)cs, c23 = *(const f32x4*)(cs + 2);
          const float cv[4] = {c01[0], c01[2], c23[0], c23[2]}, sv[4] = {c01[1], c01[3], c23[1], c23[3]};
          const float sc = seg == 1 ? 0.08838834764831845f : 1.0f;
#pragma unroll
          for (int bj = 0; bj < 2; ++bj) {
            const f32x4 x1 = acc[ai][bj][m][0], x2 = acc[ai][bj][m][1];
            float o1[4], o2[4];
#pragma unroll
            for (int r = 0; r < 4; ++r) { o1[r] = (x1[r] * cv[r] - x2[r] * sv[r]) * sc; o2[r] = (x1[r] * sv[r] + x2[r] * cv[r]) * sc; }
            u16* dst = zb + (size_t)seg * T_TOK * 512 + (size_t)row * 512 + ((u.pn & 1) * 2 + bj) * 128 + d;
            uint2 w; w.x = pk2(o1[0], o1[1]); w.y = pk2(o1[2], o1[3]); *(uint2*)dst = w;
            w.x = pk2(o2[0], o2[1]); w.y = pk2(o2[2], o2[3]); *(uint2*)(dst + 64) = w;
          }
        } else {
#pragma unroll
          for (int bj = 0; bj < 2; ++bj)
#pragma unroll
            for (int n = 0; n < 2; ++n) {
              const int col = u.pn * 256 + bj * 128 + wc * 32 + n * 16 + 4 * fq;
              const f32x4 v = acc[ai][bj][m][n];
              uint2 w; w.x = pk2(v[0], v[1]); w.y = pk2(v[2], v[3]);
              if (seg < 4) *(uint2*)(zb + (size_t)seg * T_TOK * 512 + (size_t)row * 512 + (col - seg * 512)) = w;
              else { const int ch = col - 2048, gi = ch >> 4, c = ch & 15; *(uint2*)(a2 + ((size_t)gi * 512 + (row >> 5)) * 768 + (row & 31) * 16 + c) = w; }
            }
        }
      }
  }
};
__device__ __forceinline__ void phase_inproj(const P& p, LAS unsigned char* lds) {
  pg8::DenseOrder S; S.init(p.ws + WS_XB, DM, p.ws + WS_WIN, T_TOK, 2560, DM);
  EpiInproj E{(u16*)(p.ws + WS_Z), (u16*)(p.ws + WS_A2), (const f32x2*)(p.ws + WS_ROPE)};
  pg8::gemm_phase<EpiInproj, pg8::DenseOrder, G_ALIGN, G_SP2>(lds, DM, S, E);
}
struct EpiS5E {
  float* E_;
  __device__ __forceinline__ void operator()(const f32x4 (&acc)[2][2][4][2], const pg8::Unit& u, int wr, int wc, int fr, int fq) const {
#pragma unroll
    for (int ai = 0; ai < 2; ++ai)
#pragma unroll
      for (int m = 0; m < 4; ++m) {
        const int row = u.pm * 256 + ai * 128 + wr * 64 + m * 16 + fr;
#pragma unroll
        for (int bj = 0; bj < 2; ++bj)
#pragma unroll
          for (int n = 0; n < 2; ++n) *(f32x4*)(E_ + ((size_t)u.e * 512 + row) * 256 + bj * 128 + wc * 32 + n * 16 + 4 * fq) = acc[ai][bj][m][n];
      }
  }
};
__device__ __forceinline__ void phase_s5_egemm(const P& p, LAS unsigned char* lds) {
  pg8::GroupOrder S; S.init(p.ws + WS_A2, 768, (size_t)512 * 768, p.ws + WS_WET, (size_t)256 * 512, 32, 512, 256, 512);
  EpiS5E E{(float*)(p.ws + WS_E)};
  pg8::gemm_phase<EpiS5E, pg8::GroupOrder, G_ALIGN, G_SP2>(lds, 512, S, E);
}
struct EpiS5Y {
  u16* yg;
  __device__ __forceinline__ void operator()(const f32x4 (&acc)[2][2][4][2], const pg8::Unit& u, int wr, int wc, int fr, int fq) const {
#pragma unroll
    for (int ai = 0; ai < 2; ++ai)
#pragma unroll
      for (int m = 0; m < 4; ++m) {
        const int row = u.pm * 256 + ai * 128 + wr * 64 + m * 16 + fr;
#pragma unroll
        for (int bj = 0; bj < 2; ++bj)
#pragma unroll
          for (int n = 0; n < 2; ++n) {
            const int col = u.pn * 256 + bj * 128 + wc * 32 + n * 16 + 4 * fq;
            const f32x4 v = acc[ai][bj][m][n];
            uint2 w; w.x = pk2(gelu_tanh(v[0]), gelu_tanh(v[1])); w.y = pk2(gelu_tanh(v[2]), gelu_tanh(v[3]));
            *(uint2*)(yg + ((size_t)row * 32 + (col >> 4)) * 512 + u.e * 16 + (col & 15)) = w;
          }
      }
  }
};
__device__ __forceinline__ void phase_s5_ygemm(const P& p, LAS unsigned char* lds) {
  pg8::GroupOrder S; S.init(p.ws + WS_A2, 768, (size_t)512 * 768, p.ws + WS_BTY, (size_t)512 * 768, 32, 512, 512, 768);
  EpiS5Y E{(u16*)(p.ws + WS_YGELU)};
  pg8::gemm_phase<EpiS5Y, pg8::GroupOrder, G_ALIGN, G_SP2>(lds, 768, S, E);
}
struct EpiGlu {
  const u16* yg; const float* bglu; u16* ycat;
  __device__ __forceinline__ void operator()(const f32x4 (&acc)[2][2][4][2], const pg8::Unit& u, int wr, int wc, int fr, int fq) const {
#pragma unroll
    for (int ai = 0; ai < 2; ++ai)
#pragma unroll
      for (int m = 0; m < 4; ++m) {
        const int row = u.pm * 256 + ai * 128 + wr * 64 + m * 16 + fr;
#pragma unroll
        for (int bj = 0; bj < 2; ++bj)
#pragma unroll
          for (int n = 0; n < 2; ++n) {
            const int col = u.pn * 256 + bj * 128 + wc * 32 + n * 16 + 4 * fq;
            const f32x4 v = acc[ai][bj][m][n];
            const uint2 yv = *(const uint2*)(yg + (size_t)row * 512 + col);
            const f32x4 bb = *(const f32x4*)(bglu + col);
            uint2 w;
            w.x = pk2(lo16(yv.x) * sigmoidf_(v[0] + bb[0]), hi16(yv.x) * sigmoidf_(v[1] + bb[1]));
            w.y = pk2(lo16(yv.y) * sigmoidf_(v[2] + bb[2]), hi16(yv.y) * sigmoidf_(v[3] + bb[3]));
            *(uint2*)(ycat + (size_t)row * DM + 512 + col) = w;
          }
      }
  }
};
__device__ __forceinline__ void phase_glu(const P& p, LAS unsigned char* lds) {
  pg8::DenseOrder S; S.init(p.ws + WS_YGELU, 512, p.ws + WS_WGLU, T_TOK, 512, 512);
  EpiGlu E{(const u16*)(p.ws + WS_YGELU), p.b_glu, (u16*)(p.ws + WS_YCAT)};
  pg8::gemm_phase<EpiGlu, pg8::DenseOrder, G_ALIGN, G_SP2>(lds, 512, S, E);
}
struct EpiResid {
  const float* xin; float* xout;
  __device__ __forceinline__ void operator()(const f32x4 (&acc)[2][2][4][2], const pg8::Unit& u, int wr, int wc, int fr, int fq) const {
#pragma unroll
    for (int ai = 0; ai < 2; ++ai)
#pragma unroll
      for (int m = 0; m < 4; ++m) {
        const int row = u.pm * 256 + ai * 128 + wr * 64 + m * 16 + fr;
#pragma unroll
        for (int bj = 0; bj < 2; ++bj)
#pragma unroll
          for (int n = 0; n < 2; ++n) {
            const size_t o = (size_t)row * DM + u.pn * 256 + bj * 128 + wc * 32 + n * 16 + 4 * fq;
            const f32x4 xv = *(const f32x4*)(xin + o);
            *(f32x4*)(xout + o) = xv + acc[ai][bj][m][n];
          }
      }
  }
};
__device__ __forceinline__ void phase_outproj(const P& p, const void* Wt, const float* xin, float* xout, LAS unsigned char* lds) {
  pg8::DenseOrder S; S.init(p.ws + WS_YCAT, DM, Wt, T_TOK, DM, DM);
  EpiResid E{xin, xout};
  pg8::gemm_phase<EpiResid, pg8::DenseOrder, G_ALIGN, G_SP2>(lds, DM, S, E);
}
struct EpiQkv {
  u16 *q1, *k1, *v1;
  __device__ __forceinline__ void operator()(const f32x4 (&acc)[2][2][4][2], const pg8::Unit& u, int wr, int wc, int fr, int fq) const {
#pragma unroll
    for (int ai = 0; ai < 2; ++ai)
#pragma unroll
      for (int m = 0; m < 4; ++m) {
        const int row = u.pm * 256 + ai * 128 + wr * 64 + m * 16 + fr;
#pragma unroll
        for (int bj = 0; bj < 2; ++bj)
#pragma unroll
          for (int n = 0; n < 2; ++n) {
            const int col = u.pn * 256 + bj * 128 + wc * 32 + n * 16 + 4 * fq;
            const f32x4 v = acc[ai][bj][m][n];
            uint2 w;
            if (u.pn < 4) { w.x = pk2(v[0] * 0.125f, v[1] * 0.125f); w.y = pk2(v[2] * 0.125f, v[3] * 0.125f); *(uint2*)(q1 + (size_t)row * DM + col) = w; }
            else {
              w.x = pk2(v[0], v[1]); w.y = pk2(v[2], v[3]);
              if (u.pn == 4) *(uint2*)(k1 + (size_t)row * 256 + (col - 1024)) = w; else *(uint2*)(v1 + (size_t)row * 256 + (col - 1280)) = w;
            }
          }
      }
  }
};
__device__ __forceinline__ void phase_qkv(const P& p, LAS unsigned char* lds) {
  pg8::DenseOrder S; S.init(p.ws + WS_XB, DM, p.ws + WS_WQKV, T_TOK, 1536, DM);
  EpiQkv E{(u16*)(p.ws + WS_Z), (u16*)(p.ws + WS_Z + 32 * MB), (u16*)(p.ws + WS_Z + 40 * MB)};
  pg8::gemm_phase<EpiQkv, pg8::DenseOrder, G_ALIGN, G_SP2>(lds, DM, S, E);
}
__device__ __forceinline__ void phase_moe_plan(const P& p, int layer, char* smem) {
  if (blockIdx.x != 0) return;
  using pg8::PLAN_STRIDE;
  const int tid = tidx();
  const int* cnt = (const int*)(p.ws + WS_CNT) + layer * 32;
  int* plan_n = (int*)(p.ws + WS_PLAN + layer * 65536); int4* plan = (int4*)(p.ws + WS_PLAN + layer * 65536 + 256);
  int* sc = (int*)smem;
  int* ecum = sc + 32; int* ebase = ecum + 32; int* ehb = ebase + 32; int* efull = ehb + 32; int* tot = efull + 32;
  int* sstart = tot + 8; int* sfstart = sstart + 8; int* cntF = sfstart + 8; int* cntR = cntF + 8;
  unsigned* keyR = (unsigned*)(cntR + 8);
  constexpr int NN = 4;
  __syncthreads();
  if (tid < 32) sc[tid] = cnt[tid];
  if (tid < 8) { sstart[tid] = 0x7fffffff; sfstart[tid] = 0; cntF[tid] = 0; cntR[tid] = 0; }
  if (tid < 128) keyR[tid] = 0xffffffffu;
  __syncthreads();
  if (tid == 0) {
    int cum = 0, ub = 0, hb = 0, fb = 0;
    for (int e = 0; e < 32; ++e) {
      const int c = sc[e], fl = c >> 8, rem = c & 255, rc = (rem + 63) >> 6, ntl = fl + (rem ? 1 : 0);
      ecum[e] = cum; ebase[e] = ub; ehb[e] = hb; efull[e] = fb;
      cum += (fl * 4 + rc) * NN; ub += ntl * NN; hb += ntl * 256; fb += fl * NN;
    }
    tot[0] = cum > 0 ? cum : 1; tot[1] = ub;
  }
  __syncthreads();
  const int total = tot[0], nunits = tot[1] < 1024 ? tot[1] : 1024;
  int4 en[2]; int ux[2], uF[2]; unsigned ukr[2]; bool ufull[2], uval[2];
#pragma unroll
  for (int q = 0; q < 2; ++q) {
    const int u = tid + q * NTHR;
    uval[q] = u < nunits; ux[q] = 0; uF[q] = 0; ukr[q] = 0; ufull[q] = true; en[q] = make_int4(0, 0, 0, 0);
    if (uval[q]) {
      int e = 0;
      for (int j = 1; j < 32; ++j) if (ebase[j] <= u) e = j;
      const int c = sc[e], fl = c >> 8, rem = c & 255, rc = (rem + 63) >> 6, ntl = fl + (rem ? 1 : 0);
      const int local = u - ebase[e], ct = local / ntl, rt = local - ct * ntl;
      const int cum = ecum[e] + ct * (fl * 4 + rc) + rt * 4;
      const bool isfull = rt < fl;
      int x = (cum * 8) / total; if (x > 7) x = 7;
      ux[q] = x; ufull[q] = isfull; uF[q] = efull[e] + ct * fl + (rt < fl ? rt : fl);
      en[q] = make_int4(e | (rt << 8) | (ct << 16), c, ehb[e], 0);
      atomicMin(&sstart[x], u);
      if (isfull) atomicAdd(&cntF[x], 1);
      else { atomicAdd(&cntR[x], 1); ukr[q] = ((unsigned)x << 16) | ((unsigned)(4 - rc) << 12) | (unsigned)(e * NN + ct); keyR[e * NN + ct] = ukr[q]; }
    }
  }
  __syncthreads();
#pragma unroll
  for (int q = 0; q < 2; ++q) if (uval[q] && (tid + q * NTHR) == sstart[ux[q]]) sfstart[ux[q]] = uF[q];
  __syncthreads();
#pragma unroll
  for (int q = 0; q < 2; ++q) {
    if (uval[q]) {
      const int x = ux[q];
      int pos;
      if (ufull[q]) pos = uF[q] - sfstart[x];
      else { pos = cntF[x]; for (int v = 0; v < 128; ++v) { const unsigned kv = keyR[v]; pos += ((kv >> 16) == (unsigned)x && kv < ukr[q]) ? 1 : 0; } }
      if (pos < PLAN_STRIDE) plan[x * PLAN_STRIDE + pos] = en[q];
    }
  }
  if (tid < 8) { const int n = cntF[tid] + cntR[tid]; plan_n[tid] = n < PLAN_STRIDE ? n : PLAN_STRIDE; }
  __syncthreads();
}
struct EpiMoe1 {
  u16* hbuf;
  __device__ __forceinline__ void operator()(const f32x4 (&acc)[2][2][4][2], const pg8::Unit& u, int wr, int wc, int fr, int fq) const {
#pragma unroll
    for (int ai = 0; ai < 2; ++ai)
#pragma unroll
      for (int m = 0; m < 4; ++m) {
        const int row = u.pm * 256 + ai * 128 + wr * 64 + m * 16 + fr;
        if (row < u.cnt) {
#pragma unroll
          for (int bj = 0; bj < 2; ++bj) {
            const f32x4 g = acc[ai][bj][m][0], up = acc[ai][bj][m][1];
            uint2 w; w.x = pk2(g[0] * sigmoidf_(g[0]) * up[0], g[1] * sigmoidf_(g[1]) * up[1]); w.y = pk2(g[2] * sigmoidf_(g[2]) * up[2], g[3] * sigmoidf_(g[3]) * up[3]);
            *(uint2*)(hbuf + (size_t)(u.hbase + row) * 512 + 16 * (8 * u.pn + 4 * bj + wc) + 4 * fq) = w;
          }
        }
      }
  }
};
__device__ __forceinline__ void phase_moe1(const P& p, int layer, LAS unsigned char* lds) {
  pg8::PlanOrder S; S.init(p.ws + WS_PLAN + layer * 65536, (const int*)(p.ws + WS_LIST), p.ws + WS_XB, DM, p.ws + WS_MW, (size_t)DM * DM, DM, true);
  EpiMoe1 E{(u16*)(p.ws + WS_H)};
  pg8::gemm_phase<EpiMoe1, pg8::PlanOrder, G_ALIGN, G_SP2>(lds, DM, S, E);
}
struct EpiMoe2 {
  const int* list; const float* gate; u16* slots;
  __device__ __forceinline__ void operator()(const f32x4 (&acc)[2][2][4][2], const pg8::Unit& u, int wr, int wc, int fr, int fq) const {
#pragma unroll
    for (int ai = 0; ai < 2; ++ai)
#pragma unroll
      for (int m = 0; m < 4; ++m) {
        const int row = u.pm * 256 + ai * 128 + wr * 64 + m * 16 + fr;
        if (row < u.cnt) {
          const int asg = list[(size_t)u.e * CAP + row];
          const float gt = gate[asg];
#pragma unroll
          for (int bj = 0; bj < 2; ++bj)
#pragma unroll
            for (int n = 0; n < 2; ++n) {
              const f32x4 v = acc[ai][bj][m][n];
              uint2 w; w.x = pk2(gt * v[0], gt * v[1]); w.y = pk2(gt * v[2], gt * v[3]);
              *(uint2*)(slots + (size_t)asg * DM + u.pn * 256 + bj * 128 + wc * 32 + n * 16 + 4 * fq) = w;
            }
        }
      }
  }
};
__device__ __forceinline__ void phase_moe2(const P& p, int layer, LAS unsigned char* lds) {
  pg8::PlanOrder S; S.init(p.ws + WS_PLAN + layer * 65536, (const int*)(p.ws + WS_LIST), p.ws + WS_H, 512, p.ws + WS_MW + 64 * MB, (size_t)DM * 512, 512, false);
  EpiMoe2 E{(const int*)(p.ws + WS_LIST), (const float*)(p.ws + WS_GATE), (u16*)(p.ws + WS_INC)};
  pg8::gemm_phase<EpiMoe2, pg8::PlanOrder, G_ALIGN, G_SP2>(lds, 512, S, E);
}

#define XB_TMO      128
#define XB_XCNT(j)  (256  + 64 * (j))
#define XB_XSUB(j)  (1280 + 64 * (j))
#define XB_XGEN(j)  (2304 + 64 * (j))
#define XB_TOP      3328
#define XB_TOPGEN   3392
#define XCD_BAR_WORDS 3456
#define XB_SPIN_CAP (1u << 22)
__device__ __forceinline__ unsigned xb_ld(unsigned* p)              { return __hip_atomic_load(p, __ATOMIC_RELAXED, __HIP_MEMORY_SCOPE_AGENT); }
__device__ __forceinline__ unsigned xb_add(unsigned* p, unsigned v) { return __hip_atomic_fetch_add(p, v, __ATOMIC_RELAXED, __HIP_MEMORY_SCOPE_AGENT); }
__device__ __forceinline__ unsigned xb_xcc_id() { return (unsigned)__builtin_amdgcn_s_getreg((3 << 11) | 20) & 0xFu; }
#define XB_SPIN(cond, bar) do { unsigned _sp = 0; while (cond) { __builtin_amdgcn_s_sleep(1); \
    if ((++_sp & 255u) == 0u) { if (xb_ld(&(bar)[XB_TMO])) break; if (_sp > XB_SPIN_CAP) { atomicAdd(&(bar)[XB_TMO], 1u); break; } } } } while (0)
struct XcdBarrier { unsigned* bar; unsigned x; volatile LAS unsigned* st; };
__device__ __forceinline__ XcdBarrier xcd_barrier_post(unsigned* bar, volatile LAS unsigned* st) {
  XcdBarrier b; b.bar = bar; b.x = xb_xcc_id(); b.st = st;
  if (tidx() == 0) (void)xb_add(&bar[XB_XCNT(b.x)], 1u);
  return b;
}
__device__ __forceinline__ void xcd_barrier_complete(unsigned* bar, unsigned x, unsigned& nloc, unsigned& nx) {
  const unsigned G = gridDim.x * gridDim.y * gridDim.z;
  unsigned sum, cnt, mine, sp = 0u;
  for (;;) {
    sum = 0u; cnt = 0u; mine = 0u;
#pragma unroll
    for (unsigned j = 0; j < 16; ++j) { const unsigned c = xb_ld(&bar[XB_XCNT(j)]); sum += c; cnt += (c > 0u) ? 1u : 0u; mine = (j == x) ? c : mine; }
    if (sum == G) break;
    __builtin_amdgcn_s_sleep(1);
    if ((++sp & 255u) == 0u) { if (xb_ld(&bar[XB_TMO])) break; if (sp > XB_SPIN_CAP) { atomicAdd(&bar[XB_TMO], 1u); break; } }
  }
  nloc = mine > 0u ? mine : 1u; nx = cnt > 0u ? cnt : 1u;
}
__device__ __forceinline__ void xcd_barrier(const XcdBarrier& b) {
  asm volatile("s_waitcnt vmcnt(0)" ::: "memory");
  __syncthreads();
  if (tidx() == 0) {
    unsigned* bar = b.bar;
    __builtin_amdgcn_s_waitcnt(0);
    unsigned nloc = b.st[0], nx = b.st[1];
    if (nloc == 0u) { xcd_barrier_complete(bar, b.x, nloc, nx); b.st[0] = nloc; b.st[1] = nx; }
    const unsigned old = xb_add(&bar[XB_XSUB(b.x)], 1u);
    const unsigned gen = old / nloc;
    if (old + 1u == (gen + 1u) * nloc) {
      __builtin_amdgcn_fence(__ATOMIC_RELEASE, "agent");
      asm volatile("s_waitcnt vmcnt(0)" ::: "memory");
      const unsigned og = xb_add(&bar[XB_TOP], 1u);
      const unsigned tg = og / nx;
      if (og + 1u == (tg + 1u) * nx) xb_add(&bar[XB_TOPGEN], 1u);
      else XB_SPIN(xb_ld(&bar[XB_TOPGEN]) == tg, bar);
      __builtin_amdgcn_fence(__ATOMIC_ACQUIRE, "agent");
      xb_add(&bar[XB_XGEN(b.x)], 1u);
      asm volatile("s_waitcnt vmcnt(0)" ::: "memory");
    } else {
      XB_SPIN(xb_ld(&bar[XB_XGEN(b.x)]) == gen, bar);
      __builtin_amdgcn_fence(__ATOMIC_ACQUIRE, "agent");
      asm volatile("s_waitcnt vmcnt(0)" ::: "memory");
    }
  }
  __syncthreads();
}

constexpr int NPHASE = 20;
constexpr int LDS_BYTES = 147456;
__device__ __forceinline__ void run_phase(const P& p, int ph, char* smem, LAS unsigned char* lds) {
  float* xa = (float*)(p.ws + WS_XA);
  const u16* slots = (const u16*)(p.ws + WS_INC);
  switch (ph) {
    case 0: phase_rowpass(p, p.x, nullptr, nullptr, p.norm_mix_g, -1, nullptr, smem); phase_prep(p); __syncthreads(); phase_conv_dense(p, smem); break;
    case 1: phase_inproj(p, lds); phase_s5_ktab(p); phase_s5_fill_bc(p); break;
    case 2: phase_ret_inc_mfma(p, smem); __syncthreads(); phase_s5_egemm(p, lds); phase_s5_fill_a(p); break;
    case 3: phase_ret_scan16(p); phase_s5_carry(p); break;
    case 4: phase_ret_out_mfma(p, smem); __syncthreads(); phase_s5_ygemm(p, lds); break;
    case 5: phase_glu(p, lds); break;
    case 6: phase_outproj(p, p.ws + WS_WOUT, p.x, xa, lds); break;
    case 7: phase_rowpass(p, xa, nullptr, nullptr, p.norm_ffn_g, 0, nullptr, smem); break;
    case 8: phase_moe_plan(p, 0, smem); phase_conv_moe(p, 0, smem); break;
    case 9: phase_moe1(p, 0, lds); break;
    case 10: phase_moe2(p, 0, lds); break;
    case 11: phase_rowpass(p, xa, slots, xa, p.norm_mix_g + DM, -1, nullptr, smem); break;
    case 12: phase_qkv(p, lds); break;
    case 13: phase_attn(p, smem); break;
    case 14: phase_outproj(p, p.ws + WS_WO, xa, xa, lds); break;
    case 15: phase_rowpass(p, xa, nullptr, nullptr, p.norm_ffn_g + DM, 1, nullptr, smem); break;
    case 16: phase_moe_plan(p, 1, smem); phase_conv_moe(p, 1, smem); break;
    case 17: phase_moe1(p, 1, lds); break;
    case 18: phase_moe2(p, 1, lds); break;
    case 19: phase_rowpass(p, xa, slots, nullptr, p.norm_final_g, -1, p.out, smem); break;
    default: break;
  }
}

extern __shared__ __attribute__((aligned(16))) char dyn_smem[];

template <int PH> __device__ __forceinline__ void mega_steps(const P& p, char* smem, LAS unsigned char* lds, cg::grid_group& grid, const XcdBarrier& xb) {
  run_phase(p, PH, smem, lds);
  if constexpr (PH + 1 < NPHASE) {
    if constexpr (PH == 0) grid.sync(); else xcd_barrier(xb);
    mega_steps<PH + 1>(p, smem, lds, grid, xb);
  }
}
__global__ void __launch_bounds__(NTHR, 2) k_mega(P p) {
  cg::grid_group grid = cg::this_grid();
  LAS unsigned char* lds = (LAS unsigned char*)dyn_smem;
  volatile LAS unsigned* st = (volatile LAS unsigned*)(lds + LDS_BYTES - 16);
  if (tidx() == 0) { st[0] = 0u; st[1] = 0u; }
  __syncthreads();
  const XcdBarrier xb = xcd_barrier_post((unsigned*)(p.ws + WS_BAR), st);
  mega_steps<0>(p, dyn_smem, lds, grid, xb);
}

extern "C" void kernel_launch(void* const* d_in, const int* in_sizes, int n_in, void* d_out, int out_size, void* d_ws, size_t ws_size, hipStream_t stream) {
  static int grid_blocks = 0;
  if (grid_blocks == 0) {
    if (n_in != 28 || out_size != T_TOK * DM || ws_size < WS_END) { fprintf(stderr, "kernel_launch: unexpected problem (n_in %d out %d ws %zu need %zu)\n", n_in, out_size, ws_size, (size_t)WS_END); grid_blocks = -1; return; }
    int dev = 0, cus = 0, per_cu = 0;
    (void)hipGetDevice(&dev);
    (void)hipDeviceGetAttribute(&cus, hipDeviceAttributeMultiprocessorCount, dev);
    const void* fn = (const void*)k_mega;
    if (hipFuncSetAttribute(fn, hipFuncAttributeMaxDynamicSharedMemorySize, LDS_BYTES) != hipSuccess) { fprintf(stderr, "kernel_launch: hipFuncSetAttribute failed\n"); }
    if (hipOccupancyMaxActiveBlocksPerMultiprocessor(&per_cu, fn, NTHR, LDS_BYTES) != hipSuccess || per_cu < 1) { fprintf(stderr, "kernel_launch: occupancy query failed (%d)\n", per_cu); per_cu = 1; }
    (void)hipGetLastError();
    if (per_cu > 1) per_cu = 1;
    grid_blocks = cus * per_cu;
    fprintf(stderr, "kernel_launch: cus %d per_cu %d grid %d\n", cus, per_cu, grid_blocks);
  }
  if (grid_blocks < 0) return;
  P p{};
  const float** pp = (const float**)&p;
  for (int i = 0; i < 28; ++i) pp[i] = (const float*)d_in[i];
  p.out = (float*)d_out; p.ws = (char*)d_ws;
  (void)hipMemsetAsync((char*)d_ws + WS_BAR, 0, XCD_BAR_WORDS * 4, stream);
  void* args[] = {&p};
  hipError_t e = hipLaunchCooperativeKernel((const void*)k_mega, dim3(grid_blocks), dim3(NTHR), args, LDS_BYTES, stream);
  if (e != hipSuccess) fprintf(stderr, "cooperative launch failed: %s (grid %d)\n", hipGetErrorString(e), grid_blocks);
}
```

```cpp
#include <hip/hip_runtime.h>
#include <hip/hip_cooperative_groups.h>
#include <cstdio>
#include <cstdint>
namespace cg = cooperative_groups;

#define USE_FP16 1
#define LAS __attribute__((address_space(3)))

typedef unsigned short u16;
typedef float f32x4 __attribute__((ext_vector_type(4)));
typedef float f32x2 __attribute__((ext_vector_type(2)));
typedef _Float16 f16x8 __attribute__((ext_vector_type(8)));

constexpr int T_TOK = 16384, DM = 1024, SEQ = 2048, NBATCH = 8;
constexpr int CAP = 32768;
constexpr int NTHR = 512, NWAVE = NTHR / 64;

constexpr size_t MB = 1024ull * 1024ull;
constexpr size_t WS_XA    = 0;
constexpr size_t WS_XB    = 64 * MB;
constexpr size_t WS_Z     = 96 * MB;
constexpr size_t WS_A2    = 160 * MB;
constexpr size_t WS_BTY   = 184 * MB;
constexpr size_t WS_MW1   = 160 * MB;
constexpr size_t WS_WET   = 208 * MB;
constexpr size_t WS_E     = 216 * MB;
constexpr size_t WS_KTAB  = 232 * MB;
constexpr size_t WS_SP16  = 234 * MB;
constexpr size_t WS_INC   = 266 * MB;
constexpr size_t WS_YCAT  = 330 * MB;
constexpr size_t WS_YGELU = 362 * MB;
constexpr size_t WS_H     = 330 * MB;
constexpr size_t WS_LIST  = 378 * MB;
constexpr size_t WS_GATE  = 382 * MB;
constexpr size_t WS_ROPE  = 383 * MB;
constexpr size_t WS_CNT   = 384 * MB;
constexpr size_t WS_WR16  = 385 * MB;
constexpr size_t WS_BAR   = 386 * MB;
constexpr size_t WS_PLAN  = 386 * MB + 512 * 1024;
constexpr size_t WS_WIN   = 387 * MB;
constexpr size_t WS_WGLU  = 392 * MB;
constexpr size_t WS_WOUT  = 393 * MB;
constexpr size_t WS_WQKV  = 395 * MB;
constexpr size_t WS_WO    = 398 * MB;
constexpr size_t WS_LAMT  = 400 * MB;
constexpr size_t WS_MW0   = 402 * MB;
constexpr size_t WS_END   = 498 * MB;

struct P {
  const float *x, *norm_mix_g, *norm_ffn_g, *norm_final_g, *w_in, *ret_decay, *a_re, *a_im, *log_step, *b_re, *b_im, *c_re, *c_im,
      *s5d, *w_glu, *b_glu, *w_out, *w_qkv, *sink, *w_o, *rel_bias, *w_group, *b_group, *w_er, *b_er, *w_gate, *w_up, *w_down;
  float* out;
  char* ws;
};

__device__ __forceinline__ u16 f2h(float f) { _Float16 h = (_Float16)f; return __builtin_bit_cast(u16, h); }
__device__ __forceinline__ float h2f(u16 h) { return (float)__builtin_bit_cast(_Float16, h); }
__device__ __forceinline__ unsigned pk2(float a, float b) { return (unsigned)f2h(a) | ((unsigned)f2h(b) << 16); }
__device__ __forceinline__ float lo16(unsigned w) { return h2f((u16)(w & 0xffffu)); }
__device__ __forceinline__ float hi16(unsigned w) { return h2f((u16)(w >> 16)); }
__device__ __forceinline__ f32x4 mfma16(uint4 a, uint4 b, f32x4 c) {
  return __builtin_amdgcn_mfma_f32_16x16x32_f16(__builtin_bit_cast(f16x8, a), __builtin_bit_cast(f16x8, b), c, 0, 0, 0);
}
__device__ __forceinline__ float wave_sum(float v) {
#pragma unroll
  for (int o = 1; o < 64; o <<= 1) v += __shfl_xor(v, o);
  return v;
}
__device__ __forceinline__ float sigmoidf_(float x) { return 1.0f / (1.0f + __expf(-x)); }
__device__ __forceinline__ float gelu_tanh(float x) {
  const float u = 0.7978845608028654f * (x + 0.044715f * x * x * x);
  return 0.5f * x * (1.0f + tanhf(u));
}
#define LDS_WAIT() asm volatile("s_waitcnt lgkmcnt(0)" ::: "memory")
__device__ __forceinline__ int tidx() { int t = threadIdx.x; asm volatile("" : "+v"(t)); return t; }

namespace pg8 {
constexpr int BM = 256, BK = 64, HALF = 128, HTB = HALF * BK * 2, STAGE_BYTES = 8 * HTB, NXCD = 8, WGM = 8;
__device__ __forceinline__ int lds_byte(int r, int c) { const int st = (r >> 4) * 2 + (c >> 5), rr = r & 15, cc = c & 31, ob = rr * 64 + cc * 2; return st * 1024 + (ob ^ (((ob >> 9) & 1) << 5)); }
__device__ __forceinline__ void stage_rc(int b, int& R, int& C) { const int st = b / 1024, sb = b % 1024, swz = sb ^ (((sb >> 9) & 1) << 5); R = (st >> 1) * 16 + swz / 64; C = (st & 1) * 32 + (swz % 64) / 2; }

struct Unit { const char* a; const char* b; int pm, pn, e, cnt, hbase; };

template <class Epi, class Sched, bool ALIGN_EPI, bool SP2>
__device__ __forceinline__ void gemm_phase(LAS unsigned char* lds, const int K, const Sched& S, const Epi& E) {
    const int tid = tidx(), wid = __builtin_amdgcn_readfirstlane(tid >> 6), lane = tid & 63, wr = wid >> 2, wc = wid & 3, fr = lane & 15, fq = lane >> 4;
    const int nt = K / BK;
    int Rr[2], Cc[2];
    unsigned voffB[2];
#pragma unroll
    for (int i = 0; i < 2; ++i) { stage_rc(tid * 16 + i * 8192, Rr[i], Cc[i]); voffB[i] = (unsigned)(Rr[i] * K + Cc[i]) * 2u; }
    const size_t kstep = (size_t)(BK * 2);
    const size_t hstepB = (size_t)HALF * K * 2;
    const unsigned ldsw = (unsigned)wid * 1024u;
    const int aoff = lds_byte(wr * 64 + fr, fq * 8), boff = lds_byte(wc * 32 + fr, fq * 8);
#define PG8_SA(b, h) (((b) * 2 + (h)) * HTB)
#define PG8_SB(b, h) ((4 + (b) * 2 + (h)) * HTB)
#define PG8_STAGE(bufoff, gbase, voff) do { _Pragma("unroll") for (int _i = 0; _i < 2; ++_i) \
        __builtin_amdgcn_global_load_lds((const unsigned*)((const char*)(gbase) + (voff)[_i]), (LAS unsigned*)(lds + (bufoff) + ldsw + _i * 8192), 16, 0, 0); } while (0)
#define PG8_LDA(dst, b, h) do { _Pragma("unroll") for (int m = 0; m < 4; ++m) _Pragma("unroll") for (int k = 0; k < 2; ++k) dst[m][k] = *(const LAS f16x8*)(lds + PG8_SA(b, h) + aoff + m * 2048 + k * 1024); } while (0)
#define PG8_LDB(dst, b, h) do { _Pragma("unroll") for (int n = 0; n < 2; ++n) _Pragma("unroll") for (int k = 0; k < 2; ++k) dst[n][k] = *(const LAS f16x8*)(lds + PG8_SB(b, h) + boff + n * 2048 + k * 1024); } while (0)
#define PG8_MMA(ai, bj, At, Bt) do { if (128 * (ai) + 64 * wr >= urows) break; __builtin_amdgcn_s_setprio(1); _Pragma("unroll") for (int m = 0; m < 4; ++m) _Pragma("unroll") for (int n = 0; n < 2; ++n) _Pragma("unroll") for (int k = 0; k < 2; ++k) \
        acc[ai][bj][m][n] = __builtin_amdgcn_mfma_f32_16x16x32_f16(Bt[n][k], At[m][k], acc[ai][bj][m][n], 0, 0, 0); __builtin_amdgcn_s_setprio(0); } while (0)
#define PG8_WAIT_V(n) asm volatile("s_waitcnt vmcnt(" #n ")" ::: "memory")
#define PG8_WAIT_L(n) asm volatile("s_waitcnt lgkmcnt(" #n ")" ::: "memory")
#define PG8_BAR __builtin_amdgcn_s_barrier()
#define PG8_SCHED __builtin_amdgcn_sched_barrier(0)
    Unit cur, nxt; int ui = 0;
    if (!S.next(0, cur)) return;
    unsigned cv0[2], cv1[2], nv0[2], nv1[2];
#pragma unroll
    for (int i = 0; i < 2; ++i) { cv0[i] = S.a_voff(cur, 0, Rr[i], Cc[i]); cv1[i] = S.a_voff(cur, 1, Rr[i], Cc[i]); }
    f32x4 acc[2][2][4][2];
#pragma unroll
    for (int a = 0; a < 2; ++a)
#pragma unroll
        for (int b = 0; b < 2; ++b)
#pragma unroll
            for (int m = 0; m < 4; ++m)
#pragma unroll
                for (int n = 0; n < 2; ++n) acc[a][b][m][n] = (f32x4){0.f, 0.f, 0.f, 0.f};
    f16x8 At[4][2], B0[2][2], B1[2][2];
    const char* cA = cur.a; const char* cB = cur.b;
    int urows = S.rows(cur);
    if constexpr (SP2) {
        PG8_STAGE(PG8_SB(0, 0), cB, voffB); PG8_STAGE(PG8_SB(0, 1), cB + hstepB, voffB); PG8_STAGE(PG8_SA(0, 0), cA, cv0); PG8_STAGE(PG8_SA(0, 1), cA, cv1);
        if (wr == 1) PG8_BAR;
        PG8_WAIT_V(2); PG8_BAR;
        PG8_STAGE(PG8_SB(1, 0), cB + kstep, voffB); PG8_STAGE(PG8_SA(1, 0), cA + kstep, cv0); PG8_STAGE(PG8_SB(1, 1), cB + hstepB + kstep, voffB);
        PG8_WAIT_V(6); PG8_BAR;
    } else {
        PG8_STAGE(PG8_SB(0, 0), cB, voffB); PG8_STAGE(PG8_SA(0, 0), cA, cv0); PG8_STAGE(PG8_SB(0, 1), cB + hstepB, voffB); PG8_STAGE(PG8_SA(0, 1), cA, cv1);
        if (wr == 1) PG8_BAR;
        PG8_WAIT_V(4); PG8_BAR;
        PG8_STAGE(PG8_SB(1, 0), cB + kstep, voffB); PG8_STAGE(PG8_SA(1, 0), cA + kstep, cv0); PG8_STAGE(PG8_SB(1, 1), cB + hstepB + kstep, voffB);
        PG8_WAIT_V(6); PG8_BAR;
    }
    for (;;) {
        const bool has_next = S.next(ui + 1, nxt);
        if (has_next) {
#pragma unroll
            for (int i = 0; i < 2; ++i) { nv0[i] = S.a_voff(nxt, 0, Rr[i], Cc[i]); nv1[i] = S.a_voff(nxt, 1, Rr[i], Cc[i]); }
        } else {
            nxt = cur;
#pragma unroll
            for (int i = 0; i < 2; ++i) { nv0[i] = cv0[i]; nv1[i] = cv1[i]; }
        }
        const char* nA = nxt.a; const char* nB = nxt.b;
        for (int t = 0; t < nt; t += 2) {
            const bool last = (t == nt - 2);
            const char* a1 = cA + (size_t)(t + 1) * kstep;
            const char* a2 = last ? nA : cA + (size_t)(t + 2) * kstep; const char* b2 = last ? nB : cB + (size_t)(t + 2) * kstep;
            const char* a3 = a2 + kstep; const char* b3 = b2 + kstep;
            unsigned v0[2], v1[2];
#pragma unroll
            for (int i = 0; i < 2; ++i) { v0[i] = last ? nv0[i] : cv0[i]; v1[i] = last ? nv1[i] : cv1[i]; }
            if constexpr (SP2) {
            PG8_LDB(B0, 0, 0); PG8_LDB(B1, 0, 1); PG8_SCHED; PG8_LDA(At, 0, 0); PG8_STAGE(PG8_SA(1, 1), a1, cv1);
            PG8_WAIT_V(8); PG8_WAIT_L(0); PG8_BAR; PG8_MMA(0, 0, At, B0); PG8_MMA(0, 1, At, B1); PG8_BAR; PG8_SCHED;
            PG8_LDA(At, 0, 1); PG8_STAGE(PG8_SB(0, 0), b2, voffB); PG8_STAGE(PG8_SB(0, 1), b2 + hstepB, voffB); PG8_STAGE(PG8_SA(0, 0), a2, v0);
            PG8_WAIT_V(8); PG8_WAIT_L(0); PG8_BAR; PG8_MMA(1, 0, At, B0); PG8_MMA(1, 1, At, B1); PG8_BAR; PG8_SCHED;
            PG8_LDB(B0, 1, 0); PG8_LDB(B1, 1, 1); PG8_SCHED; PG8_LDA(At, 1, 0); PG8_STAGE(PG8_SA(0, 1), a2, v1);
            PG8_WAIT_V(8); PG8_WAIT_L(0); PG8_BAR; PG8_MMA(0, 0, At, B0); PG8_MMA(0, 1, At, B1); PG8_BAR; PG8_SCHED;
            PG8_LDA(At, 1, 1); PG8_STAGE(PG8_SB(1, 0), b3, voffB); PG8_STAGE(PG8_SB(1, 1), b3 + hstepB, voffB); PG8_STAGE(PG8_SA(1, 0), a3, v0);
            PG8_WAIT_V(8); PG8_WAIT_L(0); PG8_BAR; PG8_MMA(1, 0, At, B0); PG8_MMA(1, 1, At, B1); PG8_BAR; PG8_SCHED;
            } else {
            PG8_LDB(B0, 0, 0); PG8_SCHED; PG8_LDA(At, 0, 0); PG8_STAGE(PG8_SA(1, 1), a1, cv1);
            PG8_WAIT_L(8); PG8_BAR; PG8_WAIT_L(0); PG8_MMA(0, 0, At, B0); PG8_BAR; PG8_SCHED;
            PG8_LDB(B1, 0, 1); PG8_STAGE(PG8_SB(0, 0), b2, voffB);
            PG8_BAR; PG8_WAIT_L(0); PG8_MMA(0, 1, At, B1); PG8_BAR;
            PG8_LDA(At, 0, 1); PG8_STAGE(PG8_SA(0, 0), a2, v0);
            PG8_BAR; PG8_WAIT_L(0); PG8_MMA(1, 0, At, B0); PG8_BAR; PG8_SCHED;
            PG8_STAGE(PG8_SB(0, 1), b2 + hstepB, voffB);
            PG8_WAIT_V(6); PG8_BAR; PG8_MMA(1, 1, At, B1); PG8_BAR;
            PG8_LDB(B0, 1, 0); PG8_SCHED; PG8_LDA(At, 1, 0); PG8_STAGE(PG8_SA(0, 1), a2, v1);
            PG8_WAIT_L(8); PG8_BAR; PG8_WAIT_L(0); PG8_MMA(0, 0, At, B0); PG8_BAR; PG8_SCHED;
            PG8_LDB(B1, 1, 1); PG8_STAGE(PG8_SB(1, 0), b3, voffB);
            PG8_BAR; PG8_WAIT_L(0); PG8_MMA(0, 1, At, B1); PG8_BAR;
            PG8_LDA(At, 1, 1); PG8_STAGE(PG8_SA(1, 0), a3, v0);
            PG8_BAR; PG8_WAIT_L(0); PG8_MMA(1, 0, At, B0); PG8_BAR; PG8_SCHED;
            PG8_STAGE(PG8_SB(1, 1), b3 + hstepB, voffB);
            PG8_WAIT_V(6); PG8_BAR; PG8_MMA(1, 1, At, B1); PG8_BAR;
            }
        }
        if constexpr (ALIGN_EPI) { if (wr == 0) PG8_BAR; }
        E(acc, cur, wr, wc, fr, fq);
        if (!has_next) break;
#pragma unroll
        for (int a = 0; a < 2; ++a)
#pragma unroll
            for (int b = 0; b < 2; ++b)
#pragma unroll
                for (int m = 0; m < 4; ++m)
#pragma unroll
                    for (int n = 0; n < 2; ++n) acc[a][b][m][n] = (f32x4){0.f, 0.f, 0.f, 0.f};
        cur = nxt; cA = nA; cB = nB; ++ui; urows = S.rows(cur);
#pragma unroll
        for (int i = 0; i < 2; ++i) { cv0[i] = nv0[i]; cv1[i] = nv1[i]; }
        if constexpr (ALIGN_EPI) { if (wr == 1) PG8_BAR; }
    }
    PG8_WAIT_V(0);
    if constexpr (!ALIGN_EPI) { if (wr == 0) PG8_BAR; }
    PG8_BAR;
#undef PG8_SA
#undef PG8_SB
#undef PG8_STAGE
#undef PG8_LDA
#undef PG8_LDB
#undef PG8_MMA
#undef PG8_WAIT_V
#undef PG8_WAIT_L
#undef PG8_BAR
#undef PG8_SCHED
}

struct DenseOrder {
    const char* A; const char* Bt; int lda_b, K, nM, nN, nwg, G, c;
    __device__ __forceinline__ void init(const void* A_, int lda_elems, const void* Bt_, int M, int N, int K_) { A = (const char*)A_; Bt = (const char*)Bt_; lda_b = lda_elems * 2; K = K_; nM = M / BM; nN = N / BM; nwg = nM * nN; G = gridDim.x; c = blockIdx.x; }
    __device__ __forceinline__ bool next(int i, Unit& u) const {
        const long L = (long)i * G + c; if (L >= nwg) return false;
        int wgid = (int)L; { const int q = nwg / NXCD, r = nwg % NXCD, xcd = wgid % NXCD, off = wgid / NXCD; wgid = (xcd < r ? xcd * (q + 1) : r * (q + 1) + (xcd - r) * q) + off; }
        const int nig = WGM * nN, gid = wgid / nig, fm = gid * WGM, gsz = (nM - fm) < WGM ? (nM - fm) : WGM;
        u.pm = fm + ((wgid % nig) % gsz); u.pn = (wgid % nig) / gsz; u.e = 0; u.cnt = 0; u.hbase = 0;
        u.a = A + (size_t)u.pm * BM * lda_b; u.b = Bt + (size_t)u.pn * BM * K * 2;
        return true;
    }
    __device__ __forceinline__ unsigned a_voff(const Unit&, int h, int R, int C) const { return (unsigned)((h * HALF + R) * lda_b + C * 2); }
    __device__ __forceinline__ int rows(const Unit&) const { return BM; }
};
struct GroupOrder {
    const char* A; const char* Bt; int lda_b, K, nM, nN, ng, G, c; size_t gsA, gsB;
    __device__ __forceinline__ void init(const void* A_, int lda_elems, size_t gsA_elems, const void* Bt_, size_t gsB_elems, int ng_, int M, int N, int K_) {
        A = (const char*)A_; Bt = (const char*)Bt_; lda_b = lda_elems * 2; K = K_; nM = M / BM; nN = N / BM; ng = ng_; gsA = gsA_elems * 2; gsB = gsB_elems * 2; G = gridDim.x; c = blockIdx.x; }
    __device__ __forceinline__ bool next(int i, Unit& u) const {
        const long L = (long)i * G + c; if (L >= (long)ng * nM * nN) return false;
        const int per = nM * nN, g = (int)L / per, r = (int)L % per;
        u.e = g; u.pm = r / nN; u.pn = r % nN; u.cnt = 0; u.hbase = 0;
        u.a = A + (size_t)g * gsA + (size_t)u.pm * BM * lda_b; u.b = Bt + (size_t)g * gsB + (size_t)u.pn * BM * K * 2;
        return true;
    }
    __device__ __forceinline__ unsigned a_voff(const Unit&, int h, int R, int C) const { return (unsigned)((h * HALF + R) * lda_b + C * 2); }
    __device__ __forceinline__ int rows(const Unit&) const { return BM; }
};
constexpr int PLAN_STRIDE = 256;
struct PlanOrder {
    const int4* plan; const int* plan_n; const int* list; const char* A; const char* Bt; int lda_b, K, x, ib, nbx; size_t esB; bool gather;
    __device__ __forceinline__ void init(const void* planbase, const int* list_, const void* A_, int lda_elems, const void* Bt_, size_t esB_elems, int K_, bool gather_) {
        plan_n = (const int*)planbase; plan = (const int4*)((const char*)planbase + 256); list = list_; A = (const char*)A_; Bt = (const char*)Bt_; lda_b = lda_elems * 2; K = K_; esB = esB_elems * 2; gather = gather_;
        x = blockIdx.x & 7; ib = blockIdx.x >> 3; nbx = ((int)gridDim.x - x + 7) >> 3; }
    __device__ __forceinline__ bool next(int i, Unit& u) const {
        const int j = i * nbx + ib;
        if (j >= plan_n[x]) return false;
        const int4 en = plan[x * PLAN_STRIDE + j];
        u.e = en.x & 255; u.pm = (en.x >> 8) & 255; u.pn = (en.x >> 16) & 255; u.cnt = en.y; u.hbase = en.z;
        u.a = gather ? A : A + (size_t)(u.hbase + u.pm * BM) * lda_b;
        u.b = Bt + (size_t)u.e * esB + (size_t)u.pn * BM * K * 2;
        return true;
    }
    __device__ __forceinline__ unsigned a_voff(const Unit& u, int h, int R, int C) const {
        if (!gather) return (unsigned)((h * HALF + R) * lda_b + C * 2);
        const int li = u.pm * BM + h * HALF + R;
        const int tok = (li < u.cnt) ? (list[(size_t)u.e * CAP + li] >> 1) : 0;
        return (unsigned)(tok * lda_b + C * 2);
    }
    __device__ __forceinline__ int rows(const Unit& u) const { const int r = u.cnt - u.pm * BM; return r < BM ? r : BM; }
};
}
constexpr bool G_ALIGN = true, G_SP2 = true;

__device__ __forceinline__ void phase_prep(const P& p) {
  const int gtid = blockIdx.x * NTHR + tidx(), gsz = gridDim.x * NTHR;
  int* cnt = (int*)(p.ws + WS_CNT);
  if (gtid < 64) cnt[gtid] = 0;
  f32x2* rope = (f32x2*)(p.ws + WS_ROPE);
  for (int i = gtid; i < SEQ * 64; i += gsz) {
    const int pos = i >> 6, f = i & 63;
    const float inv = powf(10000.0f, -(float)(2 * f) / 128.0f);
    const float ang = (float)pos * inv;
    float s, c; sincosf(ang, &s, &c);
    rope[i] = (f32x2){c, s};
  }
  f32x2* lamt = (f32x2*)(p.ws + WS_LAMT); f32x2* coeft = (f32x2*)(p.ws + WS_LAMT + 3 * MB / 2);
  for (int i = gtid; i < 32 * 2 * 33 * 64; i += gsz) {
    const int q = i & 63, l = (i >> 6) % 33, gd = i / (33 * 64);
    const int g = gd >> 1, dir = gd & 1;
    const float dt = expf(p.log_step[dir * 32 + g]), ar = p.a_re[(dir * 32 + g) * 64 + q], ai = p.a_im[(dir * 32 + g) * 64 + q];
    const float mag = expf(ar * dt * (float)l); float sn, cs; sincosf(ai * dt * (float)l, &sn, &cs);
    lamt[i] = (f32x2){mag * cs, mag * sn};
    if (l == 1) {
      const float em1 = expm1f(ar * dt), sh = sinf(0.5f * ai * dt);
      const float nr = em1 * cs - 2.0f * sh * sh, ni = (em1 + 1.0f) * sn, den = ar * ar + ai * ai;
      coeft[gd * 64 + q] = (f32x2){(nr * ar + ni * ai) / den, (ni * ar - nr * ai) / den};
    }
  }
  u16* wr16 = (u16*)(p.ws + WS_WR16);
  for (int i = gtid; i < 2 * 48 * DM; i += gsz) {
    const int k = i & (DM - 1), n = (i >> 10) % 48, layer = i / (48 * DM);
    float w = 0.f;
    if (n < 4) w = p.w_group[((size_t)layer * DM + k) * 4 + n];
    else if (n < 36) { const int gg = (n - 4) >> 3, j = (n - 4) & 7; w = p.w_er[(((size_t)layer * 4 + gg) * DM + k) * 8 + j]; }
    w *= p.norm_ffn_g[layer * DM + k];
    const u16 hi = f2h(w), lo = f2h(w - h2f(hi));
    wr16[((size_t)(layer * 2 + 0) * 48 + n) * DM + k] = hi;
    wr16[((size_t)(layer * 2 + 1) * 48 + n) * DM + k] = lo;
  }
}

template <class RowFn>
__device__ __forceinline__ void conv_item(const float* W, int ldw, int K, u16* WT, float* scr, int k0, int n0, int lane, RowFn rowfn) {
#pragma unroll 8
  for (int i = 0; i < 32; ++i) { const int kk = 2 * i + (lane >> 5); scr[kk * 33 + (lane & 31)] = W[(size_t)(k0 + kk) * ldw + n0 + (lane & 31)]; }
  LDS_WAIT();
  const int c = lane & 7;
#pragma unroll
  for (int j = 0; j < 4; ++j) {
    const int n = (lane >> 3) + 8 * j; const float* sp = scr + (8 * c) * 33 + n;
    uint4 o; o.x = pk2(sp[0 * 33], sp[1 * 33]); o.y = pk2(sp[2 * 33], sp[3 * 33]); o.z = pk2(sp[4 * 33], sp[5 * 33]); o.w = pk2(sp[6 * 33], sp[7 * 33]);
    *(uint4*)(WT + (size_t)rowfn(n0 + n) * K + k0 + 8 * c) = o;
  }
  LDS_WAIT();
}
template <class RowFn>
__device__ __forceinline__ int conv_matrix(const float* W, int ldw, int K, int N, u16* WT, char* smem, int item_base, RowFn rowfn) {
  const int lane = tidx() & 63, wv = tidx() >> 6, gw = blockIdx.x * NWAVE + wv, nw = gridDim.x * NWAVE;
  float* scr = (float*)smem + wv * (64 * 33);
  const int nkb = K / 64, nnb = N / 32, nitems = nkb * nnb;
  int it = gw - (item_base % nw); if (it < 0) it += nw;
  for (; it < nitems; it += nw) conv_item(W, ldw, K, WT, scr, (it / nnb) * 64, (it % nnb) * 32, lane, rowfn);
  return nitems;
}
__device__ __forceinline__ void phase_conv_dense(const P& p, char* smem) {
  auto id = [](int n) { return n; };
  int base = 0;
  base += conv_matrix(p.w_in, 2560, DM, 2560, (u16*)(p.ws + WS_WIN), smem, base, [](int n) { if (n >= 1024) return n; const int dd = n & 127, hf = dd >> 6, r = dd & 63; return (n & ~127) + 32 * (r >> 4) + 16 * hf + (r & 15); });
  base += conv_matrix(p.w_glu, 512, 512, 512, (u16*)(p.ws + WS_WGLU), smem, base, id);
  base += conv_matrix(p.w_out, DM, DM, DM, (u16*)(p.ws + WS_WOUT), smem, base, id);
  base += conv_matrix(p.w_qkv, 1536, DM, 1536, (u16*)(p.ws + WS_WQKV), smem, base, id);
  base += conv_matrix(p.w_o, DM, DM, DM, (u16*)(p.ws + WS_WO), smem, base, id);
}
__device__ __forceinline__ void phase_conv_moe(const P& p, int layer, int lo, int hi, int b0, int nb, char* smem) {
  if ((int)blockIdx.x < b0 || (int)blockIdx.x >= b0 + nb) return;
  const int lane = tidx() & 63, wv = tidx() >> 6, gw = ((int)blockIdx.x - b0) * NWAVE + wv, nw = nb * NWAVE;
  float* scr = (float*)smem + wv * (64 * 33);
  u16* w1t = (u16*)(p.ws + (layer ? WS_MW1 : WS_MW0)); u16* w2t = w1t + (size_t)32 * DM * DM;
  for (int it = lo + gw; it < hi; it += nw) {
    const int e = it / 768, r = it % 768;
    if (r < 512) {
      const int which = r >> 8, q = r & 255, k0 = (q >> 4) * 64, n0 = (q & 15) * 32;
      const float* W = (which ? p.w_up : p.w_gate) + (size_t)(layer * 32 + e) * DM * 512;
      conv_item(W, 512, DM, w1t + (size_t)e * DM * DM, scr, k0, n0, lane, [which](int n) { return (n >> 4) * 32 + which * 16 + (n & 15); });
    } else {
      const int q = r - 512, k0 = (q >> 5) * 64, n0 = (q & 31) * 32;
      const float* W = p.w_down + (size_t)(layer * 32 + e) * 512 * DM;
      conv_item(W, DM, 512, w2t + (size_t)e * DM * 512, scr, k0, n0, lane, [](int n) { return n; });
    }
  }
}

constexpr int CONV_ITEMS = 32 * 768;
constexpr int cq(int pct) { return (int)((long)CONV_ITEMS * pct / 100); }
__device__ __forceinline__ void phase_rowpass(const P& p, const float* src, const u16* slots, float* dstx, const float* gain, int route_layer, float* fout, char* smem) {
  const int lane = tidx() & 63, wv = tidx() >> 6, fr = lane & 15, lg = lane >> 4;
  u16* xb = (u16*)(p.ws + WS_XB);
  int* cnt = (int*)(p.ws + WS_CNT);
  int* list = (int*)(p.ws + WS_LIST);
  float* gate = (float*)(p.ws + WS_GATE);
  float* sRs = (float*)smem;
  float* sLg = (float*)smem + 64;
  for (int st = blockIdx.x; st < T_TOK / 64; st += gridDim.x) {
    const int row0 = st * 64 + wv * 8;
#pragma unroll 1
    for (int rp = 0; rp < 4; ++rp) {
      f32x4 v[2][4];
#pragma unroll
      for (int q = 0; q < 2; ++q) {
        const int row = row0 + rp * 2 + q;
#pragma unroll
        for (int i = 0; i < 4; ++i) v[q][i] = *(const f32x4*)(src + (size_t)row * DM + (i * 64 + lane) * 4);
      }
      if (slots) {
#pragma unroll
        for (int q = 0; q < 2; ++q) {
          const int row = row0 + rp * 2 + q;
          uint2 w[2][4];
#pragma unroll
          for (int sl = 0; sl < 2; ++sl)
#pragma unroll
            for (int i = 0; i < 4; ++i) w[sl][i] = *(const uint2*)(slots + ((size_t)row * 2 + sl) * DM + (i * 64 + lane) * 4);
#pragma unroll
          for (int sl = 0; sl < 2; ++sl)
#pragma unroll
            for (int i = 0; i < 4; ++i) { v[q][i][0] += lo16(w[sl][i].x); v[q][i][1] += hi16(w[sl][i].x); v[q][i][2] += lo16(w[sl][i].y); v[q][i][3] += hi16(w[sl][i].y); }
        }
      }
#pragma unroll
      for (int q = 0; q < 2; ++q) {
        const int row = row0 + rp * 2 + q;
        float ss = 0.f;
#pragma unroll
        for (int i = 0; i < 4; ++i) {
          if (dstx) *(f32x4*)(dstx + (size_t)row * DM + (i * 64 + lane) * 4) = v[q][i];
          ss += v[q][i][0] * v[q][i][0] + v[q][i][1] * v[q][i][1] + v[q][i][2] * v[q][i][2] + v[q][i][3] * v[q][i][3];
        }
        ss = wave_sum(ss);
        const float rstd = rsqrtf(ss * (1.0f / DM) + 1e-6f);
        if (route_layer >= 0 && lane == 0) sRs[wv * 8 + rp * 2 + q] = rstd;
#pragma unroll
        for (int i = 0; i < 4; ++i) {
          const int k = (i * 64 + lane) * 4;
          const f32x4 gv = *(const f32x4*)(gain + k);
          const f32x4 hv = v[q][i] * rstd * gv;
          if (fout) *(f32x4*)(fout + (size_t)row * DM + k) = hv;
          else { uint2 w; w.x = pk2(hv[0], hv[1]); w.y = pk2(hv[2], hv[3]); *(uint2*)(xb + (size_t)row * DM + k) = w; }
        }
      }
    }
    if (route_layer >= 0) {
      __syncthreads();
      const int tl = wv & 3, kh = wv >> 2;
      const float rsv = sRs[tl * 16 + fr];
      const float* xrow = src + (size_t)(st * 64 + tl * 16 + fr) * DM + kh * 512 + lg * 8;
      const u16* whi = (const u16*)(p.ws + WS_WR16) + ((size_t)(route_layer * 2 + 0) * 48 + fr) * DM + kh * 512 + lg * 8;
      const u16* wlo = (const u16*)(p.ws + WS_WR16) + ((size_t)(route_layer * 2 + 1) * 48 + fr) * DM + kh * 512 + lg * 8;
      f32x4 acc[3];
#pragma unroll
      for (int nb = 0; nb < 3; ++nb) acc[nb] = (f32x4){0.f, 0.f, 0.f, 0.f};
#pragma unroll 4
      for (int ks = 0; ks < 16; ++ks) {
        const f32x4 x0 = *(const f32x4*)(xrow + ks * 32), x1 = *(const f32x4*)(xrow + ks * 32 + 4);
        const float hv[8] = {x0[0] * rsv, x0[1] * rsv, x0[2] * rsv, x0[3] * rsv, x1[0] * rsv, x1[1] * rsv, x1[2] * rsv, x1[3] * rsv};
        unsigned ah[4], al[4];
#pragma unroll
        for (int j = 0; j < 4; ++j) {
          const u16 h0 = f2h(hv[2 * j]), h1 = f2h(hv[2 * j + 1]);
          ah[j] = (unsigned)h0 | ((unsigned)h1 << 16);
          al[j] = pk2(hv[2 * j] - h2f(h0), hv[2 * j + 1] - h2f(h1));
        }
        const uint4 ahi = make_uint4(ah[0], ah[1], ah[2], ah[3]), alo = make_uint4(al[0], al[1], al[2], al[3]);
#pragma unroll
        for (int nb = 0; nb < 3; ++nb) {
          const uint4 bh = *(const uint4*)(whi + (size_t)nb * 16 * DM + ks * 32), bl = *(const uint4*)(wlo + (size_t)nb * 16 * DM + ks * 32);
          acc[nb] = mfma16(bh, ahi, acc[nb]); acc[nb] = mfma16(bh, alo, acc[nb]); acc[nb] = mfma16(bl, ahi, acc[nb]);
        }
      }
      float* lgw = sLg + ((kh * 4 + tl) * 16 + fr) * 49;
#pragma unroll
      for (int nb = 0; nb < 3; ++nb)
#pragma unroll
        for (int r = 0; r < 4; ++r) lgw[nb * 16 + 4 * lg + r] = acc[nb][r];
      __syncthreads();
      if (wv < 4 && lane < 16) {
        const int row = st * 64 + wv * 16 + lane;
        const float* l0 = sLg + ((0 * 4 + wv) * 16 + lane) * 49;
        const float* l1 = sLg + ((1 * 4 + wv) * 16 + lane) * 49;
        const float* bg = p.b_group + route_layer * 4;
        const float* be = p.b_er + route_layer * 32;
        float gl[4];
#pragma unroll
        for (int j = 0; j < 4; ++j) gl[j] = l0[j] + l1[j] + bg[j];
        int gs = 0; float gm = gl[0];
#pragma unroll
        for (int j = 1; j < 4; ++j) if (gl[j] > gm) { gm = gl[j]; gs = j; }
        float den = 0.f;
#pragma unroll
        for (int j = 0; j < 4; ++j) den += expf(gl[j] - gm);
        const float pg = 1.0f / den;
        float el[8];
#pragma unroll
        for (int j = 0; j < 8; ++j) el[j] = l0[4 + gs * 8 + j] + l1[4 + gs * 8 + j] + be[gs * 8 + j];
        int i1 = 0; float v1 = el[0];
#pragma unroll
        for (int j = 1; j < 8; ++j) if (el[j] > v1) { v1 = el[j]; i1 = j; }
        int i2 = -1; float v2 = -3.0e38f;
#pragma unroll
        for (int j = 0; j < 8; ++j) if (j != i1 && el[j] > v2) { v2 = el[j]; i2 = j; }
        const float e2 = expf(v2 - v1);
        const float g1 = pg / (1.0f + e2), g2 = pg * e2 / (1.0f + e2);
        const int ex1 = gs * 8 + i1, ex2 = gs * 8 + i2;
        const int r1 = atomicAdd(&cnt[route_layer * 32 + ex1], 1);
        list[(size_t)ex1 * CAP + r1] = row * 2;
        gate[row * 2] = g1;
        const int r2 = atomicAdd(&cnt[route_layer * 32 + ex2], 1);
        list[(size_t)ex2 * CAP + r2] = row * 2 + 1;
        gate[row * 2 + 1] = g2;
      }
      __syncthreads();
    }
  }
}

constexpr int RSTR = 136;
__device__ __forceinline__ float log_sigmoid(float x) { return -log1pf(expf(-x)); }
__device__ __forceinline__ uint2 lds_tr16(const u16* ptr) {
  typedef short s16x4 __attribute__((ext_vector_type(4)));
  const s16x4 v = __builtin_amdgcn_ds_read_tr16_b64_v4i16((LAS s16x4*)ptr);
  return __builtin_bit_cast(uint2, v);
}
__device__ __forceinline__ uint4 lds_frag_T(const u16* tile, int rs, int k0, int c0, int lane) {
  const int g = lane >> 4, q = (lane & 15) >> 2, pp = lane & 3;
  const u16* a = tile + (k0 + 8 * g + q) * rs + c0 + 4 * pp;
  const uint2 lo = lds_tr16(a), hi = lds_tr16(a + 4 * rs);
  return make_uint4(lo.x, lo.y, hi.x, hi.y);
}
__device__ __forceinline__ void ret_load_tile(u16* dst0, u16* dst1, const u16* src, int t0, int h, const float* w0, const float* w1) {
  for (int c = tidx(); c < 128 * 16; c += NTHR) {
    const int i = c >> 4, ch = (c & 15) * 8;
    const uint4 v = *(const uint4*)(src + (size_t)(t0 + i) * 512 + h * 128 + ch);
    if (w0) {
      const float a = w0[i], b = w1[i];
      const float f[8] = {lo16(v.x), hi16(v.x), lo16(v.y), hi16(v.y), lo16(v.z), hi16(v.z), lo16(v.w), hi16(v.w)};
      *(uint4*)(dst0 + i * RSTR + ch) = make_uint4(pk2(f[0] * a, f[1] * a), pk2(f[2] * a, f[3] * a), pk2(f[4] * a, f[5] * a), pk2(f[6] * a, f[7] * a));
      *(uint4*)(dst1 + i * RSTR + ch) = make_uint4(pk2(f[0] * b, f[1] * b), pk2(f[2] * b, f[3] * b), pk2(f[4] * b, f[5] * b), pk2(f[6] * b, f[7] * b));
    } else *(uint4*)(dst0 + i * RSTR + ch) = v;
  }
}
template <int MB_, int NB_, bool ATR, bool BTR>
__device__ __forceinline__ void lds_mma(f32x4 (&acc)[MB_][NB_], const u16* sA, int sa, int a0, const u16* sB, int sb, int b0, int K, int lane, const float* sc) {
  const int fr = lane & 15, fq = lane >> 4;
  for (int k0 = 0; k0 < K; k0 += 32) {
    uint4 fa[MB_], fb[NB_];
#pragma unroll
    for (int m = 0; m < MB_; ++m) {
      if constexpr (ATR) fa[m] = lds_frag_T(sA, sa, k0, a0 + m * 16, lane);
      else fa[m] = *(const uint4*)(sA + (a0 + m * 16 + fr) * sa + k0 + fq * 8);
      if (sc) {
        const float f = sc[m];
        fa[m].x = pk2(lo16(fa[m].x) * f, hi16(fa[m].x) * f); fa[m].y = pk2(lo16(fa[m].y) * f, hi16(fa[m].y) * f);
        fa[m].z = pk2(lo16(fa[m].z) * f, hi16(fa[m].z) * f); fa[m].w = pk2(lo16(fa[m].w) * f, hi16(fa[m].w) * f);
      }
    }
#pragma unroll
    for (int n = 0; n < NB_; ++n) {
      if constexpr (BTR) fb[n] = lds_frag_T(sB, sb, k0, b0 + n * 16, lane);
      else fb[n] = *(const uint4*)(sB + (b0 + n * 16 + fr) * sb + k0 + fq * 8);
    }
#pragma unroll
    for (int m = 0; m < MB_; ++m)
#pragma unroll
      for (int n = 0; n < NB_; ++n) acc[m][n] = mfma16(fb[n], fa[m], acc[m][n]);
  }
}
__device__ __forceinline__ void phase_ret_inc_mfma(const P& p, char* smem) {
  u16* sKf = (u16*)smem; u16* sKb = sKf + 128 * RSTR; u16* sV = sKb + 128 * RSTR; float* sWf = (float*)(sV + 128 * RSTR); float* sWb = sWf + 128;
  const u16* kb = (const u16*)(p.ws + WS_Z) + (size_t)1 * T_TOK * 512; const u16* vb = (const u16*)(p.ws + WS_Z) + (size_t)2 * T_TOK * 512;
  float* incf = (float*)(p.ws + WS_INC); float* incb = incf + (size_t)512 * 16384;
  const int tid = tidx(), lane = tid & 63, wv = tid >> 6, wr = wv >> 1, wc = wv & 1, fr = lane & 15, fq = lane >> 4;
  for (int item = blockIdx.x; item < 512; item += gridDim.x) {
    const int h = item & 3, bn = item >> 2, t0 = bn * 128;
    const float lgf = log_sigmoid(p.ret_decay[h]), lgb = log_sigmoid(p.ret_decay[4 + h]);
    __syncthreads();
    if (tid < 128) { sWf[tid] = expf(lgf * (float)(127 - tid)); sWb[tid] = expf(lgb * (float)tid); }
    __syncthreads();
    ret_load_tile(sKf, sKb, kb, t0, h, sWf, sWb);
    ret_load_tile(sV, nullptr, vb, t0, h, nullptr, nullptr);
    __syncthreads();
#pragma unroll
    for (int dirn = 0; dirn < 2; ++dirn) {
      f32x4 acc[2][4];
#pragma unroll
      for (int m = 0; m < 2; ++m)
#pragma unroll
        for (int n = 0; n < 4; ++n) acc[m][n] = (f32x4){0.f, 0.f, 0.f, 0.f};
      lds_mma<2, 4, true, true>(acc, sV, RSTR, wr * 32, dirn ? sKb : sKf, RSTR, wc * 64, 128, lane, nullptr);
      float* o = (dirn ? incb : incf) + (size_t)item * 16384;
#pragma unroll
      for (int m = 0; m < 2; ++m)
#pragma unroll
        for (int n = 0; n < 4; ++n) *(f32x4*)(o + (wr * 32 + m * 16 + fr) * 128 + wc * 64 + n * 16 + 4 * fq) = acc[m][n];
    }
  }
}
__device__ __forceinline__ void phase_ret_scan16(const P& p) {
  const float* incf = (const float*)(p.ws + WS_INC); const float* incb = incf + (size_t)512 * 16384;
  u16* spf = (u16*)(p.ws + WS_SP16); u16* spb = spf + (size_t)512 * 16384;
  const int gtid = blockIdx.x * NTHR + tidx(), gsz = gridDim.x * NTHR;
  for (int idx = gtid; idx < 32 * 4096; idx += gsz) {
    const int de = (idx & 4095) * 4, bh = idx >> 12, b = bh >> 2, h = bh & 3;
    const float Gf = expf(128.0f * log_sigmoid(p.ret_decay[h])), Gb = expf(128.0f * log_sigmoid(p.ret_decay[4 + h]));
    f32x4 s = {0.f, 0.f, 0.f, 0.f};
    for (int n = 0; n < 16; ++n) {
      const size_t o = ((size_t)((b * 16 + n) * 4 + h)) * 16384 + de;
      const f32x4 t = *(const f32x4*)(incf + o);
      uint2 w; w.x = pk2(s[0], s[1]); w.y = pk2(s[2], s[3]); *(uint2*)(spf + o) = w;
      s = s * Gf + t;
    }
    s = (f32x4){0.f, 0.f, 0.f, 0.f};
    for (int n = 15; n >= 0; --n) {
      const size_t o = ((size_t)((b * 16 + n) * 4 + h)) * 16384 + de;
      const f32x4 t = *(const f32x4*)(incb + o);
      uint2 w; w.x = pk2(s[0], s[1]); w.y = pk2(s[2], s[3]); *(uint2*)(spb + o) = w;
      s = s * Gb + t;
    }
  }
}
__device__ __forceinline__ void phase_ret_out_mfma(const P& p, char* smem) {
  u16* R0 = (u16*)smem; u16* R1 = R0 + 128 * RSTR; u16* R2 = R1 + 128 * RSTR; u16* R3 = R2 + 128 * RSTR;
  float* sPf = (float*)(R3 + 128 * RSTR); float* sPb = sPf + 132;
  const u16* zb = (const u16*)(p.ws + WS_Z);
  const u16* qb = zb; const u16* kb = zb + (size_t)1 * T_TOK * 512; const u16* vb = zb + (size_t)2 * T_TOK * 512; const u16* gb = zb + (size_t)3 * T_TOK * 512;
  const u16* spf = (const u16*)(p.ws + WS_SP16); const u16* spb = spf + (size_t)512 * 16384;
  u16* ycat = (u16*)(p.ws + WS_YCAT);
  const int tid = tidx(), lane = tid & 63, wv = tid >> 6, wr = wv >> 1, wc = wv & 1, fr = lane & 15, fq = lane >> 4;
  for (int item = blockIdx.x; item < 512; item += gridDim.x) {
    const int h = item & 3, bn = item >> 2, t0 = bn * 128;
    const float lgf = log_sigmoid(p.ret_decay[h]), lgb = log_sigmoid(p.ret_decay[4 + h]);
    __syncthreads();
    ret_load_tile(R0, nullptr, qb, t0, h, nullptr, nullptr);
    ret_load_tile(R1, nullptr, kb, t0, h, nullptr, nullptr);
    ret_load_tile(R2, nullptr, vb, t0, h, nullptr, nullptr);
    if (tid < 129) { sPf[tid] = expf(lgf * (float)tid); sPb[tid] = expf(lgb * (float)tid); }
    __syncthreads();
    {
      f32x4 acc[2][4];
#pragma unroll
      for (int m = 0; m < 2; ++m)
#pragma unroll
        for (int n = 0; n < 4; ++n) acc[m][n] = (f32x4){0.f, 0.f, 0.f, 0.f};
      lds_mma<2, 4, false, false>(acc, R0, RSTR, wr * 32, R1, RSTR, wc * 64, 128, lane, nullptr);
#pragma unroll
      for (int m = 0; m < 2; ++m)
#pragma unroll
        for (int n = 0; n < 4; ++n) {
          const int i = wr * 32 + m * 16 + fr, j = wc * 64 + n * 16 + 4 * fq;
          float v[4];
#pragma unroll
          for (int r = 0; r < 4; ++r) { const int jj = j + r; v[r] = acc[m][n][r] * ((i >= jj) ? sPf[i - jj] : sPb[jj - i]); }
          uint2 w; w.x = pk2(v[0], v[1]); w.y = pk2(v[2], v[3]);
          *(uint2*)(R3 + i * RSTR + j) = w;
        }
    }
    __syncthreads();
    const u16* spT = spf + (size_t)item * 16384; const u16* snT = spb + (size_t)item * 16384;
    for (int c = tid; c < 128 * 16; c += NTHR) { const int e = c >> 4, ch = (c & 15) * 8; *(uint4*)(R1 + e * RSTR + ch) = *(const uint4*)(spT + e * 128 + ch); }
    f32x4 o[1][8];
#pragma unroll
    for (int m = 0; m < 1; ++m)
#pragma unroll
      for (int n = 0; n < 8; ++n) o[m][n] = (f32x4){0.f, 0.f, 0.f, 0.f};
    lds_mma<1, 8, false, true>(o, R3, RSTR, wv * 16, R2, RSTR, 0, 128, lane, nullptr);
    __syncthreads();
    for (int c = tid; c < 128 * 16; c += NTHR) { const int e = c >> 4, ch = (c & 15) * 8; *(uint4*)(R2 + e * RSTR + ch) = *(const uint4*)(snT + e * 128 + ch); }
    float scf[1], scb[1];
    { const int i = wv * 16 + fr; scf[0] = sPf[i + 1]; scb[0] = sPb[128 - i]; }
    lds_mma<1, 8, false, false>(o, R0, RSTR, wv * 16, R1, RSTR, 0, 128, lane, scf);
    __syncthreads();
    lds_mma<1, 8, false, false>(o, R0, RSTR, wv * 16, R2, RSTR, 0, 128, lane, scb);
#pragma unroll
    for (int m = 0; m < 1; ++m) {
      float s1 = 0.f;
#pragma unroll
      for (int n = 0; n < 8; ++n) s1 += (o[m][n][0] + o[m][n][1]) + (o[m][n][2] + o[m][n][3]);
      s1 += __shfl_xor(s1, 16); s1 += __shfl_xor(s1, 32);
      const float mu = s1 * (1.0f / 128.0f);
      float s2 = 0.f;
#pragma unroll
      for (int n = 0; n < 8; ++n)
#pragma unroll
        for (int r = 0; r < 4; ++r) { const float dl = o[m][n][r] - mu; s2 += dl * dl; }
      s2 += __shfl_xor(s2, 16); s2 += __shfl_xor(s2, 32);
      const float rs = rsqrtf(s2 * (1.0f / 128.0f) + 1e-5f);
      const size_t tok = (size_t)(t0 + wv * 16 + m * 16 + fr);
#pragma unroll
      for (int n = 0; n < 8; ++n) {
        const int e = n * 16 + 4 * fq;
        const uint2 gq = *(const uint2*)(gb + tok * 512 + h * 128 + e);
        const float g0 = lo16(gq.x), g1 = hi16(gq.x), g2 = lo16(gq.y), g3 = hi16(gq.y);
        uint2 w;
        w.x = pk2(g0 * sigmoidf_(g0) * (o[m][n][0] - mu) * rs, g1 * sigmoidf_(g1) * (o[m][n][1] - mu) * rs);
        w.y = pk2(g2 * sigmoidf_(g2) * (o[m][n][2] - mu) * rs, g3 * sigmoidf_(g3) * (o[m][n][3] - mu) * rs);
        *(uint2*)(ycat + tok * DM + h * 128 + e) = w;
      }
    }
  }
}

struct Cpx { float re, im; };
__device__ __forceinline__ Cpx cmul(Cpx a, Cpx b) { return {a.re * b.re - a.im * b.im, a.re * b.im + a.im * b.re}; }
__device__ __forceinline__ Cpx s5_lam(const P& p, int g, int dir, int l, int q) { const f32x2 v = ((const f32x2*)(p.ws + WS_LAMT))[((g * 2 + dir) * 33 + l) * 64 + q]; return {v[0], v[1]}; }
__device__ __forceinline__ Cpx s5_cf(const P& p, int g, int dir, int q) { const f32x2 v = ((const f32x2*)(p.ws + WS_LAMT + 3 * MB / 2))[(g * 2 + dir) * 64 + q]; return {v[0], v[1]}; }
__device__ __forceinline__ bool s5_setup_ids(int& gtid, int& gsz) {
  const bool half = (gridDim.x == 256);
  if (half && blockIdx.x < 128) return false;
  gtid = (half ? (int)blockIdx.x - 128 : (int)blockIdx.x) * NTHR + tidx(); gsz = (half ? 128 : (int)gridDim.x) * NTHR;
  return true;
}
__device__ __forceinline__ void phase_s5_ktab(const P& p) {
  float* ktab = (float*)(p.ws + WS_KTAB);
  int gtid, gsz; if (!s5_setup_ids(gtid, gsz)) return;
  for (int item = gtid; item < 32 * 2 * 32 * 16; item += gsz) {
    const int c = item & 15, l = (item >> 4) & 31, dir = (item >> 9) & 1, g = item >> 10;
    float acc[16];
#pragma unroll
    for (int j = 0; j < 16; ++j) acc[j] = 0.f;
    for (int q = 0; q < 64; ++q) {
      const Cpx L = s5_lam(p, g, dir, l, q), cf = s5_cf(p, g, dir, q);
      const Cpx C = {p.c_re[((dir * 32 + g) * 16 + c) * 64 + q], p.c_im[((dir * 32 + g) * 16 + c) * 64 + q]};
      const Cpx w = cmul(cmul(C, L), cf);
#pragma unroll
      for (int j = 0; j < 16; ++j) acc[j] += w.re * p.b_re[(g * 64 + q) * 16 + j] - w.im * p.b_im[(g * 64 + q) * 16 + j];
    }
#pragma unroll
    for (int j = 0; j < 16; j += 4) *(f32x4*)(ktab + (size_t)item * 16 + j) = (f32x4){acc[j], acc[j + 1], acc[j + 2], acc[j + 3]};
  }
}
__device__ __forceinline__ void phase_s5_fill_a(const P& p) {
  const float* ktab = (const float*)(p.ws + WS_KTAB);
  u16* bty = (u16*)(p.ws + WS_BTY);
  const int gtid = blockIdx.x * NTHR + tidx(), gsz = gridDim.x * NTHR;
  for (int item = gtid; item < 32 * 512 * 64; item += gsz) {
    const int ch = item & 63, n = (item >> 6) & 511, g = item >> 15;
    const int ip = ch >> 1, c0 = (ch & 1) * 8, i = n >> 4, c = n & 15;
    float v[8];
    if (ip != i) {
      const int dir = ip < i ? 0 : 1, l = ip < i ? i - ip : ip - i;
      const float* src = ktab + ((size_t)((g * 2 + dir) * 32 + l) * 16 + c) * 16 + c0;
      const f32x4 a = *(const f32x4*)src, b = *(const f32x4*)(src + 4);
      v[0] = a[0]; v[1] = a[1]; v[2] = a[2]; v[3] = a[3]; v[4] = b[0]; v[5] = b[1]; v[6] = b[2]; v[7] = b[3];
    } else {
      const float* s0 = ktab + ((size_t)((g * 2 + 0) * 32) * 16 + c) * 16 + c0;
      const float* s1 = ktab + ((size_t)((g * 2 + 1) * 32) * 16 + c) * 16 + c0;
      const float dd = p.s5d[g * 16 + c];
#pragma unroll
      for (int j = 0; j < 8; ++j) v[j] = s0[j] + s1[j] + ((c0 + j) == c ? dd : 0.f);
    }
    *(uint4*)(bty + ((size_t)g * 512 + n) * 768 + ch * 8) = make_uint4(pk2(v[0], v[1]), pk2(v[2], v[3]), pk2(v[4], v[5]), pk2(v[6], v[7]));
  }
}
__device__ __forceinline__ void phase_s5_fill_bc(const P& p) {
  u16* bty = (u16*)(p.ws + WS_BTY); u16* wet = (u16*)(p.ws + WS_WET);
  int gtid, gsz; if (!s5_setup_ids(gtid, gsz)) return;
  for (int item = gtid; item < 32 * 512 * 32; item += gsz) {
    const int ch = item & 31, n = (item >> 5) & 511, g = item >> 14;
    const int kk = ch * 8, dir = kk >> 7, p0 = (kk & 127) >> 1, i = n >> 4, c = n & 15;
    const int e = dir ? (32 - i) : (i + 1);
    float v[8];
#pragma unroll
    for (int q = 0; q < 4; ++q) {
      const int pq = p0 + q;
      const Cpx L = s5_lam(p, g, dir, e, pq);
      const Cpx C = {p.c_re[((dir * 32 + g) * 16 + c) * 64 + pq], p.c_im[((dir * 32 + g) * 16 + c) * 64 + pq]};
      const Cpx w = cmul(C, L);
      v[2 * q] = w.re; v[2 * q + 1] = -w.im;
    }
    *(uint4*)(bty + ((size_t)g * 512 + n) * 768 + 512 + kk) = make_uint4(pk2(v[0], v[1]), pk2(v[2], v[3]), pk2(v[4], v[5]), pk2(v[6], v[7]));
  }
  for (int item = gtid; item < 32 * 256 * 64; item += gsz) {
    const int ch = item & 63, n = (item >> 6) & 255, g = item >> 14;
    const int ip = ch >> 1, c0 = (ch & 1) * 8, ri = n & 1, pq = (n >> 1) & 63, dir = n >> 7;
    const int e = dir ? ip : (31 - ip);
    const Cpx w = cmul(s5_lam(p, g, dir, e, pq), s5_cf(p, g, dir, pq));
    float v[8];
#pragma unroll
    for (int j = 0; j < 8; ++j) {
      const float br = p.b_re[(g * 64 + pq) * 16 + c0 + j], bi = p.b_im[(g * 64 + pq) * 16 + c0 + j];
      v[j] = ri ? (w.re * bi + w.im * br) : (w.re * br - w.im * bi);
    }
    *(uint4*)(wet + ((size_t)g * 256 + n) * 512 + ch * 8) = make_uint4(pk2(v[0], v[1]), pk2(v[2], v[3]), pk2(v[4], v[5]), pk2(v[6], v[7]));
  }
}
__device__ __forceinline__ void phase_s5_carry(const P& p) {
  const float* E = (const float*)(p.ws + WS_E);
  u16* a2 = (u16*)(p.ws + WS_A2);
  const int gtid = blockIdx.x * NTHR + tidx(), gsz = gridDim.x * NTHR;
  for (int idx = gtid; idx < 32 * 8 * 128; idx += gsz) {
    const int pq = idx & 63, dir = (idx >> 6) & 1, b = (idx >> 7) & 7, g = idx >> 10;
    const Cpx L = s5_lam(p, g, dir, 32, pq);
    Cpx s = {0.f, 0.f};
    for (int jj = 0; jj < 64; ++jj) {
      const int j = dir ? 63 - jj : jj, r = b * 64 + j;
      const f32x2 e = *(const f32x2*)(E + ((size_t)g * 512 + r) * 256 + (dir * 64 + pq) * 2);
      *(unsigned*)(a2 + ((size_t)g * 512 + r) * 768 + 512 + (dir * 64 + pq) * 2) = pk2(s.re, s.im);
      const Cpx ns = cmul(L, s);
      s.re = ns.re + e[0]; s.im = ns.im + e[1];
    }
  }
}
constexpr int KSTR = 72;
__device__ __forceinline__ int t5_bucket_abs(int n) {
  return n < 8 ? n : 8 + (n >= 12) + (n >= 16) + (n >= 23) + (n >= 32) + (n >= 46) + (n >= 64) + (n >= 91);
}
__device__ __forceinline__ void phase_attn(const P& p, char* smem) {
  u16* sK = (u16*)smem; u16* sV = sK + 384 * KSTR; float* sBias = (float*)(sV + 384 * KSTR);
  const u16* q1 = (const u16*)(p.ws + WS_Z); const u16* k1 = (const u16*)(p.ws + WS_Z + 32 * MB); const u16* v1 = (const u16*)(p.ws + WS_Z + 40 * MB);
  u16* ao = (u16*)(p.ws + WS_YCAT);
  const int tid = tidx(), lane = tid & 63, wv = tid >> 6, fr = lane & 15, lg = lane >> 4, q0 = (wv & 3) * 32, hp = wv >> 2;
  const int tq = (lane & 15) >> 2, tp = lane & 3;
  for (int item = blockIdx.x; item < 512; item += gridDim.x) {
    const int b = item >> 6, nb = (item >> 2) & 15, kvh = item & 3;
    __syncthreads();
    for (int c = tid; c < 384 * 8; c += NTHR) {
      const int s = c >> 3, ch = (c & 7) * 8, pos = (nb - 1) * 128 + s;
      uint4 kq = make_uint4(0u, 0u, 0u, 0u), vq = kq;
      if (pos >= 0 && pos < SEQ) { kq = *(const uint4*)(k1 + (size_t)(b * SEQ + pos) * 256 + kvh * 64 + ch); vq = *(const uint4*)(v1 + (size_t)(b * SEQ + pos) * 256 + kvh * 64 + ch); }
      *(uint4*)(sK + s * KSTR + ch) = kq; *(uint4*)(sV + s * KSTR + ch) = vq;
    }
    for (int c = tid; c < 4 * 257; c += NTHR) {
      const int hq = c / 257, ri = c % 257, rel = ri - 128, n = rel < 0 ? -rel : rel;
      const int bucket = (rel > 0 ? 16 : 0) + t5_bucket_abs(n);
      sBias[hq * 260 + ri] = p.rel_bias[bucket * 16 + kvh * 4 + hq];
    }
    __syncthreads();
#pragma unroll 1
    for (int hh = 0; hh < 2; ++hh) {
      const int hq = hp * 2 + hh, head = kvh * 4 + hq;
      const size_t tok0 = (size_t)b * SEQ + nb * 128 + q0;
      uint4 qf[2][2];
#pragma unroll
      for (int qb = 0; qb < 2; ++qb)
#pragma unroll
        for (int ks = 0; ks < 2; ++ks) qf[qb][ks] = *(const uint4*)(q1 + (tok0 + qb * 16 + fr) * DM + head * 64 + ks * 32 + lg * 8);
      f32x4 O[4][2];
#pragma unroll
      for (int mb = 0; mb < 4; ++mb)
#pragma unroll
        for (int qb = 0; qb < 2; ++qb) O[mb][qb] = (f32x4){0.f, 0.f, 0.f, 0.f};
      const float sinkv = p.sink[head];
      float mrun[2] = {sinkv, sinkv}, lpart[2] = {lg == 0 ? 1.0f : 0.0f, lg == 0 ? 1.0f : 0.0f};
      const float* bias = sBias + hq * 260;
#pragma unroll
      for (int c = 0; c < 3; ++c) {
        if ((c == 0 && nb == 0) || (c == 2 && nb == 15)) continue;
        f32x4 S[8][2];
#pragma unroll
        for (int kb = 0; kb < 8; ++kb) {
          S[kb][0] = (f32x4){0.f, 0.f, 0.f, 0.f}; S[kb][1] = S[kb][0];
          const bool act = (c == 0) ? (16 * kb + 15 >= q0) : ((c == 2) ? (16 * kb <= q0 + 31) : true);
          if (act) {
#pragma unroll
            for (int ks = 0; ks < 2; ++ks) {
              const uint4 kf = *(const uint4*)(sK + (c * 128 + kb * 16 + fr) * KSTR + ks * 32 + lg * 8);
              S[kb][0] = mfma16(kf, qf[0][ks], S[kb][0]);
              S[kb][1] = mfma16(kf, qf[1][ks], S[kb][1]);
            }
          }
        }
        float cmax[2] = {-1e30f, -1e30f};
#pragma unroll
        for (int kb = 0; kb < 8; ++kb)
#pragma unroll
          for (int qb = 0; qb < 2; ++qb)
#pragma unroll
            for (int r = 0; r < 4; ++r) {
              const int ri = c * 128 + kb * 16 + 4 * lg + r - (q0 + qb * 16 + fr);
              float v;
              if (c == 1) v = S[kb][qb][r] + bias[ri];
              else { const bool valid = (ri >= 0) && (ri <= 256); v = valid ? S[kb][qb][r] + bias[valid ? ri : 0] : -1e30f; }
              S[kb][qb][r] = v; cmax[qb] = fmaxf(cmax[qb], v);
            }
#pragma unroll
        for (int qb = 0; qb < 2; ++qb) {
          cmax[qb] = fmaxf(cmax[qb], __shfl_xor(cmax[qb], 16)); cmax[qb] = fmaxf(cmax[qb], __shfl_xor(cmax[qb], 32));
          const float mn = fmaxf(mrun[qb], cmax[qb]), alpha = __expf(mrun[qb] - mn);
          mrun[qb] = mn; lpart[qb] *= alpha;
#pragma unroll
          for (int mb = 0; mb < 4; ++mb) O[mb][qb] = O[mb][qb] * alpha;
          float ps = 0.f;
#pragma unroll
          for (int kb = 0; kb < 8; ++kb)
#pragma unroll
            for (int r = 0; r < 4; ++r) { const float e = __expf(S[kb][qb][r] - mn); S[kb][qb][r] = e; ps += e; }
          lpart[qb] += ps;
        }
#pragma unroll
        for (int kk = 0; kk < 4; ++kk) {
          const int kb0 = 2 * kk, kb1 = 2 * kk + 1;
          const bool act = (c == 0) ? (16 * kb1 + 15 >= q0) : ((c == 2) ? (16 * kb0 <= q0 + 31) : true);
          if (act) {
            uint4 pf[2];
#pragma unroll
            for (int qb = 0; qb < 2; ++qb) pf[qb] = make_uint4(pk2(S[kb0][qb][0], S[kb0][qb][1]), pk2(S[kb0][qb][2], S[kb0][qb][3]), pk2(S[kb1][qb][0], S[kb1][qb][1]), pk2(S[kb1][qb][2], S[kb1][qb][3]));
#pragma unroll
            for (int mb = 0; mb < 4; ++mb) {
              const uint2 v0 = lds_tr16(sV + (c * 128 + kb0 * 16 + 4 * lg + tq) * KSTR + mb * 16 + 4 * tp);
              const uint2 v1r = lds_tr16(sV + (c * 128 + kb1 * 16 + 4 * lg + tq) * KSTR + mb * 16 + 4 * tp);
              const uint4 vf = make_uint4(v0.x, v0.y, v1r.x, v1r.y);
              O[mb][0] = mfma16(vf, pf[0], O[mb][0]);
              O[mb][1] = mfma16(vf, pf[1], O[mb][1]);
            }
          }
        }
      }
#pragma unroll
      for (int qb = 0; qb < 2; ++qb) {
        float lt = lpart[qb]; lt += __shfl_xor(lt, 16); lt += __shfl_xor(lt, 32);
        const float inv = 1.0f / lt;
#pragma unroll
        for (int mb = 0; mb < 4; ++mb) {
          uint2 w; w.x = pk2(O[mb][qb][0] * inv, O[mb][qb][1] * inv); w.y = pk2(O[mb][qb][2] * inv, O[mb][qb][3] * inv);
          *(uint2*)(ao + (tok0 + qb * 16 + fr) * DM + head * 64 + mb * 16 + 4 * lg) = w;
        }
      }
    }
  }
}

struct EpiInproj {
  u16* zb; u16* a2; const f32x2* rope;
  __device__ __forceinline__ void operator()(const f32x4 (&acc)[2][2][4][2], const pg8::Unit& u, int wr, int wc, int fr, int fq) const {
    const int seg = u.pn >> 1;
#pragma unroll
    for (int ai = 0; ai < 2; ++ai)
#pragma unroll
      for (int m = 0; m < 4; ++m) {
        const int row = u.pm * 256 + ai * 128 + wr * 64 + m * 16 + fr;
        if (seg < 2) {
          const int d = 16 * wc + 4 * fq;
          const f32x2* cs = rope + (size_t)(row & (SEQ - 1)) * 64 + d;
          const f32x4 c01 = *(const f32x4*)cs, c23 = *(const f32x4*)(cs + 2);
          const float cv[4] = {c01[0], c01[2], c23[0], c23[2]}, sv[4] = {c01[1], c01[3], c23[1], c23[3]};
          const float sc = seg == 1 ? 0.08838834764831845f : 1.0f;
#pragma unroll
          for (int bj = 0; bj < 2; ++bj) {
            const f32x4 x1 = acc[ai][bj][m][0], x2 = acc[ai][bj][m][1];
            float o1[4], o2[4];
#pragma unroll
            for (int r = 0; r < 4; ++r) { o1[r] = (x1[r] * cv[r] - x2[r] * sv[r]) * sc; o2[r] = (x1[r] * sv[r] + x2[r] * cv[r]) * sc; }
            u16* dst = zb + (size_t)seg * T_TOK * 512 + (size_t)row * 512 + ((u.pn & 1) * 2 + bj) * 128 + d;
            uint2 w; w.x = pk2(o1[0], o1[1]); w.y = pk2(o1[2], o1[3]); *(uint2*)dst = w;
            w.x = pk2(o2[0], o2[1]); w.y = pk2(o2[2], o2[3]); *(uint2*)(dst + 64) = w;
          }
        } else {
#pragma unroll
          for (int bj = 0; bj < 2; ++bj)
#pragma unroll
            for (int n = 0; n < 2; ++n) {
              const int col = u.pn * 256 + bj * 128 + wc * 32 + n * 16 + 4 * fq;
              const f32x4 v = acc[ai][bj][m][n];
              uint2 w; w.x = pk2(v[0], v[1]); w.y = pk2(v[2], v[3]);
              if (seg < 4) *(uint2*)(zb + (size_t)seg * T_TOK * 512 + (size_t)row * 512 + (col - seg * 512)) = w;
              else { const int ch = col - 2048, gi = ch >> 4, c = ch & 15; *(uint2*)(a2 + ((size_t)gi * 512 + (row >> 5)) * 768 + (row & 31) * 16 + c) = w; }
            }
        }
      }
  }
};
__device__ __forceinline__ void phase_inproj(const P& p, LAS unsigned char* lds) {
  pg8::DenseOrder S; S.init(p.ws + WS_XB, DM, p.ws + WS_WIN, T_TOK, 2560, DM);
  EpiInproj E{(u16*)(p.ws + WS_Z), (u16*)(p.ws + WS_A2), (const f32x2*)(p.ws + WS_ROPE)};
  pg8::gemm_phase<EpiInproj, pg8::DenseOrder, G_ALIGN, G_SP2>(lds, DM, S, E);
}
struct EpiS5E {
  float* E_;
  __device__ __forceinline__ void operator()(const f32x4 (&acc)[2][2][4][2], const pg8::Unit& u, int wr, int wc, int fr, int fq) const {
#pragma unroll
    for (int ai = 0; ai < 2; ++ai)
#pragma unroll
      for (int m = 0; m < 4; ++m) {
        const int row = u.pm * 256 + ai * 128 + wr * 64 + m * 16 + fr;
#pragma unroll
        for (int bj = 0; bj < 2; ++bj)
#pragma unroll
          for (int n = 0; n < 2; ++n) *(f32x4*)(E_ + ((size_t)u.e * 512 + row) * 256 + bj * 128 + wc * 32 + n * 16 + 4 * fq) = acc[ai][bj][m][n];
      }
  }
};
__device__ __forceinline__ void phase_s5_egemm(const P& p, LAS unsigned char* lds) {
  pg8::GroupOrder S; S.init(p.ws + WS_A2, 768, (size_t)512 * 768, p.ws + WS_WET, (size_t)256 * 512, 32, 512, 256, 512);
  EpiS5E E{(float*)(p.ws + WS_E)};
  pg8::gemm_phase<EpiS5E, pg8::GroupOrder, G_ALIGN, G_SP2>(lds, 512, S, E);
}
struct EpiS5Y {
  u16* yg;
  __device__ __forceinline__ void operator()(const f32x4 (&acc)[2][2][4][2], const pg8::Unit& u, int wr, int wc, int fr, int fq) const {
#pragma unroll
    for (int ai = 0; ai < 2; ++ai)
#pragma unroll
      for (int m = 0; m < 4; ++m) {
        const int row = u.pm * 256 + ai * 128 + wr * 64 + m * 16 + fr;
#pragma unroll
        for (int bj = 0; bj < 2; ++bj)
#pragma unroll
          for (int n = 0; n < 2; ++n) {
            const int col = u.pn * 256 + bj * 128 + wc * 32 + n * 16 + 4 * fq;
            const f32x4 v = acc[ai][bj][m][n];
            uint2 w; w.x = pk2(gelu_tanh(v[0]), gelu_tanh(v[1])); w.y = pk2(gelu_tanh(v[2]), gelu_tanh(v[3]));
            *(uint2*)(yg + ((size_t)row * 32 + (col >> 4)) * 512 + u.e * 16 + (col & 15)) = w;
          }
      }
  }
};
__device__ __forceinline__ void phase_s5_ygemm(const P& p, LAS unsigned char* lds) {
  pg8::GroupOrder S; S.init(p.ws + WS_A2, 768, (size_t)512 * 768, p.ws + WS_BTY, (size_t)512 * 768, 32, 512, 512, 768);
  EpiS5Y E{(u16*)(p.ws + WS_YGELU)};
  pg8::gemm_phase<EpiS5Y, pg8::GroupOrder, G_ALIGN, G_SP2>(lds, 768, S, E);
}
struct EpiGlu {
  const u16* yg; const float* bglu; u16* ycat;
  __device__ __forceinline__ void operator()(const f32x4 (&acc)[2][2][4][2], const pg8::Unit& u, int wr, int wc, int fr, int fq) const {
#pragma unroll
    for (int ai = 0; ai < 2; ++ai)
#pragma unroll
      for (int m = 0; m < 4; ++m) {
        const int row = u.pm * 256 + ai * 128 + wr * 64 + m * 16 + fr;
#pragma unroll
        for (int bj = 0; bj < 2; ++bj)
#pragma unroll
          for (int n = 0; n < 2; ++n) {
            const int col = u.pn * 256 + bj * 128 + wc * 32 + n * 16 + 4 * fq;
            const f32x4 v = acc[ai][bj][m][n];
            const uint2 yv = *(const uint2*)(yg + (size_t)row * 512 + col);
            const f32x4 bb = *(const f32x4*)(bglu + col);
            uint2 w;
            w.x = pk2(lo16(yv.x) * sigmoidf_(v[0] + bb[0]), hi16(yv.x) * sigmoidf_(v[1] + bb[1]));
            w.y = pk2(lo16(yv.y) * sigmoidf_(v[2] + bb[2]), hi16(yv.y) * sigmoidf_(v[3] + bb[3]));
            *(uint2*)(ycat + (size_t)row * DM + 512 + col) = w;
          }
      }
  }
};
__device__ __forceinline__ void phase_glu(const P& p, LAS unsigned char* lds) {
  pg8::DenseOrder S; S.init(p.ws + WS_YGELU, 512, p.ws + WS_WGLU, T_TOK, 512, 512);
  EpiGlu E{(const u16*)(p.ws + WS_YGELU), p.b_glu, (u16*)(p.ws + WS_YCAT)};
  pg8::gemm_phase<EpiGlu, pg8::DenseOrder, G_ALIGN, G_SP2>(lds, 512, S, E);
}
struct EpiResid {
  const float* xin; float* xout;
  __device__ __forceinline__ void operator()(const f32x4 (&acc)[2][2][4][2], const pg8::Unit& u, int wr, int wc, int fr, int fq) const {
#pragma unroll
    for (int ai = 0; ai < 2; ++ai)
#pragma unroll
      for (int m = 0; m < 4; ++m) {
        const int row = u.pm * 256 + ai * 128 + wr * 64 + m * 16 + fr;
#pragma unroll
        for (int bj = 0; bj < 2; ++bj)
#pragma unroll
          for (int n = 0; n < 2; ++n) {
            const size_t o = (size_t)row * DM + u.pn * 256 + bj * 128 + wc * 32 + n * 16 + 4 * fq;
            const f32x4 xv = *(const f32x4*)(xin + o);
            *(f32x4*)(xout + o) = xv + acc[ai][bj][m][n];
          }
      }
  }
};
__device__ __forceinline__ void phase_outproj(const P& p, const void* Wt, const float* xin, float* xout, LAS unsigned char* lds) {
  pg8::DenseOrder S; S.init(p.ws + WS_YCAT, DM, Wt, T_TOK, DM, DM);
  EpiResid E{xin, xout};
  pg8::gemm_phase<EpiResid, pg8::DenseOrder, G_ALIGN, G_SP2>(lds, DM, S, E);
}
struct EpiQkv {
  u16 *q1, *k1, *v1;
  __device__ __forceinline__ void operator()(const f32x4 (&acc)[2][2][4][2], const pg8::Unit& u, int wr, int wc, int fr, int fq) const {
#pragma unroll
    for (int ai = 0; ai < 2; ++ai)
#pragma unroll
      for (int m = 0; m < 4; ++m) {
        const int row = u.pm * 256 + ai * 128 + wr * 64 + m * 16 + fr;
#pragma unroll
        for (int bj = 0; bj < 2; ++bj)
#pragma unroll
          for (int n = 0; n < 2; ++n) {
            const int col = u.pn * 256 + bj * 128 + wc * 32 + n * 16 + 4 * fq;
            const f32x4 v = acc[ai][bj][m][n];
            uint2 w;
            if (u.pn < 4) { w.x = pk2(v[0] * 0.125f, v[1] * 0.125f); w.y = pk2(v[2] * 0.125f, v[3] * 0.125f); *(uint2*)(q1 + (size_t)row * DM + col) = w; }
            else {
              w.x = pk2(v[0], v[1]); w.y = pk2(v[2], v[3]);
              if (u.pn == 4) *(uint2*)(k1 + (size_t)row * 256 + (col - 1024)) = w; else *(uint2*)(v1 + (size_t)row * 256 + (col - 1280)) = w;
            }
          }
      }
  }
};
__device__ __forceinline__ void phase_qkv(const P& p, LAS unsigned char* lds) {
  pg8::DenseOrder S; S.init(p.ws + WS_XB, DM, p.ws + WS_WQKV, T_TOK, 1536, DM);
  EpiQkv E{(u16*)(p.ws + WS_Z), (u16*)(p.ws + WS_Z + 32 * MB), (u16*)(p.ws + WS_Z + 40 * MB)};
  pg8::gemm_phase<EpiQkv, pg8::DenseOrder, G_ALIGN, G_SP2>(lds, DM, S, E);
}
__device__ __forceinline__ void phase_moe_plan(const P& p, int layer, char* smem) {
  if (blockIdx.x != 0) return;
  using pg8::PLAN_STRIDE;
  const int tid = tidx();
  const int* cnt = (const int*)(p.ws + WS_CNT) + layer * 32;
  int* plan_n = (int*)(p.ws + WS_PLAN + layer * 65536); int4* plan = (int4*)(p.ws + WS_PLAN + layer * 65536 + 256);
  int* sc = (int*)smem;
  int* ecum = sc + 32; int* ebase = ecum + 32; int* ehb = ebase + 32; int* efull = ehb + 32; int* tot = efull + 32;
  int* sstart = tot + 8; int* sfstart = sstart + 8; int* cntF = sfstart + 8; int* cntR = cntF + 8;
  unsigned* keyR = (unsigned*)(cntR + 8);
  constexpr int NN = 4;
  __syncthreads();
  if (tid < 32) sc[tid] = cnt[tid];
  if (tid < 8) { sstart[tid] = 0x7fffffff; sfstart[tid] = 0; cntF[tid] = 0; cntR[tid] = 0; }
  if (tid < 128) keyR[tid] = 0xffffffffu;
  __syncthreads();
  if (tid == 0) {
    int cum = 0, ub = 0, hb = 0, fb = 0;
    for (int e = 0; e < 32; ++e) {
      const int c = sc[e], fl = c >> 8, rem = c & 255, rc = (rem + 63) >> 6, ntl = fl + (rem ? 1 : 0);
      ecum[e] = cum; ebase[e] = ub; ehb[e] = hb; efull[e] = fb;
      cum += (fl * 4 + rc) * NN; ub += ntl * NN; hb += ntl * 256; fb += fl * NN;
    }
    tot[0] = cum > 0 ? cum : 1; tot[1] = ub;
  }
  __syncthreads();
  const int total = tot[0], nunits = tot[1] < 1024 ? tot[1] : 1024;
  int4 en[2]; int ux[2], uF[2]; unsigned ukr[2]; bool ufull[2], uval[2];
#pragma unroll
  for (int q = 0; q < 2; ++q) {
    const int u = tid + q * NTHR;
    uval[q] = u < nunits; ux[q] = 0; uF[q] = 0; ukr[q] = 0; ufull[q] = true; en[q] = make_int4(0, 0, 0, 0);
    if (uval[q]) {
      int e = 0;
      for (int j = 1; j < 32; ++j) if (ebase[j] <= u) e = j;
      const int c = sc[e], fl = c >> 8, rem = c & 255, rc = (rem + 63) >> 6, ntl = fl + (rem ? 1 : 0);
      const int local = u - ebase[e], ct = local / ntl, rt = local - ct * ntl;
      const int cum = ecum[e] + ct * (fl * 4 + rc) + rt * 4;
      const bool isfull = rt < fl;
      int x = (cum * 8) / total; if (x > 7) x = 7;
      ux[q] = x; ufull[q] = isfull; uF[q] = efull[e] + ct * fl + (rt < fl ? rt : fl);
      en[q] = make_int4(e | (rt << 8) | (ct << 16), c, ehb[e], 0);
      atomicMin(&sstart[x], u);
      if (isfull) atomicAdd(&cntF[x], 1);
      else { atomicAdd(&cntR[x], 1); ukr[q] = ((unsigned)x << 16) | ((unsigned)(4 - rc) << 12) | (unsigned)(e * NN + ct); keyR[e * NN + ct] = ukr[q]; }
    }
  }
  __syncthreads();
#pragma unroll
  for (int q = 0; q < 2; ++q) if (uval[q] && (tid + q * NTHR) == sstart[ux[q]]) sfstart[ux[q]] = uF[q];
  __syncthreads();
#pragma unroll
  for (int q = 0; q < 2; ++q) {
    if (uval[q]) {
      const int x = ux[q];
      int pos;
      if (ufull[q]) pos = uF[q] - sfstart[x];
      else { pos = cntF[x]; for (int v = 0; v < 128; ++v) { const unsigned kv = keyR[v]; pos += ((kv >> 16) == (unsigned)x && kv < ukr[q]) ? 1 : 0; } }
      if (pos < PLAN_STRIDE) plan[x * PLAN_STRIDE + pos] = en[q];
    }
  }
  if (tid < 8) { const int n = cntF[tid] + cntR[tid]; plan_n[tid] = n < PLAN_STRIDE ? n : PLAN_STRIDE; }
  __syncthreads();
}
struct EpiMoe1 {
  u16* hbuf;
  __device__ __forceinline__ void operator()(const f32x4 (&acc)[2][2][4][2], const pg8::Unit& u, int wr, int wc, int fr, int fq) const {
#pragma unroll
    for (int ai = 0; ai < 2; ++ai)
#pragma unroll
      for (int m = 0; m < 4; ++m) {
        const int row = u.pm * 256 + ai * 128 + wr * 64 + m * 16 + fr;
        if (row < u.cnt) {
#pragma unroll
          for (int bj = 0; bj < 2; ++bj) {
            const f32x4 g = acc[ai][bj][m][0], up = acc[ai][bj][m][1];
            uint2 w; w.x = pk2(g[0] * sigmoidf_(g[0]) * up[0], g[1] * sigmoidf_(g[1]) * up[1]); w.y = pk2(g[2] * sigmoidf_(g[2]) * up[2], g[3] * sigmoidf_(g[3]) * up[3]);
            *(uint2*)(hbuf + (size_t)(u.hbase + row) * 512 + 16 * (8 * u.pn + 4 * bj + wc) + 4 * fq) = w;
          }
        }
      }
  }
};
__device__ __forceinline__ void phase_moe1(const P& p, int layer, LAS unsigned char* lds) {
  pg8::PlanOrder S; S.init(p.ws + WS_PLAN + layer * 65536, (const int*)(p.ws + WS_LIST), p.ws + WS_XB, DM, p.ws + (layer ? WS_MW1 : WS_MW0), (size_t)DM * DM, DM, true);
  EpiMoe1 E{(u16*)(p.ws + WS_H)};
  pg8::gemm_phase<EpiMoe1, pg8::PlanOrder, G_ALIGN, G_SP2>(lds, DM, S, E);
}
struct EpiMoe2 {
  const int* list; const float* gate; u16* slots;
  __device__ __forceinline__ void operator()(const f32x4 (&acc)[2][2][4][2], const pg8::Unit& u, int wr, int wc, int fr, int fq) const {
#pragma unroll
    for (int ai = 0; ai < 2; ++ai)
#pragma unroll
      for (int m = 0; m < 4; ++m) {
        const int row = u.pm * 256 + ai * 128 + wr * 64 + m * 16 + fr;
        if (row < u.cnt) {
          const int asg = list[(size_t)u.e * CAP + row];
          const float gt = gate[asg];
#pragma unroll
          for (int bj = 0; bj < 2; ++bj)
#pragma unroll
            for (int n = 0; n < 2; ++n) {
              const f32x4 v = acc[ai][bj][m][n];
              uint2 w; w.x = pk2(gt * v[0], gt * v[1]); w.y = pk2(gt * v[2], gt * v[3]);
              *(uint2*)(slots + (size_t)asg * DM + u.pn * 256 + bj * 128 + wc * 32 + n * 16 + 4 * fq) = w;
            }
        }
      }
  }
};
__device__ __forceinline__ void phase_moe2(const P& p, int layer, LAS unsigned char* lds) {
  pg8::PlanOrder S; S.init(p.ws + WS_PLAN + layer * 65536, (const int*)(p.ws + WS_LIST), p.ws + WS_H, 512, p.ws + (layer ? WS_MW1 : WS_MW0) + 64 * MB, (size_t)DM * 512, 512, false);
  EpiMoe2 E{(const int*)(p.ws + WS_LIST), (const float*)(p.ws + WS_GATE), (u16*)(p.ws + WS_INC)};
  pg8::gemm_phase<EpiMoe2, pg8::PlanOrder, G_ALIGN, G_SP2>(lds, 512, S, E);
}

#define XB_TMO      128
#define XB_XCNT(j)  (256  + 64 * (j))
#define XB_XSUB(j)  (1280 + 64 * (j))
#define XB_XGEN(j)  (2304 + 64 * (j))
#define XB_TOP      3328
#define XB_TOPGEN   3392
#define XCD_BAR_WORDS 3456
#define XB_SPIN_CAP (1u << 22)
__device__ __forceinline__ unsigned xb_ld(unsigned* p)              { return __hip_atomic_load(p, __ATOMIC_RELAXED, __HIP_MEMORY_SCOPE_AGENT); }
__device__ __forceinline__ unsigned xb_add(unsigned* p, unsigned v) { return __hip_atomic_fetch_add(p, v, __ATOMIC_RELAXED, __HIP_MEMORY_SCOPE_AGENT); }
__device__ __forceinline__ unsigned xb_xcc_id() { return (unsigned)__builtin_amdgcn_s_getreg((3 << 11) | 20) & 0xFu; }
#define XB_SPIN(cond, bar) do { unsigned _sp = 0; while (cond) { __builtin_amdgcn_s_sleep(1); \
    if ((++_sp & 255u) == 0u) { if (xb_ld(&(bar)[XB_TMO])) break; if (_sp > XB_SPIN_CAP) { atomicAdd(&(bar)[XB_TMO], 1u); break; } } } } while (0)
struct XcdBarrier { unsigned* bar; unsigned x; volatile LAS unsigned* st; };
__device__ __forceinline__ XcdBarrier xcd_barrier_post(unsigned* bar, volatile LAS unsigned* st) {
  XcdBarrier b; b.bar = bar; b.x = xb_xcc_id(); b.st = st;
  if (tidx() == 0) (void)xb_add(&bar[XB_XCNT(b.x)], 1u);
  return b;
}
__device__ __forceinline__ void xcd_barrier_complete(unsigned* bar, unsigned x, unsigned& nloc, unsigned& nx) {
  const unsigned G = gridDim.x * gridDim.y * gridDim.z;
  unsigned sum, cnt, mine, sp = 0u;
  for (;;) {
    sum = 0u; cnt = 0u; mine = 0u;
#pragma unroll
    for (unsigned j = 0; j < 16; ++j) { const unsigned c = xb_ld(&bar[XB_XCNT(j)]); sum += c; cnt += (c > 0u) ? 1u : 0u; mine = (j == x) ? c : mine; }
    if (sum == G) break;
    __builtin_amdgcn_s_sleep(1);
    if ((++sp & 255u) == 0u) { if (xb_ld(&bar[XB_TMO])) break; if (sp > XB_SPIN_CAP) { atomicAdd(&bar[XB_TMO], 1u); break; } }
  }
  nloc = mine > 0u ? mine : 1u; nx = cnt > 0u ? cnt : 1u;
}
__device__ __forceinline__ void xcd_barrier(const XcdBarrier& b) {
  asm volatile("s_waitcnt vmcnt(0)" ::: "memory");
  __syncthreads();
  if (tidx() == 0) {
    unsigned* bar = b.bar;
    __builtin_amdgcn_s_waitcnt(0);
    unsigned nloc = b.st[0], nx = b.st[1];
    if (nloc == 0u) { xcd_barrier_complete(bar, b.x, nloc, nx); b.st[0] = nloc; b.st[1] = nx; }
    const unsigned old = xb_add(&bar[XB_XSUB(b.x)], 1u);
    const unsigned gen = old / nloc;
    if (old + 1u == (gen + 1u) * nloc) {
      __builtin_amdgcn_fence(__ATOMIC_RELEASE, "agent");
      asm volatile("s_waitcnt vmcnt(0)" ::: "memory");
      const unsigned og = xb_add(&bar[XB_TOP], 1u);
      const unsigned tg = og / nx;
      if (og + 1u == (tg + 1u) * nx) xb_add(&bar[XB_TOPGEN], 1u);
      else XB_SPIN(xb_ld(&bar[XB_TOPGEN]) == tg, bar);
      __builtin_amdgcn_fence(__ATOMIC_ACQUIRE, "agent");
      xb_add(&bar[XB_XGEN(b.x)], 1u);
      asm volatile("s_waitcnt vmcnt(0)" ::: "memory");
    } else {
      XB_SPIN(xb_ld(&bar[XB_XGEN(b.x)]) == gen, bar);
      __builtin_amdgcn_fence(__ATOMIC_ACQUIRE, "agent");
      asm volatile("s_waitcnt vmcnt(0)" ::: "memory");
    }
  }
  __syncthreads();
}

constexpr int NPHASE = 20;
#ifndef C0A
#define C0A 25
#define C0B 70
#define C1A 65
#endif
constexpr int LDS_BYTES = 147456;
__device__ __forceinline__ void run_phase(const P& p, int ph, char* smem, LAS unsigned char* lds) {
  float* xa = (float*)(p.ws + WS_XA);
  const u16* slots = (const u16*)(p.ws + WS_INC);
  switch (ph) {
    case 0: phase_rowpass(p, p.x, nullptr, nullptr, p.norm_mix_g, -1, nullptr, smem); phase_prep(p); __syncthreads(); phase_conv_dense(p, smem); break;
    case 1: phase_inproj(p, lds); phase_s5_ktab(p); phase_s5_fill_bc(p); phase_conv_moe(p, 0, 0, cq(C0A), 128, 128, smem); break;
    case 2: phase_ret_inc_mfma(p, smem); __syncthreads(); phase_s5_egemm(p, lds); phase_s5_fill_a(p); break;
    case 3: phase_ret_scan16(p); phase_s5_carry(p); break;
    case 4: phase_ret_out_mfma(p, smem); __syncthreads(); phase_s5_ygemm(p, lds); break;
    case 5: phase_glu(p, lds); phase_conv_moe(p, 0, cq(C0A), cq(C0B), 128, 128, smem); break;
    case 6: phase_outproj(p, p.ws + WS_WOUT, p.x, xa, lds); break;
    case 7: phase_rowpass(p, xa, nullptr, nullptr, p.norm_ffn_g, 0, nullptr, smem); break;
    case 8: phase_moe_plan(p, 0, smem); phase_conv_moe(p, 0, cq(C0B), CONV_ITEMS, 1, 255, smem); break;
    case 9: phase_moe1(p, 0, lds); break;
    case 10: phase_moe2(p, 0, lds); break;
    case 11: phase_rowpass(p, xa, slots, xa, p.norm_mix_g + DM, -1, nullptr, smem); break;
    case 12: phase_qkv(p, lds); phase_conv_moe(p, 1, 0, cq(C1A), 128, 128, smem); break;
    case 13: phase_attn(p, smem); break;
    case 14: phase_outproj(p, p.ws + WS_WO, xa, xa, lds); break;
    case 15: phase_rowpass(p, xa, nullptr, nullptr, p.norm_ffn_g + DM, 1, nullptr, smem); break;
    case 16: phase_moe_plan(p, 1, smem); phase_conv_moe(p, 1, cq(C1A), CONV_ITEMS, 1, 255, smem); break;
    case 17: phase_moe1(p, 1, lds); break;
    case 18: phase_moe2(p, 1, lds); break;
    case 19: phase_rowpass(p, xa, slots, nullptr, p.norm_final_g, -1, p.out, smem); break;
    default: break;
  }
}

extern __shared__ __attribute__((aligned(16))) char dyn_smem[];

template <int PH> __device__ __forceinline__ void mega_steps(const P& p, char* smem, LAS unsigned char* lds, cg::grid_group& grid, const XcdBarrier& xb) {
  run_phase(p, PH, smem, lds);
  if constexpr (PH + 1 < NPHASE) {
    if constexpr (PH == 0) grid.sync(); else xcd_barrier(xb);
    mega_steps<PH + 1>(p, smem, lds, grid, xb);
  }
}
__global__ void __launch_bounds__(NTHR, 2) k_mega(P p) {
  cg::grid_group grid = cg::this_grid();
  LAS unsigned char* lds = (LAS unsigned char*)dyn_smem;
  volatile LAS unsigned* st = (volatile LAS unsigned*)(lds + LDS_BYTES - 16);
  if (tidx() == 0) { st[0] = 0u; st[1] = 0u; }
  __syncthreads();
  const XcdBarrier xb = xcd_barrier_post((unsigned*)(p.ws + WS_BAR), st);
  mega_steps<0>(p, dyn_smem, lds, grid, xb);
}

extern "C" void kernel_launch(void* const* d_in, const int* in_sizes, int n_in, void* d_out, int out_size, void* d_ws, size_t ws_size, hipStream_t stream) {
  static int grid_blocks = 0;
  if (grid_blocks == 0) {
    if (n_in != 28 || out_size != T_TOK * DM || ws_size < WS_END) { fprintf(stderr, "kernel_launch: unexpected problem (n_in %d out %d ws %zu need %zu)\n", n_in, out_size, ws_size, (size_t)WS_END); grid_blocks = -1; return; }
    int dev = 0, cus = 0, per_cu = 0;
    (void)hipGetDevice(&dev);
    (void)hipDeviceGetAttribute(&cus, hipDeviceAttributeMultiprocessorCount, dev);
    const void* fn = (const void*)k_mega;
    if (hipFuncSetAttribute(fn, hipFuncAttributeMaxDynamicSharedMemorySize, LDS_BYTES) != hipSuccess) { fprintf(stderr, "kernel_launch: hipFuncSetAttribute failed\n"); }
    if (hipOccupancyMaxActiveBlocksPerMultiprocessor(&per_cu, fn, NTHR, LDS_BYTES) != hipSuccess || per_cu < 1) { fprintf(stderr, "kernel_launch: occupancy query failed (%d)\n", per_cu); per_cu = 1; }
    (void)hipGetLastError();
    if (per_cu > 1) per_cu = 1;
    grid_blocks = cus * per_cu;
    fprintf(stderr, "kernel_launch: cus %d per_cu %d grid %d\n", cus, per_cu, grid_blocks);
  }
  if (grid_blocks < 0) return;
  P p{};
  const float** pp = (const float**)&p;
  for (int i = 0; i < 28; ++i) pp[i] = (const float*)d_in[i];
  p.out = (float*)d_out; p.ws = (char*)d_ws;
  (void)hipMemsetAsync((char*)d_ws + WS_BAR, 0, XCD_BAR_WORDS * 4, stream);
  void* args[] = {&p};
  hipError_t e = hipLaunchCooperativeKernel((const void*)k_mega, dim3(grid_blocks), dim3(NTHR), args, LDS_BYTES, stream);
  if (e != hipSuccess) fprintf(stderr, "cooperative launch failed: %s (grid %d)\n", hipGetErrorString(e), grid_blocks);
}
```

```cpp
#include <hip/hip_runtime.h>
#include <hip/hip_cooperative_groups.h>
#include <cstdio>
#include <cstdint>
namespace cg = cooperative_groups;

#define USE_FP16 1
#define LAS __attribute__((address_space(3)))

typedef unsigned short u16;
typedef float f32x4 __attribute__((ext_vector_type(4)));
typedef float f32x2 __attribute__((ext_vector_type(2)));
typedef _Float16 f16x8 __attribute__((ext_vector_type(8)));

constexpr int T_TOK = 16384, DM = 1024, SEQ = 2048, NBATCH = 8;
constexpr int CAP = 32768;
constexpr int NTHR = 512, NWAVE = NTHR / 64;

constexpr size_t MB = 1024ull * 1024ull;
constexpr size_t WS_XA    = 0;
constexpr size_t WS_XB    = 64 * MB;
constexpr size_t WS_Z     = 96 * MB;
constexpr size_t WS_A2    = 160 * MB;
constexpr size_t WS_BTY   = 184 * MB;
constexpr size_t WS_MW1   = 160 * MB;
constexpr size_t WS_WET   = 208 * MB;
constexpr size_t WS_E     = 216 * MB;
constexpr size_t WS_KTAB  = 232 * MB;
constexpr size_t WS_SP16  = 234 * MB;
constexpr size_t WS_INC   = 266 * MB;
constexpr size_t WS_YCAT  = 330 * MB;
constexpr size_t WS_YGELU = 362 * MB;
constexpr size_t WS_H     = 330 * MB;
constexpr size_t WS_LIST  = 378 * MB;
constexpr size_t WS_GATE  = 382 * MB;
constexpr size_t WS_ROPE  = 383 * MB;
constexpr size_t WS_CNT   = 384 * MB;
constexpr size_t WS_WR16  = 385 * MB;
constexpr size_t WS_BAR   = 386 * MB;
constexpr size_t WS_PLAN  = 386 * MB + 512 * 1024;
constexpr size_t WS_WIN   = 387 * MB;
constexpr size_t WS_WGLU  = 392 * MB;
constexpr size_t WS_WOUT  = 393 * MB;
constexpr size_t WS_WQKV  = 395 * MB;
constexpr size_t WS_WO    = 398 * MB;
constexpr size_t WS_LAMT  = 400 * MB;
constexpr size_t WS_MW0   = 402 * MB;
constexpr size_t WS_END   = 498 * MB;

struct P {
  const float *x, *norm_mix_g, *norm_ffn_g, *norm_final_g, *w_in, *ret_decay, *a_re, *a_im, *log_step, *b_re, *b_im, *c_re, *c_im,
      *s5d, *w_glu, *b_glu, *w_out, *w_qkv, *sink, *w_o, *rel_bias, *w_group, *b_group, *w_er, *b_er, *w_gate, *w_up, *w_down;
  float* out;
  char* ws;
};

__device__ __forceinline__ u16 f2h(float f) { _Float16 h = (_Float16)f; return __builtin_bit_cast(u16, h); }
__device__ __forceinline__ float h2f(u16 h) { return (float)__builtin_bit_cast(_Float16, h); }
__device__ __forceinline__ unsigned pk2(float a, float b) { return (unsigned)f2h(a) | ((unsigned)f2h(b) << 16); }
__device__ __forceinline__ float lo16(unsigned w) { return h2f((u16)(w & 0xffffu)); }
__device__ __forceinline__ float hi16(unsigned w) { return h2f((u16)(w >> 16)); }
__device__ __forceinline__ f32x4 mfma16(uint4 a, uint4 b, f32x4 c) {
  return __builtin_amdgcn_mfma_f32_16x16x32_f16(__builtin_bit_cast(f16x8, a), __builtin_bit_cast(f16x8, b), c, 0, 0, 0);
}
__device__ __forceinline__ float wave_sum(float v) {
#pragma unroll
  for (int o = 1; o < 64; o <<= 1) v += __shfl_xor(v, o);
  return v;
}
__device__ __forceinline__ float sigmoidf_(float x) { return 1.0f / (1.0f + __expf(-x)); }
__device__ __forceinline__ float gelu_tanh(float x) {
  const float u = 0.7978845608028654f * (x + 0.044715f * x * x * x);
  return 0.5f * x * (1.0f + tanhf(u));
}
#define LDS_WAIT() asm volatile("s_waitcnt lgkmcnt(0)" ::: "memory")
__device__ __forceinline__ int tidx() { int t = threadIdx.x; asm volatile("" : "+v"(t)); return t; }

namespace pg8 {
constexpr int BM = 256, BK = 64, HALF = 128, HTB = HALF * BK * 2, STAGE_BYTES = 8 * HTB, NXCD = 8, WGM = 8;
__device__ __forceinline__ int lds_byte(int r, int c) { const int st = (r >> 4) * 2 + (c >> 5), rr = r & 15, cc = c & 31, ob = rr * 64 + cc * 2; return st * 1024 + (ob ^ (((ob >> 9) & 1) << 5)); }
__device__ __forceinline__ void stage_rc(int b, int& R, int& C) { const int st = b / 1024, sb = b % 1024, swz = sb ^ (((sb >> 9) & 1) << 5); R = (st >> 1) * 16 + swz / 64; C = (st & 1) * 32 + (swz % 64) / 2; }

struct Unit { const char* a; const char* b; int pm, pn, e, cnt, hbase; };

template <class Epi, class Sched, bool ALIGN_EPI, bool SP2>
__device__ __forceinline__ void gemm_phase(LAS unsigned char* lds, const int K, const Sched& S, const Epi& E) {
    const int tid = tidx(), wid = __builtin_amdgcn_readfirstlane(tid >> 6), lane = tid & 63, wr = wid >> 2, wc = wid & 3, fr = lane & 15, fq = lane >> 4;
    const int nt = K / BK;
    int Rr[2], Cc[2];
    unsigned voffB[2];
#pragma unroll
    for (int i = 0; i < 2; ++i) { stage_rc(tid * 16 + i * 8192, Rr[i], Cc[i]); voffB[i] = (unsigned)(Rr[i] * K + Cc[i]) * 2u; }
    const size_t kstep = (size_t)(BK * 2);
    const size_t hstepB = (size_t)HALF * K * 2;
    const unsigned ldsw = (unsigned)wid * 1024u;
    const int aoff = lds_byte(wr * 64 + fr, fq * 8), boff = lds_byte(wc * 32 + fr, fq * 8);
#define PG8_SA(b, h) (((b) * 2 + (h)) * HTB)
#define PG8_SB(b, h) ((4 + (b) * 2 + (h)) * HTB)
#define PG8_STAGE(bufoff, gbase, voff) do { _Pragma("unroll") for (int _i = 0; _i < 2; ++_i) \
        __builtin_amdgcn_global_load_lds((const unsigned*)((const char*)(gbase) + (voff)[_i]), (LAS unsigned*)(lds + (bufoff) + ldsw + _i * 8192), 16, 0, 0); } while (0)
#define PG8_LDA(dst, b, h) do { _Pragma("unroll") for (int m = 0; m < 4; ++m) _Pragma("unroll") for (int k = 0; k < 2; ++k) dst[m][k] = *(const LAS f16x8*)(lds + PG8_SA(b, h) + aoff + m * 2048 + k * 1024); } while (0)
#define PG8_LDB(dst, b, h) do { _Pragma("unroll") for (int n = 0; n < 2; ++n) _Pragma("unroll") for (int k = 0; k < 2; ++k) dst[n][k] = *(const LAS f16x8*)(lds + PG8_SB(b, h) + boff + n * 2048 + k * 1024); } while (0)
#define PG8_MMA(ai, bj, At, Bt) do { if (128 * (ai) + 64 * wr >= urows) break; __builtin_amdgcn_s_setprio(1); _Pragma("unroll") for (int m = 0; m < 4; ++m) _Pragma("unroll") for (int n = 0; n < 2; ++n) _Pragma("unroll") for (int k = 0; k < 2; ++k) \
        acc[ai][bj][m][n] = __builtin_amdgcn_mfma_f32_16x16x32_f16(Bt[n][k], At[m][k], acc[ai][bj][m][n], 0, 0, 0); __builtin_amdgcn_s_setprio(0); } while (0)
#define PG8_WAIT_V(n) asm volatile("s_waitcnt vmcnt(" #n ")" ::: "memory")
#define PG8_WAIT_L(n) asm volatile("s_waitcnt lgkmcnt(" #n ")" ::: "memory")
#define PG8_BAR __builtin_amdgcn_s_barrier()
#define PG8_SCHED __builtin_amdgcn_sched_barrier(0)
    Unit cur, nxt; int ui = 0;
    if (!S.next(0, cur)) return;
    unsigned cv0[2], cv1[2], nv0[2], nv1[2];
#pragma unroll
    for (int i = 0; i < 2; ++i) { cv0[i] = S.a_voff(cur, 0, Rr[i], Cc[i]); cv1[i] = S.a_voff(cur, 1, Rr[i], Cc[i]); }
    f32x4 acc[2][2][4][2];
#pragma unroll
    for (int a = 0; a < 2; ++a)
#pragma unroll
        for (int b = 0; b < 2; ++b)
#pragma unroll
            for (int m = 0; m < 4; ++m)
#pragma unroll
                for (int n = 0; n < 2; ++n) acc[a][b][m][n] = (f32x4){0.f, 0.f, 0.f, 0.f};
    f16x8 At[4][2], B0[2][2], B1[2][2];
    const char* cA = cur.a; const char* cB = cur.b;
    int urows = S.rows(cur);
    if constexpr (SP2) {
        PG8_STAGE(PG8_SB(0, 0), cB, voffB); PG8_STAGE(PG8_SB(0, 1), cB + hstepB, voffB); PG8_STAGE(PG8_SA(0, 0), cA, cv0); PG8_STAGE(PG8_SA(0, 1), cA, cv1);
        if (wr == 1) PG8_BAR;
        PG8_WAIT_V(2); PG8_BAR;
        PG8_STAGE(PG8_SB(1, 0), cB + kstep, voffB); PG8_STAGE(PG8_SA(1, 0), cA + kstep, cv0); PG8_STAGE(PG8_SB(1, 1), cB + hstepB + kstep, voffB);
        PG8_WAIT_V(6); PG8_BAR;
    } else {
        PG8_STAGE(PG8_SB(0, 0), cB, voffB); PG8_STAGE(PG8_SA(0, 0), cA, cv0); PG8_STAGE(PG8_SB(0, 1), cB + hstepB, voffB); PG8_STAGE(PG8_SA(0, 1), cA, cv1);
        if (wr == 1) PG8_BAR;
        PG8_WAIT_V(4); PG8_BAR;
        PG8_STAGE(PG8_SB(1, 0), cB + kstep, voffB); PG8_STAGE(PG8_SA(1, 0), cA + kstep, cv0); PG8_STAGE(PG8_SB(1, 1), cB + hstepB + kstep, voffB);
        PG8_WAIT_V(6); PG8_BAR;
    }
    for (;;) {
        const bool has_next = S.next(ui + 1, nxt);
        if (has_next) {
#pragma unroll
            for (int i = 0; i < 2; ++i) { nv0[i] = S.a_voff(nxt, 0, Rr[i], Cc[i]); nv1[i] = S.a_voff(nxt, 1, Rr[i], Cc[i]); }
        } else {
            nxt = cur;
#pragma unroll
            for (int i = 0; i < 2; ++i) { nv0[i] = cv0[i]; nv1[i] = cv1[i]; }
        }
        const char* nA = nxt.a; const char* nB = nxt.b;
        for (int t = 0; t < nt; t += 2) {
            const bool last = (t == nt - 2);
            const char* a1 = cA + (size_t)(t + 1) * kstep;
            const char* a2 = last ? nA : cA + (size_t)(t + 2) * kstep; const char* b2 = last ? nB : cB + (size_t)(t + 2) * kstep;
            const char* a3 = a2 + kstep; const char* b3 = b2 + kstep;
            unsigned v0[2], v1[2];
#pragma unroll
            for (int i = 0; i < 2; ++i) { v0[i] = last ? nv0[i] : cv0[i]; v1[i] = last ? nv1[i] : cv1[i]; }
            if constexpr (SP2) {
            PG8_LDB(B0, 0, 0); PG8_LDB(B1, 0, 1); PG8_SCHED; PG8_LDA(At, 0, 0); PG8_STAGE(PG8_SA(1, 1), a1, cv1);
            PG8_WAIT_V(8); PG8_WAIT_L(0); PG8_BAR; PG8_MMA(0, 0, At, B0); PG8_MMA(0, 1, At, B1); PG8_BAR; PG8_SCHED;
            PG8_LDA(At, 0, 1); PG8_STAGE(PG8_SB(0, 0), b2, voffB); PG8_STAGE(PG8_SB(0, 1), b2 + hstepB, voffB); PG8_STAGE(PG8_SA(0, 0), a2, v0);
            PG8_WAIT_V(8); PG8_WAIT_L(0); PG8_BAR; PG8_MMA(1, 0, At, B0); PG8_MMA(1, 1, At, B1); PG8_BAR; PG8_SCHED;
            PG8_LDB(B0, 1, 0); PG8_LDB(B1, 1, 1); PG8_SCHED; PG8_LDA(At, 1, 0); PG8_STAGE(PG8_SA(0, 1), a2, v1);
            PG8_WAIT_V(8); PG8_WAIT_L(0); PG8_BAR; PG8_MMA(0, 0, At, B0); PG8_MMA(0, 1, At, B1); PG8_BAR; PG8_SCHED;
            PG8_LDA(At, 1, 1); PG8_STAGE(PG8_SB(1, 0), b3, voffB); PG8_STAGE(PG8_SB(1, 1), b3 + hstepB, voffB); PG8_STAGE(PG8_SA(1, 0), a3, v0);
            PG8_WAIT_V(8); PG8_WAIT_L(0); PG8_BAR; PG8_MMA(1, 0, At, B0); PG8_MMA(1, 1, At, B1); PG8_BAR; PG8_SCHED;
            } else {
            PG8_LDB(B0, 0, 0); PG8_SCHED; PG8_LDA(At, 0, 0); PG8_STAGE(PG8_SA(1, 1), a1, cv1);
            PG8_WAIT_L(8); PG8_BAR; PG8_WAIT_L(0); PG8_MMA(0, 0, At, B0); PG8_BAR; PG8_SCHED;
            PG8_LDB(B1, 0, 1); PG8_STAGE(PG8_SB(0, 0), b2, voffB);
            PG8_BAR; PG8_WAIT_L(0); PG8_MMA(0, 1, At, B1); PG8_BAR;
            PG8_LDA(At, 0, 1); PG8_STAGE(PG8_SA(0, 0), a2, v0);
            PG8_BAR; PG8_WAIT_L(0); PG8_MMA(1, 0, At, B0); PG8_BAR; PG8_SCHED;
            PG8_STAGE(PG8_SB(0, 1), b2 + hstepB, voffB);
            PG8_WAIT_V(6); PG8_BAR; PG8_MMA(1, 1, At, B1); PG8_BAR;
            PG8_LDB(B0, 1, 0); PG8_SCHED; PG8_LDA(At, 1, 0); PG8_STAGE(PG8_SA(0, 1), a2, v1);
            PG8_WAIT_L(8); PG8_BAR; PG8_WAIT_L(0); PG8_MMA(0, 0, At, B0); PG8_BAR; PG8_SCHED;
            PG8_LDB(B1, 1, 1); PG8_STAGE(PG8_SB(1, 0), b3, voffB);
            PG8_BAR; PG8_WAIT_L(0); PG8_MMA(0, 1, At, B1); PG8_BAR;
            PG8_LDA(At, 1, 1); PG8_STAGE(PG8_SA(1, 0), a3, v0);
            PG8_BAR; PG8_WAIT_L(0); PG8_MMA(1, 0, At, B0); PG8_BAR; PG8_SCHED;
            PG8_STAGE(PG8_SB(1, 1), b3 + hstepB, voffB);
            PG8_WAIT_V(6); PG8_BAR; PG8_MMA(1, 1, At, B1); PG8_BAR;
            }
        }
        if constexpr (ALIGN_EPI) { if (wr == 0) PG8_BAR; }
        E(acc, cur, wr, wc, fr, fq);
        if (!has_next) break;
#pragma unroll
        for (int a = 0; a < 2; ++a)
#pragma unroll
            for (int b = 0; b < 2; ++b)
#pragma unroll
                for (int m = 0; m < 4; ++m)
#pragma unroll
                    for (int n = 0; n < 2; ++n) acc[a][b][m][n] = (f32x4){0.f, 0.f, 0.f, 0.f};
        cur = nxt; cA = nA; cB = nB; ++ui; urows = S.rows(cur);
#pragma unroll
        for (int i = 0; i < 2; ++i) { cv0[i] = nv0[i]; cv1[i] = nv1[i]; }
        if constexpr (ALIGN_EPI) { if (wr == 1) PG8_BAR; }
    }
    PG8_WAIT_V(0);
    if constexpr (!ALIGN_EPI) { if (wr == 0) PG8_BAR; }
    PG8_BAR;
#undef PG8_SA
#undef PG8_SB
#undef PG8_STAGE
#undef PG8_LDA
#undef PG8_LDB
#undef PG8_MMA
#undef PG8_WAIT_V
#undef PG8_WAIT_L
#undef PG8_BAR
#undef PG8_SCHED
}

struct DenseOrder {
    const char* A; const char* Bt; int lda_b, K, nM, nN, nwg, G, c;
    __device__ __forceinline__ void init(const void* A_, int lda_elems, const void* Bt_, int M, int N, int K_) { A = (const char*)A_; Bt = (const char*)Bt_; lda_b = lda_elems * 2; K = K_; nM = M / BM; nN = N / BM; nwg = nM * nN; G = gridDim.x; c = blockIdx.x; }
    __device__ __forceinline__ bool next(int i, Unit& u) const {
        const long L = (long)i * G + c; if (L >= nwg) return false;
        int wgid = (int)L; { const int q = nwg / NXCD, r = nwg % NXCD, xcd = wgid % NXCD, off = wgid / NXCD; wgid = (xcd < r ? xcd * (q + 1) : r * (q + 1) + (xcd - r) * q) + off; }
        const int nig = WGM * nN, gid = wgid / nig, fm = gid * WGM, gsz = (nM - fm) < WGM ? (nM - fm) : WGM;
        u.pm = fm + ((wgid % nig) % gsz); u.pn = (wgid % nig) / gsz; u.e = 0; u.cnt = 0; u.hbase = 0;
        u.a = A + (size_t)u.pm * BM * lda_b; u.b = Bt + (size_t)u.pn * BM * K * 2;
        return true;
    }
    __device__ __forceinline__ unsigned a_voff(const Unit&, int h, int R, int C) const { return (unsigned)((h * HALF + R) * lda_b + C * 2); }
    __device__ __forceinline__ int rows(const Unit&) const { return BM; }
};
struct GroupOrder {
    const char* A; const char* Bt; int lda_b, K, nM, nN, ng, G, c; size_t gsA, gsB;
    __device__ __forceinline__ void init(const void* A_, int lda_elems, size_t gsA_elems, const void* Bt_, size_t gsB_elems, int ng_, int M, int N, int K_) {
        A = (const char*)A_; Bt = (const char*)Bt_; lda_b = lda_elems * 2; K = K_; nM = M / BM; nN = N / BM; ng = ng_; gsA = gsA_elems * 2; gsB = gsB_elems * 2; G = gridDim.x; c = blockIdx.x; }
    __device__ __forceinline__ bool next(int i, Unit& u) const {
        const long L = (long)i * G + c; if (L >= (long)ng * nM * nN) return false;
        const int per = nM * nN, g = (int)L / per, r = (int)L % per;
        u.e = g; u.pm = r / nN; u.pn = r % nN; u.cnt = 0; u.hbase = 0;
        u.a = A + (size_t)g * gsA + (size_t)u.pm * BM * lda_b; u.b = Bt + (size_t)g * gsB + (size_t)u.pn * BM * K * 2;
        return true;
    }
    __device__ __forceinline__ unsigned a_voff(const Unit&, int h, int R, int C) const { return (unsigned)((h * HALF + R) * lda_b + C * 2); }
    __device__ __forceinline__ int rows(const Unit&) const { return BM; }
};
constexpr int PLAN_STRIDE = 256;
struct PlanOrder {
    const int4* plan; const int* plan_n; const int* list; const char* A; const char* Bt; int lda_b, K, x, ib, nbx; size_t esB; bool gather;
    __device__ __forceinline__ void init(const void* planbase, const int* list_, const void* A_, int lda_elems, const void* Bt_, size_t esB_elems, int K_, bool gather_) {
        plan_n = (const int*)planbase; plan = (const int4*)((const char*)planbase + 256); list = list_; A = (const char*)A_; Bt = (const char*)Bt_; lda_b = lda_elems * 2; K = K_; esB = esB_elems * 2; gather = gather_;
        x = blockIdx.x & 7; ib = blockIdx.x >> 3; nbx = ((int)gridDim.x - x + 7) >> 3; }
    __device__ __forceinline__ bool next(int i, Unit& u) const {
        const int j = i * nbx + ib;
        if (j >= plan_n[x]) return false;
        const int4 en = plan[x * PLAN_STRIDE + j];
        u.e = en.x & 255; u.pm = (en.x >> 8) & 255; u.pn = (en.x >> 16) & 255; u.cnt = en.y; u.hbase = en.z;
        u.a = gather ? A : A + (size_t)(u.hbase + u.pm * BM) * lda_b;
        u.b = Bt + (size_t)u.e * esB + (size_t)u.pn * BM * K * 2;
        return true;
    }
    __device__ __forceinline__ unsigned a_voff(const Unit& u, int h, int R, int C) const {
        if (!gather) return (unsigned)((h * HALF + R) * lda_b + C * 2);
        const int li = u.pm * BM + h * HALF + R;
        const int tok = (li < u.cnt) ? (list[(size_t)u.e * CAP + li] >> 1) : 0;
        return (unsigned)(tok * lda_b + C * 2);
    }
    __device__ __forceinline__ int rows(const Unit& u) const { const int r = u.cnt - u.pm * BM; return r < BM ? r : BM; }
};
}
constexpr bool G_ALIGN = true, G_SP2 = true;

__device__ __forceinline__ void phase_prep(const P& p) {
  const int gtid = blockIdx.x * NTHR + tidx(), gsz = gridDim.x * NTHR;
  int* cnt = (int*)(p.ws + WS_CNT);
  if (gtid < 64) cnt[gtid] = 0;
  f32x2* rope = (f32x2*)(p.ws + WS_ROPE);
  for (int i = gtid; i < SEQ * 64; i += gsz) {
    const int pos = i >> 6, f = i & 63;
    const float inv = powf(10000.0f, -(float)(2 * f) / 128.0f);
    const float ang = (float)pos * inv;
    float s, c; sincosf(ang, &s, &c);
    rope[i] = (f32x2){c, s};
  }
  f32x2* lamt = (f32x2*)(p.ws + WS_LAMT); f32x2* coeft = (f32x2*)(p.ws + WS_LAMT + 3 * MB / 2);
  for (int i = gtid; i < 32 * 2 * 33 * 64; i += gsz) {
    const int q = i & 63, l = (i >> 6) % 33, gd = i / (33 * 64);
    const int g = gd >> 1, dir = gd & 1;
    const float dt = expf(p.log_step[dir * 32 + g]), ar = p.a_re[(dir * 32 + g) * 64 + q], ai = p.a_im[(dir * 32 + g) * 64 + q];
    const float mag = expf(ar * dt * (float)l); float sn, cs; sincosf(ai * dt * (float)l, &sn, &cs);
    lamt[i] = (f32x2){mag * cs, mag * sn};
    if (l == 1) {
      const float em1 = expm1f(ar * dt), sh = sinf(0.5f * ai * dt);
      const float nr = em1 * cs - 2.0f * sh * sh, ni = (em1 + 1.0f) * sn, den = ar * ar + ai * ai;
      coeft[gd * 64 + q] = (f32x2){(nr * ar + ni * ai) / den, (ni * ar - nr * ai) / den};
    }
  }
  u16* wr16 = (u16*)(p.ws + WS_WR16);
  for (int i = gtid; i < 2 * 48 * DM; i += gsz) {
    const int k = i & (DM - 1), n = (i >> 10) % 48, layer = i / (48 * DM);
    float w = 0.f;
    if (n < 4) w = p.w_group[((size_t)layer * DM + k) * 4 + n];
    else if (n < 36) { const int gg = (n - 4) >> 3, j = (n - 4) & 7; w = p.w_er[(((size_t)layer * 4 + gg) * DM + k) * 8 + j]; }
    w *= p.norm_ffn_g[layer * DM + k];
    const u16 hi = f2h(w), lo = f2h(w - h2f(hi));
    wr16[((size_t)(layer * 2 + 0) * 48 + n) * DM + k] = hi;
    wr16[((size_t)(layer * 2 + 1) * 48 + n) * DM + k] = lo;
  }
}

template <class RowFn>
__device__ __forceinline__ void conv_item(const float* W, int ldw, int K, u16* WT, float* scr, int k0, int n0, int lane, RowFn rowfn) {
#pragma unroll 8
  for (int i = 0; i < 32; ++i) { const int kk = 2 * i + (lane >> 5); scr[kk * 33 + (lane & 31)] = W[(size_t)(k0 + kk) * ldw + n0 + (lane & 31)]; }
  LDS_WAIT();
  const int c = lane & 7;
#pragma unroll
  for (int j = 0; j < 4; ++j) {
    const int n = (lane >> 3) + 8 * j; const float* sp = scr + (8 * c) * 33 + n;
    uint4 o; o.x = pk2(sp[0 * 33], sp[1 * 33]); o.y = pk2(sp[2 * 33], sp[3 * 33]); o.z = pk2(sp[4 * 33], sp[5 * 33]); o.w = pk2(sp[6 * 33], sp[7 * 33]);
    *(uint4*)(WT + (size_t)rowfn(n0 + n) * K + k0 + 8 * c) = o;
  }
  LDS_WAIT();
}
template <class RowFn>
__device__ __forceinline__ int conv_matrix(const float* W, int ldw, int K, int N, u16* WT, char* smem, int item_base, RowFn rowfn) {
  const int lane = tidx() & 63, wv = tidx() >> 6, gw = blockIdx.x * NWAVE + wv, nw = gridDim.x * NWAVE;
  float* scr = (float*)smem + wv * (64 * 33);
  const int nkb = K / 64, nnb = N / 32, nitems = nkb * nnb;
  int it = gw - (item_base % nw); if (it < 0) it += nw;
  for (; it < nitems; it += nw) conv_item(W, ldw, K, WT, scr, (it / nnb) * 64, (it % nnb) * 32, lane, rowfn);
  return nitems;
}
__device__ __forceinline__ void phase_conv_dense(const P& p, char* smem) {
  auto id = [](int n) { return n; };
  int base = 0;
  base += conv_matrix(p.w_in, 2560, DM, 2560, (u16*)(p.ws + WS_WIN), smem, base, [](int n) { if (n >= 1024) return n; const int dd = n & 127, hf = dd >> 6, r = dd & 63; return (n & ~127) + 32 * (r >> 4) + 16 * hf + (r & 15); });
  base += conv_matrix(p.w_glu, 512, 512, 512, (u16*)(p.ws + WS_WGLU), smem, base, id);
  base += conv_matrix(p.w_out, DM, DM, DM, (u16*)(p.ws + WS_WOUT), smem, base, id);
  base += conv_matrix(p.w_qkv, 1536, DM, 1536, (u16*)(p.ws + WS_WQKV), smem, base, id);
  base += conv_matrix(p.w_o, DM, DM, DM, (u16*)(p.ws + WS_WO), smem, base, id);
}
__device__ __forceinline__ void phase_conv_moe(const P& p, int layer, int lo, int hi, int b0, int nb, char* smem) {
  if (gridDim.x != 256) { b0 = 0; nb = (int)gridDim.x; }
  if ((int)blockIdx.x < b0 || (int)blockIdx.x >= b0 + nb) return;
  const int lane = tidx() & 63, wv = tidx() >> 6, gw = ((int)blockIdx.x - b0) * NWAVE + wv, nw = nb * NWAVE;
  float* scr = (float*)smem + wv * (64 * 33);
  u16* w1t = (u16*)(p.ws + (layer ? WS_MW1 : WS_MW0)); u16* w2t = w1t + (size_t)32 * DM * DM;
  for (int it = lo + gw; it < hi; it += nw) {
    const int e = it / 768, r = it % 768;
    if (r < 512) {
      const int which = r >> 8, q = r & 255, k0 = (q >> 4) * 64, n0 = (q & 15) * 32;
      const float* W = (which ? p.w_up : p.w_gate) + (size_t)(layer * 32 + e) * DM * 512;
      conv_item(W, 512, DM, w1t + (size_t)e * DM * DM, scr, k0, n0, lane, [which](int n) { return (n >> 4) * 32 + which * 16 + (n & 15); });
    } else {
      const int q = r - 512, k0 = (q >> 5) * 64, n0 = (q & 31) * 32;
      const float* W = p.w_down + (size_t)(layer * 32 + e) * 512 * DM;
      conv_item(W, DM, 512, w2t + (size_t)e * DM * 512, scr, k0, n0, lane, [](int n) { return n; });
    }
  }
}

constexpr int CONV_ITEMS = 32 * 768;
constexpr int cq(int pct) { return (int)((long)CONV_ITEMS * pct / 100); }
__device__ __forceinline__ void phase_rowpass(const P& p, const float* src, const u16* slots, float* dstx, const float* gain, int route_layer, float* fout, char* smem) {
  const int lane = tidx() & 63, wv = tidx() >> 6, fr = lane & 15, lg = lane >> 4;
  u16* xb = (u16*)(p.ws + WS_XB);
  int* cnt = (int*)(p.ws + WS_CNT);
  int* list = (int*)(p.ws + WS_LIST);
  float* gate = (float*)(p.ws + WS_GATE);
  float* sRs = (float*)smem;
  float* sLg = (float*)smem + 64;
  for (int st = blockIdx.x; st < T_TOK / 64; st += gridDim.x) {
    const int row0 = st * 64 + wv * 8;
#pragma unroll 1
    for (int rp = 0; rp < 4; ++rp) {
      f32x4 v[2][4];
#pragma unroll
      for (int q = 0; q < 2; ++q) {
        const int row = row0 + rp * 2 + q;
#pragma unroll
        for (int i = 0; i < 4; ++i) v[q][i] = *(const f32x4*)(src + (size_t)row * DM + (i * 64 + lane) * 4);
      }
      if (slots) {
#pragma unroll
        for (int q = 0; q < 2; ++q) {
          const int row = row0 + rp * 2 + q;
          uint2 w[2][4];
#pragma unroll
          for (int sl = 0; sl < 2; ++sl)
#pragma unroll
            for (int i = 0; i < 4; ++i) w[sl][i] = *(const uint2*)(slots + ((size_t)row * 2 + sl) * DM + (i * 64 + lane) * 4);
#pragma unroll
          for (int sl = 0; sl < 2; ++sl)
#pragma unroll
            for (int i = 0; i < 4; ++i) { v[q][i][0] += lo16(w[sl][i].x); v[q][i][1] += hi16(w[sl][i].x); v[q][i][2] += lo16(w[sl][i].y); v[q][i][3] += hi16(w[sl][i].y); }
        }
      }
#pragma unroll
      for (int q = 0; q < 2; ++q) {
        const int row = row0 + rp * 2 + q;
        float ss = 0.f;
#pragma unroll
        for (int i = 0; i < 4; ++i) {
          if (dstx) *(f32x4*)(dstx + (size_t)row * DM + (i * 64 + lane) * 4) = v[q][i];
          ss += v[q][i][0] * v[q][i][0] + v[q][i][1] * v[q][i][1] + v[q][i][2] * v[q][i][2] + v[q][i][3] * v[q][i][3];
        }
        ss = wave_sum(ss);
        const float rstd = rsqrtf(ss * (1.0f / DM) + 1e-6f);
        if (route_layer >= 0 && lane == 0) sRs[wv * 8 + rp * 2 + q] = rstd;
#pragma unroll
        for (int i = 0; i < 4; ++i) {
          const int k = (i * 64 + lane) * 4;
          const f32x4 gv = *(const f32x4*)(gain + k);
          const f32x4 hv = v[q][i] * rstd * gv;
          if (fout) *(f32x4*)(fout + (size_t)row * DM + k) = hv;
          else { uint2 w; w.x = pk2(hv[0], hv[1]); w.y = pk2(hv[2], hv[3]); *(uint2*)(xb + (size_t)row * DM + k) = w; }
        }
      }
    }
    if (route_layer >= 0) {
      __syncthreads();
      const int tl = wv & 3, kh = wv >> 2;
      const float rsv = sRs[tl * 16 + fr];
      const float* xrow = src + (size_t)(st * 64 + tl * 16 + fr) * DM + kh * 512 + lg * 8;
      const u16* whi = (const u16*)(p.ws + WS_WR16) + ((size_t)(route_layer * 2 + 0) * 48 + fr) * DM + kh * 512 + lg * 8;
      const u16* wlo = (const u16*)(p.ws + WS_WR16) + ((size_t)(route_layer * 2 + 1) * 48 + fr) * DM + kh * 512 + lg * 8;
      f32x4 acc[3];
#pragma unroll
      for (int nb = 0; nb < 3; ++nb) acc[nb] = (f32x4){0.f, 0.f, 0.f, 0.f};
#pragma unroll 4
      for (int ks = 0; ks < 16; ++ks) {
        const f32x4 x0 = *(const f32x4*)(xrow + ks * 32), x1 = *(const f32x4*)(xrow + ks * 32 + 4);
        const float hv[8] = {x0[0] * rsv, x0[1] * rsv, x0[2] * rsv, x0[3] * rsv, x1[0] * rsv, x1[1] * rsv, x1[2] * rsv, x1[3] * rsv};
        unsigned ah[4], al[4];
#pragma unroll
        for (int j = 0; j < 4; ++j) {
          const u16 h0 = f2h(hv[2 * j]), h1 = f2h(hv[2 * j + 1]);
          ah[j] = (unsigned)h0 | ((unsigned)h1 << 16);
          al[j] = pk2(hv[2 * j] - h2f(h0), hv[2 * j + 1] - h2f(h1));
        }
        const uint4 ahi = make_uint4(ah[0], ah[1], ah[2], ah[3]), alo = make_uint4(al[0], al[1], al[2], al[3]);
#pragma unroll
        for (int nb = 0; nb < 3; ++nb) {
          const uint4 bh = *(const uint4*)(whi + (size_t)nb * 16 * DM + ks * 32), bl = *(const uint4*)(wlo + (size_t)nb * 16 * DM + ks * 32);
          acc[nb] = mfma16(bh, ahi, acc[nb]); acc[nb] = mfma16(bh, alo, acc[nb]); acc[nb] = mfma16(bl, ahi, acc[nb]);
        }
      }
      float* lgw = sLg + ((kh * 4 + tl) * 16 + fr) * 49;
#pragma unroll
      for (int nb = 0; nb < 3; ++nb)
#pragma unroll
        for (int r = 0; r < 4; ++r) lgw[nb * 16 + 4 * lg + r] = acc[nb][r];
      __syncthreads();
      if (wv < 4 && lane < 16) {
        const int row = st * 64 + wv * 16 + lane;
        const float* l0 = sLg + ((0 * 4 + wv) * 16 + lane) * 49;
        const float* l1 = sLg + ((1 * 4 + wv) * 16 + lane) * 49;
        const float* bg = p.b_group + route_layer * 4;
        const float* be = p.b_er + route_layer * 32;
        float gl[4];
#pragma unroll
        for (int j = 0; j < 4; ++j) gl[j] = l0[j] + l1[j] + bg[j];
        int gs = 0; float gm = gl[0];
#pragma unroll
        for (int j = 1; j < 4; ++j) if (gl[j] > gm) { gm = gl[j]; gs = j; }
        float den = 0.f;
#pragma unroll
        for (int j = 0; j < 4; ++j) den += expf(gl[j] - gm);
        const float pg = 1.0f / den;
        float el[8];
#pragma unroll
        for (int j = 0; j < 8; ++j) el[j] = l0[4 + gs * 8 + j] + l1[4 + gs * 8 + j] + be[gs * 8 + j];
        int i1 = 0; float v1 = el[0];
#pragma unroll
        for (int j = 1; j < 8; ++j) if (el[j] > v1) { v1 = el[j]; i1 = j; }
        int i2 = -1; float v2 = -3.0e38f;
#pragma unroll
        for (int j = 0; j < 8; ++j) if (j != i1 && el[j] > v2) { v2 = el[j]; i2 = j; }
        const float e2 = expf(v2 - v1);
        const float g1 = pg / (1.0f + e2), g2 = pg * e2 / (1.0f + e2);
        const int ex1 = gs * 8 + i1, ex2 = gs * 8 + i2;
        const int r1 = atomicAdd(&cnt[route_layer * 32 + ex1], 1);
        list[(size_t)ex1 * CAP + r1] = row * 2;
        gate[row * 2] = g1;
        const int r2 = atomicAdd(&cnt[route_layer * 32 + ex2], 1);
        list[(size_t)ex2 * CAP + r2] = row * 2 + 1;
        gate[row * 2 + 1] = g2;
      }
      __syncthreads();
    }
  }
}

constexpr int RSTR = 136;
__device__ __forceinline__ float log_sigmoid(float x) { return -log1pf(expf(-x)); }
__device__ __forceinline__ uint2 lds_tr16(const u16* ptr) {
  typedef short s16x4 __attribute__((ext_vector_type(4)));
  const s16x4 v = __builtin_amdgcn_ds_read_tr16_b64_v4i16((LAS s16x4*)ptr);
  return __builtin_bit_cast(uint2, v);
}
__device__ __forceinline__ uint4 lds_frag_T(const u16* tile, int rs, int k0, int c0, int lane) {
  const int g = lane >> 4, q = (lane & 15) >> 2, pp = lane & 3;
  const u16* a = tile + (k0 + 8 * g + q) * rs + c0 + 4 * pp;
  const uint2 lo = lds_tr16(a), hi = lds_tr16(a + 4 * rs);
  return make_uint4(lo.x, lo.y, hi.x, hi.y);
}
__device__ __forceinline__ void ret_load_tile(u16* dst0, u16* dst1, const u16* src, int t0, int h, const float* w0, const float* w1) {
  for (int c = tidx(); c < 128 * 16; c += NTHR) {
    const int i = c >> 4, ch = (c & 15) * 8;
    const uint4 v = *(const uint4*)(src + (size_t)(t0 + i) * 512 + h * 128 + ch);
    if (w0) {
      const float a = w0[i], b = w1[i];
      const float f[8] = {lo16(v.x), hi16(v.x), lo16(v.y), hi16(v.y), lo16(v.z), hi16(v.z), lo16(v.w), hi16(v.w)};
      *(uint4*)(dst0 + i * RSTR + ch) = make_uint4(pk2(f[0] * a, f[1] * a), pk2(f[2] * a, f[3] * a), pk2(f[4] * a, f[5] * a), pk2(f[6] * a, f[7] * a));
      *(uint4*)(dst1 + i * RSTR + ch) = make_uint4(pk2(f[0] * b, f[1] * b), pk2(f[2] * b, f[3] * b), pk2(f[4] * b, f[5] * b), pk2(f[6] * b, f[7] * b));
    } else *(uint4*)(dst0 + i * RSTR + ch) = v;
  }
}
template <int MB_, int NB_, bool ATR, bool BTR>
__device__ __forceinline__ void lds_mma(f32x4 (&acc)[MB_][NB_], const u16* sA, int sa, int a0, const u16* sB, int sb, int b0, int K, int lane, const float* sc) {
  const int fr = lane & 15, fq = lane >> 4;
  for (int k0 = 0; k0 < K; k0 += 32) {
    uint4 fa[MB_], fb[NB_];
#pragma unroll
    for (int m = 0; m < MB_; ++m) {
      if constexpr (ATR) fa[m] = lds_frag_T(sA, sa, k0, a0 + m * 16, lane);
      else fa[m] = *(const uint4*)(sA + (a0 + m * 16 + fr) * sa + k0 + fq * 8);
      if (sc) {
        const float f = sc[m];
        fa[m].x = pk2(lo16(fa[m].x) * f, hi16(fa[m].x) * f); fa[m].y = pk2(lo16(fa[m].y) * f, hi16(fa[m].y) * f);
        fa[m].z = pk2(lo16(fa[m].z) * f, hi16(fa[m].z) * f); fa[m].w = pk2(lo16(fa[m].w) * f, hi16(fa[m].w) * f);
      }
    }
#pragma unroll
    for (int n = 0; n < NB_; ++n) {
      if constexpr (BTR) fb[n] = lds_frag_T(sB, sb, k0, b0 + n * 16, lane);
      else fb[n] = *(const uint4*)(sB + (b0 + n * 16 + fr) * sb + k0 + fq * 8);
    }
#pragma unroll
    for (int m = 0; m < MB_; ++m)
#pragma unroll
      for (int n = 0; n < NB_; ++n) acc[m][n] = mfma16(fb[n], fa[m], acc[m][n]);
  }
}
__device__ __forceinline__ void ret_items(int ng, int& first, int& count, int& stride) {
  const int c = blockIdx.x, G = gridDim.x;
  if (G != 256) { first = c; count = (512 - c + G - 1) / G; stride = G; return; }
  stride = 1;
  if (c < ng) { first = c; count = 1; return; }
  const int rest = 512 - ng, nb = 256 - ng, q = rest / nb, r = rest % nb, i = c - ng;
  first = ng + i * q + (i < r ? i : r); count = q + (i < r ? 1 : 0);
}
__device__ __forceinline__ void phase_ret_inc_mfma(const P& p, char* smem) {
  u16* sKf = (u16*)smem; u16* sKb = sKf + 128 * RSTR; u16* sV = sKb + 128 * RSTR; float* sWf = (float*)(sV + 128 * RSTR); float* sWb = sWf + 128;
  const u16* kb = (const u16*)(p.ws + WS_Z) + (size_t)1 * T_TOK * 512; const u16* vb = (const u16*)(p.ws + WS_Z) + (size_t)2 * T_TOK * 512;
  float* incf = (float*)(p.ws + WS_INC); float* incb = incf + (size_t)512 * 16384;
  const int tid = tidx(), lane = tid & 63, wv = tid >> 6, wr = wv >> 1, wc = wv & 1, fr = lane & 15, fq = lane >> 4;
  int it_first, it_count, it_stride; ret_items(64, it_first, it_count, it_stride);
  for (int ii = 0; ii < it_count; ++ii) {
    const int item = it_first + ii * it_stride;
    const int h = item & 3, bn = item >> 2, t0 = bn * 128;
    const float lgf = log_sigmoid(p.ret_decay[h]), lgb = log_sigmoid(p.ret_decay[4 + h]);
    __syncthreads();
    if (tid < 128) { sWf[tid] = expf(lgf * (float)(127 - tid)); sWb[tid] = expf(lgb * (float)tid); }
    __syncthreads();
    ret_load_tile(sKf, sKb, kb, t0, h, sWf, sWb);
    ret_load_tile(sV, nullptr, vb, t0, h, nullptr, nullptr);
    __syncthreads();
#pragma unroll
    for (int dirn = 0; dirn < 2; ++dirn) {
      f32x4 acc[2][4];
#pragma unroll
      for (int m = 0; m < 2; ++m)
#pragma unroll
        for (int n = 0; n < 4; ++n) acc[m][n] = (f32x4){0.f, 0.f, 0.f, 0.f};
      lds_mma<2, 4, true, true>(acc, sV, RSTR, wr * 32, dirn ? sKb : sKf, RSTR, wc * 64, 128, lane, nullptr);
      float* o = (dirn ? incb : incf) + (size_t)item * 16384;
#pragma unroll
      for (int m = 0; m < 2; ++m)
#pragma unroll
        for (int n = 0; n < 4; ++n) *(f32x4*)(o + (wr * 32 + m * 16 + fr) * 128 + wc * 64 + n * 16 + 4 * fq) = acc[m][n];
    }
  }
}
__device__ __forceinline__ void phase_ret_scan16(const P& p) {
  const float* incf = (const float*)(p.ws + WS_INC); const float* incb = incf + (size_t)512 * 16384;
  u16* spf = (u16*)(p.ws + WS_SP16); u16* spb = spf + (size_t)512 * 16384;
  const int gtid = blockIdx.x * NTHR + tidx(), gsz = gridDim.x * NTHR;
  for (int idx = gtid; idx < 32 * 4096; idx += gsz) {
    const int de = (idx & 4095) * 4, bh = idx >> 12, b = bh >> 2, h = bh & 3;
    const float Gf = expf(128.0f * log_sigmoid(p.ret_decay[h])), Gb = expf(128.0f * log_sigmoid(p.ret_decay[4 + h]));
    f32x4 s = {0.f, 0.f, 0.f, 0.f};
    for (int n = 0; n < 16; ++n) {
      const size_t o = ((size_t)((b * 16 + n) * 4 + h)) * 16384 + de;
      const f32x4 t = *(const f32x4*)(incf + o);
      uint2 w; w.x = pk2(s[0], s[1]); w.y = pk2(s[2], s[3]); *(uint2*)(spf + o) = w;
      s = s * Gf + t;
    }
    s = (f32x4){0.f, 0.f, 0.f, 0.f};
    for (int n = 15; n >= 0; --n) {
      const size_t o = ((size_t)((b * 16 + n) * 4 + h)) * 16384 + de;
      const f32x4 t = *(const f32x4*)(incb + o);
      uint2 w; w.x = pk2(s[0], s[1]); w.y = pk2(s[2], s[3]); *(uint2*)(spb + o) = w;
      s = s * Gb + t;
    }
  }
}
__device__ __forceinline__ void phase_ret_out_mfma(const P& p, char* smem) {
  u16* R0 = (u16*)smem; u16* R1 = R0 + 128 * RSTR; u16* R2 = R1 + 128 * RSTR; u16* R3 = R2 + 128 * RSTR;
  float* sPf = (float*)(R3 + 128 * RSTR); float* sPb = sPf + 132;
  const u16* zb = (const u16*)(p.ws + WS_Z);
  const u16* qb = zb; const u16* kb = zb + (size_t)1 * T_TOK * 512; const u16* vb = zb + (size_t)2 * T_TOK * 512; const u16* gb = zb + (size_t)3 * T_TOK * 512;
  const u16* spf = (const u16*)(p.ws + WS_SP16); const u16* spb = spf + (size_t)512 * 16384;
  u16* ycat = (u16*)(p.ws + WS_YCAT);
  const int tid = tidx(), lane = tid & 63, wv = tid >> 6, wr = wv >> 1, wc = wv & 1, fr = lane & 15, fq = lane >> 4;
  int it_first, it_count, it_stride; ret_items(128, it_first, it_count, it_stride);
  for (int ii = 0; ii < it_count; ++ii) {
    const int item = it_first + ii * it_stride;
    const int h = item & 3, bn = item >> 2, t0 = bn * 128;
    const float lgf = log_sigmoid(p.ret_decay[h]), lgb = log_sigmoid(p.ret_decay[4 + h]);
    const u16* spT = spf + (size_t)item * 16384; const u16* snT = spb + (size_t)item * 16384;
    const int pe = tid >> 4, pch = (tid & 15) * 8;
    const uint4 pp0 = *(const uint4*)(spT + (pe + 0) * 128 + pch), pp1 = *(const uint4*)(spT + (pe + 32) * 128 + pch), pp2 = *(const uint4*)(spT + (pe + 64) * 128 + pch), pp3 = *(const uint4*)(spT + (pe + 96) * 128 + pch);
    __syncthreads();
    ret_load_tile(R0, nullptr, qb, t0, h, nullptr, nullptr);
    ret_load_tile(R1, nullptr, kb, t0, h, nullptr, nullptr);
    ret_load_tile(R2, nullptr, vb, t0, h, nullptr, nullptr);
    if (tid < 129) { sPf[tid] = expf(lgf * (float)tid); sPb[tid] = expf(lgb * (float)tid); }
    __syncthreads();
    {
      f32x4 acc[2][4];
#pragma unroll
      for (int m = 0; m < 2; ++m)
#pragma unroll
        for (int n = 0; n < 4; ++n) acc[m][n] = (f32x4){0.f, 0.f, 0.f, 0.f};
      lds_mma<2, 4, false, false>(acc, R0, RSTR, wr * 32, R1, RSTR, wc * 64, 128, lane, nullptr);
#pragma unroll
      for (int m = 0; m < 2; ++m)
#pragma unroll
        for (int n = 0; n < 4; ++n) {
          const int i = wr * 32 + m * 16 + fr, j = wc * 64 + n * 16 + 4 * fq;
          float v[4];
#pragma unroll
          for (int r = 0; r < 4; ++r) { const int jj = j + r; v[r] = acc[m][n][r] * ((i >= jj) ? sPf[i - jj] : sPb[jj - i]); }
          uint2 w; w.x = pk2(v[0], v[1]); w.y = pk2(v[2], v[3]);
          *(uint2*)(R3 + i * RSTR + j) = w;
        }
    }
    __syncthreads();
    *(uint4*)(R1 + (pe + 0) * RSTR + pch) = pp0; *(uint4*)(R1 + (pe + 32) * RSTR + pch) = pp1; *(uint4*)(R1 + (pe + 64) * RSTR + pch) = pp2; *(uint4*)(R1 + (pe + 96) * RSTR + pch) = pp3;
    const uint4 pn0 = *(const uint4*)(snT + (pe + 0) * 128 + pch), pn1 = *(const uint4*)(snT + (pe + 32) * 128 + pch), pn2 = *(const uint4*)(snT + (pe + 64) * 128 + pch), pn3 = *(const uint4*)(snT + (pe + 96) * 128 + pch);
    f32x4 o[1][8];
#pragma unroll
    for (int m = 0; m < 1; ++m)
#pragma unroll
      for (int n = 0; n < 8; ++n) o[m][n] = (f32x4){0.f, 0.f, 0.f, 0.f};
    lds_mma<1, 8, false, true>(o, R3, RSTR, wv * 16, R2, RSTR, 0, 128, lane, nullptr);
    __syncthreads();
    *(uint4*)(R2 + (pe + 0) * RSTR + pch) = pn0; *(uint4*)(R2 + (pe + 32) * RSTR + pch) = pn1; *(uint4*)(R2 + (pe + 64) * RSTR + pch) = pn2; *(uint4*)(R2 + (pe + 96) * RSTR + pch) = pn3;
    float scf[1], scb[1];
    { const int i = wv * 16 + fr; scf[0] = sPf[i + 1]; scb[0] = sPb[128 - i]; }
    lds_mma<1, 8, false, false>(o, R0, RSTR, wv * 16, R1, RSTR, 0, 128, lane, scf);
    __syncthreads();
    lds_mma<1, 8, false, false>(o, R0, RSTR, wv * 16, R2, RSTR, 0, 128, lane, scb);
#pragma unroll
    for (int m = 0; m < 1; ++m) {
      float s1 = 0.f;
#pragma unroll
      for (int n = 0; n < 8; ++n) s1 += (o[m][n][0] + o[m][n][1]) + (o[m][n][2] + o[m][n][3]);
      s1 += __shfl_xor(s1, 16); s1 += __shfl_xor(s1, 32);
      const float mu = s1 * (1.0f / 128.0f);
      float s2 = 0.f;
#pragma unroll
      for (int n = 0; n < 8; ++n)
#pragma unroll
        for (int r = 0; r < 4; ++r) { const float dl = o[m][n][r] - mu; s2 += dl * dl; }
      s2 += __shfl_xor(s2, 16); s2 += __shfl_xor(s2, 32);
      const float rs = rsqrtf(s2 * (1.0f / 128.0f) + 1e-5f);
      const size_t tok = (size_t)(t0 + wv * 16 + m * 16 + fr);
#pragma unroll
      for (int n = 0; n < 8; ++n) {
        const int e = n * 16 + 4 * fq;
        const uint2 gq = *(const uint2*)(gb + tok * 512 + h * 128 + e);
        const float g0 = lo16(gq.x), g1 = hi16(gq.x), g2 = lo16(gq.y), g3 = hi16(gq.y);
        uint2 w;
        w.x = pk2(g0 * sigmoidf_(g0) * (o[m][n][0] - mu) * rs, g1 * sigmoidf_(g1) * (o[m][n][1] - mu) * rs);
        w.y = pk2(g2 * sigmoidf_(g2) * (o[m][n][2] - mu) * rs, g3 * sigmoidf_(g3) * (o[m][n][3] - mu) * rs);
        *(uint2*)(ycat + tok * DM + h * 128 + e) = w;
      }
    }
  }
}

struct Cpx { float re, im; };
__device__ __forceinline__ Cpx cmul(Cpx a, Cpx b) { return {a.re * b.re - a.im * b.im, a.re * b.im + a.im * b.re}; }
__device__ __forceinline__ Cpx s5_lam(const P& p, int g, int dir, int l, int q) { const f32x2 v = ((const f32x2*)(p.ws + WS_LAMT))[((g * 2 + dir) * 33 + l) * 64 + q]; return {v[0], v[1]}; }
__device__ __forceinline__ Cpx s5_cf(const P& p, int g, int dir, int q) { const f32x2 v = ((const f32x2*)(p.ws + WS_LAMT + 3 * MB / 2))[(g * 2 + dir) * 64 + q]; return {v[0], v[1]}; }
__device__ __forceinline__ bool s5_setup_ids(int& gtid, int& gsz) {
  const bool half = (gridDim.x == 256);
  if (half && blockIdx.x < 128) return false;
  gtid = (half ? (int)blockIdx.x - 128 : (int)blockIdx.x) * NTHR + tidx(); gsz = (half ? 128 : (int)gridDim.x) * NTHR;
  return true;
}
__device__ __forceinline__ void phase_s5_ktab(const P& p) {
  float* ktab = (float*)(p.ws + WS_KTAB);
  int gtid, gsz; if (!s5_setup_ids(gtid, gsz)) return;
  for (int item = gtid; item < 32 * 2 * 32 * 16; item += gsz) {
    const int c = item & 15, l = (item >> 4) & 31, dir = (item >> 9) & 1, g = item >> 10;
    float acc[16];
#pragma unroll
    for (int j = 0; j < 16; ++j) acc[j] = 0.f;
    for (int q = 0; q < 64; ++q) {
      const Cpx L = s5_lam(p, g, dir, l, q), cf = s5_cf(p, g, dir, q);
      const Cpx C = {p.c_re[((dir * 32 + g) * 16 + c) * 64 + q], p.c_im[((dir * 32 + g) * 16 + c) * 64 + q]};
      const Cpx w = cmul(cmul(C, L), cf);
#pragma unroll
      for (int j = 0; j < 16; ++j) acc[j] += w.re * p.b_re[(g * 64 + q) * 16 + j] - w.im * p.b_im[(g * 64 + q) * 16 + j];
    }
#pragma unroll
    for (int j = 0; j < 16; j += 4) *(f32x4*)(ktab + (size_t)item * 16 + j) = (f32x4){acc[j], acc[j + 1], acc[j + 2], acc[j + 3]};
  }
}
__device__ __forceinline__ void phase_s5_fill_a(const P& p) {
  const float* ktab = (const float*)(p.ws + WS_KTAB);
  u16* bty = (u16*)(p.ws + WS_BTY);
  const int gtid = blockIdx.x * NTHR + tidx(), gsz = gridDim.x * NTHR;
  for (int item = gtid; item < 32 * 512 * 64; item += gsz) {
    const int ch = item & 63, n = (item >> 6) & 511, g = item >> 15;
    const int ip = ch >> 1, c0 = (ch & 1) * 8, i = n >> 4, c = n & 15;
    float v[8];
    if (ip != i) {
      const int dir = ip < i ? 0 : 1, l = ip < i ? i - ip : ip - i;
      const float* src = ktab + ((size_t)((g * 2 + dir) * 32 + l) * 16 + c) * 16 + c0;
      const f32x4 a = *(const f32x4*)src, b = *(const f32x4*)(src + 4);
      v[0] = a[0]; v[1] = a[1]; v[2] = a[2]; v[3] = a[3]; v[4] = b[0]; v[5] = b[1]; v[6] = b[2]; v[7] = b[3];
    } else {
      const float* s0 = ktab + ((size_t)((g * 2 + 0) * 32) * 16 + c) * 16 + c0;
      const float* s1 = ktab + ((size_t)((g * 2 + 1) * 32) * 16 + c) * 16 + c0;
      const float dd = p.s5d[g * 16 + c];
#pragma unroll
      for (int j = 0; j < 8; ++j) v[j] = s0[j] + s1[j] + ((c0 + j) == c ? dd : 0.f);
    }
    *(uint4*)(bty + ((size_t)g * 512 + n) * 768 + ch * 8) = make_uint4(pk2(v[0], v[1]), pk2(v[2], v[3]), pk2(v[4], v[5]), pk2(v[6], v[7]));
  }
}
__device__ __forceinline__ void phase_s5_fill_bc(const P& p) {
  u16* bty = (u16*)(p.ws + WS_BTY); u16* wet = (u16*)(p.ws + WS_WET);
  int gtid, gsz; if (!s5_setup_ids(gtid, gsz)) return;
  for (int item = gtid; item < 32 * 512 * 32; item += gsz) {
    const int ch = item & 31, n = (item >> 5) & 511, g = item >> 14;
    const int kk = ch * 8, dir = kk >> 7, p0 = (kk & 127) >> 1, i = n >> 4, c = n & 15;
    const int e = dir ? (32 - i) : (i + 1);
    float v[8];
#pragma unroll
    for (int q = 0; q < 4; ++q) {
      const int pq = p0 + q;
      const Cpx L = s5_lam(p, g, dir, e, pq);
      const Cpx C = {p.c_re[((dir * 32 + g) * 16 + c) * 64 + pq], p.c_im[((dir * 32 + g) * 16 + c) * 64 + pq]};
      const Cpx w = cmul(C, L);
      v[2 * q] = w.re; v[2 * q + 1] = -w.im;
    }
    *(uint4*)(bty + ((size_t)g * 512 + n) * 768 + 512 + kk) = make_uint4(pk2(v[0], v[1]), pk2(v[2], v[3]), pk2(v[4], v[5]), pk2(v[6], v[7]));
  }
  for (int item = gtid; item < 32 * 256 * 64; item += gsz) {
    const int ch = item & 63, n = (item >> 6) & 255, g = item >> 14;
    const int ip = ch >> 1, c0 = (ch & 1) * 8, ri = n & 1, pq = (n >> 1) & 63, dir = n >> 7;
    const int e = dir ? ip : (31 - ip);
    const Cpx w = cmul(s5_lam(p, g, dir, e, pq), s5_cf(p, g, dir, pq));
    float v[8];
#pragma unroll
    for (int j = 0; j < 8; ++j) {
      const float br = p.b_re[(g * 64 + pq) * 16 + c0 + j], bi = p.b_im[(g * 64 + pq) * 16 + c0 + j];
      v[j] = ri ? (w.re * bi + w.im * br) : (w.re * br - w.im * bi);
    }
    *(uint4*)(wet + ((size_t)g * 256 + n) * 512 + ch * 8) = make_uint4(pk2(v[0], v[1]), pk2(v[2], v[3]), pk2(v[4], v[5]), pk2(v[6], v[7]));
  }
}
__device__ __forceinline__ void phase_s5_carry(const P& p) {
  const float* E = (const float*)(p.ws + WS_E);
  u16* a2 = (u16*)(p.ws + WS_A2);
  const int gtid = blockIdx.x * NTHR + tidx(), gsz = gridDim.x * NTHR;
  for (int idx = gtid; idx < 32 * 8 * 128; idx += gsz) {
    const int pq = idx & 63, dir = (idx >> 6) & 1, b = (idx >> 7) & 7, g = idx >> 10;
    const Cpx L = s5_lam(p, g, dir, 32, pq);
    Cpx s = {0.f, 0.f};
    for (int jj = 0; jj < 64; ++jj) {
      const int j = dir ? 63 - jj : jj, r = b * 64 + j;
      const f32x2 e = *(const f32x2*)(E + ((size_t)g * 512 + r) * 256 + (dir * 64 + pq) * 2);
      *(unsigned*)(a2 + ((size_t)g * 512 + r) * 768 + 512 + (dir * 64 + pq) * 2) = pk2(s.re, s.im);
      const Cpx ns = cmul(L, s);
      s.re = ns.re + e[0]; s.im = ns.im + e[1];
    }
  }
}
constexpr int KSTR = 72;
__device__ __forceinline__ int t5_bucket_abs(int n) {
  return n < 8 ? n : 8 + (n >= 12) + (n >= 16) + (n >= 23) + (n >= 32) + (n >= 46) + (n >= 64) + (n >= 91);
}
__device__ __forceinline__ void phase_attn(const P& p, char* smem) {
  u16* sK = (u16*)smem; u16* sV = sK + 384 * KSTR; float* sBias = (float*)(sV + 384 * KSTR);
  const u16* q1 = (const u16*)(p.ws + WS_Z); const u16* k1 = (const u16*)(p.ws + WS_Z + 32 * MB); const u16* v1 = (const u16*)(p.ws + WS_Z + 40 * MB);
  u16* ao = (u16*)(p.ws + WS_YCAT);
  const int tid = tidx(), lane = tid & 63, wv = tid >> 6, fr = lane & 15, lg = lane >> 4, q0 = (wv & 3) * 32, hp = wv >> 2;
  const int tq = (lane & 15) >> 2, tp = lane & 3;
  for (int item = blockIdx.x; item < 512; item += gridDim.x) {
    const int b = item >> 6, nb = (item >> 2) & 15, kvh = item & 3;
    __syncthreads();
    for (int c = tid; c < 384 * 8; c += NTHR) {
      const int s = c >> 3, ch = (c & 7) * 8, pos = (nb - 1) * 128 + s;
      uint4 kq = make_uint4(0u, 0u, 0u, 0u), vq = kq;
      if (pos >= 0 && pos < SEQ) { kq = *(const uint4*)(k1 + (size_t)(b * SEQ + pos) * 256 + kvh * 64 + ch); vq = *(const uint4*)(v1 + (size_t)(b * SEQ + pos) * 256 + kvh * 64 + ch); }
      *(uint4*)(sK + s * KSTR + ch) = kq; *(uint4*)(sV + s * KSTR + ch) = vq;
    }
    for (int c = tid; c < 4 * 257; c += NTHR) {
      const int hq = c / 257, ri = c % 257, rel = ri - 128, n = rel < 0 ? -rel : rel;
      const int bucket = (rel > 0 ? 16 : 0) + t5_bucket_abs(n);
      sBias[hq * 260 + ri] = p.rel_bias[bucket * 16 + kvh * 4 + hq];
    }
    __syncthreads();
#pragma unroll 1
    for (int hh = 0; hh < 2; ++hh) {
      const int hq = hp * 2 + hh, head = kvh * 4 + hq;
      const size_t tok0 = (size_t)b * SEQ + nb * 128 + q0;
      uint4 qf[2][2];
#pragma unroll
      for (int qb = 0; qb < 2; ++qb)
#pragma unroll
        for (int ks = 0; ks < 2; ++ks) qf[qb][ks] = *(const uint4*)(q1 + (tok0 + qb * 16 + fr) * DM + head * 64 + ks * 32 + lg * 8);
      f32x4 O[4][2];
#pragma unroll
      for (int mb = 0; mb < 4; ++mb)
#pragma unroll
        for (int qb = 0; qb < 2; ++qb) O[mb][qb] = (f32x4){0.f, 0.f, 0.f, 0.f};
      const float sinkv = p.sink[head];
      float mrun[2] = {sinkv, sinkv}, lpart[2] = {lg == 0 ? 1.0f : 0.0f, lg == 0 ? 1.0f : 0.0f};
      const float* bias = sBias + hq * 260;
#pragma unroll
      for (int c = 0; c < 3; ++c) {
        if ((c == 0 && nb == 0) || (c == 2 && nb == 15)) continue;
        f32x4 S[8][2];
#pragma unroll
        for (int kb = 0; kb < 8; ++kb) {
          S[kb][0] = (f32x4){0.f, 0.f, 0.f, 0.f}; S[kb][1] = S[kb][0];
          const bool act = (c == 0) ? (16 * kb + 15 >= q0) : ((c == 2) ? (16 * kb <= q0 + 31) : true);
          if (act) {
#pragma unroll
            for (int ks = 0; ks < 2; ++ks) {
              const uint4 kf = *(const uint4*)(sK + (c * 128 + kb * 16 + fr) * KSTR + ks * 32 + lg * 8);
              S[kb][0] = mfma16(kf, qf[0][ks], S[kb][0]);
              S[kb][1] = mfma16(kf, qf[1][ks], S[kb][1]);
            }
          }
        }
        float cmax[2] = {-1e30f, -1e30f};
#pragma unroll
        for (int kb = 0; kb < 8; ++kb)
#pragma unroll
          for (int qb = 0; qb < 2; ++qb)
#pragma unroll
            for (int r = 0; r < 4; ++r) {
              const int ri = c * 128 + kb * 16 + 4 * lg + r - (q0 + qb * 16 + fr);
              float v;
              if (c == 1) v = S[kb][qb][r] + bias[ri];
              else { const bool valid = (ri >= 0) && (ri <= 256); v = valid ? S[kb][qb][r] + bias[valid ? ri : 0] : -1e30f; }
              S[kb][qb][r] = v; cmax[qb] = fmaxf(cmax[qb], v);
            }
#pragma unroll
        for (int qb = 0; qb < 2; ++qb) {
          cmax[qb] = fmaxf(cmax[qb], __shfl_xor(cmax[qb], 16)); cmax[qb] = fmaxf(cmax[qb], __shfl_xor(cmax[qb], 32));
          const float mn = fmaxf(mrun[qb], cmax[qb]), alpha = __expf(mrun[qb] - mn);
          mrun[qb] = mn; lpart[qb] *= alpha;
#pragma unroll
          for (int mb = 0; mb < 4; ++mb) O[mb][qb] = O[mb][qb] * alpha;
          float ps = 0.f;
#pragma unroll
          for (int kb = 0; kb < 8; ++kb)
#pragma unroll
            for (int r = 0; r < 4; ++r) { const float e = __expf(S[kb][qb][r] - mn); S[kb][qb][r] = e; ps += e; }
          lpart[qb] += ps;
        }
#pragma unroll
        for (int kk = 0; kk < 4; ++kk) {
          const int kb0 = 2 * kk, kb1 = 2 * kk + 1;
          const bool act = (c == 0) ? (16 * kb1 + 15 >= q0) : ((c == 2) ? (16 * kb0 <= q0 + 31) : true);
          if (act) {
            uint4 pf[2];
#pragma unroll
            for (int qb = 0; qb < 2; ++qb) pf[qb] = make_uint4(pk2(S[kb0][qb][0], S[kb0][qb][1]), pk2(S[kb0][qb][2], S[kb0][qb][3]), pk2(S[kb1][qb][0], S[kb1][qb][1]), pk2(S[kb1][qb][2], S[kb1][qb][3]));
#pragma unroll
            for (int mb = 0; mb < 4; ++mb) {
              const uint2 v0 = lds_tr16(sV + (c * 128 + kb0 * 16 + 4 * lg + tq) * KSTR + mb * 16 + 4 * tp);
              const uint2 v1r = lds_tr16(sV + (c * 128 + kb1 * 16 + 4 * lg + tq) * KSTR + mb * 16 + 4 * tp);
              const uint4 vf = make_uint4(v0.x, v0.y, v1r.x, v1r.y);
              O[mb][0] = mfma16(vf, pf[0], O[mb][0]);
              O[mb][1] = mfma16(vf, pf[1], O[mb][1]);
            }
          }
        }
      }
#pragma unroll
      for (int qb = 0; qb < 2; ++qb) {
        float lt = lpart[qb]; lt += __shfl_xor(lt, 16); lt += __shfl_xor(lt, 32);
        const float inv = 1.0f / lt;
#pragma unroll
        for (int mb = 0; mb < 4; ++mb) {
          uint2 w; w.x = pk2(O[mb][qb][0] * inv, O[mb][qb][1] * inv); w.y = pk2(O[mb][qb][2] * inv, O[mb][qb][3] * inv);
          *(uint2*)(ao + (tok0 + qb * 16 + fr) * DM + head * 64 + mb * 16 + 4 * lg) = w;
        }
      }
    }
  }
}

struct EpiInproj {
  u16* zb; u16* a2; const f32x2* rope;
  __device__ __forceinline__ void operator()(const f32x4 (&acc)[2][2][4][2], const pg8::Unit& u, int wr, int wc, int fr, int fq) const {
    const int seg = u.pn >> 1;
#pragma unroll
    for (int ai = 0; ai < 2; ++ai)
#pragma unroll
      for (int m = 0; m < 4; ++m) {
        const int row = u.pm * 256 + ai * 128 + wr * 64 + m * 16 + fr;
        if (seg < 2) {
          const int d = 16 * wc + 4 * fq;
          const f32x2* cs = rope + (size_t)(row & (SEQ - 1)) * 64 + d;
          const f32x4 c01 = *(const f32x4*)cs, c23 = *(const f32x4*)(cs + 2);
          const float cv[4] = {c01[0], c01[2], c23[0], c23[2]}, sv[4] = {c01[1], c01[3], c23[1], c23[3]};
          const float sc = seg == 1 ? 0.08838834764831845f : 1.0f;
#pragma unroll
          for (int bj = 0; bj < 2; ++bj) {
            const f32x4 x1 = acc[ai][bj][m][0], x2 = acc[ai][bj][m][1];
            float o1[4], o2[4];
#pragma unroll
            for (int r = 0; r < 4; ++r) { o1[r] = (x1[r] * cv[r] - x2[r] * sv[r]) * sc; o2[r] = (x1[r] * sv[r] + x2[r] * cv[r]) * sc; }
            u16* dst = zb + (size_t)seg * T_TOK * 512 + (size_t)row * 512 + ((u.pn & 1) * 2 + bj) * 128 + d;
            uint2 w; w.x = pk2(o1[0], o1[1]); w.y = pk2(o1[2], o1[3]); *(uint2*)dst = w;
            w.x = pk2(o2[0], o2[1]); w.y = pk2(o2[2], o2[3]); *(uint2*)(dst + 64) = w;
          }
        } else {
#pragma unroll
          for (int bj = 0; bj < 2; ++bj)
#pragma unroll
            for (int n = 0; n < 2; ++n) {
              const int col = u.pn * 256 + bj * 128 + wc * 32 + n * 16 + 4 * fq;
              const f32x4 v = acc[ai][bj][m][n];
              uint2 w; w.x = pk2(v[0], v[1]); w.y = pk2(v[2], v[3]);
              if (seg < 4) *(uint2*)(zb + (size_t)seg * T_TOK * 512 + (size_t)row * 512 + (col - seg * 512)) = w;
              else { const int ch = col - 2048, gi = ch >> 4, c = ch & 15; *(uint2*)(a2 + ((size_t)gi * 512 + (row >> 5)) * 768 + (row & 31) * 16 + c) = w; }
            }
        }
      }
  }
};
__device__ __forceinline__ void phase_inproj(const P& p, LAS unsigned char* lds) {
  pg8::DenseOrder S; S.init(p.ws + WS_XB, DM, p.ws + WS_WIN, T_TOK, 2560, DM);
  EpiInproj E{(u16*)(p.ws + WS_Z), (u16*)(p.ws + WS_A2), (const f32x2*)(p.ws + WS_ROPE)};
  pg8::gemm_phase<EpiInproj, pg8::DenseOrder, G_ALIGN, G_SP2>(lds, DM, S, E);
}
struct EpiS5E {
  float* E_;
  __device__ __forceinline__ void operator()(const f32x4 (&acc)[2][2][4][2], const pg8::Unit& u, int wr, int wc, int fr, int fq) const {
#pragma unroll
    for (int ai = 0; ai < 2; ++ai)
#pragma unroll
      for (int m = 0; m < 4; ++m) {
        const int row = u.pm * 256 + ai * 128 + wr * 64 + m * 16 + fr;
#pragma unroll
        for (int bj = 0; bj < 2; ++bj)
#pragma unroll
          for (int n = 0; n < 2; ++n) *(f32x4*)(E_ + ((size_t)u.e * 512 + row) * 256 + bj * 128 + wc * 32 + n * 16 + 4 * fq) = acc[ai][bj][m][n];
      }
  }
};
__device__ __forceinline__ void phase_s5_egemm(const P& p, LAS unsigned char* lds) {
  pg8::GroupOrder S; S.init(p.ws + WS_A2, 768, (size_t)512 * 768, p.ws + WS_WET, (size_t)256 * 512, 32, 512, 256, 512);
  EpiS5E E{(float*)(p.ws + WS_E)};
  pg8::gemm_phase<EpiS5E, pg8::GroupOrder, G_ALIGN, G_SP2>(lds, 512, S, E);
}
struct EpiS5Y {
  u16* yg;
  __device__ __forceinline__ void operator()(const f32x4 (&acc)[2][2][4][2], const pg8::Unit& u, int wr, int wc, int fr, int fq) const {
#pragma unroll
    for (int ai = 0; ai < 2; ++ai)
#pragma unroll
      for (int m = 0; m < 4; ++m) {
        const int row = u.pm * 256 + ai * 128 + wr * 64 + m * 16 + fr;
#pragma unroll
        for (int bj = 0; bj < 2; ++bj)
#pragma unroll
          for (int n = 0; n < 2; ++n) {
            const int col = u.pn * 256 + bj * 128 + wc * 32 + n * 16 + 4 * fq;
            const f32x4 v = acc[ai][bj][m][n];
            uint2 w; w.x = pk2(gelu_tanh(v[0]), gelu_tanh(v[1])); w.y = pk2(gelu_tanh(v[2]), gelu_tanh(v[3]));
            *(uint2*)(yg + ((size_t)row * 32 + (col >> 4)) * 512 + u.e * 16 + (col & 15)) = w;
          }
      }
  }
};
__device__ __forceinline__ void phase_s5_ygemm(const P& p, LAS unsigned char* lds) {
  pg8::GroupOrder S; S.init(p.ws + WS_A2, 768, (size_t)512 * 768, p.ws + WS_BTY, (size_t)512 * 768, 32, 512, 512, 768);
  EpiS5Y E{(u16*)(p.ws + WS_YGELU)};
  pg8::gemm_phase<EpiS5Y, pg8::GroupOrder, G_ALIGN, G_SP2>(lds, 768, S, E);
}
struct EpiGlu {
  const u16* yg; const float* bglu; u16* ycat;
  __device__ __forceinline__ void operator()(const f32x4 (&acc)[2][2][4][2], const pg8::Unit& u, int wr, int wc, int fr, int fq) const {
#pragma unroll
    for (int ai = 0; ai < 2; ++ai)
#pragma unroll
      for (int m = 0; m < 4; ++m) {
        const int row = u.pm * 256 + ai * 128 + wr * 64 + m * 16 + fr;
#pragma unroll
        for (int bj = 0; bj < 2; ++bj)
#pragma unroll
          for (int n = 0; n < 2; ++n) {
            const int col = u.pn * 256 + bj * 128 + wc * 32 + n * 16 + 4 * fq;
            const f32x4 v = acc[ai][bj][m][n];
            const uint2 yv = *(const uint2*)(yg + (size_t)row * 512 + col);
            const f32x4 bb = *(const f32x4*)(bglu + col);
            uint2 w;
            w.x = pk2(lo16(yv.x) * sigmoidf_(v[0] + bb[0]), hi16(yv.x) * sigmoidf_(v[1] + bb[1]));
            w.y = pk2(lo16(yv.y) * sigmoidf_(v[2] + bb[2]), hi16(yv.y) * sigmoidf_(v[3] + bb[3]));
            *(uint2*)(ycat + (size_t)row * DM + 512 + col) = w;
          }
      }
  }
};
__device__ __forceinline__ void phase_glu(const P& p, LAS unsigned char* lds) {
  pg8::DenseOrder S; S.init(p.ws + WS_YGELU, 512, p.ws + WS_WGLU, T_TOK, 512, 512);
  EpiGlu E{(const u16*)(p.ws + WS_YGELU), p.b_glu, (u16*)(p.ws + WS_YCAT)};
  pg8::gemm_phase<EpiGlu, pg8::DenseOrder, G_ALIGN, G_SP2>(lds, 512, S, E);
}
struct EpiResid {
  const float* xin; float* xout;
  __device__ __forceinline__ void operator()(const f32x4 (&acc)[2][2][4][2], const pg8::Unit& u, int wr, int wc, int fr, int fq) const {
#pragma unroll
    for (int ai = 0; ai < 2; ++ai)
#pragma unroll
      for (int m = 0; m < 4; ++m) {
        const int row = u.pm * 256 + ai * 128 + wr * 64 + m * 16 + fr;
#pragma unroll
        for (int bj = 0; bj < 2; ++bj)
#pragma unroll
          for (int n = 0; n < 2; ++n) {
            const size_t o = (size_t)row * DM + u.pn * 256 + bj * 128 + wc * 32 + n * 16 + 4 * fq;
            const f32x4 xv = *(const f32x4*)(xin + o);
            *(f32x4*)(xout + o) = xv + acc[ai][bj][m][n];
          }
      }
  }
};
__device__ __forceinline__ void phase_outproj(const P& p, const void* Wt, const float* xin, float* xout, LAS unsigned char* lds) {
  pg8::DenseOrder S; S.init(p.ws + WS_YCAT, DM, Wt, T_TOK, DM, DM);
  EpiResid E{xin, xout};
  pg8::gemm_phase<EpiResid, pg8::DenseOrder, G_ALIGN, G_SP2>(lds, DM, S, E);
}
struct EpiQkv {
  u16 *q1, *k1, *v1;
  __device__ __forceinline__ void operator()(const f32x4 (&acc)[2][2][4][2], const pg8::Unit& u, int wr, int wc, int fr, int fq) const {
#pragma unroll
    for (int ai = 0; ai < 2; ++ai)
#pragma unroll
      for (int m = 0; m < 4; ++m) {
        const int row = u.pm * 256 + ai * 128 + wr * 64 + m * 16 + fr;
#pragma unroll
        for (int bj = 0; bj < 2; ++bj)
#pragma unroll
          for (int n = 0; n < 2; ++n) {
            const int col = u.pn * 256 + bj * 128 + wc * 32 + n * 16 + 4 * fq;
            const f32x4 v = acc[ai][bj][m][n];
            uint2 w;
            if (u.pn < 4) { w.x = pk2(v[0] * 0.125f, v[1] * 0.125f); w.y = pk2(v[2] * 0.125f, v[3] * 0.125f); *(uint2*)(q1 + (size_t)row * DM + col) = w; }
            else {
              w.x = pk2(v[0], v[1]); w.y = pk2(v[2], v[3]);
              if (u.pn == 4) *(uint2*)(k1 + (size_t)row * 256 + (col - 1024)) = w; else *(uint2*)(v1 + (size_t)row * 256 + (col - 1280)) = w;
            }
          }
      }
  }
};
__device__ __forceinline__ void phase_qkv(const P& p, LAS unsigned char* lds) {
  pg8::DenseOrder S; S.init(p.ws + WS_XB, DM, p.ws + WS_WQKV, T_TOK, 1536, DM);
  EpiQkv E{(u16*)(p.ws + WS_Z), (u16*)(p.ws + WS_Z + 32 * MB), (u16*)(p.ws + WS_Z + 40 * MB)};
  pg8::gemm_phase<EpiQkv, pg8::DenseOrder, G_ALIGN, G_SP2>(lds, DM, S, E);
}
__device__ __forceinline__ void phase_moe_plan(const P& p, int layer, char* smem) {
  if (blockIdx.x != 0) return;
  using pg8::PLAN_STRIDE;
  const int tid = tidx();
  const int* cnt = (const int*)(p.ws + WS_CNT) + layer * 32;
  int* plan_n = (int*)(p.ws + WS_PLAN + layer * 65536); int4* plan = (int4*)(p.ws + WS_PLAN + layer * 65536 + 256);
  int* sc = (int*)smem;
  int* ecum = sc + 32; int* ebase = ecum + 32; int* ehb = ebase + 32; int* efull = ehb + 32; int* tot = efull + 32;
  int* sstart = tot + 8; int* sfstart = sstart + 8; int* cntF = sfstart + 8; int* cntR = cntF + 8;
  unsigned* keyR = (unsigned*)(cntR + 8);
  constexpr int NN = 4;
  __syncthreads();
  if (tid < 32) sc[tid] = cnt[tid];
  if (tid < 8) { sstart[tid] = 0x7fffffff; sfstart[tid] = 0; cntF[tid] = 0; cntR[tid] = 0; }
  if (tid < 128) keyR[tid] = 0xffffffffu;
  __syncthreads();
  if (tid == 0) {
    int cum = 0, ub = 0, hb = 0, fb = 0;
    for (int e = 0; e < 32; ++e) {
      const int c = sc[e], fl = c >> 8, rem = c & 255, rc = (rem + 63) >> 6, ntl = fl + (rem ? 1 : 0);
      ecum[e] = cum; ebase[e] = ub; ehb[e] = hb; efull[e] = fb;
      cum += (fl * 4 + rc) * NN; ub += ntl * NN; hb += ntl * 256; fb += fl * NN;
    }
    tot[0] = cum > 0 ? cum : 1; tot[1] = ub;
  }
  __syncthreads();
  const int total = tot[0], nunits = tot[1] < 1024 ? tot[1] : 1024;
  int4 en[2]; int ux[2], uF[2]; unsigned ukr[2]; bool ufull[2], uval[2];
#pragma unroll
  for (int q = 0; q < 2; ++q) {
    const int u = tid + q * NTHR;
    uval[q] = u < nunits; ux[q] = 0; uF[q] = 0; ukr[q] = 0; ufull[q] = true; en[q] = make_int4(0, 0, 0, 0);
    if (uval[q]) {
      int e = 0;
      for (int j = 1; j < 32; ++j) if (ebase[j] <= u) e = j;
      const int c = sc[e], fl = c >> 8, rem = c & 255, rc = (rem + 63) >> 6, ntl = fl + (rem ? 1 : 0);
      const int local = u - ebase[e], ct = local / ntl, rt = local - ct * ntl;
      const int cum = ecum[e] + ct * (fl * 4 + rc) + rt * 4;
      const bool isfull = rt < fl;
      int x = (cum * 8) / total; if (x > 7) x = 7;
      ux[q] = x; ufull[q] = isfull; uF[q] = efull[e] + ct * fl + (rt < fl ? rt : fl);
      en[q] = make_int4(e | (rt << 8) | (ct << 16), c, ehb[e], 0);
      atomicMin(&sstart[x], u);
      if (isfull) atomicAdd(&cntF[x], 1);
      else { atomicAdd(&cntR[x], 1); ukr[q] = ((unsigned)x << 16) | ((unsigned)(4 - rc) << 12) | (unsigned)(e * NN + ct); keyR[e * NN + ct] = ukr[q]; }
    }
  }
  __syncthreads();
#pragma unroll
  for (int q = 0; q < 2; ++q) if (uval[q] && (tid + q * NTHR) == sstart[ux[q]]) sfstart[ux[q]] = uF[q];
  __syncthreads();
#pragma unroll
  for (int q = 0; q < 2; ++q) {
    if (uval[q]) {
      const int x = ux[q];
      int pos;
      if (ufull[q]) pos = uF[q] - sfstart[x];
      else { pos = cntF[x]; for (int v = 0; v < 128; ++v) { const unsigned kv = keyR[v]; pos += ((kv >> 16) == (unsigned)x && kv < ukr[q]) ? 1 : 0; } }
      if (pos < PLAN_STRIDE) plan[x * PLAN_STRIDE + pos] = en[q];
    }
  }
  if (tid < 8) { const int n = cntF[tid] + cntR[tid]; plan_n[tid] = n < PLAN_STRIDE ? n : PLAN_STRIDE; }
  __syncthreads();
}
struct EpiMoe1 {
  u16* hbuf;
  __device__ __forceinline__ void operator()(const f32x4 (&acc)[2][2][4][2], const pg8::Unit& u, int wr, int wc, int fr, int fq) const {
#pragma unroll
    for (int ai = 0; ai < 2; ++ai)
#pragma unroll
      for (int m = 0; m < 4; ++m) {
        const int row = u.pm * 256 + ai * 128 + wr * 64 + m * 16 + fr;
        if (row < u.cnt) {
#pragma unroll
          for (int bj = 0; bj < 2; ++bj) {
            const f32x4 g = acc[ai][bj][m][0], up = acc[ai][bj][m][1];
            uint2 w; w.x = pk2(g[0] * sigmoidf_(g[0]) * up[0], g[1] * sigmoidf_(g[1]) * up[1]); w.y = pk2(g[2] * sigmoidf_(g[2]) * up[2], g[3] * sigmoidf_(g[3]) * up[3]);
            *(uint2*)(hbuf + (size_t)(u.hbase + row) * 512 + 16 * (8 * u.pn + 4 * bj + wc) + 4 * fq) = w;
          }
        }
      }
  }
};
__device__ __forceinline__ void phase_moe1(const P& p, int layer, LAS unsigned char* lds) {
  pg8::PlanOrder S; S.init(p.ws + WS_PLAN + layer * 65536, (const int*)(p.ws + WS_LIST), p.ws + WS_XB, DM, p.ws + (layer ? WS_MW1 : WS_MW0), (size_t)DM * DM, DM, true);
  EpiMoe1 E{(u16*)(p.ws + WS_H)};
  pg8::gemm_phase<EpiMoe1, pg8::PlanOrder, G_ALIGN, G_SP2>(lds, DM, S, E);
}
struct EpiMoe2 {
  const int* list; const float* gate; u16* slots;
  __device__ __forceinline__ void operator()(const f32x4 (&acc)[2][2][4][2], const pg8::Unit& u, int wr, int wc, int fr, int fq) const {
#pragma unroll
    for (int ai = 0; ai < 2; ++ai)
#pragma unroll
      for (int m = 0; m < 4; ++m) {
        const int row = u.pm * 256 + ai * 128 + wr * 64 + m * 16 + fr;
        if (row < u.cnt) {
          const int asg = list[(size_t)u.e * CAP + row];
          const float gt = gate[asg];
#pragma unroll
          for (int bj = 0; bj < 2; ++bj)
#pragma unroll
            for (int n = 0; n < 2; ++n) {
              const f32x4 v = acc[ai][bj][m][n];
              uint2 w; w.x = pk2(gt * v[0], gt * v[1]); w.y = pk2(gt * v[2], gt * v[3]);
              *(uint2*)(slots + (size_t)asg * DM + u.pn * 256 + bj * 128 + wc * 32 + n * 16 + 4 * fq) = w;
            }
        }
      }
  }
};
__device__ __forceinline__ void phase_moe2(const P& p, int layer, LAS unsigned char* lds) {
  pg8::PlanOrder S; S.init(p.ws + WS_PLAN + layer * 65536, (const int*)(p.ws + WS_LIST), p.ws + WS_H, 512, p.ws + (layer ? WS_MW1 : WS_MW0) + 64 * MB, (size_t)DM * 512, 512, false);
  EpiMoe2 E{(const int*)(p.ws + WS_LIST), (const float*)(p.ws + WS_GATE), (u16*)(p.ws + WS_INC)};
  pg8::gemm_phase<EpiMoe2, pg8::PlanOrder, G_ALIGN, G_SP2>(lds, 512, S, E);
}

#define XB_TMO      128
#define XB_XCNT(j)  (256  + 64 * (j))
#define XB_XSUB(j)  (1280 + 64 * (j))
#define XB_XGEN(j)  (2304 + 64 * (j))
#define XB_TOP      3328
#define XB_TOPGEN   3392
#define XCD_BAR_WORDS 3456
#define XB_SPIN_CAP (1u << 22)
__device__ __forceinline__ unsigned xb_ld(unsigned* p)              { return __hip_atomic_load(p, __ATOMIC_RELAXED, __HIP_MEMORY_SCOPE_AGENT); }
__device__ __forceinline__ unsigned xb_add(unsigned* p, unsigned v) { return __hip_atomic_fetch_add(p, v, __ATOMIC_RELAXED, __HIP_MEMORY_SCOPE_AGENT); }
__device__ __forceinline__ unsigned xb_xcc_id() { return (unsigned)__builtin_amdgcn_s_getreg((3 << 11) | 20) & 0xFu; }
#define XB_SPIN(cond, bar) do { unsigned _sp = 0; while (cond) { __builtin_amdgcn_s_sleep(1); \
    if ((++_sp & 255u) == 0u) { if (xb_ld(&(bar)[XB_TMO])) break; if (_sp > XB_SPIN_CAP) { atomicAdd(&(bar)[XB_TMO], 1u); break; } } } } while (0)
struct XcdBarrier { unsigned* bar; unsigned x; volatile LAS unsigned* st; };
__device__ __forceinline__ XcdBarrier xcd_barrier_post(unsigned* bar, volatile LAS unsigned* st) {
  XcdBarrier b; b.bar = bar; b.x = xb_xcc_id(); b.st = st;
  if (tidx() == 0) (void)xb_add(&bar[XB_XCNT(b.x)], 1u);
  return b;
}
__device__ __forceinline__ void xcd_barrier_complete(unsigned* bar, unsigned x, unsigned& nloc, unsigned& nx) {
  const unsigned G = gridDim.x * gridDim.y * gridDim.z;
  unsigned sum, cnt, mine, sp = 0u;
  for (;;) {
    sum = 0u; cnt = 0u; mine = 0u;
#pragma unroll
    for (unsigned j = 0; j < 16; ++j) { const unsigned c = xb_ld(&bar[XB_XCNT(j)]); sum += c; cnt += (c > 0u) ? 1u : 0u; mine = (j == x) ? c : mine; }
    if (sum == G) break;
    __builtin_amdgcn_s_sleep(1);
    if ((++sp & 255u) == 0u) { if (xb_ld(&bar[XB_TMO])) break; if (sp > XB_SPIN_CAP) { atomicAdd(&bar[XB_TMO], 1u); break; } }
  }
  nloc = mine > 0u ? mine : 1u; nx = cnt > 0u ? cnt : 1u;
}
__device__ __forceinline__ void xcd_barrier(const XcdBarrier& b) {
  asm volatile("s_waitcnt vmcnt(0)" ::: "memory");
  __syncthreads();
  if (tidx() == 0) {
    unsigned* bar = b.bar;
    __builtin_amdgcn_s_waitcnt(0);
    unsigned nloc = b.st[0], nx = b.st[1];
    if (nloc == 0u) { xcd_barrier_complete(bar, b.x, nloc, nx); b.st[0] = nloc; b.st[1] = nx; }
    const unsigned old = xb_add(&bar[XB_XSUB(b.x)], 1u);
    const unsigned gen = old / nloc;
    if (old + 1u == (gen + 1u) * nloc) {
      __builtin_amdgcn_fence(__ATOMIC_RELEASE, "agent");
      asm volatile("s_waitcnt vmcnt(0)" ::: "memory");
      const unsigned og = xb_add(&bar[XB_TOP], 1u);
      const unsigned tg = og / nx;
      if (og + 1u == (tg + 1u) * nx) xb_add(&bar[XB_TOPGEN], 1u);
      else XB_SPIN(xb_ld(&bar[XB_TOPGEN]) == tg, bar);
      __builtin_amdgcn_fence(__ATOMIC_ACQUIRE, "agent");
      xb_add(&bar[XB_XGEN(b.x)], 1u);
      asm volatile("s_waitcnt vmcnt(0)" ::: "memory");
    } else {
      XB_SPIN(xb_ld(&bar[XB_XGEN(b.x)]) == gen, bar);
      __builtin_amdgcn_fence(__ATOMIC_ACQUIRE, "agent");
      asm volatile("s_waitcnt vmcnt(0)" ::: "memory");
    }
  }
  __syncthreads();
}

constexpr int NPHASE = 20;
#ifndef C0A
#define C0A 25
#define C0B 70
#define C1A 65
#endif
constexpr int LDS_BYTES = 147456;
__device__ __forceinline__ void run_phase(const P& p, int ph, char* smem, LAS unsigned char* lds) {
  float* xa = (float*)(p.ws + WS_XA);
  const u16* slots = (const u16*)(p.ws + WS_INC);
  switch (ph) {
    case 0: phase_rowpass(p, p.x, nullptr, nullptr, p.norm_mix_g, -1, nullptr, smem); phase_prep(p); __syncthreads(); phase_conv_dense(p, smem); break;
    case 1: phase_inproj(p, lds); phase_s5_ktab(p); phase_s5_fill_bc(p); phase_conv_moe(p, 0, 0, cq(C0A), 128, 128, smem); break;
    case 2: phase_ret_inc_mfma(p, smem); __syncthreads(); phase_s5_egemm(p, lds); phase_s5_fill_a(p); break;
    case 3: phase_ret_scan16(p); phase_s5_carry(p); break;
    case 4: phase_ret_out_mfma(p, smem); __syncthreads(); phase_s5_ygemm(p, lds); break;
    case 5: phase_glu(p, lds); phase_conv_moe(p, 0, cq(C0A), cq(C0B), 128, 128, smem); break;
    case 6: phase_outproj(p, p.ws + WS_WOUT, p.x, xa, lds); break;
    case 7: phase_rowpass(p, xa, nullptr, nullptr, p.norm_ffn_g, 0, nullptr, smem); break;
    case 8: phase_moe_plan(p, 0, smem); phase_conv_moe(p, 0, cq(C0B), CONV_ITEMS, 1, 255, smem); break;
    case 9: phase_moe1(p, 0, lds); break;
    case 10: phase_moe2(p, 0, lds); break;
    case 11: phase_rowpass(p, xa, slots, xa, p.norm_mix_g + DM, -1, nullptr, smem); break;
    case 12: phase_qkv(p, lds); phase_conv_moe(p, 1, 0, cq(C1A), 128, 128, smem); break;
    case 13: phase_attn(p, smem); break;
    case 14: phase_outproj(p, p.ws + WS_WO, xa, xa, lds); break;
    case 15: phase_rowpass(p, xa, nullptr, nullptr, p.norm_ffn_g + DM, 1, nullptr, smem); break;
    case 16: phase_moe_plan(p, 1, smem); phase_conv_moe(p, 1, cq(C1A), CONV_ITEMS, 1, 255, smem); break;
    case 17: phase_moe1(p, 1, lds); break;
    case 18: phase_moe2(p, 1, lds); break;
    case 19: phase_rowpass(p, xa, slots, nullptr, p.norm_final_g, -1, p.out, smem); break;
    default: break;
  }
}

extern __shared__ __attribute__((aligned(16))) char dyn_smem[];

template <int PH> __device__ __forceinline__ void mega_steps(const P& p, char* smem, LAS unsigned char* lds, cg::grid_group& grid, const XcdBarrier& xb) {
  run_phase(p, PH, smem, lds);
  if constexpr (PH + 1 < NPHASE) {
    if constexpr (PH == 0) grid.sync(); else xcd_barrier(xb);
    mega_steps<PH + 1>(p, smem, lds, grid, xb);
  }
}
__global__ void __launch_bounds__(NTHR, 2) k_mega(P p) {
  cg::grid_group grid = cg::this_grid();
  LAS unsigned char* lds = (LAS unsigned char*)dyn_smem;
  volatile LAS unsigned* st = (volatile LAS unsigned*)(lds + LDS_BYTES - 16);
  if (tidx() == 0) { st[0] = 0u; st[1] = 0u; }
  __syncthreads();
  const XcdBarrier xb = xcd_barrier_post((unsigned*)(p.ws + WS_BAR), st);
  mega_steps<0>(p, dyn_smem, lds, grid, xb);
}

extern "C" void kernel_launch(void* const* d_in, const int* in_sizes, int n_in, void* d_out, int out_size, void* d_ws, size_t ws_size, hipStream_t stream) {
  static int grid_blocks = 0;
  if (grid_blocks == 0) {
    if (n_in != 28 || out_size != T_TOK * DM || ws_size < WS_END) { fprintf(stderr, "kernel_launch: unexpected problem (n_in %d out %d ws %zu need %zu)\n", n_in, out_size, ws_size, (size_t)WS_END); grid_blocks = -1; return; }
    int dev = 0, cus = 0, per_cu = 0;
    (void)hipGetDevice(&dev);
    (void)hipDeviceGetAttribute(&cus, hipDeviceAttributeMultiprocessorCount, dev);
    const void* fn = (const void*)k_mega;
    if (hipFuncSetAttribute(fn, hipFuncAttributeMaxDynamicSharedMemorySize, LDS_BYTES) != hipSuccess) { fprintf(stderr, "kernel_launch: hipFuncSetAttribute failed\n"); }
    if (hipOccupancyMaxActiveBlocksPerMultiprocessor(&per_cu, fn, NTHR, LDS_BYTES) != hipSuccess || per_cu < 1) { fprintf(stderr, "kernel_launch: occupancy query failed (%d)\n", per_cu); per_cu = 1; }
    (void)hipGetLastError();
    if (per_cu > 1) per_cu = 1;
    grid_blocks = cus * per_cu;
    fprintf(stderr, "kernel_launch: cus %d per_cu %d grid %d\n", cus, per_cu, grid_blocks);
  }
  if (grid_blocks < 0) return;
  P p{};
  const float** pp = (const float**)&p;
  for (int i = 0; i < 28; ++i) pp[i] = (const float*)d_in[i];
  p.out = (float*)d_out; p.ws = (char*)d_ws;
  (void)hipMemsetAsync((char*)d_ws + WS_BAR, 0, XCD_BAR_WORDS * 4, stream);
  void* args[] = {&p};
  hipError_t e = hipLaunchCooperativeKernel((const void*)k_mega, dim3(grid_blocks), dim3(NTHR), args, LDS_BYTES, stream);
  if (e != hipSuccess) fprintf(stderr, "cooperative launch failed: %s (grid %d)\n", hipGetErrorString(e), grid_blocks);
}
```

```cpp
#include <hip/hip_runtime.h>
#include <cstdio>
#include <cstdint>

#define USE_FP16 1
#define LAS __attribute__((address_space(3)))

typedef unsigned short u16;
typedef float f32x4 __attribute__((ext_vector_type(4)));
typedef float f32x2 __attribute__((ext_vector_type(2)));
typedef _Float16 f16x8 __attribute__((ext_vector_type(8)));

constexpr int T_TOK = 16384, DM = 1024, SEQ = 2048, NBATCH = 8;
constexpr int CAP = 32768;
constexpr int NTHR = 512, NWAVE = NTHR / 64;

constexpr size_t MB = 1024ull * 1024ull;
constexpr size_t WS_XA    = 0;
constexpr size_t WS_XB    = 64 * MB;
constexpr size_t WS_Z     = 96 * MB;
constexpr size_t WS_A2    = 160 * MB;
constexpr size_t WS_BTY   = 184 * MB;
constexpr size_t WS_MW1   = 160 * MB;
constexpr size_t WS_WET   = 208 * MB;
constexpr size_t WS_E     = 216 * MB;
constexpr size_t WS_KTAB  = 232 * MB;
constexpr size_t WS_SP16  = 234 * MB;
constexpr size_t WS_INC   = 266 * MB;
constexpr size_t WS_YCAT  = 330 * MB;
constexpr size_t WS_YGELU = 362 * MB;
constexpr size_t WS_H     = 330 * MB;
constexpr size_t WS_LIST  = 378 * MB;
constexpr size_t WS_GATE  = 382 * MB;
constexpr size_t WS_ROPE  = 383 * MB;
constexpr size_t WS_CNT   = 384 * MB;
constexpr size_t WS_WR16  = 385 * MB;
constexpr size_t WS_BAR   = 386 * MB;
constexpr size_t WS_PLAN  = 386 * MB + 512 * 1024;
constexpr size_t WS_WIN   = 387 * MB;
constexpr size_t WS_WGLU  = 392 * MB;
constexpr size_t WS_WOUT  = 393 * MB;
constexpr size_t WS_WQKV  = 395 * MB;
constexpr size_t WS_WO    = 398 * MB;
constexpr size_t WS_LAMT  = 400 * MB;
constexpr size_t WS_MW0   = 402 * MB;
constexpr size_t WS_END   = 498 * MB;

struct P {
  const float *x, *norm_mix_g, *norm_ffn_g, *norm_final_g, *w_in, *ret_decay, *a_re, *a_im, *log_step, *b_re, *b_im, *c_re, *c_im,
      *s5d, *w_glu, *b_glu, *w_out, *w_qkv, *sink, *w_o, *rel_bias, *w_group, *b_group, *w_er, *b_er, *w_gate, *w_up, *w_down;
  float* out;
  char* ws;
};

__device__ __forceinline__ u16 f2h(float f) { _Float16 h = (_Float16)f; return __builtin_bit_cast(u16, h); }
__device__ __forceinline__ float h2f(u16 h) { return (float)__builtin_bit_cast(_Float16, h); }
__device__ __forceinline__ unsigned pk2(float a, float b) { return (unsigned)f2h(a) | ((unsigned)f2h(b) << 16); }
__device__ __forceinline__ float lo16(unsigned w) { return h2f((u16)(w & 0xffffu)); }
__device__ __forceinline__ float hi16(unsigned w) { return h2f((u16)(w >> 16)); }
__device__ __forceinline__ f32x4 mfma16(uint4 a, uint4 b, f32x4 c) {
  return __builtin_amdgcn_mfma_f32_16x16x32_f16(__builtin_bit_cast(f16x8, a), __builtin_bit_cast(f16x8, b), c, 0, 0, 0);
}
__device__ __forceinline__ float wave_sum(float v) {
#pragma unroll
  for (int o = 1; o < 64; o <<= 1) v += __shfl_xor(v, o);
  return v;
}
__device__ __forceinline__ float sigmoidf_(float x) { return 1.0f / (1.0f + __expf(-x)); }
__device__ __forceinline__ float gelu_tanh(float x) {
  const float u = 0.7978845608028654f * (x + 0.044715f * x * x * x);
  return 0.5f * x * (1.0f + tanhf(u));
}
#define LDS_WAIT() asm volatile("s_waitcnt lgkmcnt(0)" ::: "memory")
__device__ __forceinline__ int tidx() { int t = threadIdx.x; asm volatile("" : "+v"(t)); return t; }

namespace pg8 {
constexpr int BM = 256, BK = 64, HALF = 128, HTB = HALF * BK * 2, STAGE_BYTES = 8 * HTB, NXCD = 8, WGM = 8;
__device__ __forceinline__ int lds_byte(int r, int c) { const int st = (r >> 4) * 2 + (c >> 5), rr = r & 15, cc = c & 31, ob = rr * 64 + cc * 2; return st * 1024 + (ob ^ (((ob >> 9) & 1) << 5)); }
__device__ __forceinline__ void stage_rc(int b, int& R, int& C) { const int st = b / 1024, sb = b % 1024, swz = sb ^ (((sb >> 9) & 1) << 5); R = (st >> 1) * 16 + swz / 64; C = (st & 1) * 32 + (swz % 64) / 2; }

struct Unit { const char* a; const char* b; int pm, pn, e, cnt, hbase; };

template <class Epi, class Sched, bool ALIGN_EPI, bool SP2>
__device__ __forceinline__ void gemm_phase(LAS unsigned char* lds, const int K, const Sched& S, const Epi& E) {
    const int tid = tidx(), wid = __builtin_amdgcn_readfirstlane(tid >> 6), lane = tid & 63, wr = wid >> 2, wc = wid & 3, fr = lane & 15, fq = lane >> 4;
    const int nt = K / BK;
    int Rr[2], Cc[2];
    unsigned voffB[2];
#pragma unroll
    for (int i = 0; i < 2; ++i) { stage_rc(tid * 16 + i * 8192, Rr[i], Cc[i]); voffB[i] = (unsigned)(Rr[i] * K + Cc[i]) * 2u; }
    const size_t kstep = (size_t)(BK * 2);
    const size_t hstepB = (size_t)HALF * K * 2;
    const unsigned ldsw = (unsigned)wid * 1024u;
    const int aoff = lds_byte(wr * 64 + fr, fq * 8), boff = lds_byte(wc * 32 + fr, fq * 8);
#define PG8_SA(b, h) (((b) * 2 + (h)) * HTB)
#define PG8_SB(b, h) ((4 + (b) * 2 + (h)) * HTB)
#define PG8_STAGE(bufoff, gbase, voff) do { _Pragma("unroll") for (int _i = 0; _i < 2; ++_i) \
        __builtin_amdgcn_global_load_lds((const unsigned*)((const char*)(gbase) + (voff)[_i]), (LAS unsigned*)(lds + (bufoff) + ldsw + _i * 8192), 16, 0, 0); } while (0)
#define PG8_LDA(dst, b, h) do { _Pragma("unroll") for (int m = 0; m < 4; ++m) _Pragma("unroll") for (int k = 0; k < 2; ++k) dst[m][k] = *(const LAS f16x8*)(lds + PG8_SA(b, h) + aoff + m * 2048 + k * 1024); } while (0)
#define PG8_LDB(dst, b, h) do { _Pragma("unroll") for (int n = 0; n < 2; ++n) _Pragma("unroll") for (int k = 0; k < 2; ++k) dst[n][k] = *(const LAS f16x8*)(lds + PG8_SB(b, h) + boff + n * 2048 + k * 1024); } while (0)
#define PG8_MMA(ai, bj, At, Bt) do { if (128 * (ai) + 64 * wr >= urows) break; __builtin_amdgcn_s_setprio(1); _Pragma("unroll") for (int m = 0; m < 4; ++m) _Pragma("unroll") for (int n = 0; n < 2; ++n) _Pragma("unroll") for (int k = 0; k < 2; ++k) \
        acc[ai][bj][m][n] = __builtin_amdgcn_mfma_f32_16x16x32_f16(Bt[n][k], At[m][k], acc[ai][bj][m][n], 0, 0, 0); __builtin_amdgcn_s_setprio(0); } while (0)
#define PG8_WAIT_V(n) asm volatile("s_waitcnt vmcnt(" #n ")" ::: "memory")
#define PG8_WAIT_L(n) asm volatile("s_waitcnt lgkmcnt(" #n ")" ::: "memory")
#define PG8_BAR __builtin_amdgcn_s_barrier()
#define PG8_SCHED __builtin_amdgcn_sched_barrier(0)
    Unit cur, nxt; int ui = 0;
    if (!S.next(0, cur)) return;
    unsigned cv0[2], cv1[2], nv0[2], nv1[2];
#pragma unroll
    for (int i = 0; i < 2; ++i) { cv0[i] = S.a_voff(cur, 0, Rr[i], Cc[i]); cv1[i] = S.a_voff(cur, 1, Rr[i], Cc[i]); }
    f32x4 acc[2][2][4][2];
#pragma unroll
    for (int a = 0; a < 2; ++a)
#pragma unroll
        for (int b = 0; b < 2; ++b)
#pragma unroll
            for (int m = 0; m < 4; ++m)
#pragma unroll
                for (int n = 0; n < 2; ++n) acc[a][b][m][n] = (f32x4){0.f, 0.f, 0.f, 0.f};
    f16x8 At[4][2], B0[2][2], B1[2][2];
    const char* cA = cur.a; const char* cB = cur.b;
    int urows = S.rows(cur);
    if constexpr (SP2) {
        PG8_STAGE(PG8_SB(0, 0), cB, voffB); PG8_STAGE(PG8_SB(0, 1), cB + hstepB, voffB); PG8_STAGE(PG8_SA(0, 0), cA, cv0); PG8_STAGE(PG8_SA(0, 1), cA, cv1);
        if (wr == 1) PG8_BAR;
        PG8_WAIT_V(2); PG8_BAR;
        PG8_STAGE(PG8_SB(1, 0), cB + kstep, voffB); PG8_STAGE(PG8_SA(1, 0), cA + kstep, cv0); PG8_STAGE(PG8_SB(1, 1), cB + hstepB + kstep, voffB);
        PG8_WAIT_V(6); PG8_BAR;
    } else {
        PG8_STAGE(PG8_SB(0, 0), cB, voffB); PG8_STAGE(PG8_SA(0, 0), cA, cv0); PG8_STAGE(PG8_SB(0, 1), cB + hstepB, voffB); PG8_STAGE(PG8_SA(0, 1), cA, cv1);
        if (wr == 1) PG8_BAR;
        PG8_WAIT_V(4); PG8_BAR;
        PG8_STAGE(PG8_SB(1, 0), cB + kstep, voffB); PG8_STAGE(PG8_SA(1, 0), cA + kstep, cv0); PG8_STAGE(PG8_SB(1, 1), cB + hstepB + kstep, voffB);
        PG8_WAIT_V(6); PG8_BAR;
    }
    for (;;) {
        const bool has_next = S.next(ui + 1, nxt);
        if (has_next) {
#pragma unroll
            for (int i = 0; i < 2; ++i) { nv0[i] = S.a_voff(nxt, 0, Rr[i], Cc[i]); nv1[i] = S.a_voff(nxt, 1, Rr[i], Cc[i]); }
        } else {
            nxt = cur;
#pragma unroll
            for (int i = 0; i < 2; ++i) { nv0[i] = cv0[i]; nv1[i] = cv1[i]; }
        }
        const char* nA = nxt.a; const char* nB = nxt.b;
        for (int t = 0; t < nt; t += 2) {
            const bool last = (t == nt - 2);
            const char* a1 = cA + (size_t)(t + 1) * kstep;
            const char* a2 = last ? nA : cA + (size_t)(t + 2) * kstep; const char* b2 = last ? nB : cB + (size_t)(t + 2) * kstep;
            const char* a3 = a2 + kstep; const char* b3 = b2 + kstep;
            unsigned v0[2], v1[2];
#pragma unroll
            for (int i = 0; i < 2; ++i) { v0[i] = last ? nv0[i] : cv0[i]; v1[i] = last ? nv1[i] : cv1[i]; }
            if constexpr (SP2) {
            PG8_LDB(B0, 0, 0); PG8_LDB(B1, 0, 1); PG8_SCHED; PG8_LDA(At, 0, 0); PG8_STAGE(PG8_SA(1, 1), a1, cv1);
            PG8_WAIT_V(8); PG8_WAIT_L(0); PG8_BAR; PG8_MMA(0, 0, At, B0); PG8_MMA(0, 1, At, B1); PG8_BAR; PG8_SCHED;
            PG8_LDA(At, 0, 1); PG8_STAGE(PG8_SB(0, 0), b2, voffB); PG8_STAGE(PG8_SB(0, 1), b2 + hstepB, voffB); PG8_STAGE(PG8_SA(0, 0), a2, v0);
            PG8_WAIT_V(8); PG8_WAIT_L(0); PG8_BAR; PG8_MMA(1, 0, At, B0); PG8_MMA(1, 1, At, B1); PG8_BAR; PG8_SCHED;
            PG8_LDB(B0, 1, 0); PG8_LDB(B1, 1, 1); PG8_SCHED; PG8_LDA(At, 1, 0); PG8_STAGE(PG8_SA(0, 1), a2, v1);
            PG8_WAIT_V(8); PG8_WAIT_L(0); PG8_BAR; PG8_MMA(0, 0, At, B0); PG8_MMA(0, 1, At, B1); PG8_BAR; PG8_SCHED;
            PG8_LDA(At, 1, 1); PG8_STAGE(PG8_SB(1, 0), b3, voffB); PG8_STAGE(PG8_SB(1, 1), b3 + hstepB, voffB); PG8_STAGE(PG8_SA(1, 0), a3, v0);
            PG8_WAIT_V(8); PG8_WAIT_L(0); PG8_BAR; PG8_MMA(1, 0, At, B0); PG8_MMA(1, 1, At, B1); PG8_BAR; PG8_SCHED;
            } else {
            PG8_LDB(B0, 0, 0); PG8_SCHED; PG8_LDA(At, 0, 0); PG8_STAGE(PG8_SA(1, 1), a1, cv1);
            PG8_WAIT_L(8); PG8_BAR; PG8_WAIT_L(0); PG8_MMA(0, 0, At, B0); PG8_BAR; PG8_SCHED;
            PG8_LDB(B1, 0, 1); PG8_STAGE(PG8_SB(0, 0), b2, voffB);
            PG8_BAR; PG8_WAIT_L(0); PG8_MMA(0, 1, At, B1); PG8_BAR;
            PG8_LDA(At, 0, 1); PG8_STAGE(PG8_SA(0, 0), a2, v0);
            PG8_BAR; PG8_WAIT_L(0); PG8_MMA(1, 0, At, B0); PG8_BAR; PG8_SCHED;
            PG8_STAGE(PG8_SB(0, 1), b2 + hstepB, voffB);
            PG8_WAIT_V(6); PG8_BAR; PG8_MMA(1, 1, At, B1); PG8_BAR;
            PG8_LDB(B0, 1, 0); PG8_SCHED; PG8_LDA(At, 1, 0); PG8_STAGE(PG8_SA(0, 1), a2, v1);
            PG8_WAIT_L(8); PG8_BAR; PG8_WAIT_L(0); PG8_MMA(0, 0, At, B0); PG8_BAR; PG8_SCHED;
            PG8_LDB(B1, 1, 1); PG8_STAGE(PG8_SB(1, 0), b3, voffB);
            PG8_BAR; PG8_WAIT_L(0); PG8_MMA(0, 1, At, B1); PG8_BAR;
            PG8_LDA(At, 1, 1); PG8_STAGE(PG8_SA(1, 0), a3, v0);
            PG8_BAR; PG8_WAIT_L(0); PG8_MMA(1, 0, At, B0); PG8_BAR; PG8_SCHED;
            PG8_STAGE(PG8_SB(1, 1), b3 + hstepB, voffB);
            PG8_WAIT_V(6); PG8_BAR; PG8_MMA(1, 1, At, B1); PG8_BAR;
            }
        }
        if constexpr (ALIGN_EPI) { if (wr == 0) PG8_BAR; }
        E(acc, cur, wr, wc, fr, fq);
        if (!has_next) break;
#pragma unroll
        for (int a = 0; a < 2; ++a)
#pragma unroll
            for (int b = 0; b < 2; ++b)
#pragma unroll
                for (int m = 0; m < 4; ++m)
#pragma unroll
                    for (int n = 0; n < 2; ++n) acc[a][b][m][n] = (f32x4){0.f, 0.f, 0.f, 0.f};
        cur = nxt; cA = nA; cB = nB; ++ui; urows = S.rows(cur);
#pragma unroll
        for (int i = 0; i < 2; ++i) { cv0[i] = nv0[i]; cv1[i] = nv1[i]; }
        if constexpr (ALIGN_EPI) { if (wr == 1) PG8_BAR; }
    }
    PG8_WAIT_V(0);
    if constexpr (!ALIGN_EPI) { if (wr == 0) PG8_BAR; }
    PG8_BAR;
#undef PG8_SA
#undef PG8_SB
#undef PG8_STAGE
#undef PG8_LDA
#undef PG8_LDB
#undef PG8_MMA
#undef PG8_WAIT_V
#undef PG8_WAIT_L
#undef PG8_BAR
#undef PG8_SCHED
}

struct DenseOrder {
    const char* A; const char* Bt; int lda_b, K, nM, nN, nwg, G, c;
    __device__ __forceinline__ void init(const void* A_, int lda_elems, const void* Bt_, int M, int N, int K_) { A = (const char*)A_; Bt = (const char*)Bt_; lda_b = lda_elems * 2; K = K_; nM = M / BM; nN = N / BM; nwg = nM * nN; G = gridDim.x; c = blockIdx.x; }
    __device__ __forceinline__ bool next(int i, Unit& u) const {
        const long L = (long)i * G + c; if (L >= nwg) return false;
        int wgid = (int)L; { const int q = nwg / NXCD, r = nwg % NXCD, xcd = wgid % NXCD, off = wgid / NXCD; wgid = (xcd < r ? xcd * (q + 1) : r * (q + 1) + (xcd - r) * q) + off; }
        const int nig = WGM * nN, gid = wgid / nig, fm = gid * WGM, gsz = (nM - fm) < WGM ? (nM - fm) : WGM;
        u.pm = fm + ((wgid % nig) % gsz); u.pn = (wgid % nig) / gsz; u.e = 0; u.cnt = 0; u.hbase = 0;
        u.a = A + (size_t)u.pm * BM * lda_b; u.b = Bt + (size_t)u.pn * BM * K * 2;
        return true;
    }
    __device__ __forceinline__ unsigned a_voff(const Unit&, int h, int R, int C) const { return (unsigned)((h * HALF + R) * lda_b + C * 2); }
    __device__ __forceinline__ int rows(const Unit&) const { return BM; }
};
struct GroupOrder {
    const char* A; const char* Bt; int lda_b, K, nM, nN, ng, G, c; size_t gsA, gsB;
    __device__ __forceinline__ void init(const void* A_, int lda_elems, size_t gsA_elems, const void* Bt_, size_t gsB_elems, int ng_, int M, int N, int K_) {
        A = (const char*)A_; Bt = (const char*)Bt_; lda_b = lda_elems * 2; K = K_; nM = M / BM; nN = N / BM; ng = ng_; gsA = gsA_elems * 2; gsB = gsB_elems * 2; G = gridDim.x; c = blockIdx.x; }
    __device__ __forceinline__ bool next(int i, Unit& u) const {
        const long L = (long)i * G + c; if (L >= (long)ng * nM * nN) return false;
        const int per = nM * nN, g = (int)L / per, r = (int)L % per;
        u.e = g; u.pm = r / nN; u.pn = r % nN; u.cnt = 0; u.hbase = 0;
        u.a = A + (size_t)g * gsA + (size_t)u.pm * BM * lda_b; u.b = Bt + (size_t)g * gsB + (size_t)u.pn * BM * K * 2;
        return true;
    }
    __device__ __forceinline__ unsigned a_voff(const Unit&, int h, int R, int C) const { return (unsigned)((h * HALF + R) * lda_b + C * 2); }
    __device__ __forceinline__ int rows(const Unit&) const { return BM; }
};
constexpr int PLAN_STRIDE = 256;
struct PlanOrder {
    const int4* plan; const int* plan_n; const int* list; const char* A; const char* Bt; int lda_b, K, x, ib, nbx; size_t esB; bool gather;
    __device__ __forceinline__ void init(const void* planbase, const int* list_, const void* A_, int lda_elems, const void* Bt_, size_t esB_elems, int K_, bool gather_) {
        plan_n = (const int*)planbase; plan = (const int4*)((const char*)planbase + 256); list = list_; A = (const char*)A_; Bt = (const char*)Bt_; lda_b = lda_elems * 2; K = K_; esB = esB_elems * 2; gather = gather_;
        x = blockIdx.x & 7; ib = blockIdx.x >> 3; nbx = ((int)gridDim.x - x + 7) >> 3; }
    __device__ __forceinline__ bool next(int i, Unit& u) const {
        const int j = i * nbx + ib;
        if (j >= plan_n[x]) return false;
        const int4 en = plan[x * PLAN_STRIDE + j];
        u.e = en.x & 255; u.pm = (en.x >> 8) & 255; u.pn = (en.x >> 16) & 255; u.cnt = en.y; u.hbase = en.z;
        u.a = gather ? A : A + (size_t)(u.hbase + u.pm * BM) * lda_b;
        u.b = Bt + (size_t)u.e * esB + (size_t)u.pn * BM * K * 2;
        return true;
    }
    __device__ __forceinline__ unsigned a_voff(const Unit& u, int h, int R, int C) const {
        if (!gather) return (unsigned)((h * HALF + R) * lda_b + C * 2);
        const int li = u.pm * BM + h * HALF + R;
        const int tok = (li < u.cnt) ? (list[(size_t)u.e * CAP + li] >> 1) : 0;
        return (unsigned)(tok * lda_b + C * 2);
    }
    __device__ __forceinline__ int rows(const Unit& u) const { const int r = u.cnt - u.pm * BM; return r < BM ? r : BM; }
};
}
constexpr bool G_ALIGN = true, G_SP2 = true;

__device__ __forceinline__ void phase_prep(const P& p) {
  const int gtid = blockIdx.x * NTHR + tidx(), gsz = gridDim.x * NTHR;
  int* cnt = (int*)(p.ws + WS_CNT);
  if (gtid < 64) cnt[gtid] = 0;
  f32x2* rope = (f32x2*)(p.ws + WS_ROPE);
  for (int i = gtid; i < SEQ * 64; i += gsz) {
    const int pos = i >> 6, f = i & 63;
    const float inv = powf(10000.0f, -(float)(2 * f) / 128.0f);
    const float ang = (float)pos * inv;
    float s, c; sincosf(ang, &s, &c);
    rope[i] = (f32x2){c, s};
  }
  f32x2* lamt = (f32x2*)(p.ws + WS_LAMT); f32x2* coeft = (f32x2*)(p.ws + WS_LAMT + 3 * MB / 2);
  for (int i = gtid; i < 32 * 2 * 33 * 64; i += gsz) {
    const int q = i & 63, l = (i >> 6) % 33, gd = i / (33 * 64);
    const int g = gd >> 1, dir = gd & 1;
    const float dt = expf(p.log_step[dir * 32 + g]), ar = p.a_re[(dir * 32 + g) * 64 + q], ai = p.a_im[(dir * 32 + g) * 64 + q];
    const float mag = expf(ar * dt * (float)l); float sn, cs; sincosf(ai * dt * (float)l, &sn, &cs);
    lamt[i] = (f32x2){mag * cs, mag * sn};
    if (l == 1) {
      const float em1 = expm1f(ar * dt), sh = sinf(0.5f * ai * dt);
      const float nr = em1 * cs - 2.0f * sh * sh, ni = (em1 + 1.0f) * sn, den = ar * ar + ai * ai;
      coeft[gd * 64 + q] = (f32x2){(nr * ar + ni * ai) / den, (ni * ar - nr * ai) / den};
    }
  }
  u16* wr16 = (u16*)(p.ws + WS_WR16);
  for (int i = gtid; i < 2 * 48 * DM; i += gsz) {
    const int k = i & (DM - 1), n = (i >> 10) % 48, layer = i / (48 * DM);
    float w = 0.f;
    if (n < 4) w = p.w_group[((size_t)layer * DM + k) * 4 + n];
    else if (n < 36) { const int gg = (n - 4) >> 3, j = (n - 4) & 7; w = p.w_er[(((size_t)layer * 4 + gg) * DM + k) * 8 + j]; }
    w *= p.norm_ffn_g[layer * DM + k];
    const u16 hi = f2h(w), lo = f2h(w - h2f(hi));
    wr16[((size_t)(layer * 2 + 0) * 48 + n) * DM + k] = hi;
    wr16[((size_t)(layer * 2 + 1) * 48 + n) * DM + k] = lo;
  }
}

template <class RowFn>
__device__ __forceinline__ void conv_item(const float* W, int ldw, int K, u16* WT, float* scr, int k0, int n0, int lane, RowFn rowfn) {
#pragma unroll 8
  for (int i = 0; i < 32; ++i) { const int kk = 2 * i + (lane >> 5); scr[kk * 33 + (lane & 31)] = W[(size_t)(k0 + kk) * ldw + n0 + (lane & 31)]; }
  LDS_WAIT();
  const int c = lane & 7;
#pragma unroll
  for (int j = 0; j < 4; ++j) {
    const int n = (lane >> 3) + 8 * j; const float* sp = scr + (8 * c) * 33 + n;
    uint4 o; o.x = pk2(sp[0 * 33], sp[1 * 33]); o.y = pk2(sp[2 * 33], sp[3 * 33]); o.z = pk2(sp[4 * 33], sp[5 * 33]); o.w = pk2(sp[6 * 33], sp[7 * 33]);
    *(uint4*)(WT + (size_t)rowfn(n0 + n) * K + k0 + 8 * c) = o;
  }
  LDS_WAIT();
}
template <class RowFn>
__device__ __forceinline__ int conv_matrix(const float* W, int ldw, int K, int N, u16* WT, char* smem, int item_base, RowFn rowfn) {
  const int lane = tidx() & 63, wv = tidx() >> 6, gw = blockIdx.x * NWAVE + wv, nw = gridDim.x * NWAVE;
  float* scr = (float*)smem + wv * (64 * 33);
  const int nkb = K / 64, nnb = N / 32, nitems = nkb * nnb;
  int it = gw - (item_base % nw); if (it < 0) it += nw;
  for (; it < nitems; it += nw) conv_item(W, ldw, K, WT, scr, (it / nnb) * 64, (it % nnb) * 32, lane, rowfn);
  return nitems;
}
__device__ __forceinline__ void phase_conv_dense(const P& p, char* smem) {
  auto id = [](int n) { return n; };
  int base = 0;
  base += conv_matrix(p.w_in, 2560, DM, 2560, (u16*)(p.ws + WS_WIN), smem, base, [](int n) { if (n >= 1024) return n; const int dd = n & 127, hf = dd >> 6, r = dd & 63; return (n & ~127) + 32 * (r >> 4) + 16 * hf + (r & 15); });
  base += conv_matrix(p.w_glu, 512, 512, 512, (u16*)(p.ws + WS_WGLU), smem, base, id);
  base += conv_matrix(p.w_out, DM, DM, DM, (u16*)(p.ws + WS_WOUT), smem, base, id);
  base += conv_matrix(p.w_qkv, 1536, DM, 1536, (u16*)(p.ws + WS_WQKV), smem, base, id);
  base += conv_matrix(p.w_o, DM, DM, DM, (u16*)(p.ws + WS_WO), smem, base, id);
}
__device__ __forceinline__ void phase_conv_moe(const P& p, int layer, int lo, int hi, int b0, int nb, char* smem) {
  if (gridDim.x != 256) { b0 = 0; nb = (int)gridDim.x; }
  if ((int)blockIdx.x < b0 || (int)blockIdx.x >= b0 + nb) return;
  const int lane = tidx() & 63, wv = tidx() >> 6, gw = ((int)blockIdx.x - b0) * NWAVE + wv, nw = nb * NWAVE;
  float* scr = (float*)smem + wv * (64 * 33);
  u16* w1t = (u16*)(p.ws + (layer ? WS_MW1 : WS_MW0)); u16* w2t = w1t + (size_t)32 * DM * DM;
  for (int it = lo + gw; it < hi; it += nw) {
    const int e = it / 768, r = it % 768;
    if (r < 512) {
      const int which = r >> 8, q = r & 255, k0 = (q >> 4) * 64, n0 = (q & 15) * 32;
      const float* W = (which ? p.w_up : p.w_gate) + (size_t)(layer * 32 + e) * DM * 512;
      conv_item(W, 512, DM, w1t + (size_t)e * DM * DM, scr, k0, n0, lane, [which](int n) { return (n >> 4) * 32 + which * 16 + (n & 15); });
    } else {
      const int q = r - 512, k0 = (q >> 5) * 64, n0 = (q & 31) * 32;
      const float* W = p.w_down + (size_t)(layer * 32 + e) * 512 * DM;
      conv_item(W, DM, 512, w2t + (size_t)e * DM * 512, scr, k0, n0, lane, [](int n) { return n; });
    }
  }
}

constexpr int CONV_ITEMS = 32 * 768;
constexpr int cq(int pct) { return (int)((long)CONV_ITEMS * pct / 100); }
__device__ __forceinline__ void phase_rowpass(const P& p, const float* src, const u16* slots, float* dstx, const float* gain, int route_layer, float* fout, char* smem) {
  const int lane = tidx() & 63, wv = tidx() >> 6, fr = lane & 15, lg = lane >> 4;
  u16* xb = (u16*)(p.ws + WS_XB);
  int* cnt = (int*)(p.ws + WS_CNT);
  int* list = (int*)(p.ws + WS_LIST);
  float* gate = (float*)(p.ws + WS_GATE);
  float* sRs = (float*)smem;
  float* sLg = (float*)smem + 64;
  for (int st = blockIdx.x; st < T_TOK / 64; st += gridDim.x) {
    const int row0 = st * 64 + wv * 8;
#pragma unroll 1
    for (int rp = 0; rp < 4; ++rp) {
      f32x4 v[2][4];
#pragma unroll
      for (int q = 0; q < 2; ++q) {
        const int row = row0 + rp * 2 + q;
#pragma unroll
        for (int i = 0; i < 4; ++i) v[q][i] = *(const f32x4*)(src + (size_t)row * DM + (i * 64 + lane) * 4);
      }
      if (slots) {
#pragma unroll
        for (int q = 0; q < 2; ++q) {
          const int row = row0 + rp * 2 + q;
          uint2 w[2][4];
#pragma unroll
          for (int sl = 0; sl < 2; ++sl)
#pragma unroll
            for (int i = 0; i < 4; ++i) w[sl][i] = *(const uint2*)(slots + ((size_t)row * 2 + sl) * DM + (i * 64 + lane) * 4);
#pragma unroll
          for (int sl = 0; sl < 2; ++sl)
#pragma unroll
            for (int i = 0; i < 4; ++i) { v[q][i][0] += lo16(w[sl][i].x); v[q][i][1] += hi16(w[sl][i].x); v[q][i][2] += lo16(w[sl][i].y); v[q][i][3] += hi16(w[sl][i].y); }
        }
      }
#pragma unroll
      for (int q = 0; q < 2; ++q) {
        const int row = row0 + rp * 2 + q;
        float ss = 0.f;
#pragma unroll
        for (int i = 0; i < 4; ++i) {
          if (dstx) *(f32x4*)(dstx + (size_t)row * DM + (i * 64 + lane) * 4) = v[q][i];
          ss += v[q][i][0] * v[q][i][0] + v[q][i][1] * v[q][i][1] + v[q][i][2] * v[q][i][2] + v[q][i][3] * v[q][i][3];
        }
        ss = wave_sum(ss);
        const float rstd = rsqrtf(ss * (1.0f / DM) + 1e-6f);
        if (route_layer >= 0 && lane == 0) sRs[wv * 8 + rp * 2 + q] = rstd;
#pragma unroll
        for (int i = 0; i < 4; ++i) {
          const int k = (i * 64 + lane) * 4;
          const f32x4 gv = *(const f32x4*)(gain + k);
          const f32x4 hv = v[q][i] * rstd * gv;
          if (fout) *(f32x4*)(fout + (size_t)row * DM + k) = hv;
          else { uint2 w; w.x = pk2(hv[0], hv[1]); w.y = pk2(hv[2], hv[3]); *(uint2*)(xb + (size_t)row * DM + k) = w; }
        }
      }
    }
    if (route_layer >= 0) {
      __syncthreads();
      const int tl = wv & 3, kh = wv >> 2;
      const float rsv = sRs[tl * 16 + fr];
      const float* xrow = src + (size_t)(st * 64 + tl * 16 + fr) * DM + kh * 512 + lg * 8;
      const u16* whi = (const u16*)(p.ws + WS_WR16) + ((size_t)(route_layer * 2 + 0) * 48 + fr) * DM + kh * 512 + lg * 8;
      const u16* wlo = (const u16*)(p.ws + WS_WR16) + ((size_t)(route_layer * 2 + 1) * 48 + fr) * DM + kh * 512 + lg * 8;
      f32x4 acc[3];
#pragma unroll
      for (int nb = 0; nb < 3; ++nb) acc[nb] = (f32x4){0.f, 0.f, 0.f, 0.f};
#pragma unroll 4
      for (int ks = 0; ks < 16; ++ks) {
        const f32x4 x0 = *(const f32x4*)(xrow + ks * 32), x1 = *(const f32x4*)(xrow + ks * 32 + 4);
        const float hv[8] = {x0[0] * rsv, x0[1] * rsv, x0[2] * rsv, x0[3] * rsv, x1[0] * rsv, x1[1] * rsv, x1[2] * rsv, x1[3] * rsv};
        unsigned ah[4], al[4];
#pragma unroll
        for (int j = 0; j < 4; ++j) {
          const u16 h0 = f2h(hv[2 * j]), h1 = f2h(hv[2 * j + 1]);
          ah[j] = (unsigned)h0 | ((unsigned)h1 << 16);
          al[j] = pk2(hv[2 * j] - h2f(h0), hv[2 * j + 1] - h2f(h1));
        }
        const uint4 ahi = make_uint4(ah[0], ah[1], ah[2], ah[3]), alo = make_uint4(al[0], al[1], al[2], al[3]);
#pragma unroll
        for (int nb = 0; nb < 3; ++nb) {
          const uint4 bh = *(const uint4*)(whi + (size_t)nb * 16 * DM + ks * 32), bl = *(const uint4*)(wlo + (size_t)nb * 16 * DM + ks * 32);
          acc[nb] = mfma16(bh, ahi, acc[nb]); acc[nb] = mfma16(bh, alo, acc[nb]); acc[nb] = mfma16(bl, ahi, acc[nb]);
        }
      }
      float* lgw = sLg + ((kh * 4 + tl) * 16 + fr) * 49;
#pragma unroll
      for (int nb = 0; nb < 3; ++nb)
#pragma unroll
        for (int r = 0; r < 4; ++r) lgw[nb * 16 + 4 * lg + r] = acc[nb][r];
      __syncthreads();
      if (wv < 4 && lane < 16) {
        const int row = st * 64 + wv * 16 + lane;
        const float* l0 = sLg + ((0 * 4 + wv) * 16 + lane) * 49;
        const float* l1 = sLg + ((1 * 4 + wv) * 16 + lane) * 49;
        const float* bg = p.b_group + route_layer * 4;
        const float* be = p.b_er + route_layer * 32;
        float gl[4];
#pragma unroll
        for (int j = 0; j < 4; ++j) gl[j] = l0[j] + l1[j] + bg[j];
        int gs = 0; float gm = gl[0];
#pragma unroll
        for (int j = 1; j < 4; ++j) if (gl[j] > gm) { gm = gl[j]; gs = j; }
        float den = 0.f;
#pragma unroll
        for (int j = 0; j < 4; ++j) den += expf(gl[j] - gm);
        const float pg = 1.0f / den;
        float el[8];
#pragma unroll
        for (int j = 0; j < 8; ++j) el[j] = l0[4 + gs * 8 + j] + l1[4 + gs * 8 + j] + be[gs * 8 + j];
        int i1 = 0; float v1 = el[0];
#pragma unroll
        for (int j = 1; j < 8; ++j) if (el[j] > v1) { v1 = el[j]; i1 = j; }
        int i2 = -1; float v2 = -3.0e38f;
#pragma unroll
        for (int j = 0; j < 8; ++j) if (j != i1 && el[j] > v2) { v2 = el[j]; i2 = j; }
        const float e2 = expf(v2 - v1);
        const float g1 = pg / (1.0f + e2), g2 = pg * e2 / (1.0f + e2);
        const int ex1 = gs * 8 + i1, ex2 = gs * 8 + i2;
        const int r1 = atomicAdd(&cnt[route_layer * 32 + ex1], 1);
        list[(size_t)ex1 * CAP + r1] = row * 2;
        gate[row * 2] = g1;
        const int r2 = atomicAdd(&cnt[route_layer * 32 + ex2], 1);
        list[(size_t)ex2 * CAP + r2] = row * 2 + 1;
        gate[row * 2 + 1] = g2;
      }
      __syncthreads();
    }
  }
}

constexpr int RSTR = 136;
__device__ __forceinline__ float log_sigmoid(float x) { return -log1pf(expf(-x)); }
__device__ __forceinline__ uint2 lds_tr16(const u16* ptr) {
  typedef short s16x4 __attribute__((ext_vector_type(4)));
  const s16x4 v = __builtin_amdgcn_ds_read_tr16_b64_v4i16((LAS s16x4*)ptr);
  return __builtin_bit_cast(uint2, v);
}
__device__ __forceinline__ uint4 lds_frag_T(const u16* tile, int rs, int k0, int c0, int lane) {
  const int g = lane >> 4, q = (lane & 15) >> 2, pp = lane & 3;
  const u16* a = tile + (k0 + 8 * g + q) * rs + c0 + 4 * pp;
  const uint2 lo = lds_tr16(a), hi = lds_tr16(a + 4 * rs);
  return make_uint4(lo.x, lo.y, hi.x, hi.y);
}
__device__ __forceinline__ void ret_load_tile(u16* dst0, u16* dst1, const u16* src, int t0, int h, const float* w0, const float* w1) {
  for (int c = tidx(); c < 128 * 16; c += NTHR) {
    const int i = c >> 4, ch = (c & 15) * 8;
    const uint4 v = *(const uint4*)(src + (size_t)(t0 + i) * 512 + h * 128 + ch);
    if (w0) {
      const float a = w0[i], b = w1[i];
      const float f[8] = {lo16(v.x), hi16(v.x), lo16(v.y), hi16(v.y), lo16(v.z), hi16(v.z), lo16(v.w), hi16(v.w)};
      *(uint4*)(dst0 + i * RSTR + ch) = make_uint4(pk2(f[0] * a, f[1] * a), pk2(f[2] * a, f[3] * a), pk2(f[4] * a, f[5] * a), pk2(f[6] * a, f[7] * a));
      *(uint4*)(dst1 + i * RSTR + ch) = make_uint4(pk2(f[0] * b, f[1] * b), pk2(f[2] * b, f[3] * b), pk2(f[4] * b, f[5] * b), pk2(f[6] * b, f[7] * b));
    } else *(uint4*)(dst0 + i * RSTR + ch) = v;
  }
}
template <int MB_, int NB_, bool ATR, bool BTR>
__device__ __forceinline__ void lds_mma(f32x4 (&acc)[MB_][NB_], const u16* sA, int sa, int a0, const u16* sB, int sb, int b0, int K, int lane, const float* sc) {
  const int fr = lane & 15, fq = lane >> 4;
  for (int k0 = 0; k0 < K; k0 += 32) {
    uint4 fa[MB_], fb[NB_];
#pragma unroll
    for (int m = 0; m < MB_; ++m) {
      if constexpr (ATR) fa[m] = lds_frag_T(sA, sa, k0, a0 + m * 16, lane);
      else fa[m] = *(const uint4*)(sA + (a0 + m * 16 + fr) * sa + k0 + fq * 8);
      if (sc) {
        const float f = sc[m];
        fa[m].x = pk2(lo16(fa[m].x) * f, hi16(fa[m].x) * f); fa[m].y = pk2(lo16(fa[m].y) * f, hi16(fa[m].y) * f);
        fa[m].z = pk2(lo16(fa[m].z) * f, hi16(fa[m].z) * f); fa[m].w = pk2(lo16(fa[m].w) * f, hi16(fa[m].w) * f);
      }
    }
#pragma unroll
    for (int n = 0; n < NB_; ++n) {
      if constexpr (BTR) fb[n] = lds_frag_T(sB, sb, k0, b0 + n * 16, lane);
      else fb[n] = *(const uint4*)(sB + (b0 + n * 16 + fr) * sb + k0 + fq * 8);
    }
#pragma unroll
    for (int m = 0; m < MB_; ++m)
#pragma unroll
      for (int n = 0; n < NB_; ++n) acc[m][n] = mfma16(fb[n], fa[m], acc[m][n]);
  }
}
__device__ __forceinline__ void ret_items(int ng, int& first, int& count, int& stride) {
  const int c = blockIdx.x, G = gridDim.x;
  if (G != 256) { first = c; count = (512 - c + G - 1) / G; stride = G; return; }
  stride = 1;
  if (c < ng) { first = c; count = 1; return; }
  const int rest = 512 - ng, nb = 256 - ng, q = rest / nb, r = rest % nb, i = c - ng;
  first = ng + i * q + (i < r ? i : r); count = q + (i < r ? 1 : 0);
}
__device__ __forceinline__ void phase_ret_inc_mfma(const P& p, char* smem) {
  u16* sKf = (u16*)smem; u16* sKb = sKf + 128 * RSTR; u16* sV = sKb + 128 * RSTR; float* sWf = (float*)(sV + 128 * RSTR); float* sWb = sWf + 128;
  const u16* kb = (const u16*)(p.ws + WS_Z) + (size_t)1 * T_TOK * 512; const u16* vb = (const u16*)(p.ws + WS_Z) + (size_t)2 * T_TOK * 512;
  float* incf = (float*)(p.ws + WS_INC); float* incb = incf + (size_t)512 * 16384;
  const int tid = tidx(), lane = tid & 63, wv = tid >> 6, wr = wv >> 1, wc = wv & 1, fr = lane & 15, fq = lane >> 4;
  int it_first, it_count, it_stride; ret_items(64, it_first, it_count, it_stride);
  for (int ii = 0; ii < it_count; ++ii) {
    const int item = it_first + ii * it_stride;
    const int h = item & 3, bn = item >> 2, t0 = bn * 128;
    const float lgf = log_sigmoid(p.ret_decay[h]), lgb = log_sigmoid(p.ret_decay[4 + h]);
    __syncthreads();
    if (tid < 128) { sWf[tid] = expf(lgf * (float)(127 - tid)); sWb[tid] = expf(lgb * (float)tid); }
    __syncthreads();
    ret_load_tile(sKf, sKb, kb, t0, h, sWf, sWb);
    ret_load_tile(sV, nullptr, vb, t0, h, nullptr, nullptr);
    __syncthreads();
#pragma unroll
    for (int dirn = 0; dirn < 2; ++dirn) {
      f32x4 acc[2][4];
#pragma unroll
      for (int m = 0; m < 2; ++m)
#pragma unroll
        for (int n = 0; n < 4; ++n) acc[m][n] = (f32x4){0.f, 0.f, 0.f, 0.f};
      lds_mma<2, 4, true, true>(acc, sV, RSTR, wr * 32, dirn ? sKb : sKf, RSTR, wc * 64, 128, lane, nullptr);
      float* o = (dirn ? incb : incf) + (size_t)item * 16384;
#pragma unroll
      for (int m = 0; m < 2; ++m)
#pragma unroll
        for (int n = 0; n < 4; ++n) *(f32x4*)(o + (wr * 32 + m * 16 + fr) * 128 + wc * 64 + n * 16 + 4 * fq) = acc[m][n];
    }
  }
}
__device__ __forceinline__ void phase_ret_scan16(const P& p) {
  const float* incf = (const float*)(p.ws + WS_INC); const float* incb = incf + (size_t)512 * 16384;
  u16* spf = (u16*)(p.ws + WS_SP16); u16* spb = spf + (size_t)512 * 16384;
  const int gtid = blockIdx.x * NTHR + tidx(), gsz = gridDim.x * NTHR;
  for (int idx = gtid; idx < 32 * 4096; idx += gsz) {
    const int de = (idx & 4095) * 4, bh = idx >> 12, b = bh >> 2, h = bh & 3;
    const float Gf = expf(128.0f * log_sigmoid(p.ret_decay[h])), Gb = expf(128.0f * log_sigmoid(p.ret_decay[4 + h]));
    f32x4 s = {0.f, 0.f, 0.f, 0.f};
    for (int n = 0; n < 16; ++n) {
      const size_t o = ((size_t)((b * 16 + n) * 4 + h)) * 16384 + de;
      const f32x4 t = *(const f32x4*)(incf + o);
      uint2 w; w.x = pk2(s[0], s[1]); w.y = pk2(s[2], s[3]); *(uint2*)(spf + o) = w;
      s = s * Gf + t;
    }
    s = (f32x4){0.f, 0.f, 0.f, 0.f};
    for (int n = 15; n >= 0; --n) {
      const size_t o = ((size_t)((b * 16 + n) * 4 + h)) * 16384 + de;
      const f32x4 t = *(const f32x4*)(incb + o);
      uint2 w; w.x = pk2(s[0], s[1]); w.y = pk2(s[2], s[3]); *(uint2*)(spb + o) = w;
      s = s * Gb + t;
    }
  }
}
__device__ __forceinline__ void phase_ret_out_mfma(const P& p, char* smem) {
  u16* R0 = (u16*)smem; u16* R1 = R0 + 128 * RSTR; u16* R2 = R1 + 128 * RSTR; u16* R3 = R2 + 128 * RSTR;
  float* sPf = (float*)(R3 + 128 * RSTR); float* sPb = sPf + 132;
  const u16* zb = (const u16*)(p.ws + WS_Z);
  const u16* qb = zb; const u16* kb = zb + (size_t)1 * T_TOK * 512; const u16* vb = zb + (size_t)2 * T_TOK * 512; const u16* gb = zb + (size_t)3 * T_TOK * 512;
  const u16* spf = (const u16*)(p.ws + WS_SP16); const u16* spb = spf + (size_t)512 * 16384;
  u16* ycat = (u16*)(p.ws + WS_YCAT);
  const int tid = tidx(), lane = tid & 63, wv = tid >> 6, wr = wv >> 1, wc = wv & 1, fr = lane & 15, fq = lane >> 4;
  int it_first, it_count, it_stride; ret_items(128, it_first, it_count, it_stride);
  for (int ii = 0; ii < it_count; ++ii) {
    const int item = it_first + ii * it_stride;
    const int h = item & 3, bn = item >> 2, t0 = bn * 128;
    const float lgf = log_sigmoid(p.ret_decay[h]), lgb = log_sigmoid(p.ret_decay[4 + h]);
    const u16* spT = spf + (size_t)item * 16384; const u16* snT = spb + (size_t)item * 16384;
    const int pe = tid >> 4, pch = (tid & 15) * 8;
    const uint4 pp0 = *(const uint4*)(spT + (pe + 0) * 128 + pch), pp1 = *(const uint4*)(spT + (pe + 32) * 128 + pch), pp2 = *(const uint4*)(spT + (pe + 64) * 128 + pch), pp3 = *(const uint4*)(spT + (pe + 96) * 128 + pch);
    __syncthreads();
    ret_load_tile(R0, nullptr, qb, t0, h, nullptr, nullptr);
    ret_load_tile(R1, nullptr, kb, t0, h, nullptr, nullptr);
    ret_load_tile(R2, nullptr, vb, t0, h, nullptr, nullptr);
    if (tid < 129) { sPf[tid] = expf(lgf * (float)tid); sPb[tid] = expf(lgb * (float)tid); }
    __syncthreads();
    {
      f32x4 acc[2][4];
#pragma unroll
      for (int m = 0; m < 2; ++m)
#pragma unroll
        for (int n = 0; n < 4; ++n) acc[m][n] = (f32x4){0.f, 0.f, 0.f, 0.f};
      lds_mma<2, 4, false, false>(acc, R0, RSTR, wr * 32, R1, RSTR, wc * 64, 128, lane, nullptr);
#pragma unroll
      for (int m = 0; m < 2; ++m)
#pragma unroll
        for (int n = 0; n < 4; ++n) {
          const int i = wr * 32 + m * 16 + fr, j = wc * 64 + n * 16 + 4 * fq;
          float v[4];
#pragma unroll
          for (int r = 0; r < 4; ++r) { const int jj = j + r; v[r] = acc[m][n][r] * ((i >= jj) ? sPf[i - jj] : sPb[jj - i]); }
          uint2 w; w.x = pk2(v[0], v[1]); w.y = pk2(v[2], v[3]);
          *(uint2*)(R3 + i * RSTR + j) = w;
        }
    }
    __syncthreads();
    *(uint4*)(R1 + (pe + 0) * RSTR + pch) = pp0; *(uint4*)(R1 + (pe + 32) * RSTR + pch) = pp1; *(uint4*)(R1 + (pe + 64) * RSTR + pch) = pp2; *(uint4*)(R1 + (pe + 96) * RSTR + pch) = pp3;
    const uint4 pn0 = *(const uint4*)(snT + (pe + 0) * 128 + pch), pn1 = *(const uint4*)(snT + (pe + 32) * 128 + pch), pn2 = *(const uint4*)(snT + (pe + 64) * 128 + pch), pn3 = *(const uint4*)(snT + (pe + 96) * 128 + pch);
    f32x4 o[1][8];
#pragma unroll
    for (int m = 0; m < 1; ++m)
#pragma unroll
      for (int n = 0; n < 8; ++n) o[m][n] = (f32x4){0.f, 0.f, 0.f, 0.f};
    lds_mma<1, 8, false, true>(o, R3, RSTR, wv * 16, R2, RSTR, 0, 128, lane, nullptr);
    __syncthreads();
    *(uint4*)(R2 + (pe + 0) * RSTR + pch) = pn0; *(uint4*)(R2 + (pe + 32) * RSTR + pch) = pn1; *(uint4*)(R2 + (pe + 64) * RSTR + pch) = pn2; *(uint4*)(R2 + (pe + 96) * RSTR + pch) = pn3;
    float scf[1], scb[1];
    { const int i = wv * 16 + fr; scf[0] = sPf[i + 1]; scb[0] = sPb[128 - i]; }
    lds_mma<1, 8, false, false>(o, R0, RSTR, wv * 16, R1, RSTR, 0, 128, lane, scf);
    __syncthreads();
    lds_mma<1, 8, false, false>(o, R0, RSTR, wv * 16, R2, RSTR, 0, 128, lane, scb);
#pragma unroll
    for (int m = 0; m < 1; ++m) {
      float s1 = 0.f;
#pragma unroll
      for (int n = 0; n < 8; ++n) s1 += (o[m][n][0] + o[m][n][1]) + (o[m][n][2] + o[m][n][3]);
      s1 += __shfl_xor(s1, 16); s1 += __shfl_xor(s1, 32);
      const float mu = s1 * (1.0f / 128.0f);
      float s2 = 0.f;
#pragma unroll
      for (int n = 0; n < 8; ++n)
#pragma unroll
        for (int r = 0; r < 4; ++r) { const float dl = o[m][n][r] - mu; s2 += dl * dl; }
      s2 += __shfl_xor(s2, 16); s2 += __shfl_xor(s2, 32);
      const float rs = rsqrtf(s2 * (1.0f / 128.0f) + 1e-5f);
      const size_t tok = (size_t)(t0 + wv * 16 + m * 16 + fr);
#pragma unroll
      for (int n = 0; n < 8; ++n) {
        const int e = n * 16 + 4 * fq;
        const uint2 gq = *(const uint2*)(gb + tok * 512 + h * 128 + e);
        const float g0 = lo16(gq.x), g1 = hi16(gq.x), g2 = lo16(gq.y), g3 = hi16(gq.y);
        uint2 w;
        w.x = pk2(g0 * sigmoidf_(g0) * (o[m][n][0] - mu) * rs, g1 * sigmoidf_(g1) * (o[m][n][1] - mu) * rs);
        w.y = pk2(g2 * sigmoidf_(g2) * (o[m][n][2] - mu) * rs, g3 * sigmoidf_(g3) * (o[m][n][3] - mu) * rs);
        *(uint2*)(ycat + tok * DM + h * 128 + e) = w;
      }
    }
  }
}

struct Cpx { float re, im; };
__device__ __forceinline__ Cpx cmul(Cpx a, Cpx b) { return {a.re * b.re - a.im * b.im, a.re * b.im + a.im * b.re}; }
__device__ __forceinline__ Cpx s5_lam(const P& p, int g, int dir, int l, int q) { const f32x2 v = ((const f32x2*)(p.ws + WS_LAMT))[((g * 2 + dir) * 33 + l) * 64 + q]; return {v[0], v[1]}; }
__device__ __forceinline__ Cpx s5_cf(const P& p, int g, int dir, int q) { const f32x2 v = ((const f32x2*)(p.ws + WS_LAMT + 3 * MB / 2))[(g * 2 + dir) * 64 + q]; return {v[0], v[1]}; }
__device__ __forceinline__ bool s5_setup_ids(int& gtid, int& gsz) {
  const bool half = (gridDim.x == 256);
  if (half && blockIdx.x < 128) return false;
  gtid = (half ? (int)blockIdx.x - 128 : (int)blockIdx.x) * NTHR + tidx(); gsz = (half ? 128 : (int)gridDim.x) * NTHR;
  return true;
}
__device__ __forceinline__ void phase_s5_ktab(const P& p) {
  float* ktab = (float*)(p.ws + WS_KTAB);
  int gtid, gsz; if (!s5_setup_ids(gtid, gsz)) return;
  for (int item = gtid; item < 32 * 2 * 32 * 16; item += gsz) {
    const int c = item & 15, l = (item >> 4) & 31, dir = (item >> 9) & 1, g = item >> 10;
    float acc[16];
#pragma unroll
    for (int j = 0; j < 16; ++j) acc[j] = 0.f;
    for (int q = 0; q < 64; ++q) {
      const Cpx L = s5_lam(p, g, dir, l, q), cf = s5_cf(p, g, dir, q);
      const Cpx C = {p.c_re[((dir * 32 + g) * 16 + c) * 64 + q], p.c_im[((dir * 32 + g) * 16 + c) * 64 + q]};
      const Cpx w = cmul(cmul(C, L), cf);
#pragma unroll
      for (int j = 0; j < 16; ++j) acc[j] += w.re * p.b_re[(g * 64 + q) * 16 + j] - w.im * p.b_im[(g * 64 + q) * 16 + j];
    }
#pragma unroll
    for (int j = 0; j < 16; j += 4) *(f32x4*)(ktab + (size_t)item * 16 + j) = (f32x4){acc[j], acc[j + 1], acc[j + 2], acc[j + 3]};
  }
}
__device__ __forceinline__ void phase_s5_fill_a(const P& p) {
  const float* ktab = (const float*)(p.ws + WS_KTAB);
  u16* bty = (u16*)(p.ws + WS_BTY);
  const int gtid = blockIdx.x * NTHR + tidx(), gsz = gridDim.x * NTHR;
  for (int item = gtid; item < 32 * 512 * 64; item += gsz) {
    const int ch = item & 63, n = (item >> 6) & 511, g = item >> 15;
    const int ip = ch >> 1, c0 = (ch & 1) * 8, i = n >> 4, c = n & 15;
    float v[8];
    if (ip != i) {
      const int dir = ip < i ? 0 : 1, l = ip < i ? i - ip : ip - i;
      const float* src = ktab + ((size_t)((g * 2 + dir) * 32 + l) * 16 + c) * 16 + c0;
      const f32x4 a = *(const f32x4*)src, b = *(const f32x4*)(src + 4);
      v[0] = a[0]; v[1] = a[1]; v[2] = a[2]; v[3] = a[3]; v[4] = b[0]; v[5] = b[1]; v[6] = b[2]; v[7] = b[3];
    } else {
      const float* s0 = ktab + ((size_t)((g * 2 + 0) * 32) * 16 + c) * 16 + c0;
      const float* s1 = ktab + ((size_t)((g * 2 + 1) * 32) * 16 + c) * 16 + c0;
      const float dd = p.s5d[g * 16 + c];
#pragma unroll
      for (int j = 0; j < 8; ++j) v[j] = s0[j] + s1[j] + ((c0 + j) == c ? dd : 0.f);
    }
    *(uint4*)(bty + ((size_t)g * 512 + n) * 768 + ch * 8) = make_uint4(pk2(v[0], v[1]), pk2(v[2], v[3]), pk2(v[4], v[5]), pk2(v[6], v[7]));
  }
}
__device__ __forceinline__ void phase_s5_fill_bc(const P& p) {
  u16* bty = (u16*)(p.ws + WS_BTY); u16* wet = (u16*)(p.ws + WS_WET);
  int gtid, gsz; if (!s5_setup_ids(gtid, gsz)) return;
  for (int item = gtid; item < 32 * 512 * 32; item += gsz) {
    const int ch = item & 31, n = (item >> 5) & 511, g = item >> 14;
    const int kk = ch * 8, dir = kk >> 7, p0 = (kk & 127) >> 1, i = n >> 4, c = n & 15;
    const int e = dir ? (32 - i) : (i + 1);
    float v[8];
#pragma unroll
    for (int q = 0; q < 4; ++q) {
      const int pq = p0 + q;
      const Cpx L = s5_lam(p, g, dir, e, pq);
      const Cpx C = {p.c_re[((dir * 32 + g) * 16 + c) * 64 + pq], p.c_im[((dir * 32 + g) * 16 + c) * 64 + pq]};
      const Cpx w = cmul(C, L);
      v[2 * q] = w.re; v[2 * q + 1] = -w.im;
    }
    *(uint4*)(bty + ((size_t)g * 512 + n) * 768 + 512 + kk) = make_uint4(pk2(v[0], v[1]), pk2(v[2], v[3]), pk2(v[4], v[5]), pk2(v[6], v[7]));
  }
  for (int item = gtid; item < 32 * 256 * 64; item += gsz) {
    const int ch = item & 63, n = (item >> 6) & 255, g = item >> 14;
    const int ip = ch >> 1, c0 = (ch & 1) * 8, ri = n & 1, pq = (n >> 1) & 63, dir = n >> 7;
    const int e = dir ? ip : (31 - ip);
    const Cpx w = cmul(s5_lam(p, g, dir, e, pq), s5_cf(p, g, dir, pq));
    float v[8];
#pragma unroll
    for (int j = 0; j < 8; ++j) {
      const float br = p.b_re[(g * 64 + pq) * 16 + c0 + j], bi = p.b_im[(g * 64 + pq) * 16 + c0 + j];
      v[j] = ri ? (w.re * bi + w.im * br) : (w.re * br - w.im * bi);
    }
    *(uint4*)(wet + ((size_t)g * 256 + n) * 512 + ch * 8) = make_uint4(pk2(v[0], v[1]), pk2(v[2], v[3]), pk2(v[4], v[5]), pk2(v[6], v[7]));
  }
}
__device__ __forceinline__ void phase_s5_carry(const P& p) {
  const float* E = (const float*)(p.ws + WS_E);
  u16* a2 = (u16*)(p.ws + WS_A2);
  const int gtid = blockIdx.x * NTHR + tidx(), gsz = gridDim.x * NTHR;
  for (int idx = gtid; idx < 32 * 8 * 128; idx += gsz) {
    const int pq = idx & 63, dir = (idx >> 6) & 1, b = (idx >> 7) & 7, g = idx >> 10;
    const Cpx L = s5_lam(p, g, dir, 32, pq);
    Cpx s = {0.f, 0.f};
    for (int jj = 0; jj < 64; ++jj) {
      const int j = dir ? 63 - jj : jj, r = b * 64 + j;
      const f32x2 e = *(const f32x2*)(E + ((size_t)g * 512 + r) * 256 + (dir * 64 + pq) * 2);
      *(unsigned*)(a2 + ((size_t)g * 512 + r) * 768 + 512 + (dir * 64 + pq) * 2) = pk2(s.re, s.im);
      const Cpx ns = cmul(L, s);
      s.re = ns.re + e[0]; s.im = ns.im + e[1];
    }
  }
}
constexpr int KSTR = 72;
__device__ __forceinline__ int t5_bucket_abs(int n) {
  return n < 8 ? n : 8 + (n >= 12) + (n >= 16) + (n >= 23) + (n >= 32) + (n >= 46) + (n >= 64) + (n >= 91);
}
__device__ __forceinline__ void phase_attn(const P& p, char* smem) {
  u16* sK = (u16*)smem; u16* sV = sK + 384 * KSTR; float* sBias = (float*)(sV + 384 * KSTR);
  const u16* q1 = (const u16*)(p.ws + WS_Z); const u16* k1 = (const u16*)(p.ws + WS_Z + 32 * MB); const u16* v1 = (const u16*)(p.ws + WS_Z + 40 * MB);
  u16* ao = (u16*)(p.ws + WS_YCAT);
  const int tid = tidx(), lane = tid & 63, wv = tid >> 6, fr = lane & 15, lg = lane >> 4, q0 = (wv & 3) * 32, hp = wv >> 2;
  const int tq = (lane & 15) >> 2, tp = lane & 3;
  for (int item = blockIdx.x; item < 512; item += gridDim.x) {
    const int b = item >> 6, nb = (item >> 2) & 15, kvh = item & 3;
    __syncthreads();
    for (int c = tid; c < 384 * 8; c += NTHR) {
      const int s = c >> 3, ch = (c & 7) * 8, pos = (nb - 1) * 128 + s;
      uint4 kq = make_uint4(0u, 0u, 0u, 0u), vq = kq;
      if (pos >= 0 && pos < SEQ) { kq = *(const uint4*)(k1 + (size_t)(b * SEQ + pos) * 256 + kvh * 64 + ch); vq = *(const uint4*)(v1 + (size_t)(b * SEQ + pos) * 256 + kvh * 64 + ch); }
      *(uint4*)(sK + s * KSTR + ch) = kq; *(uint4*)(sV + s * KSTR + ch) = vq;
    }
    for (int c = tid; c < 4 * 257; c += NTHR) {
      const int hq = c / 257, ri = c % 257, rel = ri - 128, n = rel < 0 ? -rel : rel;
      const int bucket = (rel > 0 ? 16 : 0) + t5_bucket_abs(n);
      sBias[hq * 260 + ri] = p.rel_bias[bucket * 16 + kvh * 4 + hq];
    }
    __syncthreads();
#pragma unroll 1
    for (int hh = 0; hh < 2; ++hh) {
      const int hq = hp * 2 + hh, head = kvh * 4 + hq;
      const size_t tok0 = (size_t)b * SEQ + nb * 128 + q0;
      uint4 qf[2][2];
#pragma unroll
      for (int qb = 0; qb < 2; ++qb)
#pragma unroll
        for (int ks = 0; ks < 2; ++ks) qf[qb][ks] = *(const uint4*)(q1 + (tok0 + qb * 16 + fr) * DM + head * 64 + ks * 32 + lg * 8);
      f32x4 O[4][2];
#pragma unroll
      for (int mb = 0; mb < 4; ++mb)
#pragma unroll
        for (int qb = 0; qb < 2; ++qb) O[mb][qb] = (f32x4){0.f, 0.f, 0.f, 0.f};
      const float sinkv = p.sink[head];
      float mrun[2] = {sinkv, sinkv}, lpart[2] = {lg == 0 ? 1.0f : 0.0f, lg == 0 ? 1.0f : 0.0f};
      const float* bias = sBias + hq * 260;
#pragma unroll
      for (int c = 0; c < 3; ++c) {
        if ((c == 0 && nb == 0) || (c == 2 && nb == 15)) continue;
        f32x4 S[8][2];
#pragma unroll
        for (int kb = 0; kb < 8; ++kb) {
          S[kb][0] = (f32x4){0.f, 0.f, 0.f, 0.f}; S[kb][1] = S[kb][0];
          const bool act = (c == 0) ? (16 * kb + 15 >= q0) : ((c == 2) ? (16 * kb <= q0 + 31) : true);
          if (act) {
#pragma unroll
            for (int ks = 0; ks < 2; ++ks) {
              const uint4 kf = *(const uint4*)(sK + (c * 128 + kb * 16 + fr) * KSTR + ks * 32 + lg * 8);
              S[kb][0] = mfma16(kf, qf[0][ks], S[kb][0]);
              S[kb][1] = mfma16(kf, qf[1][ks], S[kb][1]);
            }
          }
        }
        float cmax[2] = {-1e30f, -1e30f};
#pragma unroll
        for (int kb = 0; kb < 8; ++kb)
#pragma unroll
          for (int qb = 0; qb < 2; ++qb)
#pragma unroll
            for (int r = 0; r < 4; ++r) {
              const int ri = c * 128 + kb * 16 + 4 * lg + r - (q0 + qb * 16 + fr);
              float v;
              if (c == 1) v = S[kb][qb][r] + bias[ri];
              else { const bool valid = (ri >= 0) && (ri <= 256); v = valid ? S[kb][qb][r] + bias[valid ? ri : 0] : -1e30f; }
              S[kb][qb][r] = v; cmax[qb] = fmaxf(cmax[qb], v);
            }
#pragma unroll
        for (int qb = 0; qb < 2; ++qb) {
          cmax[qb] = fmaxf(cmax[qb], __shfl_xor(cmax[qb], 16)); cmax[qb] = fmaxf(cmax[qb], __shfl_xor(cmax[qb], 32));
          const float mn = fmaxf(mrun[qb], cmax[qb]), alpha = __expf(mrun[qb] - mn);
          mrun[qb] = mn; lpart[qb] *= alpha;
#pragma unroll
          for (int mb = 0; mb < 4; ++mb) O[mb][qb] = O[mb][qb] * alpha;
          float ps = 0.f;
#pragma unroll
          for (int kb = 0; kb < 8; ++kb)
#pragma unroll
            for (int r = 0; r < 4; ++r) { const float e = __expf(S[kb][qb][r] - mn); S[kb][qb][r] = e; ps += e; }
          lpart[qb] += ps;
        }
#pragma unroll
        for (int kk = 0; kk < 4; ++kk) {
          const int kb0 = 2 * kk, kb1 = 2 * kk + 1;
          const bool act = (c == 0) ? (16 * kb1 + 15 >= q0) : ((c == 2) ? (16 * kb0 <= q0 + 31) : true);
          if (act) {
            uint4 pf[2];
#pragma unroll
            for (int qb = 0; qb < 2; ++qb) pf[qb] = make_uint4(pk2(S[kb0][qb][0], S[kb0][qb][1]), pk2(S[kb0][qb][2], S[kb0][qb][3]), pk2(S[kb1][qb][0], S[kb1][qb][1]), pk2(S[kb1][qb][2], S[kb1][qb][3]));
#pragma unroll
            for (int mb = 0; mb < 4; ++mb) {
              const uint2 v0 = lds_tr16(sV + (c * 128 + kb0 * 16 + 4 * lg + tq) * KSTR + mb * 16 + 4 * tp);
              const uint2 v1r = lds_tr16(sV + (c * 128 + kb1 * 16 + 4 * lg + tq) * KSTR + mb * 16 + 4 * tp);
              const uint4 vf = make_uint4(v0.x, v0.y, v1r.x, v1r.y);
              O[mb][0] = mfma16(vf, pf[0], O[mb][0]);
              O[mb][1] = mfma16(vf, pf[1], O[mb][1]);
            }
          }
        }
      }
#pragma unroll
      for (int qb = 0; qb < 2; ++qb) {
        float lt = lpart[qb]; lt += __shfl_xor(lt, 16); lt += __shfl_xor(lt, 32);
        const float inv = 1.0f / lt;
#pragma unroll
        for (int mb = 0; mb < 4; ++mb) {
          uint2 w; w.x = pk2(O[mb][qb][0] * inv, O[mb][qb][1] * inv); w.y = pk2(O[mb][qb][2] * inv, O[mb][qb][3] * inv);
          *(uint2*)(ao + (tok0 + qb * 16 + fr) * DM + head * 64 + mb * 16 + 4 * lg) = w;
        }
      }
    }
  }
}

struct EpiInproj {
  u16* zb; u16* a2; const f32x2* rope;
  __device__ __forceinline__ void operator()(const f32x4 (&acc)[2][2][4][2], const pg8::Unit& u, int wr, int wc, int fr, int fq) const {
    const int seg = u.pn >> 1;
#pragma unroll
    for (int ai = 0; ai < 2; ++ai)
#pragma unroll
      for (int m = 0; m < 4; ++m) {
        const int row = u.pm * 256 + ai * 128 + wr * 64 + m * 16 + fr;
        if (seg < 2) {
          const int d = 16 * wc + 4 * fq;
          const f32x2* cs = rope + (size_t)(row & (SEQ - 1)) * 64 + d;
          const f32x4 c01 = *(const f32x4*)cs, c23 = *(const f32x4*)(cs + 2);
          const float cv[4] = {c01[0], c01[2], c23[0], c23[2]}, sv[4] = {c01[1], c01[3], c23[1], c23[3]};
          const float sc = seg == 1 ? 0.08838834764831845f : 1.0f;
#pragma unroll
          for (int bj = 0; bj < 2; ++bj) {
            const f32x4 x1 = acc[ai][bj][m][0], x2 = acc[ai][bj][m][1];
            float o1[4], o2[4];
#pragma unroll
            for (int r = 0; r < 4; ++r) { o1[r] = (x1[r] * cv[r] - x2[r] * sv[r]) * sc; o2[r] = (x1[r] * sv[r] + x2[r] * cv[r]) * sc; }
            u16* dst = zb + (size_t)seg * T_TOK * 512 + (size_t)row * 512 + ((u.pn & 1) * 2 + bj) * 128 + d;
            uint2 w; w.x = pk2(o1[0], o1[1]); w.y = pk2(o1[2], o1[3]); *(uint2*)dst = w;
            w.x = pk2(o2[0], o2[1]); w.y = pk2(o2[2], o2[3]); *(uint2*)(dst + 64) = w;
          }
        } else {
#pragma unroll
          for (int bj = 0; bj < 2; ++bj)
#pragma unroll
            for (int n = 0; n < 2; ++n) {
              const int col = u.pn * 256 + bj * 128 + wc * 32 + n * 16 + 4 * fq;
              const f32x4 v = acc[ai][bj][m][n];
              uint2 w; w.x = pk2(v[0], v[1]); w.y = pk2(v[2], v[3]);
              if (seg < 4) *(uint2*)(zb + (size_t)seg * T_TOK * 512 + (size_t)row * 512 + (col - seg * 512)) = w;
              else { const int ch = col - 2048, gi = ch >> 4, c = ch & 15; *(uint2*)(a2 + ((size_t)gi * 512 + (row >> 5)) * 768 + (row & 31) * 16 + c) = w; }
            }
        }
      }
  }
};
__device__ __forceinline__ void phase_inproj(const P& p, LAS unsigned char* lds) {
  pg8::DenseOrder S; S.init(p.ws + WS_XB, DM, p.ws + WS_WIN, T_TOK, 2560, DM);
  EpiInproj E{(u16*)(p.ws + WS_Z), (u16*)(p.ws + WS_A2), (const f32x2*)(p.ws + WS_ROPE)};
  pg8::gemm_phase<EpiInproj, pg8::DenseOrder, G_ALIGN, G_SP2>(lds, DM, S, E);
}
struct EpiS5E {
  float* E_;
  __device__ __forceinline__ void operator()(const f32x4 (&acc)[2][2][4][2], const pg8::Unit& u, int wr, int wc, int fr, int fq) const {
#pragma unroll
    for (int ai = 0; ai < 2; ++ai)
#pragma unroll
      for (int m = 0; m < 4; ++m) {
        const int row = u.pm * 256 + ai * 128 + wr * 64 + m * 16 + fr;
#pragma unroll
        for (int bj = 0; bj < 2; ++bj)
#pragma unroll
          for (int n = 0; n < 2; ++n) *(f32x4*)(E_ + ((size_t)u.e * 512 + row) * 256 + bj * 128 + wc * 32 + n * 16 + 4 * fq) = acc[ai][bj][m][n];
      }
  }
};
__device__ __forceinline__ void phase_s5_egemm(const P& p, LAS unsigned char* lds) {
  pg8::GroupOrder S; S.init(p.ws + WS_A2, 768, (size_t)512 * 768, p.ws + WS_WET, (size_t)256 * 512, 32, 512, 256, 512);
  EpiS5E E{(float*)(p.ws + WS_E)};
  pg8::gemm_phase<EpiS5E, pg8::GroupOrder, G_ALIGN, G_SP2>(lds, 512, S, E);
}
struct EpiS5Y {
  u16* yg;
  __device__ __forceinline__ void operator()(const f32x4 (&acc)[2][2][4][2], const pg8::Unit& u, int wr, int wc, int fr, int fq) const {
#pragma unroll
    for (int ai = 0; ai < 2; ++ai)
#pragma unroll
      for (int m = 0; m < 4; ++m) {
        const int row = u.pm * 256 + ai * 128 + wr * 64 + m * 16 + fr;
#pragma unroll
        for (int bj = 0; bj < 2; ++bj)
#pragma unroll
          for (int n = 0; n < 2; ++n) {
            const int col = u.pn * 256 + bj * 128 + wc * 32 + n * 16 + 4 * fq;
            const f32x4 v = acc[ai][bj][m][n];
            uint2 w; w.x = pk2(gelu_tanh(v[0]), gelu_tanh(v[1])); w.y = pk2(gelu_tanh(v[2]), gelu_tanh(v[3]));
            *(uint2*)(yg + ((size_t)row * 32 + (col >> 4)) * 512 + u.e * 16 + (col & 15)) = w;
          }
      }
  }
};
__device__ __forceinline__ void phase_s5_ygemm(const P& p, LAS unsigned char* lds) {
  pg8::GroupOrder S; S.init(p.ws + WS_A2, 768, (size_t)512 * 768, p.ws + WS_BTY, (size_t)512 * 768, 32, 512, 512, 768);
  EpiS5Y E{(u16*)(p.ws + WS_YGELU)};
  pg8::gemm_phase<EpiS5Y, pg8::GroupOrder, G_ALIGN, G_SP2>(lds, 768, S, E);
}
struct EpiGlu {
  const u16* yg; const float* bglu; u16* ycat;
  __device__ __forceinline__ void operator()(const f32x4 (&acc)[2][2][4][2], const pg8::Unit& u, int wr, int wc, int fr, int fq) const {
#pragma unroll
    for (int ai = 0; ai < 2; ++ai)
#pragma unroll
      for (int m = 0; m < 4; ++m) {
        const int row = u.pm * 256 + ai * 128 + wr * 64 + m * 16 + fr;
#pragma unroll
        for (int bj = 0; bj < 2; ++bj)
#pragma unroll
          for (int n = 0; n < 2; ++n) {
            const int col = u.pn * 256 + bj * 128 + wc * 32 + n * 16 + 4 * fq;
            const f32x4 v = acc[ai][bj][m][n];
            const uint2 yv = *(const uint2*)(yg + (size_t)row * 512 + col);
            const f32x4 bb = *(const f32x4*)(bglu + col);
            uint2 w;
            w.x = pk2(lo16(yv.x) * sigmoidf_(v[0] + bb[0]), hi16(yv.x) * sigmoidf_(v[1] + bb[1]));
            w.y = pk2(lo16(yv.y) * sigmoidf_(v[2] + bb[2]), hi16(yv.y) * sigmoidf_(v[3] + bb[3]));
            *(uint2*)(ycat + (size_t)row * DM + 512 + col) = w;
          }
      }
  }
};
__device__ __forceinline__ void phase_glu(const P& p, LAS unsigned char* lds) {
  pg8::DenseOrder S; S.init(p.ws + WS_YGELU, 512, p.ws + WS_WGLU, T_TOK, 512, 512);
  EpiGlu E{(const u16*)(p.ws + WS_YGELU), p.b_glu, (u16*)(p.ws + WS_YCAT)};
  pg8::gemm_phase<EpiGlu, pg8::DenseOrder, G_ALIGN, G_SP2>(lds, 512, S, E);
}
struct EpiResid {
  const float* xin; float* xout;
  __device__ __forceinline__ void operator()(const f32x4 (&acc)[2][2][4][2], const pg8::Unit& u, int wr, int wc, int fr, int fq) const {
#pragma unroll
    for (int ai = 0; ai < 2; ++ai)
#pragma unroll
      for (int m = 0; m < 4; ++m) {
        const int row = u.pm * 256 + ai * 128 + wr * 64 + m * 16 + fr;
#pragma unroll
        for (int bj = 0; bj < 2; ++bj)
#pragma unroll
          for (int n = 0; n < 2; ++n) {
            const size_t o = (size_t)row * DM + u.pn * 256 + bj * 128 + wc * 32 + n * 16 + 4 * fq;
            const f32x4 xv = *(const f32x4*)(xin + o);
            *(f32x4*)(xout + o) = xv + acc[ai][bj][m][n];
          }
      }
  }
};
__device__ __forceinline__ void phase_outproj(const P& p, const void* Wt, const float* xin, float* xout, LAS unsigned char* lds) {
  pg8::DenseOrder S; S.init(p.ws + WS_YCAT, DM, Wt, T_TOK, DM, DM);
  EpiResid E{xin, xout};
  pg8::gemm_phase<EpiResid, pg8::DenseOrder, G_ALIGN, G_SP2>(lds, DM, S, E);
}
struct EpiQkv {
  u16 *q1, *k1, *v1;
  __device__ __forceinline__ void operator()(const f32x4 (&acc)[2][2][4][2], const pg8::Unit& u, int wr, int wc, int fr, int fq) const {
#pragma unroll
    for (int ai = 0; ai < 2; ++ai)
#pragma unroll
      for (int m = 0; m < 4; ++m) {
        const int row = u.pm * 256 + ai * 128 + wr * 64 + m * 16 + fr;
#pragma unroll
        for (int bj = 0; bj < 2; ++bj)
#pragma unroll
          for (int n = 0; n < 2; ++n) {
            const int col = u.pn * 256 + bj * 128 + wc * 32 + n * 16 + 4 * fq;
            const f32x4 v = acc[ai][bj][m][n];
            uint2 w;
            if (u.pn < 4) { w.x = pk2(v[0] * 0.125f, v[1] * 0.125f); w.y = pk2(v[2] * 0.125f, v[3] * 0.125f); *(uint2*)(q1 + (size_t)row * DM + col) = w; }
            else {
              w.x = pk2(v[0], v[1]); w.y = pk2(v[2], v[3]);
              if (u.pn == 4) *(uint2*)(k1 + (size_t)row * 256 + (col - 1024)) = w; else *(uint2*)(v1 + (size_t)row * 256 + (col - 1280)) = w;
            }
          }
      }
  }
};
__device__ __forceinline__ void phase_qkv(const P& p, LAS unsigned char* lds) {
  pg8::DenseOrder S; S.init(p.ws + WS_XB, DM, p.ws + WS_WQKV, T_TOK, 1536, DM);
  EpiQkv E{(u16*)(p.ws + WS_Z), (u16*)(p.ws + WS_Z + 32 * MB), (u16*)(p.ws + WS_Z + 40 * MB)};
  pg8::gemm_phase<EpiQkv, pg8::DenseOrder, G_ALIGN, G_SP2>(lds, DM, S, E);
}
__device__ __forceinline__ void phase_moe_plan(const P& p, int layer, char* smem) {
  if (blockIdx.x != 0) return;
  using pg8::PLAN_STRIDE;
  const int tid = tidx();
  const int* cnt = (const int*)(p.ws + WS_CNT) + layer * 32;
  int* plan_n = (int*)(p.ws + WS_PLAN + layer * 65536); int4* plan = (int4*)(p.ws + WS_PLAN + layer * 65536 + 256);
  int* sc = (int*)smem;
  int* ecum = sc + 32; int* ebase = ecum + 32; int* ehb = ebase + 32; int* efull = ehb + 32; int* tot = efull + 32;
  int* sstart = tot + 8; int* sfstart = sstart + 8; int* cntF = sfstart + 8; int* cntR = cntF + 8;
  unsigned* keyR = (unsigned*)(cntR + 8);
  constexpr int NN = 4;
  __syncthreads();
  if (tid < 32) sc[tid] = cnt[tid];
  if (tid < 8) { sstart[tid] = 0x7fffffff; sfstart[tid] = 0; cntF[tid] = 0; cntR[tid] = 0; }
  if (tid < 128) keyR[tid] = 0xffffffffu;
  __syncthreads();
  if (tid == 0) {
    int cum = 0, ub = 0, hb = 0, fb = 0;
    for (int e = 0; e < 32; ++e) {
      const int c = sc[e], fl = c >> 8, rem = c & 255, rc = (rem + 63) >> 6, ntl = fl + (rem ? 1 : 0);
      ecum[e] = cum; ebase[e] = ub; ehb[e] = hb; efull[e] = fb;
      cum += (fl * 4 + rc) * NN; ub += ntl * NN; hb += ntl * 256; fb += fl * NN;
    }
    tot[0] = cum > 0 ? cum : 1; tot[1] = ub;
  }
  __syncthreads();
  const int total = tot[0], nunits = tot[1] < 1024 ? tot[1] : 1024;
  int4 en[2]; int ux[2], uF[2]; unsigned ukr[2]; bool ufull[2], uval[2];
#pragma unroll
  for (int q = 0; q < 2; ++q) {
    const int u = tid + q * NTHR;
    uval[q] = u < nunits; ux[q] = 0; uF[q] = 0; ukr[q] = 0; ufull[q] = true; en[q] = make_int4(0, 0, 0, 0);
    if (uval[q]) {
      int e = 0;
      for (int j = 1; j < 32; ++j) if (ebase[j] <= u) e = j;
      const int c = sc[e], fl = c >> 8, rem = c & 255, rc = (rem + 63) >> 6, ntl = fl + (rem ? 1 : 0);
      const int local = u - ebase[e], ct = local / ntl, rt = local - ct * ntl;
      const int cum = ecum[e] + ct * (fl * 4 + rc) + rt * 4;
      const bool isfull = rt < fl;
      int x = (cum * 8) / total; if (x > 7) x = 7;
      ux[q] = x; ufull[q] = isfull; uF[q] = efull[e] + ct * fl + (rt < fl ? rt : fl);
      en[q] = make_int4(e | (rt << 8) | (ct << 16), c, ehb[e], 0);
      atomicMin(&sstart[x], u);
      if (isfull) atomicAdd(&cntF[x], 1);
      else { atomicAdd(&cntR[x], 1); ukr[q] = ((unsigned)x << 16) | ((unsigned)(4 - rc) << 12) | (unsigned)(e * NN + ct); keyR[e * NN + ct] = ukr[q]; }
    }
  }
  __syncthreads();
#pragma unroll
  for (int q = 0; q < 2; ++q) if (uval[q] && (tid + q * NTHR) == sstart[ux[q]]) sfstart[ux[q]] = uF[q];
  __syncthreads();
#pragma unroll
  for (int q = 0; q < 2; ++q) {
    if (uval[q]) {
      const int x = ux[q];
      int pos;
      if (ufull[q]) pos = uF[q] - sfstart[x];
      else { pos = cntF[x]; for (int v = 0; v < 128; ++v) { const unsigned kv = keyR[v]; pos += ((kv >> 16) == (unsigned)x && kv < ukr[q]) ? 1 : 0; } }
      if (pos < PLAN_STRIDE) plan[x * PLAN_STRIDE + pos] = en[q];
    }
  }
  if (tid < 8) { const int n = cntF[tid] + cntR[tid]; plan_n[tid] = n < PLAN_STRIDE ? n : PLAN_STRIDE; }
  __syncthreads();
}
struct EpiMoe1 {
  u16* hbuf;
  __device__ __forceinline__ void operator()(const f32x4 (&acc)[2][2][4][2], const pg8::Unit& u, int wr, int wc, int fr, int fq) const {
#pragma unroll
    for (int ai = 0; ai < 2; ++ai)
#pragma unroll
      for (int m = 0; m < 4; ++m) {
        const int row = u.pm * 256 + ai * 128 + wr * 64 + m * 16 + fr;
        if (row < u.cnt) {
#pragma unroll
          for (int bj = 0; bj < 2; ++bj) {
            const f32x4 g = acc[ai][bj][m][0], up = acc[ai][bj][m][1];
            uint2 w; w.x = pk2(g[0] * sigmoidf_(g[0]) * up[0], g[1] * sigmoidf_(g[1]) * up[1]); w.y = pk2(g[2] * sigmoidf_(g[2]) * up[2], g[3] * sigmoidf_(g[3]) * up[3]);
            *(uint2*)(hbuf + (size_t)(u.hbase + row) * 512 + 16 * (8 * u.pn + 4 * bj + wc) + 4 * fq) = w;
          }
        }
      }
  }
};
__device__ __forceinline__ void phase_moe1(const P& p, int layer, LAS unsigned char* lds) {
  pg8::PlanOrder S; S.init(p.ws + WS_PLAN + layer * 65536, (const int*)(p.ws + WS_LIST), p.ws + WS_XB, DM, p.ws + (layer ? WS_MW1 : WS_MW0), (size_t)DM * DM, DM, true);
  EpiMoe1 E{(u16*)(p.ws + WS_H)};
  pg8::gemm_phase<EpiMoe1, pg8::PlanOrder, G_ALIGN, G_SP2>(lds, DM, S, E);
}
struct EpiMoe2 {
  const int* list; const float* gate; u16* slots;
  __device__ __forceinline__ void operator()(const f32x4 (&acc)[2][2][4][2], const pg8::Unit& u, int wr, int wc, int fr, int fq) const {
#pragma unroll
    for (int ai = 0; ai < 2; ++ai)
#pragma unroll
      for (int m = 0; m < 4; ++m) {
        const int row = u.pm * 256 + ai * 128 + wr * 64 + m * 16 + fr;
        if (row < u.cnt) {
          const int asg = list[(size_t)u.e * CAP + row];
          const float gt = gate[asg];
#pragma unroll
          for (int bj = 0; bj < 2; ++bj)
#pragma unroll
            for (int n = 0; n < 2; ++n) {
              const f32x4 v = acc[ai][bj][m][n];
              uint2 w; w.x = pk2(gt * v[0], gt * v[1]); w.y = pk2(gt * v[2], gt * v[3]);
              *(uint2*)(slots + (size_t)asg * DM + u.pn * 256 + bj * 128 + wc * 32 + n * 16 + 4 * fq) = w;
            }
        }
      }
  }
};
__device__ __forceinline__ void phase_moe2(const P& p, int layer, LAS unsigned char* lds) {
  pg8::PlanOrder S; S.init(p.ws + WS_PLAN + layer * 65536, (const int*)(p.ws + WS_LIST), p.ws + WS_H, 512, p.ws + (layer ? WS_MW1 : WS_MW0) + 64 * MB, (size_t)DM * 512, 512, false);
  EpiMoe2 E{(const int*)(p.ws + WS_LIST), (const float*)(p.ws + WS_GATE), (u16*)(p.ws + WS_INC)};
  pg8::gemm_phase<EpiMoe2, pg8::PlanOrder, G_ALIGN, G_SP2>(lds, 512, S, E);
}

#define XB_TMO      128
#define XB_XCNT(j)  (256  + 64 * (j))
#define XB_XSUB(j)  (1280 + 64 * (j))
#define XB_XGEN(j)  (2304 + 64 * (j))
#define XB_TOP      3328
#define XB_TOPGEN   3392
#define XCD_BAR_WORDS 3456
#define XB_SPIN_CAP (1u << 22)
__device__ __forceinline__ unsigned xb_ld(unsigned* p)              { return __hip_atomic_load(p, __ATOMIC_RELAXED, __HIP_MEMORY_SCOPE_AGENT); }
__device__ __forceinline__ unsigned xb_add(unsigned* p, unsigned v) { return __hip_atomic_fetch_add(p, v, __ATOMIC_RELAXED, __HIP_MEMORY_SCOPE_AGENT); }
__device__ __forceinline__ unsigned xb_xcc_id() { return (unsigned)__builtin_amdgcn_s_getreg((3 << 11) | 20) & 0xFu; }
#define XB_SPIN(cond, bar) do { unsigned _sp = 0; while (cond) { __builtin_amdgcn_s_sleep(1); \
    if ((++_sp & 255u) == 0u) { if (xb_ld(&(bar)[XB_TMO])) break; if (_sp > XB_SPIN_CAP) { atomicAdd(&(bar)[XB_TMO], 1u); break; } } } } while (0)
struct XcdBarrier { unsigned* bar; unsigned x; volatile LAS unsigned* st; };
__device__ __forceinline__ XcdBarrier xcd_barrier_post(unsigned* bar, volatile LAS unsigned* st) {
  XcdBarrier b; b.bar = bar; b.x = xb_xcc_id(); b.st = st;
  if (tidx() == 0) (void)xb_add(&bar[XB_XCNT(b.x)], 1u);
  return b;
}
__device__ __forceinline__ void xcd_barrier_complete(unsigned* bar, unsigned x, unsigned& nloc, unsigned& nx) {
  const unsigned G = gridDim.x * gridDim.y * gridDim.z;
  unsigned sum, cnt, mine, sp = 0u;
  for (;;) {
    sum = 0u; cnt = 0u; mine = 0u;
#pragma unroll
    for (unsigned j = 0; j < 16; ++j) { const unsigned c = xb_ld(&bar[XB_XCNT(j)]); sum += c; cnt += (c > 0u) ? 1u : 0u; mine = (j == x) ? c : mine; }
    if (sum == G) break;
    __builtin_amdgcn_s_sleep(1);
    if ((++sp & 255u) == 0u) { if (xb_ld(&bar[XB_TMO])) break; if (sp > XB_SPIN_CAP) { atomicAdd(&bar[XB_TMO], 1u); break; } }
  }
  nloc = mine > 0u ? mine : 1u; nx = cnt > 0u ? cnt : 1u;
}
__device__ __forceinline__ void xcd_barrier(const XcdBarrier& b) {
  asm volatile("s_waitcnt vmcnt(0)" ::: "memory");
  __syncthreads();
  if (tidx() == 0) {
    unsigned* bar = b.bar;
    __builtin_amdgcn_s_waitcnt(0);
    unsigned nloc = b.st[0], nx = b.st[1];
    if (nloc == 0u) { xcd_barrier_complete(bar, b.x, nloc, nx); b.st[0] = nloc; b.st[1] = nx; }
    const unsigned old = xb_add(&bar[XB_XSUB(b.x)], 1u);
    const unsigned gen = old / nloc;
    if (old + 1u == (gen + 1u) * nloc) {
      __builtin_amdgcn_fence(__ATOMIC_RELEASE, "agent");
      asm volatile("s_waitcnt vmcnt(0)" ::: "memory");
      const unsigned og = xb_add(&bar[XB_TOP], 1u);
      const unsigned tg = og / nx;
      if (og + 1u == (tg + 1u) * nx) xb_add(&bar[XB_TOPGEN], 1u);
      else XB_SPIN(xb_ld(&bar[XB_TOPGEN]) == tg, bar);
      __builtin_amdgcn_fence(__ATOMIC_ACQUIRE, "agent");
      xb_add(&bar[XB_XGEN(b.x)], 1u);
      asm volatile("s_waitcnt vmcnt(0)" ::: "memory");
    } else {
      XB_SPIN(xb_ld(&bar[XB_XGEN(b.x)]) == gen, bar);
      __builtin_amdgcn_fence(__ATOMIC_ACQUIRE, "agent");
      asm volatile("s_waitcnt vmcnt(0)" ::: "memory");
    }
  }
  __syncthreads();
}

constexpr int NPHASE = 20;
#ifndef C0A
#define C0A 25
#define C0B 70
#define C1A 65
#endif
constexpr int LDS_BYTES = 147456;
__device__ __forceinline__ void run_phase(const P& p, int ph, char* smem, LAS unsigned char* lds) {
  float* xa = (float*)(p.ws + WS_XA);
  const u16* slots = (const u16*)(p.ws + WS_INC);
  switch (ph) {
    case 0: phase_rowpass(p, p.x, nullptr, nullptr, p.norm_mix_g, -1, nullptr, smem); phase_prep(p); __syncthreads(); phase_conv_dense(p, smem); break;
    case 1: phase_inproj(p, lds); phase_s5_ktab(p); phase_s5_fill_bc(p); phase_conv_moe(p, 0, 0, cq(C0A), 128, 128, smem); break;
    case 2: phase_ret_inc_mfma(p, smem); __syncthreads(); phase_s5_egemm(p, lds); phase_s5_fill_a(p); break;
    case 3: phase_ret_scan16(p); phase_s5_carry(p); break;
    case 4: phase_ret_out_mfma(p, smem); __syncthreads(); phase_s5_ygemm(p, lds); break;
    case 5: phase_glu(p, lds); phase_conv_moe(p, 0, cq(C0A), cq(C0B), 128, 128, smem); break;
    case 6: phase_outproj(p, p.ws + WS_WOUT, p.x, xa, lds); break;
    case 7: phase_rowpass(p, xa, nullptr, nullptr, p.norm_ffn_g, 0, nullptr, smem); break;
    case 8: phase_moe_plan(p, 0, smem); phase_conv_moe(p, 0, cq(C0B), CONV_ITEMS, 1, 255, smem); break;
    case 9: phase_moe1(p, 0, lds); break;
    case 10: phase_moe2(p, 0, lds); break;
    case 11: phase_rowpass(p, xa, slots, xa, p.norm_mix_g + DM, -1, nullptr, smem); break;
    case 12: phase_qkv(p, lds); phase_conv_moe(p, 1, 0, cq(C1A), 128, 128, smem); break;
    case 13: phase_attn(p, smem); break;
    case 14: phase_outproj(p, p.ws + WS_WO, xa, xa, lds); break;
    case 15: phase_rowpass(p, xa, nullptr, nullptr, p.norm_ffn_g + DM, 1, nullptr, smem); break;
    case 16: phase_moe_plan(p, 1, smem); phase_conv_moe(p, 1, cq(C1A), CONV_ITEMS, 1, 255, smem); break;
    case 17: phase_moe1(p, 1, lds); break;
    case 18: phase_moe2(p, 1, lds); break;
    case 19: phase_rowpass(p, xa, slots, nullptr, p.norm_final_g, -1, p.out, smem); break;
    default: break;
  }
}

extern __shared__ __attribute__((aligned(16))) char dyn_smem[];

template <int PH> __device__ __forceinline__ void mega_steps(const P& p, char* smem, LAS unsigned char* lds, const XcdBarrier& xb) {
  run_phase(p, PH, smem, lds);
  if constexpr (PH + 1 < NPHASE) {
    xcd_barrier(xb);
    mega_steps<PH + 1>(p, smem, lds, xb);
  }
}
__global__ void __launch_bounds__(NTHR, 2) k_mega(P p) {
  LAS unsigned char* lds = (LAS unsigned char*)dyn_smem;
  volatile LAS unsigned* st = (volatile LAS unsigned*)(lds + LDS_BYTES - 16);
  if (tidx() == 0) { st[0] = 0u; st[1] = 0u; }
  __syncthreads();
  const XcdBarrier xb = xcd_barrier_post((unsigned*)(p.ws + WS_BAR), st);
  mega_steps<0>(p, dyn_smem, lds, xb);
}

extern "C" void kernel_launch(void* const* d_in, const int* in_sizes, int n_in, void* d_out, int out_size, void* d_ws, size_t ws_size, hipStream_t stream) {
  static int grid_blocks = 0;
  if (grid_blocks == 0) {
    if (n_in != 28 || out_size != T_TOK * DM || ws_size < WS_END) { fprintf(stderr, "kernel_launch: unexpected problem (n_in %d out %d ws %zu need %zu)\n", n_in, out_size, ws_size, (size_t)WS_END); grid_blocks = -1; return; }
    int dev = 0, cus = 0, per_cu = 0;
    (void)hipGetDevice(&dev);
    (void)hipDeviceGetAttribute(&cus, hipDeviceAttributeMultiprocessorCount, dev);
    const void* fn = (const void*)k_mega;
    if (hipFuncSetAttribute(fn, hipFuncAttributeMaxDynamicSharedMemorySize, LDS_BYTES) != hipSuccess) { fprintf(stderr, "kernel_launch: hipFuncSetAttribute failed\n"); }
    if (hipOccupancyMaxActiveBlocksPerMultiprocessor(&per_cu, fn, NTHR, LDS_BYTES) != hipSuccess || per_cu < 1) { fprintf(stderr, "kernel_launch: occupancy query failed (%d)\n", per_cu); per_cu = 1; }
    (void)hipGetLastError();
    if (per_cu > 1) per_cu = 1;
    grid_blocks = cus * per_cu;
    fprintf(stderr, "kernel_launch: cus %d per_cu %d grid %d\n", cus, per_cu, grid_blocks);
  }
  if (grid_blocks < 0) return;
  P p{};
  const float** pp = (const float**)&p;
  for (int i = 0; i < 28; ++i) pp[i] = (const float*)d_in[i];
  p.out = (float*)d_out; p.ws = (char*)d_ws;
  (void)hipMemsetAsync((char*)d_ws + WS_BAR, 0, XCD_BAR_WORDS * 4, stream);
  void* args[] = {&p};
  const hipError_t e = hipLaunchCooperativeKernel((const void*)k_mega, dim3(grid_blocks), dim3(NTHR), args, LDS_BYTES, stream);
  if (e != hipSuccess) fprintf(stderr, "cooperative launch failed: %s (grid %d)\n", hipGetErrorString(e), grid_blocks);
}
```

```cpp
#include <hip/hip_runtime.h>
#include <cstdio>
#include <cstdint>

#define USE_FP16 1
#define LAS __attribute__((address_space(3)))

typedef unsigned short u16;
typedef float f32x4 __attribute__((ext_vector_type(4)));
typedef float f32x2 __attribute__((ext_vector_type(2)));
typedef _Float16 f16x8 __attribute__((ext_vector_type(8)));

constexpr int T_TOK = 16384, DM = 1024, SEQ = 2048, NBATCH = 8;
constexpr int CAP = 32768;
constexpr int NTHR = 512, NWAVE = NTHR / 64;

constexpr size_t MB = 1024ull * 1024ull;
constexpr size_t WS_XA    = 0;
constexpr size_t WS_XB    = 64 * MB;
constexpr size_t WS_Z     = 96 * MB;
constexpr size_t WS_A2    = 160 * MB;
constexpr size_t WS_BTY   = 184 * MB;
constexpr size_t WS_MW1   = 160 * MB;
constexpr size_t WS_WET   = 208 * MB;
constexpr size_t WS_E     = 216 * MB;
constexpr size_t WS_KTAB  = 232 * MB;
constexpr size_t WS_SP16  = 234 * MB;
constexpr size_t WS_INC   = 266 * MB;
constexpr size_t WS_YCAT  = 330 * MB;
constexpr size_t WS_YGELU = 362 * MB;
constexpr size_t WS_H     = 330 * MB;
constexpr size_t WS_LIST  = 378 * MB;
constexpr size_t WS_GATE  = 382 * MB;
constexpr size_t WS_ROPE  = 383 * MB;
constexpr size_t WS_CNT   = 384 * MB;
constexpr size_t WS_WR16  = 385 * MB;
constexpr size_t WS_BAR   = 386 * MB;
constexpr size_t WS_PLAN  = 386 * MB + 512 * 1024;
constexpr size_t WS_WIN   = 387 * MB;
constexpr size_t WS_WGLU  = 392 * MB;
constexpr size_t WS_WOUT  = 393 * MB;
constexpr size_t WS_WQKV  = 395 * MB;
constexpr size_t WS_WO    = 398 * MB;
constexpr size_t WS_LAMT  = 400 * MB;
constexpr size_t WS_MW0   = 402 * MB;
constexpr size_t WS_LIST2 = 498 * MB;
constexpr size_t WS_END   = 506 * MB;

struct P {
  const float *x, *norm_mix_g, *norm_ffn_g, *norm_final_g, *w_in, *ret_decay, *a_re, *a_im, *log_step, *b_re, *b_im, *c_re, *c_im,
      *s5d, *w_glu, *b_glu, *w_out, *w_qkv, *sink, *w_o, *rel_bias, *w_group, *b_group, *w_er, *b_er, *w_gate, *w_up, *w_down;
  float* out;
  char* ws;
};

__device__ __forceinline__ u16 f2h(float f) { _Float16 h = (_Float16)f; return __builtin_bit_cast(u16, h); }
__device__ __forceinline__ float h2f(u16 h) { return (float)__builtin_bit_cast(_Float16, h); }
__device__ __forceinline__ unsigned pk2(float a, float b) { return (unsigned)f2h(a) | ((unsigned)f2h(b) << 16); }
__device__ __forceinline__ float lo16(unsigned w) { return h2f((u16)(w & 0xffffu)); }
__device__ __forceinline__ float hi16(unsigned w) { return h2f((u16)(w >> 16)); }
__device__ __forceinline__ f32x4 mfma16(uint4 a, uint4 b, f32x4 c) {
  return __builtin_amdgcn_mfma_f32_16x16x32_f16(__builtin_bit_cast(f16x8, a), __builtin_bit_cast(f16x8, b), c, 0, 0, 0);
}
__device__ __forceinline__ float wave_sum(float v) {
#pragma unroll
  for (int o = 1; o < 64; o <<= 1) v += __shfl_xor(v, o);
  return v;
}
__device__ __forceinline__ float sigmoidf_(float x) { return 1.0f / (1.0f + __expf(-x)); }
__device__ __forceinline__ float gelu_tanh(float x) {
  const float u = 0.7978845608028654f * (x + 0.044715f * x * x * x);
  return 0.5f * x * (1.0f + tanhf(u));
}
#define LDS_WAIT() asm volatile("s_waitcnt lgkmcnt(0)" ::: "memory")
__device__ __forceinline__ int tidx() { int t = threadIdx.x; asm volatile("" : "+v"(t)); return t; }

namespace pg8 {
constexpr int BM = 256, BK = 64, HALF = 128, HTB = HALF * BK * 2, STAGE_BYTES = 8 * HTB, NXCD = 8, WGM = 8;
__device__ __forceinline__ int lds_byte(int r, int c) { const int st = (r >> 4) * 2 + (c >> 5), rr = r & 15, cc = c & 31, ob = rr * 64 + cc * 2; return st * 1024 + (ob ^ (((ob >> 9) & 1) << 5)); }
__device__ __forceinline__ int perm32(int rho) { const int n = rho >> 4, i = rho & 15; return 8 * (i >> 2) + 4 * n + (i & 3); }
__device__ __forceinline__ void stage_rc(int b, int& R, int& C) { const int st = b / 1024, sb = b % 1024, swz = sb ^ (((sb >> 9) & 1) << 5); R = (st >> 1) * 16 + swz / 64; C = (st & 1) * 32 + (swz % 64) / 2; }

struct Unit { const char* a; const char* b; int pm, pn, e, cnt, hbase; };

template <class Epi, class Sched, bool ALIGN_EPI, bool SP2>
__device__ __forceinline__ void gemm_phase(LAS unsigned char* lds, const int K, const Sched& S, const Epi& E) {
    const int tid = tidx(), wid = __builtin_amdgcn_readfirstlane(tid >> 6), lane = tid & 63, wr = wid >> 2, wc = wid & 3, fr = lane & 15, fq = lane >> 4;
    const int nt = K / BK;
    int Rr[2], Cc[2];
    unsigned voffB[2];
#pragma unroll
    for (int i = 0; i < 2; ++i) { stage_rc(tid * 16 + i * 8192, Rr[i], Cc[i]); const int Rb = Epi::PERM ? ((Rr[i] & ~31) + perm32(Rr[i] & 31)) : Rr[i]; voffB[i] = (unsigned)(Rb * K + Cc[i]) * 2u; }
    const size_t kstep = (size_t)(BK * 2);
    const size_t hstepB = (size_t)HALF * K * 2;
    const unsigned ldsw = (unsigned)wid * 1024u;
    const int aoff = lds_byte(wr * 64 + fr, fq * 8), boff = lds_byte(wc * 32 + fr, fq * 8);
#define PG8_SA(b, h) (((b) * 2 + (h)) * HTB)
#define PG8_SB(b, h) ((4 + (b) * 2 + (h)) * HTB)
#define PG8_STAGE(bufoff, gbase, voff) do { _Pragma("unroll") for (int _i = 0; _i < 2; ++_i) \
        __builtin_amdgcn_global_load_lds((const unsigned*)((const char*)(gbase) + (voff)[_i]), (LAS unsigned*)(lds + (bufoff) + ldsw + _i * 8192), 16, 0, 0); } while (0)
#define PG8_LDA(dst, b, h) do { _Pragma("unroll") for (int m = 0; m < 4; ++m) _Pragma("unroll") for (int k = 0; k < 2; ++k) dst[m][k] = *(const LAS f16x8*)(lds + PG8_SA(b, h) + aoff + m * 2048 + k * 1024); } while (0)
#define PG8_LDB(dst, b, h) do { _Pragma("unroll") for (int n = 0; n < 2; ++n) _Pragma("unroll") for (int k = 0; k < 2; ++k) dst[n][k] = *(const LAS f16x8*)(lds + PG8_SB(b, h) + boff + n * 2048 + k * 1024); } while (0)
#define PG8_MMA(ai, bj, At, Bt) do { if (128 * (ai) + 64 * wr >= urows) break; __builtin_amdgcn_s_setprio(1); _Pragma("unroll") for (int m = 0; m < 4; ++m) _Pragma("unroll") for (int n = 0; n < 2; ++n) _Pragma("unroll") for (int k = 0; k < 2; ++k) \
        acc[ai][bj][m][n] = __builtin_amdgcn_mfma_f32_16x16x32_f16(Bt[n][k], At[m][k], acc[ai][bj][m][n], 0, 0, 0); __builtin_amdgcn_s_setprio(0); } while (0)
#define PG8_WAIT_V(n) asm volatile("s_waitcnt vmcnt(" #n ")" ::: "memory")
#define PG8_WAIT_L(n) asm volatile("s_waitcnt lgkmcnt(" #n ")" ::: "memory")
#define PG8_BAR __builtin_amdgcn_s_barrier()
#define PG8_SCHED __builtin_amdgcn_sched_barrier(0)
    Unit cur, nxt; int ui = 0;
    if (!S.next(0, cur)) return;
    unsigned cv0[2], cv1[2], nv0[2], nv1[2];
#pragma unroll
    for (int i = 0; i < 2; ++i) { cv0[i] = S.a_voff(cur, 0, Rr[i], Cc[i]); cv1[i] = S.a_voff(cur, 1, Rr[i], Cc[i]); }
    f32x4 acc[2][2][4][2];
#pragma unroll
    for (int a = 0; a < 2; ++a)
#pragma unroll
        for (int b = 0; b < 2; ++b)
#pragma unroll
            for (int m = 0; m < 4; ++m)
#pragma unroll
                for (int n = 0; n < 2; ++n) acc[a][b][m][n] = (f32x4){0.f, 0.f, 0.f, 0.f};
    f16x8 At[4][2], B0[2][2], B1[2][2];
    const char* cA = cur.a; const char* cB = cur.b;
    int urows = S.rows(cur);
    if constexpr (SP2) {
        PG8_STAGE(PG8_SB(0, 0), cB, voffB); PG8_STAGE(PG8_SB(0, 1), cB + hstepB, voffB); PG8_STAGE(PG8_SA(0, 0), cA, cv0); PG8_STAGE(PG8_SA(0, 1), cA, cv1);
        if (wr == 1) PG8_BAR;
        PG8_WAIT_V(2); PG8_BAR;
        PG8_STAGE(PG8_SB(1, 0), cB + kstep, voffB); PG8_STAGE(PG8_SA(1, 0), cA + kstep, cv0); PG8_STAGE(PG8_SB(1, 1), cB + hstepB + kstep, voffB);
        PG8_WAIT_V(6); PG8_BAR;
    } else {
        PG8_STAGE(PG8_SB(0, 0), cB, voffB); PG8_STAGE(PG8_SA(0, 0), cA, cv0); PG8_STAGE(PG8_SB(0, 1), cB + hstepB, voffB); PG8_STAGE(PG8_SA(0, 1), cA, cv1);
        if (wr == 1) PG8_BAR;
        PG8_WAIT_V(4); PG8_BAR;
        PG8_STAGE(PG8_SB(1, 0), cB + kstep, voffB); PG8_STAGE(PG8_SA(1, 0), cA + kstep, cv0); PG8_STAGE(PG8_SB(1, 1), cB + hstepB + kstep, voffB);
        PG8_WAIT_V(6); PG8_BAR;
    }
    for (;;) {
        const bool has_next = S.next(ui + 1, nxt);
        if (has_next) {
#pragma unroll
            for (int i = 0; i < 2; ++i) { nv0[i] = S.a_voff(nxt, 0, Rr[i], Cc[i]); nv1[i] = S.a_voff(nxt, 1, Rr[i], Cc[i]); }
        } else {
            nxt = cur;
#pragma unroll
            for (int i = 0; i < 2; ++i) { nv0[i] = cv0[i]; nv1[i] = cv1[i]; }
        }
        const char* nA = nxt.a; const char* nB = nxt.b;
        for (int t = 0; t < nt; t += 2) {
            const bool last = (t == nt - 2);
            const char* a1 = cA + (size_t)(t + 1) * kstep;
            const char* a2 = last ? nA : cA + (size_t)(t + 2) * kstep; const char* b2 = last ? nB : cB + (size_t)(t + 2) * kstep;
            const char* a3 = a2 + kstep; const char* b3 = b2 + kstep;
            unsigned v0[2], v1[2];
#pragma unroll
            for (int i = 0; i < 2; ++i) { v0[i] = last ? nv0[i] : cv0[i]; v1[i] = last ? nv1[i] : cv1[i]; }
            if constexpr (SP2) {
            PG8_LDB(B0, 0, 0); PG8_LDB(B1, 0, 1); PG8_SCHED; PG8_LDA(At, 0, 0); PG8_STAGE(PG8_SA(1, 1), a1, cv1);
            PG8_WAIT_V(8); PG8_WAIT_L(0); PG8_BAR; PG8_MMA(0, 0, At, B0); PG8_MMA(0, 1, At, B1); PG8_BAR; PG8_SCHED;
            PG8_LDA(At, 0, 1); PG8_STAGE(PG8_SB(0, 0), b2, voffB); PG8_STAGE(PG8_SB(0, 1), b2 + hstepB, voffB); PG8_STAGE(PG8_SA(0, 0), a2, v0);
            PG8_WAIT_V(8); PG8_WAIT_L(0); PG8_BAR; PG8_MMA(1, 0, At, B0); PG8_MMA(1, 1, At, B1); PG8_BAR; PG8_SCHED;
            PG8_LDB(B0, 1, 0); PG8_LDB(B1, 1, 1); PG8_SCHED; PG8_LDA(At, 1, 0); PG8_STAGE(PG8_SA(0, 1), a2, v1);
            PG8_WAIT_V(8); PG8_WAIT_L(0); PG8_BAR; PG8_MMA(0, 0, At, B0); PG8_MMA(0, 1, At, B1); PG8_BAR; PG8_SCHED;
            PG8_LDA(At, 1, 1); PG8_STAGE(PG8_SB(1, 0), b3, voffB); PG8_STAGE(PG8_SB(1, 1), b3 + hstepB, voffB); PG8_STAGE(PG8_SA(1, 0), a3, v0);
            PG8_WAIT_V(8); PG8_WAIT_L(0); PG8_BAR; PG8_MMA(1, 0, At, B0); PG8_MMA(1, 1, At, B1); PG8_BAR; PG8_SCHED;
            } else {
            PG8_LDB(B0, 0, 0); PG8_SCHED; PG8_LDA(At, 0, 0); PG8_STAGE(PG8_SA(1, 1), a1, cv1);
            PG8_WAIT_L(8); PG8_BAR; PG8_WAIT_L(0); PG8_MMA(0, 0, At, B0); PG8_BAR; PG8_SCHED;
            PG8_LDB(B1, 0, 1); PG8_STAGE(PG8_SB(0, 0), b2, voffB);
            PG8_BAR; PG8_WAIT_L(0); PG8_MMA(0, 1, At, B1); PG8_BAR;
            PG8_LDA(At, 0, 1); PG8_STAGE(PG8_SA(0, 0), a2, v0);
            PG8_BAR; PG8_WAIT_L(0); PG8_MMA(1, 0, At, B0); PG8_BAR; PG8_SCHED;
            PG8_STAGE(PG8_SB(0, 1), b2 + hstepB, voffB);
            PG8_WAIT_V(6); PG8_BAR; PG8_MMA(1, 1, At, B1); PG8_BAR;
            PG8_LDB(B0, 1, 0); PG8_SCHED; PG8_LDA(At, 1, 0); PG8_STAGE(PG8_SA(0, 1), a2, v1);
            PG8_WAIT_L(8); PG8_BAR; PG8_WAIT_L(0); PG8_MMA(0, 0, At, B0); PG8_BAR; PG8_SCHED;
            PG8_LDB(B1, 1, 1); PG8_STAGE(PG8_SB(1, 0), b3, voffB);
            PG8_BAR; PG8_WAIT_L(0); PG8_MMA(0, 1, At, B1); PG8_BAR;
            PG8_LDA(At, 1, 1); PG8_STAGE(PG8_SA(1, 0), a3, v0);
            PG8_BAR; PG8_WAIT_L(0); PG8_MMA(1, 0, At, B0); PG8_BAR; PG8_SCHED;
            PG8_STAGE(PG8_SB(1, 1), b3 + hstepB, voffB);
            PG8_WAIT_V(6); PG8_BAR; PG8_MMA(1, 1, At, B1); PG8_BAR;
            }
        }
        if constexpr (ALIGN_EPI) { if (wr == 0) PG8_BAR; }
        E(acc, cur, wr, wc, fr, fq);
        if (!has_next) break;
#pragma unroll
        for (int a = 0; a < 2; ++a)
#pragma unroll
            for (int b = 0; b < 2; ++b)
#pragma unroll
                for (int m = 0; m < 4; ++m)
#pragma unroll
                    for (int n = 0; n < 2; ++n) acc[a][b][m][n] = (f32x4){0.f, 0.f, 0.f, 0.f};
        cur = nxt; cA = nA; cB = nB; ++ui; urows = S.rows(cur);
#pragma unroll
        for (int i = 0; i < 2; ++i) { cv0[i] = nv0[i]; cv1[i] = nv1[i]; }
        if constexpr (ALIGN_EPI) { if (wr == 1) PG8_BAR; }
    }
    PG8_WAIT_V(0);
    if constexpr (!ALIGN_EPI) { if (wr == 0) PG8_BAR; }
    PG8_BAR;
#undef PG8_SA
#undef PG8_SB
#undef PG8_STAGE
#undef PG8_LDA
#undef PG8_LDB
#undef PG8_MMA
#undef PG8_WAIT_V
#undef PG8_WAIT_L
#undef PG8_BAR
#undef PG8_SCHED
}

struct DenseOrder {
    const char* A; const char* Bt; int lda_b, K, nM, nN, nwg, G, c;
    __device__ __forceinline__ void init(const void* A_, int lda_elems, const void* Bt_, int M, int N, int K_) { A = (const char*)A_; Bt = (const char*)Bt_; lda_b = lda_elems * 2; K = K_; nM = M / BM; nN = N / BM; nwg = nM * nN; G = gridDim.x; c = blockIdx.x; }
    __device__ __forceinline__ bool next(int i, Unit& u) const {
        const long L = (long)i * G + c; if (L >= nwg) return false;
        int wgid = (int)L; { const int q = nwg / NXCD, r = nwg % NXCD, xcd = wgid % NXCD, off = wgid / NXCD; wgid = (xcd < r ? xcd * (q + 1) : r * (q + 1) + (xcd - r) * q) + off; }
        const int nig = WGM * nN, gid = wgid / nig, fm = gid * WGM, gsz = (nM - fm) < WGM ? (nM - fm) : WGM;
        u.pm = fm + ((wgid % nig) % gsz); u.pn = (wgid % nig) / gsz; u.e = 0; u.cnt = 0; u.hbase = 0;
        u.a = A + (size_t)u.pm * BM * lda_b; u.b = Bt + (size_t)u.pn * BM * K * 2;
        return true;
    }
    __device__ __forceinline__ unsigned a_voff(const Unit&, int h, int R, int C) const { return (unsigned)((h * HALF + R) * lda_b + C * 2); }
    __device__ __forceinline__ int rows(const Unit&) const { return BM; }
};
struct GroupOrder {
    const char* A; const char* Bt; int lda_b, K, nM, nN, ng, G, c; size_t gsA, gsB;
    __device__ __forceinline__ void init(const void* A_, int lda_elems, size_t gsA_elems, const void* Bt_, size_t gsB_elems, int ng_, int M, int N, int K_) {
        A = (const char*)A_; Bt = (const char*)Bt_; lda_b = lda_elems * 2; K = K_; nM = M / BM; nN = N / BM; ng = ng_; gsA = gsA_elems * 2; gsB = gsB_elems * 2; G = gridDim.x; c = blockIdx.x; }
    __device__ __forceinline__ bool next(int i, Unit& u) const {
        const long L = (long)i * G + c; if (L >= (long)ng * nM * nN) return false;
        const int per = nM * nN, g = (int)L / per, r = (int)L % per;
        u.e = g; u.pm = r / nN; u.pn = r % nN; u.cnt = 0; u.hbase = 0;
        u.a = A + (size_t)g * gsA + (size_t)u.pm * BM * lda_b; u.b = Bt + (size_t)g * gsB + (size_t)u.pn * BM * K * 2;
        return true;
    }
    __device__ __forceinline__ unsigned a_voff(const Unit&, int h, int R, int C) const { return (unsigned)((h * HALF + R) * lda_b + C * 2); }
    __device__ __forceinline__ int rows(const Unit&) const { return BM; }
};
constexpr int PLAN_STRIDE = 256;
struct PlanOrder {
    const int4* plan; const int* plan_n; const int2* list; const char* A; const char* Bt; int lda_b, K, x, ib, nbx; size_t esB; bool gather;
    __device__ __forceinline__ void init(const void* planbase, const int2* list_, const void* A_, int lda_elems, const void* Bt_, size_t esB_elems, int K_, bool gather_) {
        plan_n = (const int*)planbase; plan = (const int4*)((const char*)planbase + 256); list = list_; A = (const char*)A_; Bt = (const char*)Bt_; lda_b = lda_elems * 2; K = K_; esB = esB_elems * 2; gather = gather_;
        x = blockIdx.x & 7; ib = blockIdx.x >> 3; nbx = ((int)gridDim.x - x + 7) >> 3; }
    __device__ __forceinline__ bool next(int i, Unit& u) const {
        const int j = i * nbx + ib;
        if (j >= plan_n[x]) return false;
        const int4 en = plan[x * PLAN_STRIDE + j];
        u.e = en.x & 255; u.pm = (en.x >> 8) & 255; u.pn = (en.x >> 16) & 255; u.cnt = en.y; u.hbase = en.z;
        u.a = gather ? A : A + (size_t)(u.hbase + u.pm * BM) * lda_b;
        u.b = Bt + (size_t)u.e * esB + (size_t)u.pn * BM * K * 2;
        return true;
    }
    __device__ __forceinline__ unsigned a_voff(const Unit& u, int h, int R, int C) const {
        if (!gather) return (unsigned)((h * HALF + R) * lda_b + C * 2);
        const int li = u.pm * BM + h * HALF + R;
        const int tok = (li < u.cnt) ? (list[(size_t)u.e * CAP + li].x >> 1) : 0;
        return (unsigned)(tok * lda_b + C * 2);
    }
    __device__ __forceinline__ int rows(const Unit& u) const { const int r = u.cnt - u.pm * BM; return r < BM ? r : BM; }
};
}
constexpr bool G_ALIGN = true, G_SP2 = true;

__device__ __forceinline__ void phase_prep(const P& p) {
  const int gtid = blockIdx.x * NTHR + tidx(), gsz = gridDim.x * NTHR;
  int* cnt = (int*)(p.ws + WS_CNT);
  if (gtid < 64) cnt[gtid] = 0;
  f32x2* rope = (f32x2*)(p.ws + WS_ROPE);
  for (int i = gtid; i < SEQ * 64; i += gsz) {
    const int pos = i >> 6, f = i & 63;
    const float inv = powf(10000.0f, -(float)(2 * f) / 128.0f);
    const float ang = (float)pos * inv;
    float s, c; sincosf(ang, &s, &c);
    rope[i] = (f32x2){c, s};
  }
  f32x2* lamt = (f32x2*)(p.ws + WS_LAMT); f32x2* coeft = (f32x2*)(p.ws + WS_LAMT + 3 * MB / 2);
  for (int i = gtid; i < 32 * 2 * 33 * 64; i += gsz) {
    const int q = i & 63, l = (i >> 6) % 33, gd = i / (33 * 64);
    const int g = gd >> 1, dir = gd & 1;
    const float dt = expf(p.log_step[dir * 32 + g]), ar = p.a_re[(dir * 32 + g) * 64 + q], ai = p.a_im[(dir * 32 + g) * 64 + q];
    const float mag = expf(ar * dt * (float)l); float sn, cs; sincosf(ai * dt * (float)l, &sn, &cs);
    lamt[i] = (f32x2){mag * cs, mag * sn};
    if (l == 1) {
      const float em1 = expm1f(ar * dt), sh = sinf(0.5f * ai * dt);
      const float nr = em1 * cs - 2.0f * sh * sh, ni = (em1 + 1.0f) * sn, den = ar * ar + ai * ai;
      coeft[gd * 64 + q] = (f32x2){(nr * ar + ni * ai) / den, (ni * ar - nr * ai) / den};
    }
  }
  u16* wr16 = (u16*)(p.ws + WS_WR16);
  for (int i = gtid; i < 2 * 48 * DM; i += gsz) {
    const int k = i & (DM - 1), n = (i >> 10) % 48, layer = i / (48 * DM);
    float w = 0.f;
    if (n < 4) w = p.w_group[((size_t)layer * DM + k) * 4 + n];
    else if (n < 36) { const int gg = (n - 4) >> 3, j = (n - 4) & 7; w = p.w_er[(((size_t)layer * 4 + gg) * DM + k) * 8 + j]; }
    w *= p.norm_ffn_g[layer * DM + k];
    const u16 hi = f2h(w), lo = f2h(w - h2f(hi));
    wr16[((size_t)(layer * 2 + 0) * 48 + n) * DM + k] = hi;
    wr16[((size_t)(layer * 2 + 1) * 48 + n) * DM + k] = lo;
  }
}

template <class RowFn>
__device__ __forceinline__ void conv_item(const float* W, int ldw, int K, u16* WT, float* scr, int k0, int n0, int lane, RowFn rowfn) {
#pragma unroll 8
  for (int i = 0; i < 32; ++i) { const int kk = 2 * i + (lane >> 5); scr[kk * 33 + (lane & 31)] = W[(size_t)(k0 + kk) * ldw + n0 + (lane & 31)]; }
  LDS_WAIT();
  const int c = lane & 7;
#pragma unroll
  for (int j = 0; j < 4; ++j) {
    const int n = (lane >> 3) + 8 * j; const float* sp = scr + (8 * c) * 33 + n;
    uint4 o; o.x = pk2(sp[0 * 33], sp[1 * 33]); o.y = pk2(sp[2 * 33], sp[3 * 33]); o.z = pk2(sp[4 * 33], sp[5 * 33]); o.w = pk2(sp[6 * 33], sp[7 * 33]);
    *(uint4*)(WT + (size_t)rowfn(n0 + n) * K + k0 + 8 * c) = o;
  }
  LDS_WAIT();
}
template <class RowFn>
__device__ __forceinline__ int conv_matrix(const float* W, int ldw, int K, int N, u16* WT, char* smem, int item_base, RowFn rowfn) {
  const int lane = tidx() & 63, wv = tidx() >> 6, gw = blockIdx.x * NWAVE + wv, nw = gridDim.x * NWAVE;
  float* scr = (float*)smem + wv * (64 * 33);
  const int nkb = K / 64, nnb = N / 32, nitems = nkb * nnb;
  int it = gw - (item_base % nw); if (it < 0) it += nw;
  for (; it < nitems; it += nw) conv_item(W, ldw, K, WT, scr, (it / nnb) * 64, (it % nnb) * 32, lane, rowfn);
  return nitems;
}
__device__ __forceinline__ void phase_conv_dense(const P& p, char* smem) {
  auto id = [](int n) { return n; };
  int base = 0;
  base += conv_matrix(p.w_in, 2560, DM, 2560, (u16*)(p.ws + WS_WIN), smem, base, [](int n) { if (n >= 1024) return n; const int dd = n & 127, hf = dd >> 6, r = dd & 63; return (n & ~127) + 32 * (r >> 4) + 8 * ((r & 15) >> 2) + 4 * hf + (r & 3); });
  base += conv_matrix(p.w_glu, 512, 512, 512, (u16*)(p.ws + WS_WGLU), smem, base, id);
  base += conv_matrix(p.w_out, DM, DM, DM, (u16*)(p.ws + WS_WOUT), smem, base, id);
  base += conv_matrix(p.w_qkv, 1536, DM, 1536, (u16*)(p.ws + WS_WQKV), smem, base, id);
  base += conv_matrix(p.w_o, DM, DM, DM, (u16*)(p.ws + WS_WO), smem, base, id);
}
__device__ __forceinline__ void phase_conv_moe(const P& p, int layer, int lo, int hi, int b0, int nb, char* smem) {
  if (gridDim.x != 256) { b0 = 0; nb = (int)gridDim.x; }
  if ((int)blockIdx.x < b0 || (int)blockIdx.x >= b0 + nb) return;
  const int lane = tidx() & 63, wv = tidx() >> 6, gw = ((int)blockIdx.x - b0) * NWAVE + wv, nw = nb * NWAVE;
  float* scr = (float*)smem + wv * (64 * 33);
  u16* w1t = (u16*)(p.ws + (layer ? WS_MW1 : WS_MW0)); u16* w2t = w1t + (size_t)32 * DM * DM;
  for (int it = lo + gw; it < hi; it += nw) {
    const int e = it / 768, r = it % 768;
    if (r < 512) {
      const int which = r >> 8, q = r & 255, k0 = (q >> 4) * 64, n0 = (q & 15) * 32;
      const float* W = (which ? p.w_up : p.w_gate) + (size_t)(layer * 32 + e) * DM * 512;
      conv_item(W, 512, DM, w1t + (size_t)e * DM * DM, scr, k0, n0, lane, [which](int n) { return (n >> 4) * 32 + which * 16 + (n & 15); });
    } else {
      const int q = r - 512, k0 = (q >> 5) * 64, n0 = (q & 31) * 32;
      const float* W = p.w_down + (size_t)(layer * 32 + e) * 512 * DM;
      conv_item(W, DM, 512, w2t + (size_t)e * DM * 512, scr, k0, n0, lane, [](int n) { return n; });
    }
  }
}

constexpr int CONV_ITEMS = 32 * 768;
constexpr int cq(int pct) { return (int)((long)CONV_ITEMS * pct / 100); }
__device__ __forceinline__ void phase_rowpass(const P& p, const float* src, const u16* slots, float* dstx, const float* gain, int route_layer, float* fout, char* smem) {
  const int lane = tidx() & 63, wv = tidx() >> 6, fr = lane & 15, lg = lane >> 4;
  u16* xb = (u16*)(p.ws + WS_XB);
  int* cnt = (int*)(p.ws + WS_CNT);
  int2* list2 = (int2*)(p.ws + WS_LIST2);
  float* sRs = (float*)smem;
  float* sLg = (float*)smem + 64;
  for (int st = blockIdx.x; st < T_TOK / 64; st += gridDim.x) {
    const int row0 = st * 64 + wv * 8;
#pragma unroll 1
    for (int rp = 0; rp < 4; ++rp) {
      f32x4 v[2][4];
#pragma unroll
      for (int q = 0; q < 2; ++q) {
        const int row = row0 + rp * 2 + q;
#pragma unroll
        for (int i = 0; i < 4; ++i) v[q][i] = *(const f32x4*)(src + (size_t)row * DM + (i * 64 + lane) * 4);
      }
      if (slots) {
#pragma unroll
        for (int q = 0; q < 2; ++q) {
          const int row = row0 + rp * 2 + q;
          uint2 w[2][4];
#pragma unroll
          for (int sl = 0; sl < 2; ++sl)
#pragma unroll
            for (int i = 0; i < 4; ++i) w[sl][i] = *(const uint2*)(slots + ((size_t)row * 2 + sl) * DM + (i * 64 + lane) * 4);
#pragma unroll
          for (int sl = 0; sl < 2; ++sl)
#pragma unroll
            for (int i = 0; i < 4; ++i) { v[q][i][0] += lo16(w[sl][i].x); v[q][i][1] += hi16(w[sl][i].x); v[q][i][2] += lo16(w[sl][i].y); v[q][i][3] += hi16(w[sl][i].y); }
        }
      }
#pragma unroll
      for (int q = 0; q < 2; ++q) {
        const int row = row0 + rp * 2 + q;
        float ss = 0.f;
#pragma unroll
        for (int i = 0; i < 4; ++i) {
          if (dstx) *(f32x4*)(dstx + (size_t)row * DM + (i * 64 + lane) * 4) = v[q][i];
          ss += v[q][i][0] * v[q][i][0] + v[q][i][1] * v[q][i][1] + v[q][i][2] * v[q][i][2] + v[q][i][3] * v[q][i][3];
        }
        ss = wave_sum(ss);
        const float rstd = rsqrtf(ss * (1.0f / DM) + 1e-6f);
        if (route_layer >= 0 && lane == 0) sRs[wv * 8 + rp * 2 + q] = rstd;
#pragma unroll
        for (int i = 0; i < 4; ++i) {
          const int k = (i * 64 + lane) * 4;
          const f32x4 gv = *(const f32x4*)(gain + k);
          const f32x4 hv = v[q][i] * rstd * gv;
          if (fout) *(f32x4*)(fout + (size_t)row * DM + k) = hv;
          else { uint2 w; w.x = pk2(hv[0], hv[1]); w.y = pk2(hv[2], hv[3]); *(uint2*)(xb + (size_t)row * DM + k) = w; }
        }
      }
    }
    if (route_layer >= 0) {
      __syncthreads();
      const int tl = wv & 3, kh = wv >> 2;
      const float rsv = sRs[tl * 16 + fr];
      const float* xrow = src + (size_t)(st * 64 + tl * 16 + fr) * DM + kh * 512 + lg * 8;
      const u16* whi = (const u16*)(p.ws + WS_WR16) + ((size_t)(route_layer * 2 + 0) * 48 + fr) * DM + kh * 512 + lg * 8;
      const u16* wlo = (const u16*)(p.ws + WS_WR16) + ((size_t)(route_layer * 2 + 1) * 48 + fr) * DM + kh * 512 + lg * 8;
      f32x4 acc[3];
#pragma unroll
      for (int nb = 0; nb < 3; ++nb) acc[nb] = (f32x4){0.f, 0.f, 0.f, 0.f};
#pragma unroll 4
      for (int ks = 0; ks < 16; ++ks) {
        const f32x4 x0 = *(const f32x4*)(xrow + ks * 32), x1 = *(const f32x4*)(xrow + ks * 32 + 4);
        const float hv[8] = {x0[0] * rsv, x0[1] * rsv, x0[2] * rsv, x0[3] * rsv, x1[0] * rsv, x1[1] * rsv, x1[2] * rsv, x1[3] * rsv};
        unsigned ah[4], al[4];
#pragma unroll
        for (int j = 0; j < 4; ++j) {
          const u16 h0 = f2h(hv[2 * j]), h1 = f2h(hv[2 * j + 1]);
          ah[j] = (unsigned)h0 | ((unsigned)h1 << 16);
          al[j] = pk2(hv[2 * j] - h2f(h0), hv[2 * j + 1] - h2f(h1));
        }
        const uint4 ahi = make_uint4(ah[0], ah[1], ah[2], ah[3]), alo = make_uint4(al[0], al[1], al[2], al[3]);
#pragma unroll
        for (int nb = 0; nb < 3; ++nb) {
          const uint4 bh = *(const uint4*)(whi + (size_t)nb * 16 * DM + ks * 32), bl = *(const uint4*)(wlo + (size_t)nb * 16 * DM + ks * 32);
          acc[nb] = mfma16(bh, ahi, acc[nb]); acc[nb] = mfma16(bh, alo, acc[nb]); acc[nb] = mfma16(bl, ahi, acc[nb]);
        }
      }
      float* lgw = sLg + ((kh * 4 + tl) * 16 + fr) * 49;
#pragma unroll
      for (int nb = 0; nb < 3; ++nb)
#pragma unroll
        for (int r = 0; r < 4; ++r) lgw[nb * 16 + 4 * lg + r] = acc[nb][r];
      __syncthreads();
      if (wv < 4 && lane < 16) {
        const int row = st * 64 + wv * 16 + lane;
        const float* l0 = sLg + ((0 * 4 + wv) * 16 + lane) * 49;
        const float* l1 = sLg + ((1 * 4 + wv) * 16 + lane) * 49;
        const float* bg = p.b_group + route_layer * 4;
        const float* be = p.b_er + route_layer * 32;
        float gl[4];
#pragma unroll
        for (int j = 0; j < 4; ++j) gl[j] = l0[j] + l1[j] + bg[j];
        int gs = 0; float gm = gl[0];
#pragma unroll
        for (int j = 1; j < 4; ++j) if (gl[j] > gm) { gm = gl[j]; gs = j; }
        float den = 0.f;
#pragma unroll
        for (int j = 0; j < 4; ++j) den += expf(gl[j] - gm);
        const float pg = 1.0f / den;
        float el[8];
#pragma unroll
        for (int j = 0; j < 8; ++j) el[j] = l0[4 + gs * 8 + j] + l1[4 + gs * 8 + j] + be[gs * 8 + j];
        int i1 = 0; float v1 = el[0];
#pragma unroll
        for (int j = 1; j < 8; ++j) if (el[j] > v1) { v1 = el[j]; i1 = j; }
        int i2 = -1; float v2 = -3.0e38f;
#pragma unroll
        for (int j = 0; j < 8; ++j) if (j != i1 && el[j] > v2) { v2 = el[j]; i2 = j; }
        const float e2 = expf(v2 - v1);
        const float g1 = pg / (1.0f + e2), g2 = pg * e2 / (1.0f + e2);
        const int ex1 = gs * 8 + i1, ex2 = gs * 8 + i2;
        const int r1 = atomicAdd(&cnt[route_layer * 32 + ex1], 1);
        const int r2 = atomicAdd(&cnt[route_layer * 32 + ex2], 1);
        list2[(size_t)ex1 * CAP + r1] = make_int2(row * 2, __float_as_int(g1));
        list2[(size_t)ex2 * CAP + r2] = make_int2(row * 2 + 1, __float_as_int(g2));
      }
      __syncthreads();
    }
  }
}

constexpr int RSTR = 136;
__device__ __forceinline__ float log_sigmoid(float x) { return -log1pf(expf(-x)); }
__device__ __forceinline__ uint2 lds_tr16(const u16* ptr) {
  typedef short s16x4 __attribute__((ext_vector_type(4)));
  const s16x4 v = __builtin_amdgcn_ds_read_tr16_b64_v4i16((LAS s16x4*)ptr);
  return __builtin_bit_cast(uint2, v);
}
__device__ __forceinline__ uint4 lds_frag_T(const u16* tile, int rs, int k0, int c0, int lane) {
  const int g = lane >> 4, q = (lane & 15) >> 2, pp = lane & 3;
  const u16* a = tile + (k0 + 8 * g + q) * rs + c0 + 4 * pp;
  const uint2 lo = lds_tr16(a), hi = lds_tr16(a + 4 * rs);
  return make_uint4(lo.x, lo.y, hi.x, hi.y);
}
__device__ __forceinline__ void ret_load_tile(u16* dst0, u16* dst1, const u16* src, int t0, int h, const float* w0, const float* w1) {
  for (int c = tidx(); c < 128 * 16; c += NTHR) {
    const int i = c >> 4, ch = (c & 15) * 8;
    const uint4 v = *(const uint4*)(src + (size_t)(t0 + i) * 512 + h * 128 + ch);
    if (w0) {
      const float a = w0[i], b = w1[i];
      const float f[8] = {lo16(v.x), hi16(v.x), lo16(v.y), hi16(v.y), lo16(v.z), hi16(v.z), lo16(v.w), hi16(v.w)};
      *(uint4*)(dst0 + i * RSTR + ch) = make_uint4(pk2(f[0] * a, f[1] * a), pk2(f[2] * a, f[3] * a), pk2(f[4] * a, f[5] * a), pk2(f[6] * a, f[7] * a));
      *(uint4*)(dst1 + i * RSTR + ch) = make_uint4(pk2(f[0] * b, f[1] * b), pk2(f[2] * b, f[3] * b), pk2(f[4] * b, f[5] * b), pk2(f[6] * b, f[7] * b));
    } else *(uint4*)(dst0 + i * RSTR + ch) = v;
  }
}
template <int MB_, int NB_, bool ATR, bool BTR>
__device__ __forceinline__ void lds_mma(f32x4 (&acc)[MB_][NB_], const u16* sA, int sa, int a0, const u16* sB, int sb, int b0, int K, int lane, const float* sc) {
  const int fr = lane & 15, fq = lane >> 4;
  for (int k0 = 0; k0 < K; k0 += 32) {
    uint4 fa[MB_], fb[NB_];
#pragma unroll
    for (int m = 0; m < MB_; ++m) {
      if constexpr (ATR) fa[m] = lds_frag_T(sA, sa, k0, a0 + m * 16, lane);
      else fa[m] = *(const uint4*)(sA + (a0 + m * 16 + fr) * sa + k0 + fq * 8);
      if (sc) {
        const float f = sc[m];
        fa[m].x = pk2(lo16(fa[m].x) * f, hi16(fa[m].x) * f); fa[m].y = pk2(lo16(fa[m].y) * f, hi16(fa[m].y) * f);
        fa[m].z = pk2(lo16(fa[m].z) * f, hi16(fa[m].z) * f); fa[m].w = pk2(lo16(fa[m].w) * f, hi16(fa[m].w) * f);
      }
    }
#pragma unroll
    for (int n = 0; n < NB_; ++n) {
      if constexpr (BTR) fb[n] = lds_frag_T(sB, sb, k0, b0 + n * 16, lane);
      else fb[n] = *(const uint4*)(sB + (b0 + n * 16 + fr) * sb + k0 + fq * 8);
    }
#pragma unroll
    for (int m = 0; m < MB_; ++m)
#pragma unroll
      for (int n = 0; n < NB_; ++n) acc[m][n] = mfma16(fb[n], fa[m], acc[m][n]);
  }
}
__device__ __forceinline__ void ret_items(int ng, int& first, int& count, int& stride) {
  const int c = blockIdx.x, G = gridDim.x;
  if (G != 256) { first = c; count = (512 - c + G - 1) / G; stride = G; return; }
  stride = 1;
  if (c < ng) { first = c; count = 1; return; }
  const int rest = 512 - ng, nb = 256 - ng, q = rest / nb, r = rest % nb, i = c - ng;
  first = ng + i * q + (i < r ? i : r); count = q + (i < r ? 1 : 0);
}
__device__ __forceinline__ void phase_ret_inc_mfma(const P& p, char* smem) {
  u16* sKf = (u16*)smem; u16* sKb = sKf + 128 * RSTR; u16* sV = sKb + 128 * RSTR; float* sWf = (float*)(sV + 128 * RSTR); float* sWb = sWf + 128;
  const u16* kb = (const u16*)(p.ws + WS_Z) + (size_t)1 * T_TOK * 512; const u16* vb = (const u16*)(p.ws + WS_Z) + (size_t)2 * T_TOK * 512;
  u16* incf = (u16*)(p.ws + WS_INC); u16* incb = incf + (size_t)512 * 16384;
  const int tid = tidx(), lane = tid & 63, wv = tid >> 6, wr = wv >> 1, wc = wv & 1, fr = lane & 15, fq = lane >> 4;
  int it_first, it_count, it_stride; ret_items(64, it_first, it_count, it_stride);
  for (int ii = 0; ii < it_count; ++ii) {
    const int item = it_first + ii * it_stride;
    const int h = item & 3, bn = item >> 2, t0 = bn * 128;
    const float lgf = log_sigmoid(p.ret_decay[h]), lgb = log_sigmoid(p.ret_decay[4 + h]);
    __syncthreads();
    if (tid < 128) { sWf[tid] = expf(lgf * (float)(127 - tid)); sWb[tid] = expf(lgb * (float)tid); }
    __syncthreads();
    ret_load_tile(sKf, sKb, kb, t0, h, sWf, sWb);
    ret_load_tile(sV, nullptr, vb, t0, h, nullptr, nullptr);
    __syncthreads();
#pragma unroll
    for (int dirn = 0; dirn < 2; ++dirn) {
      f32x4 acc[2][4];
#pragma unroll
      for (int m = 0; m < 2; ++m)
#pragma unroll
        for (int n = 0; n < 4; ++n) acc[m][n] = (f32x4){0.f, 0.f, 0.f, 0.f};
      lds_mma<2, 4, true, true>(acc, sV, RSTR, wr * 32, dirn ? sKb : sKf, RSTR, wc * 64, 128, lane, nullptr);
      u16* o = (dirn ? incb : incf) + (size_t)item * 16384;
#pragma unroll
      for (int m = 0; m < 2; ++m)
#pragma unroll
        for (int n = 0; n < 4; ++n) { uint2 w; w.x = pk2(acc[m][n][0], acc[m][n][1]); w.y = pk2(acc[m][n][2], acc[m][n][3]); *(uint2*)(o + (wr * 32 + m * 16 + fr) * 128 + wc * 64 + n * 16 + 4 * fq) = w; }
    }
  }
}
__device__ __forceinline__ void phase_ret_scan16(const P& p) {
  const u16* incf = (const u16*)(p.ws + WS_INC); const u16* incb = incf + (size_t)512 * 16384;
  u16* spf = (u16*)(p.ws + WS_SP16); u16* spb = spf + (size_t)512 * 16384;
  const int gtid = blockIdx.x * NTHR + tidx(), gsz = gridDim.x * NTHR;
  for (int idx = gtid; idx < 32 * 4096; idx += gsz) {
    const int de = (idx & 4095) * 4, bh = idx >> 12, b = bh >> 2, h = bh & 3;
    const float Gf = expf(128.0f * log_sigmoid(p.ret_decay[h])), Gb = expf(128.0f * log_sigmoid(p.ret_decay[4 + h]));
    f32x4 s = {0.f, 0.f, 0.f, 0.f};
    for (int n = 0; n < 16; ++n) {
      const size_t o = ((size_t)((b * 16 + n) * 4 + h)) * 16384 + de;
      const uint2 tw = *(const uint2*)(incf + o); const f32x4 t = {lo16(tw.x), hi16(tw.x), lo16(tw.y), hi16(tw.y)};
      uint2 w; w.x = pk2(s[0], s[1]); w.y = pk2(s[2], s[3]); *(uint2*)(spf + o) = w;
      s = s * Gf + t;
    }
    s = (f32x4){0.f, 0.f, 0.f, 0.f};
    for (int n = 15; n >= 0; --n) {
      const size_t o = ((size_t)((b * 16 + n) * 4 + h)) * 16384 + de;
      const uint2 tw = *(const uint2*)(incb + o); const f32x4 t = {lo16(tw.x), hi16(tw.x), lo16(tw.y), hi16(tw.y)};
      uint2 w; w.x = pk2(s[0], s[1]); w.y = pk2(s[2], s[3]); *(uint2*)(spb + o) = w;
      s = s * Gb + t;
    }
  }
}
__device__ __forceinline__ void phase_ret_out_mfma(const P& p, char* smem) {
  u16* R0 = (u16*)smem; u16* R1 = R0 + 128 * RSTR; u16* R2 = R1 + 128 * RSTR; u16* R3 = R2 + 128 * RSTR;
  float* sPf = (float*)(R3 + 128 * RSTR); float* sPb = sPf + 132;
  const u16* zb = (const u16*)(p.ws + WS_Z);
  const u16* qb = zb; const u16* kb = zb + (size_t)1 * T_TOK * 512; const u16* vb = zb + (size_t)2 * T_TOK * 512; const u16* gb = zb + (size_t)3 * T_TOK * 512;
  const u16* spf = (const u16*)(p.ws + WS_SP16); const u16* spb = spf + (size_t)512 * 16384;
  u16* ycat = (u16*)(p.ws + WS_YCAT);
  const int tid = tidx(), lane = tid & 63, wv = tid >> 6, wr = wv >> 1, wc = wv & 1, fr = lane & 15, fq = lane >> 4;
  int it_first, it_count, it_stride; ret_items(128, it_first, it_count, it_stride);
  for (int ii = 0; ii < it_count; ++ii) {
    const int item = it_first + ii * it_stride;
    const int h = item & 3, bn = item >> 2, t0 = bn * 128;
    const float lgf = log_sigmoid(p.ret_decay[h]), lgb = log_sigmoid(p.ret_decay[4 + h]);
    const u16* spT = spf + (size_t)item * 16384; const u16* snT = spb + (size_t)item * 16384;
    const int pe = tid >> 4, pch = (tid & 15) * 8;
    const uint4 pp0 = *(const uint4*)(spT + (pe + 0) * 128 + pch), pp1 = *(const uint4*)(spT + (pe + 32) * 128 + pch), pp2 = *(const uint4*)(spT + (pe + 64) * 128 + pch), pp3 = *(const uint4*)(spT + (pe + 96) * 128 + pch);
    __syncthreads();
    ret_load_tile(R0, nullptr, qb, t0, h, nullptr, nullptr);
    ret_load_tile(R1, nullptr, kb, t0, h, nullptr, nullptr);
    ret_load_tile(R2, nullptr, vb, t0, h, nullptr, nullptr);
    if (tid < 129) { sPf[tid] = expf(lgf * (float)tid); sPb[tid] = expf(lgb * (float)tid); }
    __syncthreads();
    {
      f32x4 acc[2][4];
#pragma unroll
      for (int m = 0; m < 2; ++m)
#pragma unroll
        for (int n = 0; n < 4; ++n) acc[m][n] = (f32x4){0.f, 0.f, 0.f, 0.f};
      lds_mma<2, 4, false, false>(acc, R0, RSTR, wr * 32, R1, RSTR, wc * 64, 128, lane, nullptr);
#pragma unroll
      for (int m = 0; m < 2; ++m)
#pragma unroll
        for (int n = 0; n < 4; ++n) {
          const int i = wr * 32 + m * 16 + fr, j = wc * 64 + n * 16 + 4 * fq;
          float v[4];
#pragma unroll
          for (int r = 0; r < 4; ++r) { const int jj = j + r; v[r] = acc[m][n][r] * ((i >= jj) ? sPf[i - jj] : sPb[jj - i]); }
          uint2 w; w.x = pk2(v[0], v[1]); w.y = pk2(v[2], v[3]);
          *(uint2*)(R3 + i * RSTR + j) = w;
        }
    }
    __syncthreads();
    *(uint4*)(R1 + (pe + 0) * RSTR + pch) = pp0; *(uint4*)(R1 + (pe + 32) * RSTR + pch) = pp1; *(uint4*)(R1 + (pe + 64) * RSTR + pch) = pp2; *(uint4*)(R1 + (pe + 96) * RSTR + pch) = pp3;
    const uint4 pn0 = *(const uint4*)(snT + (pe + 0) * 128 + pch), pn1 = *(const uint4*)(snT + (pe + 32) * 128 + pch), pn2 = *(const uint4*)(snT + (pe + 64) * 128 + pch), pn3 = *(const uint4*)(snT + (pe + 96) * 128 + pch);
    f32x4 o[1][8];
#pragma unroll
    for (int m = 0; m < 1; ++m)
#pragma unroll
      for (int n = 0; n < 8; ++n) o[m][n] = (f32x4){0.f, 0.f, 0.f, 0.f};
    lds_mma<1, 8, false, true>(o, R3, RSTR, wv * 16, R2, RSTR, 0, 128, lane, nullptr);
    __syncthreads();
    *(uint4*)(R2 + (pe + 0) * RSTR + pch) = pn0; *(uint4*)(R2 + (pe + 32) * RSTR + pch) = pn1; *(uint4*)(R2 + (pe + 64) * RSTR + pch) = pn2; *(uint4*)(R2 + (pe + 96) * RSTR + pch) = pn3;
    float scf[1], scb[1];
    { const int i = wv * 16 + fr; scf[0] = sPf[i + 1]; scb[0] = sPb[128 - i]; }
    lds_mma<1, 8, false, false>(o, R0, RSTR, wv * 16, R1, RSTR, 0, 128, lane, scf);
    __syncthreads();
    lds_mma<1, 8, false, false>(o, R0, RSTR, wv * 16, R2, RSTR, 0, 128, lane, scb);
#pragma unroll
    for (int m = 0; m < 1; ++m) {
      float s1 = 0.f;
#pragma unroll
      for (int n = 0; n < 8; ++n) s1 += (o[m][n][0] + o[m][n][1]) + (o[m][n][2] + o[m][n][3]);
      s1 += __shfl_xor(s1, 16); s1 += __shfl_xor(s1, 32);
      const float mu = s1 * (1.0f / 128.0f);
      float s2 = 0.f;
#pragma unroll
      for (int n = 0; n < 8; ++n)
#pragma unroll
        for (int r = 0; r < 4; ++r) { const float dl = o[m][n][r] - mu; s2 += dl * dl; }
      s2 += __shfl_xor(s2, 16); s2 += __shfl_xor(s2, 32);
      const float rs = rsqrtf(s2 * (1.0f / 128.0f) + 1e-5f);
      const size_t tok = (size_t)(t0 + wv * 16 + m * 16 + fr);
#pragma unroll
      for (int n = 0; n < 8; ++n) {
        const int e = n * 16 + 4 * fq;
        const uint2 gq = *(const uint2*)(gb + tok * 512 + h * 128 + e);
        const float g0 = lo16(gq.x), g1 = hi16(gq.x), g2 = lo16(gq.y), g3 = hi16(gq.y);
        uint2 w;
        w.x = pk2(g0 * sigmoidf_(g0) * (o[m][n][0] - mu) * rs, g1 * sigmoidf_(g1) * (o[m][n][1] - mu) * rs);
        w.y = pk2(g2 * sigmoidf_(g2) * (o[m][n][2] - mu) * rs, g3 * sigmoidf_(g3) * (o[m][n][3] - mu) * rs);
        *(uint2*)(ycat + tok * DM + h * 128 + e) = w;
      }
    }
  }
}

struct Cpx { float re, im; };
__device__ __forceinline__ Cpx cmul(Cpx a, Cpx b) { return {a.re * b.re - a.im * b.im, a.re * b.im + a.im * b.re}; }
__device__ __forceinline__ Cpx s5_lam(const P& p, int g, int dir, int l, int q) { const f32x2 v = ((const f32x2*)(p.ws + WS_LAMT))[((g * 2 + dir) * 33 + l) * 64 + q]; return {v[0], v[1]}; }
__device__ __forceinline__ Cpx s5_cf(const P& p, int g, int dir, int q) { const f32x2 v = ((const f32x2*)(p.ws + WS_LAMT + 3 * MB / 2))[(g * 2 + dir) * 64 + q]; return {v[0], v[1]}; }
__device__ __forceinline__ bool s5_setup_ids(int& gtid, int& gsz) {
  const bool half = (gridDim.x == 256);
  if (half && blockIdx.x < 128) return false;
  gtid = (half ? (int)blockIdx.x - 128 : (int)blockIdx.x) * NTHR + tidx(); gsz = (half ? 128 : (int)gridDim.x) * NTHR;
  return true;
}
__device__ __forceinline__ void phase_s5_ktab(const P& p) {
  float* ktab = (float*)(p.ws + WS_KTAB);
  int gtid, gsz; if (!s5_setup_ids(gtid, gsz)) return;
  for (int item = gtid; item < 32 * 2 * 32 * 16; item += gsz) {
    const int c = item & 15, l = (item >> 4) & 31, dir = (item >> 9) & 1, g = item >> 10;
    float acc[16];
#pragma unroll
    for (int j = 0; j < 16; ++j) acc[j] = 0.f;
    for (int q = 0; q < 64; ++q) {
      const Cpx L = s5_lam(p, g, dir, l, q), cf = s5_cf(p, g, dir, q);
      const Cpx C = {p.c_re[((dir * 32 + g) * 16 + c) * 64 + q], p.c_im[((dir * 32 + g) * 16 + c) * 64 + q]};
      const Cpx w = cmul(cmul(C, L), cf);
#pragma unroll
      for (int j = 0; j < 16; ++j) acc[j] += w.re * p.b_re[(g * 64 + q) * 16 + j] - w.im * p.b_im[(g * 64 + q) * 16 + j];
    }
#pragma unroll
    for (int j = 0; j < 16; j += 4) *(f32x4*)(ktab + (size_t)item * 16 + j) = (f32x4){acc[j], acc[j + 1], acc[j + 2], acc[j + 3]};
  }
}
__device__ __forceinline__ void phase_s5_fill_a(const P& p) {
  const float* ktab = (const float*)(p.ws + WS_KTAB);
  u16* bty = (u16*)(p.ws + WS_BTY);
  const int gtid = blockIdx.x * NTHR + tidx(), gsz = gridDim.x * NTHR;
  for (int item = gtid; item < 32 * 512 * 64; item += gsz) {
    const int ch = item & 63, n = (item >> 6) & 511, g = item >> 15;
    const int ip = ch >> 1, c0 = (ch & 1) * 8, i = n >> 4, c = n & 15;
    float v[8];
    if (ip != i) {
      const int dir = ip < i ? 0 : 1, l = ip < i ? i - ip : ip - i;
      const float* src = ktab + ((size_t)((g * 2 + dir) * 32 + l) * 16 + c) * 16 + c0;
      const f32x4 a = *(const f32x4*)src, b = *(const f32x4*)(src + 4);
      v[0] = a[0]; v[1] = a[1]; v[2] = a[2]; v[3] = a[3]; v[4] = b[0]; v[5] = b[1]; v[6] = b[2]; v[7] = b[3];
    } else {
      const float* s0 = ktab + ((size_t)((g * 2 + 0) * 32) * 16 + c) * 16 + c0;
      const float* s1 = ktab + ((size_t)((g * 2 + 1) * 32) * 16 + c) * 16 + c0;
      const float dd = p.s5d[g * 16 + c];
#pragma unroll
      for (int j = 0; j < 8; ++j) v[j] = s0[j] + s1[j] + ((c0 + j) == c ? dd : 0.f);
    }
    *(uint4*)(bty + ((size_t)g * 512 + n) * 768 + ch * 8) = make_uint4(pk2(v[0], v[1]), pk2(v[2], v[3]), pk2(v[4], v[5]), pk2(v[6], v[7]));
  }
}
__device__ __forceinline__ void phase_s5_fill_bc(const P& p) {
  u16* bty = (u16*)(p.ws + WS_BTY); u16* wet = (u16*)(p.ws + WS_WET);
  int gtid, gsz; if (!s5_setup_ids(gtid, gsz)) return;
  for (int item = gtid; item < 32 * 512 * 32; item += gsz) {
    const int ch = item & 31, n = (item >> 5) & 511, g = item >> 14;
    const int kk = ch * 8, dir = kk >> 7, p0 = (kk & 127) >> 1, i = n >> 4, c = n & 15;
    const int e = dir ? (32 - i) : (i + 1);
    float v[8];
#pragma unroll
    for (int q = 0; q < 4; ++q) {
      const int pq = p0 + q;
      const Cpx L = s5_lam(p, g, dir, e, pq);
      const Cpx C = {p.c_re[((dir * 32 + g) * 16 + c) * 64 + pq], p.c_im[((dir * 32 + g) * 16 + c) * 64 + pq]};
      const Cpx w = cmul(C, L);
      v[2 * q] = w.re; v[2 * q + 1] = -w.im;
    }
    *(uint4*)(bty + ((size_t)g * 512 + n) * 768 + 512 + kk) = make_uint4(pk2(v[0], v[1]), pk2(v[2], v[3]), pk2(v[4], v[5]), pk2(v[6], v[7]));
  }
  for (int item = gtid; item < 32 * 256 * 64; item += gsz) {
    const int ch = item & 63, n = (item >> 6) & 255, g = item >> 14;
    const int ip = ch >> 1, c0 = (ch & 1) * 8, ri = n & 1, pq = (n >> 1) & 63, dir = n >> 7;
    const int e = dir ? ip : (31 - ip);
    const Cpx w = cmul(s5_lam(p, g, dir, e, pq), s5_cf(p, g, dir, pq));
    float v[8];
#pragma unroll
    for (int j = 0; j < 8; ++j) {
      const float br = p.b_re[(g * 64 + pq) * 16 + c0 + j], bi = p.b_im[(g * 64 + pq) * 16 + c0 + j];
      v[j] = ri ? (w.re * bi + w.im * br) : (w.re * br - w.im * bi);
    }
    *(uint4*)(wet + ((size_t)g * 256 + n) * 512 + ch * 8) = make_uint4(pk2(v[0], v[1]), pk2(v[2], v[3]), pk2(v[4], v[5]), pk2(v[6], v[7]));
  }
}
__device__ __forceinline__ void phase_s5_carry(const P& p) {
  const float* E = (const float*)(p.ws + WS_E);
  u16* a2 = (u16*)(p.ws + WS_A2);
  const int gtid = blockIdx.x * NTHR + tidx(), gsz = gridDim.x * NTHR;
  for (int idx = gtid; idx < 32 * 8 * 128; idx += gsz) {
    const int pq = idx & 63, dir = (idx >> 6) & 1, b = (idx >> 7) & 7, g = idx >> 10;
    const Cpx L = s5_lam(p, g, dir, 32, pq);
    Cpx s = {0.f, 0.f};
    for (int jj = 0; jj < 64; ++jj) {
      const int j = dir ? 63 - jj : jj, r = b * 64 + j;
      const f32x2 e = *(const f32x2*)(E + ((size_t)g * 512 + r) * 256 + (dir * 64 + pq) * 2);
      *(unsigned*)(a2 + ((size_t)g * 512 + r) * 768 + 512 + (dir * 64 + pq) * 2) = pk2(s.re, s.im);
      const Cpx ns = cmul(L, s);
      s.re = ns.re + e[0]; s.im = ns.im + e[1];
    }
  }
}
constexpr int KSTR = 72;
__device__ __forceinline__ int t5_bucket_abs(int n) {
  return n < 8 ? n : 8 + (n >= 12) + (n >= 16) + (n >= 23) + (n >= 32) + (n >= 46) + (n >= 64) + (n >= 91);
}
__device__ __forceinline__ void phase_attn(const P& p, char* smem) {
  u16* sK = (u16*)smem; u16* sV = sK + 384 * KSTR; float* sBias = (float*)(sV + 384 * KSTR);
  const u16* q1 = (const u16*)(p.ws + WS_Z); const u16* k1 = (const u16*)(p.ws + WS_Z + 32 * MB); const u16* v1 = (const u16*)(p.ws + WS_Z + 40 * MB);
  u16* ao = (u16*)(p.ws + WS_YCAT);
  const int tid = tidx(), lane = tid & 63, wv = tid >> 6, fr = lane & 15, lg = lane >> 4, q0 = (wv & 3) * 32, hp = wv >> 2;
  const int tq = (lane & 15) >> 2, tp = lane & 3;
  for (int item = blockIdx.x; item < 512; item += gridDim.x) {
    const int b = item >> 6, nb = (item >> 2) & 15, kvh = item & 3;
    __syncthreads();
    for (int c = tid; c < 384 * 8; c += NTHR) {
      const int s = c >> 3, ch = (c & 7) * 8, pos = (nb - 1) * 128 + s;
      uint4 kq = make_uint4(0u, 0u, 0u, 0u), vq = kq;
      if (pos >= 0 && pos < SEQ) { kq = *(const uint4*)(k1 + (size_t)(b * SEQ + pos) * 256 + kvh * 64 + ch); vq = *(const uint4*)(v1 + (size_t)(b * SEQ + pos) * 256 + kvh * 64 + ch); }
      *(uint4*)(sK + s * KSTR + ch) = kq; *(uint4*)(sV + s * KSTR + ch) = vq;
    }
    for (int c = tid; c < 4 * 257; c += NTHR) {
      const int hq = c / 257, ri = c % 257, rel = ri - 128, n = rel < 0 ? -rel : rel;
      const int bucket = (rel > 0 ? 16 : 0) + t5_bucket_abs(n);
      sBias[hq * 260 + ri] = p.rel_bias[bucket * 16 + kvh * 4 + hq];
    }
    __syncthreads();
#pragma unroll 1
    for (int hh = 0; hh < 2; ++hh) {
      const int hq = hp * 2 + hh, head = kvh * 4 + hq;
      const size_t tok0 = (size_t)b * SEQ + nb * 128 + q0;
      uint4 qf[2][2];
#pragma unroll
      for (int qb = 0; qb < 2; ++qb)
#pragma unroll
        for (int ks = 0; ks < 2; ++ks) qf[qb][ks] = *(const uint4*)(q1 + (tok0 + qb * 16 + fr) * DM + head * 64 + ks * 32 + lg * 8);
      f32x4 O[4][2];
#pragma unroll
      for (int mb = 0; mb < 4; ++mb)
#pragma unroll
        for (int qb = 0; qb < 2; ++qb) O[mb][qb] = (f32x4){0.f, 0.f, 0.f, 0.f};
      const float sinkv = p.sink[head];
      float mrun[2] = {sinkv, sinkv}, lpart[2] = {lg == 0 ? 1.0f : 0.0f, lg == 0 ? 1.0f : 0.0f};
      const float* bias = sBias + hq * 260;
#pragma unroll
      for (int c = 0; c < 3; ++c) {
        if ((c == 0 && nb == 0) || (c == 2 && nb == 15)) continue;
        f32x4 S[8][2];
#pragma unroll
        for (int kb = 0; kb < 8; ++kb) {
          S[kb][0] = (f32x4){0.f, 0.f, 0.f, 0.f}; S[kb][1] = S[kb][0];
          const bool act = (c == 0) ? (16 * kb + 15 >= q0) : ((c == 2) ? (16 * kb <= q0 + 31) : true);
          if (act) {
#pragma unroll
            for (int ks = 0; ks < 2; ++ks) {
              const uint4 kf = *(const uint4*)(sK + (c * 128 + kb * 16 + fr) * KSTR + ks * 32 + lg * 8);
              S[kb][0] = mfma16(kf, qf[0][ks], S[kb][0]);
              S[kb][1] = mfma16(kf, qf[1][ks], S[kb][1]);
            }
          }
        }
        float cmax[2] = {-1e30f, -1e30f};
#pragma unroll
        for (int kb = 0; kb < 8; ++kb) {
          const bool act = (c == 0) ? (16 * kb + 15 >= q0) : ((c == 2) ? (16 * kb <= q0 + 31) : true);
          if (act) {
#pragma unroll
            for (int qb = 0; qb < 2; ++qb)
#pragma unroll
              for (int r = 0; r < 4; ++r) {
                const int ri = c * 128 + kb * 16 + 4 * lg + r - (q0 + qb * 16 + fr);
                float v;
                if (c == 1) v = S[kb][qb][r] + bias[ri];
                else { const bool valid = (ri >= 0) && (ri <= 256); v = valid ? S[kb][qb][r] + bias[valid ? ri : 0] : -1e30f; }
                S[kb][qb][r] = v; cmax[qb] = fmaxf(cmax[qb], v);
              }
          }
        }
#pragma unroll
        for (int qb = 0; qb < 2; ++qb) {
          cmax[qb] = fmaxf(cmax[qb], __shfl_xor(cmax[qb], 16)); cmax[qb] = fmaxf(cmax[qb], __shfl_xor(cmax[qb], 32));
          const float mn = fmaxf(mrun[qb], cmax[qb]), alpha = __expf(mrun[qb] - mn);
          mrun[qb] = mn; lpart[qb] *= alpha;
#pragma unroll
          for (int mb = 0; mb < 4; ++mb) O[mb][qb] = O[mb][qb] * alpha;
          float ps = 0.f;
#pragma unroll
          for (int kb = 0; kb < 8; ++kb) {
            const bool act = (c == 0) ? (16 * kb + 15 >= q0) : ((c == 2) ? (16 * kb <= q0 + 31) : true);
            if (act) {
#pragma unroll
              for (int r = 0; r < 4; ++r) { const float e = __expf(S[kb][qb][r] - mn); S[kb][qb][r] = e; ps += e; }
            }
          }
          lpart[qb] += ps;
        }
#pragma unroll
        for (int kk = 0; kk < 4; ++kk) {
          const int kb0 = 2 * kk, kb1 = 2 * kk + 1;
          const bool act = (c == 0) ? (16 * kb1 + 15 >= q0) : ((c == 2) ? (16 * kb0 <= q0 + 31) : true);
          if (act) {
            uint4 pf[2];
#pragma unroll
            for (int qb = 0; qb < 2; ++qb) pf[qb] = make_uint4(pk2(S[kb0][qb][0], S[kb0][qb][1]), pk2(S[kb0][qb][2], S[kb0][qb][3]), pk2(S[kb1][qb][0], S[kb1][qb][1]), pk2(S[kb1][qb][2], S[kb1][qb][3]));
#pragma unroll
            for (int mb = 0; mb < 4; ++mb) {
              const uint2 v0 = lds_tr16(sV + (c * 128 + kb0 * 16 + 4 * lg + tq) * KSTR + mb * 16 + 4 * tp);
              const uint2 v1r = lds_tr16(sV + (c * 128 + kb1 * 16 + 4 * lg + tq) * KSTR + mb * 16 + 4 * tp);
              const uint4 vf = make_uint4(v0.x, v0.y, v1r.x, v1r.y);
              O[mb][0] = mfma16(vf, pf[0], O[mb][0]);
              O[mb][1] = mfma16(vf, pf[1], O[mb][1]);
            }
          }
        }
      }
#pragma unroll
      for (int qb = 0; qb < 2; ++qb) {
        float lt = lpart[qb]; lt += __shfl_xor(lt, 16); lt += __shfl_xor(lt, 32);
        const float inv = 1.0f / lt;
#pragma unroll
        for (int mb = 0; mb < 4; ++mb) {
          uint2 w; w.x = pk2(O[mb][qb][0] * inv, O[mb][qb][1] * inv); w.y = pk2(O[mb][qb][2] * inv, O[mb][qb][3] * inv);
          *(uint2*)(ao + (tok0 + qb * 16 + fr) * DM + head * 64 + mb * 16 + 4 * lg) = w;
        }
      }
    }
  }
}

struct EpiInproj {
  static constexpr bool PERM = true;
  u16* zb; u16* a2; const f32x2* rope;
  __device__ __forceinline__ void operator()(const f32x4 (&acc)[2][2][4][2], const pg8::Unit& u, int wr, int wc, int fr, int fq) const {
    const int seg = u.pn >> 1;
#pragma unroll
    for (int ai = 0; ai < 2; ++ai)
#pragma unroll
      for (int m = 0; m < 4; ++m) {
        const int row = u.pm * 256 + ai * 128 + wr * 64 + m * 16 + fr;
        if (seg < 2) {
          const int d = 16 * wc + 4 * fq;
          const f32x2* cs = rope + (size_t)(row & (SEQ - 1)) * 64 + d;
          const f32x4 c01 = *(const f32x4*)cs, c23 = *(const f32x4*)(cs + 2);
          const float cv[4] = {c01[0], c01[2], c23[0], c23[2]}, sv[4] = {c01[1], c01[3], c23[1], c23[3]};
          const float sc = seg == 1 ? 0.08838834764831845f : 1.0f;
#pragma unroll
          for (int bj = 0; bj < 2; ++bj) {
            const f32x4 x1 = acc[ai][bj][m][0], x2 = acc[ai][bj][m][1];
            float o1[4], o2[4];
#pragma unroll
            for (int r = 0; r < 4; ++r) { o1[r] = (x1[r] * cv[r] - x2[r] * sv[r]) * sc; o2[r] = (x1[r] * sv[r] + x2[r] * cv[r]) * sc; }
            u16* dst = zb + (size_t)seg * T_TOK * 512 + (size_t)row * 512 + ((u.pn & 1) * 2 + bj) * 128 + d;
            uint2 w; w.x = pk2(o1[0], o1[1]); w.y = pk2(o1[2], o1[3]); *(uint2*)dst = w;
            w.x = pk2(o2[0], o2[1]); w.y = pk2(o2[2], o2[3]); *(uint2*)(dst + 64) = w;
          }
        } else {
#pragma unroll
          for (int bj = 0; bj < 2; ++bj) {
            const int col = u.pn * 256 + bj * 128 + wc * 32 + 8 * fq;
            const f32x4 v0 = acc[ai][bj][m][0], v1 = acc[ai][bj][m][1];
            uint4 w; w.x = pk2(v0[0], v0[1]); w.y = pk2(v0[2], v0[3]); w.z = pk2(v1[0], v1[1]); w.w = pk2(v1[2], v1[3]);
            if (seg < 4) *(uint4*)(zb + (size_t)seg * T_TOK * 512 + (size_t)row * 512 + (col - seg * 512)) = w;
            else { const int ch = col - 2048, gi = ch >> 4, c = ch & 15; *(uint4*)(a2 + ((size_t)gi * 512 + (row >> 5)) * 768 + (row & 31) * 16 + c) = w; }
          }
        }
      }
  }
};
__device__ __forceinline__ void phase_inproj(const P& p, LAS unsigned char* lds) {
  pg8::DenseOrder S; S.init(p.ws + WS_XB, DM, p.ws + WS_WIN, T_TOK, 2560, DM);
  EpiInproj E{(u16*)(p.ws + WS_Z), (u16*)(p.ws + WS_A2), (const f32x2*)(p.ws + WS_ROPE)};
  pg8::gemm_phase<EpiInproj, pg8::DenseOrder, G_ALIGN, G_SP2>(lds, DM, S, E);
}
struct EpiS5E {
  static constexpr bool PERM = false;
  float* E_;
  __device__ __forceinline__ void operator()(const f32x4 (&acc)[2][2][4][2], const pg8::Unit& u, int wr, int wc, int fr, int fq) const {
#pragma unroll
    for (int ai = 0; ai < 2; ++ai)
#pragma unroll
      for (int m = 0; m < 4; ++m) {
        const int row = u.pm * 256 + ai * 128 + wr * 64 + m * 16 + fr;
#pragma unroll
        for (int bj = 0; bj < 2; ++bj)
#pragma unroll
          for (int n = 0; n < 2; ++n) *(f32x4*)(E_ + ((size_t)u.e * 512 + row) * 256 + bj * 128 + wc * 32 + n * 16 + 4 * fq) = acc[ai][bj][m][n];
      }
  }
};
__device__ __forceinline__ void phase_s5_egemm(const P& p, LAS unsigned char* lds) {
  pg8::GroupOrder S; S.init(p.ws + WS_A2, 768, (size_t)512 * 768, p.ws + WS_WET, (size_t)256 * 512, 32, 512, 256, 512);
  EpiS5E E{(float*)(p.ws + WS_E)};
  pg8::gemm_phase<EpiS5E, pg8::GroupOrder, G_ALIGN, G_SP2>(lds, 512, S, E);
}
struct EpiS5Y {
  static constexpr bool PERM = true;
  u16* yg;
  __device__ __forceinline__ void operator()(const f32x4 (&acc)[2][2][4][2], const pg8::Unit& u, int wr, int wc, int fr, int fq) const {
#pragma unroll
    for (int ai = 0; ai < 2; ++ai)
#pragma unroll
      for (int m = 0; m < 4; ++m) {
        const int row = u.pm * 256 + ai * 128 + wr * 64 + m * 16 + fr;
#pragma unroll
        for (int bj = 0; bj < 2; ++bj) {
          const int col = u.pn * 256 + bj * 128 + wc * 32 + 8 * fq;
          const f32x4 v0 = acc[ai][bj][m][0], v1 = acc[ai][bj][m][1];
          uint4 w; w.x = pk2(gelu_tanh(v0[0]), gelu_tanh(v0[1])); w.y = pk2(gelu_tanh(v0[2]), gelu_tanh(v0[3])); w.z = pk2(gelu_tanh(v1[0]), gelu_tanh(v1[1])); w.w = pk2(gelu_tanh(v1[2]), gelu_tanh(v1[3]));
          *(uint4*)(yg + ((size_t)row * 32 + (col >> 4)) * 512 + u.e * 16 + (col & 15)) = w;
        }
      }
  }
};
__device__ __forceinline__ void phase_s5_ygemm(const P& p, LAS unsigned char* lds) {
  pg8::GroupOrder S; S.init(p.ws + WS_A2, 768, (size_t)512 * 768, p.ws + WS_BTY, (size_t)512 * 768, 32, 512, 512, 768);
  EpiS5Y E{(u16*)(p.ws + WS_YGELU)};
  pg8::gemm_phase<EpiS5Y, pg8::GroupOrder, G_ALIGN, G_SP2>(lds, 768, S, E);
}
struct EpiGlu {
  static constexpr bool PERM = true;
  const u16* yg; const float* bglu; u16* ycat;
  __device__ __forceinline__ void operator()(const f32x4 (&acc)[2][2][4][2], const pg8::Unit& u, int wr, int wc, int fr, int fq) const {
#pragma unroll
    for (int ai = 0; ai < 2; ++ai)
#pragma unroll
      for (int m = 0; m < 4; ++m) {
        const int row = u.pm * 256 + ai * 128 + wr * 64 + m * 16 + fr;
#pragma unroll
        for (int bj = 0; bj < 2; ++bj) {
          const int col = u.pn * 256 + bj * 128 + wc * 32 + 8 * fq;
          const f32x4 v0 = acc[ai][bj][m][0], v1 = acc[ai][bj][m][1];
          const uint4 yv = *(const uint4*)(yg + (size_t)row * 512 + col);
          const f32x4 b0 = *(const f32x4*)(bglu + col), b1 = *(const f32x4*)(bglu + col + 4);
          uint4 w;
          w.x = pk2(lo16(yv.x) * sigmoidf_(v0[0] + b0[0]), hi16(yv.x) * sigmoidf_(v0[1] + b0[1]));
          w.y = pk2(lo16(yv.y) * sigmoidf_(v0[2] + b0[2]), hi16(yv.y) * sigmoidf_(v0[3] + b0[3]));
          w.z = pk2(lo16(yv.z) * sigmoidf_(v1[0] + b1[0]), hi16(yv.z) * sigmoidf_(v1[1] + b1[1]));
          w.w = pk2(lo16(yv.w) * sigmoidf_(v1[2] + b1[2]), hi16(yv.w) * sigmoidf_(v1[3] + b1[3]));
          *(uint4*)(ycat + (size_t)row * DM + 512 + col) = w;
        }
      }
  }
};
__device__ __forceinline__ void phase_glu(const P& p, LAS unsigned char* lds) {
  pg8::DenseOrder S; S.init(p.ws + WS_YGELU, 512, p.ws + WS_WGLU, T_TOK, 512, 512);
  EpiGlu E{(const u16*)(p.ws + WS_YGELU), p.b_glu, (u16*)(p.ws + WS_YCAT)};
  pg8::gemm_phase<EpiGlu, pg8::DenseOrder, G_ALIGN, G_SP2>(lds, 512, S, E);
}
struct EpiResid {
  static constexpr bool PERM = false;
  const float* xin; float* xout;
  __device__ __forceinline__ void operator()(const f32x4 (&acc)[2][2][4][2], const pg8::Unit& u, int wr, int wc, int fr, int fq) const {
#pragma unroll
    for (int ai = 0; ai < 2; ++ai)
#pragma unroll
      for (int m = 0; m < 4; ++m) {
        const int row = u.pm * 256 + ai * 128 + wr * 64 + m * 16 + fr;
#pragma unroll
        for (int bj = 0; bj < 2; ++bj)
#pragma unroll
          for (int n = 0; n < 2; ++n) {
            const size_t o = (size_t)row * DM + u.pn * 256 + bj * 128 + wc * 32 + n * 16 + 4 * fq;
            const f32x4 xv = *(const f32x4*)(xin + o);
            *(f32x4*)(xout + o) = xv + acc[ai][bj][m][n];
          }
      }
  }
};
__device__ __forceinline__ void phase_outproj(const P& p, const void* Wt, const float* xin, float* xout, LAS unsigned char* lds) {
  pg8::DenseOrder S; S.init(p.ws + WS_YCAT, DM, Wt, T_TOK, DM, DM);
  EpiResid E{xin, xout};
  pg8::gemm_phase<EpiResid, pg8::DenseOrder, G_ALIGN, G_SP2>(lds, DM, S, E);
}
struct EpiQkv {
  static constexpr bool PERM = true;
  u16 *q1, *k1, *v1;
  __device__ __forceinline__ void operator()(const f32x4 (&acc)[2][2][4][2], const pg8::Unit& u, int wr, int wc, int fr, int fq) const {
    const float sc = u.pn < 4 ? 0.125f : 1.0f;
#pragma unroll
    for (int ai = 0; ai < 2; ++ai)
#pragma unroll
      for (int m = 0; m < 4; ++m) {
        const int row = u.pm * 256 + ai * 128 + wr * 64 + m * 16 + fr;
#pragma unroll
        for (int bj = 0; bj < 2; ++bj) {
          const int col = u.pn * 256 + bj * 128 + wc * 32 + 8 * fq;
          const f32x4 a0 = acc[ai][bj][m][0] * sc, a1 = acc[ai][bj][m][1] * sc;
          uint4 w; w.x = pk2(a0[0], a0[1]); w.y = pk2(a0[2], a0[3]); w.z = pk2(a1[0], a1[1]); w.w = pk2(a1[2], a1[3]);
          if (u.pn < 4) *(uint4*)(q1 + (size_t)row * DM + col) = w;
          else if (u.pn == 4) *(uint4*)(k1 + (size_t)row * 256 + (col - 1024)) = w;
          else *(uint4*)(v1 + (size_t)row * 256 + (col - 1280)) = w;
        }
      }
  }
};
__device__ __forceinline__ void phase_qkv(const P& p, LAS unsigned char* lds) {
  pg8::DenseOrder S; S.init(p.ws + WS_XB, DM, p.ws + WS_WQKV, T_TOK, 1536, DM);
  EpiQkv E{(u16*)(p.ws + WS_Z), (u16*)(p.ws + WS_Z + 32 * MB), (u16*)(p.ws + WS_Z + 40 * MB)};
  pg8::gemm_phase<EpiQkv, pg8::DenseOrder, G_ALIGN, G_SP2>(lds, DM, S, E);
}
__device__ __forceinline__ void phase_moe_plan(const P& p, int layer, char* smem) {
  if (blockIdx.x != 0) return;
  using pg8::PLAN_STRIDE;
  const int tid = tidx();
  const int* cnt = (const int*)(p.ws + WS_CNT) + layer * 32;
  int* plan_n = (int*)(p.ws + WS_PLAN + layer * 65536); int4* plan = (int4*)(p.ws + WS_PLAN + layer * 65536 + 256);
  int* sc = (int*)smem;
  int* ecum = sc + 32; int* ebase = ecum + 32; int* ehb = ebase + 32; int* efull = ehb + 32; int* tot = efull + 32;
  int* sstart = tot + 8; int* sfstart = sstart + 8; int* cntF = sfstart + 8; int* cntR = cntF + 8;
  unsigned* keyR = (unsigned*)(cntR + 8);
  constexpr int NN = 4;
  __syncthreads();
  if (tid < 32) sc[tid] = cnt[tid];
  if (tid < 8) { sstart[tid] = 0x7fffffff; sfstart[tid] = 0; cntF[tid] = 0; cntR[tid] = 0; }
  if (tid < 128) keyR[tid] = 0xffffffffu;
  __syncthreads();
  if (tid == 0) {
    int cum = 0, ub = 0, hb = 0, fb = 0;
    for (int e = 0; e < 32; ++e) {
      const int c = sc[e], fl = c >> 8, rem = c & 255, rc = (rem + 63) >> 6, ntl = fl + (rem ? 1 : 0);
      ecum[e] = cum; ebase[e] = ub; ehb[e] = hb; efull[e] = fb;
      cum += (fl * 4 + rc) * NN; ub += ntl * NN; hb += ntl * 256; fb += fl * NN;
    }
    tot[0] = cum > 0 ? cum : 1; tot[1] = ub;
  }
  __syncthreads();
  const int total = tot[0], nunits = tot[1] < 1024 ? tot[1] : 1024;
  int4 en[2]; int ux[2], uF[2]; unsigned ukr[2]; bool ufull[2], uval[2];
#pragma unroll
  for (int q = 0; q < 2; ++q) {
    const int u = tid + q * NTHR;
    uval[q] = u < nunits; ux[q] = 0; uF[q] = 0; ukr[q] = 0; ufull[q] = true; en[q] = make_int4(0, 0, 0, 0);
    if (uval[q]) {
      int e = 0;
      for (int j = 1; j < 32; ++j) if (ebase[j] <= u) e = j;
      const int c = sc[e], fl = c >> 8, rem = c & 255, rc = (rem + 63) >> 6, ntl = fl + (rem ? 1 : 0);
      const int local = u - ebase[e], ct = local / ntl, rt = local - ct * ntl;
      const int cum = ecum[e] + ct * (fl * 4 + rc) + rt * 4;
      const bool isfull = rt < fl;
      int x = (cum * 8) / total; if (x > 7) x = 7;
      ux[q] = x; ufull[q] = isfull; uF[q] = efull[e] + ct * fl + (rt < fl ? rt : fl);
      en[q] = make_int4(e | (rt << 8) | (ct << 16), c, ehb[e], 0);
      atomicMin(&sstart[x], u);
      if (isfull) atomicAdd(&cntF[x], 1);
      else { atomicAdd(&cntR[x], 1); ukr[q] = ((unsigned)x << 16) | ((unsigned)(4 - rc) << 12) | (unsigned)(e * NN + ct); keyR[e * NN + ct] = ukr[q]; }
    }
  }
  __syncthreads();
#pragma unroll
  for (int q = 0; q < 2; ++q) if (uval[q] && (tid + q * NTHR) == sstart[ux[q]]) sfstart[ux[q]] = uF[q];
  __syncthreads();
#pragma unroll
  for (int q = 0; q < 2; ++q) {
    if (uval[q]) {
      const int x = ux[q];
      int pos;
      if (ufull[q]) pos = uF[q] - sfstart[x];
      else { pos = cntF[x]; for (int v = 0; v < 128; ++v) { const unsigned kv = keyR[v]; pos += ((kv >> 16) == (unsigned)x && kv < ukr[q]) ? 1 : 0; } }
      if (pos < PLAN_STRIDE) plan[x * PLAN_STRIDE + pos] = en[q];
    }
  }
  if (tid < 8) { const int n = cntF[tid] + cntR[tid]; plan_n[tid] = n < PLAN_STRIDE ? n : PLAN_STRIDE; }
  __syncthreads();
}
struct EpiMoe1 {
  static constexpr bool PERM = false;
  u16* hbuf;
  __device__ __forceinline__ void operator()(const f32x4 (&acc)[2][2][4][2], const pg8::Unit& u, int wr, int wc, int fr, int fq) const {
#pragma unroll
    for (int ai = 0; ai < 2; ++ai)
#pragma unroll
      for (int m = 0; m < 4; ++m) {
        const int row = u.pm * 256 + ai * 128 + wr * 64 + m * 16 + fr;
        if (row < u.cnt) {
#pragma unroll
          for (int bj = 0; bj < 2; ++bj) {
            const f32x4 g = acc[ai][bj][m][0], up = acc[ai][bj][m][1];
            uint2 w; w.x = pk2(g[0] * sigmoidf_(g[0]) * up[0], g[1] * sigmoidf_(g[1]) * up[1]); w.y = pk2(g[2] * sigmoidf_(g[2]) * up[2], g[3] * sigmoidf_(g[3]) * up[3]);
            *(uint2*)(hbuf + (size_t)(u.hbase + row) * 512 + 16 * (8 * u.pn + 4 * bj + wc) + 4 * fq) = w;
          }
        }
      }
  }
};
__device__ __forceinline__ void phase_moe1(const P& p, int layer, LAS unsigned char* lds) {
  pg8::PlanOrder S; S.init(p.ws + WS_PLAN + layer * 65536, (const int2*)(p.ws + WS_LIST2), p.ws + WS_XB, DM, p.ws + (layer ? WS_MW1 : WS_MW0), (size_t)DM * DM, DM, true);
  EpiMoe1 E{(u16*)(p.ws + WS_H)};
  pg8::gemm_phase<EpiMoe1, pg8::PlanOrder, G_ALIGN, G_SP2>(lds, DM, S, E);
}
struct EpiMoe2 {
  static constexpr bool PERM = true;
  const int2* list; u16* slots;
  __device__ __forceinline__ void operator()(const f32x4 (&acc)[2][2][4][2], const pg8::Unit& u, int wr, int wc, int fr, int fq) const {
#pragma unroll
    for (int ai = 0; ai < 2; ++ai)
#pragma unroll
      for (int m = 0; m < 4; ++m) {
        const int row = u.pm * 256 + ai * 128 + wr * 64 + m * 16 + fr;
        if (row < u.cnt) {
          const int2 en = list[(size_t)u.e * CAP + row];
          const int asg = en.x; const float gt = __int_as_float(en.y);
#pragma unroll
          for (int bj = 0; bj < 2; ++bj) {
            const f32x4 v0 = acc[ai][bj][m][0] * gt, v1 = acc[ai][bj][m][1] * gt;
            uint4 w; w.x = pk2(v0[0], v0[1]); w.y = pk2(v0[2], v0[3]); w.z = pk2(v1[0], v1[1]); w.w = pk2(v1[2], v1[3]);
            *(uint4*)(slots + (size_t)asg * DM + u.pn * 256 + bj * 128 + wc * 32 + 8 * fq) = w;
          }
        }
      }
  }
};
__device__ __forceinline__ void phase_moe2(const P& p, int layer, LAS unsigned char* lds) {
  pg8::PlanOrder S; S.init(p.ws + WS_PLAN + layer * 65536, (const int2*)(p.ws + WS_LIST2), p.ws + WS_H, 512, p.ws + (layer ? WS_MW1 : WS_MW0) + 64 * MB, (size_t)DM * 512, 512, false);
  EpiMoe2 E{(const int2*)(p.ws + WS_LIST2), (u16*)(p.ws + WS_INC)};
  pg8::gemm_phase<EpiMoe2, pg8::PlanOrder, G_ALIGN, G_SP2>(lds, 512, S, E);
}

#define XB_TMO      128
#define XB_XCNT(j)  (256  + 64 * (j))
#define XB_XSUB(j)  (1280 + 64 * (j))
#define XB_XGEN(j)  (2304 + 64 * (j))
#define XB_TOP      3328
#define XB_TOPGEN   3392
#define XCD_BAR_WORDS 3456
#define XB_SPIN_CAP (1u << 22)
__device__ __forceinline__ unsigned xb_ld(unsigned* p)              { return __hip_atomic_load(p, __ATOMIC_RELAXED, __HIP_MEMORY_SCOPE_AGENT); }
__device__ __forceinline__ unsigned xb_add(unsigned* p, unsigned v) { return __hip_atomic_fetch_add(p, v, __ATOMIC_RELAXED, __HIP_MEMORY_SCOPE_AGENT); }
__device__ __forceinline__ unsigned xb_xcc_id() { return (unsigned)__builtin_amdgcn_s_getreg((3 << 11) | 20) & 0xFu; }
#define XB_SPIN(cond, bar) do { unsigned _sp = 0; while (cond) { __builtin_amdgcn_s_sleep(1); \
    if ((++_sp & 255u) == 0u) { if (xb_ld(&(bar)[XB_TMO])) break; if (_sp > XB_SPIN_CAP) { atomicAdd(&(bar)[XB_TMO], 1u); break; } } } } while (0)
struct XcdBarrier { unsigned* bar; unsigned x; volatile LAS unsigned* st; };
__device__ __forceinline__ XcdBarrier xcd_barrier_post(unsigned* bar, volatile LAS unsigned* st) {
  XcdBarrier b; b.bar = bar; b.x = xb_xcc_id(); b.st = st;
  if (tidx() == 0) (void)xb_add(&bar[XB_XCNT(b.x)], 1u);
  return b;
}
__device__ __forceinline__ void xcd_barrier_complete(unsigned* bar, unsigned x, unsigned& nloc, unsigned& nx) {
  const unsigned G = gridDim.x * gridDim.y * gridDim.z;
  unsigned sum, cnt, mine, sp = 0u;
  for (;;) {
    sum = 0u; cnt = 0u; mine = 0u;
#pragma unroll
    for (unsigned j = 0; j < 16; ++j) { const unsigned c = xb_ld(&bar[XB_XCNT(j)]); sum += c; cnt += (c > 0u) ? 1u : 0u; mine = (j == x) ? c : mine; }
    if (sum == G) break;
    __builtin_amdgcn_s_sleep(1);
    if ((++sp & 255u) == 0u) { if (xb_ld(&bar[XB_TMO])) break; if (sp > XB_SPIN_CAP) { atomicAdd(&bar[XB_TMO], 1u); break; } }
  }
  nloc = mine > 0u ? mine : 1u; nx = cnt > 0u ? cnt : 1u;
}
__device__ __forceinline__ void xcd_barrier(const XcdBarrier& b) {
  asm volatile("s_waitcnt vmcnt(0)" ::: "memory");
  __syncthreads();
  if (tidx() == 0) {
    unsigned* bar = b.bar;
    __builtin_amdgcn_s_waitcnt(0);
    unsigned nloc = b.st[0], nx = b.st[1];
    if (nloc == 0u) { xcd_barrier_complete(bar, b.x, nloc, nx); b.st[0] = nloc; b.st[1] = nx; }
    const unsigned old = xb_add(&bar[XB_XSUB(b.x)], 1u);
    const unsigned gen = old / nloc;
    if (old + 1u == (gen + 1u) * nloc) {
      __builtin_amdgcn_fence(__ATOMIC_RELEASE, "agent");
      asm volatile("s_waitcnt vmcnt(0)" ::: "memory");
      const unsigned og = xb_add(&bar[XB_TOP], 1u);
      const unsigned tg = og / nx;
      if (og + 1u == (tg + 1u) * nx) xb_add(&bar[XB_TOPGEN], 1u);
      else XB_SPIN(xb_ld(&bar[XB_TOPGEN]) == tg, bar);
      __builtin_amdgcn_fence(__ATOMIC_ACQUIRE, "agent");
      xb_add(&bar[XB_XGEN(b.x)], 1u);
      asm volatile("s_waitcnt vmcnt(0)" ::: "memory");
    } else {
      XB_SPIN(xb_ld(&bar[XB_XGEN(b.x)]) == gen, bar);
      __builtin_amdgcn_fence(__ATOMIC_ACQUIRE, "agent");
      asm volatile("s_waitcnt vmcnt(0)" ::: "memory");
    }
  }
  __syncthreads();
}

constexpr int NPHASE = 20;
#ifndef C0A
#define C0A 25
#define C0B 70
#define C1A 65
#endif
constexpr int LDS_BYTES = 147456;
__device__ __forceinline__ void run_phase(const P& p, int ph, char* smem, LAS unsigned char* lds) {
  float* xa = (float*)(p.ws + WS_XA);
  const u16* slots = (const u16*)(p.ws + WS_INC);
  switch (ph) {
    case 0: phase_rowpass(p, p.x, nullptr, nullptr, p.norm_mix_g, -1, nullptr, smem); phase_prep(p); __syncthreads(); phase_conv_dense(p, smem); break;
    case 1: phase_inproj(p, lds); phase_s5_ktab(p); phase_s5_fill_bc(p); phase_conv_moe(p, 0, 0, cq(C0A), 128, 128, smem); break;
    case 2: phase_ret_inc_mfma(p, smem); __syncthreads(); phase_s5_egemm(p, lds); phase_s5_fill_a(p); break;
    case 3: phase_ret_scan16(p); phase_s5_carry(p); break;
    case 4: phase_ret_out_mfma(p, smem); __syncthreads(); phase_s5_ygemm(p, lds); break;
    case 5: phase_glu(p, lds); phase_conv_moe(p, 0, cq(C0A), cq(C0B), 128, 128, smem); break;
    case 6: phase_outproj(p, p.ws + WS_WOUT, p.x, xa, lds); break;
    case 7: phase_rowpass(p, xa, nullptr, nullptr, p.norm_ffn_g, 0, nullptr, smem); break;
    case 8: phase_moe_plan(p, 0, smem); phase_conv_moe(p, 0, cq(C0B), CONV_ITEMS, 1, 255, smem); break;
    case 9: phase_moe1(p, 0, lds); break;
    case 10: phase_moe2(p, 0, lds); break;
    case 11: phase_rowpass(p, xa, slots, xa, p.norm_mix_g + DM, -1, nullptr, smem); break;
    case 12: phase_qkv(p, lds); phase_conv_moe(p, 1, 0, cq(C1A), 128, 128, smem); break;
    case 13: phase_attn(p, smem); break;
    case 14: phase_outproj(p, p.ws + WS_WO, xa, xa, lds); break;
    case 15: phase_rowpass(p, xa, nullptr, nullptr, p.norm_ffn_g + DM, 1, nullptr, smem); break;
    case 16: phase_moe_plan(p, 1, smem); phase_conv_moe(p, 1, cq(C1A), CONV_ITEMS, 1, 255, smem); break;
    case 17: phase_moe1(p, 1, lds); break;
    case 18: phase_moe2(p, 1, lds); break;
    case 19: phase_rowpass(p, xa, slots, nullptr, p.norm_final_g, -1, p.out, smem); break;
    default: break;
  }
}

extern __shared__ __attribute__((aligned(16))) char dyn_smem[];

template <int PH> __device__ __forceinline__ void mega_steps(const P& p, char* smem, LAS unsigned char* lds, const XcdBarrier& xb) {
  run_phase(p, PH, smem, lds);
  if constexpr (PH + 1 < NPHASE) {
    xcd_barrier(xb);
    mega_steps<PH + 1>(p, smem, lds, xb);
  }
}
__global__ void __launch_bounds__(NTHR, 2) k_mega(P p) {
  LAS unsigned char* lds = (LAS unsigned char*)dyn_smem;
  volatile LAS unsigned* st = (volatile LAS unsigned*)(lds + LDS_BYTES - 16);
  if (tidx() == 0) { st[0] = 0u; st[1] = 0u; }
  __syncthreads();
  const XcdBarrier xb = xcd_barrier_post((unsigned*)(p.ws + WS_BAR), st);
  mega_steps<0>(p, dyn_smem, lds, xb);
}

extern "C" void kernel_launch(void* const* d_in, const int* in_sizes, int n_in, void* d_out, int out_size, void* d_ws, size_t ws_size, hipStream_t stream) {
  static int grid_blocks = 0;
  if (grid_blocks == 0) {
    if (n_in != 28 || out_size != T_TOK * DM || ws_size < WS_END) { fprintf(stderr, "kernel_launch: unexpected problem (n_in %d out %d ws %zu need %zu)\n", n_in, out_size, ws_size, (size_t)WS_END); grid_blocks = -1; return; }
    int dev = 0, cus = 0, per_cu = 0;
    (void)hipGetDevice(&dev);
    (void)hipDeviceGetAttribute(&cus, hipDeviceAttributeMultiprocessorCount, dev);
    const void* fn = (const void*)k_mega;
    if (hipFuncSetAttribute(fn, hipFuncAttributeMaxDynamicSharedMemorySize, LDS_BYTES) != hipSuccess) { fprintf(stderr, "kernel_launch: hipFuncSetAttribute failed\n"); }
    if (hipOccupancyMaxActiveBlocksPerMultiprocessor(&per_cu, fn, NTHR, LDS_BYTES) != hipSuccess || per_cu < 1) { fprintf(stderr, "kernel_launch: occupancy query failed (%d)\n", per_cu); per_cu = 1; }
    (void)hipGetLastError();
    if (per_cu > 1) per_cu = 1;
    grid_blocks = cus * per_cu;
    fprintf(stderr, "kernel_launch: cus %d per_cu %d grid %d\n", cus, per_cu, grid_blocks);
  }
  if (grid_blocks < 0) return;
  P p{};
  const float** pp = (const float**)&p;
  for (int i = 0; i < 28; ++i) pp[i] = (const float*)d_in[i];
  p.out = (float*)d_out; p.ws = (char*)d_ws;
  (void)hipMemsetAsync((char*)d_ws + WS_BAR, 0, XCD_BAR_WORDS * 4, stream);
  void* args[] = {&p};
  const hipError_t e = hipLaunchCooperativeKernel((const void*)k_mega, dim3(grid_blocks), dim3(NTHR), args, LDS_BYTES, stream);
  if (e != hipSuccess) fprintf(stderr, "cooperative launch failed: %s (grid %d)\n", hipGetErrorString(e), grid_blocks);
}
```

```cpp
#include <hip/hip_runtime.h>
#include <cstdio>
#include <cstdint>

#define USE_FP16 1
#define LAS __attribute__((address_space(3)))

typedef unsigned short u16;
typedef float f32x4 __attribute__((ext_vector_type(4)));
typedef float f32x2 __attribute__((ext_vector_type(2)));
typedef _Float16 f16x8 __attribute__((ext_vector_type(8)));

constexpr int T_TOK = 16384, DM = 1024, SEQ = 2048, NBATCH = 8;
constexpr int CAP = 32768;
constexpr int NTHR = 512, NWAVE = NTHR / 64;

constexpr size_t MB = 1024ull * 1024ull;
constexpr size_t WS_XA    = 0;
constexpr size_t WS_XB    = 64 * MB;
constexpr size_t WS_Z     = 96 * MB;
constexpr size_t WS_A2    = 160 * MB;
constexpr size_t WS_BTY   = 184 * MB;
constexpr size_t WS_MW1   = 160 * MB;
constexpr size_t WS_WET   = 208 * MB;
constexpr size_t WS_E     = 216 * MB;
constexpr size_t WS_KTAB  = 232 * MB;
constexpr size_t WS_SP16  = 234 * MB;
constexpr size_t WS_INC   = 266 * MB;
constexpr size_t WS_YCAT  = 330 * MB;
constexpr size_t WS_YGELU = 362 * MB;
constexpr size_t WS_H     = 330 * MB;
constexpr size_t WS_LIST  = 378 * MB;
constexpr size_t WS_GATE  = 382 * MB;
constexpr size_t WS_ROPE  = 383 * MB;
constexpr size_t WS_CNT   = 384 * MB;
constexpr size_t WS_WR16  = 385 * MB;
constexpr size_t WS_BAR   = 386 * MB;
constexpr size_t WS_PLAN  = 386 * MB + 512 * 1024;
constexpr size_t WS_WIN   = 387 * MB;
constexpr size_t WS_WGLU  = 392 * MB;
constexpr size_t WS_WOUT  = 393 * MB;
constexpr size_t WS_WQKV  = 395 * MB;
constexpr size_t WS_WO    = 398 * MB;
constexpr size_t WS_LAMT  = 400 * MB;
constexpr size_t WS_MW0   = 402 * MB;
constexpr size_t WS_LIST2 = 498 * MB;
constexpr size_t WS_END   = 506 * MB;

struct P {
  const float *x, *norm_mix_g, *norm_ffn_g, *norm_final_g, *w_in, *ret_decay, *a_re, *a_im, *log_step, *b_re, *b_im, *c_re, *c_im,
      *s5d, *w_glu, *b_glu, *w_out, *w_qkv, *sink, *w_o, *rel_bias, *w_group, *b_group, *w_er, *b_er, *w_gate, *w_up, *w_down;
  float* out;
  char* ws;
};

__device__ __forceinline__ u16 f2h(float f) { _Float16 h = (_Float16)f; return __builtin_bit_cast(u16, h); }
__device__ __forceinline__ float h2f(u16 h) { return (float)__builtin_bit_cast(_Float16, h); }
__device__ __forceinline__ unsigned pk2(float a, float b) { return (unsigned)f2h(a) | ((unsigned)f2h(b) << 16); }
__device__ __forceinline__ float lo16(unsigned w) { return h2f((u16)(w & 0xffffu)); }
__device__ __forceinline__ float hi16(unsigned w) { return h2f((u16)(w >> 16)); }
__device__ __forceinline__ f32x4 mfma16(uint4 a, uint4 b, f32x4 c) {
  return __builtin_amdgcn_mfma_f32_16x16x32_f16(__builtin_bit_cast(f16x8, a), __builtin_bit_cast(f16x8, b), c, 0, 0, 0);
}
__device__ __forceinline__ float wave_sum(float v) {
#pragma unroll
  for (int o = 1; o < 64; o <<= 1) v += __shfl_xor(v, o);
  return v;
}
__device__ __forceinline__ float sigmoidf_(float x) { return 1.0f / (1.0f + __expf(-x)); }
__device__ __forceinline__ float gelu_tanh(float x) {
  const float u = 0.7978845608028654f * (x + 0.044715f * x * x * x);
  return 0.5f * x * (1.0f + tanhf(u));
}
#define LDS_WAIT() asm volatile("s_waitcnt lgkmcnt(0)" ::: "memory")
__device__ __forceinline__ int tidx() { int t = threadIdx.x; asm volatile("" : "+v"(t)); return t; }

namespace pg8 {
constexpr int BM = 256, BK = 64, HALF = 128, HTB = HALF * BK * 2, STAGE_BYTES = 8 * HTB, NXCD = 8, WGM = 8;
__device__ __forceinline__ int lds_byte(int r, int c) { const int st = (r >> 4) * 2 + (c >> 5), rr = r & 15, cc = c & 31, ob = rr * 64 + cc * 2; return st * 1024 + (ob ^ (((ob >> 9) & 1) << 5)); }
__device__ __forceinline__ int perm32(int rho) { const int n = rho >> 4, i = rho & 15; return 8 * (i >> 2) + 4 * n + (i & 3); }
__device__ __forceinline__ void stage_rc(int b, int& R, int& C) { const int st = b / 1024, sb = b % 1024, swz = sb ^ (((sb >> 9) & 1) << 5); R = (st >> 1) * 16 + swz / 64; C = (st & 1) * 32 + (swz % 64) / 2; }

struct Unit { const char* a; const char* b; int pm, pn, e, cnt, hbase; };

template <class Epi, class Sched, bool ALIGN_EPI, bool SP2>
__device__ __forceinline__ void gemm_phase(LAS unsigned char* lds, const int K, const Sched& S, const Epi& E) {
    const int tid = tidx(), wid = __builtin_amdgcn_readfirstlane(tid >> 6), lane = tid & 63, wr = wid >> 2, wc = wid & 3, fr = lane & 15, fq = lane >> 4;
    const int nt = K / BK;
    int Rr[2], Cc[2];
    unsigned voffB[2];
#pragma unroll
    for (int i = 0; i < 2; ++i) { stage_rc(tid * 16 + i * 8192, Rr[i], Cc[i]); const int Rb = Epi::PERM ? ((Rr[i] & ~31) + perm32(Rr[i] & 31)) : Rr[i]; voffB[i] = (unsigned)(Rb * K + Cc[i]) * 2u; }
    const size_t kstep = (size_t)(BK * 2);
    const size_t hstepB = (size_t)HALF * K * 2;
    const unsigned ldsw = (unsigned)wid * 1024u;
    const int aoff = lds_byte(wr * 64 + fr, fq * 8), boff = lds_byte(wc * 32 + fr, fq * 8);
#define PG8_SA(b, h) (((b) * 2 + (h)) * HTB)
#define PG8_SB(b, h) ((4 + (b) * 2 + (h)) * HTB)
#define PG8_STAGE(bufoff, gbase, voff) do { _Pragma("unroll") for (int _i = 0; _i < 2; ++_i) \
        __builtin_amdgcn_global_load_lds((const unsigned*)((const char*)(gbase) + (voff)[_i]), (LAS unsigned*)(lds + (bufoff) + ldsw + _i * 8192), 16, 0, 0); } while (0)
#define PG8_LDA(dst, b, h) do { _Pragma("unroll") for (int m = 0; m < 4; ++m) _Pragma("unroll") for (int k = 0; k < 2; ++k) dst[m][k] = *(const LAS f16x8*)(lds + PG8_SA(b, h) + aoff + m * 2048 + k * 1024); } while (0)
#define PG8_LDB(dst, b, h) do { _Pragma("unroll") for (int n = 0; n < 2; ++n) _Pragma("unroll") for (int k = 0; k < 2; ++k) dst[n][k] = *(const LAS f16x8*)(lds + PG8_SB(b, h) + boff + n * 2048 + k * 1024); } while (0)
#define PG8_MMA(ai, bj, At, Bt) do { if (128 * (ai) + 64 * wr >= urows) break; __builtin_amdgcn_s_setprio(1); _Pragma("unroll") for (int m = 0; m < 4; ++m) _Pragma("unroll") for (int n = 0; n < 2; ++n) _Pragma("unroll") for (int k = 0; k < 2; ++k) \
        acc[ai][bj][m][n] = __builtin_amdgcn_mfma_f32_16x16x32_f16(Bt[n][k], At[m][k], acc[ai][bj][m][n], 0, 0, 0); __builtin_amdgcn_s_setprio(0); } while (0)
#define PG8_WAIT_V(n) asm volatile("s_waitcnt vmcnt(" #n ")" ::: "memory")
#define PG8_WAIT_L(n) asm volatile("s_waitcnt lgkmcnt(" #n ")" ::: "memory")
#define PG8_BAR __builtin_amdgcn_s_barrier()
#define PG8_SCHED __builtin_amdgcn_sched_barrier(0)
    Unit cur, nxt; int ui = 0;
    if (!S.next(0, cur)) return;
    unsigned cv0[2], cv1[2], nv0[2], nv1[2];
#pragma unroll
    for (int i = 0; i < 2; ++i) { cv0[i] = S.a_voff(cur, 0, Rr[i], Cc[i]); cv1[i] = S.a_voff(cur, 1, Rr[i], Cc[i]); }
    f32x4 acc[2][2][4][2];
#pragma unroll
    for (int a = 0; a < 2; ++a)
#pragma unroll
        for (int b = 0; b < 2; ++b)
#pragma unroll
            for (int m = 0; m < 4; ++m)
#pragma unroll
                for (int n = 0; n < 2; ++n) acc[a][b][m][n] = (f32x4){0.f, 0.f, 0.f, 0.f};
    f16x8 At[4][2], B0[2][2], B1[2][2];
    const char* cA = cur.a; const char* cB = cur.b;
    int urows = S.rows(cur);
    if constexpr (SP2) {
        PG8_STAGE(PG8_SB(0, 0), cB, voffB); PG8_STAGE(PG8_SB(0, 1), cB + hstepB, voffB); PG8_STAGE(PG8_SA(0, 0), cA, cv0); PG8_STAGE(PG8_SA(0, 1), cA, cv1);
        if (wr == 1) PG8_BAR;
        PG8_WAIT_V(2); PG8_BAR;
        PG8_STAGE(PG8_SB(1, 0), cB + kstep, voffB); PG8_STAGE(PG8_SA(1, 0), cA + kstep, cv0); PG8_STAGE(PG8_SB(1, 1), cB + hstepB + kstep, voffB);
        PG8_WAIT_V(6); PG8_BAR;
    } else {
        PG8_STAGE(PG8_SB(0, 0), cB, voffB); PG8_STAGE(PG8_SA(0, 0), cA, cv0); PG8_STAGE(PG8_SB(0, 1), cB + hstepB, voffB); PG8_STAGE(PG8_SA(0, 1), cA, cv1);
        if (wr == 1) PG8_BAR;
        PG8_WAIT_V(4); PG8_BAR;
        PG8_STAGE(PG8_SB(1, 0), cB + kstep, voffB); PG8_STAGE(PG8_SA(1, 0), cA + kstep, cv0); PG8_STAGE(PG8_SB(1, 1), cB + hstepB + kstep, voffB);
        PG8_WAIT_V(6); PG8_BAR;
    }
    for (;;) {
        const bool has_next = S.next(ui + 1, nxt);
        if (has_next) {
#pragma unroll
            for (int i = 0; i < 2; ++i) { nv0[i] = S.a_voff(nxt, 0, Rr[i], Cc[i]); nv1[i] = S.a_voff(nxt, 1, Rr[i], Cc[i]); }
        } else {
            nxt = cur;
#pragma unroll
            for (int i = 0; i < 2; ++i) { nv0[i] = cv0[i]; nv1[i] = cv1[i]; }
        }
        const char* nA = nxt.a; const char* nB = nxt.b;
        for (int t = 0; t < nt; t += 2) {
            const bool last = (t == nt - 2);
            const char* a1 = cA + (size_t)(t + 1) * kstep;
            const char* a2 = last ? nA : cA + (size_t)(t + 2) * kstep; const char* b2 = last ? nB : cB + (size_t)(t + 2) * kstep;
            const char* a3 = a2 + kstep; const char* b3 = b2 + kstep;
            unsigned v0[2], v1[2];
#pragma unroll
            for (int i = 0; i < 2; ++i) { v0[i] = last ? nv0[i] : cv0[i]; v1[i] = last ? nv1[i] : cv1[i]; }
            if constexpr (SP2) {
            PG8_LDB(B0, 0, 0); PG8_LDB(B1, 0, 1); PG8_SCHED; PG8_LDA(At, 0, 0); PG8_STAGE(PG8_SA(1, 1), a1, cv1);
            PG8_WAIT_V(8); PG8_WAIT_L(0); PG8_BAR; PG8_MMA(0, 0, At, B0); PG8_MMA(0, 1, At, B1); PG8_BAR; PG8_SCHED;
            PG8_LDA(At, 0, 1); PG8_STAGE(PG8_SB(0, 0), b2, voffB); PG8_STAGE(PG8_SB(0, 1), b2 + hstepB, voffB); PG8_STAGE(PG8_SA(0, 0), a2, v0);
            PG8_WAIT_V(8); PG8_WAIT_L(0); PG8_BAR; PG8_MMA(1, 0, At, B0); PG8_MMA(1, 1, At, B1); PG8_BAR; PG8_SCHED;
            PG8_LDB(B0, 1, 0); PG8_LDB(B1, 1, 1); PG8_SCHED; PG8_LDA(At, 1, 0); PG8_STAGE(PG8_SA(0, 1), a2, v1);
            PG8_WAIT_V(8); PG8_WAIT_L(0); PG8_BAR; PG8_MMA(0, 0, At, B0); PG8_MMA(0, 1, At, B1); PG8_BAR; PG8_SCHED;
            PG8_LDA(At, 1, 1); PG8_STAGE(PG8_SB(1, 0), b3, voffB); PG8_STAGE(PG8_SB(1, 1), b3 + hstepB, voffB); PG8_STAGE(PG8_SA(1, 0), a3, v0);
            PG8_WAIT_V(8); PG8_WAIT_L(0); PG8_BAR; PG8_MMA(1, 0, At, B0); PG8_MMA(1, 1, At, B1); PG8_BAR; PG8_SCHED;
            } else {
            PG8_LDB(B0, 0, 0); PG8_SCHED; PG8_LDA(At, 0, 0); PG8_STAGE(PG8_SA(1, 1), a1, cv1);
            PG8_WAIT_L(8); PG8_BAR; PG8_WAIT_L(0); PG8_MMA(0, 0, At, B0); PG8_BAR; PG8_SCHED;
            PG8_LDB(B1, 0, 1); PG8_STAGE(PG8_SB(0, 0), b2, voffB);
            PG8_BAR; PG8_WAIT_L(0); PG8_MMA(0, 1, At, B1); PG8_BAR;
            PG8_LDA(At, 0, 1); PG8_STAGE(PG8_SA(0, 0), a2, v0);
            PG8_BAR; PG8_WAIT_L(0); PG8_MMA(1, 0, At, B0); PG8_BAR; PG8_SCHED;
            PG8_STAGE(PG8_SB(0, 1), b2 + hstepB, voffB);
            PG8_WAIT_V(6); PG8_BAR; PG8_MMA(1, 1, At, B1); PG8_BAR;
            PG8_LDB(B0, 1, 0); PG8_SCHED; PG8_LDA(At, 1, 0); PG8_STAGE(PG8_SA(0, 1), a2, v1);
            PG8_WAIT_L(8); PG8_BAR; PG8_WAIT_L(0); PG8_MMA(0, 0, At, B0); PG8_BAR; PG8_SCHED;
            PG8_LDB(B1, 1, 1); PG8_STAGE(PG8_SB(1, 0), b3, voffB);
            PG8_BAR; PG8_WAIT_L(0); PG8_MMA(0, 1, At, B1); PG8_BAR;
            PG8_LDA(At, 1, 1); PG8_STAGE(PG8_SA(1, 0), a3, v0);
            PG8_BAR; PG8_WAIT_L(0); PG8_MMA(1, 0, At, B0); PG8_BAR; PG8_SCHED;
            PG8_STAGE(PG8_SB(1, 1), b3 + hstepB, voffB);
            PG8_WAIT_V(6); PG8_BAR; PG8_MMA(1, 1, At, B1); PG8_BAR;
            }
        }
        if constexpr (ALIGN_EPI) { if (wr == 0) PG8_BAR; }
        E(acc, cur, wr, wc, fr, fq);
        if (!has_next) break;
#pragma unroll
        for (int a = 0; a < 2; ++a)
#pragma unroll
            for (int b = 0; b < 2; ++b)
#pragma unroll
                for (int m = 0; m < 4; ++m)
#pragma unroll
                    for (int n = 0; n < 2; ++n) acc[a][b][m][n] = (f32x4){0.f, 0.f, 0.f, 0.f};
        cur = nxt; cA = nA; cB = nB; ++ui; urows = S.rows(cur);
#pragma unroll
        for (int i = 0; i < 2; ++i) { cv0[i] = nv0[i]; cv1[i] = nv1[i]; }
        if constexpr (ALIGN_EPI) { if (wr == 1) PG8_BAR; }
    }
    PG8_WAIT_V(0);
    if constexpr (!ALIGN_EPI) { if (wr == 0) PG8_BAR; }
    PG8_BAR;
#undef PG8_SA
#undef PG8_SB
#undef PG8_STAGE
#undef PG8_LDA
#undef PG8_LDB
#undef PG8_MMA
#undef PG8_WAIT_V
#undef PG8_WAIT_L
#undef PG8_BAR
#undef PG8_SCHED
}

struct DenseOrder {
    const char* A; const char* Bt; int lda_b, K, nM, nN, nwg, G, c;
    __device__ __forceinline__ void init(const void* A_, int lda_elems, const void* Bt_, int M, int N, int K_) { A = (const char*)A_; Bt = (const char*)Bt_; lda_b = lda_elems * 2; K = K_; nM = M / BM; nN = N / BM; nwg = nM * nN; G = gridDim.x; c = blockIdx.x; }
    __device__ __forceinline__ bool next(int i, Unit& u) const {
        const long L = (long)i * G + c; if (L >= nwg) return false;
        int wgid = (int)L; { const int q = nwg / NXCD, r = nwg % NXCD, xcd = wgid % NXCD, off = wgid / NXCD; wgid = (xcd < r ? xcd * (q + 1) : r * (q + 1) + (xcd - r) * q) + off; }
        const int nig = WGM * nN, gid = wgid / nig, fm = gid * WGM, gsz = (nM - fm) < WGM ? (nM - fm) : WGM;
        u.pm = fm + ((wgid % nig) % gsz); u.pn = (wgid % nig) / gsz; u.e = 0; u.cnt = 0; u.hbase = 0;
        u.a = A + (size_t)u.pm * BM * lda_b; u.b = Bt + (size_t)u.pn * BM * K * 2;
        return true;
    }
    __device__ __forceinline__ unsigned a_voff(const Unit&, int h, int R, int C) const { return (unsigned)((h * HALF + R) * lda_b + C * 2); }
    __device__ __forceinline__ int rows(const Unit&) const { return BM; }
};
struct GroupOrder {
    const char* A; const char* Bt; int lda_b, K, nM, nN, ng, G, c; size_t gsA, gsB;
    __device__ __forceinline__ void init(const void* A_, int lda_elems, size_t gsA_elems, const void* Bt_, size_t gsB_elems, int ng_, int M, int N, int K_) {
        A = (const char*)A_; Bt = (const char*)Bt_; lda_b = lda_elems * 2; K = K_; nM = M / BM; nN = N / BM; ng = ng_; gsA = gsA_elems * 2; gsB = gsB_elems * 2; G = gridDim.x; c = blockIdx.x; }
    __device__ __forceinline__ bool next(int i, Unit& u) const {
        const long L = (long)i * G + c; if (L >= (long)ng * nM * nN) return false;
        const int per = nM * nN, g = (int)L / per, r = (int)L % per;
        u.e = g; u.pm = r / nN; u.pn = r % nN; u.cnt = 0; u.hbase = 0;
        u.a = A + (size_t)g * gsA + (size_t)u.pm * BM * lda_b; u.b = Bt + (size_t)g * gsB + (size_t)u.pn * BM * K * 2;
        return true;
    }
    __device__ __forceinline__ unsigned a_voff(const Unit&, int h, int R, int C) const { return (unsigned)((h * HALF + R) * lda_b + C * 2); }
    __device__ __forceinline__ int rows(const Unit&) const { return BM; }
};
constexpr int PLAN_STRIDE = 256;
struct PlanOrder {
    const int4* plan; const int* plan_n; const int2* list; const char* A; const char* Bt; int lda_b, K, x, ib, nbx; size_t esB; bool gather;
    __device__ __forceinline__ void init(const void* planbase, const int2* list_, const void* A_, int lda_elems, const void* Bt_, size_t esB_elems, int K_, bool gather_) {
        plan_n = (const int*)planbase; plan = (const int4*)((const char*)planbase + 256); list = list_; A = (const char*)A_; Bt = (const char*)Bt_; lda_b = lda_elems * 2; K = K_; esB = esB_elems * 2; gather = gather_;
        x = blockIdx.x & 7; ib = blockIdx.x >> 3; nbx = ((int)gridDim.x - x + 7) >> 3; }
    __device__ __forceinline__ bool next(int i, Unit& u) const {
        const int j = i * nbx + ib;
        if (j >= plan_n[x]) return false;
        const int4 en = plan[x * PLAN_STRIDE + j];
        u.e = en.x & 255; u.pm = (en.x >> 8) & 255; u.pn = (en.x >> 16) & 255; u.cnt = en.y; u.hbase = en.z;
        u.a = gather ? A : A + (size_t)(u.hbase + u.pm * BM) * lda_b;
        u.b = Bt + (size_t)u.e * esB + (size_t)u.pn * BM * K * 2;
        return true;
    }
    __device__ __forceinline__ unsigned a_voff(const Unit& u, int h, int R, int C) const {
        if (!gather) return (unsigned)((h * HALF + R) * lda_b + C * 2);
        const int li = u.pm * BM + h * HALF + R;
        const int tok = (li < u.cnt) ? (list[(size_t)u.e * CAP + li].x >> 1) : 0;
        return (unsigned)(tok * lda_b + C * 2);
    }
    __device__ __forceinline__ int rows(const Unit& u) const { const int r = u.cnt - u.pm * BM; return r < BM ? r : BM; }
};
}
constexpr bool G_ALIGN = true, G_SP2 = true;

__device__ __forceinline__ void phase_prep(const P& p) {
  const int gtid = blockIdx.x * NTHR + tidx(), gsz = gridDim.x * NTHR;
  int* cnt = (int*)(p.ws + WS_CNT);
  if (gtid < 64) cnt[gtid] = 0;
  f32x2* rope = (f32x2*)(p.ws + WS_ROPE);
  for (int i = gtid; i < SEQ * 64; i += gsz) {
    const int pos = i >> 6, f = i & 63;
    const float inv = powf(10000.0f, -(float)(2 * f) / 128.0f);
    const float ang = (float)pos * inv;
    float s, c; sincosf(ang, &s, &c);
    rope[i] = (f32x2){c, s};
  }
  f32x2* lamt = (f32x2*)(p.ws + WS_LAMT); f32x2* coeft = (f32x2*)(p.ws + WS_LAMT + 3 * MB / 2);
  for (int i = gtid; i < 32 * 2 * 33 * 64; i += gsz) {
    const int q = i & 63, l = (i >> 6) % 33, gd = i / (33 * 64);
    const int g = gd >> 1, dir = gd & 1;
    const float dt = expf(p.log_step[dir * 32 + g]), ar = p.a_re[(dir * 32 + g) * 64 + q], ai = p.a_im[(dir * 32 + g) * 64 + q];
    const float mag = expf(ar * dt * (float)l); float sn, cs; sincosf(ai * dt * (float)l, &sn, &cs);
    lamt[i] = (f32x2){mag * cs, mag * sn};
    if (l == 1) {
      const float em1 = expm1f(ar * dt), sh = sinf(0.5f * ai * dt);
      const float nr = em1 * cs - 2.0f * sh * sh, ni = (em1 + 1.0f) * sn, den = ar * ar + ai * ai;
      coeft[gd * 64 + q] = (f32x2){(nr * ar + ni * ai) / den, (ni * ar - nr * ai) / den};
    }
  }
  u16* wr16 = (u16*)(p.ws + WS_WR16);
  for (int i = gtid; i < 2 * 48 * DM; i += gsz) {
    const int k = i & (DM - 1), n = (i >> 10) % 48, layer = i / (48 * DM);
    float w = 0.f;
    if (n < 4) w = p.w_group[((size_t)layer * DM + k) * 4 + n];
    else if (n < 36) { const int gg = (n - 4) >> 3, j = (n - 4) & 7; w = p.w_er[(((size_t)layer * 4 + gg) * DM + k) * 8 + j]; }
    w *= p.norm_ffn_g[layer * DM + k];
    const u16 hi = f2h(w), lo = f2h(w - h2f(hi));
    wr16[((size_t)(layer * 2 + 0) * 48 + n) * DM + k] = hi;
    wr16[((size_t)(layer * 2 + 1) * 48 + n) * DM + k] = lo;
  }
}

template <class RowFn>
__device__ __forceinline__ void conv_item(const float* W, int ldw, int K, u16* WT, float* scr, int k0, int n0, int lane, RowFn rowfn) {
#pragma unroll 8
  for (int i = 0; i < 32; ++i) { const int kk = 2 * i + (lane >> 5); scr[kk * 33 + (lane & 31)] = W[(size_t)(k0 + kk) * ldw + n0 + (lane & 31)]; }
  LDS_WAIT();
  const int c = lane & 7;
#pragma unroll
  for (int j = 0; j < 4; ++j) {
    const int n = (lane >> 3) + 8 * j; const float* sp = scr + (8 * c) * 33 + n;
    uint4 o; o.x = pk2(sp[0 * 33], sp[1 * 33]); o.y = pk2(sp[2 * 33], sp[3 * 33]); o.z = pk2(sp[4 * 33], sp[5 * 33]); o.w = pk2(sp[6 * 33], sp[7 * 33]);
    *(uint4*)(WT + (size_t)rowfn(n0 + n) * K + k0 + 8 * c) = o;
  }
  LDS_WAIT();
}
template <class RowFn>
__device__ __forceinline__ int conv_matrix(const float* W, int ldw, int K, int N, u16* WT, char* smem, int item_base, RowFn rowfn) {
  const int lane = tidx() & 63, wv = tidx() >> 6, gw = blockIdx.x * NWAVE + wv, nw = gridDim.x * NWAVE;
  float* scr = (float*)smem + wv * (64 * 33);
  const int nkb = K / 64, nnb = N / 32, nitems = nkb * nnb;
  int it = gw - (item_base % nw); if (it < 0) it += nw;
  for (; it < nitems; it += nw) conv_item(W, ldw, K, WT, scr, (it / nnb) * 64, (it % nnb) * 32, lane, rowfn);
  return nitems;
}
__device__ __forceinline__ void phase_conv_dense(const P& p, char* smem) {
  auto id = [](int n) { return n; };
  int base = 0;
  base += conv_matrix(p.w_in, 2560, DM, 2560, (u16*)(p.ws + WS_WIN), smem, base, [](int n) { if (n >= 1024) return n; const int dd = n & 127, hf = dd >> 6, r = dd & 63; return (n & ~127) + 32 * (r >> 4) + 8 * ((r & 15) >> 2) + 4 * hf + (r & 3); });
  base += conv_matrix(p.w_glu, 512, 512, 512, (u16*)(p.ws + WS_WGLU), smem, base, id);
  base += conv_matrix(p.w_out, DM, DM, DM, (u16*)(p.ws + WS_WOUT), smem, base, id);
  base += conv_matrix(p.w_qkv, 1536, DM, 1536, (u16*)(p.ws + WS_WQKV), smem, base, id);
  base += conv_matrix(p.w_o, DM, DM, DM, (u16*)(p.ws + WS_WO), smem, base, id);
}
__device__ __forceinline__ void phase_conv_moe(const P& p, int layer, int lo, int hi, int b0, int nb, char* smem) {
  if (gridDim.x != 256) { b0 = 0; nb = (int)gridDim.x; }
  if ((int)blockIdx.x < b0 || (int)blockIdx.x >= b0 + nb) return;
  const int lane = tidx() & 63, wv = tidx() >> 6, gw = ((int)blockIdx.x - b0) * NWAVE + wv, nw = nb * NWAVE;
  float* scr = (float*)smem + wv * (64 * 33);
  u16* w1t = (u16*)(p.ws + (layer ? WS_MW1 : WS_MW0)); u16* w2t = w1t + (size_t)32 * DM * DM;
  for (int it = lo + gw; it < hi; it += nw) {
    const int e = it / 768, r = it % 768;
    if (r < 512) {
      const int which = r >> 8, q = r & 255, k0 = (q >> 4) * 64, n0 = (q & 15) * 32;
      const float* W = (which ? p.w_up : p.w_gate) + (size_t)(layer * 32 + e) * DM * 512;
      conv_item(W, 512, DM, w1t + (size_t)e * DM * DM, scr, k0, n0, lane, [which](int n) { return (n >> 4) * 32 + which * 16 + (n & 15); });
    } else {
      const int q = r - 512, k0 = (q >> 5) * 64, n0 = (q & 31) * 32;
      const float* W = p.w_down + (size_t)(layer * 32 + e) * 512 * DM;
      conv_item(W, DM, 512, w2t + (size_t)e * DM * 512, scr, k0, n0, lane, [](int n) { return n; });
    }
  }
}

constexpr int CONV_ITEMS = 32 * 768;
constexpr int cq(int pct) { return (int)((long)CONV_ITEMS * pct / 100); }
__device__ __forceinline__ void phase_rowpass(const P& p, const float* src, const u16* slots, float* dstx, const float* gain, int route_layer, float* fout, char* smem) {
  const int lane = tidx() & 63, wv = tidx() >> 6, fr = lane & 15, lg = lane >> 4;
  u16* xb = (u16*)(p.ws + WS_XB);
  int* cnt = (int*)(p.ws + WS_CNT);
  int2* list2 = (int2*)(p.ws + WS_LIST2);
  float* sRs = (float*)smem;
  float* sLg = (float*)smem + 64;
  for (int st = blockIdx.x; st < T_TOK / 64; st += gridDim.x) {
    const int row0 = st * 64 + wv * 8;
#pragma unroll 1
    for (int rp = 0; rp < 4; ++rp) {
      f32x4 v[2][4];
#pragma unroll
      for (int q = 0; q < 2; ++q) {
        const int row = row0 + rp * 2 + q;
#pragma unroll
        for (int i = 0; i < 4; ++i) v[q][i] = *(const f32x4*)(src + (size_t)row * DM + (i * 64 + lane) * 4);
      }
      if (slots) {
#pragma unroll
        for (int q = 0; q < 2; ++q) {
          const int row = row0 + rp * 2 + q;
          uint2 w[2][4];
#pragma unroll
          for (int sl = 0; sl < 2; ++sl)
#pragma unroll
            for (int i = 0; i < 4; ++i) w[sl][i] = *(const uint2*)(slots + ((size_t)row * 2 + sl) * DM + (i * 64 + lane) * 4);
#pragma unroll
          for (int sl = 0; sl < 2; ++sl)
#pragma unroll
            for (int i = 0; i < 4; ++i) { v[q][i][0] += lo16(w[sl][i].x); v[q][i][1] += hi16(w[sl][i].x); v[q][i][2] += lo16(w[sl][i].y); v[q][i][3] += hi16(w[sl][i].y); }
        }
      }
#pragma unroll
      for (int q = 0; q < 2; ++q) {
        const int row = row0 + rp * 2 + q;
        float ss = 0.f;
#pragma unroll
        for (int i = 0; i < 4; ++i) {
          if (dstx) *(f32x4*)(dstx + (size_t)row * DM + (i * 64 + lane) * 4) = v[q][i];
          ss += v[q][i][0] * v[q][i][0] + v[q][i][1] * v[q][i][1] + v[q][i][2] * v[q][i][2] + v[q][i][3] * v[q][i][3];
        }
        ss = wave_sum(ss);
        const float rstd = rsqrtf(ss * (1.0f / DM) + 1e-6f);
        if (route_layer >= 0 && lane == 0) sRs[wv * 8 + rp * 2 + q] = rstd;
#pragma unroll
        for (int i = 0; i < 4; ++i) {
          const int k = (i * 64 + lane) * 4;
          const f32x4 gv = *(const f32x4*)(gain + k);
          const f32x4 hv = v[q][i] * rstd * gv;
          if (fout) *(f32x4*)(fout + (size_t)row * DM + k) = hv;
          else { uint2 w; w.x = pk2(hv[0], hv[1]); w.y = pk2(hv[2], hv[3]); *(uint2*)(xb + (size_t)row * DM + k) = w; }
        }
      }
    }
    if (route_layer >= 0) {
      __syncthreads();
      const int tl = wv & 3, kh = wv >> 2;
      const float rsv = sRs[tl * 16 + fr];
      const float* xrow = src + (size_t)(st * 64 + tl * 16 + fr) * DM + kh * 512 + lg * 8;
      const u16* whi = (const u16*)(p.ws + WS_WR16) + ((size_t)(route_layer * 2 + 0) * 48 + fr) * DM + kh * 512 + lg * 8;
      const u16* wlo = (const u16*)(p.ws + WS_WR16) + ((size_t)(route_layer * 2 + 1) * 48 + fr) * DM + kh * 512 + lg * 8;
      f32x4 acc[3];
#pragma unroll
      for (int nb = 0; nb < 3; ++nb) acc[nb] = (f32x4){0.f, 0.f, 0.f, 0.f};
#pragma unroll 4
      for (int ks = 0; ks < 16; ++ks) {
        const f32x4 x0 = *(const f32x4*)(xrow + ks * 32), x1 = *(const f32x4*)(xrow + ks * 32 + 4);
        const float hv[8] = {x0[0] * rsv, x0[1] * rsv, x0[2] * rsv, x0[3] * rsv, x1[0] * rsv, x1[1] * rsv, x1[2] * rsv, x1[3] * rsv};
        unsigned ah[4], al[4];
#pragma unroll
        for (int j = 0; j < 4; ++j) {
          const u16 h0 = f2h(hv[2 * j]), h1 = f2h(hv[2 * j + 1]);
          ah[j] = (unsigned)h0 | ((unsigned)h1 << 16);
          al[j] = pk2(hv[2 * j] - h2f(h0), hv[2 * j + 1] - h2f(h1));
        }
        const uint4 ahi = make_uint4(ah[0], ah[1], ah[2], ah[3]), alo = make_uint4(al[0], al[1], al[2], al[3]);
#pragma unroll
        for (int nb = 0; nb < 3; ++nb) {
          const uint4 bh = *(const uint4*)(whi + (size_t)nb * 16 * DM + ks * 32), bl = *(const uint4*)(wlo + (size_t)nb * 16 * DM + ks * 32);
          acc[nb] = mfma16(bh, ahi, acc[nb]); acc[nb] = mfma16(bh, alo, acc[nb]); acc[nb] = mfma16(bl, ahi, acc[nb]);
        }
      }
      float* lgw = sLg + ((kh * 4 + tl) * 16 + fr) * 49;
#pragma unroll
      for (int nb = 0; nb < 3; ++nb)
#pragma unroll
        for (int r = 0; r < 4; ++r) lgw[nb * 16 + 4 * lg + r] = acc[nb][r];
      __syncthreads();
      if (wv < 4 && lane < 16) {
        const int row = st * 64 + wv * 16 + lane;
        const float* l0 = sLg + ((0 * 4 + wv) * 16 + lane) * 49;
        const float* l1 = sLg + ((1 * 4 + wv) * 16 + lane) * 49;
        const float* bg = p.b_group + route_layer * 4;
        const float* be = p.b_er + route_layer * 32;
        float gl[4];
#pragma unroll
        for (int j = 0; j < 4; ++j) gl[j] = l0[j] + l1[j] + bg[j];
        int gs = 0; float gm = gl[0];
#pragma unroll
        for (int j = 1; j < 4; ++j) if (gl[j] > gm) { gm = gl[j]; gs = j; }
        float den = 0.f;
#pragma unroll
        for (int j = 0; j < 4; ++j) den += expf(gl[j] - gm);
        const float pg = 1.0f / den;
        float el[8];
#pragma unroll
        for (int j = 0; j < 8; ++j) el[j] = l0[4 + gs * 8 + j] + l1[4 + gs * 8 + j] + be[gs * 8 + j];
        int i1 = 0; float v1 = el[0];
#pragma unroll
        for (int j = 1; j < 8; ++j) if (el[j] > v1) { v1 = el[j]; i1 = j; }
        int i2 = -1; float v2 = -3.0e38f;
#pragma unroll
        for (int j = 0; j < 8; ++j) if (j != i1 && el[j] > v2) { v2 = el[j]; i2 = j; }
        const float e2 = expf(v2 - v1);
        const float g1 = pg / (1.0f + e2), g2 = pg * e2 / (1.0f + e2);
        const int ex1 = gs * 8 + i1, ex2 = gs * 8 + i2;
        const int r1 = atomicAdd(&cnt[route_layer * 32 + ex1], 1);
        const int r2 = atomicAdd(&cnt[route_layer * 32 + ex2], 1);
        list2[(size_t)ex1 * CAP + r1] = make_int2(row * 2, __float_as_int(g1));
        list2[(size_t)ex2 * CAP + r2] = make_int2(row * 2 + 1, __float_as_int(g2));
      }
      __syncthreads();
    }
  }
}

constexpr int RSTR = 136;
__device__ __forceinline__ float log_sigmoid(float x) { return -log1pf(expf(-x)); }
__device__ __forceinline__ uint2 lds_tr16(const u16* ptr) {
  typedef short s16x4 __attribute__((ext_vector_type(4)));
  const s16x4 v = __builtin_amdgcn_ds_read_tr16_b64_v4i16((LAS s16x4*)ptr);
  return __builtin_bit_cast(uint2, v);
}
__device__ __forceinline__ uint4 lds_frag_T(const u16* tile, int rs, int k0, int c0, int lane) {
  const int g = lane >> 4, q = (lane & 15) >> 2, pp = lane & 3;
  const u16* a = tile + (k0 + 8 * g + q) * rs + c0 + 4 * pp;
  const uint2 lo = lds_tr16(a), hi = lds_tr16(a + 4 * rs);
  return make_uint4(lo.x, lo.y, hi.x, hi.y);
}
__device__ __forceinline__ void ret_load_tile(u16* dst0, u16* dst1, const u16* src, int t0, int h, const float* w0, const float* w1) {
  for (int c = tidx(); c < 128 * 16; c += NTHR) {
    const int i = c >> 4, ch = (c & 15) * 8;
    const uint4 v = *(const uint4*)(src + (size_t)(t0 + i) * 512 + h * 128 + ch);
    if (w0) {
      const float a = w0[i], b = w1[i];
      const float f[8] = {lo16(v.x), hi16(v.x), lo16(v.y), hi16(v.y), lo16(v.z), hi16(v.z), lo16(v.w), hi16(v.w)};
      *(uint4*)(dst0 + i * RSTR + ch) = make_uint4(pk2(f[0] * a, f[1] * a), pk2(f[2] * a, f[3] * a), pk2(f[4] * a, f[5] * a), pk2(f[6] * a, f[7] * a));
      *(uint4*)(dst1 + i * RSTR + ch) = make_uint4(pk2(f[0] * b, f[1] * b), pk2(f[2] * b, f[3] * b), pk2(f[4] * b, f[5] * b), pk2(f[6] * b, f[7] * b));
    } else *(uint4*)(dst0 + i * RSTR + ch) = v;
  }
}
template <int MB_, int NB_, bool ATR, bool BTR>
__device__ __forceinline__ void lds_mma(f32x4 (&acc)[MB_][NB_], const u16* sA, int sa, int a0, const u16* sB, int sb, int b0, int K, int lane, const float* sc) {
  const int fr = lane & 15, fq = lane >> 4;
  for (int k0 = 0; k0 < K; k0 += 32) {
    uint4 fa[MB_], fb[NB_];
#pragma unroll
    for (int m = 0; m < MB_; ++m) {
      if constexpr (ATR) fa[m] = lds_frag_T(sA, sa, k0, a0 + m * 16, lane);
      else fa[m] = *(const uint4*)(sA + (a0 + m * 16 + fr) * sa + k0 + fq * 8);
      if (sc) {
        const float f = sc[m];
        fa[m].x = pk2(lo16(fa[m].x) * f, hi16(fa[m].x) * f); fa[m].y = pk2(lo16(fa[m].y) * f, hi16(fa[m].y) * f);
        fa[m].z = pk2(lo16(fa[m].z) * f, hi16(fa[m].z) * f); fa[m].w = pk2(lo16(fa[m].w) * f, hi16(fa[m].w) * f);
      }
    }
#pragma unroll
    for (int n = 0; n < NB_; ++n) {
      if constexpr (BTR) fb[n] = lds_frag_T(sB, sb, k0, b0 + n * 16, lane);
      else fb[n] = *(const uint4*)(sB + (b0 + n * 16 + fr) * sb + k0 + fq * 8);
    }
#pragma unroll
    for (int m = 0; m < MB_; ++m)
#pragma unroll
      for (int n = 0; n < NB_; ++n) acc[m][n] = mfma16(fb[n], fa[m], acc[m][n]);
  }
}
__device__ __forceinline__ void ret_items(int ng, int& first, int& count, int& stride) {
  const int c = blockIdx.x, G = gridDim.x;
  if (G != 256) { first = c; count = (512 - c + G - 1) / G; stride = G; return; }
  stride = 1;
  if (c < ng) { first = c; count = 1; return; }
  const int rest = 512 - ng, nb = 256 - ng, q = rest / nb, r = rest % nb, i = c - ng;
  first = ng + i * q + (i < r ? i : r); count = q + (i < r ? 1 : 0);
}
__device__ __forceinline__ void phase_ret_inc_mfma(const P& p, char* smem) {
  u16* sKf = (u16*)smem; u16* sKb = sKf + 128 * RSTR; u16* sV = sKb + 128 * RSTR; float* sWf = (float*)(sV + 128 * RSTR); float* sWb = sWf + 128;
  const u16* kb = (const u16*)(p.ws + WS_Z) + (size_t)1 * T_TOK * 512; const u16* vb = (const u16*)(p.ws + WS_Z) + (size_t)2 * T_TOK * 512;
  u16* incf = (u16*)(p.ws + WS_INC); u16* incb = incf + (size_t)512 * 16384;
  const int tid = tidx(), lane = tid & 63, wv = tid >> 6, wr = wv >> 1, wc = wv & 1, fr = lane & 15, fq = lane >> 4;
  int it_first, it_count, it_stride; ret_items(64, it_first, it_count, it_stride);
  for (int ii = 0; ii < it_count; ++ii) {
    const int item = it_first + ii * it_stride;
    const int h = item & 3, bn = item >> 2, t0 = bn * 128;
    const float lgf = log_sigmoid(p.ret_decay[h]), lgb = log_sigmoid(p.ret_decay[4 + h]);
    __syncthreads();
    if (tid < 128) { sWf[tid] = expf(lgf * (float)(127 - tid)); sWb[tid] = expf(lgb * (float)tid); }
    __syncthreads();
    ret_load_tile(sKf, sKb, kb, t0, h, sWf, sWb);
    ret_load_tile(sV, nullptr, vb, t0, h, nullptr, nullptr);
    __syncthreads();
#pragma unroll
    for (int dirn = 0; dirn < 2; ++dirn) {
      f32x4 acc[2][4];
#pragma unroll
      for (int m = 0; m < 2; ++m)
#pragma unroll
        for (int n = 0; n < 4; ++n) acc[m][n] = (f32x4){0.f, 0.f, 0.f, 0.f};
      lds_mma<2, 4, true, true>(acc, sV, RSTR, wr * 32, dirn ? sKb : sKf, RSTR, wc * 64, 128, lane, nullptr);
      u16* o = (dirn ? incb : incf) + (size_t)item * 16384;
#pragma unroll
      for (int m = 0; m < 2; ++m)
#pragma unroll
        for (int n = 0; n < 4; ++n) { uint2 w; w.x = pk2(acc[m][n][0], acc[m][n][1]); w.y = pk2(acc[m][n][2], acc[m][n][3]); *(uint2*)(o + (wr * 32 + m * 16 + fr) * 128 + wc * 64 + n * 16 + 4 * fq) = w; }
    }
  }
}
__device__ __forceinline__ void phase_ret_scan16(const P& p) {
  const u16* incf = (const u16*)(p.ws + WS_INC); const u16* incb = incf + (size_t)512 * 16384;
  u16* spf = (u16*)(p.ws + WS_SP16); u16* spb = spf + (size_t)512 * 16384;
  const int gtid = blockIdx.x * NTHR + tidx(), gsz = gridDim.x * NTHR;
  for (int idx = gtid; idx < 32 * 4096; idx += gsz) {
    const int de = (idx & 4095) * 4, bh = idx >> 12, b = bh >> 2, h = bh & 3;
    const float Gf = expf(128.0f * log_sigmoid(p.ret_decay[h])), Gb = expf(128.0f * log_sigmoid(p.ret_decay[4 + h]));
    f32x4 s = {0.f, 0.f, 0.f, 0.f};
    for (int n = 0; n < 16; ++n) {
      const size_t o = ((size_t)((b * 16 + n) * 4 + h)) * 16384 + de;
      const uint2 tw = *(const uint2*)(incf + o); const f32x4 t = {lo16(tw.x), hi16(tw.x), lo16(tw.y), hi16(tw.y)};
      uint2 w; w.x = pk2(s[0], s[1]); w.y = pk2(s[2], s[3]); *(uint2*)(spf + o) = w;
      s = s * Gf + t;
    }
    s = (f32x4){0.f, 0.f, 0.f, 0.f};
    for (int n = 15; n >= 0; --n) {
      const size_t o = ((size_t)((b * 16 + n) * 4 + h)) * 16384 + de;
      const uint2 tw = *(const uint2*)(incb + o); const f32x4 t = {lo16(tw.x), hi16(tw.x), lo16(tw.y), hi16(tw.y)};
      uint2 w; w.x = pk2(s[0], s[1]); w.y = pk2(s[2], s[3]); *(uint2*)(spb + o) = w;
      s = s * Gb + t;
    }
  }
}
__device__ __forceinline__ void phase_ret_out_mfma(const P& p, char* smem) {
  u16* R0 = (u16*)smem; u16* R1 = R0 + 128 * RSTR; u16* R2 = R1 + 128 * RSTR; u16* R3 = R2 + 128 * RSTR;
  float* sPf = (float*)(R3 + 128 * RSTR); float* sPb = sPf + 132;
  const u16* zb = (const u16*)(p.ws + WS_Z);
  const u16* qb = zb; const u16* kb = zb + (size_t)1 * T_TOK * 512; const u16* vb = zb + (size_t)2 * T_TOK * 512; const u16* gb = zb + (size_t)3 * T_TOK * 512;
  const u16* spf = (const u16*)(p.ws + WS_SP16); const u16* spb = spf + (size_t)512 * 16384;
  u16* ycat = (u16*)(p.ws + WS_YCAT);
  const int tid = tidx(), lane = tid & 63, wv = tid >> 6, wr = wv >> 1, wc = wv & 1, fr = lane & 15, fq = lane >> 4;
  int it_first, it_count, it_stride; ret_items(128, it_first, it_count, it_stride);
  for (int ii = 0; ii < it_count; ++ii) {
    const int item = it_first + ii * it_stride;
    const int h = item & 3, bn = item >> 2, t0 = bn * 128;
    const float lgf = log_sigmoid(p.ret_decay[h]), lgb = log_sigmoid(p.ret_decay[4 + h]);
    const u16* spT = spf + (size_t)item * 16384; const u16* snT = spb + (size_t)item * 16384;
    const int pe = tid >> 4, pch = (tid & 15) * 8;
    const uint4 pp0 = *(const uint4*)(spT + (pe + 0) * 128 + pch), pp1 = *(const uint4*)(spT + (pe + 32) * 128 + pch), pp2 = *(const uint4*)(spT + (pe + 64) * 128 + pch), pp3 = *(const uint4*)(spT + (pe + 96) * 128 + pch);
    __syncthreads();
    ret_load_tile(R0, nullptr, qb, t0, h, nullptr, nullptr);
    ret_load_tile(R1, nullptr, kb, t0, h, nullptr, nullptr);
    ret_load_tile(R2, nullptr, vb, t0, h, nullptr, nullptr);
    if (tid < 129) { sPf[tid] = expf(lgf * (float)tid); sPb[tid] = expf(lgb * (float)tid); }
    __syncthreads();
    {
      f32x4 acc[2][4];
#pragma unroll
      for (int m = 0; m < 2; ++m)
#pragma unroll
        for (int n = 0; n < 4; ++n) acc[m][n] = (f32x4){0.f, 0.f, 0.f, 0.f};
      lds_mma<2, 4, false, false>(acc, R0, RSTR, wr * 32, R1, RSTR, wc * 64, 128, lane, nullptr);
#pragma unroll
      for (int m = 0; m < 2; ++m)
#pragma unroll
        for (int n = 0; n < 4; ++n) {
          const int i = wr * 32 + m * 16 + fr, j = wc * 64 + n * 16 + 4 * fq;
          float v[4];
#pragma unroll
          for (int r = 0; r < 4; ++r) { const int jj = j + r; v[r] = acc[m][n][r] * ((i >= jj) ? sPf[i - jj] : sPb[jj - i]); }
          uint2 w; w.x = pk2(v[0], v[1]); w.y = pk2(v[2], v[3]);
          *(uint2*)(R3 + i * RSTR + j) = w;
        }
    }
    __syncthreads();
    *(uint4*)(R1 + (pe + 0) * RSTR + pch) = pp0; *(uint4*)(R1 + (pe + 32) * RSTR + pch) = pp1; *(uint4*)(R1 + (pe + 64) * RSTR + pch) = pp2; *(uint4*)(R1 + (pe + 96) * RSTR + pch) = pp3;
    const uint4 pn0 = *(const uint4*)(snT + (pe + 0) * 128 + pch), pn1 = *(const uint4*)(snT + (pe + 32) * 128 + pch), pn2 = *(const uint4*)(snT + (pe + 64) * 128 + pch), pn3 = *(const uint4*)(snT + (pe + 96) * 128 + pch);
    f32x4 o[1][8];
#pragma unroll
    for (int m = 0; m < 1; ++m)
#pragma unroll
      for (int n = 0; n < 8; ++n) o[m][n] = (f32x4){0.f, 0.f, 0.f, 0.f};
    lds_mma<1, 8, false, true>(o, R3, RSTR, wv * 16, R2, RSTR, 0, 128, lane, nullptr);
    __syncthreads();
    *(uint4*)(R2 + (pe + 0) * RSTR + pch) = pn0; *(uint4*)(R2 + (pe + 32) * RSTR + pch) = pn1; *(uint4*)(R2 + (pe + 64) * RSTR + pch) = pn2; *(uint4*)(R2 + (pe + 96) * RSTR + pch) = pn3;
    float scf[1], scb[1];
    { const int i = wv * 16 + fr; scf[0] = sPf[i + 1]; scb[0] = sPb[128 - i]; }
    lds_mma<1, 8, false, false>(o, R0, RSTR, wv * 16, R1, RSTR, 0, 128, lane, scf);
    __syncthreads();
    lds_mma<1, 8, false, false>(o, R0, RSTR, wv * 16, R2, RSTR, 0, 128, lane, scb);
#pragma unroll
    for (int m = 0; m < 1; ++m) {
      float s1 = 0.f;
#pragma unroll
      for (int n = 0; n < 8; ++n) s1 += (o[m][n][0] + o[m][n][1]) + (o[m][n][2] + o[m][n][3]);
      s1 += __shfl_xor(s1, 16); s1 += __shfl_xor(s1, 32);
      const float mu = s1 * (1.0f / 128.0f);
      float s2 = 0.f;
#pragma unroll
      for (int n = 0; n < 8; ++n)
#pragma unroll
        for (int r = 0; r < 4; ++r) { const float dl = o[m][n][r] - mu; s2 += dl * dl; }
      s2 += __shfl_xor(s2, 16); s2 += __shfl_xor(s2, 32);
      const float rs = rsqrtf(s2 * (1.0f / 128.0f) + 1e-5f);
      const size_t tok = (size_t)(t0 + wv * 16 + m * 16 + fr);
#pragma unroll
      for (int n = 0; n < 8; ++n) {
        const int e = n * 16 + 4 * fq;
        const uint2 gq = *(const uint2*)(gb + tok * 512 + h * 128 + e);
        const float g0 = lo16(gq.x), g1 = hi16(gq.x), g2 = lo16(gq.y), g3 = hi16(gq.y);
        uint2 w;
        w.x = pk2(g0 * sigmoidf_(g0) * (o[m][n][0] - mu) * rs, g1 * sigmoidf_(g1) * (o[m][n][1] - mu) * rs);
        w.y = pk2(g2 * sigmoidf_(g2) * (o[m][n][2] - mu) * rs, g3 * sigmoidf_(g3) * (o[m][n][3] - mu) * rs);
        *(uint2*)(ycat + tok * DM + h * 128 + e) = w;
      }
    }
  }
}

struct Cpx { float re, im; };
__device__ __forceinline__ Cpx cmul(Cpx a, Cpx b) { return {a.re * b.re - a.im * b.im, a.re * b.im + a.im * b.re}; }
__device__ __forceinline__ Cpx s5_lam(const P& p, int g, int dir, int l, int q) { const f32x2 v = ((const f32x2*)(p.ws + WS_LAMT))[((g * 2 + dir) * 33 + l) * 64 + q]; return {v[0], v[1]}; }
__device__ __forceinline__ Cpx s5_cf(const P& p, int g, int dir, int q) { const f32x2 v = ((const f32x2*)(p.ws + WS_LAMT + 3 * MB / 2))[(g * 2 + dir) * 64 + q]; return {v[0], v[1]}; }
__device__ __forceinline__ bool s5_setup_ids(int& gtid, int& gsz) {
  const bool half = (gridDim.x == 256);
  if (half && blockIdx.x < 128) return false;
  gtid = (half ? (int)blockIdx.x - 128 : (int)blockIdx.x) * NTHR + tidx(); gsz = (half ? 128 : (int)gridDim.x) * NTHR;
  return true;
}
__device__ __forceinline__ void phase_s5_ktab(const P& p) {
  float* ktab = (float*)(p.ws + WS_KTAB);
  int gtid, gsz; if (!s5_setup_ids(gtid, gsz)) return;
  for (int item = gtid; item < 32 * 2 * 32 * 16; item += gsz) {
    const int c = item & 15, l = (item >> 4) & 31, dir = (item >> 9) & 1, g = item >> 10;
    float acc[16];
#pragma unroll
    for (int j = 0; j < 16; ++j) acc[j] = 0.f;
    for (int q = 0; q < 64; ++q) {
      const Cpx L = s5_lam(p, g, dir, l, q), cf = s5_cf(p, g, dir, q);
      const Cpx C = {p.c_re[((dir * 32 + g) * 16 + c) * 64 + q], p.c_im[((dir * 32 + g) * 16 + c) * 64 + q]};
      const Cpx w = cmul(cmul(C, L), cf);
#pragma unroll
      for (int j = 0; j < 16; ++j) acc[j] += w.re * p.b_re[(g * 64 + q) * 16 + j] - w.im * p.b_im[(g * 64 + q) * 16 + j];
    }
#pragma unroll
    for (int j = 0; j < 16; j += 4) *(f32x4*)(ktab + (size_t)item * 16 + j) = (f32x4){acc[j], acc[j + 1], acc[j + 2], acc[j + 3]};
  }
}
__device__ __forceinline__ void phase_s5_fill_a(const P& p) {
  const float* ktab = (const float*)(p.ws + WS_KTAB);
  u16* bty = (u16*)(p.ws + WS_BTY);
  const int gtid = blockIdx.x * NTHR + tidx(), gsz = gridDim.x * NTHR;
  for (int item = gtid; item < 32 * 512 * 64; item += gsz) {
    const int ch = item & 63, n = (item >> 6) & 511, g = item >> 15;
    const int ip = ch >> 1, c0 = (ch & 1) * 8, i = n >> 4, c = n & 15;
    float v[8];
    if (ip != i) {
      const int dir = ip < i ? 0 : 1, l = ip < i ? i - ip : ip - i;
      const float* src = ktab + ((size_t)((g * 2 + dir) * 32 + l) * 16 + c) * 16 + c0;
      const f32x4 a = *(const f32x4*)src, b = *(const f32x4*)(src + 4);
      v[0] = a[0]; v[1] = a[1]; v[2] = a[2]; v[3] = a[3]; v[4] = b[0]; v[5] = b[1]; v[6] = b[2]; v[7] = b[3];
    } else {
      const float* s0 = ktab + ((size_t)((g * 2 + 0) * 32) * 16 + c) * 16 + c0;
      const float* s1 = ktab + ((size_t)((g * 2 + 1) * 32) * 16 + c) * 16 + c0;
      const float dd = p.s5d[g * 16 + c];
#pragma unroll
      for (int j = 0; j < 8; ++j) v[j] = s0[j] + s1[j] + ((c0 + j) == c ? dd : 0.f);
    }
    *(uint4*)(bty + ((size_t)g * 512 + n) * 768 + ch * 8) = make_uint4(pk2(v[0], v[1]), pk2(v[2], v[3]), pk2(v[4], v[5]), pk2(v[6], v[7]));
  }
}
__device__ __forceinline__ void phase_s5_fill_bc(const P& p) {
  u16* bty = (u16*)(p.ws + WS_BTY); u16* wet = (u16*)(p.ws + WS_WET);
  int gtid, gsz; if (!s5_setup_ids(gtid, gsz)) return;
  for (int item = gtid; item < 32 * 512 * 32; item += gsz) {
    const int ch = item & 31, n = (item >> 5) & 511, g = item >> 14;
    const int kk = ch * 8, dir = kk >> 7, p0 = (kk & 127) >> 1, i = n >> 4, c = n & 15;
    const int e = dir ? (32 - i) : (i + 1);
    float v[8];
#pragma unroll
    for (int q = 0; q < 4; ++q) {
      const int pq = p0 + q;
      const Cpx L = s5_lam(p, g, dir, e, pq);
      const Cpx C = {p.c_re[((dir * 32 + g) * 16 + c) * 64 + pq], p.c_im[((dir * 32 + g) * 16 + c) * 64 + pq]};
      const Cpx w = cmul(C, L);
      v[2 * q] = w.re; v[2 * q + 1] = -w.im;
    }
    *(uint4*)(bty + ((size_t)g * 512 + n) * 768 + 512 + kk) = make_uint4(pk2(v[0], v[1]), pk2(v[2], v[3]), pk2(v[4], v[5]), pk2(v[6], v[7]));
  }
  for (int item = gtid; item < 32 * 256 * 64; item += gsz) {
    const int ch = item & 63, n = (item >> 6) & 255, g = item >> 14;
    const int ip = ch >> 1, c0 = (ch & 1) * 8, ri = n & 1, pq = (n >> 1) & 63, dir = n >> 7;
    const int e = dir ? ip : (31 - ip);
    const Cpx w = cmul(s5_lam(p, g, dir, e, pq), s5_cf(p, g, dir, pq));
    float v[8];
#pragma unroll
    for (int j = 0; j < 8; ++j) {
      const float br = p.b_re[(g * 64 + pq) * 16 + c0 + j], bi = p.b_im[(g * 64 + pq) * 16 + c0 + j];
      v[j] = ri ? (w.re * bi + w.im * br) : (w.re * br - w.im * bi);
    }
    *(uint4*)(wet + ((size_t)g * 256 + n) * 512 + ch * 8) = make_uint4(pk2(v[0], v[1]), pk2(v[2], v[3]), pk2(v[4], v[5]), pk2(v[6], v[7]));
  }
}
__device__ __forceinline__ void phase_s5_carry(const P& p) {
  const float* E = (const float*)(p.ws + WS_E);
  u16* a2 = (u16*)(p.ws + WS_A2);
  const int gtid = blockIdx.x * NTHR + tidx(), gsz = gridDim.x * NTHR;
  for (int idx = gtid; idx < 32 * 8 * 128; idx += gsz) {
    const int pq = idx & 63, dir = (idx >> 6) & 1, b = (idx >> 7) & 7, g = idx >> 10;
    const Cpx L = s5_lam(p, g, dir, 32, pq);
    Cpx s = {0.f, 0.f};
    for (int jj = 0; jj < 64; ++jj) {
      const int j = dir ? 63 - jj : jj, r = b * 64 + j;
      const f32x2 e = *(const f32x2*)(E + ((size_t)g * 512 + r) * 256 + (dir * 64 + pq) * 2);
      *(unsigned*)(a2 + ((size_t)g * 512 + r) * 768 + 512 + (dir * 64 + pq) * 2) = pk2(s.re, s.im);
      const Cpx ns = cmul(L, s);
      s.re = ns.re + e[0]; s.im = ns.im + e[1];
    }
  }
}
constexpr int KSTR = 72;
__device__ __forceinline__ int t5_bucket_abs(int n) {
  return n < 8 ? n : 8 + (n >= 12) + (n >= 16) + (n >= 23) + (n >= 32) + (n >= 46) + (n >= 64) + (n >= 91);
}
__device__ __forceinline__ void phase_attn(const P& p, char* smem) {
  u16* sK = (u16*)smem; u16* sV = sK + 384 * KSTR; float* sBias = (float*)(sV + 384 * KSTR);
  const u16* q1 = (const u16*)(p.ws + WS_Z); const u16* k1 = (const u16*)(p.ws + WS_Z + 32 * MB); const u16* v1 = (const u16*)(p.ws + WS_Z + 40 * MB);
  u16* ao = (u16*)(p.ws + WS_YCAT);
  const int tid = tidx(), lane = tid & 63, wv = tid >> 6, fr = lane & 15, lg = lane >> 4, q0 = (wv & 3) * 32, hp = wv >> 2;
  const int tq = (lane & 15) >> 2, tp = lane & 3;
  for (int item = blockIdx.x; item < 512; item += gridDim.x) {
    const int b = item >> 6, nb = (item >> 2) & 15, kvh = item & 3;
    __syncthreads();
    for (int c = tid; c < 384 * 8; c += NTHR) {
      const int s = c >> 3, ch = (c & 7) * 8, pos = (nb - 1) * 128 + s;
      uint4 kq = make_uint4(0u, 0u, 0u, 0u), vq = kq;
      if (pos >= 0 && pos < SEQ) { kq = *(const uint4*)(k1 + (size_t)(b * SEQ + pos) * 256 + kvh * 64 + ch); vq = *(const uint4*)(v1 + (size_t)(b * SEQ + pos) * 256 + kvh * 64 + ch); }
      *(uint4*)(sK + s * KSTR + ch) = kq; *(uint4*)(sV + s * KSTR + ch) = vq;
    }
    for (int c = tid; c < 4 * 512; c += NTHR) {
      const int hq = c >> 9, ri = (c & 511) - 128, rel = ri - 128, n = rel < 0 ? -rel : rel;
      const int bucket = (rel > 0 ? 16 : 0) + t5_bucket_abs(n < 128 ? n : 128);
      sBias[c] = (ri >= 0 && ri <= 256) ? 1.4426950408889634f * p.rel_bias[bucket * 16 + kvh * 4 + hq] : -1e30f;
    }
    __syncthreads();
#pragma unroll 1
    for (int hh = 0; hh < 2; ++hh) {
      const int hq = hp * 2 + hh, head = kvh * 4 + hq;
      const size_t tok0 = (size_t)b * SEQ + nb * 128 + q0;
      uint4 qf[2][2];
#pragma unroll
      for (int qb = 0; qb < 2; ++qb)
#pragma unroll
        for (int ks = 0; ks < 2; ++ks) qf[qb][ks] = *(const uint4*)(q1 + (tok0 + qb * 16 + fr) * DM + head * 64 + ks * 32 + lg * 8);
      f32x4 O[4][2];
#pragma unroll
      for (int mb = 0; mb < 4; ++mb)
#pragma unroll
        for (int qb = 0; qb < 2; ++qb) O[mb][qb] = (f32x4){0.f, 0.f, 0.f, 0.f};
      const float sinkv = 1.4426950408889634f * p.sink[head];
      float mrun[2] = {sinkv, sinkv}, lpart[2] = {lg == 0 ? 1.0f : 0.0f, lg == 0 ? 1.0f : 0.0f};
      const float* bias = sBias + hq * 512 + 128 - (q0 + fr) + 4 * lg;
#pragma unroll
      for (int c = 0; c < 3; ++c) {
        if ((c == 0 && nb == 0) || (c == 2 && nb == 15)) continue;
        f32x4 S[8][2];
#pragma unroll
        for (int kb = 0; kb < 8; ++kb) {
          S[kb][0] = (f32x4){0.f, 0.f, 0.f, 0.f}; S[kb][1] = S[kb][0];
          const bool act = (c == 0) ? (16 * kb + 15 >= q0) : ((c == 2) ? (16 * kb <= q0 + 31) : true);
          if (act) {
#pragma unroll
            for (int qb = 0; qb < 2; ++qb)
#pragma unroll
              for (int r = 0; r < 4; ++r) S[kb][qb][r] = bias[c * 128 + kb * 16 + r - qb * 16];
#pragma unroll
            for (int ks = 0; ks < 2; ++ks) {
              const uint4 kf = *(const uint4*)(sK + (c * 128 + kb * 16 + fr) * KSTR + ks * 32 + lg * 8);
              S[kb][0] = mfma16(kf, qf[0][ks], S[kb][0]);
              S[kb][1] = mfma16(kf, qf[1][ks], S[kb][1]);
            }
          }
        }
        float cmax[2] = {-1e30f, -1e30f};
#pragma unroll
        for (int kb = 0; kb < 8; ++kb) {
          const bool act = (c == 0) ? (16 * kb + 15 >= q0) : ((c == 2) ? (16 * kb <= q0 + 31) : true);
          if (act) {
#pragma unroll
            for (int qb = 0; qb < 2; ++qb)
#pragma unroll
              for (int r = 0; r < 4; ++r) cmax[qb] = fmaxf(cmax[qb], S[kb][qb][r]);
          }
        }
#pragma unroll
        for (int qb = 0; qb < 2; ++qb) {
          cmax[qb] = fmaxf(cmax[qb], __shfl_xor(cmax[qb], 16)); cmax[qb] = fmaxf(cmax[qb], __shfl_xor(cmax[qb], 32));
          const float mn = fmaxf(mrun[qb], cmax[qb]), alpha = __builtin_amdgcn_exp2f(mrun[qb] - mn);
          mrun[qb] = mn; lpart[qb] *= alpha;
#pragma unroll
          for (int mb = 0; mb < 4; ++mb) O[mb][qb] = O[mb][qb] * alpha;
          float ps = 0.f;
#pragma unroll
          for (int kb = 0; kb < 8; ++kb) {
            const bool act = (c == 0) ? (16 * kb + 15 >= q0) : ((c == 2) ? (16 * kb <= q0 + 31) : true);
            if (act) {
#pragma unroll
              for (int r = 0; r < 4; ++r) { const float e = __builtin_amdgcn_exp2f(S[kb][qb][r] - mn); S[kb][qb][r] = e; ps += e; }
            }
          }
          lpart[qb] += ps;
        }
#pragma unroll
        for (int kk = 0; kk < 4; ++kk) {
          const int kb0 = 2 * kk, kb1 = 2 * kk + 1;
          const bool act = (c == 0) ? (16 * kb1 + 15 >= q0) : ((c == 2) ? (16 * kb0 <= q0 + 31) : true);
          if (act) {
            uint4 pf[2];
#pragma unroll
            for (int qb = 0; qb < 2; ++qb) pf[qb] = make_uint4(pk2(S[kb0][qb][0], S[kb0][qb][1]), pk2(S[kb0][qb][2], S[kb0][qb][3]), pk2(S[kb1][qb][0], S[kb1][qb][1]), pk2(S[kb1][qb][2], S[kb1][qb][3]));
#pragma unroll
            for (int mb = 0; mb < 4; ++mb) {
              const uint2 v0 = lds_tr16(sV + (c * 128 + kb0 * 16 + 4 * lg + tq) * KSTR + mb * 16 + 4 * tp);
              const uint2 v1r = lds_tr16(sV + (c * 128 + kb1 * 16 + 4 * lg + tq) * KSTR + mb * 16 + 4 * tp);
              const uint4 vf = make_uint4(v0.x, v0.y, v1r.x, v1r.y);
              O[mb][0] = mfma16(vf, pf[0], O[mb][0]);
              O[mb][1] = mfma16(vf, pf[1], O[mb][1]);
            }
          }
        }
      }
#pragma unroll
      for (int qb = 0; qb < 2; ++qb) {
        float lt = lpart[qb]; lt += __shfl_xor(lt, 16); lt += __shfl_xor(lt, 32);
        const float inv = 1.0f / lt;
#pragma unroll
        for (int mb = 0; mb < 4; ++mb) {
          uint2 w; w.x = pk2(O[mb][qb][0] * inv, O[mb][qb][1] * inv); w.y = pk2(O[mb][qb][2] * inv, O[mb][qb][3] * inv);
          *(uint2*)(ao + (tok0 + qb * 16 + fr) * DM + head * 64 + mb * 16 + 4 * lg) = w;
        }
      }
    }
  }
}

struct EpiInproj {
  static constexpr bool PERM = true;
  u16* zb; u16* a2; const f32x2* rope;
  __device__ __forceinline__ void operator()(const f32x4 (&acc)[2][2][4][2], const pg8::Unit& u, int wr, int wc, int fr, int fq) const {
    const int seg = u.pn >> 1;
#pragma unroll
    for (int ai = 0; ai < 2; ++ai)
#pragma unroll
      for (int m = 0; m < 4; ++m) {
        const int row = u.pm * 256 + ai * 128 + wr * 64 + m * 16 + fr;
        if (seg < 2) {
          const int d = 16 * wc + 4 * fq;
          const f32x2* cs = rope + (size_t)(row & (SEQ - 1)) * 64 + d;
          const f32x4 c01 = *(const f32x4*)cs, c23 = *(const f32x4*)(cs + 2);
          const float cv[4] = {c01[0], c01[2], c23[0], c23[2]}, sv[4] = {c01[1], c01[3], c23[1], c23[3]};
          const float sc = seg == 1 ? 0.08838834764831845f : 1.0f;
#pragma unroll
          for (int bj = 0; bj < 2; ++bj) {
            const f32x4 x1 = acc[ai][bj][m][0], x2 = acc[ai][bj][m][1];
            float o1[4], o2[4];
#pragma unroll
            for (int r = 0; r < 4; ++r) { o1[r] = (x1[r] * cv[r] - x2[r] * sv[r]) * sc; o2[r] = (x1[r] * sv[r] + x2[r] * cv[r]) * sc; }
            u16* dst = zb + (size_t)seg * T_TOK * 512 + (size_t)row * 512 + ((u.pn & 1) * 2 + bj) * 128 + d;
            uint2 w; w.x = pk2(o1[0], o1[1]); w.y = pk2(o1[2], o1[3]); *(uint2*)dst = w;
            w.x = pk2(o2[0], o2[1]); w.y = pk2(o2[2], o2[3]); *(uint2*)(dst + 64) = w;
          }
        } else {
#pragma unroll
          for (int bj = 0; bj < 2; ++bj) {
            const int col = u.pn * 256 + bj * 128 + wc * 32 + 8 * fq;
            const f32x4 v0 = acc[ai][bj][m][0], v1 = acc[ai][bj][m][1];
            uint4 w; w.x = pk2(v0[0], v0[1]); w.y = pk2(v0[2], v0[3]); w.z = pk2(v1[0], v1[1]); w.w = pk2(v1[2], v1[3]);
            if (seg < 4) *(uint4*)(zb + (size_t)seg * T_TOK * 512 + (size_t)row * 512 + (col - seg * 512)) = w;
            else { const int ch = col - 2048, gi = ch >> 4, c = ch & 15; *(uint4*)(a2 + ((size_t)gi * 512 + (row >> 5)) * 768 + (row & 31) * 16 + c) = w; }
          }
        }
      }
  }
};
__device__ __forceinline__ void phase_inproj(const P& p, LAS unsigned char* lds) {
  pg8::DenseOrder S; S.init(p.ws + WS_XB, DM, p.ws + WS_WIN, T_TOK, 2560, DM);
  EpiInproj E{(u16*)(p.ws + WS_Z), (u16*)(p.ws + WS_A2), (const f32x2*)(p.ws + WS_ROPE)};
  pg8::gemm_phase<EpiInproj, pg8::DenseOrder, G_ALIGN, G_SP2>(lds, DM, S, E);
}
struct EpiS5E {
  static constexpr bool PERM = false;
  float* E_;
  __device__ __forceinline__ void operator()(const f32x4 (&acc)[2][2][4][2], const pg8::Unit& u, int wr, int wc, int fr, int fq) const {
#pragma unroll
    for (int ai = 0; ai < 2; ++ai)
#pragma unroll
      for (int m = 0; m < 4; ++m) {
        const int row = u.pm * 256 + ai * 128 + wr * 64 + m * 16 + fr;
#pragma unroll
        for (int bj = 0; bj < 2; ++bj)
#pragma unroll
          for (int n = 0; n < 2; ++n) *(f32x4*)(E_ + ((size_t)u.e * 512 + row) * 256 + bj * 128 + wc * 32 + n * 16 + 4 * fq) = acc[ai][bj][m][n];
      }
  }
};
__device__ __forceinline__ void phase_s5_egemm(const P& p, LAS unsigned char* lds) {
  pg8::GroupOrder S; S.init(p.ws + WS_A2, 768, (size_t)512 * 768, p.ws + WS_WET, (size_t)256 * 512, 32, 512, 256, 512);
  EpiS5E E{(float*)(p.ws + WS_E)};
  pg8::gemm_phase<EpiS5E, pg8::GroupOrder, G_ALIGN, G_SP2>(lds, 512, S, E);
}
struct EpiS5Y {
  static constexpr bool PERM = true;
  u16* yg;
  __device__ __forceinline__ void operator()(const f32x4 (&acc)[2][2][4][2], const pg8::Unit& u, int wr, int wc, int fr, int fq) const {
#pragma unroll
    for (int ai = 0; ai < 2; ++ai)
#pragma unroll
      for (int m = 0; m < 4; ++m) {
        const int row = u.pm * 256 + ai * 128 + wr * 64 + m * 16 + fr;
#pragma unroll
        for (int bj = 0; bj < 2; ++bj) {
          const int col = u.pn * 256 + bj * 128 + wc * 32 + 8 * fq;
          const f32x4 v0 = acc[ai][bj][m][0], v1 = acc[ai][bj][m][1];
          uint4 w; w.x = pk2(gelu_tanh(v0[0]), gelu_tanh(v0[1])); w.y = pk2(gelu_tanh(v0[2]), gelu_tanh(v0[3])); w.z = pk2(gelu_tanh(v1[0]), gelu_tanh(v1[1])); w.w = pk2(gelu_tanh(v1[2]), gelu_tanh(v1[3]));
          *(uint4*)(yg + ((size_t)row * 32 + (col >> 4)) * 512 + u.e * 16 + (col & 15)) = w;
        }
      }
  }
};
__device__ __forceinline__ void phase_s5_ygemm(const P& p, LAS unsigned char* lds) {
  pg8::GroupOrder S; S.init(p.ws + WS_A2, 768, (size_t)512 * 768, p.ws + WS_BTY, (size_t)512 * 768, 32, 512, 512, 768);
  EpiS5Y E{(u16*)(p.ws + WS_YGELU)};
  pg8::gemm_phase<EpiS5Y, pg8::GroupOrder, G_ALIGN, G_SP2>(lds, 768, S, E);
}
struct EpiGlu {
  static constexpr bool PERM = true;
  const u16* yg; const float* bglu; u16* ycat;
  __device__ __forceinline__ void operator()(const f32x4 (&acc)[2][2][4][2], const pg8::Unit& u, int wr, int wc, int fr, int fq) const {
#pragma unroll
    for (int ai = 0; ai < 2; ++ai)
#pragma unroll
      for (int m = 0; m < 4; ++m) {
        const int row = u.pm * 256 + ai * 128 + wr * 64 + m * 16 + fr;
#pragma unroll
        for (int bj = 0; bj < 2; ++bj) {
          const int col = u.pn * 256 + bj * 128 + wc * 32 + 8 * fq;
          const f32x4 v0 = acc[ai][bj][m][0], v1 = acc[ai][bj][m][1];
          const uint4 yv = *(const uint4*)(yg + (size_t)row * 512 + col);
          const f32x4 b0 = *(const f32x4*)(bglu + col), b1 = *(const f32x4*)(bglu + col + 4);
          uint4 w;
          w.x = pk2(lo16(yv.x) * sigmoidf_(v0[0] + b0[0]), hi16(yv.x) * sigmoidf_(v0[1] + b0[1]));
          w.y = pk2(lo16(yv.y) * sigmoidf_(v0[2] + b0[2]), hi16(yv.y) * sigmoidf_(v0[3] + b0[3]));
          w.z = pk2(lo16(yv.z) * sigmoidf_(v1[0] + b1[0]), hi16(yv.z) * sigmoidf_(v1[1] + b1[1]));
          w.w = pk2(lo16(yv.w) * sigmoidf_(v1[2] + b1[2]), hi16(yv.w) * sigmoidf_(v1[3] + b1[3]));
          *(uint4*)(ycat + (size_t)row * DM + 512 + col) = w;
        }
      }
  }
};
__device__ __forceinline__ void phase_glu(const P& p, LAS unsigned char* lds) {
  pg8::DenseOrder S; S.init(p.ws + WS_YGELU, 512, p.ws + WS_WGLU, T_TOK, 512, 512);
  EpiGlu E{(const u16*)(p.ws + WS_YGELU), p.b_glu, (u16*)(p.ws + WS_YCAT)};
  pg8::gemm_phase<EpiGlu, pg8::DenseOrder, G_ALIGN, G_SP2>(lds, 512, S, E);
}
struct EpiResid {
  static constexpr bool PERM = false;
  const float* xin; float* xout;
  __device__ __forceinline__ void operator()(const f32x4 (&acc)[2][2][4][2], const pg8::Unit& u, int wr, int wc, int fr, int fq) const {
#pragma unroll
    for (int ai = 0; ai < 2; ++ai)
#pragma unroll
      for (int m = 0; m < 4; ++m) {
        const int row = u.pm * 256 + ai * 128 + wr * 64 + m * 16 + fr;
#pragma unroll
        for (int bj = 0; bj < 2; ++bj)
#pragma unroll
          for (int n = 0; n < 2; ++n) {
            const size_t o = (size_t)row * DM + u.pn * 256 + bj * 128 + wc * 32 + n * 16 + 4 * fq;
            const f32x4 xv = *(const f32x4*)(xin + o);
            *(f32x4*)(xout + o) = xv + acc[ai][bj][m][n];
          }
      }
  }
};
__device__ __forceinline__ void phase_outproj(const P& p, const void* Wt, const float* xin, float* xout, LAS unsigned char* lds) {
  pg8::DenseOrder S; S.init(p.ws + WS_YCAT, DM, Wt, T_TOK, DM, DM);
  EpiResid E{xin, xout};
  pg8::gemm_phase<EpiResid, pg8::DenseOrder, G_ALIGN, G_SP2>(lds, DM, S, E);
}
struct EpiQkv {
  static constexpr bool PERM = true;
  u16 *q1, *k1, *v1;
  __device__ __forceinline__ void operator()(const f32x4 (&acc)[2][2][4][2], const pg8::Unit& u, int wr, int wc, int fr, int fq) const {
    const float sc = u.pn < 4 ? 0.18033688011112042f : 1.0f;
#pragma unroll
    for (int ai = 0; ai < 2; ++ai)
#pragma unroll
      for (int m = 0; m < 4; ++m) {
        const int row = u.pm * 256 + ai * 128 + wr * 64 + m * 16 + fr;
#pragma unroll
        for (int bj = 0; bj < 2; ++bj) {
          const int col = u.pn * 256 + bj * 128 + wc * 32 + 8 * fq;
          const f32x4 a0 = acc[ai][bj][m][0] * sc, a1 = acc[ai][bj][m][1] * sc;
          uint4 w; w.x = pk2(a0[0], a0[1]); w.y = pk2(a0[2], a0[3]); w.z = pk2(a1[0], a1[1]); w.w = pk2(a1[2], a1[3]);
          if (u.pn < 4) *(uint4*)(q1 + (size_t)row * DM + col) = w;
          else if (u.pn == 4) *(uint4*)(k1 + (size_t)row * 256 + (col - 1024)) = w;
          else *(uint4*)(v1 + (size_t)row * 256 + (col - 1280)) = w;
        }
      }
  }
};
__device__ __forceinline__ void phase_qkv(const P& p, LAS unsigned char* lds) {
  pg8::DenseOrder S; S.init(p.ws + WS_XB, DM, p.ws + WS_WQKV, T_TOK, 1536, DM);
  EpiQkv E{(u16*)(p.ws + WS_Z), (u16*)(p.ws + WS_Z + 32 * MB), (u16*)(p.ws + WS_Z + 40 * MB)};
  pg8::gemm_phase<EpiQkv, pg8::DenseOrder, G_ALIGN, G_SP2>(lds, DM, S, E);
}
__device__ __forceinline__ void phase_moe_plan(const P& p, int layer, char* smem) {
  if (blockIdx.x != 0) return;
  using pg8::PLAN_STRIDE;
  const int tid = tidx();
  const int* cnt = (const int*)(p.ws + WS_CNT) + layer * 32;
  int* plan_n = (int*)(p.ws + WS_PLAN + layer * 65536); int4* plan = (int4*)(p.ws + WS_PLAN + layer * 65536 + 256);
  int* sc = (int*)smem;
  int* ecum = sc + 32; int* ebase = ecum + 32; int* ehb = ebase + 32; int* efull = ehb + 32; int* tot = efull + 32;
  int* sstart = tot + 8; int* sfstart = sstart + 8; int* cntF = sfstart + 8; int* cntR = cntF + 8;
  unsigned* keyR = (unsigned*)(cntR + 8);
  constexpr int NN = 4;
  __syncthreads();
  if (tid < 32) sc[tid] = cnt[tid];
  if (tid < 8) { sstart[tid] = 0x7fffffff; sfstart[tid] = 0; cntF[tid] = 0; cntR[tid] = 0; }
  if (tid < 128) keyR[tid] = 0xffffffffu;
  __syncthreads();
  if (tid == 0) {
    int cum = 0, ub = 0, hb = 0, fb = 0;
    for (int e = 0; e < 32; ++e) {
      const int c = sc[e], fl = c >> 8, rem = c & 255, rc = (rem + 63) >> 6, ntl = fl + (rem ? 1 : 0);
      ecum[e] = cum; ebase[e] = ub; ehb[e] = hb; efull[e] = fb;
      cum += (fl * 4 + rc) * NN; ub += ntl * NN; hb += ntl * 256; fb += fl * NN;
    }
    tot[0] = cum > 0 ? cum : 1; tot[1] = ub;
  }
  __syncthreads();
  const int total = tot[0], nunits = tot[1] < 1024 ? tot[1] : 1024;
  int4 en[2]; int ux[2], uF[2]; unsigned ukr[2]; bool ufull[2], uval[2];
#pragma unroll
  for (int q = 0; q < 2; ++q) {
    const int u = tid + q * NTHR;
    uval[q] = u < nunits; ux[q] = 0; uF[q] = 0; ukr[q] = 0; ufull[q] = true; en[q] = make_int4(0, 0, 0, 0);
    if (uval[q]) {
      int e = 0;
      for (int j = 1; j < 32; ++j) if (ebase[j] <= u) e = j;
      const int c = sc[e], fl = c >> 8, rem = c & 255, rc = (rem + 63) >> 6, ntl = fl + (rem ? 1 : 0);
      const int local = u - ebase[e], ct = local / ntl, rt = local - ct * ntl;
      const int cum = ecum[e] + ct * (fl * 4 + rc) + rt * 4;
      const bool isfull = rt < fl;
      int x = (cum * 8) / total; if (x > 7) x = 7;
      ux[q] = x; ufull[q] = isfull; uF[q] = efull[e] + ct * fl + (rt < fl ? rt : fl);
      en[q] = make_int4(e | (rt << 8) | (ct << 16), c, ehb[e], 0);
      atomicMin(&sstart[x], u);
      if (isfull) atomicAdd(&cntF[x], 1);
      else { atomicAdd(&cntR[x], 1); ukr[q] = ((unsigned)x << 16) | ((unsigned)(4 - rc) << 12) | (unsigned)(e * NN + ct); keyR[e * NN + ct] = ukr[q]; }
    }
  }
  __syncthreads();
#pragma unroll
  for (int q = 0; q < 2; ++q) if (uval[q] && (tid + q * NTHR) == sstart[ux[q]]) sfstart[ux[q]] = uF[q];
  __syncthreads();
#pragma unroll
  for (int q = 0; q < 2; ++q) {
    if (uval[q]) {
      const int x = ux[q];
      int pos;
      if (ufull[q]) pos = uF[q] - sfstart[x];
      else { pos = cntF[x]; for (int v = 0; v < 128; ++v) { const unsigned kv = keyR[v]; pos += ((kv >> 16) == (unsigned)x && kv < ukr[q]) ? 1 : 0; } }
      if (pos < PLAN_STRIDE) plan[x * PLAN_STRIDE + pos] = en[q];
    }
  }
  if (tid < 8) { const int n = cntF[tid] + cntR[tid]; plan_n[tid] = n < PLAN_STRIDE ? n : PLAN_STRIDE; }
  __syncthreads();
}
struct EpiMoe1 {
  static constexpr bool PERM = false;
  u16* hbuf;
  __device__ __forceinline__ void operator()(const f32x4 (&acc)[2][2][4][2], const pg8::Unit& u, int wr, int wc, int fr, int fq) const {
#pragma unroll
    for (int ai = 0; ai < 2; ++ai)
#pragma unroll
      for (int m = 0; m < 4; ++m) {
        const int row = u.pm * 256 + ai * 128 + wr * 64 + m * 16 + fr;
        if (row < u.cnt) {
#pragma unroll
          for (int bj = 0; bj < 2; ++bj) {
            const f32x4 g = acc[ai][bj][m][0], up = acc[ai][bj][m][1];
            uint2 w; w.x = pk2(g[0] * sigmoidf_(g[0]) * up[0], g[1] * sigmoidf_(g[1]) * up[1]); w.y = pk2(g[2] * sigmoidf_(g[2]) * up[2], g[3] * sigmoidf_(g[3]) * up[3]);
            *(uint2*)(hbuf + (size_t)(u.hbase + row) * 512 + 16 * (8 * u.pn + 4 * bj + wc) + 4 * fq) = w;
          }
        }
      }
  }
};
__device__ __forceinline__ void phase_moe1(const P& p, int layer, LAS unsigned char* lds) {
  pg8::PlanOrder S; S.init(p.ws + WS_PLAN + layer * 65536, (const int2*)(p.ws + WS_LIST2), p.ws + WS_XB, DM, p.ws + (layer ? WS_MW1 : WS_MW0), (size_t)DM * DM, DM, true);
  EpiMoe1 E{(u16*)(p.ws + WS_H)};
  pg8::gemm_phase<EpiMoe1, pg8::PlanOrder, G_ALIGN, G_SP2>(lds, DM, S, E);
}
struct EpiMoe2 {
  static constexpr bool PERM = true;
  const int2* list; u16* slots;
  __device__ __forceinline__ void operator()(const f32x4 (&acc)[2][2][4][2], const pg8::Unit& u, int wr, int wc, int fr, int fq) const {
#pragma unroll
    for (int ai = 0; ai < 2; ++ai)
#pragma unroll
      for (int m = 0; m < 4; ++m) {
        const int row = u.pm * 256 + ai * 128 + wr * 64 + m * 16 + fr;
        if (row < u.cnt) {
          const int2 en = list[(size_t)u.e * CAP + row];
          const int asg = en.x; const float gt = __int_as_float(en.y);
#pragma unroll
          for (int bj = 0; bj < 2; ++bj) {
            const f32x4 v0 = acc[ai][bj][m][0] * gt, v1 = acc[ai][bj][m][1] * gt;
            uint4 w; w.x = pk2(v0[0], v0[1]); w.y = pk2(v0[2], v0[3]); w.z = pk2(v1[0], v1[1]); w.w = pk2(v1[2], v1[3]);
            *(uint4*)(slots + (size_t)asg * DM + u.pn * 256 + bj * 128 + wc * 32 + 8 * fq) = w;
          }
        }
      }
  }
};
__device__ __forceinline__ void phase_moe2(const P& p, int layer, LAS unsigned char* lds) {
  pg8::PlanOrder S; S.init(p.ws + WS_PLAN + layer * 65536, (const int2*)(p.ws + WS_LIST2), p.ws + WS_H, 512, p.ws + (layer ? WS_MW1 : WS_MW0) + 64 * MB, (size_t)DM * 512, 512, false);
  EpiMoe2 E{(const int2*)(p.ws + WS_LIST2), (u16*)(p.ws + WS_INC)};
  pg8::gemm_phase<EpiMoe2, pg8::PlanOrder, G_ALIGN, G_SP2>(lds, 512, S, E);
}

#define XB_TMO      128
#define XB_XCNT(j)  (256  + 64 * (j))
#define XB_XSUB(j)  (1280 + 64 * (j))
#define XB_XGEN(j)  (2304 + 64 * (j))
#define XB_TOP      3328
#define XB_TOPGEN   3392
#define XCD_BAR_WORDS 3456
#define XB_SPIN_CAP (1u << 22)
__device__ __forceinline__ unsigned xb_ld(unsigned* p)              { return __hip_atomic_load(p, __ATOMIC_RELAXED, __HIP_MEMORY_SCOPE_AGENT); }
__device__ __forceinline__ unsigned xb_add(unsigned* p, unsigned v) { return __hip_atomic_fetch_add(p, v, __ATOMIC_RELAXED, __HIP_MEMORY_SCOPE_AGENT); }
__device__ __forceinline__ unsigned xb_xcc_id() { return (unsigned)__builtin_amdgcn_s_getreg((3 << 11) | 20) & 0xFu; }
#define XB_SPIN(cond, bar) do { unsigned _sp = 0; while (cond) { __builtin_amdgcn_s_sleep(1); \
    if ((++_sp & 255u) == 0u) { if (xb_ld(&(bar)[XB_TMO])) break; if (_sp > XB_SPIN_CAP) { atomicAdd(&(bar)[XB_TMO], 1u); break; } } } } while (0)
struct XcdBarrier { unsigned* bar; unsigned x; volatile LAS unsigned* st; };
__device__ __forceinline__ XcdBarrier xcd_barrier_post(unsigned* bar, volatile LAS unsigned* st) {
  XcdBarrier b; b.bar = bar; b.x = xb_xcc_id(); b.st = st;
  if (tidx() == 0) (void)xb_add(&bar[XB_XCNT(b.x)], 1u);
  return b;
}
__device__ __forceinline__ void xcd_barrier_complete(unsigned* bar, unsigned x, unsigned& nloc, unsigned& nx) {
  const unsigned G = gridDim.x * gridDim.y * gridDim.z;
  unsigned sum, cnt, mine, sp = 0u;
  for (;;) {
    sum = 0u; cnt = 0u; mine = 0u;
#pragma unroll
    for (unsigned j = 0; j < 16; ++j) { const unsigned c = xb_ld(&bar[XB_XCNT(j)]); sum += c; cnt += (c > 0u) ? 1u : 0u; mine = (j == x) ? c : mine; }
    if (sum == G) break;
    __builtin_amdgcn_s_sleep(1);
    if ((++sp & 255u) == 0u) { if (xb_ld(&bar[XB_TMO])) break; if (sp > XB_SPIN_CAP) { atomicAdd(&bar[XB_TMO], 1u); break; } }
  }
  nloc = mine > 0u ? mine : 1u; nx = cnt > 0u ? cnt : 1u;
}
__device__ __forceinline__ void xcd_barrier(const XcdBarrier& b) {
  asm volatile("s_waitcnt vmcnt(0)" ::: "memory");
  __syncthreads();
  if (tidx() == 0) {
    unsigned* bar = b.bar;
    __builtin_amdgcn_s_waitcnt(0);
    unsigned nloc = b.st[0], nx = b.st[1];
    if (nloc == 0u) { xcd_barrier_complete(bar, b.x, nloc, nx); b.st[0] = nloc; b.st[1] = nx; }
    const unsigned old = xb_add(&bar[XB_XSUB(b.x)], 1u);
    const unsigned gen = old / nloc;
    if (old + 1u == (gen + 1u) * nloc) {
      __builtin_amdgcn_fence(__ATOMIC_RELEASE, "agent");
      asm volatile("s_waitcnt vmcnt(0)" ::: "memory");
      const unsigned og = xb_add(&bar[XB_TOP], 1u);
      const unsigned tg = og / nx;
      if (og + 1u == (tg + 1u) * nx) xb_add(&bar[XB_TOPGEN], 1u);
      else XB_SPIN(xb_ld(&bar[XB_TOPGEN]) == tg, bar);
      __builtin_amdgcn_fence(__ATOMIC_ACQUIRE, "agent");
      xb_add(&bar[XB_XGEN(b.x)], 1u);
      asm volatile("s_waitcnt vmcnt(0)" ::: "memory");
    } else {
      XB_SPIN(xb_ld(&bar[XB_XGEN(b.x)]) == gen, bar);
      __builtin_amdgcn_fence(__ATOMIC_ACQUIRE, "agent");
      asm volatile("s_waitcnt vmcnt(0)" ::: "memory");
    }
  }
  __syncthreads();
}

constexpr int NPHASE = 20;
#ifndef C0A
#define C0A 25
#define C0B 70
#define C1A 65
#endif
constexpr int LDS_BYTES = 147456;
__device__ __forceinline__ void run_phase(const P& p, int ph, char* smem, LAS unsigned char* lds) {
  float* xa = (float*)(p.ws + WS_XA);
  const u16* slots = (const u16*)(p.ws + WS_INC);
  switch (ph) {
    case 0: phase_rowpass(p, p.x, nullptr, nullptr, p.norm_mix_g, -1, nullptr, smem); phase_prep(p); __syncthreads(); phase_conv_dense(p, smem); break;
    case 1: phase_inproj(p, lds); phase_s5_ktab(p); phase_s5_fill_bc(p); phase_conv_moe(p, 0, 0, cq(C0A), 128, 128, smem); break;
    case 2: phase_ret_inc_mfma(p, smem); __syncthreads(); phase_s5_egemm(p, lds); phase_s5_fill_a(p); break;
    case 3: phase_ret_scan16(p); phase_s5_carry(p); break;
    case 4: phase_ret_out_mfma(p, smem); __syncthreads(); phase_s5_ygemm(p, lds); break;
    case 5: phase_glu(p, lds); phase_conv_moe(p, 0, cq(C0A), cq(C0B), 128, 128, smem); break;
    case 6: phase_outproj(p, p.ws + WS_WOUT, p.x, xa, lds); break;
    case 7: phase_rowpass(p, xa, nullptr, nullptr, p.norm_ffn_g, 0, nullptr, smem); break;
    case 8: phase_moe_plan(p, 0, smem); phase_conv_moe(p, 0, cq(C0B), CONV_ITEMS, 1, 255, smem); break;
    case 9: phase_moe1(p, 0, lds); break;
    case 10: phase_moe2(p, 0, lds); break;
    case 11: phase_rowpass(p, xa, slots, xa, p.norm_mix_g + DM, -1, nullptr, smem); break;
    case 12: phase_qkv(p, lds); phase_conv_moe(p, 1, 0, cq(C1A), 128, 128, smem); break;
    case 13: phase_attn(p, smem); break;
    case 14: phase_outproj(p, p.ws + WS_WO, xa, xa, lds); break;
    case 15: phase_rowpass(p, xa, nullptr, nullptr, p.norm_ffn_g + DM, 1, nullptr, smem); break;
    case 16: phase_moe_plan(p, 1, smem); phase_conv_moe(p, 1, cq(C1A), CONV_ITEMS, 1, 255, smem); break;
    case 17: phase_moe1(p, 1, lds); break;
    case 18: phase_moe2(p, 1, lds); break;
    case 19: phase_rowpass(p, xa, slots, nullptr, p.norm_final_g, -1, p.out, smem); break;
    default: break;
  }
}

extern __shared__ __attribute__((aligned(16))) char dyn_smem[];

template <int PH> __device__ __forceinline__ void mega_steps(const P& p, char* smem, LAS unsigned char* lds, const XcdBarrier& xb) {
  run_phase(p, PH, smem, lds);
  if constexpr (PH + 1 < NPHASE) {
    xcd_barrier(xb);
    mega_steps<PH + 1>(p, smem, lds, xb);
  }
}
__global__ void __launch_bounds__(NTHR, 2) k_mega(P p) {
  LAS unsigned char* lds = (LAS unsigned char*)dyn_smem;
  volatile LAS unsigned* st = (volatile LAS unsigned*)(lds + LDS_BYTES - 16);
  if (tidx() == 0) { st[0] = 0u; st[1] = 0u; }
  __syncthreads();
  const XcdBarrier xb = xcd_barrier_post((unsigned*)(p.ws + WS_BAR), st);
  mega_steps<0>(p, dyn_smem, lds, xb);
}

extern "C" void kernel_launch(void* const* d_in, const int* in_sizes, int n_in, void* d_out, int out_size, void* d_ws, size_t ws_size, hipStream_t stream) {
  static int grid_blocks = 0;
  if (grid_blocks == 0) {
    if (n_in != 28 || out_size != T_TOK * DM || ws_size < WS_END) { fprintf(stderr, "kernel_launch: unexpected problem (n_in %d out %d ws %zu need %zu)\n", n_in, out_size, ws_size, (size_t)WS_END); grid_blocks = -1; return; }
    int dev = 0, cus = 0, per_cu = 0;
    (void)hipGetDevice(&dev);
    (void)hipDeviceGetAttribute(&cus, hipDeviceAttributeMultiprocessorCount, dev);
    const void* fn = (const void*)k_mega;
    if (hipFuncSetAttribute(fn, hipFuncAttributeMaxDynamicSharedMemorySize, LDS_BYTES) != hipSuccess) { fprintf(stderr, "kernel_launch: hipFuncSetAttribute failed\n"); }
    if (hipOccupancyMaxActiveBlocksPerMultiprocessor(&per_cu, fn, NTHR, LDS_BYTES) != hipSuccess || per_cu < 1) { fprintf(stderr, "kernel_launch: occupancy query failed (%d)\n", per_cu); per_cu = 1; }
    (void)hipGetLastError();
    if (per_cu > 1) per_cu = 1;
    grid_blocks = cus * per_cu;
    fprintf(stderr, "kernel_launch: cus %d per_cu %d grid %d\n", cus, per_cu, grid_blocks);
  }
  if (grid_blocks < 0) return;
  P p{};
  const float** pp = (const float**)&p;
  for (int i = 0; i < 28; ++i) pp[i] = (const float*)d_in[i];
  p.out = (float*)d_out; p.ws = (char*)d_ws;
  (void)hipMemsetAsync((char*)d_ws + WS_BAR, 0, XCD_BAR_WORDS * 4, stream);
  void* args[] = {&p};
  const hipError_t e = hipLaunchCooperativeKernel((const void*)k_mega, dim3(grid_blocks), dim3(NTHR), args, LDS_BYTES, stream);
  if (e != hipSuccess) fprintf(stderr, "cooperative launch failed: %s (grid %d)\n", hipGetErrorString(e), grid_blocks);
}
```

```cpp
#include <hip/hip_runtime.h>
#include <cstdio>
#include <cstdint>

#define USE_FP16 1
#define LAS __attribute__((address_space(3)))

typedef unsigned short u16;
typedef float f32x4 __attribute__((ext_vector_type(4)));
typedef float f32x2 __attribute__((ext_vector_type(2)));
typedef _Float16 f16x8 __attribute__((ext_vector_type(8)));

constexpr int T_TOK = 16384, DM = 1024, SEQ = 2048, NBATCH = 8;
constexpr int CAP = 32768;
constexpr int NTHR = 512, NWAVE = NTHR / 64;

constexpr size_t MB = 1024ull * 1024ull;
constexpr size_t WS_XA    = 0;
constexpr size_t WS_XB    = 64 * MB;
constexpr size_t WS_Z     = 96 * MB;
constexpr size_t WS_A2    = 160 * MB;
constexpr size_t WS_BTY   = 184 * MB;
constexpr size_t WS_MW1   = 160 * MB;
constexpr size_t WS_WET   = 208 * MB;
constexpr size_t WS_E     = 216 * MB;
constexpr size_t WS_KTAB  = 232 * MB;
constexpr size_t WS_SP16  = 234 * MB;
constexpr size_t WS_INC   = 266 * MB;
constexpr size_t WS_YCAT  = 330 * MB;
constexpr size_t WS_YGELU = 362 * MB;
constexpr size_t WS_H     = 330 * MB;
constexpr size_t WS_LIST  = 378 * MB;
constexpr size_t WS_GATE  = 382 * MB;
constexpr size_t WS_ROPE  = 383 * MB;
constexpr size_t WS_CNT   = 384 * MB;
constexpr int CNT_STRIDE = 64;
constexpr size_t WS_WR16  = 385 * MB;
constexpr size_t WS_BAR   = 386 * MB;
constexpr size_t WS_PLAN  = 386 * MB + 512 * 1024;
constexpr size_t WS_WIN   = 387 * MB;
constexpr size_t WS_WGLU  = 392 * MB;
constexpr size_t WS_WOUT  = 393 * MB;
constexpr size_t WS_WQKV  = 395 * MB;
constexpr size_t WS_WO    = 398 * MB;
constexpr size_t WS_LAMT  = 400 * MB;
constexpr size_t WS_MW0   = 402 * MB;
constexpr size_t WS_LIST2 = 498 * MB;
constexpr size_t WS_END   = 506 * MB;

struct P {
  const float *x, *norm_mix_g, *norm_ffn_g, *norm_final_g, *w_in, *ret_decay, *a_re, *a_im, *log_step, *b_re, *b_im, *c_re, *c_im,
      *s5d, *w_glu, *b_glu, *w_out, *w_qkv, *sink, *w_o, *rel_bias, *w_group, *b_group, *w_er, *b_er, *w_gate, *w_up, *w_down;
  float* out;
  char* ws;
};

__device__ __forceinline__ u16 f2h(float f) { _Float16 h = (_Float16)f; return __builtin_bit_cast(u16, h); }
__device__ __forceinline__ float h2f(u16 h) { return (float)__builtin_bit_cast(_Float16, h); }
__device__ __forceinline__ unsigned pk2(float a, float b) { return (unsigned)f2h(a) | ((unsigned)f2h(b) << 16); }
__device__ __forceinline__ float lo16(unsigned w) { return h2f((u16)(w & 0xffffu)); }
__device__ __forceinline__ float hi16(unsigned w) { return h2f((u16)(w >> 16)); }
__device__ __forceinline__ f32x4 mfma16(uint4 a, uint4 b, f32x4 c) {
  return __builtin_amdgcn_mfma_f32_16x16x32_f16(__builtin_bit_cast(f16x8, a), __builtin_bit_cast(f16x8, b), c, 0, 0, 0);
}
__device__ __forceinline__ float wave_sum(float v) {
#pragma unroll
  for (int o = 1; o < 64; o <<= 1) v += __shfl_xor(v, o);
  return v;
}
__device__ __forceinline__ float sigmoidf_(float x) { return 1.0f / (1.0f + __expf(-x)); }
__device__ __forceinline__ float gelu_tanh(float x) {
  const float u = 0.7978845608028654f * (x + 0.044715f * x * x * x);
  return 0.5f * x * (1.0f + tanhf(u));
}
#define LDS_WAIT() asm volatile("s_waitcnt lgkmcnt(0)" ::: "memory")
__device__ __forceinline__ int tidx() { int t = threadIdx.x; asm volatile("" : "+v"(t)); return t; }

namespace pg8 {
constexpr int BM = 256, BK = 64, HALF = 128, HTB = HALF * BK * 2, STAGE_BYTES = 8 * HTB, NXCD = 8, WGM = 8;
__device__ __forceinline__ int lds_byte(int r, int c) { const int st = (r >> 4) * 2 + (c >> 5), rr = r & 15, cc = c & 31, ob = rr * 64 + cc * 2; return st * 1024 + (ob ^ (((ob >> 9) & 1) << 5)); }
__device__ __forceinline__ int perm32(int rho) { const int n = rho >> 4, i = rho & 15; return 8 * (i >> 2) + 4 * n + (i & 3); }
__device__ __forceinline__ void stage_rc(int b, int& R, int& C) { const int st = b / 1024, sb = b % 1024, swz = sb ^ (((sb >> 9) & 1) << 5); R = (st >> 1) * 16 + swz / 64; C = (st & 1) * 32 + (swz % 64) / 2; }

struct Unit { const char* a; const char* b; int pm, pn, e, cnt, hbase; };

template <class Epi, class Sched, bool ALIGN_EPI, bool SP2>
__device__ __forceinline__ void gemm_phase(LAS unsigned char* lds, const int K, const Sched& S, const Epi& E) {
    const int tid = tidx(), wid = __builtin_amdgcn_readfirstlane(tid >> 6), lane = tid & 63, wr = wid >> 2, wc = wid & 3, fr = lane & 15, fq = lane >> 4;
    const int nt = K / BK;
    int Rr[2], Cc[2];
    unsigned voffB[2];
#pragma unroll
    for (int i = 0; i < 2; ++i) { stage_rc(tid * 16 + i * 8192, Rr[i], Cc[i]); const int Rb = Epi::PERM ? ((Rr[i] & ~31) + perm32(Rr[i] & 31)) : Rr[i]; voffB[i] = (unsigned)(Rb * K + Cc[i]) * 2u; }
    const size_t kstep = (size_t)(BK * 2);
    const size_t hstepB = (size_t)HALF * K * 2;
    const unsigned ldsw = (unsigned)wid * 1024u;
    const int aoff = lds_byte(wr * 64 + fr, fq * 8), boff = lds_byte(wc * 32 + fr, fq * 8);
#define PG8_SA(b, h) (((b) * 2 + (h)) * HTB)
#define PG8_SB(b, h) ((4 + (b) * 2 + (h)) * HTB)
#define PG8_STAGE(bufoff, gbase, voff) do { _Pragma("unroll") for (int _i = 0; _i < 2; ++_i) \
        __builtin_amdgcn_global_load_lds((const unsigned*)((const char*)(gbase) + (voff)[_i]), (LAS unsigned*)(lds + (bufoff) + ldsw + _i * 8192), 16, 0, 0); } while (0)
#define PG8_LDA(dst, b, h) do { _Pragma("unroll") for (int m = 0; m < 4; ++m) _Pragma("unroll") for (int k = 0; k < 2; ++k) dst[m][k] = *(const LAS f16x8*)(lds + PG8_SA(b, h) + aoff + m * 2048 + k * 1024); } while (0)
#define PG8_LDB(dst, b, h) do { _Pragma("unroll") for (int n = 0; n < 2; ++n) _Pragma("unroll") for (int k = 0; k < 2; ++k) dst[n][k] = *(const LAS f16x8*)(lds + PG8_SB(b, h) + boff + n * 2048 + k * 1024); } while (0)
#define PG8_MMA(ai, bj, At, Bt) do { if (128 * (ai) + 64 * wr >= urows) break; __builtin_amdgcn_s_setprio(1); _Pragma("unroll") for (int m = 0; m < 4; ++m) _Pragma("unroll") for (int n = 0; n < 2; ++n) _Pragma("unroll") for (int k = 0; k < 2; ++k) \
        acc[ai][bj][m][n] = __builtin_amdgcn_mfma_f32_16x16x32_f16(Bt[n][k], At[m][k], acc[ai][bj][m][n], 0, 0, 0); __builtin_amdgcn_s_setprio(0); } while (0)
#define PG8_WAIT_V(n) asm volatile("s_waitcnt vmcnt(" #n ")" ::: "memory")
#define PG8_WAIT_L(n) asm volatile("s_waitcnt lgkmcnt(" #n ")" ::: "memory")
#define PG8_BAR __builtin_amdgcn_s_barrier()
#define PG8_SCHED __builtin_amdgcn_sched_barrier(0)
    Unit cur, nxt; int ui = 0;
    if (!S.next(0, cur)) return;
    unsigned cv0[2], cv1[2], nv0[2], nv1[2];
#pragma unroll
    for (int i = 0; i < 2; ++i) { cv0[i] = S.a_voff(cur, 0, Rr[i], Cc[i]); cv1[i] = S.a_voff(cur, 1, Rr[i], Cc[i]); }
    f32x4 acc[2][2][4][2];
#pragma unroll
    for (int a = 0; a < 2; ++a)
#pragma unroll
        for (int b = 0; b < 2; ++b)
#pragma unroll
            for (int m = 0; m < 4; ++m)
#pragma unroll
                for (int n = 0; n < 2; ++n) acc[a][b][m][n] = (f32x4){0.f, 0.f, 0.f, 0.f};
    f16x8 At[4][2], B0[2][2], B1[2][2];
    const char* cA = cur.a; const char* cB = cur.b;
    int urows = S.rows(cur);
    if constexpr (SP2) {
        PG8_STAGE(PG8_SB(0, 0), cB, voffB); PG8_STAGE(PG8_SB(0, 1), cB + hstepB, voffB); PG8_STAGE(PG8_SA(0, 0), cA, cv0); PG8_STAGE(PG8_SA(0, 1), cA, cv1);
        if (wr == 1) PG8_BAR;
        PG8_WAIT_V(2); PG8_BAR;
        PG8_STAGE(PG8_SB(1, 0), cB + kstep, voffB); PG8_STAGE(PG8_SA(1, 0), cA + kstep, cv0); PG8_STAGE(PG8_SB(1, 1), cB + hstepB + kstep, voffB);
        PG8_WAIT_V(6); PG8_BAR;
    } else {
        PG8_STAGE(PG8_SB(0, 0), cB, voffB); PG8_STAGE(PG8_SA(0, 0), cA, cv0); PG8_STAGE(PG8_SB(0, 1), cB + hstepB, voffB); PG8_STAGE(PG8_SA(0, 1), cA, cv1);
        if (wr == 1) PG8_BAR;
        PG8_WAIT_V(4); PG8_BAR;
        PG8_STAGE(PG8_SB(1, 0), cB + kstep, voffB); PG8_STAGE(PG8_SA(1, 0), cA + kstep, cv0); PG8_STAGE(PG8_SB(1, 1), cB + hstepB + kstep, voffB);
        PG8_WAIT_V(6); PG8_BAR;
    }
    for (;;) {
        const bool has_next = S.next(ui + 1, nxt);
        if (has_next) {
#pragma unroll
            for (int i = 0; i < 2; ++i) { nv0[i] = S.a_voff(nxt, 0, Rr[i], Cc[i]); nv1[i] = S.a_voff(nxt, 1, Rr[i], Cc[i]); }
        } else {
            nxt = cur;
#pragma unroll
            for (int i = 0; i < 2; ++i) { nv0[i] = cv0[i]; nv1[i] = cv1[i]; }
        }
        const char* nA = nxt.a; const char* nB = nxt.b;
        for (int t = 0; t < nt; t += 2) {
            const bool last = (t == nt - 2);
            const char* a1 = cA + (size_t)(t + 1) * kstep;
            const char* a2 = last ? nA : cA + (size_t)(t + 2) * kstep; const char* b2 = last ? nB : cB + (size_t)(t + 2) * kstep;
            const char* a3 = a2 + kstep; const char* b3 = b2 + kstep;
            unsigned v0[2], v1[2];
#pragma unroll
            for (int i = 0; i < 2; ++i) { v0[i] = last ? nv0[i] : cv0[i]; v1[i] = last ? nv1[i] : cv1[i]; }
            if constexpr (SP2) {
            PG8_LDB(B0, 0, 0); PG8_LDB(B1, 0, 1); PG8_SCHED; PG8_LDA(At, 0, 0); PG8_STAGE(PG8_SA(1, 1), a1, cv1);
            PG8_WAIT_V(8); PG8_WAIT_L(0); PG8_BAR; PG8_MMA(0, 0, At, B0); PG8_MMA(0, 1, At, B1); PG8_BAR; PG8_SCHED;
            PG8_LDA(At, 0, 1); PG8_STAGE(PG8_SB(0, 0), b2, voffB); PG8_STAGE(PG8_SB(0, 1), b2 + hstepB, voffB); PG8_STAGE(PG8_SA(0, 0), a2, v0);
            PG8_WAIT_V(8); PG8_WAIT_L(0); PG8_BAR; PG8_MMA(1, 0, At, B0); PG8_MMA(1, 1, At, B1); PG8_BAR; PG8_SCHED;
            PG8_LDB(B0, 1, 0); PG8_LDB(B1, 1, 1); PG8_SCHED; PG8_LDA(At, 1, 0); PG8_STAGE(PG8_SA(0, 1), a2, v1);
            PG8_WAIT_V(8); PG8_WAIT_L(0); PG8_BAR; PG8_MMA(0, 0, At, B0); PG8_MMA(0, 1, At, B1); PG8_BAR; PG8_SCHED;
            PG8_LDA(At, 1, 1); PG8_STAGE(PG8_SB(1, 0), b3, voffB); PG8_STAGE(PG8_SB(1, 1), b3 + hstepB, voffB); PG8_STAGE(PG8_SA(1, 0), a3, v0);
            PG8_WAIT_V(8); PG8_WAIT_L(0); PG8_BAR; PG8_MMA(1, 0, At, B0); PG8_MMA(1, 1, At, B1); PG8_BAR; PG8_SCHED;
            } else {
            PG8_LDB(B0, 0, 0); PG8_SCHED; PG8_LDA(At, 0, 0); PG8_STAGE(PG8_SA(1, 1), a1, cv1);
            PG8_WAIT_L(8); PG8_BAR; PG8_WAIT_L(0); PG8_MMA(0, 0, At, B0); PG8_BAR; PG8_SCHED;
            PG8_LDB(B1, 0, 1); PG8_STAGE(PG8_SB(0, 0), b2, voffB);
            PG8_BAR; PG8_WAIT_L(0); PG8_MMA(0, 1, At, B1); PG8_BAR;
            PG8_LDA(At, 0, 1); PG8_STAGE(PG8_SA(0, 0), a2, v0);
            PG8_BAR; PG8_WAIT_L(0); PG8_MMA(1, 0, At, B0); PG8_BAR; PG8_SCHED;
            PG8_STAGE(PG8_SB(0, 1), b2 + hstepB, voffB);
            PG8_WAIT_V(6); PG8_BAR; PG8_MMA(1, 1, At, B1); PG8_BAR;
            PG8_LDB(B0, 1, 0); PG8_SCHED; PG8_LDA(At, 1, 0); PG8_STAGE(PG8_SA(0, 1), a2, v1);
            PG8_WAIT_L(8); PG8_BAR; PG8_WAIT_L(0); PG8_MMA(0, 0, At, B0); PG8_BAR; PG8_SCHED;
            PG8_LDB(B1, 1, 1); PG8_STAGE(PG8_SB(1, 0), b3, voffB);
            PG8_BAR; PG8_WAIT_L(0); PG8_MMA(0, 1, At, B1); PG8_BAR;
            PG8_LDA(At, 1, 1); PG8_STAGE(PG8_SA(1, 0), a3, v0);
            PG8_BAR; PG8_WAIT_L(0); PG8_MMA(1, 0, At, B0); PG8_BAR; PG8_SCHED;
            PG8_STAGE(PG8_SB(1, 1), b3 + hstepB, voffB);
            PG8_WAIT_V(6); PG8_BAR; PG8_MMA(1, 1, At, B1); PG8_BAR;
            }
        }
        if constexpr (ALIGN_EPI) { if (wr == 0) PG8_BAR; }
        E(acc, cur, wr, wc, fr, fq);
        if (!has_next) break;
#pragma unroll
        for (int a = 0; a < 2; ++a)
#pragma unroll
            for (int b = 0; b < 2; ++b)
#pragma unroll
                for (int m = 0; m < 4; ++m)
#pragma unroll
                    for (int n = 0; n < 2; ++n) acc[a][b][m][n] = (f32x4){0.f, 0.f, 0.f, 0.f};
        cur = nxt; cA = nA; cB = nB; ++ui; urows = S.rows(cur);
#pragma unroll
        for (int i = 0; i < 2; ++i) { cv0[i] = nv0[i]; cv1[i] = nv1[i]; }
        if constexpr (ALIGN_EPI) { if (wr == 1) PG8_BAR; }
    }
    PG8_WAIT_V(0);
    if constexpr (!ALIGN_EPI) { if (wr == 0) PG8_BAR; }
    PG8_BAR;
#undef PG8_SA
#undef PG8_SB
#undef PG8_STAGE
#undef PG8_LDA
#undef PG8_LDB
#undef PG8_MMA
#undef PG8_WAIT_V
#undef PG8_WAIT_L
#undef PG8_BAR
#undef PG8_SCHED
}

struct DenseOrder {
    const char* A; const char* Bt; int lda_b, K, nM, nN, nwg, G, c;
    __device__ __forceinline__ void init(const void* A_, int lda_elems, const void* Bt_, int M, int N, int K_) { A = (const char*)A_; Bt = (const char*)Bt_; lda_b = lda_elems * 2; K = K_; nM = M / BM; nN = N / BM; nwg = nM * nN; G = gridDim.x; c = blockIdx.x; }
    __device__ __forceinline__ bool next(int i, Unit& u) const {
        const long L = (long)i * G + c; if (L >= nwg) return false;
        int wgid = (int)L; { const int q = nwg / NXCD, r = nwg % NXCD, xcd = wgid % NXCD, off = wgid / NXCD; wgid = (xcd < r ? xcd * (q + 1) : r * (q + 1) + (xcd - r) * q) + off; }
        const int nig = WGM * nN, gid = wgid / nig, fm = gid * WGM, gsz = (nM - fm) < WGM ? (nM - fm) : WGM;
        u.pm = fm + ((wgid % nig) % gsz); u.pn = (wgid % nig) / gsz; u.e = 0; u.cnt = 0; u.hbase = 0;
        u.a = A + (size_t)u.pm * BM * lda_b; u.b = Bt + (size_t)u.pn * BM * K * 2;
        return true;
    }
    __device__ __forceinline__ unsigned a_voff(const Unit&, int h, int R, int C) const { return (unsigned)((h * HALF + R) * lda_b + C * 2); }
    __device__ __forceinline__ int rows(const Unit&) const { return BM; }
};
struct GroupOrder {
    const char* A; const char* Bt; int lda_b, K, nM, nN, ng, G, c; size_t gsA, gsB;
    __device__ __forceinline__ void init(const void* A_, int lda_elems, size_t gsA_elems, const void* Bt_, size_t gsB_elems, int ng_, int M, int N, int K_) {
        A = (const char*)A_; Bt = (const char*)Bt_; lda_b = lda_elems * 2; K = K_; nM = M / BM; nN = N / BM; ng = ng_; gsA = gsA_elems * 2; gsB = gsB_elems * 2; G = gridDim.x; c = blockIdx.x; }
    __device__ __forceinline__ bool next(int i, Unit& u) const {
        const long L = (long)i * G + c; if (L >= (long)ng * nM * nN) return false;
        const int per = nM * nN, g = (int)L / per, r = (int)L % per;
        u.e = g; u.pm = r / nN; u.pn = r % nN; u.cnt = 0; u.hbase = 0;
        u.a = A + (size_t)g * gsA + (size_t)u.pm * BM * lda_b; u.b = Bt + (size_t)g * gsB + (size_t)u.pn * BM * K * 2;
        return true;
    }
    __device__ __forceinline__ unsigned a_voff(const Unit&, int h, int R, int C) const { return (unsigned)((h * HALF + R) * lda_b + C * 2); }
    __device__ __forceinline__ int rows(const Unit&) const { return BM; }
};
constexpr int PLAN_STRIDE = 256;
struct PlanOrder {
    const int4* plan; const int* plan_n; const int2* list; const char* A; const char* Bt; int lda_b, K, x, ib, nbx; size_t esB; bool gather;
    __device__ __forceinline__ void init(const void* planbase, const int2* list_, const void* A_, int lda_elems, const void* Bt_, size_t esB_elems, int K_, bool gather_) {
        plan_n = (const int*)planbase; plan = (const int4*)((const char*)planbase + 256); list = list_; A = (const char*)A_; Bt = (const char*)Bt_; lda_b = lda_elems * 2; K = K_; esB = esB_elems * 2; gather = gather_;
        x = blockIdx.x & 7; ib = blockIdx.x >> 3; nbx = ((int)gridDim.x - x + 7) >> 3; }
    __device__ __forceinline__ bool next(int i, Unit& u) const {
        const int j = i * nbx + ib;
        if (j >= plan_n[x]) return false;
        const int4 en = plan[x * PLAN_STRIDE + j];
        u.e = en.x & 255; u.pm = (en.x >> 8) & 255; u.pn = (en.x >> 16) & 255; u.cnt = en.y; u.hbase = en.z;
        u.a = gather ? A : A + (size_t)(u.hbase + u.pm * BM) * lda_b;
        u.b = Bt + (size_t)u.e * esB + (size_t)u.pn * BM * K * 2;
        return true;
    }
    __device__ __forceinline__ unsigned a_voff(const Unit& u, int h, int R, int C) const {
        if (!gather) return (unsigned)((h * HALF + R) * lda_b + C * 2);
        const int li = u.pm * BM + h * HALF + R;
        const int tok = (li < u.cnt) ? (list[(size_t)u.e * CAP + li].x >> 1) : 0;
        return (unsigned)(tok * lda_b + C * 2);
    }
    __device__ __forceinline__ int rows(const Unit& u) const { const int r = u.cnt - u.pm * BM; return r < BM ? r : BM; }
};
}
constexpr bool G_ALIGN = true, G_SP2 = true;

__device__ __forceinline__ void phase_prep(const P& p) {
  const int gtid = blockIdx.x * NTHR + tidx(), gsz = gridDim.x * NTHR;
  int* cnt = (int*)(p.ws + WS_CNT);
  if (gtid < 64) cnt[gtid * CNT_STRIDE] = 0;
  f32x2* rope = (f32x2*)(p.ws + WS_ROPE);
  for (int i = gtid; i < SEQ * 64; i += gsz) {
    const int pos = i >> 6, f = i & 63;
    const float inv = powf(10000.0f, -(float)(2 * f) / 128.0f);
    const float ang = (float)pos * inv;
    float s, c; sincosf(ang, &s, &c);
    rope[i] = (f32x2){c, s};
  }
  f32x2* lamt = (f32x2*)(p.ws + WS_LAMT); f32x2* coeft = (f32x2*)(p.ws + WS_LAMT + 3 * MB / 2);
  for (int i = gtid; i < 32 * 2 * 33 * 64; i += gsz) {
    const int q = i & 63, l = (i >> 6) % 33, gd = i / (33 * 64);
    const int g = gd >> 1, dir = gd & 1;
    const float dt = expf(p.log_step[dir * 32 + g]), ar = p.a_re[(dir * 32 + g) * 64 + q], ai = p.a_im[(dir * 32 + g) * 64 + q];
    const float mag = expf(ar * dt * (float)l); float sn, cs; sincosf(ai * dt * (float)l, &sn, &cs);
    lamt[i] = (f32x2){mag * cs, mag * sn};
    if (l == 1) {
      const float em1 = expm1f(ar * dt), sh = sinf(0.5f * ai * dt);
      const float nr = em1 * cs - 2.0f * sh * sh, ni = (em1 + 1.0f) * sn, den = ar * ar + ai * ai;
      coeft[gd * 64 + q] = (f32x2){(nr * ar + ni * ai) / den, (ni * ar - nr * ai) / den};
    }
  }
  u16* wr16 = (u16*)(p.ws + WS_WR16);
  for (int i = gtid; i < 2 * 48 * DM; i += gsz) {
    const int k = i & (DM - 1), n = (i >> 10) % 48, layer = i / (48 * DM);
    float w = 0.f;
    if (n < 4) w = p.w_group[((size_t)layer * DM + k) * 4 + n];
    else if (n < 36) { const int gg = (n - 4) >> 3, j = (n - 4) & 7; w = p.w_er[(((size_t)layer * 4 + gg) * DM + k) * 8 + j]; }
    w *= p.norm_ffn_g[layer * DM + k];
    const u16 hi = f2h(w), lo = f2h(w - h2f(hi));
    wr16[((size_t)(layer * 2 + 0) * 48 + n) * DM + k] = hi;
    wr16[((size_t)(layer * 2 + 1) * 48 + n) * DM + k] = lo;
  }
}

template <class RowFn>
__device__ __forceinline__ void conv_item(const float* W, int ldw, int K, u16* WT, float* scr, int k0, int n0, int lane, RowFn rowfn) {
#pragma unroll 8
  for (int i = 0; i < 32; ++i) { const int kk = 2 * i + (lane >> 5); scr[kk * 33 + (lane & 31)] = W[(size_t)(k0 + kk) * ldw + n0 + (lane & 31)]; }
  LDS_WAIT();
  const int c = lane & 7;
#pragma unroll
  for (int j = 0; j < 4; ++j) {
    const int n = (lane >> 3) + 8 * j; const float* sp = scr + (8 * c) * 33 + n;
    uint4 o; o.x = pk2(sp[0 * 33], sp[1 * 33]); o.y = pk2(sp[2 * 33], sp[3 * 33]); o.z = pk2(sp[4 * 33], sp[5 * 33]); o.w = pk2(sp[6 * 33], sp[7 * 33]);
    *(uint4*)(WT + (size_t)rowfn(n0 + n) * K + k0 + 8 * c) = o;
  }
  LDS_WAIT();
}
template <class RowFn>
__device__ __forceinline__ int conv_matrix(const float* W, int ldw, int K, int N, u16* WT, char* smem, int item_base, RowFn rowfn) {
  const int lane = tidx() & 63, wv = tidx() >> 6, gw = blockIdx.x * NWAVE + wv, nw = gridDim.x * NWAVE;
  float* scr = (float*)smem + wv * (64 * 33);
  const int nkb = K / 64, nnb = N / 32, nitems = nkb * nnb;
  int it = gw - (item_base % nw); if (it < 0) it += nw;
  for (; it < nitems; it += nw) conv_item(W, ldw, K, WT, scr, (it / nnb) * 64, (it % nnb) * 32, lane, rowfn);
  return nitems;
}
__device__ __forceinline__ void phase_conv_dense(const P& p, char* smem) {
  auto id = [](int n) { return n; };
  int base = 0;
  base += conv_matrix(p.w_in, 2560, DM, 2560, (u16*)(p.ws + WS_WIN), smem, base, [](int n) { if (n >= 1024) return n; const int dd = n & 127, hf = dd >> 6, r = dd & 63; return (n & ~127) + 32 * (r >> 4) + 8 * ((r & 15) >> 2) + 4 * hf + (r & 3); });
  base += conv_matrix(p.w_glu, 512, 512, 512, (u16*)(p.ws + WS_WGLU), smem, base, id);
  base += conv_matrix(p.w_out, DM, DM, DM, (u16*)(p.ws + WS_WOUT), smem, base, id);
  base += conv_matrix(p.w_qkv, 1536, DM, 1536, (u16*)(p.ws + WS_WQKV), smem, base, id);
  base += conv_matrix(p.w_o, DM, DM, DM, (u16*)(p.ws + WS_WO), smem, base, id);
}
__device__ __forceinline__ void phase_conv_moe(const P& p, int layer, int lo, int hi, int b0, int nb, char* smem) {
  if (gridDim.x != 256) { b0 = 0; nb = (int)gridDim.x; }
  if ((int)blockIdx.x < b0 || (int)blockIdx.x >= b0 + nb) return;
  const int lane = tidx() & 63, wv = tidx() >> 6, gw = ((int)blockIdx.x - b0) * NWAVE + wv, nw = nb * NWAVE;
  float* scr = (float*)smem + wv * (64 * 33);
  u16* w1t = (u16*)(p.ws + (layer ? WS_MW1 : WS_MW0)); u16* w2t = w1t + (size_t)32 * DM * DM;
  for (int it = lo + gw; it < hi; it += nw) {
    const int e = it / 768, r = it % 768;
    if (r < 512) {
      const int which = r >> 8, q = r & 255, k0 = (q >> 4) * 64, n0 = (q & 15) * 32;
      const float* W = (which ? p.w_up : p.w_gate) + (size_t)(layer * 32 + e) * DM * 512;
      conv_item(W, 512, DM, w1t + (size_t)e * DM * DM, scr, k0, n0, lane, [which](int n) { return (n >> 4) * 32 + which * 16 + (n & 15); });
    } else {
      const int q = r - 512, k0 = (q >> 5) * 64, n0 = (q & 31) * 32;
      const float* W = p.w_down + (size_t)(layer * 32 + e) * 512 * DM;
      conv_item(W, DM, 512, w2t + (size_t)e * DM * 512, scr, k0, n0, lane, [](int n) { return n; });
    }
  }
}

constexpr int CONV_ITEMS = 32 * 768;
constexpr int cq(int pct) { return (int)((long)CONV_ITEMS * pct / 100); }
__device__ __forceinline__ void phase_rowpass(const P& p, const float* src, const u16* slots, float* dstx, const float* gain, int route_layer, float* fout, char* smem) {
  const int lane = tidx() & 63, wv = tidx() >> 6, fr = lane & 15, lg = lane >> 4;
  u16* xb = (u16*)(p.ws + WS_XB);
  int* cnt = (int*)(p.ws + WS_CNT);
  int2* list2 = (int2*)(p.ws + WS_LIST2);
  float* sRs = (float*)smem;
  float* sLg = (float*)smem + 64;
  for (int st = blockIdx.x; st < T_TOK / 64; st += gridDim.x) {
    const int row0 = st * 64 + wv * 8;
#pragma unroll 1
    for (int rp = 0; rp < 4; ++rp) {
      f32x4 v[2][4];
#pragma unroll
      for (int q = 0; q < 2; ++q) {
        const int row = row0 + rp * 2 + q;
#pragma unroll
        for (int i = 0; i < 4; ++i) v[q][i] = *(const f32x4*)(src + (size_t)row * DM + (i * 64 + lane) * 4);
      }
      if (slots) {
#pragma unroll
        for (int q = 0; q < 2; ++q) {
          const int row = row0 + rp * 2 + q;
          uint2 w[2][4];
#pragma unroll
          for (int sl = 0; sl < 2; ++sl)
#pragma unroll
            for (int i = 0; i < 4; ++i) w[sl][i] = *(const uint2*)(slots + ((size_t)row * 2 + sl) * DM + (i * 64 + lane) * 4);
#pragma unroll
          for (int sl = 0; sl < 2; ++sl)
#pragma unroll
            for (int i = 0; i < 4; ++i) { v[q][i][0] += lo16(w[sl][i].x); v[q][i][1] += hi16(w[sl][i].x); v[q][i][2] += lo16(w[sl][i].y); v[q][i][3] += hi16(w[sl][i].y); }
        }
      }
#pragma unroll
      for (int q = 0; q < 2; ++q) {
        const int row = row0 + rp * 2 + q;
        float ss = 0.f;
#pragma unroll
        for (int i = 0; i < 4; ++i) {
          if (dstx) *(f32x4*)(dstx + (size_t)row * DM + (i * 64 + lane) * 4) = v[q][i];
          ss += v[q][i][0] * v[q][i][0] + v[q][i][1] * v[q][i][1] + v[q][i][2] * v[q][i][2] + v[q][i][3] * v[q][i][3];
        }
        ss = wave_sum(ss);
        const float rstd = rsqrtf(ss * (1.0f / DM) + 1e-6f);
        if (route_layer >= 0 && lane == 0) sRs[wv * 8 + rp * 2 + q] = rstd;
#pragma unroll
        for (int i = 0; i < 4; ++i) {
          const int k = (i * 64 + lane) * 4;
          const f32x4 gv = *(const f32x4*)(gain + k);
          const f32x4 hv = v[q][i] * rstd * gv;
          if (fout) *(f32x4*)(fout + (size_t)row * DM + k) = hv;
          else { uint2 w; w.x = pk2(hv[0], hv[1]); w.y = pk2(hv[2], hv[3]); *(uint2*)(xb + (size_t)row * DM + k) = w; }
        }
      }
    }
    if (route_layer >= 0) {
      __syncthreads();
      const int tl = wv & 3, kh = wv >> 2;
      const float rsv = sRs[tl * 16 + fr];
      const float* xrow = src + (size_t)(st * 64 + tl * 16 + fr) * DM + kh * 512 + lg * 8;
      const u16* whi = (const u16*)(p.ws + WS_WR16) + ((size_t)(route_layer * 2 + 0) * 48 + fr) * DM + kh * 512 + lg * 8;
      const u16* wlo = (const u16*)(p.ws + WS_WR16) + ((size_t)(route_layer * 2 + 1) * 48 + fr) * DM + kh * 512 + lg * 8;
      f32x4 acc[3];
#pragma unroll
      for (int nb = 0; nb < 3; ++nb) acc[nb] = (f32x4){0.f, 0.f, 0.f, 0.f};
#pragma unroll 4
      for (int ks = 0; ks < 16; ++ks) {
        const f32x4 x0 = *(const f32x4*)(xrow + ks * 32), x1 = *(const f32x4*)(xrow + ks * 32 + 4);
        const float hv[8] = {x0[0] * rsv, x0[1] * rsv, x0[2] * rsv, x0[3] * rsv, x1[0] * rsv, x1[1] * rsv, x1[2] * rsv, x1[3] * rsv};
        unsigned ah[4], al[4];
#pragma unroll
        for (int j = 0; j < 4; ++j) {
          const u16 h0 = f2h(hv[2 * j]), h1 = f2h(hv[2 * j + 1]);
          ah[j] = (unsigned)h0 | ((unsigned)h1 << 16);
          al[j] = pk2(hv[2 * j] - h2f(h0), hv[2 * j + 1] - h2f(h1));
        }
        const uint4 ahi = make_uint4(ah[0], ah[1], ah[2], ah[3]), alo = make_uint4(al[0], al[1], al[2], al[3]);
#pragma unroll
        for (int nb = 0; nb < 3; ++nb) {
          const uint4 bh = *(const uint4*)(whi + (size_t)nb * 16 * DM + ks * 32), bl = *(const uint4*)(wlo + (size_t)nb * 16 * DM + ks * 32);
          acc[nb] = mfma16(bh, ahi, acc[nb]); acc[nb] = mfma16(bh, alo, acc[nb]); acc[nb] = mfma16(bl, ahi, acc[nb]);
        }
      }
      float* lgw = sLg + ((kh * 4 + tl) * 16 + fr) * 49;
#pragma unroll
      for (int nb = 0; nb < 3; ++nb)
#pragma unroll
        for (int r = 0; r < 4; ++r) lgw[nb * 16 + 4 * lg + r] = acc[nb][r];
      int* lcnt = (int*)(sLg + 2 * 4 * 16 * 49); int* lbase = lcnt + 32;
      if (tidx() < 32) lcnt[tidx()] = 0;
      __syncthreads();
      int ex1 = 0, ex2 = 0, lr1 = 0, lr2 = 0; float g1 = 0.f, g2 = 0.f;
      const bool decider = (wv < 4 && lane < 16);
      if (decider) {
        const float* l0 = sLg + ((0 * 4 + wv) * 16 + lane) * 49;
        const float* l1 = sLg + ((1 * 4 + wv) * 16 + lane) * 49;
        const float* bg = p.b_group + route_layer * 4;
        const float* be = p.b_er + route_layer * 32;
        float gl[4];
#pragma unroll
        for (int j = 0; j < 4; ++j) gl[j] = l0[j] + l1[j] + bg[j];
        int gs = 0; float gm = gl[0];
#pragma unroll
        for (int j = 1; j < 4; ++j) if (gl[j] > gm) { gm = gl[j]; gs = j; }
        float den = 0.f;
#pragma unroll
        for (int j = 0; j < 4; ++j) den += expf(gl[j] - gm);
        const float pg = 1.0f / den;
        float el[8];
#pragma unroll
        for (int j = 0; j < 8; ++j) el[j] = l0[4 + gs * 8 + j] + l1[4 + gs * 8 + j] + be[gs * 8 + j];
        int i1 = 0; float v1 = el[0];
#pragma unroll
        for (int j = 1; j < 8; ++j) if (el[j] > v1) { v1 = el[j]; i1 = j; }
        int i2 = -1; float v2 = -3.0e38f;
#pragma unroll
        for (int j = 0; j < 8; ++j) if (j != i1 && el[j] > v2) { v2 = el[j]; i2 = j; }
        const float e2 = expf(v2 - v1);
        g1 = pg / (1.0f + e2); g2 = pg * e2 / (1.0f + e2);
        ex1 = gs * 8 + i1; ex2 = gs * 8 + i2;
        lr1 = atomicAdd(&lcnt[ex1], 1); lr2 = atomicAdd(&lcnt[ex2], 1);
      }
      __syncthreads();
      if (tidx() < 32) { const int c = lcnt[tidx()]; lbase[tidx()] = c ? atomicAdd(&cnt[(route_layer * 32 + tidx()) * CNT_STRIDE], c) : 0; }
      __syncthreads();
      if (decider) {
        const int row = st * 64 + wv * 16 + lane;
        list2[(size_t)ex1 * CAP + lbase[ex1] + lr1] = make_int2(row * 2, __float_as_int(g1));
        list2[(size_t)ex2 * CAP + lbase[ex2] + lr2] = make_int2(row * 2 + 1, __float_as_int(g2));
      }
      __syncthreads();
    }
  }
}

constexpr int RSTR = 136;
__device__ __forceinline__ float log_sigmoid(float x) { return -log1pf(expf(-x)); }
__device__ __forceinline__ uint2 lds_tr16(const u16* ptr) {
  typedef short s16x4 __attribute__((ext_vector_type(4)));
  const s16x4 v = __builtin_amdgcn_ds_read_tr16_b64_v4i16((LAS s16x4*)ptr);
  return __builtin_bit_cast(uint2, v);
}
__device__ __forceinline__ uint4 lds_frag_T(const u16* tile, int rs, int k0, int c0, int lane) {
  const int g = lane >> 4, q = (lane & 15) >> 2, pp = lane & 3;
  const u16* a = tile + (k0 + 8 * g + q) * rs + c0 + 4 * pp;
  const uint2 lo = lds_tr16(a), hi = lds_tr16(a + 4 * rs);
  return make_uint4(lo.x, lo.y, hi.x, hi.y);
}
__device__ __forceinline__ void ret_load_tile(u16* dst0, u16* dst1, const u16* src, int t0, int h, const float* w0, const float* w1) {
  for (int c = tidx(); c < 128 * 16; c += NTHR) {
    const int i = c >> 4, ch = (c & 15) * 8;
    const uint4 v = *(const uint4*)(src + (size_t)(t0 + i) * 512 + h * 128 + ch);
    if (w0) {
      const float a = w0[i], b = w1[i];
      const float f[8] = {lo16(v.x), hi16(v.x), lo16(v.y), hi16(v.y), lo16(v.z), hi16(v.z), lo16(v.w), hi16(v.w)};
      *(uint4*)(dst0 + i * RSTR + ch) = make_uint4(pk2(f[0] * a, f[1] * a), pk2(f[2] * a, f[3] * a), pk2(f[4] * a, f[5] * a), pk2(f[6] * a, f[7] * a));
      *(uint4*)(dst1 + i * RSTR + ch) = make_uint4(pk2(f[0] * b, f[1] * b), pk2(f[2] * b, f[3] * b), pk2(f[4] * b, f[5] * b), pk2(f[6] * b, f[7] * b));
    } else *(uint4*)(dst0 + i * RSTR + ch) = v;
  }
}
template <int MB_, int NB_, bool ATR, bool BTR>
__device__ __forceinline__ void lds_mma(f32x4 (&acc)[MB_][NB_], const u16* sA, int sa, int a0, const u16* sB, int sb, int b0, int K, int lane, const float* sc) {
  const int fr = lane & 15, fq = lane >> 4;
  for (int k0 = 0; k0 < K; k0 += 32) {
    uint4 fa[MB_], fb[NB_];
#pragma unroll
    for (int m = 0; m < MB_; ++m) {
      if constexpr (ATR) fa[m] = lds_frag_T(sA, sa, k0, a0 + m * 16, lane);
      else fa[m] = *(const uint4*)(sA + (a0 + m * 16 + fr) * sa + k0 + fq * 8);
      if (sc) {
        const float f = sc[m];
        fa[m].x = pk2(lo16(fa[m].x) * f, hi16(fa[m].x) * f); fa[m].y = pk2(lo16(fa[m].y) * f, hi16(fa[m].y) * f);
        fa[m].z = pk2(lo16(fa[m].z) * f, hi16(fa[m].z) * f); fa[m].w = pk2(lo16(fa[m].w) * f, hi16(fa[m].w) * f);
      }
    }
#pragma unroll
    for (int n = 0; n < NB_; ++n) {
      if constexpr (BTR) fb[n] = lds_frag_T(sB, sb, k0, b0 + n * 16, lane);
      else fb[n] = *(const uint4*)(sB + (b0 + n * 16 + fr) * sb + k0 + fq * 8);
    }
#pragma unroll
    for (int m = 0; m < MB_; ++m)
#pragma unroll
      for (int n = 0; n < NB_; ++n) acc[m][n] = mfma16(fb[n], fa[m], acc[m][n]);
  }
}
__device__ __forceinline__ void ret_items(int ng, int& first, int& count, int& stride) {
  const int c = blockIdx.x, G = gridDim.x;
  if (G != 256) { first = c; count = (512 - c + G - 1) / G; stride = G; return; }
  stride = 1;
  if (c < ng) { first = c; count = 1; return; }
  const int rest = 512 - ng, nb = 256 - ng, q = rest / nb, r = rest % nb, i = c - ng;
  first = ng + i * q + (i < r ? i : r); count = q + (i < r ? 1 : 0);
}
__device__ __forceinline__ void phase_ret_inc_mfma(const P& p, char* smem) {
  u16* sKf = (u16*)smem; u16* sKb = sKf + 128 * RSTR; u16* sV = sKb + 128 * RSTR; float* sWf = (float*)(sV + 128 * RSTR); float* sWb = sWf + 128;
  const u16* kb = (const u16*)(p.ws + WS_Z) + (size_t)1 * T_TOK * 512; const u16* vb = (const u16*)(p.ws + WS_Z) + (size_t)2 * T_TOK * 512;
  u16* incf = (u16*)(p.ws + WS_INC); u16* incb = incf + (size_t)512 * 16384;
  const int tid = tidx(), lane = tid & 63, wv = tid >> 6, wr = wv >> 1, wc = wv & 1, fr = lane & 15, fq = lane >> 4;
  int it_first, it_count, it_stride; ret_items(64, it_first, it_count, it_stride);
  for (int ii = 0; ii < it_count; ++ii) {
    const int item = it_first + ii * it_stride;
    const int h = item & 3, bn = item >> 2, t0 = bn * 128;
    const float lgf = log_sigmoid(p.ret_decay[h]), lgb = log_sigmoid(p.ret_decay[4 + h]);
    __syncthreads();
    if (tid < 128) { sWf[tid] = expf(lgf * (float)(127 - tid)); sWb[tid] = expf(lgb * (float)tid); }
    __syncthreads();
    ret_load_tile(sKf, sKb, kb, t0, h, sWf, sWb);
    ret_load_tile(sV, nullptr, vb, t0, h, nullptr, nullptr);
    __syncthreads();
#pragma unroll
    for (int dirn = 0; dirn < 2; ++dirn) {
      f32x4 acc[2][4];
#pragma unroll
      for (int m = 0; m < 2; ++m)
#pragma unroll
        for (int n = 0; n < 4; ++n) acc[m][n] = (f32x4){0.f, 0.f, 0.f, 0.f};
      lds_mma<2, 4, true, true>(acc, sV, RSTR, wr * 32, dirn ? sKb : sKf, RSTR, wc * 64, 128, lane, nullptr);
      u16* o = (dirn ? incb : incf) + (size_t)item * 16384;
#pragma unroll
      for (int m = 0; m < 2; ++m)
#pragma unroll
        for (int n = 0; n < 4; ++n) { uint2 w; w.x = pk2(acc[m][n][0], acc[m][n][1]); w.y = pk2(acc[m][n][2], acc[m][n][3]); *(uint2*)(o + (wr * 32 + m * 16 + fr) * 128 + wc * 64 + n * 16 + 4 * fq) = w; }
    }
  }
}
__device__ __forceinline__ void phase_ret_scan16(const P& p) {
  const u16* incf = (const u16*)(p.ws + WS_INC); const u16* incb = incf + (size_t)512 * 16384;
  u16* spf = (u16*)(p.ws + WS_SP16); u16* spb = spf + (size_t)512 * 16384;
  const int gtid = blockIdx.x * NTHR + tidx(), gsz = gridDim.x * NTHR;
  for (int idx = gtid; idx < 32 * 4096; idx += gsz) {
    const int de = (idx & 4095) * 4, bh = idx >> 12, b = bh >> 2, h = bh & 3;
    const float Gf = expf(128.0f * log_sigmoid(p.ret_decay[h])), Gb = expf(128.0f * log_sigmoid(p.ret_decay[4 + h]));
    f32x4 s = {0.f, 0.f, 0.f, 0.f};
    for (int n = 0; n < 16; ++n) {
      const size_t o = ((size_t)((b * 16 + n) * 4 + h)) * 16384 + de;
      const uint2 tw = *(const uint2*)(incf + o); const f32x4 t = {lo16(tw.x), hi16(tw.x), lo16(tw.y), hi16(tw.y)};
      uint2 w; w.x = pk2(s[0], s[1]); w.y = pk2(s[2], s[3]); *(uint2*)(spf + o) = w;
      s = s * Gf + t;
    }
    s = (f32x4){0.f, 0.f, 0.f, 0.f};
    for (int n = 15; n >= 0; --n) {
      const size_t o = ((size_t)((b * 16 + n) * 4 + h)) * 16384 + de;
      const uint2 tw = *(const uint2*)(incb + o); const f32x4 t = {lo16(tw.x), hi16(tw.x), lo16(tw.y), hi16(tw.y)};
      uint2 w; w.x = pk2(s[0], s[1]); w.y = pk2(s[2], s[3]); *(uint2*)(spb + o) = w;
      s = s * Gb + t;
    }
  }
}
__device__ __forceinline__ void phase_ret_out_mfma(const P& p, char* smem) {
  u16* R0 = (u16*)smem; u16* R1 = R0 + 128 * RSTR; u16* R2 = R1 + 128 * RSTR; u16* R3 = R2 + 128 * RSTR;
  float* sPf = (float*)(R3 + 128 * RSTR); float* sPb = sPf + 132;
  const u16* zb = (const u16*)(p.ws + WS_Z);
  const u16* qb = zb; const u16* kb = zb + (size_t)1 * T_TOK * 512; const u16* vb = zb + (size_t)2 * T_TOK * 512; const u16* gb = zb + (size_t)3 * T_TOK * 512;
  const u16* spf = (const u16*)(p.ws + WS_SP16); const u16* spb = spf + (size_t)512 * 16384;
  u16* ycat = (u16*)(p.ws + WS_YCAT);
  const int tid = tidx(), lane = tid & 63, wv = tid >> 6, wr = wv >> 1, wc = wv & 1, fr = lane & 15, fq = lane >> 4;
  int it_first, it_count, it_stride; ret_items(128, it_first, it_count, it_stride);
  for (int ii = 0; ii < it_count; ++ii) {
    const int item = it_first + ii * it_stride;
    const int h = item & 3, bn = item >> 2, t0 = bn * 128;
    const float lgf = log_sigmoid(p.ret_decay[h]), lgb = log_sigmoid(p.ret_decay[4 + h]);
    const u16* spT = spf + (size_t)item * 16384; const u16* snT = spb + (size_t)item * 16384;
    const int pe = tid >> 4, pch = (tid & 15) * 8;
    const uint4 pp0 = *(const uint4*)(spT + (pe + 0) * 128 + pch), pp1 = *(const uint4*)(spT + (pe + 32) * 128 + pch), pp2 = *(const uint4*)(spT + (pe + 64) * 128 + pch), pp3 = *(const uint4*)(spT + (pe + 96) * 128 + pch);
    __syncthreads();
    ret_load_tile(R0, nullptr, qb, t0, h, nullptr, nullptr);
    ret_load_tile(R1, nullptr, kb, t0, h, nullptr, nullptr);
    ret_load_tile(R2, nullptr, vb, t0, h, nullptr, nullptr);
    if (tid < 129) { sPf[tid] = expf(lgf * (float)tid); sPb[tid] = expf(lgb * (float)tid); }
    __syncthreads();
    {
      f32x4 acc[2][4];
#pragma unroll
      for (int m = 0; m < 2; ++m)
#pragma unroll
        for (int n = 0; n < 4; ++n) acc[m][n] = (f32x4){0.f, 0.f, 0.f, 0.f};
      lds_mma<2, 4, false, false>(acc, R0, RSTR, wr * 32, R1, RSTR, wc * 64, 128, lane, nullptr);
#pragma unroll
      for (int m = 0; m < 2; ++m)
#pragma unroll
        for (int n = 0; n < 4; ++n) {
          const int i = wr * 32 + m * 16 + fr, j = wc * 64 + n * 16 + 4 * fq;
          float v[4];
#pragma unroll
          for (int r = 0; r < 4; ++r) { const int jj = j + r; v[r] = acc[m][n][r] * ((i >= jj) ? sPf[i - jj] : sPb[jj - i]); }
          uint2 w; w.x = pk2(v[0], v[1]); w.y = pk2(v[2], v[3]);
          *(uint2*)(R3 + i * RSTR + j) = w;
        }
    }
    __syncthreads();
    *(uint4*)(R1 + (pe + 0) * RSTR + pch) = pp0; *(uint4*)(R1 + (pe + 32) * RSTR + pch) = pp1; *(uint4*)(R1 + (pe + 64) * RSTR + pch) = pp2; *(uint4*)(R1 + (pe + 96) * RSTR + pch) = pp3;
    const uint4 pn0 = *(const uint4*)(snT + (pe + 0) * 128 + pch), pn1 = *(const uint4*)(snT + (pe + 32) * 128 + pch), pn2 = *(const uint4*)(snT + (pe + 64) * 128 + pch), pn3 = *(const uint4*)(snT + (pe + 96) * 128 + pch);
    f32x4 o[1][8];
#pragma unroll
    for (int m = 0; m < 1; ++m)
#pragma unroll
      for (int n = 0; n < 8; ++n) o[m][n] = (f32x4){0.f, 0.f, 0.f, 0.f};
    lds_mma<1, 8, false, true>(o, R3, RSTR, wv * 16, R2, RSTR, 0, 128, lane, nullptr);
    __syncthreads();
    *(uint4*)(R2 + (pe + 0) * RSTR + pch) = pn0; *(uint4*)(R2 + (pe + 32) * RSTR + pch) = pn1; *(uint4*)(R2 + (pe + 64) * RSTR + pch) = pn2; *(uint4*)(R2 + (pe + 96) * RSTR + pch) = pn3;
    float scf[1], scb[1];
    { const int i = wv * 16 + fr; scf[0] = sPf[i + 1]; scb[0] = sPb[128 - i]; }
    lds_mma<1, 8, false, false>(o, R0, RSTR, wv * 16, R1, RSTR, 0, 128, lane, scf);
    __syncthreads();
    lds_mma<1, 8, false, false>(o, R0, RSTR, wv * 16, R2, RSTR, 0, 128, lane, scb);
#pragma unroll
    for (int m = 0; m < 1; ++m) {
      float s1 = 0.f;
#pragma unroll
      for (int n = 0; n < 8; ++n) s1 += (o[m][n][0] + o[m][n][1]) + (o[m][n][2] + o[m][n][3]);
      s1 += __shfl_xor(s1, 16); s1 += __shfl_xor(s1, 32);
      const float mu = s1 * (1.0f / 128.0f);
      float s2 = 0.f;
#pragma unroll
      for (int n = 0; n < 8; ++n)
#pragma unroll
        for (int r = 0; r < 4; ++r) { const float dl = o[m][n][r] - mu; s2 += dl * dl; }
      s2 += __shfl_xor(s2, 16); s2 += __shfl_xor(s2, 32);
      const float rs = rsqrtf(s2 * (1.0f / 128.0f) + 1e-5f);
      const size_t tok = (size_t)(t0 + wv * 16 + m * 16 + fr);
#pragma unroll
      for (int n = 0; n < 8; ++n) {
        const int e = n * 16 + 4 * fq;
        const uint2 gq = *(const uint2*)(gb + tok * 512 + h * 128 + e);
        const float g0 = lo16(gq.x), g1 = hi16(gq.x), g2 = lo16(gq.y), g3 = hi16(gq.y);
        uint2 w;
        w.x = pk2(g0 * sigmoidf_(g0) * (o[m][n][0] - mu) * rs, g1 * sigmoidf_(g1) * (o[m][n][1] - mu) * rs);
        w.y = pk2(g2 * sigmoidf_(g2) * (o[m][n][2] - mu) * rs, g3 * sigmoidf_(g3) * (o[m][n][3] - mu) * rs);
        *(uint2*)(ycat + tok * DM + h * 128 + e) = w;
      }
    }
  }
}

struct Cpx { float re, im; };
__device__ __forceinline__ Cpx cmul(Cpx a, Cpx b) { return {a.re * b.re - a.im * b.im, a.re * b.im + a.im * b.re}; }
__device__ __forceinline__ Cpx s5_lam(const P& p, int g, int dir, int l, int q) { const f32x2 v = ((const f32x2*)(p.ws + WS_LAMT))[((g * 2 + dir) * 33 + l) * 64 + q]; return {v[0], v[1]}; }
__device__ __forceinline__ Cpx s5_cf(const P& p, int g, int dir, int q) { const f32x2 v = ((const f32x2*)(p.ws + WS_LAMT + 3 * MB / 2))[(g * 2 + dir) * 64 + q]; return {v[0], v[1]}; }
__device__ __forceinline__ bool s5_setup_ids(int& gtid, int& gsz) {
  const bool half = (gridDim.x == 256);
  if (half && blockIdx.x < 128) return false;
  gtid = (half ? (int)blockIdx.x - 128 : (int)blockIdx.x) * NTHR + tidx(); gsz = (half ? 128 : (int)gridDim.x) * NTHR;
  return true;
}
__device__ __forceinline__ void phase_s5_ktab(const P& p) {
  float* ktab = (float*)(p.ws + WS_KTAB);
  int gtid, gsz; if (!s5_setup_ids(gtid, gsz)) return;
  for (int item = gtid; item < 32 * 2 * 32 * 16; item += gsz) {
    const int c = item & 15, l = (item >> 4) & 31, dir = (item >> 9) & 1, g = item >> 10;
    float acc[16];
#pragma unroll
    for (int j = 0; j < 16; ++j) acc[j] = 0.f;
    for (int q = 0; q < 64; ++q) {
      const Cpx L = s5_lam(p, g, dir, l, q), cf = s5_cf(p, g, dir, q);
      const Cpx C = {p.c_re[((dir * 32 + g) * 16 + c) * 64 + q], p.c_im[((dir * 32 + g) * 16 + c) * 64 + q]};
      const Cpx w = cmul(cmul(C, L), cf);
#pragma unroll
      for (int j = 0; j < 16; ++j) acc[j] += w.re * p.b_re[(g * 64 + q) * 16 + j] - w.im * p.b_im[(g * 64 + q) * 16 + j];
    }
#pragma unroll
    for (int j = 0; j < 16; j += 4) *(f32x4*)(ktab + (size_t)item * 16 + j) = (f32x4){acc[j], acc[j + 1], acc[j + 2], acc[j + 3]};
  }
}
__device__ __forceinline__ void phase_s5_fill_a(const P& p) {
  const float* ktab = (const float*)(p.ws + WS_KTAB);
  u16* bty = (u16*)(p.ws + WS_BTY);
  const int gtid = blockIdx.x * NTHR + tidx(), gsz = gridDim.x * NTHR;
  for (int item = gtid; item < 32 * 512 * 64; item += gsz) {
    const int ch = item & 63, n = (item >> 6) & 511, g = item >> 15;
    const int ip = ch >> 1, c0 = (ch & 1) * 8, i = n >> 4, c = n & 15;
    float v[8];
    if (ip != i) {
      const int dir = ip < i ? 0 : 1, l = ip < i ? i - ip : ip - i;
      const float* src = ktab + ((size_t)((g * 2 + dir) * 32 + l) * 16 + c) * 16 + c0;
      const f32x4 a = *(const f32x4*)src, b = *(const f32x4*)(src + 4);
      v[0] = a[0]; v[1] = a[1]; v[2] = a[2]; v[3] = a[3]; v[4] = b[0]; v[5] = b[1]; v[6] = b[2]; v[7] = b[3];
    } else {
      const float* s0 = ktab + ((size_t)((g * 2 + 0) * 32) * 16 + c) * 16 + c0;
      const float* s1 = ktab + ((size_t)((g * 2 + 1) * 32) * 16 + c) * 16 + c0;
      const float dd = p.s5d[g * 16 + c];
#pragma unroll
      for (int j = 0; j < 8; ++j) v[j] = s0[j] + s1[j] + ((c0 + j) == c ? dd : 0.f);
    }
    *(uint4*)(bty + ((size_t)g * 512 + n) * 768 + ch * 8) = make_uint4(pk2(v[0], v[1]), pk2(v[2], v[3]), pk2(v[4], v[5]), pk2(v[6], v[7]));
  }
}
__device__ __forceinline__ void phase_s5_fill_bc(const P& p) {
  u16* bty = (u16*)(p.ws + WS_BTY); u16* wet = (u16*)(p.ws + WS_WET);
  int gtid, gsz; if (!s5_setup_ids(gtid, gsz)) return;
  for (int item = gtid; item < 32 * 512 * 32; item += gsz) {
    const int ch = item & 31, n = (item >> 5) & 511, g = item >> 14;
    const int kk = ch * 8, dir = kk >> 7, p0 = (kk & 127) >> 1, i = n >> 4, c = n & 15;
    const int e = dir ? (32 - i) : (i + 1);
    float v[8];
#pragma unroll
    for (int q = 0; q < 4; ++q) {
      const int pq = p0 + q;
      const Cpx L = s5_lam(p, g, dir, e, pq);
      const Cpx C = {p.c_re[((dir * 32 + g) * 16 + c) * 64 + pq], p.c_im[((dir * 32 + g) * 16 + c) * 64 + pq]};
      const Cpx w = cmul(C, L);
      v[2 * q] = w.re; v[2 * q + 1] = -w.im;
    }
    *(uint4*)(bty + ((size_t)g * 512 + n) * 768 + 512 + kk) = make_uint4(pk2(v[0], v[1]), pk2(v[2], v[3]), pk2(v[4], v[5]), pk2(v[6], v[7]));
  }
  for (int item = gtid; item < 32 * 256 * 64; item += gsz) {
    const int ch = item & 63, n = (item >> 6) & 255, g = item >> 14;
    const int ip = ch >> 1, c0 = (ch & 1) * 8, ri = n & 1, pq = (n >> 1) & 63, dir = n >> 7;
    const int e = dir ? ip : (31 - ip);
    const Cpx w = cmul(s5_lam(p, g, dir, e, pq), s5_cf(p, g, dir, pq));
    float v[8];
#pragma unroll
    for (int j = 0; j < 8; ++j) {
      const float br = p.b_re[(g * 64 + pq) * 16 + c0 + j], bi = p.b_im[(g * 64 + pq) * 16 + c0 + j];
      v[j] = ri ? (w.re * bi + w.im * br) : (w.re * br - w.im * bi);
    }
    *(uint4*)(wet + ((size_t)g * 256 + n) * 512 + ch * 8) = make_uint4(pk2(v[0], v[1]), pk2(v[2], v[3]), pk2(v[4], v[5]), pk2(v[6], v[7]));
  }
}
__device__ __forceinline__ void phase_s5_carry(const P& p) {
  const float* E = (const float*)(p.ws + WS_E);
  u16* a2 = (u16*)(p.ws + WS_A2);
  const int gtid = blockIdx.x * NTHR + tidx(), gsz = gridDim.x * NTHR;
  for (int idx = gtid; idx < 32 * 8 * 128; idx += gsz) {
    const int pq = idx & 63, dir = (idx >> 6) & 1, b = (idx >> 7) & 7, g = idx >> 10;
    const Cpx L = s5_lam(p, g, dir, 32, pq);
    Cpx s = {0.f, 0.f};
    for (int jj = 0; jj < 64; ++jj) {
      const int j = dir ? 63 - jj : jj, r = b * 64 + j;
      const f32x2 e = *(const f32x2*)(E + ((size_t)g * 512 + r) * 256 + (dir * 64 + pq) * 2);
      *(unsigned*)(a2 + ((size_t)g * 512 + r) * 768 + 512 + (dir * 64 + pq) * 2) = pk2(s.re, s.im);
      const Cpx ns = cmul(L, s);
      s.re = ns.re + e[0]; s.im = ns.im + e[1];
    }
  }
}
constexpr int KSTR = 72;
__device__ __forceinline__ int t5_bucket_abs(int n) {
  return n < 8 ? n : 8 + (n >= 12) + (n >= 16) + (n >= 23) + (n >= 32) + (n >= 46) + (n >= 64) + (n >= 91);
}
__device__ __forceinline__ void phase_attn(const P& p, char* smem) {
  u16* sK = (u16*)smem; u16* sV = sK + 384 * KSTR; float* sBias = (float*)(sV + 384 * KSTR);
  const u16* q1 = (const u16*)(p.ws + WS_Z); const u16* k1 = (const u16*)(p.ws + WS_Z + 32 * MB); const u16* v1 = (const u16*)(p.ws + WS_Z + 40 * MB);
  u16* ao = (u16*)(p.ws + WS_YCAT);
  const int tid = tidx(), lane = tid & 63, wv = tid >> 6, fr = lane & 15, lg = lane >> 4, q0 = (wv & 3) * 32, hp = wv >> 2;
  const int tq = (lane & 15) >> 2, tp = lane & 3;
  for (int item = blockIdx.x; item < 512; item += gridDim.x) {
    const int b = item >> 6, nb = (item >> 2) & 15, kvh = item & 3;
    __syncthreads();
    for (int c = tid; c < 384 * 8; c += NTHR) {
      const int s = c >> 3, ch = (c & 7) * 8, pos = (nb - 1) * 128 + s;
      uint4 kq = make_uint4(0u, 0u, 0u, 0u), vq = kq;
      if (pos >= 0 && pos < SEQ) { kq = *(const uint4*)(k1 + (size_t)(b * SEQ + pos) * 256 + kvh * 64 + ch); vq = *(const uint4*)(v1 + (size_t)(b * SEQ + pos) * 256 + kvh * 64 + ch); }
      *(uint4*)(sK + s * KSTR + ch) = kq; *(uint4*)(sV + s * KSTR + ch) = vq;
    }
    for (int c = tid; c < 4 * 512; c += NTHR) {
      const int hq = c >> 9, ri = (c & 511) - 128, rel = ri - 128, n = rel < 0 ? -rel : rel;
      const int bucket = (rel > 0 ? 16 : 0) + t5_bucket_abs(n < 128 ? n : 128);
      sBias[c] = (ri >= 0 && ri <= 256) ? 1.4426950408889634f * p.rel_bias[bucket * 16 + kvh * 4 + hq] : -1e30f;
    }
    __syncthreads();
#pragma unroll 1
    for (int hh = 0; hh < 2; ++hh) {
      const int hq = hp * 2 + hh, head = kvh * 4 + hq;
      const size_t tok0 = (size_t)b * SEQ + nb * 128 + q0;
      uint4 qf[2][2];
#pragma unroll
      for (int qb = 0; qb < 2; ++qb)
#pragma unroll
        for (int ks = 0; ks < 2; ++ks) qf[qb][ks] = *(const uint4*)(q1 + (tok0 + qb * 16 + fr) * DM + head * 64 + ks * 32 + lg * 8);
      f32x4 O[4][2];
#pragma unroll
      for (int mb = 0; mb < 4; ++mb)
#pragma unroll
        for (int qb = 0; qb < 2; ++qb) O[mb][qb] = (f32x4){0.f, 0.f, 0.f, 0.f};
      const float sinkv = 1.4426950408889634f * p.sink[head];
      float mrun[2] = {sinkv, sinkv}, lpart[2] = {lg == 0 ? 1.0f : 0.0f, lg == 0 ? 1.0f : 0.0f};
      const float* bias = sBias + hq * 512 + 128 - (q0 + fr) + 4 * lg;
#pragma unroll
      for (int c = 0; c < 3; ++c) {
        if ((c == 0 && nb == 0) || (c == 2 && nb == 15)) continue;
        f32x4 S[8][2];
#pragma unroll
        for (int kb = 0; kb < 8; ++kb) {
          S[kb][0] = (f32x4){0.f, 0.f, 0.f, 0.f}; S[kb][1] = S[kb][0];
          const bool act = (c == 0) ? (16 * kb + 15 >= q0) : ((c == 2) ? (16 * kb <= q0 + 31) : true);
          if (act) {
#pragma unroll
            for (int qb = 0; qb < 2; ++qb)
#pragma unroll
              for (int r = 0; r < 4; ++r) S[kb][qb][r] = bias[c * 128 + kb * 16 + r - qb * 16];
#pragma unroll
            for (int ks = 0; ks < 2; ++ks) {
              const uint4 kf = *(const uint4*)(sK + (c * 128 + kb * 16 + fr) * KSTR + ks * 32 + lg * 8);
              S[kb][0] = mfma16(kf, qf[0][ks], S[kb][0]);
              S[kb][1] = mfma16(kf, qf[1][ks], S[kb][1]);
            }
          }
        }
        float cmax[2] = {-1e30f, -1e30f};
#pragma unroll
        for (int kb = 0; kb < 8; ++kb) {
          const bool act = (c == 0) ? (16 * kb + 15 >= q0) : ((c == 2) ? (16 * kb <= q0 + 31) : true);
          if (act) {
#pragma unroll
            for (int qb = 0; qb < 2; ++qb)
#pragma unroll
              for (int r = 0; r < 4; ++r) cmax[qb] = fmaxf(cmax[qb], S[kb][qb][r]);
          }
        }
#pragma unroll
        for (int qb = 0; qb < 2; ++qb) {
          cmax[qb] = fmaxf(cmax[qb], __shfl_xor(cmax[qb], 16)); cmax[qb] = fmaxf(cmax[qb], __shfl_xor(cmax[qb], 32));
          const float mn = fmaxf(mrun[qb], cmax[qb]), alpha = __builtin_amdgcn_exp2f(mrun[qb] - mn);
          mrun[qb] = mn; lpart[qb] *= alpha;
#pragma unroll
          for (int mb = 0; mb < 4; ++mb) O[mb][qb] = O[mb][qb] * alpha;
          float ps = 0.f;
#pragma unroll
          for (int kb = 0; kb < 8; ++kb) {
            const bool act = (c == 0) ? (16 * kb + 15 >= q0) : ((c == 2) ? (16 * kb <= q0 + 31) : true);
            if (act) {
#pragma unroll
              for (int r = 0; r < 4; ++r) { const float e = __builtin_amdgcn_exp2f(S[kb][qb][r] - mn); S[kb][qb][r] = e; ps += e; }
            }
          }
          lpart[qb] += ps;
        }
#pragma unroll
        for (int kk = 0; kk < 4; ++kk) {
          const int kb0 = 2 * kk, kb1 = 2 * kk + 1;
          const bool act = (c == 0) ? (16 * kb1 + 15 >= q0) : ((c == 2) ? (16 * kb0 <= q0 + 31) : true);
          if (act) {
            uint4 pf[2];
#pragma unroll
            for (int qb = 0; qb < 2; ++qb) pf[qb] = make_uint4(pk2(S[kb0][qb][0], S[kb0][qb][1]), pk2(S[kb0][qb][2], S[kb0][qb][3]), pk2(S[kb1][qb][0], S[kb1][qb][1]), pk2(S[kb1][qb][2], S[kb1][qb][3]));
#pragma unroll
            for (int mb = 0; mb < 4; ++mb) {
              const uint2 v0 = lds_tr16(sV + (c * 128 + kb0 * 16 + 4 * lg + tq) * KSTR + mb * 16 + 4 * tp);
              const uint2 v1r = lds_tr16(sV + (c * 128 + kb1 * 16 + 4 * lg + tq) * KSTR + mb * 16 + 4 * tp);
              const uint4 vf = make_uint4(v0.x, v0.y, v1r.x, v1r.y);
              O[mb][0] = mfma16(vf, pf[0], O[mb][0]);
              O[mb][1] = mfma16(vf, pf[1], O[mb][1]);
            }
          }
        }
      }
#pragma unroll
      for (int qb = 0; qb < 2; ++qb) {
        float lt = lpart[qb]; lt += __shfl_xor(lt, 16); lt += __shfl_xor(lt, 32);
        const float inv = 1.0f / lt;
#pragma unroll
        for (int mb = 0; mb < 4; ++mb) {
          uint2 w; w.x = pk2(O[mb][qb][0] * inv, O[mb][qb][1] * inv); w.y = pk2(O[mb][qb][2] * inv, O[mb][qb][3] * inv);
          *(uint2*)(ao + (tok0 + qb * 16 + fr) * DM + head * 64 + mb * 16 + 4 * lg) = w;
        }
      }
    }
  }
}

struct EpiInproj {
  static constexpr bool PERM = true;
  u16* zb; u16* a2; const f32x2* rope;
  __device__ __forceinline__ void operator()(const f32x4 (&acc)[2][2][4][2], const pg8::Unit& u, int wr, int wc, int fr, int fq) const {
    const int seg = u.pn >> 1;
#pragma unroll
    for (int ai = 0; ai < 2; ++ai)
#pragma unroll
      for (int m = 0; m < 4; ++m) {
        const int row = u.pm * 256 + ai * 128 + wr * 64 + m * 16 + fr;
        if (seg < 2) {
          const int d = 16 * wc + 4 * fq;
          const f32x2* cs = rope + (size_t)(row & (SEQ - 1)) * 64 + d;
          const f32x4 c01 = *(const f32x4*)cs, c23 = *(const f32x4*)(cs + 2);
          const float cv[4] = {c01[0], c01[2], c23[0], c23[2]}, sv[4] = {c01[1], c01[3], c23[1], c23[3]};
          const float sc = seg == 1 ? 0.08838834764831845f : 1.0f;
#pragma unroll
          for (int bj = 0; bj < 2; ++bj) {
            const f32x4 x1 = acc[ai][bj][m][0], x2 = acc[ai][bj][m][1];
            float o1[4], o2[4];
#pragma unroll
            for (int r = 0; r < 4; ++r) { o1[r] = (x1[r] * cv[r] - x2[r] * sv[r]) * sc; o2[r] = (x1[r] * sv[r] + x2[r] * cv[r]) * sc; }
            u16* dst = zb + (size_t)seg * T_TOK * 512 + (size_t)row * 512 + ((u.pn & 1) * 2 + bj) * 128 + d;
            uint2 w; w.x = pk2(o1[0], o1[1]); w.y = pk2(o1[2], o1[3]); *(uint2*)dst = w;
            w.x = pk2(o2[0], o2[1]); w.y = pk2(o2[2], o2[3]); *(uint2*)(dst + 64) = w;
          }
        } else {
#pragma unroll
          for (int bj = 0; bj < 2; ++bj) {
            const int col = u.pn * 256 + bj * 128 + wc * 32 + 8 * fq;
            const f32x4 v0 = acc[ai][bj][m][0], v1 = acc[ai][bj][m][1];
            uint4 w; w.x = pk2(v0[0], v0[1]); w.y = pk2(v0[2], v0[3]); w.z = pk2(v1[0], v1[1]); w.w = pk2(v1[2], v1[3]);
            if (seg < 4) *(uint4*)(zb + (size_t)seg * T_TOK * 512 + (size_t)row * 512 + (col - seg * 512)) = w;
            else { const int ch = col - 2048, gi = ch >> 4, c = ch & 15; *(uint4*)(a2 + ((size_t)gi * 512 + (row >> 5)) * 768 + (row & 31) * 16 + c) = w; }
          }
        }
      }
  }
};
__device__ __forceinline__ void phase_inproj(const P& p, LAS unsigned char* lds) {
  pg8::DenseOrder S; S.init(p.ws + WS_XB, DM, p.ws + WS_WIN, T_TOK, 2560, DM);
  EpiInproj E{(u16*)(p.ws + WS_Z), (u16*)(p.ws + WS_A2), (const f32x2*)(p.ws + WS_ROPE)};
  pg8::gemm_phase<EpiInproj, pg8::DenseOrder, G_ALIGN, G_SP2>(lds, DM, S, E);
}
struct EpiS5E {
  static constexpr bool PERM = false;
  float* E_;
  __device__ __forceinline__ void operator()(const f32x4 (&acc)[2][2][4][2], const pg8::Unit& u, int wr, int wc, int fr, int fq) const {
#pragma unroll
    for (int ai = 0; ai < 2; ++ai)
#pragma unroll
      for (int m = 0; m < 4; ++m) {
        const int row = u.pm * 256 + ai * 128 + wr * 64 + m * 16 + fr;
#pragma unroll
        for (int bj = 0; bj < 2; ++bj)
#pragma unroll
          for (int n = 0; n < 2; ++n) *(f32x4*)(E_ + ((size_t)u.e * 512 + row) * 256 + bj * 128 + wc * 32 + n * 16 + 4 * fq) = acc[ai][bj][m][n];
      }
  }
};
__device__ __forceinline__ void phase_s5_egemm(const P& p, LAS unsigned char* lds) {
  pg8::GroupOrder S; S.init(p.ws + WS_A2, 768, (size_t)512 * 768, p.ws + WS_WET, (size_t)256 * 512, 32, 512, 256, 512);
  EpiS5E E{(float*)(p.ws + WS_E)};
  pg8::gemm_phase<EpiS5E, pg8::GroupOrder, G_ALIGN, G_SP2>(lds, 512, S, E);
}
struct EpiS5Y {
  static constexpr bool PERM = true;
  u16* yg;
  __device__ __forceinline__ void operator()(const f32x4 (&acc)[2][2][4][2], const pg8::Unit& u, int wr, int wc, int fr, int fq) const {
#pragma unroll
    for (int ai = 0; ai < 2; ++ai)
#pragma unroll
      for (int m = 0; m < 4; ++m) {
        const int row = u.pm * 256 + ai * 128 + wr * 64 + m * 16 + fr;
#pragma unroll
        for (int bj = 0; bj < 2; ++bj) {
          const int col = u.pn * 256 + bj * 128 + wc * 32 + 8 * fq;
          const f32x4 v0 = acc[ai][bj][m][0], v1 = acc[ai][bj][m][1];
          uint4 w; w.x = pk2(gelu_tanh(v0[0]), gelu_tanh(v0[1])); w.y = pk2(gelu_tanh(v0[2]), gelu_tanh(v0[3])); w.z = pk2(gelu_tanh(v1[0]), gelu_tanh(v1[1])); w.w = pk2(gelu_tanh(v1[2]), gelu_tanh(v1[3]));
          *(uint4*)(yg + ((size_t)row * 32 + (col >> 4)) * 512 + u.e * 16 + (col & 15)) = w;
        }
      }
  }
};
__device__ __forceinline__ void phase_s5_ygemm(const P& p, LAS unsigned char* lds) {
  pg8::GroupOrder S; S.init(p.ws + WS_A2, 768, (size_t)512 * 768, p.ws + WS_BTY, (size_t)512 * 768, 32, 512, 512, 768);
  EpiS5Y E{(u16*)(p.ws + WS_YGELU)};
  pg8::gemm_phase<EpiS5Y, pg8::GroupOrder, G_ALIGN, G_SP2>(lds, 768, S, E);
}
struct EpiGlu {
  static constexpr bool PERM = true;
  const u16* yg; const float* bglu; u16* ycat;
  __device__ __forceinline__ void operator()(const f32x4 (&acc)[2][2][4][2], const pg8::Unit& u, int wr, int wc, int fr, int fq) const {
#pragma unroll
    for (int ai = 0; ai < 2; ++ai)
#pragma unroll
      for (int m = 0; m < 4; ++m) {
        const int row = u.pm * 256 + ai * 128 + wr * 64 + m * 16 + fr;
#pragma unroll
        for (int bj = 0; bj < 2; ++bj) {
          const int col = u.pn * 256 + bj * 128 + wc * 32 + 8 * fq;
          const f32x4 v0 = acc[ai][bj][m][0], v1 = acc[ai][bj][m][1];
          const uint4 yv = *(const uint4*)(yg + (size_t)row * 512 + col);
          const f32x4 b0 = *(const f32x4*)(bglu + col), b1 = *(const f32x4*)(bglu + col + 4);
          uint4 w;
          w.x = pk2(lo16(yv.x) * sigmoidf_(v0[0] + b0[0]), hi16(yv.x) * sigmoidf_(v0[1] + b0[1]));
          w.y = pk2(lo16(yv.y) * sigmoidf_(v0[2] + b0[2]), hi16(yv.y) * sigmoidf_(v0[3] + b0[3]));
          w.z = pk2(lo16(yv.z) * sigmoidf_(v1[0] + b1[0]), hi16(yv.z) * sigmoidf_(v1[1] + b1[1]));
          w.w = pk2(lo16(yv.w) * sigmoidf_(v1[2] + b1[2]), hi16(yv.w) * sigmoidf_(v1[3] + b1[3]));
          *(uint4*)(ycat + (size_t)row * DM + 512 + col) = w;
        }
      }
  }
};
__device__ __forceinline__ void phase_glu(const P& p, LAS unsigned char* lds) {
  pg8::DenseOrder S; S.init(p.ws + WS_YGELU, 512, p.ws + WS_WGLU, T_TOK, 512, 512);
  EpiGlu E{(const u16*)(p.ws + WS_YGELU), p.b_glu, (u16*)(p.ws + WS_YCAT)};
  pg8::gemm_phase<EpiGlu, pg8::DenseOrder, G_ALIGN, G_SP2>(lds, 512, S, E);
}
struct EpiResid {
  static constexpr bool PERM = false;
  const float* xin; float* xout;
  __device__ __forceinline__ void operator()(const f32x4 (&acc)[2][2][4][2], const pg8::Unit& u, int wr, int wc, int fr, int fq) const {
#pragma unroll
    for (int ai = 0; ai < 2; ++ai)
#pragma unroll
      for (int m = 0; m < 4; ++m) {
        const int row = u.pm * 256 + ai * 128 + wr * 64 + m * 16 + fr;
#pragma unroll
        for (int bj = 0; bj < 2; ++bj)
#pragma unroll
          for (int n = 0; n < 2; ++n) {
            const size_t o = (size_t)row * DM + u.pn * 256 + bj * 128 + wc * 32 + n * 16 + 4 * fq;
            const f32x4 xv = *(const f32x4*)(xin + o);
            *(f32x4*)(xout + o) = xv + acc[ai][bj][m][n];
          }
      }
  }
};
__device__ __forceinline__ void phase_outproj(const P& p, const void* Wt, const float* xin, float* xout, LAS unsigned char* lds) {
  pg8::DenseOrder S; S.init(p.ws + WS_YCAT, DM, Wt, T_TOK, DM, DM);
  EpiResid E{xin, xout};
  pg8::gemm_phase<EpiResid, pg8::DenseOrder, G_ALIGN, G_SP2>(lds, DM, S, E);
}
struct EpiQkv {
  static constexpr bool PERM = true;
  u16 *q1, *k1, *v1;
  __device__ __forceinline__ void operator()(const f32x4 (&acc)[2][2][4][2], const pg8::Unit& u, int wr, int wc, int fr, int fq) const {
    const float sc = u.pn < 4 ? 0.18033688011112042f : 1.0f;
#pragma unroll
    for (int ai = 0; ai < 2; ++ai)
#pragma unroll
      for (int m = 0; m < 4; ++m) {
        const int row = u.pm * 256 + ai * 128 + wr * 64 + m * 16 + fr;
#pragma unroll
        for (int bj = 0; bj < 2; ++bj) {
          const int col = u.pn * 256 + bj * 128 + wc * 32 + 8 * fq;
          const f32x4 a0 = acc[ai][bj][m][0] * sc, a1 = acc[ai][bj][m][1] * sc;
          uint4 w; w.x = pk2(a0[0], a0[1]); w.y = pk2(a0[2], a0[3]); w.z = pk2(a1[0], a1[1]); w.w = pk2(a1[2], a1[3]);
          if (u.pn < 4) *(uint4*)(q1 + (size_t)row * DM + col) = w;
          else if (u.pn == 4) *(uint4*)(k1 + (size_t)row * 256 + (col - 1024)) = w;
          else *(uint4*)(v1 + (size_t)row * 256 + (col - 1280)) = w;
        }
      }
  }
};
__device__ __forceinline__ void phase_qkv(const P& p, LAS unsigned char* lds) {
  pg8::DenseOrder S; S.init(p.ws + WS_XB, DM, p.ws + WS_WQKV, T_TOK, 1536, DM);
  EpiQkv E{(u16*)(p.ws + WS_Z), (u16*)(p.ws + WS_Z + 32 * MB), (u16*)(p.ws + WS_Z + 40 * MB)};
  pg8::gemm_phase<EpiQkv, pg8::DenseOrder, G_ALIGN, G_SP2>(lds, DM, S, E);
}
__device__ __forceinline__ void phase_moe_plan(const P& p, int layer, char* smem) {
  if (blockIdx.x != 0) return;
  using pg8::PLAN_STRIDE;
  const int tid = tidx();
  const int* cnt = (const int*)(p.ws + WS_CNT) + layer * 32 * CNT_STRIDE;
  int* plan_n = (int*)(p.ws + WS_PLAN + layer * 65536); int4* plan = (int4*)(p.ws + WS_PLAN + layer * 65536 + 256);
  int* sc = (int*)smem;
  int* ecum = sc + 32; int* ebase = ecum + 32; int* ehb = ebase + 32; int* efull = ehb + 32; int* tot = efull + 32;
  int* sstart = tot + 8; int* sfstart = sstart + 8; int* cntF = sfstart + 8; int* cntR = cntF + 8;
  unsigned* keyR = (unsigned*)(cntR + 8);
  constexpr int NN = 4;
  __syncthreads();
  if (tid < 32) sc[tid] = cnt[tid * CNT_STRIDE];
  if (tid < 8) { sstart[tid] = 0x7fffffff; sfstart[tid] = 0; cntF[tid] = 0; cntR[tid] = 0; }
  if (tid < 128) keyR[tid] = 0xffffffffu;
  __syncthreads();
  if (tid == 0) {
    int cum = 0, ub = 0, hb = 0, fb = 0;
    for (int e = 0; e < 32; ++e) {
      const int c = sc[e], fl = c >> 8, rem = c & 255, rc = (rem + 63) >> 6, ntl = fl + (rem ? 1 : 0);
      ecum[e] = cum; ebase[e] = ub; ehb[e] = hb; efull[e] = fb;
      cum += (fl * 4 + rc) * NN; ub += ntl * NN; hb += ntl * 256; fb += fl * NN;
    }
    tot[0] = cum > 0 ? cum : 1; tot[1] = ub;
  }
  __syncthreads();
  const int total = tot[0], nunits = tot[1] < 1024 ? tot[1] : 1024;
  int4 en[2]; int ux[2], uF[2]; unsigned ukr[2]; bool ufull[2], uval[2];
#pragma unroll
  for (int q = 0; q < 2; ++q) {
    const int u = tid + q * NTHR;
    uval[q] = u < nunits; ux[q] = 0; uF[q] = 0; ukr[q] = 0; ufull[q] = true; en[q] = make_int4(0, 0, 0, 0);
    if (uval[q]) {
      int e = 0;
      for (int j = 1; j < 32; ++j) if (ebase[j] <= u) e = j;
      const int c = sc[e], fl = c >> 8, rem = c & 255, rc = (rem + 63) >> 6, ntl = fl + (rem ? 1 : 0);
      const int local = u - ebase[e], ct = local / ntl, rt = local - ct * ntl;
      const int cum = ecum[e] + ct * (fl * 4 + rc) + rt * 4;
      const bool isfull = rt < fl;
      int x = (cum * 8) / total; if (x > 7) x = 7;
      ux[q] = x; ufull[q] = isfull; uF[q] = efull[e] + ct * fl + (rt < fl ? rt : fl);
      en[q] = make_int4(e | (rt << 8) | (ct << 16), c, ehb[e], 0);
      atomicMin(&sstart[x], u);
      if (isfull) atomicAdd(&cntF[x], 1);
      else { atomicAdd(&cntR[x], 1); ukr[q] = ((unsigned)x << 16) | ((unsigned)(4 - rc) << 12) | (unsigned)(e * NN + ct); keyR[e * NN + ct] = ukr[q]; }
    }
  }
  __syncthreads();
#pragma unroll
  for (int q = 0; q < 2; ++q) if (uval[q] && (tid + q * NTHR) == sstart[ux[q]]) sfstart[ux[q]] = uF[q];
  __syncthreads();
#pragma unroll
  for (int q = 0; q < 2; ++q) {
    if (uval[q]) {
      const int x = ux[q];
      int pos;
      if (ufull[q]) pos = uF[q] - sfstart[x];
      else { pos = cntF[x]; for (int v = 0; v < 128; ++v) { const unsigned kv = keyR[v]; pos += ((kv >> 16) == (unsigned)x && kv < ukr[q]) ? 1 : 0; } }
      if (pos < PLAN_STRIDE) plan[x * PLAN_STRIDE + pos] = en[q];
    }
  }
  if (tid < 8) { const int n = cntF[tid] + cntR[tid]; plan_n[tid] = n < PLAN_STRIDE ? n : PLAN_STRIDE; }
  __syncthreads();
}
struct EpiMoe1 {
  static constexpr bool PERM = false;
  u16* hbuf;
  __device__ __forceinline__ void operator()(const f32x4 (&acc)[2][2][4][2], const pg8::Unit& u, int wr, int wc, int fr, int fq) const {
#pragma unroll
    for (int ai = 0; ai < 2; ++ai)
#pragma unroll
      for (int m = 0; m < 4; ++m) {
        const int row = u.pm * 256 + ai * 128 + wr * 64 + m * 16 + fr;
        if (row < u.cnt) {
#pragma unroll
          for (int bj = 0; bj < 2; ++bj) {
            const f32x4 g = acc[ai][bj][m][0], up = acc[ai][bj][m][1];
            uint2 w; w.x = pk2(g[0] * sigmoidf_(g[0]) * up[0], g[1] * sigmoidf_(g[1]) * up[1]); w.y = pk2(g[2] * sigmoidf_(g[2]) * up[2], g[3] * sigmoidf_(g[3]) * up[3]);
            *(uint2*)(hbuf + (size_t)(u.hbase + row) * 512 + 16 * (8 * u.pn + 4 * bj + wc) + 4 * fq) = w;
          }
        }
      }
  }
};
__device__ __forceinline__ void phase_moe1(const P& p, int layer, LAS unsigned char* lds) {
  pg8::PlanOrder S; S.init(p.ws + WS_PLAN + layer * 65536, (const int2*)(p.ws + WS_LIST2), p.ws + WS_XB, DM, p.ws + (layer ? WS_MW1 : WS_MW0), (size_t)DM * DM, DM, true);
  EpiMoe1 E{(u16*)(p.ws + WS_H)};
  pg8::gemm_phase<EpiMoe1, pg8::PlanOrder, G_ALIGN, G_SP2>(lds, DM, S, E);
}
struct EpiMoe2 {
  static constexpr bool PERM = true;
  const int2* list; u16* slots;
  __device__ __forceinline__ void operator()(const f32x4 (&acc)[2][2][4][2], const pg8::Unit& u, int wr, int wc, int fr, int fq) const {
#pragma unroll
    for (int ai = 0; ai < 2; ++ai)
#pragma unroll
      for (int m = 0; m < 4; ++m) {
        const int row = u.pm * 256 + ai * 128 + wr * 64 + m * 16 + fr;
        if (row < u.cnt) {
          const int2 en = list[(size_t)u.e * CAP + row];
          const int asg = en.x; const float gt = __int_as_float(en.y);
#pragma unroll
          for (int bj = 0; bj < 2; ++bj) {
            const f32x4 v0 = acc[ai][bj][m][0] * gt, v1 = acc[ai][bj][m][1] * gt;
            uint4 w; w.x = pk2(v0[0], v0[1]); w.y = pk2(v0[2], v0[3]); w.z = pk2(v1[0], v1[1]); w.w = pk2(v1[2], v1[3]);
            *(uint4*)(slots + (size_t)asg * DM + u.pn * 256 + bj * 128 + wc * 32 + 8 * fq) = w;
          }
        }
      }
  }
};
__device__ __forceinline__ void phase_moe2(const P& p, int layer, LAS unsigned char* lds) {
  pg8::PlanOrder S; S.init(p.ws + WS_PLAN + layer * 65536, (const int2*)(p.ws + WS_LIST2), p.ws + WS_H, 512, p.ws + (layer ? WS_MW1 : WS_MW0) + 64 * MB, (size_t)DM * 512, 512, false);
  EpiMoe2 E{(const int2*)(p.ws + WS_LIST2), (u16*)(p.ws + WS_INC)};
  pg8::gemm_phase<EpiMoe2, pg8::PlanOrder, G_ALIGN, G_SP2>(lds, 512, S, E);
}

#define XB_TMO      128
#define XB_XCNT(j)  (256  + 64 * (j))
#define XB_XSUB(j)  (1280 + 64 * (j))
#define XB_XGEN(j)  (2304 + 64 * (j))
#define XB_TOP      3328
#define XB_TOPGEN   3392
#define XCD_BAR_WORDS 3456
#define XB_SPIN_CAP (1u << 22)
__device__ __forceinline__ unsigned xb_ld(unsigned* p)              { return __hip_atomic_load(p, __ATOMIC_RELAXED, __HIP_MEMORY_SCOPE_AGENT); }
__device__ __forceinline__ unsigned xb_add(unsigned* p, unsigned v) { return __hip_atomic_fetch_add(p, v, __ATOMIC_RELAXED, __HIP_MEMORY_SCOPE_AGENT); }
__device__ __forceinline__ unsigned xb_xcc_id() { return (unsigned)__builtin_amdgcn_s_getreg((3 << 11) | 20) & 0xFu; }
#define XB_SPIN(cond, bar) do { unsigned _sp = 0; while (cond) { __builtin_amdgcn_s_sleep(1); \
    if ((++_sp & 255u) == 0u) { if (xb_ld(&(bar)[XB_TMO])) break; if (_sp > XB_SPIN_CAP) { atomicAdd(&(bar)[XB_TMO], 1u); break; } } } } while (0)
struct XcdBarrier { unsigned* bar; unsigned x; volatile LAS unsigned* st; };
__device__ __forceinline__ XcdBarrier xcd_barrier_post(unsigned* bar, volatile LAS unsigned* st) {
  XcdBarrier b; b.bar = bar; b.x = xb_xcc_id(); b.st = st;
  if (tidx() == 0) (void)xb_add(&bar[XB_XCNT(b.x)], 1u);
  return b;
}
__device__ __forceinline__ void xcd_barrier_complete(unsigned* bar, unsigned x, unsigned& nloc, unsigned& nx) {
  const unsigned G = gridDim.x * gridDim.y * gridDim.z;
  unsigned sum, cnt, mine, sp = 0u;
  for (;;) {
    sum = 0u; cnt = 0u; mine = 0u;
#pragma unroll
    for (unsigned j = 0; j < 16; ++j) { const unsigned c = xb_ld(&bar[XB_XCNT(j)]); sum += c; cnt += (c > 0u) ? 1u : 0u; mine = (j == x) ? c : mine; }
    if (sum == G) break;
    __builtin_amdgcn_s_sleep(1);
    if ((++sp & 255u) == 0u) { if (xb_ld(&bar[XB_TMO])) break; if (sp > XB_SPIN_CAP) { atomicAdd(&bar[XB_TMO], 1u); break; } }
  }
  nloc = mine > 0u ? mine : 1u; nx = cnt > 0u ? cnt : 1u;
}
__device__ __forceinline__ void xcd_barrier(const XcdBarrier& b) {
  asm volatile("s_waitcnt vmcnt(0)" ::: "memory");
  __syncthreads();
  if (tidx() == 0) {
    unsigned* bar = b.bar;
    __builtin_amdgcn_s_waitcnt(0);
    unsigned nloc = b.st[0], nx = b.st[1];
    if (nloc == 0u) { xcd_barrier_complete(bar, b.x, nloc, nx); b.st[0] = nloc; b.st[1] = nx; }
    const unsigned old = xb_add(&bar[XB_XSUB(b.x)], 1u);
    const unsigned gen = old / nloc;
    if (old + 1u == (gen + 1u) * nloc) {
      __builtin_amdgcn_fence(__ATOMIC_RELEASE, "agent");
      asm volatile("s_waitcnt vmcnt(0)" ::: "memory");
      const unsigned og = xb_add(&bar[XB_TOP], 1u);
      const unsigned tg = og / nx;
      if (og + 1u == (tg + 1u) * nx) xb_add(&bar[XB_TOPGEN], 1u);
      else XB_SPIN(xb_ld(&bar[XB_TOPGEN]) == tg, bar);
      __builtin_amdgcn_fence(__ATOMIC_ACQUIRE, "agent");
      xb_add(&bar[XB_XGEN(b.x)], 1u);
      asm volatile("s_waitcnt vmcnt(0)" ::: "memory");
    } else {
      XB_SPIN(xb_ld(&bar[XB_XGEN(b.x)]) == gen, bar);
      __builtin_amdgcn_fence(__ATOMIC_ACQUIRE, "agent");
      asm volatile("s_waitcnt vmcnt(0)" ::: "memory");
    }
  }
  __syncthreads();
}

constexpr int NPHASE = 20;
#ifndef C0A
#define C0A 25
#define C0B 70
#define C1A 65
#endif
constexpr int LDS_BYTES = 147456;
__device__ __forceinline__ void run_phase(const P& p, int ph, char* smem, LAS unsigned char* lds) {
  float* xa = (float*)(p.ws + WS_XA);
  const u16* slots = (const u16*)(p.ws + WS_INC);
  switch (ph) {
    case 0: phase_rowpass(p, p.x, nullptr, nullptr, p.norm_mix_g, -1, nullptr, smem); phase_prep(p); __syncthreads(); phase_conv_dense(p, smem); break;
    case 1: phase_inproj(p, lds); phase_s5_ktab(p); phase_s5_fill_bc(p); phase_conv_moe(p, 0, 0, cq(C0A), 128, 128, smem); break;
    case 2: phase_ret_inc_mfma(p, smem); __syncthreads(); phase_s5_egemm(p, lds); phase_s5_fill_a(p); break;
    case 3: phase_ret_scan16(p); phase_s5_carry(p); break;
    case 4: phase_ret_out_mfma(p, smem); __syncthreads(); phase_s5_ygemm(p, lds); break;
    case 5: phase_glu(p, lds); phase_conv_moe(p, 0, cq(C0A), cq(C0B), 128, 128, smem); break;
    case 6: phase_outproj(p, p.ws + WS_WOUT, p.x, xa, lds); break;
    case 7: phase_rowpass(p, xa, nullptr, nullptr, p.norm_ffn_g, 0, nullptr, smem); break;
    case 8: phase_moe_plan(p, 0, smem); phase_conv_moe(p, 0, cq(C0B), CONV_ITEMS, 1, 255, smem); break;
    case 9: phase_moe1(p, 0, lds); break;
    case 10: phase_moe2(p, 0, lds); break;
    case 11: phase_rowpass(p, xa, slots, xa, p.norm_mix_g + DM, -1, nullptr, smem); break;
    case 12: phase_qkv(p, lds); phase_conv_moe(p, 1, 0, cq(C1A), 128, 128, smem); break;
    case 13: phase_attn(p, smem); break;
    case 14: phase_outproj(p, p.ws + WS_WO, xa, xa, lds); break;
    case 15: phase_rowpass(p, xa, nullptr, nullptr, p.norm_ffn_g + DM, 1, nullptr, smem); break;
    case 16: phase_moe_plan(p, 1, smem); phase_conv_moe(p, 1, cq(C1A), CONV_ITEMS, 1, 255, smem); break;
    case 17: phase_moe1(p, 1, lds); break;
    case 18: phase_moe2(p, 1, lds); break;
    case 19: phase_rowpass(p, xa, slots, nullptr, p.norm_final_g, -1, p.out, smem); break;
    default: break;
  }
}

extern __shared__ __attribute__((aligned(16))) char dyn_smem[];

template <int PH> __device__ __forceinline__ void mega_steps(const P& p, char* smem, LAS unsigned char* lds, const XcdBarrier& xb) {
  run_phase(p, PH, smem, lds);
  if constexpr (PH + 1 < NPHASE) {
    xcd_barrier(xb);
    mega_steps<PH + 1>(p, smem, lds, xb);
  }
}
__global__ void __launch_bounds__(NTHR, 2) k_mega(P p) {
  LAS unsigned char* lds = (LAS unsigned char*)dyn_smem;
  volatile LAS unsigned* st = (volatile LAS unsigned*)(lds + LDS_BYTES - 16);
  if (tidx() == 0) { st[0] = 0u; st[1] = 0u; }
  __syncthreads();
  const XcdBarrier xb = xcd_barrier_post((unsigned*)(p.ws + WS_BAR), st);
  mega_steps<0>(p, dyn_smem, lds, xb);
}

extern "C" void kernel_launch(void* const* d_in, const int* in_sizes, int n_in, void* d_out, int out_size, void* d_ws, size_t ws_size, hipStream_t stream) {
  static int grid_blocks = 0;
  if (grid_blocks == 0) {
    if (n_in != 28 || out_size != T_TOK * DM || ws_size < WS_END) { fprintf(stderr, "kernel_launch: unexpected problem (n_in %d out %d ws %zu need %zu)\n", n_in, out_size, ws_size, (size_t)WS_END); grid_blocks = -1; return; }
    int dev = 0, cus = 0, per_cu = 0;
    (void)hipGetDevice(&dev);
    (void)hipDeviceGetAttribute(&cus, hipDeviceAttributeMultiprocessorCount, dev);
    const void* fn = (const void*)k_mega;
    if (hipFuncSetAttribute(fn, hipFuncAttributeMaxDynamicSharedMemorySize, LDS_BYTES) != hipSuccess) { fprintf(stderr, "kernel_launch: hipFuncSetAttribute failed\n"); }
    if (hipOccupancyMaxActiveBlocksPerMultiprocessor(&per_cu, fn, NTHR, LDS_BYTES) != hipSuccess || per_cu < 1) { fprintf(stderr, "kernel_launch: occupancy query failed (%d)\n", per_cu); per_cu = 1; }
    (void)hipGetLastError();
    if (per_cu > 1) per_cu = 1;
    grid_blocks = cus * per_cu;
    fprintf(stderr, "kernel_launch: cus %d per_cu %d grid %d\n", cus, per_cu, grid_blocks);
  }
  if (grid_blocks < 0) return;
  P p{};
  const float** pp = (const float**)&p;
  for (int i = 0; i < 28; ++i) pp[i] = (const float*)d_in[i];
  p.out = (float*)d_out; p.ws = (char*)d_ws;
  (void)hipMemsetAsync((char*)d_ws + WS_BAR, 0, XCD_BAR_WORDS * 4, stream);
  void* args[] = {&p};
  const hipError_t e = hipLaunchCooperativeKernel((const void*)k_mega, dim3(grid_blocks), dim3(NTHR), args, LDS_BYTES, stream);
  if (e != hipSuccess) fprintf(stderr, "cooperative launch failed: %s (grid %d)\n", hipGetErrorString(e), grid_blocks);
}
```

```cpp
#include <hip/hip_runtime.h>
#include <cstdio>
#include <cstdint>

#define USE_FP16 1
#define LAS __attribute__((address_space(3)))

typedef unsigned short u16;
typedef float f32x4 __attribute__((ext_vector_type(4)));
typedef float f32x2 __attribute__((ext_vector_type(2)));
typedef _Float16 f16x8 __attribute__((ext_vector_type(8)));

constexpr int T_TOK = 16384, DM = 1024, SEQ = 2048, NBATCH = 8;
constexpr int CAP = 32768;
constexpr int NTHR = 512, NWAVE = NTHR / 64;

constexpr size_t MB = 1024ull * 1024ull;
constexpr size_t WS_XA    = 0;
constexpr size_t WS_XB    = 64 * MB;
constexpr size_t WS_Z     = 96 * MB;
constexpr size_t WS_A2    = 160 * MB;
constexpr size_t WS_BTY   = 184 * MB;
constexpr size_t WS_MW1   = 160 * MB;
constexpr size_t WS_WET   = 208 * MB;
constexpr size_t WS_E     = 216 * MB;
constexpr size_t WS_KTAB  = 232 * MB;
constexpr size_t WS_SP16  = 234 * MB;
constexpr size_t WS_INC   = 266 * MB;
constexpr size_t WS_YCAT  = 330 * MB;
constexpr size_t WS_YGELU = 362 * MB;
constexpr size_t WS_H     = 330 * MB;
constexpr size_t WS_LIST  = 378 * MB;
constexpr size_t WS_GATE  = 382 * MB;
constexpr size_t WS_ROPE  = 383 * MB;
constexpr size_t WS_CNT   = 384 * MB;
constexpr int CNT_STRIDE = 64;
constexpr size_t WS_WR16  = 385 * MB;
constexpr size_t WS_BAR   = 386 * MB;
constexpr size_t WS_PLAN  = 386 * MB + 512 * 1024;
constexpr size_t WS_WIN   = 387 * MB;
constexpr size_t WS_WGLU  = 392 * MB;
constexpr size_t WS_WOUT  = 393 * MB;
constexpr size_t WS_WQKV  = 395 * MB;
constexpr size_t WS_WO    = 398 * MB;
constexpr size_t WS_LAMT  = 400 * MB;
constexpr size_t WS_MW0   = 402 * MB;
constexpr size_t WS_LIST2 = 32 * MB;
constexpr size_t WS_RSTD  = 382 * MB;
constexpr size_t WS_END   = 506 * MB;

struct P {
  const float *x, *norm_mix_g, *norm_ffn_g, *norm_final_g, *w_in, *ret_decay, *a_re, *a_im, *log_step, *b_re, *b_im, *c_re, *c_im,
      *s5d, *w_glu, *b_glu, *w_out, *w_qkv, *sink, *w_o, *rel_bias, *w_group, *b_group, *w_er, *b_er, *w_gate, *w_up, *w_down;
  float* out;
  char* ws;
};

__device__ __forceinline__ u16 f2h(float f) { _Float16 h = (_Float16)f; return __builtin_bit_cast(u16, h); }
__device__ __forceinline__ float h2f(u16 h) { return (float)__builtin_bit_cast(_Float16, h); }
__device__ __forceinline__ unsigned pk2(float a, float b) { return (unsigned)f2h(a) | ((unsigned)f2h(b) << 16); }
__device__ __forceinline__ float lo16(unsigned w) { return h2f((u16)(w & 0xffffu)); }
__device__ __forceinline__ float hi16(unsigned w) { return h2f((u16)(w >> 16)); }
__device__ __forceinline__ f32x4 mfma16(uint4 a, uint4 b, f32x4 c) {
  return __builtin_amdgcn_mfma_f32_16x16x32_f16(__builtin_bit_cast(f16x8, a), __builtin_bit_cast(f16x8, b), c, 0, 0, 0);
}
__device__ __forceinline__ float wave_sum(float v) {
#pragma unroll
  for (int o = 1; o < 64; o <<= 1) v += __shfl_xor(v, o);
  return v;
}
__device__ __forceinline__ float sigmoidf_(float x) { return 1.0f / (1.0f + __expf(-x)); }
__device__ __forceinline__ float gelu_tanh(float x) {
  const float u = 0.7978845608028654f * (x + 0.044715f * x * x * x);
  return 0.5f * x * (1.0f + tanhf(u));
}
#define LDS_WAIT() asm volatile("s_waitcnt lgkmcnt(0)" ::: "memory")
__device__ __forceinline__ int tidx() { int t = threadIdx.x; asm volatile("" : "+v"(t)); return t; }

namespace pg8 {
constexpr int BM = 256, BK = 64, HALF = 128, HTB = HALF * BK * 2, STAGE_BYTES = 8 * HTB, NXCD = 8, WGM = 8;
__device__ __forceinline__ int lds_byte(int r, int c) { const int st = (r >> 4) * 2 + (c >> 5), rr = r & 15, cc = c & 31, ob = rr * 64 + cc * 2; return st * 1024 + (ob ^ (((ob >> 9) & 1) << 5)); }
__device__ __forceinline__ int perm32(int rho) { const int n = rho >> 4, i = rho & 15; return 8 * (i >> 2) + 4 * n + (i & 3); }
__device__ __forceinline__ void stage_rc(int b, int& R, int& C) { const int st = b / 1024, sb = b % 1024, swz = sb ^ (((sb >> 9) & 1) << 5); R = (st >> 1) * 16 + swz / 64; C = (st & 1) * 32 + (swz % 64) / 2; }

struct Unit { const char* a; const char* b; int pm, pn, e, cnt, hbase; };

template <class Epi, class Sched, bool ALIGN_EPI, bool SP2>
__device__ __forceinline__ void gemm_phase(LAS unsigned char* lds, const int K, const Sched& S, const Epi& E) {
    const int tid = tidx(), wid = __builtin_amdgcn_readfirstlane(tid >> 6), lane = tid & 63, wr = wid >> 2, wc = wid & 3, fr = lane & 15, fq = lane >> 4;
    const int nt = K / BK;
    int Rr[2], Cc[2];
    unsigned voffB[2];
#pragma unroll
    for (int i = 0; i < 2; ++i) { stage_rc(tid * 16 + i * 8192, Rr[i], Cc[i]); const int Rb = Epi::PERM ? ((Rr[i] & ~31) + perm32(Rr[i] & 31)) : Rr[i]; voffB[i] = (unsigned)(Rb * K + Cc[i]) * 2u; }
    const size_t kstep = (size_t)(BK * 2);
    const size_t hstepB = (size_t)HALF * K * 2;
    const unsigned ldsw = (unsigned)wid * 1024u;
    const int aoff = lds_byte(wr * 64 + fr, fq * 8), boff = lds_byte(wc * 32 + fr, fq * 8);
#define PG8_SA(b, h) (((b) * 2 + (h)) * HTB)
#define PG8_SB(b, h) ((4 + (b) * 2 + (h)) * HTB)
#define PG8_STAGE(bufoff, gbase, voff) do { _Pragma("unroll") for (int _i = 0; _i < 2; ++_i) \
        __builtin_amdgcn_global_load_lds((const unsigned*)((const char*)(gbase) + (voff)[_i]), (LAS unsigned*)(lds + (bufoff) + ldsw + _i * 8192), 16, 0, 0); } while (0)
#define PG8_LDA(dst, b, h) do { _Pragma("unroll") for (int m = 0; m < 4; ++m) _Pragma("unroll") for (int k = 0; k < 2; ++k) dst[m][k] = *(const LAS f16x8*)(lds + PG8_SA(b, h) + aoff + m * 2048 + k * 1024); } while (0)
#define PG8_LDB(dst, b, h) do { _Pragma("unroll") for (int n = 0; n < 2; ++n) _Pragma("unroll") for (int k = 0; k < 2; ++k) dst[n][k] = *(const LAS f16x8*)(lds + PG8_SB(b, h) + boff + n * 2048 + k * 1024); } while (0)
#define PG8_MMA(ai, bj, At, Bt) do { if (128 * (ai) + 64 * wr >= urows) break; __builtin_amdgcn_s_setprio(1); _Pragma("unroll") for (int m = 0; m < 4; ++m) _Pragma("unroll") for (int n = 0; n < 2; ++n) _Pragma("unroll") for (int k = 0; k < 2; ++k) \
        acc[ai][bj][m][n] = __builtin_amdgcn_mfma_f32_16x16x32_f16(Bt[n][k], At[m][k], acc[ai][bj][m][n], 0, 0, 0); __builtin_amdgcn_s_setprio(0); } while (0)
#define PG8_WAIT_V(n) asm volatile("s_waitcnt vmcnt(" #n ")" ::: "memory")
#define PG8_WAIT_L(n) asm volatile("s_waitcnt lgkmcnt(" #n ")" ::: "memory")
#define PG8_BAR __builtin_amdgcn_s_barrier()
#define PG8_SCHED __builtin_amdgcn_sched_barrier(0)
    Unit cur, nxt; int ui = 0;
    if (!S.next(0, cur)) return;
    unsigned cv0[2], cv1[2], nv0[2], nv1[2];
#pragma unroll
    for (int i = 0; i < 2; ++i) { cv0[i] = S.a_voff(cur, 0, Rr[i], Cc[i]); cv1[i] = S.a_voff(cur, 1, Rr[i], Cc[i]); }
    f32x4 acc[2][2][4][2];
#pragma unroll
    for (int a = 0; a < 2; ++a)
#pragma unroll
        for (int b = 0; b < 2; ++b)
#pragma unroll
            for (int m = 0; m < 4; ++m)
#pragma unroll
                for (int n = 0; n < 2; ++n) acc[a][b][m][n] = (f32x4){0.f, 0.f, 0.f, 0.f};
    f16x8 At[4][2], B0[2][2], B1[2][2];
    const char* cA = cur.a; const char* cB = cur.b;
    int urows = S.rows(cur);
    if constexpr (SP2) {
        PG8_STAGE(PG8_SB(0, 0), cB, voffB); PG8_STAGE(PG8_SB(0, 1), cB + hstepB, voffB); PG8_STAGE(PG8_SA(0, 0), cA, cv0); PG8_STAGE(PG8_SA(0, 1), cA, cv1);
        if (wr == 1) PG8_BAR;
        PG8_WAIT_V(2); PG8_BAR;
        PG8_STAGE(PG8_SB(1, 0), cB + kstep, voffB); PG8_STAGE(PG8_SA(1, 0), cA + kstep, cv0); PG8_STAGE(PG8_SB(1, 1), cB + hstepB + kstep, voffB);
        PG8_WAIT_V(6); PG8_BAR;
    } else {
        PG8_STAGE(PG8_SB(0, 0), cB, voffB); PG8_STAGE(PG8_SA(0, 0), cA, cv0); PG8_STAGE(PG8_SB(0, 1), cB + hstepB, voffB); PG8_STAGE(PG8_SA(0, 1), cA, cv1);
        if (wr == 1) PG8_BAR;
        PG8_WAIT_V(4); PG8_BAR;
        PG8_STAGE(PG8_SB(1, 0), cB + kstep, voffB); PG8_STAGE(PG8_SA(1, 0), cA + kstep, cv0); PG8_STAGE(PG8_SB(1, 1), cB + hstepB + kstep, voffB);
        PG8_WAIT_V(6); PG8_BAR;
    }
    for (;;) {
        const bool has_next = S.next(ui + 1, nxt);
        if (has_next) {
#pragma unroll
            for (int i = 0; i < 2; ++i) { nv0[i] = S.a_voff(nxt, 0, Rr[i], Cc[i]); nv1[i] = S.a_voff(nxt, 1, Rr[i], Cc[i]); }
        } else {
            nxt = cur;
#pragma unroll
            for (int i = 0; i < 2; ++i) { nv0[i] = cv0[i]; nv1[i] = cv1[i]; }
        }
        const char* nA = nxt.a; const char* nB = nxt.b;
        for (int t = 0; t < nt; t += 2) {
            const bool last = (t == nt - 2);
            const char* a1 = cA + (size_t)(t + 1) * kstep;
            const char* a2 = last ? nA : cA + (size_t)(t + 2) * kstep; const char* b2 = last ? nB : cB + (size_t)(t + 2) * kstep;
            const char* a3 = a2 + kstep; const char* b3 = b2 + kstep;
            unsigned v0[2], v1[2];
#pragma unroll
            for (int i = 0; i < 2; ++i) { v0[i] = last ? nv0[i] : cv0[i]; v1[i] = last ? nv1[i] : cv1[i]; }
            if constexpr (SP2) {
            PG8_LDB(B0, 0, 0); PG8_LDB(B1, 0, 1); PG8_SCHED; PG8_LDA(At, 0, 0); PG8_STAGE(PG8_SA(1, 1), a1, cv1);
            PG8_WAIT_L(0); PG8_BAR; PG8_MMA(0, 0, At, B0); PG8_MMA(0, 1, At, B1); PG8_SCHED; PG8_WAIT_V(8); PG8_BAR; PG8_SCHED;
            PG8_LDA(At, 0, 1); PG8_STAGE(PG8_SB(0, 0), b2, voffB); PG8_STAGE(PG8_SB(0, 1), b2 + hstepB, voffB); PG8_STAGE(PG8_SA(0, 0), a2, v0);
            PG8_WAIT_L(0); PG8_BAR; PG8_MMA(1, 0, At, B0); PG8_MMA(1, 1, At, B1); PG8_SCHED; PG8_WAIT_V(8); PG8_BAR; PG8_SCHED;
            PG8_LDB(B0, 1, 0); PG8_LDB(B1, 1, 1); PG8_SCHED; PG8_LDA(At, 1, 0); PG8_STAGE(PG8_SA(0, 1), a2, v1);
            PG8_WAIT_L(0); PG8_BAR; PG8_MMA(0, 0, At, B0); PG8_MMA(0, 1, At, B1); PG8_SCHED; PG8_WAIT_V(8); PG8_BAR; PG8_SCHED;
            PG8_LDA(At, 1, 1); PG8_STAGE(PG8_SB(1, 0), b3, voffB); PG8_STAGE(PG8_SB(1, 1), b3 + hstepB, voffB); PG8_STAGE(PG8_SA(1, 0), a3, v0);
            PG8_WAIT_L(0); PG8_BAR; PG8_MMA(1, 0, At, B0); PG8_MMA(1, 1, At, B1); PG8_SCHED; PG8_WAIT_V(8); PG8_BAR; PG8_SCHED;
            } else {
            PG8_LDB(B0, 0, 0); PG8_SCHED; PG8_LDA(At, 0, 0); PG8_STAGE(PG8_SA(1, 1), a1, cv1);
            PG8_WAIT_L(8); PG8_BAR; PG8_WAIT_L(0); PG8_MMA(0, 0, At, B0); PG8_BAR; PG8_SCHED;
            PG8_LDB(B1, 0, 1); PG8_STAGE(PG8_SB(0, 0), b2, voffB);
            PG8_BAR; PG8_WAIT_L(0); PG8_MMA(0, 1, At, B1); PG8_BAR;
            PG8_LDA(At, 0, 1); PG8_STAGE(PG8_SA(0, 0), a2, v0);
            PG8_BAR; PG8_WAIT_L(0); PG8_MMA(1, 0, At, B0); PG8_BAR; PG8_SCHED;
            PG8_STAGE(PG8_SB(0, 1), b2 + hstepB, voffB);
            PG8_WAIT_V(6); PG8_BAR; PG8_MMA(1, 1, At, B1); PG8_BAR;
            PG8_LDB(B0, 1, 0); PG8_SCHED; PG8_LDA(At, 1, 0); PG8_STAGE(PG8_SA(0, 1), a2, v1);
            PG8_WAIT_L(8); PG8_BAR; PG8_WAIT_L(0); PG8_MMA(0, 0, At, B0); PG8_BAR; PG8_SCHED;
            PG8_LDB(B1, 1, 1); PG8_STAGE(PG8_SB(1, 0), b3, voffB);
            PG8_BAR; PG8_WAIT_L(0); PG8_MMA(0, 1, At, B1); PG8_BAR;
            PG8_LDA(At, 1, 1); PG8_STAGE(PG8_SA(1, 0), a3, v0);
            PG8_BAR; PG8_WAIT_L(0); PG8_MMA(1, 0, At, B0); PG8_BAR; PG8_SCHED;
            PG8_STAGE(PG8_SB(1, 1), b3 + hstepB, voffB);
            PG8_WAIT_V(6); PG8_BAR; PG8_MMA(1, 1, At, B1); PG8_BAR;
            }
        }
        if constexpr (ALIGN_EPI) { if (wr == 0) PG8_BAR; }
        E(acc, cur, wr, wc, fr, fq);
        if (!has_next) break;
#pragma unroll
        for (int a = 0; a < 2; ++a)
#pragma unroll
            for (int b = 0; b < 2; ++b)
#pragma unroll
                for (int m = 0; m < 4; ++m)
#pragma unroll
                    for (int n = 0; n < 2; ++n) acc[a][b][m][n] = (f32x4){0.f, 0.f, 0.f, 0.f};
        cur = nxt; cA = nA; cB = nB; ++ui; urows = S.rows(cur);
#pragma unroll
        for (int i = 0; i < 2; ++i) { cv0[i] = nv0[i]; cv1[i] = nv1[i]; }
        if constexpr (ALIGN_EPI) { if (wr == 1) PG8_BAR; }
    }
    PG8_WAIT_V(0);
    if constexpr (!ALIGN_EPI) { if (wr == 0) PG8_BAR; }
    PG8_BAR;
#undef PG8_SA
#undef PG8_SB
#undef PG8_STAGE
#undef PG8_LDA
#undef PG8_LDB
#undef PG8_MMA
#undef PG8_WAIT_V
#undef PG8_WAIT_L
#undef PG8_BAR
#undef PG8_SCHED
}

struct DenseOrder {
    const char* A; const char* Bt; int lda_b, K, nM, nN, nwg, G, c;
    __device__ __forceinline__ void init(const void* A_, int lda_elems, const void* Bt_, int M, int N, int K_) { A = (const char*)A_; Bt = (const char*)Bt_; lda_b = lda_elems * 2; K = K_; nM = M / BM; nN = N / BM; nwg = nM * nN; G = gridDim.x; c = blockIdx.x; }
    __device__ __forceinline__ bool next(int i, Unit& u) const {
        const long L = (long)i * G + c; if (L >= nwg) return false;
        int wgid = (int)L; { const int q = nwg / NXCD, r = nwg % NXCD, xcd = wgid % NXCD, off = wgid / NXCD; wgid = (xcd < r ? xcd * (q + 1) : r * (q + 1) + (xcd - r) * q) + off; }
        const int nig = WGM * nN, gid = wgid / nig, fm = gid * WGM, gsz = (nM - fm) < WGM ? (nM - fm) : WGM;
        u.pm = fm + ((wgid % nig) % gsz); u.pn = (wgid % nig) / gsz; u.e = 0; u.cnt = 0; u.hbase = 0;
        u.a = A + (size_t)u.pm * BM * lda_b; u.b = Bt + (size_t)u.pn * BM * K * 2;
        return true;
    }
    __device__ __forceinline__ unsigned a_voff(const Unit&, int h, int R, int C) const { return (unsigned)((h * HALF + R) * lda_b + C * 2); }
    __device__ __forceinline__ int rows(const Unit&) const { return BM; }
};
struct GroupOrder {
    const char* A; const char* Bt; int lda_b, K, nM, nN, ng, G, c; size_t gsA, gsB;
    __device__ __forceinline__ void init(const void* A_, int lda_elems, size_t gsA_elems, const void* Bt_, size_t gsB_elems, int ng_, int M, int N, int K_) {
        A = (const char*)A_; Bt = (const char*)Bt_; lda_b = lda_elems * 2; K = K_; nM = M / BM; nN = N / BM; ng = ng_; gsA = gsA_elems * 2; gsB = gsB_elems * 2; G = gridDim.x; c = blockIdx.x; }
    __device__ __forceinline__ bool next(int i, Unit& u) const {
        const long L = (long)i * G + c; if (L >= (long)ng * nM * nN) return false;
        const int per = nM * nN, g = (int)L / per, r = (int)L % per;
        u.e = g; u.pm = r / nN; u.pn = r % nN; u.cnt = 0; u.hbase = 0;
        u.a = A + (size_t)g * gsA + (size_t)u.pm * BM * lda_b; u.b = Bt + (size_t)g * gsB + (size_t)u.pn * BM * K * 2;
        return true;
    }
    __device__ __forceinline__ unsigned a_voff(const Unit&, int h, int R, int C) const { return (unsigned)((h * HALF + R) * lda_b + C * 2); }
    __device__ __forceinline__ int rows(const Unit&) const { return BM; }
};
constexpr int PLAN_STRIDE = 256;
struct PlanOrder {
    const int4* plan; const int* plan_n; const int4* list; const char* A; const char* Bt; int lda_b, K, x, ib, nbx; size_t esB; bool gather;
    __device__ __forceinline__ void init(const void* planbase, const int4* list_, const void* A_, int lda_elems, const void* Bt_, size_t esB_elems, int K_, bool gather_) {
        plan_n = (const int*)planbase; plan = (const int4*)((const char*)planbase + 256); list = list_; A = (const char*)A_; Bt = (const char*)Bt_; lda_b = lda_elems * 2; K = K_; esB = esB_elems * 2; gather = gather_;
        x = blockIdx.x & 7; ib = blockIdx.x >> 3; nbx = ((int)gridDim.x - x + 7) >> 3; }
    __device__ __forceinline__ bool next(int i, Unit& u) const {
        const int j = i * nbx + ib;
        if (j >= plan_n[x]) return false;
        const int4 en = plan[x * PLAN_STRIDE + j];
        u.e = en.x & 255; u.pm = (en.x >> 8) & 255; u.pn = (en.x >> 16) & 255; u.cnt = en.y; u.hbase = en.z;
        u.a = gather ? A : A + (size_t)(u.hbase + u.pm * BM) * lda_b;
        u.b = Bt + (size_t)u.e * esB + (size_t)u.pn * BM * K * 2;
        return true;
    }
    __device__ __forceinline__ unsigned a_voff(const Unit& u, int h, int R, int C) const {
        if (!gather) return (unsigned)((h * HALF + R) * lda_b + C * 2);
        const int li = u.pm * BM + h * HALF + R;
        const int tok = (li < u.cnt) ? (list[(size_t)u.e * CAP + li].x >> 1) : 0;
        return (unsigned)(tok * lda_b + C * 2);
    }
    __device__ __forceinline__ int rows(const Unit& u) const { const int r = u.cnt - u.pm * BM; return r < BM ? r : BM; }
};
}
constexpr bool G_ALIGN = true, G_SP2 = true;

__device__ __forceinline__ void phase_prep(const P& p) {
  const int gtid = blockIdx.x * NTHR + tidx(), gsz = gridDim.x * NTHR;
  int* cnt = (int*)(p.ws + WS_CNT);
  if (gtid < 64) cnt[gtid * CNT_STRIDE] = 0;
  f32x2* rope = (f32x2*)(p.ws + WS_ROPE);
  for (int i = gtid; i < SEQ * 64; i += gsz) {
    const int pos = i >> 6, f = i & 63;
    const float inv = powf(10000.0f, -(float)(2 * f) / 128.0f);
    const float ang = (float)pos * inv;
    float s, c; sincosf(ang, &s, &c);
    rope[i] = (f32x2){c, s};
  }
  f32x2* lamt = (f32x2*)(p.ws + WS_LAMT); f32x2* coeft = (f32x2*)(p.ws + WS_LAMT + 3 * MB / 2);
  for (int i = gtid; i < 32 * 2 * 33 * 64; i += gsz) {
    const int q = i & 63, l = (i >> 6) % 33, gd = i / (33 * 64);
    const int g = gd >> 1, dir = gd & 1;
    const float dt = expf(p.log_step[dir * 32 + g]), ar = p.a_re[(dir * 32 + g) * 64 + q], ai = p.a_im[(dir * 32 + g) * 64 + q];
    const float mag = expf(ar * dt * (float)l); float sn, cs; sincosf(ai * dt * (float)l, &sn, &cs);
    lamt[i] = (f32x2){mag * cs, mag * sn};
    if (l == 1) {
      const float em1 = expm1f(ar * dt), sh = sinf(0.5f * ai * dt);
      const float nr = em1 * cs - 2.0f * sh * sh, ni = (em1 + 1.0f) * sn, den = ar * ar + ai * ai;
      coeft[gd * 64 + q] = (f32x2){(nr * ar + ni * ai) / den, (ni * ar - nr * ai) / den};
    }
  }
  u16* wr16 = (u16*)(p.ws + WS_WR16);
  for (int i = gtid; i < 2 * 48 * DM; i += gsz) {
    const int k = i & (DM - 1), n = (i >> 10) % 48, layer = i / (48 * DM);
    float w = 0.f;
    if (n < 4) w = p.w_group[((size_t)layer * DM + k) * 4 + n];
    else if (n < 36) { const int gg = (n - 4) >> 3, j = (n - 4) & 7; w = p.w_er[(((size_t)layer * 4 + gg) * DM + k) * 8 + j]; }
    w *= p.norm_ffn_g[layer * DM + k];
    const u16 hi = f2h(w), lo = f2h(w - h2f(hi));
    wr16[((size_t)(layer * 2 + 0) * 48 + n) * DM + k] = hi;
    wr16[((size_t)(layer * 2 + 1) * 48 + n) * DM + k] = lo;
  }
}

template <class RowFn>
__device__ __forceinline__ void conv_item(const float* W, int ldw, int K, u16* WT, float* scr, int k0, int n0, int lane, RowFn rowfn, const float* kg = nullptr) {
#pragma unroll 8
  for (int i = 0; i < 32; ++i) { const int kk = 2 * i + (lane >> 5); scr[kk * 33 + (lane & 31)] = W[(size_t)(k0 + kk) * ldw + n0 + (lane & 31)]; }
  const int c = lane & 7;
  f32x4 ga = {1.f, 1.f, 1.f, 1.f}, gb = ga;
  if (kg) { ga = *(const f32x4*)(kg + k0 + 8 * c); gb = *(const f32x4*)(kg + k0 + 8 * c + 4); }
  LDS_WAIT();
#pragma unroll
  for (int j = 0; j < 4; ++j) {
    const int n = (lane >> 3) + 8 * j; const float* sp = scr + (8 * c) * 33 + n;
    uint4 o; o.x = pk2(sp[0 * 33] * ga[0], sp[1 * 33] * ga[1]); o.y = pk2(sp[2 * 33] * ga[2], sp[3 * 33] * ga[3]); o.z = pk2(sp[4 * 33] * gb[0], sp[5 * 33] * gb[1]); o.w = pk2(sp[6 * 33] * gb[2], sp[7 * 33] * gb[3]);
    *(uint4*)(WT + (size_t)rowfn(n0 + n) * K + k0 + 8 * c) = o;
  }
  LDS_WAIT();
}
template <class RowFn>
__device__ __forceinline__ int conv_matrix(const float* W, int ldw, int K, int N, u16* WT, char* smem, int item_base, RowFn rowfn, const float* kg = nullptr) {
  const int lane = tidx() & 63, wv = tidx() >> 6, gw = blockIdx.x * NWAVE + wv, nw = gridDim.x * NWAVE;
  float* scr = (float*)smem + wv * (64 * 33);
  const int nkb = K / 64, nnb = N / 32, nitems = nkb * nnb;
  int it = gw - (item_base % nw); if (it < 0) it += nw;
  for (; it < nitems; it += nw) conv_item(W, ldw, K, WT, scr, (it / nnb) * 64, (it % nnb) * 32, lane, rowfn, kg);
  return nitems;
}
__device__ __forceinline__ void phase_conv_dense(const P& p, char* smem) {
  auto id = [](int n) { return n; };
  int base = 0;
  base += conv_matrix(p.w_in, 2560, DM, 2560, (u16*)(p.ws + WS_WIN), smem, base, [](int n) { if (n >= 1024) return n; const int dd = n & 127, hf = dd >> 6, r = dd & 63; return (n & ~127) + 32 * (r >> 4) + 8 * ((r & 15) >> 2) + 4 * hf + (r & 3); }, p.norm_mix_g);
  base += conv_matrix(p.w_glu, 512, 512, 512, (u16*)(p.ws + WS_WGLU), smem, base, id);
  base += conv_matrix(p.w_out, DM, DM, DM, (u16*)(p.ws + WS_WOUT), smem, base, id);
  base += conv_matrix(p.w_qkv, 1536, DM, 1536, (u16*)(p.ws + WS_WQKV), smem, base, id, p.norm_mix_g + DM);
  base += conv_matrix(p.w_o, DM, DM, DM, (u16*)(p.ws + WS_WO), smem, base, id);
}
__device__ __forceinline__ void phase_conv_moe(const P& p, int layer, int lo, int hi, int b0, int nb, char* smem) {
  if (gridDim.x != 256) { b0 = 0; nb = (int)gridDim.x; }
  if ((int)blockIdx.x < b0 || (int)blockIdx.x >= b0 + nb) return;
  const int lane = tidx() & 63, wv = tidx() >> 6, gw = ((int)blockIdx.x - b0) * NWAVE + wv, nw = nb * NWAVE;
  float* scr = (float*)smem + wv * (64 * 33);
  u16* w1t = (u16*)(p.ws + (layer ? WS_MW1 : WS_MW0)); u16* w2t = w1t + (size_t)32 * DM * DM;
  for (int it = lo + gw; it < hi; it += nw) {
    const int e = it / 768, r = it % 768;
    if (r < 512) {
      const int which = r >> 8, q = r & 255, k0 = (q >> 4) * 64, n0 = (q & 15) * 32;
      const float* W = (which ? p.w_up : p.w_gate) + (size_t)(layer * 32 + e) * DM * 512;
      conv_item(W, 512, DM, w1t + (size_t)e * DM * DM, scr, k0, n0, lane, [which](int n) { return (n >> 4) * 32 + which * 16 + (n & 15); }, p.norm_ffn_g + layer * DM);
    } else {
      const int q = r - 512, k0 = (q >> 5) * 64, n0 = (q & 31) * 32;
      const float* W = p.w_down + (size_t)(layer * 32 + e) * 512 * DM;
      conv_item(W, DM, 512, w2t + (size_t)e * DM * 512, scr, k0, n0, lane, [](int n) { return n; });
    }
  }
}

constexpr int CONV_ITEMS = 32 * 768;
constexpr int cq(int pct) { return (int)((long)CONV_ITEMS * pct / 100); }
__device__ __forceinline__ void phase_rowpass(const P& p, const float* src, const u16* src16, const u16* slots, u16* dstx, float* rstd_out, const float* gain, int route_layer, float* fout, char* smem) {
  const int lane = tidx() & 63, wv = tidx() >> 6, fr = lane & 15, lg = lane >> 4;
  int* cnt = (int*)(p.ws + WS_CNT);
  int4* list2 = (int4*)(p.ws + WS_LIST2);
  float* sLg = (float*)smem + 64;
  for (int st = blockIdx.x; st < T_TOK / 64; st += gridDim.x) {
    const int row0 = st * 64 + wv * 8;
#pragma unroll 1
    for (int rp = 0; rp < (route_layer >= 0 ? 0 : 4); ++rp) {
      f32x4 v[2][4];
#pragma unroll
      for (int q = 0; q < 2; ++q) {
        const int row = row0 + rp * 2 + q;
#pragma unroll
        for (int j = 0; j < 2; ++j) {
          const int k = (j * 64 + lane) * 8;
          if (src16) { const uint4 w = *(const uint4*)(src16 + (size_t)row * DM + k); v[q][2 * j] = (f32x4){lo16(w.x), hi16(w.x), lo16(w.y), hi16(w.y)}; v[q][2 * j + 1] = (f32x4){lo16(w.z), hi16(w.z), lo16(w.w), hi16(w.w)}; }
          else { v[q][2 * j] = *(const f32x4*)(src + (size_t)row * DM + k); v[q][2 * j + 1] = *(const f32x4*)(src + (size_t)row * DM + k + 4); }
        }
      }
      if (slots) {
#pragma unroll
        for (int q = 0; q < 2; ++q) {
          const int row = row0 + rp * 2 + q;
          uint4 w[2][2];
#pragma unroll
          for (int sl = 0; sl < 2; ++sl)
#pragma unroll
            for (int j = 0; j < 2; ++j) w[sl][j] = *(const uint4*)(slots + ((size_t)row * 2 + sl) * DM + (j * 64 + lane) * 8);
#pragma unroll
          for (int sl = 0; sl < 2; ++sl)
#pragma unroll
            for (int j = 0; j < 2; ++j) {
              v[q][2 * j][0] += lo16(w[sl][j].x); v[q][2 * j][1] += hi16(w[sl][j].x); v[q][2 * j][2] += lo16(w[sl][j].y); v[q][2 * j][3] += hi16(w[sl][j].y);
              v[q][2 * j + 1][0] += lo16(w[sl][j].z); v[q][2 * j + 1][1] += hi16(w[sl][j].z); v[q][2 * j + 1][2] += lo16(w[sl][j].w); v[q][2 * j + 1][3] += hi16(w[sl][j].w);
            }
        }
      }
#pragma unroll
      for (int q = 0; q < 2; ++q) {
        const int row = row0 + rp * 2 + q;
        float ss = 0.f;
#pragma unroll
        for (int i = 0; i < 4; ++i) ss += v[q][i][0] * v[q][i][0] + v[q][i][1] * v[q][i][1] + v[q][i][2] * v[q][i][2] + v[q][i][3] * v[q][i][3];
        if (dstx) {
#pragma unroll
          for (int j = 0; j < 2; ++j) {
            uint4 w; w.x = pk2(v[q][2 * j][0], v[q][2 * j][1]); w.y = pk2(v[q][2 * j][2], v[q][2 * j][3]); w.z = pk2(v[q][2 * j + 1][0], v[q][2 * j + 1][1]); w.w = pk2(v[q][2 * j + 1][2], v[q][2 * j + 1][3]);
            *(uint4*)(dstx + (size_t)row * DM + (j * 64 + lane) * 8) = w;
          }
        }
        ss = wave_sum(ss);
        const float rstd = rsqrtf(ss * (1.0f / DM) + 1e-6f);
        if (rstd_out && lane == 0) rstd_out[row] = rstd;
        if (fout) {
#pragma unroll
          for (int j = 0; j < 2; ++j) {
            const int k = (j * 64 + lane) * 8;
            const f32x4 g0 = *(const f32x4*)(gain + k), g1 = *(const f32x4*)(gain + k + 4);
            *(f32x4*)(fout + (size_t)row * DM + k) = v[q][2 * j] * rstd * g0; *(f32x4*)(fout + (size_t)row * DM + k + 4) = v[q][2 * j + 1] * rstd * g1;
          }
        }
      }
    }
    if (route_layer >= 0) {
      const u16* xrow = src16 + (size_t)(st * 64 + fr) * DM + wv * 128 + lg * 8;
      const u16* whi = (const u16*)(p.ws + WS_WR16) + ((size_t)(route_layer * 2 + 0) * 48 + fr) * DM + wv * 128 + lg * 8;
      const u16* wlo = (const u16*)(p.ws + WS_WR16) + ((size_t)(route_layer * 2 + 1) * 48 + fr) * DM + wv * 128 + lg * 8;
      float sq0 = 0.f, sq1 = 0.f, sq2 = 0.f, sq3 = 0.f;
      f32x4 acc[4][3];
#pragma unroll
      for (int tl = 0; tl < 4; ++tl)
#pragma unroll
        for (int nb = 0; nb < 3; ++nb) acc[tl][nb] = (f32x4){0.f, 0.f, 0.f, 0.f};
#pragma unroll
      for (int ks = 0; ks < 4; ++ks) {
        const uint4 bh0 = *(const uint4*)(whi + (size_t)0 * 16 * DM + ks * 32), bh1 = *(const uint4*)(whi + (size_t)1 * 16 * DM + ks * 32), bh2 = *(const uint4*)(whi + (size_t)2 * 16 * DM + ks * 32);
        const uint4 bl0 = *(const uint4*)(wlo + (size_t)0 * 16 * DM + ks * 32), bl1 = *(const uint4*)(wlo + (size_t)1 * 16 * DM + ks * 32), bl2 = *(const uint4*)(wlo + (size_t)2 * 16 * DM + ks * 32);
#pragma unroll
        for (int tl = 0; tl < 4; ++tl) {
          const uint4 xw = *(const uint4*)(xrow + (size_t)tl * 16 * DM + ks * 32);
          const float e0 = lo16(xw.x), e1 = hi16(xw.x), e2 = lo16(xw.y), e3 = hi16(xw.y), e4 = lo16(xw.z), e5 = hi16(xw.z), e6 = lo16(xw.w), e7 = hi16(xw.w);
          const float sq = ((e0 * e0 + e1 * e1) + (e2 * e2 + e3 * e3)) + ((e4 * e4 + e5 * e5) + (e6 * e6 + e7 * e7));
          if (tl == 0) sq0 += sq; else if (tl == 1) sq1 += sq; else if (tl == 2) sq2 += sq; else sq3 += sq;
          acc[tl][0] = mfma16(bh0, xw, acc[tl][0]); acc[tl][0] = mfma16(bl0, xw, acc[tl][0]);
          acc[tl][1] = mfma16(bh1, xw, acc[tl][1]); acc[tl][1] = mfma16(bl1, xw, acc[tl][1]);
          acc[tl][2] = mfma16(bh2, xw, acc[tl][2]); acc[tl][2] = mfma16(bl2, xw, acc[tl][2]);
        }
      }
      float* sSq = sLg + 8 * 4 * 16 * 49 + 64;
      sq0 += __shfl_xor(sq0, 16); sq0 += __shfl_xor(sq0, 32); sq1 += __shfl_xor(sq1, 16); sq1 += __shfl_xor(sq1, 32);
      sq2 += __shfl_xor(sq2, 16); sq2 += __shfl_xor(sq2, 32); sq3 += __shfl_xor(sq3, 16); sq3 += __shfl_xor(sq3, 32);
      if (lg == 0) { sSq[wv * 64 + 0 * 16 + fr] = sq0; sSq[wv * 64 + 1 * 16 + fr] = sq1; sSq[wv * 64 + 2 * 16 + fr] = sq2; sSq[wv * 64 + 3 * 16 + fr] = sq3; }
#pragma unroll
      for (int tl = 0; tl < 4; ++tl) {
        float* lgw = sLg + ((wv * 4 + tl) * 16 + fr) * 49;
#pragma unroll
        for (int nb = 0; nb < 3; ++nb)
#pragma unroll
          for (int r = 0; r < 4; ++r) lgw[nb * 16 + 4 * lg + r] = acc[tl][nb][r];
      }
      int* lcnt = (int*)(sLg + 8 * 4 * 16 * 49); int* lbase = lcnt + 32;
      if (tidx() < 32) lcnt[tidx()] = 0;
      __syncthreads();
      int ex1 = 0, ex2 = 0, lr1 = 0, lr2 = 0; float g1 = 0.f, g2 = 0.f, rstd = 0.f;
      const bool decider = (wv < 4 && lane < 16);
      if (decider) {
        const float* l0 = sLg + (wv * 16 + lane) * 49;
#define RT_LSUM(j_) (((l0[0 * 3136 + (j_)] + l0[1 * 3136 + (j_)]) + (l0[2 * 3136 + (j_)] + l0[3 * 3136 + (j_)])) + ((l0[4 * 3136 + (j_)] + l0[5 * 3136 + (j_)]) + (l0[6 * 3136 + (j_)] + l0[7 * 3136 + (j_)])))
        const float* sq = sSq + wv * 16 + lane;
        rstd = rsqrtf((((sq[0] + sq[64]) + (sq[128] + sq[192])) + ((sq[256] + sq[320]) + (sq[384] + sq[448]))) * (1.0f / DM) + 1e-6f);
        const float* bg = p.b_group + route_layer * 4;
        const float* be = p.b_er + route_layer * 32;
        float gl[4];
#pragma unroll
        for (int j = 0; j < 4; ++j) gl[j] = RT_LSUM(j) * rstd + bg[j];
        int gs = 0; float gm = gl[0];
#pragma unroll
        for (int j = 1; j < 4; ++j) if (gl[j] > gm) { gm = gl[j]; gs = j; }
        float den = 0.f;
#pragma unroll
        for (int j = 0; j < 4; ++j) den += expf(gl[j] - gm);
        const float pg = 1.0f / den;
        float el[8];
#pragma unroll
        for (int j = 0; j < 8; ++j) el[j] = RT_LSUM(4 + gs * 8 + j) * rstd + be[gs * 8 + j];
        int i1 = 0; float v1 = el[0];
#pragma unroll
        for (int j = 1; j < 8; ++j) if (el[j] > v1) { v1 = el[j]; i1 = j; }
        int i2 = -1; float v2 = -3.0e38f;
#pragma unroll
        for (int j = 0; j < 8; ++j) if (j != i1 && el[j] > v2) { v2 = el[j]; i2 = j; }
        const float e2 = expf(v2 - v1);
        g1 = pg / (1.0f + e2); g2 = pg * e2 / (1.0f + e2);
        ex1 = gs * 8 + i1; ex2 = gs * 8 + i2;
        lr1 = atomicAdd(&lcnt[ex1], 1); lr2 = atomicAdd(&lcnt[ex2], 1);
      }
      __syncthreads();
      if (tidx() < 32) { const int c = lcnt[tidx()]; lbase[tidx()] = c ? atomicAdd(&cnt[(route_layer * 32 + tidx()) * CNT_STRIDE], c) : 0; }
      __syncthreads();
      if (decider) {
        const int row = st * 64 + wv * 16 + lane;
        const int rsb = __float_as_int(rstd);
        list2[(size_t)ex1 * CAP + lbase[ex1] + lr1] = make_int4(row * 2, __float_as_int(g1), rsb, 0);
        list2[(size_t)ex2 * CAP + lbase[ex2] + lr2] = make_int4(row * 2 + 1, __float_as_int(g2), rsb, 0);
      }
      __syncthreads();
    }
  }
}

constexpr int RSTR = 136;
__device__ __forceinline__ float log_sigmoid(float x) { return -log1pf(expf(-x)); }
__device__ __forceinline__ uint2 lds_tr16(const u16* ptr) {
  typedef short s16x4 __attribute__((ext_vector_type(4)));
  const s16x4 v = __builtin_amdgcn_ds_read_tr16_b64_v4i16((LAS s16x4*)ptr);
  return __builtin_bit_cast(uint2, v);
}
__device__ __forceinline__ uint4 lds_frag_T(const u16* tile, int rs, int k0, int c0, int lane) {
  const int g = lane >> 4, q = (lane & 15) >> 2, pp = lane & 3;
  const u16* a = tile + (k0 + 8 * g + q) * rs + c0 + 4 * pp;
  const uint2 lo = lds_tr16(a), hi = lds_tr16(a + 4 * rs);
  return make_uint4(lo.x, lo.y, hi.x, hi.y);
}
__device__ __forceinline__ void ret_load_tile(u16* dst0, u16* dst1, const u16* src, int t0, int h, const float* w0, const float* w1) {
  for (int c = tidx(); c < 128 * 16; c += NTHR) {
    const int i = c >> 4, ch = (c & 15) * 8;
    const uint4 v = *(const uint4*)(src + (size_t)(t0 + i) * 512 + h * 128 + ch);
    if (w0) {
      const float a = w0[i], b = w1[i];
      const float f[8] = {lo16(v.x), hi16(v.x), lo16(v.y), hi16(v.y), lo16(v.z), hi16(v.z), lo16(v.w), hi16(v.w)};
      *(uint4*)(dst0 + i * RSTR + ch) = make_uint4(pk2(f[0] * a, f[1] * a), pk2(f[2] * a, f[3] * a), pk2(f[4] * a, f[5] * a), pk2(f[6] * a, f[7] * a));
      *(uint4*)(dst1 + i * RSTR + ch) = make_uint4(pk2(f[0] * b, f[1] * b), pk2(f[2] * b, f[3] * b), pk2(f[4] * b, f[5] * b), pk2(f[6] * b, f[7] * b));
    } else *(uint4*)(dst0 + i * RSTR + ch) = v;
  }
}
template <int MB_, int NB_, bool ATR, bool BTR>
__device__ __forceinline__ void lds_mma(f32x4 (&acc)[MB_][NB_], const u16* sA, int sa, int a0, const u16* sB, int sb, int b0, int K, int lane, const float* sc) {
  const int fr = lane & 15, fq = lane >> 4;
  for (int k0 = 0; k0 < K; k0 += 32) {
    uint4 fa[MB_], fb[NB_];
#pragma unroll
    for (int m = 0; m < MB_; ++m) {
      if constexpr (ATR) fa[m] = lds_frag_T(sA, sa, k0, a0 + m * 16, lane);
      else fa[m] = *(const uint4*)(sA + (a0 + m * 16 + fr) * sa + k0 + fq * 8);
      if (sc) {
        const float f = sc[m];
        fa[m].x = pk2(lo16(fa[m].x) * f, hi16(fa[m].x) * f); fa[m].y = pk2(lo16(fa[m].y) * f, hi16(fa[m].y) * f);
        fa[m].z = pk2(lo16(fa[m].z) * f, hi16(fa[m].z) * f); fa[m].w = pk2(lo16(fa[m].w) * f, hi16(fa[m].w) * f);
      }
    }
#pragma unroll
    for (int n = 0; n < NB_; ++n) {
      if constexpr (BTR) fb[n] = lds_frag_T(sB, sb, k0, b0 + n * 16, lane);
      else fb[n] = *(const uint4*)(sB + (b0 + n * 16 + fr) * sb + k0 + fq * 8);
    }
#pragma unroll
    for (int m = 0; m < MB_; ++m)
#pragma unroll
      for (int n = 0; n < NB_; ++n) acc[m][n] = mfma16(fb[n], fa[m], acc[m][n]);
  }
}
__device__ __forceinline__ void ret_items(int ng, int& first, int& count, int& stride) {
  const int c = blockIdx.x, G = gridDim.x;
  if (G != 256) { first = c; count = (512 - c + G - 1) / G; stride = G; return; }
  stride = 1;
  if (c < ng) { first = c; count = 1; return; }
  const int rest = 512 - ng, nb = 256 - ng, q = rest / nb, r = rest % nb, i = c - ng;
  first = ng + i * q + (i < r ? i : r); count = q + (i < r ? 1 : 0);
}
__device__ __forceinline__ void phase_ret_inc_mfma(const P& p, char* smem) {
  u16* sKf = (u16*)smem; u16* sKb = sKf + 128 * RSTR; u16* sV = sKb + 128 * RSTR; float* sWf = (float*)(sV + 128 * RSTR); float* sWb = sWf + 128;
  const u16* kb = (const u16*)(p.ws + WS_Z) + (size_t)1 * T_TOK * 512; const u16* vb = (const u16*)(p.ws + WS_Z) + (size_t)2 * T_TOK * 512;
  u16* incf = (u16*)(p.ws + WS_INC); u16* incb = incf + (size_t)512 * 16384;
  const int tid = tidx(), lane = tid & 63, wv = tid >> 6, wr = wv >> 1, wc = wv & 1, fr = lane & 15, fq = lane >> 4;
  int it_first, it_count, it_stride; ret_items(64, it_first, it_count, it_stride);
  for (int ii = 0; ii < it_count; ++ii) {
    const int item = it_first + ii * it_stride;
    const int h = item & 3, bn = item >> 2, t0 = bn * 128;
    const float lgf = log_sigmoid(p.ret_decay[h]), lgb = log_sigmoid(p.ret_decay[4 + h]);
    __syncthreads();
    if (tid < 128) { sWf[tid] = expf(lgf * (float)(127 - tid)); sWb[tid] = expf(lgb * (float)tid); }
    __syncthreads();
    ret_load_tile(sKf, sKb, kb, t0, h, sWf, sWb);
    ret_load_tile(sV, nullptr, vb, t0, h, nullptr, nullptr);
    __syncthreads();
#pragma unroll
    for (int dirn = 0; dirn < 2; ++dirn) {
      f32x4 acc[2][4];
#pragma unroll
      for (int m = 0; m < 2; ++m)
#pragma unroll
        for (int n = 0; n < 4; ++n) acc[m][n] = (f32x4){0.f, 0.f, 0.f, 0.f};
      lds_mma<2, 4, true, true>(acc, sV, RSTR, wr * 32, dirn ? sKb : sKf, RSTR, wc * 64, 128, lane, nullptr);
      u16* o = (dirn ? incb : incf) + (size_t)item * 16384;
#pragma unroll
      for (int m = 0; m < 2; ++m)
#pragma unroll
        for (int n = 0; n < 4; ++n) { uint2 w; w.x = pk2(acc[m][n][0], acc[m][n][1]); w.y = pk2(acc[m][n][2], acc[m][n][3]); *(uint2*)(o + (wr * 32 + m * 16 + fr) * 128 + wc * 64 + n * 16 + 4 * fq) = w; }
    }
  }
}
__device__ __forceinline__ void phase_ret_scan16(const P& p) {
  const u16* incf = (const u16*)(p.ws + WS_INC); const u16* incb = incf + (size_t)512 * 16384;
  u16* spf = (u16*)(p.ws + WS_SP16); u16* spb = spf + (size_t)512 * 16384;
  const int gtid = blockIdx.x * NTHR + tidx(), gsz = gridDim.x * NTHR;
  for (int idx = gtid; idx < 32 * 4096; idx += gsz) {
    const int de = (idx & 4095) * 4, bh = idx >> 12, b = bh >> 2, h = bh & 3;
    const float Gf = expf(128.0f * log_sigmoid(p.ret_decay[h])), Gb = expf(128.0f * log_sigmoid(p.ret_decay[4 + h]));
    const size_t o0 = ((size_t)(b * 16 * 4 + h)) * 16384 + de;
    uint2 tf[16], tb[16];
#pragma unroll
    for (int n = 0; n < 16; ++n) { tf[n] = *(const uint2*)(incf + o0 + (size_t)n * 65536); tb[n] = *(const uint2*)(incb + o0 + (size_t)n * 65536); }
    f32x4 s = {0.f, 0.f, 0.f, 0.f};
#pragma unroll
    for (int n = 0; n < 16; ++n) {
      const f32x4 t = {lo16(tf[n].x), hi16(tf[n].x), lo16(tf[n].y), hi16(tf[n].y)};
      uint2 w; w.x = pk2(s[0], s[1]); w.y = pk2(s[2], s[3]); *(uint2*)(spf + o0 + (size_t)n * 65536) = w;
      s = s * Gf + t;
    }
    s = (f32x4){0.f, 0.f, 0.f, 0.f};
#pragma unroll
    for (int n = 15; n >= 0; --n) {
      const f32x4 t = {lo16(tb[n].x), hi16(tb[n].x), lo16(tb[n].y), hi16(tb[n].y)};
      uint2 w; w.x = pk2(s[0], s[1]); w.y = pk2(s[2], s[3]); *(uint2*)(spb + o0 + (size_t)n * 65536) = w;
      s = s * Gb + t;
    }
  }
}
__device__ __forceinline__ void phase_ret_out_mfma(const P& p, char* smem) {
  u16* R0 = (u16*)smem; u16* R1 = R0 + 128 * RSTR; u16* R2 = R1 + 128 * RSTR; u16* R3 = R2 + 128 * RSTR;
  float* sPf = (float*)(R3 + 128 * RSTR); float* sPb = sPf + 132;
  const u16* zb = (const u16*)(p.ws + WS_Z);
  const u16* qb = zb; const u16* kb = zb + (size_t)1 * T_TOK * 512; const u16* vb = zb + (size_t)2 * T_TOK * 512; const u16* gb = zb + (size_t)3 * T_TOK * 512;
  const u16* spf = (const u16*)(p.ws + WS_SP16); const u16* spb = spf + (size_t)512 * 16384;
  u16* ycat = (u16*)(p.ws + WS_YCAT);
  const int tid = tidx(), lane = tid & 63, wv = tid >> 6, wr = wv >> 1, wc = wv & 1, fr = lane & 15, fq = lane >> 4;
  int it_first, it_count, it_stride; ret_items(128, it_first, it_count, it_stride);
  for (int ii = 0; ii < it_count; ++ii) {
    const int item = it_first + ii * it_stride;
    const int h = item & 3, bn = item >> 2, t0 = bn * 128;
    const float lgf = log_sigmoid(p.ret_decay[h]), lgb = log_sigmoid(p.ret_decay[4 + h]);
    const u16* spT = spf + (size_t)item * 16384; const u16* snT = spb + (size_t)item * 16384;
    const int pe = tid >> 4, pch = (tid & 15) * 8;
    const uint4 pp0 = *(const uint4*)(spT + (pe + 0) * 128 + pch), pp1 = *(const uint4*)(spT + (pe + 32) * 128 + pch), pp2 = *(const uint4*)(spT + (pe + 64) * 128 + pch), pp3 = *(const uint4*)(spT + (pe + 96) * 128 + pch);
    __syncthreads();
    ret_load_tile(R0, nullptr, qb, t0, h, nullptr, nullptr);
    ret_load_tile(R1, nullptr, kb, t0, h, nullptr, nullptr);
    ret_load_tile(R2, nullptr, vb, t0, h, nullptr, nullptr);
    if (tid < 129) { sPf[tid] = expf(lgf * (float)tid); sPb[tid] = expf(lgb * (float)tid); }
    __syncthreads();
    {
      f32x4 acc[2][4];
#pragma unroll
      for (int m = 0; m < 2; ++m)
#pragma unroll
        for (int n = 0; n < 4; ++n) acc[m][n] = (f32x4){0.f, 0.f, 0.f, 0.f};
      lds_mma<2, 4, false, false>(acc, R0, RSTR, wr * 32, R1, RSTR, wc * 64, 128, lane, nullptr);
#pragma unroll
      for (int m = 0; m < 2; ++m)
#pragma unroll
        for (int n = 0; n < 4; ++n) {
          const int i = wr * 32 + m * 16 + fr, j = wc * 64 + n * 16 + 4 * fq;
          float v[4];
#pragma unroll
          for (int r = 0; r < 4; ++r) { const int jj = j + r; v[r] = acc[m][n][r] * ((i >= jj) ? sPf[i - jj] : sPb[jj - i]); }
          uint2 w; w.x = pk2(v[0], v[1]); w.y = pk2(v[2], v[3]);
          *(uint2*)(R3 + i * RSTR + j) = w;
        }
    }
    __syncthreads();
    *(uint4*)(R1 + (pe + 0) * RSTR + pch) = pp0; *(uint4*)(R1 + (pe + 32) * RSTR + pch) = pp1; *(uint4*)(R1 + (pe + 64) * RSTR + pch) = pp2; *(uint4*)(R1 + (pe + 96) * RSTR + pch) = pp3;
    const uint4 pn0 = *(const uint4*)(snT + (pe + 0) * 128 + pch), pn1 = *(const uint4*)(snT + (pe + 32) * 128 + pch), pn2 = *(const uint4*)(snT + (pe + 64) * 128 + pch), pn3 = *(const uint4*)(snT + (pe + 96) * 128 + pch);
    f32x4 o[1][8];
#pragma unroll
    for (int m = 0; m < 1; ++m)
#pragma unroll
      for (int n = 0; n < 8; ++n) o[m][n] = (f32x4){0.f, 0.f, 0.f, 0.f};
    lds_mma<1, 8, false, true>(o, R3, RSTR, wv * 16, R2, RSTR, 0, 128, lane, nullptr);
    __syncthreads();
    *(uint4*)(R2 + (pe + 0) * RSTR + pch) = pn0; *(uint4*)(R2 + (pe + 32) * RSTR + pch) = pn1; *(uint4*)(R2 + (pe + 64) * RSTR + pch) = pn2; *(uint4*)(R2 + (pe + 96) * RSTR + pch) = pn3;
    float scf[1], scb[1];
    { const int i = wv * 16 + fr; scf[0] = sPf[i + 1]; scb[0] = sPb[128 - i]; }
    lds_mma<1, 8, false, false>(o, R0, RSTR, wv * 16, R1, RSTR, 0, 128, lane, scf);
    __syncthreads();
    lds_mma<1, 8, false, false>(o, R0, RSTR, wv * 16, R2, RSTR, 0, 128, lane, scb);
#pragma unroll
    for (int m = 0; m < 1; ++m) {
      float s1 = 0.f;
#pragma unroll
      for (int n = 0; n < 8; ++n) s1 += (o[m][n][0] + o[m][n][1]) + (o[m][n][2] + o[m][n][3]);
      s1 += __shfl_xor(s1, 16); s1 += __shfl_xor(s1, 32);
      const float mu = s1 * (1.0f / 128.0f);
      float s2 = 0.f;
#pragma unroll
      for (int n = 0; n < 8; ++n)
#pragma unroll
        for (int r = 0; r < 4; ++r) { const float dl = o[m][n][r] - mu; s2 += dl * dl; }
      s2 += __shfl_xor(s2, 16); s2 += __shfl_xor(s2, 32);
      const float rs = rsqrtf(s2 * (1.0f / 128.0f) + 1e-5f);
      const size_t tok = (size_t)(t0 + wv * 16 + m * 16 + fr);
#pragma unroll
      for (int n = 0; n < 8; ++n) {
        const int e = n * 16 + 4 * fq;
        const uint2 gq = *(const uint2*)(gb + tok * 512 + h * 128 + e);
        const float g0 = lo16(gq.x), g1 = hi16(gq.x), g2 = lo16(gq.y), g3 = hi16(gq.y);
        uint2 w;
        w.x = pk2(g0 * sigmoidf_(g0) * (o[m][n][0] - mu) * rs, g1 * sigmoidf_(g1) * (o[m][n][1] - mu) * rs);
        w.y = pk2(g2 * sigmoidf_(g2) * (o[m][n][2] - mu) * rs, g3 * sigmoidf_(g3) * (o[m][n][3] - mu) * rs);
        *(uint2*)(ycat + tok * DM + h * 128 + e) = w;
      }
    }
  }
}

struct Cpx { float re, im; };
__device__ __forceinline__ Cpx cmul(Cpx a, Cpx b) { return {a.re * b.re - a.im * b.im, a.re * b.im + a.im * b.re}; }
__device__ __forceinline__ Cpx s5_lam(const P& p, int g, int dir, int l, int q) { const f32x2 v = ((const f32x2*)(p.ws + WS_LAMT))[((g * 2 + dir) * 33 + l) * 64 + q]; return {v[0], v[1]}; }
__device__ __forceinline__ Cpx s5_cf(const P& p, int g, int dir, int q) { const f32x2 v = ((const f32x2*)(p.ws + WS_LAMT + 3 * MB / 2))[(g * 2 + dir) * 64 + q]; return {v[0], v[1]}; }
__device__ __forceinline__ bool s5_setup_ids(int& gtid, int& gsz) {
  const bool half = (gridDim.x == 256);
  if (half && blockIdx.x < 128) return false;
  gtid = (half ? (int)blockIdx.x - 128 : (int)blockIdx.x) * NTHR + tidx(); gsz = (half ? 128 : (int)gridDim.x) * NTHR;
  return true;
}
__device__ __forceinline__ void phase_s5_ktab(const P& p, char* smem) {
  float* ktab = (float*)(p.ws + WS_KTAB);
  float* sBr = (float*)smem; float* sBi = sBr + 64 * 16; float* sCr = sBi + 64 * 16; float* sCi = sCr + 16 * 65;
  f32x2* sCf = (f32x2*)(sCi + 16 * 65); f32x2* sLam = sCf + 64;
  const int tid = tidx(), lane = tid & 63, wv = tid >> 6, c = lane >> 2, part = lane & 3;
  for (int w = blockIdx.x; w < 256; w += gridDim.x) {
    const int gd = w >> 2, g = gd >> 1, dir = gd & 1, l0 = (w & 3) * 8;
    __syncthreads();
    for (int i = tid; i < 64 * 16; i += NTHR) { sBr[i] = p.b_re[g * 1024 + i]; sBi[i] = p.b_im[g * 1024 + i]; }
    for (int i = tid; i < 16 * 64; i += NTHR) { const int cc = i >> 6, q = i & 63; sCr[cc * 65 + q] = p.c_re[((dir * 32 + g) * 16 + cc) * 64 + q]; sCi[cc * 65 + q] = p.c_im[((dir * 32 + g) * 16 + cc) * 64 + q]; }
    if (tid < 64) sCf[tid] = ((const f32x2*)(p.ws + WS_LAMT + 3 * MB / 2))[gd * 64 + tid];
    sLam[tid] = ((const f32x2*)(p.ws + WS_LAMT))[(gd * 33 + l0 + (tid >> 6)) * 64 + (tid & 63)];
    __syncthreads();
    float acc[16];
#pragma unroll
    for (int j = 0; j < 16; ++j) acc[j] = 0.f;
#pragma unroll 4
    for (int qq = 0; qq < 16; ++qq) {
      const int q = part * 16 + qq;
      const f32x2 Lv = sLam[wv * 64 + q], cv = sCf[q];
      const Cpx wq = cmul(cmul((Cpx){sCr[c * 65 + q], sCi[c * 65 + q]}, (Cpx){Lv[0], Lv[1]}), (Cpx){cv[0], cv[1]});
#pragma unroll
      for (int j = 0; j < 16; ++j) acc[j] += wq.re * sBr[q * 16 + j] - wq.im * sBi[q * 16 + j];
    }
#pragma unroll
    for (int j = 0; j < 16; ++j) { acc[j] += __shfl_xor(acc[j], 1); acc[j] += __shfl_xor(acc[j], 2); }
    if (part == 0) {
      const int item = ((gd * 32) + l0 + wv) * 16 + c;
#pragma unroll
      for (int j = 0; j < 16; j += 4) *(f32x4*)(ktab + (size_t)item * 16 + j) = (f32x4){acc[j], acc[j + 1], acc[j + 2], acc[j + 3]};
    }
  }
}
__device__ __forceinline__ void phase_s5_fill_a(const P& p) {
  const float* ktab = (const float*)(p.ws + WS_KTAB);
  u16* bty = (u16*)(p.ws + WS_BTY);
  const int gtid = blockIdx.x * NTHR + tidx(), gsz = gridDim.x * NTHR;
  for (int item = gtid; item < 32 * 512 * 64; item += gsz) {
    const int ch = item & 63, n = (item >> 6) & 511, g = item >> 15;
    const int ip = ch >> 1, c0 = (ch & 1) * 8, i = n >> 4, c = n & 15;
    float v[8];
    if (ip != i) {
      const int dir = ip < i ? 0 : 1, l = ip < i ? i - ip : ip - i;
      const float* src = ktab + ((size_t)((g * 2 + dir) * 32 + l) * 16 + c) * 16 + c0;
      const f32x4 a = *(const f32x4*)src, b = *(const f32x4*)(src + 4);
      v[0] = a[0]; v[1] = a[1]; v[2] = a[2]; v[3] = a[3]; v[4] = b[0]; v[5] = b[1]; v[6] = b[2]; v[7] = b[3];
    } else {
      const float* s0 = ktab + ((size_t)((g * 2 + 0) * 32) * 16 + c) * 16 + c0;
      const float* s1 = ktab + ((size_t)((g * 2 + 1) * 32) * 16 + c) * 16 + c0;
      const float dd = p.s5d[g * 16 + c];
#pragma unroll
      for (int j = 0; j < 8; ++j) v[j] = s0[j] + s1[j] + ((c0 + j) == c ? dd : 0.f);
    }
    *(uint4*)(bty + ((size_t)g * 512 + n) * 768 + ch * 8) = make_uint4(pk2(v[0], v[1]), pk2(v[2], v[3]), pk2(v[4], v[5]), pk2(v[6], v[7]));
  }
}
__device__ __forceinline__ void phase_s5_fill_bc(const P& p) {
  u16* bty = (u16*)(p.ws + WS_BTY); u16* wet = (u16*)(p.ws + WS_WET);
  int gtid, gsz; if (!s5_setup_ids(gtid, gsz)) return;
  for (int item = gtid; item < 32 * 512 * 32; item += gsz) {
    const int ch = item & 31, n = (item >> 5) & 511, g = item >> 14;
    const int kk = ch * 8, dir = kk >> 7, p0 = (kk & 127) >> 1, i = n >> 4, c = n & 15;
    const int e = dir ? (32 - i) : (i + 1);
    float v[8];
#pragma unroll
    for (int q = 0; q < 4; ++q) {
      const int pq = p0 + q;
      const Cpx L = s5_lam(p, g, dir, e, pq);
      const Cpx C = {p.c_re[((dir * 32 + g) * 16 + c) * 64 + pq], p.c_im[((dir * 32 + g) * 16 + c) * 64 + pq]};
      const Cpx w = cmul(C, L);
      v[2 * q] = w.re; v[2 * q + 1] = -w.im;
    }
    *(uint4*)(bty + ((size_t)g * 512 + n) * 768 + 512 + kk) = make_uint4(pk2(v[0], v[1]), pk2(v[2], v[3]), pk2(v[4], v[5]), pk2(v[6], v[7]));
  }
  for (int item = gtid; item < 32 * 256 * 64; item += gsz) {
    const int ch = item & 63, n = (item >> 6) & 255, g = item >> 14;
    const int ip = ch >> 1, c0 = (ch & 1) * 8, ri = n & 1, pq = (n >> 1) & 63, dir = n >> 7;
    const int e = dir ? ip : (31 - ip);
    const Cpx w = cmul(s5_lam(p, g, dir, e, pq), s5_cf(p, g, dir, pq));
    float v[8];
#pragma unroll
    for (int j = 0; j < 8; ++j) {
      const float br = p.b_re[(g * 64 + pq) * 16 + c0 + j], bi = p.b_im[(g * 64 + pq) * 16 + c0 + j];
      v[j] = ri ? (w.re * bi + w.im * br) : (w.re * br - w.im * bi);
    }
    *(uint4*)(wet + ((size_t)g * 256 + n) * 512 + ch * 8) = make_uint4(pk2(v[0], v[1]), pk2(v[2], v[3]), pk2(v[4], v[5]), pk2(v[6], v[7]));
  }
}
__device__ __forceinline__ void phase_s5_carry(const P& p) {
  const float* E = (const float*)(p.ws + WS_E);
  u16* a2 = (u16*)(p.ws + WS_A2);
  const int gtid = blockIdx.x * NTHR + tidx(), gsz = gridDim.x * NTHR;
  for (int idx = gtid; idx < 32 * 8 * 128; idx += gsz) {
    const int pq = idx & 63, dir = (idx >> 6) & 1, b = (idx >> 7) & 7, g = idx >> 10;
    const Cpx L = s5_lam(p, g, dir, 32, pq);
    Cpx s = {0.f, 0.f};
    for (int jj = 0; jj < 64; ++jj) {
      const int j = dir ? 63 - jj : jj, r = b * 64 + j;
      const f32x2 e = *(const f32x2*)(E + ((size_t)g * 512 + r) * 256 + (dir * 64 + pq) * 2);
      *(unsigned*)(a2 + ((size_t)g * 512 + r) * 768 + 512 + (dir * 64 + pq) * 2) = pk2(s.re, s.im);
      const Cpx ns = cmul(L, s);
      s.re = ns.re + e[0]; s.im = ns.im + e[1];
    }
  }
}
constexpr int KSTR = 72;
__device__ __forceinline__ int t5_bucket_abs(int n) {
  return n < 8 ? n : 8 + (n >= 12) + (n >= 16) + (n >= 23) + (n >= 32) + (n >= 46) + (n >= 64) + (n >= 91);
}
__device__ __forceinline__ void phase_attn(const P& p, char* smem) {
  u16* sK = (u16*)smem; u16* sV = sK + 384 * KSTR; float* sBias = (float*)(sV + 384 * KSTR);
  const u16* q1 = (const u16*)(p.ws + WS_Z); const u16* k1 = (const u16*)(p.ws + WS_Z + 32 * MB); const u16* v1 = (const u16*)(p.ws + WS_Z + 40 * MB);
  u16* ao = (u16*)(p.ws + WS_YCAT);
  const int tid = tidx(), lane = tid & 63, wv = tid >> 6, fr = lane & 15, lg = lane >> 4, q0 = (wv & 3) * 32, hp = wv >> 2;
  for (int item = blockIdx.x; item < 512; item += gridDim.x) {
    const int b = item >> 6, nb = (item >> 2) & 15, kvh = item & 3;
    __syncthreads();
    for (int c = tid; c < 384 * 8; c += NTHR) {
      const int s = c >> 3, ch = (c & 7) * 8, pos = (nb - 1) * 128 + s;
      uint4 kq = make_uint4(0u, 0u, 0u, 0u), vq = kq;
      if (pos >= 0 && pos < SEQ) { kq = *(const uint4*)(k1 + (size_t)(b * SEQ + pos) * 256 + kvh * 64 + ch); vq = *(const uint4*)(v1 + (size_t)(b * SEQ + pos) * 256 + kvh * 64 + ch); }
      *(uint4*)(sK + s * KSTR + ch) = kq; *(uint4*)(sV + s * KSTR + ch) = vq;
    }
    for (int c = tid; c < 4 * 512; c += NTHR) {
      const int hq = c >> 9, ri = (c & 511) - 128, rel = ri - 128, n = rel < 0 ? -rel : rel;
      const int bucket = (rel > 0 ? 16 : 0) + t5_bucket_abs(n < 128 ? n : 128);
      sBias[c] = (ri >= 0 && ri <= 256) ? 1.4426950408889634f * p.rel_bias[bucket * 16 + kvh * 4 + hq] : -1e30f;
    }
    __syncthreads();
#pragma unroll 1
    for (int hh = 0; hh < 2; ++hh) {
      const int hq = hp * 2 + hh, head = kvh * 4 + hq;
      const size_t tok0 = (size_t)b * SEQ + nb * 128 + q0;
      uint4 qf[2][2];
#pragma unroll
      for (int qb = 0; qb < 2; ++qb)
#pragma unroll
        for (int ks = 0; ks < 2; ++ks) qf[qb][ks] = *(const uint4*)(q1 + (tok0 + qb * 16 + fr) * DM + head * 64 + ks * 32 + lg * 8);
      f32x4 O[4][2];
#pragma unroll
      for (int mb = 0; mb < 4; ++mb)
#pragma unroll
        for (int qb = 0; qb < 2; ++qb) O[mb][qb] = (f32x4){0.f, 0.f, 0.f, 0.f};
      const float sinkv = 1.4426950408889634f * p.sink[head];
      float mrun[2] = {sinkv, sinkv}, lpart[2] = {lg == 0 ? 1.0f : 0.0f, lg == 0 ? 1.0f : 0.0f};
      const float* bias = sBias + hq * 512 + 128 - (q0 + fr) + 4 * lg;
#pragma unroll
      for (int c = 0; c < 3; ++c) {
        if ((c == 0 && nb == 0) || (c == 2 && nb == 15)) continue;
        f32x4 S[8][2];
#pragma unroll
        for (int kb = 0; kb < 8; ++kb) {
          S[kb][0] = (f32x4){0.f, 0.f, 0.f, 0.f}; S[kb][1] = S[kb][0];
          const bool act = (c == 0) ? (16 * kb + 15 >= q0) : ((c == 2) ? (16 * kb <= q0 + 31) : true);
          if (act) {
#pragma unroll
            for (int qb = 0; qb < 2; ++qb)
#pragma unroll
              for (int r = 0; r < 4; ++r) S[kb][qb][r] = bias[c * 128 + kb * 16 + r - qb * 16];
#pragma unroll
            for (int ks = 0; ks < 2; ++ks) {
              const uint4 kf = *(const uint4*)(sK + (c * 128 + kb * 16 + fr) * KSTR + ks * 32 + lg * 8);
              S[kb][0] = mfma16(kf, qf[0][ks], S[kb][0]);
              S[kb][1] = mfma16(kf, qf[1][ks], S[kb][1]);
            }
          }
        }
        float cmax[2] = {-1e30f, -1e30f};
#pragma unroll
        for (int kb = 0; kb < 8; ++kb) {
          const bool act = (c == 0) ? (16 * kb + 15 >= q0) : ((c == 2) ? (16 * kb <= q0 + 31) : true);
          if (act) {
#pragma unroll
            for (int qb = 0; qb < 2; ++qb)
#pragma unroll
              for (int r = 0; r < 4; ++r) cmax[qb] = fmaxf(cmax[qb], S[kb][qb][r]);
          }
        }
#pragma unroll
        for (int qb = 0; qb < 2; ++qb) {
          cmax[qb] = fmaxf(cmax[qb], __shfl_xor(cmax[qb], 16)); cmax[qb] = fmaxf(cmax[qb], __shfl_xor(cmax[qb], 32));
          const float mn = fmaxf(mrun[qb], cmax[qb]), alpha = __builtin_amdgcn_exp2f(mrun[qb] - mn);
          mrun[qb] = mn; lpart[qb] *= alpha;
#pragma unroll
          for (int mb = 0; mb < 4; ++mb) O[mb][qb] = O[mb][qb] * alpha;
          float ps = 0.f;
#pragma unroll
          for (int kb = 0; kb < 8; ++kb) {
            const bool act = (c == 0) ? (16 * kb + 15 >= q0) : ((c == 2) ? (16 * kb <= q0 + 31) : true);
            if (act) {
#pragma unroll
              for (int r = 0; r < 4; ++r) { const float e = __builtin_amdgcn_exp2f(S[kb][qb][r] - mn); S[kb][qb][r] = e; ps += e; }
            }
          }
          lpart[qb] += ps;
        }
#pragma unroll
        for (int kk = 0; kk < 4; ++kk) {
          const int kb0 = 2 * kk, kb1 = 2 * kk + 1;
          const bool act = (c == 0) ? (16 * kb1 + 15 >= q0) : ((c == 2) ? (16 * kb0 <= q0 + 31) : true);
          if (act) {
            uint4 pf[2];
#pragma unroll
            for (int qb = 0; qb < 2; ++qb) pf[qb] = make_uint4(pk2(S[kb0][qb][0], S[kb0][qb][1]), pk2(S[kb0][qb][2], S[kb0][qb][3]), pk2(S[kb1][qb][0], S[kb1][qb][1]), pk2(S[kb1][qb][2], S[kb1][qb][3]));
#pragma unroll
            for (int mb = 0; mb < 4; ++mb) {
              const int l2 = tidx() & 63, tq = (l2 & 15) >> 2, tp = l2 & 3;
              const uint2 v0 = lds_tr16(sV + (c * 128 + kb0 * 16 + 4 * lg + tq) * KSTR + mb * 16 + 4 * tp);
              const uint2 v1r = lds_tr16(sV + (c * 128 + kb1 * 16 + 4 * lg + tq) * KSTR + mb * 16 + 4 * tp);
              const uint4 vf = make_uint4(v0.x, v0.y, v1r.x, v1r.y);
              O[mb][0] = mfma16(vf, pf[0], O[mb][0]);
              O[mb][1] = mfma16(vf, pf[1], O[mb][1]);
            }
          }
        }
      }
#pragma unroll
      for (int qb = 0; qb < 2; ++qb) {
        float lt = lpart[qb]; lt += __shfl_xor(lt, 16); lt += __shfl_xor(lt, 32);
        const float inv = 1.0f / lt;
#pragma unroll
        for (int mb = 0; mb < 4; ++mb) {
          uint2 w; w.x = pk2(O[mb][qb][0] * inv, O[mb][qb][1] * inv); w.y = pk2(O[mb][qb][2] * inv, O[mb][qb][3] * inv);
          *(uint2*)(ao + (tok0 + qb * 16 + fr) * DM + head * 64 + mb * 16 + 4 * lg) = w;
        }
      }
    }
  }
}

struct EpiInproj {
  static constexpr bool PERM = true;
  u16* zb; u16* a2; const f32x2* rope; const float* rstd;
  __device__ __forceinline__ void operator()(const f32x4 (&acc)[2][2][4][2], const pg8::Unit& u, int wr, int wc, int fr, int fq) const {
    const int seg = u.pn >> 1;
#pragma unroll
    for (int ai = 0; ai < 2; ++ai)
#pragma unroll
      for (int m = 0; m < 4; ++m) {
        const int row = u.pm * 256 + ai * 128 + wr * 64 + m * 16 + fr;
        const float rs = rstd[row];
        if (seg < 2) {
          const int d = 16 * wc + 4 * fq;
          const f32x2* cs = rope + (size_t)(row & (SEQ - 1)) * 64 + d;
          const f32x4 c01 = *(const f32x4*)cs, c23 = *(const f32x4*)(cs + 2);
          const float cv[4] = {c01[0], c01[2], c23[0], c23[2]}, sv[4] = {c01[1], c01[3], c23[1], c23[3]};
          const float sc = seg == 1 ? 0.08838834764831845f : 1.0f;
#pragma unroll
          for (int bj = 0; bj < 2; ++bj) {
            const f32x4 x1 = acc[ai][bj][m][0] * rs, x2 = acc[ai][bj][m][1] * rs;
            float o1[4], o2[4];
#pragma unroll
            for (int r = 0; r < 4; ++r) { o1[r] = (x1[r] * cv[r] - x2[r] * sv[r]) * sc; o2[r] = (x1[r] * sv[r] + x2[r] * cv[r]) * sc; }
            u16* dst = zb + (size_t)seg * T_TOK * 512 + (size_t)row * 512 + ((u.pn & 1) * 2 + bj) * 128 + d;
            uint2 w; w.x = pk2(o1[0], o1[1]); w.y = pk2(o1[2], o1[3]); *(uint2*)dst = w;
            w.x = pk2(o2[0], o2[1]); w.y = pk2(o2[2], o2[3]); *(uint2*)(dst + 64) = w;
          }
        } else {
#pragma unroll
          for (int bj = 0; bj < 2; ++bj) {
            const int col = u.pn * 256 + bj * 128 + wc * 32 + 8 * fq;
            const f32x4 v0 = acc[ai][bj][m][0] * rs, v1 = acc[ai][bj][m][1] * rs;
            uint4 w; w.x = pk2(v0[0], v0[1]); w.y = pk2(v0[2], v0[3]); w.z = pk2(v1[0], v1[1]); w.w = pk2(v1[2], v1[3]);
            if (seg < 4) *(uint4*)(zb + (size_t)seg * T_TOK * 512 + (size_t)row * 512 + (col - seg * 512)) = w;
            else { const int ch = col - 2048, gi = ch >> 4, c = ch & 15; *(uint4*)(a2 + ((size_t)gi * 512 + (row >> 5)) * 768 + (row & 31) * 16 + c) = w; }
          }
        }
      }
  }
};
__device__ __forceinline__ void phase_inproj(const P& p, LAS unsigned char* lds) {
  pg8::DenseOrder S; S.init(p.ws + WS_XB, DM, p.ws + WS_WIN, T_TOK, 2560, DM);
  EpiInproj E{(u16*)(p.ws + WS_Z), (u16*)(p.ws + WS_A2), (const f32x2*)(p.ws + WS_ROPE), (const float*)(p.ws + WS_RSTD)};
  pg8::gemm_phase<EpiInproj, pg8::DenseOrder, G_ALIGN, G_SP2>(lds, DM, S, E);
}
struct EpiS5E {
  static constexpr bool PERM = false;
  float* E_;
  __device__ __forceinline__ void operator()(const f32x4 (&acc)[2][2][4][2], const pg8::Unit& u, int wr, int wc, int fr, int fq) const {
#pragma unroll
    for (int ai = 0; ai < 2; ++ai)
#pragma unroll
      for (int m = 0; m < 4; ++m) {
        const int row = u.pm * 256 + ai * 128 + wr * 64 + m * 16 + fr;
#pragma unroll
        for (int bj = 0; bj < 2; ++bj)
#pragma unroll
          for (int n = 0; n < 2; ++n) *(f32x4*)(E_ + ((size_t)u.e * 512 + row) * 256 + bj * 128 + wc * 32 + n * 16 + 4 * fq) = acc[ai][bj][m][n];
      }
  }
};
__device__ __forceinline__ void phase_s5_egemm(const P& p, LAS unsigned char* lds) {
  pg8::GroupOrder S; S.init(p.ws + WS_A2, 768, (size_t)512 * 768, p.ws + WS_WET, (size_t)256 * 512, 32, 512, 256, 512);
  EpiS5E E{(float*)(p.ws + WS_E)};
  pg8::gemm_phase<EpiS5E, pg8::GroupOrder, G_ALIGN, G_SP2>(lds, 512, S, E);
}
struct EpiS5Y {
  static constexpr bool PERM = true;
  u16* yg;
  __device__ __forceinline__ void operator()(const f32x4 (&acc)[2][2][4][2], const pg8::Unit& u, int wr, int wc, int fr, int fq) const {
#pragma unroll
    for (int ai = 0; ai < 2; ++ai)
#pragma unroll
      for (int m = 0; m < 4; ++m) {
        const int row = u.pm * 256 + ai * 128 + wr * 64 + m * 16 + fr;
#pragma unroll
        for (int bj = 0; bj < 2; ++bj) {
          const int col = u.pn * 256 + bj * 128 + wc * 32 + 8 * fq;
          const f32x4 v0 = acc[ai][bj][m][0], v1 = acc[ai][bj][m][1];
          uint4 w; w.x = pk2(gelu_tanh(v0[0]), gelu_tanh(v0[1])); w.y = pk2(gelu_tanh(v0[2]), gelu_tanh(v0[3])); w.z = pk2(gelu_tanh(v1[0]), gelu_tanh(v1[1])); w.w = pk2(gelu_tanh(v1[2]), gelu_tanh(v1[3]));
          *(uint4*)(yg + ((size_t)row * 32 + (col >> 4)) * 512 + u.e * 16 + (col & 15)) = w;
        }
      }
  }
};
__device__ __forceinline__ void phase_s5_ygemm(const P& p, LAS unsigned char* lds) {
  pg8::GroupOrder S; S.init(p.ws + WS_A2, 768, (size_t)512 * 768, p.ws + WS_BTY, (size_t)512 * 768, 32, 512, 512, 768);
  EpiS5Y E{(u16*)(p.ws + WS_YGELU)};
  pg8::gemm_phase<EpiS5Y, pg8::GroupOrder, G_ALIGN, G_SP2>(lds, 768, S, E);
}
struct EpiGlu {
  static constexpr bool PERM = true;
  const u16* yg; const float* bglu; u16* ycat;
  __device__ __forceinline__ void operator()(const f32x4 (&acc)[2][2][4][2], const pg8::Unit& u, int wr, int wc, int fr, int fq) const {
#pragma unroll
    for (int ai = 0; ai < 2; ++ai)
#pragma unroll
      for (int m = 0; m < 4; ++m) {
        const int row = u.pm * 256 + ai * 128 + wr * 64 + m * 16 + fr;
#pragma unroll
        for (int bj = 0; bj < 2; ++bj) {
          const int col = u.pn * 256 + bj * 128 + wc * 32 + 8 * fq;
          const f32x4 v0 = acc[ai][bj][m][0], v1 = acc[ai][bj][m][1];
          const uint4 yv = *(const uint4*)(yg + (size_t)row * 512 + col);
          const f32x4 b0 = *(const f32x4*)(bglu + col), b1 = *(const f32x4*)(bglu + col + 4);
          uint4 w;
          w.x = pk2(lo16(yv.x) * sigmoidf_(v0[0] + b0[0]), hi16(yv.x) * sigmoidf_(v0[1] + b0[1]));
          w.y = pk2(lo16(yv.y) * sigmoidf_(v0[2] + b0[2]), hi16(yv.y) * sigmoidf_(v0[3] + b0[3]));
          w.z = pk2(lo16(yv.z) * sigmoidf_(v1[0] + b1[0]), hi16(yv.z) * sigmoidf_(v1[1] + b1[1]));
          w.w = pk2(lo16(yv.w) * sigmoidf_(v1[2] + b1[2]), hi16(yv.w) * sigmoidf_(v1[3] + b1[3]));
          *(uint4*)(ycat + (size_t)row * DM + 512 + col) = w;
        }
      }
  }
};
__device__ __forceinline__ void phase_glu(const P& p, LAS unsigned char* lds) {
  pg8::DenseOrder S; S.init(p.ws + WS_YGELU, 512, p.ws + WS_WGLU, T_TOK, 512, 512);
  EpiGlu E{(const u16*)(p.ws + WS_YGELU), p.b_glu, (u16*)(p.ws + WS_YCAT)};
  pg8::gemm_phase<EpiGlu, pg8::DenseOrder, G_ALIGN, G_SP2>(lds, 512, S, E);
}
template <bool XIN16> struct EpiResid {
  static constexpr bool PERM = true;
  const float* xin; const u16* xin16; u16* xout;
  __device__ __forceinline__ void operator()(const f32x4 (&acc)[2][2][4][2], const pg8::Unit& u, int wr, int wc, int fr, int fq) const {
#pragma unroll
    for (int ai = 0; ai < 2; ++ai)
#pragma unroll
      for (int m = 0; m < 4; ++m) {
        const int row = u.pm * 256 + ai * 128 + wr * 64 + m * 16 + fr;
#pragma unroll
        for (int bj = 0; bj < 2; ++bj) {
          const size_t o = (size_t)row * DM + u.pn * 256 + bj * 128 + wc * 32 + 8 * fq;
          f32x4 x0, x1;
          if constexpr (XIN16) { const uint4 w = *(const uint4*)(xin16 + o); x0 = (f32x4){lo16(w.x), hi16(w.x), lo16(w.y), hi16(w.y)}; x1 = (f32x4){lo16(w.z), hi16(w.z), lo16(w.w), hi16(w.w)}; }
          else { x0 = *(const f32x4*)(xin + o); x1 = *(const f32x4*)(xin + o + 4); }
          x0 += acc[ai][bj][m][0]; x1 += acc[ai][bj][m][1];
          uint4 r; r.x = pk2(x0[0], x0[1]); r.y = pk2(x0[2], x0[3]); r.z = pk2(x1[0], x1[1]); r.w = pk2(x1[2], x1[3]);
          *(uint4*)(xout + o) = r;
        }
      }
  }
};
template <bool XIN16>
__device__ __forceinline__ void phase_outproj(const P& p, const void* Wt, const float* xin, const u16* xin16, u16* xout, LAS unsigned char* lds) {
  pg8::DenseOrder S; S.init(p.ws + WS_YCAT, DM, Wt, T_TOK, DM, DM);
  EpiResid<XIN16> E{xin, xin16, xout};
  pg8::gemm_phase<EpiResid<XIN16>, pg8::DenseOrder, G_ALIGN, G_SP2>(lds, DM, S, E);
}
struct EpiQkv {
  static constexpr bool PERM = true;
  u16 *q1, *k1, *v1; const float* rstd;
  __device__ __forceinline__ void operator()(const f32x4 (&acc)[2][2][4][2], const pg8::Unit& u, int wr, int wc, int fr, int fq) const {
    const float sc = u.pn < 4 ? 0.18033688011112042f : 1.0f;
#pragma unroll
    for (int ai = 0; ai < 2; ++ai)
#pragma unroll
      for (int m = 0; m < 4; ++m) {
        const int row = u.pm * 256 + ai * 128 + wr * 64 + m * 16 + fr;
#pragma unroll
        for (int bj = 0; bj < 2; ++bj) {
          const int col = u.pn * 256 + bj * 128 + wc * 32 + 8 * fq;
          const float rsc = sc * rstd[row];
          const f32x4 a0 = acc[ai][bj][m][0] * rsc, a1 = acc[ai][bj][m][1] * rsc;
          uint4 w; w.x = pk2(a0[0], a0[1]); w.y = pk2(a0[2], a0[3]); w.z = pk2(a1[0], a1[1]); w.w = pk2(a1[2], a1[3]);
          if (u.pn < 4) *(uint4*)(q1 + (size_t)row * DM + col) = w;
          else if (u.pn == 4) *(uint4*)(k1 + (size_t)row * 256 + (col - 1024)) = w;
          else *(uint4*)(v1 + (size_t)row * 256 + (col - 1280)) = w;
        }
      }
  }
};
__device__ __forceinline__ void phase_qkv(const P& p, LAS unsigned char* lds) {
  pg8::DenseOrder S; S.init(p.ws + WS_XA, DM, p.ws + WS_WQKV, T_TOK, 1536, DM);
  EpiQkv E{(u16*)(p.ws + WS_Z), (u16*)(p.ws + WS_Z + 32 * MB), (u16*)(p.ws + WS_Z + 40 * MB), (const float*)(p.ws + WS_RSTD)};
  pg8::gemm_phase<EpiQkv, pg8::DenseOrder, G_ALIGN, G_SP2>(lds, DM, S, E);
}
__device__ __forceinline__ void phase_moe_plan(const P& p, int layer, char* smem) {
  if (blockIdx.x != 0) return;
  using pg8::PLAN_STRIDE;
  const int tid = tidx();
  const int* cnt = (const int*)(p.ws + WS_CNT) + layer * 32 * CNT_STRIDE;
  int* plan_n = (int*)(p.ws + WS_PLAN + layer * 65536); int4* plan = (int4*)(p.ws + WS_PLAN + layer * 65536 + 256);
  int* sc = (int*)smem;
  int* ecum = sc + 32; int* ebase = ecum + 32; int* ehb = ebase + 32; int* efull = ehb + 32; int* tot = efull + 32;
  int* sstart = tot + 8; int* sfstart = sstart + 8; int* cntF = sfstart + 8; int* cntR = cntF + 8;
  unsigned* keyR = (unsigned*)(cntR + 8);
  constexpr int NN = 4;
  __syncthreads();
  if (tid < 32) sc[tid] = cnt[tid * CNT_STRIDE];
  if (tid < 8) { sstart[tid] = 0x7fffffff; sfstart[tid] = 0; cntF[tid] = 0; cntR[tid] = 0; }
  if (tid < 128) keyR[tid] = 0xffffffffu;
  __syncthreads();
  if (tid == 0) {
    int cum = 0, ub = 0, hb = 0, fb = 0;
    for (int e = 0; e < 32; ++e) {
      const int c = sc[e], fl = c >> 8, rem = c & 255, rc = (rem + 63) >> 6, ntl = fl + (rem ? 1 : 0);
      ecum[e] = cum; ebase[e] = ub; ehb[e] = hb; efull[e] = fb;
      cum += (fl * 4 + rc) * NN; ub += ntl * NN; hb += ntl * 256; fb += fl * NN;
    }
    tot[0] = cum > 0 ? cum : 1; tot[1] = ub;
  }
  __syncthreads();
  const int total = tot[0], nunits = tot[1] < 1024 ? tot[1] : 1024;
  int4 en[2]; int ux[2], uF[2]; unsigned ukr[2]; bool ufull[2], uval[2];
#pragma unroll
  for (int q = 0; q < 2; ++q) {
    const int u = tid + q * NTHR;
    uval[q] = u < nunits; ux[q] = 0; uF[q] = 0; ukr[q] = 0; ufull[q] = true; en[q] = make_int4(0, 0, 0, 0);
    if (uval[q]) {
      int e = 0;
      for (int j = 1; j < 32; ++j) if (ebase[j] <= u) e = j;
      const int c = sc[e], fl = c >> 8, rem = c & 255, rc = (rem + 63) >> 6, ntl = fl + (rem ? 1 : 0);
      const int local = u - ebase[e], ct = local / ntl, rt = local - ct * ntl;
      const int cum = ecum[e] + ct * (fl * 4 + rc) + rt * 4;
      const bool isfull = rt < fl;
      int x = (cum * 8) / total; if (x > 7) x = 7;
      ux[q] = x; ufull[q] = isfull; uF[q] = efull[e] + ct * fl + (rt < fl ? rt : fl);
      en[q] = make_int4(e | (rt << 8) | (ct << 16), c, ehb[e], 0);
      atomicMin(&sstart[x], u);
      if (isfull) atomicAdd(&cntF[x], 1);
      else { atomicAdd(&cntR[x], 1); ukr[q] = ((unsigned)x << 16) | ((unsigned)(4 - rc) << 12) | (unsigned)(e * NN + ct); keyR[e * NN + ct] = ukr[q]; }
    }
  }
  __syncthreads();
#pragma unroll
  for (int q = 0; q < 2; ++q) if (uval[q] && (tid + q * NTHR) == sstart[ux[q]]) sfstart[ux[q]] = uF[q];
  __syncthreads();
#pragma unroll
  for (int q = 0; q < 2; ++q) {
    if (uval[q]) {
      const int x = ux[q];
      int pos;
      if (ufull[q]) pos = uF[q] - sfstart[x];
      else { pos = cntF[x]; for (int v = 0; v < 128; ++v) { const unsigned kv = keyR[v]; pos += ((kv >> 16) == (unsigned)x && kv < ukr[q]) ? 1 : 0; } }
      if (pos < PLAN_STRIDE) plan[x * PLAN_STRIDE + pos] = en[q];
    }
  }
  if (tid < 8) { const int n = cntF[tid] + cntR[tid]; plan_n[tid] = n < PLAN_STRIDE ? n : PLAN_STRIDE; }
  __syncthreads();
}
struct EpiMoe1 {
  static constexpr bool PERM = false;
  u16* hbuf; const int4* list;
  __device__ __forceinline__ void operator()(const f32x4 (&acc)[2][2][4][2], const pg8::Unit& u, int wr, int wc, int fr, int fq) const {
#pragma unroll
    for (int ai = 0; ai < 2; ++ai)
#pragma unroll
      for (int m = 0; m < 4; ++m) {
        const int row = u.pm * 256 + ai * 128 + wr * 64 + m * 16 + fr;
        if (row < u.cnt) {
          const float rs = __int_as_float(list[(size_t)u.e * CAP + row].z);
#pragma unroll
          for (int bj = 0; bj < 2; ++bj) {
            const f32x4 g = acc[ai][bj][m][0] * rs, up = acc[ai][bj][m][1] * rs;
            uint2 w; w.x = pk2(g[0] * sigmoidf_(g[0]) * up[0], g[1] * sigmoidf_(g[1]) * up[1]); w.y = pk2(g[2] * sigmoidf_(g[2]) * up[2], g[3] * sigmoidf_(g[3]) * up[3]);
            *(uint2*)(hbuf + (size_t)(u.hbase + row) * 512 + 16 * (8 * u.pn + 4 * bj + wc) + 4 * fq) = w;
          }
        }
      }
  }
};
__device__ __forceinline__ void phase_moe1(const P& p, int layer, LAS unsigned char* lds) {
  pg8::PlanOrder S; S.init(p.ws + WS_PLAN + layer * 65536, (const int4*)(p.ws + WS_LIST2), p.ws + WS_XA, DM, p.ws + (layer ? WS_MW1 : WS_MW0), (size_t)DM * DM, DM, true);
  EpiMoe1 E{(u16*)(p.ws + WS_H), (const int4*)(p.ws + WS_LIST2)};
  pg8::gemm_phase<EpiMoe1, pg8::PlanOrder, G_ALIGN, G_SP2>(lds, DM, S, E);
}
struct EpiMoe2 {
  static constexpr bool PERM = true;
  const int4* list; u16* slots;
  __device__ __forceinline__ void operator()(const f32x4 (&acc)[2][2][4][2], const pg8::Unit& u, int wr, int wc, int fr, int fq) const {
#pragma unroll
    for (int ai = 0; ai < 2; ++ai)
#pragma unroll
      for (int m = 0; m < 4; ++m) {
        const int row = u.pm * 256 + ai * 128 + wr * 64 + m * 16 + fr;
        if (row < u.cnt) {
          const int4 en = list[(size_t)u.e * CAP + row];
          const int asg = en.x; const float gt = __int_as_float(en.y);
#pragma unroll
          for (int bj = 0; bj < 2; ++bj) {
            const f32x4 v0 = acc[ai][bj][m][0] * gt, v1 = acc[ai][bj][m][1] * gt;
            uint4 w; w.x = pk2(v0[0], v0[1]); w.y = pk2(v0[2], v0[3]); w.z = pk2(v1[0], v1[1]); w.w = pk2(v1[2], v1[3]);
            *(uint4*)(slots + (size_t)asg * DM + u.pn * 256 + bj * 128 + wc * 32 + 8 * fq) = w;
          }
        }
      }
  }
};
__device__ __forceinline__ void phase_moe2(const P& p, int layer, LAS unsigned char* lds) {
  pg8::PlanOrder S; S.init(p.ws + WS_PLAN + layer * 65536, (const int4*)(p.ws + WS_LIST2), p.ws + WS_H, 512, p.ws + (layer ? WS_MW1 : WS_MW0) + 64 * MB, (size_t)DM * 512, 512, false);
  EpiMoe2 E{(const int4*)(p.ws + WS_LIST2), (u16*)(p.ws + WS_INC)};
  pg8::gemm_phase<EpiMoe2, pg8::PlanOrder, G_ALIGN, G_SP2>(lds, 512, S, E);
}

#define XB_TMO      128
#define XB_XCNT(j)  (256  + 64 * (j))
#define XB_XSUB(j)  (1280 + 64 * (j))
#define XB_XGEN(j)  (2304 + 64 * (j))
#define XB_TOP      3328
#define XB_TOPGEN   3392
#define XCD_BAR_WORDS 3456
#define XB_SPIN_CAP (1u << 22)
__device__ __forceinline__ unsigned xb_ld(unsigned* p)              { return __hip_atomic_load(p, __ATOMIC_RELAXED, __HIP_MEMORY_SCOPE_AGENT); }
__device__ __forceinline__ unsigned xb_add(unsigned* p, unsigned v) { return __hip_atomic_fetch_add(p, v, __ATOMIC_RELAXED, __HIP_MEMORY_SCOPE_AGENT); }
__device__ __forceinline__ unsigned xb_xcc_id() { return (unsigned)__builtin_amdgcn_s_getreg((3 << 11) | 20) & 0xFu; }
#define XB_SPIN(cond, bar) do { unsigned _sp = 0; while (cond) { __builtin_amdgcn_s_sleep(1); \
    if ((++_sp & 255u) == 0u) { if (xb_ld(&(bar)[XB_TMO])) break; if (_sp > XB_SPIN_CAP) { atomicAdd(&(bar)[XB_TMO], 1u); break; } } } } while (0)
struct XcdBarrier { unsigned* bar; unsigned x; volatile LAS unsigned* st; };
__device__ __forceinline__ XcdBarrier xcd_barrier_post(unsigned* bar, volatile LAS unsigned* st) {
  XcdBarrier b; b.bar = bar; b.x = xb_xcc_id(); b.st = st;
  if (tidx() == 0) (void)xb_add(&bar[XB_XCNT(b.x)], 1u);
  return b;
}
__device__ __forceinline__ void xcd_barrier_complete(unsigned* bar, unsigned x, unsigned& nloc, unsigned& nx) {
  const unsigned G = gridDim.x * gridDim.y * gridDim.z;
  unsigned sum, cnt, mine, sp = 0u;
  for (;;) {
    sum = 0u; cnt = 0u; mine = 0u;
#pragma unroll
    for (unsigned j = 0; j < 16; ++j) { const unsigned c = xb_ld(&bar[XB_XCNT(j)]); sum += c; cnt += (c > 0u) ? 1u : 0u; mine = (j == x) ? c : mine; }
    if (sum == G) break;
    __builtin_amdgcn_s_sleep(1);
    if ((++sp & 255u) == 0u) { if (xb_ld(&bar[XB_TMO])) break; if (sp > XB_SPIN_CAP) { atomicAdd(&bar[XB_TMO], 1u); break; } }
  }
  nloc = mine > 0u ? mine : 1u; nx = cnt > 0u ? cnt : 1u;
}
__device__ __forceinline__ void xcd_barrier(const XcdBarrier& b) {
  asm volatile("s_waitcnt vmcnt(0)" ::: "memory");
  __syncthreads();
  if (tidx() == 0) {
    unsigned* bar = b.bar;
    __builtin_amdgcn_s_waitcnt(0);
    unsigned nloc = b.st[0], nx = b.st[1];
    if (nloc == 0u) { xcd_barrier_complete(bar, b.x, nloc, nx); b.st[0] = nloc; b.st[1] = nx; }
    const unsigned old = xb_add(&bar[XB_XSUB(b.x)], 1u);
    const unsigned gen = old / nloc;
    if (old + 1u == (gen + 1u) * nloc) {
      __builtin_amdgcn_fence(__ATOMIC_RELEASE, "agent");
      asm volatile("s_waitcnt vmcnt(0)" ::: "memory");
      const unsigned og = xb_add(&bar[XB_TOP], 1u);
      const unsigned tg = og / nx;
      if (og + 1u == (tg + 1u) * nx) xb_add(&bar[XB_TOPGEN], 1u);
      else XB_SPIN(xb_ld(&bar[XB_TOPGEN]) == tg, bar);
      __builtin_amdgcn_fence(__ATOMIC_ACQUIRE, "agent");
      xb_add(&bar[XB_XGEN(b.x)], 1u);
      asm volatile("s_waitcnt vmcnt(0)" ::: "memory");
    } else {
      XB_SPIN(xb_ld(&bar[XB_XGEN(b.x)]) == gen, bar);
      __builtin_amdgcn_fence(__ATOMIC_ACQUIRE, "agent");
      asm volatile("s_waitcnt vmcnt(0)" ::: "memory");
    }
  }
  __syncthreads();
}

constexpr int NPHASE = 20;
#ifndef C0A
#define C0A 0
#define C0B 35
#define C1A 40
#endif
constexpr int LDS_BYTES = 147456;
__device__ __forceinline__ void run_phase(const P& p, int ph, char* smem, LAS unsigned char* lds) {
  u16* xa = (u16*)(p.ws + WS_XA);
  float* rsd = (float*)(p.ws + WS_RSTD);
  const u16* slots = (const u16*)(p.ws + WS_INC);
  switch (ph) {
    case 0: phase_rowpass(p, p.x, nullptr, nullptr, (u16*)(p.ws + WS_XB), rsd, nullptr, -1, nullptr, smem); phase_prep(p); __syncthreads(); phase_conv_dense(p, smem); break;
    case 1: phase_inproj(p, lds); phase_s5_fill_bc(p); phase_conv_moe(p, 0, 0, cq(C0A), 128, 128, smem); break;
    case 2: phase_ret_inc_mfma(p, smem); __syncthreads(); phase_s5_egemm(p, lds); phase_s5_ktab(p, smem); break;
    case 3: phase_ret_scan16(p); phase_s5_carry(p); phase_s5_fill_a(p); break;
    case 4: phase_ret_out_mfma(p, smem); __syncthreads(); phase_s5_ygemm(p, lds); break;
    case 5: phase_glu(p, lds); phase_conv_moe(p, 0, cq(C0A), cq(C0B), 128, 128, smem); break;
    case 6: phase_outproj<false>(p, p.ws + WS_WOUT, p.x, nullptr, xa, lds); break;
    case 7: phase_rowpass(p, nullptr, xa, nullptr, nullptr, nullptr, nullptr, 0, nullptr, smem); break;
    case 8: phase_moe_plan(p, 0, smem); phase_conv_moe(p, 0, cq(C0B), CONV_ITEMS, 1, 255, smem); break;
    case 9: phase_moe1(p, 0, lds); break;
    case 10: phase_moe2(p, 0, lds); break;
    case 11: phase_rowpass(p, nullptr, xa, slots, xa, rsd, nullptr, -1, nullptr, smem); break;
    case 12: phase_qkv(p, lds); phase_conv_moe(p, 1, 0, cq(C1A), 128, 128, smem); break;
    case 13: phase_attn(p, smem); break;
    case 14: phase_outproj<true>(p, p.ws + WS_WO, nullptr, xa, xa, lds); break;
    case 15: phase_rowpass(p, nullptr, xa, nullptr, nullptr, nullptr, nullptr, 1, nullptr, smem); break;
    case 16: phase_moe_plan(p, 1, smem); phase_conv_moe(p, 1, cq(C1A), CONV_ITEMS, 1, 255, smem); break;
    case 17: phase_moe1(p, 1, lds); break;
    case 18: phase_moe2(p, 1, lds); break;
    case 19: phase_rowpass(p, nullptr, xa, slots, nullptr, nullptr, p.norm_final_g, -1, p.out, smem); break;
    default: break;
  }
}

extern __shared__ __attribute__((aligned(16))) char dyn_smem[];

template <int PH> __device__ __forceinline__ void mega_steps(const P& p, char* smem, LAS unsigned char* lds, const XcdBarrier& xb) {
  run_phase(p, PH, smem, lds);
  if constexpr (PH + 1 < NPHASE) {
    xcd_barrier(xb);
    mega_steps<PH + 1>(p, smem, lds, xb);
  }
}
__global__ void __launch_bounds__(NTHR, 2) k_mega(P p) {
  LAS unsigned char* lds = (LAS unsigned char*)dyn_smem;
  volatile LAS unsigned* st = (volatile LAS unsigned*)(lds + LDS_BYTES - 16);
  if (tidx() == 0) { st[0] = 0u; st[1] = 0u; }
  __syncthreads();
  const XcdBarrier xb = xcd_barrier_post((unsigned*)(p.ws + WS_BAR), st);
  mega_steps<0>(p, dyn_smem, lds, xb);
}

extern "C" void kernel_launch(void* const* d_in, const int* in_sizes, int n_in, void* d_out, int out_size, void* d_ws, size_t ws_size, hipStream_t stream) {
  static int grid_blocks = 0;
  if (grid_blocks == 0) {
    if (n_in != 28 || out_size != T_TOK * DM || ws_size < WS_END) { fprintf(stderr, "kernel_launch: unexpected problem (n_in %d out %d ws %zu need %zu)\n", n_in, out_size, ws_size, (size_t)WS_END); grid_blocks = -1; return; }
    int dev = 0, cus = 0, per_cu = 0;
    (void)hipGetDevice(&dev);
    (void)hipDeviceGetAttribute(&cus, hipDeviceAttributeMultiprocessorCount, dev);
    const void* fn = (const void*)k_mega;
    if (hipFuncSetAttribute(fn, hipFuncAttributeMaxDynamicSharedMemorySize, LDS_BYTES) != hipSuccess) { fprintf(stderr, "kernel_launch: hipFuncSetAttribute failed\n"); }
    if (hipOccupancyMaxActiveBlocksPerMultiprocessor(&per_cu, fn, NTHR, LDS_BYTES) != hipSuccess || per_cu < 1) { fprintf(stderr, "kernel_launch: occupancy query failed (%d)\n", per_cu); per_cu = 1; }
    (void)hipGetLastError();
    if (per_cu > 1) per_cu = 1;
    grid_blocks = cus * per_cu;
    fprintf(stderr, "kernel_launch: cus %d per_cu %d grid %d\n", cus, per_cu, grid_blocks);
  }
  if (grid_blocks < 0) return;
  P p{};
  const float** pp = (const float**)&p;
  for (int i = 0; i < 28; ++i) pp[i] = (const float*)d_in[i];
  p.out = (float*)d_out; p.ws = (char*)d_ws;
  (void)hipMemsetAsync((char*)d_ws + WS_BAR, 0, XCD_BAR_WORDS * 4, stream);
  void* args[] = {&p};
  const hipError_t e = hipLaunchCooperativeKernel((const void*)k_mega, dim3(grid_blocks), dim3(NTHR), args, LDS_BYTES, stream);
  if (e != hipSuccess) fprintf(stderr, "cooperative launch failed: %s (grid %d)\n", hipGetErrorString(e), grid_blocks);
}
```
